# Optimizing an MI355X kernel written in HIP

```python
import math
import jax
import jax.numpy as jnp
from jax import lax
import numpy as np

D_MODEL = 2048
BATCH = 8
SEQ = 4096
DEPTH = 2

GRID_W = 64
HEAD_DIM = 128
Q_BLOCK = 128
ROPE_THETA = 10000.0
RMS_EPS = 1e-6
LN_EPS = 1e-5

A_HEADS = 8
A_KV_HEADS = 2
A_Q_DIM = A_HEADS * HEAD_DIM
A_KV_DIM = A_KV_HEADS * HEAD_DIM

B_HEADS = 8
B_DIM = B_HEADS * HEAD_DIM
B_BRANCHES = ((128, 1), (512, 4), (2048, 16))

C_HEADS = 8
C_DIM = C_HEADS * HEAD_DIM
NA_ROWS = 8
NA_COLS = 16

D_HEADS = 8
D_Q_RANK = 512
D_KV_RANK = 256
D_NOPE = 128
D_ROPE = 64
D_V = 128

IN0_DIM = A_Q_DIM + 2 * A_KV_DIM + 3 * B_DIM
IN1_DIM = 3 * C_DIM + D_Q_RANK + D_KV_RANK + D_ROPE
MIX_DIM = A_Q_DIM + B_DIM

N_EXPERTS = 32
N_GROUPS = 8
EXPERTS_PER_GROUP = N_EXPERTS // N_GROUPS
TOP_K = 2
D_EXPERT = 512
MOE_BLOCK = 256

ALPHA = (2.0 * DEPTH) ** 0.25
BETA = (8.0 * DEPTH) ** -0.25

kernel_name = 'hybrid_axial_dilated_na_mla_moe_encoder'


def rms_norm(x, g):
    xf = x.astype(jnp.float32)
    y = xf * lax.rsqrt(jnp.mean(xf * xf, axis=-1, keepdims=True) + RMS_EPS)
    return (y * g.astype(jnp.float32)).astype(x.dtype)


def layer_norm(x, g, b):
    xf = x.astype(jnp.float32)
    mu = jnp.mean(xf, axis=-1, keepdims=True)
    xc = xf - mu
    var = jnp.mean(xc * xc, axis=-1, keepdims=True)
    return (xc * lax.rsqrt(var + LN_EPS) * g.astype(jnp.float32) + b.astype(jnp.float32)).astype(x.dtype)


def rope_angles(pos, dim):
    inv_freq = ROPE_THETA ** (-jnp.arange(0, dim, 2, dtype=jnp.float32) / dim)
    return pos.astype(jnp.float32)[:, None] * inv_freq[None, :]


def apply_rope(x, ang):
    xf = x.astype(jnp.float32)
    x1, x2 = jnp.split(xf, 2, axis=-1)
    cos = jnp.cos(ang)[:, None, :]
    sin = jnp.sin(ang)[:, None, :]
    return jnp.concatenate([x1 * cos - x2 * sin, x2 * cos + x1 * sin], axis=-1).astype(x.dtype)


def alibi_slopes(n):
    return jnp.asarray(2.0 ** (-8.0 * np.arange(1, n + 1) / n), dtype=jnp.float32)


def dense_blocked_attention(q, k, v, scale):
    Bsz, S, Hkv, G, dq = q.shape
    dv = v.shape[-1]
    nb = S // Q_BLOCK
    qb = q.reshape(Bsz, nb, Q_BLOCK, Hkv, G, dq).transpose(1, 0, 2, 3, 4, 5)

    def block(qblk):
        s = jnp.einsum('bqhgd,bkhd->bhgqk', qblk, k).astype(jnp.float32) * scale
        p = jax.nn.softmax(s, axis=-1).astype(v.dtype)
        return jnp.einsum('bhgqk,bkhd->bqhgd', p, v)

    o = lax.map(block, qb)
    return o.transpose(1, 0, 2, 3, 4, 5).reshape(Bsz, S, Hkv, G, dv)


def dilated_branch(q, k, v, window, dil, slopes):
    Bsz, S, H, hd = q.shape
    half = window // (2 * dil)
    L = S // dil
    N = Bsz * dil
    nb = -(-L // half)
    Lp = nb * half

    def strided(t):
        return t.reshape(Bsz, L, dil, H, hd).transpose(0, 2, 1, 3, 4).reshape(N, L, H, hd)

    qs = jnp.pad(strided(q), ((0, 0), (0, Lp - L), (0, 0), (0, 0))).reshape(N, nb, half, H, hd)
    kpad = ((0, 0), (half, Lp - L + half), (0, 0), (0, 0))
    ks = jnp.pad(strided(k), kpad).reshape(N, nb + 2, half, H, hd)
    vs = jnp.pad(strided(v), kpad).reshape(N, nb + 2, half, H, hd)
    kw = jnp.concatenate([ks[:, :-2], ks[:, 1:-1], ks[:, 2:]], axis=2)
    vw = jnp.concatenate([vs[:, :-2], vs[:, 1:-1], vs[:, 2:]], axis=2)

    qpos = jnp.arange(Lp).reshape(nb, half)
    kpos = jnp.arange(nb)[:, None] * half - half + jnp.arange(3 * half)[None, :]
    rel = kpos[:, None, :] - qpos[:, :, None]
    valid = (jnp.abs(rel) <= half) & (kpos[:, None, :] >= 0) & (kpos[:, None, :] < L)
    dist = (jnp.abs(rel) * dil).astype(jnp.float32)
    bias = -slopes[:, None, None, None] * dist[None]

    s = jnp.einsum('nbqhd,nbkhd->nhbqk', qs, kw).astype(jnp.float32) * (hd ** -0.5) + bias[None]
    s = jnp.where(valid[None, None], s, -jnp.inf)
    m = jnp.max(s, axis=-1, keepdims=True)
    p = jnp.exp(s - m)
    den = jnp.sum(p, axis=-1, keepdims=True)
    o = jnp.einsum('nhbqk,nbkhd->nbqhd', (p / den).astype(v.dtype), vw)
    lse = (m + jnp.log(den))[..., 0]

    o = o.reshape(Bsz, dil, Lp, H, hd)[:, :, :L].transpose(0, 2, 1, 3, 4).reshape(Bsz, S, H, hd)
    lse = lse.reshape(Bsz, dil, H, Lp)[..., :L].transpose(0, 3, 1, 2).reshape(Bsz, S, H)
    return o, lse


def dilated_attention(q, k, v):
    slopes = alibi_slopes(q.shape[2])
    outs = []
    lses = []
    for window, dil in B_BRANCHES:
        o, l = dilated_branch(q, k, v, window, dil, slopes)
        outs.append(o)
        lses.append(l)
    w = jax.nn.softmax(jnp.stack(lses, axis=0), axis=0)
    o = jnp.stack(outs, axis=0).astype(jnp.float32)
    return jnp.sum(w[..., None] * o, axis=0).astype(q.dtype)


def neighbourhood_attention(q, k, v, rpb):
    Bsz, S, H, hd = q.shape
    rows = S // GRID_W
    kr = min(NA_ROWS, rows)
    nk = kr * GRID_W
    col = jnp.arange(GRID_W)
    c0 = jnp.clip(col - NA_COLS // 2, 0, GRID_W - NA_COLS)
    kcol = jnp.tile(col, kr)
    krow = jnp.repeat(jnp.arange(kr), GRID_W)
    col_ok = (kcol[None, :] >= c0[:, None]) & (kcol[None, :] < c0[:, None] + NA_COLS)
    dcol = jnp.clip(kcol[None, :] - col[:, None] + NA_COLS - 1, 0, 2 * NA_COLS - 2)
    qr = q.reshape(Bsz, rows, GRID_W, H, hd).transpose(1, 0, 2, 3, 4)

    def row_block(args):
        r, qrow = args
        r0 = jnp.clip(r - NA_ROWS // 2, 0, rows - kr)
        kb = lax.dynamic_slice_in_dim(k, r0 * GRID_W, nk, axis=1)
        vb = lax.dynamic_slice_in_dim(v, r0 * GRID_W, nk, axis=1)
        drow = r0 + krow - r + NA_ROWS - 1
        bias = rpb[:, drow[None, :], dcol].astype(jnp.float32)
        s = jnp.einsum('bqhd,bkhd->bhqk', qrow, kb).astype(jnp.float32) * (hd ** -0.5) + bias[None]
        s = jnp.where(col_ok[None, None], s, -jnp.inf)
        p = jax.nn.softmax(s, axis=-1).astype(v.dtype)
        return jnp.einsum('bhqk,bkhd->bqhd', p, vb)

    o = lax.map(row_block, (jnp.arange(rows), qr))
    return o.transpose(1, 0, 2, 3, 4).reshape(Bsz, S, H, hd)


def mixer_ab(x, w_in, a_q_norm, a_k_norm, w_out):
    Bsz, S, _ = x.shape
    h = x @ w_in
    cuts = [A_Q_DIM, A_Q_DIM + A_KV_DIM, A_Q_DIM + 2 * A_KV_DIM,
            A_Q_DIM + 2 * A_KV_DIM + B_DIM, A_Q_DIM + 2 * A_KV_DIM + 2 * B_DIM]
    qa, ka, va, qb, kb, vb = jnp.split(h, cuts, axis=-1)
    pos = jnp.arange(S)
    half = HEAD_DIM // 2
    ang_row = rope_angles(pos // GRID_W, half)
    ang_col = rope_angles(pos % GRID_W, half)

    def axial(t):
        return jnp.concatenate([apply_rope(t[..., :half], ang_row), apply_rope(t[..., half:], ang_col)], axis=-1)

    qa = axial(rms_norm(qa.reshape(Bsz, S, A_HEADS, HEAD_DIM), a_q_norm))
    ka = axial(rms_norm(ka.reshape(Bsz, S, A_KV_HEADS, HEAD_DIM), a_k_norm))
    va = va.reshape(Bsz, S, A_KV_HEADS, HEAD_DIM)
    groups = A_HEADS // A_KV_HEADS
    oa = dense_blocked_attention(qa.reshape(Bsz, S, A_KV_HEADS, groups, HEAD_DIM), ka, va,
                                 HEAD_DIM ** -0.5).reshape(Bsz, S, A_Q_DIM)
    shp = (Bsz, S, B_HEADS, HEAD_DIM)
    ob = dilated_attention(qb.reshape(shp), kb.reshape(shp), vb.reshape(shp)).reshape(Bsz, S, B_DIM)
    return jnp.concatenate([oa, ob], axis=-1) @ w_out


def mixer_cd(x, w_in, c_rpb, d_q_norm, d_w_q_up, d_kv_norm, d_w_kv_up, w_out):
    Bsz, S, _ = x.shape
    h = x @ w_in
    cuts = [C_DIM, 2 * C_DIM, 3 * C_DIM, 3 * C_DIM + D_Q_RANK, 3 * C_DIM + D_Q_RANK + D_KV_RANK]
    qc, kc, vc, cq, ckv, kr = jnp.split(h, cuts, axis=-1)
    shp = (Bsz, S, C_HEADS, HEAD_DIM)
    oc = neighbourhood_attention(qc.reshape(shp), kc.reshape(shp), vc.reshape(shp), c_rpb).reshape(Bsz, S, C_DIM)
    ang = rope_angles(jnp.arange(S), D_ROPE)
    q = (rms_norm(cq, d_q_norm) @ d_w_q_up).reshape(Bsz, S, D_HEADS, D_NOPE + D_ROPE)
    kv = (rms_norm(ckv, d_kv_norm) @ d_w_kv_up).reshape(Bsz, S, D_HEADS, D_NOPE + D_V)
    q = jnp.concatenate([q[..., :D_NOPE], apply_rope(q[..., D_NOPE:], ang)], axis=-1)
    k_rope = jnp.broadcast_to(apply_rope(kr[:, :, None, :], ang), (Bsz, S, D_HEADS, D_ROPE))
    k = jnp.concatenate([kv[..., :D_NOPE], k_rope], axis=-1)
    v = kv[..., D_NOPE:]
    od = dense_blocked_attention(q[:, :, :, None, :], k, v,
                                 (D_NOPE + D_ROPE) ** -0.5).reshape(Bsz, S, D_HEADS * D_V)
    return jnp.concatenate([oc, od], axis=-1) @ w_out


def moe(x, router_w, router_b, w_gate, w_up, w_down):
    Bsz, S, D = x.shape
    T = Bsz * S
    xf = x.reshape(T, D)
    scores = jax.nn.sigmoid(xf.astype(jnp.float32) @ router_w.astype(jnp.float32))
    sel = scores + router_b.astype(jnp.float32)
    grp_score = jnp.sum(lax.top_k(sel.reshape(T, N_GROUPS, EXPERTS_PER_GROUP), TOP_K)[0], axis=-1)
    g = jnp.argmax(grp_score, axis=-1)
    in_grp = (jnp.arange(N_EXPERTS) // EXPERTS_PER_GROUP)[None, :] == g[:, None]
    _, eid = lax.top_k(jnp.where(in_grp, sel, -jnp.inf), TOP_K)
    gate = jnp.take_along_axis(scores, eid, axis=-1)
    gate = gate / jnp.sum(gate, axis=-1, keepdims=True)

    n_assign = T * TOP_K
    flat_e = eid.reshape(n_assign)
    flat_tok = jnp.repeat(jnp.arange(T, dtype=jnp.int32), TOP_K)
    flat_w = gate.reshape(n_assign)
    order = jnp.argsort(flat_e)
    se = flat_e[order]
    stok = flat_tok[order]
    sw = flat_w[order]
    counts = jnp.zeros((N_EXPERTS,), jnp.int32).at[flat_e].add(1)
    starts = jnp.cumsum(counts) - counts
    pcounts = (counts + MOE_BLOCK - 1) // MOE_BLOCK * MOE_BLOCK
    pends = jnp.cumsum(pcounts)
    pstarts = pends - pcounts
    dest = pstarts[se] + (jnp.arange(n_assign, dtype=jnp.int32) - starts[se])
    n_blocks = (n_assign + N_EXPERTS * (MOE_BLOCK - 1) + MOE_BLOCK - 1) // MOE_BLOCK
    n_rows = n_blocks * MOE_BLOCK
    row_tok = jnp.zeros((n_rows,), jnp.int32).at[dest].set(stok)
    blk_e = jnp.minimum(jnp.searchsorted(pends, jnp.arange(n_blocks) * MOE_BLOCK, side='right'), N_EXPERTS - 1)

    def expert_block(args):
        e, toks = args
        xb = xf[toks]
        hb = jax.nn.silu(xb @ w_gate[e]) * (xb @ w_up[e])
        return hb @ w_down[e]

    y_rows = lax.map(expert_block, (blk_e, row_tok.reshape(n_blocks, MOE_BLOCK))).reshape(n_rows, D)
    y = y_rows[dest] * sw[:, None].astype(y_rows.dtype)
    out = jax.ops.segment_sum(y, stok, num_segments=T)
    return out.reshape(Bsz, S, D)


def setup_inputs(seed: int = 0) -> dict:
    key = jax.random.key(seed)
    ks = iter(jax.random.split(key, 32))
    d = D_MODEL

    def nrm(shape, scale):
        return jax.random.normal(next(ks), shape, jnp.float32) * scale

    def gain(n):
        return 1.0 + nrm((n,), 0.02)

    inp = {}
    inp['x'] = nrm((BATCH, SEQ, d), 1.0)
    inp['router_w'] = nrm((d, N_EXPERTS), d ** -0.5)
    inp['router_b'] = nrm((N_EXPERTS,), 0.01)
    inp['l0_w_in'] = nrm((d, IN0_DIM), d ** -0.5)
    inp['l0_a_q_norm'] = gain(HEAD_DIM)
    inp['l0_a_k_norm'] = gain(HEAD_DIM)
    inp['l0_w_out'] = nrm((MIX_DIM, d), MIX_DIM ** -0.5 * BETA)
    inp['l0_ln1_g'] = gain(d)
    inp['l0_ln1_b'] = nrm((d,), 0.02)
    inp['l0_w_gate'] = nrm((N_EXPERTS, d, D_EXPERT), d ** -0.5)
    inp['l0_w_up'] = nrm((N_EXPERTS, d, D_EXPERT), d ** -0.5)
    inp['l0_w_down'] = nrm((N_EXPERTS, D_EXPERT, d), D_EXPERT ** -0.5 * BETA)
    inp['l0_ln2_g'] = gain(d)
    inp['l0_ln2_b'] = nrm((d,), 0.02)
    inp['l1_w_in'] = nrm((d, IN1_DIM), d ** -0.5)
    inp['l1_c_rpb'] = nrm((C_HEADS, 2 * NA_ROWS - 1, 2 * NA_COLS - 1), 0.1)
    inp['l1_d_q_norm'] = gain(D_Q_RANK)
    inp['l1_d_w_q_up'] = nrm((D_Q_RANK, D_HEADS * (D_NOPE + D_ROPE)), D_Q_RANK ** -0.5)
    inp['l1_d_kv_norm'] = gain(D_KV_RANK)
    inp['l1_d_w_kv_up'] = nrm((D_KV_RANK, D_HEADS * (D_NOPE + D_V)), D_KV_RANK ** -0.5)
    inp['l1_w_out'] = nrm((MIX_DIM, d), MIX_DIM ** -0.5 * BETA)
    inp['l1_ln1_g'] = gain(d)
    inp['l1_ln1_b'] = nrm((d,), 0.02)
    inp['l1_w_gate'] = nrm((N_EXPERTS, d, D_EXPERT), d ** -0.5)
    inp['l1_w_up'] = nrm((N_EXPERTS, d, D_EXPERT), d ** -0.5)
    inp['l1_w_down'] = nrm((N_EXPERTS, D_EXPERT, d), D_EXPERT ** -0.5 * BETA)
    inp['l1_ln2_g'] = gain(d)
    inp['l1_ln2_b'] = nrm((d,), 0.02)
    return inp


def reference(x, router_w, router_b,
              l0_w_in, l0_a_q_norm, l0_a_k_norm, l0_w_out, l0_ln1_g, l0_ln1_b,
              l0_w_gate, l0_w_up, l0_w_down, l0_ln2_g, l0_ln2_b,
              l1_w_in, l1_c_rpb, l1_d_q_norm, l1_d_w_q_up, l1_d_kv_norm, l1_d_w_kv_up, l1_w_out,
              l1_ln1_g, l1_ln1_b, l1_w_gate, l1_w_up, l1_w_down, l1_ln2_g, l1_ln2_b):
    mixers = (
        lambda h: mixer_ab(h, l0_w_in, l0_a_q_norm, l0_a_k_norm, l0_w_out),
        lambda h: mixer_cd(h, l1_w_in, l1_c_rpb, l1_d_q_norm, l1_d_w_q_up, l1_d_kv_norm, l1_d_w_kv_up, l1_w_out),
    )
    post = (
        (l0_ln1_g, l0_ln1_b, l0_w_gate, l0_w_up, l0_w_down, l0_ln2_g, l0_ln2_b),
        (l1_ln1_g, l1_ln1_b, l1_w_gate, l1_w_up, l1_w_down, l1_ln2_g, l1_ln2_b),
    )
    for layer in range(DEPTH):
        ln1_g, ln1_b, w_gate, w_up, w_down, ln2_g, ln2_b = post[layer]
        x = layer_norm(ALPHA * x + mixers[layer % 2](x), ln1_g, ln1_b)
        x = layer_norm(ALPHA * x + moe(x, router_w, router_b, w_gate, w_up, w_down), ln2_g, ln2_b)
    return x
```

```cpp
#include <hip/hip_runtime.h>
#include <cstdio>
#include <cstdint>

#ifndef N_LAUNCH_MODE
#define N_LAUNCH_MODE 0
#endif
#ifndef DBG_CHECK
#define DBG_CHECK 0
#endif

#define LAS __attribute__((address_space(3)))
typedef unsigned short bf16_t;
typedef short bf16x8 __attribute__((ext_vector_type(8)));
typedef short s16x4 __attribute__((ext_vector_type(4)));
typedef float f32x2 __attribute__((ext_vector_type(2)));
typedef float f32x4 __attribute__((ext_vector_type(4)));
typedef float f32x8 __attribute__((ext_vector_type(8)));
typedef float f32x16 __attribute__((ext_vector_type(16)));
typedef unsigned u32x2 __attribute__((ext_vector_type(2)));
typedef unsigned u32x4 __attribute__((ext_vector_type(4)));

constexpr int T_ = 32768, DM = 2048, SEQ = 4096, NBATCH = 8;
constexpr int IN0 = 4608, IN1 = 3904, IN1P = 4096;
constexpr int NE = 32, DE = 512, MAXBLK = 288;
constexpr float ALPHA = 1.4142135623730951f;
constexpr float LOG2E = 1.4426950408889634f;
constexpr int NTHR = 512;

constexpr size_t MiB = 1u << 20;
constexpr size_t WS_CTL = 0, CTL_ZERO_BYTES = 1 * MiB;
constexpr size_t WS_LIST = 1 * MiB;
constexpr size_t WS_TOKE = 9 * MiB;
constexpr size_t WS_TOKP = WS_TOKE + 256 * 1024;
constexpr size_t WS_TOKG = WS_TOKP + 256 * 1024;
constexpr size_t WS_RSTAT = WS_TOKG + 256 * 1024;
constexpr size_t WS_KROPE = 10 * MiB;
constexpr size_t WS_WIN0 = 16 * MiB, WS_WOUT0 = 34 * MiB, WS_WGU0 = 42 * MiB, WS_WD0 = 170 * MiB;
constexpr size_t WS_WIN1 = 234 * MiB, WS_WOUT1 = 250 * MiB, WS_WGU1 = 258 * MiB, WS_WD1 = 386 * MiB;
constexpr size_t WS_WQUP = 450 * MiB, WS_WKVUP = 452 * MiB;
constexpr size_t WS_RA = 454 * MiB, WS_RB = 582 * MiB, WS_RC = 870 * MiB, WS_END = 998 * MiB;
constexpr size_t OUT_QD = 0, OUT_O1 = 96 * MiB;
constexpr int CW_CNT = 64;
constexpr int CW_DBG = 512;
constexpr int CW_BAR = 4096;

constexpr int LDS_BYTES = 155648;
constexpr int MISC_OFF = LDS_BYTES - 64;

__device__ __forceinline__ unsigned cvtpk(float lo, float hi) { unsigned r; asm volatile("v_cvt_pk_bf16_f32 %0, %1, %2" : "=v"(r) : "v"(lo), "v"(hi)); return r; }
__device__ __forceinline__ float bf2f(unsigned short b) { return __uint_as_float(((unsigned)b) << 16); }
__device__ __forceinline__ float bflo(unsigned w) { return __uint_as_float(w << 16); }
__device__ __forceinline__ float bfhi(unsigned w) { return __uint_as_float(w & 0xffff0000u); }
__device__ __forceinline__ bf16_t f2bf(float f) { return (bf16_t)(cvtpk(f, f) & 0xffffu); }
__device__ __forceinline__ int fresh_tid() { int t = threadIdx.x; asm volatile("" : "+v"(t)); return t; }
__device__ __forceinline__ float fresh_zero() { float z; asm volatile("v_mov_b32 %0, 0" : "=v"(z)); return z; }
__device__ __forceinline__ float wave_sum(float v) {
#pragma unroll
    for (int o = 32; o >= 1; o >>= 1) v += __shfl_xor(v, o);
    return v;
}
__device__ __forceinline__ float inv_freq32(int i) { return __builtin_amdgcn_exp2f(-(float)i * 0.41524101186092029f); }
__device__ __forceinline__ void sincos_rev(float angle, float& s, float& c) {
    float rev = angle * 0.15915494309189535f; rev = rev - floorf(rev);
    s = __builtin_amdgcn_sinf(rev); c = __builtin_amdgcn_cosf(rev);
}

#define XB_TMO      128
#define XB_XCNT(j)  (256  + 64 * (j))
#define XB_XSUB(j)  (1280 + 64 * (j))
#define XB_XGEN(j)  (2304 + 64 * (j))
#define XB_TOP      3328
#define XB_TOPGEN   3392
#define XCD_BAR_WORDS 3456
#define XB_SPIN_CAP (1u << 20)
__device__ __forceinline__ unsigned xb_ld(unsigned* p)              { return __hip_atomic_load(p, __ATOMIC_RELAXED, __HIP_MEMORY_SCOPE_AGENT); }
__device__ __forceinline__ unsigned xb_add(unsigned* p, unsigned v) { return __hip_atomic_fetch_add(p, v, __ATOMIC_RELAXED, __HIP_MEMORY_SCOPE_AGENT); }
__device__ __forceinline__ unsigned xb_xcc_id() { return (unsigned)__builtin_amdgcn_s_getreg((3 << 11) | 20) & 0xFu; }
#define XB_SPIN(cond, bar) do { unsigned _sp = 0; while (cond) { __builtin_amdgcn_s_sleep(1); \
    if ((++_sp & 255u) == 0u) { if (xb_ld(&(bar)[XB_TMO])) break; if (_sp > XB_SPIN_CAP) { atomicAdd(&(bar)[XB_TMO], 1u); break; } } } } while (0)
struct XcdBarrier { unsigned* bar; unsigned x; volatile LAS unsigned* st; };
__device__ __forceinline__ XcdBarrier xcd_barrier_post(unsigned* bar, volatile LAS unsigned* st) {
    XcdBarrier b; b.bar = bar; b.x = xb_xcc_id(); b.st = st;
    if (threadIdx.x == 0) (void)xb_add(&bar[XB_XCNT(b.x)], 1u);
    return b;
}
__device__ __forceinline__ void xcd_barrier_complete(unsigned* bar, unsigned x, unsigned& nloc, unsigned& nx) {
    const unsigned G = gridDim.x * gridDim.y * gridDim.z;
    unsigned sum, cnt, mine, sp = 0u;
    for (;;) {
        sum = 0u; cnt = 0u; mine = 0u;
#pragma unroll
        for (unsigned j = 0; j < 16; ++j) { const unsigned c = xb_ld(&bar[XB_XCNT(j)]); sum += c; cnt += (c > 0u) ? 1u : 0u; mine = (j == x) ? c : mine; }
        if (sum == G) break;
        __builtin_amdgcn_s_sleep(1);
        if ((++sp & 255u) == 0u) { if (xb_ld(&bar[XB_TMO])) break; if (sp > XB_SPIN_CAP) { atomicAdd(&bar[XB_TMO], 1u); break; } }
    }
    nloc = mine > 0u ? mine : 1u; nx = cnt > 0u ? cnt : 1u;
}
__device__ __forceinline__ void xcd_barrier(const XcdBarrier& b) {
    asm volatile("s_waitcnt vmcnt(0)" ::: "memory");
    __syncthreads();
    if (threadIdx.x == 0) {
        unsigned* bar = b.bar;
        __builtin_amdgcn_s_waitcnt(0);
        unsigned nloc = b.st[0], nx = b.st[1];
        if (nloc == 0u) { xcd_barrier_complete(bar, b.x, nloc, nx); b.st[0] = nloc; b.st[1] = nx; }
        const unsigned old = xb_add(&bar[XB_XSUB(b.x)], 1u);
        const unsigned gen = old / nloc;
        if (old + 1u == (gen + 1u) * nloc) {
            __builtin_amdgcn_fence(__ATOMIC_RELEASE, "agent");
            asm volatile("s_waitcnt vmcnt(0)" ::: "memory");
            const unsigned og = xb_add(&bar[XB_TOP], 1u);
            const unsigned tg = og / nx;
            if (og + 1u == (tg + 1u) * nx) xb_add(&bar[XB_TOPGEN], 1u);
            else XB_SPIN(xb_ld(&bar[XB_TOPGEN]) == tg, bar);
            __builtin_amdgcn_fence(__ATOMIC_ACQUIRE, "agent");
            xb_add(&bar[XB_XGEN(b.x)], 1u);
            asm volatile("s_waitcnt vmcnt(0)" ::: "memory");
        } else {
            XB_SPIN(xb_ld(&bar[XB_XGEN(b.x)]) == gen, bar);
            __builtin_amdgcn_fence(__ATOMIC_ACQUIRE, "agent");
            asm volatile("s_waitcnt vmcnt(0)" ::: "memory");
        }
    }
    __syncthreads();
}

namespace pg8 {
constexpr int BM = 256, BK = 64, HALF = 128, HTB = HALF * BK * 2, STAGE_BYTES = 8 * HTB, NXCD = 8, WGM = 8;
__device__ __forceinline__ int lds_byte(int r, int c) { const int st = (r >> 4) * 2 + (c >> 5), rr = r & 15, cc = c & 31, ob = rr * 64 + cc * 2; return st * 1024 + (ob ^ (((ob >> 9) & 1) << 5)); }
__device__ __forceinline__ void stage_rc(int b, int& R, int& C) { const int st = b / 1024, sb = b % 1024, swz = sb ^ (((sb >> 9) & 1) << 5); R = (st >> 1) * 16 + swz / 64; C = (st & 1) * 32 + (swz % 64) / 2; }
__device__ __forceinline__ int perm32(int rho) { const int n = rho >> 4, i = rho & 15; return 8 * (i >> 2) + 4 * n + (i & 3); }
struct Unit { int pm, pn, q; };
struct Gemm { const bf16_t* A; const bf16_t* Bt; int K, lda, ldb; };

struct StaticOrder {
    static constexpr bool GATHER = false;
    int nM, nN, nwg, G, c, lda;
    __device__ void init(int M, int N, int G_, int c_, int lda_) { nM = M / BM; nN = N / BM; nwg = nM * nN; G = G_; c = c_; lda = lda_; }
    __device__ __forceinline__ bool next(int i, Unit& u) const {
        const long L = (long)i * G + c; if (L >= nwg) return false;
        int wgid = (int)L; { const int q = nwg / NXCD, r = nwg % NXCD, xcd = wgid % NXCD, off = wgid / NXCD; wgid = (xcd < r ? xcd * (q + 1) : r * (q + 1) + (xcd - r) * q) + off; }
        const int nig = WGM * nN, gid = wgid / nig, fm = gid * WGM, gsz = (nM - fm) < WGM ? (nM - fm) : WGM;
        u.pm = fm + ((wgid % nig) % gsz); u.pn = (wgid % nig) / gsz; u.q = i; return true;
    }
    __device__ __forceinline__ void aoff(const Unit& u, const int (&R)[2], const int (&C)[2], unsigned (&o)[2][2]) const {
#pragma unroll
        for (int h = 0; h < 2; ++h)
#pragma unroll
            for (int i = 0; i < 2; ++i) o[h][i] = (unsigned)((u.pm * BM + h * HALF + R[i]) * lda + C[i]) * 2u;
    }
};
template <bool GATHER_> struct TableOrder {
    static constexpr bool GATHER = GATHER_;
    const LAS int* tab; const LAS int* idx; int n, lda;
    __device__ __forceinline__ bool next(int i, Unit& u) const { if (i >= n) return false; u.pm = tab[i]; u.pn = tab[16 + i]; u.q = i; return true; }
    __device__ __forceinline__ void aoff(const Unit& u, const int (&R)[2], const int (&C)[2], unsigned (&o)[2][2]) const {
#pragma unroll
        for (int h = 0; h < 2; ++h)
#pragma unroll
            for (int i = 0; i < 2; ++i) { const int row = GATHER ? idx[u.q * 256 + h * HALF + R[i]] : (u.pm * BM + h * HALF + R[i]); o[h][i] = (unsigned)(row * lda + C[i]) * 2u; }
    }
};

struct EpiBf16 {
    static constexpr bool PERM = true;
    bf16_t* O; int ldc; int pnmask;
    __device__ __forceinline__ void operator()(const f32x4 (&acc)[2][2][4][2], const Unit& u, int wr, int wc, int fr, int fq) const {
        const int row0 = u.pm * BM + wr * 64 + fr; const int col0 = (u.pn & pnmask) * BM + wc * 32 + 8 * fq;
#pragma unroll
        for (int ai = 0; ai < 2; ++ai)
#pragma unroll
            for (int m = 0; m < 4; ++m) { bf16_t* rowp = O + (size_t)(row0 + ai * HALF + m * 16) * ldc + col0;
#pragma unroll
                for (int bj = 0; bj < 2; ++bj) { const f32x4 v0 = acc[ai][bj][m][0], v1 = acc[ai][bj][m][1];
                    u32x4 w; w.x = cvtpk(v0[0], v0[1]); w.y = cvtpk(v0[2], v0[3]); w.z = cvtpk(v1[0], v1[1]); w.w = cvtpk(v1[2], v1[3]);
                    *(u32x4*)(rowp + bj * HALF) = w; } }
    }
};
struct EpiRowScale {
    static constexpr bool PERM = true;
    bf16_t* O; int ldc; const float* rs; int which;
    __device__ __forceinline__ void operator()(const f32x4 (&acc)[2][2][4][2], const Unit& u, int wr, int wc, int fr, int fq) const {
        const int row0 = u.pm * BM + wr * 64 + fr; const int col0 = u.pn * BM + wc * 32 + 8 * fq;
#pragma unroll
        for (int ai = 0; ai < 2; ++ai)
#pragma unroll
            for (int m = 0; m < 4; ++m) { const int row = row0 + ai * HALF + m * 16; const float s = rs[row * 2 + which]; bf16_t* rowp = O + (size_t)row * ldc + col0;
#pragma unroll
                for (int bj = 0; bj < 2; ++bj) { const f32x4 v0 = acc[ai][bj][m][0] * s, v1 = acc[ai][bj][m][1] * s;
                    u32x4 w; w.x = cvtpk(v0[0], v0[1]); w.y = cvtpk(v0[2], v0[3]); w.z = cvtpk(v1[0], v1[1]); w.w = cvtpk(v1[2], v1[3]);
                    *(u32x4*)(rowp + bj * HALF) = w; } }
    }
};
struct EpiSiluMul {
    static constexpr bool PERM = true;
    bf16_t* O;
    __device__ __forceinline__ void operator()(const f32x4 (&acc)[2][2][4][2], const Unit& u, int wr, int wc, int fr, int fq) const {
        const int row0 = u.pm * BM + wr * 64 + fr; const int col0 = (u.pn & 3) * HALF + wc * 32 + 8 * fq;
#pragma unroll
        for (int ai = 0; ai < 2; ++ai)
#pragma unroll
            for (int m = 0; m < 4; ++m) { bf16_t* rowp = O + (size_t)(row0 + ai * HALF + m * 16) * DE + col0; float h[8];
#pragma unroll
                for (int n = 0; n < 2; ++n)
#pragma unroll
                    for (int j = 0; j < 4; ++j) { const float g = acc[ai][0][m][n][j], up = acc[ai][1][m][n][j];
                        const float sg = g * __builtin_amdgcn_rcpf(1.0f + __builtin_amdgcn_exp2f(-g * LOG2E)); h[n * 4 + j] = sg * up; }
                u32x4 w; w.x = cvtpk(h[0], h[1]); w.y = cvtpk(h[2], h[3]); w.z = cvtpk(h[4], h[5]); w.w = cvtpk(h[6], h[7]);
                *(u32x4*)rowp = w; }
    }
};
struct EpiResF32 {
    static constexpr bool PERM = false;
    float* Z; const bf16_t* res;
    __device__ __forceinline__ void operator()(const f32x4 (&acc)[2][2][4][2], const Unit& u, int wr, int wc, int fr, int fq) const {
        const int row0 = u.pm * BM + wr * 64 + fr, col0 = u.pn * BM + wc * 32 + 4 * fq;
#pragma unroll
        for (int ai = 0; ai < 2; ++ai)
#pragma unroll
            for (int m = 0; m < 4; ++m) { const size_t off = (size_t)(row0 + ai * HALF + m * 16) * DM + col0;
#pragma unroll
                for (int bj = 0; bj < 2; ++bj)
#pragma unroll
                    for (int n = 0; n < 2; ++n) { const u32x2 rb = *(const u32x2*)(res + off + bj * HALF + n * 16);
                        f32x4 o = acc[ai][bj][m][n]; o[0] += ALPHA * bflo(rb.x); o[1] += ALPHA * bfhi(rb.x); o[2] += ALPHA * bflo(rb.y); o[3] += ALPHA * bfhi(rb.y);
                        *(f32x4*)(Z + off + bj * HALF + n * 16) = o; } }
    }
};

template <class Epi, class Sched>
__device__ __forceinline__ void gemm_phase(LAS unsigned char* lds, const Gemm g, const Sched& S, const Epi& E) {
    constexpr bool GA = Sched::GATHER;
    const int tid = fresh_tid(), wid = __builtin_amdgcn_readfirstlane(tid >> 6), lane = tid & 63, wr = wid >> 2, wc = wid & 3, fr = lane & 15, fq = lane >> 4;
    const int K = g.K, nt = K / BK;
    int Rr[2], Cc[2]; unsigned voffA[2], voffB[2];
#pragma unroll
    for (int i = 0; i < 2; ++i) { int R, C; stage_rc(tid * 16 + i * 8192, R, C); Rr[i] = R; Cc[i] = C; const int Rb = Epi::PERM ? ((R & ~31) + perm32(R & 31)) : R;
        voffA[i] = (unsigned)(R * g.lda + C) * 2u; voffB[i] = (unsigned)(Rb * g.ldb + C) * 2u; }
    const size_t kstep = (size_t)(BK * 2);
    const size_t hstepA = (size_t)HALF * g.lda * 2, tstepA = 2 * hstepA;
    const size_t hstepB = (size_t)HALF * g.ldb * 2, tstepB = 2 * hstepB;
    const unsigned ldsw = (unsigned)wid * 1024u;
    const int aoff = lds_byte(wr * 64 + fr, fq * 8), boff = lds_byte(wc * 32 + fr, fq * 8);
#define PG8_SA(b, h) (((b) * 2 + (h)) * HTB)
#define PG8_SB(b, h) ((4 + (b) * 2 + (h)) * HTB)
#define PG8_STAGE(bufoff, gbase, voff) do { _Pragma("unroll") for (int _i = 0; _i < 2; ++_i) \
        __builtin_amdgcn_global_load_lds((const unsigned*)((const char*)(gbase) + (voff)[_i]), (LAS unsigned*)(lds + (bufoff) + ldsw + _i * 8192), 16, 0, 0); } while (0)
#define PG8_STAGE_A(bufoff, h, pbase, koff, goffs) do { if constexpr (GA) { PG8_STAGE(bufoff, gA + (koff), (goffs)[h]); } else { PG8_STAGE(bufoff, (pbase) + (h) * hstepA, voffA); } } while (0)
#define PG8_LDA(dst, b, h) do { _Pragma("unroll") for (int m = 0; m < 4; ++m) _Pragma("unroll") for (int k = 0; k < 2; ++k) dst[m][k] = *(const LAS bf16x8*)(lds + PG8_SA(b, h) + aoff + m * 2048 + k * 1024); } while (0)
#define PG8_LDB(dst, b, h) do { _Pragma("unroll") for (int n = 0; n < 2; ++n) _Pragma("unroll") for (int k = 0; k < 2; ++k) dst[n][k] = *(const LAS bf16x8*)(lds + PG8_SB(b, h) + boff + n * 2048 + k * 1024); } while (0)
#define PG8_MMA(ai, bj, At, Bt) do { __builtin_amdgcn_s_setprio(1); _Pragma("unroll") for (int m = 0; m < 4; ++m) _Pragma("unroll") for (int n = 0; n < 2; ++n) _Pragma("unroll") for (int k = 0; k < 2; ++k) \
        acc[ai][bj][m][n] = __builtin_amdgcn_mfma_f32_16x16x32_bf16(Bt[n][k], At[m][k], acc[ai][bj][m][n], 0, 0, 0); __builtin_amdgcn_s_setprio(0); } while (0)
#define PG8_WAIT_V(n) asm volatile("s_waitcnt vmcnt(" #n ")" ::: "memory")
#define PG8_WAIT_L(n) asm volatile("s_waitcnt lgkmcnt(" #n ")" ::: "memory")
#define PG8_BAR __builtin_amdgcn_s_barrier()
#define PG8_SCHED __builtin_amdgcn_sched_barrier(0)
    Unit cur, nxt; int ui = 0;
    if (!S.next(0, cur)) return;
    f32x4 acc[2][2][4][2];
#pragma unroll
    for (int a = 0; a < 2; ++a)
#pragma unroll
        for (int b = 0; b < 2; ++b)
#pragma unroll
            for (int m = 0; m < 4; ++m)
#pragma unroll
                for (int n = 0; n < 2; ++n) { const float zf = fresh_zero(); acc[a][b][m][n] = (f32x4){zf, zf, zf, zf}; }
    bf16x8 At[4][2], B0[2][2], B1[2][2];
    unsigned ca[2][2], na[2][2];
    if constexpr (GA) S.aoff(cur, Rr, Cc, ca);
    const char* gA = (const char*)g.A;
    const char* cA = gA + (GA ? (size_t)0 : (size_t)cur.pm * tstepA);
    const char* cB = (const char*)g.Bt + (size_t)cur.pn * tstepB;
    PG8_STAGE(PG8_SB(0, 0), cB, voffB); PG8_STAGE_A(PG8_SA(0, 0), 0, cA, 0, ca); PG8_STAGE(PG8_SB(0, 1), cB + hstepB, voffB); PG8_STAGE_A(PG8_SA(0, 1), 1, cA, 0, ca);
    if (wr == 1) PG8_BAR;
    PG8_WAIT_V(4); PG8_BAR;
    PG8_STAGE(PG8_SB(1, 0), cB + kstep, voffB); PG8_STAGE_A(PG8_SA(1, 0), 0, cA + kstep, kstep, ca); PG8_STAGE(PG8_SB(1, 1), cB + hstepB + kstep, voffB);
    PG8_WAIT_V(6); PG8_BAR;
    for (;;) {
        const bool has_next = S.next(ui + 1, nxt);
        if constexpr (GA) {
            if (has_next) S.aoff(nxt, Rr, Cc, na);
            else {
#pragma unroll
                for (int h = 0; h < 2; ++h)
#pragma unroll
                    for (int i = 0; i < 2; ++i) na[h][i] = ca[h][i];
            }
        }
        const char* nA = (!GA && has_next) ? gA + (size_t)nxt.pm * tstepA : cA;
        const char* nB = has_next ? (const char*)g.Bt + (size_t)nxt.pn * tstepB : cB;
#pragma unroll 1
        for (int t = 0; t < nt; t += 2) {
            const bool last = (t == nt - 2);
            const size_t k1 = (size_t)(t + 1) * kstep, k2 = last ? (size_t)0 : (size_t)(t + 2) * kstep, k3 = k2 + kstep;
            const char* a1 = cA + k1;
            const char* a2 = last ? nA : cA + k2; const char* b2 = last ? nB : cB + (size_t)(t + 2) * kstep;
            const char* a3 = a2 + kstep; const char* b3 = b2 + kstep;
            unsigned xa[2][2];
            if constexpr (GA) {
#pragma unroll
                for (int h = 0; h < 2; ++h)
#pragma unroll
                    for (int i = 0; i < 2; ++i) xa[h][i] = last ? na[h][i] : ca[h][i];
            }
            PG8_LDB(B0, 0, 0); PG8_SCHED; PG8_LDA(At, 0, 0); PG8_STAGE_A(PG8_SA(1, 1), 1, a1, k1, ca);
            PG8_WAIT_L(8); PG8_BAR; PG8_WAIT_L(0); PG8_MMA(0, 0, At, B0); PG8_BAR; PG8_SCHED;
            PG8_LDB(B1, 0, 1); PG8_STAGE(PG8_SB(0, 0), b2, voffB);
            PG8_BAR; PG8_WAIT_L(0); PG8_MMA(0, 1, At, B1); PG8_BAR;
            PG8_LDA(At, 0, 1); PG8_STAGE_A(PG8_SA(0, 0), 0, a2, k2, xa);
            PG8_BAR; PG8_WAIT_L(0); PG8_MMA(1, 0, At, B0); PG8_BAR; PG8_SCHED;
            PG8_STAGE(PG8_SB(0, 1), b2 + hstepB, voffB);
            PG8_WAIT_V(6); PG8_BAR; PG8_MMA(1, 1, At, B1); PG8_BAR;
            PG8_LDB(B0, 1, 0); PG8_SCHED; PG8_LDA(At, 1, 0); PG8_STAGE_A(PG8_SA(0, 1), 1, a2, k2, xa);
            PG8_WAIT_L(8); PG8_BAR; PG8_WAIT_L(0); PG8_MMA(0, 0, At, B0); PG8_BAR; PG8_SCHED;
            PG8_LDB(B1, 1, 1); PG8_STAGE(PG8_SB(1, 0), b3, voffB);
            PG8_BAR; PG8_WAIT_L(0); PG8_MMA(0, 1, At, B1); PG8_BAR;
            PG8_LDA(At, 1, 1); PG8_STAGE_A(PG8_SA(1, 0), 0, a3, k3, xa);
            PG8_BAR; PG8_WAIT_L(0); PG8_MMA(1, 0, At, B0); PG8_BAR; PG8_SCHED;
            PG8_STAGE(PG8_SB(1, 1), b3 + hstepB, voffB);
            PG8_WAIT_V(6); PG8_BAR; PG8_MMA(1, 1, At, B1); PG8_BAR;
        }
        E(acc, cur, wr, wc, fr, fq);
        if (!has_next) break;
#pragma unroll
        for (int a = 0; a < 2; ++a)
#pragma unroll
            for (int b = 0; b < 2; ++b)
#pragma unroll
                for (int m = 0; m < 4; ++m)
#pragma unroll
                    for (int n = 0; n < 2; ++n) { const float zf = fresh_zero(); acc[a][b][m][n] = (f32x4){zf, zf, zf, zf}; }
        cur = nxt; cA = nA; cB = nB; ++ui;
        if constexpr (GA) {
#pragma unroll
            for (int h = 0; h < 2; ++h)
#pragma unroll
                for (int i = 0; i < 2; ++i) ca[h][i] = na[h][i];
        }
    }
    PG8_WAIT_V(0);
    if (wr == 0) PG8_BAR;
    PG8_BAR;
#undef PG8_SA
#undef PG8_SB
#undef PG8_STAGE
#undef PG8_STAGE_A
#undef PG8_LDA
#undef PG8_LDB
#undef PG8_MMA
#undef PG8_WAIT_V
#undef PG8_WAIT_L
#undef PG8_BAR
#undef PG8_SCHED
}
}

namespace da {
constexpr int KVBLK = 64;
constexpr float THR = 8.f;
constexpr int SHM_V = KVBLK * 128 * 2, SHM_K = KVBLK * 128 * 2, SHM_KR = KVBLK * 64 * 2;
constexpr int OFF_V = 0, OFF_K = 2 * SHM_V, OFF_WS = OFF_K + 2 * SHM_K, OFF_KR = OFF_WS + 8 * 64 * 4, OFF_QR = OFF_KR + 2 * SHM_KR, LDS_DENSE = OFF_QR + 8 * 4096;
#define KSWZ(row, colB) ((row) * 256 + ((colB) ^ (((row) & 7) << 4)))
#define KRSWZ(row, ch) ((row) * 128 + ((((ch) ^ ((row) >> 1)) & 7) << 4))
#define SBAR() __builtin_amdgcn_sched_barrier(0)
__device__ __forceinline__ int crow(int r, int hi) { return (r & 3) + 8 * (r >> 2) + 4 * hi; }
__device__ __forceinline__ int v_st(int k, int c) { const int kk = (k & ~0xC) | ((k & 4) << 1) | ((k & 8) >> 1); return ((kk >> 3) * 4 + (c >> 5)) * 512 + ((kk & 7) * 32 + (c & 31)) * 2; }
__device__ __forceinline__ int v_rd_base(int lane) { return ((lane & 3) << 3) | (((lane >> 2) & 3) << 6) | (((lane >> 4) & 1) << 5) | (((lane >> 5) & 1) << 8); }
constexpr int v_rd_off(int d0, int ks, int half) { return d0 * 512 + ks * 4096 + half * 2048; }
template <int OFF> __device__ __forceinline__ s16x4 tr_read(int vb) {
    s16x4 r; asm volatile("ds_read_b64_tr_b16 %0, %1 offset:%2" : "=&v"(r) : "v"(vb), "i"(OFF) : "memory"); return r;
}
template <int D0> __device__ __forceinline__ void pv_one(f32x16& od, int vb, bf16x8 pa0, bf16x8 pa1, bf16x8 pa2, bf16x8 pa3) {
    const s16x4 l0 = tr_read<v_rd_off(D0, 0, 0)>(vb), h0 = tr_read<v_rd_off(D0, 0, 1)>(vb), l1 = tr_read<v_rd_off(D0, 1, 0)>(vb), h1 = tr_read<v_rd_off(D0, 1, 1)>(vb);
    const s16x4 l2 = tr_read<v_rd_off(D0, 2, 0)>(vb), h2 = tr_read<v_rd_off(D0, 2, 1)>(vb), l3 = tr_read<v_rd_off(D0, 3, 0)>(vb), h3 = tr_read<v_rd_off(D0, 3, 1)>(vb);
    asm volatile("s_waitcnt lgkmcnt(0)" ::: "memory"); SBAR();
#define PK(L, H) (bf16x8){L[0], L[1], L[2], L[3], H[0], H[1], H[2], H[3]}
    od = __builtin_amdgcn_mfma_f32_32x32x16_bf16(pa0, PK(l0, h0), od, 0, 0, 0);
    od = __builtin_amdgcn_mfma_f32_32x32x16_bf16(pa1, PK(l1, h1), od, 0, 0, 0);
    od = __builtin_amdgcn_mfma_f32_32x32x16_bf16(pa2, PK(l2, h2), od, 0, 0, 0);
    od = __builtin_amdgcn_mfma_f32_32x32x16_bf16(pa3, PK(l3, h3), od, 0, 0, 0);
}
__device__ __forceinline__ void pv_d0(f32x16* o, int vb, bf16x8 pa0, bf16x8 pa1, bf16x8 pa2, bf16x8 pa3) {
    pv_one<0>(o[0], vb, pa0, pa1, pa2, pa3); pv_one<1>(o[1], vb, pa0, pa1, pa2, pa3); pv_one<2>(o[2], vb, pa0, pa1, pa2, pa3); pv_one<3>(o[3], vb, pa0, pa1, pa2, pa3);
}
template <int D0> __device__ __forceinline__ void pv_one32(f32x16& od, int vb, bf16x8 pa0, bf16x8 pa1) {
    const s16x4 l0 = tr_read<v_rd_off(D0, 0, 0)>(vb), h0 = tr_read<v_rd_off(D0, 0, 1)>(vb), l1 = tr_read<v_rd_off(D0, 1, 0)>(vb), h1 = tr_read<v_rd_off(D0, 1, 1)>(vb);
    asm volatile("s_waitcnt lgkmcnt(0)" ::: "memory"); SBAR();
    od = __builtin_amdgcn_mfma_f32_32x32x16_bf16(pa0, PK(l0, h0), od, 0, 0, 0);
    od = __builtin_amdgcn_mfma_f32_32x32x16_bf16(pa1, PK(l1, h1), od, 0, 0, 0);
}
#undef PK
#define PK4(P, BASE, OUT) do { unsigned a0 = cvtpk(P[BASE + 0], P[BASE + 1]), a1 = cvtpk(P[BASE + 2], P[BASE + 3]);   \
    unsigned b0 = cvtpk(P[BASE + 4], P[BASE + 5]), b1 = cvtpk(P[BASE + 6], P[BASE + 7]);                              \
    auto r0 = __builtin_amdgcn_permlane32_swap(a0, b0, false, false); auto r1 = __builtin_amdgcn_permlane32_swap(a1, b1, false, false); \
    u32x4 w = {r0[0], r1[0], r0[1], r1[1]}; OUT = *reinterpret_cast<bf16x8*>(&w); } while (0)

template <int NDQ> struct Cst { static constexpr float SCALE = (NDQ == 8) ? 0.088388347648318440f : 0.072168783648703220f; static constexpr float C = SCALE * LOG2E; };

template <int NDQ>
__device__ __forceinline__ void partialSM(f32x16& p0, f32x16& p1, float& m_reg, float& mn, float& alpha) {
    constexpr float C = Cst<NDQ>::C, SCALE = Cst<NDQ>::SCALE;
    float pmax = p0[0];
#pragma unroll
    for (int r = 1; r < 16; ++r) pmax = fmaxf(pmax, p0[r]);
#pragma unroll
    for (int r = 0; r < 16; ++r) pmax = fmaxf(pmax, p1[r]);
    { auto rr = __builtin_amdgcn_permlane32_swap(__float_as_uint(pmax), __float_as_uint(pmax), false, false);
      pmax = fmaxf(__uint_as_float(rr[0]), __uint_as_float(rr[1])); }
    if (__builtin_expect(__all(pmax - m_reg <= THR / SCALE), 1)) { mn = m_reg; alpha = 1.f; }
    else { mn = fmaxf(m_reg, pmax); alpha = __builtin_amdgcn_exp2f((m_reg - mn) * C); m_reg = mn; }
    const float mnC = -mn * C;
#pragma unroll
    for (int r = 0; r < 16; ++r) p0[r] = fmaf(p0[r], C, mnC);
#pragma unroll
    for (int r = 0; r < 16; ++r) p1[r] = fmaf(p1[r], C, mnC);
#pragma unroll
    for (int r = 0; r < 16; ++r) p0[r] = __builtin_amdgcn_exp2f(p0[r]);
}
__device__ __forceinline__ void finishSM(f32x16& p0, f32x16& p1, float alpha, float& l_reg, bf16x8& pa0, bf16x8& pa1, bf16x8& pa2, bf16x8& pa3) {
#pragma unroll
    for (int r = 0; r < 16; ++r) p1[r] = __builtin_amdgcn_exp2f(p1[r]);
    float ps = 0;
#pragma unroll
    for (int r = 0; r < 16; ++r) ps += p0[r];
#pragma unroll
    for (int r = 0; r < 16; ++r) ps += p1[r];
    { auto rr = __builtin_amdgcn_permlane32_swap(__float_as_uint(ps), __float_as_uint(ps), false, false);
      ps = __uint_as_float(rr[0]) + __uint_as_float(rr[1]); }
    l_reg = l_reg * alpha + ps;
    PK4(p0, 0, pa0); PK4(p0, 8, pa1); PK4(p1, 0, pa2); PK4(p1, 8, pa3);
}
template <int NDQ>
__device__ __forceinline__ void qkt(f32x16& p0, f32x16& p1, const char* Ks, const char* Krs, const bf16x8* qr, const char* qrl, int r32, int hi) {
    p0 = f32x16{}; p1 = f32x16{};
#pragma unroll
    for (int d0 = 0; d0 < 8; ++d0) { const int cb = (d0 * 16 + hi * 8) * 2;
        bf16x8 b0 = *reinterpret_cast<const bf16x8*>(Ks + KSWZ(r32, cb));
        bf16x8 b1 = *reinterpret_cast<const bf16x8*>(Ks + KSWZ(32 + r32, cb));
        p0 = __builtin_amdgcn_mfma_f32_32x32x16_bf16(b0, qr[d0], p0, 0, 0, 0);
        p1 = __builtin_amdgcn_mfma_f32_32x32x16_bf16(b1, qr[d0], p1, 0, 0, 0); }
    if constexpr (NDQ == 12) {
#pragma unroll
        for (int d0 = 0; d0 < 4; ++d0) { const int ch = d0 * 2 + hi;
            bf16x8 b0 = *reinterpret_cast<const bf16x8*>(Krs + KRSWZ(r32, ch));
            bf16x8 b1 = *reinterpret_cast<const bf16x8*>(Krs + KRSWZ(32 + r32, ch));
            const bf16x8 qf = *reinterpret_cast<const bf16x8*>(qrl + d0 * 1024);
            p0 = __builtin_amdgcn_mfma_f32_32x32x16_bf16(b0, qf, p0, 0, 0, 0);
            p1 = __builtin_amdgcn_mfma_f32_32x32x16_bf16(b1, qf, p1, 0, 0, 0); }
    }
}

struct DArgs { const bf16_t* Q; const bf16_t* K; const bf16_t* V; const bf16_t* Kr; bf16_t* O; int ldq, ldk, ldv, ldo; int seq; int pos0; };

template <int NDQ, int SDEPTH>
__device__ __forceinline__ void attn_dense_body(const DArgs a, char* lds) {
    const int tid = fresh_tid(), wid = tid >> 6, lane = tid & 63, r32 = lane & 31, hi = lane >> 5;
    char* V_lds = lds + OFF_V; char* K_lds = lds + OFF_K; char* Kr_lds = lds + OFF_KR;
    float* ws = (float*)(lds + OFF_WS) + wid * 64; float* li_l = ws; float* al_l = ws + 32;
    float m_reg = -1e30f, l_reg = 0; f32x16 o[4] = {}; bf16x8 qr[8];
    char* qrl = lds + OFF_QR + wid * 4096 + lane * 16;
    const bf16_t* Qw = a.Q + (long)(wid * 32 + r32) * a.ldq + hi * 8;
#pragma unroll
    for (int d0 = 0; d0 < 8; ++d0) qr[d0] = *reinterpret_cast<const bf16x8*>(Qw + d0 * 16);
    if constexpr (NDQ == 12) {
        const float pos = (float)(a.pos0 + wid * 32 + r32);
#pragma unroll
        for (int f = 0; f < 2; ++f) {
            const bf16x8 x1v = *reinterpret_cast<const bf16x8*>(Qw + (8 + f) * 16), x2v = *reinterpret_cast<const bf16x8*>(Qw + (10 + f) * 16); bf16x8 y1v, y2v;
#pragma unroll
            for (int j = 0; j < 8; ++j) { const int i = f * 16 + hi * 8 + j; float sn, cs; sincos_rev(pos * inv_freq32(i), sn, cs);
                const float x1 = bf2f((unsigned short)x1v[j]), x2 = bf2f((unsigned short)x2v[j]);
                y1v[j] = (short)f2bf(x1 * cs - x2 * sn); y2v[j] = (short)f2bf(x2 * cs + x1 * sn); }
            *reinterpret_cast<bf16x8*>(qrl + f * 1024) = y1v; *reinterpret_cast<bf16x8*>(qrl + (2 + f) * 1024) = y2v;
        }
    }
    const int sr = tid >> 4, sc = (tid & 15) * 8, vst0 = v_st(sr, sc), vst1 = v_st(32 + sr, sc);
    const int krr = tid >> 3, krc = tid & 7;
    const int vb0 = (int)(uintptr_t)V_lds + v_rd_base(lane);
    struct { bf16x8 vs0, vs1, ks0, ks1, kr; } sr_[SDEPTH];
#define SLOAD(i, k0) do { sr_[i].vs0 = *(const bf16x8*)(a.V + (long)((k0) + sr) * a.ldv + sc); sr_[i].vs1 = *(const bf16x8*)(a.V + (long)((k0) + 32 + sr) * a.ldv + sc); \
    sr_[i].ks0 = *(const bf16x8*)(a.K + (long)((k0) + sr) * a.ldk + sc); sr_[i].ks1 = *(const bf16x8*)(a.K + (long)((k0) + 32 + sr) * a.ldk + sc); \
    if constexpr (NDQ == 12) sr_[i].kr = *(const bf16x8*)(a.Kr + (long)((k0) + krr) * 64 + krc * 8); } while (0)
#define SWRITE(b, i) do { *(bf16x8*)(V_lds + (b) * SHM_V + vst0) = sr_[i].vs0; *(bf16x8*)(V_lds + (b) * SHM_V + vst1) = sr_[i].vs1; const int kc = sc * 2; \
    *(bf16x8*)(K_lds + (b) * SHM_K + KSWZ(sr, kc)) = sr_[i].ks0; *(bf16x8*)(K_lds + (b) * SHM_K + KSWZ(32 + sr, kc)) = sr_[i].ks1; \
    if constexpr (NDQ == 12) *(bf16x8*)(Kr_lds + (b) * SHM_KR + KRSWZ(krr, krc)) = sr_[i].kr; } while (0)
#define SWAIT() do { if constexpr (SDEPTH == 2) { if constexpr (NDQ == 12) asm volatile("s_waitcnt vmcnt(5)" ::: "memory"); else asm volatile("s_waitcnt vmcnt(4)" ::: "memory"); } else asm volatile("s_waitcnt vmcnt(0)" ::: "memory"); } while (0)
#define RESC(al) do { if (__any((al) < 1.f)) { if (hi == 0) al_l[r32] = (al); asm volatile("s_waitcnt lgkmcnt(0)" ::: "memory"); \
    _Pragma("unroll") for (int d = 0; d < 4; ++d) _Pragma("unroll") for (int r = 0; r < 16; ++r) o[d][r] *= al_l[crow(r, hi)]; } } while (0)
    f32x16 pA0, pA1, pB0, pB1; float mnA, mnB, alA, alB; bf16x8 pa0, pa1, pa2, pa3; const int NT = a.seq / KVBLK;
    constexpr int SE = 0, SO = SDEPTH - 1;
    SLOAD(SE, 0); asm volatile("s_waitcnt vmcnt(0)" ::: "memory"); SWRITE(0, SE); __syncthreads();
    qkt<NDQ>(pA0, pA1, K_lds, Kr_lds, qr, qrl, r32, hi); partialSM<NDQ>(pA0, pA1, m_reg, mnA, alA);
    SLOAD(SO, KVBLK); if constexpr (SDEPTH == 2) { if (2 < NT) SLOAD(SE, 2 * KVBLK); }
    SWAIT(); SWRITE(1, SO); __syncthreads();
#pragma unroll 1
    for (int j = 1; j + 1 < NT; j += 2) {
        SBAR(); qkt<NDQ>(pB0, pB1, K_lds + SHM_K, Kr_lds + SHM_KR, qr, qrl, r32, hi);
        finishSM(pA0, pA1, alA, l_reg, pa0, pa1, pa2, pa3); SBAR();
        SLOAD(SO, (j + SDEPTH) * KVBLK); SBAR();
        pv_d0(o, vb0, pa0, pa1, pa2, pa3); partialSM<NDQ>(pB0, pB1, m_reg, mnB, alB);
        __syncthreads(); SWAIT(); SWRITE(0, SE);
        RESC(alB); __syncthreads();
        SBAR(); qkt<NDQ>(pA0, pA1, K_lds, Kr_lds, qr, qrl, r32, hi);
        finishSM(pB0, pB1, alB, l_reg, pa0, pa1, pa2, pa3); SBAR();
        if (SDEPTH == 1 || j + 3 < NT) SLOAD(SE, (j + 1 + SDEPTH) * KVBLK); SBAR();
        pv_d0(o, vb0 + (int)SHM_V, pa0, pa1, pa2, pa3); partialSM<NDQ>(pA0, pA1, m_reg, mnA, alA);
        __syncthreads(); SWAIT(); SWRITE(1, SO);
        RESC(alA); __syncthreads();
    }
    SBAR(); qkt<NDQ>(pB0, pB1, K_lds + SHM_K, Kr_lds + SHM_KR, qr, qrl, r32, hi);
    finishSM(pA0, pA1, alA, l_reg, pa0, pa1, pa2, pa3); SBAR();
    pv_d0(o, vb0, pa0, pa1, pa2, pa3); partialSM<NDQ>(pB0, pB1, m_reg, mnB, alB);
    __syncthreads(); RESC(alB);
    finishSM(pB0, pB1, alB, l_reg, pa0, pa1, pa2, pa3); SBAR();
    pv_d0(o, vb0 + (int)SHM_V, pa0, pa1, pa2, pa3);
    if (hi == 0) li_l[r32] = l_reg; asm volatile("s_waitcnt lgkmcnt(0)" ::: "memory");
    float rli[16];
#pragma unroll
    for (int r = 0; r < 16; ++r) rli[r] = __builtin_amdgcn_rcpf(li_l[crow(r, hi)]);
    bf16_t* Ow = a.O + (long)(wid * 32) * a.ldo;
#pragma unroll
    for (int r = 0; r < 16; ++r) { const int orow = crow(r, hi);
#pragma unroll
        for (int d0 = 0; d0 < 4; ++d0) Ow[(long)orow * a.ldo + d0 * 32 + r32] = f2bf(o[d0][r] * rli[r]); }
#undef SLOAD
#undef SWRITE
#undef SWAIT
#undef RESC
}

constexpr int SP_WAVE_LDS = 18688;
template <class P>
__device__ __forceinline__ void sparse_wave(P& pol, char* wl, int lane) {
    const int r32 = lane & 31, hi = lane >> 5;
    char* Kl = wl; char* Vl = wl + 8192; float* li_l = (float*)(wl + 16384); float* al_l = li_l + 32;
    bf16x8 qr[8];
    { const bf16_t* qp = pol.qptr(r32) + hi * 8;
#pragma unroll
      for (int d0 = 0; d0 < 8; ++d0) qr[d0] = *reinterpret_cast<const bf16x8*>(qp + d0 * 16); }
    f32x16 o[4] = {}; float m_reg = -1e30f, l_reg = 0.f;
    const int srow = lane >> 4, sch = lane & 15;
    const int vb = (int)(uintptr_t)Vl + v_rd_base(lane);
    bf16x8 ks[8], vs[8];
    const int nt = pol.ntiles();
    typename P::TI ti, tn;
    pol.tile(0, ti);
#pragma unroll
    for (int i = 0; i < 8; ++i) { ks[i] = *(const bf16x8*)(ti.k + (long)(srow + 4 * i) * ti.rs + sch * 8); vs[i] = *(const bf16x8*)(ti.v + (long)(srow + 4 * i) * ti.rs + sch * 8); }
#pragma unroll 1
    for (int j = 0; j < nt; ++j) {
#pragma unroll
        for (int i = 0; i < 8; ++i) { *(bf16x8*)(Kl + KSWZ(srow + 4 * i, sch * 16)) = ks[i]; *(bf16x8*)(Vl + v_st(srow + 4 * i, sch * 8)) = vs[i]; }
        if (j + 1 < nt) { pol.tile(j + 1, tn);
#pragma unroll
            for (int i = 0; i < 8; ++i) { ks[i] = *(const bf16x8*)(tn.k + (long)(srow + 4 * i) * tn.rs + sch * 8); vs[i] = *(const bf16x8*)(tn.v + (long)(srow + 4 * i) * tn.rs + sch * 8); } }
        asm volatile("s_waitcnt lgkmcnt(0)" ::: "memory");
        f32x16 p = f32x16{};
#pragma unroll
        for (int d0 = 0; d0 < 8; ++d0) { const int cb = (d0 * 16 + hi * 8) * 2;
            bf16x8 b0 = *reinterpret_cast<const bf16x8*>(Kl + KSWZ(r32, cb));
            p = __builtin_amdgcn_mfma_f32_32x32x16_bf16(b0, qr[d0], p, 0, 0, 0); }
        float pmax = -INFINITY;
#pragma unroll
        for (int r = 0; r < 16; ++r) { p[r] = pol.adj(ti, crow(r, hi), p[r]); pmax = fmaxf(pmax, p[r]); }
        { auto rr = __builtin_amdgcn_permlane32_swap(__float_as_uint(pmax), __float_as_uint(pmax), false, false);
          pmax = fmaxf(__uint_as_float(rr[0]), __uint_as_float(rr[1])); }
        const float mn = fmaxf(m_reg, pmax); const float alpha = __builtin_amdgcn_exp2f(m_reg - mn); m_reg = mn;
        float ps = 0.f;
#pragma unroll
        for (int r = 0; r < 16; ++r) { p[r] = __builtin_amdgcn_exp2f(p[r] - mn); ps += p[r]; }
        { auto rr = __builtin_amdgcn_permlane32_swap(__float_as_uint(ps), __float_as_uint(ps), false, false);
          ps = __uint_as_float(rr[0]) + __uint_as_float(rr[1]); }
        l_reg = l_reg * alpha + ps;
        if (__any(alpha < 1.f)) { if (hi == 0) al_l[r32] = alpha; asm volatile("s_waitcnt lgkmcnt(0)" ::: "memory");
#pragma unroll
            for (int d = 0; d < 4; ++d)
#pragma unroll
                for (int r = 0; r < 16; ++r) o[d][r] *= al_l[crow(r, hi)]; }
        bf16x8 pa0, pa1; PK4(p, 0, pa0); PK4(p, 8, pa1);
        pv_one32<0>(o[0], vb, pa0, pa1); pv_one32<1>(o[1], vb, pa0, pa1); pv_one32<2>(o[2], vb, pa0, pa1); pv_one32<3>(o[3], vb, pa0, pa1);
        ti = tn;
    }
    if (hi == 0) li_l[r32] = l_reg; asm volatile("s_waitcnt lgkmcnt(0)" ::: "memory");
#pragma unroll
    for (int r = 0; r < 16; ++r) { const int qn = crow(r, hi); const float rl = __builtin_amdgcn_rcpf(li_l[qn]); bf16_t* op = pol.optr(qn);
#pragma unroll
        for (int d0 = 0; d0 < 4; ++d0) op[d0 * 32 + r32] = f2bf(o[d0][r] * rl); }
}
#undef PK4
}

struct PolB {
    struct TI { const bf16_t* k; const bf16_t* v; long rs; int kpos0; int iq; float cd; };
    const bf16_t* H0; bf16_t* O; int b, h, a, r16, myn; int lo3, n3, lo2, n2, lo1, n1; float slope2;
    __device__ __forceinline__ void init(const bf16_t* H0_, bf16_t* O_, int w, int lane) {
        H0 = H0_; O = O_; b = w >> 10; h = (w >> 7) & 7; const int wu = w & 127; a = wu >> 4; r16 = wu & 15; myn = lane & 31;
        lo3 = max(a - 2, 0); n3 = min(a + 2, 7) - lo3 + 1;
        lo2 = max(4 * a - 2, 0); n2 = min(4 * a + 5, 31) - lo2 + 1;
        lo1 = max(16 * a - 2, 0); n1 = min(16 * a + 17, 127) - lo1 + 1;
        slope2 = __builtin_amdgcn_exp2f(-(float)(h + 1)) * LOG2E;
    }
    __device__ __forceinline__ const bf16_t* qptr(int n) const { return H0 + (long)(b * SEQ + 512 * a + r16 + 16 * n) * IN0 + 1536 + h * 128; }
    __device__ __forceinline__ bf16_t* optr(int qn) const { return O + (long)(b * SEQ + 512 * a + r16 + 16 * qn) * DM + 1024 + h * 128; }
    __device__ __forceinline__ int ntiles() const { return n3 + n2 + n1; }
    __device__ __forceinline__ void tile(int j, TI& ti) const {
        int dil, kt, rd;
        if (j < n3) { dil = 16; kt = lo3 + j; rd = r16; }
        else if (j < n3 + n2) { dil = 4; kt = lo2 + (j - n3); rd = r16 & 3; }
        else { dil = 1; kt = lo1 + (j - n3 - n2); rd = 0; }
        const long tok = (long)b * SEQ + dil * 32 * kt + rd;
        ti.k = H0 + tok * IN0 + 2560 + h * 128; ti.v = H0 + tok * IN0 + 3584 + h * 128; ti.rs = (long)dil * IN0;
        ti.kpos0 = 32 * kt; ti.iq = (512 * a + r16 + 16 * myn - rd) / dil; ti.cd = slope2 * (float)dil;
    }
    __device__ __forceinline__ float adj(const TI& ti, int kloc, float s) const {
        const int d = ti.kpos0 + kloc - ti.iq; const int ad = d < 0 ? -d : d;
        return ad <= 64 ? fmaf(s, 0.088388347648318440f * LOG2E, -ti.cd * (float)ad) : -INFINITY;
    }
};
struct PolC {
    struct TI { const bf16_t* k; const bf16_t* v; long rs; int kc0; int drow; };
    const bf16_t* H1; bf16_t* O; const float* tab; int b, h, r, a, r0, qc, c0;
    __device__ __forceinline__ void init(const bf16_t* H1_, bf16_t* O_, const float* rpb, float* tab_, int w, int lane) {
        H1 = H1_; O = O_; tab = tab_; b = w >> 10; h = (w >> 7) & 7; const int wu = w & 127; r = wu >> 1; a = wu & 1;
        r0 = min(max(r - 4, 0), 56); qc = 32 * a + (lane & 31); c0 = min(max(qc - 8, 0), 48);
        for (int idx = lane; idx < 480; idx += 64) { const int dr = idx >> 5, dc = idx & 31; tab_[idx] = dc < 31 ? rpb[h * 465 + dr * 31 + dc] * LOG2E : 0.f; }
        asm volatile("s_waitcnt vmcnt(0) lgkmcnt(0)" ::: "memory");
    }
    __device__ __forceinline__ const bf16_t* qptr(int n) const { return H1 + (long)(b * SEQ + 64 * r + 32 * a + n) * IN1P + h * 128; }
    __device__ __forceinline__ bf16_t* optr(int qn) const { return O + (long)(b * SEQ + 64 * r + 32 * a + qn) * DM + h * 128; }
    __device__ __forceinline__ int ntiles() const { return 16; }
    __device__ __forceinline__ void tile(int j, TI& ti) const {
        const int kr = r0 + (j >> 1), ch = j & 1; const long tok = (long)b * SEQ + 64 * kr + 32 * ch;
        ti.k = H1 + tok * IN1P + 1024 + h * 128; ti.v = H1 + tok * IN1P + 2048 + h * 128; ti.rs = IN1P; ti.kc0 = 32 * ch; ti.drow = kr - r + 7;
    }
    __device__ __forceinline__ float adj(const TI& ti, int kloc, float s) const {
        const int kc = ti.kc0 + kloc; const int dc = min(max(kc - qc + 15, 0), 30);
        const float bias = tab[ti.drow * 32 + dc];
        return (kc >= c0 && kc < c0 + 16) ? fmaf(s, 0.088388347648318440f * LOG2E, bias) : -INFINITY;
    }
};

struct Params { const float* in[28]; float* out; unsigned char* ws; int ph_lo, ph_hi; };
enum { I_X = 0, I_RW = 1, I_RB = 2, I_WIN0 = 3, I_AQN = 4, I_AKN = 5, I_WOUT0 = 6, I_LN1G0 = 7, I_LN1B0 = 8, I_WG0 = 9, I_WU0 = 10, I_WD0 = 11, I_LN2G0 = 12, I_LN2B0 = 13,
       I_WIN1 = 14, I_RPB = 15, I_DQN = 16, I_WQUP = 17, I_DKVN = 18, I_WKVUP = 19, I_WOUT1 = 20, I_LN1G1 = 21, I_LN1B1 = 22, I_WG1 = 23, I_WU1 = 24, I_WD1 = 25, I_LN2G1 = 26, I_LN2B1 = 27 };

__device__ __forceinline__ void tr_tile(const float* __restrict__ src, int N, const float* __restrict__ ksc, bf16_t* __restrict__ dst, int ldd, int k0, int n0, int drow0, LAS unsigned* tl, int tid) {
    const int c4 = (tid & 15) * 4;
#pragma unroll
    for (int i = 0; i < 2; ++i) {
        const int kp = (tid >> 4) + 32 * i;
        const float* s0 = src + (size_t)(k0 + 2 * kp) * N + n0 + c4;
        f32x4 a = *(const f32x4*)s0, b = *(const f32x4*)(s0 + N);
        if (ksc) { const float sa = ksc[k0 + 2 * kp], sb = ksc[k0 + 2 * kp + 1]; a *= sa; b *= sb; }
#pragma unroll
        for (int j = 0; j < 4; ++j) tl[(c4 + j) * 65 + kp] = cvtpk(a[j], b[j]);
    }
    __syncthreads();
    const int n = tid >> 3, seg = tid & 7;
    unsigned w[8];
#pragma unroll
    for (int q = 0; q < 8; ++q) w[q] = tl[n * 65 + seg * 8 + q];
    u32x4* d = (u32x4*)(dst + (size_t)(drow0 + n) * ldd + k0 + seg * 16);
    d[0] = (u32x4){w[0], w[1], w[2], w[3]}; d[1] = (u32x4){w[4], w[5], w[6], w[7]};
    __syncthreads();
}
struct TJob { const float* src; bf16_t* dst; const float* ksc; int K, N, ldd, gu; size_t sbs, dbs; };
__device__ __forceinline__ void run_tjob(const TJob& jb, int t, LAS unsigned* tl, int tid) {
    const int ntn = jb.N / 64, ntk = jb.K / 128, per = ntn * ntk;
    const int bi = t / per, r = t % per, tk = r / ntn, tn = r % ntn;
    const int n0 = tn * 64;
    const int drow0 = jb.gu ? (256 * (n0 >> 7) + (jb.gu == 2 ? 128 : 0) + (n0 & 127)) : n0;
    tr_tile(jb.src + (size_t)bi * jb.sbs, jb.N, jb.ksc, jb.dst + (size_t)bi * jb.dbs, jb.ldd, tk * 128, n0, drow0, tl, tid);
}
__device__ __forceinline__ void phase_prologue(const Params& p, LAS unsigned char* lds, int G, int bid, int tid) {
    unsigned char* ws = p.ws;
    LAS unsigned* tl = (LAS unsigned*)lds;
    constexpr int NJ = 12;
    const int cnts[NJ] = {16 * 72, 16 * 32, 4096, 4096, 4096, 16 * 61, 16 * 32, 4096, 4096, 4096, 4 * 24, 2 * 32};
    int total = 0;
#pragma unroll
    for (int j = 0; j < NJ; ++j) total += cnts[j];
    for (int t = bid; t < total; t += G) {
        int j = 0, base = 0;
#pragma unroll
        for (int q = 0; q < NJ - 1; ++q) if (t >= base + cnts[q] && j == q) { base += cnts[q]; j = q + 1; }
        const int tt = t - base;
        TJob jb;
        switch (j) {
            case 0: jb = TJob{p.in[I_WIN0], (bf16_t*)(ws + WS_WIN0), nullptr, 2048, IN0, 2048, 0, 0, 0}; break;
            case 1: jb = TJob{p.in[I_WOUT0], (bf16_t*)(ws + WS_WOUT0), nullptr, 2048, 2048, 2048, 0, 0, 0}; break;
            case 2: jb = TJob{p.in[I_WG0], (bf16_t*)(ws + WS_WGU0), nullptr, 2048, 512, 2048, 1, (size_t)2048 * 512, (size_t)1024 * 2048}; break;
            case 3: jb = TJob{p.in[I_WU0], (bf16_t*)(ws + WS_WGU0), nullptr, 2048, 512, 2048, 2, (size_t)2048 * 512, (size_t)1024 * 2048}; break;
            case 4: jb = TJob{p.in[I_WD0], (bf16_t*)(ws + WS_WD0), nullptr, 512, 2048, 512, 0, (size_t)512 * 2048, (size_t)2048 * 512}; break;
            case 5: jb = TJob{p.in[I_WIN1], (bf16_t*)(ws + WS_WIN1), nullptr, 2048, IN1, 2048, 0, 0, 0}; break;
            case 6: jb = TJob{p.in[I_WOUT1], (bf16_t*)(ws + WS_WOUT1), nullptr, 2048, 2048, 2048, 0, 0, 0}; break;
            case 7: jb = TJob{p.in[I_WG1], (bf16_t*)(ws + WS_WGU1), nullptr, 2048, 512, 2048, 1, (size_t)2048 * 512, (size_t)1024 * 2048}; break;
            case 8: jb = TJob{p.in[I_WU1], (bf16_t*)(ws + WS_WGU1), nullptr, 2048, 512, 2048, 2, (size_t)2048 * 512, (size_t)1024 * 2048}; break;
            case 9: jb = TJob{p.in[I_WD1], (bf16_t*)(ws + WS_WD1), nullptr, 512, 2048, 512, 0, (size_t)512 * 2048, (size_t)2048 * 512}; break;
            case 10: jb = TJob{p.in[I_WQUP], (bf16_t*)(ws + WS_WQUP), p.in[I_DQN], 512, 1536, 512, 0, 0, 0}; break;
            default: jb = TJob{p.in[I_WKVUP], (bf16_t*)(ws + WS_WKVUP), p.in[I_DKVN], 256, 2048, 256, 0, 0, 0}; break;
        }
        run_tjob(jb, tt, tl, tid);
    }
    { u32x4* z = (u32x4*)((bf16_t*)(ws + WS_WIN1) + (size_t)IN1 * 2048); const size_t n16 = (size_t)(IN1P - IN1) * 2048 * 2 / 16;
      const unsigned zu = __float_as_uint(fresh_zero());
      for (size_t i = (size_t)bid * NTHR + tid; i < n16; i += (size_t)G * NTHR) z[i] = (u32x4){zu, zu, zu, zu}; }
    { const f32x8* xs = (const f32x8*)p.in[I_X]; u32x4* xd = (u32x4*)(ws + WS_RA); const size_t n8 = (size_t)T_ * DM / 8;
      for (size_t i = (size_t)bid * NTHR + tid; i < n8; i += (size_t)G * NTHR) { const f32x8 v = xs[i];
          xd[i] = (u32x4){cvtpk(v[0], v[1]), cvtpk(v[2], v[3]), cvtpk(v[4], v[5]), cvtpk(v[6], v[7])}; } }
}

__device__ __forceinline__ void phase_prep_qk(bf16_t* H0, const float* qn, const float* kn, int G, int bid, int tid) {
    const int wid = tid >> 6, lane = tid & 63, i = lane & 31, half = lane >> 5;
    const float invf = inv_freq32(i);
    const int e0 = 64 * half + i, e1 = e0 + 32;
    const float gq0 = qn[e0], gq1 = qn[e1], gk0 = kn[e0], gk1 = kn[e1];
    for (int m = bid * 8 + wid; m < T_; m += G * 8) {
        const int s = m & (SEQ - 1); const int pos = half ? (s & 63) : (s >> 6);
        float sn, cs; sincos_rev((float)pos * invf, sn, cs);
        bf16_t* rowp = H0 + (size_t)m * IN0;
#pragma unroll
        for (int hh = 0; hh < 10; ++hh) {
            bf16_t* base = rowp + (hh < 8 ? hh * 128 : 1024 + (hh - 8) * 128);
            const float x0 = bf2f(base[e0]), x1 = bf2f(base[e1]);
            const float ss = wave_sum(x0 * x0 + x1 * x1);
            const float r = rsqrtf(ss * (1.0f / 128.0f) + 1e-6f);
            const float y0 = x0 * r * (hh < 8 ? gq0 : gk0), y1 = x1 * r * (hh < 8 ? gq1 : gk1);
            base[e0] = f2bf(y0 * cs - y1 * sn); base[e1] = f2bf(y1 * cs + y0 * sn);
        }
    }
}
__device__ __forceinline__ void phase_prep_mla(bf16_t* H1, bf16_t* krope, int G, int bid, int tid) {
    const int wid = tid >> 6, lane = tid & 63;
    const float invf = inv_freq32(lane & 31);
    for (int m = bid * 8 + wid; m < T_; m += G * 8) {
        bf16_t* rowp = H1 + (size_t)m * IN1P;
        const u32x4 a = *(const u32x4*)(rowp + 3072 + lane * 8);
        float ss = bflo(a.x) * bflo(a.x) + bfhi(a.x) * bfhi(a.x) + bflo(a.y) * bflo(a.y) + bfhi(a.y) * bfhi(a.y) + bflo(a.z) * bflo(a.z) + bfhi(a.z) * bfhi(a.z) + bflo(a.w) * bflo(a.w) + bfhi(a.w) * bfhi(a.w);
        ss = wave_sum(ss);
        const u32x2 c = *(const u32x2*)(rowp + 3584 + lane * 4);
        float s2 = bflo(c.x) * bflo(c.x) + bfhi(c.x) * bfhi(c.x) + bflo(c.y) * bflo(c.y) + bfhi(c.y) * bfhi(c.y);
        s2 = wave_sum(s2);
        const float rq = rsqrtf(ss * (1.0f / 512.0f) + 1e-6f), rkv = rsqrtf(s2 * (1.0f / 256.0f) + 1e-6f);
        *(u32x4*)(rowp + 3072 + lane * 8) = (u32x4){cvtpk(bflo(a.x) * rq, bfhi(a.x) * rq), cvtpk(bflo(a.y) * rq, bfhi(a.y) * rq), cvtpk(bflo(a.z) * rq, bfhi(a.z) * rq), cvtpk(bflo(a.w) * rq, bfhi(a.w) * rq)};
        *(u32x2*)(rowp + 3584 + lane * 4) = (u32x2){cvtpk(bflo(c.x) * rkv, bfhi(c.x) * rkv), cvtpk(bflo(c.y) * rkv, bfhi(c.y) * rkv)};
        if (lane < 32) { const float x1 = bf2f(rowp[3840 + lane]), x2 = bf2f(rowp[3840 + 32 + lane]);
            float sn, cs; sincos_rev((float)(m & (SEQ - 1)) * invf, sn, cs);
            krope[(size_t)m * 64 + lane] = f2bf(x1 * cs - x2 * sn); krope[(size_t)m * 64 + 32 + lane] = f2bf(x2 * cs + x1 * sn); }
    }
}

constexpr int LNR_PITCH = 2050;
constexpr int LNR_PART = 131328, LNR_SC = 147712, LNR_SEL = 149760, LNR_BLE = 151808, LNR_HIST = 152832;
__device__ __forceinline__ void phase_ln_router(const float* z, const float* g, const float* bb, const float* rw, const float* rb, bf16_t* x1b,
                                                int* tok_e, int* tok_p, float* tok_g, int* list, unsigned* cnt, LAS unsigned char* lds, int G, int bid, int tid) {
    const int wid = tid >> 6, lane = tid & 63;
    LAS float* xs = (LAS float*)lds; LAS float* part = (LAS float*)(lds + LNR_PART); LAS float* scs = (LAS float*)(lds + LNR_SC); LAS float* sels = (LAS float*)(lds + LNR_SEL);
    LAS int* ble = (LAS int*)(lds + LNR_BLE); LAS int* hist = (LAS int*)(lds + LNR_HIST);
    int ntl = 0;
    for (int it = 0; bid + G * it < T_ / 16; ++it) {
        const int tix = bid + G * it;
#pragma unroll 1
        for (int rr = 0; rr < 2; ++rr) {
            const int row = 2 * wid + rr; const size_t m = (size_t)tix * 16 + row;
            f32x4 v[8]; float s = 0.f;
#pragma unroll
            for (int i = 0; i < 8; ++i) { v[i] = *(const f32x4*)(z + m * DM + 4 * lane + 256 * i); s += (v[i][0] + v[i][1]) + (v[i][2] + v[i][3]); }
            const float mean = wave_sum(s) * (1.0f / DM); float q = 0.f;
#pragma unroll
            for (int i = 0; i < 8; ++i) { const f32x4 d = v[i] - mean; q += (d[0] * d[0] + d[1] * d[1]) + (d[2] * d[2] + d[3] * d[3]); }
            const float rstd = rsqrtf(wave_sum(q) * (1.0f / DM) + 1e-5f);
#pragma unroll
            for (int i = 0; i < 8; ++i) { const int col = 4 * lane + 256 * i; const f32x4 gv = *(const f32x4*)(g + col), bv = *(const f32x4*)(bb + col);
                const f32x4 y = (v[i] - mean) * rstd * gv + bv;
                LAS f32x2* xp = (LAS f32x2*)(xs + row * LNR_PITCH + col); xp[0] = (f32x2){y[0], y[1]}; xp[1] = (f32x2){y[2], y[3]};
                *(u32x2*)(x1b + m * DM + col) = (u32x2){cvtpk(y[0], y[1]), cvtpk(y[2], y[3])}; }
        }
        __syncthreads();
        { f32x4 acc0 = {0.f, 0.f, 0.f, 0.f}, acc1 = {0.f, 0.f, 0.f, 0.f}; const int k0 = 256 * wid + (lane >> 4); const int e = lane & 15;
#pragma unroll 4
          for (int kk = 0; kk < 64; ++kk) { const int k = k0 + 4 * kk; const float a = xs[(lane & 15) * LNR_PITCH + k]; const float b0 = rw[k * 32 + e], b1 = rw[k * 32 + 16 + e];
              acc0 = __builtin_amdgcn_mfma_f32_16x16x4f32(a, b0, acc0, 0, 0, 0); acc1 = __builtin_amdgcn_mfma_f32_16x16x4f32(a, b1, acc1, 0, 0, 0); }
#pragma unroll
          for (int r = 0; r < 4; ++r) { const int row = (lane >> 4) * 4 + r; part[(wid * 16 + row) * 32 + e] = acc0[r]; part[(wid * 16 + row) * 32 + 16 + e] = acc1[r]; } }
        __syncthreads();
        { const int row = tid >> 5, e = tid & 31; float lg = 0.f;
#pragma unroll
          for (int w = 0; w < 8; ++w) lg += part[(w * 16 + row) * 32 + e];
          const float sc = 1.0f / (1.0f + __expf(-lg)); scs[row * 32 + e] = sc; sels[row * 32 + e] = sc + rb[e]; }
        __syncthreads();
        if (tid < 16) { const int row = tid; float best = -INFINITY; int bg = 0;
            for (int gI = 0; gI < 8; ++gI) { const float a = sels[row * 32 + 4 * gI], b = sels[row * 32 + 4 * gI + 1], c = sels[row * 32 + 4 * gI + 2], d = sels[row * 32 + 4 * gI + 3];
                const float h1 = fmaxf(a, b), l1 = fminf(a, b), h2 = fmaxf(c, d), l2 = fminf(c, d); const float gs = fmaxf(h1, h2) + fmaxf(fminf(h1, h2), fmaxf(l1, l2));
                if (gs > best) { best = gs; bg = gI; } }
            const float v0 = sels[row * 32 + 4 * bg], v1 = sels[row * 32 + 4 * bg + 1], v2 = sels[row * 32 + 4 * bg + 2], v3 = sels[row * 32 + 4 * bg + 3];
            int i1 = 0; float b1 = v0; if (v1 > b1) { b1 = v1; i1 = 1; } if (v2 > b1) { b1 = v2; i1 = 2; } if (v3 > b1) { b1 = v3; i1 = 3; }
            int i2 = -1; float b2 = -INFINITY;
            if (i1 != 0 && v0 > b2) { b2 = v0; i2 = 0; } if (i1 != 1 && v1 > b2) { b2 = v1; i2 = 1; } if (i1 != 2 && v2 > b2) { b2 = v2; i2 = 2; } if (i1 != 3 && v3 > b2) { b2 = v3; i2 = 3; }
            const int e1 = 4 * bg + i1, e2 = 4 * bg + i2; const float s1 = scs[row * 32 + e1], s2 = scs[row * 32 + e2]; const float inv = 1.0f / (s1 + s2);
            const size_t m = (size_t)tix * 16 + row;
            tok_e[2 * m] = e1; tok_e[2 * m + 1] = e2; tok_g[2 * m] = s1 * inv; tok_g[2 * m + 1] = s2 * inv;
            ble[(it * 16 + row) * 2] = e1; ble[(it * 16 + row) * 2 + 1] = e2; }
        __syncthreads();
        ntl = it + 1;
    }
    const int nasg = ntl * 32;
    if (tid < 32) { int c = 0; for (int i = 0; i < nasg; ++i) c += (ble[i] == tid) ? 1 : 0;
        unsigned base = 0; if (c) base = __hip_atomic_fetch_add(cnt + tid, (unsigned)c, __ATOMIC_RELAXED, __HIP_MEMORY_SCOPE_AGENT);
        hist[tid] = (int)base; }
    __syncthreads();
    if (tid < 32) { int run = hist[tid];
        for (int i = 0; i < nasg; ++i) if (ble[i] == tid) { const int tr = i >> 1; const size_t m = (size_t)(bid + G * (tr >> 4)) * 16 + (tr & 15);
            list[(size_t)tid * 65536 + run] = (int)m; tok_p[2 * m + (i & 1)] = run; ++run; } }
    __syncthreads();
}

constexpr int MOE_LDS = 131072;
__device__ __forceinline__ int moe_prefix(const unsigned* cnt, LAS int* pblk, int tid) {
    if (tid == 0) { int acc = 0; for (int e = 0; e < NE; ++e) { pblk[e] = acc; acc += ((int)cnt[e] + 255) >> 8; } pblk[NE] = acc; }
    __syncthreads();
    return pblk[NE];
}
template <int NJ> __device__ __forceinline__ int moe_table(const unsigned* cnt, LAS int* pblk, LAS int* tab, LAS int* aux, int NB, int G, int bid, int tid) {
    const int NU = NB * NJ;
    if (tid < 16) { const int L = bid + G * tid;
        if (L < NU) { const int rb = L / NJ, j = L % NJ; int e = 0; for (int q = 1; q < NE; ++q) if (pblk[q] <= rb) e = q;
            tab[tid] = rb; tab[16 + tid] = NJ * e + j; aux[tid * 3] = e; aux[tid * 3 + 1] = (rb - pblk[e]) * 256; aux[tid * 3 + 2] = (int)cnt[e]; } }
    __syncthreads();
    int n = 0; for (int i = 0; i < 16; ++i) if (bid + G * i < NU) n = i + 1;
    return n;
}

template <bool FINAL>
__device__ __forceinline__ void phase_combine_ln(const bf16_t* x1b, const bf16_t* Yr, const int* tok_e, const int* tok_p, const float* tok_g, const unsigned* cnt,
                                                 const float* g, const float* bb, bf16_t* xo, float* fo, LAS unsigned char* lds, int G, int bid, int tid) {
    LAS int* pblk = (LAS int*)lds;
    moe_prefix(cnt, pblk, tid);
    const int wid = tid >> 6, lane = tid & 63;
    for (int m = bid * 8 + wid; m < T_; m += G * 8) {
        const int e0 = tok_e[2 * m], e1 = tok_e[2 * m + 1];
        const size_t p0 = (size_t)pblk[e0] * 256 + tok_p[2 * m], p1 = (size_t)pblk[e1] * 256 + tok_p[2 * m + 1];
        const float g0 = tok_g[2 * m], g1 = tok_g[2 * m + 1];
        float v[32]; float s = 0.f;
#pragma unroll
        for (int i = 0; i < 4; ++i) { const int col = 8 * lane + 512 * i;
            const u32x4 xa = *(const u32x4*)(x1b + (size_t)m * DM + col), ya = *(const u32x4*)(Yr + p0 * DM + col), yb = *(const u32x4*)(Yr + p1 * DM + col);
            const unsigned xw[4] = {xa.x, xa.y, xa.z, xa.w}, aw[4] = {ya.x, ya.y, ya.z, ya.w}, bw[4] = {yb.x, yb.y, yb.z, yb.w};
#pragma unroll
            for (int j = 0; j < 4; ++j) { v[i * 8 + 2 * j] = ALPHA * bflo(xw[j]) + g0 * bflo(aw[j]) + g1 * bflo(bw[j]); v[i * 8 + 2 * j + 1] = ALPHA * bfhi(xw[j]) + g0 * bfhi(aw[j]) + g1 * bfhi(bw[j]);
                s += v[i * 8 + 2 * j] + v[i * 8 + 2 * j + 1]; } }
        const float mean = wave_sum(s) * (1.0f / DM); float q = 0.f;
#pragma unroll
        for (int i = 0; i < 32; ++i) { const float d = v[i] - mean; q += d * d; }
        const float rstd = rsqrtf(wave_sum(q) * (1.0f / DM) + 1e-5f);
#pragma unroll
        for (int i = 0; i < 4; ++i) { const int col = 8 * lane + 512 * i;
            const f32x4 ga = *(const f32x4*)(g + col), gb = *(const f32x4*)(g + col + 4), ba = *(const f32x4*)(bb + col), bbv = *(const f32x4*)(bb + col + 4);
            float y[8];
#pragma unroll
            for (int j = 0; j < 4; ++j) { y[j] = (v[i * 8 + j] - mean) * rstd * ga[j] + ba[j]; y[4 + j] = (v[i * 8 + 4 + j] - mean) * rstd * gb[j] + bbv[j]; }
            if constexpr (FINAL) { *(f32x4*)(fo + (size_t)m * DM + col) = (f32x4){y[0], y[1], y[2], y[3]}; *(f32x4*)(fo + (size_t)m * DM + col + 4) = (f32x4){y[4], y[5], y[6], y[7]}; }
            else *(u32x4*)(xo + (size_t)m * DM + col) = (u32x4){cvtpk(y[0], y[1]), cvtpk(y[2], y[3]), cvtpk(y[4], y[5]), cvtpk(y[6], y[7])}; }
    }
}

#ifndef ATT_ONLY
#define ATT_ONLY -1
#endif
constexpr int N_PHASES = 20;
__global__ void __launch_bounds__(NTHR, 2) fwd(Params p) {
    extern __shared__ __attribute__((aligned(16))) unsigned char lds_raw[];
    LAS unsigned char* lds = (LAS unsigned char*)lds_raw;
    const int tid0 = threadIdx.x, bid = blockIdx.x, G = gridDim.x;
    const int vcu = (G % 8 == 0) ? (bid % 8) * (G / 8) + bid / 8 : bid;
    unsigned* ctl = (unsigned*)(p.ws + WS_CTL);
    if (tid0 < 4) ((LAS unsigned*)(lds + MISC_OFF))[tid0] = 0u;
    __syncthreads();
    XcdBarrier bar; bar.bar = ctl + CW_BAR; bar.x = 0; bar.st = (volatile LAS unsigned*)(lds + MISC_OFF);
    if (N_LAUNCH_MODE == 1) bar = xcd_barrier_post(ctl + CW_BAR, (volatile LAS unsigned*)(lds + MISC_OFF));
    const int lo = p.ph_lo, hi = p.ph_hi;
#ifndef PH_ONLY
#define PH_ONLY -1
#endif
#define IN(k) ((PH_ONLY < 0 || (PH_ONLY % 10) == ((k) % 10)) && lo <= (k) && (k) < hi)
#define SEAM(k) do { if ((k) + 1 < hi) xcd_barrier(bar); } while (0)

    for (int L = 0; L < 2; ++L) {
        const int pb = L * 10;
        typedef __attribute__((address_space(1))) unsigned char gu8;
        gu8* wsg = (gu8*)p.ws; gu8* outg = (gu8*)p.out;
        asm volatile("" : "+s"(wsg), "+s"(outg));
        unsigned char* ws = (unsigned char*)wsg; unsigned char* outb = (unsigned char*)outg;
        bf16_t* RA = (bf16_t*)(ws + WS_RA); bf16_t* RB = (bf16_t*)(ws + WS_RB); bf16_t* RC = (bf16_t*)(ws + WS_RC);
        int* list = (int*)(ws + WS_LIST); int* tok_e = (int*)(ws + WS_TOKE); int* tok_p = (int*)(ws + WS_TOKP); float* tok_g = (float*)(ws + WS_TOKG);
        bf16_t* krope = (bf16_t*)(ws + WS_KROPE);
        bf16_t* Qd = (bf16_t*)(outb + OUT_QD); bf16_t* O1 = (bf16_t*)(outb + OUT_O1);
        const bf16_t* Win = (const bf16_t*)(ws + (L ? WS_WIN1 : WS_WIN0)); const bf16_t* Wout = (const bf16_t*)(ws + (L ? WS_WOUT1 : WS_WOUT0));
        const bf16_t* Wgu = (const bf16_t*)(ws + (L ? WS_WGU1 : WS_WGU0)); const bf16_t* Wd = (const bf16_t*)(ws + (L ? WS_WD1 : WS_WD0));
        const int NIN = L ? IN1P : IN0;
        const bf16_t* xin = L ? RC : RA;
        bf16_t* Hx = RB;
        bf16_t* Oat = L ? O1 : RC;
        float* Z = (float*)RB;
        bf16_t* x1b = RA; bf16_t* Hm = RC; bf16_t* Yr = RB;
        unsigned* cnt = ctl + CW_CNT + L * 64;

        if (L == 0 && IN(0)) { phase_prologue(p, lds, G, bid, fresh_tid()); SEAM(0); }

        if (IN(pb + 1)) {
            pg8::Gemm g{xin, Win, 2048, 2048, 2048}; pg8::StaticOrder S; S.init(T_, NIN, G, bid, 2048);
            pg8::EpiBf16 E{Hx, NIN, 0xffff};
            pg8::gemm_phase(lds, g, S, E);
            SEAM(pb + 1);
        }
        if (IN(pb + 2)) {
            if (L == 0) phase_prep_qk(Hx, p.in[I_AQN], p.in[I_AKN], G, bid, fresh_tid());
            else phase_prep_mla(Hx, krope, G, bid, fresh_tid());
            SEAM(pb + 2);
        }
        if (L == 1 && IN(pb + 3)) {
#ifndef P3_ONLY
#define P3_ONLY -1
#endif
            if (P3_ONLY < 0 || P3_ONLY == 0) { pg8::Gemm g{Hx + 3072, (const bf16_t*)(ws + WS_WQUP), 512, IN1P, 512}; pg8::StaticOrder S; S.init(T_, 1536, G, bid, IN1P);
              pg8::EpiBf16 E{Qd, 1536, 0xffff}; pg8::gemm_phase(lds, g, S, E); }
            if (P3_ONLY < 0 || P3_ONLY == 1) { pg8::Gemm g{Hx + 3584, (const bf16_t*)(ws + WS_WKVUP), 256, IN1P, 256}; pg8::StaticOrder S; S.init(T_, 2048, G, bid, IN1P);
              pg8::EpiBf16 E{RA, 2048, 0xffff}; pg8::gemm_phase(lds, g, S, E); }
            SEAM(pb + 3);
        }
        if (IN(pb + 4)) {
            if (L == 0) {
                if (ATT_ONLY < 0 || ATT_ONLY == 0)
                for (int u = vcu; u < 1024; u += G) {
                    __syncthreads();
                    const int b = u >> 7, qb = u & 15, kvh = (u >> 6) & 1, gq = (u >> 4) & 3, h = kvh * 4 + gq;
                    da::DArgs a; a.Q = Hx + (size_t)(b * SEQ + 256 * qb) * IN0 + h * 128; a.ldq = IN0;
                    a.K = Hx + (size_t)b * SEQ * IN0 + 1024 + kvh * 128; a.ldk = IN0; a.V = Hx + (size_t)b * SEQ * IN0 + 1280 + kvh * 128; a.ldv = IN0; a.Kr = nullptr;
                    a.O = Oat + (size_t)(b * SEQ + 256 * qb) * DM + h * 128; a.ldo = DM; a.seq = SEQ; a.pos0 = 0;
                    da::attn_dense_body<8, 2>(a, (char*)lds_raw);
                }
                __syncthreads();
                if (ATT_ONLY < 0 || ATT_ONLY == 2)
                for (int it = vcu; it < 1024; it += G) {
                    const int tid2 = fresh_tid(), wid = __builtin_amdgcn_readfirstlane(tid2 >> 6), lane = tid2 & 63;
                    const int w = it * 8 + wid; char* wl = (char*)lds_raw + wid * da::SP_WAVE_LDS;
                    PolB pol; pol.init(Hx, Oat, w, lane); da::sparse_wave(pol, wl, lane);
                }
            } else {
                if (ATT_ONLY < 0 || ATT_ONLY == 1)
                for (int u = vcu; u < 1024; u += G) {
                    __syncthreads();
                    const int b = u >> 7, qb = u & 15, h = (u >> 4) & 7;
                    da::DArgs a; a.Q = Qd + (size_t)(b * SEQ + 256 * qb) * 1536 + h * 192; a.ldq = 1536;
                    a.K = RA + (size_t)b * SEQ * DM + h * 256; a.ldk = DM; a.V = a.K + 128; a.ldv = DM; a.Kr = krope + (size_t)b * SEQ * 64;
                    a.O = Oat + (size_t)(b * SEQ + 256 * qb) * DM + 1024 + h * 128; a.ldo = DM; a.seq = SEQ; a.pos0 = 256 * qb;
                    da::attn_dense_body<12, 1>(a, (char*)lds_raw);
                }
                __syncthreads();
                if (ATT_ONLY < 0 || ATT_ONLY == 3)
                for (int it = vcu; it < 1024; it += G) {
                    const int tid2 = fresh_tid(), wid = __builtin_amdgcn_readfirstlane(tid2 >> 6), lane = tid2 & 63;
                    const int w = it * 8 + wid; char* wl = (char*)lds_raw + wid * da::SP_WAVE_LDS;
                    PolC pol; pol.init(Hx, Oat, p.in[I_RPB], (float*)(wl + 16640), w, lane); da::sparse_wave(pol, wl, lane);
                }
            }
            SEAM(pb + 4);
        }
        if (IN(pb + 5)) {
            pg8::Gemm g{Oat, Wout, 2048, 2048, 2048}; pg8::StaticOrder S; S.init(T_, DM, G, bid, 2048);
            pg8::EpiResF32 E{Z, xin};
            pg8::gemm_phase(lds, g, S, E);
            SEAM(pb + 5);
        }
        if (IN(pb + 6)) {
            phase_ln_router(Z, p.in[L ? I_LN1G1 : I_LN1G0], p.in[L ? I_LN1B1 : I_LN1B0], p.in[I_RW], p.in[I_RB], x1b, tok_e, tok_p, tok_g, list, cnt, lds, G, bid, fresh_tid());
            SEAM(pb + 6);
        }
        if (IN(pb + 7)) {
            LAS int* pblk = (LAS int*)(lds + MOE_LDS); LAS int* tab = pblk + 64; LAS int* aux = tab + 32; LAS int* idx = aux + 64;
            const int tid = fresh_tid();
            const int NB = moe_prefix(cnt, pblk, tid);
            const int n = moe_table<4>(cnt, pblk, tab, aux, NB, G, bid, tid);
            for (int i = 0; i < n; ++i) if (tid < 256) { const int e = aux[i * 3], rs = aux[i * 3 + 1], ce = aux[i * 3 + 2]; idx[i * 256 + tid] = list[(size_t)e * 65536 + min(rs + tid, ce - 1)]; }
            __syncthreads();
            pg8::Gemm g{x1b, Wgu, 2048, 2048, 2048}; pg8::TableOrder<true> S{tab, idx, n, 2048}; pg8::EpiSiluMul E{Hm};
            pg8::gemm_phase(lds, g, S, E);
            SEAM(pb + 7);
        }
        if (IN(pb + 8)) {
            LAS int* pblk = (LAS int*)(lds + MOE_LDS); LAS int* tab = pblk + 64; LAS int* aux = tab + 32;
            const int tid = fresh_tid();
            const int NB = moe_prefix(cnt, pblk, tid);
            const int n = moe_table<8>(cnt, pblk, tab, aux, NB, G, bid, tid);
            pg8::Gemm g{Hm, Wd, 512, 512, 512}; pg8::TableOrder<false> S{tab, nullptr, n, 512}; pg8::EpiBf16 E{Yr, DM, 7};
            pg8::gemm_phase(lds, g, S, E);
            SEAM(pb + 8);
        }
        if (IN(pb + 9)) {
            if (L == 0) phase_combine_ln<false>(x1b, Yr, tok_e, tok_p, tok_g, cnt, p.in[I_LN2G0], p.in[I_LN2B0], RC, nullptr, lds, G, bid, fresh_tid());
            else phase_combine_ln<true>(x1b, Yr, tok_e, tok_p, tok_g, cnt, p.in[I_LN2G1], p.in[I_LN2B1], nullptr, (float*)outb, lds, G, bid, fresh_tid());
            SEAM(pb + 9);
        }
    }
#undef IN
#undef SEAM
}

extern "C" void kernel_launch(void* const* d_in, const int* in_sizes, int n_in, void* d_out, int out_size, void* d_ws, size_t ws_size, hipStream_t stream) {
    static int grid = 0;
    if (grid == 0) {
        if (n_in != 28 || out_size != T_ * DM || ws_size < WS_END) { fprintf(stderr, "kernel_launch: unexpected shapes: n_in %d out %d ws %zu (need %zu)\n", n_in, out_size, ws_size, (size_t)WS_END); grid = -1; return; }
        int dev = 0, cus = 0, per_cu = 0;
        if (hipGetDevice(&dev) != hipSuccess || hipDeviceGetAttribute(&cus, hipDeviceAttributeMultiprocessorCount, dev) != hipSuccess) { grid = -1; return; }
        if (hipFuncSetAttribute((const void*)fwd, hipFuncAttributeMaxDynamicSharedMemorySize, LDS_BYTES) != hipSuccess) { fprintf(stderr, "kernel_launch: hipFuncSetAttribute failed\n"); grid = -1; return; }
        if (hipOccupancyMaxActiveBlocksPerMultiprocessor(&per_cu, (const void*)fwd, NTHR, LDS_BYTES) != hipSuccess || per_cu < 1)
            fprintf(stderr, "kernel_launch: occupancy query reports %d workgroups per CU\n", per_cu);
        (void)hipGetLastError();
        grid = cus;
    }
    if (grid < 0) return;
    (void)hipMemsetAsync((char*)d_ws + WS_CTL, 0, CTL_ZERO_BYTES, stream);
    Params p{};
    for (int i = 0; i < 28; ++i) p.in[i] = (const float*)d_in[i];
    p.out = (float*)d_out; p.ws = (unsigned char*)d_ws;
#if N_LAUNCH_MODE == 1
    p.ph_lo = 0; p.ph_hi = N_PHASES;
    hipLaunchKernelGGL(fwd, dim3(grid), dim3(NTHR), LDS_BYTES, stream, p);
#else
    for (int k = 0; k < N_PHASES; ++k) { if (k == 3 || k == 10) continue; p.ph_lo = k; p.ph_hi = k + 1;
        hipLaunchKernelGGL(fwd, dim3(grid), dim3(NTHR), LDS_BYTES, stream, p); }
#endif
    const hipError_t le = hipPeekAtLastError();
    if (le != hipSuccess) fprintf(stderr, "kernel_launch: launch failed: %s\n", hipGetErrorName(le));
}
```

```cpp
#include <hip/hip_runtime.h>
#include <cstdio>
#include <cstdint>

#ifndef N_LAUNCH_MODE
#define N_LAUNCH_MODE 1
#endif
#ifndef DBG_CHECK
#define DBG_CHECK 0
#endif

#define LAS __attribute__((address_space(3)))
typedef unsigned short bf16_t;
typedef short bf16x8 __attribute__((ext_vector_type(8)));
typedef short s16x4 __attribute__((ext_vector_type(4)));
typedef float f32x2 __attribute__((ext_vector_type(2)));
typedef float f32x4 __attribute__((ext_vector_type(4)));
typedef float f32x8 __attribute__((ext_vector_type(8)));
typedef float f32x16 __attribute__((ext_vector_type(16)));
typedef unsigned u32x2 __attribute__((ext_vector_type(2)));
typedef unsigned u32x4 __attribute__((ext_vector_type(4)));

constexpr int T_ = 32768, DM = 2048, SEQ = 4096, NBATCH = 8;
constexpr int IN0 = 4608, IN1 = 3904, IN1P = 4096;
constexpr int NE = 32, DE = 512, MAXBLK = 288;
constexpr float ALPHA = 1.4142135623730951f;
constexpr float LOG2E = 1.4426950408889634f;
constexpr int NTHR = 512;

constexpr size_t MiB = 1u << 20;
constexpr size_t WS_CTL = 0, CTL_ZERO_BYTES = 1 * MiB;
constexpr size_t WS_LIST = 1 * MiB;
constexpr size_t WS_TOKE = 9 * MiB;
constexpr size_t WS_TOKP = WS_TOKE + 256 * 1024;
constexpr size_t WS_TOKG = WS_TOKP + 256 * 1024;
constexpr size_t WS_RSTAT = WS_TOKG + 256 * 1024;
constexpr size_t WS_KROPE = 10 * MiB;
constexpr size_t WS_WIN0 = 16 * MiB, WS_WOUT0 = 34 * MiB, WS_WGU0 = 42 * MiB, WS_WD0 = 170 * MiB;
constexpr size_t WS_WIN1 = 234 * MiB, WS_WOUT1 = 250 * MiB, WS_WGU1 = 258 * MiB, WS_WD1 = 386 * MiB;
constexpr size_t WS_WQUP = 450 * MiB, WS_WKVUP = 452 * MiB;
constexpr size_t WS_RA = 454 * MiB, WS_RB = 582 * MiB, WS_RC = 870 * MiB, WS_END = 998 * MiB;
constexpr size_t OUT_QD = 0, OUT_O1 = 96 * MiB;
constexpr int CW_CNT = 64;
constexpr int CW_DBG = 512;
constexpr int CW_BAR = 4096;

constexpr int LDS_BYTES = 155648;
constexpr int MISC_OFF = LDS_BYTES - 64;

__device__ __forceinline__ unsigned cvtpk(float lo, float hi) { unsigned r; asm volatile("v_cvt_pk_bf16_f32 %0, %1, %2" : "=v"(r) : "v"(lo), "v"(hi)); return r; }
__device__ __forceinline__ float bf2f(unsigned short b) { return __uint_as_float(((unsigned)b) << 16); }
__device__ __forceinline__ float bflo(unsigned w) { return __uint_as_float(w << 16); }
__device__ __forceinline__ float bfhi(unsigned w) { return __uint_as_float(w & 0xffff0000u); }
__device__ __forceinline__ bf16_t f2bf(float f) { return (bf16_t)(cvtpk(f, f) & 0xffffu); }
__device__ __forceinline__ int fresh_tid() { int t = threadIdx.x; asm volatile("" : "+v"(t)); return t; }
__device__ __forceinline__ float fresh_zero() { float z; asm volatile("v_mov_b32 %0, 0" : "=v"(z)); return z; }
__device__ __forceinline__ float wave_sum(float v) {
#pragma unroll
    for (int o = 32; o >= 1; o >>= 1) v += __shfl_xor(v, o);
    return v;
}
__device__ __forceinline__ float inv_freq32(int i) { return __builtin_amdgcn_exp2f(-(float)i * 0.41524101186092029f); }
__device__ __forceinline__ void sincos_rev(float angle, float& s, float& c) {
    float rev = angle * 0.15915494309189535f; rev = rev - floorf(rev);
    s = __builtin_amdgcn_sinf(rev); c = __builtin_amdgcn_cosf(rev);
}

#define XB_TMO      128
#define XB_XCNT(j)  (256  + 64 * (j))
#define XB_XSUB(j)  (1280 + 64 * (j))
#define XB_XGEN(j)  (2304 + 64 * (j))
#define XB_TOP      3328
#define XB_TOPGEN   3392
#define XCD_BAR_WORDS 3456
#define XB_SPIN_CAP (1u << 20)
__device__ __forceinline__ unsigned xb_ld(unsigned* p)              { return __hip_atomic_load(p, __ATOMIC_RELAXED, __HIP_MEMORY_SCOPE_AGENT); }
__device__ __forceinline__ unsigned xb_add(unsigned* p, unsigned v) { return __hip_atomic_fetch_add(p, v, __ATOMIC_RELAXED, __HIP_MEMORY_SCOPE_AGENT); }
__device__ __forceinline__ unsigned xb_xcc_id() { return (unsigned)__builtin_amdgcn_s_getreg((3 << 11) | 20) & 0xFu; }
#define XB_SPIN(cond, bar) do { unsigned _sp = 0; while (cond) { __builtin_amdgcn_s_sleep(1); \
    if ((++_sp & 255u) == 0u) { if (xb_ld(&(bar)[XB_TMO])) break; if (_sp > XB_SPIN_CAP) { atomicAdd(&(bar)[XB_TMO], 1u); break; } } } } while (0)
struct XcdBarrier { unsigned* bar; unsigned x; volatile LAS unsigned* st; };
__device__ __forceinline__ XcdBarrier xcd_barrier_post(unsigned* bar, volatile LAS unsigned* st) {
    XcdBarrier b; b.bar = bar; b.x = xb_xcc_id(); b.st = st;
    if (threadIdx.x == 0) (void)xb_add(&bar[XB_XCNT(b.x)], 1u);
    return b;
}
__device__ __forceinline__ void xcd_barrier_complete(unsigned* bar, unsigned x, unsigned& nloc, unsigned& nx) {
    const unsigned G = gridDim.x * gridDim.y * gridDim.z;
    unsigned sum, cnt, mine, sp = 0u;
    for (;;) {
        sum = 0u; cnt = 0u; mine = 0u;
#pragma unroll
        for (unsigned j = 0; j < 16; ++j) { const unsigned c = xb_ld(&bar[XB_XCNT(j)]); sum += c; cnt += (c > 0u) ? 1u : 0u; mine = (j == x) ? c : mine; }
        if (sum == G) break;
        __builtin_amdgcn_s_sleep(1);
        if ((++sp & 255u) == 0u) { if (xb_ld(&bar[XB_TMO])) break; if (sp > XB_SPIN_CAP) { atomicAdd(&bar[XB_TMO], 1u); break; } }
    }
    nloc = mine > 0u ? mine : 1u; nx = cnt > 0u ? cnt : 1u;
}
__device__ __forceinline__ void xcd_barrier(const XcdBarrier& b) {
    asm volatile("s_waitcnt vmcnt(0)" ::: "memory");
    __syncthreads();
    if (threadIdx.x == 0) {
        unsigned* bar = b.bar;
        __builtin_amdgcn_s_waitcnt(0);
        unsigned nloc = b.st[0], nx = b.st[1];
        if (nloc == 0u) { xcd_barrier_complete(bar, b.x, nloc, nx); b.st[0] = nloc; b.st[1] = nx; }
        const unsigned old = xb_add(&bar[XB_XSUB(b.x)], 1u);
        const unsigned gen = old / nloc;
        if (old + 1u == (gen + 1u) * nloc) {
            __builtin_amdgcn_fence(__ATOMIC_RELEASE, "agent");
            asm volatile("s_waitcnt vmcnt(0)" ::: "memory");
            const unsigned og = xb_add(&bar[XB_TOP], 1u);
            const unsigned tg = og / nx;
            if (og + 1u == (tg + 1u) * nx) xb_add(&bar[XB_TOPGEN], 1u);
            else XB_SPIN(xb_ld(&bar[XB_TOPGEN]) == tg, bar);
            __builtin_amdgcn_fence(__ATOMIC_ACQUIRE, "agent");
            xb_add(&bar[XB_XGEN(b.x)], 1u);
            asm volatile("s_waitcnt vmcnt(0)" ::: "memory");
        } else {
            XB_SPIN(xb_ld(&bar[XB_XGEN(b.x)]) == gen, bar);
            __builtin_amdgcn_fence(__ATOMIC_ACQUIRE, "agent");
            asm volatile("s_waitcnt vmcnt(0)" ::: "memory");
        }
    }
    __syncthreads();
}

namespace pg8 {
constexpr int BM = 256, BK = 64, HALF = 128, HTB = HALF * BK * 2, STAGE_BYTES = 8 * HTB, NXCD = 8, WGM = 8;
__device__ __forceinline__ int lds_byte(int r, int c) { const int st = (r >> 4) * 2 + (c >> 5), rr = r & 15, cc = c & 31, ob = rr * 64 + cc * 2; return st * 1024 + (ob ^ (((ob >> 9) & 1) << 5)); }
__device__ __forceinline__ void stage_rc(int b, int& R, int& C) { const int st = b / 1024, sb = b % 1024, swz = sb ^ (((sb >> 9) & 1) << 5); R = (st >> 1) * 16 + swz / 64; C = (st & 1) * 32 + (swz % 64) / 2; }
__device__ __forceinline__ int perm32(int rho) { const int n = rho >> 4, i = rho & 15; return 8 * (i >> 2) + 4 * n + (i & 3); }
struct Unit { int pm, pn, q; };
struct Gemm { const bf16_t* A; const bf16_t* Bt; int K, lda, ldb; };

struct StaticOrder {
    static constexpr bool GATHER = false;
    int nM, nN, nwg, G, c, lda;
    __device__ void init(int M, int N, int G_, int c_, int lda_) { nM = M / BM; nN = N / BM; nwg = nM * nN; G = G_; c = c_; lda = lda_; }
    __device__ __forceinline__ bool next(int i, Unit& u) const {
        const long L = (long)i * G + c; if (L >= nwg) return false;
        int wgid = (int)L; { const int q = nwg / NXCD, r = nwg % NXCD, xcd = wgid % NXCD, off = wgid / NXCD; wgid = (xcd < r ? xcd * (q + 1) : r * (q + 1) + (xcd - r) * q) + off; }
        const int nig = WGM * nN, gid = wgid / nig, fm = gid * WGM, gsz = (nM - fm) < WGM ? (nM - fm) : WGM;
        u.pm = fm + ((wgid % nig) % gsz); u.pn = (wgid % nig) / gsz; u.q = i; return true;
    }
    __device__ __forceinline__ void aoff(const Unit& u, const int (&R)[2], const int (&C)[2], unsigned (&o)[2][2]) const {
#pragma unroll
        for (int h = 0; h < 2; ++h)
#pragma unroll
            for (int i = 0; i < 2; ++i) o[h][i] = (unsigned)((u.pm * BM + h * HALF + R[i]) * lda + C[i]) * 2u;
    }
};
template <bool GATHER_> struct TableOrder {
    static constexpr bool GATHER = GATHER_;
    const LAS int* tab; const LAS int* idx; int n, lda;
    __device__ __forceinline__ bool next(int i, Unit& u) const { if (i >= n) return false; u.pm = tab[i]; u.pn = tab[16 + i]; u.q = i; return true; }
    __device__ __forceinline__ void aoff(const Unit& u, const int (&R)[2], const int (&C)[2], unsigned (&o)[2][2]) const {
#pragma unroll
        for (int h = 0; h < 2; ++h)
#pragma unroll
            for (int i = 0; i < 2; ++i) { const int row = GATHER ? idx[u.q * 256 + h * HALF + R[i]] : (u.pm * BM + h * HALF + R[i]); o[h][i] = (unsigned)(row * lda + C[i]) * 2u; }
    }
};

struct EpiBf16 {
    static constexpr bool PERM = true;
    bf16_t* O; int ldc; int pnmask;
    __device__ __forceinline__ void operator()(const f32x4 (&acc)[2][2][4][2], const Unit& u, int wr, int wc, int fr, int fq) const {
        const int row0 = u.pm * BM + wr * 64 + fr; const int col0 = (u.pn & pnmask) * BM + wc * 32 + 8 * fq;
#pragma unroll
        for (int ai = 0; ai < 2; ++ai)
#pragma unroll
            for (int m = 0; m < 4; ++m) { bf16_t* rowp = O + (size_t)(row0 + ai * HALF + m * 16) * ldc + col0;
#pragma unroll
                for (int bj = 0; bj < 2; ++bj) { const f32x4 v0 = acc[ai][bj][m][0], v1 = acc[ai][bj][m][1];
                    u32x4 w; w.x = cvtpk(v0[0], v0[1]); w.y = cvtpk(v0[2], v0[3]); w.z = cvtpk(v1[0], v1[1]); w.w = cvtpk(v1[2], v1[3]);
                    *(u32x4*)(rowp + bj * HALF) = w; } }
    }
};
struct EpiRowScale {
    static constexpr bool PERM = true;
    bf16_t* O; int ldc; const float* rs; int which;
    __device__ __forceinline__ void operator()(const f32x4 (&acc)[2][2][4][2], const Unit& u, int wr, int wc, int fr, int fq) const {
        const int row0 = u.pm * BM + wr * 64 + fr; const int col0 = u.pn * BM + wc * 32 + 8 * fq;
#pragma unroll
        for (int ai = 0; ai < 2; ++ai)
#pragma unroll
            for (int m = 0; m < 4; ++m) { const int row = row0 + ai * HALF + m * 16; const float s = rs[row * 2 + which]; bf16_t* rowp = O + (size_t)row * ldc + col0;
#pragma unroll
                for (int bj = 0; bj < 2; ++bj) { const f32x4 v0 = acc[ai][bj][m][0] * s, v1 = acc[ai][bj][m][1] * s;
                    u32x4 w; w.x = cvtpk(v0[0], v0[1]); w.y = cvtpk(v0[2], v0[3]); w.z = cvtpk(v1[0], v1[1]); w.w = cvtpk(v1[2], v1[3]);
                    *(u32x4*)(rowp + bj * HALF) = w; } }
    }
};
struct EpiSiluMul {
    static constexpr bool PERM = true;
    bf16_t* O;
    __device__ __forceinline__ void operator()(const f32x4 (&acc)[2][2][4][2], const Unit& u, int wr, int wc, int fr, int fq) const {
        const int row0 = u.pm * BM + wr * 64 + fr; const int col0 = (u.pn & 3) * HALF + wc * 32 + 8 * fq;
#pragma unroll
        for (int ai = 0; ai < 2; ++ai)
#pragma unroll
            for (int m = 0; m < 4; ++m) { bf16_t* rowp = O + (size_t)(row0 + ai * HALF + m * 16) * DE + col0; float h[8];
#pragma unroll
                for (int n = 0; n < 2; ++n)
#pragma unroll
                    for (int j = 0; j < 4; ++j) { const float g = acc[ai][0][m][n][j], up = acc[ai][1][m][n][j];
                        const float sg = g * __builtin_amdgcn_rcpf(1.0f + __builtin_amdgcn_exp2f(-g * LOG2E)); h[n * 4 + j] = sg * up; }
                u32x4 w; w.x = cvtpk(h[0], h[1]); w.y = cvtpk(h[2], h[3]); w.z = cvtpk(h[4], h[5]); w.w = cvtpk(h[6], h[7]);
                *(u32x4*)rowp = w; }
    }
};
struct EpiResF32 {
    static constexpr bool PERM = false;
    float* Z; const bf16_t* res;
    __device__ __forceinline__ void operator()(const f32x4 (&acc)[2][2][4][2], const Unit& u, int wr, int wc, int fr, int fq) const {
        const int row0 = u.pm * BM + wr * 64 + fr, col0 = u.pn * BM + wc * 32 + 4 * fq;
#pragma unroll
        for (int ai = 0; ai < 2; ++ai)
#pragma unroll
            for (int m = 0; m < 4; ++m) { const size_t off = (size_t)(row0 + ai * HALF + m * 16) * DM + col0;
#pragma unroll
                for (int bj = 0; bj < 2; ++bj)
#pragma unroll
                    for (int n = 0; n < 2; ++n) { const u32x2 rb = *(const u32x2*)(res + off + bj * HALF + n * 16);
                        f32x4 o = acc[ai][bj][m][n]; o[0] += ALPHA * bflo(rb.x); o[1] += ALPHA * bfhi(rb.x); o[2] += ALPHA * bflo(rb.y); o[3] += ALPHA * bfhi(rb.y);
                        *(f32x4*)(Z + off + bj * HALF + n * 16) = o; } }
    }
};

template <class Epi, class Sched>
__device__ __forceinline__ void gemm_phase(LAS unsigned char* lds, const Gemm g, const Sched& S, const Epi& E) {
    constexpr bool GA = Sched::GATHER;
    const int tid = fresh_tid(), wid = __builtin_amdgcn_readfirstlane(tid >> 6), lane = tid & 63, wr = wid >> 2, wc = wid & 3, fr = lane & 15, fq = lane >> 4;
    const int K = g.K, nt = K / BK;
    int Rr[2], Cc[2]; unsigned voffA[2], voffB[2];
#pragma unroll
    for (int i = 0; i < 2; ++i) { int R, C; stage_rc(tid * 16 + i * 8192, R, C); Rr[i] = R; Cc[i] = C; const int Rb = Epi::PERM ? ((R & ~31) + perm32(R & 31)) : R;
        voffA[i] = (unsigned)(R * g.lda + C) * 2u; voffB[i] = (unsigned)(Rb * g.ldb + C) * 2u; }
    const size_t kstep = (size_t)(BK * 2);
    const size_t hstepA = (size_t)HALF * g.lda * 2, tstepA = 2 * hstepA;
    const size_t hstepB = (size_t)HALF * g.ldb * 2, tstepB = 2 * hstepB;
    const unsigned ldsw = (unsigned)wid * 1024u;
    const int aoff = lds_byte(wr * 64 + fr, fq * 8), boff = lds_byte(wc * 32 + fr, fq * 8);
#define PG8_SA(b, h) (((b) * 2 + (h)) * HTB)
#define PG8_SB(b, h) ((4 + (b) * 2 + (h)) * HTB)
#define PG8_STAGE(bufoff, gbase, voff) do { _Pragma("unroll") for (int _i = 0; _i < 2; ++_i) \
        __builtin_amdgcn_global_load_lds((const unsigned*)((const char*)(gbase) + (voff)[_i]), (LAS unsigned*)(lds + (bufoff) + ldsw + _i * 8192), 16, 0, 0); } while (0)
#define PG8_STAGE_A(bufoff, h, pbase, koff, goffs) do { if constexpr (GA) { PG8_STAGE(bufoff, gA + (koff), (goffs)[h]); } else { PG8_STAGE(bufoff, (pbase) + (h) * hstepA, voffA); } } while (0)
#define PG8_LDA(dst, b, h) do { _Pragma("unroll") for (int m = 0; m < 4; ++m) _Pragma("unroll") for (int k = 0; k < 2; ++k) dst[m][k] = *(const LAS bf16x8*)(lds + PG8_SA(b, h) + aoff + m * 2048 + k * 1024); } while (0)
#define PG8_LDB(dst, b, h) do { _Pragma("unroll") for (int n = 0; n < 2; ++n) _Pragma("unroll") for (int k = 0; k < 2; ++k) dst[n][k] = *(const LAS bf16x8*)(lds + PG8_SB(b, h) + boff + n * 2048 + k * 1024); } while (0)
#define PG8_MMA(ai, bj, At, Bt) do { __builtin_amdgcn_s_setprio(1); _Pragma("unroll") for (int m = 0; m < 4; ++m) _Pragma("unroll") for (int n = 0; n < 2; ++n) _Pragma("unroll") for (int k = 0; k < 2; ++k) \
        acc[ai][bj][m][n] = __builtin_amdgcn_mfma_f32_16x16x32_bf16(Bt[n][k], At[m][k], acc[ai][bj][m][n], 0, 0, 0); __builtin_amdgcn_s_setprio(0); } while (0)
#define PG8_WAIT_V(n) asm volatile("s_waitcnt vmcnt(" #n ")" ::: "memory")
#define PG8_WAIT_L(n) asm volatile("s_waitcnt lgkmcnt(" #n ")" ::: "memory")
#define PG8_BAR __builtin_amdgcn_s_barrier()
#define PG8_SCHED __builtin_amdgcn_sched_barrier(0)
    Unit cur, nxt; int ui = 0;
    if (!S.next(0, cur)) return;
    f32x4 acc[2][2][4][2];
#pragma unroll
    for (int a = 0; a < 2; ++a)
#pragma unroll
        for (int b = 0; b < 2; ++b)
#pragma unroll
            for (int m = 0; m < 4; ++m)
#pragma unroll
                for (int n = 0; n < 2; ++n) { const float zf = fresh_zero(); acc[a][b][m][n] = (f32x4){zf, zf, zf, zf}; }
    bf16x8 At[4][2], B0[2][2], B1[2][2];
    unsigned ca[2][2], na[2][2];
    if constexpr (GA) S.aoff(cur, Rr, Cc, ca);
    const char* gA = (const char*)g.A;
    const char* cA = gA + (GA ? (size_t)0 : (size_t)cur.pm * tstepA);
    const char* cB = (const char*)g.Bt + (size_t)cur.pn * tstepB;
    PG8_STAGE(PG8_SB(0, 0), cB, voffB); PG8_STAGE_A(PG8_SA(0, 0), 0, cA, 0, ca); PG8_STAGE(PG8_SB(0, 1), cB + hstepB, voffB); PG8_STAGE_A(PG8_SA(0, 1), 1, cA, 0, ca);
    if (wr == 1) PG8_BAR;
    PG8_WAIT_V(4); PG8_BAR;
    PG8_STAGE(PG8_SB(1, 0), cB + kstep, voffB); PG8_STAGE_A(PG8_SA(1, 0), 0, cA + kstep, kstep, ca); PG8_STAGE(PG8_SB(1, 1), cB + hstepB + kstep, voffB);
    PG8_WAIT_V(6); PG8_BAR;
    for (;;) {
        const bool has_next = S.next(ui + 1, nxt);
        if constexpr (GA) {
            if (has_next) S.aoff(nxt, Rr, Cc, na);
            else {
#pragma unroll
                for (int h = 0; h < 2; ++h)
#pragma unroll
                    for (int i = 0; i < 2; ++i) na[h][i] = ca[h][i];
            }
        }
        const char* nA = (!GA && has_next) ? gA + (size_t)nxt.pm * tstepA : cA;
        const char* nB = has_next ? (const char*)g.Bt + (size_t)nxt.pn * tstepB : cB;
#pragma unroll 1
        for (int t = 0; t < nt; t += 2) {
            const bool last = (t == nt - 2);
            const size_t k1 = (size_t)(t + 1) * kstep, k2 = last ? (size_t)0 : (size_t)(t + 2) * kstep, k3 = k2 + kstep;
            const char* a1 = cA + k1;
            const char* a2 = last ? nA : cA + k2; const char* b2 = last ? nB : cB + (size_t)(t + 2) * kstep;
            const char* a3 = a2 + kstep; const char* b3 = b2 + kstep;
            unsigned xa[2][2];
            if constexpr (GA) {
#pragma unroll
                for (int h = 0; h < 2; ++h)
#pragma unroll
                    for (int i = 0; i < 2; ++i) xa[h][i] = last ? na[h][i] : ca[h][i];
            }
            PG8_LDB(B0, 0, 0); PG8_SCHED; PG8_LDA(At, 0, 0); PG8_STAGE_A(PG8_SA(1, 1), 1, a1, k1, ca);
            PG8_WAIT_L(8); PG8_BAR; PG8_WAIT_L(0); PG8_MMA(0, 0, At, B0); PG8_BAR; PG8_SCHED;
            PG8_LDB(B1, 0, 1); PG8_STAGE(PG8_SB(0, 0), b2, voffB);
            PG8_BAR; PG8_WAIT_L(0); PG8_MMA(0, 1, At, B1); PG8_BAR;
            PG8_LDA(At, 0, 1); PG8_STAGE_A(PG8_SA(0, 0), 0, a2, k2, xa);
            PG8_BAR; PG8_WAIT_L(0); PG8_MMA(1, 0, At, B0); PG8_BAR; PG8_SCHED;
            PG8_STAGE(PG8_SB(0, 1), b2 + hstepB, voffB);
            PG8_WAIT_V(6); PG8_BAR; PG8_MMA(1, 1, At, B1); PG8_BAR;
            PG8_LDB(B0, 1, 0); PG8_SCHED; PG8_LDA(At, 1, 0); PG8_STAGE_A(PG8_SA(0, 1), 1, a2, k2, xa);
            PG8_WAIT_L(8); PG8_BAR; PG8_WAIT_L(0); PG8_MMA(0, 0, At, B0); PG8_BAR; PG8_SCHED;
            PG8_LDB(B1, 1, 1); PG8_STAGE(PG8_SB(1, 0), b3, voffB);
            PG8_BAR; PG8_WAIT_L(0); PG8_MMA(0, 1, At, B1); PG8_BAR;
            PG8_LDA(At, 1, 1); PG8_STAGE_A(PG8_SA(1, 0), 0, a3, k3, xa);
            PG8_BAR; PG8_WAIT_L(0); PG8_MMA(1, 0, At, B0); PG8_BAR; PG8_SCHED;
            PG8_STAGE(PG8_SB(1, 1), b3 + hstepB, voffB);
            PG8_WAIT_V(6); PG8_BAR; PG8_MMA(1, 1, At, B1); PG8_BAR;
        }
        E(acc, cur, wr, wc, fr, fq);
        if (!has_next) break;
#pragma unroll
        for (int a = 0; a < 2; ++a)
#pragma unroll
            for (int b = 0; b < 2; ++b)
#pragma unroll
                for (int m = 0; m < 4; ++m)
#pragma unroll
                    for (int n = 0; n < 2; ++n) { const float zf = fresh_zero(); acc[a][b][m][n] = (f32x4){zf, zf, zf, zf}; }
        cur = nxt; cA = nA; cB = nB; ++ui;
        if constexpr (GA) {
#pragma unroll
            for (int h = 0; h < 2; ++h)
#pragma unroll
                for (int i = 0; i < 2; ++i) ca[h][i] = na[h][i];
        }
    }
    PG8_WAIT_V(0);
    if (wr == 0) PG8_BAR;
    PG8_BAR;
#undef PG8_SA
#undef PG8_SB
#undef PG8_STAGE
#undef PG8_STAGE_A
#undef PG8_LDA
#undef PG8_LDB
#undef PG8_MMA
#undef PG8_WAIT_V
#undef PG8_WAIT_L
#undef PG8_BAR
#undef PG8_SCHED
}
}

namespace da {
constexpr int KVBLK = 64;
constexpr float THR = 8.f;
constexpr int SHM_V = KVBLK * 128 * 2, SHM_K = KVBLK * 128 * 2, SHM_KR = KVBLK * 64 * 2;
constexpr int OFF_V = 0, OFF_K = 2 * SHM_V, OFF_WS = OFF_K + 2 * SHM_K, OFF_KR = OFF_WS + 8 * 64 * 4, OFF_QR = OFF_KR + 2 * SHM_KR, LDS_DENSE = OFF_QR + 8 * 4096;
#define KSWZ(row, colB) ((row) * 256 + ((colB) ^ (((row) & 7) << 4)))
#define KRSWZ(row, ch) ((row) * 128 + ((((ch) ^ ((row) >> 1)) & 7) << 4))
#define SBAR() __builtin_amdgcn_sched_barrier(0)
__device__ __forceinline__ int crow(int r, int hi) { return (r & 3) + 8 * (r >> 2) + 4 * hi; }
__device__ __forceinline__ int v_st(int k, int c) { const int kk = (k & ~0xC) | ((k & 4) << 1) | ((k & 8) >> 1); return ((kk >> 3) * 4 + (c >> 5)) * 512 + ((kk & 7) * 32 + (c & 31)) * 2; }
__device__ __forceinline__ int v_rd_base(int lane) { return ((lane & 3) << 3) | (((lane >> 2) & 3) << 6) | (((lane >> 4) & 1) << 5) | (((lane >> 5) & 1) << 8); }
constexpr int v_rd_off(int d0, int ks, int half) { return d0 * 512 + ks * 4096 + half * 2048; }
template <int OFF> __device__ __forceinline__ s16x4 tr_read(int vb) {
    s16x4 r; asm volatile("ds_read_b64_tr_b16 %0, %1 offset:%2" : "=&v"(r) : "v"(vb), "i"(OFF) : "memory"); return r;
}
template <int D0> __device__ __forceinline__ void pv_one(f32x16& od, int vb, bf16x8 pa0, bf16x8 pa1, bf16x8 pa2, bf16x8 pa3) {
    const s16x4 l0 = tr_read<v_rd_off(D0, 0, 0)>(vb), h0 = tr_read<v_rd_off(D0, 0, 1)>(vb), l1 = tr_read<v_rd_off(D0, 1, 0)>(vb), h1 = tr_read<v_rd_off(D0, 1, 1)>(vb);
    const s16x4 l2 = tr_read<v_rd_off(D0, 2, 0)>(vb), h2 = tr_read<v_rd_off(D0, 2, 1)>(vb), l3 = tr_read<v_rd_off(D0, 3, 0)>(vb), h3 = tr_read<v_rd_off(D0, 3, 1)>(vb);
    asm volatile("s_waitcnt lgkmcnt(0)" ::: "memory"); SBAR();
#define PK(L, H) (bf16x8){L[0], L[1], L[2], L[3], H[0], H[1], H[2], H[3]}
    od = __builtin_amdgcn_mfma_f32_32x32x16_bf16(pa0, PK(l0, h0), od, 0, 0, 0);
    od = __builtin_amdgcn_mfma_f32_32x32x16_bf16(pa1, PK(l1, h1), od, 0, 0, 0);
    od = __builtin_amdgcn_mfma_f32_32x32x16_bf16(pa2, PK(l2, h2), od, 0, 0, 0);
    od = __builtin_amdgcn_mfma_f32_32x32x16_bf16(pa3, PK(l3, h3), od, 0, 0, 0);
}
__device__ __forceinline__ void pv_d0(f32x16* o, int vb, bf16x8 pa0, bf16x8 pa1, bf16x8 pa2, bf16x8 pa3) {
    pv_one<0>(o[0], vb, pa0, pa1, pa2, pa3); pv_one<1>(o[1], vb, pa0, pa1, pa2, pa3); pv_one<2>(o[2], vb, pa0, pa1, pa2, pa3); pv_one<3>(o[3], vb, pa0, pa1, pa2, pa3);
}
template <int D0> __device__ __forceinline__ void pv_one32(f32x16& od, int vb, bf16x8 pa0, bf16x8 pa1) {
    const s16x4 l0 = tr_read<v_rd_off(D0, 0, 0)>(vb), h0 = tr_read<v_rd_off(D0, 0, 1)>(vb), l1 = tr_read<v_rd_off(D0, 1, 0)>(vb), h1 = tr_read<v_rd_off(D0, 1, 1)>(vb);
    asm volatile("s_waitcnt lgkmcnt(0)" ::: "memory"); SBAR();
    od = __builtin_amdgcn_mfma_f32_32x32x16_bf16(pa0, PK(l0, h0), od, 0, 0, 0);
    od = __builtin_amdgcn_mfma_f32_32x32x16_bf16(pa1, PK(l1, h1), od, 0, 0, 0);
}
#undef PK
#define PK4(P, BASE, OUT) do { unsigned a0 = cvtpk(P[BASE + 0], P[BASE + 1]), a1 = cvtpk(P[BASE + 2], P[BASE + 3]);   \
    unsigned b0 = cvtpk(P[BASE + 4], P[BASE + 5]), b1 = cvtpk(P[BASE + 6], P[BASE + 7]);                              \
    auto r0 = __builtin_amdgcn_permlane32_swap(a0, b0, false, false); auto r1 = __builtin_amdgcn_permlane32_swap(a1, b1, false, false); \
    u32x4 w = {r0[0], r1[0], r0[1], r1[1]}; OUT = *reinterpret_cast<bf16x8*>(&w); } while (0)

template <int NDQ> struct Cst { static constexpr float SCALE = (NDQ == 8) ? 0.088388347648318440f : 0.072168783648703220f; static constexpr float C = SCALE * LOG2E; };

template <int NDQ>
__device__ __forceinline__ void partialSM(f32x16& p0, f32x16& p1, float& m_reg, float& mn, float& alpha) {
    constexpr float C = Cst<NDQ>::C, SCALE = Cst<NDQ>::SCALE;
    float pmax = p0[0];
#pragma unroll
    for (int r = 1; r < 16; ++r) pmax = fmaxf(pmax, p0[r]);
#pragma unroll
    for (int r = 0; r < 16; ++r) pmax = fmaxf(pmax, p1[r]);
    { auto rr = __builtin_amdgcn_permlane32_swap(__float_as_uint(pmax), __float_as_uint(pmax), false, false);
      pmax = fmaxf(__uint_as_float(rr[0]), __uint_as_float(rr[1])); }
    if (__builtin_expect(__all(pmax - m_reg <= THR / SCALE), 1)) { mn = m_reg; alpha = 1.f; }
    else { mn = fmaxf(m_reg, pmax); alpha = __builtin_amdgcn_exp2f((m_reg - mn) * C); m_reg = mn; }
    const float mnC = -mn * C;
#pragma unroll
    for (int r = 0; r < 16; ++r) p0[r] = fmaf(p0[r], C, mnC);
#pragma unroll
    for (int r = 0; r < 16; ++r) p1[r] = fmaf(p1[r], C, mnC);
#pragma unroll
    for (int r = 0; r < 16; ++r) p0[r] = __builtin_amdgcn_exp2f(p0[r]);
}
__device__ __forceinline__ void finishSM(f32x16& p0, f32x16& p1, float alpha, float& l_reg, bf16x8& pa0, bf16x8& pa1, bf16x8& pa2, bf16x8& pa3) {
#pragma unroll
    for (int r = 0; r < 16; ++r) p1[r] = __builtin_amdgcn_exp2f(p1[r]);
    float ps = 0;
#pragma unroll
    for (int r = 0; r < 16; ++r) ps += p0[r];
#pragma unroll
    for (int r = 0; r < 16; ++r) ps += p1[r];
    { auto rr = __builtin_amdgcn_permlane32_swap(__float_as_uint(ps), __float_as_uint(ps), false, false);
      ps = __uint_as_float(rr[0]) + __uint_as_float(rr[1]); }
    l_reg = l_reg * alpha + ps;
    PK4(p0, 0, pa0); PK4(p0, 8, pa1); PK4(p1, 0, pa2); PK4(p1, 8, pa3);
}
template <int NDQ>
__device__ __forceinline__ void qkt(f32x16& p0, f32x16& p1, const char* Ks, const char* Krs, const bf16x8* qr, const char* qrl, int r32, int hi) {
    p0 = f32x16{}; p1 = f32x16{};
#pragma unroll
    for (int d0 = 0; d0 < 8; ++d0) { const int cb = (d0 * 16 + hi * 8) * 2;
        bf16x8 b0 = *reinterpret_cast<const bf16x8*>(Ks + KSWZ(r32, cb));
        bf16x8 b1 = *reinterpret_cast<const bf16x8*>(Ks + KSWZ(32 + r32, cb));
        p0 = __builtin_amdgcn_mfma_f32_32x32x16_bf16(b0, qr[d0], p0, 0, 0, 0);
        p1 = __builtin_amdgcn_mfma_f32_32x32x16_bf16(b1, qr[d0], p1, 0, 0, 0); }
    if constexpr (NDQ == 12) {
#pragma unroll
        for (int d0 = 0; d0 < 4; ++d0) { const int ch = d0 * 2 + hi;
            bf16x8 b0 = *reinterpret_cast<const bf16x8*>(Krs + KRSWZ(r32, ch));
            bf16x8 b1 = *reinterpret_cast<const bf16x8*>(Krs + KRSWZ(32 + r32, ch));
            const bf16x8 qf = *reinterpret_cast<const bf16x8*>(qrl + d0 * 1024);
            p0 = __builtin_amdgcn_mfma_f32_32x32x16_bf16(b0, qf, p0, 0, 0, 0);
            p1 = __builtin_amdgcn_mfma_f32_32x32x16_bf16(b1, qf, p1, 0, 0, 0); }
    }
}

struct DArgs { const bf16_t* Q; const bf16_t* K; const bf16_t* V; const bf16_t* Kr; bf16_t* O; int ldq, ldk, ldv, ldo; int seq; int pos0; };

template <int NDQ, int SDEPTH>
__device__ __forceinline__ void attn_dense_body(const DArgs a, char* lds) {
    const int tid = fresh_tid(), wid = tid >> 6, lane = tid & 63, r32 = lane & 31, hi = lane >> 5;
    char* V_lds = lds + OFF_V; char* K_lds = lds + OFF_K; char* Kr_lds = lds + OFF_KR;
    float* ws = (float*)(lds + OFF_WS) + wid * 64; float* li_l = ws; float* al_l = ws + 32;
    float m_reg = -1e30f, l_reg = 0; f32x16 o[4] = {}; bf16x8 qr[8];
    char* qrl = lds + OFF_QR + wid * 4096 + lane * 16;
    const bf16_t* Qw = a.Q + (long)(wid * 32 + r32) * a.ldq + hi * 8;
#pragma unroll
    for (int d0 = 0; d0 < 8; ++d0) qr[d0] = *reinterpret_cast<const bf16x8*>(Qw + d0 * 16);
    if constexpr (NDQ == 12) {
        const float pos = (float)(a.pos0 + wid * 32 + r32);
#pragma unroll
        for (int f = 0; f < 2; ++f) {
            const bf16x8 x1v = *reinterpret_cast<const bf16x8*>(Qw + (8 + f) * 16), x2v = *reinterpret_cast<const bf16x8*>(Qw + (10 + f) * 16); bf16x8 y1v, y2v;
#pragma unroll
            for (int j = 0; j < 8; ++j) { const int i = f * 16 + hi * 8 + j; float sn, cs; sincos_rev(pos * inv_freq32(i), sn, cs);
                const float x1 = bf2f((unsigned short)x1v[j]), x2 = bf2f((unsigned short)x2v[j]);
                y1v[j] = (short)f2bf(x1 * cs - x2 * sn); y2v[j] = (short)f2bf(x2 * cs + x1 * sn); }
            *reinterpret_cast<bf16x8*>(qrl + f * 1024) = y1v; *reinterpret_cast<bf16x8*>(qrl + (2 + f) * 1024) = y2v;
        }
    }
    const int sr = tid >> 4, sc = (tid & 15) * 8, vst0 = v_st(sr, sc), vst1 = v_st(32 + sr, sc);
    const int krr = tid >> 3, krc = tid & 7;
    const int vb0 = (int)(uintptr_t)V_lds + v_rd_base(lane);
    struct { bf16x8 vs0, vs1, ks0, ks1, kr; } sr_[SDEPTH];
#define SLOAD(i, k0) do { sr_[i].vs0 = *(const bf16x8*)(a.V + (long)((k0) + sr) * a.ldv + sc); sr_[i].vs1 = *(const bf16x8*)(a.V + (long)((k0) + 32 + sr) * a.ldv + sc); \
    sr_[i].ks0 = *(const bf16x8*)(a.K + (long)((k0) + sr) * a.ldk + sc); sr_[i].ks1 = *(const bf16x8*)(a.K + (long)((k0) + 32 + sr) * a.ldk + sc); \
    if constexpr (NDQ == 12) sr_[i].kr = *(const bf16x8*)(a.Kr + (long)((k0) + krr) * 64 + krc * 8); } while (0)
#define SWRITE(b, i) do { *(bf16x8*)(V_lds + (b) * SHM_V + vst0) = sr_[i].vs0; *(bf16x8*)(V_lds + (b) * SHM_V + vst1) = sr_[i].vs1; const int kc = sc * 2; \
    *(bf16x8*)(K_lds + (b) * SHM_K + KSWZ(sr, kc)) = sr_[i].ks0; *(bf16x8*)(K_lds + (b) * SHM_K + KSWZ(32 + sr, kc)) = sr_[i].ks1; \
    if constexpr (NDQ == 12) *(bf16x8*)(Kr_lds + (b) * SHM_KR + KRSWZ(krr, krc)) = sr_[i].kr; } while (0)
#define SWAIT() do { if constexpr (SDEPTH == 2) { if constexpr (NDQ == 12) asm volatile("s_waitcnt vmcnt(5)" ::: "memory"); else asm volatile("s_waitcnt vmcnt(4)" ::: "memory"); } else asm volatile("s_waitcnt vmcnt(0)" ::: "memory"); } while (0)
#define RESC(al) do { if (__any((al) < 1.f)) { if (hi == 0) al_l[r32] = (al); asm volatile("s_waitcnt lgkmcnt(0)" ::: "memory"); \
    _Pragma("unroll") for (int d = 0; d < 4; ++d) _Pragma("unroll") for (int r = 0; r < 16; ++r) o[d][r] *= al_l[crow(r, hi)]; } } while (0)
    f32x16 pA0, pA1, pB0, pB1; float mnA, mnB, alA, alB; bf16x8 pa0, pa1, pa2, pa3; const int NT = a.seq / KVBLK;
    constexpr int SE = 0, SO = SDEPTH - 1;
    SLOAD(SE, 0); asm volatile("s_waitcnt vmcnt(0)" ::: "memory"); SWRITE(0, SE); __syncthreads();
    qkt<NDQ>(pA0, pA1, K_lds, Kr_lds, qr, qrl, r32, hi); partialSM<NDQ>(pA0, pA1, m_reg, mnA, alA);
    SLOAD(SO, KVBLK); if constexpr (SDEPTH == 2) { if (2 < NT) SLOAD(SE, 2 * KVBLK); }
    SWAIT(); SWRITE(1, SO); __syncthreads();
#pragma unroll 1
    for (int j = 1; j + 1 < NT; j += 2) {
        SBAR(); qkt<NDQ>(pB0, pB1, K_lds + SHM_K, Kr_lds + SHM_KR, qr, qrl, r32, hi);
        finishSM(pA0, pA1, alA, l_reg, pa0, pa1, pa2, pa3); SBAR();
        SLOAD(SO, (j + SDEPTH) * KVBLK); SBAR();
        pv_d0(o, vb0, pa0, pa1, pa2, pa3); partialSM<NDQ>(pB0, pB1, m_reg, mnB, alB);
        __syncthreads(); SWAIT(); SWRITE(0, SE);
        RESC(alB); __syncthreads();
        SBAR(); qkt<NDQ>(pA0, pA1, K_lds, Kr_lds, qr, qrl, r32, hi);
        finishSM(pB0, pB1, alB, l_reg, pa0, pa1, pa2, pa3); SBAR();
        if (SDEPTH == 1 || j + 3 < NT) SLOAD(SE, (j + 1 + SDEPTH) * KVBLK); SBAR();
        pv_d0(o, vb0 + (int)SHM_V, pa0, pa1, pa2, pa3); partialSM<NDQ>(pA0, pA1, m_reg, mnA, alA);
        __syncthreads(); SWAIT(); SWRITE(1, SO);
        RESC(alA); __syncthreads();
    }
    SBAR(); qkt<NDQ>(pB0, pB1, K_lds + SHM_K, Kr_lds + SHM_KR, qr, qrl, r32, hi);
    finishSM(pA0, pA1, alA, l_reg, pa0, pa1, pa2, pa3); SBAR();
    pv_d0(o, vb0, pa0, pa1, pa2, pa3); partialSM<NDQ>(pB0, pB1, m_reg, mnB, alB);
    __syncthreads(); RESC(alB);
    finishSM(pB0, pB1, alB, l_reg, pa0, pa1, pa2, pa3); SBAR();
    pv_d0(o, vb0 + (int)SHM_V, pa0, pa1, pa2, pa3);
    if (hi == 0) li_l[r32] = l_reg; asm volatile("s_waitcnt lgkmcnt(0)" ::: "memory");
    float rli[16];
#pragma unroll
    for (int r = 0; r < 16; ++r) rli[r] = __builtin_amdgcn_rcpf(li_l[crow(r, hi)]);
    bf16_t* Ow = a.O + (long)(wid * 32) * a.ldo;
#pragma unroll
    for (int r = 0; r < 16; ++r) { const int orow = crow(r, hi);
#pragma unroll
        for (int d0 = 0; d0 < 4; ++d0) Ow[(long)orow * a.ldo + d0 * 32 + r32] = f2bf(o[d0][r] * rli[r]); }
#undef SLOAD
#undef SWRITE
#undef SWAIT
#undef RESC
}

constexpr int SP_WAVE_LDS = 18688;
template <class P>
__device__ __forceinline__ void sparse_wave(P& pol, char* wl, int lane) {
    const int r32 = lane & 31, hi = lane >> 5;
    char* Kl = wl; char* Vl = wl + 8192; float* li_l = (float*)(wl + 16384); float* al_l = li_l + 32;
    bf16x8 qr[8];
    { const bf16_t* qp = pol.qptr(r32) + hi * 8;
#pragma unroll
      for (int d0 = 0; d0 < 8; ++d0) qr[d0] = *reinterpret_cast<const bf16x8*>(qp + d0 * 16); }
    f32x16 o[4] = {}; float m_reg = -1e30f, l_reg = 0.f;
    const int srow = lane >> 4, sch = lane & 15;
    const int vb = (int)(uintptr_t)Vl + v_rd_base(lane);
    bf16x8 ks[8], vs[8];
    const int nt = pol.ntiles();
    typename P::TI ti, tn;
    pol.tile(0, ti);
#pragma unroll
    for (int i = 0; i < 8; ++i) { ks[i] = *(const bf16x8*)(ti.k + (long)(srow + 4 * i) * ti.rs + sch * 8); vs[i] = *(const bf16x8*)(ti.v + (long)(srow + 4 * i) * ti.rs + sch * 8); }
#pragma unroll 1
    for (int j = 0; j < nt; ++j) {
#pragma unroll
        for (int i = 0; i < 8; ++i) { *(bf16x8*)(Kl + KSWZ(srow + 4 * i, sch * 16)) = ks[i]; *(bf16x8*)(Vl + v_st(srow + 4 * i, sch * 8)) = vs[i]; }
        if (j + 1 < nt) { pol.tile(j + 1, tn);
#pragma unroll
            for (int i = 0; i < 8; ++i) { ks[i] = *(const bf16x8*)(tn.k + (long)(srow + 4 * i) * tn.rs + sch * 8); vs[i] = *(const bf16x8*)(tn.v + (long)(srow + 4 * i) * tn.rs + sch * 8); } }
        asm volatile("s_waitcnt lgkmcnt(0)" ::: "memory");
        f32x16 p = f32x16{};
#pragma unroll
        for (int d0 = 0; d0 < 8; ++d0) { const int cb = (d0 * 16 + hi * 8) * 2;
            bf16x8 b0 = *reinterpret_cast<const bf16x8*>(Kl + KSWZ(r32, cb));
            p = __builtin_amdgcn_mfma_f32_32x32x16_bf16(b0, qr[d0], p, 0, 0, 0); }
        float pmax = -INFINITY;
#pragma unroll
        for (int r = 0; r < 16; ++r) { p[r] = pol.adj(ti, crow(r, hi), p[r]); pmax = fmaxf(pmax, p[r]); }
        { auto rr = __builtin_amdgcn_permlane32_swap(__float_as_uint(pmax), __float_as_uint(pmax), false, false);
          pmax = fmaxf(__uint_as_float(rr[0]), __uint_as_float(rr[1])); }
        const float mn = fmaxf(m_reg, pmax); const float alpha = __builtin_amdgcn_exp2f(m_reg - mn); m_reg = mn;
        float ps = 0.f;
#pragma unroll
        for (int r = 0; r < 16; ++r) { p[r] = __builtin_amdgcn_exp2f(p[r] - mn); ps += p[r]; }
        { auto rr = __builtin_amdgcn_permlane32_swap(__float_as_uint(ps), __float_as_uint(ps), false, false);
          ps = __uint_as_float(rr[0]) + __uint_as_float(rr[1]); }
        l_reg = l_reg * alpha + ps;
        if (__any(alpha < 1.f)) { if (hi == 0) al_l[r32] = alpha; asm volatile("s_waitcnt lgkmcnt(0)" ::: "memory");
#pragma unroll
            for (int d = 0; d < 4; ++d)
#pragma unroll
                for (int r = 0; r < 16; ++r) o[d][r] *= al_l[crow(r, hi)]; }
        bf16x8 pa0, pa1; PK4(p, 0, pa0); PK4(p, 8, pa1);
        pv_one32<0>(o[0], vb, pa0, pa1); pv_one32<1>(o[1], vb, pa0, pa1); pv_one32<2>(o[2], vb, pa0, pa1); pv_one32<3>(o[3], vb, pa0, pa1);
        ti = tn;
    }
    if (hi == 0) li_l[r32] = l_reg; asm volatile("s_waitcnt lgkmcnt(0)" ::: "memory");
#pragma unroll
    for (int r = 0; r < 16; ++r) { const int qn = crow(r, hi); const float rl = __builtin_amdgcn_rcpf(li_l[qn]); bf16_t* op = pol.optr(qn);
#pragma unroll
        for (int d0 = 0; d0 < 4; ++d0) op[d0 * 32 + r32] = f2bf(o[d0][r] * rl); }
}
#undef PK4
}

struct PolB {
    struct TI { const bf16_t* k; const bf16_t* v; long rs; int kpos0; int iq; float cd; };
    const bf16_t* H0; bf16_t* O; int b, h, a, r16, myn; int lo3, n3, lo2, n2, lo1, n1; float slope2;
    __device__ __forceinline__ void init(const bf16_t* H0_, bf16_t* O_, int w, int lane) {
        H0 = H0_; O = O_; b = w >> 10; h = (w >> 7) & 7; const int wu = w & 127; a = wu >> 4; r16 = wu & 15; myn = lane & 31;
        lo3 = max(a - 2, 0); n3 = min(a + 2, 7) - lo3 + 1;
        lo2 = max(4 * a - 2, 0); n2 = min(4 * a + 5, 31) - lo2 + 1;
        lo1 = max(16 * a - 2, 0); n1 = min(16 * a + 17, 127) - lo1 + 1;
        slope2 = __builtin_amdgcn_exp2f(-(float)(h + 1)) * LOG2E;
    }
    __device__ __forceinline__ const bf16_t* qptr(int n) const { return H0 + (long)(b * SEQ + 512 * a + r16 + 16 * n) * IN0 + 1536 + h * 128; }
    __device__ __forceinline__ bf16_t* optr(int qn) const { return O + (long)(b * SEQ + 512 * a + r16 + 16 * qn) * DM + 1024 + h * 128; }
    __device__ __forceinline__ int ntiles() const { return n3 + n2 + n1; }
    __device__ __forceinline__ void tile(int j, TI& ti) const {
        int dil, kt, rd;
        if (j < n3) { dil = 16; kt = lo3 + j; rd = r16; }
        else if (j < n3 + n2) { dil = 4; kt = lo2 + (j - n3); rd = r16 & 3; }
        else { dil = 1; kt = lo1 + (j - n3 - n2); rd = 0; }
        const long tok = (long)b * SEQ + dil * 32 * kt + rd;
        ti.k = H0 + tok * IN0 + 2560 + h * 128; ti.v = H0 + tok * IN0 + 3584 + h * 128; ti.rs = (long)dil * IN0;
        ti.kpos0 = 32 * kt; ti.iq = (512 * a + r16 + 16 * myn - rd) / dil; ti.cd = slope2 * (float)dil;
    }
    __device__ __forceinline__ float adj(const TI& ti, int kloc, float s) const {
        const int d = ti.kpos0 + kloc - ti.iq; const int ad = d < 0 ? -d : d;
        return ad <= 64 ? fmaf(s, 0.088388347648318440f * LOG2E, -ti.cd * (float)ad) : -INFINITY;
    }
};
struct PolC {
    struct TI { const bf16_t* k; const bf16_t* v; long rs; int kc0; int drow; };
    const bf16_t* H1; bf16_t* O; const float* tab; int b, h, r, a, r0, qc, c0;
    __device__ __forceinline__ void init(const bf16_t* H1_, bf16_t* O_, const float* rpb, float* tab_, int w, int lane) {
        H1 = H1_; O = O_; tab = tab_; b = w >> 10; h = (w >> 7) & 7; const int wu = w & 127; r = wu >> 1; a = wu & 1;
        r0 = min(max(r - 4, 0), 56); qc = 32 * a + (lane & 31); c0 = min(max(qc - 8, 0), 48);
        for (int idx = lane; idx < 480; idx += 64) { const int dr = idx >> 5, dc = idx & 31; tab_[idx] = dc < 31 ? rpb[h * 465 + dr * 31 + dc] * LOG2E : 0.f; }
        asm volatile("s_waitcnt vmcnt(0) lgkmcnt(0)" ::: "memory");
    }
    __device__ __forceinline__ const bf16_t* qptr(int n) const { return H1 + (long)(b * SEQ + 64 * r + 32 * a + n) * IN1P + h * 128; }
    __device__ __forceinline__ bf16_t* optr(int qn) const { return O + (long)(b * SEQ + 64 * r + 32 * a + qn) * DM + h * 128; }
    __device__ __forceinline__ int ntiles() const { return 16; }
    __device__ __forceinline__ void tile(int j, TI& ti) const {
        const int kr = r0 + (j >> 1), ch = j & 1; const long tok = (long)b * SEQ + 64 * kr + 32 * ch;
        ti.k = H1 + tok * IN1P + 1024 + h * 128; ti.v = H1 + tok * IN1P + 2048 + h * 128; ti.rs = IN1P; ti.kc0 = 32 * ch; ti.drow = kr - r + 7;
    }
    __device__ __forceinline__ float adj(const TI& ti, int kloc, float s) const {
        const int kc = ti.kc0 + kloc; const int dc = min(max(kc - qc + 15, 0), 30);
        const float bias = tab[ti.drow * 32 + dc];
        return (kc >= c0 && kc < c0 + 16) ? fmaf(s, 0.088388347648318440f * LOG2E, bias) : -INFINITY;
    }
};

struct Params { const float* in[28]; float* out; unsigned char* ws; int ph_lo, ph_hi; };
enum { I_X = 0, I_RW = 1, I_RB = 2, I_WIN0 = 3, I_AQN = 4, I_AKN = 5, I_WOUT0 = 6, I_LN1G0 = 7, I_LN1B0 = 8, I_WG0 = 9, I_WU0 = 10, I_WD0 = 11, I_LN2G0 = 12, I_LN2B0 = 13,
       I_WIN1 = 14, I_RPB = 15, I_DQN = 16, I_WQUP = 17, I_DKVN = 18, I_WKVUP = 19, I_WOUT1 = 20, I_LN1G1 = 21, I_LN1B1 = 22, I_WG1 = 23, I_WU1 = 24, I_WD1 = 25, I_LN2G1 = 26, I_LN2B1 = 27 };

__device__ __forceinline__ void tr_tile(const float* __restrict__ src, int N, const float* __restrict__ ksc, bf16_t* __restrict__ dst, int ldd, int k0, int n0, int drow0, LAS unsigned* tl, int tid) {
    const int c4 = (tid & 15) * 4;
#pragma unroll
    for (int i = 0; i < 2; ++i) {
        const int kp = (tid >> 4) + 32 * i;
        const float* s0 = src + (size_t)(k0 + 2 * kp) * N + n0 + c4;
        f32x4 a = *(const f32x4*)s0, b = *(const f32x4*)(s0 + N);
        if (ksc) { const float sa = ksc[k0 + 2 * kp], sb = ksc[k0 + 2 * kp + 1]; a *= sa; b *= sb; }
#pragma unroll
        for (int j = 0; j < 4; ++j) tl[(c4 + j) * 65 + kp] = cvtpk(a[j], b[j]);
    }
    __syncthreads();
    const int n = tid >> 3, seg = tid & 7;
    unsigned w[8];
#pragma unroll
    for (int q = 0; q < 8; ++q) w[q] = tl[n * 65 + seg * 8 + q];
    u32x4* d = (u32x4*)(dst + (size_t)(drow0 + n) * ldd + k0 + seg * 16);
    d[0] = (u32x4){w[0], w[1], w[2], w[3]}; d[1] = (u32x4){w[4], w[5], w[6], w[7]};
    __syncthreads();
}
struct TJob { const float* src; bf16_t* dst; const float* ksc; int K, N, ldd, gu; size_t sbs, dbs; };
__device__ __forceinline__ void run_tjob(const TJob& jb, int t, LAS unsigned* tl, int tid) {
    const int ntn = jb.N / 64, ntk = jb.K / 128, per = ntn * ntk;
    const int bi = t / per, r = t % per, tk = r / ntn, tn = r % ntn;
    const int n0 = tn * 64;
    const int drow0 = jb.gu ? (256 * (n0 >> 7) + (jb.gu == 2 ? 128 : 0) + (n0 & 127)) : n0;
    tr_tile(jb.src + (size_t)bi * jb.sbs, jb.N, jb.ksc, jb.dst + (size_t)bi * jb.dbs, jb.ldd, tk * 128, n0, drow0, tl, tid);
}
__device__ __forceinline__ void phase_prologue(const Params& p, LAS unsigned char* lds, int G, int bid, int tid) {
    unsigned char* ws = p.ws;
    LAS unsigned* tl = (LAS unsigned*)lds;
    constexpr int NJ = 12;
    const int cnts[NJ] = {16 * 72, 16 * 32, 4096, 4096, 4096, 16 * 61, 16 * 32, 4096, 4096, 4096, 4 * 24, 2 * 32};
    int total = 0;
#pragma unroll
    for (int j = 0; j < NJ; ++j) total += cnts[j];
    for (int t = bid; t < total; t += G) {
        int j = 0, base = 0;
#pragma unroll
        for (int q = 0; q < NJ - 1; ++q) if (t >= base + cnts[q] && j == q) { base += cnts[q]; j = q + 1; }
        const int tt = t - base;
        TJob jb;
        switch (j) {
            case 0: jb = TJob{p.in[I_WIN0], (bf16_t*)(ws + WS_WIN0), nullptr, 2048, IN0, 2048, 0, 0, 0}; break;
            case 1: jb = TJob{p.in[I_WOUT0], (bf16_t*)(ws + WS_WOUT0), nullptr, 2048, 2048, 2048, 0, 0, 0}; break;
            case 2: jb = TJob{p.in[I_WG0], (bf16_t*)(ws + WS_WGU0), nullptr, 2048, 512, 2048, 1, (size_t)2048 * 512, (size_t)1024 * 2048}; break;
            case 3: jb = TJob{p.in[I_WU0], (bf16_t*)(ws + WS_WGU0), nullptr, 2048, 512, 2048, 2, (size_t)2048 * 512, (size_t)1024 * 2048}; break;
            case 4: jb = TJob{p.in[I_WD0], (bf16_t*)(ws + WS_WD0), nullptr, 512, 2048, 512, 0, (size_t)512 * 2048, (size_t)2048 * 512}; break;
            case 5: jb = TJob{p.in[I_WIN1], (bf16_t*)(ws + WS_WIN1), nullptr, 2048, IN1, 2048, 0, 0, 0}; break;
            case 6: jb = TJob{p.in[I_WOUT1], (bf16_t*)(ws + WS_WOUT1), nullptr, 2048, 2048, 2048, 0, 0, 0}; break;
            case 7: jb = TJob{p.in[I_WG1], (bf16_t*)(ws + WS_WGU1), nullptr, 2048, 512, 2048, 1, (size_t)2048 * 512, (size_t)1024 * 2048}; break;
            case 8: jb = TJob{p.in[I_WU1], (bf16_t*)(ws + WS_WGU1), nullptr, 2048, 512, 2048, 2, (size_t)2048 * 512, (size_t)1024 * 2048}; break;
            case 9: jb = TJob{p.in[I_WD1], (bf16_t*)(ws + WS_WD1), nullptr, 512, 2048, 512, 0, (size_t)512 * 2048, (size_t)2048 * 512}; break;
            case 10: jb = TJob{p.in[I_WQUP], (bf16_t*)(ws + WS_WQUP), p.in[I_DQN], 512, 1536, 512, 0, 0, 0}; break;
            default: jb = TJob{p.in[I_WKVUP], (bf16_t*)(ws + WS_WKVUP), p.in[I_DKVN], 256, 2048, 256, 0, 0, 0}; break;
        }
        run_tjob(jb, tt, tl, tid);
    }
    { u32x4* z = (u32x4*)((bf16_t*)(ws + WS_WIN1) + (size_t)IN1 * 2048); const size_t n16 = (size_t)(IN1P - IN1) * 2048 * 2 / 16;
      const unsigned zu = __float_as_uint(fresh_zero());
      for (size_t i = (size_t)bid * NTHR + tid; i < n16; i += (size_t)G * NTHR) z[i] = (u32x4){zu, zu, zu, zu}; }
    { const f32x8* xs = (const f32x8*)p.in[I_X]; u32x4* xd = (u32x4*)(ws + WS_RA); const size_t n8 = (size_t)T_ * DM / 8;
      for (size_t i = (size_t)bid * NTHR + tid; i < n8; i += (size_t)G * NTHR) { const f32x8 v = xs[i];
          xd[i] = (u32x4){cvtpk(v[0], v[1]), cvtpk(v[2], v[3]), cvtpk(v[4], v[5]), cvtpk(v[6], v[7])}; } }
}

__device__ __forceinline__ void phase_prep_qk(bf16_t* H0, const float* qn, const float* kn, int G, int bid, int tid) {
    const int wid = tid >> 6, lane = tid & 63, i = lane & 31, half = lane >> 5;
    const float invf = inv_freq32(i);
    const int e0 = 64 * half + i, e1 = e0 + 32;
    const float gq0 = qn[e0], gq1 = qn[e1], gk0 = kn[e0], gk1 = kn[e1];
    for (int m = bid * 8 + wid; m < T_; m += G * 8) {
        const int s = m & (SEQ - 1); const int pos = half ? (s & 63) : (s >> 6);
        float sn, cs; sincos_rev((float)pos * invf, sn, cs);
        bf16_t* rowp = H0 + (size_t)m * IN0;
#pragma unroll
        for (int hh = 0; hh < 10; ++hh) {
            bf16_t* base = rowp + (hh < 8 ? hh * 128 : 1024 + (hh - 8) * 128);
            const float x0 = bf2f(base[e0]), x1 = bf2f(base[e1]);
            const float ss = wave_sum(x0 * x0 + x1 * x1);
            const float r = rsqrtf(ss * (1.0f / 128.0f) + 1e-6f);
            const float y0 = x0 * r * (hh < 8 ? gq0 : gk0), y1 = x1 * r * (hh < 8 ? gq1 : gk1);
            base[e0] = f2bf(y0 * cs - y1 * sn); base[e1] = f2bf(y1 * cs + y0 * sn);
        }
    }
}
__device__ __forceinline__ void phase_prep_mla(bf16_t* H1, bf16_t* krope, int G, int bid, int tid) {
    const int wid = tid >> 6, lane = tid & 63;
    const float invf = inv_freq32(lane & 31);
    for (int m = bid * 8 + wid; m < T_; m += G * 8) {
        bf16_t* rowp = H1 + (size_t)m * IN1P;
        const u32x4 a = *(const u32x4*)(rowp + 3072 + lane * 8);
        float ss = bflo(a.x) * bflo(a.x) + bfhi(a.x) * bfhi(a.x) + bflo(a.y) * bflo(a.y) + bfhi(a.y) * bfhi(a.y) + bflo(a.z) * bflo(a.z) + bfhi(a.z) * bfhi(a.z) + bflo(a.w) * bflo(a.w) + bfhi(a.w) * bfhi(a.w);
        ss = wave_sum(ss);
        const u32x2 c = *(const u32x2*)(rowp + 3584 + lane * 4);
        float s2 = bflo(c.x) * bflo(c.x) + bfhi(c.x) * bfhi(c.x) + bflo(c.y) * bflo(c.y) + bfhi(c.y) * bfhi(c.y);
        s2 = wave_sum(s2);
        const float rq = rsqrtf(ss * (1.0f / 512.0f) + 1e-6f), rkv = rsqrtf(s2 * (1.0f / 256.0f) + 1e-6f);
        *(u32x4*)(rowp + 3072 + lane * 8) = (u32x4){cvtpk(bflo(a.x) * rq, bfhi(a.x) * rq), cvtpk(bflo(a.y) * rq, bfhi(a.y) * rq), cvtpk(bflo(a.z) * rq, bfhi(a.z) * rq), cvtpk(bflo(a.w) * rq, bfhi(a.w) * rq)};
        *(u32x2*)(rowp + 3584 + lane * 4) = (u32x2){cvtpk(bflo(c.x) * rkv, bfhi(c.x) * rkv), cvtpk(bflo(c.y) * rkv, bfhi(c.y) * rkv)};
        if (lane < 32) { const float x1 = bf2f(rowp[3840 + lane]), x2 = bf2f(rowp[3840 + 32 + lane]);
            float sn, cs; sincos_rev((float)(m & (SEQ - 1)) * invf, sn, cs);
            krope[(size_t)m * 64 + lane] = f2bf(x1 * cs - x2 * sn); krope[(size_t)m * 64 + 32 + lane] = f2bf(x2 * cs + x1 * sn); }
    }
}

constexpr int LNR_PITCH = 2050;
constexpr int LNR_PART = 131328, LNR_SC = 147712, LNR_SEL = 149760, LNR_BLE = 151808, LNR_HIST = 152832;
__device__ __forceinline__ void phase_ln_router(const float* z, const float* g, const float* bb, const float* rw, const float* rb, bf16_t* x1b,
                                                int* tok_e, int* tok_p, float* tok_g, int* list, unsigned* cnt, LAS unsigned char* lds, int G, int bid, int tid) {
    const int wid = tid >> 6, lane = tid & 63;
    LAS float* xs = (LAS float*)lds; LAS float* part = (LAS float*)(lds + LNR_PART); LAS float* scs = (LAS float*)(lds + LNR_SC); LAS float* sels = (LAS float*)(lds + LNR_SEL);
    LAS int* ble = (LAS int*)(lds + LNR_BLE); LAS int* hist = (LAS int*)(lds + LNR_HIST);
    int ntl = 0;
    for (int it = 0; bid + G * it < T_ / 16; ++it) {
        const int tix = bid + G * it;
#pragma unroll 1
        for (int rr = 0; rr < 2; ++rr) {
            const int row = 2 * wid + rr; const size_t m = (size_t)tix * 16 + row;
            f32x4 v[8]; float s = 0.f;
#pragma unroll
            for (int i = 0; i < 8; ++i) { v[i] = *(const f32x4*)(z + m * DM + 4 * lane + 256 * i); s += (v[i][0] + v[i][1]) + (v[i][2] + v[i][3]); }
            const float mean = wave_sum(s) * (1.0f / DM); float q = 0.f;
#pragma unroll
            for (int i = 0; i < 8; ++i) { const f32x4 d = v[i] - mean; q += (d[0] * d[0] + d[1] * d[1]) + (d[2] * d[2] + d[3] * d[3]); }
            const float rstd = rsqrtf(wave_sum(q) * (1.0f / DM) + 1e-5f);
#pragma unroll
            for (int i = 0; i < 8; ++i) { const int col = 4 * lane + 256 * i; const f32x4 gv = *(const f32x4*)(g + col), bv = *(const f32x4*)(bb + col);
                const f32x4 y = (v[i] - mean) * rstd * gv + bv;
                LAS f32x2* xp = (LAS f32x2*)(xs + row * LNR_PITCH + col); xp[0] = (f32x2){y[0], y[1]}; xp[1] = (f32x2){y[2], y[3]};
                *(u32x2*)(x1b + m * DM + col) = (u32x2){cvtpk(y[0], y[1]), cvtpk(y[2], y[3])}; }
        }
        __syncthreads();
        { f32x4 acc0 = {0.f, 0.f, 0.f, 0.f}, acc1 = {0.f, 0.f, 0.f, 0.f}; const int k0 = 256 * wid + (lane >> 4); const int e = lane & 15;
#pragma unroll 4
          for (int kk = 0; kk < 64; ++kk) { const int k = k0 + 4 * kk; const float a = xs[(lane & 15) * LNR_PITCH + k]; const float b0 = rw[k * 32 + e], b1 = rw[k * 32 + 16 + e];
              acc0 = __builtin_amdgcn_mfma_f32_16x16x4f32(a, b0, acc0, 0, 0, 0); acc1 = __builtin_amdgcn_mfma_f32_16x16x4f32(a, b1, acc1, 0, 0, 0); }
#pragma unroll
          for (int r = 0; r < 4; ++r) { const int row = (lane >> 4) * 4 + r; part[(wid * 16 + row) * 32 + e] = acc0[r]; part[(wid * 16 + row) * 32 + 16 + e] = acc1[r]; } }
        __syncthreads();
        { const int row = tid >> 5, e = tid & 31; float lg = 0.f;
#pragma unroll
          for (int w = 0; w < 8; ++w) lg += part[(w * 16 + row) * 32 + e];
          const float sc = 1.0f / (1.0f + __expf(-lg)); scs[row * 32 + e] = sc; sels[row * 32 + e] = sc + rb[e]; }
        __syncthreads();
        if (tid < 16) { const int row = tid; float best = -INFINITY; int bg = 0;
            for (int gI = 0; gI < 8; ++gI) { const float a = sels[row * 32 + 4 * gI], b = sels[row * 32 + 4 * gI + 1], c = sels[row * 32 + 4 * gI + 2], d = sels[row * 32 + 4 * gI + 3];
                const float h1 = fmaxf(a, b), l1 = fminf(a, b), h2 = fmaxf(c, d), l2 = fminf(c, d); const float gs = fmaxf(h1, h2) + fmaxf(fminf(h1, h2), fmaxf(l1, l2));
                if (gs > best) { best = gs; bg = gI; } }
            const float v0 = sels[row * 32 + 4 * bg], v1 = sels[row * 32 + 4 * bg + 1], v2 = sels[row * 32 + 4 * bg + 2], v3 = sels[row * 32 + 4 * bg + 3];
            int i1 = 0; float b1 = v0; if (v1 > b1) { b1 = v1; i1 = 1; } if (v2 > b1) { b1 = v2; i1 = 2; } if (v3 > b1) { b1 = v3; i1 = 3; }
            int i2 = -1; float b2 = -INFINITY;
            if (i1 != 0 && v0 > b2) { b2 = v0; i2 = 0; } if (i1 != 1 && v1 > b2) { b2 = v1; i2 = 1; } if (i1 != 2 && v2 > b2) { b2 = v2; i2 = 2; } if (i1 != 3 && v3 > b2) { b2 = v3; i2 = 3; }
            const int e1 = 4 * bg + i1, e2 = 4 * bg + i2; const float s1 = scs[row * 32 + e1], s2 = scs[row * 32 + e2]; const float inv = 1.0f / (s1 + s2);
            const size_t m = (size_t)tix * 16 + row;
            tok_e[2 * m] = e1; tok_e[2 * m + 1] = e2; tok_g[2 * m] = s1 * inv; tok_g[2 * m + 1] = s2 * inv;
            ble[(it * 16 + row) * 2] = e1; ble[(it * 16 + row) * 2 + 1] = e2; }
        __syncthreads();
        ntl = it + 1;
    }
    const int nasg = ntl * 32;
    if (tid < 32) { int c = 0; for (int i = 0; i < nasg; ++i) c += (ble[i] == tid) ? 1 : 0;
        unsigned base = 0; if (c) base = __hip_atomic_fetch_add(cnt + tid, (unsigned)c, __ATOMIC_RELAXED, __HIP_MEMORY_SCOPE_AGENT);
        hist[tid] = (int)base; }
    __syncthreads();
    if (tid < 32) { int run = hist[tid];
        for (int i = 0; i < nasg; ++i) if (ble[i] == tid) { const int tr = i >> 1; const size_t m = (size_t)(bid + G * (tr >> 4)) * 16 + (tr & 15);
            list[(size_t)tid * 65536 + run] = (int)m; tok_p[2 * m + (i & 1)] = run; ++run; } }
    __syncthreads();
}

constexpr int MOE_LDS = 131072;
__device__ __forceinline__ int moe_prefix(const unsigned* cnt, LAS int* pblk, int tid) {
    if (tid == 0) { int acc = 0; for (int e = 0; e < NE; ++e) { pblk[e] = acc; acc += ((int)cnt[e] + 255) >> 8; } pblk[NE] = acc; }
    __syncthreads();
    return pblk[NE];
}
template <int NJ> __device__ __forceinline__ int moe_table(const unsigned* cnt, LAS int* pblk, LAS int* tab, LAS int* aux, int NB, int G, int bid, int tid) {
    const int NU = NB * NJ;
    if (tid < 16) { const int L = bid + G * tid;
        if (L < NU) { const int rb = L / NJ, j = L % NJ; int e = 0; for (int q = 1; q < NE; ++q) if (pblk[q] <= rb) e = q;
            tab[tid] = rb; tab[16 + tid] = NJ * e + j; aux[tid * 3] = e; aux[tid * 3 + 1] = (rb - pblk[e]) * 256; aux[tid * 3 + 2] = (int)cnt[e]; } }
    __syncthreads();
    int n = 0; for (int i = 0; i < 16; ++i) if (bid + G * i < NU) n = i + 1;
    return n;
}

template <bool FINAL>
__device__ __forceinline__ void phase_combine_ln(const bf16_t* x1b, const bf16_t* Yr, const int* tok_e, const int* tok_p, const float* tok_g, const unsigned* cnt,
                                                 const float* g, const float* bb, bf16_t* xo, float* fo, LAS unsigned char* lds, int G, int bid, int tid) {
    LAS int* pblk = (LAS int*)lds;
    moe_prefix(cnt, pblk, tid);
    const int wid = tid >> 6, lane = tid & 63;
    for (int m = bid * 8 + wid; m < T_; m += G * 8) {
        const int e0 = tok_e[2 * m], e1 = tok_e[2 * m + 1];
        const size_t p0 = (size_t)pblk[e0] * 256 + tok_p[2 * m], p1 = (size_t)pblk[e1] * 256 + tok_p[2 * m + 1];
        const float g0 = tok_g[2 * m], g1 = tok_g[2 * m + 1];
        float v[32]; float s = 0.f;
#pragma unroll
        for (int i = 0; i < 4; ++i) { const int col = 8 * lane + 512 * i;
            const u32x4 xa = *(const u32x4*)(x1b + (size_t)m * DM + col), ya = *(const u32x4*)(Yr + p0 * DM + col), yb = *(const u32x4*)(Yr + p1 * DM + col);
            const unsigned xw[4] = {xa.x, xa.y, xa.z, xa.w}, aw[4] = {ya.x, ya.y, ya.z, ya.w}, bw[4] = {yb.x, yb.y, yb.z, yb.w};
#pragma unroll
            for (int j = 0; j < 4; ++j) { v[i * 8 + 2 * j] = ALPHA * bflo(xw[j]) + g0 * bflo(aw[j]) + g1 * bflo(bw[j]); v[i * 8 + 2 * j + 1] = ALPHA * bfhi(xw[j]) + g0 * bfhi(aw[j]) + g1 * bfhi(bw[j]);
                s += v[i * 8 + 2 * j] + v[i * 8 + 2 * j + 1]; } }
        const float mean = wave_sum(s) * (1.0f / DM); float q = 0.f;
#pragma unroll
        for (int i = 0; i < 32; ++i) { const float d = v[i] - mean; q += d * d; }
        const float rstd = rsqrtf(wave_sum(q) * (1.0f / DM) + 1e-5f);
#pragma unroll
        for (int i = 0; i < 4; ++i) { const int col = 8 * lane + 512 * i;
            const f32x4 ga = *(const f32x4*)(g + col), gb = *(const f32x4*)(g + col + 4), ba = *(const f32x4*)(bb + col), bbv = *(const f32x4*)(bb + col + 4);
            float y[8];
#pragma unroll
            for (int j = 0; j < 4; ++j) { y[j] = (v[i * 8 + j] - mean) * rstd * ga[j] + ba[j]; y[4 + j] = (v[i * 8 + 4 + j] - mean) * rstd * gb[j] + bbv[j]; }
            if constexpr (FINAL) { *(f32x4*)(fo + (size_t)m * DM + col) = (f32x4){y[0], y[1], y[2], y[3]}; *(f32x4*)(fo + (size_t)m * DM + col + 4) = (f32x4){y[4], y[5], y[6], y[7]}; }
            else *(u32x4*)(xo + (size_t)m * DM + col) = (u32x4){cvtpk(y[0], y[1]), cvtpk(y[2], y[3]), cvtpk(y[4], y[5]), cvtpk(y[6], y[7])}; }
    }
}

#ifndef ATT_ONLY
#define ATT_ONLY -1
#endif
constexpr int N_PHASES = 20;
__global__ void __launch_bounds__(NTHR, 2) fwd(Params p) {
    extern __shared__ __attribute__((aligned(16))) unsigned char lds_raw[];
    LAS unsigned char* lds = (LAS unsigned char*)lds_raw;
    const int tid0 = threadIdx.x, bid = blockIdx.x, G = gridDim.x;
    const int vcu = (G % 8 == 0) ? (bid % 8) * (G / 8) + bid / 8 : bid;
    unsigned* ctl = (unsigned*)(p.ws + WS_CTL);
    if (tid0 < 4) ((LAS unsigned*)(lds + MISC_OFF))[tid0] = 0u;
    __syncthreads();
    XcdBarrier bar; bar.bar = ctl + CW_BAR; bar.x = 0; bar.st = (volatile LAS unsigned*)(lds + MISC_OFF);
    if (N_LAUNCH_MODE == 1) bar = xcd_barrier_post(ctl + CW_BAR, (volatile LAS unsigned*)(lds + MISC_OFF));
    const int lo = p.ph_lo, hi = p.ph_hi;
#ifndef PH_ONLY
#define PH_ONLY -1
#endif
#define IN(k) ((PH_ONLY < 0 || (PH_ONLY % 10) == ((k) % 10)) && lo <= (k) && (k) < hi)
#define SEAM(k) do { if ((k) + 1 < hi) xcd_barrier(bar); } while (0)

    for (int L = 0; L < 2; ++L) {
        const int pb = L * 10;
        typedef __attribute__((address_space(1))) unsigned char gu8;
        gu8* wsg = (gu8*)p.ws; gu8* outg = (gu8*)p.out;
        asm volatile("" : "+s"(wsg), "+s"(outg));
        unsigned char* ws = (unsigned char*)wsg; unsigned char* outb = (unsigned char*)outg;
        bf16_t* RA = (bf16_t*)(ws + WS_RA); bf16_t* RB = (bf16_t*)(ws + WS_RB); bf16_t* RC = (bf16_t*)(ws + WS_RC);
        int* list = (int*)(ws + WS_LIST); int* tok_e = (int*)(ws + WS_TOKE); int* tok_p = (int*)(ws + WS_TOKP); float* tok_g = (float*)(ws + WS_TOKG);
        bf16_t* krope = (bf16_t*)(ws + WS_KROPE);
        bf16_t* Qd = (bf16_t*)(outb + OUT_QD); bf16_t* O1 = (bf16_t*)(outb + OUT_O1);
        const bf16_t* Win = (const bf16_t*)(ws + (L ? WS_WIN1 : WS_WIN0)); const bf16_t* Wout = (const bf16_t*)(ws + (L ? WS_WOUT1 : WS_WOUT0));
        const bf16_t* Wgu = (const bf16_t*)(ws + (L ? WS_WGU1 : WS_WGU0)); const bf16_t* Wd = (const bf16_t*)(ws + (L ? WS_WD1 : WS_WD0));
        const int NIN = L ? IN1P : IN0;
        const bf16_t* xin = L ? RC : RA;
        bf16_t* Hx = RB;
        bf16_t* Oat = L ? O1 : RC;
        float* Z = (float*)RB;
        bf16_t* x1b = RA; bf16_t* Hm = RC; bf16_t* Yr = RB;
        unsigned* cnt = ctl + CW_CNT + L * 64;

        if (L == 0 && IN(0)) { phase_prologue(p, lds, G, bid, fresh_tid()); SEAM(0); }

        if (IN(pb + 1)) {
            pg8::Gemm g{xin, Win, 2048, 2048, 2048}; pg8::StaticOrder S; S.init(T_, NIN, G, bid, 2048);
            pg8::EpiBf16 E{Hx, NIN, 0xffff};
            pg8::gemm_phase(lds, g, S, E);
            SEAM(pb + 1);
        }
        if (IN(pb + 2)) {
            if (L == 0) phase_prep_qk(Hx, p.in[I_AQN], p.in[I_AKN], G, bid, fresh_tid());
            else phase_prep_mla(Hx, krope, G, bid, fresh_tid());
            SEAM(pb + 2);
        }
        if (L == 1 && IN(pb + 3)) {
#ifndef P3_ONLY
#define P3_ONLY -1
#endif
            if (P3_ONLY < 0 || P3_ONLY == 0) { pg8::Gemm g{Hx + 3072, (const bf16_t*)(ws + WS_WQUP), 512, IN1P, 512}; pg8::StaticOrder S; S.init(T_, 1536, G, bid, IN1P);
              pg8::EpiBf16 E{Qd, 1536, 0xffff}; pg8::gemm_phase(lds, g, S, E); }
            if (P3_ONLY < 0 || P3_ONLY == 1) { pg8::Gemm g{Hx + 3584, (const bf16_t*)(ws + WS_WKVUP), 256, IN1P, 256}; pg8::StaticOrder S; S.init(T_, 2048, G, bid, IN1P);
              pg8::EpiBf16 E{RA, 2048, 0xffff}; pg8::gemm_phase(lds, g, S, E); }
            SEAM(pb + 3);
        }
        if (IN(pb + 4)) {
            if (L == 0) {
                if (ATT_ONLY < 0 || ATT_ONLY == 0)
                for (int u = vcu; u < 1024; u += G) {
                    __syncthreads();
                    const int b = u >> 7, qb = u & 15, kvh = (u >> 6) & 1, gq = (u >> 4) & 3, h = kvh * 4 + gq;
                    da::DArgs a; a.Q = Hx + (size_t)(b * SEQ + 256 * qb) * IN0 + h * 128; a.ldq = IN0;
                    a.K = Hx + (size_t)b * SEQ * IN0 + 1024 + kvh * 128; a.ldk = IN0; a.V = Hx + (size_t)b * SEQ * IN0 + 1280 + kvh * 128; a.ldv = IN0; a.Kr = nullptr;
                    a.O = Oat + (size_t)(b * SEQ + 256 * qb) * DM + h * 128; a.ldo = DM; a.seq = SEQ; a.pos0 = 0;
                    da::attn_dense_body<8, 1>(a, (char*)lds_raw);
                }
                __syncthreads();
                if (ATT_ONLY < 0 || ATT_ONLY == 2)
                for (int it = vcu; it < 1024; it += G) {
                    const int tid2 = fresh_tid(), wid = __builtin_amdgcn_readfirstlane(tid2 >> 6), lane = tid2 & 63;
                    const int w = it * 8 + wid; char* wl = (char*)lds_raw + wid * da::SP_WAVE_LDS;
                    PolB pol; pol.init(Hx, Oat, w, lane); da::sparse_wave(pol, wl, lane);
                }
            } else {
                if (ATT_ONLY < 0 || ATT_ONLY == 1)
                for (int u = vcu; u < 1024; u += G) {
                    __syncthreads();
                    const int b = u >> 7, qb = u & 15, h = (u >> 4) & 7;
                    da::DArgs a; a.Q = Qd + (size_t)(b * SEQ + 256 * qb) * 1536 + h * 192; a.ldq = 1536;
                    a.K = RA + (size_t)b * SEQ * DM + h * 256; a.ldk = DM; a.V = a.K + 128; a.ldv = DM; a.Kr = krope + (size_t)b * SEQ * 64;
                    a.O = Oat + (size_t)(b * SEQ + 256 * qb) * DM + 1024 + h * 128; a.ldo = DM; a.seq = SEQ; a.pos0 = 256 * qb;
                    da::attn_dense_body<12, 1>(a, (char*)lds_raw);
                }
                __syncthreads();
                if (ATT_ONLY < 0 || ATT_ONLY == 3)
                for (int it = vcu; it < 1024; it += G) {
                    const int tid2 = fresh_tid(), wid = __builtin_amdgcn_readfirstlane(tid2 >> 6), lane = tid2 & 63;
                    const int w = it * 8 + wid; char* wl = (char*)lds_raw + wid * da::SP_WAVE_LDS;
                    PolC pol; pol.init(Hx, Oat, p.in[I_RPB], (float*)(wl + 16640), w, lane); da::sparse_wave(pol, wl, lane);
                }
            }
            SEAM(pb + 4);
        }
        if (IN(pb + 5)) {
            pg8::Gemm g{Oat, Wout, 2048, 2048, 2048}; pg8::StaticOrder S; S.init(T_, DM, G, bid, 2048);
            pg8::EpiResF32 E{Z, xin};
            pg8::gemm_phase(lds, g, S, E);
            SEAM(pb + 5);
        }
        if (IN(pb + 6)) {
            phase_ln_router(Z, p.in[L ? I_LN1G1 : I_LN1G0], p.in[L ? I_LN1B1 : I_LN1B0], p.in[I_RW], p.in[I_RB], x1b, tok_e, tok_p, tok_g, list, cnt, lds, G, bid, fresh_tid());
            SEAM(pb + 6);
        }
        if (IN(pb + 7)) {
            LAS int* pblk = (LAS int*)(lds + MOE_LDS); LAS int* tab = pblk + 64; LAS int* aux = tab + 32; LAS int* idx = aux + 64;
            const int tid = fresh_tid();
            const int NB = moe_prefix(cnt, pblk, tid);
            const int n = moe_table<4>(cnt, pblk, tab, aux, NB, G, bid, tid);
            for (int i = 0; i < n; ++i) if (tid < 256) { const int e = aux[i * 3], rs = aux[i * 3 + 1], ce = aux[i * 3 + 2]; idx[i * 256 + tid] = list[(size_t)e * 65536 + min(rs + tid, ce - 1)]; }
            __syncthreads();
            pg8::Gemm g{x1b, Wgu, 2048, 2048, 2048}; pg8::TableOrder<true> S{tab, idx, n, 2048}; pg8::EpiSiluMul E{Hm};
            pg8::gemm_phase(lds, g, S, E);
            SEAM(pb + 7);
        }
        if (IN(pb + 8)) {
            LAS int* pblk = (LAS int*)(lds + MOE_LDS); LAS int* tab = pblk + 64; LAS int* aux = tab + 32;
            const int tid = fresh_tid();
            const int NB = moe_prefix(cnt, pblk, tid);
            const int n = moe_table<8>(cnt, pblk, tab, aux, NB, G, bid, tid);
            pg8::Gemm g{Hm, Wd, 512, 512, 512}; pg8::TableOrder<false> S{tab, nullptr, n, 512}; pg8::EpiBf16 E{Yr, DM, 7};
            pg8::gemm_phase(lds, g, S, E);
            SEAM(pb + 8);
        }
        if (IN(pb + 9)) {
            if (L == 0) phase_combine_ln<false>(x1b, Yr, tok_e, tok_p, tok_g, cnt, p.in[I_LN2G0], p.in[I_LN2B0], RC, nullptr, lds, G, bid, fresh_tid());
            else phase_combine_ln<true>(x1b, Yr, tok_e, tok_p, tok_g, cnt, p.in[I_LN2G1], p.in[I_LN2B1], nullptr, (float*)outb, lds, G, bid, fresh_tid());
            SEAM(pb + 9);
        }
    }
#undef IN
#undef SEAM
}

extern "C" void kernel_launch(void* const* d_in, const int* in_sizes, int n_in, void* d_out, int out_size, void* d_ws, size_t ws_size, hipStream_t stream) {
    static int grid = 0;
    if (grid == 0) {
        if (n_in != 28 || out_size != T_ * DM || ws_size < WS_END) { fprintf(stderr, "kernel_launch: unexpected shapes: n_in %d out %d ws %zu (need %zu)\n", n_in, out_size, ws_size, (size_t)WS_END); grid = -1; return; }
        int dev = 0, cus = 0, per_cu = 0;
        if (hipGetDevice(&dev) != hipSuccess || hipDeviceGetAttribute(&cus, hipDeviceAttributeMultiprocessorCount, dev) != hipSuccess) { grid = -1; return; }
        if (hipFuncSetAttribute((const void*)fwd, hipFuncAttributeMaxDynamicSharedMemorySize, LDS_BYTES) != hipSuccess) { fprintf(stderr, "kernel_launch: hipFuncSetAttribute failed\n"); grid = -1; return; }
        if (hipOccupancyMaxActiveBlocksPerMultiprocessor(&per_cu, (const void*)fwd, NTHR, LDS_BYTES) != hipSuccess || per_cu < 1)
            fprintf(stderr, "kernel_launch: occupancy query reports %d workgroups per CU\n", per_cu);
        (void)hipGetLastError();
        grid = cus;
    }
    if (grid < 0) return;
    (void)hipMemsetAsync((char*)d_ws + WS_CTL, 0, CTL_ZERO_BYTES, stream);
    Params p{};
    for (int i = 0; i < 28; ++i) p.in[i] = (const float*)d_in[i];
    p.out = (float*)d_out; p.ws = (unsigned char*)d_ws;
#if N_LAUNCH_MODE == 1
    p.ph_lo = 0; p.ph_hi = N_PHASES;
    hipLaunchKernelGGL(fwd, dim3(grid), dim3(NTHR), LDS_BYTES, stream, p);
#else
    for (int k = 0; k < N_PHASES; ++k) { if (k == 3 || k == 10) continue; p.ph_lo = k; p.ph_hi = k + 1;
        hipLaunchKernelGGL(fwd, dim3(grid), dim3(NTHR), LDS_BYTES, stream, p); }
#endif
    const hipError_t le = hipPeekAtLastError();
    if (le != hipSuccess) fprintf(stderr, "kernel_launch: launch failed: %s\n", hipGetErrorName(le));
}
```

```cpp
#include <hip/hip_runtime.h>
#include <cstdio>
#include <cstdint>

#ifndef N_LAUNCH_MODE
#define N_LAUNCH_MODE 1
#endif
#ifndef DBG_CHECK
#define DBG_CHECK 0
#endif
#ifndef F8_DOWN
#define F8_DOWN 1
#endif
#ifndef F8_GU
#define F8_GU 1
#endif
#ifndef F8_IN
#define F8_IN 1
#endif
#ifndef F8_OUT
#define F8_OUT 0
#endif

#define LAS __attribute__((address_space(3)))
typedef unsigned short bf16_t;
typedef short bf16x8 __attribute__((ext_vector_type(8)));
typedef short s16x4 __attribute__((ext_vector_type(4)));
typedef float f32x2 __attribute__((ext_vector_type(2)));
typedef float f32x4 __attribute__((ext_vector_type(4)));
typedef float f32x8 __attribute__((ext_vector_type(8)));
typedef float f32x16 __attribute__((ext_vector_type(16)));
typedef unsigned u32x2 __attribute__((ext_vector_type(2)));
typedef unsigned u32x4 __attribute__((ext_vector_type(4)));
typedef int i32x8 __attribute__((ext_vector_type(8)));
typedef int i32x4 __attribute__((ext_vector_type(4)));

constexpr int T_ = 32768, DM = 2048, SEQ = 4096, NBATCH = 8;
constexpr int IN0 = 4608, IN1 = 3904, IN1P = 4096;
constexpr int NE = 32, DE = 512, MAXBLK = 288;
constexpr float ALPHA = 1.4142135623730951f;
constexpr float LOG2E = 1.4426950408889634f;
constexpr int NTHR = 512;

constexpr size_t MiB = 1u << 20;
constexpr size_t WS_CTL = 0, CTL_ZERO_BYTES = 1 * MiB;
constexpr size_t WS_LIST = 1 * MiB;
constexpr size_t WS_TOKE = 9 * MiB;
constexpr size_t WS_TOKP = WS_TOKE + 256 * 1024;
constexpr size_t WS_TOKG = WS_TOKP + 256 * 1024;
constexpr size_t WS_RSTAT = WS_TOKG + 256 * 1024;
constexpr size_t WS_KROPE = 10 * MiB;
constexpr size_t WS_WIN0 = 16 * MiB, WS_WOUT0 = 34 * MiB, WS_WGU0 = 42 * MiB, WS_WD0 = 170 * MiB;
constexpr size_t WS_WIN1 = 234 * MiB, WS_WOUT1 = 250 * MiB, WS_WGU1 = 258 * MiB, WS_WD1 = 386 * MiB;
constexpr size_t WS_WQUP = 450 * MiB, WS_WKVUP = 452 * MiB;
constexpr size_t WS_RA = 454 * MiB, WS_RB = 582 * MiB, WS_RC = 870 * MiB, WS_END = 998 * MiB;
constexpr size_t OUT_QD = 0, OUT_O1 = 96 * MiB;
constexpr int CW_CNT = 64;
constexpr int CW_DBG = 512;
constexpr int CW_BAR = 4096;

constexpr int LDS_BYTES = 155648;
constexpr int MISC_OFF = LDS_BYTES - 64;

__device__ __forceinline__ unsigned cvtpk(float lo, float hi) { unsigned r; asm volatile("v_cvt_pk_bf16_f32 %0, %1, %2" : "=v"(r) : "v"(lo), "v"(hi)); return r; }
__device__ __forceinline__ float bf2f(unsigned short b) { return __uint_as_float(((unsigned)b) << 16); }
__device__ __forceinline__ float bflo(unsigned w) { return __uint_as_float(w << 16); }
__device__ __forceinline__ float bfhi(unsigned w) { return __uint_as_float(w & 0xffff0000u); }
__device__ __forceinline__ bf16_t f2bf(float f) { return (bf16_t)(cvtpk(f, f) & 0xffffu); }
__device__ __forceinline__ unsigned pk4_fp8(float a, float b, float c, float d) { int w = 0; w = __builtin_amdgcn_cvt_pk_fp8_f32(a, b, w, false); w = __builtin_amdgcn_cvt_pk_fp8_f32(c, d, w, true); return (unsigned)w; }
__device__ __forceinline__ float clamp8(float v) { return fminf(fmaxf(v, -400.f), 400.f); }
__device__ __forceinline__ int fresh_tid(int wv) { int l; asm volatile("v_mbcnt_lo_u32_b32 %0, -1, 0\n\tv_mbcnt_hi_u32_b32 %0, -1, %0" : "=v"(l)); return wv * 64 + l; }
__device__ __forceinline__ float fresh_zero() { float z; asm volatile("v_mov_b32 %0, 0" : "=v"(z)); return z; }
__device__ __forceinline__ float wave_sum(float v) {
    v += __int_as_float(__builtin_amdgcn_ds_swizzle(__float_as_int(v), (1 << 10) | 0x1f));
    v += __int_as_float(__builtin_amdgcn_ds_swizzle(__float_as_int(v), (2 << 10) | 0x1f));
    v += __int_as_float(__builtin_amdgcn_ds_swizzle(__float_as_int(v), (4 << 10) | 0x1f));
    v += __int_as_float(__builtin_amdgcn_ds_swizzle(__float_as_int(v), (8 << 10) | 0x1f));
    v += __int_as_float(__builtin_amdgcn_ds_swizzle(__float_as_int(v), (16 << 10) | 0x1f));
    auto rr = __builtin_amdgcn_permlane32_swap(__float_as_uint(v), __float_as_uint(v), false, false);
    return __uint_as_float(rr[0]) + __uint_as_float(rr[1]);
}
__device__ __forceinline__ float inv_freq32(int i) { return __builtin_amdgcn_exp2f(-(float)i * 0.41524101186092029f); }
__device__ __forceinline__ void sincos_rev(float angle, float& s, float& c) {
    float rev = angle * 0.15915494309189535f; rev = rev - floorf(rev);
    s = __builtin_amdgcn_sinf(rev); c = __builtin_amdgcn_cosf(rev);
}

#define XB_TMO      128
#define XB_XCNT(j)  (256  + 64 * (j))
#define XB_XSUB(j)  (1280 + 64 * (j))
#define XB_XGEN(j)  (2304 + 64 * (j))
#define XB_TOP      3328
#define XB_TOPGEN   3392
#define XCD_BAR_WORDS 3456
#define XB_SPIN_CAP (1u << 20)
__device__ __forceinline__ unsigned xb_ld(unsigned* p)              { return __hip_atomic_load(p, __ATOMIC_RELAXED, __HIP_MEMORY_SCOPE_AGENT); }
__device__ __forceinline__ unsigned xb_add(unsigned* p, unsigned v) { return __hip_atomic_fetch_add(p, v, __ATOMIC_RELAXED, __HIP_MEMORY_SCOPE_AGENT); }
__device__ __forceinline__ unsigned xb_xcc_id() { return (unsigned)__builtin_amdgcn_s_getreg((3 << 11) | 20) & 0xFu; }
#define XB_SPIN(cond, bar) do { unsigned _sp = 0; while (cond) { __builtin_amdgcn_s_sleep(1); \
    if ((++_sp & 255u) == 0u) { if (xb_ld(&(bar)[XB_TMO])) break; if (_sp > XB_SPIN_CAP) { atomicAdd(&(bar)[XB_TMO], 1u); break; } } } } while (0)
struct XcdBarrier { unsigned* bar; unsigned x; volatile LAS unsigned* st; };
__device__ __forceinline__ XcdBarrier xcd_barrier_post(unsigned* bar, volatile LAS unsigned* st) {
    XcdBarrier b; b.bar = bar; b.x = xb_xcc_id(); b.st = st;
    if (threadIdx.x == 0) (void)xb_add(&bar[XB_XCNT(b.x)], 1u);
    return b;
}
__device__ __forceinline__ void xcd_barrier_complete(unsigned* bar, unsigned x, unsigned& nloc, unsigned& nx) {
    const unsigned G = gridDim.x * gridDim.y * gridDim.z;
    unsigned sum, cnt, mine, sp = 0u;
    for (;;) {
        sum = 0u; cnt = 0u; mine = 0u;
#pragma unroll
        for (unsigned j = 0; j < 16; ++j) { const unsigned c = xb_ld(&bar[XB_XCNT(j)]); sum += c; cnt += (c > 0u) ? 1u : 0u; mine = (j == x) ? c : mine; }
        if (sum == G) break;
        __builtin_amdgcn_s_sleep(1);
        if ((++sp & 255u) == 0u) { if (xb_ld(&bar[XB_TMO])) break; if (sp > XB_SPIN_CAP) { atomicAdd(&bar[XB_TMO], 1u); break; } }
    }
    nloc = mine > 0u ? mine : 1u; nx = cnt > 0u ? cnt : 1u;
}
__device__ __forceinline__ void xcd_barrier(const XcdBarrier& b) {
    asm volatile("s_waitcnt vmcnt(0)" ::: "memory");
    __syncthreads();
    if (threadIdx.x == 0) {
        unsigned* bar = b.bar;
        __builtin_amdgcn_s_waitcnt(0);
        unsigned nloc = b.st[0], nx = b.st[1];
        if (nloc == 0u) { xcd_barrier_complete(bar, b.x, nloc, nx); b.st[0] = nloc; b.st[1] = nx; }
        const unsigned old = xb_add(&bar[XB_XSUB(b.x)], 1u);
        const unsigned gen = old / nloc;
        if (old + 1u == (gen + 1u) * nloc) {
            __builtin_amdgcn_fence(__ATOMIC_RELEASE, "agent");
            asm volatile("s_waitcnt vmcnt(0)" ::: "memory");
            const unsigned og = xb_add(&bar[XB_TOP], 1u);
            const unsigned tg = og / nx;
            if (og + 1u == (tg + 1u) * nx) xb_add(&bar[XB_TOPGEN], 1u);
            else XB_SPIN(xb_ld(&bar[XB_TOPGEN]) == tg, bar);
            __builtin_amdgcn_fence(__ATOMIC_ACQUIRE, "agent");
            xb_add(&bar[XB_XGEN(b.x)], 1u);
            asm volatile("s_waitcnt vmcnt(0)" ::: "memory");
        } else {
            XB_SPIN(xb_ld(&bar[XB_XGEN(b.x)]) == gen, bar);
            __builtin_amdgcn_fence(__ATOMIC_ACQUIRE, "agent");
            asm volatile("s_waitcnt vmcnt(0)" ::: "memory");
        }
    }
    __syncthreads();
}

namespace pg8 {
constexpr int BM = 256, BK = 64, HALF = 128, HTB = HALF * BK * 2, STAGE_BYTES = 8 * HTB, NXCD = 8, WGM = 8;
__device__ __forceinline__ int lds_byte(int r, int c) { const int st = (r >> 4) * 2 + (c >> 5), rr = r & 15, cc = c & 31, ob = rr * 64 + cc * 2; return st * 1024 + (ob ^ (((ob >> 9) & 1) << 5)); }
__device__ __forceinline__ void stage_rc(int b, int& R, int& C) { const int st = b / 1024, sb = b % 1024, swz = sb ^ (((sb >> 9) & 1) << 5); R = (st >> 1) * 16 + swz / 64; C = (st & 1) * 32 + (swz % 64) / 2; }
__device__ __forceinline__ int perm32(int rho) { const int n = rho >> 4, i = rho & 15; return 8 * (i >> 2) + 4 * n + (i & 3); }
struct Unit { int pm, pn, q; };
struct Gemm { const bf16_t* A; const bf16_t* Bt; int K, lda, ldb; };

struct StaticOrder {
    static constexpr bool GATHER = false;
    int nM, nN, nwg, G, c, lda;
    __device__ void init(int M, int N, int G_, int c_, int lda_) { nM = M / BM; nN = N / BM; nwg = nM * nN; G = G_; c = c_; lda = lda_; }
    __device__ __forceinline__ bool next(int i, Unit& u) const {
        const long L = (long)i * G + c; if (L >= nwg) return false;
        int wgid = (int)L; { const int q = nwg / NXCD, r = nwg % NXCD, xcd = wgid % NXCD, off = wgid / NXCD; wgid = (xcd < r ? xcd * (q + 1) : r * (q + 1) + (xcd - r) * q) + off; }
        const int nig = WGM * nN, gid = wgid / nig, fm = gid * WGM, gsz = (nM - fm) < WGM ? (nM - fm) : WGM;
        u.pm = fm + ((wgid % nig) % gsz); u.pn = (wgid % nig) / gsz; u.q = i; return true;
    }
    __device__ __forceinline__ void aoff(const Unit& u, const int (&R)[2], const int (&C)[2], unsigned (&o)[2][2]) const {
#pragma unroll
        for (int h = 0; h < 2; ++h)
#pragma unroll
            for (int i = 0; i < 2; ++i) o[h][i] = (unsigned)((u.pm * BM + h * HALF + R[i]) * lda + C[i]) * 2u;
    }
};
template <bool GATHER_> struct TableOrder {
    static constexpr bool GATHER = GATHER_;
    const LAS int* tab; const LAS int* idx; int n, lda;
    __device__ __forceinline__ bool next(int i, Unit& u) const { if (i >= n) return false; u.pm = tab[i]; u.pn = tab[16 + i]; u.q = i; return true; }
    __device__ __forceinline__ void aoff(const Unit& u, const int (&R)[2], const int (&C)[2], unsigned (&o)[2][2]) const {
#pragma unroll
        for (int h = 0; h < 2; ++h)
#pragma unroll
            for (int i = 0; i < 2; ++i) { const int row = GATHER ? idx[u.q * 256 + h * HALF + R[i]] : (u.pm * BM + h * HALF + R[i]); o[h][i] = (unsigned)(row * lda + C[i]) * 2u; }
    }
};

struct EpiBf16 {
    static constexpr bool PERM = true;
    bf16_t* O; int ldc; int pnmask;
    __device__ __forceinline__ void operator()(const f32x4 (&acc)[2][2][4][2], const Unit& u, int wr, int wc, int fr, int fq) const {
        const int row0 = u.pm * BM + wr * 64 + fr; const int col0 = (u.pn & pnmask) * BM + wc * 32 + 8 * fq;
#pragma unroll
        for (int ai = 0; ai < 2; ++ai)
#pragma unroll
            for (int m = 0; m < 4; ++m) { bf16_t* rowp = O + (size_t)(row0 + ai * HALF + m * 16) * ldc + col0;
#pragma unroll
                for (int bj = 0; bj < 2; ++bj) { const f32x4 v0 = acc[ai][bj][m][0], v1 = acc[ai][bj][m][1];
                    u32x4 w; w.x = cvtpk(v0[0], v0[1]); w.y = cvtpk(v0[2], v0[3]); w.z = cvtpk(v1[0], v1[1]); w.w = cvtpk(v1[2], v1[3]);
                    *(u32x4*)(rowp + bj * HALF) = w; } }
    }
};
struct EpiRowScale {
    static constexpr bool PERM = true;
    bf16_t* O; int ldc; const float* rs; int which;
    __device__ __forceinline__ void operator()(const f32x4 (&acc)[2][2][4][2], const Unit& u, int wr, int wc, int fr, int fq) const {
        const int row0 = u.pm * BM + wr * 64 + fr; const int col0 = u.pn * BM + wc * 32 + 8 * fq;
#pragma unroll
        for (int ai = 0; ai < 2; ++ai)
#pragma unroll
            for (int m = 0; m < 4; ++m) { const int row = row0 + ai * HALF + m * 16; const float s = rs[row * 2 + which]; bf16_t* rowp = O + (size_t)row * ldc + col0;
#pragma unroll
                for (int bj = 0; bj < 2; ++bj) { const f32x4 v0 = acc[ai][bj][m][0] * s, v1 = acc[ai][bj][m][1] * s;
                    u32x4 w; w.x = cvtpk(v0[0], v0[1]); w.y = cvtpk(v0[2], v0[3]); w.z = cvtpk(v1[0], v1[1]); w.w = cvtpk(v1[2], v1[3]);
                    *(u32x4*)(rowp + bj * HALF) = w; } }
    }
};
template <bool O8> struct EpiSiluMul {
    static constexpr bool PERM = true;
    bf16_t* O;
    __device__ __forceinline__ void operator()(const f32x4 (&acc)[2][2][4][2], const Unit& u, int wr, int wc, int fr, int fq) const {
        const int row0 = u.pm * BM + wr * 64 + fr; const int col0 = (u.pn & 3) * HALF + wc * 32 + 8 * fq;
#pragma unroll
        for (int ai = 0; ai < 2; ++ai)
#pragma unroll
            for (int m = 0; m < 4; ++m) { const size_t eoff = (size_t)(row0 + ai * HALF + m * 16) * DE + col0; float h[8];
#pragma unroll
                for (int n = 0; n < 2; ++n)
#pragma unroll
                    for (int j = 0; j < 4; ++j) { const float g = acc[ai][0][m][n][j], up = acc[ai][1][m][n][j];
                        const float sg = g * __builtin_amdgcn_rcpf(1.0f + __builtin_amdgcn_exp2f(-g * LOG2E)); h[n * 4 + j] = sg * up; }
                if constexpr (O8) { u32x2 w; w.x = pk4_fp8(clamp8(h[0]), clamp8(h[1]), clamp8(h[2]), clamp8(h[3])); w.y = pk4_fp8(clamp8(h[4]), clamp8(h[5]), clamp8(h[6]), clamp8(h[7]));
                    *(u32x2*)((unsigned char*)O + eoff) = w; }
                else { u32x4 w; w.x = cvtpk(h[0], h[1]); w.y = cvtpk(h[2], h[3]); w.z = cvtpk(h[4], h[5]); w.w = cvtpk(h[6], h[7]);
                    *(u32x4*)(O + eoff) = w; } }
    }
};
template <bool RES_F32> struct EpiResF32 {
    static constexpr bool PERM = false;
    float* Z; const void* res;
    __device__ __forceinline__ void operator()(const f32x4 (&acc)[2][2][4][2], const Unit& u, int wr, int wc, int fr, int fq) const {
        const int row0 = u.pm * BM + wr * 64 + fr, col0 = u.pn * BM + wc * 32 + 4 * fq;
#pragma unroll
        for (int ai = 0; ai < 2; ++ai)
#pragma unroll
            for (int m = 0; m < 4; ++m) { const size_t off = (size_t)(row0 + ai * HALF + m * 16) * DM + col0;
#pragma unroll
                for (int bj = 0; bj < 2; ++bj)
#pragma unroll
                    for (int n = 0; n < 2; ++n) { f32x4 o = acc[ai][bj][m][n];
                        if constexpr (RES_F32) { const f32x4 rv = *(const f32x4*)((const float*)res + off + bj * HALF + n * 16); o += ALPHA * rv; }
                        else { const u32x2 rb = *(const u32x2*)((const bf16_t*)res + off + bj * HALF + n * 16);
                            o[0] += ALPHA * bflo(rb.x); o[1] += ALPHA * bfhi(rb.x); o[2] += ALPHA * bflo(rb.y); o[3] += ALPHA * bfhi(rb.y); }
                        *(f32x4*)(Z + off + bj * HALF + n * 16) = o; } }
    }
};

template <bool F8, class Epi, class Sched>
__device__ __forceinline__ void gemm_phase(int wv, LAS unsigned char* lds, const Gemm g, const Sched& S, const Epi& E, int sW = 0x7f7f7f7f, int sX = 0x7f7f7f7f) {
    constexpr bool GA = Sched::GATHER;
    const int tid = fresh_tid(wv), wid = __builtin_amdgcn_readfirstlane(tid >> 6), lane = tid & 63, wr = wid >> 2, wc = wid & 3, fr = lane & 15, fq = lane >> 4;
    int K = g.K; asm volatile("" : "+s"(K));
    const int nt = K / BK;
    int Rr[2], Cc[2]; unsigned voffA[2], voffB[2];
#pragma unroll
    for (int i = 0; i < 2; ++i) { int R, C; stage_rc(tid * 16 + i * 8192, R, C); Rr[i] = R; Cc[i] = C; const int Rb = Epi::PERM ? ((R & ~31) + perm32(R & 31)) : R;
        voffA[i] = (unsigned)(R * g.lda + C) * 2u; voffB[i] = (unsigned)(Rb * g.ldb + C) * 2u; }
    const size_t kstep = (size_t)(BK * 2);
    const size_t hstepA = (size_t)HALF * g.lda * 2, tstepA = 2 * hstepA;
    const size_t hstepB = (size_t)HALF * g.ldb * 2, tstepB = 2 * hstepB;
    const unsigned ldsw = (unsigned)wid * 1024u;
    const int aoff = lds_byte(wr * 64 + fr, fq * 8), boff = lds_byte(wc * 32 + fr, fq * 8);
#define PG8_SA(b, h) (((b) * 2 + (h)) * HTB)
#define PG8_SB(b, h) ((4 + (b) * 2 + (h)) * HTB)
#define PG8_STAGE(bufoff, gbase, voff) do { _Pragma("unroll") for (int _i = 0; _i < 2; ++_i) \
        __builtin_amdgcn_global_load_lds((const unsigned*)((const char*)(gbase) + (voff)[_i]), (LAS unsigned*)(lds + (bufoff) + ldsw + _i * 8192), 16, 0, 0); } while (0)
#define PG8_STAGE_A(bufoff, h, pbase, koff, goffs) do { if constexpr (GA) { PG8_STAGE(bufoff, gA + (koff), (goffs)[h]); } else { PG8_STAGE(bufoff, (pbase) + (h) * hstepA, voffA); } } while (0)
#define PG8_LD32(dst, off) do { const i32x4 _lo = *(const LAS i32x4*)(lds + (off)), _hi = *(const LAS i32x4*)(lds + (off) + 1024); dst = __builtin_shufflevector(_lo, _hi, 0, 1, 2, 3, 4, 5, 6, 7); } while (0)
#define PG8_LDA(dst, b, h) do { _Pragma("unroll") for (int m = 0; m < 4; ++m) PG8_LD32(dst[m], PG8_SA(b, h) + aoff + m * 2048); } while (0)
#define PG8_LDB(dst, b, h) do { _Pragma("unroll") for (int n = 0; n < 2; ++n) PG8_LD32(dst[n], PG8_SB(b, h) + boff + n * 2048); } while (0)
#define PG8_LOH(v) __builtin_bit_cast(bf16x8, __builtin_shufflevector(v, v, 0, 1, 2, 3))
#define PG8_HIH(v) __builtin_bit_cast(bf16x8, __builtin_shufflevector(v, v, 4, 5, 6, 7))
#define PG8_MMA(ai, bj, At, Bt) do { __builtin_amdgcn_s_setprio(1); \
        if constexpr (F8) { _Pragma("unroll") for (int m = 0; m < 4; ++m) _Pragma("unroll") for (int n = 0; n < 2; ++n) \
            asm volatile("v_mfma_scale_f32_16x16x128_f8f6f4 %0, %1, %2, %0, %3, %4 op_sel_hi:[0,0,0]" : "+v"(acc[ai][bj][m][n]) : "v"(Bt[n]), "v"(At[m]), "v"(sW), "v"(sX)); } \
        else { _Pragma("unroll") for (int m = 0; m < 4; ++m) _Pragma("unroll") for (int n = 0; n < 2; ++n) { \
            acc[ai][bj][m][n] = __builtin_amdgcn_mfma_f32_16x16x32_bf16(PG8_LOH(Bt[n]), PG8_LOH(At[m]), acc[ai][bj][m][n], 0, 0, 0); \
            acc[ai][bj][m][n] = __builtin_amdgcn_mfma_f32_16x16x32_bf16(PG8_HIH(Bt[n]), PG8_HIH(At[m]), acc[ai][bj][m][n], 0, 0, 0); } } \
        __builtin_amdgcn_s_setprio(0); } while (0)
#define PG8_WAIT_V(n) asm volatile("s_waitcnt vmcnt(" #n ")" ::: "memory")
#define PG8_WAIT_L(n) asm volatile("s_waitcnt lgkmcnt(" #n ")" ::: "memory")
#define PG8_BAR __builtin_amdgcn_s_barrier()
#define PG8_SCHED __builtin_amdgcn_sched_barrier(0)
    Unit cur, nxt; int ui = 0;
    if (!S.next(0, cur)) return;
    f32x4 acc[2][2][4][2];
#pragma unroll
    for (int a = 0; a < 2; ++a)
#pragma unroll
        for (int b = 0; b < 2; ++b)
#pragma unroll
            for (int m = 0; m < 4; ++m)
#pragma unroll
                for (int n = 0; n < 2; ++n) { const float zf = fresh_zero(); acc[a][b][m][n] = (f32x4){zf, zf, zf, zf}; }
    unsigned ca[2][2];
    if constexpr (GA) S.aoff(cur, Rr, Cc, ca);
    const char* gA = (const char*)g.A;
    const char* cA = gA + (GA ? (size_t)0 : (size_t)cur.pm * tstepA);
    const char* cB = (const char*)g.Bt + (size_t)cur.pn * tstepB;
    PG8_STAGE(PG8_SB(0, 0), cB, voffB); PG8_STAGE_A(PG8_SA(0, 0), 0, cA, 0, ca); PG8_STAGE(PG8_SB(0, 1), cB + hstepB, voffB); PG8_STAGE_A(PG8_SA(0, 1), 1, cA, 0, ca);
    if (wr == 1) PG8_BAR;
    PG8_WAIT_V(4); PG8_BAR;
    PG8_STAGE(PG8_SB(1, 0), cB + kstep, voffB); PG8_STAGE_A(PG8_SA(1, 0), 0, cA + kstep, kstep, ca); PG8_STAGE(PG8_SB(1, 1), cB + hstepB + kstep, voffB);
    PG8_WAIT_V(6); PG8_BAR;
    for (;;) {
        const bool has_next = S.next(ui + 1, nxt);
        const char* nA = (!GA && has_next) ? gA + (size_t)nxt.pm * tstepA : cA;
        const char* nB = has_next ? (const char*)g.Bt + (size_t)nxt.pn * tstepB : cB;
#pragma unroll 1
        for (int t = 0; t < nt; t += 2) {
            const bool last = (t == nt - 2);
            const size_t k1 = (size_t)(t + 1) * kstep, k2 = last ? (size_t)0 : (size_t)(t + 2) * kstep, k3 = k2 + kstep;
            const char* a1 = cA + k1;
            const char* a2 = last ? nA : cA + k2; const char* b2 = last ? nB : cB + (size_t)(t + 2) * kstep;
            const char* a3 = a2 + kstep; const char* b3 = b2 + kstep;
            i32x8 At[4], B0[2], B1[2];
            unsigned xa[2][2];
            if constexpr (GA) {
                if (last && has_next) { int R2[2], C2[2]; const int t2 = fresh_tid(wv); stage_rc(t2 * 16, R2[0], C2[0]); stage_rc(t2 * 16 + 8192, R2[1], C2[1]); S.aoff(nxt, R2, C2, xa); }
                else {
#pragma unroll
                    for (int h = 0; h < 2; ++h)
#pragma unroll
                        for (int i = 0; i < 2; ++i) xa[h][i] = ca[h][i];
                }
            }
            PG8_LDB(B0, 0, 0); PG8_SCHED; PG8_LDA(At, 0, 0); PG8_STAGE_A(PG8_SA(1, 1), 1, a1, k1, ca);
            PG8_WAIT_L(8); PG8_BAR; PG8_WAIT_L(0); PG8_MMA(0, 0, At, B0); PG8_BAR; PG8_SCHED;
            PG8_LDB(B1, 0, 1); PG8_STAGE(PG8_SB(0, 0), b2, voffB);
            PG8_BAR; PG8_WAIT_L(0); PG8_MMA(0, 1, At, B1); PG8_BAR;
            PG8_LDA(At, 0, 1); PG8_STAGE_A(PG8_SA(0, 0), 0, a2, k2, xa);
            PG8_BAR; PG8_WAIT_L(0); PG8_MMA(1, 0, At, B0); PG8_BAR; PG8_SCHED;
            PG8_STAGE(PG8_SB(0, 1), b2 + hstepB, voffB);
            PG8_WAIT_V(6); PG8_BAR; PG8_MMA(1, 1, At, B1); PG8_BAR;
            PG8_LDB(B0, 1, 0); PG8_SCHED; PG8_LDA(At, 1, 0); PG8_STAGE_A(PG8_SA(0, 1), 1, a2, k2, xa);
            PG8_WAIT_L(8); PG8_BAR; PG8_WAIT_L(0); PG8_MMA(0, 0, At, B0); PG8_BAR; PG8_SCHED;
            PG8_LDB(B1, 1, 1); PG8_STAGE(PG8_SB(1, 0), b3, voffB);
            PG8_BAR; PG8_WAIT_L(0); PG8_MMA(0, 1, At, B1); PG8_BAR;
            PG8_LDA(At, 1, 1); PG8_STAGE_A(PG8_SA(1, 0), 0, a3, k3, xa);
            PG8_BAR; PG8_WAIT_L(0); PG8_MMA(1, 0, At, B0); PG8_BAR; PG8_SCHED;
            PG8_STAGE(PG8_SB(1, 1), b3 + hstepB, voffB);
            PG8_WAIT_V(6); PG8_BAR; PG8_MMA(1, 1, At, B1); PG8_BAR;
        }
        if constexpr (F8) asm volatile("s_nop 7\n\ts_nop 7\n\ts_nop 7" ::: "memory");
        { const int l2 = fresh_tid(0); E(acc, cur, wr, wc, l2 & 15, l2 >> 4); }
        if (!has_next) break;
#pragma unroll
        for (int a = 0; a < 2; ++a)
#pragma unroll
            for (int b = 0; b < 2; ++b)
#pragma unroll
                for (int m = 0; m < 4; ++m)
#pragma unroll
                    for (int n = 0; n < 2; ++n) { const float zf = fresh_zero(); acc[a][b][m][n] = (f32x4){zf, zf, zf, zf}; }
        cur = nxt; cA = nA; cB = nB; ++ui;
        if constexpr (GA) { int R2[2], C2[2]; const int t2 = fresh_tid(wv); stage_rc(t2 * 16, R2[0], C2[0]); stage_rc(t2 * 16 + 8192, R2[1], C2[1]); S.aoff(cur, R2, C2, ca); }
    }
    PG8_WAIT_V(0);
    if (wr == 0) PG8_BAR;
    PG8_BAR;
#undef PG8_SA
#undef PG8_SB
#undef PG8_STAGE
#undef PG8_STAGE_A
#undef PG8_LDA
#undef PG8_LDB
#undef PG8_MMA
#undef PG8_LD32
#undef PG8_LOH
#undef PG8_HIH
#undef PG8_WAIT_V
#undef PG8_WAIT_L
#undef PG8_BAR
#undef PG8_SCHED
}
}

namespace da {
constexpr int KVBLK = 64;
constexpr float THR = 8.f;
constexpr int SHM_V = KVBLK * 128 * 2, SHM_K = KVBLK * 128 * 2, SHM_KR = KVBLK * 64 * 2;
constexpr int OFF_V = 0, OFF_K = 2 * SHM_V, OFF_WS = OFF_K + 2 * SHM_K, OFF_KR = OFF_WS + 8 * 64 * 4, OFF_QR = OFF_KR + 2 * SHM_KR, LDS_DENSE = OFF_QR + 8 * 4096;
#define KSWZ(row, colB) ((row) * 256 + ((colB) ^ (((row) & 7) << 4)))
#define KRSWZ(row, ch) ((row) * 128 + ((((ch) ^ ((row) >> 1)) & 7) << 4))
#define SBAR() __builtin_amdgcn_sched_barrier(0)
__device__ __forceinline__ int crow(int r, int hi) { return (r & 3) + 8 * (r >> 2) + 4 * hi; }
__device__ __forceinline__ int v_st(int k, int c) { const int kk = (k & ~0xC) | ((k & 4) << 1) | ((k & 8) >> 1); return ((kk >> 3) * 4 + (c >> 5)) * 512 + ((kk & 7) * 32 + (c & 31)) * 2; }
__device__ __forceinline__ int v_rd_base(int lane) { return ((lane & 3) << 3) | (((lane >> 2) & 3) << 6) | (((lane >> 4) & 1) << 5) | (((lane >> 5) & 1) << 8); }
constexpr int v_rd_off(int d0, int ks, int half) { return d0 * 512 + ks * 4096 + half * 2048; }
template <int OFF> __device__ __forceinline__ s16x4 tr_read(int vb) {
    s16x4 r; asm volatile("ds_read_b64_tr_b16 %0, %1 offset:%2" : "=&v"(r) : "v"(vb), "i"(OFF) : "memory"); return r;
}
template <int D0> __device__ __forceinline__ void pv_one(f32x16& od, int vb, bf16x8 pa0, bf16x8 pa1, bf16x8 pa2, bf16x8 pa3) {
    const s16x4 l0 = tr_read<v_rd_off(D0, 0, 0)>(vb), h0 = tr_read<v_rd_off(D0, 0, 1)>(vb), l1 = tr_read<v_rd_off(D0, 1, 0)>(vb), h1 = tr_read<v_rd_off(D0, 1, 1)>(vb);
    const s16x4 l2 = tr_read<v_rd_off(D0, 2, 0)>(vb), h2 = tr_read<v_rd_off(D0, 2, 1)>(vb), l3 = tr_read<v_rd_off(D0, 3, 0)>(vb), h3 = tr_read<v_rd_off(D0, 3, 1)>(vb);
    asm volatile("s_waitcnt lgkmcnt(0)" ::: "memory"); SBAR();
#define PK(L, H) (bf16x8){L[0], L[1], L[2], L[3], H[0], H[1], H[2], H[3]}
    od = __builtin_amdgcn_mfma_f32_32x32x16_bf16(pa0, PK(l0, h0), od, 0, 0, 0);
    od = __builtin_amdgcn_mfma_f32_32x32x16_bf16(pa1, PK(l1, h1), od, 0, 0, 0);
    od = __builtin_amdgcn_mfma_f32_32x32x16_bf16(pa2, PK(l2, h2), od, 0, 0, 0);
    od = __builtin_amdgcn_mfma_f32_32x32x16_bf16(pa3, PK(l3, h3), od, 0, 0, 0);
}
__device__ __forceinline__ void pv_d0(f32x16* o, int vb, bf16x8 pa0, bf16x8 pa1, bf16x8 pa2, bf16x8 pa3) {
    pv_one<0>(o[0], vb, pa0, pa1, pa2, pa3); pv_one<1>(o[1], vb, pa0, pa1, pa2, pa3); pv_one<2>(o[2], vb, pa0, pa1, pa2, pa3); pv_one<3>(o[3], vb, pa0, pa1, pa2, pa3);
}
template <int D0> __device__ __forceinline__ void pv_one32(f32x16& od, int vb, bf16x8 pa0, bf16x8 pa1) {
    const s16x4 l0 = tr_read<v_rd_off(D0, 0, 0)>(vb), h0 = tr_read<v_rd_off(D0, 0, 1)>(vb), l1 = tr_read<v_rd_off(D0, 1, 0)>(vb), h1 = tr_read<v_rd_off(D0, 1, 1)>(vb);
    asm volatile("s_waitcnt lgkmcnt(0)" ::: "memory"); SBAR();
    od = __builtin_amdgcn_mfma_f32_32x32x16_bf16(pa0, PK(l0, h0), od, 0, 0, 0);
    od = __builtin_amdgcn_mfma_f32_32x32x16_bf16(pa1, PK(l1, h1), od, 0, 0, 0);
}
#undef PK
#define PK4(P, BASE, OUT) do { unsigned a0 = cvtpk(P[BASE + 0], P[BASE + 1]), a1 = cvtpk(P[BASE + 2], P[BASE + 3]);   \
    unsigned b0 = cvtpk(P[BASE + 4], P[BASE + 5]), b1 = cvtpk(P[BASE + 6], P[BASE + 7]);                              \
    auto r0 = __builtin_amdgcn_permlane32_swap(a0, b0, false, false); auto r1 = __builtin_amdgcn_permlane32_swap(a1, b1, false, false); \
    u32x4 w = {r0[0], r1[0], r0[1], r1[1]}; OUT = *reinterpret_cast<bf16x8*>(&w); } while (0)

template <int NDQ> struct Cst { static constexpr float SCALE = (NDQ == 8) ? 0.088388347648318440f : 0.072168783648703220f; static constexpr float C = SCALE * LOG2E; };

template <int NDQ>
__device__ __forceinline__ void partialSM(f32x16& p0, f32x16& p1, float& m_reg, float& mn, float& alpha) {
    constexpr float C = Cst<NDQ>::C, SCALE = Cst<NDQ>::SCALE;
    float pmax = p0[0];
#pragma unroll
    for (int r = 1; r < 16; ++r) pmax = fmaxf(pmax, p0[r]);
#pragma unroll
    for (int r = 0; r < 16; ++r) pmax = fmaxf(pmax, p1[r]);
    { auto rr = __builtin_amdgcn_permlane32_swap(__float_as_uint(pmax), __float_as_uint(pmax), false, false);
      pmax = fmaxf(__uint_as_float(rr[0]), __uint_as_float(rr[1])); }
    if (__builtin_expect(__all(pmax - m_reg <= THR / SCALE), 1)) { mn = m_reg; alpha = 1.f; }
    else { mn = fmaxf(m_reg, pmax); alpha = __builtin_amdgcn_exp2f((m_reg - mn) * C); m_reg = mn; }
    const float mnC = -mn * C;
#pragma unroll
    for (int r = 0; r < 16; ++r) p0[r] = fmaf(p0[r], C, mnC);
#pragma unroll
    for (int r = 0; r < 16; ++r) p1[r] = fmaf(p1[r], C, mnC);
#pragma unroll
    for (int r = 0; r < 16; ++r) p0[r] = __builtin_amdgcn_exp2f(p0[r]);
}
__device__ __forceinline__ void finishSM(f32x16& p0, f32x16& p1, float alpha, float& l_reg, bf16x8& pa0, bf16x8& pa1, bf16x8& pa2, bf16x8& pa3) {
#pragma unroll
    for (int r = 0; r < 16; ++r) p1[r] = __builtin_amdgcn_exp2f(p1[r]);
    float ps = 0;
#pragma unroll
    for (int r = 0; r < 16; ++r) ps += p0[r];
#pragma unroll
    for (int r = 0; r < 16; ++r) ps += p1[r];
    { auto rr = __builtin_amdgcn_permlane32_swap(__float_as_uint(ps), __float_as_uint(ps), false, false);
      ps = __uint_as_float(rr[0]) + __uint_as_float(rr[1]); }
    l_reg = l_reg * alpha + ps;
    PK4(p0, 0, pa0); PK4(p0, 8, pa1); PK4(p1, 0, pa2); PK4(p1, 8, pa3);
}
template <int NDQ>
__device__ __forceinline__ void qkt(f32x16& p0, f32x16& p1, const char* Ks, const char* Krs, const bf16x8* qr, const char* qrl, int r32, int hi) {
    p0 = f32x16{}; p1 = f32x16{};
#pragma unroll
    for (int d0 = 0; d0 < 8; ++d0) { const int cb = (d0 * 16 + hi * 8) * 2;
        bf16x8 b0 = *reinterpret_cast<const bf16x8*>(Ks + KSWZ(r32, cb));
        bf16x8 b1 = *reinterpret_cast<const bf16x8*>(Ks + KSWZ(32 + r32, cb));
        p0 = __builtin_amdgcn_mfma_f32_32x32x16_bf16(b0, qr[d0], p0, 0, 0, 0);
        p1 = __builtin_amdgcn_mfma_f32_32x32x16_bf16(b1, qr[d0], p1, 0, 0, 0); }
    if constexpr (NDQ == 12) {
#pragma unroll
        for (int d0 = 0; d0 < 4; ++d0) { const int ch = d0 * 2 + hi;
            bf16x8 b0 = *reinterpret_cast<const bf16x8*>(Krs + KRSWZ(r32, ch));
            bf16x8 b1 = *reinterpret_cast<const bf16x8*>(Krs + KRSWZ(32 + r32, ch));
            const bf16x8 qf = *reinterpret_cast<const bf16x8*>(qrl + d0 * 1024);
            p0 = __builtin_amdgcn_mfma_f32_32x32x16_bf16(b0, qf, p0, 0, 0, 0);
            p1 = __builtin_amdgcn_mfma_f32_32x32x16_bf16(b1, qf, p1, 0, 0, 0); }
    }
}

struct DArgs { const bf16_t* Q; const bf16_t* K; const bf16_t* V; const bf16_t* Kr; bf16_t* O; int ldq, ldk, ldv, ldo; int seq; int pos0; };

template <int NDQ, int SDEPTH>
__device__ __forceinline__ void attn_dense_body(int wv, const DArgs a, char* lds) {
    const int tid = fresh_tid(wv), wid = tid >> 6, lane = tid & 63, r32 = lane & 31, hi = lane >> 5;
    char* V_lds = lds + OFF_V; char* K_lds = lds + OFF_K; char* Kr_lds = lds + OFF_KR;
    float* ws = (float*)(lds + OFF_WS) + wid * 64; float* li_l = ws; float* al_l = ws + 32;
    float m_reg = -1e30f, l_reg = 0; f32x16 o[4] = {}; bf16x8 qr[8];
    char* qrl = lds + OFF_QR + wid * 4096 + lane * 16;
    const bf16_t* Qw = a.Q + (long)(wid * 32 + r32) * a.ldq + hi * 8;
#pragma unroll
    for (int d0 = 0; d0 < 8; ++d0) qr[d0] = *reinterpret_cast<const bf16x8*>(Qw + d0 * 16);
    if constexpr (NDQ == 12) {
        const float pos = (float)(a.pos0 + wid * 32 + r32);
#pragma unroll
        for (int f = 0; f < 2; ++f) {
            const bf16x8 x1v = *reinterpret_cast<const bf16x8*>(Qw + (8 + f) * 16), x2v = *reinterpret_cast<const bf16x8*>(Qw + (10 + f) * 16); bf16x8 y1v, y2v;
#pragma unroll
            for (int j = 0; j < 8; ++j) { const int i = f * 16 + hi * 8 + j; float sn, cs; sincos_rev(pos * inv_freq32(i), sn, cs);
                const float x1 = bf2f((unsigned short)x1v[j]), x2 = bf2f((unsigned short)x2v[j]);
                y1v[j] = (short)f2bf(x1 * cs - x2 * sn); y2v[j] = (short)f2bf(x2 * cs + x1 * sn); }
            *reinterpret_cast<bf16x8*>(qrl + f * 1024) = y1v; *reinterpret_cast<bf16x8*>(qrl + (2 + f) * 1024) = y2v;
        }
    }
    const int sr = tid >> 4, sc = (tid & 15) * 8, vst0 = v_st(sr, sc), vst1 = v_st(32 + sr, sc);
    const int krr = tid >> 3, krc = tid & 7;
    const int vb0 = (int)(uintptr_t)V_lds + v_rd_base(lane);
    struct { bf16x8 vs0, vs1, ks0, ks1, kr; } sr_[SDEPTH];
#define SLOAD(i, k0) do { sr_[i].vs0 = *(const bf16x8*)(a.V + (long)((k0) + sr) * a.ldv + sc); sr_[i].vs1 = *(const bf16x8*)(a.V + (long)((k0) + 32 + sr) * a.ldv + sc); \
    sr_[i].ks0 = *(const bf16x8*)(a.K + (long)((k0) + sr) * a.ldk + sc); sr_[i].ks1 = *(const bf16x8*)(a.K + (long)((k0) + 32 + sr) * a.ldk + sc); \
    if constexpr (NDQ == 12) sr_[i].kr = *(const bf16x8*)(a.Kr + (long)((k0) + krr) * 64 + krc * 8); } while (0)
#define SWRITE(b, i) do { *(bf16x8*)(V_lds + (b) * SHM_V + vst0) = sr_[i].vs0; *(bf16x8*)(V_lds + (b) * SHM_V + vst1) = sr_[i].vs1; const int kc = sc * 2; \
    *(bf16x8*)(K_lds + (b) * SHM_K + KSWZ(sr, kc)) = sr_[i].ks0; *(bf16x8*)(K_lds + (b) * SHM_K + KSWZ(32 + sr, kc)) = sr_[i].ks1; \
    if constexpr (NDQ == 12) *(bf16x8*)(Kr_lds + (b) * SHM_KR + KRSWZ(krr, krc)) = sr_[i].kr; } while (0)
#define SWAIT() do { if constexpr (SDEPTH == 2) { if constexpr (NDQ == 12) asm volatile("s_waitcnt vmcnt(5)" ::: "memory"); else asm volatile("s_waitcnt vmcnt(4)" ::: "memory"); } else asm volatile("s_waitcnt vmcnt(0)" ::: "memory"); } while (0)
#define RESC(al) do { if (__any((al) < 1.f)) { if (hi == 0) al_l[r32] = (al); asm volatile("s_waitcnt lgkmcnt(0)" ::: "memory"); \
    _Pragma("unroll") for (int d = 0; d < 4; ++d) _Pragma("unroll") for (int r = 0; r < 16; ++r) o[d][r] *= al_l[crow(r, hi)]; } } while (0)
    f32x16 pA0, pA1, pB0, pB1; float mnA, mnB, alA, alB; bf16x8 pa0, pa1, pa2, pa3; const int NT = a.seq / KVBLK;
    constexpr int SE = 0, SO = SDEPTH - 1;
    SLOAD(SE, 0); asm volatile("s_waitcnt vmcnt(0)" ::: "memory"); SWRITE(0, SE); __syncthreads();
    qkt<NDQ>(pA0, pA1, K_lds, Kr_lds, qr, qrl, r32, hi); partialSM<NDQ>(pA0, pA1, m_reg, mnA, alA);
    SLOAD(SO, KVBLK); if constexpr (SDEPTH == 2) { if (2 < NT) SLOAD(SE, 2 * KVBLK); }
    SWAIT(); SWRITE(1, SO); __syncthreads();
#pragma unroll 1
    for (int j = 1; j + 1 < NT; j += 2) {
        SBAR(); qkt<NDQ>(pB0, pB1, K_lds + SHM_K, Kr_lds + SHM_KR, qr, qrl, r32, hi);
        finishSM(pA0, pA1, alA, l_reg, pa0, pa1, pa2, pa3); SBAR();
        SLOAD(SO, (j + SDEPTH) * KVBLK); SBAR();
        pv_d0(o, vb0, pa0, pa1, pa2, pa3); partialSM<NDQ>(pB0, pB1, m_reg, mnB, alB);
        __syncthreads(); SWAIT(); SWRITE(0, SE);
        RESC(alB); __syncthreads();
        SBAR(); qkt<NDQ>(pA0, pA1, K_lds, Kr_lds, qr, qrl, r32, hi);
        finishSM(pB0, pB1, alB, l_reg, pa0, pa1, pa2, pa3); SBAR();
        if (SDEPTH == 1 || j + 3 < NT) SLOAD(SE, (j + 1 + SDEPTH) * KVBLK); SBAR();
        pv_d0(o, vb0 + (int)SHM_V, pa0, pa1, pa2, pa3); partialSM<NDQ>(pA0, pA1, m_reg, mnA, alA);
        __syncthreads(); SWAIT(); SWRITE(1, SO);
        RESC(alA); __syncthreads();
    }
    SBAR(); qkt<NDQ>(pB0, pB1, K_lds + SHM_K, Kr_lds + SHM_KR, qr, qrl, r32, hi);
    finishSM(pA0, pA1, alA, l_reg, pa0, pa1, pa2, pa3); SBAR();
    pv_d0(o, vb0, pa0, pa1, pa2, pa3); partialSM<NDQ>(pB0, pB1, m_reg, mnB, alB);
    __syncthreads(); RESC(alB);
    finishSM(pB0, pB1, alB, l_reg, pa0, pa1, pa2, pa3); SBAR();
    pv_d0(o, vb0 + (int)SHM_V, pa0, pa1, pa2, pa3);
    if (hi == 0) li_l[r32] = l_reg; asm volatile("s_waitcnt lgkmcnt(0)" ::: "memory");
    float rli[16];
#pragma unroll
    for (int r = 0; r < 16; ++r) rli[r] = __builtin_amdgcn_rcpf(li_l[crow(r, hi)]);
    bf16_t* Ow = a.O + (long)(wid * 32) * a.ldo;
#pragma unroll
    for (int r = 0; r < 16; ++r) { const int orow = crow(r, hi);
#pragma unroll
        for (int d0 = 0; d0 < 4; ++d0) Ow[(long)orow * a.ldo + d0 * 32 + r32] = f2bf(o[d0][r] * rli[r]); }
#undef SLOAD
#undef SWRITE
#undef SWAIT
#undef RESC
}

constexpr int SP_WAVE_LDS = 18688;
template <class P>
__device__ __forceinline__ void sparse_wave(P& pol, LAS unsigned char* wll, int lane) {
    const int r32 = lane & 31, hi = lane >> 5;
    char* wl = (char*)wll;
    char* Kl = wl; char* Vl = wl + 8192; float* li_l = (float*)(wl + 16384); float* al_l = li_l + 32;
    bf16x8 qr[8];
    { const bf16_t* qp = pol.qptr(r32) + hi * 8;
#pragma unroll
      for (int d0 = 0; d0 < 8; ++d0) qr[d0] = *reinterpret_cast<const bf16x8*>(qp + d0 * 16); }
    asm volatile("s_waitcnt vmcnt(0)" ::: "memory");
    f32x16 o[4] = {}; float m_reg = -1e30f, l_reg = 0.f;
    const int krow0 = lane >> 4;
    const int kce = (((lane & 15) ^ (krow0 & 7)) * 8), kco = (((lane & 15) ^ ((4 + krow0) & 7)) * 8);
    const int vk0 = 8 * ((lane >> 4) & 1) + ((lane >> 2) & 3), vc0 = 32 * (lane >> 5) + 8 * (lane & 3);
    const int vb = (int)(uintptr_t)Vl + v_rd_base(lane);
    const int nt = pol.ntiles();
    typename P::TI ti, tn;
#define SP_DMA_K(T) do { _Pragma("unroll") for (int i = 0; i < 8; ++i) { const bf16_t* src = (T).k + (long)(4 * i + krow0) * (T).rs + ((i & 1) ? kco : kce); \
        __builtin_amdgcn_global_load_lds((const unsigned*)src, (LAS unsigned*)(wll + i * 1024), 16, 0, 0); } } while (0)
#define SP_DMA_V(T) do { _Pragma("unroll") for (int i = 0; i < 8; ++i) { const bf16_t* src = (T).v + (long)(16 * (i >> 2) + 4 * ((i >> 1) & 1) + vk0) * (T).rs + 64 * (i & 1) + vc0; \
        __builtin_amdgcn_global_load_lds((const unsigned*)src, (LAS unsigned*)(wll + 8192 + i * 1024), 16, 0, 0); } } while (0)
    pol.tile(0, ti);
    SP_DMA_K(ti); SP_DMA_V(ti);
#pragma unroll 1
    for (int j = 0; j < nt; ++j) {
        const bool more = (j + 1 < nt);
        if (more) pol.tile(j + 1, tn);
        asm volatile("s_waitcnt vmcnt(8)" ::: "memory");
        f32x16 p = f32x16{};
#pragma unroll
        for (int d0 = 0; d0 < 8; ++d0) { const int cb = (d0 * 16 + hi * 8) * 2;
            bf16x8 b0 = *reinterpret_cast<const bf16x8*>(Kl + KSWZ(r32, cb));
            p = __builtin_amdgcn_mfma_f32_32x32x16_bf16(b0, qr[d0], p, 0, 0, 0); }
        asm volatile("s_waitcnt lgkmcnt(0)" ::: "memory"); SBAR();
        if (more) SP_DMA_K(tn);
        SBAR();
        float pmax = -INFINITY;
#pragma unroll
        for (int r = 0; r < 16; ++r) { p[r] = pol.adj(ti, crow(r, hi), p[r]); pmax = fmaxf(pmax, p[r]); }
        { auto rr = __builtin_amdgcn_permlane32_swap(__float_as_uint(pmax), __float_as_uint(pmax), false, false);
          pmax = fmaxf(__uint_as_float(rr[0]), __uint_as_float(rr[1])); }
        const float mn = fmaxf(m_reg, pmax); const float alpha = __builtin_amdgcn_exp2f(m_reg - mn); m_reg = mn;
        float ps = 0.f;
#pragma unroll
        for (int r = 0; r < 16; ++r) { p[r] = __builtin_amdgcn_exp2f(p[r] - mn); ps += p[r]; }
        { auto rr = __builtin_amdgcn_permlane32_swap(__float_as_uint(ps), __float_as_uint(ps), false, false);
          ps = __uint_as_float(rr[0]) + __uint_as_float(rr[1]); }
        l_reg = l_reg * alpha + ps;
        if (__any(alpha < 1.f)) { if (hi == 0) al_l[r32] = alpha; asm volatile("s_waitcnt lgkmcnt(0)" ::: "memory");
#pragma unroll
            for (int d = 0; d < 4; ++d)
#pragma unroll
                for (int r = 0; r < 16; ++r) o[d][r] *= al_l[crow(r, hi)]; }
        bf16x8 pa0, pa1; PK4(p, 0, pa0); PK4(p, 8, pa1);
        SBAR();
        if (more) asm volatile("s_waitcnt vmcnt(8)" ::: "memory"); else asm volatile("s_waitcnt vmcnt(0)" ::: "memory");
        SBAR();
        pv_one32<0>(o[0], vb, pa0, pa1); pv_one32<1>(o[1], vb, pa0, pa1); pv_one32<2>(o[2], vb, pa0, pa1); pv_one32<3>(o[3], vb, pa0, pa1);
        SBAR();
        if (more) SP_DMA_V(tn);
        SBAR();
        ti = tn;
    }
#undef SP_DMA_K
#undef SP_DMA_V
    if (hi == 0) li_l[r32] = l_reg; asm volatile("s_waitcnt lgkmcnt(0)" ::: "memory");
#pragma unroll
    for (int r = 0; r < 16; ++r) { const int qn = crow(r, hi); const float rl = __builtin_amdgcn_rcpf(li_l[qn]); bf16_t* op = pol.optr(qn);
#pragma unroll
        for (int d0 = 0; d0 < 4; ++d0) op[d0 * 32 + r32] = f2bf(o[d0][r] * rl); }
}
#undef PK4
}

struct PolB {
    struct TI { const bf16_t* k; const bf16_t* v; long rs; int kpos0; int iq; float cd; };
    const bf16_t* H0; bf16_t* O; int b, h, a, r16, myn; int lo3, n3, lo2, n2, lo1, n1; float slope2;
    __device__ __forceinline__ void init(const bf16_t* H0_, bf16_t* O_, int w, int lane) {
        H0 = H0_; O = O_; b = w >> 10; h = (w >> 7) & 7; const int wu = w & 127; a = wu >> 4; r16 = wu & 15; myn = lane & 31;
        lo3 = max(a - 2, 0); n3 = min(a + 2, 7) - lo3 + 1;
        lo2 = max(4 * a - 2, 0); n2 = min(4 * a + 5, 31) - lo2 + 1;
        lo1 = max(16 * a - 2, 0); n1 = min(16 * a + 17, 127) - lo1 + 1;
        slope2 = __builtin_amdgcn_exp2f(-(float)(h + 1)) * LOG2E;
    }
    __device__ __forceinline__ const bf16_t* qptr(int n) const { return H0 + (long)(b * SEQ + 512 * a + r16 + 16 * n) * IN0 + 1536 + h * 128; }
    __device__ __forceinline__ bf16_t* optr(int qn) const { return O + (long)(b * SEQ + 512 * a + r16 + 16 * qn) * DM + 1024 + h * 128; }
    __device__ __forceinline__ int ntiles() const { return n3 + n2 + n1; }
    __device__ __forceinline__ void tile(int j, TI& ti) const {
        int dil, kt, rd;
        if (j < n3) { dil = 16; kt = lo3 + j; rd = r16; }
        else if (j < n3 + n2) { dil = 4; kt = lo2 + (j - n3); rd = r16 & 3; }
        else { dil = 1; kt = lo1 + (j - n3 - n2); rd = 0; }
        const long tok = (long)b * SEQ + dil * 32 * kt + rd;
        ti.k = H0 + tok * IN0 + 2560 + h * 128; ti.v = H0 + tok * IN0 + 3584 + h * 128; ti.rs = (long)dil * IN0;
        ti.kpos0 = 32 * kt; ti.iq = (512 * a + r16 + 16 * myn - rd) / dil; ti.cd = slope2 * (float)dil;
    }
    __device__ __forceinline__ float adj(const TI& ti, int kloc, float s) const {
        const int d = ti.kpos0 + kloc - ti.iq; const int ad = d < 0 ? -d : d;
        return ad <= 64 ? fmaf(s, 0.088388347648318440f * LOG2E, -ti.cd * (float)ad) : -INFINITY;
    }
};
struct PolC {
    struct TI { const bf16_t* k; const bf16_t* v; long rs; int kc0; int drow; };
    const bf16_t* H1; bf16_t* O; const float* tab; int b, h, r, a, r0, qc, c0;
    __device__ __forceinline__ void init(const bf16_t* H1_, bf16_t* O_, const float* rpb, float* tab_, int w, int lane) {
        H1 = H1_; O = O_; tab = tab_; b = w >> 10; h = (w >> 7) & 7; const int wu = w & 127; r = wu >> 1; a = wu & 1;
        r0 = min(max(r - 4, 0), 56); qc = 32 * a + (lane & 31); c0 = min(max(qc - 8, 0), 48);
        for (int idx = lane; idx < 480; idx += 64) { const int dr = idx >> 5, dc = idx & 31; tab_[idx] = dc < 31 ? rpb[h * 465 + dr * 31 + dc] * LOG2E : 0.f; }
        asm volatile("s_waitcnt vmcnt(0) lgkmcnt(0)" ::: "memory");
    }
    __device__ __forceinline__ const bf16_t* qptr(int n) const { return H1 + (long)(b * SEQ + 64 * r + 32 * a + n) * IN1P + h * 128; }
    __device__ __forceinline__ bf16_t* optr(int qn) const { return O + (long)(b * SEQ + 64 * r + 32 * a + qn) * DM + h * 128; }
    __device__ __forceinline__ int ntiles() const { return 16; }
    __device__ __forceinline__ void tile(int j, TI& ti) const {
        const int kr = r0 + (j >> 1), ch = j & 1; const long tok = (long)b * SEQ + 64 * kr + 32 * ch;
        ti.k = H1 + tok * IN1P + 1024 + h * 128; ti.v = H1 + tok * IN1P + 2048 + h * 128; ti.rs = IN1P; ti.kc0 = 32 * ch; ti.drow = kr - r + 7;
    }
    __device__ __forceinline__ float adj(const TI& ti, int kloc, float s) const {
        const int kc = ti.kc0 + kloc; const int dc = min(max(kc - qc + 15, 0), 30);
        const float bias = tab[ti.drow * 32 + dc];
        return (kc >= c0 && kc < c0 + 16) ? fmaf(s, 0.088388347648318440f * LOG2E, bias) : -INFINITY;
    }
};

struct Params { const float* in[28]; float* out; unsigned char* ws; int ph_lo, ph_hi; };
enum { I_X = 0, I_RW = 1, I_RB = 2, I_WIN0 = 3, I_AQN = 4, I_AKN = 5, I_WOUT0 = 6, I_LN1G0 = 7, I_LN1B0 = 8, I_WG0 = 9, I_WU0 = 10, I_WD0 = 11, I_LN2G0 = 12, I_LN2B0 = 13,
       I_WIN1 = 14, I_RPB = 15, I_DQN = 16, I_WQUP = 17, I_DKVN = 18, I_WKVUP = 19, I_WOUT1 = 20, I_LN1G1 = 21, I_LN1B1 = 22, I_WG1 = 23, I_WU1 = 24, I_WD1 = 25, I_LN2G1 = 26, I_LN2B1 = 27 };

__device__ __forceinline__ void tr_tile(const float* __restrict__ src, int N, const float* __restrict__ ksc, bf16_t* __restrict__ dst, int ldd, int k0, int n0, int drow0, LAS unsigned* tl, int tid) {
    const int c4 = (tid & 15) * 4;
#pragma unroll
    for (int i = 0; i < 2; ++i) {
        const int kp = (tid >> 4) + 32 * i;
        const float* s0 = src + (size_t)(k0 + 2 * kp) * N + n0 + c4;
        f32x4 a = *(const f32x4*)s0, b = *(const f32x4*)(s0 + N);
        if (ksc) { const float sa = ksc[k0 + 2 * kp], sb = ksc[k0 + 2 * kp + 1]; a *= sa; b *= sb; }
#pragma unroll
        for (int j = 0; j < 4; ++j) tl[(c4 + j) * 65 + kp] = cvtpk(a[j], b[j]);
    }
    __syncthreads();
    const int n = tid >> 3, seg = tid & 7;
    unsigned w[8];
#pragma unroll
    for (int q = 0; q < 8; ++q) w[q] = tl[n * 65 + seg * 8 + q];
    u32x4* d = (u32x4*)(dst + (size_t)(drow0 + n) * ldd + k0 + seg * 16);
    d[0] = (u32x4){w[0], w[1], w[2], w[3]}; d[1] = (u32x4){w[4], w[5], w[6], w[7]};
    __syncthreads();
}
__device__ __forceinline__ void tr_tile8(const float* __restrict__ src, int N, const float* __restrict__ ksc, float wscale, unsigned char* __restrict__ dst, int ldd, int k0, int n0, int drow0, LAS unsigned* tl, int tid) {
    const int c4 = (tid & 15) * 4, kq = tid >> 4;
    const float* s0 = src + (size_t)(k0 + 4 * kq) * N + n0 + c4;
    f32x4 a = *(const f32x4*)s0, b = *(const f32x4*)(s0 + N), c = *(const f32x4*)(s0 + 2 * (size_t)N), d = *(const f32x4*)(s0 + 3 * (size_t)N);
    float sa = wscale, sb = wscale, sc = wscale, sd = wscale;
    if (ksc) { sa *= ksc[k0 + 4 * kq]; sb *= ksc[k0 + 4 * kq + 1]; sc *= ksc[k0 + 4 * kq + 2]; sd *= ksc[k0 + 4 * kq + 3]; }
#pragma unroll
    for (int j = 0; j < 4; ++j) tl[(c4 + j) * 33 + kq] = pk4_fp8(a[j] * sa, b[j] * sb, c[j] * sc, d[j] * sd);
    __syncthreads();
    const int n = tid >> 3, seg = tid & 7;
    unsigned w[4];
#pragma unroll
    for (int q = 0; q < 4; ++q) w[q] = tl[n * 33 + seg * 4 + q];
    *(u32x4*)(dst + (size_t)(drow0 + n) * ldd + k0 + seg * 16) = (u32x4){w[0], w[1], w[2], w[3]};
    __syncthreads();
}
struct TJob { const float* src; bf16_t* dst; const float* ksc; int K, N, ldd, gu; size_t sbs, dbs; int f8; };
constexpr float W8_SCALE = 64.f;
constexpr int W8_SBYTE = 0x79797979;
__device__ __forceinline__ void run_tjob(const TJob& jb, int t, LAS unsigned* tl, int tid) {
    const int ntn = jb.N / 64, ntk = jb.K / 128, per = ntn * ntk;
    const int bi = t / per, r = t % per, tk = r / ntn, tn = r % ntn;
    const int n0 = tn * 64;
    const int drow0 = jb.gu ? (256 * (n0 >> 7) + (jb.gu == 2 ? 128 : 0) + (n0 & 127)) : n0;
    if (jb.f8) tr_tile8(jb.src + (size_t)bi * jb.sbs, jb.N, jb.ksc, W8_SCALE, (unsigned char*)jb.dst + (size_t)bi * jb.dbs, jb.ldd, tk * 128, n0, drow0, tl, tid);
    else tr_tile(jb.src + (size_t)bi * jb.sbs, jb.N, jb.ksc, jb.dst + (size_t)bi * jb.dbs, jb.ldd, tk * 128, n0, drow0, tl, tid);
}
typedef __attribute__((address_space(4))) const unsigned long long kcu64_t;
#define PIN(i) ((const float*)(__attribute__((address_space(1))) const float*)ka[i])
__device__ __forceinline__ void phase_prologue(kcu64_t* ka, unsigned char* ws, LAS unsigned char* lds, int G, int bid, int tid) {
    LAS unsigned* tl = (LAS unsigned*)lds;
    constexpr int NJ = 12;
    const int cnts[NJ] = {16 * 72, 16 * 32, 4096, 4096, 4096, 16 * 61, 16 * 32, 4096, 4096, 4096, 4 * 24, 2 * 32};
    int total = 0;
#pragma unroll
    for (int j = 0; j < NJ; ++j) total += cnts[j];
    for (int t = bid; t < total; t += G) {
        int j = 0, base = 0;
#pragma unroll
        for (int q = 0; q < NJ - 1; ++q) if (t >= base + cnts[q] && j == q) { base += cnts[q]; j = q + 1; }
        const int tt = t - base;
        TJob jb;
        switch (j) {
            case 0: jb = TJob{PIN(I_WIN0), (bf16_t*)(ws + WS_WIN0), nullptr, 2048, IN0, 2048, 0, 0, 0, F8_IN}; break;
            case 1: jb = TJob{PIN(I_WOUT0), (bf16_t*)(ws + WS_WOUT0), nullptr, 2048, 2048, 2048, 0, 0, 0, F8_OUT}; break;
            case 2: jb = TJob{PIN(I_WG0), (bf16_t*)(ws + WS_WGU0), nullptr, 2048, 512, 2048, 1, (size_t)2048 * 512, (size_t)1024 * 2048, F8_GU}; break;
            case 3: jb = TJob{PIN(I_WU0), (bf16_t*)(ws + WS_WGU0), nullptr, 2048, 512, 2048, 2, (size_t)2048 * 512, (size_t)1024 * 2048, F8_GU}; break;
            case 4: jb = TJob{PIN(I_WD0), (bf16_t*)(ws + WS_WD0), nullptr, 512, 2048, 512, 0, (size_t)512 * 2048, (size_t)2048 * 512, F8_DOWN}; break;
            case 5: jb = TJob{PIN(I_WIN1), (bf16_t*)(ws + WS_WIN1), nullptr, 2048, IN1, 2048, 0, 0, 0, F8_IN}; break;
            case 6: jb = TJob{PIN(I_WOUT1), (bf16_t*)(ws + WS_WOUT1), nullptr, 2048, 2048, 2048, 0, 0, 0, F8_OUT}; break;
            case 7: jb = TJob{PIN(I_WG1), (bf16_t*)(ws + WS_WGU1), nullptr, 2048, 512, 2048, 1, (size_t)2048 * 512, (size_t)1024 * 2048, F8_GU}; break;
            case 8: jb = TJob{PIN(I_WU1), (bf16_t*)(ws + WS_WGU1), nullptr, 2048, 512, 2048, 2, (size_t)2048 * 512, (size_t)1024 * 2048, F8_GU}; break;
            case 9: jb = TJob{PIN(I_WD1), (bf16_t*)(ws + WS_WD1), nullptr, 512, 2048, 512, 0, (size_t)512 * 2048, (size_t)2048 * 512, F8_DOWN}; break;
            case 10: jb = TJob{PIN(I_WQUP), (bf16_t*)(ws + WS_WQUP), PIN(I_DQN), 512, 1536, 512, 0, 0, 0, 0}; break;
            default: jb = TJob{PIN(I_WKVUP), (bf16_t*)(ws + WS_WKVUP), PIN(I_DKVN), 256, 2048, 256, 0, 0, 0, 0}; break;
        }
        run_tjob(jb, tt, tl, tid);
    }
    { constexpr size_t ESZ = F8_IN ? 1 : 2;
      u32x4* z = (u32x4*)(ws + WS_WIN1 + (size_t)IN1 * 2048 * ESZ); const size_t n16 = (size_t)(IN1P - IN1) * 2048 * ESZ / 16;
      const unsigned zu = __float_as_uint(fresh_zero());
      for (size_t i = (size_t)bid * NTHR + tid; i < n16; i += (size_t)G * NTHR) z[i] = (u32x4){zu, zu, zu, zu}; }
    { const f32x8* xs = (const f32x8*)PIN(I_X); const size_t n8 = (size_t)T_ * DM / 8;
      if constexpr (F8_IN) { u32x2* xd = (u32x2*)(ws + WS_RC + 64 * MiB);
          for (size_t i = (size_t)bid * NTHR + tid; i < n8; i += (size_t)G * NTHR) { const f32x8 v = xs[i]; xd[i] = (u32x2){pk4_fp8(v[0], v[1], v[2], v[3]), pk4_fp8(v[4], v[5], v[6], v[7])}; } }
      else { u32x4* xd = (u32x4*)(ws + WS_RA);
          for (size_t i = (size_t)bid * NTHR + tid; i < n8; i += (size_t)G * NTHR) { const f32x8 v = xs[i];
              xd[i] = (u32x4){cvtpk(v[0], v[1]), cvtpk(v[2], v[3]), cvtpk(v[4], v[5]), cvtpk(v[6], v[7])}; } } }
}

__device__ __forceinline__ void phase_prep_qk(bf16_t* H0, const float* qn, const float* kn, int G, int bid, int tid) {
    const int wid = tid >> 6, lane = tid & 63, i = lane & 31, half = lane >> 5;
    const float invf = inv_freq32(i);
    const int e0 = 64 * half + i, e1 = e0 + 32;
    const float gq0 = qn[e0], gq1 = qn[e1], gk0 = kn[e0], gk1 = kn[e1];
    for (int m = bid * 8 + wid; m < T_; m += G * 8) {
        const int s = m & (SEQ - 1); const int pos = half ? (s & 63) : (s >> 6);
        float sn, cs; sincos_rev((float)pos * invf, sn, cs);
        bf16_t* rowp = H0 + (size_t)m * IN0;
#pragma unroll
        for (int hh = 0; hh < 10; ++hh) {
            bf16_t* base = rowp + (hh < 8 ? hh * 128 : 1024 + (hh - 8) * 128);
            const float x0 = bf2f(base[e0]), x1 = bf2f(base[e1]);
            const float ss = wave_sum(x0 * x0 + x1 * x1);
            const float r = rsqrtf(ss * (1.0f / 128.0f) + 1e-6f);
            const float y0 = x0 * r * (hh < 8 ? gq0 : gk0), y1 = x1 * r * (hh < 8 ? gq1 : gk1);
            base[e0] = f2bf(y0 * cs - y1 * sn); base[e1] = f2bf(y1 * cs + y0 * sn);
        }
    }
}
__device__ __forceinline__ void phase_prep_mla(bf16_t* H1, bf16_t* krope, int G, int bid, int tid) {
    const int wid = tid >> 6, lane = tid & 63;
    const float invf = inv_freq32(lane & 31);
    for (int m = bid * 8 + wid; m < T_; m += G * 8) {
        bf16_t* rowp = H1 + (size_t)m * IN1P;
        const u32x4 a = *(const u32x4*)(rowp + 3072 + lane * 8);
        float ss = bflo(a.x) * bflo(a.x) + bfhi(a.x) * bfhi(a.x) + bflo(a.y) * bflo(a.y) + bfhi(a.y) * bfhi(a.y) + bflo(a.z) * bflo(a.z) + bfhi(a.z) * bfhi(a.z) + bflo(a.w) * bflo(a.w) + bfhi(a.w) * bfhi(a.w);
        ss = wave_sum(ss);
        const u32x2 c = *(const u32x2*)(rowp + 3584 + lane * 4);
        float s2 = bflo(c.x) * bflo(c.x) + bfhi(c.x) * bfhi(c.x) + bflo(c.y) * bflo(c.y) + bfhi(c.y) * bfhi(c.y);
        s2 = wave_sum(s2);
        const float rq = rsqrtf(ss * (1.0f / 512.0f) + 1e-6f), rkv = rsqrtf(s2 * (1.0f / 256.0f) + 1e-6f);
        *(u32x4*)(rowp + 3072 + lane * 8) = (u32x4){cvtpk(bflo(a.x) * rq, bfhi(a.x) * rq), cvtpk(bflo(a.y) * rq, bfhi(a.y) * rq), cvtpk(bflo(a.z) * rq, bfhi(a.z) * rq), cvtpk(bflo(a.w) * rq, bfhi(a.w) * rq)};
        *(u32x2*)(rowp + 3584 + lane * 4) = (u32x2){cvtpk(bflo(c.x) * rkv, bfhi(c.x) * rkv), cvtpk(bflo(c.y) * rkv, bfhi(c.y) * rkv)};
        if (lane < 32) { const float x1 = bf2f(rowp[3840 + lane]), x2 = bf2f(rowp[3840 + 32 + lane]);
            float sn, cs; sincos_rev((float)(m & (SEQ - 1)) * invf, sn, cs);
            krope[(size_t)m * 64 + lane] = f2bf(x1 * cs - x2 * sn); krope[(size_t)m * 64 + 32 + lane] = f2bf(x2 * cs + x1 * sn); }
    }
}

constexpr int LNR_PITCH = 2050;
constexpr int LNR_PART = 131328, LNR_SC = 147712, LNR_SEL = 149760, LNR_BLE = 151808, LNR_HIST = 152832;
__device__ __forceinline__ void phase_ln_router(const float* z, const float* g, const float* bb, const float* rw, const float* rb, bf16_t* x1b, unsigned char* x1q,
                                                int* tok_e, int* tok_p, float* tok_g, int* list, unsigned* cnt, LAS unsigned char* lds, int G, int bid, int tid) {
    const int wid = tid >> 6, lane = tid & 63;
    LAS float* xs = (LAS float*)lds; LAS float* part = (LAS float*)(lds + LNR_PART); LAS float* scs = (LAS float*)(lds + LNR_SC); LAS float* sels = (LAS float*)(lds + LNR_SEL);
    LAS int* ble = (LAS int*)(lds + LNR_BLE); LAS int* hist = (LAS int*)(lds + LNR_HIST);
    int ntl = 0;
    for (int it = 0; bid + G * it < T_ / 16; ++it) {
        const int tix = bid + G * it;
#pragma unroll 1
        for (int rr = 0; rr < 2; ++rr) {
            const int row = 2 * wid + rr; const size_t m = (size_t)tix * 16 + row;
            f32x4 v[8]; float s = 0.f;
#pragma unroll
            for (int i = 0; i < 8; ++i) { v[i] = *(const f32x4*)(z + m * DM + 4 * lane + 256 * i); s += (v[i][0] + v[i][1]) + (v[i][2] + v[i][3]); }
            const float mean = wave_sum(s) * (1.0f / DM); float q = 0.f;
#pragma unroll
            for (int i = 0; i < 8; ++i) { const f32x4 d = v[i] - mean; q += (d[0] * d[0] + d[1] * d[1]) + (d[2] * d[2] + d[3] * d[3]); }
            const float rstd = rsqrtf(wave_sum(q) * (1.0f / DM) + 1e-5f);
#pragma unroll
            for (int i = 0; i < 8; ++i) { const int col = 4 * lane + 256 * i; const f32x4 gv = *(const f32x4*)(g + col), bv = *(const f32x4*)(bb + col);
                const f32x4 y = (v[i] - mean) * rstd * gv + bv;
                LAS f32x2* xp = (LAS f32x2*)(xs + row * LNR_PITCH + col); xp[0] = (f32x2){y[0], y[1]}; xp[1] = (f32x2){y[2], y[3]};
                *(u32x2*)(x1b + m * DM + col) = (u32x2){cvtpk(y[0], y[1]), cvtpk(y[2], y[3])};
                if constexpr (F8_GU) *(unsigned*)(x1q + m * DM + col) = pk4_fp8(y[0], y[1], y[2], y[3]); }
        }
        __syncthreads();
        { f32x4 acc0 = {0.f, 0.f, 0.f, 0.f}, acc1 = {0.f, 0.f, 0.f, 0.f}; const int k0 = 256 * wid + (lane >> 4); const int e = lane & 15;
#pragma unroll 4
          for (int kk = 0; kk < 64; ++kk) { const int k = k0 + 4 * kk; const float a = xs[(lane & 15) * LNR_PITCH + k]; const float b0 = rw[k * 32 + e], b1 = rw[k * 32 + 16 + e];
              acc0 = __builtin_amdgcn_mfma_f32_16x16x4f32(a, b0, acc0, 0, 0, 0); acc1 = __builtin_amdgcn_mfma_f32_16x16x4f32(a, b1, acc1, 0, 0, 0); }
#pragma unroll
          for (int r = 0; r < 4; ++r) { const int row = (lane >> 4) * 4 + r; part[(wid * 16 + row) * 32 + e] = acc0[r]; part[(wid * 16 + row) * 32 + 16 + e] = acc1[r]; } }
        __syncthreads();
        { const int row = tid >> 5, e = tid & 31; float lg = 0.f;
#pragma unroll
          for (int w = 0; w < 8; ++w) lg += part[(w * 16 + row) * 32 + e];
          const float sc = 1.0f / (1.0f + __expf(-lg)); scs[row * 32 + e] = sc; sels[row * 32 + e] = sc + rb[e]; }
        __syncthreads();
        if (tid < 16) { const int row = tid; float best = -INFINITY; int bg = 0;
            for (int gI = 0; gI < 8; ++gI) { const float a = sels[row * 32 + 4 * gI], b = sels[row * 32 + 4 * gI + 1], c = sels[row * 32 + 4 * gI + 2], d = sels[row * 32 + 4 * gI + 3];
                const float h1 = fmaxf(a, b), l1 = fminf(a, b), h2 = fmaxf(c, d), l2 = fminf(c, d); const float gs = fmaxf(h1, h2) + fmaxf(fminf(h1, h2), fmaxf(l1, l2));
                if (gs > best) { best = gs; bg = gI; } }
            const float v0 = sels[row * 32 + 4 * bg], v1 = sels[row * 32 + 4 * bg + 1], v2 = sels[row * 32 + 4 * bg + 2], v3 = sels[row * 32 + 4 * bg + 3];
            int i1 = 0; float b1 = v0; if (v1 > b1) { b1 = v1; i1 = 1; } if (v2 > b1) { b1 = v2; i1 = 2; } if (v3 > b1) { b1 = v3; i1 = 3; }
            int i2 = -1; float b2 = -INFINITY;
            if (i1 != 0 && v0 > b2) { b2 = v0; i2 = 0; } if (i1 != 1 && v1 > b2) { b2 = v1; i2 = 1; } if (i1 != 2 && v2 > b2) { b2 = v2; i2 = 2; } if (i1 != 3 && v3 > b2) { b2 = v3; i2 = 3; }
            const int e1 = 4 * bg + i1, e2 = 4 * bg + i2; const float s1 = scs[row * 32 + e1], s2 = scs[row * 32 + e2]; const float inv = 1.0f / (s1 + s2);
            const size_t m = (size_t)tix * 16 + row;
            tok_e[2 * m] = e1; tok_e[2 * m + 1] = e2; tok_g[2 * m] = s1 * inv; tok_g[2 * m + 1] = s2 * inv;
            ble[(it * 16 + row) * 2] = e1; ble[(it * 16 + row) * 2 + 1] = e2; }
        __syncthreads();
        ntl = it + 1;
    }
    const int nasg = ntl * 32;
    if (tid < 32) { int c = 0; for (int i = 0; i < nasg; ++i) c += (ble[i] == tid) ? 1 : 0;
        unsigned base = 0; if (c) base = __hip_atomic_fetch_add(cnt + tid, (unsigned)c, __ATOMIC_RELAXED, __HIP_MEMORY_SCOPE_AGENT);
        hist[tid] = (int)base; }
    __syncthreads();
    if (tid < 32) { int run = hist[tid];
        for (int i = 0; i < nasg; ++i) if (ble[i] == tid) { const int tr = i >> 1; const size_t m = (size_t)(bid + G * (tr >> 4)) * 16 + (tr & 15);
            list[(size_t)tid * 65536 + run] = (int)m; tok_p[2 * m + (i & 1)] = run; ++run; } }
    __syncthreads();
}

constexpr int MOE_LDS = 131072;
__device__ __forceinline__ int moe_prefix(const unsigned* cnt, LAS int* pblk, int tid) {
    if (tid == 0) { int acc = 0; for (int e = 0; e < NE; ++e) { pblk[e] = acc; acc += ((int)cnt[e] + 255) >> 8; } pblk[NE] = acc; }
    __syncthreads();
    return pblk[NE];
}
template <int NJ> __device__ __forceinline__ int moe_table(const unsigned* cnt, LAS int* pblk, LAS int* tab, LAS int* aux, int NB, int G, int bid, int tid) {
    const int NU = NB * NJ;
    if (tid < 16) { const int L = bid + G * tid;
        if (L < NU) { const int rb = L / NJ, j = L % NJ; int e = 0; for (int q = 1; q < NE; ++q) if (pblk[q] <= rb) e = q;
            tab[tid] = rb; tab[16 + tid] = NJ * e + j; aux[tid * 3] = e; aux[tid * 3 + 1] = (rb - pblk[e]) * 256; aux[tid * 3 + 2] = (int)cnt[e]; } }
    __syncthreads();
    int n = 0; for (int i = 0; i < 16; ++i) if (bid + G * i < NU) n = i + 1;
    return n;
}

template <bool FINAL>
__device__ __forceinline__ void phase_combine_ln(const bf16_t* x1b, const bf16_t* Yr, const int* tok_e, const int* tok_p, const float* tok_g, const unsigned* cnt,
                                                 const float* g, const float* bb, bf16_t* xo, unsigned char* xq, float* fo, LAS unsigned char* lds, int G, int bid, int tid) {
    LAS int* pblk = (LAS int*)lds;
    moe_prefix(cnt, pblk, tid);
    const int wid = tid >> 6, lane = tid & 63;
    for (int m = bid * 8 + wid; m < T_; m += G * 8) {
        const int e0 = tok_e[2 * m], e1 = tok_e[2 * m + 1];
        const size_t p0 = (size_t)pblk[e0] * 256 + tok_p[2 * m], p1 = (size_t)pblk[e1] * 256 + tok_p[2 * m + 1];
        const float g0 = tok_g[2 * m], g1 = tok_g[2 * m + 1];
        float v[32]; float s = 0.f;
#pragma unroll
        for (int i = 0; i < 4; ++i) { const int col = 8 * lane + 512 * i;
            const u32x4 xa = *(const u32x4*)(x1b + (size_t)m * DM + col), ya = *(const u32x4*)(Yr + p0 * DM + col), yb = *(const u32x4*)(Yr + p1 * DM + col);
            const unsigned xw[4] = {xa.x, xa.y, xa.z, xa.w}, aw[4] = {ya.x, ya.y, ya.z, ya.w}, bw[4] = {yb.x, yb.y, yb.z, yb.w};
#pragma unroll
            for (int j = 0; j < 4; ++j) { v[i * 8 + 2 * j] = ALPHA * bflo(xw[j]) + g0 * bflo(aw[j]) + g1 * bflo(bw[j]); v[i * 8 + 2 * j + 1] = ALPHA * bfhi(xw[j]) + g0 * bfhi(aw[j]) + g1 * bfhi(bw[j]);
                s += v[i * 8 + 2 * j] + v[i * 8 + 2 * j + 1]; } }
        const float mean = wave_sum(s) * (1.0f / DM); float q = 0.f;
#pragma unroll
        for (int i = 0; i < 32; ++i) { const float d = v[i] - mean; q += d * d; }
        const float rstd = rsqrtf(wave_sum(q) * (1.0f / DM) + 1e-5f);
#pragma unroll
        for (int i = 0; i < 4; ++i) { const int col = 8 * lane + 512 * i;
            const f32x4 ga = *(const f32x4*)(g + col), gb = *(const f32x4*)(g + col + 4), ba = *(const f32x4*)(bb + col), bbv = *(const f32x4*)(bb + col + 4);
            float y[8];
#pragma unroll
            for (int j = 0; j < 4; ++j) { y[j] = (v[i * 8 + j] - mean) * rstd * ga[j] + ba[j]; y[4 + j] = (v[i * 8 + 4 + j] - mean) * rstd * gb[j] + bbv[j]; }
            if constexpr (FINAL) { *(f32x4*)(fo + (size_t)m * DM + col) = (f32x4){y[0], y[1], y[2], y[3]}; *(f32x4*)(fo + (size_t)m * DM + col + 4) = (f32x4){y[4], y[5], y[6], y[7]}; }
            else { *(u32x4*)(xo + (size_t)m * DM + col) = (u32x4){cvtpk(y[0], y[1]), cvtpk(y[2], y[3]), cvtpk(y[4], y[5]), cvtpk(y[6], y[7])};
                if constexpr (F8_IN) *(u32x2*)(xq + (size_t)m * DM + col) = (u32x2){pk4_fp8(y[0], y[1], y[2], y[3]), pk4_fp8(y[4], y[5], y[6], y[7])}; } }
    }
}

#ifndef ATT_ONLY
#define ATT_ONLY -1
#endif
#ifndef REP_K
#define REP_K -1
#endif
#ifndef REP_ATT
#define REP_ATT -1
#endif
#define NREP(k) ((REP_K == (k)) ? 2 : 1)
#define NREPA(k) ((REP_ATT == (k)) ? 2 : 1)
constexpr int N_PHASES = 20;
__global__ void __launch_bounds__(NTHR, 2) fwd(Params p) {
    extern __shared__ __attribute__((aligned(16))) unsigned char lds_raw[];
    LAS unsigned char* lds = (LAS unsigned char*)lds_raw;
    const int tid0 = threadIdx.x, bid = blockIdx.x, G = gridDim.x;
    const int wv = __builtin_amdgcn_readfirstlane(tid0 >> 6);
    const int vcu = (G % 8 == 0) ? (bid % 8) * (G / 8) + bid / 8 : bid;
    unsigned* ctl = (unsigned*)(p.ws + WS_CTL);
    if (tid0 < 4) ((LAS unsigned*)(lds + MISC_OFF))[tid0] = 0u;
    __syncthreads();
    XcdBarrier bar; bar.bar = ctl + CW_BAR; bar.x = 0; bar.st = (volatile LAS unsigned*)(lds + MISC_OFF);
    if (N_LAUNCH_MODE == 1) bar = xcd_barrier_post(ctl + CW_BAR, (volatile LAS unsigned*)(lds + MISC_OFF));
    const int lo = p.ph_lo, hi = p.ph_hi;
#ifndef PH_ONLY
#define PH_ONLY -1
#endif
#define IN(k) ((PH_ONLY < 0 || (PH_ONLY % 10) == ((k) % 10)) && lo <= (k) && (k) < hi)
#define SEAM(k) do { if ((k) + 1 < hi) xcd_barrier(bar); } while (0)

    for (int L = 0; L < 2; ++L) {
        const int pb = L * 10;
        typedef __attribute__((address_space(1))) unsigned char gu8;
        typedef __attribute__((address_space(1))) const float gcf;
        typedef __attribute__((address_space(4))) const unsigned long long kcu64;
#define INP(i) ((const float*)(gcf*)ka[i])
#define PHASE_PTRS \
        kcu64* ka = (kcu64*)__builtin_amdgcn_kernarg_segment_ptr(); asm volatile("" : "+s"(ka)); \
        unsigned char* ws = (unsigned char*)(gu8*)ka[29]; unsigned char* outb = (unsigned char*)(gu8*)ka[28]; \
        unsigned* ctl = (unsigned*)(ws + WS_CTL); \
        bf16_t* RA = (bf16_t*)(ws + WS_RA); bf16_t* RB = (bf16_t*)(ws + WS_RB); bf16_t* RC = (bf16_t*)(ws + WS_RC); \
        int* list = (int*)(ws + WS_LIST); int* tok_e = (int*)(ws + WS_TOKE); int* tok_p = (int*)(ws + WS_TOKP); float* tok_g = (float*)(ws + WS_TOKG); \
        bf16_t* krope = (bf16_t*)(ws + WS_KROPE); \
        bf16_t* Qd = (bf16_t*)(outb + OUT_QD); bf16_t* O1 = (bf16_t*)(outb + OUT_O1); \
        const bf16_t* Win = (const bf16_t*)(ws + (L ? WS_WIN1 : WS_WIN0)); const bf16_t* Wout = (const bf16_t*)(ws + (L ? WS_WOUT1 : WS_WOUT0)); \
        const bf16_t* Wgu = (const bf16_t*)(ws + (L ? WS_WGU1 : WS_WGU0)); const bf16_t* Wd = (const bf16_t*)(ws + (L ? WS_WD1 : WS_WD0)); \
        const int NIN = L ? IN1P : IN0; \
        const bf16_t* xin = L ? RC : RA; \
        bf16_t* Hx = RB; bf16_t* Oat = L ? O1 : RC; float* Z = (float*)RB; \
        bf16_t* x1b = RA; bf16_t* Hm = RC; bf16_t* Yr = RB; \
        unsigned* cnt = ctl + CW_CNT + L * 64; \
        (void)ctl; (void)RA; (void)RB; (void)RC; (void)list; (void)tok_e; (void)tok_p; (void)tok_g; (void)krope; (void)Qd; (void)O1; (void)Win; (void)Wout; (void)Wgu; (void)Wd; (void)NIN; (void)xin; (void)Hx; (void)Oat; (void)Z; (void)x1b; (void)Hm; (void)Yr; (void)cnt; (void)outb

        if (L == 0 && IN(0)) { PHASE_PTRS; _Pragma("unroll 1") for (int rep = 0; rep < NREP(0); ++rep) phase_prologue(ka, ws, lds, G, bid, fresh_tid(wv)); SEAM(0); }

        if (IN(pb + 1)) {
            PHASE_PTRS;
            constexpr int KI = F8_IN ? 1024 : 2048;
            const bf16_t* ain = F8_IN ? (L ? (const bf16_t*)outb : (const bf16_t*)((unsigned char*)RC + 64 * MiB)) : xin;
            pg8::Gemm g{ain, Win, KI, KI, KI}; pg8::StaticOrder S; S.init(T_, NIN, G, bid, KI);
            pg8::EpiBf16 E{Hx, NIN, 0xffff};
            _Pragma("unroll 1") for (int rep = 0; rep < NREP(1); ++rep) pg8::gemm_phase<F8_IN != 0>(wv, lds, g, S, E, W8_SBYTE, 0x7f7f7f7f);
            SEAM(pb + 1);
        }
        if (IN(pb + 2)) {
            PHASE_PTRS;
            if (L == 0) phase_prep_qk(Hx, INP(I_AQN), INP(I_AKN), G, bid, fresh_tid(wv));
            else phase_prep_mla(Hx, krope, G, bid, fresh_tid(wv));
            SEAM(pb + 2);
        }
        if (L == 1 && IN(pb + 3)) _Pragma("unroll 1") for (int rep = 0; rep < NREP(3); ++rep) {
            PHASE_PTRS;
#ifndef P3_ONLY
#define P3_ONLY -1
#endif
            if (P3_ONLY < 0 || P3_ONLY == 0) { pg8::Gemm g{Hx + 3072, (const bf16_t*)(ws + WS_WQUP), 512, IN1P, 512}; pg8::StaticOrder S; S.init(T_, 1536, G, bid, IN1P);
              pg8::EpiBf16 E{Qd, 1536, 0xffff}; pg8::gemm_phase<false>(wv, lds, g, S, E); }
            if (P3_ONLY < 0 || P3_ONLY == 1) { pg8::Gemm g{Hx + 3584, (const bf16_t*)(ws + WS_WKVUP), 256, IN1P, 256}; pg8::StaticOrder S; S.init(T_, 2048, G, bid, IN1P);
              pg8::EpiBf16 E{RA, 2048, 0xffff}; pg8::gemm_phase<false>(wv, lds, g, S, E); }
            if (rep + 1 == NREP(3)) SEAM(pb + 3);
        }
        if (IN(pb + 4)) {
            PHASE_PTRS;
            if (L == 0) {
                if (ATT_ONLY < 0 || ATT_ONLY == 0)
                _Pragma("unroll 1") for (int rep = 0; rep < NREPA(0); ++rep)
                for (int u = vcu; u < 1024; u += G) {
                    __syncthreads();
                    const int b = u >> 7, qb = u & 15, kvh = (u >> 6) & 1, gq = (u >> 4) & 3, h = kvh * 4 + gq;
                    da::DArgs a; a.Q = Hx + (size_t)(b * SEQ + 256 * qb) * IN0 + h * 128; a.ldq = IN0;
                    a.K = Hx + (size_t)b * SEQ * IN0 + 1024 + kvh * 128; a.ldk = IN0; a.V = Hx + (size_t)b * SEQ * IN0 + 1280 + kvh * 128; a.ldv = IN0; a.Kr = nullptr;
                    a.O = Oat + (size_t)(b * SEQ + 256 * qb) * DM + h * 128; a.ldo = DM; a.seq = SEQ; a.pos0 = 0;
                    da::attn_dense_body<8, 1>(wv, a, (char*)lds_raw);
                }
                __syncthreads();
                if (ATT_ONLY < 0 || ATT_ONLY == 2)
                _Pragma("unroll 1") for (int rep = 0; rep < NREPA(2); ++rep)
                for (int it = vcu; it < 1024; it += G) {
                    const int tid2 = fresh_tid(wv), wid = __builtin_amdgcn_readfirstlane(tid2 >> 6), lane = tid2 & 63;
                    const int w = it * 8 + wid; LAS unsigned char* wl = lds + wid * da::SP_WAVE_LDS;
                    PolB pol; pol.init(Hx, Oat, w, lane); da::sparse_wave(pol, wl, lane);
                }
            } else {
                if (ATT_ONLY < 0 || ATT_ONLY == 1)
                _Pragma("unroll 1") for (int rep = 0; rep < NREPA(1); ++rep)
                for (int u = vcu; u < 1024; u += G) {
                    __syncthreads();
                    const int b = u >> 7, qb = u & 15, h = (u >> 4) & 7;
                    da::DArgs a; a.Q = Qd + (size_t)(b * SEQ + 256 * qb) * 1536 + h * 192; a.ldq = 1536;
                    a.K = RA + (size_t)b * SEQ * DM + h * 256; a.ldk = DM; a.V = a.K + 128; a.ldv = DM; a.Kr = krope + (size_t)b * SEQ * 64;
                    a.O = Oat + (size_t)(b * SEQ + 256 * qb) * DM + 1024 + h * 128; a.ldo = DM; a.seq = SEQ; a.pos0 = 256 * qb;
                    da::attn_dense_body<12, 1>(wv, a, (char*)lds_raw);
                }
                __syncthreads();
                if (ATT_ONLY < 0 || ATT_ONLY == 3)
                _Pragma("unroll 1") for (int rep = 0; rep < NREPA(3); ++rep)
                for (int it = vcu; it < 1024; it += G) {
                    const int tid2 = fresh_tid(wv), wid = __builtin_amdgcn_readfirstlane(tid2 >> 6), lane = tid2 & 63;
                    const int w = it * 8 + wid; LAS unsigned char* wl = lds + wid * da::SP_WAVE_LDS;
                    PolC pol; pol.init(Hx, Oat, INP(I_RPB), (float*)((char*)wl + 16640), w, lane); da::sparse_wave(pol, wl, lane);
                }
            }
            SEAM(pb + 4);
        }
        if (IN(pb + 5)) {
            PHASE_PTRS;
            pg8::Gemm g{Oat, Wout, 2048, 2048, 2048}; pg8::StaticOrder S; S.init(T_, DM, G, bid, 2048);
            if (L == 0) { pg8::EpiResF32<true> E{Z, INP(I_X)}; _Pragma("unroll 1") for (int rep = 0; rep < NREP(5); ++rep) pg8::gemm_phase<false>(wv, lds, g, S, E); }
            else { pg8::EpiResF32<false> E{Z, RC}; _Pragma("unroll 1") for (int rep = 0; rep < NREP(5); ++rep) pg8::gemm_phase<false>(wv, lds, g, S, E); }
            SEAM(pb + 5);
        }
        if (IN(pb + 6)) {
            PHASE_PTRS;
            phase_ln_router(Z, INP(L ? I_LN1G1 : I_LN1G0), INP(L ? I_LN1B1 : I_LN1B0), INP(I_RW), INP(I_RB), x1b, (unsigned char*)RC + 64 * MiB, tok_e, tok_p, tok_g, list, cnt, lds, G, bid, fresh_tid(wv));
            SEAM(pb + 6);
        }
        if (IN(pb + 7)) {
            PHASE_PTRS;
            LAS int* pblk = (LAS int*)(lds + MOE_LDS); LAS int* tab = pblk + 64; LAS int* aux = tab + 32; LAS int* idx = aux + 64;
            const int tid = fresh_tid(wv);
            const int NB = moe_prefix(cnt, pblk, tid);
            const int n = moe_table<4>(cnt, pblk, tab, aux, NB, G, bid, tid);
            for (int i = 0; i < n; ++i) if (tid < 256) { const int e = aux[i * 3], rs = aux[i * 3 + 1], ce = aux[i * 3 + 2]; idx[i * 256 + tid] = list[(size_t)e * 65536 + min(rs + tid, ce - 1)]; }
            __syncthreads();
            constexpr int KG = F8_GU ? 1024 : 2048;
            const bf16_t* agu = F8_GU ? (const bf16_t*)((unsigned char*)RC + 64 * MiB) : x1b;
            pg8::Gemm g{agu, Wgu, KG, KG, KG}; pg8::TableOrder<true> S{tab, idx, n, KG}; pg8::EpiSiluMul<F8_DOWN != 0> E{Hm};
            _Pragma("unroll 1") for (int rep = 0; rep < NREP(7); ++rep) pg8::gemm_phase<F8_GU != 0>(wv, lds, g, S, E, W8_SBYTE, 0x7f7f7f7f);
            SEAM(pb + 7);
        }
        if (IN(pb + 8)) {
            PHASE_PTRS;
            LAS int* pblk = (LAS int*)(lds + MOE_LDS); LAS int* tab = pblk + 64; LAS int* aux = tab + 32;
            const int tid = fresh_tid(wv);
            const int NB = moe_prefix(cnt, pblk, tid);
            const int n = moe_table<8>(cnt, pblk, tab, aux, NB, G, bid, tid);
            constexpr int KD = F8_DOWN ? 256 : 512;
            pg8::Gemm g{Hm, Wd, KD, KD, KD}; pg8::TableOrder<false> S{tab, nullptr, n, KD}; pg8::EpiBf16 E{Yr, DM, 7};
            _Pragma("unroll 1") for (int rep = 0; rep < NREP(8); ++rep) pg8::gemm_phase<F8_DOWN != 0>(wv, lds, g, S, E, W8_SBYTE, 0x7f7f7f7f);
            SEAM(pb + 8);
        }
        if (IN(pb + 9)) _Pragma("unroll 1") for (int rep = 0; rep < NREP(9); ++rep) {
            PHASE_PTRS;
            if (L == 0) phase_combine_ln<false>(x1b, Yr, tok_e, tok_p, tok_g, cnt, INP(I_LN2G0), INP(I_LN2B0), RC, outb, nullptr, lds, G, bid, fresh_tid(wv));
            else phase_combine_ln<true>(x1b, Yr, tok_e, tok_p, tok_g, cnt, INP(I_LN2G1), INP(I_LN2B1), nullptr, nullptr, (float*)outb, lds, G, bid, fresh_tid(wv));
            if (rep + 1 == NREP(9)) SEAM(pb + 9);
        }
    }
#undef IN
#undef SEAM
#undef INP
#undef PHASE_PTRS
}

extern "C" void kernel_launch(void* const* d_in, const int* in_sizes, int n_in, void* d_out, int out_size, void* d_ws, size_t ws_size, hipStream_t stream) {
    static int grid = 0;
    if (grid == 0) {
        if (n_in != 28 || out_size != T_ * DM || ws_size < WS_END) { fprintf(stderr, "kernel_launch: unexpected shapes: n_in %d out %d ws %zu (need %zu)\n", n_in, out_size, ws_size, (size_t)WS_END); grid = -1; return; }
        int dev = 0, cus = 0, per_cu = 0;
        if (hipGetDevice(&dev) != hipSuccess || hipDeviceGetAttribute(&cus, hipDeviceAttributeMultiprocessorCount, dev) != hipSuccess) { grid = -1; return; }
        if (hipFuncSetAttribute((const void*)fwd, hipFuncAttributeMaxDynamicSharedMemorySize, LDS_BYTES) != hipSuccess) { fprintf(stderr, "kernel_launch: hipFuncSetAttribute failed\n"); grid = -1; return; }
        if (hipOccupancyMaxActiveBlocksPerMultiprocessor(&per_cu, (const void*)fwd, NTHR, LDS_BYTES) != hipSuccess || per_cu < 1)
            fprintf(stderr, "kernel_launch: occupancy query reports %d workgroups per CU\n", per_cu);
        (void)hipGetLastError();
        grid = cus;
    }
    if (grid < 0) return;
    (void)hipMemsetAsync((char*)d_ws + WS_CTL, 0, CTL_ZERO_BYTES, stream);
    Params p{};
    for (int i = 0; i < 28; ++i) p.in[i] = (const float*)d_in[i];
    p.out = (float*)d_out; p.ws = (unsigned char*)d_ws;
#if N_LAUNCH_MODE == 1
    p.ph_lo = 0; p.ph_hi = N_PHASES;
    hipLaunchKernelGGL(fwd, dim3(grid), dim3(NTHR), LDS_BYTES, stream, p);
#else
    for (int k = 0; k < N_PHASES; ++k) { if (k == 3 || k == 10) continue; p.ph_lo = k; p.ph_hi = k + 1;
        hipLaunchKernelGGL(fwd, dim3(grid), dim3(NTHR), LDS_BYTES, stream, p); }
#endif
    const hipError_t le = hipPeekAtLastError();
    if (le != hipSuccess) fprintf(stderr, "kernel_launch: launch failed: %s\n", hipGetErrorName(le));
}
```

```cpp
#include <hip/hip_runtime.h>
#include <cstdio>
#include <cstdint>

#ifndef N_LAUNCH_MODE
#define N_LAUNCH_MODE 1
#endif
#ifndef DBG_CHECK
#define DBG_CHECK 0
#endif
#ifndef F8_DOWN
#define F8_DOWN 1
#endif
#ifndef F8_GU
#define F8_GU 1
#endif
#ifndef F8_IN
#define F8_IN 1
#endif
#ifndef F8_OUT
#define F8_OUT 1
#endif

#define LAS __attribute__((address_space(3)))
typedef unsigned short bf16_t;
typedef short bf16x8 __attribute__((ext_vector_type(8)));
typedef short s16x4 __attribute__((ext_vector_type(4)));
typedef float f32x2 __attribute__((ext_vector_type(2)));
typedef float f32x4 __attribute__((ext_vector_type(4)));
typedef float f32x8 __attribute__((ext_vector_type(8)));
typedef float f32x16 __attribute__((ext_vector_type(16)));
typedef unsigned u32x2 __attribute__((ext_vector_type(2)));
typedef unsigned u32x4 __attribute__((ext_vector_type(4)));
typedef int i32x8 __attribute__((ext_vector_type(8)));
typedef int i32x4 __attribute__((ext_vector_type(4)));

constexpr int T_ = 32768, DM = 2048, SEQ = 4096, NBATCH = 8;
constexpr int IN0 = 4608, IN1 = 3904, IN1P = 4096;
constexpr int NE = 32, DE = 512, MAXBLK = 288;
constexpr float ALPHA = 1.4142135623730951f;
constexpr float LOG2E = 1.4426950408889634f;
constexpr int NTHR = 512;

constexpr size_t MiB = 1u << 20;
constexpr size_t WS_CTL = 0, CTL_ZERO_BYTES = 1 * MiB;
constexpr size_t WS_LIST = 1 * MiB;
constexpr size_t WS_TOKE = 9 * MiB;
constexpr size_t WS_TOKP = WS_TOKE + 256 * 1024;
constexpr size_t WS_TOKG = WS_TOKP + 256 * 1024;
constexpr size_t WS_RSTAT = WS_TOKG + 256 * 1024;
constexpr size_t WS_KROPE = 10 * MiB;
constexpr size_t WS_WIN0 = 16 * MiB, WS_WOUT0 = 34 * MiB, WS_WGU0 = 42 * MiB, WS_WD0 = 170 * MiB;
constexpr size_t WS_WIN1 = 234 * MiB, WS_WOUT1 = 250 * MiB, WS_WGU1 = 258 * MiB, WS_WD1 = 386 * MiB;
constexpr size_t WS_WQUP = 450 * MiB, WS_WKVUP = 452 * MiB;
constexpr size_t WS_RA = 454 * MiB, WS_RB = 582 * MiB, WS_RC = 870 * MiB, WS_END = 998 * MiB;
constexpr size_t OUT_QD = 0, OUT_O1 = 96 * MiB;
constexpr int CW_CNT = 64;
constexpr int CW_DBG = 512;
constexpr int CW_BAR = 4096;

constexpr int LDS_BYTES = 155648;
constexpr int MISC_OFF = LDS_BYTES - 64;

__device__ __forceinline__ unsigned cvtpk(float lo, float hi) { unsigned r; asm volatile("v_cvt_pk_bf16_f32 %0, %1, %2" : "=v"(r) : "v"(lo), "v"(hi)); return r; }
__device__ __forceinline__ float bf2f(unsigned short b) { return __uint_as_float(((unsigned)b) << 16); }
__device__ __forceinline__ float bflo(unsigned w) { return __uint_as_float(w << 16); }
__device__ __forceinline__ float bfhi(unsigned w) { return __uint_as_float(w & 0xffff0000u); }
__device__ __forceinline__ bf16_t f2bf(float f) { return (bf16_t)(cvtpk(f, f) & 0xffffu); }
__device__ __forceinline__ unsigned pk4_fp8(float a, float b, float c, float d) { int w = 0; w = __builtin_amdgcn_cvt_pk_fp8_f32(a, b, w, false); w = __builtin_amdgcn_cvt_pk_fp8_f32(c, d, w, true); return (unsigned)w; }
constexpr float O8_SCALE = 16.f;
__device__ __forceinline__ unsigned char f2fp8(float v) { return (unsigned char)(__builtin_amdgcn_cvt_pk_fp8_f32(v, v, 0, false) & 0xff); }
__device__ __forceinline__ float clamp8(float v) { return fminf(fmaxf(v, -400.f), 400.f); }
__device__ __forceinline__ int fresh_tid(int wv) { int l; asm volatile("v_mbcnt_lo_u32_b32 %0, -1, 0\n\tv_mbcnt_hi_u32_b32 %0, -1, %0" : "=v"(l)); return wv * 64 + l; }
__device__ __forceinline__ float fresh_zero() { float z; asm volatile("v_mov_b32 %0, 0" : "=v"(z)); return z; }
__device__ __forceinline__ float wave_sum(float v) {
    v += __int_as_float(__builtin_amdgcn_ds_swizzle(__float_as_int(v), (1 << 10) | 0x1f));
    v += __int_as_float(__builtin_amdgcn_ds_swizzle(__float_as_int(v), (2 << 10) | 0x1f));
    v += __int_as_float(__builtin_amdgcn_ds_swizzle(__float_as_int(v), (4 << 10) | 0x1f));
    v += __int_as_float(__builtin_amdgcn_ds_swizzle(__float_as_int(v), (8 << 10) | 0x1f));
    v += __int_as_float(__builtin_amdgcn_ds_swizzle(__float_as_int(v), (16 << 10) | 0x1f));
    auto rr = __builtin_amdgcn_permlane32_swap(__float_as_uint(v), __float_as_uint(v), false, false);
    return __uint_as_float(rr[0]) + __uint_as_float(rr[1]);
}
__device__ __forceinline__ float inv_freq32(int i) { return __builtin_amdgcn_exp2f(-(float)i * 0.41524101186092029f); }
__device__ __forceinline__ void sincos_rev(float angle, float& s, float& c) {
    float rev = angle * 0.15915494309189535f; rev = rev - floorf(rev);
    s = __builtin_amdgcn_sinf(rev); c = __builtin_amdgcn_cosf(rev);
}

#define XB_TMO      128
#define XB_XCNT(j)  (256  + 64 * (j))
#define XB_XSUB(j)  (1280 + 64 * (j))
#define XB_XGEN(j)  (2304 + 64 * (j))
#define XB_TOP      3328
#define XB_TOPGEN   3392
#define XCD_BAR_WORDS 3456
#define XB_SPIN_CAP (1u << 20)
__device__ __forceinline__ unsigned xb_ld(unsigned* p)              { return __hip_atomic_load(p, __ATOMIC_RELAXED, __HIP_MEMORY_SCOPE_AGENT); }
__device__ __forceinline__ unsigned xb_add(unsigned* p, unsigned v) { return __hip_atomic_fetch_add(p, v, __ATOMIC_RELAXED, __HIP_MEMORY_SCOPE_AGENT); }
__device__ __forceinline__ unsigned xb_xcc_id() { return (unsigned)__builtin_amdgcn_s_getreg((3 << 11) | 20) & 0xFu; }
#define XB_SPIN(cond, bar) do { unsigned _sp = 0; while (cond) { __builtin_amdgcn_s_sleep(1); \
    if ((++_sp & 255u) == 0u) { if (xb_ld(&(bar)[XB_TMO])) break; if (_sp > XB_SPIN_CAP) { atomicAdd(&(bar)[XB_TMO], 1u); break; } } } } while (0)
struct XcdBarrier { unsigned* bar; unsigned x; volatile LAS unsigned* st; };
__device__ __forceinline__ XcdBarrier xcd_barrier_post(unsigned* bar, volatile LAS unsigned* st) {
    XcdBarrier b; b.bar = bar; b.x = xb_xcc_id(); b.st = st;
    if (threadIdx.x == 0) (void)xb_add(&bar[XB_XCNT(b.x)], 1u);
    return b;
}
__device__ __forceinline__ void xcd_barrier_complete(unsigned* bar, unsigned x, unsigned& nloc, unsigned& nx) {
    const unsigned G = gridDim.x * gridDim.y * gridDim.z;
    unsigned sum, cnt, mine, sp = 0u;
    for (;;) {
        sum = 0u; cnt = 0u; mine = 0u;
#pragma unroll
        for (unsigned j = 0; j < 16; ++j) { const unsigned c = xb_ld(&bar[XB_XCNT(j)]); sum += c; cnt += (c > 0u) ? 1u : 0u; mine = (j == x) ? c : mine; }
        if (sum == G) break;
        __builtin_amdgcn_s_sleep(1);
        if ((++sp & 255u) == 0u) { if (xb_ld(&bar[XB_TMO])) break; if (sp > XB_SPIN_CAP) { atomicAdd(&bar[XB_TMO], 1u); break; } }
    }
    nloc = mine > 0u ? mine : 1u; nx = cnt > 0u ? cnt : 1u;
}
__device__ __forceinline__ void xcd_barrier(const XcdBarrier& b) {
    asm volatile("s_waitcnt vmcnt(0)" ::: "memory");
    __syncthreads();
    if (threadIdx.x == 0) {
        unsigned* bar = b.bar;
        __builtin_amdgcn_s_waitcnt(0);
        unsigned nloc = b.st[0], nx = b.st[1];
        if (nloc == 0u) { xcd_barrier_complete(bar, b.x, nloc, nx); b.st[0] = nloc; b.st[1] = nx; }
        const unsigned old = xb_add(&bar[XB_XSUB(b.x)], 1u);
        const unsigned gen = old / nloc;
        if (old + 1u == (gen + 1u) * nloc) {
            __builtin_amdgcn_fence(__ATOMIC_RELEASE, "agent");
            asm volatile("s_waitcnt vmcnt(0)" ::: "memory");
            const unsigned og = xb_add(&bar[XB_TOP], 1u);
            const unsigned tg = og / nx;
            if (og + 1u == (tg + 1u) * nx) xb_add(&bar[XB_TOPGEN], 1u);
            else XB_SPIN(xb_ld(&bar[XB_TOPGEN]) == tg, bar);
            __builtin_amdgcn_fence(__ATOMIC_ACQUIRE, "agent");
            xb_add(&bar[XB_XGEN(b.x)], 1u);
            asm volatile("s_waitcnt vmcnt(0)" ::: "memory");
        } else {
            XB_SPIN(xb_ld(&bar[XB_XGEN(b.x)]) == gen, bar);
            __builtin_amdgcn_fence(__ATOMIC_ACQUIRE, "agent");
            asm volatile("s_waitcnt vmcnt(0)" ::: "memory");
        }
    }
    __syncthreads();
}

namespace pg8 {
constexpr int BM = 256, BK = 64, HALF = 128, HTB = HALF * BK * 2, STAGE_BYTES = 8 * HTB, NXCD = 8, WGM = 8;
__device__ __forceinline__ int lds_byte(int r, int c) { const int st = (r >> 4) * 2 + (c >> 5), rr = r & 15, cc = c & 31, ob = rr * 64 + cc * 2; return st * 1024 + (ob ^ (((ob >> 9) & 1) << 5)); }
__device__ __forceinline__ void stage_rc(int b, int& R, int& C) { const int st = b / 1024, sb = b % 1024, swz = sb ^ (((sb >> 9) & 1) << 5); R = (st >> 1) * 16 + swz / 64; C = (st & 1) * 32 + (swz % 64) / 2; }
__device__ __forceinline__ int perm32(int rho) { const int n = rho >> 4, i = rho & 15; return 8 * (i >> 2) + 4 * n + (i & 3); }
struct Unit { int pm, pn, q; };
struct Gemm { const bf16_t* A; const bf16_t* Bt; int K, lda, ldb; };

struct StaticOrder {
    static constexpr bool GATHER = false;
    int nM, nN, nwg, G, c, lda;
    __device__ void init(int M, int N, int G_, int c_, int lda_) { nM = M / BM; nN = N / BM; nwg = nM * nN; G = G_; c = c_; lda = lda_; }
    __device__ __forceinline__ bool next(int i, Unit& u) const {
        const long L = (long)i * G + c; if (L >= nwg) return false;
        int wgid = (int)L; { const int q = nwg / NXCD, r = nwg % NXCD, xcd = wgid % NXCD, off = wgid / NXCD; wgid = (xcd < r ? xcd * (q + 1) : r * (q + 1) + (xcd - r) * q) + off; }
        const int nig = WGM * nN, gid = wgid / nig, fm = gid * WGM, gsz = (nM - fm) < WGM ? (nM - fm) : WGM;
        u.pm = fm + ((wgid % nig) % gsz); u.pn = (wgid % nig) / gsz; u.q = i; return true;
    }
    __device__ __forceinline__ void aoff(const Unit& u, const int (&R)[2], const int (&C)[2], unsigned (&o)[2][2]) const {
#pragma unroll
        for (int h = 0; h < 2; ++h)
#pragma unroll
            for (int i = 0; i < 2; ++i) o[h][i] = (unsigned)((u.pm * BM + h * HALF + R[i]) * lda + C[i]) * 2u;
    }
};
template <bool GATHER_> struct TableOrder {
    static constexpr bool GATHER = GATHER_;
    const LAS int* tab; const LAS int* idx; int n, lda;
    __device__ __forceinline__ bool next(int i, Unit& u) const { if (i >= n) return false; u.pm = tab[i]; u.pn = tab[16 + i]; u.q = i; return true; }
    __device__ __forceinline__ void aoff(const Unit& u, const int (&R)[2], const int (&C)[2], unsigned (&o)[2][2]) const {
#pragma unroll
        for (int h = 0; h < 2; ++h)
#pragma unroll
            for (int i = 0; i < 2; ++i) { const int row = GATHER ? idx[u.q * 256 + h * HALF + R[i]] : (u.pm * BM + h * HALF + R[i]); o[h][i] = (unsigned)(row * lda + C[i]) * 2u; }
    }
};

struct EpiBf16 {
    static constexpr bool PERM = true;
    bf16_t* O; int ldc; int pnmask;
    __device__ __forceinline__ void operator()(const f32x4 (&acc)[2][2][4][2], const Unit& u, int wr, int wc, int fr, int fq) const {
        const int row0 = u.pm * BM + wr * 64 + fr; const int col0 = (u.pn & pnmask) * BM + wc * 32 + 8 * fq;
#pragma unroll
        for (int ai = 0; ai < 2; ++ai)
#pragma unroll
            for (int m = 0; m < 4; ++m) { bf16_t* rowp = O + (size_t)(row0 + ai * HALF + m * 16) * ldc + col0;
#pragma unroll
                for (int bj = 0; bj < 2; ++bj) { const f32x4 v0 = acc[ai][bj][m][0], v1 = acc[ai][bj][m][1];
                    u32x4 w; w.x = cvtpk(v0[0], v0[1]); w.y = cvtpk(v0[2], v0[3]); w.z = cvtpk(v1[0], v1[1]); w.w = cvtpk(v1[2], v1[3]);
                    *(u32x4*)(rowp + bj * HALF) = w; } }
    }
};
struct EpiRowScale {
    static constexpr bool PERM = true;
    bf16_t* O; int ldc; const float* rs; int which;
    __device__ __forceinline__ void operator()(const f32x4 (&acc)[2][2][4][2], const Unit& u, int wr, int wc, int fr, int fq) const {
        const int row0 = u.pm * BM + wr * 64 + fr; const int col0 = u.pn * BM + wc * 32 + 8 * fq;
#pragma unroll
        for (int ai = 0; ai < 2; ++ai)
#pragma unroll
            for (int m = 0; m < 4; ++m) { const int row = row0 + ai * HALF + m * 16; const float s = rs[row * 2 + which]; bf16_t* rowp = O + (size_t)row * ldc + col0;
#pragma unroll
                for (int bj = 0; bj < 2; ++bj) { const f32x4 v0 = acc[ai][bj][m][0] * s, v1 = acc[ai][bj][m][1] * s;
                    u32x4 w; w.x = cvtpk(v0[0], v0[1]); w.y = cvtpk(v0[2], v0[3]); w.z = cvtpk(v1[0], v1[1]); w.w = cvtpk(v1[2], v1[3]);
                    *(u32x4*)(rowp + bj * HALF) = w; } }
    }
};
template <bool O8> struct EpiSiluMul {
    static constexpr bool PERM = true;
    bf16_t* O;
    __device__ __forceinline__ void operator()(const f32x4 (&acc)[2][2][4][2], const Unit& u, int wr, int wc, int fr, int fq) const {
        const int row0 = u.pm * BM + wr * 64 + fr; const int col0 = (u.pn & 3) * HALF + wc * 32 + 8 * fq;
#pragma unroll
        for (int ai = 0; ai < 2; ++ai)
#pragma unroll
            for (int m = 0; m < 4; ++m) { const size_t eoff = (size_t)(row0 + ai * HALF + m * 16) * DE + col0; float h[8];
#pragma unroll
                for (int n = 0; n < 2; ++n)
#pragma unroll
                    for (int j = 0; j < 4; ++j) { const float g = acc[ai][0][m][n][j], up = acc[ai][1][m][n][j];
                        const float sg = g * __builtin_amdgcn_rcpf(1.0f + __builtin_amdgcn_exp2f(-g * LOG2E)); h[n * 4 + j] = sg * up; }
                if constexpr (O8) { u32x2 w; w.x = pk4_fp8(clamp8(h[0]), clamp8(h[1]), clamp8(h[2]), clamp8(h[3])); w.y = pk4_fp8(clamp8(h[4]), clamp8(h[5]), clamp8(h[6]), clamp8(h[7]));
                    *(u32x2*)((unsigned char*)O + eoff) = w; }
                else { u32x4 w; w.x = cvtpk(h[0], h[1]); w.y = cvtpk(h[2], h[3]); w.z = cvtpk(h[4], h[5]); w.w = cvtpk(h[6], h[7]);
                    *(u32x4*)(O + eoff) = w; } }
    }
};
template <bool RES_F32> struct EpiResF32 {
    static constexpr bool PERM = false;
    float* Z; const void* res;
    __device__ __forceinline__ void operator()(const f32x4 (&acc)[2][2][4][2], const Unit& u, int wr, int wc, int fr, int fq) const {
        const int row0 = u.pm * BM + wr * 64 + fr, col0 = u.pn * BM + wc * 32 + 4 * fq;
        float ALPHA = 1.4142135623730951f; asm volatile("" : "+v"(ALPHA));
#pragma unroll
        for (int ai = 0; ai < 2; ++ai)
#pragma unroll
            for (int m = 0; m < 4; ++m) { const size_t off = (size_t)(row0 + ai * HALF + m * 16) * DM + col0;
#pragma unroll
                for (int bj = 0; bj < 2; ++bj)
#pragma unroll
                    for (int n = 0; n < 2; ++n) { f32x4 o = acc[ai][bj][m][n];
                        if constexpr (RES_F32) { const f32x4 rv = *(const f32x4*)((const float*)res + off + bj * HALF + n * 16); o += ALPHA * rv; }
                        else { const u32x2 rb = *(const u32x2*)((const bf16_t*)res + off + bj * HALF + n * 16);
                            o[0] += ALPHA * bflo(rb.x); o[1] += ALPHA * bfhi(rb.x); o[2] += ALPHA * bflo(rb.y); o[3] += ALPHA * bfhi(rb.y); }
                        *(f32x4*)(Z + off + bj * HALF + n * 16) = o; } }
    }
};

template <bool F8, class Epi, class Sched>
__device__ __forceinline__ void gemm_phase(int wv, LAS unsigned char* lds, const Gemm g, const Sched& S, const Epi& E, int sW = 0x7f7f7f7f, int sX = 0x7f7f7f7f) {
    constexpr bool GA = Sched::GATHER;
    const int tid = fresh_tid(wv), wid = __builtin_amdgcn_readfirstlane(tid >> 6), lane = tid & 63, wr = wid >> 2, wc = wid & 3, fr = lane & 15, fq = lane >> 4;
    int K = g.K; asm volatile("" : "+s"(K));
    const int nt = K / BK;
    int Rr[2], Cc[2]; unsigned voffA[2], voffB[2];
#pragma unroll
    for (int i = 0; i < 2; ++i) { int R, C; stage_rc(tid * 16 + i * 8192, R, C); Rr[i] = R; Cc[i] = C; const int Rb = Epi::PERM ? ((R & ~31) + perm32(R & 31)) : R;
        voffA[i] = (unsigned)(R * g.lda + C) * 2u; voffB[i] = (unsigned)(Rb * g.ldb + C) * 2u; }
    const size_t kstep = (size_t)(BK * 2);
    const size_t hstepA = (size_t)HALF * g.lda * 2, tstepA = 2 * hstepA;
    const size_t hstepB = (size_t)HALF * g.ldb * 2, tstepB = 2 * hstepB;
    const unsigned ldsw = (unsigned)wid * 1024u;
    const int aoff = lds_byte(wr * 64 + fr, fq * 8), boff = lds_byte(wc * 32 + fr, fq * 8);
#define PG8_SA(b, h) (((b) * 2 + (h)) * HTB)
#define PG8_SB(b, h) ((4 + (b) * 2 + (h)) * HTB)
#define PG8_STAGE(bufoff, gbase, voff) do { _Pragma("unroll") for (int _i = 0; _i < 2; ++_i) \
        __builtin_amdgcn_global_load_lds((const unsigned*)((const char*)(gbase) + (voff)[_i]), (LAS unsigned*)(lds + (bufoff) + ldsw + _i * 8192), 16, 0, 0); } while (0)
#define PG8_STAGE_A(bufoff, h, pbase, koff, goffs) do { if constexpr (GA) { PG8_STAGE(bufoff, gA + (koff), (goffs)[h]); } else { PG8_STAGE(bufoff, (pbase) + (h) * hstepA, voffA); } } while (0)
#define PG8_LD32(dst, off) do { const i32x4 _lo = *(const LAS i32x4*)(lds + (off)), _hi = *(const LAS i32x4*)(lds + (off) + 1024); dst = __builtin_shufflevector(_lo, _hi, 0, 1, 2, 3, 4, 5, 6, 7); } while (0)
#define PG8_LDA(dst, b, h) do { _Pragma("unroll") for (int m = 0; m < 4; ++m) PG8_LD32(dst[m], PG8_SA(b, h) + aoff + m * 2048); } while (0)
#define PG8_LDB(dst, b, h) do { _Pragma("unroll") for (int n = 0; n < 2; ++n) PG8_LD32(dst[n], PG8_SB(b, h) + boff + n * 2048); } while (0)
#define PG8_LOH(v) __builtin_bit_cast(bf16x8, __builtin_shufflevector(v, v, 0, 1, 2, 3))
#define PG8_HIH(v) __builtin_bit_cast(bf16x8, __builtin_shufflevector(v, v, 4, 5, 6, 7))
#define PG8_MMA(ai, bj, At, Bt) do { __builtin_amdgcn_s_setprio(1); \
        if constexpr (F8) { _Pragma("unroll") for (int m = 0; m < 4; ++m) _Pragma("unroll") for (int n = 0; n < 2; ++n) \
            asm volatile("v_mfma_scale_f32_16x16x128_f8f6f4 %0, %1, %2, %0, %3, %4 op_sel_hi:[0,0,0]" : "+v"(acc[ai][bj][m][n]) : "v"(Bt[n]), "v"(At[m]), "v"(sW), "v"(sX)); } \
        else { _Pragma("unroll") for (int m = 0; m < 4; ++m) _Pragma("unroll") for (int n = 0; n < 2; ++n) { \
            acc[ai][bj][m][n] = __builtin_amdgcn_mfma_f32_16x16x32_bf16(PG8_LOH(Bt[n]), PG8_LOH(At[m]), acc[ai][bj][m][n], 0, 0, 0); \
            acc[ai][bj][m][n] = __builtin_amdgcn_mfma_f32_16x16x32_bf16(PG8_HIH(Bt[n]), PG8_HIH(At[m]), acc[ai][bj][m][n], 0, 0, 0); } } \
        __builtin_amdgcn_s_setprio(0); } while (0)
#define PG8_WAIT_V(n) asm volatile("s_waitcnt vmcnt(" #n ")" ::: "memory")
#define PG8_WAIT_L(n) asm volatile("s_waitcnt lgkmcnt(" #n ")" ::: "memory")
#define PG8_BAR __builtin_amdgcn_s_barrier()
#define PG8_SCHED __builtin_amdgcn_sched_barrier(0)
    Unit cur, nxt; int ui = 0;
    if (!S.next(0, cur)) return;
    f32x4 acc[2][2][4][2];
#pragma unroll
    for (int a = 0; a < 2; ++a)
#pragma unroll
        for (int b = 0; b < 2; ++b)
#pragma unroll
            for (int m = 0; m < 4; ++m)
#pragma unroll
                for (int n = 0; n < 2; ++n) { const float zf = fresh_zero(); acc[a][b][m][n] = (f32x4){zf, zf, zf, zf}; }
    unsigned ca[2][2];
    if constexpr (GA) S.aoff(cur, Rr, Cc, ca);
    const char* gA = (const char*)g.A;
    const char* cA = gA + (GA ? (size_t)0 : (size_t)cur.pm * tstepA);
    const char* cB = (const char*)g.Bt + (size_t)cur.pn * tstepB;
    PG8_STAGE(PG8_SB(0, 0), cB, voffB); PG8_STAGE_A(PG8_SA(0, 0), 0, cA, 0, ca); PG8_STAGE(PG8_SB(0, 1), cB + hstepB, voffB); PG8_STAGE_A(PG8_SA(0, 1), 1, cA, 0, ca);
    if (wr == 1) PG8_BAR;
    PG8_WAIT_V(4); PG8_BAR;
    PG8_STAGE(PG8_SB(1, 0), cB + kstep, voffB); PG8_STAGE_A(PG8_SA(1, 0), 0, cA + kstep, kstep, ca); PG8_STAGE(PG8_SB(1, 1), cB + hstepB + kstep, voffB);
    PG8_WAIT_V(6); PG8_BAR;
    for (;;) {
        const bool has_next = S.next(ui + 1, nxt);
        const char* nA = (!GA && has_next) ? gA + (size_t)nxt.pm * tstepA : cA;
        const char* nB = has_next ? (const char*)g.Bt + (size_t)nxt.pn * tstepB : cB;
#pragma unroll 1
        for (int t = 0; t < nt; t += 2) {
            const bool last = (t == nt - 2);
            const size_t k1 = (size_t)(t + 1) * kstep, k2 = last ? (size_t)0 : (size_t)(t + 2) * kstep, k3 = k2 + kstep;
            const char* a1 = cA + k1;
            const char* a2 = last ? nA : cA + k2; const char* b2 = last ? nB : cB + (size_t)(t + 2) * kstep;
            const char* a3 = a2 + kstep; const char* b3 = b2 + kstep;
            i32x8 At[4], B0[2], B1[2];
            unsigned xa[2][2];
            if constexpr (GA) {
                if (last && has_next) { int R2[2], C2[2]; const int t2 = fresh_tid(wv); stage_rc(t2 * 16, R2[0], C2[0]); stage_rc(t2 * 16 + 8192, R2[1], C2[1]); S.aoff(nxt, R2, C2, xa); }
                else {
#pragma unroll
                    for (int h = 0; h < 2; ++h)
#pragma unroll
                        for (int i = 0; i < 2; ++i) xa[h][i] = ca[h][i];
                }
            }
            PG8_LDB(B0, 0, 0); PG8_SCHED; PG8_LDA(At, 0, 0); PG8_STAGE_A(PG8_SA(1, 1), 1, a1, k1, ca);
            PG8_WAIT_L(8); PG8_BAR; PG8_WAIT_L(0); PG8_MMA(0, 0, At, B0); PG8_BAR; PG8_SCHED;
            PG8_LDB(B1, 0, 1); PG8_STAGE(PG8_SB(0, 0), b2, voffB);
            PG8_BAR; PG8_WAIT_L(0); PG8_MMA(0, 1, At, B1); PG8_BAR;
            PG8_LDA(At, 0, 1); PG8_STAGE_A(PG8_SA(0, 0), 0, a2, k2, xa);
            PG8_BAR; PG8_WAIT_L(0); PG8_MMA(1, 0, At, B0); PG8_BAR; PG8_SCHED;
            PG8_STAGE(PG8_SB(0, 1), b2 + hstepB, voffB);
            PG8_WAIT_V(6); PG8_BAR; PG8_MMA(1, 1, At, B1); PG8_BAR;
            PG8_LDB(B0, 1, 0); PG8_SCHED; PG8_LDA(At, 1, 0); PG8_STAGE_A(PG8_SA(0, 1), 1, a2, k2, xa);
            PG8_WAIT_L(8); PG8_BAR; PG8_WAIT_L(0); PG8_MMA(0, 0, At, B0); PG8_BAR; PG8_SCHED;
            PG8_LDB(B1, 1, 1); PG8_STAGE(PG8_SB(1, 0), b3, voffB);
            PG8_BAR; PG8_WAIT_L(0); PG8_MMA(0, 1, At, B1); PG8_BAR;
            PG8_LDA(At, 1, 1); PG8_STAGE_A(PG8_SA(1, 0), 0, a3, k3, xa);
            PG8_BAR; PG8_WAIT_L(0); PG8_MMA(1, 0, At, B0); PG8_BAR; PG8_SCHED;
            PG8_STAGE(PG8_SB(1, 1), b3 + hstepB, voffB);
            PG8_WAIT_V(6); PG8_BAR; PG8_MMA(1, 1, At, B1); PG8_BAR;
        }
        if constexpr (F8) asm volatile("s_nop 7\n\ts_nop 7\n\ts_nop 7" ::: "memory");
        { const int l2 = fresh_tid(0); E(acc, cur, wr, wc, l2 & 15, l2 >> 4); }
        if (!has_next) break;
#pragma unroll
        for (int a = 0; a < 2; ++a)
#pragma unroll
            for (int b = 0; b < 2; ++b)
#pragma unroll
                for (int m = 0; m < 4; ++m)
#pragma unroll
                    for (int n = 0; n < 2; ++n) { const float zf = fresh_zero(); acc[a][b][m][n] = (f32x4){zf, zf, zf, zf}; }
        cur = nxt; cA = nA; cB = nB; ++ui;
        if constexpr (GA) { int R2[2], C2[2]; const int t2 = fresh_tid(wv); stage_rc(t2 * 16, R2[0], C2[0]); stage_rc(t2 * 16 + 8192, R2[1], C2[1]); S.aoff(cur, R2, C2, ca); }
    }
    PG8_WAIT_V(0);
    if (wr == 0) PG8_BAR;
    PG8_BAR;
#undef PG8_SA
#undef PG8_SB
#undef PG8_STAGE
#undef PG8_STAGE_A
#undef PG8_LDA
#undef PG8_LDB
#undef PG8_MMA
#undef PG8_LD32
#undef PG8_LOH
#undef PG8_HIH
#undef PG8_WAIT_V
#undef PG8_WAIT_L
#undef PG8_BAR
#undef PG8_SCHED
}
}

namespace da {
constexpr int KVBLK = 64;
constexpr float THR = 8.f;
constexpr int SHM_V = KVBLK * 128 * 2, SHM_K = KVBLK * 128 * 2, SHM_KR = KVBLK * 64 * 2;
constexpr int OFF_V = 0, OFF_K = 2 * SHM_V, OFF_WS = OFF_K + 2 * SHM_K, OFF_KR = OFF_WS + 8 * 64 * 4, OFF_QR = OFF_KR + 2 * SHM_KR, LDS_DENSE = OFF_QR + 8 * 4096;
#define KSWZ(row, colB) ((row) * 256 + ((colB) ^ (((row) & 7) << 4)))
#define KRSWZ(row, ch) ((row) * 128 + ((((ch) ^ ((row) >> 1)) & 7) << 4))
#define SBAR() __builtin_amdgcn_sched_barrier(0)
__device__ __forceinline__ int crow(int r, int hi) { return (r & 3) + 8 * (r >> 2) + 4 * hi; }
__device__ __forceinline__ int v_st(int k, int c) { const int kk = (k & ~0xC) | ((k & 4) << 1) | ((k & 8) >> 1); return ((kk >> 3) * 4 + (c >> 5)) * 512 + ((kk & 7) * 32 + (c & 31)) * 2; }
__device__ __forceinline__ int v_rd_base(int lane) { return ((lane & 3) << 3) | (((lane >> 2) & 3) << 6) | (((lane >> 4) & 1) << 5) | (((lane >> 5) & 1) << 8); }
constexpr int v_rd_off(int d0, int ks, int half) { return d0 * 512 + ks * 4096 + half * 2048; }
template <int OFF> __device__ __forceinline__ s16x4 tr_read(int vb) {
    s16x4 r; asm volatile("ds_read_b64_tr_b16 %0, %1 offset:%2" : "=&v"(r) : "v"(vb), "i"(OFF) : "memory"); return r;
}
template <int D0> __device__ __forceinline__ void pv_one(f32x16& od, int vb, bf16x8 pa0, bf16x8 pa1, bf16x8 pa2, bf16x8 pa3) {
    const s16x4 l0 = tr_read<v_rd_off(D0, 0, 0)>(vb), h0 = tr_read<v_rd_off(D0, 0, 1)>(vb), l1 = tr_read<v_rd_off(D0, 1, 0)>(vb), h1 = tr_read<v_rd_off(D0, 1, 1)>(vb);
    const s16x4 l2 = tr_read<v_rd_off(D0, 2, 0)>(vb), h2 = tr_read<v_rd_off(D0, 2, 1)>(vb), l3 = tr_read<v_rd_off(D0, 3, 0)>(vb), h3 = tr_read<v_rd_off(D0, 3, 1)>(vb);
    asm volatile("s_waitcnt lgkmcnt(0)" ::: "memory"); SBAR();
#define PK(L, H) (bf16x8){L[0], L[1], L[2], L[3], H[0], H[1], H[2], H[3]}
    od = __builtin_amdgcn_mfma_f32_32x32x16_bf16(pa0, PK(l0, h0), od, 0, 0, 0);
    od = __builtin_amdgcn_mfma_f32_32x32x16_bf16(pa1, PK(l1, h1), od, 0, 0, 0);
    od = __builtin_amdgcn_mfma_f32_32x32x16_bf16(pa2, PK(l2, h2), od, 0, 0, 0);
    od = __builtin_amdgcn_mfma_f32_32x32x16_bf16(pa3, PK(l3, h3), od, 0, 0, 0);
}
__device__ __forceinline__ void pv_d0(f32x16* o, int vb, bf16x8 pa0, bf16x8 pa1, bf16x8 pa2, bf16x8 pa3) {
    pv_one<0>(o[0], vb, pa0, pa1, pa2, pa3); pv_one<1>(o[1], vb, pa0, pa1, pa2, pa3); pv_one<2>(o[2], vb, pa0, pa1, pa2, pa3); pv_one<3>(o[3], vb, pa0, pa1, pa2, pa3);
}
template <int D0> __device__ __forceinline__ void pv_one32(f32x16& od, int vb, bf16x8 pa0, bf16x8 pa1) {
    const s16x4 l0 = tr_read<v_rd_off(D0, 0, 0)>(vb), h0 = tr_read<v_rd_off(D0, 0, 1)>(vb), l1 = tr_read<v_rd_off(D0, 1, 0)>(vb), h1 = tr_read<v_rd_off(D0, 1, 1)>(vb);
    asm volatile("s_waitcnt lgkmcnt(0)" ::: "memory"); SBAR();
    od = __builtin_amdgcn_mfma_f32_32x32x16_bf16(pa0, PK(l0, h0), od, 0, 0, 0);
    od = __builtin_amdgcn_mfma_f32_32x32x16_bf16(pa1, PK(l1, h1), od, 0, 0, 0);
}
#undef PK
#define PK4(P, BASE, OUT) do { unsigned a0 = cvtpk(P[BASE + 0], P[BASE + 1]), a1 = cvtpk(P[BASE + 2], P[BASE + 3]);   \
    unsigned b0 = cvtpk(P[BASE + 4], P[BASE + 5]), b1 = cvtpk(P[BASE + 6], P[BASE + 7]);                              \
    auto r0 = __builtin_amdgcn_permlane32_swap(a0, b0, false, false); auto r1 = __builtin_amdgcn_permlane32_swap(a1, b1, false, false); \
    u32x4 w = {r0[0], r1[0], r0[1], r1[1]}; OUT = *reinterpret_cast<bf16x8*>(&w); } while (0)

template <int NDQ> struct Cst { static constexpr float SCALE = (NDQ == 8) ? 0.088388347648318440f : 0.072168783648703220f; static constexpr float C = SCALE * LOG2E; };

template <int NDQ>
__device__ __forceinline__ void partialSM(f32x16& p0, f32x16& p1, float& m_reg, float& mn, float& alpha) {
    constexpr float C = Cst<NDQ>::C, SCALE = Cst<NDQ>::SCALE;
    float pmax = p0[0];
#pragma unroll
    for (int r = 1; r < 16; ++r) pmax = fmaxf(pmax, p0[r]);
#pragma unroll
    for (int r = 0; r < 16; ++r) pmax = fmaxf(pmax, p1[r]);
    { auto rr = __builtin_amdgcn_permlane32_swap(__float_as_uint(pmax), __float_as_uint(pmax), false, false);
      pmax = fmaxf(__uint_as_float(rr[0]), __uint_as_float(rr[1])); }
    if (__builtin_expect(__all(pmax - m_reg <= THR / SCALE), 1)) { mn = m_reg; alpha = 1.f; }
    else { mn = fmaxf(m_reg, pmax); alpha = __builtin_amdgcn_exp2f((m_reg - mn) * C); m_reg = mn; }
    const float mnC = -mn * C;
#pragma unroll
    for (int r = 0; r < 16; ++r) p0[r] = fmaf(p0[r], C, mnC);
#pragma unroll
    for (int r = 0; r < 16; ++r) p1[r] = fmaf(p1[r], C, mnC);
#pragma unroll
    for (int r = 0; r < 16; ++r) p0[r] = __builtin_amdgcn_exp2f(p0[r]);
}
__device__ __forceinline__ void finishSM(f32x16& p0, f32x16& p1, float alpha, float& l_reg, bf16x8& pa0, bf16x8& pa1, bf16x8& pa2, bf16x8& pa3) {
#pragma unroll
    for (int r = 0; r < 16; ++r) p1[r] = __builtin_amdgcn_exp2f(p1[r]);
    float ps = 0;
#pragma unroll
    for (int r = 0; r < 16; ++r) ps += p0[r];
#pragma unroll
    for (int r = 0; r < 16; ++r) ps += p1[r];
    { auto rr = __builtin_amdgcn_permlane32_swap(__float_as_uint(ps), __float_as_uint(ps), false, false);
      ps = __uint_as_float(rr[0]) + __uint_as_float(rr[1]); }
    l_reg = l_reg * alpha + ps;
    PK4(p0, 0, pa0); PK4(p0, 8, pa1); PK4(p1, 0, pa2); PK4(p1, 8, pa3);
}
template <int NDQ>
__device__ __forceinline__ void qkt(f32x16& p0, f32x16& p1, const char* Ks, const char* Krs, const bf16x8* qr, const char* qrl, int r32, int hi) {
    p0 = f32x16{}; p1 = f32x16{};
#pragma unroll
    for (int d0 = 0; d0 < 8; ++d0) { const int cb = (d0 * 16 + hi * 8) * 2;
        bf16x8 b0 = *reinterpret_cast<const bf16x8*>(Ks + KSWZ(r32, cb));
        bf16x8 b1 = *reinterpret_cast<const bf16x8*>(Ks + KSWZ(32 + r32, cb));
        p0 = __builtin_amdgcn_mfma_f32_32x32x16_bf16(b0, qr[d0], p0, 0, 0, 0);
        p1 = __builtin_amdgcn_mfma_f32_32x32x16_bf16(b1, qr[d0], p1, 0, 0, 0); }
    if constexpr (NDQ == 12) {
#pragma unroll
        for (int d0 = 0; d0 < 4; ++d0) { const int ch = d0 * 2 + hi;
            bf16x8 b0 = *reinterpret_cast<const bf16x8*>(Krs + KRSWZ(r32, ch));
            bf16x8 b1 = *reinterpret_cast<const bf16x8*>(Krs + KRSWZ(32 + r32, ch));
            const bf16x8 qf = *reinterpret_cast<const bf16x8*>(qrl + d0 * 1024);
            p0 = __builtin_amdgcn_mfma_f32_32x32x16_bf16(b0, qf, p0, 0, 0, 0);
            p1 = __builtin_amdgcn_mfma_f32_32x32x16_bf16(b1, qf, p1, 0, 0, 0); }
    }
}

struct DArgs { const bf16_t* Q; const bf16_t* K; const bf16_t* V; const bf16_t* Kr; bf16_t* O; int ldq, ldk, ldv, ldo; int seq; int pos0; };

template <int NDQ, int SDEPTH>
__device__ __forceinline__ void attn_dense_body(int wv, const DArgs a, char* lds) {
    const int tid = fresh_tid(wv), wid = tid >> 6, lane = tid & 63, r32 = lane & 31, hi = lane >> 5;
    char* V_lds = lds + OFF_V; char* K_lds = lds + OFF_K; char* Kr_lds = lds + OFF_KR;
    float* ws = (float*)(lds + OFF_WS) + wid * 64; float* li_l = ws; float* al_l = ws + 32;
    float m_reg = -1e30f, l_reg = 0; f32x16 o[4] = {}; bf16x8 qr[8];
    char* qrl = lds + OFF_QR + wid * 4096 + lane * 16;
    const bf16_t* Qw = a.Q + (long)(wid * 32 + r32) * a.ldq + hi * 8;
#pragma unroll
    for (int d0 = 0; d0 < 8; ++d0) qr[d0] = *reinterpret_cast<const bf16x8*>(Qw + d0 * 16);
    if constexpr (NDQ == 12) {
        const float pos = (float)(a.pos0 + wid * 32 + r32);
#pragma unroll
        for (int f = 0; f < 2; ++f) {
            const bf16x8 x1v = *reinterpret_cast<const bf16x8*>(Qw + (8 + f) * 16), x2v = *reinterpret_cast<const bf16x8*>(Qw + (10 + f) * 16); bf16x8 y1v, y2v;
#pragma unroll
            for (int j = 0; j < 8; ++j) { const int i = f * 16 + hi * 8 + j; float sn, cs; sincos_rev(pos * inv_freq32(i), sn, cs);
                const float x1 = bf2f((unsigned short)x1v[j]), x2 = bf2f((unsigned short)x2v[j]);
                y1v[j] = (short)f2bf(x1 * cs - x2 * sn); y2v[j] = (short)f2bf(x2 * cs + x1 * sn); }
            *reinterpret_cast<bf16x8*>(qrl + f * 1024) = y1v; *reinterpret_cast<bf16x8*>(qrl + (2 + f) * 1024) = y2v;
        }
    }
    const int sr = tid >> 4, sc = (tid & 15) * 8, vst0 = v_st(sr, sc), vst1 = v_st(32 + sr, sc);
    const int krr = tid >> 3, krc = tid & 7;
    const int vb0 = (int)(uintptr_t)V_lds + v_rd_base(lane);
    struct { bf16x8 vs0, vs1, ks0, ks1, kr; } sr_[SDEPTH];
#define SLOAD(i, k0) do { sr_[i].vs0 = *(const bf16x8*)(a.V + (long)((k0) + sr) * a.ldv + sc); sr_[i].vs1 = *(const bf16x8*)(a.V + (long)((k0) + 32 + sr) * a.ldv + sc); \
    sr_[i].ks0 = *(const bf16x8*)(a.K + (long)((k0) + sr) * a.ldk + sc); sr_[i].ks1 = *(const bf16x8*)(a.K + (long)((k0) + 32 + sr) * a.ldk + sc); \
    if constexpr (NDQ == 12) sr_[i].kr = *(const bf16x8*)(a.Kr + (long)((k0) + krr) * 64 + krc * 8); } while (0)
#define SWRITE(b, i) do { *(bf16x8*)(V_lds + (b) * SHM_V + vst0) = sr_[i].vs0; *(bf16x8*)(V_lds + (b) * SHM_V + vst1) = sr_[i].vs1; const int kc = sc * 2; \
    *(bf16x8*)(K_lds + (b) * SHM_K + KSWZ(sr, kc)) = sr_[i].ks0; *(bf16x8*)(K_lds + (b) * SHM_K + KSWZ(32 + sr, kc)) = sr_[i].ks1; \
    if constexpr (NDQ == 12) *(bf16x8*)(Kr_lds + (b) * SHM_KR + KRSWZ(krr, krc)) = sr_[i].kr; } while (0)
#define SWAIT() do { if constexpr (SDEPTH == 2) { if constexpr (NDQ == 12) asm volatile("s_waitcnt vmcnt(5)" ::: "memory"); else asm volatile("s_waitcnt vmcnt(4)" ::: "memory"); } else asm volatile("s_waitcnt vmcnt(0)" ::: "memory"); } while (0)
#define RESC(al) do { if (__any((al) < 1.f)) { if (hi == 0) al_l[r32] = (al); asm volatile("s_waitcnt lgkmcnt(0)" ::: "memory"); \
    _Pragma("unroll") for (int d = 0; d < 4; ++d) _Pragma("unroll") for (int r = 0; r < 16; ++r) o[d][r] *= al_l[crow(r, hi)]; } } while (0)
    f32x16 pA0, pA1, pB0, pB1; float mnA, mnB, alA, alB; bf16x8 pa0, pa1, pa2, pa3; const int NT = a.seq / KVBLK;
    constexpr int SE = 0, SO = SDEPTH - 1;
    SLOAD(SE, 0); asm volatile("s_waitcnt vmcnt(0)" ::: "memory"); SWRITE(0, SE); __syncthreads();
    qkt<NDQ>(pA0, pA1, K_lds, Kr_lds, qr, qrl, r32, hi); partialSM<NDQ>(pA0, pA1, m_reg, mnA, alA);
    SLOAD(SO, KVBLK); if constexpr (SDEPTH == 2) { if (2 < NT) SLOAD(SE, 2 * KVBLK); }
    SWAIT(); SWRITE(1, SO); __syncthreads();
#pragma unroll 1
    for (int j = 1; j + 1 < NT; j += 2) {
        SBAR(); qkt<NDQ>(pB0, pB1, K_lds + SHM_K, Kr_lds + SHM_KR, qr, qrl, r32, hi);
        finishSM(pA0, pA1, alA, l_reg, pa0, pa1, pa2, pa3); SBAR();
        SLOAD(SO, (j + SDEPTH) * KVBLK); SBAR();
        pv_d0(o, vb0, pa0, pa1, pa2, pa3); partialSM<NDQ>(pB0, pB1, m_reg, mnB, alB);
        __syncthreads(); SWAIT(); SWRITE(0, SE);
        RESC(alB); __syncthreads();
        SBAR(); qkt<NDQ>(pA0, pA1, K_lds, Kr_lds, qr, qrl, r32, hi);
        finishSM(pB0, pB1, alB, l_reg, pa0, pa1, pa2, pa3); SBAR();
        if (SDEPTH == 1 || j + 3 < NT) SLOAD(SE, (j + 1 + SDEPTH) * KVBLK); SBAR();
        pv_d0(o, vb0 + (int)SHM_V, pa0, pa1, pa2, pa3); partialSM<NDQ>(pA0, pA1, m_reg, mnA, alA);
        __syncthreads(); SWAIT(); SWRITE(1, SO);
        RESC(alA); __syncthreads();
    }
    SBAR(); qkt<NDQ>(pB0, pB1, K_lds + SHM_K, Kr_lds + SHM_KR, qr, qrl, r32, hi);
    finishSM(pA0, pA1, alA, l_reg, pa0, pa1, pa2, pa3); SBAR();
    pv_d0(o, vb0, pa0, pa1, pa2, pa3); partialSM<NDQ>(pB0, pB1, m_reg, mnB, alB);
    __syncthreads(); RESC(alB);
    finishSM(pB0, pB1, alB, l_reg, pa0, pa1, pa2, pa3); SBAR();
    pv_d0(o, vb0 + (int)SHM_V, pa0, pa1, pa2, pa3);
    if (hi == 0) li_l[r32] = l_reg; asm volatile("s_waitcnt lgkmcnt(0)" ::: "memory");
    float rli[16];
#pragma unroll
    for (int r = 0; r < 16; ++r) rli[r] = __builtin_amdgcn_rcpf(li_l[crow(r, hi)]);
    bf16_t* Ow = F8_OUT ? (bf16_t*)((unsigned char*)a.O + (long)(wid * 32) * a.ldo) : a.O + (long)(wid * 32) * a.ldo;
#pragma unroll
    for (int r = 0; r < 16; ++r) { const int orow = crow(r, hi);
#pragma unroll
        for (int d0 = 0; d0 < 4; ++d0) { if constexpr (F8_OUT) ((unsigned char*)Ow)[(long)orow * a.ldo + d0 * 32 + r32] = f2fp8(o[d0][r] * rli[r] * O8_SCALE); else Ow[(long)orow * a.ldo + d0 * 32 + r32] = f2bf(o[d0][r] * rli[r]); } }
#undef SLOAD
#undef SWRITE
#undef SWAIT
#undef RESC
}

constexpr int SP_WAVE_LDS = 18688;
template <class P>
__device__ __forceinline__ void sparse_wave(P& pol, LAS unsigned char* wll, int lane) {
    const int r32 = lane & 31, hi = lane >> 5;
    char* wl = (char*)wll;
    char* Kl = wl; char* Vl = wl + 8192; float* li_l = (float*)(wl + 16384); float* al_l = li_l + 32;
    bf16x8 qr[8];
    { const bf16_t* qp = pol.qptr(r32) + hi * 8;
#pragma unroll
      for (int d0 = 0; d0 < 8; ++d0) qr[d0] = *reinterpret_cast<const bf16x8*>(qp + d0 * 16); }
    asm volatile("s_waitcnt vmcnt(0)" ::: "memory");
    f32x16 o[4] = {}; float m_reg = -1e30f, l_reg = 0.f;
    const int krow0 = lane >> 4;
    const int kce = (((lane & 15) ^ (krow0 & 7)) * 8), kco = (((lane & 15) ^ ((4 + krow0) & 7)) * 8);
    const int vk0 = 8 * ((lane >> 4) & 1) + ((lane >> 2) & 3), vc0 = 32 * (lane >> 5) + 8 * (lane & 3);
    const int vb = (int)(uintptr_t)Vl + v_rd_base(lane);
    const int nt = pol.ntiles();
    typename P::TI ti, tn;
#define SP_DMA_K(T) do { _Pragma("unroll") for (int i = 0; i < 8; ++i) { const bf16_t* src = (T).k + (long)(4 * i + krow0) * (T).rs + ((i & 1) ? kco : kce); \
        __builtin_amdgcn_global_load_lds((const unsigned*)src, (LAS unsigned*)(wll + i * 1024), 16, 0, 0); } } while (0)
#define SP_DMA_V(T) do { _Pragma("unroll") for (int i = 0; i < 8; ++i) { const bf16_t* src = (T).v + (long)(16 * (i >> 2) + 4 * ((i >> 1) & 1) + vk0) * (T).rs + 64 * (i & 1) + vc0; \
        __builtin_amdgcn_global_load_lds((const unsigned*)src, (LAS unsigned*)(wll + 8192 + i * 1024), 16, 0, 0); } } while (0)
    pol.tile(0, ti);
    SP_DMA_K(ti); SP_DMA_V(ti);
#pragma unroll 1
    for (int j = 0; j < nt; ++j) {
        const bool more = (j + 1 < nt);
        if (more) pol.tile(j + 1, tn);
        asm volatile("s_waitcnt vmcnt(8)" ::: "memory");
        f32x16 p = f32x16{};
#pragma unroll
        for (int d0 = 0; d0 < 8; ++d0) { const int cb = (d0 * 16 + hi * 8) * 2;
            bf16x8 b0 = *reinterpret_cast<const bf16x8*>(Kl + KSWZ(r32, cb));
            p = __builtin_amdgcn_mfma_f32_32x32x16_bf16(b0, qr[d0], p, 0, 0, 0); }
        asm volatile("s_waitcnt lgkmcnt(0)" ::: "memory"); SBAR();
        if (more) SP_DMA_K(tn);
        SBAR();
        float pmax = -INFINITY;
#pragma unroll
        for (int r = 0; r < 16; ++r) { p[r] = pol.adj(ti, crow(r, hi), p[r]); pmax = fmaxf(pmax, p[r]); }
        { auto rr = __builtin_amdgcn_permlane32_swap(__float_as_uint(pmax), __float_as_uint(pmax), false, false);
          pmax = fmaxf(__uint_as_float(rr[0]), __uint_as_float(rr[1])); }
        const float mn = fmaxf(m_reg, pmax); const float alpha = __builtin_amdgcn_exp2f(m_reg - mn); m_reg = mn;
        float ps = 0.f;
#pragma unroll
        for (int r = 0; r < 16; ++r) { p[r] = __builtin_amdgcn_exp2f(p[r] - mn); ps += p[r]; }
        { auto rr = __builtin_amdgcn_permlane32_swap(__float_as_uint(ps), __float_as_uint(ps), false, false);
          ps = __uint_as_float(rr[0]) + __uint_as_float(rr[1]); }
        l_reg = l_reg * alpha + ps;
        if (__any(alpha < 1.f)) { if (hi == 0) al_l[r32] = alpha; asm volatile("s_waitcnt lgkmcnt(0)" ::: "memory");
#pragma unroll
            for (int d = 0; d < 4; ++d)
#pragma unroll
                for (int r = 0; r < 16; ++r) o[d][r] *= al_l[crow(r, hi)]; }
        bf16x8 pa0, pa1; PK4(p, 0, pa0); PK4(p, 8, pa1);
        SBAR();
        if (more) asm volatile("s_waitcnt vmcnt(8)" ::: "memory"); else asm volatile("s_waitcnt vmcnt(0)" ::: "memory");
        SBAR();
        pv_one32<0>(o[0], vb, pa0, pa1); pv_one32<1>(o[1], vb, pa0, pa1); pv_one32<2>(o[2], vb, pa0, pa1); pv_one32<3>(o[3], vb, pa0, pa1);
        SBAR();
        if (more) SP_DMA_V(tn);
        SBAR();
        ti = tn;
    }
#undef SP_DMA_K
#undef SP_DMA_V
    if (hi == 0) li_l[r32] = l_reg; asm volatile("s_waitcnt lgkmcnt(0)" ::: "memory");
#pragma unroll
    for (int r = 0; r < 16; ++r) { const int qn = crow(r, hi); const float rl = __builtin_amdgcn_rcpf(li_l[qn]); bf16_t* op = pol.optr(qn);
#pragma unroll
        for (int d0 = 0; d0 < 4; ++d0) { if constexpr (F8_OUT) ((unsigned char*)op)[d0 * 32 + r32] = f2fp8(o[d0][r] * rl * O8_SCALE); else op[d0 * 32 + r32] = f2bf(o[d0][r] * rl); } }
}
#undef PK4
}

struct PolB {
    struct TI { const bf16_t* k; const bf16_t* v; long rs; int kpos0; int iq; float cd; };
    const bf16_t* H0; bf16_t* O; int b, h, a, r16, myn; int lo3, n3, lo2, n2, lo1, n1; float slope2;
    __device__ __forceinline__ void init(const bf16_t* H0_, bf16_t* O_, int w, int lane) {
        H0 = H0_; O = O_; b = w >> 10; h = (w >> 7) & 7; const int wu = w & 127; a = wu >> 4; r16 = wu & 15; myn = lane & 31;
        lo3 = max(a - 2, 0); n3 = min(a + 2, 7) - lo3 + 1;
        lo2 = max(4 * a - 2, 0); n2 = min(4 * a + 5, 31) - lo2 + 1;
        lo1 = max(16 * a - 2, 0); n1 = min(16 * a + 17, 127) - lo1 + 1;
        slope2 = __builtin_amdgcn_exp2f(-(float)(h + 1)) * LOG2E;
    }
    __device__ __forceinline__ const bf16_t* qptr(int n) const { return H0 + (long)(b * SEQ + 512 * a + r16 + 16 * n) * IN0 + 1536 + h * 128; }
    __device__ __forceinline__ bf16_t* optr(int qn) const { const long e = (long)(b * SEQ + 512 * a + r16 + 16 * qn) * DM + 1024 + h * 128; return F8_OUT ? (bf16_t*)((unsigned char*)O + e) : O + e; }
    __device__ __forceinline__ int ntiles() const { return n3 + n2 + n1; }
    __device__ __forceinline__ void tile(int j, TI& ti) const {
        int dil, kt, rd;
        if (j < n3) { dil = 16; kt = lo3 + j; rd = r16; }
        else if (j < n3 + n2) { dil = 4; kt = lo2 + (j - n3); rd = r16 & 3; }
        else { dil = 1; kt = lo1 + (j - n3 - n2); rd = 0; }
        const long tok = (long)b * SEQ + dil * 32 * kt + rd;
        ti.k = H0 + tok * IN0 + 2560 + h * 128; ti.v = H0 + tok * IN0 + 3584 + h * 128; ti.rs = (long)dil * IN0;
        ti.kpos0 = 32 * kt; ti.iq = (512 * a + r16 + 16 * myn - rd) / dil; ti.cd = slope2 * (float)dil;
    }
    __device__ __forceinline__ float adj(const TI& ti, int kloc, float s) const {
        const int d = ti.kpos0 + kloc - ti.iq; const int ad = d < 0 ? -d : d;
        return ad <= 64 ? fmaf(s, 0.088388347648318440f * LOG2E, -ti.cd * (float)ad) : -INFINITY;
    }
};
struct PolC {
    struct TI { const bf16_t* k; const bf16_t* v; long rs; int kc0; int drow; };
    const bf16_t* H1; bf16_t* O; const float* tab; int b, h, r, a, r0, qc, c0;
    __device__ __forceinline__ void init(const bf16_t* H1_, bf16_t* O_, const float* rpb, float* tab_, int w, int lane) {
        H1 = H1_; O = O_; tab = tab_; b = w >> 10; h = (w >> 7) & 7; const int wu = w & 127; r = wu >> 1; a = wu & 1;
        r0 = min(max(r - 4, 0), 56); qc = 32 * a + (lane & 31); c0 = min(max(qc - 8, 0), 48);
        for (int idx = lane; idx < 480; idx += 64) { const int dr = idx >> 5, dc = idx & 31; tab_[idx] = dc < 31 ? rpb[h * 465 + dr * 31 + dc] * LOG2E : 0.f; }
        asm volatile("s_waitcnt vmcnt(0) lgkmcnt(0)" ::: "memory");
    }
    __device__ __forceinline__ const bf16_t* qptr(int n) const { return H1 + (long)(b * SEQ + 64 * r + 32 * a + n) * IN1P + h * 128; }
    __device__ __forceinline__ bf16_t* optr(int qn) const { const long e = (long)(b * SEQ + 64 * r + 32 * a + qn) * DM + h * 128; return F8_OUT ? (bf16_t*)((unsigned char*)O + e) : O + e; }
    __device__ __forceinline__ int ntiles() const { return 16; }
    __device__ __forceinline__ void tile(int j, TI& ti) const {
        const int kr = r0 + (j >> 1), ch = j & 1; const long tok = (long)b * SEQ + 64 * kr + 32 * ch;
        ti.k = H1 + tok * IN1P + 1024 + h * 128; ti.v = H1 + tok * IN1P + 2048 + h * 128; ti.rs = IN1P; ti.kc0 = 32 * ch; ti.drow = kr - r + 7;
    }
    __device__ __forceinline__ float adj(const TI& ti, int kloc, float s) const {
        const int kc = ti.kc0 + kloc; const int dc = min(max(kc - qc + 15, 0), 30);
        const float bias = tab[ti.drow * 32 + dc];
        return (kc >= c0 && kc < c0 + 16) ? fmaf(s, 0.088388347648318440f * LOG2E, bias) : -INFINITY;
    }
};

struct Params { const float* in[28]; float* out; unsigned char* ws; int ph_lo, ph_hi; };
enum { I_X = 0, I_RW = 1, I_RB = 2, I_WIN0 = 3, I_AQN = 4, I_AKN = 5, I_WOUT0 = 6, I_LN1G0 = 7, I_LN1B0 = 8, I_WG0 = 9, I_WU0 = 10, I_WD0 = 11, I_LN2G0 = 12, I_LN2B0 = 13,
       I_WIN1 = 14, I_RPB = 15, I_DQN = 16, I_WQUP = 17, I_DKVN = 18, I_WKVUP = 19, I_WOUT1 = 20, I_LN1G1 = 21, I_LN1B1 = 22, I_WG1 = 23, I_WU1 = 24, I_WD1 = 25, I_LN2G1 = 26, I_LN2B1 = 27 };

__device__ __forceinline__ void tr_tile(const float* __restrict__ src, int N, const float* __restrict__ ksc, bf16_t* __restrict__ dst, int ldd, int k0, int n0, int drow0, LAS unsigned* tl, int tid) {
    const int c4 = (tid & 15) * 4;
#pragma unroll
    for (int i = 0; i < 2; ++i) {
        const int kp = (tid >> 4) + 32 * i;
        const float* s0 = src + (size_t)(k0 + 2 * kp) * N + n0 + c4;
        f32x4 a = *(const f32x4*)s0, b = *(const f32x4*)(s0 + N);
        if (ksc) { const float sa = ksc[k0 + 2 * kp], sb = ksc[k0 + 2 * kp + 1]; a *= sa; b *= sb; }
#pragma unroll
        for (int j = 0; j < 4; ++j) tl[(c4 + j) * 65 + kp] = cvtpk(a[j], b[j]);
    }
    __syncthreads();
    const int n = tid >> 3, seg = tid & 7;
    unsigned w[8];
#pragma unroll
    for (int q = 0; q < 8; ++q) w[q] = tl[n * 65 + seg * 8 + q];
    u32x4* d = (u32x4*)(dst + (size_t)(drow0 + n) * ldd + k0 + seg * 16);
    d[0] = (u32x4){w[0], w[1], w[2], w[3]}; d[1] = (u32x4){w[4], w[5], w[6], w[7]};
    __syncthreads();
}
__device__ __forceinline__ void tr_tile8(const float* __restrict__ src, int N, const float* __restrict__ ksc, float wscale, unsigned char* __restrict__ dst, int ldd, int k0, int n0, int drow0, LAS unsigned* tl, int tid) {
    const int c4 = (tid & 15) * 4, kq = tid >> 4;
    const float* s0 = src + (size_t)(k0 + 4 * kq) * N + n0 + c4;
    f32x4 a = *(const f32x4*)s0, b = *(const f32x4*)(s0 + N), c = *(const f32x4*)(s0 + 2 * (size_t)N), d = *(const f32x4*)(s0 + 3 * (size_t)N);
    float sa = wscale, sb = wscale, sc = wscale, sd = wscale;
    if (ksc) { sa *= ksc[k0 + 4 * kq]; sb *= ksc[k0 + 4 * kq + 1]; sc *= ksc[k0 + 4 * kq + 2]; sd *= ksc[k0 + 4 * kq + 3]; }
#pragma unroll
    for (int j = 0; j < 4; ++j) tl[(c4 + j) * 33 + kq] = pk4_fp8(a[j] * sa, b[j] * sb, c[j] * sc, d[j] * sd);
    __syncthreads();
    const int n = tid >> 3, seg = tid & 7;
    unsigned w[4];
#pragma unroll
    for (int q = 0; q < 4; ++q) w[q] = tl[n * 33 + seg * 4 + q];
    *(u32x4*)(dst + (size_t)(drow0 + n) * ldd + k0 + seg * 16) = (u32x4){w[0], w[1], w[2], w[3]};
    __syncthreads();
}
struct TJob { const float* src; bf16_t* dst; const float* ksc; int K, N, ldd, gu; size_t sbs, dbs; int f8; };
constexpr float W8_SCALE = 64.f;
constexpr int W8_SBYTE = 0x79797979;
__device__ __forceinline__ void run_tjob(const TJob& jb, int t, LAS unsigned* tl, int tid) {
    const int ntn = jb.N / 64, ntk = jb.K / 128, per = ntn * ntk;
    const int bi = t / per, r = t % per, tk = r / ntn, tn = r % ntn;
    const int n0 = tn * 64;
    const int drow0 = jb.gu ? (256 * (n0 >> 7) + (jb.gu == 2 ? 128 : 0) + (n0 & 127)) : n0;
    if (jb.f8) tr_tile8(jb.src + (size_t)bi * jb.sbs, jb.N, jb.ksc, W8_SCALE, (unsigned char*)jb.dst + (size_t)bi * jb.dbs, jb.ldd, tk * 128, n0, drow0, tl, tid);
    else tr_tile(jb.src + (size_t)bi * jb.sbs, jb.N, jb.ksc, jb.dst + (size_t)bi * jb.dbs, jb.ldd, tk * 128, n0, drow0, tl, tid);
}
typedef __attribute__((address_space(4))) const unsigned long long kcu64_t;
#define PIN(i) ((const float*)(__attribute__((address_space(1))) const float*)ka[i])
__device__ __forceinline__ void phase_prologue(kcu64_t* ka, unsigned char* ws, LAS unsigned char* lds, int G, int bid, int tid) {
    LAS unsigned* tl = (LAS unsigned*)lds;
    constexpr int NJ = 12;
    const int cnts[NJ] = {16 * 72, 16 * 32, 4096, 4096, 4096, 16 * 61, 16 * 32, 4096, 4096, 4096, 4 * 24, 2 * 32};
    int total = 0;
#pragma unroll
    for (int j = 0; j < NJ; ++j) total += cnts[j];
    for (int t = bid; t < total; t += G) {
        int j = 0, base = 0;
#pragma unroll
        for (int q = 0; q < NJ - 1; ++q) if (t >= base + cnts[q] && j == q) { base += cnts[q]; j = q + 1; }
        const int tt = t - base;
        TJob jb;
        switch (j) {
            case 0: jb = TJob{PIN(I_WIN0), (bf16_t*)(ws + WS_WIN0), nullptr, 2048, IN0, 2048, 0, 0, 0, F8_IN}; break;
            case 1: jb = TJob{PIN(I_WOUT0), (bf16_t*)(ws + WS_WOUT0), nullptr, 2048, 2048, 2048, 0, 0, 0, F8_OUT}; break;
            case 2: jb = TJob{PIN(I_WG0), (bf16_t*)(ws + WS_WGU0), nullptr, 2048, 512, 2048, 1, (size_t)2048 * 512, (size_t)1024 * 2048, F8_GU}; break;
            case 3: jb = TJob{PIN(I_WU0), (bf16_t*)(ws + WS_WGU0), nullptr, 2048, 512, 2048, 2, (size_t)2048 * 512, (size_t)1024 * 2048, F8_GU}; break;
            case 4: jb = TJob{PIN(I_WD0), (bf16_t*)(ws + WS_WD0), nullptr, 512, 2048, 512, 0, (size_t)512 * 2048, (size_t)2048 * 512, F8_DOWN}; break;
            case 5: jb = TJob{PIN(I_WIN1), (bf16_t*)(ws + WS_WIN1), nullptr, 2048, IN1, 2048, 0, 0, 0, F8_IN}; break;
            case 6: jb = TJob{PIN(I_WOUT1), (bf16_t*)(ws + WS_WOUT1), nullptr, 2048, 2048, 2048, 0, 0, 0, F8_OUT}; break;
            case 7: jb = TJob{PIN(I_WG1), (bf16_t*)(ws + WS_WGU1), nullptr, 2048, 512, 2048, 1, (size_t)2048 * 512, (size_t)1024 * 2048, F8_GU}; break;
            case 8: jb = TJob{PIN(I_WU1), (bf16_t*)(ws + WS_WGU1), nullptr, 2048, 512, 2048, 2, (size_t)2048 * 512, (size_t)1024 * 2048, F8_GU}; break;
            case 9: jb = TJob{PIN(I_WD1), (bf16_t*)(ws + WS_WD1), nullptr, 512, 2048, 512, 0, (size_t)512 * 2048, (size_t)2048 * 512, F8_DOWN}; break;
            case 10: jb = TJob{PIN(I_WQUP), (bf16_t*)(ws + WS_WQUP), PIN(I_DQN), 512, 1536, 512, 0, 0, 0, 0}; break;
            default: jb = TJob{PIN(I_WKVUP), (bf16_t*)(ws + WS_WKVUP), PIN(I_DKVN), 256, 2048, 256, 0, 0, 0, 0}; break;
        }
        run_tjob(jb, tt, tl, tid);
    }
    { constexpr size_t ESZ = F8_IN ? 1 : 2;
      u32x4* z = (u32x4*)(ws + WS_WIN1 + (size_t)IN1 * 2048 * ESZ); const size_t n16 = (size_t)(IN1P - IN1) * 2048 * ESZ / 16;
      const unsigned zu = __float_as_uint(fresh_zero());
      for (size_t i = (size_t)bid * NTHR + tid; i < n16; i += (size_t)G * NTHR) z[i] = (u32x4){zu, zu, zu, zu}; }
    { const f32x8* xs = (const f32x8*)PIN(I_X); const size_t n8 = (size_t)T_ * DM / 8;
      if constexpr (F8_IN) { u32x2* xd = (u32x2*)(ws + WS_RC + 64 * MiB);
          for (size_t i = (size_t)bid * NTHR + tid; i < n8; i += (size_t)G * NTHR) { const f32x8 v = xs[i]; xd[i] = (u32x2){pk4_fp8(v[0], v[1], v[2], v[3]), pk4_fp8(v[4], v[5], v[6], v[7])}; } }
      else { u32x4* xd = (u32x4*)(ws + WS_RA);
          for (size_t i = (size_t)bid * NTHR + tid; i < n8; i += (size_t)G * NTHR) { const f32x8 v = xs[i];
              xd[i] = (u32x4){cvtpk(v[0], v[1]), cvtpk(v[2], v[3]), cvtpk(v[4], v[5]), cvtpk(v[6], v[7])}; } } }
}

__device__ __forceinline__ void phase_prep_qk(bf16_t* H0, const float* qn, const float* kn, int G, int bid, int tid) {
    const int wid = tid >> 6, lane = tid & 63, i = lane & 31, half = lane >> 5;
    const float invf = inv_freq32(i);
    const int e0 = 64 * half + i, e1 = e0 + 32;
    const float gq0 = qn[e0], gq1 = qn[e1], gk0 = kn[e0], gk1 = kn[e1];
    for (int m = bid * 8 + wid; m < T_; m += G * 8) {
        const int s = m & (SEQ - 1); const int pos = half ? (s & 63) : (s >> 6);
        float sn, cs; sincos_rev((float)pos * invf, sn, cs);
        bf16_t* rowp = H0 + (size_t)m * IN0;
#pragma unroll
        for (int hh = 0; hh < 10; ++hh) {
            bf16_t* base = rowp + (hh < 8 ? hh * 128 : 1024 + (hh - 8) * 128);
            const float x0 = bf2f(base[e0]), x1 = bf2f(base[e1]);
            const float ss = wave_sum(x0 * x0 + x1 * x1);
            const float r = rsqrtf(ss * (1.0f / 128.0f) + 1e-6f);
            const float y0 = x0 * r * (hh < 8 ? gq0 : gk0), y1 = x1 * r * (hh < 8 ? gq1 : gk1);
            base[e0] = f2bf(y0 * cs - y1 * sn); base[e1] = f2bf(y1 * cs + y0 * sn);
        }
    }
}
__device__ __forceinline__ void phase_prep_mla(bf16_t* H1, bf16_t* krope, int G, int bid, int tid) {
    const int wid = tid >> 6, lane = tid & 63;
    const float invf = inv_freq32(lane & 31);
    for (int m = bid * 8 + wid; m < T_; m += G * 8) {
        bf16_t* rowp = H1 + (size_t)m * IN1P;
        const u32x4 a = *(const u32x4*)(rowp + 3072 + lane * 8);
        float ss = bflo(a.x) * bflo(a.x) + bfhi(a.x) * bfhi(a.x) + bflo(a.y) * bflo(a.y) + bfhi(a.y) * bfhi(a.y) + bflo(a.z) * bflo(a.z) + bfhi(a.z) * bfhi(a.z) + bflo(a.w) * bflo(a.w) + bfhi(a.w) * bfhi(a.w);
        ss = wave_sum(ss);
        const u32x2 c = *(const u32x2*)(rowp + 3584 + lane * 4);
        float s2 = bflo(c.x) * bflo(c.x) + bfhi(c.x) * bfhi(c.x) + bflo(c.y) * bflo(c.y) + bfhi(c.y) * bfhi(c.y);
        s2 = wave_sum(s2);
        const float rq = rsqrtf(ss * (1.0f / 512.0f) + 1e-6f), rkv = rsqrtf(s2 * (1.0f / 256.0f) + 1e-6f);
        *(u32x4*)(rowp + 3072 + lane * 8) = (u32x4){cvtpk(bflo(a.x) * rq, bfhi(a.x) * rq), cvtpk(bflo(a.y) * rq, bfhi(a.y) * rq), cvtpk(bflo(a.z) * rq, bfhi(a.z) * rq), cvtpk(bflo(a.w) * rq, bfhi(a.w) * rq)};
        *(u32x2*)(rowp + 3584 + lane * 4) = (u32x2){cvtpk(bflo(c.x) * rkv, bfhi(c.x) * rkv), cvtpk(bflo(c.y) * rkv, bfhi(c.y) * rkv)};
        if (lane < 32) { const float x1 = bf2f(rowp[3840 + lane]), x2 = bf2f(rowp[3840 + 32 + lane]);
            float sn, cs; sincos_rev((float)(m & (SEQ - 1)) * invf, sn, cs);
            krope[(size_t)m * 64 + lane] = f2bf(x1 * cs - x2 * sn); krope[(size_t)m * 64 + 32 + lane] = f2bf(x2 * cs + x1 * sn); }
    }
}

constexpr int LNR_PITCH = 2050;
constexpr int LNR_PART = 131328, LNR_SC = 147712, LNR_SEL = 149760, LNR_BLE = 151808, LNR_HIST = 152832;
__device__ __forceinline__ void phase_ln_router(const float* z, const float* g, const float* bb, const float* rw, const float* rb, bf16_t* x1b, unsigned char* x1q,
                                                int* tok_e, int* tok_p, float* tok_g, int* list, unsigned* cnt, LAS unsigned char* lds, int G, int bid, int tid) {
    const int wid = tid >> 6, lane = tid & 63;
    LAS float* xs = (LAS float*)lds; LAS float* part = (LAS float*)(lds + LNR_PART); LAS float* scs = (LAS float*)(lds + LNR_SC); LAS float* sels = (LAS float*)(lds + LNR_SEL);
    LAS int* ble = (LAS int*)(lds + LNR_BLE); LAS int* hist = (LAS int*)(lds + LNR_HIST);
    int ntl = 0;
    for (int it = 0; bid + G * it < T_ / 16; ++it) {
        const int tix = bid + G * it;
#pragma unroll 1
        for (int rr = 0; rr < 2; ++rr) {
            const int row = 2 * wid + rr; const size_t m = (size_t)tix * 16 + row;
            f32x4 v[8]; float s = 0.f;
#pragma unroll
            for (int i = 0; i < 8; ++i) { v[i] = *(const f32x4*)(z + m * DM + 4 * lane + 256 * i); s += (v[i][0] + v[i][1]) + (v[i][2] + v[i][3]); }
            const float mean = wave_sum(s) * (1.0f / DM); float q = 0.f;
#pragma unroll
            for (int i = 0; i < 8; ++i) { const f32x4 d = v[i] - mean; q += (d[0] * d[0] + d[1] * d[1]) + (d[2] * d[2] + d[3] * d[3]); }
            const float rstd = rsqrtf(wave_sum(q) * (1.0f / DM) + 1e-5f);
#pragma unroll
            for (int i = 0; i < 8; ++i) { const int col = 4 * lane + 256 * i; const f32x4 gv = *(const f32x4*)(g + col), bv = *(const f32x4*)(bb + col);
                const f32x4 y = (v[i] - mean) * rstd * gv + bv;
                LAS f32x2* xp = (LAS f32x2*)(xs + row * LNR_PITCH + col); xp[0] = (f32x2){y[0], y[1]}; xp[1] = (f32x2){y[2], y[3]};
                *(u32x2*)(x1b + m * DM + col) = (u32x2){cvtpk(y[0], y[1]), cvtpk(y[2], y[3])};
                if constexpr (F8_GU) *(unsigned*)(x1q + m * DM + col) = pk4_fp8(y[0], y[1], y[2], y[3]); }
        }
        __syncthreads();
        { f32x4 acc0 = {0.f, 0.f, 0.f, 0.f}, acc1 = {0.f, 0.f, 0.f, 0.f}; const int k0 = 256 * wid + (lane >> 4); const int e = lane & 15;
#pragma unroll 4
          for (int kk = 0; kk < 64; ++kk) { const int k = k0 + 4 * kk; const float a = xs[(lane & 15) * LNR_PITCH + k]; const float b0 = rw[k * 32 + e], b1 = rw[k * 32 + 16 + e];
              acc0 = __builtin_amdgcn_mfma_f32_16x16x4f32(a, b0, acc0, 0, 0, 0); acc1 = __builtin_amdgcn_mfma_f32_16x16x4f32(a, b1, acc1, 0, 0, 0); }
#pragma unroll
          for (int r = 0; r < 4; ++r) { const int row = (lane >> 4) * 4 + r; part[(wid * 16 + row) * 32 + e] = acc0[r]; part[(wid * 16 + row) * 32 + 16 + e] = acc1[r]; } }
        __syncthreads();
        { const int row = tid >> 5, e = tid & 31; float lg = 0.f;
#pragma unroll
          for (int w = 0; w < 8; ++w) lg += part[(w * 16 + row) * 32 + e];
          const float sc = 1.0f / (1.0f + __expf(-lg)); scs[row * 32 + e] = sc; sels[row * 32 + e] = sc + rb[e]; }
        __syncthreads();
        if (tid < 16) { const int row = tid; float best = -INFINITY; int bg = 0;
            for (int gI = 0; gI < 8; ++gI) { const float a = sels[row * 32 + 4 * gI], b = sels[row * 32 + 4 * gI + 1], c = sels[row * 32 + 4 * gI + 2], d = sels[row * 32 + 4 * gI + 3];
                const float h1 = fmaxf(a, b), l1 = fminf(a, b), h2 = fmaxf(c, d), l2 = fminf(c, d); const float gs = fmaxf(h1, h2) + fmaxf(fminf(h1, h2), fmaxf(l1, l2));
                if (gs > best) { best = gs; bg = gI; } }
            const float v0 = sels[row * 32 + 4 * bg], v1 = sels[row * 32 + 4 * bg + 1], v2 = sels[row * 32 + 4 * bg + 2], v3 = sels[row * 32 + 4 * bg + 3];
            int i1 = 0; float b1 = v0; if (v1 > b1) { b1 = v1; i1 = 1; } if (v2 > b1) { b1 = v2; i1 = 2; } if (v3 > b1) { b1 = v3; i1 = 3; }
            int i2 = -1; float b2 = -INFINITY;
            if (i1 != 0 && v0 > b2) { b2 = v0; i2 = 0; } if (i1 != 1 && v1 > b2) { b2 = v1; i2 = 1; } if (i1 != 2 && v2 > b2) { b2 = v2; i2 = 2; } if (i1 != 3 && v3 > b2) { b2 = v3; i2 = 3; }
            const int e1 = 4 * bg + i1, e2 = 4 * bg + i2; const float s1 = scs[row * 32 + e1], s2 = scs[row * 32 + e2]; const float inv = 1.0f / (s1 + s2);
            const size_t m = (size_t)tix * 16 + row;
            tok_e[2 * m] = e1; tok_e[2 * m + 1] = e2; tok_g[2 * m] = s1 * inv; tok_g[2 * m + 1] = s2 * inv;
            ble[(it * 16 + row) * 2] = e1; ble[(it * 16 + row) * 2 + 1] = e2; }
        __syncthreads();
        ntl = it + 1;
    }
    const int nasg = ntl * 32;
    if (tid < 32) { int c = 0; for (int i = 0; i < nasg; ++i) c += (ble[i] == tid) ? 1 : 0;
        unsigned base = 0; if (c) base = __hip_atomic_fetch_add(cnt + tid, (unsigned)c, __ATOMIC_RELAXED, __HIP_MEMORY_SCOPE_AGENT);
        hist[tid] = (int)base; }
    __syncthreads();
    if (tid < 32) { int run = hist[tid];
        for (int i = 0; i < nasg; ++i) if (ble[i] == tid) { const int tr = i >> 1; const size_t m = (size_t)(bid + G * (tr >> 4)) * 16 + (tr & 15);
            list[(size_t)tid * 65536 + run] = (int)m; tok_p[2 * m + (i & 1)] = run; ++run; } }
    __syncthreads();
}

constexpr int MOE_LDS = 131072;
__device__ __forceinline__ int moe_prefix(const unsigned* cnt, LAS int* pblk, int tid) {
    if (tid == 0) { int acc = 0; for (int e = 0; e < NE; ++e) { pblk[e] = acc; acc += ((int)cnt[e] + 255) >> 8; } pblk[NE] = acc; }
    __syncthreads();
    return pblk[NE];
}
template <int NJ> __device__ __forceinline__ int moe_table(const unsigned* cnt, LAS int* pblk, LAS int* tab, LAS int* aux, int NB, int G, int bid, int tid) {
    const int NU = NB * NJ;
    if (tid < 16) { const int L = bid + G * tid;
        if (L < NU) { const int rb = L / NJ, j = L % NJ; int e = 0; for (int q = 1; q < NE; ++q) if (pblk[q] <= rb) e = q;
            tab[tid] = rb; tab[16 + tid] = NJ * e + j; aux[tid * 3] = e; aux[tid * 3 + 1] = (rb - pblk[e]) * 256; aux[tid * 3 + 2] = (int)cnt[e]; } }
    __syncthreads();
    int n = 0; for (int i = 0; i < 16; ++i) if (bid + G * i < NU) n = i + 1;
    return n;
}

template <bool FINAL>
__device__ __forceinline__ void phase_combine_ln(const bf16_t* x1b, const bf16_t* Yr, const int* tok_e, const int* tok_p, const float* tok_g, const unsigned* cnt,
                                                 const float* g, const float* bb, bf16_t* xo, unsigned char* xq, float* fo, LAS unsigned char* lds, int G, int bid, int tid) {
    LAS int* pblk = (LAS int*)lds;
    moe_prefix(cnt, pblk, tid);
    const int wid = tid >> 6, lane = tid & 63;
    for (int m = bid * 8 + wid; m < T_; m += G * 8) {
        const int e0 = tok_e[2 * m], e1 = tok_e[2 * m + 1];
        const size_t p0 = (size_t)pblk[e0] * 256 + tok_p[2 * m], p1 = (size_t)pblk[e1] * 256 + tok_p[2 * m + 1];
        const float g0 = tok_g[2 * m], g1 = tok_g[2 * m + 1];
        float v[32]; float s = 0.f;
#pragma unroll
        for (int i = 0; i < 4; ++i) { const int col = 8 * lane + 512 * i;
            const u32x4 xa = *(const u32x4*)(x1b + (size_t)m * DM + col), ya = *(const u32x4*)(Yr + p0 * DM + col), yb = *(const u32x4*)(Yr + p1 * DM + col);
            const unsigned xw[4] = {xa.x, xa.y, xa.z, xa.w}, aw[4] = {ya.x, ya.y, ya.z, ya.w}, bw[4] = {yb.x, yb.y, yb.z, yb.w};
#pragma unroll
            for (int j = 0; j < 4; ++j) { v[i * 8 + 2 * j] = ALPHA * bflo(xw[j]) + g0 * bflo(aw[j]) + g1 * bflo(bw[j]); v[i * 8 + 2 * j + 1] = ALPHA * bfhi(xw[j]) + g0 * bfhi(aw[j]) + g1 * bfhi(bw[j]);
                s += v[i * 8 + 2 * j] + v[i * 8 + 2 * j + 1]; } }
        const float mean = wave_sum(s) * (1.0f / DM); float q = 0.f;
#pragma unroll
        for (int i = 0; i < 32; ++i) { const float d = v[i] - mean; q += d * d; }
        const float rstd = rsqrtf(wave_sum(q) * (1.0f / DM) + 1e-5f);
#pragma unroll
        for (int i = 0; i < 4; ++i) { const int col = 8 * lane + 512 * i;
            const f32x4 ga = *(const f32x4*)(g + col), gb = *(const f32x4*)(g + col + 4), ba = *(const f32x4*)(bb + col), bbv = *(const f32x4*)(bb + col + 4);
            float y[8];
#pragma unroll
            for (int j = 0; j < 4; ++j) { y[j] = (v[i * 8 + j] - mean) * rstd * ga[j] + ba[j]; y[4 + j] = (v[i * 8 + 4 + j] - mean) * rstd * gb[j] + bbv[j]; }
            if constexpr (FINAL) { *(f32x4*)(fo + (size_t)m * DM + col) = (f32x4){y[0], y[1], y[2], y[3]}; *(f32x4*)(fo + (size_t)m * DM + col + 4) = (f32x4){y[4], y[5], y[6], y[7]}; }
            else { *(u32x4*)(xo + (size_t)m * DM + col) = (u32x4){cvtpk(y[0], y[1]), cvtpk(y[2], y[3]), cvtpk(y[4], y[5]), cvtpk(y[6], y[7])};
                if constexpr (F8_IN) *(u32x2*)(xq + (size_t)m * DM + col) = (u32x2){pk4_fp8(y[0], y[1], y[2], y[3]), pk4_fp8(y[4], y[5], y[6], y[7])}; } }
    }
}

#ifndef ATT_ONLY
#define ATT_ONLY -1
#endif
#ifndef REP_K
#define REP_K -1
#endif
#ifndef REP_ATT
#define REP_ATT -1
#endif
#define NREP(k) ((REP_K == (k)) ? 2 : 1)
#define NREPA(k) ((REP_ATT == (k)) ? 2 : 1)
constexpr int N_PHASES = 20;
__global__ void __launch_bounds__(NTHR, 2) fwd(Params p) {
    extern __shared__ __attribute__((aligned(16))) unsigned char lds_raw[];
    LAS unsigned char* lds = (LAS unsigned char*)lds_raw;
    const int tid0 = threadIdx.x, bid = blockIdx.x, G = gridDim.x;
    const int wv = __builtin_amdgcn_readfirstlane(tid0 >> 6);
    const int vcu = (G % 8 == 0) ? (bid % 8) * (G / 8) + bid / 8 : bid;
    unsigned* ctl = (unsigned*)(p.ws + WS_CTL);
    if (tid0 < 4) ((LAS unsigned*)(lds + MISC_OFF))[tid0] = 0u;
    __syncthreads();
    XcdBarrier bar; bar.bar = ctl + CW_BAR; bar.x = 0; bar.st = (volatile LAS unsigned*)(lds + MISC_OFF);
    if (N_LAUNCH_MODE == 1) bar = xcd_barrier_post(ctl + CW_BAR, (volatile LAS unsigned*)(lds + MISC_OFF));
    const int lo = p.ph_lo, hi = p.ph_hi;
#ifndef PH_ONLY
#define PH_ONLY -1
#endif
#define IN(k) ((PH_ONLY < 0 || (PH_ONLY % 10) == ((k) % 10)) && lo <= (k) && (k) < hi)
#define SEAM(k) do { if ((k) + 1 < hi) xcd_barrier(bar); } while (0)

    for (int L = 0; L < 2; ++L) {
        const int pb = L * 10;
        typedef __attribute__((address_space(1))) unsigned char gu8;
        typedef __attribute__((address_space(1))) const float gcf;
        typedef __attribute__((address_space(4))) const unsigned long long kcu64;
#define INP(i) ((const float*)(gcf*)ka[i])
#define PHASE_PTRS \
        kcu64* ka = (kcu64*)__builtin_amdgcn_kernarg_segment_ptr(); asm volatile("" : "+s"(ka)); \
        unsigned char* ws = (unsigned char*)(gu8*)ka[29]; unsigned char* outb = (unsigned char*)(gu8*)ka[28]; \
        unsigned* ctl = (unsigned*)(ws + WS_CTL); \
        bf16_t* RA = (bf16_t*)(ws + WS_RA); bf16_t* RB = (bf16_t*)(ws + WS_RB); bf16_t* RC = (bf16_t*)(ws + WS_RC); \
        int* list = (int*)(ws + WS_LIST); int* tok_e = (int*)(ws + WS_TOKE); int* tok_p = (int*)(ws + WS_TOKP); float* tok_g = (float*)(ws + WS_TOKG); \
        bf16_t* krope = (bf16_t*)(ws + WS_KROPE); \
        bf16_t* Qd = (bf16_t*)(outb + OUT_QD); bf16_t* O1 = (bf16_t*)(outb + OUT_O1); \
        const bf16_t* Win = (const bf16_t*)(ws + (L ? WS_WIN1 : WS_WIN0)); const bf16_t* Wout = (const bf16_t*)(ws + (L ? WS_WOUT1 : WS_WOUT0)); \
        const bf16_t* Wgu = (const bf16_t*)(ws + (L ? WS_WGU1 : WS_WGU0)); const bf16_t* Wd = (const bf16_t*)(ws + (L ? WS_WD1 : WS_WD0)); \
        const int NIN = L ? IN1P : IN0; \
        const bf16_t* xin = L ? RC : RA; \
        bf16_t* Hx = RB; bf16_t* Oat = L ? O1 : RC; float* Z = (float*)RB; \
        bf16_t* x1b = RA; bf16_t* Hm = RC; bf16_t* Yr = RB; \
        unsigned* cnt = ctl + CW_CNT + L * 64; \
        (void)ctl; (void)RA; (void)RB; (void)RC; (void)list; (void)tok_e; (void)tok_p; (void)tok_g; (void)krope; (void)Qd; (void)O1; (void)Win; (void)Wout; (void)Wgu; (void)Wd; (void)NIN; (void)xin; (void)Hx; (void)Oat; (void)Z; (void)x1b; (void)Hm; (void)Yr; (void)cnt; (void)outb

        if (L == 0 && IN(0)) { PHASE_PTRS; _Pragma("unroll 1") for (int rep = 0; rep < NREP(0); ++rep) phase_prologue(ka, ws, lds, G, bid, fresh_tid(wv)); SEAM(0); }

        if (IN(pb + 1)) {
            PHASE_PTRS;
            constexpr int KI = F8_IN ? 1024 : 2048;
            const bf16_t* ain = F8_IN ? (L ? (const bf16_t*)outb : (const bf16_t*)((unsigned char*)RC + 64 * MiB)) : xin;
            pg8::Gemm g{ain, Win, KI, KI, KI}; pg8::StaticOrder S; S.init(T_, NIN, G, bid, KI);
            pg8::EpiBf16 E{Hx, NIN, 0xffff};
            _Pragma("unroll 1") for (int rep = 0; rep < NREP(1); ++rep) pg8::gemm_phase<F8_IN != 0>(wv, lds, g, S, E, W8_SBYTE, 0x7f7f7f7f);
            SEAM(pb + 1);
        }
        if (IN(pb + 2)) {
            PHASE_PTRS;
            if (L == 0) phase_prep_qk(Hx, INP(I_AQN), INP(I_AKN), G, bid, fresh_tid(wv));
            else phase_prep_mla(Hx, krope, G, bid, fresh_tid(wv));
            SEAM(pb + 2);
        }
        if (L == 1 && IN(pb + 3)) _Pragma("unroll 1") for (int rep = 0; rep < NREP(3); ++rep) {
            PHASE_PTRS;
#ifndef P3_ONLY
#define P3_ONLY -1
#endif
            if (P3_ONLY < 0 || P3_ONLY == 0) { pg8::Gemm g{Hx + 3072, (const bf16_t*)(ws + WS_WQUP), 512, IN1P, 512}; pg8::StaticOrder S; S.init(T_, 1536, G, bid, IN1P);
              pg8::EpiBf16 E{Qd, 1536, 0xffff}; pg8::gemm_phase<false>(wv, lds, g, S, E); }
            if (P3_ONLY < 0 || P3_ONLY == 1) { pg8::Gemm g{Hx + 3584, (const bf16_t*)(ws + WS_WKVUP), 256, IN1P, 256}; pg8::StaticOrder S; S.init(T_, 2048, G, bid, IN1P);
              pg8::EpiBf16 E{RA, 2048, 0xffff}; pg8::gemm_phase<false>(wv, lds, g, S, E); }
            if (rep + 1 == NREP(3)) SEAM(pb + 3);
        }
        if (IN(pb + 4)) {
            PHASE_PTRS;
            if (L == 0) {
                if (ATT_ONLY < 0 || ATT_ONLY == 0)
                _Pragma("unroll 1") for (int rep = 0; rep < NREPA(0); ++rep)
                for (int u = vcu; u < 1024; u += G) {
                    __syncthreads();
                    const int b = u >> 7, qb = u & 15, kvh = (u >> 6) & 1, gq = (u >> 4) & 3, h = kvh * 4 + gq;
                    da::DArgs a; a.Q = Hx + (size_t)(b * SEQ + 256 * qb) * IN0 + h * 128; a.ldq = IN0;
                    a.K = Hx + (size_t)b * SEQ * IN0 + 1024 + kvh * 128; a.ldk = IN0; a.V = Hx + (size_t)b * SEQ * IN0 + 1280 + kvh * 128; a.ldv = IN0; a.Kr = nullptr;
                    { const size_t eo = (size_t)(b * SEQ + 256 * qb) * DM + h * 128; a.O = F8_OUT ? (bf16_t*)((unsigned char*)Oat + eo) : Oat + eo; } a.ldo = DM; a.seq = SEQ; a.pos0 = 0;
                    da::attn_dense_body<8, 1>(wv, a, (char*)lds_raw);
                }
                __syncthreads();
                if (ATT_ONLY < 0 || ATT_ONLY == 2)
                _Pragma("unroll 1") for (int rep = 0; rep < NREPA(2); ++rep)
                for (int it = vcu; it < 1024; it += G) {
                    const int tid2 = fresh_tid(wv), wid = __builtin_amdgcn_readfirstlane(tid2 >> 6), lane = tid2 & 63;
                    const int w = it * 8 + wid; LAS unsigned char* wl = lds + wid * da::SP_WAVE_LDS;
                    PolB pol; pol.init(Hx, Oat, w, lane); da::sparse_wave(pol, wl, lane);
                }
            } else {
                if (ATT_ONLY < 0 || ATT_ONLY == 1)
                _Pragma("unroll 1") for (int rep = 0; rep < NREPA(1); ++rep)
                for (int u = vcu; u < 1024; u += G) {
                    __syncthreads();
                    const int b = u >> 7, qb = u & 15, h = (u >> 4) & 7;
                    da::DArgs a; a.Q = Qd + (size_t)(b * SEQ + 256 * qb) * 1536 + h * 192; a.ldq = 1536;
                    a.K = RA + (size_t)b * SEQ * DM + h * 256; a.ldk = DM; a.V = a.K + 128; a.ldv = DM; a.Kr = krope + (size_t)b * SEQ * 64;
                    { const size_t eo = (size_t)(b * SEQ + 256 * qb) * DM + 1024 + h * 128; a.O = F8_OUT ? (bf16_t*)((unsigned char*)Oat + eo) : Oat + eo; } a.ldo = DM; a.seq = SEQ; a.pos0 = 256 * qb;
                    da::attn_dense_body<12, 1>(wv, a, (char*)lds_raw);
                }
                __syncthreads();
                if (ATT_ONLY < 0 || ATT_ONLY == 3)
                _Pragma("unroll 1") for (int rep = 0; rep < NREPA(3); ++rep)
                for (int it = vcu; it < 1024; it += G) {
                    const int tid2 = fresh_tid(wv), wid = __builtin_amdgcn_readfirstlane(tid2 >> 6), lane = tid2 & 63;
                    const int w = it * 8 + wid; LAS unsigned char* wl = lds + wid * da::SP_WAVE_LDS;
                    PolC pol; pol.init(Hx, Oat, INP(I_RPB), (float*)((char*)wl + 16640), w, lane); da::sparse_wave(pol, wl, lane);
                }
            }
            SEAM(pb + 4);
        }
        if (IN(pb + 5)) {
            PHASE_PTRS;
            constexpr int KO = F8_OUT ? 1024 : 2048; constexpr int SXO = F8_OUT ? 0x7b7b7b7b : 0x7f7f7f7f;
            pg8::Gemm g{Oat, Wout, KO, KO, KO}; pg8::StaticOrder S; S.init(T_, DM, G, bid, KO);
            if (L == 0) { pg8::EpiResF32<true> E{Z, INP(I_X)}; _Pragma("unroll 1") for (int rep = 0; rep < NREP(5); ++rep) pg8::gemm_phase<F8_OUT != 0>(wv, lds, g, S, E, W8_SBYTE, SXO); }
            else { pg8::EpiResF32<false> E{Z, RC}; _Pragma("unroll 1") for (int rep = 0; rep < NREP(5); ++rep) pg8::gemm_phase<F8_OUT != 0>(wv, lds, g, S, E, W8_SBYTE, SXO); }
            SEAM(pb + 5);
        }
        if (IN(pb + 6)) {
            PHASE_PTRS;
            phase_ln_router(Z, INP(L ? I_LN1G1 : I_LN1G0), INP(L ? I_LN1B1 : I_LN1B0), INP(I_RW), INP(I_RB), x1b, (unsigned char*)RC + 64 * MiB, tok_e, tok_p, tok_g, list, cnt, lds, G, bid, fresh_tid(wv));
            SEAM(pb + 6);
        }
        if (IN(pb + 7)) {
            PHASE_PTRS;
            LAS int* pblk = (LAS int*)(lds + MOE_LDS); LAS int* tab = pblk + 64; LAS int* aux = tab + 32; LAS int* idx = aux + 64;
            const int tid = fresh_tid(wv);
            const int NB = moe_prefix(cnt, pblk, tid);
            const int n = moe_table<4>(cnt, pblk, tab, aux, NB, G, bid, tid);
            for (int i = 0; i < n; ++i) if (tid < 256) { const int e = aux[i * 3], rs = aux[i * 3 + 1], ce = aux[i * 3 + 2]; idx[i * 256 + tid] = list[(size_t)e * 65536 + min(rs + tid, ce - 1)]; }
            __syncthreads();
            constexpr int KG = F8_GU ? 1024 : 2048;
            const bf16_t* agu = F8_GU ? (const bf16_t*)((unsigned char*)RC + 64 * MiB) : x1b;
            pg8::Gemm g{agu, Wgu, KG, KG, KG}; pg8::TableOrder<true> S{tab, idx, n, KG}; pg8::EpiSiluMul<F8_DOWN != 0> E{Hm};
            _Pragma("unroll 1") for (int rep = 0; rep < NREP(7); ++rep) pg8::gemm_phase<F8_GU != 0>(wv, lds, g, S, E, W8_SBYTE, 0x7f7f7f7f);
            SEAM(pb + 7);
        }
        if (IN(pb + 8)) {
            PHASE_PTRS;
            LAS int* pblk = (LAS int*)(lds + MOE_LDS); LAS int* tab = pblk + 64; LAS int* aux = tab + 32;
            const int tid = fresh_tid(wv);
            const int NB = moe_prefix(cnt, pblk, tid);
            const int n = moe_table<8>(cnt, pblk, tab, aux, NB, G, bid, tid);
            constexpr int KD = F8_DOWN ? 256 : 512;
            pg8::Gemm g{Hm, Wd, KD, KD, KD}; pg8::TableOrder<false> S{tab, nullptr, n, KD}; pg8::EpiBf16 E{Yr, DM, 7};
            _Pragma("unroll 1") for (int rep = 0; rep < NREP(8); ++rep) pg8::gemm_phase<F8_DOWN != 0>(wv, lds, g, S, E, W8_SBYTE, 0x7f7f7f7f);
            SEAM(pb + 8);
        }
        if (IN(pb + 9)) _Pragma("unroll 1") for (int rep = 0; rep < NREP(9); ++rep) {
            PHASE_PTRS;
            if (L == 0) phase_combine_ln<false>(x1b, Yr, tok_e, tok_p, tok_g, cnt, INP(I_LN2G0), INP(I_LN2B0), RC, outb, nullptr, lds, G, bid, fresh_tid(wv));
            else phase_combine_ln<true>(x1b, Yr, tok_e, tok_p, tok_g, cnt, INP(I_LN2G1), INP(I_LN2B1), nullptr, nullptr, (float*)outb, lds, G, bid, fresh_tid(wv));
            if (rep + 1 == NREP(9)) SEAM(pb + 9);
        }
    }
#undef IN
#undef SEAM
#undef INP
#undef PHASE_PTRS
}

extern "C" void kernel_launch(void* const* d_in, const int* in_sizes, int n_in, void* d_out, int out_size, void* d_ws, size_t ws_size, hipStream_t stream) {
    static int grid = 0;
    if (grid == 0) {
        if (n_in != 28 || out_size != T_ * DM || ws_size < WS_END) { fprintf(stderr, "kernel_launch: unexpected shapes: n_in %d out %d ws %zu (need %zu)\n", n_in, out_size, ws_size, (size_t)WS_END); grid = -1; return; }
        int dev = 0, cus = 0, per_cu = 0;
        if (hipGetDevice(&dev) != hipSuccess || hipDeviceGetAttribute(&cus, hipDeviceAttributeMultiprocessorCount, dev) != hipSuccess) { grid = -1; return; }
        if (hipFuncSetAttribute((const void*)fwd, hipFuncAttributeMaxDynamicSharedMemorySize, LDS_BYTES) != hipSuccess) { fprintf(stderr, "kernel_launch: hipFuncSetAttribute failed\n"); grid = -1; return; }
        if (hipOccupancyMaxActiveBlocksPerMultiprocessor(&per_cu, (const void*)fwd, NTHR, LDS_BYTES) != hipSuccess || per_cu < 1)
            fprintf(stderr, "kernel_launch: occupancy query reports %d workgroups per CU\n", per_cu);
        (void)hipGetLastError();
        grid = cus;
    }
    if (grid < 0) return;
    (void)hipMemsetAsync((char*)d_ws + WS_CTL, 0, CTL_ZERO_BYTES, stream);
    Params p{};
    for (int i = 0; i < 28; ++i) p.in[i] = (const float*)d_in[i];
    p.out = (float*)d_out; p.ws = (unsigned char*)d_ws;
#if N_LAUNCH_MODE == 1
    p.ph_lo = 0; p.ph_hi = N_PHASES;
    hipLaunchKernelGGL(fwd, dim3(grid), dim3(NTHR), LDS_BYTES, stream, p);
#else
    for (int k = 0; k < N_PHASES; ++k) { if (k == 3 || k == 10) continue; p.ph_lo = k; p.ph_hi = k + 1;
        hipLaunchKernelGGL(fwd, dim3(grid), dim3(NTHR), LDS_BYTES, stream, p); }
#endif
    const hipError_t le = hipPeekAtLastError();
    if (le != hipSuccess) fprintf(stderr, "kernel_launch: launch failed: %s\n", hipGetErrorName(le));
}
```

```cpp
#include <hip/hip_runtime.h>
#include <cstdio>
#include <cstdint>

#ifndef N_LAUNCH_MODE
#define N_LAUNCH_MODE 1
#endif
#ifndef DBG_CHECK
#define DBG_CHECK 0
#endif
#ifndef F8_DOWN
#define F8_DOWN 1
#endif
#ifndef F8_GU
#define F8_GU 1
#endif
#ifndef F8_IN
#define F8_IN 1
#endif
#ifndef F8_OUT
#define F8_OUT 1
#endif

#define LAS __attribute__((address_space(3)))
typedef unsigned short bf16_t;
typedef short bf16x8 __attribute__((ext_vector_type(8)));
typedef short s16x4 __attribute__((ext_vector_type(4)));
typedef float f32x2 __attribute__((ext_vector_type(2)));
typedef float f32x4 __attribute__((ext_vector_type(4)));
typedef float f32x8 __attribute__((ext_vector_type(8)));
typedef float f32x16 __attribute__((ext_vector_type(16)));
typedef unsigned u32x2 __attribute__((ext_vector_type(2)));
typedef unsigned u32x4 __attribute__((ext_vector_type(4)));
typedef int i32x8 __attribute__((ext_vector_type(8)));
typedef _Float16 f16x8 __attribute__((ext_vector_type(8)));
typedef _Float16 f16x2 __attribute__((ext_vector_type(2)));
typedef int i32x4 __attribute__((ext_vector_type(4)));

constexpr int T_ = 32768, DM = 2048, SEQ = 4096, NBATCH = 8;
constexpr int IN0 = 4608, IN1 = 3904, IN1P = 4096;
constexpr int NE = 32, DE = 512, MAXBLK = 288;
constexpr float ALPHA = 1.4142135623730951f;
constexpr float LOG2E = 1.4426950408889634f;
constexpr int NTHR = 512;

constexpr size_t MiB = 1u << 20;
constexpr size_t WS_CTL = 0, CTL_ZERO_BYTES = 1 * MiB;
constexpr size_t WS_LIST = 1 * MiB;
constexpr size_t WS_TOKE = 9 * MiB;
constexpr size_t WS_TOKP = WS_TOKE + 256 * 1024;
constexpr size_t WS_TOKG = WS_TOKP + 256 * 1024;
constexpr size_t WS_RSTAT = WS_TOKG + 256 * 1024;
constexpr size_t WS_KROPE = 10 * MiB;
constexpr size_t WS_WIN0 = 16 * MiB, WS_WOUT0 = 34 * MiB, WS_WGU0 = 42 * MiB, WS_WD0 = 170 * MiB;
constexpr size_t WS_WIN1 = 234 * MiB, WS_WOUT1 = 250 * MiB, WS_WGU1 = 258 * MiB, WS_WD1 = 386 * MiB;
constexpr size_t WS_WQUP = 450 * MiB, WS_WKVUP = 452 * MiB;
constexpr size_t WS_RA = 454 * MiB, WS_RB = 582 * MiB, WS_RC = 870 * MiB, WS_END = 998 * MiB;
constexpr size_t OUT_QD = 0, OUT_O1 = 96 * MiB;
constexpr int CW_CNT = 64;
constexpr int CW_DBG = 512;
constexpr int CW_BAR = 4096;

constexpr int LDS_BYTES = 155648;
constexpr int MISC_OFF = LDS_BYTES - 64;

__device__ __forceinline__ unsigned cvtpk(float lo, float hi) { unsigned r; asm volatile("v_cvt_pk_bf16_f32 %0, %1, %2" : "=v"(r) : "v"(lo), "v"(hi)); return r; }
__device__ __forceinline__ float bf2f(unsigned short b) { return __uint_as_float(((unsigned)b) << 16); }
__device__ __forceinline__ float bflo(unsigned w) { return __uint_as_float(w << 16); }
__device__ __forceinline__ float bfhi(unsigned w) { return __uint_as_float(w & 0xffff0000u); }
__device__ __forceinline__ bf16_t f2bf(float f) { return (bf16_t)(cvtpk(f, f) & 0xffffu); }
__device__ __forceinline__ unsigned pk4_fp8(float a, float b, float c, float d) { int w = 0; w = __builtin_amdgcn_cvt_pk_fp8_f32(a, b, w, false); w = __builtin_amdgcn_cvt_pk_fp8_f32(c, d, w, true); return (unsigned)w; }
constexpr float O8_SCALE = 16.f;
__device__ __forceinline__ unsigned char f2fp8(float v) { return (unsigned char)(__builtin_amdgcn_cvt_pk_fp8_f32(v, v, 0, false) & 0xff); }
__device__ __forceinline__ float clamp8(float v) { return fminf(fmaxf(v, -400.f), 400.f); }
__device__ __forceinline__ int fresh_tid(int wv) { int l; asm volatile("v_mbcnt_lo_u32_b32 %0, -1, 0\n\tv_mbcnt_hi_u32_b32 %0, -1, %0" : "=v"(l)); return wv * 64 + l; }
__device__ __forceinline__ float fresh_zero() { float z; asm volatile("v_mov_b32 %0, 0" : "=v"(z)); return z; }
__device__ __forceinline__ float wave_sum(float v) {
    v += __int_as_float(__builtin_amdgcn_ds_swizzle(__float_as_int(v), (1 << 10) | 0x1f));
    v += __int_as_float(__builtin_amdgcn_ds_swizzle(__float_as_int(v), (2 << 10) | 0x1f));
    v += __int_as_float(__builtin_amdgcn_ds_swizzle(__float_as_int(v), (4 << 10) | 0x1f));
    v += __int_as_float(__builtin_amdgcn_ds_swizzle(__float_as_int(v), (8 << 10) | 0x1f));
    v += __int_as_float(__builtin_amdgcn_ds_swizzle(__float_as_int(v), (16 << 10) | 0x1f));
    auto rr = __builtin_amdgcn_permlane32_swap(__float_as_uint(v), __float_as_uint(v), false, false);
    return __uint_as_float(rr[0]) + __uint_as_float(rr[1]);
}
__device__ __forceinline__ float inv_freq32(int i) { return __builtin_amdgcn_exp2f(-(float)i * 0.41524101186092029f); }
__device__ __forceinline__ void sincos_rev(float angle, float& s, float& c) {
    float rev = angle * 0.15915494309189535f; rev = rev - floorf(rev);
    s = __builtin_amdgcn_sinf(rev); c = __builtin_amdgcn_cosf(rev);
}

#define XB_TMO      128
#define XB_XCNT(j)  (256  + 64 * (j))
#define XB_XSUB(j)  (1280 + 64 * (j))
#define XB_XGEN(j)  (2304 + 64 * (j))
#define XB_TOP      3328
#define XB_TOPGEN   3392
#define XCD_BAR_WORDS 3456
#define XB_SPIN_CAP (1u << 20)
__device__ __forceinline__ unsigned xb_ld(unsigned* p)              { return __hip_atomic_load(p, __ATOMIC_RELAXED, __HIP_MEMORY_SCOPE_AGENT); }
__device__ __forceinline__ unsigned xb_add(unsigned* p, unsigned v) { return __hip_atomic_fetch_add(p, v, __ATOMIC_RELAXED, __HIP_MEMORY_SCOPE_AGENT); }
__device__ __forceinline__ unsigned xb_xcc_id() { return (unsigned)__builtin_amdgcn_s_getreg((3 << 11) | 20) & 0xFu; }
#define XB_SPIN(cond, bar) do { unsigned _sp = 0; while (cond) { __builtin_amdgcn_s_sleep(1); \
    if ((++_sp & 255u) == 0u) { if (xb_ld(&(bar)[XB_TMO])) break; if (_sp > XB_SPIN_CAP) { atomicAdd(&(bar)[XB_TMO], 1u); break; } } } } while (0)
struct XcdBarrier { unsigned* bar; unsigned x; volatile LAS unsigned* st; };
__device__ __forceinline__ XcdBarrier xcd_barrier_post(unsigned* bar, volatile LAS unsigned* st) {
    XcdBarrier b; b.bar = bar; b.x = xb_xcc_id(); b.st = st;
    if (threadIdx.x == 0) (void)xb_add(&bar[XB_XCNT(b.x)], 1u);
    return b;
}
__device__ __forceinline__ void xcd_barrier_complete(unsigned* bar, unsigned x, unsigned& nloc, unsigned& nx) {
    const unsigned G = gridDim.x * gridDim.y * gridDim.z;
    unsigned sum, cnt, mine, sp = 0u;
    for (;;) {
        sum = 0u; cnt = 0u; mine = 0u;
#pragma unroll
        for (unsigned j = 0; j < 16; ++j) { const unsigned c = xb_ld(&bar[XB_XCNT(j)]); sum += c; cnt += (c > 0u) ? 1u : 0u; mine = (j == x) ? c : mine; }
        if (sum == G) break;
        __builtin_amdgcn_s_sleep(1);
        if ((++sp & 255u) == 0u) { if (xb_ld(&bar[XB_TMO])) break; if (sp > XB_SPIN_CAP) { atomicAdd(&bar[XB_TMO], 1u); break; } }
    }
    nloc = mine > 0u ? mine : 1u; nx = cnt > 0u ? cnt : 1u;
}
__device__ __forceinline__ void xcd_barrier(const XcdBarrier& b) {
    asm volatile("s_waitcnt vmcnt(0)" ::: "memory");
    __syncthreads();
    if (threadIdx.x == 0) {
        unsigned* bar = b.bar;
        __builtin_amdgcn_s_waitcnt(0);
        unsigned nloc = b.st[0], nx = b.st[1];
        if (nloc == 0u) { xcd_barrier_complete(bar, b.x, nloc, nx); b.st[0] = nloc; b.st[1] = nx; }
        const unsigned old = xb_add(&bar[XB_XSUB(b.x)], 1u);
        const unsigned gen = old / nloc;
        if (old + 1u == (gen + 1u) * nloc) {
            __builtin_amdgcn_fence(__ATOMIC_RELEASE, "agent");
            asm volatile("s_waitcnt vmcnt(0)" ::: "memory");
            const unsigned og = xb_add(&bar[XB_TOP], 1u);
            const unsigned tg = og / nx;
            if (og + 1u == (tg + 1u) * nx) xb_add(&bar[XB_TOPGEN], 1u);
            else XB_SPIN(xb_ld(&bar[XB_TOPGEN]) == tg, bar);
            __builtin_amdgcn_fence(__ATOMIC_ACQUIRE, "agent");
            xb_add(&bar[XB_XGEN(b.x)], 1u);
            asm volatile("s_waitcnt vmcnt(0)" ::: "memory");
        } else {
            XB_SPIN(xb_ld(&bar[XB_XGEN(b.x)]) == gen, bar);
            __builtin_amdgcn_fence(__ATOMIC_ACQUIRE, "agent");
            asm volatile("s_waitcnt vmcnt(0)" ::: "memory");
        }
    }
    __syncthreads();
}

namespace pg8 {
constexpr int BM = 256, BK = 64, HALF = 128, HTB = HALF * BK * 2, STAGE_BYTES = 8 * HTB, NXCD = 8, WGM = 8;
__device__ __forceinline__ int lds_byte(int r, int c) { const int st = (r >> 4) * 2 + (c >> 5), rr = r & 15, cc = c & 31, ob = rr * 64 + cc * 2; return st * 1024 + (ob ^ (((ob >> 9) & 1) << 5)); }
__device__ __forceinline__ void stage_rc(int b, int& R, int& C) { const int st = b / 1024, sb = b % 1024, swz = sb ^ (((sb >> 9) & 1) << 5); R = (st >> 1) * 16 + swz / 64; C = (st & 1) * 32 + (swz % 64) / 2; }
__device__ __forceinline__ int perm32(int rho) { const int n = rho >> 4, i = rho & 15; return 8 * (i >> 2) + 4 * n + (i & 3); }
struct Unit { int pm, pn, q; };
struct Gemm { const bf16_t* A; const bf16_t* Bt; int K, lda, ldb; };

struct StaticOrder {
    static constexpr bool GATHER = false;
    int nM, nN, nwg, G, c, lda;
    __device__ void init(int M, int N, int G_, int c_, int lda_) { nM = M / BM; nN = N / BM; nwg = nM * nN; G = G_; c = c_; lda = lda_; }
    __device__ __forceinline__ bool next(int i, Unit& u) const {
        const long L = (long)i * G + c; if (L >= nwg) return false;
        int wgid = (int)L; { const int q = nwg / NXCD, r = nwg % NXCD, xcd = wgid % NXCD, off = wgid / NXCD; wgid = (xcd < r ? xcd * (q + 1) : r * (q + 1) + (xcd - r) * q) + off; }
        const int nig = WGM * nN, gid = wgid / nig, fm = gid * WGM, gsz = (nM - fm) < WGM ? (nM - fm) : WGM;
        u.pm = fm + ((wgid % nig) % gsz); u.pn = (wgid % nig) / gsz; u.q = i; return true;
    }
    __device__ __forceinline__ void aoff(const Unit& u, const int (&R)[2], const int (&C)[2], unsigned (&o)[2][2]) const {
#pragma unroll
        for (int h = 0; h < 2; ++h)
#pragma unroll
            for (int i = 0; i < 2; ++i) o[h][i] = (unsigned)((u.pm * BM + h * HALF + R[i]) * lda + C[i]) * 2u;
    }
};
template <bool GATHER_> struct TableOrder {
    static constexpr bool GATHER = GATHER_;
    const LAS int* tab; const LAS int* idx; int n, lda;
    __device__ __forceinline__ bool next(int i, Unit& u) const { if (i >= n) return false; u.pm = tab[i]; u.pn = tab[16 + i]; u.q = i; return true; }
    __device__ __forceinline__ void aoff(const Unit& u, const int (&R)[2], const int (&C)[2], unsigned (&o)[2][2]) const {
#pragma unroll
        for (int h = 0; h < 2; ++h)
#pragma unroll
            for (int i = 0; i < 2; ++i) { const int row = GATHER ? idx[u.q * 256 + h * HALF + R[i]] : (u.pm * BM + h * HALF + R[i]); o[h][i] = (unsigned)(row * lda + C[i]) * 2u; }
    }
};

struct EpiBf16 {
    static constexpr bool PERM = true;
    bf16_t* O; int ldc; int pnmask;
    __device__ __forceinline__ void operator()(const f32x4 (&acc)[2][2][4][2], const Unit& u, int wr, int wc, int fr, int fq) const {
        const int row0 = u.pm * BM + wr * 64 + fr; const int col0 = (u.pn & pnmask) * BM + wc * 32 + 8 * fq;
#pragma unroll
        for (int ai = 0; ai < 2; ++ai)
#pragma unroll
            for (int m = 0; m < 4; ++m) { bf16_t* rowp = O + (size_t)(row0 + ai * HALF + m * 16) * ldc + col0;
#pragma unroll
                for (int bj = 0; bj < 2; ++bj) { const f32x4 v0 = acc[ai][bj][m][0], v1 = acc[ai][bj][m][1];
                    u32x4 w; w.x = cvtpk(v0[0], v0[1]); w.y = cvtpk(v0[2], v0[3]); w.z = cvtpk(v1[0], v1[1]); w.w = cvtpk(v1[2], v1[3]);
                    *(u32x4*)(rowp + bj * HALF) = w; } }
    }
};
struct EpiRowScale {
    static constexpr bool PERM = true;
    bf16_t* O; int ldc; const float* rs; int which;
    __device__ __forceinline__ void operator()(const f32x4 (&acc)[2][2][4][2], const Unit& u, int wr, int wc, int fr, int fq) const {
        const int row0 = u.pm * BM + wr * 64 + fr; const int col0 = u.pn * BM + wc * 32 + 8 * fq;
#pragma unroll
        for (int ai = 0; ai < 2; ++ai)
#pragma unroll
            for (int m = 0; m < 4; ++m) { const int row = row0 + ai * HALF + m * 16; const float s = rs[row * 2 + which]; bf16_t* rowp = O + (size_t)row * ldc + col0;
#pragma unroll
                for (int bj = 0; bj < 2; ++bj) { const f32x4 v0 = acc[ai][bj][m][0] * s, v1 = acc[ai][bj][m][1] * s;
                    u32x4 w; w.x = cvtpk(v0[0], v0[1]); w.y = cvtpk(v0[2], v0[3]); w.z = cvtpk(v1[0], v1[1]); w.w = cvtpk(v1[2], v1[3]);
                    *(u32x4*)(rowp + bj * HALF) = w; } }
    }
};
template <bool O8> struct EpiSiluMul {
    static constexpr bool PERM = true;
    bf16_t* O;
    __device__ __forceinline__ void operator()(const f32x4 (&acc)[2][2][4][2], const Unit& u, int wr, int wc, int fr, int fq) const {
        const int row0 = u.pm * BM + wr * 64 + fr; const int col0 = (u.pn & 3) * HALF + wc * 32 + 8 * fq;
#pragma unroll
        for (int ai = 0; ai < 2; ++ai)
#pragma unroll
            for (int m = 0; m < 4; ++m) { const size_t eoff = (size_t)(row0 + ai * HALF + m * 16) * DE + col0; float h[8];
#pragma unroll
                for (int n = 0; n < 2; ++n)
#pragma unroll
                    for (int j = 0; j < 4; ++j) { const float g = acc[ai][0][m][n][j], up = acc[ai][1][m][n][j];
                        const float sg = g * __builtin_amdgcn_rcpf(1.0f + __builtin_amdgcn_exp2f(-g * LOG2E)); h[n * 4 + j] = sg * up; }
                if constexpr (O8) { u32x2 w; w.x = pk4_fp8(clamp8(h[0]), clamp8(h[1]), clamp8(h[2]), clamp8(h[3])); w.y = pk4_fp8(clamp8(h[4]), clamp8(h[5]), clamp8(h[6]), clamp8(h[7]));
                    *(u32x2*)((unsigned char*)O + eoff) = w; }
                else { u32x4 w; w.x = cvtpk(h[0], h[1]); w.y = cvtpk(h[2], h[3]); w.z = cvtpk(h[4], h[5]); w.w = cvtpk(h[6], h[7]);
                    *(u32x4*)(O + eoff) = w; } }
    }
};
template <bool RES_F32> struct EpiResF32 {
    static constexpr bool PERM = false;
    float* Z; const void* res;
    __device__ __forceinline__ void operator()(const f32x4 (&acc)[2][2][4][2], const Unit& u, int wr, int wc, int fr, int fq) const {
        const int row0 = u.pm * BM + wr * 64 + fr, col0 = u.pn * BM + wc * 32 + 4 * fq;
        float ALPHA = 1.4142135623730951f; asm volatile("" : "+v"(ALPHA));
#pragma unroll
        for (int ai = 0; ai < 2; ++ai)
#pragma unroll
            for (int m = 0; m < 4; ++m) { const size_t off = (size_t)(row0 + ai * HALF + m * 16) * DM + col0;
#pragma unroll
                for (int bj = 0; bj < 2; ++bj)
#pragma unroll
                    for (int n = 0; n < 2; ++n) { f32x4 o = acc[ai][bj][m][n];
                        if constexpr (RES_F32) { const f32x4 rv = *(const f32x4*)((const float*)res + off + bj * HALF + n * 16); o += ALPHA * rv; }
                        else { const u32x2 rb = *(const u32x2*)((const bf16_t*)res + off + bj * HALF + n * 16);
                            o[0] += ALPHA * bflo(rb.x); o[1] += ALPHA * bfhi(rb.x); o[2] += ALPHA * bflo(rb.y); o[3] += ALPHA * bfhi(rb.y); }
                        *(f32x4*)(Z + off + bj * HALF + n * 16) = o; } }
    }
};

template <bool F8, class Epi, class Sched>
__device__ __forceinline__ void gemm_phase(int wv, LAS unsigned char* lds, const Gemm g, const Sched& S, const Epi& E, int sW = 0x7f7f7f7f, int sX = 0x7f7f7f7f) {
    constexpr bool GA = Sched::GATHER;
    const int tid = fresh_tid(wv), wid = __builtin_amdgcn_readfirstlane(tid >> 6), lane = tid & 63, wr = wid >> 2, wc = wid & 3, fr = lane & 15, fq = lane >> 4;
    int K = g.K; asm volatile("" : "+s"(K));
    const int nt = K / BK;
    int Rr[2], Cc[2]; unsigned voffA[2], voffB[2];
#pragma unroll
    for (int i = 0; i < 2; ++i) { int R, C; stage_rc(tid * 16 + i * 8192, R, C); Rr[i] = R; Cc[i] = C; const int Rb = Epi::PERM ? ((R & ~31) + perm32(R & 31)) : R;
        voffA[i] = (unsigned)(R * g.lda + C) * 2u; voffB[i] = (unsigned)(Rb * g.ldb + C) * 2u; }
    const size_t kstep = (size_t)(BK * 2);
    const size_t hstepA = (size_t)HALF * g.lda * 2, tstepA = 2 * hstepA;
    const size_t hstepB = (size_t)HALF * g.ldb * 2, tstepB = 2 * hstepB;
    const unsigned ldsw = (unsigned)wid * 1024u;
    const int aoff = lds_byte(wr * 64 + fr, fq * 8), boff = lds_byte(wc * 32 + fr, fq * 8);
#define PG8_SA(b, h) (((b) * 2 + (h)) * HTB)
#define PG8_SB(b, h) ((4 + (b) * 2 + (h)) * HTB)
#define PG8_STAGE(bufoff, gbase, voff) do { _Pragma("unroll") for (int _i = 0; _i < 2; ++_i) \
        __builtin_amdgcn_global_load_lds((const unsigned*)((const char*)(gbase) + (voff)[_i]), (LAS unsigned*)(lds + (bufoff) + ldsw + _i * 8192), 16, 0, 0); } while (0)
#define PG8_STAGE_A(bufoff, h, pbase, koff, goffs) do { if constexpr (GA) { PG8_STAGE(bufoff, gA + (koff), (goffs)[h]); } else { PG8_STAGE(bufoff, (pbase) + (h) * hstepA, voffA); } } while (0)
#define PG8_LD32(dst, off) do { const i32x4 _lo = *(const LAS i32x4*)(lds + (off)), _hi = *(const LAS i32x4*)(lds + (off) + 1024); dst = __builtin_shufflevector(_lo, _hi, 0, 1, 2, 3, 4, 5, 6, 7); } while (0)
#define PG8_LDA(dst, b, h) do { _Pragma("unroll") for (int m = 0; m < 4; ++m) PG8_LD32(dst[m], PG8_SA(b, h) + aoff + m * 2048); } while (0)
#define PG8_LDB(dst, b, h) do { _Pragma("unroll") for (int n = 0; n < 2; ++n) PG8_LD32(dst[n], PG8_SB(b, h) + boff + n * 2048); } while (0)
#define PG8_LOH(v) __builtin_bit_cast(bf16x8, __builtin_shufflevector(v, v, 0, 1, 2, 3))
#define PG8_HIH(v) __builtin_bit_cast(bf16x8, __builtin_shufflevector(v, v, 4, 5, 6, 7))
#define PG8_MMA(ai, bj, At, Bt) do { __builtin_amdgcn_s_setprio(1); \
        if constexpr (F8) { _Pragma("unroll") for (int m = 0; m < 4; ++m) _Pragma("unroll") for (int n = 0; n < 2; ++n) \
            asm volatile("v_mfma_scale_f32_16x16x128_f8f6f4 %0, %1, %2, %0, %3, %4 op_sel_hi:[0,0,0]" : "+v"(acc[ai][bj][m][n]) : "v"(Bt[n]), "v"(At[m]), "v"(sW), "v"(sX)); } \
        else { _Pragma("unroll") for (int m = 0; m < 4; ++m) _Pragma("unroll") for (int n = 0; n < 2; ++n) { \
            acc[ai][bj][m][n] = __builtin_amdgcn_mfma_f32_16x16x32_bf16(PG8_LOH(Bt[n]), PG8_LOH(At[m]), acc[ai][bj][m][n], 0, 0, 0); \
            acc[ai][bj][m][n] = __builtin_amdgcn_mfma_f32_16x16x32_bf16(PG8_HIH(Bt[n]), PG8_HIH(At[m]), acc[ai][bj][m][n], 0, 0, 0); } } \
        __builtin_amdgcn_s_setprio(0); } while (0)
#define PG8_WAIT_V(n) asm volatile("s_waitcnt vmcnt(" #n ")" ::: "memory")
#define PG8_WAIT_L(n) asm volatile("s_waitcnt lgkmcnt(" #n ")" ::: "memory")
#define PG8_BAR __builtin_amdgcn_s_barrier()
#define PG8_SCHED __builtin_amdgcn_sched_barrier(0)
    Unit cur, nxt; int ui = 0;
    if (!S.next(0, cur)) return;
    f32x4 acc[2][2][4][2];
#pragma unroll
    for (int a = 0; a < 2; ++a)
#pragma unroll
        for (int b = 0; b < 2; ++b)
#pragma unroll
            for (int m = 0; m < 4; ++m)
#pragma unroll
                for (int n = 0; n < 2; ++n) { const float zf = fresh_zero(); acc[a][b][m][n] = (f32x4){zf, zf, zf, zf}; }
    unsigned ca[2][2];
    if constexpr (GA) S.aoff(cur, Rr, Cc, ca);
    const char* gA = (const char*)g.A;
    const char* cA = gA + (GA ? (size_t)0 : (size_t)cur.pm * tstepA);
    const char* cB = (const char*)g.Bt + (size_t)cur.pn * tstepB;
    PG8_STAGE(PG8_SB(0, 0), cB, voffB); PG8_STAGE_A(PG8_SA(0, 0), 0, cA, 0, ca); PG8_STAGE(PG8_SB(0, 1), cB + hstepB, voffB); PG8_STAGE_A(PG8_SA(0, 1), 1, cA, 0, ca);
    if (wr == 1) PG8_BAR;
    PG8_WAIT_V(4); PG8_BAR;
    PG8_STAGE(PG8_SB(1, 0), cB + kstep, voffB); PG8_STAGE_A(PG8_SA(1, 0), 0, cA + kstep, kstep, ca); PG8_STAGE(PG8_SB(1, 1), cB + hstepB + kstep, voffB);
    PG8_WAIT_V(6); PG8_BAR;
    for (;;) {
        const bool has_next = S.next(ui + 1, nxt);
        const char* nA = (!GA && has_next) ? gA + (size_t)nxt.pm * tstepA : cA;
        const char* nB = has_next ? (const char*)g.Bt + (size_t)nxt.pn * tstepB : cB;
#pragma unroll 1
        for (int t = 0; t < nt; t += 2) {
            const bool last = (t == nt - 2);
            const size_t k1 = (size_t)(t + 1) * kstep, k2 = last ? (size_t)0 : (size_t)(t + 2) * kstep, k3 = k2 + kstep;
            const char* a1 = cA + k1;
            const char* a2 = last ? nA : cA + k2; const char* b2 = last ? nB : cB + (size_t)(t + 2) * kstep;
            const char* a3 = a2 + kstep; const char* b3 = b2 + kstep;
            i32x8 At[4], B0[2], B1[2];
            unsigned xa[2][2];
            if constexpr (GA) {
                if (last && has_next) { int R2[2], C2[2]; const int t2 = fresh_tid(wv); stage_rc(t2 * 16, R2[0], C2[0]); stage_rc(t2 * 16 + 8192, R2[1], C2[1]); S.aoff(nxt, R2, C2, xa); }
                else {
#pragma unroll
                    for (int h = 0; h < 2; ++h)
#pragma unroll
                        for (int i = 0; i < 2; ++i) xa[h][i] = ca[h][i];
                }
            }
            PG8_LDB(B0, 0, 0); PG8_SCHED; PG8_LDA(At, 0, 0); PG8_STAGE_A(PG8_SA(1, 1), 1, a1, k1, ca);
            PG8_WAIT_L(8); PG8_BAR; PG8_WAIT_L(0); PG8_MMA(0, 0, At, B0); PG8_BAR; PG8_SCHED;
            PG8_LDB(B1, 0, 1); PG8_STAGE(PG8_SB(0, 0), b2, voffB);
            PG8_BAR; PG8_WAIT_L(0); PG8_MMA(0, 1, At, B1); PG8_BAR;
            PG8_LDA(At, 0, 1); PG8_STAGE_A(PG8_SA(0, 0), 0, a2, k2, xa);
            PG8_BAR; PG8_WAIT_L(0); PG8_MMA(1, 0, At, B0); PG8_BAR; PG8_SCHED;
            PG8_STAGE(PG8_SB(0, 1), b2 + hstepB, voffB);
            PG8_WAIT_V(6); PG8_BAR; PG8_MMA(1, 1, At, B1); PG8_BAR;
            PG8_LDB(B0, 1, 0); PG8_SCHED; PG8_LDA(At, 1, 0); PG8_STAGE_A(PG8_SA(0, 1), 1, a2, k2, xa);
            PG8_WAIT_L(8); PG8_BAR; PG8_WAIT_L(0); PG8_MMA(0, 0, At, B0); PG8_BAR; PG8_SCHED;
            PG8_LDB(B1, 1, 1); PG8_STAGE(PG8_SB(1, 0), b3, voffB);
            PG8_BAR; PG8_WAIT_L(0); PG8_MMA(0, 1, At, B1); PG8_BAR;
            PG8_LDA(At, 1, 1); PG8_STAGE_A(PG8_SA(1, 0), 0, a3, k3, xa);
            PG8_BAR; PG8_WAIT_L(0); PG8_MMA(1, 0, At, B0); PG8_BAR; PG8_SCHED;
            PG8_STAGE(PG8_SB(1, 1), b3 + hstepB, voffB);
            PG8_WAIT_V(6); PG8_BAR; PG8_MMA(1, 1, At, B1); PG8_BAR;
        }
        if constexpr (F8) asm volatile("s_nop 7\n\ts_nop 7\n\ts_nop 7" ::: "memory");
        { const int l2 = fresh_tid(0); E(acc, cur, wr, wc, l2 & 15, l2 >> 4); }
        if (!has_next) break;
#pragma unroll
        for (int a = 0; a < 2; ++a)
#pragma unroll
            for (int b = 0; b < 2; ++b)
#pragma unroll
                for (int m = 0; m < 4; ++m)
#pragma unroll
                    for (int n = 0; n < 2; ++n) { const float zf = fresh_zero(); acc[a][b][m][n] = (f32x4){zf, zf, zf, zf}; }
        cur = nxt; cA = nA; cB = nB; ++ui;
        if constexpr (GA) { int R2[2], C2[2]; const int t2 = fresh_tid(wv); stage_rc(t2 * 16, R2[0], C2[0]); stage_rc(t2 * 16 + 8192, R2[1], C2[1]); S.aoff(cur, R2, C2, ca); }
    }
    PG8_WAIT_V(0);
    if (wr == 0) PG8_BAR;
    PG8_BAR;
#undef PG8_SA
#undef PG8_SB
#undef PG8_STAGE
#undef PG8_STAGE_A
#undef PG8_LDA
#undef PG8_LDB
#undef PG8_MMA
#undef PG8_LD32
#undef PG8_LOH
#undef PG8_HIH
#undef PG8_WAIT_V
#undef PG8_WAIT_L
#undef PG8_BAR
#undef PG8_SCHED
}
}

namespace da {
constexpr int KVBLK = 64;
constexpr float THR = 8.f;
constexpr int SHM_V = KVBLK * 128 * 2, SHM_K = KVBLK * 128 * 2, SHM_KR = KVBLK * 64 * 2;
constexpr int OFF_V = 0, OFF_K = 2 * SHM_V, OFF_WS = OFF_K + 2 * SHM_K, OFF_KR = OFF_WS + 8 * 64 * 4, OFF_QR = OFF_KR + 2 * SHM_KR, LDS_DENSE = OFF_QR + 8 * 4096;
#define KSWZ(row, colB) ((row) * 256 + ((colB) ^ (((row) & 7) << 4)))
#define KRSWZ(row, ch) ((row) * 128 + ((((ch) ^ ((row) >> 1)) & 7) << 4))
#define SBAR() __builtin_amdgcn_sched_barrier(0)
__device__ __forceinline__ int crow(int r, int hi) { return (r & 3) + 8 * (r >> 2) + 4 * hi; }
__device__ __forceinline__ int v_st(int k, int c) { const int kk = (k & ~0xC) | ((k & 4) << 1) | ((k & 8) >> 1); return ((kk >> 3) * 4 + (c >> 5)) * 512 + ((kk & 7) * 32 + (c & 31)) * 2; }
__device__ __forceinline__ int v_rd_base(int lane) { return ((lane & 3) << 3) | (((lane >> 2) & 3) << 6) | (((lane >> 4) & 1) << 5) | (((lane >> 5) & 1) << 8); }
constexpr int v_rd_off(int d0, int ks, int half) { return d0 * 512 + ks * 4096 + half * 2048; }
template <int OFF> __device__ __forceinline__ s16x4 tr_read(int vb) {
    s16x4 r; asm volatile("ds_read_b64_tr_b16 %0, %1 offset:%2" : "=&v"(r) : "v"(vb), "i"(OFF) : "memory"); return r;
}
template <int D0> __device__ __forceinline__ void pv_one(f32x16& od, int vb, bf16x8 pa0, bf16x8 pa1, bf16x8 pa2, bf16x8 pa3) {
    const s16x4 l0 = tr_read<v_rd_off(D0, 0, 0)>(vb), h0 = tr_read<v_rd_off(D0, 0, 1)>(vb), l1 = tr_read<v_rd_off(D0, 1, 0)>(vb), h1 = tr_read<v_rd_off(D0, 1, 1)>(vb);
    const s16x4 l2 = tr_read<v_rd_off(D0, 2, 0)>(vb), h2 = tr_read<v_rd_off(D0, 2, 1)>(vb), l3 = tr_read<v_rd_off(D0, 3, 0)>(vb), h3 = tr_read<v_rd_off(D0, 3, 1)>(vb);
    asm volatile("s_waitcnt lgkmcnt(0)" ::: "memory"); SBAR();
#define PK(L, H) (bf16x8){L[0], L[1], L[2], L[3], H[0], H[1], H[2], H[3]}
    od = __builtin_amdgcn_mfma_f32_32x32x16_bf16(pa0, PK(l0, h0), od, 0, 0, 0);
    od = __builtin_amdgcn_mfma_f32_32x32x16_bf16(pa1, PK(l1, h1), od, 0, 0, 0);
    od = __builtin_amdgcn_mfma_f32_32x32x16_bf16(pa2, PK(l2, h2), od, 0, 0, 0);
    od = __builtin_amdgcn_mfma_f32_32x32x16_bf16(pa3, PK(l3, h3), od, 0, 0, 0);
}
__device__ __forceinline__ void pv_d0(f32x16* o, int vb, bf16x8 pa0, bf16x8 pa1, bf16x8 pa2, bf16x8 pa3) {
    pv_one<0>(o[0], vb, pa0, pa1, pa2, pa3); pv_one<1>(o[1], vb, pa0, pa1, pa2, pa3); pv_one<2>(o[2], vb, pa0, pa1, pa2, pa3); pv_one<3>(o[3], vb, pa0, pa1, pa2, pa3);
}
template <int D0> __device__ __forceinline__ void pv_one32(f32x16& od, int vb, bf16x8 pa0, bf16x8 pa1) {
    const s16x4 l0 = tr_read<v_rd_off(D0, 0, 0)>(vb), h0 = tr_read<v_rd_off(D0, 0, 1)>(vb), l1 = tr_read<v_rd_off(D0, 1, 0)>(vb), h1 = tr_read<v_rd_off(D0, 1, 1)>(vb);
    asm volatile("s_waitcnt lgkmcnt(0)" ::: "memory"); SBAR();
    od = __builtin_amdgcn_mfma_f32_32x32x16_bf16(pa0, PK(l0, h0), od, 0, 0, 0);
    od = __builtin_amdgcn_mfma_f32_32x32x16_bf16(pa1, PK(l1, h1), od, 0, 0, 0);
}
#undef PK
#define PK4(P, BASE, OUT) do { unsigned a0 = cvtpk(P[BASE + 0], P[BASE + 1]), a1 = cvtpk(P[BASE + 2], P[BASE + 3]);   \
    unsigned b0 = cvtpk(P[BASE + 4], P[BASE + 5]), b1 = cvtpk(P[BASE + 6], P[BASE + 7]);                              \
    auto r0 = __builtin_amdgcn_permlane32_swap(a0, b0, false, false); auto r1 = __builtin_amdgcn_permlane32_swap(a1, b1, false, false); \
    u32x4 w = {r0[0], r1[0], r0[1], r1[1]}; OUT = *reinterpret_cast<bf16x8*>(&w); } while (0)

template <int NDQ> struct Cst { static constexpr float SCALE = (NDQ == 8) ? 0.088388347648318440f : 0.072168783648703220f; static constexpr float C = SCALE * LOG2E; };

template <int NDQ>
__device__ __forceinline__ void partialSM(f32x16& p0, f32x16& p1, float& m_reg, float& mn, float& alpha) {
    constexpr float C = Cst<NDQ>::C, SCALE = Cst<NDQ>::SCALE;
    float pmax = p0[0];
#pragma unroll
    for (int r = 1; r < 16; ++r) pmax = fmaxf(pmax, p0[r]);
#pragma unroll
    for (int r = 0; r < 16; ++r) pmax = fmaxf(pmax, p1[r]);
    { auto rr = __builtin_amdgcn_permlane32_swap(__float_as_uint(pmax), __float_as_uint(pmax), false, false);
      pmax = fmaxf(__uint_as_float(rr[0]), __uint_as_float(rr[1])); }
    if (__builtin_expect(__all(pmax - m_reg <= THR / SCALE), 1)) { mn = m_reg; alpha = 1.f; }
    else { mn = fmaxf(m_reg, pmax); alpha = __builtin_amdgcn_exp2f((m_reg - mn) * C); m_reg = mn; }
    const float mnC = -mn * C;
#pragma unroll
    for (int r = 0; r < 16; ++r) p0[r] = fmaf(p0[r], C, mnC);
#pragma unroll
    for (int r = 0; r < 16; ++r) p1[r] = fmaf(p1[r], C, mnC);
#pragma unroll
    for (int r = 0; r < 16; ++r) p0[r] = __builtin_amdgcn_exp2f(p0[r]);
}
__device__ __forceinline__ void finishSM(f32x16& p0, f32x16& p1, float alpha, float& l_reg, bf16x8& pa0, bf16x8& pa1, bf16x8& pa2, bf16x8& pa3) {
#pragma unroll
    for (int r = 0; r < 16; ++r) p1[r] = __builtin_amdgcn_exp2f(p1[r]);
    float ps = 0;
#pragma unroll
    for (int r = 0; r < 16; ++r) ps += p0[r];
#pragma unroll
    for (int r = 0; r < 16; ++r) ps += p1[r];
    { auto rr = __builtin_amdgcn_permlane32_swap(__float_as_uint(ps), __float_as_uint(ps), false, false);
      ps = __uint_as_float(rr[0]) + __uint_as_float(rr[1]); }
    l_reg = l_reg * alpha + ps;
    PK4(p0, 0, pa0); PK4(p0, 8, pa1); PK4(p1, 0, pa2); PK4(p1, 8, pa3);
}
template <int NDQ>
__device__ __forceinline__ void qkt(f32x16& p0, f32x16& p1, const char* Ks, const char* Krs, const bf16x8* qr, const char* qrl, int r32, int hi) {
    p0 = f32x16{}; p1 = f32x16{};
#pragma unroll
    for (int d0 = 0; d0 < 8; ++d0) { const int cb = (d0 * 16 + hi * 8) * 2;
        bf16x8 b0 = *reinterpret_cast<const bf16x8*>(Ks + KSWZ(r32, cb));
        bf16x8 b1 = *reinterpret_cast<const bf16x8*>(Ks + KSWZ(32 + r32, cb));
        p0 = __builtin_amdgcn_mfma_f32_32x32x16_bf16(b0, qr[d0], p0, 0, 0, 0);
        p1 = __builtin_amdgcn_mfma_f32_32x32x16_bf16(b1, qr[d0], p1, 0, 0, 0); }
    if constexpr (NDQ == 12) {
#pragma unroll
        for (int d0 = 0; d0 < 4; ++d0) { const int ch = d0 * 2 + hi;
            bf16x8 b0 = *reinterpret_cast<const bf16x8*>(Krs + KRSWZ(r32, ch));
            bf16x8 b1 = *reinterpret_cast<const bf16x8*>(Krs + KRSWZ(32 + r32, ch));
            const bf16x8 qf = *reinterpret_cast<const bf16x8*>(qrl + d0 * 1024);
            p0 = __builtin_amdgcn_mfma_f32_32x32x16_bf16(b0, qf, p0, 0, 0, 0);
            p1 = __builtin_amdgcn_mfma_f32_32x32x16_bf16(b1, qf, p1, 0, 0, 0); }
    }
}

struct DArgs { const bf16_t* Q; const bf16_t* K; const bf16_t* V; const bf16_t* Kr; bf16_t* O; int ldq, ldk, ldv, ldo; int seq; int pos0; };

template <int NDQ, int SDEPTH>
__device__ __forceinline__ void attn_dense_body(int wv, const DArgs a, char* lds) {
    const int tid = fresh_tid(wv), wid = tid >> 6, lane = tid & 63, r32 = lane & 31, hi = lane >> 5;
    char* V_lds = lds + OFF_V; char* K_lds = lds + OFF_K; char* Kr_lds = lds + OFF_KR;
    float* ws = (float*)(lds + OFF_WS) + wid * 64; float* li_l = ws; float* al_l = ws + 32;
    float m_reg = -1e30f, l_reg = 0; f32x16 o[4] = {}; bf16x8 qr[8];
    char* qrl = lds + OFF_QR + wid * 4096 + lane * 16;
    const bf16_t* Qw = a.Q + (long)(wid * 32 + r32) * a.ldq + hi * 8;
#pragma unroll
    for (int d0 = 0; d0 < 8; ++d0) qr[d0] = *reinterpret_cast<const bf16x8*>(Qw + d0 * 16);
    if constexpr (NDQ == 12) {
        const float pos = (float)(a.pos0 + wid * 32 + r32);
#pragma unroll
        for (int f = 0; f < 2; ++f) {
            const bf16x8 x1v = *reinterpret_cast<const bf16x8*>(Qw + (8 + f) * 16), x2v = *reinterpret_cast<const bf16x8*>(Qw + (10 + f) * 16); bf16x8 y1v, y2v;
#pragma unroll
            for (int j = 0; j < 8; ++j) { const int i = f * 16 + hi * 8 + j; float sn, cs; sincos_rev(pos * inv_freq32(i), sn, cs);
                const float x1 = bf2f((unsigned short)x1v[j]), x2 = bf2f((unsigned short)x2v[j]);
                y1v[j] = (short)f2bf(x1 * cs - x2 * sn); y2v[j] = (short)f2bf(x2 * cs + x1 * sn); }
            *reinterpret_cast<bf16x8*>(qrl + f * 1024) = y1v; *reinterpret_cast<bf16x8*>(qrl + (2 + f) * 1024) = y2v;
        }
    }
    const int sr = tid >> 4, sc = (tid & 15) * 8, vst0 = v_st(sr, sc), vst1 = v_st(32 + sr, sc);
    const int krr = tid >> 3, krc = tid & 7;
    const int vb0 = (int)(uintptr_t)V_lds + v_rd_base(lane);
    struct { bf16x8 vs0, vs1, ks0, ks1, kr; } sr_[SDEPTH];
#define SLOAD(i, k0) do { sr_[i].vs0 = *(const bf16x8*)(a.V + (long)((k0) + sr) * a.ldv + sc); sr_[i].vs1 = *(const bf16x8*)(a.V + (long)((k0) + 32 + sr) * a.ldv + sc); \
    sr_[i].ks0 = *(const bf16x8*)(a.K + (long)((k0) + sr) * a.ldk + sc); sr_[i].ks1 = *(const bf16x8*)(a.K + (long)((k0) + 32 + sr) * a.ldk + sc); \
    if constexpr (NDQ == 12) sr_[i].kr = *(const bf16x8*)(a.Kr + (long)((k0) + krr) * 64 + krc * 8); } while (0)
#define SWRITE(b, i) do { *(bf16x8*)(V_lds + (b) * SHM_V + vst0) = sr_[i].vs0; *(bf16x8*)(V_lds + (b) * SHM_V + vst1) = sr_[i].vs1; const int kc = sc * 2; \
    *(bf16x8*)(K_lds + (b) * SHM_K + KSWZ(sr, kc)) = sr_[i].ks0; *(bf16x8*)(K_lds + (b) * SHM_K + KSWZ(32 + sr, kc)) = sr_[i].ks1; \
    if constexpr (NDQ == 12) *(bf16x8*)(Kr_lds + (b) * SHM_KR + KRSWZ(krr, krc)) = sr_[i].kr; } while (0)
#define SWAIT() do { if constexpr (SDEPTH == 2) { if constexpr (NDQ == 12) asm volatile("s_waitcnt vmcnt(5)" ::: "memory"); else asm volatile("s_waitcnt vmcnt(4)" ::: "memory"); } else asm volatile("s_waitcnt vmcnt(0)" ::: "memory"); } while (0)
#define RESC(al) do { if (__any((al) < 1.f)) { if (hi == 0) al_l[r32] = (al); asm volatile("s_waitcnt lgkmcnt(0)" ::: "memory"); \
    _Pragma("unroll") for (int d = 0; d < 4; ++d) _Pragma("unroll") for (int r = 0; r < 16; ++r) o[d][r] *= al_l[crow(r, hi)]; } } while (0)
    f32x16 pA0, pA1, pB0, pB1; float mnA, mnB, alA, alB; bf16x8 pa0, pa1, pa2, pa3; const int NT = a.seq / KVBLK;
    constexpr int SE = 0, SO = SDEPTH - 1;
    SLOAD(SE, 0); asm volatile("s_waitcnt vmcnt(0)" ::: "memory"); SWRITE(0, SE); __syncthreads();
    qkt<NDQ>(pA0, pA1, K_lds, Kr_lds, qr, qrl, r32, hi); partialSM<NDQ>(pA0, pA1, m_reg, mnA, alA);
    SLOAD(SO, KVBLK); if constexpr (SDEPTH == 2) { if (2 < NT) SLOAD(SE, 2 * KVBLK); }
    SWAIT(); SWRITE(1, SO); __syncthreads();
#pragma unroll 1
    for (int j = 1; j + 1 < NT; j += 2) {
        SBAR(); qkt<NDQ>(pB0, pB1, K_lds + SHM_K, Kr_lds + SHM_KR, qr, qrl, r32, hi);
        finishSM(pA0, pA1, alA, l_reg, pa0, pa1, pa2, pa3); SBAR();
        SLOAD(SO, (j + SDEPTH) * KVBLK); SBAR();
        pv_d0(o, vb0, pa0, pa1, pa2, pa3); partialSM<NDQ>(pB0, pB1, m_reg, mnB, alB);
        __syncthreads(); SWAIT(); SWRITE(0, SE);
        RESC(alB); __syncthreads();
        SBAR(); qkt<NDQ>(pA0, pA1, K_lds, Kr_lds, qr, qrl, r32, hi);
        finishSM(pB0, pB1, alB, l_reg, pa0, pa1, pa2, pa3); SBAR();
        if (SDEPTH == 1 || j + 3 < NT) SLOAD(SE, (j + 1 + SDEPTH) * KVBLK); SBAR();
        pv_d0(o, vb0 + (int)SHM_V, pa0, pa1, pa2, pa3); partialSM<NDQ>(pA0, pA1, m_reg, mnA, alA);
        __syncthreads(); SWAIT(); SWRITE(1, SO);
        RESC(alA); __syncthreads();
    }
    SBAR(); qkt<NDQ>(pB0, pB1, K_lds + SHM_K, Kr_lds + SHM_KR, qr, qrl, r32, hi);
    finishSM(pA0, pA1, alA, l_reg, pa0, pa1, pa2, pa3); SBAR();
    pv_d0(o, vb0, pa0, pa1, pa2, pa3); partialSM<NDQ>(pB0, pB1, m_reg, mnB, alB);
    __syncthreads(); RESC(alB);
    finishSM(pB0, pB1, alB, l_reg, pa0, pa1, pa2, pa3); SBAR();
    pv_d0(o, vb0 + (int)SHM_V, pa0, pa1, pa2, pa3);
    if (hi == 0) li_l[r32] = l_reg; asm volatile("s_waitcnt lgkmcnt(0)" ::: "memory");
    float rli[16];
#pragma unroll
    for (int r = 0; r < 16; ++r) rli[r] = __builtin_amdgcn_rcpf(li_l[crow(r, hi)]);
    bf16_t* Ow = F8_OUT ? (bf16_t*)((unsigned char*)a.O + (long)(wid * 32) * a.ldo) : a.O + (long)(wid * 32) * a.ldo;
#pragma unroll
    for (int r = 0; r < 16; ++r) { const int orow = crow(r, hi);
#pragma unroll
        for (int d0 = 0; d0 < 4; ++d0) { if constexpr (F8_OUT) ((unsigned char*)Ow)[(long)orow * a.ldo + d0 * 32 + r32] = f2fp8(o[d0][r] * rli[r] * O8_SCALE); else Ow[(long)orow * a.ldo + d0 * 32 + r32] = f2bf(o[d0][r] * rli[r]); } }
#undef SLOAD
#undef SWRITE
#undef SWAIT
#undef RESC
}

constexpr int SP_WAVE_LDS = 18688;
template <class P>
__device__ __forceinline__ void sparse_wave(P& pol, LAS unsigned char* wll, int lane) {
    const int r32 = lane & 31, hi = lane >> 5;
    char* wl = (char*)wll;
    char* Kl = wl; char* Vl = wl + 8192; float* li_l = (float*)(wl + 16384); float* al_l = li_l + 32;
    bf16x8 qr[8];
    { const bf16_t* qp = pol.qptr(r32) + hi * 8;
#pragma unroll
      for (int d0 = 0; d0 < 8; ++d0) qr[d0] = *reinterpret_cast<const bf16x8*>(qp + d0 * 16); }
    asm volatile("s_waitcnt vmcnt(0)" ::: "memory");
    f32x16 o[4] = {}; float m_reg = -1e30f, l_reg = 0.f;
    const int krow0 = lane >> 4;
    const int kce = (((lane & 15) ^ (krow0 & 7)) * 8), kco = (((lane & 15) ^ ((4 + krow0) & 7)) * 8);
    const int vk0 = 8 * ((lane >> 4) & 1) + ((lane >> 2) & 3), vc0 = 32 * (lane >> 5) + 8 * (lane & 3);
    const int vb = (int)(uintptr_t)Vl + v_rd_base(lane);
    const int nt = pol.ntiles();
    typename P::TI ti, tn;
#define SP_DMA_K(T) do { _Pragma("unroll") for (int i = 0; i < 8; ++i) { const bf16_t* src = (T).k + (long)(4 * i + krow0) * (T).rs + ((i & 1) ? kco : kce); \
        __builtin_amdgcn_global_load_lds((const unsigned*)src, (LAS unsigned*)(wll + i * 1024), 16, 0, 0); } } while (0)
#define SP_DMA_V(T) do { _Pragma("unroll") for (int i = 0; i < 8; ++i) { const bf16_t* src = (T).v + (long)(16 * (i >> 2) + 4 * ((i >> 1) & 1) + vk0) * (T).rs + 64 * (i & 1) + vc0; \
        __builtin_amdgcn_global_load_lds((const unsigned*)src, (LAS unsigned*)(wll + 8192 + i * 1024), 16, 0, 0); } } while (0)
    pol.tile(0, ti);
    SP_DMA_K(ti); SP_DMA_V(ti);
#pragma unroll 1
    for (int j = 0; j < nt; ++j) {
        const bool more = (j + 1 < nt);
        if (more) pol.tile(j + 1, tn);
        asm volatile("s_waitcnt vmcnt(8)" ::: "memory");
        f32x16 p = f32x16{};
#pragma unroll
        for (int d0 = 0; d0 < 8; ++d0) { const int cb = (d0 * 16 + hi * 8) * 2;
            bf16x8 b0 = *reinterpret_cast<const bf16x8*>(Kl + KSWZ(r32, cb));
            p = __builtin_amdgcn_mfma_f32_32x32x16_bf16(b0, qr[d0], p, 0, 0, 0); }
        asm volatile("s_waitcnt lgkmcnt(0)" ::: "memory"); SBAR();
        if (more) SP_DMA_K(tn);
        SBAR();
        float pmax = -INFINITY;
#pragma unroll
        for (int r = 0; r < 16; ++r) { p[r] = pol.adj(ti, crow(r, hi), p[r]); pmax = fmaxf(pmax, p[r]); }
        { auto rr = __builtin_amdgcn_permlane32_swap(__float_as_uint(pmax), __float_as_uint(pmax), false, false);
          pmax = fmaxf(__uint_as_float(rr[0]), __uint_as_float(rr[1])); }
        const float mn = fmaxf(m_reg, pmax); const float alpha = __builtin_amdgcn_exp2f(m_reg - mn); m_reg = mn;
        float ps = 0.f;
#pragma unroll
        for (int r = 0; r < 16; ++r) { p[r] = __builtin_amdgcn_exp2f(p[r] - mn); ps += p[r]; }
        { auto rr = __builtin_amdgcn_permlane32_swap(__float_as_uint(ps), __float_as_uint(ps), false, false);
          ps = __uint_as_float(rr[0]) + __uint_as_float(rr[1]); }
        l_reg = l_reg * alpha + ps;
        if (__any(alpha < 1.f)) { if (hi == 0) al_l[r32] = alpha; asm volatile("s_waitcnt lgkmcnt(0)" ::: "memory");
#pragma unroll
            for (int d = 0; d < 4; ++d)
#pragma unroll
                for (int r = 0; r < 16; ++r) o[d][r] *= al_l[crow(r, hi)]; }
        bf16x8 pa0, pa1; PK4(p, 0, pa0); PK4(p, 8, pa1);
        SBAR();
        if (more) asm volatile("s_waitcnt vmcnt(8)" ::: "memory"); else asm volatile("s_waitcnt vmcnt(0)" ::: "memory");
        SBAR();
        pv_one32<0>(o[0], vb, pa0, pa1); pv_one32<1>(o[1], vb, pa0, pa1); pv_one32<2>(o[2], vb, pa0, pa1); pv_one32<3>(o[3], vb, pa0, pa1);
        SBAR();
        if (more) SP_DMA_V(tn);
        SBAR();
        ti = tn;
    }
#undef SP_DMA_K
#undef SP_DMA_V
    if (hi == 0) li_l[r32] = l_reg; asm volatile("s_waitcnt lgkmcnt(0)" ::: "memory");
#pragma unroll
    for (int r = 0; r < 16; ++r) { const int qn = crow(r, hi); const float rl = __builtin_amdgcn_rcpf(li_l[qn]); bf16_t* op = pol.optr(qn);
#pragma unroll
        for (int d0 = 0; d0 < 4; ++d0) { if constexpr (F8_OUT) ((unsigned char*)op)[d0 * 32 + r32] = f2fp8(o[d0][r] * rl * O8_SCALE); else op[d0 * 32 + r32] = f2bf(o[d0][r] * rl); } }
}
#undef PK4
}

struct PolB {
    struct TI { const bf16_t* k; const bf16_t* v; long rs; int kpos0; int iq; float cd; };
    const bf16_t* H0; bf16_t* O; int b, h, a, r16, myn; int lo3, n3, lo2, n2, lo1, n1; float slope2;
    __device__ __forceinline__ void init(const bf16_t* H0_, bf16_t* O_, int w, int lane) {
        H0 = H0_; O = O_; b = w >> 10; h = (w >> 7) & 7; const int wu = w & 127; a = wu >> 4; r16 = wu & 15; myn = lane & 31;
        lo3 = max(a - 2, 0); n3 = min(a + 2, 7) - lo3 + 1;
        lo2 = max(4 * a - 2, 0); n2 = min(4 * a + 5, 31) - lo2 + 1;
        lo1 = max(16 * a - 2, 0); n1 = min(16 * a + 17, 127) - lo1 + 1;
        slope2 = __builtin_amdgcn_exp2f(-(float)(h + 1)) * LOG2E;
    }
    __device__ __forceinline__ const bf16_t* qptr(int n) const { return H0 + (long)(b * SEQ + 512 * a + r16 + 16 * n) * IN0 + 1536 + h * 128; }
    __device__ __forceinline__ bf16_t* optr(int qn) const { const long e = (long)(b * SEQ + 512 * a + r16 + 16 * qn) * DM + 1024 + h * 128; return F8_OUT ? (bf16_t*)((unsigned char*)O + e) : O + e; }
    __device__ __forceinline__ int ntiles() const { return n3 + n2 + n1; }
    __device__ __forceinline__ void tile(int j, TI& ti) const {
        int dil, kt, rd;
        if (j < n3) { dil = 16; kt = lo3 + j; rd = r16; }
        else if (j < n3 + n2) { dil = 4; kt = lo2 + (j - n3); rd = r16 & 3; }
        else { dil = 1; kt = lo1 + (j - n3 - n2); rd = 0; }
        const long tok = (long)b * SEQ + dil * 32 * kt + rd;
        ti.k = H0 + tok * IN0 + 2560 + h * 128; ti.v = H0 + tok * IN0 + 3584 + h * 128; ti.rs = (long)dil * IN0;
        ti.kpos0 = 32 * kt; ti.iq = (512 * a + r16 + 16 * myn - rd) / dil; ti.cd = slope2 * (float)dil;
    }
    __device__ __forceinline__ float adj(const TI& ti, int kloc, float s) const {
        const int d = ti.kpos0 + kloc - ti.iq; const int ad = d < 0 ? -d : d;
        return ad <= 64 ? fmaf(s, 0.088388347648318440f * LOG2E, -ti.cd * (float)ad) : -INFINITY;
    }
};
struct PolC {
    struct TI { const bf16_t* k; const bf16_t* v; long rs; int kc0; int drow; };
    const bf16_t* H1; bf16_t* O; const float* tab; int b, h, r, a, r0, qc, c0;
    __device__ __forceinline__ void init(const bf16_t* H1_, bf16_t* O_, const float* rpb, float* tab_, int w, int lane) {
        H1 = H1_; O = O_; tab = tab_; b = w >> 10; h = (w >> 7) & 7; const int wu = w & 127; r = wu >> 1; a = wu & 1;
        r0 = min(max(r - 4, 0), 56); qc = 32 * a + (lane & 31); c0 = min(max(qc - 8, 0), 48);
        for (int idx = lane; idx < 480; idx += 64) { const int dr = idx >> 5, dc = idx & 31; tab_[idx] = dc < 31 ? rpb[h * 465 + dr * 31 + dc] * LOG2E : 0.f; }
        asm volatile("s_waitcnt vmcnt(0) lgkmcnt(0)" ::: "memory");
    }
    __device__ __forceinline__ const bf16_t* qptr(int n) const { return H1 + (long)(b * SEQ + 64 * r + 32 * a + n) * IN1P + h * 128; }
    __device__ __forceinline__ bf16_t* optr(int qn) const { const long e = (long)(b * SEQ + 64 * r + 32 * a + qn) * DM + h * 128; return F8_OUT ? (bf16_t*)((unsigned char*)O + e) : O + e; }
    __device__ __forceinline__ int ntiles() const { return 16; }
    __device__ __forceinline__ void tile(int j, TI& ti) const {
        const int kr = r0 + (j >> 1), ch = j & 1; const long tok = (long)b * SEQ + 64 * kr + 32 * ch;
        ti.k = H1 + tok * IN1P + 1024 + h * 128; ti.v = H1 + tok * IN1P + 2048 + h * 128; ti.rs = IN1P; ti.kc0 = 32 * ch; ti.drow = kr - r + 7;
    }
    __device__ __forceinline__ float adj(const TI& ti, int kloc, float s) const {
        const int kc = ti.kc0 + kloc; const int dc = min(max(kc - qc + 15, 0), 30);
        const float bias = tab[ti.drow * 32 + dc];
        return (kc >= c0 && kc < c0 + 16) ? fmaf(s, 0.088388347648318440f * LOG2E, bias) : -INFINITY;
    }
};

struct Params { const float* in[28]; float* out; unsigned char* ws; int ph_lo, ph_hi; };
enum { I_X = 0, I_RW = 1, I_RB = 2, I_WIN0 = 3, I_AQN = 4, I_AKN = 5, I_WOUT0 = 6, I_LN1G0 = 7, I_LN1B0 = 8, I_WG0 = 9, I_WU0 = 10, I_WD0 = 11, I_LN2G0 = 12, I_LN2B0 = 13,
       I_WIN1 = 14, I_RPB = 15, I_DQN = 16, I_WQUP = 17, I_DKVN = 18, I_WKVUP = 19, I_WOUT1 = 20, I_LN1G1 = 21, I_LN1B1 = 22, I_WG1 = 23, I_WU1 = 24, I_WD1 = 25, I_LN2G1 = 26, I_LN2B1 = 27 };

__device__ __forceinline__ void tr_tile(const float* __restrict__ src, int N, const float* __restrict__ ksc, bf16_t* __restrict__ dst, int ldd, int k0, int n0, int drow0, LAS unsigned* tl, int tid) {
    const int c4 = (tid & 15) * 4;
#pragma unroll
    for (int i = 0; i < 2; ++i) {
        const int kp = (tid >> 4) + 32 * i;
        const float* s0 = src + (size_t)(k0 + 2 * kp) * N + n0 + c4;
        f32x4 a = *(const f32x4*)s0, b = *(const f32x4*)(s0 + N);
        if (ksc) { const float sa = ksc[k0 + 2 * kp], sb = ksc[k0 + 2 * kp + 1]; a *= sa; b *= sb; }
#pragma unroll
        for (int j = 0; j < 4; ++j) tl[(c4 + j) * 65 + kp] = cvtpk(a[j], b[j]);
    }
    __syncthreads();
    const int n = tid >> 3, seg = tid & 7;
    unsigned w[8];
#pragma unroll
    for (int q = 0; q < 8; ++q) w[q] = tl[n * 65 + seg * 8 + q];
    u32x4* d = (u32x4*)(dst + (size_t)(drow0 + n) * ldd + k0 + seg * 16);
    d[0] = (u32x4){w[0], w[1], w[2], w[3]}; d[1] = (u32x4){w[4], w[5], w[6], w[7]};
    __syncthreads();
}
__device__ __forceinline__ void tr_tile8(const float* __restrict__ src, int N, const float* __restrict__ ksc, float wscale, unsigned char* __restrict__ dst, int ldd, int k0, int n0, int drow0, LAS unsigned* tl, int tid) {
    const int c4 = (tid & 15) * 4, kq = tid >> 4;
    const float* s0 = src + (size_t)(k0 + 4 * kq) * N + n0 + c4;
    f32x4 a = *(const f32x4*)s0, b = *(const f32x4*)(s0 + N), c = *(const f32x4*)(s0 + 2 * (size_t)N), d = *(const f32x4*)(s0 + 3 * (size_t)N);
    float sa = wscale, sb = wscale, sc = wscale, sd = wscale;
    if (ksc) { sa *= ksc[k0 + 4 * kq]; sb *= ksc[k0 + 4 * kq + 1]; sc *= ksc[k0 + 4 * kq + 2]; sd *= ksc[k0 + 4 * kq + 3]; }
#pragma unroll
    for (int j = 0; j < 4; ++j) tl[(c4 + j) * 33 + kq] = pk4_fp8(a[j] * sa, b[j] * sb, c[j] * sc, d[j] * sd);
    __syncthreads();
    const int n = tid >> 3, seg = tid & 7;
    unsigned w[4];
#pragma unroll
    for (int q = 0; q < 4; ++q) w[q] = tl[n * 33 + seg * 4 + q];
    *(u32x4*)(dst + (size_t)(drow0 + n) * ldd + k0 + seg * 16) = (u32x4){w[0], w[1], w[2], w[3]};
    __syncthreads();
}
struct TJob { const float* src; bf16_t* dst; const float* ksc; int K, N, ldd, gu; size_t sbs, dbs; int f8; };
constexpr float W8_SCALE = 64.f;
constexpr int W8_SBYTE = 0x79797979;
__device__ __forceinline__ void run_tjob(const TJob& jb, int t, LAS unsigned* tl, int tid) {
    const int ntn = jb.N / 64, ntk = jb.K / 128, per = ntn * ntk;
    const int bi = t / per, r = t % per, tk = r / ntn, tn = r % ntn;
    const int n0 = tn * 64;
    const int drow0 = jb.gu ? (256 * (n0 >> 7) + (jb.gu == 2 ? 128 : 0) + (n0 & 127)) : n0;
    if (jb.f8) tr_tile8(jb.src + (size_t)bi * jb.sbs, jb.N, jb.ksc, W8_SCALE, (unsigned char*)jb.dst + (size_t)bi * jb.dbs, jb.ldd, tk * 128, n0, drow0, tl, tid);
    else tr_tile(jb.src + (size_t)bi * jb.sbs, jb.N, jb.ksc, jb.dst + (size_t)bi * jb.dbs, jb.ldd, tk * 128, n0, drow0, tl, tid);
}
typedef __attribute__((address_space(4))) const unsigned long long kcu64_t;
#define PIN(i) ((const float*)(__attribute__((address_space(1))) const float*)ka[i])
__device__ __forceinline__ void phase_prologue(kcu64_t* ka, unsigned char* ws, LAS unsigned char* lds, int G, int bid, int tid) {
    LAS unsigned* tl = (LAS unsigned*)lds;
    constexpr int NJ = 12;
    const int cnts[NJ] = {16 * 72, 16 * 32, 4096, 4096, 4096, 16 * 61, 16 * 32, 4096, 4096, 4096, 4 * 24, 2 * 32};
    int total = 0;
#pragma unroll
    for (int j = 0; j < NJ; ++j) total += cnts[j];
    for (int t = bid; t < total; t += G) {
        int j = 0, base = 0;
#pragma unroll
        for (int q = 0; q < NJ - 1; ++q) if (t >= base + cnts[q] && j == q) { base += cnts[q]; j = q + 1; }
        const int tt = t - base;
        TJob jb;
        switch (j) {
            case 0: jb = TJob{PIN(I_WIN0), (bf16_t*)(ws + WS_WIN0), nullptr, 2048, IN0, 2048, 0, 0, 0, F8_IN}; break;
            case 1: jb = TJob{PIN(I_WOUT0), (bf16_t*)(ws + WS_WOUT0), nullptr, 2048, 2048, 2048, 0, 0, 0, F8_OUT}; break;
            case 2: jb = TJob{PIN(I_WG0), (bf16_t*)(ws + WS_WGU0), nullptr, 2048, 512, 2048, 1, (size_t)2048 * 512, (size_t)1024 * 2048, F8_GU}; break;
            case 3: jb = TJob{PIN(I_WU0), (bf16_t*)(ws + WS_WGU0), nullptr, 2048, 512, 2048, 2, (size_t)2048 * 512, (size_t)1024 * 2048, F8_GU}; break;
            case 4: jb = TJob{PIN(I_WD0), (bf16_t*)(ws + WS_WD0), nullptr, 512, 2048, 512, 0, (size_t)512 * 2048, (size_t)2048 * 512, F8_DOWN}; break;
            case 5: jb = TJob{PIN(I_WIN1), (bf16_t*)(ws + WS_WIN1), nullptr, 2048, IN1, 2048, 0, 0, 0, F8_IN}; break;
            case 6: jb = TJob{PIN(I_WOUT1), (bf16_t*)(ws + WS_WOUT1), nullptr, 2048, 2048, 2048, 0, 0, 0, F8_OUT}; break;
            case 7: jb = TJob{PIN(I_WG1), (bf16_t*)(ws + WS_WGU1), nullptr, 2048, 512, 2048, 1, (size_t)2048 * 512, (size_t)1024 * 2048, F8_GU}; break;
            case 8: jb = TJob{PIN(I_WU1), (bf16_t*)(ws + WS_WGU1), nullptr, 2048, 512, 2048, 2, (size_t)2048 * 512, (size_t)1024 * 2048, F8_GU}; break;
            case 9: jb = TJob{PIN(I_WD1), (bf16_t*)(ws + WS_WD1), nullptr, 512, 2048, 512, 0, (size_t)512 * 2048, (size_t)2048 * 512, F8_DOWN}; break;
            case 10: jb = TJob{PIN(I_WQUP), (bf16_t*)(ws + WS_WQUP), PIN(I_DQN), 512, 1536, 512, 0, 0, 0, 0}; break;
            default: jb = TJob{PIN(I_WKVUP), (bf16_t*)(ws + WS_WKVUP), PIN(I_DKVN), 256, 2048, 256, 0, 0, 0, 0}; break;
        }
        run_tjob(jb, tt, tl, tid);
    }
    { constexpr size_t ESZ = F8_IN ? 1 : 2;
      u32x4* z = (u32x4*)(ws + WS_WIN1 + (size_t)IN1 * 2048 * ESZ); const size_t n16 = (size_t)(IN1P - IN1) * 2048 * ESZ / 16;
      const unsigned zu = __float_as_uint(fresh_zero());
      for (size_t i = (size_t)bid * NTHR + tid; i < n16; i += (size_t)G * NTHR) z[i] = (u32x4){zu, zu, zu, zu}; }
    { const f32x8* xs = (const f32x8*)PIN(I_X); const size_t n8 = (size_t)T_ * DM / 8;
      if constexpr (F8_IN) { u32x2* xd = (u32x2*)(ws + WS_RC + 64 * MiB);
          for (size_t i = (size_t)bid * NTHR + tid; i < n8; i += (size_t)G * NTHR) { const f32x8 v = xs[i]; xd[i] = (u32x2){pk4_fp8(v[0], v[1], v[2], v[3]), pk4_fp8(v[4], v[5], v[6], v[7])}; } }
      else { u32x4* xd = (u32x4*)(ws + WS_RA);
          for (size_t i = (size_t)bid * NTHR + tid; i < n8; i += (size_t)G * NTHR) { const f32x8 v = xs[i];
              xd[i] = (u32x4){cvtpk(v[0], v[1]), cvtpk(v[2], v[3]), cvtpk(v[4], v[5]), cvtpk(v[6], v[7])}; } } }
}

__device__ __forceinline__ void phase_prep_qk(bf16_t* H0, const float* qn, const float* kn, int G, int bid, int tid) {
    const int wid = tid >> 6, lane = tid & 63, i = lane & 31, half = lane >> 5;
    const float invf = inv_freq32(i);
    const int e0 = 64 * half + i, e1 = e0 + 32;
    const float gq0 = qn[e0], gq1 = qn[e1], gk0 = kn[e0], gk1 = kn[e1];
    for (int m = bid * 8 + wid; m < T_; m += G * 8) {
        const int s = m & (SEQ - 1); const int pos = half ? (s & 63) : (s >> 6);
        float sn, cs; sincos_rev((float)pos * invf, sn, cs);
        bf16_t* rowp = H0 + (size_t)m * IN0;
#pragma unroll
        for (int hh = 0; hh < 10; ++hh) {
            bf16_t* base = rowp + (hh < 8 ? hh * 128 : 1024 + (hh - 8) * 128);
            const float x0 = bf2f(base[e0]), x1 = bf2f(base[e1]);
            const float ss = wave_sum(x0 * x0 + x1 * x1);
            const float r = rsqrtf(ss * (1.0f / 128.0f) + 1e-6f);
            const float y0 = x0 * r * (hh < 8 ? gq0 : gk0), y1 = x1 * r * (hh < 8 ? gq1 : gk1);
            base[e0] = f2bf(y0 * cs - y1 * sn); base[e1] = f2bf(y1 * cs + y0 * sn);
        }
    }
}
__device__ __forceinline__ void phase_prep_mla(bf16_t* H1, bf16_t* krope, int G, int bid, int tid) {
    const int wid = tid >> 6, lane = tid & 63;
    const float invf = inv_freq32(lane & 31);
    for (int m = bid * 8 + wid; m < T_; m += G * 8) {
        bf16_t* rowp = H1 + (size_t)m * IN1P;
        const u32x4 a = *(const u32x4*)(rowp + 3072 + lane * 8);
        float ss = bflo(a.x) * bflo(a.x) + bfhi(a.x) * bfhi(a.x) + bflo(a.y) * bflo(a.y) + bfhi(a.y) * bfhi(a.y) + bflo(a.z) * bflo(a.z) + bfhi(a.z) * bfhi(a.z) + bflo(a.w) * bflo(a.w) + bfhi(a.w) * bfhi(a.w);
        ss = wave_sum(ss);
        const u32x2 c = *(const u32x2*)(rowp + 3584 + lane * 4);
        float s2 = bflo(c.x) * bflo(c.x) + bfhi(c.x) * bfhi(c.x) + bflo(c.y) * bflo(c.y) + bfhi(c.y) * bfhi(c.y);
        s2 = wave_sum(s2);
        const float rq = rsqrtf(ss * (1.0f / 512.0f) + 1e-6f), rkv = rsqrtf(s2 * (1.0f / 256.0f) + 1e-6f);
        *(u32x4*)(rowp + 3072 + lane * 8) = (u32x4){cvtpk(bflo(a.x) * rq, bfhi(a.x) * rq), cvtpk(bflo(a.y) * rq, bfhi(a.y) * rq), cvtpk(bflo(a.z) * rq, bfhi(a.z) * rq), cvtpk(bflo(a.w) * rq, bfhi(a.w) * rq)};
        *(u32x2*)(rowp + 3584 + lane * 4) = (u32x2){cvtpk(bflo(c.x) * rkv, bfhi(c.x) * rkv), cvtpk(bflo(c.y) * rkv, bfhi(c.y) * rkv)};
        if (lane < 32) { const float x1 = bf2f(rowp[3840 + lane]), x2 = bf2f(rowp[3840 + 32 + lane]);
            float sn, cs; sincos_rev((float)(m & (SEQ - 1)) * invf, sn, cs);
            krope[(size_t)m * 64 + lane] = f2bf(x1 * cs - x2 * sn); krope[(size_t)m * 64 + 32 + lane] = f2bf(x2 * cs + x1 * sn); }
    }
}

constexpr int LNR_PITCH = 2052;
constexpr int LNR_PART = 131584, LNR_SC = 147968, LNR_SEL = 150016, LNR_BLE = 152064, LNR_HIST = 153088;
__device__ __forceinline__ void phase_ln_router(const float* z, const float* g, const float* bb, const float* rw, const float* rb, bf16_t* x1b, unsigned char* x1q,
                                                int* tok_e, int* tok_p, float* tok_g, int* list, unsigned* cnt, LAS unsigned char* lds, int G, int bid, int tid, bool commit = true) {
    const int wid = tid >> 6, lane = tid & 63;
    LAS float* xs = (LAS float*)lds; LAS float* part = (LAS float*)(lds + LNR_PART); LAS float* scs = (LAS float*)(lds + LNR_SC); LAS float* sels = (LAS float*)(lds + LNR_SEL);
    LAS int* ble = (LAS int*)(lds + LNR_BLE); LAS int* hist = (LAS int*)(lds + LNR_HIST);
    f16x8 bw[8][2];
    { const float* rwp = rw + (size_t)(256 * wid + 8 * (lane >> 4)) * 32 + (lane & 15);
#pragma unroll
      for (int ks = 0; ks < 8; ++ks)
#pragma unroll
        for (int hf = 0; hf < 2; ++hf)
#pragma unroll
          for (int j = 0; j < 8; ++j) bw[ks][hf][j] = (_Float16)rwp[(32 * ks + j) * 32 + 16 * hf]; }
    f32x4 v[2][8];
#define LNR_LOAD(tix_, rr) do { const float* zp = z + ((size_t)(tix_) * 16 + 2 * wid + (rr)) * DM + 4 * lane; \
        _Pragma("unroll") for (int i = 0; i < 8; ++i) v[rr][i] = *(const f32x4*)(zp + 256 * i); } while (0)
    const int ntile = T_ / 16;
    int ntl = 0;
    if (bid < ntile) { LNR_LOAD(bid, 0); LNR_LOAD(bid, 1); }
    for (int it = 0; bid + G * it < ntile; ++it) {
        const int tix = bid + G * it;
#pragma unroll
        for (int rr = 0; rr < 2; ++rr) {
            const int row = 2 * wid + rr; const size_t m = (size_t)tix * 16 + row;
            float s = 0.f;
#pragma unroll
            for (int i = 0; i < 8; ++i) s += (v[rr][i][0] + v[rr][i][1]) + (v[rr][i][2] + v[rr][i][3]);
            const float mean = wave_sum(s) * (1.0f / DM); float q = 0.f;
#pragma unroll
            for (int i = 0; i < 8; ++i) { const f32x4 d = v[rr][i] - mean; q += (d[0] * d[0] + d[1] * d[1]) + (d[2] * d[2] + d[3] * d[3]); }
            const float rstd = rsqrtf(wave_sum(q) * (1.0f / DM) + 1e-5f);
#pragma unroll
            for (int i = 0; i < 8; ++i) { const int col = 4 * lane + 256 * i; const f32x4 gv = *(const f32x4*)(g + col), bv = *(const f32x4*)(bb + col);
                const f32x4 y = (v[rr][i] - mean) * rstd * gv + bv;
                LAS f32x2* xp = (LAS f32x2*)(xs + row * LNR_PITCH + col); xp[0] = (f32x2){y[0], y[1]}; xp[1] = (f32x2){y[2], y[3]};
                *(u32x2*)(x1b + m * DM + col) = (u32x2){cvtpk(y[0], y[1]), cvtpk(y[2], y[3])};
                if constexpr (F8_GU) *(unsigned*)(x1q + m * DM + col) = pk4_fp8(y[0], y[1], y[2], y[3]);
                if (i & 1) asm volatile("" ::: "memory"); }
        }
        __builtin_amdgcn_sched_barrier(0);
        if (tix + G < ntile) LNR_LOAD(tix + G, 0);
        __builtin_amdgcn_sched_barrier(0);
        __syncthreads();
        { f32x4 acc0 = {0.f, 0.f, 0.f, 0.f}, acc1 = {0.f, 0.f, 0.f, 0.f}; const LAS float* xa = xs + (lane & 15) * LNR_PITCH + 256 * wid + 8 * (lane >> 4); const int e = lane & 15;
#pragma unroll
          for (int ks = 0; ks < 8; ++ks) { const f32x4 xa0 = *(const LAS f32x4*)(xa + 32 * ks), xa1 = *(const LAS f32x4*)(xa + 32 * ks + 4);
              const float xv[8] = {xa0[0], xa0[1], xa0[2], xa0[3], xa1[0], xa1[1], xa1[2], xa1[3]}; f16x8 ah, al;
#pragma unroll
              for (int j = 0; j < 8; ++j) { const _Float16 hh = (_Float16)xv[j]; ah[j] = hh; al[j] = (_Float16)(xv[j] - (float)hh); }
              acc0 = __builtin_amdgcn_mfma_f32_16x16x32_f16(ah, bw[ks][0], acc0, 0, 0, 0); acc1 = __builtin_amdgcn_mfma_f32_16x16x32_f16(ah, bw[ks][1], acc1, 0, 0, 0);
              acc0 = __builtin_amdgcn_mfma_f32_16x16x32_f16(al, bw[ks][0], acc0, 0, 0, 0); acc1 = __builtin_amdgcn_mfma_f32_16x16x32_f16(al, bw[ks][1], acc1, 0, 0, 0); }
          __builtin_amdgcn_sched_barrier(0);
          if (tix + G < ntile) LNR_LOAD(tix + G, 1);
          __builtin_amdgcn_sched_barrier(0);
#pragma unroll
          for (int r = 0; r < 4; ++r) { const int row = (lane >> 4) * 4 + r; part[(wid * 16 + row) * 32 + e] = acc0[r]; part[(wid * 16 + row) * 32 + 16 + e] = acc1[r]; } }
        __syncthreads();
        { const int row = tid >> 5, e = tid & 31; float lg = 0.f;
#pragma unroll
          for (int w = 0; w < 8; ++w) lg += part[(w * 16 + row) * 32 + e];
          const float sc = 1.0f / (1.0f + __expf(-lg)); scs[row * 32 + e] = sc; sels[row * 32 + e] = sc + rb[e]; }
        __syncthreads();
        if (tid < 16) { const int row = tid; float best = -INFINITY; int bg = 0;
            for (int gI = 0; gI < 8; ++gI) { const float a = sels[row * 32 + 4 * gI], b = sels[row * 32 + 4 * gI + 1], c = sels[row * 32 + 4 * gI + 2], d = sels[row * 32 + 4 * gI + 3];
                const float h1 = fmaxf(a, b), l1 = fminf(a, b), h2 = fmaxf(c, d), l2 = fminf(c, d); const float gs = fmaxf(h1, h2) + fmaxf(fminf(h1, h2), fmaxf(l1, l2));
                if (gs > best) { best = gs; bg = gI; } }
            const float v0 = sels[row * 32 + 4 * bg], v1 = sels[row * 32 + 4 * bg + 1], v2 = sels[row * 32 + 4 * bg + 2], v3 = sels[row * 32 + 4 * bg + 3];
            int i1 = 0; float b1v = v0; if (v1 > b1v) { b1v = v1; i1 = 1; } if (v2 > b1v) { b1v = v2; i1 = 2; } if (v3 > b1v) { b1v = v3; i1 = 3; }
            int i2 = -1; float b2v = -INFINITY;
            if (i1 != 0 && v0 > b2v) { b2v = v0; i2 = 0; } if (i1 != 1 && v1 > b2v) { b2v = v1; i2 = 1; } if (i1 != 2 && v2 > b2v) { b2v = v2; i2 = 2; } if (i1 != 3 && v3 > b2v) { b2v = v3; i2 = 3; }
            const int e1 = 4 * bg + i1, e2 = 4 * bg + i2; const float s1 = scs[row * 32 + e1], s2 = scs[row * 32 + e2]; const float inv = 1.0f / (s1 + s2);
            const size_t m = (size_t)tix * 16 + row;
            tok_e[2 * m] = e1; tok_e[2 * m + 1] = e2; tok_g[2 * m] = s1 * inv; tok_g[2 * m + 1] = s2 * inv;
            ble[(it * 16 + row) * 2] = e1; ble[(it * 16 + row) * 2 + 1] = e2; }
        __syncthreads();
        ntl = it + 1;
    }
#undef LNR_LOAD
    const int nasg = commit ? ntl * 32 : 0;
    if (tid < 32) { int c = 0; for (int i = 0; i < nasg; ++i) c += (ble[i] == tid) ? 1 : 0;
        unsigned base = 0; if (c) base = __hip_atomic_fetch_add(cnt + tid, (unsigned)c, __ATOMIC_RELAXED, __HIP_MEMORY_SCOPE_AGENT);
        hist[tid] = (int)base; }
    __syncthreads();
    if (tid < 32) { int run = hist[tid];
        for (int i = 0; i < nasg; ++i) if (ble[i] == tid) { const int tr = i >> 1; const size_t m = (size_t)(bid + G * (tr >> 4)) * 16 + (tr & 15);
            list[(size_t)tid * 65536 + run] = (int)m; tok_p[2 * m + (i & 1)] = run; ++run; } }
    __syncthreads();
}

constexpr int MOE_LDS = 131072;
__device__ __forceinline__ int moe_prefix(const unsigned* cnt, LAS int* pblk, int tid) {
    if (tid == 0) { int acc = 0; for (int e = 0; e < NE; ++e) { pblk[e] = acc; acc += ((int)cnt[e] + 255) >> 8; } pblk[NE] = acc; }
    __syncthreads();
    return pblk[NE];
}
template <int NJ> __device__ __forceinline__ int moe_table(const unsigned* cnt, LAS int* pblk, LAS int* tab, LAS int* aux, int NB, int G, int bid, int tid) {
    const int NU = NB * NJ;
    if (tid < 16) { const int L = bid + G * tid;
        if (L < NU) { const int rb = L / NJ, j = L % NJ; int e = 0; for (int q = 1; q < NE; ++q) if (pblk[q] <= rb) e = q;
            tab[tid] = rb; tab[16 + tid] = NJ * e + j; aux[tid * 3] = e; aux[tid * 3 + 1] = (rb - pblk[e]) * 256; aux[tid * 3 + 2] = (int)cnt[e]; } }
    __syncthreads();
    int n = 0; for (int i = 0; i < 16; ++i) if (bid + G * i < NU) n = i + 1;
    return n;
}

template <bool FINAL>
__device__ __forceinline__ void phase_combine_ln(const bf16_t* x1b, const bf16_t* Yr, const int* tok_e, const int* tok_p, const float* tok_g, const unsigned* cnt,
                                                 const float* g, const float* bb, bf16_t* xo, unsigned char* xq, float* fo, LAS unsigned char* lds, int G, int bid, int tid) {
    LAS int* pblk = (LAS int*)lds;
    moe_prefix(cnt, pblk, tid);
    const int wid = tid >> 6, lane = tid & 63;
    float ALPHA = 1.4142135623730951f; asm volatile("" : "+v"(ALPHA));
    for (int m = bid * 8 + wid; m < T_; m += G * 8) {
        const int e0 = tok_e[2 * m], e1 = tok_e[2 * m + 1];
        const size_t p0 = (size_t)pblk[e0] * 256 + tok_p[2 * m], p1 = (size_t)pblk[e1] * 256 + tok_p[2 * m + 1];
        const float g0 = tok_g[2 * m], g1 = tok_g[2 * m + 1];
        float v[32]; float s = 0.f;
#pragma unroll
        for (int i = 0; i < 4; ++i) { const int col = 8 * lane + 512 * i;
            const u32x4 xa = *(const u32x4*)(x1b + (size_t)m * DM + col), ya = *(const u32x4*)(Yr + p0 * DM + col), yb = *(const u32x4*)(Yr + p1 * DM + col);
            const unsigned xw[4] = {xa.x, xa.y, xa.z, xa.w}, aw[4] = {ya.x, ya.y, ya.z, ya.w}, bw[4] = {yb.x, yb.y, yb.z, yb.w};
#pragma unroll
            for (int j = 0; j < 4; ++j) { v[i * 8 + 2 * j] = ALPHA * bflo(xw[j]) + g0 * bflo(aw[j]) + g1 * bflo(bw[j]); v[i * 8 + 2 * j + 1] = ALPHA * bfhi(xw[j]) + g0 * bfhi(aw[j]) + g1 * bfhi(bw[j]);
                s += v[i * 8 + 2 * j] + v[i * 8 + 2 * j + 1]; } }
        const float mean = wave_sum(s) * (1.0f / DM); float q = 0.f;
#pragma unroll
        for (int i = 0; i < 32; ++i) { const float d = v[i] - mean; q += d * d; }
        const float rstd = rsqrtf(wave_sum(q) * (1.0f / DM) + 1e-5f);
#pragma unroll
        for (int i = 0; i < 4; ++i) { const int col = 8 * lane + 512 * i;
            const f32x4 ga = *(const f32x4*)(g + col), gb = *(const f32x4*)(g + col + 4), ba = *(const f32x4*)(bb + col), bbv = *(const f32x4*)(bb + col + 4);
            float y[8];
#pragma unroll
            for (int j = 0; j < 4; ++j) { y[j] = (v[i * 8 + j] - mean) * rstd * ga[j] + ba[j]; y[4 + j] = (v[i * 8 + 4 + j] - mean) * rstd * gb[j] + bbv[j]; }
            if constexpr (FINAL) { *(f32x4*)(fo + (size_t)m * DM + col) = (f32x4){y[0], y[1], y[2], y[3]}; *(f32x4*)(fo + (size_t)m * DM + col + 4) = (f32x4){y[4], y[5], y[6], y[7]}; }
            else { *(u32x4*)(xo + (size_t)m * DM + col) = (u32x4){cvtpk(y[0], y[1]), cvtpk(y[2], y[3]), cvtpk(y[4], y[5]), cvtpk(y[6], y[7])};
                if constexpr (F8_IN) *(u32x2*)(xq + (size_t)m * DM + col) = (u32x2){pk4_fp8(y[0], y[1], y[2], y[3]), pk4_fp8(y[4], y[5], y[6], y[7])}; } }
    }
}

#ifndef ATT_ONLY
#define ATT_ONLY -1
#endif
#ifndef REP_K
#define REP_K -1
#endif
#ifndef REP_ATT
#define REP_ATT -1
#endif
#define NREP(k) ((REP_K == (k)) ? 2 : 1)
#define NREPA(k) ((REP_ATT == (k)) ? 2 : 1)
constexpr int N_PHASES = 20;
__global__ void __launch_bounds__(NTHR, 2) fwd(Params p) {
    extern __shared__ __attribute__((aligned(16))) unsigned char lds_raw[];
    LAS unsigned char* lds = (LAS unsigned char*)lds_raw;
    const int tid0 = threadIdx.x, bid = blockIdx.x, G = gridDim.x;
    const int wv = __builtin_amdgcn_readfirstlane(tid0 >> 6);
    const int vcu = (G % 8 == 0) ? (bid % 8) * (G / 8) + bid / 8 : bid;
    unsigned* ctl = (unsigned*)(p.ws + WS_CTL);
    if (tid0 < 4) ((LAS unsigned*)(lds + MISC_OFF))[tid0] = 0u;
    __syncthreads();
    XcdBarrier bar; bar.bar = ctl + CW_BAR; bar.x = 0; bar.st = (volatile LAS unsigned*)(lds + MISC_OFF);
    if (N_LAUNCH_MODE == 1) bar = xcd_barrier_post(ctl + CW_BAR, (volatile LAS unsigned*)(lds + MISC_OFF));
    const int lo = p.ph_lo, hi = p.ph_hi;
#ifndef PH_ONLY
#define PH_ONLY -1
#endif
#define IN(k) ((PH_ONLY < 0 || (PH_ONLY % 10) == ((k) % 10)) && lo <= (k) && (k) < hi)
#define SEAM(k) do { if ((k) + 1 < hi) xcd_barrier(bar); } while (0)

    for (int L = 0; L < 2; ++L) {
        const int pb = L * 10;
        typedef __attribute__((address_space(1))) unsigned char gu8;
        typedef __attribute__((address_space(1))) const float gcf;
        typedef __attribute__((address_space(4))) const unsigned long long kcu64;
#define INP(i) ((const float*)(gcf*)ka[i])
#define PHASE_PTRS \
        kcu64* ka = (kcu64*)__builtin_amdgcn_kernarg_segment_ptr(); asm volatile("" : "+s"(ka)); \
        unsigned char* ws = (unsigned char*)(gu8*)ka[29]; unsigned char* outb = (unsigned char*)(gu8*)ka[28]; \
        unsigned* ctl = (unsigned*)(ws + WS_CTL); \
        bf16_t* RA = (bf16_t*)(ws + WS_RA); bf16_t* RB = (bf16_t*)(ws + WS_RB); bf16_t* RC = (bf16_t*)(ws + WS_RC); \
        int* list = (int*)(ws + WS_LIST); int* tok_e = (int*)(ws + WS_TOKE); int* tok_p = (int*)(ws + WS_TOKP); float* tok_g = (float*)(ws + WS_TOKG); \
        bf16_t* krope = (bf16_t*)(ws + WS_KROPE); \
        bf16_t* Qd = (bf16_t*)(outb + OUT_QD); bf16_t* O1 = (bf16_t*)(outb + OUT_O1); \
        const bf16_t* Win = (const bf16_t*)(ws + (L ? WS_WIN1 : WS_WIN0)); const bf16_t* Wout = (const bf16_t*)(ws + (L ? WS_WOUT1 : WS_WOUT0)); \
        const bf16_t* Wgu = (const bf16_t*)(ws + (L ? WS_WGU1 : WS_WGU0)); const bf16_t* Wd = (const bf16_t*)(ws + (L ? WS_WD1 : WS_WD0)); \
        const int NIN = L ? IN1P : IN0; \
        const bf16_t* xin = L ? RC : RA; \
        bf16_t* Hx = RB; bf16_t* Oat = L ? O1 : RC; float* Z = (float*)RB; \
        bf16_t* x1b = RA; bf16_t* Hm = RC; bf16_t* Yr = RB; \
        unsigned* cnt = ctl + CW_CNT + L * 64; \
        (void)ctl; (void)RA; (void)RB; (void)RC; (void)list; (void)tok_e; (void)tok_p; (void)tok_g; (void)krope; (void)Qd; (void)O1; (void)Win; (void)Wout; (void)Wgu; (void)Wd; (void)NIN; (void)xin; (void)Hx; (void)Oat; (void)Z; (void)x1b; (void)Hm; (void)Yr; (void)cnt; (void)outb

        if (L == 0 && IN(0)) { PHASE_PTRS; _Pragma("unroll 1") for (int rep = 0; rep < NREP(0); ++rep) phase_prologue(ka, ws, lds, G, bid, fresh_tid(wv)); SEAM(0); }

        if (IN(pb + 1)) {
            PHASE_PTRS;
            constexpr int KI = F8_IN ? 1024 : 2048;
            const bf16_t* ain = F8_IN ? (L ? (const bf16_t*)outb : (const bf16_t*)((unsigned char*)RC + 64 * MiB)) : xin;
            pg8::Gemm g{ain, Win, KI, KI, KI}; pg8::StaticOrder S; S.init(T_, NIN, G, bid, KI);
            pg8::EpiBf16 E{Hx, NIN, 0xffff};
            _Pragma("unroll 1") for (int rep = 0; rep < NREP(1); ++rep) pg8::gemm_phase<F8_IN != 0>(wv, lds, g, S, E, W8_SBYTE, 0x7f7f7f7f);
            SEAM(pb + 1);
        }
        if (IN(pb + 2)) {
            PHASE_PTRS;
            if (L == 0) phase_prep_qk(Hx, INP(I_AQN), INP(I_AKN), G, bid, fresh_tid(wv));
            else phase_prep_mla(Hx, krope, G, bid, fresh_tid(wv));
            SEAM(pb + 2);
        }
        if (L == 1 && IN(pb + 3)) _Pragma("unroll 1") for (int rep = 0; rep < NREP(3); ++rep) {
            PHASE_PTRS;
#ifndef P3_ONLY
#define P3_ONLY -1
#endif
            if (P3_ONLY < 0 || P3_ONLY == 0) { pg8::Gemm g{Hx + 3072, (const bf16_t*)(ws + WS_WQUP), 512, IN1P, 512}; pg8::StaticOrder S; S.init(T_, 1536, G, bid, IN1P);
              pg8::EpiBf16 E{Qd, 1536, 0xffff}; pg8::gemm_phase<false>(wv, lds, g, S, E); }
            if (P3_ONLY < 0 || P3_ONLY == 1) { pg8::Gemm g{Hx + 3584, (const bf16_t*)(ws + WS_WKVUP), 256, IN1P, 256}; pg8::StaticOrder S; S.init(T_, 2048, G, bid, IN1P);
              pg8::EpiBf16 E{RA, 2048, 0xffff}; pg8::gemm_phase<false>(wv, lds, g, S, E); }
            if (rep + 1 == NREP(3)) SEAM(pb + 3);
        }
        if (IN(pb + 4)) {
            PHASE_PTRS;
            if (L == 0) {
                if (ATT_ONLY < 0 || ATT_ONLY == 0)
                _Pragma("unroll 1") for (int rep = 0; rep < NREPA(0); ++rep)
                for (int u = vcu; u < 1024; u += G) {
                    __syncthreads();
                    const int b = u >> 7, qb = u & 15, kvh = (u >> 6) & 1, gq = (u >> 4) & 3, h = kvh * 4 + gq;
                    da::DArgs a; a.Q = Hx + (size_t)(b * SEQ + 256 * qb) * IN0 + h * 128; a.ldq = IN0;
                    a.K = Hx + (size_t)b * SEQ * IN0 + 1024 + kvh * 128; a.ldk = IN0; a.V = Hx + (size_t)b * SEQ * IN0 + 1280 + kvh * 128; a.ldv = IN0; a.Kr = nullptr;
                    { const size_t eo = (size_t)(b * SEQ + 256 * qb) * DM + h * 128; a.O = F8_OUT ? (bf16_t*)((unsigned char*)Oat + eo) : Oat + eo; } a.ldo = DM; a.seq = SEQ; a.pos0 = 0;
                    da::attn_dense_body<8, 1>(wv, a, (char*)lds_raw);
                }
                __syncthreads();
                if (ATT_ONLY < 0 || ATT_ONLY == 2)
                _Pragma("unroll 1") for (int rep = 0; rep < NREPA(2); ++rep)
                for (int it = vcu; it < 1024; it += G) {
                    const int tid2 = fresh_tid(wv), wid = __builtin_amdgcn_readfirstlane(tid2 >> 6), lane = tid2 & 63;
                    const int w = it * 8 + wid; LAS unsigned char* wl = lds + wid * da::SP_WAVE_LDS;
                    PolB pol; pol.init(Hx, Oat, w, lane); da::sparse_wave(pol, wl, lane);
                }
            } else {
                if (ATT_ONLY < 0 || ATT_ONLY == 1)
                _Pragma("unroll 1") for (int rep = 0; rep < NREPA(1); ++rep)
                for (int u = vcu; u < 1024; u += G) {
                    __syncthreads();
                    const int b = u >> 7, qb = u & 15, h = (u >> 4) & 7;
                    da::DArgs a; a.Q = Qd + (size_t)(b * SEQ + 256 * qb) * 1536 + h * 192; a.ldq = 1536;
                    a.K = RA + (size_t)b * SEQ * DM + h * 256; a.ldk = DM; a.V = a.K + 128; a.ldv = DM; a.Kr = krope + (size_t)b * SEQ * 64;
                    { const size_t eo = (size_t)(b * SEQ + 256 * qb) * DM + 1024 + h * 128; a.O = F8_OUT ? (bf16_t*)((unsigned char*)Oat + eo) : Oat + eo; } a.ldo = DM; a.seq = SEQ; a.pos0 = 256 * qb;
                    da::attn_dense_body<12, 1>(wv, a, (char*)lds_raw);
                }
                __syncthreads();
                if (ATT_ONLY < 0 || ATT_ONLY == 3)
                _Pragma("unroll 1") for (int rep = 0; rep < NREPA(3); ++rep)
                for (int it = vcu; it < 1024; it += G) {
                    const int tid2 = fresh_tid(wv), wid = __builtin_amdgcn_readfirstlane(tid2 >> 6), lane = tid2 & 63;
                    const int w = it * 8 + wid; LAS unsigned char* wl = lds + wid * da::SP_WAVE_LDS;
                    PolC pol; pol.init(Hx, Oat, INP(I_RPB), (float*)((char*)wl + 16640), w, lane); da::sparse_wave(pol, wl, lane);
                }
            }
            SEAM(pb + 4);
        }
        if (IN(pb + 5)) {
            PHASE_PTRS;
            constexpr int KO = F8_OUT ? 1024 : 2048; constexpr int SXO = F8_OUT ? 0x7b7b7b7b : 0x7f7f7f7f;
            pg8::Gemm g{Oat, Wout, KO, KO, KO}; pg8::StaticOrder S; S.init(T_, DM, G, bid, KO);
            if (L == 0) { pg8::EpiResF32<true> E{Z, INP(I_X)}; _Pragma("unroll 1") for (int rep = 0; rep < NREP(5); ++rep) pg8::gemm_phase<F8_OUT != 0>(wv, lds, g, S, E, W8_SBYTE, SXO); }
            else { pg8::EpiResF32<false> E{Z, RC}; _Pragma("unroll 1") for (int rep = 0; rep < NREP(5); ++rep) pg8::gemm_phase<F8_OUT != 0>(wv, lds, g, S, E, W8_SBYTE, SXO); }
            SEAM(pb + 5);
        }
        if (IN(pb + 6)) {
            PHASE_PTRS;
            _Pragma("unroll 1") for (int rep = 0; rep < NREP(6); ++rep) phase_ln_router(Z, INP(L ? I_LN1G1 : I_LN1G0), INP(L ? I_LN1B1 : I_LN1B0), INP(I_RW), INP(I_RB), x1b, (unsigned char*)RC + 64 * MiB, tok_e, tok_p, tok_g, list, cnt, lds, G, bid, fresh_tid(wv), rep + 1 == NREP(6));
            SEAM(pb + 6);
        }
        if (IN(pb + 7)) {
            PHASE_PTRS;
            LAS int* pblk = (LAS int*)(lds + MOE_LDS); LAS int* tab = pblk + 64; LAS int* aux = tab + 32; LAS int* idx = aux + 64;
            const int tid = fresh_tid(wv);
            const int NB = moe_prefix(cnt, pblk, tid);
            const int n = moe_table<4>(cnt, pblk, tab, aux, NB, G, bid, tid);
            for (int i = 0; i < n; ++i) if (tid < 256) { const int e = aux[i * 3], rs = aux[i * 3 + 1], ce = aux[i * 3 + 2]; idx[i * 256 + tid] = list[(size_t)e * 65536 + min(rs + tid, ce - 1)]; }
            __syncthreads();
            constexpr int KG = F8_GU ? 1024 : 2048;
            const bf16_t* agu = F8_GU ? (const bf16_t*)((unsigned char*)RC + 64 * MiB) : x1b;
            pg8::Gemm g{agu, Wgu, KG, KG, KG}; pg8::TableOrder<true> S{tab, idx, n, KG}; pg8::EpiSiluMul<F8_DOWN != 0> E{Hm};
            _Pragma("unroll 1") for (int rep = 0; rep < NREP(7); ++rep) pg8::gemm_phase<F8_GU != 0>(wv, lds, g, S, E, W8_SBYTE, 0x7f7f7f7f);
            SEAM(pb + 7);
        }
        if (IN(pb + 8)) {
            PHASE_PTRS;
            LAS int* pblk = (LAS int*)(lds + MOE_LDS); LAS int* tab = pblk + 64; LAS int* aux = tab + 32;
            const int tid = fresh_tid(wv);
            const int NB = moe_prefix(cnt, pblk, tid);
            const int n = moe_table<8>(cnt, pblk, tab, aux, NB, G, bid, tid);
            constexpr int KD = F8_DOWN ? 256 : 512;
            pg8::Gemm g{Hm, Wd, KD, KD, KD}; pg8::TableOrder<false> S{tab, nullptr, n, KD}; pg8::EpiBf16 E{Yr, DM, 7};
            _Pragma("unroll 1") for (int rep = 0; rep < NREP(8); ++rep) pg8::gemm_phase<F8_DOWN != 0>(wv, lds, g, S, E, W8_SBYTE, 0x7f7f7f7f);
            SEAM(pb + 8);
        }
        if (IN(pb + 9)) _Pragma("unroll 1") for (int rep = 0; rep < NREP(9); ++rep) {
            PHASE_PTRS;
            if (L == 0) phase_combine_ln<false>(x1b, Yr, tok_e, tok_p, tok_g, cnt, INP(I_LN2G0), INP(I_LN2B0), RC, outb, nullptr, lds, G, bid, fresh_tid(wv));
            else phase_combine_ln<true>(x1b, Yr, tok_e, tok_p, tok_g, cnt, INP(I_LN2G1), INP(I_LN2B1), nullptr, nullptr, (float*)outb, lds, G, bid, fresh_tid(wv));
            if (rep + 1 == NREP(9)) SEAM(pb + 9);
        }
    }
#undef IN
#undef SEAM
#undef INP
#undef PHASE_PTRS
}

extern "C" void kernel_launch(void* const* d_in, const int* in_sizes, int n_in, void* d_out, int out_size, void* d_ws, size_t ws_size, hipStream_t stream) {
    static int grid = 0;
    if (grid == 0) {
        if (n_in != 28 || out_size != T_ * DM || ws_size < WS_END) { fprintf(stderr, "kernel_launch: unexpected shapes: n_in %d out %d ws %zu (need %zu)\n", n_in, out_size, ws_size, (size_t)WS_END); grid = -1; return; }
        int dev = 0, cus = 0, per_cu = 0;
        if (hipGetDevice(&dev) != hipSuccess || hipDeviceGetAttribute(&cus, hipDeviceAttributeMultiprocessorCount, dev) != hipSuccess) { grid = -1; return; }
        if (hipFuncSetAttribute((const void*)fwd, hipFuncAttributeMaxDynamicSharedMemorySize, LDS_BYTES) != hipSuccess) { fprintf(stderr, "kernel_launch: hipFuncSetAttribute failed\n"); grid = -1; return; }
        if (hipOccupancyMaxActiveBlocksPerMultiprocessor(&per_cu, (const void*)fwd, NTHR, LDS_BYTES) != hipSuccess || per_cu < 1)
            fprintf(stderr, "kernel_launch: occupancy query reports %d workgroups per CU\n", per_cu);
        (void)hipGetLastError();
        grid = cus;
    }
    if (grid < 0) return;
    (void)hipMemsetAsync((char*)d_ws + WS_CTL, 0, CTL_ZERO_BYTES, stream);
    Params p{};
    for (int i = 0; i < 28; ++i) p.in[i] = (const float*)d_in[i];
    p.out = (float*)d_out; p.ws = (unsigned char*)d_ws;
#if N_LAUNCH_MODE == 1
    p.ph_lo = 0; p.ph_hi = N_PHASES;
    hipLaunchKernelGGL(fwd, dim3(grid), dim3(NTHR), LDS_BYTES, stream, p);
#else
    for (int k = 0; k < N_PHASES; ++k) { if (k == 3 || k == 10) continue; p.ph_lo = k; p.ph_hi = k + 1;
        hipLaunchKernelGGL(fwd, dim3(grid), dim3(NTHR), LDS_BYTES, stream, p); }
#endif
    const hipError_t le = hipPeekAtLastError();
    if (le != hipSuccess) fprintf(stderr, "kernel_launch: launch failed: %s\n", hipGetErrorName(le));
}
```

```cpp
#include <hip/hip_runtime.h>
#include <cstdio>
#include <cstdint>

#ifndef N_LAUNCH_MODE
#define N_LAUNCH_MODE 1
#endif
#ifndef DBG_CHECK
#define DBG_CHECK 0
#endif
#ifndef F8_DOWN
#define F8_DOWN 1
#endif
#ifndef F8_GU
#define F8_GU 1
#endif
#ifndef F8_IN
#define F8_IN 1
#endif
#ifndef F8_OUT
#define F8_OUT 1
#endif
#ifndef F8_YR
#define F8_YR 1
#endif

#define LAS __attribute__((address_space(3)))
typedef unsigned short bf16_t;
typedef short bf16x8 __attribute__((ext_vector_type(8)));
typedef short s16x4 __attribute__((ext_vector_type(4)));
typedef float f32x2 __attribute__((ext_vector_type(2)));
typedef float f32x4 __attribute__((ext_vector_type(4)));
typedef float f32x8 __attribute__((ext_vector_type(8)));
typedef float f32x16 __attribute__((ext_vector_type(16)));
typedef unsigned u32x2 __attribute__((ext_vector_type(2)));
typedef unsigned u32x4 __attribute__((ext_vector_type(4)));
typedef int i32x8 __attribute__((ext_vector_type(8)));
typedef _Float16 f16x8 __attribute__((ext_vector_type(8)));
typedef _Float16 f16x2 __attribute__((ext_vector_type(2)));
typedef int i32x4 __attribute__((ext_vector_type(4)));

constexpr int T_ = 32768, DM = 2048, SEQ = 4096, NBATCH = 8;
constexpr int IN0 = 4608, IN1 = 3904, IN1P = 4096;
constexpr int NE = 32, DE = 512, MAXBLK = 288;
constexpr float ALPHA = 1.4142135623730951f;
constexpr float LOG2E = 1.4426950408889634f;
constexpr int NTHR = 512;

constexpr size_t MiB = 1u << 20;
constexpr size_t WS_CTL = 0, CTL_ZERO_BYTES = 1 * MiB;
constexpr size_t WS_LIST = 1 * MiB;
constexpr size_t WS_TOKE = 9 * MiB;
constexpr size_t WS_TOKP = WS_TOKE + 256 * 1024;
constexpr size_t WS_TOKG = WS_TOKP + 256 * 1024;
constexpr size_t WS_RSTAT = WS_TOKG + 256 * 1024;
constexpr size_t WS_KROPE = 10 * MiB;
constexpr size_t WS_WIN0 = 16 * MiB, WS_WOUT0 = 34 * MiB, WS_WGU0 = 42 * MiB, WS_WD0 = 170 * MiB;
constexpr size_t WS_WIN1 = 234 * MiB, WS_WOUT1 = 250 * MiB, WS_WGU1 = 258 * MiB, WS_WD1 = 386 * MiB;
constexpr size_t WS_WQUP = 450 * MiB, WS_WKVUP = 452 * MiB;
constexpr size_t WS_RA = 454 * MiB, WS_RB = 582 * MiB, WS_RC = 870 * MiB, WS_END = 998 * MiB;
constexpr size_t OUT_QD = 0, OUT_O1 = 96 * MiB;
constexpr int CW_CNT = 64;
constexpr int CW_DBG = 512;
constexpr int CW_BAR = 4096;

constexpr int LDS_BYTES = 155648;
constexpr int MISC_OFF = LDS_BYTES - 64;

__device__ __forceinline__ unsigned cvtpk(float lo, float hi) { unsigned r; asm volatile("v_cvt_pk_bf16_f32 %0, %1, %2" : "=v"(r) : "v"(lo), "v"(hi)); return r; }
__device__ __forceinline__ float bf2f(unsigned short b) { return __uint_as_float(((unsigned)b) << 16); }
__device__ __forceinline__ float bflo(unsigned w) { return __uint_as_float(w << 16); }
__device__ __forceinline__ float bfhi(unsigned w) { return __uint_as_float(w & 0xffff0000u); }
__device__ __forceinline__ bf16_t f2bf(float f) { return (bf16_t)(cvtpk(f, f) & 0xffffu); }
__device__ __forceinline__ unsigned pk4_fp8(float a, float b, float c, float d) { int w = 0; w = __builtin_amdgcn_cvt_pk_fp8_f32(a, b, w, false); w = __builtin_amdgcn_cvt_pk_fp8_f32(c, d, w, true); return (unsigned)w; }
constexpr float O8_SCALE = 16.f;
__device__ __forceinline__ unsigned char f2fp8(float v) { return (unsigned char)(__builtin_amdgcn_cvt_pk_fp8_f32(v, v, 0, false) & 0xff); }
__device__ __forceinline__ float clamp8(float v) { return fminf(fmaxf(v, -400.f), 400.f); }
__device__ __forceinline__ int fresh_tid(int wv) { int l; asm volatile("v_mbcnt_lo_u32_b32 %0, -1, 0\n\tv_mbcnt_hi_u32_b32 %0, -1, %0" : "=v"(l)); return wv * 64 + l; }
__device__ __forceinline__ float fresh_zero() { float z; asm volatile("v_mov_b32 %0, 0" : "=v"(z)); return z; }
__device__ __forceinline__ float wave_sum(float v) {
    v += __int_as_float(__builtin_amdgcn_ds_swizzle(__float_as_int(v), (1 << 10) | 0x1f));
    v += __int_as_float(__builtin_amdgcn_ds_swizzle(__float_as_int(v), (2 << 10) | 0x1f));
    v += __int_as_float(__builtin_amdgcn_ds_swizzle(__float_as_int(v), (4 << 10) | 0x1f));
    v += __int_as_float(__builtin_amdgcn_ds_swizzle(__float_as_int(v), (8 << 10) | 0x1f));
    v += __int_as_float(__builtin_amdgcn_ds_swizzle(__float_as_int(v), (16 << 10) | 0x1f));
    auto rr = __builtin_amdgcn_permlane32_swap(__float_as_uint(v), __float_as_uint(v), false, false);
    return __uint_as_float(rr[0]) + __uint_as_float(rr[1]);
}
__device__ __forceinline__ float inv_freq32(int i) { return __builtin_amdgcn_exp2f(-(float)i * 0.41524101186092029f); }
__device__ __forceinline__ void sincos_rev(float angle, float& s, float& c) {
    float rev = angle * 0.15915494309189535f; rev = rev - floorf(rev);
    s = __builtin_amdgcn_sinf(rev); c = __builtin_amdgcn_cosf(rev);
}

#define XB_TMO      128
#define XB_XCNT(j)  (256  + 64 * (j))
#define XB_XSUB(j)  (1280 + 64 * (j))
#define XB_XGEN(j)  (2304 + 64 * (j))
#define XB_TOP      3328
#define XB_TOPGEN   3392
#define XCD_BAR_WORDS 3456
#define XB_SPIN_CAP (1u << 20)
__device__ __forceinline__ unsigned xb_ld(unsigned* p)              { return __hip_atomic_load(p, __ATOMIC_RELAXED, __HIP_MEMORY_SCOPE_AGENT); }
__device__ __forceinline__ unsigned xb_add(unsigned* p, unsigned v) { return __hip_atomic_fetch_add(p, v, __ATOMIC_RELAXED, __HIP_MEMORY_SCOPE_AGENT); }
__device__ __forceinline__ unsigned xb_xcc_id() { return (unsigned)__builtin_amdgcn_s_getreg((3 << 11) | 20) & 0xFu; }
#define XB_SPIN(cond, bar) do { unsigned _sp = 0; while (cond) { __builtin_amdgcn_s_sleep(1); \
    if ((++_sp & 255u) == 0u) { if (xb_ld(&(bar)[XB_TMO])) break; if (_sp > XB_SPIN_CAP) { atomicAdd(&(bar)[XB_TMO], 1u); break; } } } } while (0)
struct XcdBarrier { unsigned* bar; unsigned x; volatile LAS unsigned* st; };
__device__ __forceinline__ XcdBarrier xcd_barrier_post(unsigned* bar, volatile LAS unsigned* st) {
    XcdBarrier b; b.bar = bar; b.x = xb_xcc_id(); b.st = st;
    if (threadIdx.x == 0) (void)xb_add(&bar[XB_XCNT(b.x)], 1u);
    return b;
}
__device__ __forceinline__ void xcd_barrier_complete(unsigned* bar, unsigned x, unsigned& nloc, unsigned& nx) {
    const unsigned G = gridDim.x * gridDim.y * gridDim.z;
    unsigned sum, cnt, mine, sp = 0u;
    for (;;) {
        sum = 0u; cnt = 0u; mine = 0u;
#pragma unroll
        for (unsigned j = 0; j < 16; ++j) { const unsigned c = xb_ld(&bar[XB_XCNT(j)]); sum += c; cnt += (c > 0u) ? 1u : 0u; mine = (j == x) ? c : mine; }
        if (sum == G) break;
        __builtin_amdgcn_s_sleep(1);
        if ((++sp & 255u) == 0u) { if (xb_ld(&bar[XB_TMO])) break; if (sp > XB_SPIN_CAP) { atomicAdd(&bar[XB_TMO], 1u); break; } }
    }
    nloc = mine > 0u ? mine : 1u; nx = cnt > 0u ? cnt : 1u;
}
__device__ __forceinline__ void xcd_barrier(const XcdBarrier& b) {
    asm volatile("s_waitcnt vmcnt(0)" ::: "memory");
    __syncthreads();
    if (threadIdx.x == 0) {
        unsigned* bar = b.bar;
        __builtin_amdgcn_s_waitcnt(0);
        unsigned nloc = b.st[0], nx = b.st[1];
        if (nloc == 0u) { xcd_barrier_complete(bar, b.x, nloc, nx); b.st[0] = nloc; b.st[1] = nx; }
        const unsigned old = xb_add(&bar[XB_XSUB(b.x)], 1u);
        const unsigned gen = old / nloc;
        if (old + 1u == (gen + 1u) * nloc) {
            __builtin_amdgcn_fence(__ATOMIC_RELEASE, "agent");
            asm volatile("s_waitcnt vmcnt(0)" ::: "memory");
            const unsigned og = xb_add(&bar[XB_TOP], 1u);
            const unsigned tg = og / nx;
            if (og + 1u == (tg + 1u) * nx) xb_add(&bar[XB_TOPGEN], 1u);
            else XB_SPIN(xb_ld(&bar[XB_TOPGEN]) == tg, bar);
            __builtin_amdgcn_fence(__ATOMIC_ACQUIRE, "agent");
            xb_add(&bar[XB_XGEN(b.x)], 1u);
            asm volatile("s_waitcnt vmcnt(0)" ::: "memory");
        } else {
            XB_SPIN(xb_ld(&bar[XB_XGEN(b.x)]) == gen, bar);
            __builtin_amdgcn_fence(__ATOMIC_ACQUIRE, "agent");
            asm volatile("s_waitcnt vmcnt(0)" ::: "memory");
        }
    }
    __syncthreads();
}

namespace pg8 {
constexpr int BM = 256, BK = 64, HALF = 128, HTB = HALF * BK * 2, STAGE_BYTES = 8 * HTB, NXCD = 8, WGM = 8;
__device__ __forceinline__ int lds_byte(int r, int c) { const int st = (r >> 4) * 2 + (c >> 5), rr = r & 15, cc = c & 31, ob = rr * 64 + cc * 2; return st * 1024 + (ob ^ (((ob >> 9) & 1) << 5)); }
__device__ __forceinline__ void stage_rc(int b, int& R, int& C) { const int st = b / 1024, sb = b % 1024, swz = sb ^ (((sb >> 9) & 1) << 5); R = (st >> 1) * 16 + swz / 64; C = (st & 1) * 32 + (swz % 64) / 2; }
__device__ __forceinline__ int perm32(int rho) { const int n = rho >> 4, i = rho & 15; return 8 * (i >> 2) + 4 * n + (i & 3); }
struct Unit { int pm, pn, q; };
struct Gemm { const bf16_t* A; const bf16_t* Bt; int K, lda, ldb; };

struct StaticOrder {
    static constexpr bool GATHER = false;
    int nM, nN, nwg, G, c, lda;
    __device__ void init(int M, int N, int G_, int c_, int lda_) { nM = M / BM; nN = N / BM; nwg = nM * nN; G = G_; c = c_; lda = lda_; }
    __device__ __forceinline__ bool next(int i, Unit& u) const {
        const long L = (long)i * G + c; if (L >= nwg) return false;
        int wgid = (int)L; { const int q = nwg / NXCD, r = nwg % NXCD, xcd = wgid % NXCD, off = wgid / NXCD; wgid = (xcd < r ? xcd * (q + 1) : r * (q + 1) + (xcd - r) * q) + off; }
        const int nig = WGM * nN, gid = wgid / nig, fm = gid * WGM, gsz = (nM - fm) < WGM ? (nM - fm) : WGM;
        u.pm = fm + ((wgid % nig) % gsz); u.pn = (wgid % nig) / gsz; u.q = i; return true;
    }
    __device__ __forceinline__ void aoff(const Unit& u, const int (&R)[2], const int (&C)[2], unsigned (&o)[2][2]) const {
#pragma unroll
        for (int h = 0; h < 2; ++h)
#pragma unroll
            for (int i = 0; i < 2; ++i) o[h][i] = (unsigned)((u.pm * BM + h * HALF + R[i]) * lda + C[i]) * 2u;
    }
};
template <bool GATHER_> struct TableOrder {
    static constexpr bool GATHER = GATHER_;
    const LAS int* tab; const LAS int* idx; int n, lda;
    __device__ __forceinline__ bool next(int i, Unit& u) const { if (i >= n) return false; u.pm = tab[i]; u.pn = tab[16 + i]; u.q = i; return true; }
    __device__ __forceinline__ void aoff(const Unit& u, const int (&R)[2], const int (&C)[2], unsigned (&o)[2][2]) const {
#pragma unroll
        for (int h = 0; h < 2; ++h)
#pragma unroll
            for (int i = 0; i < 2; ++i) { const int row = GATHER ? idx[u.q * 256 + h * HALF + R[i]] : (u.pm * BM + h * HALF + R[i]); o[h][i] = (unsigned)(row * lda + C[i]) * 2u; }
    }
};

template <bool O8> struct EpiBf16T {
    static constexpr bool PERM = true;
    bf16_t* O; int ldc; int pnmask;
    __device__ __forceinline__ void operator()(const f32x4 (&acc)[2][2][4][2], const Unit& u, int wr, int wc, int fr, int fq) const {
        const int row0 = u.pm * BM + wr * 64 + fr; const int col0 = (u.pn & pnmask) * BM + wc * 32 + 8 * fq;
#pragma unroll
        for (int ai = 0; ai < 2; ++ai)
#pragma unroll
            for (int m = 0; m < 4; ++m) { const size_t eoff = (size_t)(row0 + ai * HALF + m * 16) * ldc + col0;
#pragma unroll
                for (int bj = 0; bj < 2; ++bj) { const f32x4 v0 = acc[ai][bj][m][0], v1 = acc[ai][bj][m][1];
                    if constexpr (O8) { u32x2 w; w.x = pk4_fp8(v0[0] * 16.f, v0[1] * 16.f, v0[2] * 16.f, v0[3] * 16.f); w.y = pk4_fp8(v1[0] * 16.f, v1[1] * 16.f, v1[2] * 16.f, v1[3] * 16.f);
                        *(u32x2*)((unsigned char*)O + eoff + bj * HALF) = w; }
                    else { u32x4 w; w.x = cvtpk(v0[0], v0[1]); w.y = cvtpk(v0[2], v0[3]); w.z = cvtpk(v1[0], v1[1]); w.w = cvtpk(v1[2], v1[3]);
                        *(u32x4*)(O + eoff + bj * HALF) = w; } } }
    }
};
typedef EpiBf16T<false> EpiBf16;
struct EpiRowScale {
    static constexpr bool PERM = true;
    bf16_t* O; int ldc; const float* rs; int which;
    __device__ __forceinline__ void operator()(const f32x4 (&acc)[2][2][4][2], const Unit& u, int wr, int wc, int fr, int fq) const {
        const int row0 = u.pm * BM + wr * 64 + fr; const int col0 = u.pn * BM + wc * 32 + 8 * fq;
#pragma unroll
        for (int ai = 0; ai < 2; ++ai)
#pragma unroll
            for (int m = 0; m < 4; ++m) { const int row = row0 + ai * HALF + m * 16; const float s = rs[row * 2 + which]; bf16_t* rowp = O + (size_t)row * ldc + col0;
#pragma unroll
                for (int bj = 0; bj < 2; ++bj) { const f32x4 v0 = acc[ai][bj][m][0] * s, v1 = acc[ai][bj][m][1] * s;
                    u32x4 w; w.x = cvtpk(v0[0], v0[1]); w.y = cvtpk(v0[2], v0[3]); w.z = cvtpk(v1[0], v1[1]); w.w = cvtpk(v1[2], v1[3]);
                    *(u32x4*)(rowp + bj * HALF) = w; } }
    }
};
template <bool O8> struct EpiSiluMul {
    static constexpr bool PERM = true;
    bf16_t* O;
    __device__ __forceinline__ void operator()(const f32x4 (&acc)[2][2][4][2], const Unit& u, int wr, int wc, int fr, int fq) const {
        const int row0 = u.pm * BM + wr * 64 + fr; const int col0 = (u.pn & 3) * HALF + wc * 32 + 8 * fq;
#pragma unroll
        for (int ai = 0; ai < 2; ++ai)
#pragma unroll
            for (int m = 0; m < 4; ++m) { const size_t eoff = (size_t)(row0 + ai * HALF + m * 16) * DE + col0; float h[8];
#pragma unroll
                for (int n = 0; n < 2; ++n)
#pragma unroll
                    for (int j = 0; j < 4; ++j) { const float g = acc[ai][0][m][n][j], up = acc[ai][1][m][n][j];
                        const float sg = g * __builtin_amdgcn_rcpf(1.0f + __builtin_amdgcn_exp2f(-g * LOG2E)); h[n * 4 + j] = sg * up; }
                if constexpr (O8) { u32x2 w; w.x = pk4_fp8(clamp8(h[0]), clamp8(h[1]), clamp8(h[2]), clamp8(h[3])); w.y = pk4_fp8(clamp8(h[4]), clamp8(h[5]), clamp8(h[6]), clamp8(h[7]));
                    *(u32x2*)((unsigned char*)O + eoff) = w; }
                else { u32x4 w; w.x = cvtpk(h[0], h[1]); w.y = cvtpk(h[2], h[3]); w.z = cvtpk(h[4], h[5]); w.w = cvtpk(h[6], h[7]);
                    *(u32x4*)(O + eoff) = w; } }
    }
};
template <bool RES_F32> struct EpiResF32 {
    static constexpr bool PERM = false;
    float* Z; const void* res;
    __device__ __forceinline__ void operator()(const f32x4 (&acc)[2][2][4][2], const Unit& u, int wr, int wc, int fr, int fq) const {
        const int row0 = u.pm * BM + wr * 64 + fr, col0 = u.pn * BM + wc * 32 + 4 * fq;
        float ALPHA = 1.4142135623730951f; asm volatile("" : "+v"(ALPHA));
#pragma unroll
        for (int ai = 0; ai < 2; ++ai)
#pragma unroll
            for (int m = 0; m < 4; ++m) { const size_t off = (size_t)(row0 + ai * HALF + m * 16) * DM + col0;
#pragma unroll
                for (int bj = 0; bj < 2; ++bj)
#pragma unroll
                    for (int n = 0; n < 2; ++n) { f32x4 o = acc[ai][bj][m][n];
                        if constexpr (RES_F32) { const f32x4 rv = *(const f32x4*)((const float*)res + off + bj * HALF + n * 16); o += ALPHA * rv; }
                        else { const u32x2 rb = *(const u32x2*)((const bf16_t*)res + off + bj * HALF + n * 16);
                            o[0] += ALPHA * bflo(rb.x); o[1] += ALPHA * bfhi(rb.x); o[2] += ALPHA * bflo(rb.y); o[3] += ALPHA * bfhi(rb.y); }
                        *(f32x4*)(Z + off + bj * HALF + n * 16) = o; } }
    }
};

template <bool F8, class Epi, class Sched>
__device__ __forceinline__ void gemm_phase(int wv, LAS unsigned char* lds, const Gemm g, const Sched& S, const Epi& E, int sW = 0x7f7f7f7f, int sX = 0x7f7f7f7f) {
    constexpr bool GA = Sched::GATHER;
    const int tid = fresh_tid(wv), wid = __builtin_amdgcn_readfirstlane(tid >> 6), lane = tid & 63, wr = wid >> 2, wc = wid & 3, fr = lane & 15, fq = lane >> 4;
    int K = g.K; asm volatile("" : "+s"(K));
    const int nt = K / BK;
    int Rr[2], Cc[2]; unsigned voffA[2], voffB[2];
#pragma unroll
    for (int i = 0; i < 2; ++i) { int R, C; stage_rc(tid * 16 + i * 8192, R, C); Rr[i] = R; Cc[i] = C; const int Rb = Epi::PERM ? ((R & ~31) + perm32(R & 31)) : R;
        voffA[i] = (unsigned)(R * g.lda + C) * 2u; voffB[i] = (unsigned)(Rb * g.ldb + C) * 2u; }
    const size_t kstep = (size_t)(BK * 2);
    const size_t hstepA = (size_t)HALF * g.lda * 2, tstepA = 2 * hstepA;
    const size_t hstepB = (size_t)HALF * g.ldb * 2, tstepB = 2 * hstepB;
    const unsigned ldsw = (unsigned)wid * 1024u;
    const int aoff = lds_byte(wr * 64 + fr, fq * 8), boff = lds_byte(wc * 32 + fr, fq * 8);
#define PG8_SA(b, h) (((b) * 2 + (h)) * HTB)
#define PG8_SB(b, h) ((4 + (b) * 2 + (h)) * HTB)
#define PG8_STAGE(bufoff, gbase, voff) do { _Pragma("unroll") for (int _i = 0; _i < 2; ++_i) \
        __builtin_amdgcn_global_load_lds((const unsigned*)((const char*)(gbase) + (voff)[_i]), (LAS unsigned*)(lds + (bufoff) + ldsw + _i * 8192), 16, 0, 0); } while (0)
#define PG8_STAGE_A(bufoff, h, pbase, koff, goffs) do { if constexpr (GA) { PG8_STAGE(bufoff, gA + (koff), (goffs)[h]); } else { PG8_STAGE(bufoff, (pbase) + (h) * hstepA, voffA); } } while (0)
#define PG8_LD32(dst, off) do { const i32x4 _lo = *(const LAS i32x4*)(lds + (off)), _hi = *(const LAS i32x4*)(lds + (off) + 1024); dst = __builtin_shufflevector(_lo, _hi, 0, 1, 2, 3, 4, 5, 6, 7); } while (0)
#define PG8_LDA(dst, b, h) do { _Pragma("unroll") for (int m = 0; m < 4; ++m) PG8_LD32(dst[m], PG8_SA(b, h) + aoff + m * 2048); } while (0)
#define PG8_LDB(dst, b, h) do { _Pragma("unroll") for (int n = 0; n < 2; ++n) PG8_LD32(dst[n], PG8_SB(b, h) + boff + n * 2048); } while (0)
#define PG8_LOH(v) __builtin_bit_cast(bf16x8, __builtin_shufflevector(v, v, 0, 1, 2, 3))
#define PG8_HIH(v) __builtin_bit_cast(bf16x8, __builtin_shufflevector(v, v, 4, 5, 6, 7))
#define PG8_MMA(ai, bj, At, Bt) do { __builtin_amdgcn_s_setprio(1); \
        if constexpr (F8) { _Pragma("unroll") for (int m = 0; m < 4; ++m) _Pragma("unroll") for (int n = 0; n < 2; ++n) \
            asm volatile("v_mfma_scale_f32_16x16x128_f8f6f4 %0, %1, %2, %0, %3, %4 op_sel_hi:[0,0,0]" : "+v"(acc[ai][bj][m][n]) : "v"(Bt[n]), "v"(At[m]), "v"(sW), "v"(sX)); } \
        else { _Pragma("unroll") for (int m = 0; m < 4; ++m) _Pragma("unroll") for (int n = 0; n < 2; ++n) { \
            acc[ai][bj][m][n] = __builtin_amdgcn_mfma_f32_16x16x32_bf16(PG8_LOH(Bt[n]), PG8_LOH(At[m]), acc[ai][bj][m][n], 0, 0, 0); \
            acc[ai][bj][m][n] = __builtin_amdgcn_mfma_f32_16x16x32_bf16(PG8_HIH(Bt[n]), PG8_HIH(At[m]), acc[ai][bj][m][n], 0, 0, 0); } } \
        __builtin_amdgcn_s_setprio(0); } while (0)
#define PG8_WAIT_V(n) asm volatile("s_waitcnt vmcnt(" #n ")" ::: "memory")
#define PG8_WAIT_L(n) asm volatile("s_waitcnt lgkmcnt(" #n ")" ::: "memory")
#define PG8_BAR __builtin_amdgcn_s_barrier()
#define PG8_SCHED __builtin_amdgcn_sched_barrier(0)
    Unit cur, nxt; int ui = 0;
    if (!S.next(0, cur)) return;
    f32x4 acc[2][2][4][2];
#pragma unroll
    for (int a = 0; a < 2; ++a)
#pragma unroll
        for (int b = 0; b < 2; ++b)
#pragma unroll
            for (int m = 0; m < 4; ++m)
#pragma unroll
                for (int n = 0; n < 2; ++n) { const float zf = fresh_zero(); acc[a][b][m][n] = (f32x4){zf, zf, zf, zf}; }
    unsigned ca[2][2];
    if constexpr (GA) S.aoff(cur, Rr, Cc, ca);
    const char* gA = (const char*)g.A;
    const char* cA = gA + (GA ? (size_t)0 : (size_t)cur.pm * tstepA);
    const char* cB = (const char*)g.Bt + (size_t)cur.pn * tstepB;
    PG8_STAGE(PG8_SB(0, 0), cB, voffB); PG8_STAGE_A(PG8_SA(0, 0), 0, cA, 0, ca); PG8_STAGE(PG8_SB(0, 1), cB + hstepB, voffB); PG8_STAGE_A(PG8_SA(0, 1), 1, cA, 0, ca);
    if (wr == 1) PG8_BAR;
    PG8_WAIT_V(4); PG8_BAR;
    PG8_STAGE(PG8_SB(1, 0), cB + kstep, voffB); PG8_STAGE_A(PG8_SA(1, 0), 0, cA + kstep, kstep, ca); PG8_STAGE(PG8_SB(1, 1), cB + hstepB + kstep, voffB);
    PG8_WAIT_V(6); PG8_BAR;
    for (;;) {
        const bool has_next = S.next(ui + 1, nxt);
        const char* nA = (!GA && has_next) ? gA + (size_t)nxt.pm * tstepA : cA;
        const char* nB = has_next ? (const char*)g.Bt + (size_t)nxt.pn * tstepB : cB;
#pragma unroll 1
        for (int t = 0; t < nt; t += 2) {
            const bool last = (t == nt - 2);
            const size_t k1 = (size_t)(t + 1) * kstep, k2 = last ? (size_t)0 : (size_t)(t + 2) * kstep, k3 = k2 + kstep;
            const char* a1 = cA + k1;
            const char* a2 = last ? nA : cA + k2; const char* b2 = last ? nB : cB + (size_t)(t + 2) * kstep;
            const char* a3 = a2 + kstep; const char* b3 = b2 + kstep;
            i32x8 At[4], B0[2], B1[2];
            unsigned xa[2][2];
            if constexpr (GA) {
                if (last && has_next) { int R2[2], C2[2]; const int t2 = fresh_tid(wv); stage_rc(t2 * 16, R2[0], C2[0]); stage_rc(t2 * 16 + 8192, R2[1], C2[1]); S.aoff(nxt, R2, C2, xa); }
                else {
#pragma unroll
                    for (int h = 0; h < 2; ++h)
#pragma unroll
                        for (int i = 0; i < 2; ++i) xa[h][i] = ca[h][i];
                }
            }
            PG8_LDB(B0, 0, 0); PG8_SCHED; PG8_LDA(At, 0, 0); PG8_STAGE_A(PG8_SA(1, 1), 1, a1, k1, ca);
            PG8_WAIT_L(8); PG8_BAR; PG8_WAIT_L(0); PG8_MMA(0, 0, At, B0); PG8_BAR; PG8_SCHED;
            PG8_LDB(B1, 0, 1); PG8_STAGE(PG8_SB(0, 0), b2, voffB);
            PG8_BAR; PG8_WAIT_L(0); PG8_MMA(0, 1, At, B1); PG8_BAR;
            PG8_LDA(At, 0, 1); PG8_STAGE_A(PG8_SA(0, 0), 0, a2, k2, xa);
            PG8_BAR; PG8_WAIT_L(0); PG8_MMA(1, 0, At, B0); PG8_BAR; PG8_SCHED;
            PG8_STAGE(PG8_SB(0, 1), b2 + hstepB, voffB);
            PG8_WAIT_V(6); PG8_BAR; PG8_MMA(1, 1, At, B1); PG8_BAR;
            PG8_LDB(B0, 1, 0); PG8_SCHED; PG8_LDA(At, 1, 0); PG8_STAGE_A(PG8_SA(0, 1), 1, a2, k2, xa);
            PG8_WAIT_L(8); PG8_BAR; PG8_WAIT_L(0); PG8_MMA(0, 0, At, B0); PG8_BAR; PG8_SCHED;
            PG8_LDB(B1, 1, 1); PG8_STAGE(PG8_SB(1, 0), b3, voffB);
            PG8_BAR; PG8_WAIT_L(0); PG8_MMA(0, 1, At, B1); PG8_BAR;
            PG8_LDA(At, 1, 1); PG8_STAGE_A(PG8_SA(1, 0), 0, a3, k3, xa);
            PG8_BAR; PG8_WAIT_L(0); PG8_MMA(1, 0, At, B0); PG8_BAR; PG8_SCHED;
            PG8_STAGE(PG8_SB(1, 1), b3 + hstepB, voffB);
            PG8_WAIT_V(6); PG8_BAR; PG8_MMA(1, 1, At, B1); PG8_BAR;
        }
        if constexpr (F8) asm volatile("s_nop 7\n\ts_nop 7\n\ts_nop 7" ::: "memory");
        { const int l2 = fresh_tid(0); E(acc, cur, wr, wc, l2 & 15, l2 >> 4); }
        if (!has_next) break;
#pragma unroll
        for (int a = 0; a < 2; ++a)
#pragma unroll
            for (int b = 0; b < 2; ++b)
#pragma unroll
                for (int m = 0; m < 4; ++m)
#pragma unroll
                    for (int n = 0; n < 2; ++n) { const float zf = fresh_zero(); acc[a][b][m][n] = (f32x4){zf, zf, zf, zf}; }
        cur = nxt; cA = nA; cB = nB; ++ui;
        if constexpr (GA) { int R2[2], C2[2]; const int t2 = fresh_tid(wv); stage_rc(t2 * 16, R2[0], C2[0]); stage_rc(t2 * 16 + 8192, R2[1], C2[1]); S.aoff(cur, R2, C2, ca); }
    }
    PG8_WAIT_V(0);
    if (wr == 0) PG8_BAR;
    PG8_BAR;
#undef PG8_SA
#undef PG8_SB
#undef PG8_STAGE
#undef PG8_STAGE_A
#undef PG8_LDA
#undef PG8_LDB
#undef PG8_MMA
#undef PG8_LD32
#undef PG8_LOH
#undef PG8_HIH
#undef PG8_WAIT_V
#undef PG8_WAIT_L
#undef PG8_BAR
#undef PG8_SCHED
}
}

namespace da {
constexpr int KVBLK = 64;
constexpr float THR = 8.f;
constexpr int SHM_V = KVBLK * 128 * 2, SHM_K = KVBLK * 128 * 2, SHM_KR = KVBLK * 64 * 2;
constexpr int OFF_V = 0, OFF_K = 2 * SHM_V, OFF_WS = OFF_K + 2 * SHM_K, OFF_KR = OFF_WS + 8 * 64 * 4, OFF_QR = OFF_KR + 2 * SHM_KR, LDS_DENSE = OFF_QR + 8 * 4096;
#define KSWZ(row, colB) ((row) * 256 + ((colB) ^ (((row) & 7) << 4)))
#define KRSWZ(row, ch) ((row) * 128 + ((((ch) ^ ((row) >> 1)) & 7) << 4))
#define SBAR() __builtin_amdgcn_sched_barrier(0)
__device__ __forceinline__ int crow(int r, int hi) { return (r & 3) + 8 * (r >> 2) + 4 * hi; }
__device__ __forceinline__ int v_st(int k, int c) { const int kk = (k & ~0xC) | ((k & 4) << 1) | ((k & 8) >> 1); return ((kk >> 3) * 4 + (c >> 5)) * 512 + ((kk & 7) * 32 + (c & 31)) * 2; }
__device__ __forceinline__ int v_rd_base(int lane) { return ((lane & 3) << 3) | (((lane >> 2) & 3) << 6) | (((lane >> 4) & 1) << 5) | (((lane >> 5) & 1) << 8); }
constexpr int v_rd_off(int d0, int ks, int half) { return d0 * 512 + ks * 4096 + half * 2048; }
template <int OFF> __device__ __forceinline__ s16x4 tr_read(int vb) {
    s16x4 r; asm volatile("ds_read_b64_tr_b16 %0, %1 offset:%2" : "=&v"(r) : "v"(vb), "i"(OFF) : "memory"); return r;
}
template <int D0> __device__ __forceinline__ void pv_one(f32x16& od, int vb, bf16x8 pa0, bf16x8 pa1, bf16x8 pa2, bf16x8 pa3) {
    const s16x4 l0 = tr_read<v_rd_off(D0, 0, 0)>(vb), h0 = tr_read<v_rd_off(D0, 0, 1)>(vb), l1 = tr_read<v_rd_off(D0, 1, 0)>(vb), h1 = tr_read<v_rd_off(D0, 1, 1)>(vb);
    const s16x4 l2 = tr_read<v_rd_off(D0, 2, 0)>(vb), h2 = tr_read<v_rd_off(D0, 2, 1)>(vb), l3 = tr_read<v_rd_off(D0, 3, 0)>(vb), h3 = tr_read<v_rd_off(D0, 3, 1)>(vb);
    asm volatile("s_waitcnt lgkmcnt(0)" ::: "memory"); SBAR();
#define PK(L, H) (bf16x8){L[0], L[1], L[2], L[3], H[0], H[1], H[2], H[3]}
    od = __builtin_amdgcn_mfma_f32_32x32x16_bf16(pa0, PK(l0, h0), od, 0, 0, 0);
    od = __builtin_amdgcn_mfma_f32_32x32x16_bf16(pa1, PK(l1, h1), od, 0, 0, 0);
    od = __builtin_amdgcn_mfma_f32_32x32x16_bf16(pa2, PK(l2, h2), od, 0, 0, 0);
    od = __builtin_amdgcn_mfma_f32_32x32x16_bf16(pa3, PK(l3, h3), od, 0, 0, 0);
}
__device__ __forceinline__ void pv_d0(f32x16* o, int vb, bf16x8 pa0, bf16x8 pa1, bf16x8 pa2, bf16x8 pa3) {
    pv_one<0>(o[0], vb, pa0, pa1, pa2, pa3); pv_one<1>(o[1], vb, pa0, pa1, pa2, pa3); pv_one<2>(o[2], vb, pa0, pa1, pa2, pa3); pv_one<3>(o[3], vb, pa0, pa1, pa2, pa3);
}
template <int D0> __device__ __forceinline__ void pv_one32(f32x16& od, int vb, bf16x8 pa0, bf16x8 pa1) {
    const s16x4 l0 = tr_read<v_rd_off(D0, 0, 0)>(vb), h0 = tr_read<v_rd_off(D0, 0, 1)>(vb), l1 = tr_read<v_rd_off(D0, 1, 0)>(vb), h1 = tr_read<v_rd_off(D0, 1, 1)>(vb);
    asm volatile("s_waitcnt lgkmcnt(0)" ::: "memory"); SBAR();
    od = __builtin_amdgcn_mfma_f32_32x32x16_bf16(pa0, PK(l0, h0), od, 0, 0, 0);
    od = __builtin_amdgcn_mfma_f32_32x32x16_bf16(pa1, PK(l1, h1), od, 0, 0, 0);
}
#undef PK
#define PK4(P, BASE, OUT) do { unsigned a0 = cvtpk(P[BASE + 0], P[BASE + 1]), a1 = cvtpk(P[BASE + 2], P[BASE + 3]);   \
    unsigned b0 = cvtpk(P[BASE + 4], P[BASE + 5]), b1 = cvtpk(P[BASE + 6], P[BASE + 7]);                              \
    auto r0 = __builtin_amdgcn_permlane32_swap(a0, b0, false, false); auto r1 = __builtin_amdgcn_permlane32_swap(a1, b1, false, false); \
    u32x4 w = {r0[0], r1[0], r0[1], r1[1]}; OUT = *reinterpret_cast<bf16x8*>(&w); } while (0)

template <int NDQ> struct Cst { static constexpr float SCALE = (NDQ == 8) ? 0.088388347648318440f : 0.072168783648703220f; static constexpr float C = SCALE * LOG2E; };

template <int NDQ>
__device__ __forceinline__ void partialSM(f32x16& p0, f32x16& p1, float& m_reg, float& mn, float& alpha) {
    constexpr float C = Cst<NDQ>::C, SCALE = Cst<NDQ>::SCALE;
    float pmax = p0[0];
#pragma unroll
    for (int r = 1; r < 16; ++r) pmax = fmaxf(pmax, p0[r]);
#pragma unroll
    for (int r = 0; r < 16; ++r) pmax = fmaxf(pmax, p1[r]);
    { auto rr = __builtin_amdgcn_permlane32_swap(__float_as_uint(pmax), __float_as_uint(pmax), false, false);
      pmax = fmaxf(__uint_as_float(rr[0]), __uint_as_float(rr[1])); }
    if (__builtin_expect(__all(pmax - m_reg <= THR / SCALE), 1)) { mn = m_reg; alpha = 1.f; }
    else { mn = fmaxf(m_reg, pmax); alpha = __builtin_amdgcn_exp2f((m_reg - mn) * C); m_reg = mn; }
    const float mnC = -mn * C;
#pragma unroll
    for (int r = 0; r < 16; ++r) p0[r] = fmaf(p0[r], C, mnC);
#pragma unroll
    for (int r = 0; r < 16; ++r) p1[r] = fmaf(p1[r], C, mnC);
#pragma unroll
    for (int r = 0; r < 16; ++r) p0[r] = __builtin_amdgcn_exp2f(p0[r]);
}
__device__ __forceinline__ void finishSM(f32x16& p0, f32x16& p1, float alpha, float& l_reg, bf16x8& pa0, bf16x8& pa1, bf16x8& pa2, bf16x8& pa3) {
#pragma unroll
    for (int r = 0; r < 16; ++r) p1[r] = __builtin_amdgcn_exp2f(p1[r]);
    float ps = 0;
#pragma unroll
    for (int r = 0; r < 16; ++r) ps += p0[r];
#pragma unroll
    for (int r = 0; r < 16; ++r) ps += p1[r];
    { auto rr = __builtin_amdgcn_permlane32_swap(__float_as_uint(ps), __float_as_uint(ps), false, false);
      ps = __uint_as_float(rr[0]) + __uint_as_float(rr[1]); }
    l_reg = l_reg * alpha + ps;
    PK4(p0, 0, pa0); PK4(p0, 8, pa1); PK4(p1, 0, pa2); PK4(p1, 8, pa3);
}
template <int NDQ>
__device__ __forceinline__ void qkt(f32x16& p0, f32x16& p1, const char* Ks, const char* Krs, const bf16x8* qr, const char* qrl, int r32, int hi) {
    p0 = f32x16{}; p1 = f32x16{};
#pragma unroll
    for (int d0 = 0; d0 < 8; ++d0) { const int cb = (d0 * 16 + hi * 8) * 2;
        bf16x8 b0 = *reinterpret_cast<const bf16x8*>(Ks + KSWZ(r32, cb));
        bf16x8 b1 = *reinterpret_cast<const bf16x8*>(Ks + KSWZ(32 + r32, cb));
        p0 = __builtin_amdgcn_mfma_f32_32x32x16_bf16(b0, qr[d0], p0, 0, 0, 0);
        p1 = __builtin_amdgcn_mfma_f32_32x32x16_bf16(b1, qr[d0], p1, 0, 0, 0); }
    if constexpr (NDQ == 12) {
#pragma unroll
        for (int d0 = 0; d0 < 4; ++d0) { const int ch = d0 * 2 + hi;
            bf16x8 b0 = *reinterpret_cast<const bf16x8*>(Krs + KRSWZ(r32, ch));
            bf16x8 b1 = *reinterpret_cast<const bf16x8*>(Krs + KRSWZ(32 + r32, ch));
            const bf16x8 qf = *reinterpret_cast<const bf16x8*>(qrl + d0 * 1024);
            p0 = __builtin_amdgcn_mfma_f32_32x32x16_bf16(b0, qf, p0, 0, 0, 0);
            p1 = __builtin_amdgcn_mfma_f32_32x32x16_bf16(b1, qf, p1, 0, 0, 0); }
    }
}

struct DArgs { const bf16_t* Q; const bf16_t* K; const bf16_t* V; const bf16_t* Kr; bf16_t* O; int ldq, ldk, ldv, ldo; int seq; int pos0; };

template <int NDQ, int SDEPTH>
__device__ __forceinline__ void attn_dense_body(int wv, const DArgs a, char* lds) {
    const int tid = fresh_tid(wv), wid = tid >> 6, lane = tid & 63, r32 = lane & 31, hi = lane >> 5;
    char* V_lds = lds + OFF_V; char* K_lds = lds + OFF_K; char* Kr_lds = lds + OFF_KR;
    float* ws = (float*)(lds + OFF_WS) + wid * 64; float* li_l = ws; float* al_l = ws + 32;
    float m_reg = -1e30f, l_reg = 0; f32x16 o[4] = {}; bf16x8 qr[8];
    char* qrl = lds + OFF_QR + wid * 4096 + lane * 16;
    const bf16_t* Qw = a.Q + (long)(wid * 32 + r32) * a.ldq + hi * 8;
#pragma unroll
    for (int d0 = 0; d0 < 8; ++d0) qr[d0] = *reinterpret_cast<const bf16x8*>(Qw + d0 * 16);
    if constexpr (NDQ == 12) {
        const float pos = (float)(a.pos0 + wid * 32 + r32);
#pragma unroll
        for (int f = 0; f < 2; ++f) {
            const bf16x8 x1v = *reinterpret_cast<const bf16x8*>(Qw + (8 + f) * 16), x2v = *reinterpret_cast<const bf16x8*>(Qw + (10 + f) * 16); bf16x8 y1v, y2v;
#pragma unroll
            for (int j = 0; j < 8; ++j) { const int i = f * 16 + hi * 8 + j; float sn, cs; sincos_rev(pos * inv_freq32(i), sn, cs);
                const float x1 = bf2f((unsigned short)x1v[j]), x2 = bf2f((unsigned short)x2v[j]);
                y1v[j] = (short)f2bf(x1 * cs - x2 * sn); y2v[j] = (short)f2bf(x2 * cs + x1 * sn); }
            *reinterpret_cast<bf16x8*>(qrl + f * 1024) = y1v; *reinterpret_cast<bf16x8*>(qrl + (2 + f) * 1024) = y2v;
        }
    }
    const int sr = tid >> 4, sc = (tid & 15) * 8, vst0 = v_st(sr, sc), vst1 = v_st(32 + sr, sc);
    const int krr = tid >> 3, krc = tid & 7;
    const int vb0 = (int)(uintptr_t)V_lds + v_rd_base(lane);
    struct { bf16x8 vs0, vs1, ks0, ks1, kr; } sr_[SDEPTH];
#define SLOAD(i, k0) do { sr_[i].vs0 = *(const bf16x8*)(a.V + (long)((k0) + sr) * a.ldv + sc); sr_[i].vs1 = *(const bf16x8*)(a.V + (long)((k0) + 32 + sr) * a.ldv + sc); \
    sr_[i].ks0 = *(const bf16x8*)(a.K + (long)((k0) + sr) * a.ldk + sc); sr_[i].ks1 = *(const bf16x8*)(a.K + (long)((k0) + 32 + sr) * a.ldk + sc); \
    if constexpr (NDQ == 12) sr_[i].kr = *(const bf16x8*)(a.Kr + (long)((k0) + krr) * 64 + krc * 8); } while (0)
#define SWRITE(b, i) do { *(bf16x8*)(V_lds + (b) * SHM_V + vst0) = sr_[i].vs0; *(bf16x8*)(V_lds + (b) * SHM_V + vst1) = sr_[i].vs1; const int kc = sc * 2; \
    *(bf16x8*)(K_lds + (b) * SHM_K + KSWZ(sr, kc)) = sr_[i].ks0; *(bf16x8*)(K_lds + (b) * SHM_K + KSWZ(32 + sr, kc)) = sr_[i].ks1; \
    if constexpr (NDQ == 12) *(bf16x8*)(Kr_lds + (b) * SHM_KR + KRSWZ(krr, krc)) = sr_[i].kr; } while (0)
#define SWAIT() do { if constexpr (SDEPTH == 2) { if constexpr (NDQ == 12) asm volatile("s_waitcnt vmcnt(5)" ::: "memory"); else asm volatile("s_waitcnt vmcnt(4)" ::: "memory"); } else asm volatile("s_waitcnt vmcnt(0)" ::: "memory"); } while (0)
#define RESC(al) do { if (__any((al) < 1.f)) { if (hi == 0) al_l[r32] = (al); asm volatile("s_waitcnt lgkmcnt(0)" ::: "memory"); \
    _Pragma("unroll") for (int d = 0; d < 4; ++d) _Pragma("unroll") for (int r = 0; r < 16; ++r) o[d][r] *= al_l[crow(r, hi)]; } } while (0)
    f32x16 pA0, pA1, pB0, pB1; float mnA, mnB, alA, alB; bf16x8 pa0, pa1, pa2, pa3; const int NT = a.seq / KVBLK;
    constexpr int SE = 0, SO = SDEPTH - 1;
    SLOAD(SE, 0); asm volatile("s_waitcnt vmcnt(0)" ::: "memory"); SWRITE(0, SE); __syncthreads();
    qkt<NDQ>(pA0, pA1, K_lds, Kr_lds, qr, qrl, r32, hi); partialSM<NDQ>(pA0, pA1, m_reg, mnA, alA);
    SLOAD(SO, KVBLK); if constexpr (SDEPTH == 2) { if (2 < NT) SLOAD(SE, 2 * KVBLK); }
    SWAIT(); SWRITE(1, SO); __syncthreads();
#pragma unroll 1
    for (int j = 1; j + 1 < NT; j += 2) {
        SBAR(); qkt<NDQ>(pB0, pB1, K_lds + SHM_K, Kr_lds + SHM_KR, qr, qrl, r32, hi);
        finishSM(pA0, pA1, alA, l_reg, pa0, pa1, pa2, pa3); SBAR();
        SLOAD(SO, (j + SDEPTH) * KVBLK); SBAR();
        pv_d0(o, vb0, pa0, pa1, pa2, pa3); partialSM<NDQ>(pB0, pB1, m_reg, mnB, alB);
        __syncthreads(); SWAIT(); SWRITE(0, SE);
        RESC(alB); __syncthreads();
        SBAR(); qkt<NDQ>(pA0, pA1, K_lds, Kr_lds, qr, qrl, r32, hi);
        finishSM(pB0, pB1, alB, l_reg, pa0, pa1, pa2, pa3); SBAR();
        if (SDEPTH == 1 || j + 3 < NT) SLOAD(SE, (j + 1 + SDEPTH) * KVBLK); SBAR();
        pv_d0(o, vb0 + (int)SHM_V, pa0, pa1, pa2, pa3); partialSM<NDQ>(pA0, pA1, m_reg, mnA, alA);
        __syncthreads(); SWAIT(); SWRITE(1, SO);
        RESC(alA); __syncthreads();
    }
    SBAR(); qkt<NDQ>(pB0, pB1, K_lds + SHM_K, Kr_lds + SHM_KR, qr, qrl, r32, hi);
    finishSM(pA0, pA1, alA, l_reg, pa0, pa1, pa2, pa3); SBAR();
    pv_d0(o, vb0, pa0, pa1, pa2, pa3); partialSM<NDQ>(pB0, pB1, m_reg, mnB, alB);
    __syncthreads(); RESC(alB);
    finishSM(pB0, pB1, alB, l_reg, pa0, pa1, pa2, pa3); SBAR();
    pv_d0(o, vb0 + (int)SHM_V, pa0, pa1, pa2, pa3);
    if (hi == 0) li_l[r32] = l_reg; asm volatile("s_waitcnt lgkmcnt(0)" ::: "memory");
    float rli[16];
#pragma unroll
    for (int r = 0; r < 16; ++r) rli[r] = __builtin_amdgcn_rcpf(li_l[crow(r, hi)]);
    bf16_t* Ow = F8_OUT ? (bf16_t*)((unsigned char*)a.O + (long)(wid * 32) * a.ldo) : a.O + (long)(wid * 32) * a.ldo;
#pragma unroll
    for (int r = 0; r < 16; ++r) { const int orow = crow(r, hi);
#pragma unroll
        for (int d0 = 0; d0 < 4; ++d0) { if constexpr (F8_OUT) ((unsigned char*)Ow)[(long)orow * a.ldo + d0 * 32 + r32] = f2fp8(o[d0][r] * rli[r] * O8_SCALE); else Ow[(long)orow * a.ldo + d0 * 32 + r32] = f2bf(o[d0][r] * rli[r]); } }
#undef SLOAD
#undef SWRITE
#undef SWAIT
#undef RESC
}

constexpr int SP_WAVE_LDS = 18688;
template <class P>
__device__ __forceinline__ void sparse_wave(P& pol, LAS unsigned char* wll, int lane) {
    const int r32 = lane & 31, hi = lane >> 5;
    char* wl = (char*)wll;
    char* Kl = wl; char* Vl = wl + 8192; float* li_l = (float*)(wl + 16384); float* al_l = li_l + 32;
    bf16x8 qr[8];
    { const bf16_t* qp = pol.qptr(r32) + hi * 8;
#pragma unroll
      for (int d0 = 0; d0 < 8; ++d0) qr[d0] = *reinterpret_cast<const bf16x8*>(qp + d0 * 16); }
    asm volatile("s_waitcnt vmcnt(0)" ::: "memory");
    f32x16 o[4] = {}; float m_reg = -1e30f, l_reg = 0.f;
    const int krow0 = lane >> 4;
    const int kce = (((lane & 15) ^ (krow0 & 7)) * 8), kco = (((lane & 15) ^ ((4 + krow0) & 7)) * 8);
    const int vk0 = 8 * ((lane >> 4) & 1) + ((lane >> 2) & 3), vc0 = 32 * (lane >> 5) + 8 * (lane & 3);
    const int vb = (int)(uintptr_t)Vl + v_rd_base(lane);
    const int nt = pol.ntiles();
    typename P::TI ti, tn;
#define SP_DMA_K(T) do { _Pragma("unroll") for (int i = 0; i < 8; ++i) { const bf16_t* src = (T).k + (long)(4 * i + krow0) * (T).rs + ((i & 1) ? kco : kce); \
        __builtin_amdgcn_global_load_lds((const unsigned*)src, (LAS unsigned*)(wll + i * 1024), 16, 0, 0); } } while (0)
#define SP_DMA_V(T) do { _Pragma("unroll") for (int i = 0; i < 8; ++i) { const bf16_t* src = (T).v + (long)(16 * (i >> 2) + 4 * ((i >> 1) & 1) + vk0) * (T).rs + 64 * (i & 1) + vc0; \
        __builtin_amdgcn_global_load_lds((const unsigned*)src, (LAS unsigned*)(wll + 8192 + i * 1024), 16, 0, 0); } } while (0)
    pol.tile(0, ti);
    SP_DMA_K(ti); SP_DMA_V(ti);
#pragma unroll 1
    for (int j = 0; j < nt; ++j) {
        const bool more = (j + 1 < nt);
        if (more) pol.tile(j + 1, tn);
        asm volatile("s_waitcnt vmcnt(8)" ::: "memory");
        f32x16 p = f32x16{};
#pragma unroll
        for (int d0 = 0; d0 < 8; ++d0) { const int cb = (d0 * 16 + hi * 8) * 2;
            bf16x8 b0 = *reinterpret_cast<const bf16x8*>(Kl + KSWZ(r32, cb));
            p = __builtin_amdgcn_mfma_f32_32x32x16_bf16(b0, qr[d0], p, 0, 0, 0); }
        asm volatile("s_waitcnt lgkmcnt(0)" ::: "memory"); SBAR();
        if (more) SP_DMA_K(tn);
        SBAR();
        float pmax = -INFINITY;
#pragma unroll
        for (int r = 0; r < 16; ++r) { p[r] = pol.adj(ti, crow(r, hi), p[r]); pmax = fmaxf(pmax, p[r]); }
        { auto rr = __builtin_amdgcn_permlane32_swap(__float_as_uint(pmax), __float_as_uint(pmax), false, false);
          pmax = fmaxf(__uint_as_float(rr[0]), __uint_as_float(rr[1])); }
        const float mn = fmaxf(m_reg, pmax); const float alpha = __builtin_amdgcn_exp2f(m_reg - mn); m_reg = mn;
        float ps = 0.f;
#pragma unroll
        for (int r = 0; r < 16; ++r) { p[r] = __builtin_amdgcn_exp2f(p[r] - mn); ps += p[r]; }
        { auto rr = __builtin_amdgcn_permlane32_swap(__float_as_uint(ps), __float_as_uint(ps), false, false);
          ps = __uint_as_float(rr[0]) + __uint_as_float(rr[1]); }
        l_reg = l_reg * alpha + ps;
        if (__any(alpha < 1.f)) { if (hi == 0) al_l[r32] = alpha; asm volatile("s_waitcnt lgkmcnt(0)" ::: "memory");
#pragma unroll
            for (int d = 0; d < 4; ++d)
#pragma unroll
                for (int r = 0; r < 16; ++r) o[d][r] *= al_l[crow(r, hi)]; }
        bf16x8 pa0, pa1; PK4(p, 0, pa0); PK4(p, 8, pa1);
        SBAR();
        if (more) asm volatile("s_waitcnt vmcnt(8)" ::: "memory"); else asm volatile("s_waitcnt vmcnt(0)" ::: "memory");
        SBAR();
        pv_one32<0>(o[0], vb, pa0, pa1); pv_one32<1>(o[1], vb, pa0, pa1); pv_one32<2>(o[2], vb, pa0, pa1); pv_one32<3>(o[3], vb, pa0, pa1);
        SBAR();
        if (more) SP_DMA_V(tn);
        SBAR();
        ti = tn;
    }
#undef SP_DMA_K
#undef SP_DMA_V
    if (hi == 0) li_l[r32] = l_reg; asm volatile("s_waitcnt lgkmcnt(0)" ::: "memory");
#pragma unroll
    for (int r = 0; r < 16; ++r) { const int qn = crow(r, hi); const float rl = __builtin_amdgcn_rcpf(li_l[qn]); bf16_t* op = pol.optr(qn);
#pragma unroll
        for (int d0 = 0; d0 < 4; ++d0) { if constexpr (F8_OUT) ((unsigned char*)op)[d0 * 32 + r32] = f2fp8(o[d0][r] * rl * O8_SCALE); else op[d0 * 32 + r32] = f2bf(o[d0][r] * rl); } }
}
#undef PK4
}

struct PolB {
    struct TI { const bf16_t* k; const bf16_t* v; long rs; int kpos0; int iq; float cd; };
    const bf16_t* H0; bf16_t* O; int b, h, a, r16, myn; int lo3, n3, lo2, n2, lo1, n1; float slope2;
    __device__ __forceinline__ void init(const bf16_t* H0_, bf16_t* O_, int w, int lane) {
        H0 = H0_; O = O_; b = w >> 10; h = (w >> 7) & 7; const int wu = w & 127; a = wu >> 4; r16 = wu & 15; myn = lane & 31;
        lo3 = max(a - 2, 0); n3 = min(a + 2, 7) - lo3 + 1;
        lo2 = max(4 * a - 2, 0); n2 = min(4 * a + 5, 31) - lo2 + 1;
        lo1 = max(16 * a - 2, 0); n1 = min(16 * a + 17, 127) - lo1 + 1;
        slope2 = __builtin_amdgcn_exp2f(-(float)(h + 1)) * LOG2E;
    }
    __device__ __forceinline__ const bf16_t* qptr(int n) const { return H0 + (long)(b * SEQ + 512 * a + r16 + 16 * n) * IN0 + 1536 + h * 128; }
    __device__ __forceinline__ bf16_t* optr(int qn) const { const long e = (long)(b * SEQ + 512 * a + r16 + 16 * qn) * DM + 1024 + h * 128; return F8_OUT ? (bf16_t*)((unsigned char*)O + e) : O + e; }
    __device__ __forceinline__ int ntiles() const { return n3 + n2 + n1; }
    __device__ __forceinline__ void tile(int j, TI& ti) const {
        int dil, kt, rd;
        if (j < n3) { dil = 16; kt = lo3 + j; rd = r16; }
        else if (j < n3 + n2) { dil = 4; kt = lo2 + (j - n3); rd = r16 & 3; }
        else { dil = 1; kt = lo1 + (j - n3 - n2); rd = 0; }
        const long tok = (long)b * SEQ + dil * 32 * kt + rd;
        ti.k = H0 + tok * IN0 + 2560 + h * 128; ti.v = H0 + tok * IN0 + 3584 + h * 128; ti.rs = (long)dil * IN0;
        ti.kpos0 = 32 * kt; ti.iq = (512 * a + r16 + 16 * myn - rd) / dil; ti.cd = slope2 * (float)dil;
    }
    __device__ __forceinline__ float adj(const TI& ti, int kloc, float s) const {
        const int d = ti.kpos0 + kloc - ti.iq; const int ad = d < 0 ? -d : d;
        return ad <= 64 ? fmaf(s, 0.088388347648318440f * LOG2E, -ti.cd * (float)ad) : -INFINITY;
    }
};
struct PolC {
    struct TI { const bf16_t* k; const bf16_t* v; long rs; int kc0; int drow; };
    const bf16_t* H1; bf16_t* O; const float* tab; int b, h, r, a, r0, qc, c0;
    __device__ __forceinline__ void init(const bf16_t* H1_, bf16_t* O_, const float* rpb, float* tab_, int w, int lane) {
        H1 = H1_; O = O_; tab = tab_; b = w >> 10; h = (w >> 7) & 7; const int wu = w & 127; r = wu >> 1; a = wu & 1;
        r0 = min(max(r - 4, 0), 56); qc = 32 * a + (lane & 31); c0 = min(max(qc - 8, 0), 48);
        for (int idx = lane; idx < 480; idx += 64) { const int dr = idx >> 5, dc = idx & 31; tab_[idx] = dc < 31 ? rpb[h * 465 + dr * 31 + dc] * LOG2E : 0.f; }
        asm volatile("s_waitcnt vmcnt(0) lgkmcnt(0)" ::: "memory");
    }
    __device__ __forceinline__ const bf16_t* qptr(int n) const { return H1 + (long)(b * SEQ + 64 * r + 32 * a + n) * IN1P + h * 128; }
    __device__ __forceinline__ bf16_t* optr(int qn) const { const long e = (long)(b * SEQ + 64 * r + 32 * a + qn) * DM + h * 128; return F8_OUT ? (bf16_t*)((unsigned char*)O + e) : O + e; }
    __device__ __forceinline__ int ntiles() const { return 16; }
    __device__ __forceinline__ void tile(int j, TI& ti) const {
        const int kr = r0 + (j >> 1), ch = j & 1; const long tok = (long)b * SEQ + 64 * kr + 32 * ch;
        ti.k = H1 + tok * IN1P + 1024 + h * 128; ti.v = H1 + tok * IN1P + 2048 + h * 128; ti.rs = IN1P; ti.kc0 = 32 * ch; ti.drow = kr - r + 7;
    }
    __device__ __forceinline__ float adj(const TI& ti, int kloc, float s) const {
        const int kc = ti.kc0 + kloc; const int dc = min(max(kc - qc + 15, 0), 30);
        const float bias = tab[ti.drow * 32 + dc];
        return (kc >= c0 && kc < c0 + 16) ? fmaf(s, 0.088388347648318440f * LOG2E, bias) : -INFINITY;
    }
};

struct Params { const float* in[28]; float* out; unsigned char* ws; int ph_lo, ph_hi; };
enum { I_X = 0, I_RW = 1, I_RB = 2, I_WIN0 = 3, I_AQN = 4, I_AKN = 5, I_WOUT0 = 6, I_LN1G0 = 7, I_LN1B0 = 8, I_WG0 = 9, I_WU0 = 10, I_WD0 = 11, I_LN2G0 = 12, I_LN2B0 = 13,
       I_WIN1 = 14, I_RPB = 15, I_DQN = 16, I_WQUP = 17, I_DKVN = 18, I_WKVUP = 19, I_WOUT1 = 20, I_LN1G1 = 21, I_LN1B1 = 22, I_WG1 = 23, I_WU1 = 24, I_WD1 = 25, I_LN2G1 = 26, I_LN2B1 = 27 };

__device__ __forceinline__ void tr_tile(const float* __restrict__ src, int N, const float* __restrict__ ksc, bf16_t* __restrict__ dst, int ldd, int k0, int n0, int drow0, LAS unsigned* tl, int tid) {
    const int c4 = (tid & 15) * 4;
#pragma unroll
    for (int i = 0; i < 2; ++i) {
        const int kp = (tid >> 4) + 32 * i;
        const float* s0 = src + (size_t)(k0 + 2 * kp) * N + n0 + c4;
        f32x4 a = *(const f32x4*)s0, b = *(const f32x4*)(s0 + N);
        if (ksc) { const float sa = ksc[k0 + 2 * kp], sb = ksc[k0 + 2 * kp + 1]; a *= sa; b *= sb; }
#pragma unroll
        for (int j = 0; j < 4; ++j) tl[(c4 + j) * 65 + kp] = cvtpk(a[j], b[j]);
    }
    __syncthreads();
    const int n = tid >> 3, seg = tid & 7;
    unsigned w[8];
#pragma unroll
    for (int q = 0; q < 8; ++q) w[q] = tl[n * 65 + seg * 8 + q];
    u32x4* d = (u32x4*)(dst + (size_t)(drow0 + n) * ldd + k0 + seg * 16);
    d[0] = (u32x4){w[0], w[1], w[2], w[3]}; d[1] = (u32x4){w[4], w[5], w[6], w[7]};
    __syncthreads();
}
__device__ __forceinline__ void tr_tile8(const float* __restrict__ src, int N, const float* __restrict__ ksc, float wscale, unsigned char* __restrict__ dst, int ldd, int k0, int n0, int drow0, LAS unsigned* tl, int tid) {
    const int c4 = (tid & 15) * 4, kq = tid >> 4;
    const float* s0 = src + (size_t)(k0 + 4 * kq) * N + n0 + c4;
    f32x4 a = *(const f32x4*)s0, b = *(const f32x4*)(s0 + N), c = *(const f32x4*)(s0 + 2 * (size_t)N), d = *(const f32x4*)(s0 + 3 * (size_t)N);
    float sa = wscale, sb = wscale, sc = wscale, sd = wscale;
    if (ksc) { sa *= ksc[k0 + 4 * kq]; sb *= ksc[k0 + 4 * kq + 1]; sc *= ksc[k0 + 4 * kq + 2]; sd *= ksc[k0 + 4 * kq + 3]; }
#pragma unroll
    for (int j = 0; j < 4; ++j) tl[(c4 + j) * 33 + kq] = pk4_fp8(a[j] * sa, b[j] * sb, c[j] * sc, d[j] * sd);
    __syncthreads();
    const int n = tid >> 3, seg = tid & 7;
    unsigned w[4];
#pragma unroll
    for (int q = 0; q < 4; ++q) w[q] = tl[n * 33 + seg * 4 + q];
    *(u32x4*)(dst + (size_t)(drow0 + n) * ldd + k0 + seg * 16) = (u32x4){w[0], w[1], w[2], w[3]};
    __syncthreads();
}
struct TJob { const float* src; bf16_t* dst; const float* ksc; int K, N, ldd, gu; size_t sbs, dbs; int f8; };
constexpr float W8_SCALE = 64.f;
constexpr int W8_SBYTE = 0x79797979;
__device__ __forceinline__ void run_tjob(const TJob& jb, int t, LAS unsigned* tl, int tid) {
    const int ntn = jb.N / 64, ntk = jb.K / 128, per = ntn * ntk;
    const int bi = t / per, r = t % per, tk = r / ntn, tn = r % ntn;
    const int n0 = tn * 64;
    const int drow0 = jb.gu ? (256 * (n0 >> 7) + (jb.gu == 2 ? 128 : 0) + (n0 & 127)) : n0;
    if (jb.f8) tr_tile8(jb.src + (size_t)bi * jb.sbs, jb.N, jb.ksc, W8_SCALE, (unsigned char*)jb.dst + (size_t)bi * jb.dbs, jb.ldd, tk * 128, n0, drow0, tl, tid);
    else tr_tile(jb.src + (size_t)bi * jb.sbs, jb.N, jb.ksc, jb.dst + (size_t)bi * jb.dbs, jb.ldd, tk * 128, n0, drow0, tl, tid);
}
typedef __attribute__((address_space(4))) const unsigned long long kcu64_t;
#define PIN(i) ((const float*)(__attribute__((address_space(1))) const float*)ka[i])
__device__ __forceinline__ void phase_prologue(kcu64_t* ka, unsigned char* ws, LAS unsigned char* lds, int G, int bid, int tid) {
    LAS unsigned* tl = (LAS unsigned*)lds;
    constexpr int NJ = 12;
    const int cnts[NJ] = {16 * 72, 16 * 32, 4096, 4096, 4096, 16 * 61, 16 * 32, 4096, 4096, 4096, 4 * 24, 2 * 32};
    int total = 0;
#pragma unroll
    for (int j = 0; j < NJ; ++j) total += cnts[j];
    for (int t = bid; t < total; t += G) {
        int j = 0, base = 0;
#pragma unroll
        for (int q = 0; q < NJ - 1; ++q) if (t >= base + cnts[q] && j == q) { base += cnts[q]; j = q + 1; }
        const int tt = t - base;
        TJob jb;
        switch (j) {
            case 0: jb = TJob{PIN(I_WIN0), (bf16_t*)(ws + WS_WIN0), nullptr, 2048, IN0, 2048, 0, 0, 0, F8_IN}; break;
            case 1: jb = TJob{PIN(I_WOUT0), (bf16_t*)(ws + WS_WOUT0), nullptr, 2048, 2048, 2048, 0, 0, 0, F8_OUT}; break;
            case 2: jb = TJob{PIN(I_WG0), (bf16_t*)(ws + WS_WGU0), nullptr, 2048, 512, 2048, 1, (size_t)2048 * 512, (size_t)1024 * 2048, F8_GU}; break;
            case 3: jb = TJob{PIN(I_WU0), (bf16_t*)(ws + WS_WGU0), nullptr, 2048, 512, 2048, 2, (size_t)2048 * 512, (size_t)1024 * 2048, F8_GU}; break;
            case 4: jb = TJob{PIN(I_WD0), (bf16_t*)(ws + WS_WD0), nullptr, 512, 2048, 512, 0, (size_t)512 * 2048, (size_t)2048 * 512, F8_DOWN}; break;
            case 5: jb = TJob{PIN(I_WIN1), (bf16_t*)(ws + WS_WIN1), nullptr, 2048, IN1, 2048, 0, 0, 0, F8_IN}; break;
            case 6: jb = TJob{PIN(I_WOUT1), (bf16_t*)(ws + WS_WOUT1), nullptr, 2048, 2048, 2048, 0, 0, 0, F8_OUT}; break;
            case 7: jb = TJob{PIN(I_WG1), (bf16_t*)(ws + WS_WGU1), nullptr, 2048, 512, 2048, 1, (size_t)2048 * 512, (size_t)1024 * 2048, F8_GU}; break;
            case 8: jb = TJob{PIN(I_WU1), (bf16_t*)(ws + WS_WGU1), nullptr, 2048, 512, 2048, 2, (size_t)2048 * 512, (size_t)1024 * 2048, F8_GU}; break;
            case 9: jb = TJob{PIN(I_WD1), (bf16_t*)(ws + WS_WD1), nullptr, 512, 2048, 512, 0, (size_t)512 * 2048, (size_t)2048 * 512, F8_DOWN}; break;
            case 10: jb = TJob{PIN(I_WQUP), (bf16_t*)(ws + WS_WQUP), PIN(I_DQN), 512, 1536, 512, 0, 0, 0, 0}; break;
            default: jb = TJob{PIN(I_WKVUP), (bf16_t*)(ws + WS_WKVUP), PIN(I_DKVN), 256, 2048, 256, 0, 0, 0, 0}; break;
        }
        run_tjob(jb, tt, tl, tid);
    }
    { constexpr size_t ESZ = F8_IN ? 1 : 2;
      u32x4* z = (u32x4*)(ws + WS_WIN1 + (size_t)IN1 * 2048 * ESZ); const size_t n16 = (size_t)(IN1P - IN1) * 2048 * ESZ / 16;
      const unsigned zu = __float_as_uint(fresh_zero());
      for (size_t i = (size_t)bid * NTHR + tid; i < n16; i += (size_t)G * NTHR) z[i] = (u32x4){zu, zu, zu, zu}; }
    { const f32x8* xs = (const f32x8*)PIN(I_X); const size_t n8 = (size_t)T_ * DM / 8;
      if constexpr (F8_IN) { u32x2* xd = (u32x2*)(ws + WS_RC + 64 * MiB);
          for (size_t i = (size_t)bid * NTHR + tid; i < n8; i += (size_t)G * NTHR) { const f32x8 v = xs[i]; xd[i] = (u32x2){pk4_fp8(v[0], v[1], v[2], v[3]), pk4_fp8(v[4], v[5], v[6], v[7])}; } }
      else { u32x4* xd = (u32x4*)(ws + WS_RA);
          for (size_t i = (size_t)bid * NTHR + tid; i < n8; i += (size_t)G * NTHR) { const f32x8 v = xs[i];
              xd[i] = (u32x4){cvtpk(v[0], v[1]), cvtpk(v[2], v[3]), cvtpk(v[4], v[5]), cvtpk(v[6], v[7])}; } } }
}

__device__ __forceinline__ void phase_prep_qk(bf16_t* H0, const float* qn, const float* kn, int G, int bid, int tid) {
    const int wid = tid >> 6, lane = tid & 63, i = lane & 31, half = lane >> 5;
    const float invf = inv_freq32(i);
    const int e0 = 64 * half + i, e1 = e0 + 32;
    const float gq0 = qn[e0], gq1 = qn[e1], gk0 = kn[e0], gk1 = kn[e1];
    for (int m = bid * 8 + wid; m < T_; m += G * 8) {
        const int s = m & (SEQ - 1); const int pos = half ? (s & 63) : (s >> 6);
        float sn, cs; sincos_rev((float)pos * invf, sn, cs);
        bf16_t* rowp = H0 + (size_t)m * IN0;
#pragma unroll
        for (int hh = 0; hh < 10; ++hh) {
            bf16_t* base = rowp + (hh < 8 ? hh * 128 : 1024 + (hh - 8) * 128);
            const float x0 = bf2f(base[e0]), x1 = bf2f(base[e1]);
            const float ss = wave_sum(x0 * x0 + x1 * x1);
            const float r = rsqrtf(ss * (1.0f / 128.0f) + 1e-6f);
            const float y0 = x0 * r * (hh < 8 ? gq0 : gk0), y1 = x1 * r * (hh < 8 ? gq1 : gk1);
            base[e0] = f2bf(y0 * cs - y1 * sn); base[e1] = f2bf(y1 * cs + y0 * sn);
        }
    }
}
__device__ __forceinline__ void phase_prep_mla(bf16_t* H1, bf16_t* krope, int G, int bid, int tid) {
    const int wid = tid >> 6, lane = tid & 63;
    const float invf = inv_freq32(lane & 31);
    for (int m = bid * 8 + wid; m < T_; m += G * 8) {
        bf16_t* rowp = H1 + (size_t)m * IN1P;
        const u32x4 a = *(const u32x4*)(rowp + 3072 + lane * 8);
        float ss = bflo(a.x) * bflo(a.x) + bfhi(a.x) * bfhi(a.x) + bflo(a.y) * bflo(a.y) + bfhi(a.y) * bfhi(a.y) + bflo(a.z) * bflo(a.z) + bfhi(a.z) * bfhi(a.z) + bflo(a.w) * bflo(a.w) + bfhi(a.w) * bfhi(a.w);
        ss = wave_sum(ss);
        const u32x2 c = *(const u32x2*)(rowp + 3584 + lane * 4);
        float s2 = bflo(c.x) * bflo(c.x) + bfhi(c.x) * bfhi(c.x) + bflo(c.y) * bflo(c.y) + bfhi(c.y) * bfhi(c.y);
        s2 = wave_sum(s2);
        const float rq = rsqrtf(ss * (1.0f / 512.0f) + 1e-6f), rkv = rsqrtf(s2 * (1.0f / 256.0f) + 1e-6f);
        *(u32x4*)(rowp + 3072 + lane * 8) = (u32x4){cvtpk(bflo(a.x) * rq, bfhi(a.x) * rq), cvtpk(bflo(a.y) * rq, bfhi(a.y) * rq), cvtpk(bflo(a.z) * rq, bfhi(a.z) * rq), cvtpk(bflo(a.w) * rq, bfhi(a.w) * rq)};
        *(u32x2*)(rowp + 3584 + lane * 4) = (u32x2){cvtpk(bflo(c.x) * rkv, bfhi(c.x) * rkv), cvtpk(bflo(c.y) * rkv, bfhi(c.y) * rkv)};
        if (lane < 32) { const float x1 = bf2f(rowp[3840 + lane]), x2 = bf2f(rowp[3840 + 32 + lane]);
            float sn, cs; sincos_rev((float)(m & (SEQ - 1)) * invf, sn, cs);
            krope[(size_t)m * 64 + lane] = f2bf(x1 * cs - x2 * sn); krope[(size_t)m * 64 + 32 + lane] = f2bf(x2 * cs + x1 * sn); }
    }
}

constexpr int LNR_PITCH = 2052;
constexpr int LNR_PART = 131584, LNR_SC = 147968, LNR_SEL = 150016, LNR_BLE = 152064, LNR_HIST = 153088;
__device__ __forceinline__ void phase_ln_router(const float* z, const float* g, const float* bb, const float* rw, const float* rb, bf16_t* x1b, unsigned char* x1q,
                                                int* tok_e, int* tok_p, float* tok_g, int* list, unsigned* cnt, LAS unsigned char* lds, int G, int bid, int tid, bool commit = true) {
    const int wid = tid >> 6, lane = tid & 63;
    LAS float* xs = (LAS float*)lds; LAS float* part = (LAS float*)(lds + LNR_PART); LAS float* scs = (LAS float*)(lds + LNR_SC); LAS float* sels = (LAS float*)(lds + LNR_SEL);
    LAS int* ble = (LAS int*)(lds + LNR_BLE); LAS int* hist = (LAS int*)(lds + LNR_HIST);
    f16x8 bw[8][2];
    { const float* rwp = rw + (size_t)(256 * wid + 8 * (lane >> 4)) * 32 + (lane & 15);
#pragma unroll
      for (int ks = 0; ks < 8; ++ks)
#pragma unroll
        for (int hf = 0; hf < 2; ++hf)
#pragma unroll
          for (int j = 0; j < 8; ++j) bw[ks][hf][j] = (_Float16)rwp[(32 * ks + j) * 32 + 16 * hf]; }
    f32x4 v[2][8];
#define LNR_LOAD(tix_, rr) do { const float* zp = z + ((size_t)(tix_) * 16 + 2 * wid + (rr)) * DM + 4 * lane; \
        _Pragma("unroll") for (int i = 0; i < 8; ++i) v[rr][i] = *(const f32x4*)(zp + 256 * i); } while (0)
    const int ntile = T_ / 16;
    int ntl = 0;
    if (bid < ntile) { LNR_LOAD(bid, 0); LNR_LOAD(bid, 1); }
    for (int it = 0; bid + G * it < ntile; ++it) {
        const int tix = bid + G * it;
#pragma unroll
        for (int rr = 0; rr < 2; ++rr) {
            const int row = 2 * wid + rr; const size_t m = (size_t)tix * 16 + row;
            float s = 0.f;
#pragma unroll
            for (int i = 0; i < 8; ++i) s += (v[rr][i][0] + v[rr][i][1]) + (v[rr][i][2] + v[rr][i][3]);
            const float mean = wave_sum(s) * (1.0f / DM); float q = 0.f;
#pragma unroll
            for (int i = 0; i < 8; ++i) { const f32x4 d = v[rr][i] - mean; q += (d[0] * d[0] + d[1] * d[1]) + (d[2] * d[2] + d[3] * d[3]); }
            const float rstd = rsqrtf(wave_sum(q) * (1.0f / DM) + 1e-5f);
#pragma unroll
            for (int i = 0; i < 8; ++i) { const int col = 4 * lane + 256 * i; const f32x4 gv = *(const f32x4*)(g + col), bv = *(const f32x4*)(bb + col);
                const f32x4 y = (v[rr][i] - mean) * rstd * gv + bv;
                LAS f32x2* xp = (LAS f32x2*)(xs + row * LNR_PITCH + col); xp[0] = (f32x2){y[0], y[1]}; xp[1] = (f32x2){y[2], y[3]};
                *(u32x2*)(x1b + m * DM + col) = (u32x2){cvtpk(y[0], y[1]), cvtpk(y[2], y[3])};
                if constexpr (F8_GU) *(unsigned*)(x1q + m * DM + col) = pk4_fp8(y[0], y[1], y[2], y[3]);
                if (i & 1) asm volatile("" ::: "memory"); }
        }
        __builtin_amdgcn_sched_barrier(0);
        if (tix + G < ntile) LNR_LOAD(tix + G, 0);
        __builtin_amdgcn_sched_barrier(0);
        __syncthreads();
        { f32x4 acc0 = {0.f, 0.f, 0.f, 0.f}, acc1 = {0.f, 0.f, 0.f, 0.f}; const LAS float* xa = xs + (lane & 15) * LNR_PITCH + 256 * wid + 8 * (lane >> 4); const int e = lane & 15;
#pragma unroll
          for (int ks = 0; ks < 8; ++ks) { const f32x4 xa0 = *(const LAS f32x4*)(xa + 32 * ks), xa1 = *(const LAS f32x4*)(xa + 32 * ks + 4);
              const float xv[8] = {xa0[0], xa0[1], xa0[2], xa0[3], xa1[0], xa1[1], xa1[2], xa1[3]}; f16x8 ah, al;
#pragma unroll
              for (int j = 0; j < 8; ++j) { const _Float16 hh = (_Float16)xv[j]; ah[j] = hh; al[j] = (_Float16)(xv[j] - (float)hh); }
              acc0 = __builtin_amdgcn_mfma_f32_16x16x32_f16(ah, bw[ks][0], acc0, 0, 0, 0); acc1 = __builtin_amdgcn_mfma_f32_16x16x32_f16(ah, bw[ks][1], acc1, 0, 0, 0);
              acc0 = __builtin_amdgcn_mfma_f32_16x16x32_f16(al, bw[ks][0], acc0, 0, 0, 0); acc1 = __builtin_amdgcn_mfma_f32_16x16x32_f16(al, bw[ks][1], acc1, 0, 0, 0); }
          __builtin_amdgcn_sched_barrier(0);
          if (tix + G < ntile) LNR_LOAD(tix + G, 1);
          __builtin_amdgcn_sched_barrier(0);
#pragma unroll
          for (int r = 0; r < 4; ++r) { const int row = (lane >> 4) * 4 + r; part[(wid * 16 + row) * 32 + e] = acc0[r]; part[(wid * 16 + row) * 32 + 16 + e] = acc1[r]; } }
        __syncthreads();
        { const int row = tid >> 5, e = tid & 31; float lg = 0.f;
#pragma unroll
          for (int w = 0; w < 8; ++w) lg += part[(w * 16 + row) * 32 + e];
          const float sc = 1.0f / (1.0f + __expf(-lg)); scs[row * 32 + e] = sc; sels[row * 32 + e] = sc + rb[e]; }
        __syncthreads();
        if (tid < 16) { const int row = tid; float best = -INFINITY; int bg = 0;
            for (int gI = 0; gI < 8; ++gI) { const float a = sels[row * 32 + 4 * gI], b = sels[row * 32 + 4 * gI + 1], c = sels[row * 32 + 4 * gI + 2], d = sels[row * 32 + 4 * gI + 3];
                const float h1 = fmaxf(a, b), l1 = fminf(a, b), h2 = fmaxf(c, d), l2 = fminf(c, d); const float gs = fmaxf(h1, h2) + fmaxf(fminf(h1, h2), fmaxf(l1, l2));
                if (gs > best) { best = gs; bg = gI; } }
            const float v0 = sels[row * 32 + 4 * bg], v1 = sels[row * 32 + 4 * bg + 1], v2 = sels[row * 32 + 4 * bg + 2], v3 = sels[row * 32 + 4 * bg + 3];
            int i1 = 0; float b1v = v0; if (v1 > b1v) { b1v = v1; i1 = 1; } if (v2 > b1v) { b1v = v2; i1 = 2; } if (v3 > b1v) { b1v = v3; i1 = 3; }
            int i2 = -1; float b2v = -INFINITY;
            if (i1 != 0 && v0 > b2v) { b2v = v0; i2 = 0; } if (i1 != 1 && v1 > b2v) { b2v = v1; i2 = 1; } if (i1 != 2 && v2 > b2v) { b2v = v2; i2 = 2; } if (i1 != 3 && v3 > b2v) { b2v = v3; i2 = 3; }
            const int e1 = 4 * bg + i1, e2 = 4 * bg + i2; const float s1 = scs[row * 32 + e1], s2 = scs[row * 32 + e2]; const float inv = 1.0f / (s1 + s2);
            const size_t m = (size_t)tix * 16 + row;
            tok_e[2 * m] = e1; tok_e[2 * m + 1] = e2; tok_g[2 * m] = s1 * inv; tok_g[2 * m + 1] = s2 * inv;
            ble[(it * 16 + row) * 2] = e1; ble[(it * 16 + row) * 2 + 1] = e2; }
        __syncthreads();
        ntl = it + 1;
    }
#undef LNR_LOAD
    const int nasg = commit ? ntl * 32 : 0;
    if (tid < 32) { int c = 0; for (int i = 0; i < nasg; ++i) c += (ble[i] == tid) ? 1 : 0;
        unsigned base = 0; if (c) base = __hip_atomic_fetch_add(cnt + tid, (unsigned)c, __ATOMIC_RELAXED, __HIP_MEMORY_SCOPE_AGENT);
        hist[tid] = (int)base; }
    __syncthreads();
    if (tid < 32) { int run = hist[tid];
        for (int i = 0; i < nasg; ++i) if (ble[i] == tid) { const int tr = i >> 1; const size_t m = (size_t)(bid + G * (tr >> 4)) * 16 + (tr & 15);
            list[(size_t)tid * 65536 + run] = (int)m; tok_p[2 * m + (i & 1)] = run; ++run; } }
    __syncthreads();
}

constexpr int MOE_LDS = 131072;
__device__ __forceinline__ int moe_prefix(const unsigned* cnt, LAS int* pblk, int tid) {
    if (tid == 0) { int acc = 0; for (int e = 0; e < NE; ++e) { pblk[e] = acc; acc += ((int)cnt[e] + 255) >> 8; } pblk[NE] = acc; }
    __syncthreads();
    return pblk[NE];
}
template <int NJ> __device__ __forceinline__ int moe_table(const unsigned* cnt, LAS int* pblk, LAS int* tab, LAS int* aux, int NB, int G, int bid, int tid) {
    const int NU = NB * NJ;
    if (tid < 16) { const int L = bid + G * tid;
        if (L < NU) { const int rb = L / NJ, j = L % NJ; int e = 0; for (int q = 1; q < NE; ++q) if (pblk[q] <= rb) e = q;
            tab[tid] = rb; tab[16 + tid] = NJ * e + j; aux[tid * 3] = e; aux[tid * 3 + 1] = (rb - pblk[e]) * 256; aux[tid * 3 + 2] = (int)cnt[e]; } }
    __syncthreads();
    int n = 0; for (int i = 0; i < 16; ++i) if (bid + G * i < NU) n = i + 1;
    return n;
}

template <bool FINAL>
__device__ __forceinline__ void phase_combine_ln(const bf16_t* x1b, const bf16_t* Yr, const int* tok_e, const int* tok_p, const float* tok_g, const unsigned* cnt,
                                                 const float* g, const float* bb, bf16_t* xo, unsigned char* xq, float* fo, LAS unsigned char* lds, int G, int bid, int tid) {
    LAS int* pblk = (LAS int*)lds;
    moe_prefix(cnt, pblk, tid);
    const int wid = tid >> 6, lane = tid & 63;
    float ALPHA = 1.4142135623730951f; asm volatile("" : "+v"(ALPHA));
    for (int m = bid * 8 + wid; m < T_; m += G * 8) {
        const int e0 = tok_e[2 * m], e1 = tok_e[2 * m + 1];
        const size_t p0 = (size_t)pblk[e0] * 256 + tok_p[2 * m], p1 = (size_t)pblk[e1] * 256 + tok_p[2 * m + 1];
        const float g0 = tok_g[2 * m], g1 = tok_g[2 * m + 1];
        float v[32]; float s = 0.f;
#pragma unroll
        for (int i = 0; i < 4; ++i) { const int col = 8 * lane + 512 * i;
            const u32x4 xa = *(const u32x4*)(x1b + (size_t)m * DM + col);
            const unsigned xw[4] = {xa.x, xa.y, xa.z, xa.w};
            if constexpr (F8_YR) {
                const u32x2 ya = *(const u32x2*)((const unsigned char*)Yr + p0 * DM + col), yb = *(const u32x2*)((const unsigned char*)Yr + p1 * DM + col);
                const unsigned aw[2] = {ya.x, ya.y}, bw[2] = {yb.x, yb.y}; const float h0 = g0 * (1.0f / 16.0f), h1 = g1 * (1.0f / 16.0f);
#define CMB_PAIR(j, W, SEL) do { const f32x2 a2 = __builtin_amdgcn_cvt_pk_f32_fp8((int)aw[W], SEL), b2 = __builtin_amdgcn_cvt_pk_f32_fp8((int)bw[W], SEL); \
                    v[i * 8 + 2 * (j)] = ALPHA * bflo(xw[j]) + h0 * a2[0] + h1 * b2[0]; v[i * 8 + 2 * (j) + 1] = ALPHA * bfhi(xw[j]) + h0 * a2[1] + h1 * b2[1]; \
                    s += v[i * 8 + 2 * (j)] + v[i * 8 + 2 * (j) + 1]; } while (0)
                CMB_PAIR(0, 0, false); CMB_PAIR(1, 0, true); CMB_PAIR(2, 1, false); CMB_PAIR(3, 1, true);
#undef CMB_PAIR
            } else {
                const u32x4 ya = *(const u32x4*)(Yr + p0 * DM + col), yb = *(const u32x4*)(Yr + p1 * DM + col);
                const unsigned aw[4] = {ya.x, ya.y, ya.z, ya.w}, bw[4] = {yb.x, yb.y, yb.z, yb.w};
#pragma unroll
                for (int j = 0; j < 4; ++j) { v[i * 8 + 2 * j] = ALPHA * bflo(xw[j]) + g0 * bflo(aw[j]) + g1 * bflo(bw[j]); v[i * 8 + 2 * j + 1] = ALPHA * bfhi(xw[j]) + g0 * bfhi(aw[j]) + g1 * bfhi(bw[j]);
                    s += v[i * 8 + 2 * j] + v[i * 8 + 2 * j + 1]; }
            } }
        const float mean = wave_sum(s) * (1.0f / DM); float q = 0.f;
#pragma unroll
        for (int i = 0; i < 32; ++i) { const float d = v[i] - mean; q += d * d; }
        const float rstd = rsqrtf(wave_sum(q) * (1.0f / DM) + 1e-5f);
#pragma unroll
        for (int i = 0; i < 4; ++i) { const int col = 8 * lane + 512 * i;
            const f32x4 ga = *(const f32x4*)(g + col), gb = *(const f32x4*)(g + col + 4), ba = *(const f32x4*)(bb + col), bbv = *(const f32x4*)(bb + col + 4);
            float y[8];
#pragma unroll
            for (int j = 0; j < 4; ++j) { y[j] = (v[i * 8 + j] - mean) * rstd * ga[j] + ba[j]; y[4 + j] = (v[i * 8 + 4 + j] - mean) * rstd * gb[j] + bbv[j]; }
            if constexpr (FINAL) { *(f32x4*)(fo + (size_t)m * DM + col) = (f32x4){y[0], y[1], y[2], y[3]}; *(f32x4*)(fo + (size_t)m * DM + col + 4) = (f32x4){y[4], y[5], y[6], y[7]}; }
            else { *(u32x4*)(xo + (size_t)m * DM + col) = (u32x4){cvtpk(y[0], y[1]), cvtpk(y[2], y[3]), cvtpk(y[4], y[5]), cvtpk(y[6], y[7])};
                if constexpr (F8_IN) *(u32x2*)(xq + (size_t)m * DM + col) = (u32x2){pk4_fp8(y[0], y[1], y[2], y[3]), pk4_fp8(y[4], y[5], y[6], y[7])}; } }
    }
}

#ifndef ATT_ONLY
#define ATT_ONLY -1
#endif
#ifndef REP_K
#define REP_K -1
#endif
#ifndef REP_ATT
#define REP_ATT -1
#endif
#define NREP(k) ((REP_K == (k)) ? 2 : 1)
#define NREPA(k) ((REP_ATT == (k)) ? 2 : 1)
constexpr int N_PHASES = 20;
__global__ void __launch_bounds__(NTHR, 2) fwd(Params p) {
    extern __shared__ __attribute__((aligned(16))) unsigned char lds_raw[];
    LAS unsigned char* lds = (LAS unsigned char*)lds_raw;
    const int tid0 = threadIdx.x, bid = blockIdx.x, G = gridDim.x;
    const int wv = __builtin_amdgcn_readfirstlane(tid0 >> 6);
    const int vcu = (G % 8 == 0) ? (bid % 8) * (G / 8) + bid / 8 : bid;
    unsigned* ctl = (unsigned*)(p.ws + WS_CTL);
    if (tid0 < 4) ((LAS unsigned*)(lds + MISC_OFF))[tid0] = 0u;
    __syncthreads();
    XcdBarrier bar; bar.bar = ctl + CW_BAR; bar.x = 0; bar.st = (volatile LAS unsigned*)(lds + MISC_OFF);
    if (N_LAUNCH_MODE == 1) bar = xcd_barrier_post(ctl + CW_BAR, (volatile LAS unsigned*)(lds + MISC_OFF));
    const int lo = p.ph_lo, hi = p.ph_hi;
#ifndef PH_ONLY
#define PH_ONLY -1
#endif
#define IN(k) ((PH_ONLY < 0 || (PH_ONLY % 10) == ((k) % 10)) && lo <= (k) && (k) < hi)
#define SEAM(k) do { if ((k) + 1 < hi) xcd_barrier(bar); } while (0)

    for (int L = 0; L < 2; ++L) {
        const int pb = L * 10;
        typedef __attribute__((address_space(1))) unsigned char gu8;
        typedef __attribute__((address_space(1))) const float gcf;
        typedef __attribute__((address_space(4))) const unsigned long long kcu64;
#define INP(i) ((const float*)(gcf*)ka[i])
#define PHASE_PTRS \
        kcu64* ka = (kcu64*)__builtin_amdgcn_kernarg_segment_ptr(); asm volatile("" : "+s"(ka)); \
        unsigned char* ws = (unsigned char*)(gu8*)ka[29]; unsigned char* outb = (unsigned char*)(gu8*)ka[28]; \
        unsigned* ctl = (unsigned*)(ws + WS_CTL); \
        bf16_t* RA = (bf16_t*)(ws + WS_RA); bf16_t* RB = (bf16_t*)(ws + WS_RB); bf16_t* RC = (bf16_t*)(ws + WS_RC); \
        int* list = (int*)(ws + WS_LIST); int* tok_e = (int*)(ws + WS_TOKE); int* tok_p = (int*)(ws + WS_TOKP); float* tok_g = (float*)(ws + WS_TOKG); \
        bf16_t* krope = (bf16_t*)(ws + WS_KROPE); \
        bf16_t* Qd = (bf16_t*)(outb + OUT_QD); bf16_t* O1 = (bf16_t*)(outb + OUT_O1); \
        const bf16_t* Win = (const bf16_t*)(ws + (L ? WS_WIN1 : WS_WIN0)); const bf16_t* Wout = (const bf16_t*)(ws + (L ? WS_WOUT1 : WS_WOUT0)); \
        const bf16_t* Wgu = (const bf16_t*)(ws + (L ? WS_WGU1 : WS_WGU0)); const bf16_t* Wd = (const bf16_t*)(ws + (L ? WS_WD1 : WS_WD0)); \
        const int NIN = L ? IN1P : IN0; \
        const bf16_t* xin = L ? RC : RA; \
        bf16_t* Hx = RB; bf16_t* Oat = L ? O1 : RC; float* Z = (float*)RB; \
        bf16_t* x1b = RA; bf16_t* Hm = RC; bf16_t* Yr = RB; \
        unsigned* cnt = ctl + CW_CNT + L * 64; \
        (void)ctl; (void)RA; (void)RB; (void)RC; (void)list; (void)tok_e; (void)tok_p; (void)tok_g; (void)krope; (void)Qd; (void)O1; (void)Win; (void)Wout; (void)Wgu; (void)Wd; (void)NIN; (void)xin; (void)Hx; (void)Oat; (void)Z; (void)x1b; (void)Hm; (void)Yr; (void)cnt; (void)outb

        if (L == 0 && IN(0)) { PHASE_PTRS; _Pragma("unroll 1") for (int rep = 0; rep < NREP(0); ++rep) phase_prologue(ka, ws, lds, G, bid, fresh_tid(wv)); SEAM(0); }

        if (IN(pb + 1)) {
            PHASE_PTRS;
            constexpr int KI = F8_IN ? 1024 : 2048;
            const bf16_t* ain = F8_IN ? (L ? (const bf16_t*)outb : (const bf16_t*)((unsigned char*)RC + 64 * MiB)) : xin;
            pg8::Gemm g{ain, Win, KI, KI, KI}; pg8::StaticOrder S; S.init(T_, NIN, G, bid, KI);
            pg8::EpiBf16 E{Hx, NIN, 0xffff};
            _Pragma("unroll 1") for (int rep = 0; rep < NREP(1); ++rep) pg8::gemm_phase<F8_IN != 0>(wv, lds, g, S, E, W8_SBYTE, 0x7f7f7f7f);
            SEAM(pb + 1);
        }
        if (IN(pb + 2)) {
            PHASE_PTRS;
            if (L == 0) phase_prep_qk(Hx, INP(I_AQN), INP(I_AKN), G, bid, fresh_tid(wv));
            else phase_prep_mla(Hx, krope, G, bid, fresh_tid(wv));
            SEAM(pb + 2);
        }
        if (L == 1 && IN(pb + 3)) _Pragma("unroll 1") for (int rep = 0; rep < NREP(3); ++rep) {
            PHASE_PTRS;
#ifndef P3_ONLY
#define P3_ONLY -1
#endif
            if (P3_ONLY < 0 || P3_ONLY == 0) { pg8::Gemm g{Hx + 3072, (const bf16_t*)(ws + WS_WQUP), 512, IN1P, 512}; pg8::StaticOrder S; S.init(T_, 1536, G, bid, IN1P);
              pg8::EpiBf16 E{Qd, 1536, 0xffff}; pg8::gemm_phase<false>(wv, lds, g, S, E); }
            if (P3_ONLY < 0 || P3_ONLY == 1) { pg8::Gemm g{Hx + 3584, (const bf16_t*)(ws + WS_WKVUP), 256, IN1P, 256}; pg8::StaticOrder S; S.init(T_, 2048, G, bid, IN1P);
              pg8::EpiBf16 E{RA, 2048, 0xffff}; pg8::gemm_phase<false>(wv, lds, g, S, E); }
            if (rep + 1 == NREP(3)) SEAM(pb + 3);
        }
        if (IN(pb + 4)) {
            PHASE_PTRS;
            if (L == 0) {
                if (ATT_ONLY < 0 || ATT_ONLY == 0)
                _Pragma("unroll 1") for (int rep = 0; rep < NREPA(0); ++rep)
                for (int u = vcu; u < 1024; u += G) {
                    __syncthreads();
                    const int b = u >> 7, qb = u & 15, kvh = (u >> 6) & 1, gq = (u >> 4) & 3, h = kvh * 4 + gq;
                    da::DArgs a; a.Q = Hx + (size_t)(b * SEQ + 256 * qb) * IN0 + h * 128; a.ldq = IN0;
                    a.K = Hx + (size_t)b * SEQ * IN0 + 1024 + kvh * 128; a.ldk = IN0; a.V = Hx + (size_t)b * SEQ * IN0 + 1280 + kvh * 128; a.ldv = IN0; a.Kr = nullptr;
                    { const size_t eo = (size_t)(b * SEQ + 256 * qb) * DM + h * 128; a.O = F8_OUT ? (bf16_t*)((unsigned char*)Oat + eo) : Oat + eo; } a.ldo = DM; a.seq = SEQ; a.pos0 = 0;
                    da::attn_dense_body<8, 1>(wv, a, (char*)lds_raw);
                }
                __syncthreads();
                if (ATT_ONLY < 0 || ATT_ONLY == 2)
                _Pragma("unroll 1") for (int rep = 0; rep < NREPA(2); ++rep)
                for (int it = vcu; it < 1024; it += G) {
                    const int tid2 = fresh_tid(wv), wid = __builtin_amdgcn_readfirstlane(tid2 >> 6), lane = tid2 & 63;
                    const int w = it * 8 + wid; LAS unsigned char* wl = lds + wid * da::SP_WAVE_LDS;
                    PolB pol; pol.init(Hx, Oat, w, lane); da::sparse_wave(pol, wl, lane);
                }
            } else {
                if (ATT_ONLY < 0 || ATT_ONLY == 1)
                _Pragma("unroll 1") for (int rep = 0; rep < NREPA(1); ++rep)
                for (int u = vcu; u < 1024; u += G) {
                    __syncthreads();
                    const int b = u >> 7, qb = u & 15, h = (u >> 4) & 7;
                    da::DArgs a; a.Q = Qd + (size_t)(b * SEQ + 256 * qb) * 1536 + h * 192; a.ldq = 1536;
                    a.K = RA + (size_t)b * SEQ * DM + h * 256; a.ldk = DM; a.V = a.K + 128; a.ldv = DM; a.Kr = krope + (size_t)b * SEQ * 64;
                    { const size_t eo = (size_t)(b * SEQ + 256 * qb) * DM + 1024 + h * 128; a.O = F8_OUT ? (bf16_t*)((unsigned char*)Oat + eo) : Oat + eo; } a.ldo = DM; a.seq = SEQ; a.pos0 = 256 * qb;
                    da::attn_dense_body<12, 1>(wv, a, (char*)lds_raw);
                }
                __syncthreads();
                if (ATT_ONLY < 0 || ATT_ONLY == 3)
                _Pragma("unroll 1") for (int rep = 0; rep < NREPA(3); ++rep)
                for (int it = vcu; it < 1024; it += G) {
                    const int tid2 = fresh_tid(wv), wid = __builtin_amdgcn_readfirstlane(tid2 >> 6), lane = tid2 & 63;
                    const int w = it * 8 + wid; LAS unsigned char* wl = lds + wid * da::SP_WAVE_LDS;
                    PolC pol; pol.init(Hx, Oat, INP(I_RPB), (float*)((char*)wl + 16640), w, lane); da::sparse_wave(pol, wl, lane);
                }
            }
            SEAM(pb + 4);
        }
        if (IN(pb + 5)) {
            PHASE_PTRS;
            constexpr int KO = F8_OUT ? 1024 : 2048; constexpr int SXO = F8_OUT ? 0x7b7b7b7b : 0x7f7f7f7f;
            pg8::Gemm g{Oat, Wout, KO, KO, KO}; pg8::StaticOrder S; S.init(T_, DM, G, bid, KO);
            if (L == 0) { pg8::EpiResF32<true> E{Z, INP(I_X)}; _Pragma("unroll 1") for (int rep = 0; rep < NREP(5); ++rep) pg8::gemm_phase<F8_OUT != 0>(wv, lds, g, S, E, W8_SBYTE, SXO); }
            else { pg8::EpiResF32<false> E{Z, RC}; _Pragma("unroll 1") for (int rep = 0; rep < NREP(5); ++rep) pg8::gemm_phase<F8_OUT != 0>(wv, lds, g, S, E, W8_SBYTE, SXO); }
            SEAM(pb + 5);
        }
        if (IN(pb + 6)) {
            PHASE_PTRS;
            _Pragma("unroll 1") for (int rep = 0; rep < NREP(6); ++rep) phase_ln_router(Z, INP(L ? I_LN1G1 : I_LN1G0), INP(L ? I_LN1B1 : I_LN1B0), INP(I_RW), INP(I_RB), x1b, (unsigned char*)RC + 64 * MiB, tok_e, tok_p, tok_g, list, cnt, lds, G, bid, fresh_tid(wv), rep + 1 == NREP(6));
            SEAM(pb + 6);
        }
        if (IN(pb + 7)) {
            PHASE_PTRS;
            LAS int* pblk = (LAS int*)(lds + MOE_LDS); LAS int* tab = pblk + 64; LAS int* aux = tab + 32; LAS int* idx = aux + 64;
            const int tid = fresh_tid(wv);
            const int NB = moe_prefix(cnt, pblk, tid);
            const int n = moe_table<4>(cnt, pblk, tab, aux, NB, G, bid, tid);
            for (int i = 0; i < n; ++i) if (tid < 256) { const int e = aux[i * 3], rs = aux[i * 3 + 1], ce = aux[i * 3 + 2]; idx[i * 256 + tid] = list[(size_t)e * 65536 + min(rs + tid, ce - 1)]; }
            __syncthreads();
            constexpr int KG = F8_GU ? 1024 : 2048;
            const bf16_t* agu = F8_GU ? (const bf16_t*)((unsigned char*)RC + 64 * MiB) : x1b;
            pg8::Gemm g{agu, Wgu, KG, KG, KG}; pg8::TableOrder<true> S{tab, idx, n, KG}; pg8::EpiSiluMul<F8_DOWN != 0> E{Hm};
            _Pragma("unroll 1") for (int rep = 0; rep < NREP(7); ++rep) pg8::gemm_phase<F8_GU != 0>(wv, lds, g, S, E, W8_SBYTE, 0x7f7f7f7f);
            SEAM(pb + 7);
        }
        if (IN(pb + 8)) {
            PHASE_PTRS;
            LAS int* pblk = (LAS int*)(lds + MOE_LDS); LAS int* tab = pblk + 64; LAS int* aux = tab + 32;
            const int tid = fresh_tid(wv);
            const int NB = moe_prefix(cnt, pblk, tid);
            const int n = moe_table<8>(cnt, pblk, tab, aux, NB, G, bid, tid);
            constexpr int KD = F8_DOWN ? 256 : 512;
            pg8::Gemm g{Hm, Wd, KD, KD, KD}; pg8::TableOrder<false> S{tab, nullptr, n, KD}; pg8::EpiBf16T<F8_YR != 0> E{Yr, DM, 7};
            _Pragma("unroll 1") for (int rep = 0; rep < NREP(8); ++rep) pg8::gemm_phase<F8_DOWN != 0>(wv, lds, g, S, E, W8_SBYTE, 0x7f7f7f7f);
            SEAM(pb + 8);
        }
        if (IN(pb + 9)) _Pragma("unroll 1") for (int rep = 0; rep < NREP(9); ++rep) {
            PHASE_PTRS;
            if (L == 0) phase_combine_ln<false>(x1b, Yr, tok_e, tok_p, tok_g, cnt, INP(I_LN2G0), INP(I_LN2B0), RC, outb, nullptr, lds, G, bid, fresh_tid(wv));
            else phase_combine_ln<true>(x1b, Yr, tok_e, tok_p, tok_g, cnt, INP(I_LN2G1), INP(I_LN2B1), nullptr, nullptr, (float*)outb, lds, G, bid, fresh_tid(wv));
            if (rep + 1 == NREP(9)) SEAM(pb + 9);
        }
    }
#undef IN
#undef SEAM
#undef INP
#undef PHASE_PTRS
}

extern "C" void kernel_launch(void* const* d_in, const int* in_sizes, int n_in, void* d_out, int out_size, void* d_ws, size_t ws_size, hipStream_t stream) {
    static int grid = 0;
    if (grid == 0) {
        if (n_in != 28 || out_size != T_ * DM || ws_size < WS_END) { fprintf(stderr, "kernel_launch: unexpected shapes: n_in %d out %d ws %zu (need %zu)\n", n_in, out_size, ws_size, (size_t)WS_END); grid = -1; return; }
        int dev = 0, cus = 0, per_cu = 0;
        if (hipGetDevice(&dev) != hipSuccess || hipDeviceGetAttribute(&cus, hipDeviceAttributeMultiprocessorCount, dev) != hipSuccess) { grid = -1; return; }
        if (hipFuncSetAttribute((const void*)fwd, hipFuncAttributeMaxDynamicSharedMemorySize, LDS_BYTES) != hipSuccess) { fprintf(stderr, "kernel_launch: hipFuncSetAttribute failed\n"); grid = -1; return; }
        if (hipOccupancyMaxActiveBlocksPerMultiprocessor(&per_cu, (const void*)fwd, NTHR, LDS_BYTES) != hipSuccess || per_cu < 1)
            fprintf(stderr, "kernel_launch: occupancy query reports %d workgroups per CU\n", per_cu);
        (void)hipGetLastError();
        grid = cus;
    }
    if (grid < 0) return;
    (void)hipMemsetAsync((char*)d_ws + WS_CTL, 0, CTL_ZERO_BYTES, stream);
    Params p{};
    for (int i = 0; i < 28; ++i) p.in[i] = (const float*)d_in[i];
    p.out = (float*)d_out; p.ws = (unsigned char*)d_ws;
#if N_LAUNCH_MODE == 1
    p.ph_lo = 0; p.ph_hi = N_PHASES;
    hipLaunchKernelGGL(fwd, dim3(grid), dim3(NTHR), LDS_BYTES, stream, p);
#else
    for (int k = 0; k < N_PHASES; ++k) { if (k == 3 || k == 10) continue; p.ph_lo = k; p.ph_hi = k + 1;
        hipLaunchKernelGGL(fwd, dim3(grid), dim3(NTHR), LDS_BYTES, stream, p); }
#endif
    const hipError_t le = hipPeekAtLastError();
    if (le != hipSuccess) fprintf(stderr, "kernel_launch: launch failed: %s\n", hipGetErrorName(le));
}
```

```cpp
#include <hip/hip_runtime.h>
#include <cstdio>
#include <cstdint>

#ifndef N_LAUNCH_MODE
#define N_LAUNCH_MODE 1
#endif
#ifndef DBG_CHECK
#define DBG_CHECK 0
#endif
#ifndef DBG_TOL
#define DBG_TOL 0.3f
#endif
#ifndef F8_DOWN
#define F8_DOWN 1
#endif
#ifndef F8_GU
#define F8_GU 1
#endif
#ifndef F8_IN
#define F8_IN 1
#endif
#ifndef F8_OUT
#define F8_OUT 1
#endif
#ifndef F8_ATTA
#define F8_ATTA 1
#endif
#ifndef F8_ATTD
#define F8_ATTD 1
#endif
#ifndef F8_YR
#define F8_YR 1
#endif

#define LAS __attribute__((address_space(3)))
typedef unsigned short bf16_t;
typedef short bf16x8 __attribute__((ext_vector_type(8)));
typedef short s16x4 __attribute__((ext_vector_type(4)));
typedef float f32x2 __attribute__((ext_vector_type(2)));
typedef float f32x4 __attribute__((ext_vector_type(4)));
typedef float f32x8 __attribute__((ext_vector_type(8)));
typedef float f32x16 __attribute__((ext_vector_type(16)));
typedef unsigned u32x2 __attribute__((ext_vector_type(2)));
typedef unsigned u32x4 __attribute__((ext_vector_type(4)));
typedef int i32x8 __attribute__((ext_vector_type(8)));
typedef _Float16 f16x8 __attribute__((ext_vector_type(8)));
typedef _Float16 f16x2 __attribute__((ext_vector_type(2)));
typedef int i32x4 __attribute__((ext_vector_type(4)));

constexpr int T_ = 32768, DM = 2048, SEQ = 4096, NBATCH = 8;
constexpr int IN0 = 4608, IN1 = 3904, IN1P = 4096;
constexpr int NE = 32, DE = 512, MAXBLK = 288;
constexpr float ALPHA = 1.4142135623730951f;
constexpr float LOG2E = 1.4426950408889634f;
constexpr int NTHR = 512;

constexpr size_t MiB = 1u << 20;
constexpr size_t WS_CTL = 0, CTL_ZERO_BYTES = 1 * MiB;
constexpr size_t WS_LIST = 1 * MiB;
constexpr size_t WS_TOKE = 9 * MiB;
constexpr size_t WS_TOKP = WS_TOKE + 256 * 1024;
constexpr size_t WS_TOKG = WS_TOKP + 256 * 1024;
constexpr size_t WS_RSTAT = WS_TOKG + 256 * 1024;
constexpr size_t WS_KROPE = 10 * MiB;
constexpr size_t WS_WIN0 = 16 * MiB, WS_WOUT0 = 34 * MiB, WS_WGU0 = 42 * MiB, WS_WD0 = 170 * MiB;
constexpr size_t WS_WIN1 = 234 * MiB, WS_WOUT1 = 250 * MiB, WS_WGU1 = 258 * MiB, WS_WD1 = 386 * MiB;
constexpr size_t WS_WQUP = 450 * MiB, WS_WKVUP = 452 * MiB;
constexpr size_t WS_RA = 454 * MiB, WS_RB = 582 * MiB, WS_RC = 870 * MiB, WS_END = 998 * MiB;
constexpr size_t OUT_QD = 0, OUT_O1 = 96 * MiB;
constexpr int CW_CNT = 64;
constexpr int CW_DBG = 512;
constexpr int CW_BAR = 4096;

constexpr int LDS_BYTES = 155648;
constexpr int MISC_OFF = LDS_BYTES - 64;

__device__ __forceinline__ unsigned cvtpk(float lo, float hi) { unsigned r; asm volatile("v_cvt_pk_bf16_f32 %0, %1, %2" : "=v"(r) : "v"(lo), "v"(hi)); return r; }
__device__ __forceinline__ float bf2f(unsigned short b) { return __uint_as_float(((unsigned)b) << 16); }
__device__ __forceinline__ float bflo(unsigned w) { return __uint_as_float(w << 16); }
__device__ __forceinline__ float bfhi(unsigned w) { return __uint_as_float(w & 0xffff0000u); }
__device__ __forceinline__ bf16_t f2bf(float f) { return (bf16_t)(cvtpk(f, f) & 0xffffu); }
__device__ __forceinline__ unsigned pk4_fp8(float a, float b, float c, float d) { int w = 0; w = __builtin_amdgcn_cvt_pk_fp8_f32(a, b, w, false); w = __builtin_amdgcn_cvt_pk_fp8_f32(c, d, w, true); return (unsigned)w; }
constexpr float O8_SCALE = 16.f;
__device__ __forceinline__ unsigned char f2fp8(float v) { return (unsigned char)(__builtin_amdgcn_cvt_pk_fp8_f32(v, v, 0, false) & 0xff); }
__device__ __forceinline__ float clamp8(float v) { return fminf(fmaxf(v, -400.f), 400.f); }
__device__ __forceinline__ int fresh_tid(int wv) { int l; asm volatile("v_mbcnt_lo_u32_b32 %0, -1, 0\n\tv_mbcnt_hi_u32_b32 %0, -1, %0" : "=v"(l)); return wv * 64 + l; }
__device__ __forceinline__ float fresh_zero() { float z; asm volatile("v_mov_b32 %0, 0" : "=v"(z)); return z; }
__device__ __forceinline__ float wave_sum(float v) {
    v += __int_as_float(__builtin_amdgcn_ds_swizzle(__float_as_int(v), (1 << 10) | 0x1f));
    v += __int_as_float(__builtin_amdgcn_ds_swizzle(__float_as_int(v), (2 << 10) | 0x1f));
    v += __int_as_float(__builtin_amdgcn_ds_swizzle(__float_as_int(v), (4 << 10) | 0x1f));
    v += __int_as_float(__builtin_amdgcn_ds_swizzle(__float_as_int(v), (8 << 10) | 0x1f));
    v += __int_as_float(__builtin_amdgcn_ds_swizzle(__float_as_int(v), (16 << 10) | 0x1f));
    auto rr = __builtin_amdgcn_permlane32_swap(__float_as_uint(v), __float_as_uint(v), false, false);
    return __uint_as_float(rr[0]) + __uint_as_float(rr[1]);
}
__device__ __forceinline__ float wave_max(float v) {
    v = fmaxf(v, __int_as_float(__builtin_amdgcn_ds_swizzle(__float_as_int(v), (1 << 10) | 0x1f)));
    v = fmaxf(v, __int_as_float(__builtin_amdgcn_ds_swizzle(__float_as_int(v), (2 << 10) | 0x1f)));
    v = fmaxf(v, __int_as_float(__builtin_amdgcn_ds_swizzle(__float_as_int(v), (4 << 10) | 0x1f)));
    v = fmaxf(v, __int_as_float(__builtin_amdgcn_ds_swizzle(__float_as_int(v), (8 << 10) | 0x1f)));
    v = fmaxf(v, __int_as_float(__builtin_amdgcn_ds_swizzle(__float_as_int(v), (16 << 10) | 0x1f)));
    auto rr = __builtin_amdgcn_permlane32_swap(__float_as_uint(v), __float_as_uint(v), false, false);
    return fmaxf(__uint_as_float(rr[0]), __uint_as_float(rr[1]));
}
__device__ __forceinline__ float inv_freq32(int i) { return __builtin_amdgcn_exp2f(-(float)i * 0.41524101186092029f); }
__device__ __forceinline__ void sincos_rev(float angle, float& s, float& c) {
    float rev = angle * 0.15915494309189535f; rev = rev - floorf(rev);
    s = __builtin_amdgcn_sinf(rev); c = __builtin_amdgcn_cosf(rev);
}

#define XB_TMO      128
#define XB_XCNT(j)  (256  + 64 * (j))
#define XB_XSUB(j)  (1280 + 64 * (j))
#define XB_XGEN(j)  (2304 + 64 * (j))
#define XB_TOP      3328
#define XB_TOPGEN   3392
#define XCD_BAR_WORDS 3456
#define XB_SPIN_CAP (1u << 20)
__device__ __forceinline__ unsigned xb_ld(unsigned* p)              { return __hip_atomic_load(p, __ATOMIC_RELAXED, __HIP_MEMORY_SCOPE_AGENT); }
__device__ __forceinline__ unsigned xb_add(unsigned* p, unsigned v) { return __hip_atomic_fetch_add(p, v, __ATOMIC_RELAXED, __HIP_MEMORY_SCOPE_AGENT); }
__device__ __forceinline__ unsigned xb_xcc_id() { return (unsigned)__builtin_amdgcn_s_getreg((3 << 11) | 20) & 0xFu; }
#define XB_SPIN(cond, bar) do { unsigned _sp = 0; while (cond) { __builtin_amdgcn_s_sleep(1); \
    if ((++_sp & 255u) == 0u) { if (xb_ld(&(bar)[XB_TMO])) break; if (_sp > XB_SPIN_CAP) { atomicAdd(&(bar)[XB_TMO], 1u); break; } } } } while (0)
struct XcdBarrier { unsigned* bar; unsigned x; volatile LAS unsigned* st; };
__device__ __forceinline__ XcdBarrier xcd_barrier_post(unsigned* bar, volatile LAS unsigned* st) {
    XcdBarrier b; b.bar = bar; b.x = xb_xcc_id(); b.st = st;
    if (threadIdx.x == 0) (void)xb_add(&bar[XB_XCNT(b.x)], 1u);
    return b;
}
__device__ __forceinline__ void xcd_barrier_complete(unsigned* bar, unsigned x, unsigned& nloc, unsigned& nx) {
    const unsigned G = gridDim.x * gridDim.y * gridDim.z;
    unsigned sum, cnt, mine, sp = 0u;
    for (;;) {
        sum = 0u; cnt = 0u; mine = 0u;
#pragma unroll
        for (unsigned j = 0; j < 16; ++j) { const unsigned c = xb_ld(&bar[XB_XCNT(j)]); sum += c; cnt += (c > 0u) ? 1u : 0u; mine = (j == x) ? c : mine; }
        if (sum == G) break;
        __builtin_amdgcn_s_sleep(1);
        if ((++sp & 255u) == 0u) { if (xb_ld(&bar[XB_TMO])) break; if (sp > XB_SPIN_CAP) { atomicAdd(&bar[XB_TMO], 1u); break; } }
    }
    nloc = mine > 0u ? mine : 1u; nx = cnt > 0u ? cnt : 1u;
}
__device__ __forceinline__ void xcd_barrier(const XcdBarrier& b, int tid_now) {
    asm volatile("s_waitcnt vmcnt(0)" ::: "memory");
    __syncthreads();
    if (tid_now == 0) {
        unsigned* bar = b.bar;
        __builtin_amdgcn_s_waitcnt(0);
        unsigned nloc = b.st[0], nx = b.st[1];
        if (nloc == 0u) { xcd_barrier_complete(bar, b.x, nloc, nx); b.st[0] = nloc; b.st[1] = nx; }
        const unsigned old = xb_add(&bar[XB_XSUB(b.x)], 1u);
        const unsigned gen = old / nloc;
        if (old + 1u == (gen + 1u) * nloc) {
            __builtin_amdgcn_fence(__ATOMIC_RELEASE, "agent");
            asm volatile("s_waitcnt vmcnt(0)" ::: "memory");
            const unsigned og = xb_add(&bar[XB_TOP], 1u);
            const unsigned tg = og / nx;
            if (og + 1u == (tg + 1u) * nx) xb_add(&bar[XB_TOPGEN], 1u);
            else XB_SPIN(xb_ld(&bar[XB_TOPGEN]) == tg, bar);
            __builtin_amdgcn_fence(__ATOMIC_ACQUIRE, "agent");
            xb_add(&bar[XB_XGEN(b.x)], 1u);
            asm volatile("s_waitcnt vmcnt(0)" ::: "memory");
        } else {
            XB_SPIN(xb_ld(&bar[XB_XGEN(b.x)]) == gen, bar);
            __builtin_amdgcn_fence(__ATOMIC_ACQUIRE, "agent");
            asm volatile("s_waitcnt vmcnt(0)" ::: "memory");
        }
    }
    __syncthreads();
}

namespace pg8 {
constexpr int BM = 256, BK = 64, HALF = 128, HTB = HALF * BK * 2, STAGE_BYTES = 8 * HTB, NXCD = 8, WGM = 8;
__device__ __forceinline__ int lds_byte(int r, int c) { const int st = (r >> 4) * 2 + (c >> 5), rr = r & 15, cc = c & 31, ob = rr * 64 + cc * 2; return st * 1024 + (ob ^ (((ob >> 9) & 1) << 5)); }
__device__ __forceinline__ void stage_rc(int b, int& R, int& C) { const int st = b / 1024, sb = b % 1024, swz = sb ^ (((sb >> 9) & 1) << 5); R = (st >> 1) * 16 + swz / 64; C = (st & 1) * 32 + (swz % 64) / 2; }
__device__ __forceinline__ int perm32(int rho) { const int n = rho >> 4, i = rho & 15; return 8 * (i >> 2) + 4 * n + (i & 3); }
struct Unit { int pm, pn, q; };
struct Gemm { const bf16_t* A; const bf16_t* Bt; int K, lda, ldb; };

struct StaticOrder {
    static constexpr bool GATHER = false;
    int nM, nN, nwg, G, c, lda;
    __device__ void init(int M, int N, int G_, int c_, int lda_) { nM = M / BM; nN = N / BM; nwg = nM * nN; G = G_; c = c_; lda = lda_; }
    __device__ __forceinline__ bool next(int i, Unit& u) const {
        const long L = (long)i * G + c; if (L >= nwg) return false;
        int wgid = (int)L; { const int q = nwg / NXCD, r = nwg % NXCD, xcd = wgid % NXCD, off = wgid / NXCD; wgid = (xcd < r ? xcd * (q + 1) : r * (q + 1) + (xcd - r) * q) + off; }
        const int nig = WGM * nN, gid = wgid / nig, fm = gid * WGM, gsz = (nM - fm) < WGM ? (nM - fm) : WGM;
        u.pm = fm + ((wgid % nig) % gsz); u.pn = (wgid % nig) / gsz; u.q = i; return true;
    }
    __device__ __forceinline__ void aoff(const Unit& u, const int (&R)[2], const int (&C)[2], unsigned (&o)[2][2]) const {
#pragma unroll
        for (int h = 0; h < 2; ++h)
#pragma unroll
            for (int i = 0; i < 2; ++i) o[h][i] = (unsigned)((u.pm * BM + h * HALF + R[i]) * lda + C[i]) * 2u;
    }
};
template <bool GATHER_> struct TableOrder {
    static constexpr bool GATHER = GATHER_;
    const LAS int* tab; const LAS int* idx; int n, lda;
    __device__ __forceinline__ bool next(int i, Unit& u) const { if (i >= n) return false; u.pm = tab[i]; u.pn = tab[16 + i]; u.q = i; return true; }
    __device__ __forceinline__ void aoff(const Unit& u, const int (&R)[2], const int (&C)[2], unsigned (&o)[2][2]) const {
#pragma unroll
        for (int h = 0; h < 2; ++h)
#pragma unroll
            for (int i = 0; i < 2; ++i) { const int row = GATHER ? idx[u.q * 256 + h * HALF + R[i]] : (u.pm * BM + h * HALF + R[i]); o[h][i] = (unsigned)(row * lda + C[i]) * 2u; }
    }
};

template <bool O8> struct EpiBf16T {
    static constexpr bool PERM = true;
    bf16_t* O; int ldc; int pnmask;
    __device__ __forceinline__ void operator()(const f32x4 (&acc)[2][2][4][2], const Unit& u, int wr, int wc, int fr, int fq) const {
        const int row0 = u.pm * BM + wr * 64 + fr; const int col0 = (u.pn & pnmask) * BM + wc * 32 + 8 * fq;
#pragma unroll
        for (int ai = 0; ai < 2; ++ai)
#pragma unroll
            for (int m = 0; m < 4; ++m) { const size_t eoff = (size_t)(row0 + ai * HALF + m * 16) * ldc + col0;
#pragma unroll
                for (int bj = 0; bj < 2; ++bj) { const f32x4 v0 = acc[ai][bj][m][0], v1 = acc[ai][bj][m][1];
                    if constexpr (O8) { u32x2 w; w.x = pk4_fp8(v0[0] * 16.f, v0[1] * 16.f, v0[2] * 16.f, v0[3] * 16.f); w.y = pk4_fp8(v1[0] * 16.f, v1[1] * 16.f, v1[2] * 16.f, v1[3] * 16.f);
                        *(u32x2*)((unsigned char*)O + eoff + bj * HALF) = w; }
                    else { u32x4 w; w.x = cvtpk(v0[0], v0[1]); w.y = cvtpk(v0[2], v0[3]); w.z = cvtpk(v1[0], v1[1]); w.w = cvtpk(v1[2], v1[3]);
                        *(u32x4*)(O + eoff + bj * HALF) = w; } } }
    }
};
typedef EpiBf16T<false> EpiBf16;
struct EpiRowScale {
    static constexpr bool PERM = true;
    bf16_t* O; int ldc; const float* rs; int which;
    __device__ __forceinline__ void operator()(const f32x4 (&acc)[2][2][4][2], const Unit& u, int wr, int wc, int fr, int fq) const {
        const int row0 = u.pm * BM + wr * 64 + fr; const int col0 = u.pn * BM + wc * 32 + 8 * fq;
#pragma unroll
        for (int ai = 0; ai < 2; ++ai)
#pragma unroll
            for (int m = 0; m < 4; ++m) { const int row = row0 + ai * HALF + m * 16; const float s = rs[row * 2 + which]; bf16_t* rowp = O + (size_t)row * ldc + col0;
#pragma unroll
                for (int bj = 0; bj < 2; ++bj) { const f32x4 v0 = acc[ai][bj][m][0] * s, v1 = acc[ai][bj][m][1] * s;
                    u32x4 w; w.x = cvtpk(v0[0], v0[1]); w.y = cvtpk(v0[2], v0[3]); w.z = cvtpk(v1[0], v1[1]); w.w = cvtpk(v1[2], v1[3]);
                    *(u32x4*)(rowp + bj * HALF) = w; } }
    }
};
struct EpiKV8 {
    static constexpr bool PERM = true;
    unsigned char* K8; unsigned char* Vt8; bf16_t* KV; bool wr_bf16;
    __device__ __forceinline__ void operator()(const f32x4 (&acc)[2][2][4][2], const Unit& u, int wr, int wc, int fr, int fq) const {
        const int row0 = u.pm * BM + wr * 64 + fr; const int c0 = wc * 32 + 8 * fq;
#pragma unroll
        for (int ai = 0; ai < 2; ++ai)
#pragma unroll
            for (int m = 0; m < 4; ++m) { const int row = row0 + ai * HALF + m * 16;
                { const f32x4 v0 = acc[ai][0][m][0], v1 = acc[ai][0][m][1];
                  *(u32x2*)(K8 + (size_t)row * 1024 + u.pn * 128 + c0) = (u32x2){pk4_fp8(v0[0], v0[1], v0[2], v0[3]), pk4_fp8(v1[0], v1[1], v1[2], v1[3])}; }
                { const f32x4 v0 = acc[ai][1][m][0], v1 = acc[ai][1][m][1]; const float vv[8] = {v0[0], v0[1], v0[2], v0[3], v1[0], v1[1], v1[2], v1[3]};
                  unsigned char* vp = Vt8 + ((size_t)((row >> 12) * 8 + u.pn) * 128 + c0) * SEQ + (row & (SEQ - 1));
#pragma unroll
                  for (int e = 0; e < 8; ++e) vp[(size_t)e * SEQ] = f2fp8(vv[e]); }
                if (wr_bf16) {
#pragma unroll
                    for (int bj = 0; bj < 2; ++bj) { const f32x4 v0 = acc[ai][bj][m][0], v1 = acc[ai][bj][m][1];
                        u32x4 w; w.x = cvtpk(v0[0], v0[1]); w.y = cvtpk(v0[2], v0[3]); w.z = cvtpk(v1[0], v1[1]); w.w = cvtpk(v1[2], v1[3]);
                        *(u32x4*)(KV + (size_t)row * DM + u.pn * BM + bj * HALF + c0) = w; } } }
    }
};
template <bool O8> struct EpiSiluMul {
    static constexpr bool PERM = true;
    bf16_t* O;
    __device__ __forceinline__ void operator()(const f32x4 (&acc)[2][2][4][2], const Unit& u, int wr, int wc, int fr, int fq) const {
        const int row0 = u.pm * BM + wr * 64 + fr; const int col0 = (u.pn & 3) * HALF + wc * 32 + 8 * fq;
#pragma unroll
        for (int ai = 0; ai < 2; ++ai)
#pragma unroll
            for (int m = 0; m < 4; ++m) { const size_t eoff = (size_t)(row0 + ai * HALF + m * 16) * DE + col0; float h[8];
#pragma unroll
                for (int n = 0; n < 2; ++n)
#pragma unroll
                    for (int j = 0; j < 4; ++j) { const float g = acc[ai][0][m][n][j], up = acc[ai][1][m][n][j];
                        const float sg = g * __builtin_amdgcn_rcpf(1.0f + __builtin_amdgcn_exp2f(-g * LOG2E)); h[n * 4 + j] = sg * up; }
                if constexpr (O8) { u32x2 w; w.x = pk4_fp8(clamp8(h[0]), clamp8(h[1]), clamp8(h[2]), clamp8(h[3])); w.y = pk4_fp8(clamp8(h[4]), clamp8(h[5]), clamp8(h[6]), clamp8(h[7]));
                    *(u32x2*)((unsigned char*)O + eoff) = w; }
                else { u32x4 w; w.x = cvtpk(h[0], h[1]); w.y = cvtpk(h[2], h[3]); w.z = cvtpk(h[4], h[5]); w.w = cvtpk(h[6], h[7]);
                    *(u32x4*)(O + eoff) = w; } }
    }
};
template <bool RES_F32> struct EpiResF32 {
    static constexpr bool PERM = false;
    float* Z; const void* res;
    __device__ __forceinline__ void operator()(const f32x4 (&acc)[2][2][4][2], const Unit& u, int wr, int wc, int fr, int fq) const {
        const int row0 = u.pm * BM + wr * 64 + fr, col0 = u.pn * BM + wc * 32 + 4 * fq;
        float ALPHA = 1.4142135623730951f; asm volatile("" : "+v"(ALPHA));
#pragma unroll
        for (int ai = 0; ai < 2; ++ai)
#pragma unroll
            for (int m = 0; m < 4; ++m) { const size_t off = (size_t)(row0 + ai * HALF + m * 16) * DM + col0;
#pragma unroll
                for (int bj = 0; bj < 2; ++bj)
#pragma unroll
                    for (int n = 0; n < 2; ++n) { f32x4 o = acc[ai][bj][m][n];
                        if constexpr (RES_F32) { const f32x4 rv = *(const f32x4*)((const float*)res + off + bj * HALF + n * 16); o += ALPHA * rv; }
                        else { const u32x2 rb = *(const u32x2*)((const bf16_t*)res + off + bj * HALF + n * 16);
                            o[0] += ALPHA * bflo(rb.x); o[1] += ALPHA * bfhi(rb.x); o[2] += ALPHA * bflo(rb.y); o[3] += ALPHA * bfhi(rb.y); }
                        *(f32x4*)(Z + off + bj * HALF + n * 16) = o; } }
    }
};

template <bool F8, class Epi, class Sched>
__device__ __forceinline__ void gemm_phase(int wv, LAS unsigned char* lds, const Gemm g, const Sched& S, const Epi& E, int sW = 0x7f7f7f7f, int sX = 0x7f7f7f7f) {
    constexpr bool GA = Sched::GATHER;
    const int tid = fresh_tid(wv), wid = __builtin_amdgcn_readfirstlane(tid >> 6), lane = tid & 63, wr = wid >> 2, wc = wid & 3, fr = lane & 15, fq = lane >> 4;
    int K = g.K; asm volatile("" : "+s"(K));
    const int nt = K / BK;
    int Rr[2], Cc[2]; unsigned voffA[2], voffB[2];
#pragma unroll
    for (int i = 0; i < 2; ++i) { int R, C; stage_rc(tid * 16 + i * 8192, R, C); Rr[i] = R; Cc[i] = C; const int Rb = Epi::PERM ? ((R & ~31) + perm32(R & 31)) : R;
        voffA[i] = (unsigned)(R * g.lda + C) * 2u; voffB[i] = (unsigned)(Rb * g.ldb + C) * 2u; }
    const size_t kstep = (size_t)(BK * 2);
    const size_t hstepA = (size_t)HALF * g.lda * 2, tstepA = 2 * hstepA;
    const size_t hstepB = (size_t)HALF * g.ldb * 2, tstepB = 2 * hstepB;
    const unsigned ldsw = (unsigned)wid * 1024u;
    const int aoff = lds_byte(wr * 64 + fr, fq * 8), boff = lds_byte(wc * 32 + fr, fq * 8);
#define PG8_SA(b, h) (((b) * 2 + (h)) * HTB)
#define PG8_SB(b, h) ((4 + (b) * 2 + (h)) * HTB)
#define PG8_STAGE(bufoff, gbase, voff) do { _Pragma("unroll") for (int _i = 0; _i < 2; ++_i) \
        __builtin_amdgcn_global_load_lds((const unsigned*)((const char*)(gbase) + (voff)[_i]), (LAS unsigned*)(lds + (bufoff) + ldsw + _i * 8192), 16, 0, 0); } while (0)
#define PG8_STAGE_A(bufoff, h, pbase, koff, goffs) do { if constexpr (GA) { PG8_STAGE(bufoff, gA + (koff), (goffs)[h]); } else { PG8_STAGE(bufoff, (pbase) + (h) * hstepA, voffA); } } while (0)
#define PG8_LD32(dst, off) do { const i32x4 _lo = *(const LAS i32x4*)(lds + (off)), _hi = *(const LAS i32x4*)(lds + (off) + 1024); dst = __builtin_shufflevector(_lo, _hi, 0, 1, 2, 3, 4, 5, 6, 7); } while (0)
#define PG8_LDA(dst, b, h) do { _Pragma("unroll") for (int m = 0; m < 4; ++m) PG8_LD32(dst[m], PG8_SA(b, h) + aoff + m * 2048); } while (0)
#define PG8_LDB(dst, b, h) do { _Pragma("unroll") for (int n = 0; n < 2; ++n) PG8_LD32(dst[n], PG8_SB(b, h) + boff + n * 2048); } while (0)
#define PG8_LOH(v) __builtin_bit_cast(bf16x8, __builtin_shufflevector(v, v, 0, 1, 2, 3))
#define PG8_HIH(v) __builtin_bit_cast(bf16x8, __builtin_shufflevector(v, v, 4, 5, 6, 7))
#define PG8_MMA(ai, bj, At, Bt) do { __builtin_amdgcn_s_setprio(1); \
        if constexpr (F8) { _Pragma("unroll") for (int m = 0; m < 4; ++m) _Pragma("unroll") for (int n = 0; n < 2; ++n) \
            asm volatile("v_mfma_scale_f32_16x16x128_f8f6f4 %0, %1, %2, %0, %3, %4 op_sel_hi:[0,0,0]" : "+v"(acc[ai][bj][m][n]) : "v"(Bt[n]), "v"(At[m]), "v"(sW), "v"(sX)); } \
        else { _Pragma("unroll") for (int m = 0; m < 4; ++m) _Pragma("unroll") for (int n = 0; n < 2; ++n) { \
            acc[ai][bj][m][n] = __builtin_amdgcn_mfma_f32_16x16x32_bf16(PG8_LOH(Bt[n]), PG8_LOH(At[m]), acc[ai][bj][m][n], 0, 0, 0); \
            acc[ai][bj][m][n] = __builtin_amdgcn_mfma_f32_16x16x32_bf16(PG8_HIH(Bt[n]), PG8_HIH(At[m]), acc[ai][bj][m][n], 0, 0, 0); } } \
        __builtin_amdgcn_s_setprio(0); } while (0)
#define PG8_WAIT_V(n) asm volatile("s_waitcnt vmcnt(" #n ")" ::: "memory")
#define PG8_WAIT_L(n) asm volatile("s_waitcnt lgkmcnt(" #n ")" ::: "memory")
#define PG8_BAR __builtin_amdgcn_s_barrier()
#define PG8_SCHED __builtin_amdgcn_sched_barrier(0)
    Unit cur, nxt; int ui = 0;
    if (!S.next(0, cur)) return;
    f32x4 acc[2][2][4][2];
#pragma unroll
    for (int a = 0; a < 2; ++a)
#pragma unroll
        for (int b = 0; b < 2; ++b)
#pragma unroll
            for (int m = 0; m < 4; ++m)
#pragma unroll
                for (int n = 0; n < 2; ++n) { const float zf = fresh_zero(); acc[a][b][m][n] = (f32x4){zf, zf, zf, zf}; }
    unsigned ca[2][2];
    if constexpr (GA) S.aoff(cur, Rr, Cc, ca);
    const char* gA = (const char*)g.A;
    const char* cA = gA + (GA ? (size_t)0 : (size_t)cur.pm * tstepA);
    const char* cB = (const char*)g.Bt + (size_t)cur.pn * tstepB;
    PG8_STAGE(PG8_SB(0, 0), cB, voffB); PG8_STAGE_A(PG8_SA(0, 0), 0, cA, 0, ca); PG8_STAGE(PG8_SB(0, 1), cB + hstepB, voffB); PG8_STAGE_A(PG8_SA(0, 1), 1, cA, 0, ca);
    if (wr == 1) PG8_BAR;
    PG8_WAIT_V(4); PG8_BAR;
    PG8_STAGE(PG8_SB(1, 0), cB + kstep, voffB); PG8_STAGE_A(PG8_SA(1, 0), 0, cA + kstep, kstep, ca); PG8_STAGE(PG8_SB(1, 1), cB + hstepB + kstep, voffB);
    PG8_WAIT_V(6); PG8_BAR;
    for (;;) {
        const bool has_next = S.next(ui + 1, nxt);
        const char* nA = (!GA && has_next) ? gA + (size_t)nxt.pm * tstepA : cA;
        const char* nB = has_next ? (const char*)g.Bt + (size_t)nxt.pn * tstepB : cB;
#pragma unroll 1
        for (int t = 0; t < nt; t += 2) {
            const bool last = (t == nt - 2);
            const size_t k1 = (size_t)(t + 1) * kstep, k2 = last ? (size_t)0 : (size_t)(t + 2) * kstep, k3 = k2 + kstep;
            const char* a1 = cA + k1;
            const char* a2 = last ? nA : cA + k2; const char* b2 = last ? nB : cB + (size_t)(t + 2) * kstep;
            const char* a3 = a2 + kstep; const char* b3 = b2 + kstep;
            i32x8 At[4], B0[2], B1[2];
            unsigned xa[2][2];
            if constexpr (GA) {
                if (last && has_next) { int R2[2], C2[2]; const int t2 = fresh_tid(wv); stage_rc(t2 * 16, R2[0], C2[0]); stage_rc(t2 * 16 + 8192, R2[1], C2[1]); S.aoff(nxt, R2, C2, xa); }
                else {
#pragma unroll
                    for (int h = 0; h < 2; ++h)
#pragma unroll
                        for (int i = 0; i < 2; ++i) xa[h][i] = ca[h][i];
                }
            }
            PG8_LDB(B0, 0, 0); PG8_SCHED; PG8_LDA(At, 0, 0); PG8_STAGE_A(PG8_SA(1, 1), 1, a1, k1, ca);
            PG8_WAIT_L(8); PG8_BAR; PG8_WAIT_L(0); PG8_MMA(0, 0, At, B0); PG8_BAR; PG8_SCHED;
            PG8_LDB(B1, 0, 1); PG8_STAGE(PG8_SB(0, 0), b2, voffB);
            PG8_BAR; PG8_WAIT_L(0); PG8_MMA(0, 1, At, B1); PG8_BAR;
            PG8_LDA(At, 0, 1); PG8_STAGE_A(PG8_SA(0, 0), 0, a2, k2, xa);
            PG8_BAR; PG8_WAIT_L(0); PG8_MMA(1, 0, At, B0); PG8_BAR; PG8_SCHED;
            PG8_STAGE(PG8_SB(0, 1), b2 + hstepB, voffB);
            PG8_WAIT_V(6); PG8_BAR; PG8_MMA(1, 1, At, B1); PG8_BAR;
            PG8_LDB(B0, 1, 0); PG8_SCHED; PG8_LDA(At, 1, 0); PG8_STAGE_A(PG8_SA(0, 1), 1, a2, k2, xa);
            PG8_WAIT_L(8); PG8_BAR; PG8_WAIT_L(0); PG8_MMA(0, 0, At, B0); PG8_BAR; PG8_SCHED;
            PG8_LDB(B1, 1, 1); PG8_STAGE(PG8_SB(1, 0), b3, voffB);
            PG8_BAR; PG8_WAIT_L(0); PG8_MMA(0, 1, At, B1); PG8_BAR;
            PG8_LDA(At, 1, 1); PG8_STAGE_A(PG8_SA(1, 0), 0, a3, k3, xa);
            PG8_BAR; PG8_WAIT_L(0); PG8_MMA(1, 0, At, B0); PG8_BAR; PG8_SCHED;
            PG8_STAGE(PG8_SB(1, 1), b3 + hstepB, voffB);
            PG8_WAIT_V(6); PG8_BAR; PG8_MMA(1, 1, At, B1); PG8_BAR;
        }
        if constexpr (F8) asm volatile("s_nop 7\n\ts_nop 7\n\ts_nop 7" ::: "memory");
        { const int l2 = fresh_tid(0); E(acc, cur, wr, wc, l2 & 15, l2 >> 4); }
        if (!has_next) break;
#pragma unroll
        for (int a = 0; a < 2; ++a)
#pragma unroll
            for (int b = 0; b < 2; ++b)
#pragma unroll
                for (int m = 0; m < 4; ++m)
#pragma unroll
                    for (int n = 0; n < 2; ++n) { const float zf = fresh_zero(); acc[a][b][m][n] = (f32x4){zf, zf, zf, zf}; }
        cur = nxt; cA = nA; cB = nB; ++ui;
        if constexpr (GA) { int R2[2], C2[2]; const int t2 = fresh_tid(wv); stage_rc(t2 * 16, R2[0], C2[0]); stage_rc(t2 * 16 + 8192, R2[1], C2[1]); S.aoff(cur, R2, C2, ca); }
    }
    PG8_WAIT_V(0);
    if (wr == 0) PG8_BAR;
    PG8_BAR;
#undef PG8_SA
#undef PG8_SB
#undef PG8_STAGE
#undef PG8_STAGE_A
#undef PG8_LDA
#undef PG8_LDB
#undef PG8_MMA
#undef PG8_LD32
#undef PG8_LOH
#undef PG8_HIH
#undef PG8_WAIT_V
#undef PG8_WAIT_L
#undef PG8_BAR
#undef PG8_SCHED
}
}

namespace da {
constexpr int KVBLK = 64;
constexpr float THR = 8.f;
constexpr int SHM_V = KVBLK * 128 * 2, SHM_K = KVBLK * 128 * 2, SHM_KR = KVBLK * 64 * 2;
constexpr int OFF_V = 0, OFF_K = 2 * SHM_V, OFF_WS = OFF_K + 2 * SHM_K, OFF_KR = OFF_WS + 8 * 64 * 4, OFF_QR = OFF_KR + 2 * SHM_KR, LDS_DENSE = OFF_QR + 8 * 4096;
#define KSWZ(row, colB) ((row) * 256 + ((colB) ^ (((row) & 7) << 4)))
#define KRSWZ(row, ch) ((row) * 128 + ((((ch) ^ ((row) >> 1)) & 7) << 4))
#define SBAR() __builtin_amdgcn_sched_barrier(0)
__device__ __forceinline__ int crow(int r, int hi) { return (r & 3) + 8 * (r >> 2) + 4 * hi; }
__device__ __forceinline__ int v_st(int k, int c) { const int kk = (k & ~0xC) | ((k & 4) << 1) | ((k & 8) >> 1); return ((kk >> 3) * 4 + (c >> 5)) * 512 + ((kk & 7) * 32 + (c & 31)) * 2; }
__device__ __forceinline__ int v_rd_base(int lane) { return ((lane & 3) << 3) | (((lane >> 2) & 3) << 6) | (((lane >> 4) & 1) << 5) | (((lane >> 5) & 1) << 8); }
constexpr int v_rd_off(int d0, int ks, int half) { return d0 * 512 + ks * 4096 + half * 2048; }
template <int OFF> __device__ __forceinline__ s16x4 tr_read(int vb) {
    s16x4 r; asm volatile("ds_read_b64_tr_b16 %0, %1 offset:%2" : "=&v"(r) : "v"(vb), "i"(OFF) : "memory"); return r;
}
template <int D0> __device__ __forceinline__ void pv_one(f32x16& od, int vb, bf16x8 pa0, bf16x8 pa1, bf16x8 pa2, bf16x8 pa3) {
    const s16x4 l0 = tr_read<v_rd_off(D0, 0, 0)>(vb), h0 = tr_read<v_rd_off(D0, 0, 1)>(vb), l1 = tr_read<v_rd_off(D0, 1, 0)>(vb), h1 = tr_read<v_rd_off(D0, 1, 1)>(vb);
    const s16x4 l2 = tr_read<v_rd_off(D0, 2, 0)>(vb), h2 = tr_read<v_rd_off(D0, 2, 1)>(vb), l3 = tr_read<v_rd_off(D0, 3, 0)>(vb), h3 = tr_read<v_rd_off(D0, 3, 1)>(vb);
    asm volatile("s_waitcnt lgkmcnt(0)" ::: "memory"); SBAR();
#define PK(L, H) (bf16x8){L[0], L[1], L[2], L[3], H[0], H[1], H[2], H[3]}
    od = __builtin_amdgcn_mfma_f32_32x32x16_bf16(pa0, PK(l0, h0), od, 0, 0, 0);
    od = __builtin_amdgcn_mfma_f32_32x32x16_bf16(pa1, PK(l1, h1), od, 0, 0, 0);
    od = __builtin_amdgcn_mfma_f32_32x32x16_bf16(pa2, PK(l2, h2), od, 0, 0, 0);
    od = __builtin_amdgcn_mfma_f32_32x32x16_bf16(pa3, PK(l3, h3), od, 0, 0, 0);
}
__device__ __forceinline__ void pv_d0(f32x16* o, int vb, bf16x8 pa0, bf16x8 pa1, bf16x8 pa2, bf16x8 pa3) {
    pv_one<0>(o[0], vb, pa0, pa1, pa2, pa3); pv_one<1>(o[1], vb, pa0, pa1, pa2, pa3); pv_one<2>(o[2], vb, pa0, pa1, pa2, pa3); pv_one<3>(o[3], vb, pa0, pa1, pa2, pa3);
}
template <int D0> __device__ __forceinline__ void pv_one32(f32x16& od, int vb, bf16x8 pa0, bf16x8 pa1) {
    const s16x4 l0 = tr_read<v_rd_off(D0, 0, 0)>(vb), h0 = tr_read<v_rd_off(D0, 0, 1)>(vb), l1 = tr_read<v_rd_off(D0, 1, 0)>(vb), h1 = tr_read<v_rd_off(D0, 1, 1)>(vb);
    asm volatile("s_waitcnt lgkmcnt(0)" ::: "memory"); SBAR();
    od = __builtin_amdgcn_mfma_f32_32x32x16_bf16(pa0, PK(l0, h0), od, 0, 0, 0);
    od = __builtin_amdgcn_mfma_f32_32x32x16_bf16(pa1, PK(l1, h1), od, 0, 0, 0);
}
#undef PK
#define PK4(P, BASE, OUT) do { unsigned a0 = cvtpk(P[BASE + 0], P[BASE + 1]), a1 = cvtpk(P[BASE + 2], P[BASE + 3]);   \
    unsigned b0 = cvtpk(P[BASE + 4], P[BASE + 5]), b1 = cvtpk(P[BASE + 6], P[BASE + 7]);                              \
    auto r0 = __builtin_amdgcn_permlane32_swap(a0, b0, false, false); auto r1 = __builtin_amdgcn_permlane32_swap(a1, b1, false, false); \
    u32x4 w = {r0[0], r1[0], r0[1], r1[1]}; OUT = *reinterpret_cast<bf16x8*>(&w); } while (0)

template <int NDQ> struct Cst { static constexpr float SCALE = (NDQ == 8) ? 0.088388347648318440f : 0.072168783648703220f; static constexpr float C = SCALE * LOG2E; };

template <int NDQ>
__device__ __forceinline__ void partialSM(f32x16& p0, f32x16& p1, float& m_reg, float& mn, float& alpha) {
    constexpr float C = Cst<NDQ>::C, SCALE = Cst<NDQ>::SCALE;
    float pmax = p0[0];
#pragma unroll
    for (int r = 1; r < 16; ++r) pmax = fmaxf(pmax, p0[r]);
#pragma unroll
    for (int r = 0; r < 16; ++r) pmax = fmaxf(pmax, p1[r]);
    { auto rr = __builtin_amdgcn_permlane32_swap(__float_as_uint(pmax), __float_as_uint(pmax), false, false);
      pmax = fmaxf(__uint_as_float(rr[0]), __uint_as_float(rr[1])); }
    if (__builtin_expect(__all(pmax - m_reg <= THR / SCALE), 1)) { mn = m_reg; alpha = 1.f; }
    else { mn = fmaxf(m_reg, pmax); alpha = __builtin_amdgcn_exp2f((m_reg - mn) * C); m_reg = mn; }
    const float mnC = -mn * C;
#pragma unroll
    for (int r = 0; r < 16; ++r) p0[r] = fmaf(p0[r], C, mnC);
#pragma unroll
    for (int r = 0; r < 16; ++r) p1[r] = fmaf(p1[r], C, mnC);
#pragma unroll
    for (int r = 0; r < 16; ++r) p0[r] = __builtin_amdgcn_exp2f(p0[r]);
}
__device__ __forceinline__ void finishSM(f32x16& p0, f32x16& p1, float alpha, float& l_reg, bf16x8& pa0, bf16x8& pa1, bf16x8& pa2, bf16x8& pa3) {
#pragma unroll
    for (int r = 0; r < 16; ++r) p1[r] = __builtin_amdgcn_exp2f(p1[r]);
    float ps = 0;
#pragma unroll
    for (int r = 0; r < 16; ++r) ps += p0[r];
#pragma unroll
    for (int r = 0; r < 16; ++r) ps += p1[r];
    { auto rr = __builtin_amdgcn_permlane32_swap(__float_as_uint(ps), __float_as_uint(ps), false, false);
      ps = __uint_as_float(rr[0]) + __uint_as_float(rr[1]); }
    l_reg = l_reg * alpha + ps;
    PK4(p0, 0, pa0); PK4(p0, 8, pa1); PK4(p1, 0, pa2); PK4(p1, 8, pa3);
}
template <int NDQ>
__device__ __forceinline__ void qkt(f32x16& p0, f32x16& p1, const char* Ks, const char* Krs, const bf16x8* qr, const char* qrl, int r32, int hi) {
    p0 = f32x16{}; p1 = f32x16{};
#pragma unroll
    for (int d0 = 0; d0 < 8; ++d0) { const int cb = (d0 * 16 + hi * 8) * 2;
        bf16x8 b0 = *reinterpret_cast<const bf16x8*>(Ks + KSWZ(r32, cb));
        bf16x8 b1 = *reinterpret_cast<const bf16x8*>(Ks + KSWZ(32 + r32, cb));
        p0 = __builtin_amdgcn_mfma_f32_32x32x16_bf16(b0, qr[d0], p0, 0, 0, 0);
        p1 = __builtin_amdgcn_mfma_f32_32x32x16_bf16(b1, qr[d0], p1, 0, 0, 0); }
    if constexpr (NDQ == 12) {
#pragma unroll
        for (int d0 = 0; d0 < 4; ++d0) { const int ch = d0 * 2 + hi;
            bf16x8 b0 = *reinterpret_cast<const bf16x8*>(Krs + KRSWZ(r32, ch));
            bf16x8 b1 = *reinterpret_cast<const bf16x8*>(Krs + KRSWZ(32 + r32, ch));
            const bf16x8 qf = *reinterpret_cast<const bf16x8*>(qrl + d0 * 1024);
            p0 = __builtin_amdgcn_mfma_f32_32x32x16_bf16(b0, qf, p0, 0, 0, 0);
            p1 = __builtin_amdgcn_mfma_f32_32x32x16_bf16(b1, qf, p1, 0, 0, 0); }
    }
}

struct DArgs { const bf16_t* Q; const bf16_t* K; const bf16_t* V; const bf16_t* Kr; bf16_t* O; int ldq, ldk, ldv, ldo; int seq; int pos0; };

template <int NDQ, int SDEPTH>
__device__ __forceinline__ void attn_dense_body(int wv, const DArgs a, char* lds) {
    const int tid = fresh_tid(wv), wid = tid >> 6, lane = tid & 63, r32 = lane & 31, hi = lane >> 5;
    char* V_lds = lds + OFF_V; char* K_lds = lds + OFF_K; char* Kr_lds = lds + OFF_KR;
    float* ws = (float*)(lds + OFF_WS) + wid * 64; float* li_l = ws; float* al_l = ws + 32;
    float m_reg = -1e30f, l_reg = 0; f32x16 o[4] = {}; bf16x8 qr[8];
    char* qrl = lds + OFF_QR + wid * 4096 + lane * 16;
    const bf16_t* Qw = a.Q + (long)(wid * 32 + r32) * a.ldq + hi * 8;
#pragma unroll
    for (int d0 = 0; d0 < 8; ++d0) qr[d0] = *reinterpret_cast<const bf16x8*>(Qw + d0 * 16);
    if constexpr (NDQ == 12) {
        const float pos = (float)(a.pos0 + wid * 32 + r32);
#pragma unroll
        for (int f = 0; f < 2; ++f) {
            const bf16x8 x1v = *reinterpret_cast<const bf16x8*>(Qw + (8 + f) * 16), x2v = *reinterpret_cast<const bf16x8*>(Qw + (10 + f) * 16); bf16x8 y1v, y2v;
#pragma unroll
            for (int j = 0; j < 8; ++j) { const int i = f * 16 + hi * 8 + j; float sn, cs; sincos_rev(pos * inv_freq32(i), sn, cs);
                const float x1 = bf2f((unsigned short)x1v[j]), x2 = bf2f((unsigned short)x2v[j]);
                y1v[j] = (short)f2bf(x1 * cs - x2 * sn); y2v[j] = (short)f2bf(x2 * cs + x1 * sn); }
            *reinterpret_cast<bf16x8*>(qrl + f * 1024) = y1v; *reinterpret_cast<bf16x8*>(qrl + (2 + f) * 1024) = y2v;
        }
    }
    const int sr = tid >> 4, sc = (tid & 15) * 8, vst0 = v_st(sr, sc), vst1 = v_st(32 + sr, sc);
    const int krr = tid >> 3, krc = tid & 7;
    const int vb0 = (int)(uintptr_t)V_lds + v_rd_base(lane);
    struct { bf16x8 vs0, vs1, ks0, ks1, kr; } sr_[SDEPTH];
#define SLOAD(i, k0) do { sr_[i].vs0 = *(const bf16x8*)(a.V + (long)((k0) + sr) * a.ldv + sc); sr_[i].vs1 = *(const bf16x8*)(a.V + (long)((k0) + 32 + sr) * a.ldv + sc); \
    sr_[i].ks0 = *(const bf16x8*)(a.K + (long)((k0) + sr) * a.ldk + sc); sr_[i].ks1 = *(const bf16x8*)(a.K + (long)((k0) + 32 + sr) * a.ldk + sc); \
    if constexpr (NDQ == 12) sr_[i].kr = *(const bf16x8*)(a.Kr + (long)((k0) + krr) * 64 + krc * 8); } while (0)
#define SWRITE(b, i) do { *(bf16x8*)(V_lds + (b) * SHM_V + vst0) = sr_[i].vs0; *(bf16x8*)(V_lds + (b) * SHM_V + vst1) = sr_[i].vs1; const int kc = sc * 2; \
    *(bf16x8*)(K_lds + (b) * SHM_K + KSWZ(sr, kc)) = sr_[i].ks0; *(bf16x8*)(K_lds + (b) * SHM_K + KSWZ(32 + sr, kc)) = sr_[i].ks1; \
    if constexpr (NDQ == 12) *(bf16x8*)(Kr_lds + (b) * SHM_KR + KRSWZ(krr, krc)) = sr_[i].kr; } while (0)
#define SWAIT() do { if constexpr (SDEPTH == 2) { if constexpr (NDQ == 12) asm volatile("s_waitcnt vmcnt(5)" ::: "memory"); else asm volatile("s_waitcnt vmcnt(4)" ::: "memory"); } else asm volatile("s_waitcnt vmcnt(0)" ::: "memory"); } while (0)
#define RESC(al) do { if (__any((al) < 1.f)) { if (hi == 0) al_l[r32] = (al); asm volatile("s_waitcnt lgkmcnt(0)" ::: "memory"); \
    _Pragma("unroll") for (int d = 0; d < 4; ++d) _Pragma("unroll") for (int r = 0; r < 16; ++r) o[d][r] *= al_l[crow(r, hi)]; } } while (0)
    f32x16 pA0, pA1, pB0, pB1; float mnA, mnB, alA, alB; bf16x8 pa0, pa1, pa2, pa3; const int NT = a.seq / KVBLK;
    constexpr int SE = 0, SO = SDEPTH - 1;
    SLOAD(SE, 0); asm volatile("s_waitcnt vmcnt(0)" ::: "memory"); SWRITE(0, SE); __syncthreads();
    qkt<NDQ>(pA0, pA1, K_lds, Kr_lds, qr, qrl, r32, hi); partialSM<NDQ>(pA0, pA1, m_reg, mnA, alA);
    SLOAD(SO, KVBLK); if constexpr (SDEPTH == 2) { if (2 < NT) SLOAD(SE, 2 * KVBLK); }
    SWAIT(); SWRITE(1, SO); __syncthreads();
#pragma unroll 1
    for (int j = 1; j + 1 < NT; j += 2) {
        SBAR(); qkt<NDQ>(pB0, pB1, K_lds + SHM_K, Kr_lds + SHM_KR, qr, qrl, r32, hi);
        finishSM(pA0, pA1, alA, l_reg, pa0, pa1, pa2, pa3); SBAR();
        SLOAD(SO, (j + SDEPTH) * KVBLK); SBAR();
        pv_d0(o, vb0, pa0, pa1, pa2, pa3); partialSM<NDQ>(pB0, pB1, m_reg, mnB, alB);
        __syncthreads(); SWAIT(); SWRITE(0, SE);
        RESC(alB); __syncthreads();
        SBAR(); qkt<NDQ>(pA0, pA1, K_lds, Kr_lds, qr, qrl, r32, hi);
        finishSM(pB0, pB1, alB, l_reg, pa0, pa1, pa2, pa3); SBAR();
        if (SDEPTH == 1 || j + 3 < NT) SLOAD(SE, (j + 1 + SDEPTH) * KVBLK); SBAR();
        pv_d0(o, vb0 + (int)SHM_V, pa0, pa1, pa2, pa3); partialSM<NDQ>(pA0, pA1, m_reg, mnA, alA);
        __syncthreads(); SWAIT(); SWRITE(1, SO);
        RESC(alA); __syncthreads();
    }
    SBAR(); qkt<NDQ>(pB0, pB1, K_lds + SHM_K, Kr_lds + SHM_KR, qr, qrl, r32, hi);
    finishSM(pA0, pA1, alA, l_reg, pa0, pa1, pa2, pa3); SBAR();
    pv_d0(o, vb0, pa0, pa1, pa2, pa3); partialSM<NDQ>(pB0, pB1, m_reg, mnB, alB);
    __syncthreads(); RESC(alB);
    finishSM(pB0, pB1, alB, l_reg, pa0, pa1, pa2, pa3); SBAR();
    pv_d0(o, vb0 + (int)SHM_V, pa0, pa1, pa2, pa3);
    if (hi == 0) li_l[r32] = l_reg; asm volatile("s_waitcnt lgkmcnt(0)" ::: "memory");
    float rli[16];
#pragma unroll
    for (int r = 0; r < 16; ++r) rli[r] = __builtin_amdgcn_rcpf(li_l[crow(r, hi)]);
    bf16_t* Ow = F8_OUT ? (bf16_t*)((unsigned char*)a.O + (long)(wid * 32) * a.ldo) : a.O + (long)(wid * 32) * a.ldo;
#pragma unroll
    for (int r = 0; r < 16; ++r) { const int orow = crow(r, hi);
#pragma unroll
        for (int d0 = 0; d0 < 4; ++d0) { if constexpr (F8_OUT) ((unsigned char*)Ow)[(long)orow * a.ldo + d0 * 32 + r32] = f2fp8(o[d0][r] * rli[r] * O8_SCALE); else Ow[(long)orow * a.ldo + d0 * 32 + r32] = f2bf(o[d0][r] * rli[r]); } }
#undef SLOAD
#undef SWRITE
#undef SWAIT
#undef RESC
}

constexpr int SP_WAVE_LDS = 18688;
template <class P>
__device__ __forceinline__ void sparse_wave(P& pol, LAS unsigned char* wll, int lane) {
    const int r32 = lane & 31, hi = lane >> 5;
    char* wl = (char*)wll;
    char* Kl = wl; char* Vl = wl + 8192; float* li_l = (float*)(wl + 16384); float* al_l = li_l + 32;
    bf16x8 qr[8];
    { const bf16_t* qp = pol.qptr(r32) + hi * 8;
#pragma unroll
      for (int d0 = 0; d0 < 8; ++d0) qr[d0] = *reinterpret_cast<const bf16x8*>(qp + d0 * 16); }
    asm volatile("s_waitcnt vmcnt(0)" ::: "memory");
    f32x16 o[4] = {}; float m_reg = -1e30f, l_reg = 0.f;
    const int krow0 = lane >> 4;
    const int kce = (((lane & 15) ^ (krow0 & 7)) * 8), kco = (((lane & 15) ^ ((4 + krow0) & 7)) * 8);
    const int vk0 = 8 * ((lane >> 4) & 1) + ((lane >> 2) & 3), vc0 = 32 * (lane >> 5) + 8 * (lane & 3);
    const int vb = (int)(uintptr_t)Vl + v_rd_base(lane);
    const int nt = pol.ntiles();
    typename P::TI ti, tn;
#define SP_DMA_K(T) do { _Pragma("unroll") for (int i = 0; i < 8; ++i) { const bf16_t* src = (T).k + (long)(4 * i + krow0) * (T).rs + ((i & 1) ? kco : kce); \
        __builtin_amdgcn_global_load_lds((const unsigned*)src, (LAS unsigned*)(wll + i * 1024), 16, 0, 0); } } while (0)
#define SP_DMA_V(T) do { _Pragma("unroll") for (int i = 0; i < 8; ++i) { const bf16_t* src = (T).v + (long)(16 * (i >> 2) + 4 * ((i >> 1) & 1) + vk0) * (T).rs + 64 * (i & 1) + vc0; \
        __builtin_amdgcn_global_load_lds((const unsigned*)src, (LAS unsigned*)(wll + 8192 + i * 1024), 16, 0, 0); } } while (0)
    pol.tile(0, ti);
    SP_DMA_K(ti); SP_DMA_V(ti);
#pragma unroll 1
    for (int j = 0; j < nt; ++j) {
        const bool more = (j + 1 < nt);
        if (more) pol.tile(j + 1, tn);
        asm volatile("s_waitcnt vmcnt(8)" ::: "memory");
        f32x16 p = f32x16{};
#pragma unroll
        for (int d0 = 0; d0 < 8; ++d0) { const int cb = (d0 * 16 + hi * 8) * 2;
            bf16x8 b0 = *reinterpret_cast<const bf16x8*>(Kl + KSWZ(r32, cb));
            p = __builtin_amdgcn_mfma_f32_32x32x16_bf16(b0, qr[d0], p, 0, 0, 0); }
        asm volatile("s_waitcnt lgkmcnt(0)" ::: "memory"); SBAR();
        if (more) SP_DMA_K(tn);
        SBAR();
        float pmax = -INFINITY;
#pragma unroll
        for (int r = 0; r < 16; ++r) { p[r] = pol.adj(ti, crow(r, hi), p[r]); pmax = fmaxf(pmax, p[r]); }
        { auto rr = __builtin_amdgcn_permlane32_swap(__float_as_uint(pmax), __float_as_uint(pmax), false, false);
          pmax = fmaxf(__uint_as_float(rr[0]), __uint_as_float(rr[1])); }
        const float mn = fmaxf(m_reg, pmax); const float alpha = __builtin_amdgcn_exp2f(m_reg - mn); m_reg = mn;
        float ps = 0.f;
#pragma unroll
        for (int r = 0; r < 16; ++r) { p[r] = __builtin_amdgcn_exp2f(p[r] - mn); ps += p[r]; }
        { auto rr = __builtin_amdgcn_permlane32_swap(__float_as_uint(ps), __float_as_uint(ps), false, false);
          ps = __uint_as_float(rr[0]) + __uint_as_float(rr[1]); }
        l_reg = l_reg * alpha + ps;
        if (__any(alpha < 1.f)) { if (hi == 0) al_l[r32] = alpha; asm volatile("s_waitcnt lgkmcnt(0)" ::: "memory");
#pragma unroll
            for (int d = 0; d < 4; ++d)
#pragma unroll
                for (int r = 0; r < 16; ++r) o[d][r] *= al_l[crow(r, hi)]; }
        bf16x8 pa0, pa1; PK4(p, 0, pa0); PK4(p, 8, pa1);
        SBAR();
        if (more) asm volatile("s_waitcnt vmcnt(8)" ::: "memory"); else asm volatile("s_waitcnt vmcnt(0)" ::: "memory");
        SBAR();
        pv_one32<0>(o[0], vb, pa0, pa1); pv_one32<1>(o[1], vb, pa0, pa1); pv_one32<2>(o[2], vb, pa0, pa1); pv_one32<3>(o[3], vb, pa0, pa1);
        SBAR();
        if (more) SP_DMA_V(tn);
        SBAR();
        ti = tn;
    }
#undef SP_DMA_K
#undef SP_DMA_V
    if (hi == 0) li_l[r32] = l_reg; asm volatile("s_waitcnt lgkmcnt(0)" ::: "memory");
#pragma unroll
    for (int r = 0; r < 16; ++r) { const int qn = crow(r, hi); const float rl = __builtin_amdgcn_rcpf(li_l[qn]); bf16_t* op = pol.optr(qn);
#pragma unroll
        for (int d0 = 0; d0 < 4; ++d0) { if constexpr (F8_OUT) ((unsigned char*)op)[d0 * 32 + r32] = f2fp8(o[d0][r] * rl * O8_SCALE); else op[d0 * 32 + r32] = f2bf(o[d0][r] * rl); } }
}
#undef PK4
}

#define SBAR() __builtin_amdgcn_sched_barrier(0)
namespace d8 {
constexpr int K8_BYTES = 64 * 128, KR8_BYTES = 64 * 64, VT_PITCH = 80, VT_BYTES = 128 * VT_PITCH;
constexpr int OFF_K8 = 0, OFF_KR8 = 2 * K8_BYTES, OFF_VT = OFF_KR8 + 2 * KR8_BYTES, OFF_WS8 = OFF_VT + 2 * VT_BYTES, LDS_D8 = OFF_WS8 + 8 * 64 * 4;
constexpr float THR8 = 4.f;
#define K8SWZ(row, ch) ((row) * 128 + ((((ch) ^ ((row) >> 1)) & 7) << 4))
#define KR8SWZ(row, ch) ((row) * 64 + ((((ch) ^ ((row) >> 2)) & 3) << 4))
__device__ __forceinline__ int krow_of(int a) { const int hi = a >> 5, j = a & 31; return da::crow(j & 15, hi) + 32 * (j >> 4); }
struct D8Args { const bf16_t* Q; const unsigned char* K8; const unsigned char* Kr8; const unsigned char* Vt8; bf16_t* O; int ldq, ldk, ldvt, ldo; int seq; int pos0; };
template <int NKS> struct Cst8 { static constexpr float SCALE = (NKS == 2) ? 0.088388347648318440f : 0.072168783648703220f; static constexpr float C = SCALE * LOG2E; };
#define D8_LD32(dst, p) do { const i32x4 _lo = *(const i32x4*)(p), _hi = *(const i32x4*)((p) + 16); dst = __builtin_shufflevector(_lo, _hi, 0, 1, 2, 3, 4, 5, 6, 7); } while (0)
#define D8_MX(a, b, c) __builtin_amdgcn_mfma_scale_f32_32x32x64_f8f6f4(a, b, c, 0, 0, 0, 0x7f7f7f7f, 0, 0x7f7f7f7f)
template <int NKS>
__device__ __forceinline__ void qkt8(f32x16& p0, f32x16& p1, const char* Ks, const char* Krs, const i32x8* qf, int r32, int hi) {
    p0 = f32x16{}; p1 = f32x16{};
#pragma unroll
    for (int sK = 0; sK < 2; ++sK) { i32x8 a0, a1; const int ch = 4 * sK + 2 * hi;
        { const i32x4 lo = *(const i32x4*)(Ks + K8SWZ(r32, ch)), hh = *(const i32x4*)(Ks + K8SWZ(r32, ch + 1)); a0 = __builtin_shufflevector(lo, hh, 0, 1, 2, 3, 4, 5, 6, 7); }
        { const i32x4 lo = *(const i32x4*)(Ks + K8SWZ(32 + r32, ch)), hh = *(const i32x4*)(Ks + K8SWZ(32 + r32, ch + 1)); a1 = __builtin_shufflevector(lo, hh, 0, 1, 2, 3, 4, 5, 6, 7); }
        p0 = D8_MX(a0, qf[sK], p0); p1 = D8_MX(a1, qf[sK], p1); }
    if constexpr (NKS == 3) { i32x8 a0, a1; const int ch = 2 * hi;
        { const i32x4 lo = *(const i32x4*)(Krs + KR8SWZ(r32, ch)), hh = *(const i32x4*)(Krs + KR8SWZ(r32, ch + 1)); a0 = __builtin_shufflevector(lo, hh, 0, 1, 2, 3, 4, 5, 6, 7); }
        { const i32x4 lo = *(const i32x4*)(Krs + KR8SWZ(32 + r32, ch)), hh = *(const i32x4*)(Krs + KR8SWZ(32 + r32, ch + 1)); a1 = __builtin_shufflevector(lo, hh, 0, 1, 2, 3, 4, 5, 6, 7); }
        p0 = D8_MX(a0, qf[2], p0); p1 = D8_MX(a1, qf[2], p1); }
}
template <int NKS>
__device__ __forceinline__ void partialSM8(f32x16& p0, f32x16& p1, float& m_reg, float& mn, float& alpha) {
    constexpr float C = Cst8<NKS>::C, SCALE = Cst8<NKS>::SCALE;
    float pmax = p0[0];
#pragma unroll
    for (int r = 1; r < 16; ++r) pmax = fmaxf(pmax, p0[r]);
#pragma unroll
    for (int r = 0; r < 16; ++r) pmax = fmaxf(pmax, p1[r]);
    { auto rr = __builtin_amdgcn_permlane32_swap(__float_as_uint(pmax), __float_as_uint(pmax), false, false);
      pmax = fmaxf(__uint_as_float(rr[0]), __uint_as_float(rr[1])); }
    if (__builtin_expect(__all(pmax - m_reg <= THR8 / SCALE), 1)) { mn = m_reg; alpha = 1.f; }
    else { mn = fmaxf(m_reg, pmax); alpha = __builtin_amdgcn_exp2f((m_reg - mn) * C); m_reg = mn; }
    const float mnC = -mn * C;
#pragma unroll
    for (int r = 0; r < 16; ++r) p0[r] = fmaf(p0[r], C, mnC);
#pragma unroll
    for (int r = 0; r < 16; ++r) p1[r] = fmaf(p1[r], C, mnC);
#pragma unroll
    for (int r = 0; r < 16; ++r) p0[r] = __builtin_amdgcn_exp2f(p0[r]);
}
__device__ __forceinline__ void finishSM8(f32x16& p0, f32x16& p1, float alpha, float& l_reg, i32x8& pa) {
#pragma unroll
    for (int r = 0; r < 16; ++r) p1[r] = __builtin_amdgcn_exp2f(p1[r]);
    float ps = 0;
#pragma unroll
    for (int r = 0; r < 16; ++r) ps += p0[r];
#pragma unroll
    for (int r = 0; r < 16; ++r) ps += p1[r];
    { auto rr = __builtin_amdgcn_permlane32_swap(__float_as_uint(ps), __float_as_uint(ps), false, false);
      ps = __uint_as_float(rr[0]) + __uint_as_float(rr[1]); }
    l_reg = l_reg * alpha + ps;
    pa = (i32x8){(int)pk4_fp8(p0[0], p0[1], p0[2], p0[3]), (int)pk4_fp8(p0[4], p0[5], p0[6], p0[7]), (int)pk4_fp8(p0[8], p0[9], p0[10], p0[11]), (int)pk4_fp8(p0[12], p0[13], p0[14], p0[15]),
                 (int)pk4_fp8(p1[0], p1[1], p1[2], p1[3]), (int)pk4_fp8(p1[4], p1[5], p1[6], p1[7]), (int)pk4_fp8(p1[8], p1[9], p1[10], p1[11]), (int)pk4_fp8(p1[12], p1[13], p1[14], p1[15])};
}
__device__ __forceinline__ void pv8(f32x16* o, const char* Vt, const i32x8 pa, int r32, int hi) {
#pragma unroll
    for (int d0 = 0; d0 < 4; ++d0) { const char* vp = Vt + (32 * d0 + r32) * VT_PITCH + 32 * hi; i32x8 bfr;
        { const i32x4 lo = *(const i32x4*)vp, hh = *(const i32x4*)(vp + 16); bfr = __builtin_shufflevector(lo, hh, 0, 1, 2, 3, 4, 5, 6, 7); }
        o[d0] = D8_MX(pa, bfr, o[d0]); }
}
template <int NKS>
__device__ __forceinline__ void attn_dense8_body(int wv, const D8Args a, char* lds) {
    const int tid = fresh_tid(wv), wid = tid >> 6, lane = tid & 63, r32 = lane & 31, hi = lane >> 5;
    char* K_lds = lds + OFF_K8; char* Kr_lds = lds + OFF_KR8; char* Vt_lds = lds + OFF_VT;
    float* ws = (float*)(lds + OFF_WS8) + wid * 64; float* li_l = ws; float* al_l = ws + 32;
    float m_reg = -1e30f, l_reg = 0; f32x16 o[4] = {}; i32x8 qf[NKS];
    { const bf16_t* Qw = a.Q + (long)(wid * 32 + r32) * a.ldq;
#pragma unroll
      for (int sK = 0; sK < 2; ++sK) { const bf16_t* qp = Qw + 64 * sK + 32 * hi; unsigned w[8];
#pragma unroll
          for (int c = 0; c < 4; ++c) { const u32x4 v = *(const u32x4*)(qp + 8 * c);
              w[2 * c] = pk4_fp8(bflo(v.x), bfhi(v.x), bflo(v.y), bfhi(v.y)); w[2 * c + 1] = pk4_fp8(bflo(v.z), bfhi(v.z), bflo(v.w), bfhi(v.w)); }
          qf[sK] = (i32x8){(int)w[0], (int)w[1], (int)w[2], (int)w[3], (int)w[4], (int)w[5], (int)w[6], (int)w[7]}; }
      if constexpr (NKS == 3) {
          const float pos = (float)(a.pos0 + wid * 32 + r32); const bf16_t* qp = Qw + 128; unsigned w[8];
#pragma unroll
          for (int c = 0; c < 4; ++c) { const u32x4 v1 = *(const u32x4*)(qp + 8 * c), v2 = *(const u32x4*)(qp + 32 + 8 * c);
              const unsigned a1[4] = {v1.x, v1.y, v1.z, v1.w}, a2[4] = {v2.x, v2.y, v2.z, v2.w}; float y[8];
#pragma unroll
              for (int e = 0; e < 8; ++e) { const int i = 8 * c + e; float sn, cs; sincos_rev(pos * inv_freq32(i), sn, cs);
                  const float x1 = (e & 1) ? bfhi(a1[e >> 1]) : bflo(a1[e >> 1]), x2 = (e & 1) ? bfhi(a2[e >> 1]) : bflo(a2[e >> 1]);
                  y[e] = hi ? (x2 * cs + x1 * sn) : (x1 * cs - x2 * sn); }
              w[2 * c] = pk4_fp8(y[0], y[1], y[2], y[3]); w[2 * c + 1] = pk4_fp8(y[4], y[5], y[6], y[7]); }
          qf[2] = (i32x8){(int)w[0], (int)w[1], (int)w[2], (int)w[3], (int)w[4], (int)w[5], (int)w[6], (int)w[7]}; } }
    const int ka = tid >> 3, kch = tid & 7, kdst = K8SWZ(krow_of(ka), kch);
    const int vc = tid >> 2, vq = tid & 3, vdst = vc * VT_PITCH + vq * 16;
    const int ra = (tid >> 2) & 63, rch = tid & 3, rdst = KR8SWZ(krow_of(ra), rch);
    struct { u32x4 k, v, r; } sr_[2];
#define SLOAD8(i, k0) do { sr_[i].k = *(const u32x4*)(a.K8 + (long)((k0) + ka) * a.ldk + kch * 16); sr_[i].v = *(const u32x4*)(a.Vt8 + (long)vc * a.ldvt + (k0) + vq * 16); \
    if constexpr (NKS == 3) sr_[i].r = *(const u32x4*)(a.Kr8 + (long)((k0) + ra) * 64 + rch * 16); } while (0)
#define SWRITE8(b, i) do { *(u32x4*)(K_lds + (b) * K8_BYTES + kdst) = sr_[i].k; *(u32x4*)(Vt_lds + (b) * VT_BYTES + vdst) = sr_[i].v; \
    if constexpr (NKS == 3) *(u32x4*)(Kr_lds + (b) * KR8_BYTES + rdst) = sr_[i].r; } while (0)
#define RESC8(al) do { if (__any((al) < 1.f)) { if (hi == 0) al_l[r32] = (al); asm volatile("s_waitcnt lgkmcnt(0)" ::: "memory"); \
    _Pragma("unroll") for (int d = 0; d < 4; ++d) _Pragma("unroll") for (int r = 0; r < 16; ++r) o[d][r] *= al_l[da::crow(r, hi)]; } } while (0)
    f32x16 pA0, pA1, pB0, pB1; float mnA, mnB, alA, alB; i32x8 pa; const int NT = a.seq / 64;
    SLOAD8(0, 0); asm volatile("s_waitcnt vmcnt(0)" ::: "memory"); SWRITE8(0, 0); __syncthreads();
    qkt8<NKS>(pA0, pA1, K_lds, Kr_lds, qf, r32, hi); partialSM8<NKS>(pA0, pA1, m_reg, mnA, alA);
    SLOAD8(1, 64); if (2 < NT) SLOAD8(0, 128);
    if constexpr (NKS == 3) asm volatile("s_waitcnt vmcnt(3)" ::: "memory"); else asm volatile("s_waitcnt vmcnt(2)" ::: "memory");
    SWRITE8(1, 1); __syncthreads();
#pragma unroll 1
    for (int j = 1; j + 1 < NT; j += 2) {
        SBAR(); qkt8<NKS>(pB0, pB1, K_lds + K8_BYTES, Kr_lds + KR8_BYTES, qf, r32, hi);
        finishSM8(pA0, pA1, alA, l_reg, pa); SBAR();
        SLOAD8(1, (j + 2) * 64); SBAR();
        pv8(o, Vt_lds, pa, r32, hi); partialSM8<NKS>(pB0, pB1, m_reg, mnB, alB);
        __syncthreads(); if constexpr (NKS == 3) asm volatile("s_waitcnt vmcnt(3)" ::: "memory"); else asm volatile("s_waitcnt vmcnt(2)" ::: "memory");
        SWRITE8(0, 0);
        RESC8(alB); __syncthreads();
        SBAR(); qkt8<NKS>(pA0, pA1, K_lds, Kr_lds, qf, r32, hi);
        finishSM8(pB0, pB1, alB, l_reg, pa); SBAR();
        if (j + 3 < NT) SLOAD8(0, (j + 3) * 64); SBAR();
        pv8(o, Vt_lds + VT_BYTES, pa, r32, hi); partialSM8<NKS>(pA0, pA1, m_reg, mnA, alA);
        __syncthreads(); if constexpr (NKS == 3) asm volatile("s_waitcnt vmcnt(3)" ::: "memory"); else asm volatile("s_waitcnt vmcnt(2)" ::: "memory");
        SWRITE8(1, 1);
        RESC8(alA); __syncthreads();
    }
    SBAR(); qkt8<NKS>(pB0, pB1, K_lds + K8_BYTES, Kr_lds + KR8_BYTES, qf, r32, hi);
    finishSM8(pA0, pA1, alA, l_reg, pa); SBAR();
    pv8(o, Vt_lds, pa, r32, hi); partialSM8<NKS>(pB0, pB1, m_reg, mnB, alB);
    __syncthreads(); RESC8(alB);
    finishSM8(pB0, pB1, alB, l_reg, pa); SBAR();
    pv8(o, Vt_lds + VT_BYTES, pa, r32, hi);
    if (hi == 0) li_l[r32] = l_reg; asm volatile("s_waitcnt lgkmcnt(0)" ::: "memory");
    float rli[16];
#pragma unroll
    for (int r = 0; r < 16; ++r) rli[r] = __builtin_amdgcn_rcpf(li_l[da::crow(r, hi)]);
    bf16_t* Ow = F8_OUT ? (bf16_t*)((unsigned char*)a.O + (long)(wid * 32) * a.ldo) : a.O + (long)(wid * 32) * a.ldo;
#pragma unroll
    for (int r = 0; r < 16; ++r) { const int orow = da::crow(r, hi);
#pragma unroll
        for (int d0 = 0; d0 < 4; ++d0) { if constexpr (F8_OUT) ((unsigned char*)Ow)[(long)orow * a.ldo + d0 * 32 + r32] = f2fp8(o[d0][r] * rli[r] * O8_SCALE); else Ow[(long)orow * a.ldo + d0 * 32 + r32] = f2bf(o[d0][r] * rli[r]); } }
#undef SLOAD8
#undef SWRITE8
#undef RESC8
}
#undef D8_LD32
#undef D8_MX
}


struct PolB {
    struct TI { const bf16_t* k; const bf16_t* v; long rs; int kpos0; int iq; float cd; };
    const bf16_t* H0; bf16_t* O; int b, h, a, r16, myn; int lo3, n3, lo2, n2, lo1, n1; float slope2;
    __device__ __forceinline__ void init(const bf16_t* H0_, bf16_t* O_, int w, int lane) {
        H0 = H0_; O = O_; b = w >> 10; h = (w >> 7) & 7; const int wu = w & 127; a = wu >> 4; r16 = wu & 15; myn = lane & 31;
        lo3 = max(a - 2, 0); n3 = min(a + 2, 7) - lo3 + 1;
        lo2 = max(4 * a - 2, 0); n2 = min(4 * a + 5, 31) - lo2 + 1;
        lo1 = max(16 * a - 2, 0); n1 = min(16 * a + 17, 127) - lo1 + 1;
        slope2 = __builtin_amdgcn_exp2f(-(float)(h + 1)) * LOG2E;
    }
    __device__ __forceinline__ const bf16_t* qptr(int n) const { return H0 + (long)(b * SEQ + 512 * a + r16 + 16 * n) * IN0 + 1536 + h * 128; }
    __device__ __forceinline__ bf16_t* optr(int qn) const { const long e = (long)(b * SEQ + 512 * a + r16 + 16 * qn) * DM + 1024 + h * 128; return F8_OUT ? (bf16_t*)((unsigned char*)O + e) : O + e; }
    __device__ __forceinline__ int ntiles() const { return n3 + n2 + n1; }
    __device__ __forceinline__ void tile(int j, TI& ti) const {
        int dil, kt, rd;
        if (j < n3) { dil = 16; kt = lo3 + j; rd = r16; }
        else if (j < n3 + n2) { dil = 4; kt = lo2 + (j - n3); rd = r16 & 3; }
        else { dil = 1; kt = lo1 + (j - n3 - n2); rd = 0; }
        const long tok = (long)b * SEQ + dil * 32 * kt + rd;
        ti.k = H0 + tok * IN0 + 2560 + h * 128; ti.v = H0 + tok * IN0 + 3584 + h * 128; ti.rs = (long)dil * IN0;
        ti.kpos0 = 32 * kt; ti.iq = (512 * a + r16 + 16 * myn - rd) / dil; ti.cd = slope2 * (float)dil;
    }
    __device__ __forceinline__ float adj(const TI& ti, int kloc, float s) const {
        const int d = ti.kpos0 + kloc - ti.iq; const int ad = d < 0 ? -d : d;
        return ad <= 64 ? fmaf(s, 0.088388347648318440f * LOG2E, -ti.cd * (float)ad) : -INFINITY;
    }
};
struct PolC {
    struct TI { const bf16_t* k; const bf16_t* v; long rs; int kc0; int drow; };
    const bf16_t* H1; bf16_t* O; const float* tab; int b, h, r, a, r0, qc, c0;
    __device__ __forceinline__ void init(const bf16_t* H1_, bf16_t* O_, const float* rpb, float* tab_, int w, int lane) {
        H1 = H1_; O = O_; tab = tab_; b = w >> 10; h = (w >> 7) & 7; const int wu = w & 127; r = wu >> 1; a = wu & 1;
        r0 = min(max(r - 4, 0), 56); qc = 32 * a + (lane & 31); c0 = min(max(qc - 8, 0), 48);
        for (int idx = lane; idx < 480; idx += 64) { const int dr = idx >> 5, dc = idx & 31; tab_[idx] = dc < 31 ? rpb[h * 465 + dr * 31 + dc] * LOG2E : 0.f; }
        asm volatile("s_waitcnt vmcnt(0) lgkmcnt(0)" ::: "memory");
    }
    __device__ __forceinline__ const bf16_t* qptr(int n) const { return H1 + (long)(b * SEQ + 64 * r + 32 * a + n) * IN1P + h * 128; }
    __device__ __forceinline__ bf16_t* optr(int qn) const { const long e = (long)(b * SEQ + 64 * r + 32 * a + qn) * DM + h * 128; return F8_OUT ? (bf16_t*)((unsigned char*)O + e) : O + e; }
    __device__ __forceinline__ int ntiles() const { return 16; }
    __device__ __forceinline__ void tile(int j, TI& ti) const {
        const int kr = r0 + (j >> 1), ch = j & 1; const long tok = (long)b * SEQ + 64 * kr + 32 * ch;
        ti.k = H1 + tok * IN1P + 1024 + h * 128; ti.v = H1 + tok * IN1P + 2048 + h * 128; ti.rs = IN1P; ti.kc0 = 32 * ch; ti.drow = kr - r + 7;
    }
    __device__ __forceinline__ float adj(const TI& ti, int kloc, float s) const {
        const int kc = ti.kc0 + kloc; const int dc = min(max(kc - qc + 15, 0), 30);
        const float bias = tab[ti.drow * 32 + dc];
        return (kc >= c0 && kc < c0 + 16) ? fmaf(s, 0.088388347648318440f * LOG2E, bias) : -INFINITY;
    }
};

struct Params { const float* in[28]; float* out; unsigned char* ws; int ph_lo, ph_hi; };
enum { I_X = 0, I_RW = 1, I_RB = 2, I_WIN0 = 3, I_AQN = 4, I_AKN = 5, I_WOUT0 = 6, I_LN1G0 = 7, I_LN1B0 = 8, I_WG0 = 9, I_WU0 = 10, I_WD0 = 11, I_LN2G0 = 12, I_LN2B0 = 13,
       I_WIN1 = 14, I_RPB = 15, I_DQN = 16, I_WQUP = 17, I_DKVN = 18, I_WKVUP = 19, I_WOUT1 = 20, I_LN1G1 = 21, I_LN1B1 = 22, I_WG1 = 23, I_WU1 = 24, I_WD1 = 25, I_LN2G1 = 26, I_LN2B1 = 27 };

__device__ __forceinline__ void tr_tile(const float* __restrict__ src, int N, const float* __restrict__ ksc, bf16_t* __restrict__ dst, int ldd, int k0, int n0, int drow0, LAS unsigned* tl, int tid) {
    const int c4 = (tid & 15) * 4;
#pragma unroll
    for (int i = 0; i < 2; ++i) {
        const int kp = (tid >> 4) + 32 * i;
        const float* s0 = src + (size_t)(k0 + 2 * kp) * N + n0 + c4;
        f32x4 a = *(const f32x4*)s0, b = *(const f32x4*)(s0 + N);
        if (ksc) { const float sa = ksc[k0 + 2 * kp], sb = ksc[k0 + 2 * kp + 1]; a *= sa; b *= sb; }
#pragma unroll
        for (int j = 0; j < 4; ++j) tl[(c4 + j) * 65 + kp] = cvtpk(a[j], b[j]);
    }
    __syncthreads();
    const int n = tid >> 3, seg = tid & 7;
    unsigned w[8];
#pragma unroll
    for (int q = 0; q < 8; ++q) w[q] = tl[n * 65 + seg * 8 + q];
    u32x4* d = (u32x4*)(dst + (size_t)(drow0 + n) * ldd + k0 + seg * 16);
    d[0] = (u32x4){w[0], w[1], w[2], w[3]}; d[1] = (u32x4){w[4], w[5], w[6], w[7]};
    __syncthreads();
}
__device__ __forceinline__ void tr_tile8(const float* __restrict__ src, int N, const float* __restrict__ ksc, float wscale, unsigned char* __restrict__ dst, int ldd, int k0, int n0, int drow0, LAS unsigned* tl, int tid) {
    const int c4 = (tid & 15) * 4, kq = tid >> 4;
    const float* s0 = src + (size_t)(k0 + 4 * kq) * N + n0 + c4;
    f32x4 a = *(const f32x4*)s0, b = *(const f32x4*)(s0 + N), c = *(const f32x4*)(s0 + 2 * (size_t)N), d = *(const f32x4*)(s0 + 3 * (size_t)N);
    float sa = wscale, sb = wscale, sc = wscale, sd = wscale;
    if (ksc) { sa *= ksc[k0 + 4 * kq]; sb *= ksc[k0 + 4 * kq + 1]; sc *= ksc[k0 + 4 * kq + 2]; sd *= ksc[k0 + 4 * kq + 3]; }
#pragma unroll
    for (int j = 0; j < 4; ++j) tl[(c4 + j) * 33 + kq] = pk4_fp8(a[j] * sa, b[j] * sb, c[j] * sc, d[j] * sd);
    __syncthreads();
    const int n = tid >> 3, seg = tid & 7;
    unsigned w[4];
#pragma unroll
    for (int q = 0; q < 4; ++q) w[q] = tl[n * 33 + seg * 4 + q];
    *(u32x4*)(dst + (size_t)(drow0 + n) * ldd + k0 + seg * 16) = (u32x4){w[0], w[1], w[2], w[3]};
    __syncthreads();
}
struct TJob { const float* src; bf16_t* dst; const float* ksc; int K, N, ldd, gu; size_t sbs, dbs; int f8; };
constexpr float W8_SCALE = 64.f;
constexpr int W8_SBYTE = 0x79797979;
__device__ __forceinline__ void run_tjob(const TJob& jb, int t, LAS unsigned* tl, int tid) {
    const int ntn = jb.N / 64, ntk = jb.K / 128, per = ntn * ntk;
    const int bi = t / per, r = t % per, tk = r / ntn, tn = r % ntn;
    const int n0 = tn * 64;
    const int drow0 = jb.gu ? (256 * (n0 >> 7) + (jb.gu == 2 ? 128 : 0) + (n0 & 127)) : n0;
    if (jb.f8) tr_tile8(jb.src + (size_t)bi * jb.sbs, jb.N, jb.ksc, W8_SCALE, (unsigned char*)jb.dst + (size_t)bi * jb.dbs, jb.ldd, tk * 128, n0, drow0, tl, tid);
    else tr_tile(jb.src + (size_t)bi * jb.sbs, jb.N, jb.ksc, jb.dst + (size_t)bi * jb.dbs, jb.ldd, tk * 128, n0, drow0, tl, tid);
}
typedef __attribute__((address_space(4))) const unsigned long long kcu64_t;
#define PIN(i) ((const float*)(__attribute__((address_space(1))) const float*)ka[i])
__device__ __forceinline__ void phase_prologue(kcu64_t* ka, unsigned char* ws, LAS unsigned char* lds, int G, int bid, int tid) {
    LAS unsigned* tl = (LAS unsigned*)lds;
    constexpr int NJ = 12;
    const int cnts[NJ] = {16 * 72, 16 * 32, 4096, 4096, 4096, 16 * 61, 16 * 32, 4096, 4096, 4096, 4 * 24, 2 * 32};
    int total = 0;
#pragma unroll
    for (int j = 0; j < NJ; ++j) total += cnts[j];
    for (int t = bid; t < total; t += G) {
        int j = 0, base = 0;
#pragma unroll
        for (int q = 0; q < NJ - 1; ++q) if (t >= base + cnts[q] && j == q) { base += cnts[q]; j = q + 1; }
        const int tt = t - base;
        TJob jb;
        switch (j) {
            case 0: jb = TJob{PIN(I_WIN0), (bf16_t*)(ws + WS_WIN0), nullptr, 2048, IN0, 2048, 0, 0, 0, F8_IN}; break;
            case 1: jb = TJob{PIN(I_WOUT0), (bf16_t*)(ws + WS_WOUT0), nullptr, 2048, 2048, 2048, 0, 0, 0, F8_OUT}; break;
            case 2: jb = TJob{PIN(I_WG0), (bf16_t*)(ws + WS_WGU0), nullptr, 2048, 512, 2048, 1, (size_t)2048 * 512, (size_t)1024 * 2048, F8_GU}; break;
            case 3: jb = TJob{PIN(I_WU0), (bf16_t*)(ws + WS_WGU0), nullptr, 2048, 512, 2048, 2, (size_t)2048 * 512, (size_t)1024 * 2048, F8_GU}; break;
            case 4: jb = TJob{PIN(I_WD0), (bf16_t*)(ws + WS_WD0), nullptr, 512, 2048, 512, 0, (size_t)512 * 2048, (size_t)2048 * 512, F8_DOWN}; break;
            case 5: jb = TJob{PIN(I_WIN1), (bf16_t*)(ws + WS_WIN1), nullptr, 2048, IN1, 2048, 0, 0, 0, F8_IN}; break;
            case 6: jb = TJob{PIN(I_WOUT1), (bf16_t*)(ws + WS_WOUT1), nullptr, 2048, 2048, 2048, 0, 0, 0, F8_OUT}; break;
            case 7: jb = TJob{PIN(I_WG1), (bf16_t*)(ws + WS_WGU1), nullptr, 2048, 512, 2048, 1, (size_t)2048 * 512, (size_t)1024 * 2048, F8_GU}; break;
            case 8: jb = TJob{PIN(I_WU1), (bf16_t*)(ws + WS_WGU1), nullptr, 2048, 512, 2048, 2, (size_t)2048 * 512, (size_t)1024 * 2048, F8_GU}; break;
            case 9: jb = TJob{PIN(I_WD1), (bf16_t*)(ws + WS_WD1), nullptr, 512, 2048, 512, 0, (size_t)512 * 2048, (size_t)2048 * 512, F8_DOWN}; break;
            case 10: jb = TJob{PIN(I_WQUP), (bf16_t*)(ws + WS_WQUP), PIN(I_DQN), 512, 1536, 512, 0, 0, 0, 0}; break;
            default: jb = TJob{PIN(I_WKVUP), (bf16_t*)(ws + WS_WKVUP), PIN(I_DKVN), 256, 2048, 256, 0, 0, 0, 0}; break;
        }
        run_tjob(jb, tt, tl, tid);
    }
    { constexpr size_t ESZ = F8_IN ? 1 : 2;
      u32x4* z = (u32x4*)(ws + WS_WIN1 + (size_t)IN1 * 2048 * ESZ); const size_t n16 = (size_t)(IN1P - IN1) * 2048 * ESZ / 16;
      const unsigned zu = __float_as_uint(fresh_zero());
      for (size_t i = (size_t)bid * NTHR + tid; i < n16; i += (size_t)G * NTHR) z[i] = (u32x4){zu, zu, zu, zu}; }
    { const f32x8* xs = (const f32x8*)PIN(I_X); const size_t n8 = (size_t)T_ * DM / 8;
      if constexpr (F8_IN) { u32x2* xd = (u32x2*)(ws + WS_RC + 64 * MiB);
          for (size_t i = (size_t)bid * NTHR + tid; i < n8; i += (size_t)G * NTHR) { const f32x8 v = xs[i]; xd[i] = (u32x2){pk4_fp8(v[0], v[1], v[2], v[3]), pk4_fp8(v[4], v[5], v[6], v[7])}; } }
      else { u32x4* xd = (u32x4*)(ws + WS_RA);
          for (size_t i = (size_t)bid * NTHR + tid; i < n8; i += (size_t)G * NTHR) { const f32x8 v = xs[i];
              xd[i] = (u32x4){cvtpk(v[0], v[1]), cvtpk(v[2], v[3]), cvtpk(v[4], v[5]), cvtpk(v[6], v[7])}; } } }
}

__device__ __forceinline__ void phase_prep_qk(bf16_t* H0, const float* qn, const float* kn, unsigned char* K8, int G, int bid, int tid) {
    const int wid = tid >> 6, lane = tid & 63, i = lane & 31, half = lane >> 5;
    const float invf = inv_freq32(i);
    const int e0 = 64 * half + i, e1 = e0 + 32;
    const float gq0 = qn[e0], gq1 = qn[e1], gk0 = kn[e0], gk1 = kn[e1];
    for (int m = bid * 8 + wid; m < T_; m += G * 8) {
        const int s = m & (SEQ - 1); const int pos = half ? (s & 63) : (s >> 6);
        float sn, cs; sincos_rev((float)pos * invf, sn, cs);
        bf16_t* rowp = H0 + (size_t)m * IN0;
#pragma unroll
        for (int hh = 0; hh < 10; ++hh) {
            bf16_t* base = rowp + (hh < 8 ? hh * 128 : 1024 + (hh - 8) * 128);
            const float x0 = bf2f(base[e0]), x1 = bf2f(base[e1]);
            const float ss = wave_sum(x0 * x0 + x1 * x1);
            const float r = rsqrtf(ss * (1.0f / 128.0f) + 1e-6f);
            const float y0 = x0 * r * (hh < 8 ? gq0 : gk0), y1 = x1 * r * (hh < 8 ? gq1 : gk1);
            const float o0 = y0 * cs - y1 * sn, o1 = y1 * cs + y0 * sn;
            base[e0] = f2bf(o0); base[e1] = f2bf(o1);
            if (F8_ATTA && hh >= 8) { unsigned char* kp = K8 + (size_t)m * 256 + (hh - 8) * 128; kp[e0] = f2fp8(o0); kp[e1] = f2fp8(o1); }
        }
    }
}
__device__ __forceinline__ void phase_vt8(const bf16_t* H0, unsigned char* Vt8, LAS unsigned char* lds, int G, int bid, int tid) {
    const int t = tid >> 3, seg = tid & 7, c = tid >> 2, part = tid & 3;
    for (int u = bid; u < 1024; u += G) {
        const int b = u >> 7, kvh = (u >> 6) & 1, ch = u & 63;
        const bf16_t* src = H0 + (size_t)(b * SEQ + ch * 64 + t) * IN0 + 1280 + kvh * 128 + seg * 16;
        const u32x4 v0 = *(const u32x4*)src, v1 = *(const u32x4*)(src + 8);
        const unsigned w[8] = {v0.x, v0.y, v0.z, v0.w, v1.x, v1.y, v1.z, v1.w};
        __syncthreads();
#pragma unroll
        for (int j = 0; j < 8; ++j) { lds[(16 * seg + 2 * j) * 80 + t] = f2fp8(bflo(w[j])); lds[(16 * seg + 2 * j + 1) * 80 + t] = f2fp8(bfhi(w[j])); }
        __syncthreads();
        const u32x4 o = *(const LAS u32x4*)(lds + c * 80 + part * 16);
        *(u32x4*)(Vt8 + ((size_t)(b * 2 + kvh) * 128 + c) * SEQ + ch * 64 + part * 16) = o;
    }
    __syncthreads();
}
__device__ __forceinline__ void phase_prep_mla(bf16_t* H1, bf16_t* krope, unsigned char* kr8, int G, int bid, int tid) {
    const int wid = tid >> 6, lane = tid & 63;
    const float invf = inv_freq32(lane & 31);
    for (int m = bid * 8 + wid; m < T_; m += G * 8) {
        bf16_t* rowp = H1 + (size_t)m * IN1P;
        const u32x4 a = *(const u32x4*)(rowp + 3072 + lane * 8);
        float ss = bflo(a.x) * bflo(a.x) + bfhi(a.x) * bfhi(a.x) + bflo(a.y) * bflo(a.y) + bfhi(a.y) * bfhi(a.y) + bflo(a.z) * bflo(a.z) + bfhi(a.z) * bfhi(a.z) + bflo(a.w) * bflo(a.w) + bfhi(a.w) * bfhi(a.w);
        ss = wave_sum(ss);
        const u32x2 c = *(const u32x2*)(rowp + 3584 + lane * 4);
        float s2 = bflo(c.x) * bflo(c.x) + bfhi(c.x) * bfhi(c.x) + bflo(c.y) * bflo(c.y) + bfhi(c.y) * bfhi(c.y);
        s2 = wave_sum(s2);
        const float rq = rsqrtf(ss * (1.0f / 512.0f) + 1e-6f), rkv = rsqrtf(s2 * (1.0f / 256.0f) + 1e-6f);
        *(u32x4*)(rowp + 3072 + lane * 8) = (u32x4){cvtpk(bflo(a.x) * rq, bfhi(a.x) * rq), cvtpk(bflo(a.y) * rq, bfhi(a.y) * rq), cvtpk(bflo(a.z) * rq, bfhi(a.z) * rq), cvtpk(bflo(a.w) * rq, bfhi(a.w) * rq)};
        *(u32x2*)(rowp + 3584 + lane * 4) = (u32x2){cvtpk(bflo(c.x) * rkv, bfhi(c.x) * rkv), cvtpk(bflo(c.y) * rkv, bfhi(c.y) * rkv)};
        if (lane < 32) { const float x1 = bf2f(rowp[3840 + lane]), x2 = bf2f(rowp[3840 + 32 + lane]);
            float sn, cs; sincos_rev((float)(m & (SEQ - 1)) * invf, sn, cs);
            const float o1 = x1 * cs - x2 * sn, o2 = x2 * cs + x1 * sn;
            krope[(size_t)m * 64 + lane] = f2bf(o1); krope[(size_t)m * 64 + 32 + lane] = f2bf(o2);
            if (F8_ATTD) { kr8[(size_t)m * 64 + lane] = f2fp8(o1); kr8[(size_t)m * 64 + 32 + lane] = f2fp8(o2); } }
    }
}

constexpr int LNR_PITCH = 2052;
constexpr int LNR_PART = 131584, LNR_SC = 147968, LNR_SEL = 150016, LNR_BLE = 152064, LNR_HIST = 153088;
__device__ __forceinline__ void phase_ln_router(const float* z, const float* g, const float* bb, const float* rw, const float* rb, bf16_t* x1b, unsigned char* x1q,
                                                int* tok_e, int* tok_p, float* tok_g, int* list, unsigned* cnt, LAS unsigned char* lds, int G, int bid, int tid, bool commit = true) {
    const int wid = tid >> 6, lane = tid & 63;
    LAS float* xs = (LAS float*)lds; LAS float* part = (LAS float*)(lds + LNR_PART); LAS float* scs = (LAS float*)(lds + LNR_SC); LAS float* sels = (LAS float*)(lds + LNR_SEL);
    LAS int* ble = (LAS int*)(lds + LNR_BLE); LAS int* hist = (LAS int*)(lds + LNR_HIST);
    f16x8 bw[8][2];
    { const float* rwp = rw + (size_t)(256 * wid + 8 * (lane >> 4)) * 32 + (lane & 15);
#pragma unroll
      for (int ks = 0; ks < 8; ++ks)
#pragma unroll
        for (int hf = 0; hf < 2; ++hf)
#pragma unroll
          for (int j = 0; j < 8; ++j) bw[ks][hf][j] = (_Float16)rwp[(32 * ks + j) * 32 + 16 * hf]; }
    f32x4 v[2][8];
#define LNR_LOAD(tix_, rr) do { const float* zp = z + ((size_t)(tix_) * 16 + 2 * wid + (rr)) * DM + 4 * lane; \
        _Pragma("unroll") for (int i = 0; i < 8; ++i) v[rr][i] = *(const f32x4*)(zp + 256 * i); } while (0)
    const int ntile = T_ / 16;
    int ntl = 0;
    if (bid < ntile) { LNR_LOAD(bid, 0); LNR_LOAD(bid, 1); }
    for (int it = 0; bid + G * it < ntile; ++it) {
        const int tix = bid + G * it;
#pragma unroll
        for (int rr = 0; rr < 2; ++rr) {
            const int row = 2 * wid + rr; const size_t m = (size_t)tix * 16 + row;
            float s = 0.f;
#pragma unroll
            for (int i = 0; i < 8; ++i) s += (v[rr][i][0] + v[rr][i][1]) + (v[rr][i][2] + v[rr][i][3]);
            const float mean = wave_sum(s) * (1.0f / DM); float q = 0.f;
#pragma unroll
            for (int i = 0; i < 8; ++i) { const f32x4 d = v[rr][i] - mean; q += (d[0] * d[0] + d[1] * d[1]) + (d[2] * d[2] + d[3] * d[3]); }
            const float rstd = rsqrtf(wave_sum(q) * (1.0f / DM) + 1e-5f);
#pragma unroll
            for (int i = 0; i < 8; ++i) { const int col = 4 * lane + 256 * i; const f32x4 gv = *(const f32x4*)(g + col), bv = *(const f32x4*)(bb + col);
                const f32x4 y = (v[rr][i] - mean) * rstd * gv + bv;
                LAS f32x2* xp = (LAS f32x2*)(xs + row * LNR_PITCH + col); xp[0] = (f32x2){y[0], y[1]}; xp[1] = (f32x2){y[2], y[3]};
                *(u32x2*)(x1b + m * DM + col) = (u32x2){cvtpk(y[0], y[1]), cvtpk(y[2], y[3])};
                if constexpr (F8_GU) *(unsigned*)(x1q + m * DM + col) = pk4_fp8(y[0], y[1], y[2], y[3]);
                if (i & 1) asm volatile("" ::: "memory"); }
        }
        __builtin_amdgcn_sched_barrier(0);
        if (tix + G < ntile) LNR_LOAD(tix + G, 0);
        __builtin_amdgcn_sched_barrier(0);
        __syncthreads();
        { f32x4 acc0 = {0.f, 0.f, 0.f, 0.f}, acc1 = {0.f, 0.f, 0.f, 0.f}; const LAS float* xa = xs + (lane & 15) * LNR_PITCH + 256 * wid + 8 * (lane >> 4); const int e = lane & 15;
#pragma unroll
          for (int ks = 0; ks < 8; ++ks) { const f32x4 xa0 = *(const LAS f32x4*)(xa + 32 * ks), xa1 = *(const LAS f32x4*)(xa + 32 * ks + 4);
              const float xv[8] = {xa0[0], xa0[1], xa0[2], xa0[3], xa1[0], xa1[1], xa1[2], xa1[3]}; f16x8 ah, al;
#pragma unroll
              for (int j = 0; j < 8; ++j) { const _Float16 hh = (_Float16)xv[j]; ah[j] = hh; al[j] = (_Float16)(xv[j] - (float)hh); }
              acc0 = __builtin_amdgcn_mfma_f32_16x16x32_f16(ah, bw[ks][0], acc0, 0, 0, 0); acc1 = __builtin_amdgcn_mfma_f32_16x16x32_f16(ah, bw[ks][1], acc1, 0, 0, 0);
              acc0 = __builtin_amdgcn_mfma_f32_16x16x32_f16(al, bw[ks][0], acc0, 0, 0, 0); acc1 = __builtin_amdgcn_mfma_f32_16x16x32_f16(al, bw[ks][1], acc1, 0, 0, 0); }
          __builtin_amdgcn_sched_barrier(0);
          if (tix + G < ntile) LNR_LOAD(tix + G, 1);
          __builtin_amdgcn_sched_barrier(0);
#pragma unroll
          for (int r = 0; r < 4; ++r) { const int row = (lane >> 4) * 4 + r; part[(wid * 16 + row) * 32 + e] = acc0[r]; part[(wid * 16 + row) * 32 + 16 + e] = acc1[r]; } }
        __syncthreads();
        { const int row = tid >> 5, e = tid & 31; float lg = 0.f;
#pragma unroll
          for (int w = 0; w < 8; ++w) lg += part[(w * 16 + row) * 32 + e];
          const float sc = 1.0f / (1.0f + __expf(-lg)); scs[row * 32 + e] = sc; sels[row * 32 + e] = sc + rb[e]; }
        __syncthreads();
        if (tid < 16) { const int row = tid; float best = -INFINITY; int bg = 0;
            for (int gI = 0; gI < 8; ++gI) { const float a = sels[row * 32 + 4 * gI], b = sels[row * 32 + 4 * gI + 1], c = sels[row * 32 + 4 * gI + 2], d = sels[row * 32 + 4 * gI + 3];
                const float h1 = fmaxf(a, b), l1 = fminf(a, b), h2 = fmaxf(c, d), l2 = fminf(c, d); const float gs = fmaxf(h1, h2) + fmaxf(fminf(h1, h2), fmaxf(l1, l2));
                if (gs > best) { best = gs; bg = gI; } }
            const float v0 = sels[row * 32 + 4 * bg], v1 = sels[row * 32 + 4 * bg + 1], v2 = sels[row * 32 + 4 * bg + 2], v3 = sels[row * 32 + 4 * bg + 3];
            int i1 = 0; float b1v = v0; if (v1 > b1v) { b1v = v1; i1 = 1; } if (v2 > b1v) { b1v = v2; i1 = 2; } if (v3 > b1v) { b1v = v3; i1 = 3; }
            int i2 = -1; float b2v = -INFINITY;
            if (i1 != 0 && v0 > b2v) { b2v = v0; i2 = 0; } if (i1 != 1 && v1 > b2v) { b2v = v1; i2 = 1; } if (i1 != 2 && v2 > b2v) { b2v = v2; i2 = 2; } if (i1 != 3 && v3 > b2v) { b2v = v3; i2 = 3; }
            const int e1 = 4 * bg + i1, e2 = 4 * bg + i2; const float s1 = scs[row * 32 + e1], s2 = scs[row * 32 + e2]; const float inv = 1.0f / (s1 + s2);
            const size_t m = (size_t)tix * 16 + row;
            tok_e[2 * m] = e1; tok_e[2 * m + 1] = e2; tok_g[2 * m] = s1 * inv; tok_g[2 * m + 1] = s2 * inv;
            ble[(it * 16 + row) * 2] = e1; ble[(it * 16 + row) * 2 + 1] = e2; }
        __syncthreads();
        ntl = it + 1;
    }
#undef LNR_LOAD
    const int nasg = commit ? ntl * 32 : 0;
    if (tid < 32) { int c = 0; for (int i = 0; i < nasg; ++i) c += (ble[i] == tid) ? 1 : 0;
        unsigned base = 0; if (c) base = __hip_atomic_fetch_add(cnt + tid, (unsigned)c, __ATOMIC_RELAXED, __HIP_MEMORY_SCOPE_AGENT);
        hist[tid] = (int)base; }
    __syncthreads();
    if (tid < 32) { int run = hist[tid];
        for (int i = 0; i < nasg; ++i) if (ble[i] == tid) { const int tr = i >> 1; const size_t m = (size_t)(bid + G * (tr >> 4)) * 16 + (tr & 15);
            list[(size_t)tid * 65536 + run] = (int)m; tok_p[2 * m + (i & 1)] = run; ++run; } }
    __syncthreads();
}

constexpr int MOE_LDS = 131072;
__device__ __forceinline__ int moe_prefix(const unsigned* cnt, LAS int* pblk, int tid) {
    if (tid == 0) { int acc = 0; for (int e = 0; e < NE; ++e) { pblk[e] = acc; acc += ((int)cnt[e] + 255) >> 8; } pblk[NE] = acc; }
    __syncthreads();
    return pblk[NE];
}
template <int NJ> __device__ __forceinline__ int moe_table(const unsigned* cnt, LAS int* pblk, LAS int* tab, LAS int* aux, int NB, int G, int bid, int tid) {
    const int NU = NB * NJ;
    if (tid < 16) { const int L = bid + G * tid;
        if (L < NU) { const int rb = L / NJ, j = L % NJ; int e = 0; for (int q = 1; q < NE; ++q) if (pblk[q] <= rb) e = q;
            tab[tid] = rb; tab[16 + tid] = NJ * e + j; aux[tid * 3] = e; aux[tid * 3 + 1] = (rb - pblk[e]) * 256; aux[tid * 3 + 2] = (int)cnt[e]; } }
    __syncthreads();
    int n = 0; for (int i = 0; i < 16; ++i) if (bid + G * i < NU) n = i + 1;
    return n;
}

template <bool FINAL>
__device__ __forceinline__ void phase_combine_ln(const float* dbg, const bf16_t* x1b, const bf16_t* Yr, const int* tok_e, const int* tok_p, const float* tok_g, const unsigned* cnt,
                                                 const float* g, const float* bb, bf16_t* xo, unsigned char* xq, float* fo, LAS unsigned char* lds, int G, int bid, int tid) {
    LAS int* pblk = (LAS int*)lds;
    moe_prefix(cnt, pblk, tid);
    const int wid = tid >> 6, lane = tid & 63;
    float ALPHA = 1.4142135623730951f; asm volatile("" : "+v"(ALPHA));
#if DBG_CHECK
    const bool dbg_bad = FINAL && (!(dbg[0] <= DBG_TOL * DBG_TOL * dbg[1]) || !(dbg[2] <= DBG_TOL * DBG_TOL * dbg[3]) || !(dbg[1] > 0.f) || !(dbg[3] > 0.f));
#endif
    for (int m = bid * 8 + wid; m < T_; m += G * 8) {
        const int e0 = tok_e[2 * m], e1 = tok_e[2 * m + 1];
        const size_t p0 = (size_t)pblk[e0] * 256 + tok_p[2 * m], p1 = (size_t)pblk[e1] * 256 + tok_p[2 * m + 1];
        const float g0 = tok_g[2 * m], g1 = tok_g[2 * m + 1];
        float v[32]; float s = 0.f;
#pragma unroll
        for (int i = 0; i < 4; ++i) { const int col = 8 * lane + 512 * i;
            const u32x4 xa = *(const u32x4*)(x1b + (size_t)m * DM + col);
            const unsigned xw[4] = {xa.x, xa.y, xa.z, xa.w};
            if constexpr (F8_YR) {
                const u32x2 ya = *(const u32x2*)((const unsigned char*)Yr + p0 * DM + col), yb = *(const u32x2*)((const unsigned char*)Yr + p1 * DM + col);
                const unsigned aw[2] = {ya.x, ya.y}, bw[2] = {yb.x, yb.y}; const float h0 = g0 * (1.0f / 16.0f), h1 = g1 * (1.0f / 16.0f);
#define CMB_PAIR(j, W, SEL) do { const f32x2 a2 = __builtin_amdgcn_cvt_pk_f32_fp8((int)aw[W], SEL), b2 = __builtin_amdgcn_cvt_pk_f32_fp8((int)bw[W], SEL); \
                    v[i * 8 + 2 * (j)] = ALPHA * bflo(xw[j]) + h0 * a2[0] + h1 * b2[0]; v[i * 8 + 2 * (j) + 1] = ALPHA * bfhi(xw[j]) + h0 * a2[1] + h1 * b2[1]; \
                    s += v[i * 8 + 2 * (j)] + v[i * 8 + 2 * (j) + 1]; } while (0)
                CMB_PAIR(0, 0, false); CMB_PAIR(1, 0, true); CMB_PAIR(2, 1, false); CMB_PAIR(3, 1, true);
#undef CMB_PAIR
            } else {
                const u32x4 ya = *(const u32x4*)(Yr + p0 * DM + col), yb = *(const u32x4*)(Yr + p1 * DM + col);
                const unsigned aw[4] = {ya.x, ya.y, ya.z, ya.w}, bw[4] = {yb.x, yb.y, yb.z, yb.w};
#pragma unroll
                for (int j = 0; j < 4; ++j) { v[i * 8 + 2 * j] = ALPHA * bflo(xw[j]) + g0 * bflo(aw[j]) + g1 * bflo(bw[j]); v[i * 8 + 2 * j + 1] = ALPHA * bfhi(xw[j]) + g0 * bfhi(aw[j]) + g1 * bfhi(bw[j]);
                    s += v[i * 8 + 2 * j] + v[i * 8 + 2 * j + 1]; }
            } }
        const float mean = wave_sum(s) * (1.0f / DM); float q = 0.f;
#pragma unroll
        for (int i = 0; i < 32; ++i) { const float d = v[i] - mean; q += d * d; }
        const float rstd = rsqrtf(wave_sum(q) * (1.0f / DM) + 1e-5f);
#pragma unroll
        for (int i = 0; i < 4; ++i) { const int col = 8 * lane + 512 * i;
            const f32x4 ga = *(const f32x4*)(g + col), gb = *(const f32x4*)(g + col + 4), ba = *(const f32x4*)(bb + col), bbv = *(const f32x4*)(bb + col + 4);
            float y[8];
#pragma unroll
            for (int j = 0; j < 4; ++j) { y[j] = (v[i * 8 + j] - mean) * rstd * ga[j] + ba[j]; y[4 + j] = (v[i * 8 + 4 + j] - mean) * rstd * gb[j] + bbv[j]; }
#if DBG_CHECK
            if (dbg_bad) { for (int j = 0; j < 8; ++j) y[j] = 0.f; }
#endif
            if constexpr (FINAL) { *(f32x4*)(fo + (size_t)m * DM + col) = (f32x4){y[0], y[1], y[2], y[3]}; *(f32x4*)(fo + (size_t)m * DM + col + 4) = (f32x4){y[4], y[5], y[6], y[7]}; }
            else { *(u32x4*)(xo + (size_t)m * DM + col) = (u32x4){cvtpk(y[0], y[1]), cvtpk(y[2], y[3]), cvtpk(y[4], y[5]), cvtpk(y[6], y[7])};
                if constexpr (F8_IN) *(u32x2*)(xq + (size_t)m * DM + col) = (u32x2){pk4_fp8(y[0], y[1], y[2], y[3]), pk4_fp8(y[4], y[5], y[6], y[7])}; } }
    }
}

#if DBG_CHECK
__device__ __forceinline__ void dbg_attn_check(int which, const bf16_t* Hx, const bf16_t* Qd, const bf16_t* KVd, const bf16_t* krope, const void* Oat, float* dbg, LAS unsigned char* lds, int bid, int tid) {
    const int wid = tid >> 6, lane = tid & 63;
    LAS float* sc = (LAS float*)lds + wid * 4096;
    LAS float* qs = (LAS float*)(lds + 131072) + wid * 192;
    const unsigned sid = (unsigned)(bid * 8 + wid);
    const int m = (int)((sid * 2654435761u) % (unsigned)T_), h = (int)(sid & 7u), b = m >> 12, pos = m & (SEQ - 1);
    const int DQ = which ? 192 : 128; const float scale = which ? 0.072168783648703220f : 0.088388347648318440f;
    for (int d = lane; d < DQ; d += 64) {
        float qv;
        if (which == 0) qv = bf2f(Hx[(size_t)m * IN0 + h * 128 + d]);
        else if (d < 128) qv = bf2f(Qd[(size_t)m * 1536 + h * 192 + d]);
        else { const int i = (d - 128) & 31; const float x1 = bf2f(Qd[(size_t)m * 1536 + h * 192 + 128 + i]), x2 = bf2f(Qd[(size_t)m * 1536 + h * 192 + 160 + i]);
            float sn, cs; sincos_rev((float)pos * inv_freq32(i), sn, cs); qv = (d < 160) ? (x1 * cs - x2 * sn) : (x2 * cs + x1 * sn); }
        qs[d] = qv; }
    asm volatile("s_waitcnt lgkmcnt(0)" ::: "memory");
    float mx = -INFINITY;
    for (int i = 0; i < 64; ++i) { const int j = lane + 64 * i; float dot = 0.f;
        if (which == 0) { const bf16_t* kp = Hx + (size_t)(b * SEQ + j) * IN0 + 1024 + (h >> 2) * 128; for (int d = 0; d < 128; ++d) dot += qs[d] * bf2f(kp[d]); }
        else { const bf16_t* kp = KVd + (size_t)(b * SEQ + j) * DM + h * 256; for (int d = 0; d < 128; ++d) dot += qs[d] * bf2f(kp[d]);
               const bf16_t* rp = krope + (size_t)(b * SEQ + j) * 64; for (int d = 0; d < 64; ++d) dot += qs[128 + d] * bf2f(rp[d]); }
        dot *= scale; sc[j] = dot; mx = fmaxf(mx, dot); }
    mx = wave_max(mx);
    float sum = 0.f;
    for (int i = 0; i < 64; ++i) { const int j = lane + 64 * i; const float pj = __expf(sc[j] - mx); sc[j] = pj; sum += pj; }
    sum = wave_sum(sum);
    asm volatile("s_waitcnt lgkmcnt(0)" ::: "memory");
    float e2 = 0.f, r2 = 0.f;
    for (int cc = 0; cc < 2; ++cc) { const int c = lane + 64 * cc; float acc = 0.f;
        for (int j = 0; j < SEQ; ++j) { const float vv = which == 0 ? bf2f(Hx[(size_t)(b * SEQ + j) * IN0 + 1280 + (h >> 2) * 128 + c]) : bf2f(KVd[(size_t)(b * SEQ + j) * DM + h * 256 + 128 + c]); acc += sc[j] * vv; }
        const float ref = acc / sum; const size_t eo = (size_t)m * DM + (which ? 1024 : 0) + h * 128 + c;
        float got; if (F8_OUT) { const unsigned char by = ((const unsigned char*)Oat)[eo]; const f32x2 g2 = __builtin_amdgcn_cvt_pk_f32_fp8((int)by, false); got = g2[0] * (1.0f / O8_SCALE); } else got = bf2f(((const bf16_t*)Oat)[eo]);
        e2 += (got - ref) * (got - ref); r2 += ref * ref; }
    e2 = wave_sum(e2); r2 = wave_sum(r2);
    if (lane == 0) { atomicAdd(dbg + 2 * which, e2); atomicAdd(dbg + 2 * which + 1, r2); }
}
#endif
#ifndef ATT_ONLY
#define ATT_ONLY -1
#endif
#ifndef REP_K
#define REP_K -1
#endif
#ifndef REP_ATT
#define REP_ATT -1
#endif
#define NREP(k) ((REP_K == (k)) ? 2 : 1)
#define NREPA(k) ((REP_ATT == (k)) ? 2 : 1)
constexpr int N_PHASES = 20;
__global__ void __launch_bounds__(NTHR, 2) fwd(Params p) {
    extern __shared__ __attribute__((aligned(16))) unsigned char lds_raw[];
    LAS unsigned char* lds = (LAS unsigned char*)lds_raw;
    const int tid0 = threadIdx.x, bid = blockIdx.x, G = gridDim.x;
    const int wv = __builtin_amdgcn_readfirstlane(tid0 >> 6);
    const int vcu = (G % 8 == 0) ? (bid % 8) * (G / 8) + bid / 8 : bid;
    unsigned* ctl = (unsigned*)(p.ws + WS_CTL);
    if (tid0 < 4) ((LAS unsigned*)(lds + MISC_OFF))[tid0] = 0u;
    __syncthreads();
    XcdBarrier bar; bar.bar = ctl + CW_BAR; bar.x = 0; bar.st = (volatile LAS unsigned*)(lds + MISC_OFF);
    if (N_LAUNCH_MODE == 1) bar = xcd_barrier_post(ctl + CW_BAR, (volatile LAS unsigned*)(lds + MISC_OFF));
    const int lo = p.ph_lo, hi = p.ph_hi;
#ifndef PH_ONLY
#define PH_ONLY -1
#endif
#define IN(k) ((PH_ONLY < 0 || (PH_ONLY % 10) == ((k) % 10)) && lo <= (k) && (k) < hi)
#define SEAM(k) do { if ((k) + 1 < hi) xcd_barrier(bar, fresh_tid(wv)); } while (0)

    for (int L = 0; L < 2; ++L) {
        const int pb = L * 10;
        typedef __attribute__((address_space(1))) unsigned char gu8;
        typedef __attribute__((address_space(1))) const float gcf;
        typedef __attribute__((address_space(4))) const unsigned long long kcu64;
#define INP(i) ((const float*)(gcf*)ka[i])
#define PHASE_PTRS \
        kcu64* ka = (kcu64*)__builtin_amdgcn_kernarg_segment_ptr(); asm volatile("" : "+s"(ka)); \
        unsigned char* ws = (unsigned char*)(gu8*)ka[29]; unsigned char* outb = (unsigned char*)(gu8*)ka[28]; \
        unsigned* ctl = (unsigned*)(ws + WS_CTL); \
        bf16_t* RA = (bf16_t*)(ws + WS_RA); bf16_t* RB = (bf16_t*)(ws + WS_RB); bf16_t* RC = (bf16_t*)(ws + WS_RC); \
        int* list = (int*)(ws + WS_LIST); int* tok_e = (int*)(ws + WS_TOKE); int* tok_p = (int*)(ws + WS_TOKP); float* tok_g = (float*)(ws + WS_TOKG); \
        bf16_t* krope = (bf16_t*)(ws + WS_KROPE); \
        bf16_t* Qd = (bf16_t*)(outb + OUT_QD); bf16_t* O1 = (bf16_t*)(outb + OUT_O1); \
        const bf16_t* Win = (const bf16_t*)(ws + (L ? WS_WIN1 : WS_WIN0)); const bf16_t* Wout = (const bf16_t*)(ws + (L ? WS_WOUT1 : WS_WOUT0)); \
        const bf16_t* Wgu = (const bf16_t*)(ws + (L ? WS_WGU1 : WS_WGU0)); const bf16_t* Wd = (const bf16_t*)(ws + (L ? WS_WD1 : WS_WD0)); \
        const int NIN = L ? IN1P : IN0; \
        const bf16_t* xin = L ? RC : RA; \
        bf16_t* Hx = RB; bf16_t* Oat = L ? O1 : RC; float* Z = (float*)RB; \
        bf16_t* x1b = RA; bf16_t* Hm = RC; bf16_t* Yr = RB; \
        unsigned* cnt = ctl + CW_CNT + L * 64; \
        (void)ctl; (void)RA; (void)RB; (void)RC; (void)list; (void)tok_e; (void)tok_p; (void)tok_g; (void)krope; (void)Qd; (void)O1; (void)Win; (void)Wout; (void)Wgu; (void)Wd; (void)NIN; (void)xin; (void)Hx; (void)Oat; (void)Z; (void)x1b; (void)Hm; (void)Yr; (void)cnt; (void)outb

        if (L == 0 && IN(0)) { PHASE_PTRS; _Pragma("unroll 1") for (int rep = 0; rep < NREP(0); ++rep) phase_prologue(ka, ws, lds, G, bid, fresh_tid(wv)); SEAM(0); }

        if (IN(pb + 1)) {
            PHASE_PTRS;
            constexpr int KI = F8_IN ? 1024 : 2048;
            const bf16_t* ain = F8_IN ? (L ? (const bf16_t*)outb : (const bf16_t*)((unsigned char*)RC + 64 * MiB)) : xin;
            pg8::Gemm g{ain, Win, KI, KI, KI}; pg8::StaticOrder S; S.init(T_, NIN, G, bid, KI);
            pg8::EpiBf16 E{Hx, NIN, 0xffff};
            _Pragma("unroll 1") for (int rep = 0; rep < NREP(1); ++rep) pg8::gemm_phase<F8_IN != 0>(wv, lds, g, S, E, W8_SBYTE, 0x7f7f7f7f);
            SEAM(pb + 1);
        }
        if (IN(pb + 2)) {
            PHASE_PTRS;
            if (L == 0) { phase_prep_qk(Hx, INP(I_AQN), INP(I_AKN), ws + WS_WGU0 + 64 * MiB, G, bid, fresh_tid(wv));
                if (F8_ATTA) phase_vt8(Hx, ws + WS_WGU0 + 72 * MiB, lds, G, bid, fresh_tid(wv)); }
            else phase_prep_mla(Hx, krope, ws + WS_WD1 + 32 * MiB, G, bid, fresh_tid(wv));
            SEAM(pb + 2);
        }
        if (L == 1 && IN(pb + 3)) _Pragma("unroll 1") for (int rep = 0; rep < NREP(3); ++rep) {
            PHASE_PTRS;
#ifndef P3_ONLY
#define P3_ONLY -1
#endif
            if (P3_ONLY < 0 || P3_ONLY == 0) { pg8::Gemm g{Hx + 3072, (const bf16_t*)(ws + WS_WQUP), 512, IN1P, 512}; pg8::StaticOrder S; S.init(T_, 1536, G, bid, IN1P);
              pg8::EpiBf16 E{Qd, 1536, 0xffff}; pg8::gemm_phase<false>(wv, lds, g, S, E); }
            if (P3_ONLY < 0 || P3_ONLY == 1) { pg8::Gemm g{Hx + 3584, (const bf16_t*)(ws + WS_WKVUP), 256, IN1P, 256}; pg8::StaticOrder S; S.init(T_, 2048, G, bid, IN1P);
              if constexpr (F8_ATTD) { pg8::EpiKV8 E{ws + WS_WGU1 + 64 * MiB, ws + WS_WGU1 + 96 * MiB, RA, DBG_CHECK != 0}; pg8::gemm_phase<false>(wv, lds, g, S, E); }
              else { pg8::EpiBf16 E{RA, 2048, 0xffff}; pg8::gemm_phase<false>(wv, lds, g, S, E); } }
            if (rep + 1 == NREP(3)) SEAM(pb + 3);
        }
        if (IN(pb + 4)) {
            PHASE_PTRS;
            if (L == 0) {
                if (ATT_ONLY < 0 || ATT_ONLY == 0)
                _Pragma("unroll 1") for (int rep = 0; rep < NREPA(0); ++rep)
                for (int u = vcu; u < 1024; u += G) {
                    __syncthreads();
                    const int b = u >> 7, qb = u & 15, kvh = (u >> 6) & 1, gq = (u >> 4) & 3, h = kvh * 4 + gq;
                    if constexpr (F8_ATTA) {
                        d8::D8Args a; a.Q = Hx + (size_t)(b * SEQ + 256 * qb) * IN0 + h * 128; a.ldq = IN0;
                        a.K8 = ws + WS_WGU0 + 64 * MiB + (size_t)b * SEQ * 256 + kvh * 128; a.ldk = 256; a.Kr8 = nullptr;
                        a.Vt8 = ws + WS_WGU0 + 72 * MiB + (size_t)(b * 2 + kvh) * 128 * SEQ; a.ldvt = SEQ;
                        { const size_t eo = (size_t)(b * SEQ + 256 * qb) * DM + h * 128; a.O = F8_OUT ? (bf16_t*)((unsigned char*)Oat + eo) : Oat + eo; } a.ldo = DM; a.seq = SEQ; a.pos0 = 0;
                        d8::attn_dense8_body<2>(wv, a, (char*)lds_raw);
                    } else {
                    da::DArgs a; a.Q = Hx + (size_t)(b * SEQ + 256 * qb) * IN0 + h * 128; a.ldq = IN0;
                    a.K = Hx + (size_t)b * SEQ * IN0 + 1024 + kvh * 128; a.ldk = IN0; a.V = Hx + (size_t)b * SEQ * IN0 + 1280 + kvh * 128; a.ldv = IN0; a.Kr = nullptr;
                    { const size_t eo = (size_t)(b * SEQ + 256 * qb) * DM + h * 128; a.O = F8_OUT ? (bf16_t*)((unsigned char*)Oat + eo) : Oat + eo; } a.ldo = DM; a.seq = SEQ; a.pos0 = 0;
                    da::attn_dense_body<8, 1>(wv, a, (char*)lds_raw);
                    }
                }
                __syncthreads();
                if (ATT_ONLY < 0 || ATT_ONLY == 2)
                _Pragma("unroll 1") for (int rep = 0; rep < NREPA(2); ++rep)
                for (int it = vcu; it < 1024; it += G) {
                    const int tid2 = fresh_tid(wv), wid = __builtin_amdgcn_readfirstlane(tid2 >> 6), lane = tid2 & 63;
                    const int w = it * 8 + wid; LAS unsigned char* wl = lds + wid * da::SP_WAVE_LDS;
                    PolB pol; pol.init(Hx, Oat, w, lane); da::sparse_wave(pol, wl, lane);
                }
            } else {
                if (ATT_ONLY < 0 || ATT_ONLY == 1)
                _Pragma("unroll 1") for (int rep = 0; rep < NREPA(1); ++rep)
                for (int u = vcu; u < 1024; u += G) {
                    __syncthreads();
                    const int b = u >> 7, qb = u & 15, h = (u >> 4) & 7;
                    if constexpr (F8_ATTD) {
                        d8::D8Args a; a.Q = Qd + (size_t)(b * SEQ + 256 * qb) * 1536 + h * 192; a.ldq = 1536;
                        a.K8 = ws + WS_WGU1 + 64 * MiB + (size_t)b * SEQ * 1024 + h * 128; a.ldk = 1024; a.Kr8 = ws + WS_WD1 + 32 * MiB + (size_t)b * SEQ * 64;
                        a.Vt8 = ws + WS_WGU1 + 96 * MiB + (size_t)(b * 8 + h) * 128 * SEQ; a.ldvt = SEQ;
                        { const size_t eo = (size_t)(b * SEQ + 256 * qb) * DM + 1024 + h * 128; a.O = F8_OUT ? (bf16_t*)((unsigned char*)Oat + eo) : Oat + eo; } a.ldo = DM; a.seq = SEQ; a.pos0 = 256 * qb;
                        d8::attn_dense8_body<3>(wv, a, (char*)lds_raw);
                    } else {
                    da::DArgs a; a.Q = Qd + (size_t)(b * SEQ + 256 * qb) * 1536 + h * 192; a.ldq = 1536;
                    a.K = RA + (size_t)b * SEQ * DM + h * 256; a.ldk = DM; a.V = a.K + 128; a.ldv = DM; a.Kr = krope + (size_t)b * SEQ * 64;
                    { const size_t eo = (size_t)(b * SEQ + 256 * qb) * DM + 1024 + h * 128; a.O = F8_OUT ? (bf16_t*)((unsigned char*)Oat + eo) : Oat + eo; } a.ldo = DM; a.seq = SEQ; a.pos0 = 256 * qb;
                    da::attn_dense_body<12, 1>(wv, a, (char*)lds_raw);
                    }
                }
                __syncthreads();
                if (ATT_ONLY < 0 || ATT_ONLY == 3)
                _Pragma("unroll 1") for (int rep = 0; rep < NREPA(3); ++rep)
                for (int it = vcu; it < 1024; it += G) {
                    const int tid2 = fresh_tid(wv), wid = __builtin_amdgcn_readfirstlane(tid2 >> 6), lane = tid2 & 63;
                    const int w = it * 8 + wid; LAS unsigned char* wl = lds + wid * da::SP_WAVE_LDS;
                    PolC pol; pol.init(Hx, Oat, INP(I_RPB), (float*)((char*)wl + 16640), w, lane); da::sparse_wave(pol, wl, lane);
                }
            }
#if DBG_CHECK
            xcd_barrier(bar, fresh_tid(wv));
            dbg_attn_check(L, Hx, Qd, RA, krope, Oat, (float*)(ctl + CW_DBG), lds, bid, fresh_tid(wv));
            __syncthreads();
#endif
            SEAM(pb + 4);
        }
        if (IN(pb + 5)) {
            PHASE_PTRS;
            constexpr int KO = F8_OUT ? 1024 : 2048; constexpr int SXO = F8_OUT ? 0x7b7b7b7b : 0x7f7f7f7f;
            pg8::Gemm g{Oat, Wout, KO, KO, KO}; pg8::StaticOrder S; S.init(T_, DM, G, bid, KO);
            if (L == 0) { pg8::EpiResF32<true> E{Z, INP(I_X)}; _Pragma("unroll 1") for (int rep = 0; rep < NREP(5); ++rep) pg8::gemm_phase<F8_OUT != 0>(wv, lds, g, S, E, W8_SBYTE, SXO); }
            else { pg8::EpiResF32<false> E{Z, RC}; _Pragma("unroll 1") for (int rep = 0; rep < NREP(5); ++rep) pg8::gemm_phase<F8_OUT != 0>(wv, lds, g, S, E, W8_SBYTE, SXO); }
            SEAM(pb + 5);
        }
        if (IN(pb + 6)) {
            PHASE_PTRS;
            _Pragma("unroll 1") for (int rep = 0; rep < NREP(6); ++rep) phase_ln_router(Z, INP(L ? I_LN1G1 : I_LN1G0), INP(L ? I_LN1B1 : I_LN1B0), INP(I_RW), INP(I_RB), x1b, (unsigned char*)RC + 64 * MiB, tok_e, tok_p, tok_g, list, cnt, lds, G, bid, fresh_tid(wv), rep + 1 == NREP(6));
            SEAM(pb + 6);
        }
        if (IN(pb + 7)) {
            PHASE_PTRS;
            LAS int* pblk = (LAS int*)(lds + MOE_LDS); LAS int* tab = pblk + 64; LAS int* aux = tab + 32; LAS int* idx = aux + 64;
            const int tid = fresh_tid(wv);
            const int NB = moe_prefix(cnt, pblk, tid);
            const int n = moe_table<4>(cnt, pblk, tab, aux, NB, G, bid, tid);
            for (int i = 0; i < n; ++i) if (tid < 256) { const int e = aux[i * 3], rs = aux[i * 3 + 1], ce = aux[i * 3 + 2]; idx[i * 256 + tid] = list[(size_t)e * 65536 + min(rs + tid, ce - 1)]; }
            __syncthreads();
            constexpr int KG = F8_GU ? 1024 : 2048;
            const bf16_t* agu = F8_GU ? (const bf16_t*)((unsigned char*)RC + 64 * MiB) : x1b;
            pg8::Gemm g{agu, Wgu, KG, KG, KG}; pg8::TableOrder<true> S{tab, idx, n, KG}; pg8::EpiSiluMul<F8_DOWN != 0> E{Hm};
            _Pragma("unroll 1") for (int rep = 0; rep < NREP(7); ++rep) pg8::gemm_phase<F8_GU != 0>(wv, lds, g, S, E, W8_SBYTE, 0x7f7f7f7f);
            SEAM(pb + 7);
        }
        if (IN(pb + 8)) {
            PHASE_PTRS;
            LAS int* pblk = (LAS int*)(lds + MOE_LDS); LAS int* tab = pblk + 64; LAS int* aux = tab + 32;
            const int tid = fresh_tid(wv);
            const int NB = moe_prefix(cnt, pblk, tid);
            const int n = moe_table<8>(cnt, pblk, tab, aux, NB, G, bid, tid);
            constexpr int KD = F8_DOWN ? 256 : 512;
            pg8::Gemm g{Hm, Wd, KD, KD, KD}; pg8::TableOrder<false> S{tab, nullptr, n, KD}; pg8::EpiBf16T<F8_YR != 0> E{Yr, DM, 7};
            _Pragma("unroll 1") for (int rep = 0; rep < NREP(8); ++rep) pg8::gemm_phase<F8_DOWN != 0>(wv, lds, g, S, E, W8_SBYTE, 0x7f7f7f7f);
            SEAM(pb + 8);
        }
        if (IN(pb + 9)) _Pragma("unroll 1") for (int rep = 0; rep < NREP(9); ++rep) {
            PHASE_PTRS;
            if (L == 0) phase_combine_ln<false>((const float*)(ctl + CW_DBG), x1b, Yr, tok_e, tok_p, tok_g, cnt, INP(I_LN2G0), INP(I_LN2B0), RC, outb, nullptr, lds, G, bid, fresh_tid(wv));
            else phase_combine_ln<true>((const float*)(ctl + CW_DBG), x1b, Yr, tok_e, tok_p, tok_g, cnt, INP(I_LN2G1), INP(I_LN2B1), nullptr, nullptr, (float*)outb, lds, G, bid, fresh_tid(wv));
            if (rep + 1 == NREP(9)) SEAM(pb + 9);
        }
    }
#undef IN
#undef SEAM
#undef INP
#undef PHASE_PTRS
}

extern "C" void kernel_launch(void* const* d_in, const int* in_sizes, int n_in, void* d_out, int out_size, void* d_ws, size_t ws_size, hipStream_t stream) {
    static int grid = 0;
    if (grid == 0) {
        if (n_in != 28 || out_size != T_ * DM || ws_size < WS_END) { fprintf(stderr, "kernel_launch: unexpected shapes: n_in %d out %d ws %zu (need %zu)\n", n_in, out_size, ws_size, (size_t)WS_END); grid = -1; return; }
        int dev = 0, cus = 0, per_cu = 0;
        if (hipGetDevice(&dev) != hipSuccess || hipDeviceGetAttribute(&cus, hipDeviceAttributeMultiprocessorCount, dev) != hipSuccess) { grid = -1; return; }
        if (hipFuncSetAttribute((const void*)fwd, hipFuncAttributeMaxDynamicSharedMemorySize, LDS_BYTES) != hipSuccess) { fprintf(stderr, "kernel_launch: hipFuncSetAttribute failed\n"); grid = -1; return; }
        if (hipOccupancyMaxActiveBlocksPerMultiprocessor(&per_cu, (const void*)fwd, NTHR, LDS_BYTES) != hipSuccess || per_cu < 1)
            fprintf(stderr, "kernel_launch: occupancy query reports %d workgroups per CU\n", per_cu);
        (void)hipGetLastError();
        grid = cus;
    }
    if (grid < 0) return;
    (void)hipMemsetAsync((char*)d_ws + WS_CTL, 0, CTL_ZERO_BYTES, stream);
    Params p{};
    for (int i = 0; i < 28; ++i) p.in[i] = (const float*)d_in[i];
    p.out = (float*)d_out; p.ws = (unsigned char*)d_ws;
#if N_LAUNCH_MODE == 1
    p.ph_lo = 0; p.ph_hi = N_PHASES;
    hipLaunchKernelGGL(fwd, dim3(grid), dim3(NTHR), LDS_BYTES, stream, p);
#else
    for (int k = 0; k < N_PHASES; ++k) { if (k == 3 || k == 10) continue; p.ph_lo = k; p.ph_hi = k + 1;
        hipLaunchKernelGGL(fwd, dim3(grid), dim3(NTHR), LDS_BYTES, stream, p); }
#endif
    const hipError_t le = hipPeekAtLastError();
    if (le != hipSuccess) fprintf(stderr, "kernel_launch: launch failed: %s\n", hipGetErrorName(le));
}
```

```cpp
#include <hip/hip_runtime.h>
#include <cstdio>
#include <cstdint>
#include <type_traits>

#ifndef N_LAUNCH_MODE
#define N_LAUNCH_MODE 1
#endif
#ifndef DBG_CHECK
#define DBG_CHECK 0
#endif
#ifndef DBG_TOL
#define DBG_TOL 0.3f
#endif
#ifndef F8_DOWN
#define F8_DOWN 1
#endif
#ifndef F8_GU
#define F8_GU 1
#endif
#ifndef F8_IN
#define F8_IN 1
#endif
#ifndef F8_OUT
#define F8_OUT 1
#endif
#ifndef F8_ATTA
#define F8_ATTA 1
#endif
#ifndef F8_ATTD
#define F8_ATTD 1
#endif
#ifndef F8_YR
#define F8_YR 1
#endif

#define LAS __attribute__((address_space(3)))
typedef unsigned short bf16_t;
typedef short bf16x8 __attribute__((ext_vector_type(8)));
typedef short s16x4 __attribute__((ext_vector_type(4)));
typedef float f32x2 __attribute__((ext_vector_type(2)));
typedef float f32x4 __attribute__((ext_vector_type(4)));
typedef float f32x8 __attribute__((ext_vector_type(8)));
typedef float f32x16 __attribute__((ext_vector_type(16)));
typedef unsigned u32x2 __attribute__((ext_vector_type(2)));
typedef unsigned u32x4 __attribute__((ext_vector_type(4)));
typedef int i32x8 __attribute__((ext_vector_type(8)));
typedef _Float16 f16x8 __attribute__((ext_vector_type(8)));
typedef _Float16 f16x2 __attribute__((ext_vector_type(2)));
typedef int i32x4 __attribute__((ext_vector_type(4)));

constexpr int T_ = 32768, DM = 2048, SEQ = 4096, NBATCH = 8;
constexpr int IN0 = 4608, IN1 = 3904, IN1P = 4096;
constexpr int NE = 32, DE = 512, MAXBLK = 288;
constexpr float ALPHA = 1.4142135623730951f;
constexpr float LOG2E = 1.4426950408889634f;
constexpr int NTHR = 512;

constexpr size_t MiB = 1u << 20;
constexpr size_t WS_CTL = 0, CTL_ZERO_BYTES = 1 * MiB;
constexpr size_t WS_LIST = 1 * MiB;
constexpr size_t WS_TOKE = 9 * MiB;
constexpr size_t WS_TOKP = WS_TOKE + 256 * 1024;
constexpr size_t WS_TOKG = WS_TOKP + 256 * 1024;
constexpr size_t WS_RSTAT = WS_TOKG + 256 * 1024;
constexpr size_t WS_KROPE = 10 * MiB;
constexpr size_t WS_WIN0 = 16 * MiB, WS_WOUT0 = 34 * MiB, WS_WGU0 = 42 * MiB, WS_WD0 = 170 * MiB;
constexpr size_t WS_WIN1 = 234 * MiB, WS_WOUT1 = 250 * MiB, WS_WGU1 = 258 * MiB, WS_WD1 = 386 * MiB;
constexpr size_t WS_WQUP = 450 * MiB, WS_WKVUP = 452 * MiB;
constexpr size_t WS_RA = 454 * MiB, WS_RB = 582 * MiB, WS_RC = 870 * MiB, WS_END = 998 * MiB;
constexpr size_t OUT_QD = 0, OUT_O1 = 96 * MiB;
constexpr int CW_CNT = 64;
constexpr int CW_DBG = 512;
constexpr int CW_BAR = 4096;

constexpr int LDS_BYTES = 155648;
constexpr int MISC_OFF = LDS_BYTES - 64;

__device__ __forceinline__ unsigned cvtpk(float lo, float hi) { unsigned r; asm volatile("v_cvt_pk_bf16_f32 %0, %1, %2" : "=v"(r) : "v"(lo), "v"(hi)); return r; }
__device__ __forceinline__ float bf2f(unsigned short b) { return __uint_as_float(((unsigned)b) << 16); }
__device__ __forceinline__ float bflo(unsigned w) { return __uint_as_float(w << 16); }
__device__ __forceinline__ float bfhi(unsigned w) { return __uint_as_float(w & 0xffff0000u); }
__device__ __forceinline__ bf16_t f2bf(float f) { return (bf16_t)(cvtpk(f, f) & 0xffffu); }
__device__ __forceinline__ unsigned pk4_fp8(float a, float b, float c, float d) { int w = 0; w = __builtin_amdgcn_cvt_pk_fp8_f32(a, b, w, false); w = __builtin_amdgcn_cvt_pk_fp8_f32(c, d, w, true); return (unsigned)w; }
constexpr float O8_SCALE = 16.f;
__device__ __forceinline__ unsigned char f2fp8(float v) { return (unsigned char)(__builtin_amdgcn_cvt_pk_fp8_f32(v, v, 0, false) & 0xff); }
__device__ __forceinline__ float clamp8(float v) { return fminf(fmaxf(v, -400.f), 400.f); }
__device__ __forceinline__ int fresh_tid(int wv) { int l; asm volatile("v_mbcnt_lo_u32_b32 %0, -1, 0\n\tv_mbcnt_hi_u32_b32 %0, -1, %0" : "=v"(l)); return wv * 64 + l; }
__device__ __forceinline__ float fresh_zero() { float z; asm volatile("v_mov_b32 %0, 0" : "=v"(z)); return z; }
__device__ __forceinline__ float wave_sum(float v) {
    v += __int_as_float(__builtin_amdgcn_ds_swizzle(__float_as_int(v), (1 << 10) | 0x1f));
    v += __int_as_float(__builtin_amdgcn_ds_swizzle(__float_as_int(v), (2 << 10) | 0x1f));
    v += __int_as_float(__builtin_amdgcn_ds_swizzle(__float_as_int(v), (4 << 10) | 0x1f));
    v += __int_as_float(__builtin_amdgcn_ds_swizzle(__float_as_int(v), (8 << 10) | 0x1f));
    v += __int_as_float(__builtin_amdgcn_ds_swizzle(__float_as_int(v), (16 << 10) | 0x1f));
    auto rr = __builtin_amdgcn_permlane32_swap(__float_as_uint(v), __float_as_uint(v), false, false);
    return __uint_as_float(rr[0]) + __uint_as_float(rr[1]);
}
__device__ __forceinline__ float wave_max(float v) {
    v = fmaxf(v, __int_as_float(__builtin_amdgcn_ds_swizzle(__float_as_int(v), (1 << 10) | 0x1f)));
    v = fmaxf(v, __int_as_float(__builtin_amdgcn_ds_swizzle(__float_as_int(v), (2 << 10) | 0x1f)));
    v = fmaxf(v, __int_as_float(__builtin_amdgcn_ds_swizzle(__float_as_int(v), (4 << 10) | 0x1f)));
    v = fmaxf(v, __int_as_float(__builtin_amdgcn_ds_swizzle(__float_as_int(v), (8 << 10) | 0x1f)));
    v = fmaxf(v, __int_as_float(__builtin_amdgcn_ds_swizzle(__float_as_int(v), (16 << 10) | 0x1f)));
    auto rr = __builtin_amdgcn_permlane32_swap(__float_as_uint(v), __float_as_uint(v), false, false);
    return fmaxf(__uint_as_float(rr[0]), __uint_as_float(rr[1]));
}
__device__ __forceinline__ float inv_freq32(int i) { return __builtin_amdgcn_exp2f(-(float)i * 0.41524101186092029f); }
__device__ __forceinline__ void sincos_rev(float angle, float& s, float& c) {
    float rev = angle * 0.15915494309189535f; rev = rev - floorf(rev);
    s = __builtin_amdgcn_sinf(rev); c = __builtin_amdgcn_cosf(rev);
}

#define XB_TMO      128
#define XB_XCNT(j)  (256  + 64 * (j))
#define XB_XSUB(j)  (1280 + 64 * (j))
#define XB_XGEN(j)  (2304 + 64 * (j))
#define XB_TOP      3328
#define XB_TOPGEN   3392
#define XCD_BAR_WORDS 3456
#define XB_SPIN_CAP (1u << 20)
__device__ __forceinline__ unsigned xb_ld(unsigned* p)              { return __hip_atomic_load(p, __ATOMIC_RELAXED, __HIP_MEMORY_SCOPE_AGENT); }
__device__ __forceinline__ unsigned xb_add(unsigned* p, unsigned v) { return __hip_atomic_fetch_add(p, v, __ATOMIC_RELAXED, __HIP_MEMORY_SCOPE_AGENT); }
__device__ __forceinline__ unsigned xb_xcc_id() { return (unsigned)__builtin_amdgcn_s_getreg((3 << 11) | 20) & 0xFu; }
#define XB_SPIN(cond, bar) do { unsigned _sp = 0; while (cond) { __builtin_amdgcn_s_sleep(1); \
    if ((++_sp & 255u) == 0u) { if (xb_ld(&(bar)[XB_TMO])) break; if (_sp > XB_SPIN_CAP) { atomicAdd(&(bar)[XB_TMO], 1u); break; } } } } while (0)
struct XcdBarrier { unsigned* bar; unsigned x; volatile LAS unsigned* st; };
__device__ __forceinline__ XcdBarrier xcd_barrier_post(unsigned* bar, volatile LAS unsigned* st) {
    XcdBarrier b; b.bar = bar; b.x = xb_xcc_id(); b.st = st;
    if (threadIdx.x == 0) (void)xb_add(&bar[XB_XCNT(b.x)], 1u);
    return b;
}
__device__ __forceinline__ void xcd_barrier_complete(unsigned* bar, unsigned x, unsigned& nloc, unsigned& nx) {
    const unsigned G = gridDim.x * gridDim.y * gridDim.z;
    unsigned sum, cnt, mine, sp = 0u;
    for (;;) {
        sum = 0u; cnt = 0u; mine = 0u;
#pragma unroll
        for (unsigned j = 0; j < 16; ++j) { const unsigned c = xb_ld(&bar[XB_XCNT(j)]); sum += c; cnt += (c > 0u) ? 1u : 0u; mine = (j == x) ? c : mine; }
        if (sum == G) break;
        __builtin_amdgcn_s_sleep(1);
        if ((++sp & 255u) == 0u) { if (xb_ld(&bar[XB_TMO])) break; if (sp > XB_SPIN_CAP) { atomicAdd(&bar[XB_TMO], 1u); break; } }
    }
    nloc = mine > 0u ? mine : 1u; nx = cnt > 0u ? cnt : 1u;
}
__device__ __forceinline__ void xcd_barrier(const XcdBarrier& b, int tid_now) {
    asm volatile("s_waitcnt vmcnt(0)" ::: "memory");
    __syncthreads();
    if (tid_now == 0) {
        unsigned* bar = b.bar;
        __builtin_amdgcn_s_waitcnt(0);
        unsigned nloc = b.st[0], nx = b.st[1];
        if (nloc == 0u) { xcd_barrier_complete(bar, b.x, nloc, nx); b.st[0] = nloc; b.st[1] = nx; }
        const unsigned old = xb_add(&bar[XB_XSUB(b.x)], 1u);
        const unsigned gen = old / nloc;
        if (old + 1u == (gen + 1u) * nloc) {
            __builtin_amdgcn_fence(__ATOMIC_RELEASE, "agent");
            asm volatile("s_waitcnt vmcnt(0)" ::: "memory");
            const unsigned og = xb_add(&bar[XB_TOP], 1u);
            const unsigned tg = og / nx;
            if (og + 1u == (tg + 1u) * nx) xb_add(&bar[XB_TOPGEN], 1u);
            else XB_SPIN(xb_ld(&bar[XB_TOPGEN]) == tg, bar);
            __builtin_amdgcn_fence(__ATOMIC_ACQUIRE, "agent");
            xb_add(&bar[XB_XGEN(b.x)], 1u);
            asm volatile("s_waitcnt vmcnt(0)" ::: "memory");
        } else {
            XB_SPIN(xb_ld(&bar[XB_XGEN(b.x)]) == gen, bar);
            __builtin_amdgcn_fence(__ATOMIC_ACQUIRE, "agent");
            asm volatile("s_waitcnt vmcnt(0)" ::: "memory");
        }
    }
    __syncthreads();
}

namespace pg8 {
constexpr int BM = 256, BK = 64, HALF = 128, HTB = HALF * BK * 2, STAGE_BYTES = 8 * HTB, NXCD = 8, WGM = 8;
__device__ __forceinline__ int lds_byte(int r, int c) { const int st = (r >> 4) * 2 + (c >> 5), rr = r & 15, cc = c & 31, ob = rr * 64 + cc * 2; return st * 1024 + (ob ^ (((ob >> 9) & 1) << 5)); }
__device__ __forceinline__ void stage_rc(int b, int& R, int& C) { const int st = b / 1024, sb = b % 1024, swz = sb ^ (((sb >> 9) & 1) << 5); R = (st >> 1) * 16 + swz / 64; C = (st & 1) * 32 + (swz % 64) / 2; }
__device__ __forceinline__ int perm32(int rho) { const int n = rho >> 4, i = rho & 15; return 8 * (i >> 2) + 4 * n + (i & 3); }
struct Unit { int pm, pn, q; };
struct Gemm { const bf16_t* A; const bf16_t* Bt; int K, lda, ldb; };

struct StaticOrder {
    static constexpr bool GATHER = false;
    int nM, nN, nwg, G, c, lda;
    __device__ void init(int M, int N, int G_, int c_, int lda_) { nM = M / BM; nN = N / BM; nwg = nM * nN; G = G_; c = c_; lda = lda_; }
    __device__ __forceinline__ bool next(int i, Unit& u) const {
        const long L = (long)i * G + c; if (L >= nwg) return false;
        int wgid = (int)L; { const int q = nwg / NXCD, r = nwg % NXCD, xcd = wgid % NXCD, off = wgid / NXCD; wgid = (xcd < r ? xcd * (q + 1) : r * (q + 1) + (xcd - r) * q) + off; }
        const int nig = WGM * nN, gid = wgid / nig, fm = gid * WGM, gsz = (nM - fm) < WGM ? (nM - fm) : WGM;
        u.pm = fm + ((wgid % nig) % gsz); u.pn = (wgid % nig) / gsz; u.q = i; return true;
    }
    __device__ __forceinline__ void aoff(const Unit& u, const int (&R)[2], const int (&C)[2], unsigned (&o)[2][2]) const {
#pragma unroll
        for (int h = 0; h < 2; ++h)
#pragma unroll
            for (int i = 0; i < 2; ++i) o[h][i] = (unsigned)((u.pm * BM + h * HALF + R[i]) * lda + C[i]) * 2u;
    }
};
template <bool GATHER_> struct TableOrder {
    static constexpr bool GATHER = GATHER_;
    const LAS int* tab; const LAS int* idx; int n, lda;
    __device__ __forceinline__ bool next(int i, Unit& u) const { if (i >= n) return false; u.pm = tab[i]; u.pn = tab[16 + i]; u.q = i; return true; }
    __device__ __forceinline__ void aoff(const Unit& u, const int (&R)[2], const int (&C)[2], unsigned (&o)[2][2]) const {
#pragma unroll
        for (int h = 0; h < 2; ++h)
#pragma unroll
            for (int i = 0; i < 2; ++i) { const int row = GATHER ? idx[u.q * 256 + h * HALF + R[i]] : (u.pm * BM + h * HALF + R[i]); o[h][i] = (unsigned)(row * lda + C[i]) * 2u; }
    }
};

template <bool O8> struct EpiBf16T {
    static constexpr bool PERM = true;
    bf16_t* O; int ldc; int pnmask;
    __device__ __forceinline__ void operator()(const f32x4 (&acc)[2][2][4][2], const Unit& u, int wr, int wc, int fr, int fq) const {
        const int row0 = u.pm * BM + wr * 64 + fr; const int col0 = (u.pn & pnmask) * BM + wc * 32 + 8 * fq;
#pragma unroll
        for (int ai = 0; ai < 2; ++ai)
#pragma unroll
            for (int m = 0; m < 4; ++m) { const size_t eoff = (size_t)(row0 + ai * HALF + m * 16) * ldc + col0;
#pragma unroll
                for (int bj = 0; bj < 2; ++bj) { const f32x4 v0 = acc[ai][bj][m][0], v1 = acc[ai][bj][m][1];
                    if constexpr (O8) { u32x2 w; w.x = pk4_fp8(v0[0] * 16.f, v0[1] * 16.f, v0[2] * 16.f, v0[3] * 16.f); w.y = pk4_fp8(v1[0] * 16.f, v1[1] * 16.f, v1[2] * 16.f, v1[3] * 16.f);
                        *(u32x2*)((unsigned char*)O + eoff + bj * HALF) = w; }
                    else { u32x4 w; w.x = cvtpk(v0[0], v0[1]); w.y = cvtpk(v0[2], v0[3]); w.z = cvtpk(v1[0], v1[1]); w.w = cvtpk(v1[2], v1[3]);
                        *(u32x4*)(O + eoff + bj * HALF) = w; } } }
    }
};
typedef EpiBf16T<false> EpiBf16;
struct EpiRowScale {
    static constexpr bool PERM = true;
    bf16_t* O; int ldc; const float* rs; int which;
    __device__ __forceinline__ void operator()(const f32x4 (&acc)[2][2][4][2], const Unit& u, int wr, int wc, int fr, int fq) const {
        const int row0 = u.pm * BM + wr * 64 + fr; const int col0 = u.pn * BM + wc * 32 + 8 * fq;
#pragma unroll
        for (int ai = 0; ai < 2; ++ai)
#pragma unroll
            for (int m = 0; m < 4; ++m) { const int row = row0 + ai * HALF + m * 16; const float s = rs[row * 2 + which]; bf16_t* rowp = O + (size_t)row * ldc + col0;
#pragma unroll
                for (int bj = 0; bj < 2; ++bj) { const f32x4 v0 = acc[ai][bj][m][0] * s, v1 = acc[ai][bj][m][1] * s;
                    u32x4 w; w.x = cvtpk(v0[0], v0[1]); w.y = cvtpk(v0[2], v0[3]); w.z = cvtpk(v1[0], v1[1]); w.w = cvtpk(v1[2], v1[3]);
                    *(u32x4*)(rowp + bj * HALF) = w; } }
    }
};
struct EpiKV8 {
    static constexpr bool PERM = true;
    unsigned char* K8; unsigned char* Vt8; bf16_t* KV; bool wr_bf16;
    __device__ __forceinline__ void operator()(const f32x4 (&acc)[2][2][4][2], const Unit& u, int wr, int wc, int fr, int fq) const {
        const int row0 = u.pm * BM + wr * 64 + fr; const int c0 = wc * 32 + 8 * fq;
#pragma unroll
        for (int ai = 0; ai < 2; ++ai)
#pragma unroll
            for (int m = 0; m < 4; ++m) { const int row = row0 + ai * HALF + m * 16;
                { const f32x4 v0 = acc[ai][0][m][0], v1 = acc[ai][0][m][1];
                  *(u32x2*)(K8 + (size_t)row * 1024 + u.pn * 128 + c0) = (u32x2){pk4_fp8(v0[0], v0[1], v0[2], v0[3]), pk4_fp8(v1[0], v1[1], v1[2], v1[3])}; }
                { const f32x4 v0 = acc[ai][1][m][0], v1 = acc[ai][1][m][1]; const float vv[8] = {v0[0], v0[1], v0[2], v0[3], v1[0], v1[1], v1[2], v1[3]};
                  unsigned char* vp = Vt8 + ((size_t)((row >> 12) * 8 + u.pn) * 128 + c0) * SEQ + (row & (SEQ - 1));
#pragma unroll
                  for (int e = 0; e < 8; ++e) vp[(size_t)e * SEQ] = f2fp8(vv[e]); }
                if (wr_bf16) {
#pragma unroll
                    for (int bj = 0; bj < 2; ++bj) { const f32x4 v0 = acc[ai][bj][m][0], v1 = acc[ai][bj][m][1];
                        u32x4 w; w.x = cvtpk(v0[0], v0[1]); w.y = cvtpk(v0[2], v0[3]); w.z = cvtpk(v1[0], v1[1]); w.w = cvtpk(v1[2], v1[3]);
                        *(u32x4*)(KV + (size_t)row * DM + u.pn * BM + bj * HALF + c0) = w; } } }
    }
};
template <bool O8> struct EpiSiluMul {
    static constexpr bool PERM = true;
    bf16_t* O;
    __device__ __forceinline__ void operator()(const f32x4 (&acc)[2][2][4][2], const Unit& u, int wr, int wc, int fr, int fq) const {
        const int row0 = u.pm * BM + wr * 64 + fr; const int col0 = (u.pn & 3) * HALF + wc * 32 + 8 * fq;
#pragma unroll
        for (int ai = 0; ai < 2; ++ai)
#pragma unroll
            for (int m = 0; m < 4; ++m) { const size_t eoff = (size_t)(row0 + ai * HALF + m * 16) * DE + col0; float h[8];
#pragma unroll
                for (int n = 0; n < 2; ++n)
#pragma unroll
                    for (int j = 0; j < 4; ++j) { const float g = acc[ai][0][m][n][j], up = acc[ai][1][m][n][j];
                        const float sg = g * __builtin_amdgcn_rcpf(1.0f + __builtin_amdgcn_exp2f(-g * LOG2E)); h[n * 4 + j] = sg * up; }
                if constexpr (O8) { u32x2 w; w.x = pk4_fp8(clamp8(h[0]), clamp8(h[1]), clamp8(h[2]), clamp8(h[3])); w.y = pk4_fp8(clamp8(h[4]), clamp8(h[5]), clamp8(h[6]), clamp8(h[7]));
                    *(u32x2*)((unsigned char*)O + eoff) = w; }
                else { u32x4 w; w.x = cvtpk(h[0], h[1]); w.y = cvtpk(h[2], h[3]); w.z = cvtpk(h[4], h[5]); w.w = cvtpk(h[6], h[7]);
                    *(u32x4*)(O + eoff) = w; } }
    }
};
template <bool RES_F32> struct EpiResF32 {
    static constexpr bool PERM = false;
    float* Z; const void* res;
    __device__ __forceinline__ void operator()(const f32x4 (&acc)[2][2][4][2], const Unit& u, int wr, int wc, int fr, int fq) const {
        const int row0 = u.pm * BM + wr * 64 + fr, col0 = u.pn * BM + wc * 32 + 4 * fq;
        float ALPHA = 1.4142135623730951f; asm volatile("" : "+v"(ALPHA));
#pragma unroll
        for (int ai = 0; ai < 2; ++ai)
#pragma unroll
            for (int m = 0; m < 4; ++m) { const size_t off = (size_t)(row0 + ai * HALF + m * 16) * DM + col0;
#pragma unroll
                for (int bj = 0; bj < 2; ++bj)
#pragma unroll
                    for (int n = 0; n < 2; ++n) { f32x4 o = acc[ai][bj][m][n];
                        if constexpr (RES_F32) { const f32x4 rv = *(const f32x4*)((const float*)res + off + bj * HALF + n * 16); o += ALPHA * rv; }
                        else { const u32x2 rb = *(const u32x2*)((const bf16_t*)res + off + bj * HALF + n * 16);
                            o[0] += ALPHA * bflo(rb.x); o[1] += ALPHA * bfhi(rb.x); o[2] += ALPHA * bflo(rb.y); o[3] += ALPHA * bfhi(rb.y); }
                        *(f32x4*)(Z + off + bj * HALF + n * 16) = o; } }
    }
};

template <bool F8, class Epi, class Sched>
__device__ __forceinline__ void gemm_phase(int wv, LAS unsigned char* lds, const Gemm g, const Sched& S, const Epi& E, int sW = 0x7f7f7f7f, int sX = 0x7f7f7f7f) {
    constexpr bool GA = Sched::GATHER;
    const int tid = fresh_tid(wv), wid = __builtin_amdgcn_readfirstlane(tid >> 6), lane = tid & 63, wr = wid >> 2, wc = wid & 3, fr = lane & 15, fq = lane >> 4;
    int K = g.K; asm volatile("" : "+s"(K));
    const int nt = K / BK;
    int Rr[2], Cc[2]; unsigned voffA[2], voffB[2];
#pragma unroll
    for (int i = 0; i < 2; ++i) { int R, C; stage_rc(tid * 16 + i * 8192, R, C); Rr[i] = R; Cc[i] = C; const int Rb = Epi::PERM ? ((R & ~31) + perm32(R & 31)) : R;
        voffA[i] = (unsigned)(R * g.lda + C) * 2u; voffB[i] = (unsigned)(Rb * g.ldb + C) * 2u; }
    const size_t kstep = (size_t)(BK * 2);
    const size_t hstepA = (size_t)HALF * g.lda * 2, tstepA = 2 * hstepA;
    const size_t hstepB = (size_t)HALF * g.ldb * 2, tstepB = 2 * hstepB;
    const unsigned ldsw = (unsigned)wid * 1024u;
    const int aoff = lds_byte(wr * 64 + fr, fq * 8), boff = lds_byte(wc * 32 + fr, fq * 8);
#define PG8_SA(b, h) (((b) * 2 + (h)) * HTB)
#define PG8_SB(b, h) ((4 + (b) * 2 + (h)) * HTB)
#define PG8_STAGE(bufoff, gbase, voff) do { _Pragma("unroll") for (int _i = 0; _i < 2; ++_i) \
        __builtin_amdgcn_global_load_lds((const unsigned*)((const char*)(gbase) + (voff)[_i]), (LAS unsigned*)(lds + (bufoff) + ldsw + _i * 8192), 16, 0, 0); } while (0)
#define PG8_STAGE_A(bufoff, h, pbase, koff, goffs) do { if constexpr (GA) { PG8_STAGE(bufoff, gA + (koff), (goffs)[h]); } else { PG8_STAGE(bufoff, (pbase) + (h) * hstepA, voffA); } } while (0)
#define PG8_LD32(dst, off) do { const i32x4 _lo = *(const LAS i32x4*)(lds + (off)), _hi = *(const LAS i32x4*)(lds + (off) + 1024); dst = __builtin_shufflevector(_lo, _hi, 0, 1, 2, 3, 4, 5, 6, 7); } while (0)
#define PG8_LDA(dst, b, h) do { _Pragma("unroll") for (int m = 0; m < 4; ++m) PG8_LD32(dst[m], PG8_SA(b, h) + aoff + m * 2048); } while (0)
#define PG8_LDB(dst, b, h) do { _Pragma("unroll") for (int n = 0; n < 2; ++n) PG8_LD32(dst[n], PG8_SB(b, h) + boff + n * 2048); } while (0)
#define PG8_LOH(v) __builtin_bit_cast(bf16x8, __builtin_shufflevector(v, v, 0, 1, 2, 3))
#define PG8_HIH(v) __builtin_bit_cast(bf16x8, __builtin_shufflevector(v, v, 4, 5, 6, 7))
#define PG8_MMA(ai, bj, At, Bt) do { __builtin_amdgcn_s_setprio(1); \
        if constexpr (F8) { _Pragma("unroll") for (int m = 0; m < 4; ++m) _Pragma("unroll") for (int n = 0; n < 2; ++n) \
            asm volatile("v_mfma_scale_f32_16x16x128_f8f6f4 %0, %1, %2, %0, %3, %4 op_sel_hi:[0,0,0]" : "+v"(acc[ai][bj][m][n]) : "v"(Bt[n]), "v"(At[m]), "v"(sW), "v"(sX)); } \
        else { _Pragma("unroll") for (int m = 0; m < 4; ++m) _Pragma("unroll") for (int n = 0; n < 2; ++n) { \
            acc[ai][bj][m][n] = __builtin_amdgcn_mfma_f32_16x16x32_bf16(PG8_LOH(Bt[n]), PG8_LOH(At[m]), acc[ai][bj][m][n], 0, 0, 0); \
            acc[ai][bj][m][n] = __builtin_amdgcn_mfma_f32_16x16x32_bf16(PG8_HIH(Bt[n]), PG8_HIH(At[m]), acc[ai][bj][m][n], 0, 0, 0); } } \
        __builtin_amdgcn_s_setprio(0); } while (0)
#define PG8_WAIT_V(n) asm volatile("s_waitcnt vmcnt(" #n ")" ::: "memory")
#define PG8_WAIT_L(n) asm volatile("s_waitcnt lgkmcnt(" #n ")" ::: "memory")
#define PG8_BAR __builtin_amdgcn_s_barrier()
#define PG8_SCHED __builtin_amdgcn_sched_barrier(0)
    Unit cur, nxt; int ui = 0;
    if (!S.next(0, cur)) return;
    f32x4 acc[2][2][4][2];
#pragma unroll
    for (int a = 0; a < 2; ++a)
#pragma unroll
        for (int b = 0; b < 2; ++b)
#pragma unroll
            for (int m = 0; m < 4; ++m)
#pragma unroll
                for (int n = 0; n < 2; ++n) { const float zf = fresh_zero(); acc[a][b][m][n] = (f32x4){zf, zf, zf, zf}; }
    unsigned ca[2][2];
    if constexpr (GA) S.aoff(cur, Rr, Cc, ca);
    const char* gA = (const char*)g.A;
    const char* cA = gA + (GA ? (size_t)0 : (size_t)cur.pm * tstepA);
    const char* cB = (const char*)g.Bt + (size_t)cur.pn * tstepB;
    PG8_STAGE(PG8_SB(0, 0), cB, voffB); PG8_STAGE_A(PG8_SA(0, 0), 0, cA, 0, ca); PG8_STAGE(PG8_SB(0, 1), cB + hstepB, voffB); PG8_STAGE_A(PG8_SA(0, 1), 1, cA, 0, ca);
    if (wr == 1) PG8_BAR;
    PG8_WAIT_V(4); PG8_BAR;
    PG8_STAGE(PG8_SB(1, 0), cB + kstep, voffB); PG8_STAGE_A(PG8_SA(1, 0), 0, cA + kstep, kstep, ca); PG8_STAGE(PG8_SB(1, 1), cB + hstepB + kstep, voffB);
    PG8_WAIT_V(6); PG8_BAR;
    for (;;) {
        const bool has_next = S.next(ui + 1, nxt);
        const char* nA = (!GA && has_next) ? gA + (size_t)nxt.pm * tstepA : cA;
        const char* nB = has_next ? (const char*)g.Bt + (size_t)nxt.pn * tstepB : cB;
#pragma unroll 1
        for (int t = 0; t < nt; t += 2) {
            const bool last = (t == nt - 2);
            const size_t k1 = (size_t)(t + 1) * kstep, k2 = last ? (size_t)0 : (size_t)(t + 2) * kstep, k3 = k2 + kstep;
            const char* a1 = cA + k1;
            const char* a2 = last ? nA : cA + k2; const char* b2 = last ? nB : cB + (size_t)(t + 2) * kstep;
            const char* a3 = a2 + kstep; const char* b3 = b2 + kstep;
            i32x8 At[4], B0[2], B1[2];
            unsigned xa[2][2];
            if constexpr (GA) {
                if (last && has_next) { int R2[2], C2[2]; const int t2 = fresh_tid(wv); stage_rc(t2 * 16, R2[0], C2[0]); stage_rc(t2 * 16 + 8192, R2[1], C2[1]); S.aoff(nxt, R2, C2, xa); }
                else {
#pragma unroll
                    for (int h = 0; h < 2; ++h)
#pragma unroll
                        for (int i = 0; i < 2; ++i) xa[h][i] = ca[h][i];
                }
            }
            PG8_LDB(B0, 0, 0); PG8_SCHED; PG8_LDA(At, 0, 0); PG8_STAGE_A(PG8_SA(1, 1), 1, a1, k1, ca);
            PG8_WAIT_L(8); PG8_BAR; PG8_WAIT_L(0); PG8_MMA(0, 0, At, B0); PG8_BAR; PG8_SCHED;
            PG8_LDB(B1, 0, 1); PG8_STAGE(PG8_SB(0, 0), b2, voffB);
            PG8_BAR; PG8_WAIT_L(0); PG8_MMA(0, 1, At, B1); PG8_BAR;
            PG8_LDA(At, 0, 1); PG8_STAGE_A(PG8_SA(0, 0), 0, a2, k2, xa);
            PG8_BAR; PG8_WAIT_L(0); PG8_MMA(1, 0, At, B0); PG8_BAR; PG8_SCHED;
            PG8_STAGE(PG8_SB(0, 1), b2 + hstepB, voffB);
            PG8_WAIT_V(6); PG8_BAR; PG8_MMA(1, 1, At, B1); PG8_BAR;
            PG8_LDB(B0, 1, 0); PG8_SCHED; PG8_LDA(At, 1, 0); PG8_STAGE_A(PG8_SA(0, 1), 1, a2, k2, xa);
            PG8_WAIT_L(8); PG8_BAR; PG8_WAIT_L(0); PG8_MMA(0, 0, At, B0); PG8_BAR; PG8_SCHED;
            PG8_LDB(B1, 1, 1); PG8_STAGE(PG8_SB(1, 0), b3, voffB);
            PG8_BAR; PG8_WAIT_L(0); PG8_MMA(0, 1, At, B1); PG8_BAR;
            PG8_LDA(At, 1, 1); PG8_STAGE_A(PG8_SA(1, 0), 0, a3, k3, xa);
            PG8_BAR; PG8_WAIT_L(0); PG8_MMA(1, 0, At, B0); PG8_BAR; PG8_SCHED;
            PG8_STAGE(PG8_SB(1, 1), b3 + hstepB, voffB);
            PG8_WAIT_V(6); PG8_BAR; PG8_MMA(1, 1, At, B1); PG8_BAR;
        }
        if constexpr (F8) asm volatile("s_nop 7\n\ts_nop 7\n\ts_nop 7" ::: "memory");
        { const int l2 = fresh_tid(0); E(acc, cur, wr, wc, l2 & 15, l2 >> 4); }
        if (!has_next) break;
#pragma unroll
        for (int a = 0; a < 2; ++a)
#pragma unroll
            for (int b = 0; b < 2; ++b)
#pragma unroll
                for (int m = 0; m < 4; ++m)
#pragma unroll
                    for (int n = 0; n < 2; ++n) { const float zf = fresh_zero(); acc[a][b][m][n] = (f32x4){zf, zf, zf, zf}; }
        cur = nxt; cA = nA; cB = nB; ++ui;
        if constexpr (GA) { int R2[2], C2[2]; const int t2 = fresh_tid(wv); stage_rc(t2 * 16, R2[0], C2[0]); stage_rc(t2 * 16 + 8192, R2[1], C2[1]); S.aoff(cur, R2, C2, ca); }
    }
    PG8_WAIT_V(0);
    if (wr == 0) PG8_BAR;
    PG8_BAR;
#undef PG8_SA
#undef PG8_SB
#undef PG8_STAGE
#undef PG8_STAGE_A
#undef PG8_LDA
#undef PG8_LDB
#undef PG8_MMA
#undef PG8_LD32
#undef PG8_LOH
#undef PG8_HIH
#undef PG8_WAIT_V
#undef PG8_WAIT_L
#undef PG8_BAR
#undef PG8_SCHED
}
}

namespace da {
constexpr int KVBLK = 64;
constexpr float THR = 8.f;
constexpr int SHM_V = KVBLK * 128 * 2, SHM_K = KVBLK * 128 * 2, SHM_KR = KVBLK * 64 * 2;
constexpr int OFF_V = 0, OFF_K = 2 * SHM_V, OFF_WS = OFF_K + 2 * SHM_K, OFF_KR = OFF_WS + 8 * 64 * 4, OFF_QR = OFF_KR + 2 * SHM_KR, LDS_DENSE = OFF_QR + 8 * 4096;
#define KSWZ(row, colB) ((row) * 256 + ((colB) ^ (((row) & 7) << 4)))
#define KRSWZ(row, ch) ((row) * 128 + ((((ch) ^ ((row) >> 1)) & 7) << 4))
#define SBAR() __builtin_amdgcn_sched_barrier(0)
__device__ __forceinline__ int crow(int r, int hi) { return (r & 3) + 8 * (r >> 2) + 4 * hi; }
__device__ __forceinline__ int v_st(int k, int c) { const int kk = (k & ~0xC) | ((k & 4) << 1) | ((k & 8) >> 1); return ((kk >> 3) * 4 + (c >> 5)) * 512 + ((kk & 7) * 32 + (c & 31)) * 2; }
__device__ __forceinline__ int v_rd_base(int lane) { return ((lane & 3) << 3) | (((lane >> 2) & 3) << 6) | (((lane >> 4) & 1) << 5) | (((lane >> 5) & 1) << 8); }
constexpr int v_rd_off(int d0, int ks, int half) { return d0 * 512 + ks * 4096 + half * 2048; }
template <int OFF> __device__ __forceinline__ s16x4 tr_read(int vb) {
    s16x4 r; asm volatile("ds_read_b64_tr_b16 %0, %1 offset:%2" : "=&v"(r) : "v"(vb), "i"(OFF) : "memory"); return r;
}
template <int D0> __device__ __forceinline__ void pv_one(f32x16& od, int vb, bf16x8 pa0, bf16x8 pa1, bf16x8 pa2, bf16x8 pa3) {
    const s16x4 l0 = tr_read<v_rd_off(D0, 0, 0)>(vb), h0 = tr_read<v_rd_off(D0, 0, 1)>(vb), l1 = tr_read<v_rd_off(D0, 1, 0)>(vb), h1 = tr_read<v_rd_off(D0, 1, 1)>(vb);
    const s16x4 l2 = tr_read<v_rd_off(D0, 2, 0)>(vb), h2 = tr_read<v_rd_off(D0, 2, 1)>(vb), l3 = tr_read<v_rd_off(D0, 3, 0)>(vb), h3 = tr_read<v_rd_off(D0, 3, 1)>(vb);
    asm volatile("s_waitcnt lgkmcnt(0)" ::: "memory"); SBAR();
#define PK(L, H) (bf16x8){L[0], L[1], L[2], L[3], H[0], H[1], H[2], H[3]}
    od = __builtin_amdgcn_mfma_f32_32x32x16_bf16(pa0, PK(l0, h0), od, 0, 0, 0);
    od = __builtin_amdgcn_mfma_f32_32x32x16_bf16(pa1, PK(l1, h1), od, 0, 0, 0);
    od = __builtin_amdgcn_mfma_f32_32x32x16_bf16(pa2, PK(l2, h2), od, 0, 0, 0);
    od = __builtin_amdgcn_mfma_f32_32x32x16_bf16(pa3, PK(l3, h3), od, 0, 0, 0);
}
__device__ __forceinline__ void pv_d0(f32x16* o, int vb, bf16x8 pa0, bf16x8 pa1, bf16x8 pa2, bf16x8 pa3) {
    pv_one<0>(o[0], vb, pa0, pa1, pa2, pa3); pv_one<1>(o[1], vb, pa0, pa1, pa2, pa3); pv_one<2>(o[2], vb, pa0, pa1, pa2, pa3); pv_one<3>(o[3], vb, pa0, pa1, pa2, pa3);
}
template <int D0> __device__ __forceinline__ void pv_one32(f32x16& od, int vb, bf16x8 pa0, bf16x8 pa1) {
    const s16x4 l0 = tr_read<v_rd_off(D0, 0, 0)>(vb), h0 = tr_read<v_rd_off(D0, 0, 1)>(vb), l1 = tr_read<v_rd_off(D0, 1, 0)>(vb), h1 = tr_read<v_rd_off(D0, 1, 1)>(vb);
    asm volatile("s_waitcnt lgkmcnt(0)" ::: "memory"); SBAR();
    od = __builtin_amdgcn_mfma_f32_32x32x16_bf16(pa0, PK(l0, h0), od, 0, 0, 0);
    od = __builtin_amdgcn_mfma_f32_32x32x16_bf16(pa1, PK(l1, h1), od, 0, 0, 0);
}
#undef PK
#define PK4(P, BASE, OUT) do { unsigned a0 = cvtpk(P[BASE + 0], P[BASE + 1]), a1 = cvtpk(P[BASE + 2], P[BASE + 3]);   \
    unsigned b0 = cvtpk(P[BASE + 4], P[BASE + 5]), b1 = cvtpk(P[BASE + 6], P[BASE + 7]);                              \
    auto r0 = __builtin_amdgcn_permlane32_swap(a0, b0, false, false); auto r1 = __builtin_amdgcn_permlane32_swap(a1, b1, false, false); \
    u32x4 w = {r0[0], r1[0], r0[1], r1[1]}; OUT = *reinterpret_cast<bf16x8*>(&w); } while (0)

template <int NDQ> struct Cst { static constexpr float SCALE = (NDQ == 8) ? 0.088388347648318440f : 0.072168783648703220f; static constexpr float C = SCALE * LOG2E; };

template <int NDQ>
__device__ __forceinline__ void partialSM(f32x16& p0, f32x16& p1, float& m_reg, float& mn, float& alpha) {
    constexpr float C = Cst<NDQ>::C, SCALE = Cst<NDQ>::SCALE;
    float pmax = p0[0];
#pragma unroll
    for (int r = 1; r < 16; ++r) pmax = fmaxf(pmax, p0[r]);
#pragma unroll
    for (int r = 0; r < 16; ++r) pmax = fmaxf(pmax, p1[r]);
    { auto rr = __builtin_amdgcn_permlane32_swap(__float_as_uint(pmax), __float_as_uint(pmax), false, false);
      pmax = fmaxf(__uint_as_float(rr[0]), __uint_as_float(rr[1])); }
    if (__builtin_expect(__all(pmax - m_reg <= THR / SCALE), 1)) { mn = m_reg; alpha = 1.f; }
    else { mn = fmaxf(m_reg, pmax); alpha = __builtin_amdgcn_exp2f((m_reg - mn) * C); m_reg = mn; }
    const float mnC = -mn * C;
#pragma unroll
    for (int r = 0; r < 16; ++r) p0[r] = fmaf(p0[r], C, mnC);
#pragma unroll
    for (int r = 0; r < 16; ++r) p1[r] = fmaf(p1[r], C, mnC);
#pragma unroll
    for (int r = 0; r < 16; ++r) p0[r] = __builtin_amdgcn_exp2f(p0[r]);
}
__device__ __forceinline__ void finishSM(f32x16& p0, f32x16& p1, float alpha, float& l_reg, bf16x8& pa0, bf16x8& pa1, bf16x8& pa2, bf16x8& pa3) {
#pragma unroll
    for (int r = 0; r < 16; ++r) p1[r] = __builtin_amdgcn_exp2f(p1[r]);
    float ps = 0;
#pragma unroll
    for (int r = 0; r < 16; ++r) ps += p0[r];
#pragma unroll
    for (int r = 0; r < 16; ++r) ps += p1[r];
    { auto rr = __builtin_amdgcn_permlane32_swap(__float_as_uint(ps), __float_as_uint(ps), false, false);
      ps = __uint_as_float(rr[0]) + __uint_as_float(rr[1]); }
    l_reg = l_reg * alpha + ps;
    PK4(p0, 0, pa0); PK4(p0, 8, pa1); PK4(p1, 0, pa2); PK4(p1, 8, pa3);
}
template <int NDQ>
__device__ __forceinline__ void qkt(f32x16& p0, f32x16& p1, const char* Ks, const char* Krs, const bf16x8* qr, const char* qrl, int r32, int hi) {
    p0 = f32x16{}; p1 = f32x16{};
#pragma unroll
    for (int d0 = 0; d0 < 8; ++d0) { const int cb = (d0 * 16 + hi * 8) * 2;
        bf16x8 b0 = *reinterpret_cast<const bf16x8*>(Ks + KSWZ(r32, cb));
        bf16x8 b1 = *reinterpret_cast<const bf16x8*>(Ks + KSWZ(32 + r32, cb));
        p0 = __builtin_amdgcn_mfma_f32_32x32x16_bf16(b0, qr[d0], p0, 0, 0, 0);
        p1 = __builtin_amdgcn_mfma_f32_32x32x16_bf16(b1, qr[d0], p1, 0, 0, 0); }
    if constexpr (NDQ == 12) {
#pragma unroll
        for (int d0 = 0; d0 < 4; ++d0) { const int ch = d0 * 2 + hi;
            bf16x8 b0 = *reinterpret_cast<const bf16x8*>(Krs + KRSWZ(r32, ch));
            bf16x8 b1 = *reinterpret_cast<const bf16x8*>(Krs + KRSWZ(32 + r32, ch));
            const bf16x8 qf = *reinterpret_cast<const bf16x8*>(qrl + d0 * 1024);
            p0 = __builtin_amdgcn_mfma_f32_32x32x16_bf16(b0, qf, p0, 0, 0, 0);
            p1 = __builtin_amdgcn_mfma_f32_32x32x16_bf16(b1, qf, p1, 0, 0, 0); }
    }
}

struct DArgs { const bf16_t* Q; const bf16_t* K; const bf16_t* V; const bf16_t* Kr; bf16_t* O; int ldq, ldk, ldv, ldo; int seq; int pos0; };

template <int NDQ, int SDEPTH>
__device__ __forceinline__ void attn_dense_body(int wv, const DArgs a, char* lds) {
    const int tid = fresh_tid(wv), wid = tid >> 6, lane = tid & 63, r32 = lane & 31, hi = lane >> 5;
    char* V_lds = lds + OFF_V; char* K_lds = lds + OFF_K; char* Kr_lds = lds + OFF_KR;
    float* ws = (float*)(lds + OFF_WS) + wid * 64; float* li_l = ws; float* al_l = ws + 32;
    float m_reg = -1e30f, l_reg = 0; f32x16 o[4] = {}; bf16x8 qr[8];
    char* qrl = lds + OFF_QR + wid * 4096 + lane * 16;
    const bf16_t* Qw = a.Q + (long)(wid * 32 + r32) * a.ldq + hi * 8;
#pragma unroll
    for (int d0 = 0; d0 < 8; ++d0) qr[d0] = *reinterpret_cast<const bf16x8*>(Qw + d0 * 16);
    if constexpr (NDQ == 12) {
        const float pos = (float)(a.pos0 + wid * 32 + r32);
#pragma unroll
        for (int f = 0; f < 2; ++f) {
            const bf16x8 x1v = *reinterpret_cast<const bf16x8*>(Qw + (8 + f) * 16), x2v = *reinterpret_cast<const bf16x8*>(Qw + (10 + f) * 16); bf16x8 y1v, y2v;
#pragma unroll
            for (int j = 0; j < 8; ++j) { const int i = f * 16 + hi * 8 + j; float sn, cs; sincos_rev(pos * inv_freq32(i), sn, cs);
                const float x1 = bf2f((unsigned short)x1v[j]), x2 = bf2f((unsigned short)x2v[j]);
                y1v[j] = (short)f2bf(x1 * cs - x2 * sn); y2v[j] = (short)f2bf(x2 * cs + x1 * sn); }
            *reinterpret_cast<bf16x8*>(qrl + f * 1024) = y1v; *reinterpret_cast<bf16x8*>(qrl + (2 + f) * 1024) = y2v;
        }
    }
    const int sr = tid >> 4, sc = (tid & 15) * 8, vst0 = v_st(sr, sc), vst1 = v_st(32 + sr, sc);
    const int krr = tid >> 3, krc = tid & 7;
    const int vb0 = (int)(uintptr_t)V_lds + v_rd_base(lane);
    struct { bf16x8 vs0, vs1, ks0, ks1, kr; } sr_[SDEPTH];
#define SLOAD(i, k0) do { sr_[i].vs0 = *(const bf16x8*)(a.V + (long)((k0) + sr) * a.ldv + sc); sr_[i].vs1 = *(const bf16x8*)(a.V + (long)((k0) + 32 + sr) * a.ldv + sc); \
    sr_[i].ks0 = *(const bf16x8*)(a.K + (long)((k0) + sr) * a.ldk + sc); sr_[i].ks1 = *(const bf16x8*)(a.K + (long)((k0) + 32 + sr) * a.ldk + sc); \
    if constexpr (NDQ == 12) sr_[i].kr = *(const bf16x8*)(a.Kr + (long)((k0) + krr) * 64 + krc * 8); } while (0)
#define SWRITE(b, i) do { *(bf16x8*)(V_lds + (b) * SHM_V + vst0) = sr_[i].vs0; *(bf16x8*)(V_lds + (b) * SHM_V + vst1) = sr_[i].vs1; const int kc = sc * 2; \
    *(bf16x8*)(K_lds + (b) * SHM_K + KSWZ(sr, kc)) = sr_[i].ks0; *(bf16x8*)(K_lds + (b) * SHM_K + KSWZ(32 + sr, kc)) = sr_[i].ks1; \
    if constexpr (NDQ == 12) *(bf16x8*)(Kr_lds + (b) * SHM_KR + KRSWZ(krr, krc)) = sr_[i].kr; } while (0)
#define SWAIT() do { if constexpr (SDEPTH == 2) { if constexpr (NDQ == 12) asm volatile("s_waitcnt vmcnt(5)" ::: "memory"); else asm volatile("s_waitcnt vmcnt(4)" ::: "memory"); } else asm volatile("s_waitcnt vmcnt(0)" ::: "memory"); } while (0)
#define RESC(al) do { if (__any((al) < 1.f)) { if (hi == 0) al_l[r32] = (al); asm volatile("s_waitcnt lgkmcnt(0)" ::: "memory"); \
    _Pragma("unroll") for (int d = 0; d < 4; ++d) _Pragma("unroll") for (int r = 0; r < 16; ++r) o[d][r] *= al_l[crow(r, hi)]; } } while (0)
    f32x16 pA0, pA1, pB0, pB1; float mnA, mnB, alA, alB; bf16x8 pa0, pa1, pa2, pa3; const int NT = a.seq / KVBLK;
    constexpr int SE = 0, SO = SDEPTH - 1;
    SLOAD(SE, 0); asm volatile("s_waitcnt vmcnt(0)" ::: "memory"); SWRITE(0, SE); __syncthreads();
    qkt<NDQ>(pA0, pA1, K_lds, Kr_lds, qr, qrl, r32, hi); partialSM<NDQ>(pA0, pA1, m_reg, mnA, alA);
    SLOAD(SO, KVBLK); if constexpr (SDEPTH == 2) { if (2 < NT) SLOAD(SE, 2 * KVBLK); }
    SWAIT(); SWRITE(1, SO); __syncthreads();
#pragma unroll 1
    for (int j = 1; j + 1 < NT; j += 2) {
        SBAR(); qkt<NDQ>(pB0, pB1, K_lds + SHM_K, Kr_lds + SHM_KR, qr, qrl, r32, hi);
        finishSM(pA0, pA1, alA, l_reg, pa0, pa1, pa2, pa3); SBAR();
        SLOAD(SO, (j + SDEPTH) * KVBLK); SBAR();
        pv_d0(o, vb0, pa0, pa1, pa2, pa3); partialSM<NDQ>(pB0, pB1, m_reg, mnB, alB);
        __syncthreads(); SWAIT(); SWRITE(0, SE);
        RESC(alB); __syncthreads();
        SBAR(); qkt<NDQ>(pA0, pA1, K_lds, Kr_lds, qr, qrl, r32, hi);
        finishSM(pB0, pB1, alB, l_reg, pa0, pa1, pa2, pa3); SBAR();
        if (SDEPTH == 1 || j + 3 < NT) SLOAD(SE, (j + 1 + SDEPTH) * KVBLK); SBAR();
        pv_d0(o, vb0 + (int)SHM_V, pa0, pa1, pa2, pa3); partialSM<NDQ>(pA0, pA1, m_reg, mnA, alA);
        __syncthreads(); SWAIT(); SWRITE(1, SO);
        RESC(alA); __syncthreads();
    }
    SBAR(); qkt<NDQ>(pB0, pB1, K_lds + SHM_K, Kr_lds + SHM_KR, qr, qrl, r32, hi);
    finishSM(pA0, pA1, alA, l_reg, pa0, pa1, pa2, pa3); SBAR();
    pv_d0(o, vb0, pa0, pa1, pa2, pa3); partialSM<NDQ>(pB0, pB1, m_reg, mnB, alB);
    __syncthreads(); RESC(alB);
    finishSM(pB0, pB1, alB, l_reg, pa0, pa1, pa2, pa3); SBAR();
    pv_d0(o, vb0 + (int)SHM_V, pa0, pa1, pa2, pa3);
    if (hi == 0) li_l[r32] = l_reg; asm volatile("s_waitcnt lgkmcnt(0)" ::: "memory");
    float rli[16];
#pragma unroll
    for (int r = 0; r < 16; ++r) rli[r] = __builtin_amdgcn_rcpf(li_l[crow(r, hi)]);
    bf16_t* Ow = F8_OUT ? (bf16_t*)((unsigned char*)a.O + (long)(wid * 32) * a.ldo) : a.O + (long)(wid * 32) * a.ldo;
#pragma unroll
    for (int r = 0; r < 16; ++r) { const int orow = crow(r, hi);
#pragma unroll
        for (int d0 = 0; d0 < 4; ++d0) { if constexpr (F8_OUT) ((unsigned char*)Ow)[(long)orow * a.ldo + d0 * 32 + r32] = f2fp8(o[d0][r] * rli[r] * O8_SCALE); else Ow[(long)orow * a.ldo + d0 * 32 + r32] = f2bf(o[d0][r] * rli[r]); } }
#undef SLOAD
#undef SWRITE
#undef SWAIT
#undef RESC
}

constexpr int SP_WAVE_LDS = 18688;
template <class P>
__device__ __forceinline__ void sparse_wave(P& pol, LAS unsigned char* wll, int lane) {
    const int r32 = lane & 31, hi = lane >> 5;
    char* wl = (char*)wll;
    char* Kl = wl; char* Vl = wl + 8192; float* li_l = (float*)(wl + 16384); float* al_l = li_l + 32;
    bf16x8 qr[8];
    { const bf16_t* qp = pol.qptr(r32) + hi * 8;
#pragma unroll
      for (int d0 = 0; d0 < 8; ++d0) qr[d0] = *reinterpret_cast<const bf16x8*>(qp + d0 * 16); }
    asm volatile("s_waitcnt vmcnt(0)" ::: "memory");
    f32x16 o[4] = {}; float m_reg = -1e30f, l_reg = 0.f;
    const int krow0 = lane >> 4;
    const int kce = (((lane & 15) ^ (krow0 & 7)) * 8), kco = (((lane & 15) ^ ((4 + krow0) & 7)) * 8);
    const int vk0 = 8 * ((lane >> 4) & 1) + ((lane >> 2) & 3), vc0 = 32 * (lane >> 5) + 8 * (lane & 3);
    const int vb = (int)(uintptr_t)Vl + v_rd_base(lane);
    const int nt = pol.ntiles();
    typename P::TI ti, tn;
#define SP_DMA_K(T) do { _Pragma("unroll") for (int i = 0; i < 8; ++i) { const bf16_t* src = (T).k + (long)(4 * i + krow0) * (T).rs + ((i & 1) ? kco : kce); \
        __builtin_amdgcn_global_load_lds((const unsigned*)src, (LAS unsigned*)(wll + i * 1024), 16, 0, 0); } } while (0)
#define SP_DMA_V(T) do { _Pragma("unroll") for (int i = 0; i < 8; ++i) { const bf16_t* src = (T).v + (long)(16 * (i >> 2) + 4 * ((i >> 1) & 1) + vk0) * (T).rs + 64 * (i & 1) + vc0; \
        __builtin_amdgcn_global_load_lds((const unsigned*)src, (LAS unsigned*)(wll + 8192 + i * 1024), 16, 0, 0); } } while (0)
    pol.tile(0, ti);
    SP_DMA_K(ti); SP_DMA_V(ti);
#pragma unroll 1
    for (int j = 0; j < nt; ++j) {
        const bool more = (j + 1 < nt);
        if (more) pol.tile(j + 1, tn);
        asm volatile("s_waitcnt vmcnt(8)" ::: "memory");
        f32x16 p = f32x16{};
#pragma unroll
        for (int d0 = 0; d0 < 8; ++d0) { const int cb = (d0 * 16 + hi * 8) * 2;
            bf16x8 b0 = *reinterpret_cast<const bf16x8*>(Kl + KSWZ(r32, cb));
            p = __builtin_amdgcn_mfma_f32_32x32x16_bf16(b0, qr[d0], p, 0, 0, 0); }
        asm volatile("s_waitcnt lgkmcnt(0)" ::: "memory"); SBAR();
        if (more) SP_DMA_K(tn);
        SBAR();
        float pmax = -INFINITY;
#pragma unroll
        for (int r = 0; r < 16; ++r) { p[r] = pol.adj(ti, crow(r, hi), p[r]); pmax = fmaxf(pmax, p[r]); }
        { auto rr = __builtin_amdgcn_permlane32_swap(__float_as_uint(pmax), __float_as_uint(pmax), false, false);
          pmax = fmaxf(__uint_as_float(rr[0]), __uint_as_float(rr[1])); }
        const float mn = fmaxf(m_reg, pmax); const float alpha = __builtin_amdgcn_exp2f(m_reg - mn); m_reg = mn;
        float ps = 0.f;
#pragma unroll
        for (int r = 0; r < 16; ++r) { p[r] = __builtin_amdgcn_exp2f(p[r] - mn); ps += p[r]; }
        { auto rr = __builtin_amdgcn_permlane32_swap(__float_as_uint(ps), __float_as_uint(ps), false, false);
          ps = __uint_as_float(rr[0]) + __uint_as_float(rr[1]); }
        l_reg = l_reg * alpha + ps;
        if (__any(alpha < 1.f)) { if (hi == 0) al_l[r32] = alpha; asm volatile("s_waitcnt lgkmcnt(0)" ::: "memory");
#pragma unroll
            for (int d = 0; d < 4; ++d)
#pragma unroll
                for (int r = 0; r < 16; ++r) o[d][r] *= al_l[crow(r, hi)]; }
        bf16x8 pa0, pa1; PK4(p, 0, pa0); PK4(p, 8, pa1);
        SBAR();
        if (more) asm volatile("s_waitcnt vmcnt(8)" ::: "memory"); else asm volatile("s_waitcnt vmcnt(0)" ::: "memory");
        SBAR();
        pv_one32<0>(o[0], vb, pa0, pa1); pv_one32<1>(o[1], vb, pa0, pa1); pv_one32<2>(o[2], vb, pa0, pa1); pv_one32<3>(o[3], vb, pa0, pa1);
        SBAR();
        if (more) SP_DMA_V(tn);
        SBAR();
        ti = tn;
    }
#undef SP_DMA_K
#undef SP_DMA_V
    if (hi == 0) li_l[r32] = l_reg; asm volatile("s_waitcnt lgkmcnt(0)" ::: "memory");
#pragma unroll
    for (int r = 0; r < 16; ++r) { const int qn = crow(r, hi); const float rl = __builtin_amdgcn_rcpf(li_l[qn]); bf16_t* op = pol.optr(qn);
#pragma unroll
        for (int d0 = 0; d0 < 4; ++d0) { if constexpr (F8_OUT) ((unsigned char*)op)[d0 * 32 + r32] = f2fp8(o[d0][r] * rl * O8_SCALE); else op[d0 * 32 + r32] = f2bf(o[d0][r] * rl); } }
}
#undef PK4
}

#define SBAR() __builtin_amdgcn_sched_barrier(0)
namespace d8 {
constexpr int K8_BYTES = 64 * 128, KR8_BYTES = 64 * 64, VT_PITCH = 80, VT_BYTES = 128 * VT_PITCH;
constexpr int OFF_K8 = 0, OFF_KR8 = 2 * K8_BYTES, OFF_VT = OFF_KR8 + 2 * KR8_BYTES, OFF_WS8 = OFF_VT + 2 * VT_BYTES, LDS_D8 = OFF_WS8 + 8 * 64 * 4;
constexpr float THR8 = 4.f;
#define K8SWZ(row, ch) ((row) * 128 + ((((ch) ^ ((row) >> 1)) & 7) << 4))
#define KR8SWZ(row, ch) ((row) * 64 + ((((ch) ^ ((row) >> 2)) & 3) << 4))
__device__ __forceinline__ int krow_of(int a) { const int hi = a >> 5, j = a & 31; return da::crow(j & 15, hi) + 32 * (j >> 4); }
struct D8Args { const bf16_t* Q; const unsigned char* K8; const unsigned char* Kr8; const unsigned char* Vt8; bf16_t* O; int ldq, ldk, ldvt, ldo; int seq; int pos0; };
template <int NKS> struct Cst8 { static constexpr float SCALE = (NKS == 2) ? 0.088388347648318440f : 0.072168783648703220f; static constexpr float C = SCALE * LOG2E; };
#define D8_LD32(dst, p) do { const i32x4 _lo = *(const i32x4*)(p), _hi = *(const i32x4*)((p) + 16); dst = __builtin_shufflevector(_lo, _hi, 0, 1, 2, 3, 4, 5, 6, 7); } while (0)
#define D8_MX(a, b, c) __builtin_amdgcn_mfma_scale_f32_32x32x64_f8f6f4(a, b, c, 0, 0, 0, 0x7f7f7f7f, 0, 0x7f7f7f7f)
template <int NKS>
__device__ __forceinline__ void qkt8(f32x16& p0, f32x16& p1, const char* Ks, const char* Krs, const i32x8* qf, int r32, int hi) {
    p0 = f32x16{}; p1 = f32x16{};
#pragma unroll
    for (int sK = 0; sK < 2; ++sK) { i32x8 a0, a1; const int ch = 4 * sK + 2 * hi;
        { const i32x4 lo = *(const i32x4*)(Ks + K8SWZ(r32, ch)), hh = *(const i32x4*)(Ks + K8SWZ(r32, ch + 1)); a0 = __builtin_shufflevector(lo, hh, 0, 1, 2, 3, 4, 5, 6, 7); }
        { const i32x4 lo = *(const i32x4*)(Ks + K8SWZ(32 + r32, ch)), hh = *(const i32x4*)(Ks + K8SWZ(32 + r32, ch + 1)); a1 = __builtin_shufflevector(lo, hh, 0, 1, 2, 3, 4, 5, 6, 7); }
        p0 = D8_MX(a0, qf[sK], p0); p1 = D8_MX(a1, qf[sK], p1); }
    if constexpr (NKS == 3) { i32x8 a0, a1; const int ch = 2 * hi;
        { const i32x4 lo = *(const i32x4*)(Krs + KR8SWZ(r32, ch)), hh = *(const i32x4*)(Krs + KR8SWZ(r32, ch + 1)); a0 = __builtin_shufflevector(lo, hh, 0, 1, 2, 3, 4, 5, 6, 7); }
        { const i32x4 lo = *(const i32x4*)(Krs + KR8SWZ(32 + r32, ch)), hh = *(const i32x4*)(Krs + KR8SWZ(32 + r32, ch + 1)); a1 = __builtin_shufflevector(lo, hh, 0, 1, 2, 3, 4, 5, 6, 7); }
        p0 = D8_MX(a0, qf[2], p0); p1 = D8_MX(a1, qf[2], p1); }
}
template <int NKS>
__device__ __forceinline__ void partialSM8(f32x16& p0, f32x16& p1, float& m_reg, float& mn, float& alpha) {
    constexpr float C = Cst8<NKS>::C, SCALE = Cst8<NKS>::SCALE;
    float pmax = p0[0];
#pragma unroll
    for (int r = 1; r < 16; ++r) pmax = fmaxf(pmax, p0[r]);
#pragma unroll
    for (int r = 0; r < 16; ++r) pmax = fmaxf(pmax, p1[r]);
    { auto rr = __builtin_amdgcn_permlane32_swap(__float_as_uint(pmax), __float_as_uint(pmax), false, false);
      pmax = fmaxf(__uint_as_float(rr[0]), __uint_as_float(rr[1])); }
    if (__builtin_expect(__all(pmax - m_reg <= THR8 / SCALE), 1)) { mn = m_reg; alpha = 1.f; }
    else { mn = fmaxf(m_reg, pmax); alpha = __builtin_amdgcn_exp2f((m_reg - mn) * C); m_reg = mn; }
    const float mnC = -mn * C;
#pragma unroll
    for (int r = 0; r < 16; ++r) p0[r] = fmaf(p0[r], C, mnC);
#pragma unroll
    for (int r = 0; r < 16; ++r) p1[r] = fmaf(p1[r], C, mnC);
#pragma unroll
    for (int r = 0; r < 16; ++r) p0[r] = __builtin_amdgcn_exp2f(p0[r]);
}
__device__ __forceinline__ void finishSM8(f32x16& p0, f32x16& p1, float alpha, float& l_reg, i32x8& pa) {
#pragma unroll
    for (int r = 0; r < 16; ++r) p1[r] = __builtin_amdgcn_exp2f(p1[r]);
    float ps = 0;
#pragma unroll
    for (int r = 0; r < 16; ++r) ps += p0[r];
#pragma unroll
    for (int r = 0; r < 16; ++r) ps += p1[r];
    { auto rr = __builtin_amdgcn_permlane32_swap(__float_as_uint(ps), __float_as_uint(ps), false, false);
      ps = __uint_as_float(rr[0]) + __uint_as_float(rr[1]); }
    l_reg = l_reg * alpha + ps;
    pa = (i32x8){(int)pk4_fp8(p0[0], p0[1], p0[2], p0[3]), (int)pk4_fp8(p0[4], p0[5], p0[6], p0[7]), (int)pk4_fp8(p0[8], p0[9], p0[10], p0[11]), (int)pk4_fp8(p0[12], p0[13], p0[14], p0[15]),
                 (int)pk4_fp8(p1[0], p1[1], p1[2], p1[3]), (int)pk4_fp8(p1[4], p1[5], p1[6], p1[7]), (int)pk4_fp8(p1[8], p1[9], p1[10], p1[11]), (int)pk4_fp8(p1[12], p1[13], p1[14], p1[15])};
}
__device__ __forceinline__ void pv8(f32x16* o, const char* Vt, const i32x8 pa, int r32, int hi) {
#pragma unroll
    for (int d0 = 0; d0 < 4; ++d0) { const char* vp = Vt + (32 * d0 + r32) * VT_PITCH + 32 * hi; i32x8 bfr;
        { const i32x4 lo = *(const i32x4*)vp, hh = *(const i32x4*)(vp + 16); bfr = __builtin_shufflevector(lo, hh, 0, 1, 2, 3, 4, 5, 6, 7); }
        o[d0] = D8_MX(pa, bfr, o[d0]); }
}
template <int NKS>
__device__ __forceinline__ void attn_dense8_body(int wv, const D8Args a, char* lds) {
    const int tid = fresh_tid(wv), wid = tid >> 6, lane = tid & 63, r32 = lane & 31, hi = lane >> 5;
    char* K_lds = lds + OFF_K8; char* Kr_lds = lds + OFF_KR8; char* Vt_lds = lds + OFF_VT;
    float* ws = (float*)(lds + OFF_WS8) + wid * 64; float* li_l = ws; float* al_l = ws + 32;
    float m_reg = -1e30f, l_reg = 0; f32x16 o[4] = {}; i32x8 qf[NKS];
    { const bf16_t* Qw = a.Q + (long)(wid * 32 + r32) * a.ldq;
#pragma unroll
      for (int sK = 0; sK < 2; ++sK) { const bf16_t* qp = Qw + 64 * sK + 32 * hi; unsigned w[8];
#pragma unroll
          for (int c = 0; c < 4; ++c) { const u32x4 v = *(const u32x4*)(qp + 8 * c);
              w[2 * c] = pk4_fp8(bflo(v.x), bfhi(v.x), bflo(v.y), bfhi(v.y)); w[2 * c + 1] = pk4_fp8(bflo(v.z), bfhi(v.z), bflo(v.w), bfhi(v.w)); }
          qf[sK] = (i32x8){(int)w[0], (int)w[1], (int)w[2], (int)w[3], (int)w[4], (int)w[5], (int)w[6], (int)w[7]}; }
      if constexpr (NKS == 3) {
          const float pos = (float)(a.pos0 + wid * 32 + r32); const bf16_t* qp = Qw + 128; unsigned w[8];
#pragma unroll
          for (int c = 0; c < 4; ++c) { const u32x4 v1 = *(const u32x4*)(qp + 8 * c), v2 = *(const u32x4*)(qp + 32 + 8 * c);
              const unsigned a1[4] = {v1.x, v1.y, v1.z, v1.w}, a2[4] = {v2.x, v2.y, v2.z, v2.w}; float y[8];
#pragma unroll
              for (int e = 0; e < 8; ++e) { const int i = 8 * c + e; float sn, cs; sincos_rev(pos * inv_freq32(i), sn, cs);
                  const float x1 = (e & 1) ? bfhi(a1[e >> 1]) : bflo(a1[e >> 1]), x2 = (e & 1) ? bfhi(a2[e >> 1]) : bflo(a2[e >> 1]);
                  y[e] = hi ? (x2 * cs + x1 * sn) : (x1 * cs - x2 * sn); }
              w[2 * c] = pk4_fp8(y[0], y[1], y[2], y[3]); w[2 * c + 1] = pk4_fp8(y[4], y[5], y[6], y[7]); }
          qf[2] = (i32x8){(int)w[0], (int)w[1], (int)w[2], (int)w[3], (int)w[4], (int)w[5], (int)w[6], (int)w[7]}; } }
    const int ka = tid >> 3, kch = tid & 7, kdst = K8SWZ(krow_of(ka), kch);
    const int vc = tid >> 2, vq = tid & 3, vdst = vc * VT_PITCH + vq * 16;
    const int ra = (tid >> 2) & 63, rch = tid & 3, rdst = KR8SWZ(krow_of(ra), rch);
    struct { u32x4 k, v, r; } sr_[2];
#define SLOAD8(i, k0) do { sr_[i].k = *(const u32x4*)(a.K8 + (long)((k0) + ka) * a.ldk + kch * 16); sr_[i].v = *(const u32x4*)(a.Vt8 + (long)vc * a.ldvt + (k0) + vq * 16); \
    if constexpr (NKS == 3) sr_[i].r = *(const u32x4*)(a.Kr8 + (long)((k0) + ra) * 64 + rch * 16); } while (0)
#define SWRITE8(b, i) do { *(u32x4*)(K_lds + (b) * K8_BYTES + kdst) = sr_[i].k; *(u32x4*)(Vt_lds + (b) * VT_BYTES + vdst) = sr_[i].v; \
    if constexpr (NKS == 3) *(u32x4*)(Kr_lds + (b) * KR8_BYTES + rdst) = sr_[i].r; } while (0)
#define RESC8(al) do { if (__any((al) < 1.f)) { if (hi == 0) al_l[r32] = (al); asm volatile("s_waitcnt lgkmcnt(0)" ::: "memory"); \
    _Pragma("unroll") for (int d = 0; d < 4; ++d) _Pragma("unroll") for (int r = 0; r < 16; ++r) o[d][r] *= al_l[da::crow(r, hi)]; } } while (0)
    f32x16 pA0, pA1, pB0, pB1; float mnA, mnB, alA, alB; i32x8 pa; const int NT = a.seq / 64;
    SLOAD8(0, 0); asm volatile("s_waitcnt vmcnt(0)" ::: "memory"); SWRITE8(0, 0); __syncthreads();
    qkt8<NKS>(pA0, pA1, K_lds, Kr_lds, qf, r32, hi); partialSM8<NKS>(pA0, pA1, m_reg, mnA, alA);
    SLOAD8(1, 64); if (2 < NT) SLOAD8(0, 128);
    if constexpr (NKS == 3) asm volatile("s_waitcnt vmcnt(3)" ::: "memory"); else asm volatile("s_waitcnt vmcnt(2)" ::: "memory");
    SWRITE8(1, 1); __syncthreads();
#pragma unroll 1
    for (int j = 1; j + 1 < NT; j += 2) {
        SBAR(); qkt8<NKS>(pB0, pB1, K_lds + K8_BYTES, Kr_lds + KR8_BYTES, qf, r32, hi);
        finishSM8(pA0, pA1, alA, l_reg, pa); SBAR();
        SLOAD8(1, (j + 2) * 64); SBAR();
        pv8(o, Vt_lds, pa, r32, hi); partialSM8<NKS>(pB0, pB1, m_reg, mnB, alB);
        __syncthreads(); if constexpr (NKS == 3) asm volatile("s_waitcnt vmcnt(3)" ::: "memory"); else asm volatile("s_waitcnt vmcnt(2)" ::: "memory");
        SWRITE8(0, 0);
        RESC8(alB); __syncthreads();
        SBAR(); qkt8<NKS>(pA0, pA1, K_lds, Kr_lds, qf, r32, hi);
        finishSM8(pB0, pB1, alB, l_reg, pa); SBAR();
        if (j + 3 < NT) SLOAD8(0, (j + 3) * 64); SBAR();
        pv8(o, Vt_lds + VT_BYTES, pa, r32, hi); partialSM8<NKS>(pA0, pA1, m_reg, mnA, alA);
        __syncthreads(); if constexpr (NKS == 3) asm volatile("s_waitcnt vmcnt(3)" ::: "memory"); else asm volatile("s_waitcnt vmcnt(2)" ::: "memory");
        SWRITE8(1, 1);
        RESC8(alA); __syncthreads();
    }
    SBAR(); qkt8<NKS>(pB0, pB1, K_lds + K8_BYTES, Kr_lds + KR8_BYTES, qf, r32, hi);
    finishSM8(pA0, pA1, alA, l_reg, pa); SBAR();
    pv8(o, Vt_lds, pa, r32, hi); partialSM8<NKS>(pB0, pB1, m_reg, mnB, alB);
    __syncthreads(); RESC8(alB);
    finishSM8(pB0, pB1, alB, l_reg, pa); SBAR();
    pv8(o, Vt_lds + VT_BYTES, pa, r32, hi);
    if (hi == 0) li_l[r32] = l_reg; asm volatile("s_waitcnt lgkmcnt(0)" ::: "memory");
    float rli[16];
#pragma unroll
    for (int r = 0; r < 16; ++r) rli[r] = __builtin_amdgcn_rcpf(li_l[da::crow(r, hi)]);
    bf16_t* Ow = F8_OUT ? (bf16_t*)((unsigned char*)a.O + (long)(wid * 32) * a.ldo) : a.O + (long)(wid * 32) * a.ldo;
#pragma unroll
    for (int r = 0; r < 16; ++r) { const int orow = da::crow(r, hi);
#pragma unroll
        for (int d0 = 0; d0 < 4; ++d0) { if constexpr (F8_OUT) ((unsigned char*)Ow)[(long)orow * a.ldo + d0 * 32 + r32] = f2fp8(o[d0][r] * rli[r] * O8_SCALE); else Ow[(long)orow * a.ldo + d0 * 32 + r32] = f2bf(o[d0][r] * rli[r]); } }
#undef SLOAD8
#undef SWRITE8
#undef RESC8
}
#undef D8_LD32
#undef D8_MX
}


struct PolB {
    struct TI { const bf16_t* k; const bf16_t* v; long rs; int kpos0; int iq; float cd; };
    const bf16_t* H0; bf16_t* O; int b, h, a, r16, myn; int lo3, n3, lo2, n2, lo1, n1; float slope2;
    __device__ __forceinline__ void init(const bf16_t* H0_, bf16_t* O_, int w, int lane) {
        H0 = H0_; O = O_; b = w >> 10; h = (w >> 7) & 7; const int wu = w & 127; a = wu >> 4; r16 = wu & 15; myn = lane & 31;
        lo3 = max(a - 2, 0); n3 = min(a + 2, 7) - lo3 + 1;
        lo2 = max(4 * a - 2, 0); n2 = min(4 * a + 5, 31) - lo2 + 1;
        lo1 = max(16 * a - 2, 0); n1 = min(16 * a + 17, 127) - lo1 + 1;
        slope2 = __builtin_amdgcn_exp2f(-(float)(h + 1)) * LOG2E;
    }
    __device__ __forceinline__ const bf16_t* qptr(int n) const { return H0 + (long)(b * SEQ + 512 * a + r16 + 16 * n) * IN0 + 1536 + h * 128; }
    __device__ __forceinline__ bf16_t* optr(int qn) const { const long e = (long)(b * SEQ + 512 * a + r16 + 16 * qn) * DM + 1024 + h * 128; return F8_OUT ? (bf16_t*)((unsigned char*)O + e) : O + e; }
    __device__ __forceinline__ int ntiles() const { return n3 + n2 + n1; }
    __device__ __forceinline__ void tile(int j, TI& ti) const {
        int dil, kt, rd;
        if (j < n3) { dil = 16; kt = lo3 + j; rd = r16; }
        else if (j < n3 + n2) { dil = 4; kt = lo2 + (j - n3); rd = r16 & 3; }
        else { dil = 1; kt = lo1 + (j - n3 - n2); rd = 0; }
        const long tok = (long)b * SEQ + dil * 32 * kt + rd;
        ti.k = H0 + tok * IN0 + 2560 + h * 128; ti.v = H0 + tok * IN0 + 3584 + h * 128; ti.rs = (long)dil * IN0;
        ti.kpos0 = 32 * kt; ti.iq = (512 * a + r16 + 16 * myn - rd) / dil; ti.cd = slope2 * (float)dil;
    }
    __device__ __forceinline__ float adj(const TI& ti, int kloc, float s) const {
        const int d = ti.kpos0 + kloc - ti.iq; const int ad = d < 0 ? -d : d;
        return ad <= 64 ? fmaf(s, 0.088388347648318440f * LOG2E, -ti.cd * (float)ad) : -INFINITY;
    }
};
struct PolC {
    struct TI { const bf16_t* k; const bf16_t* v; long rs; int kc0; int drow; };
    const bf16_t* H1; bf16_t* O; const float* tab; int b, h, r, a, r0, qc, c0;
    __device__ __forceinline__ void init(const bf16_t* H1_, bf16_t* O_, const float* rpb, float* tab_, int w, int lane) {
        H1 = H1_; O = O_; tab = tab_; b = w >> 10; h = (w >> 7) & 7; const int wu = w & 127; r = wu >> 1; a = wu & 1;
        r0 = min(max(r - 4, 0), 56); qc = 32 * a + (lane & 31); c0 = min(max(qc - 8, 0), 48);
        for (int idx = lane; idx < 480; idx += 64) { const int dr = idx >> 5, dc = idx & 31; tab_[idx] = dc < 31 ? rpb[h * 465 + dr * 31 + dc] * LOG2E : 0.f; }
        asm volatile("s_waitcnt vmcnt(0) lgkmcnt(0)" ::: "memory");
    }
    __device__ __forceinline__ const bf16_t* qptr(int n) const { return H1 + (long)(b * SEQ + 64 * r + 32 * a + n) * IN1P + h * 128; }
    __device__ __forceinline__ bf16_t* optr(int qn) const { const long e = (long)(b * SEQ + 64 * r + 32 * a + qn) * DM + h * 128; return F8_OUT ? (bf16_t*)((unsigned char*)O + e) : O + e; }
    __device__ __forceinline__ int ntiles() const { return 16; }
    __device__ __forceinline__ void tile(int j, TI& ti) const {
        const int kr = r0 + (j >> 1), ch = j & 1; const long tok = (long)b * SEQ + 64 * kr + 32 * ch;
        ti.k = H1 + tok * IN1P + 1024 + h * 128; ti.v = H1 + tok * IN1P + 2048 + h * 128; ti.rs = IN1P; ti.kc0 = 32 * ch; ti.drow = kr - r + 7;
    }
    __device__ __forceinline__ float adj(const TI& ti, int kloc, float s) const {
        const int kc = ti.kc0 + kloc; const int dc = min(max(kc - qc + 15, 0), 30);
        const float bias = tab[ti.drow * 32 + dc];
        return (kc >= c0 && kc < c0 + 16) ? fmaf(s, 0.088388347648318440f * LOG2E, bias) : -INFINITY;
    }
};

struct Params { const float* in[28]; float* out; unsigned char* ws; int ph_lo, ph_hi; };
enum { I_X = 0, I_RW = 1, I_RB = 2, I_WIN0 = 3, I_AQN = 4, I_AKN = 5, I_WOUT0 = 6, I_LN1G0 = 7, I_LN1B0 = 8, I_WG0 = 9, I_WU0 = 10, I_WD0 = 11, I_LN2G0 = 12, I_LN2B0 = 13,
       I_WIN1 = 14, I_RPB = 15, I_DQN = 16, I_WQUP = 17, I_DKVN = 18, I_WKVUP = 19, I_WOUT1 = 20, I_LN1G1 = 21, I_LN1B1 = 22, I_WG1 = 23, I_WU1 = 24, I_WD1 = 25, I_LN2G1 = 26, I_LN2B1 = 27 };

__device__ __forceinline__ void tr_tile(const float* __restrict__ src, int N, const float* __restrict__ ksc, bf16_t* __restrict__ dst, int ldd, int k0, int n0, int drow0, LAS unsigned* tl, int tid) {
    const int c4 = (tid & 15) * 4;
#pragma unroll
    for (int i = 0; i < 2; ++i) {
        const int kp = (tid >> 4) + 32 * i;
        const float* s0 = src + (size_t)(k0 + 2 * kp) * N + n0 + c4;
        f32x4 a = *(const f32x4*)s0, b = *(const f32x4*)(s0 + N);
        if (ksc) { const float sa = ksc[k0 + 2 * kp], sb = ksc[k0 + 2 * kp + 1]; a *= sa; b *= sb; }
#pragma unroll
        for (int j = 0; j < 4; ++j) tl[(c4 + j) * 65 + kp] = cvtpk(a[j], b[j]);
    }
    __syncthreads();
    const int n = tid >> 3, seg = tid & 7;
    unsigned w[8];
#pragma unroll
    for (int q = 0; q < 8; ++q) w[q] = tl[n * 65 + seg * 8 + q];
    u32x4* d = (u32x4*)(dst + (size_t)(drow0 + n) * ldd + k0 + seg * 16);
    d[0] = (u32x4){w[0], w[1], w[2], w[3]}; d[1] = (u32x4){w[4], w[5], w[6], w[7]};
    __syncthreads();
}
__device__ __forceinline__ void tr_tile8(const float* __restrict__ src, int N, const float* __restrict__ ksc, float wscale, unsigned char* __restrict__ dst, int ldd, int k0, int n0, int drow0, LAS unsigned* tl, int tid) {
    const int c4 = (tid & 15) * 4, kq = tid >> 4;
    const float* s0 = src + (size_t)(k0 + 4 * kq) * N + n0 + c4;
    f32x4 a = *(const f32x4*)s0, b = *(const f32x4*)(s0 + N), c = *(const f32x4*)(s0 + 2 * (size_t)N), d = *(const f32x4*)(s0 + 3 * (size_t)N);
    float sa = wscale, sb = wscale, sc = wscale, sd = wscale;
    if (ksc) { sa *= ksc[k0 + 4 * kq]; sb *= ksc[k0 + 4 * kq + 1]; sc *= ksc[k0 + 4 * kq + 2]; sd *= ksc[k0 + 4 * kq + 3]; }
#pragma unroll
    for (int j = 0; j < 4; ++j) tl[(c4 + j) * 33 + kq] = pk4_fp8(a[j] * sa, b[j] * sb, c[j] * sc, d[j] * sd);
    __syncthreads();
    const int n = tid >> 3, seg = tid & 7;
    unsigned w[4];
#pragma unroll
    for (int q = 0; q < 4; ++q) w[q] = tl[n * 33 + seg * 4 + q];
    *(u32x4*)(dst + (size_t)(drow0 + n) * ldd + k0 + seg * 16) = (u32x4){w[0], w[1], w[2], w[3]};
    __syncthreads();
}
struct TJob { const float* src; bf16_t* dst; const float* ksc; int K, N, ldd, gu; size_t sbs, dbs; int f8; };
constexpr float W8_SCALE = 64.f;
constexpr int W8_SBYTE = 0x79797979;
__device__ __forceinline__ void run_tjob(const TJob& jb, int t, LAS unsigned* tl, int tid) {
    const int ntn = jb.N / 64, ntk = jb.K / 128, per = ntn * ntk;
    const int bi = t / per, r = t % per, tk = r / ntn, tn = r % ntn;
    const int n0 = tn * 64;
    const int drow0 = jb.gu ? (256 * (n0 >> 7) + (jb.gu == 2 ? 128 : 0) + (n0 & 127)) : n0;
    if (jb.f8) tr_tile8(jb.src + (size_t)bi * jb.sbs, jb.N, jb.ksc, W8_SCALE, (unsigned char*)jb.dst + (size_t)bi * jb.dbs, jb.ldd, tk * 128, n0, drow0, tl, tid);
    else tr_tile(jb.src + (size_t)bi * jb.sbs, jb.N, jb.ksc, jb.dst + (size_t)bi * jb.dbs, jb.ldd, tk * 128, n0, drow0, tl, tid);
}
typedef __attribute__((address_space(4))) const unsigned long long kcu64_t;
#define PIN(i) ((const float*)(__attribute__((address_space(1))) const float*)ka[i])
__device__ __forceinline__ void phase_prologue(kcu64_t* ka, unsigned char* ws, LAS unsigned char* lds, int G, int bid, int tid) {
    LAS unsigned* tl = (LAS unsigned*)lds;
    constexpr int NJ = 12;
    const int cnts[NJ] = {16 * 72, 16 * 32, 4096, 4096, 4096, 16 * 61, 16 * 32, 4096, 4096, 4096, 4 * 24, 2 * 32};
    int total = 0;
#pragma unroll
    for (int j = 0; j < NJ; ++j) total += cnts[j];
    for (int t = bid; t < total; t += G) {
        int j = 0, base = 0;
#pragma unroll
        for (int q = 0; q < NJ - 1; ++q) if (t >= base + cnts[q] && j == q) { base += cnts[q]; j = q + 1; }
        const int tt = t - base;
        TJob jb;
        switch (j) {
            case 0: jb = TJob{PIN(I_WIN0), (bf16_t*)(ws + WS_WIN0), nullptr, 2048, IN0, 2048, 0, 0, 0, F8_IN}; break;
            case 1: jb = TJob{PIN(I_WOUT0), (bf16_t*)(ws + WS_WOUT0), nullptr, 2048, 2048, 2048, 0, 0, 0, F8_OUT}; break;
            case 2: jb = TJob{PIN(I_WG0), (bf16_t*)(ws + WS_WGU0), nullptr, 2048, 512, 2048, 1, (size_t)2048 * 512, (size_t)1024 * 2048, F8_GU}; break;
            case 3: jb = TJob{PIN(I_WU0), (bf16_t*)(ws + WS_WGU0), nullptr, 2048, 512, 2048, 2, (size_t)2048 * 512, (size_t)1024 * 2048, F8_GU}; break;
            case 4: jb = TJob{PIN(I_WD0), (bf16_t*)(ws + WS_WD0), nullptr, 512, 2048, 512, 0, (size_t)512 * 2048, (size_t)2048 * 512, F8_DOWN}; break;
            case 5: jb = TJob{PIN(I_WIN1), (bf16_t*)(ws + WS_WIN1), nullptr, 2048, IN1, 2048, 0, 0, 0, F8_IN}; break;
            case 6: jb = TJob{PIN(I_WOUT1), (bf16_t*)(ws + WS_WOUT1), nullptr, 2048, 2048, 2048, 0, 0, 0, F8_OUT}; break;
            case 7: jb = TJob{PIN(I_WG1), (bf16_t*)(ws + WS_WGU1), nullptr, 2048, 512, 2048, 1, (size_t)2048 * 512, (size_t)1024 * 2048, F8_GU}; break;
            case 8: jb = TJob{PIN(I_WU1), (bf16_t*)(ws + WS_WGU1), nullptr, 2048, 512, 2048, 2, (size_t)2048 * 512, (size_t)1024 * 2048, F8_GU}; break;
            case 9: jb = TJob{PIN(I_WD1), (bf16_t*)(ws + WS_WD1), nullptr, 512, 2048, 512, 0, (size_t)512 * 2048, (size_t)2048 * 512, F8_DOWN}; break;
            case 10: jb = TJob{PIN(I_WQUP), (bf16_t*)(ws + WS_WQUP), PIN(I_DQN), 512, 1536, 512, 0, 0, 0, 0}; break;
            default: jb = TJob{PIN(I_WKVUP), (bf16_t*)(ws + WS_WKVUP), PIN(I_DKVN), 256, 2048, 256, 0, 0, 0, 0}; break;
        }
        run_tjob(jb, tt, tl, tid);
    }
    { constexpr size_t ESZ = F8_IN ? 1 : 2;
      u32x4* z = (u32x4*)(ws + WS_WIN1 + (size_t)IN1 * 2048 * ESZ); const size_t n16 = (size_t)(IN1P - IN1) * 2048 * ESZ / 16;
      const unsigned zu = __float_as_uint(fresh_zero());
      for (size_t i = (size_t)bid * NTHR + tid; i < n16; i += (size_t)G * NTHR) z[i] = (u32x4){zu, zu, zu, zu}; }
    { const f32x8* xs = (const f32x8*)PIN(I_X); const size_t n8 = (size_t)T_ * DM / 8;
      if constexpr (F8_IN) { u32x2* xd = (u32x2*)(ws + WS_RC + 64 * MiB);
          for (size_t i = (size_t)bid * NTHR + tid; i < n8; i += (size_t)G * NTHR) { const f32x8 v = xs[i]; xd[i] = (u32x2){pk4_fp8(v[0], v[1], v[2], v[3]), pk4_fp8(v[4], v[5], v[6], v[7])}; } }
      else { u32x4* xd = (u32x4*)(ws + WS_RA);
          for (size_t i = (size_t)bid * NTHR + tid; i < n8; i += (size_t)G * NTHR) { const f32x8 v = xs[i];
              xd[i] = (u32x4){cvtpk(v[0], v[1]), cvtpk(v[2], v[3]), cvtpk(v[4], v[5]), cvtpk(v[6], v[7])}; } } }
}

__device__ __forceinline__ void phase_prep_qk(bf16_t* H0, const float* qn, const float* kn, unsigned char* K8, int G, int bid, int tid) {
    const int wid = __builtin_amdgcn_readfirstlane(tid >> 6), lane = tid & 63, i = lane & 31, half = lane >> 5;
    const float invf = inv_freq32(i);
    const int e0 = 64 * half + i, e1 = e0 + 32;
    const float gq0 = qn[e0], gq1 = qn[e1], gk0 = kn[e0], gk1 = kn[e1];
    for (int m = bid * 8 + wid; m < T_; m += G * 8) {
        const int s = m & (SEQ - 1); const int pos = half ? (s & 63) : (s >> 6);
        float sn, cs; sincos_rev((float)pos * invf, sn, cs);
        bf16_t* rowp = H0 + (size_t)m * IN0;
#pragma unroll
        for (int hh = 0; hh < 10; ++hh) {
            bf16_t* base = rowp + (hh < 8 ? hh * 128 : 1024 + (hh - 8) * 128);
            const float x0 = bf2f(base[e0]), x1 = bf2f(base[e1]);
            const float ss = wave_sum(x0 * x0 + x1 * x1);
            const float r = rsqrtf(ss * (1.0f / 128.0f) + 1e-6f);
            const float y0 = x0 * r * (hh < 8 ? gq0 : gk0), y1 = x1 * r * (hh < 8 ? gq1 : gk1);
            const float o0 = y0 * cs - y1 * sn, o1 = y1 * cs + y0 * sn;
            base[e0] = f2bf(o0); base[e1] = f2bf(o1);
            if (F8_ATTA && hh >= 8) { unsigned char* kp = K8 + (size_t)m * 256 + (hh - 8) * 128; kp[e0] = f2fp8(o0); kp[e1] = f2fp8(o1); }
        }
    }
}
__device__ __forceinline__ void phase_vt8(const bf16_t* H0, unsigned char* Vt8, LAS unsigned char* lds, int G, int bid, int tid) {
    const int t = tid >> 3, seg = tid & 7, c = tid >> 2, part = tid & 3;
    for (int u = bid; u < 1024; u += G) {
        const int b = u >> 7, kvh = (u >> 6) & 1, ch = u & 63;
        const bf16_t* src = H0 + (size_t)(b * SEQ + ch * 64 + t) * IN0 + 1280 + kvh * 128 + seg * 16;
        const u32x4 v0 = *(const u32x4*)src, v1 = *(const u32x4*)(src + 8);
        const unsigned w[8] = {v0.x, v0.y, v0.z, v0.w, v1.x, v1.y, v1.z, v1.w};
        __syncthreads();
#pragma unroll
        for (int j = 0; j < 8; ++j) { lds[(16 * seg + 2 * j) * 80 + t] = f2fp8(bflo(w[j])); lds[(16 * seg + 2 * j + 1) * 80 + t] = f2fp8(bfhi(w[j])); }
        __syncthreads();
        const u32x4 o = *(const LAS u32x4*)(lds + c * 80 + part * 16);
        *(u32x4*)(Vt8 + ((size_t)(b * 2 + kvh) * 128 + c) * SEQ + ch * 64 + part * 16) = o;
    }
    __syncthreads();
}
__device__ __forceinline__ void phase_prep_mla(bf16_t* H1, bf16_t* krope, unsigned char* kr8, int G, int bid, int tid) {
    const int wid = __builtin_amdgcn_readfirstlane(tid >> 6), lane = tid & 63;
    const float invf = inv_freq32(lane & 31);
    for (int m = bid * 8 + wid; m < T_; m += G * 8) {
        bf16_t* rowp = H1 + (size_t)m * IN1P;
        const u32x4 a = *(const u32x4*)(rowp + 3072 + lane * 8);
        float ss = bflo(a.x) * bflo(a.x) + bfhi(a.x) * bfhi(a.x) + bflo(a.y) * bflo(a.y) + bfhi(a.y) * bfhi(a.y) + bflo(a.z) * bflo(a.z) + bfhi(a.z) * bfhi(a.z) + bflo(a.w) * bflo(a.w) + bfhi(a.w) * bfhi(a.w);
        ss = wave_sum(ss);
        const u32x2 c = *(const u32x2*)(rowp + 3584 + lane * 4);
        float s2 = bflo(c.x) * bflo(c.x) + bfhi(c.x) * bfhi(c.x) + bflo(c.y) * bflo(c.y) + bfhi(c.y) * bfhi(c.y);
        s2 = wave_sum(s2);
        const float rq = rsqrtf(ss * (1.0f / 512.0f) + 1e-6f), rkv = rsqrtf(s2 * (1.0f / 256.0f) + 1e-6f);
        *(u32x4*)(rowp + 3072 + lane * 8) = (u32x4){cvtpk(bflo(a.x) * rq, bfhi(a.x) * rq), cvtpk(bflo(a.y) * rq, bfhi(a.y) * rq), cvtpk(bflo(a.z) * rq, bfhi(a.z) * rq), cvtpk(bflo(a.w) * rq, bfhi(a.w) * rq)};
        *(u32x2*)(rowp + 3584 + lane * 4) = (u32x2){cvtpk(bflo(c.x) * rkv, bfhi(c.x) * rkv), cvtpk(bflo(c.y) * rkv, bfhi(c.y) * rkv)};
        if (lane < 32) { const float x1 = bf2f(rowp[3840 + lane]), x2 = bf2f(rowp[3840 + 32 + lane]);
            float sn, cs; sincos_rev((float)(m & (SEQ - 1)) * invf, sn, cs);
            const float o1 = x1 * cs - x2 * sn, o2 = x2 * cs + x1 * sn;
            krope[(size_t)m * 64 + lane] = f2bf(o1); krope[(size_t)m * 64 + 32 + lane] = f2bf(o2);
            if (F8_ATTD) { kr8[(size_t)m * 64 + lane] = f2fp8(o1); kr8[(size_t)m * 64 + 32 + lane] = f2fp8(o2); } }
    }
}

constexpr int LNR_PITCH = 2052;
constexpr int LNR_PART = 131584, LNR_SC = 147968, LNR_SEL = 150016, LNR_BLE = 152064, LNR_HIST = 153088;
template <bool RES_F32>
__device__ __forceinline__ void phase_ln_router(const bf16_t* mix, const void* res, const float* g, const float* bb, const float* rw, const float* rb, bf16_t* x1b, unsigned char* x1q,
                                                int* tok_e, int* tok_p, float* tok_g, int* list, unsigned* cnt, LAS unsigned char* lds, int G, int bid, int tid, bool commit = true) {
    const int wid = __builtin_amdgcn_readfirstlane(tid >> 6), lane = tid & 63;
    float ALPHA = 1.4142135623730951f; asm volatile("" : "+v"(ALPHA));
    LAS float* xs = (LAS float*)lds; LAS float* part = (LAS float*)(lds + LNR_PART); LAS float* scs = (LAS float*)(lds + LNR_SC); LAS float* sels = (LAS float*)(lds + LNR_SEL);
    LAS int* ble = (LAS int*)(lds + LNR_BLE); LAS int* hist = (LAS int*)(lds + LNR_HIST);
    f16x8 bw[8][2];
    { const float* rwp = rw + (size_t)(256 * wid + 8 * (lane >> 4)) * 32 + (lane & 15);
#pragma unroll
      for (int ks = 0; ks < 8; ++ks)
#pragma unroll
        for (int hf = 0; hf < 2; ++hf)
#pragma unroll
          for (int j = 0; j < 8; ++j) bw[ks][hf][j] = (_Float16)rwp[(32 * ks + j) * 32 + 16 * hf]; }
    typedef typename std::conditional<RES_F32, f32x4, u32x2>::type res_t;
    u32x2 mv[2][8]; res_t rv[2][8];
#define LNR_LOAD(tix_, rr) do { const size_t eo = ((size_t)(tix_) * 16 + 2 * wid + (rr)) * DM + 4 * lane; \
        _Pragma("unroll") for (int i = 0; i < 8; ++i) { mv[rr][i] = *(const u32x2*)(mix + eo + 256 * i); \
            if constexpr (RES_F32) rv[rr][i] = *(const res_t*)((const float*)res + eo + 256 * i); else rv[rr][i] = *(const res_t*)((const bf16_t*)res + eo + 256 * i); } } while (0)
    const int ntile = T_ / 16;
    int ntl = 0;
    if (bid < ntile) LNR_LOAD(bid, 0);
    const int lane0 = lane;
    for (int it = 0; bid + G * it < ntile; ++it) {
        const int tix = bid + G * it;
        int lane = lane0; asm volatile("" : "+v"(lane));
#pragma unroll
        for (int rr = 0; rr < 2; ++rr) {
            const int row = 2 * wid + rr; const size_t m = (size_t)tix * 16 + row;
            f32x4 zr[8]; float s = 0.f;
#pragma unroll
            for (int i = 0; i < 8; ++i) { const f32x4 mx = {bflo(mv[rr][i].x), bfhi(mv[rr][i].x), bflo(mv[rr][i].y), bfhi(mv[rr][i].y)}; f32x4 rx;
                if constexpr (RES_F32) rx = rv[rr][i]; else { const u32x2 rb2 = rv[rr][i]; rx = (f32x4){bflo(rb2.x), bfhi(rb2.x), bflo(rb2.y), bfhi(rb2.y)}; }
                zr[i] = ALPHA * rx + mx; s += (zr[i][0] + zr[i][1]) + (zr[i][2] + zr[i][3]); }
            if (rr == 0) { __builtin_amdgcn_sched_barrier(0); LNR_LOAD(tix, 1); __builtin_amdgcn_sched_barrier(0); }
            const float mean = wave_sum(s) * (1.0f / DM); float q = 0.f;
#pragma unroll
            for (int i = 0; i < 8; ++i) { const f32x4 d = zr[i] - mean; q += (d[0] * d[0] + d[1] * d[1]) + (d[2] * d[2] + d[3] * d[3]); }
            const float rstd = rsqrtf(wave_sum(q) * (1.0f / DM) + 1e-5f);
#pragma unroll
            for (int i = 0; i < 8; ++i) { const int col = 4 * lane + 256 * i; const f32x4 gv = *(const f32x4*)(g + col), bv = *(const f32x4*)(bb + col);
                const f32x4 y = (zr[i] - mean) * rstd * gv + bv;
                LAS f32x2* xp = (LAS f32x2*)(xs + row * LNR_PITCH + col); xp[0] = (f32x2){y[0], y[1]}; xp[1] = (f32x2){y[2], y[3]};
                *(u32x2*)(x1b + m * DM + col) = (u32x2){cvtpk(y[0], y[1]), cvtpk(y[2], y[3])};
                if constexpr (F8_GU) *(unsigned*)(x1q + m * DM + col) = pk4_fp8(y[0], y[1], y[2], y[3]);
                if (i & 1) asm volatile("" ::: "memory"); }
        }
        __builtin_amdgcn_sched_barrier(0);
        if (tix + G < ntile) LNR_LOAD(tix + G, 0);
        __builtin_amdgcn_sched_barrier(0);
        __syncthreads();
        { f32x4 acc0 = {0.f, 0.f, 0.f, 0.f}, acc1 = {0.f, 0.f, 0.f, 0.f}; const LAS float* xa = xs + (lane & 15) * LNR_PITCH + 256 * wid + 8 * (lane >> 4); const int e = lane & 15;
#pragma unroll
          for (int ks = 0; ks < 8; ++ks) { const f32x4 xa0 = *(const LAS f32x4*)(xa + 32 * ks), xa1 = *(const LAS f32x4*)(xa + 32 * ks + 4);
              const float xv[8] = {xa0[0], xa0[1], xa0[2], xa0[3], xa1[0], xa1[1], xa1[2], xa1[3]}; f16x8 ah, al;
#pragma unroll
              for (int j = 0; j < 8; ++j) { const _Float16 hh = (_Float16)xv[j]; ah[j] = hh; al[j] = (_Float16)(xv[j] - (float)hh); }
              acc0 = __builtin_amdgcn_mfma_f32_16x16x32_f16(ah, bw[ks][0], acc0, 0, 0, 0); acc1 = __builtin_amdgcn_mfma_f32_16x16x32_f16(ah, bw[ks][1], acc1, 0, 0, 0);
              acc0 = __builtin_amdgcn_mfma_f32_16x16x32_f16(al, bw[ks][0], acc0, 0, 0, 0); acc1 = __builtin_amdgcn_mfma_f32_16x16x32_f16(al, bw[ks][1], acc1, 0, 0, 0); }
          __builtin_amdgcn_sched_barrier(0);
          __builtin_amdgcn_sched_barrier(0);
#pragma unroll
          for (int r = 0; r < 4; ++r) { const int row = (lane >> 4) * 4 + r; part[(wid * 16 + row) * 32 + e] = acc0[r]; part[(wid * 16 + row) * 32 + 16 + e] = acc1[r]; } }
        __syncthreads();
        { const int row = tid >> 5, e = tid & 31; float lg = 0.f;
#pragma unroll
          for (int w = 0; w < 8; ++w) lg += part[(w * 16 + row) * 32 + e];
          const float sc = 1.0f / (1.0f + __expf(-lg)); scs[row * 32 + e] = sc; sels[row * 32 + e] = sc + rb[e]; }
        __syncthreads();
        if (tid < 16) { const int row = tid; float best = -INFINITY; int bg = 0;
            for (int gI = 0; gI < 8; ++gI) { const float a = sels[row * 32 + 4 * gI], b = sels[row * 32 + 4 * gI + 1], c = sels[row * 32 + 4 * gI + 2], d = sels[row * 32 + 4 * gI + 3];
                const float h1 = fmaxf(a, b), l1 = fminf(a, b), h2 = fmaxf(c, d), l2 = fminf(c, d); const float gs = fmaxf(h1, h2) + fmaxf(fminf(h1, h2), fmaxf(l1, l2));
                if (gs > best) { best = gs; bg = gI; } }
            const float v0 = sels[row * 32 + 4 * bg], v1 = sels[row * 32 + 4 * bg + 1], v2 = sels[row * 32 + 4 * bg + 2], v3 = sels[row * 32 + 4 * bg + 3];
            int i1 = 0; float b1v = v0; if (v1 > b1v) { b1v = v1; i1 = 1; } if (v2 > b1v) { b1v = v2; i1 = 2; } if (v3 > b1v) { b1v = v3; i1 = 3; }
            int i2 = -1; float b2v = -INFINITY;
            if (i1 != 0 && v0 > b2v) { b2v = v0; i2 = 0; } if (i1 != 1 && v1 > b2v) { b2v = v1; i2 = 1; } if (i1 != 2 && v2 > b2v) { b2v = v2; i2 = 2; } if (i1 != 3 && v3 > b2v) { b2v = v3; i2 = 3; }
            const int e1 = 4 * bg + i1, e2 = 4 * bg + i2; const float s1 = scs[row * 32 + e1], s2 = scs[row * 32 + e2]; const float inv = 1.0f / (s1 + s2);
            const int m = tix * 16 + row;
            tok_e[2 * m] = e1; tok_e[2 * m + 1] = e2; tok_g[2 * m] = s1 * inv; tok_g[2 * m + 1] = s2 * inv;
            ble[(it * 16 + row) * 2] = e1; ble[(it * 16 + row) * 2 + 1] = e2; }
        __syncthreads();
        ntl = it + 1;
    }
#undef LNR_LOAD
    const int nasg = commit ? ntl * 32 : 0;
    if (tid < 32) { int c = 0; for (int i = 0; i < nasg; ++i) c += (ble[i] == tid) ? 1 : 0;
        unsigned base = 0; if (c) base = __hip_atomic_fetch_add(cnt + tid, (unsigned)c, __ATOMIC_RELAXED, __HIP_MEMORY_SCOPE_AGENT);
        hist[tid] = (int)base; }
    __syncthreads();
    if (tid < 32) { int run = hist[tid];
        for (int i = 0; i < nasg; ++i) if (ble[i] == tid) { const int tr = i >> 1; const size_t m = (size_t)(bid + G * (tr >> 4)) * 16 + (tr & 15);
            list[(size_t)tid * 65536 + run] = (int)m; tok_p[2 * m + (i & 1)] = run; ++run; } }
    __syncthreads();
}

constexpr int MOE_LDS = 131072;
__device__ __forceinline__ int moe_prefix(const unsigned* cnt, LAS int* pblk, int tid) {
    if (tid == 0) { int acc = 0; for (int e = 0; e < NE; ++e) { pblk[e] = acc; acc += ((int)cnt[e] + 255) >> 8; } pblk[NE] = acc; }
    __syncthreads();
    return pblk[NE];
}
template <int NJ> __device__ __forceinline__ int moe_table(const unsigned* cnt, LAS int* pblk, LAS int* tab, LAS int* aux, int NB, int G, int bid, int tid) {
    const int NU = NB * NJ;
    if (tid < 16) { const int L = bid + G * tid;
        if (L < NU) { const int rb = L / NJ, j = L % NJ; int e = 0; for (int q = 1; q < NE; ++q) if (pblk[q] <= rb) e = q;
            tab[tid] = rb; tab[16 + tid] = NJ * e + j; aux[tid * 3] = e; aux[tid * 3 + 1] = (rb - pblk[e]) * 256; aux[tid * 3 + 2] = (int)cnt[e]; } }
    __syncthreads();
    int n = 0; for (int i = 0; i < 16; ++i) if (bid + G * i < NU) n = i + 1;
    return n;
}

template <bool FINAL>
__device__ __forceinline__ void phase_combine_ln(const float* dbg, const bf16_t* x1b, const bf16_t* Yr, const int* tok_e, const int* tok_p, const float* tok_g, const unsigned* cnt,
                                                 const float* g, const float* bb, bf16_t* xo, unsigned char* xq, float* fo, LAS unsigned char* lds, int G, int bid, int tid) {
    LAS int* pblk = (LAS int*)lds;
    moe_prefix(cnt, pblk, tid);
    const int wid = __builtin_amdgcn_readfirstlane(tid >> 6), lane = tid & 63;
    float ALPHA = 1.4142135623730951f; asm volatile("" : "+v"(ALPHA));
#if DBG_CHECK
    const bool dbg_bad = FINAL && (!(dbg[0] <= DBG_TOL * DBG_TOL * dbg[1]) || !(dbg[2] <= DBG_TOL * DBG_TOL * dbg[3]) || !(dbg[1] > 0.f) || !(dbg[3] > 0.f));
#endif
    for (int m = bid * 8 + wid; m < T_; m += G * 8) {
        const int e0 = tok_e[2 * m], e1 = tok_e[2 * m + 1];
        const size_t p0 = (size_t)pblk[e0] * 256 + tok_p[2 * m], p1 = (size_t)pblk[e1] * 256 + tok_p[2 * m + 1];
        const float g0 = tok_g[2 * m], g1 = tok_g[2 * m + 1];
        float v[32]; float s = 0.f;
#pragma unroll
        for (int i = 0; i < 4; ++i) { const int col = 8 * lane + 512 * i;
            const u32x4 xa = *(const u32x4*)(x1b + (size_t)m * DM + col);
            const unsigned xw[4] = {xa.x, xa.y, xa.z, xa.w};
            if constexpr (F8_YR) {
                const u32x2 ya = *(const u32x2*)((const unsigned char*)Yr + p0 * DM + col), yb = *(const u32x2*)((const unsigned char*)Yr + p1 * DM + col);
                const unsigned aw[2] = {ya.x, ya.y}, bw[2] = {yb.x, yb.y}; const float h0 = g0 * (1.0f / 16.0f), h1 = g1 * (1.0f / 16.0f);
#define CMB_PAIR(j, W, SEL) do { const f32x2 a2 = __builtin_amdgcn_cvt_pk_f32_fp8((int)aw[W], SEL), b2 = __builtin_amdgcn_cvt_pk_f32_fp8((int)bw[W], SEL); \
                    v[i * 8 + 2 * (j)] = ALPHA * bflo(xw[j]) + h0 * a2[0] + h1 * b2[0]; v[i * 8 + 2 * (j) + 1] = ALPHA * bfhi(xw[j]) + h0 * a2[1] + h1 * b2[1]; \
                    s += v[i * 8 + 2 * (j)] + v[i * 8 + 2 * (j) + 1]; } while (0)
                CMB_PAIR(0, 0, false); CMB_PAIR(1, 0, true); CMB_PAIR(2, 1, false); CMB_PAIR(3, 1, true);
#undef CMB_PAIR
            } else {
                const u32x4 ya = *(const u32x4*)(Yr + p0 * DM + col), yb = *(const u32x4*)(Yr + p1 * DM + col);
                const unsigned aw[4] = {ya.x, ya.y, ya.z, ya.w}, bw[4] = {yb.x, yb.y, yb.z, yb.w};
#pragma unroll
                for (int j = 0; j < 4; ++j) { v[i * 8 + 2 * j] = ALPHA * bflo(xw[j]) + g0 * bflo(aw[j]) + g1 * bflo(bw[j]); v[i * 8 + 2 * j + 1] = ALPHA * bfhi(xw[j]) + g0 * bfhi(aw[j]) + g1 * bfhi(bw[j]);
                    s += v[i * 8 + 2 * j] + v[i * 8 + 2 * j + 1]; }
            } }
        const float mean = wave_sum(s) * (1.0f / DM); float q = 0.f;
#pragma unroll
        for (int i = 0; i < 32; ++i) { const float d = v[i] - mean; q += d * d; }
        const float rstd = rsqrtf(wave_sum(q) * (1.0f / DM) + 1e-5f);
#pragma unroll
        for (int i = 0; i < 4; ++i) { const int col = 8 * lane + 512 * i;
            const f32x4 ga = *(const f32x4*)(g + col), gb = *(const f32x4*)(g + col + 4), ba = *(const f32x4*)(bb + col), bbv = *(const f32x4*)(bb + col + 4);
            float y[8];
#pragma unroll
            for (int j = 0; j < 4; ++j) { y[j] = (v[i * 8 + j] - mean) * rstd * ga[j] + ba[j]; y[4 + j] = (v[i * 8 + 4 + j] - mean) * rstd * gb[j] + bbv[j]; }
#if DBG_CHECK
            if (dbg_bad) { for (int j = 0; j < 8; ++j) y[j] = 0.f; }
#endif
            if constexpr (FINAL) { *(f32x4*)(fo + (size_t)m * DM + col) = (f32x4){y[0], y[1], y[2], y[3]}; *(f32x4*)(fo + (size_t)m * DM + col + 4) = (f32x4){y[4], y[5], y[6], y[7]}; }
            else { *(u32x4*)(xo + (size_t)m * DM + col) = (u32x4){cvtpk(y[0], y[1]), cvtpk(y[2], y[3]), cvtpk(y[4], y[5]), cvtpk(y[6], y[7])};
                if constexpr (F8_IN) *(u32x2*)(xq + (size_t)m * DM + col) = (u32x2){pk4_fp8(y[0], y[1], y[2], y[3]), pk4_fp8(y[4], y[5], y[6], y[7])}; } }
    }
}

#if DBG_CHECK
__device__ __forceinline__ void dbg_attn_check(int which, const bf16_t* Hx, const bf16_t* Qd, const bf16_t* KVd, const bf16_t* krope, const void* Oat, float* dbg, LAS unsigned char* lds, int bid, int tid) {
    const int wid = __builtin_amdgcn_readfirstlane(tid >> 6), lane = tid & 63;
    LAS float* sc = (LAS float*)lds + wid * 4096;
    LAS float* qs = (LAS float*)(lds + 131072) + wid * 192;
    const unsigned sid = (unsigned)(bid * 8 + wid);
    const int m = (int)((sid * 2654435761u) % (unsigned)T_), h = (int)(sid & 7u), b = m >> 12, pos = m & (SEQ - 1);
    const int DQ = which ? 192 : 128; const float scale = which ? 0.072168783648703220f : 0.088388347648318440f;
    for (int d = lane; d < DQ; d += 64) {
        float qv;
        if (which == 0) qv = bf2f(Hx[(size_t)m * IN0 + h * 128 + d]);
        else if (d < 128) qv = bf2f(Qd[(size_t)m * 1536 + h * 192 + d]);
        else { const int i = (d - 128) & 31; const float x1 = bf2f(Qd[(size_t)m * 1536 + h * 192 + 128 + i]), x2 = bf2f(Qd[(size_t)m * 1536 + h * 192 + 160 + i]);
            float sn, cs; sincos_rev((float)pos * inv_freq32(i), sn, cs); qv = (d < 160) ? (x1 * cs - x2 * sn) : (x2 * cs + x1 * sn); }
        qs[d] = qv; }
    asm volatile("s_waitcnt lgkmcnt(0)" ::: "memory");
    float mx = -INFINITY;
    for (int i = 0; i < 64; ++i) { const int j = lane + 64 * i; float dot = 0.f;
        if (which == 0) { const bf16_t* kp = Hx + (size_t)(b * SEQ + j) * IN0 + 1024 + (h >> 2) * 128; for (int d = 0; d < 128; ++d) dot += qs[d] * bf2f(kp[d]); }
        else { const bf16_t* kp = KVd + (size_t)(b * SEQ + j) * DM + h * 256; for (int d = 0; d < 128; ++d) dot += qs[d] * bf2f(kp[d]);
               const bf16_t* rp = krope + (size_t)(b * SEQ + j) * 64; for (int d = 0; d < 64; ++d) dot += qs[128 + d] * bf2f(rp[d]); }
        dot *= scale; sc[j] = dot; mx = fmaxf(mx, dot); }
    mx = wave_max(mx);
    float sum = 0.f;
    for (int i = 0; i < 64; ++i) { const int j = lane + 64 * i; const float pj = __expf(sc[j] - mx); sc[j] = pj; sum += pj; }
    sum = wave_sum(sum);
    asm volatile("s_waitcnt lgkmcnt(0)" ::: "memory");
    float e2 = 0.f, r2 = 0.f;
    for (int cc = 0; cc < 2; ++cc) { const int c = lane + 64 * cc; float acc = 0.f;
        for (int j = 0; j < SEQ; ++j) { const float vv = which == 0 ? bf2f(Hx[(size_t)(b * SEQ + j) * IN0 + 1280 + (h >> 2) * 128 + c]) : bf2f(KVd[(size_t)(b * SEQ + j) * DM + h * 256 + 128 + c]); acc += sc[j] * vv; }
        const float ref = acc / sum; const size_t eo = (size_t)m * DM + (which ? 1024 : 0) + h * 128 + c;
        float got; if (F8_OUT) { const unsigned char by = ((const unsigned char*)Oat)[eo]; const f32x2 g2 = __builtin_amdgcn_cvt_pk_f32_fp8((int)by, false); got = g2[0] * (1.0f / O8_SCALE); } else got = bf2f(((const bf16_t*)Oat)[eo]);
        e2 += (got - ref) * (got - ref); r2 += ref * ref; }
    e2 = wave_sum(e2); r2 = wave_sum(r2);
    if (lane == 0) { atomicAdd(dbg + 2 * which, e2); atomicAdd(dbg + 2 * which + 1, r2); }
}
#endif
#ifndef ATT_ONLY
#define ATT_ONLY -1
#endif
#ifndef REP_K
#define REP_K -1
#endif
#ifndef REP_ATT
#define REP_ATT -1
#endif
#define NREP(k) ((REP_K == (k)) ? 2 : 1)
#define NREPA(k) ((REP_ATT == (k)) ? 2 : 1)
constexpr int N_PHASES = 20;
__global__ void __launch_bounds__(NTHR, 2) fwd(Params p) {
    extern __shared__ __attribute__((aligned(16))) unsigned char lds_raw[];
    LAS unsigned char* lds = (LAS unsigned char*)lds_raw;
    const int tid0 = threadIdx.x, bid = blockIdx.x, G = gridDim.x;
    const int wv = __builtin_amdgcn_readfirstlane(tid0 >> 6);
    const int vcu = (G % 8 == 0) ? (bid % 8) * (G / 8) + bid / 8 : bid;
    unsigned* ctl = (unsigned*)(p.ws + WS_CTL);
    if (tid0 < 4) ((LAS unsigned*)(lds + MISC_OFF))[tid0] = 0u;
    __syncthreads();
    XcdBarrier bar; bar.bar = ctl + CW_BAR; bar.x = 0; bar.st = (volatile LAS unsigned*)(lds + MISC_OFF);
    if (N_LAUNCH_MODE == 1) bar = xcd_barrier_post(ctl + CW_BAR, (volatile LAS unsigned*)(lds + MISC_OFF));
    const int lo = p.ph_lo, hi = p.ph_hi;
#ifndef PH_ONLY
#define PH_ONLY -1
#endif
#define IN(k) ((PH_ONLY < 0 || (PH_ONLY % 10) == ((k) % 10)) && lo <= (k) && (k) < hi)
#define SEAM(k) do { if ((k) + 1 < hi) xcd_barrier(bar, fresh_tid(wv)); } while (0)

    for (int L = 0; L < 2; ++L) {
        const int pb = L * 10;
        typedef __attribute__((address_space(1))) unsigned char gu8;
        typedef __attribute__((address_space(1))) const float gcf;
        typedef __attribute__((address_space(4))) const unsigned long long kcu64;
#define INP(i) ((const float*)(gcf*)ka[i])
#define PHASE_PTRS \
        kcu64* ka = (kcu64*)__builtin_amdgcn_kernarg_segment_ptr(); asm volatile("" : "+s"(ka)); \
        unsigned char* ws = (unsigned char*)(gu8*)ka[29]; unsigned char* outb = (unsigned char*)(gu8*)ka[28]; \
        unsigned* ctl = (unsigned*)(ws + WS_CTL); \
        bf16_t* RA = (bf16_t*)(ws + WS_RA); bf16_t* RB = (bf16_t*)(ws + WS_RB); bf16_t* RC = (bf16_t*)(ws + WS_RC); \
        int* list = (int*)(ws + WS_LIST); int* tok_e = (int*)(ws + WS_TOKE); int* tok_p = (int*)(ws + WS_TOKP); float* tok_g = (float*)(ws + WS_TOKG); \
        bf16_t* krope = (bf16_t*)(ws + WS_KROPE); \
        bf16_t* Qd = (bf16_t*)(outb + OUT_QD); bf16_t* O1 = (bf16_t*)(outb + OUT_O1); \
        const bf16_t* Win = (const bf16_t*)(ws + (L ? WS_WIN1 : WS_WIN0)); const bf16_t* Wout = (const bf16_t*)(ws + (L ? WS_WOUT1 : WS_WOUT0)); \
        const bf16_t* Wgu = (const bf16_t*)(ws + (L ? WS_WGU1 : WS_WGU0)); const bf16_t* Wd = (const bf16_t*)(ws + (L ? WS_WD1 : WS_WD0)); \
        const int NIN = L ? IN1P : IN0; \
        const bf16_t* xin = L ? RC : RA; \
        bf16_t* Hx = RB; bf16_t* Oat = L ? O1 : RC; float* Z = (float*)RB; \
        bf16_t* x1b = RA; bf16_t* Hm = RC; bf16_t* Yr = RB; \
        unsigned* cnt = ctl + CW_CNT + L * 64; \
        (void)ctl; (void)RA; (void)RB; (void)RC; (void)list; (void)tok_e; (void)tok_p; (void)tok_g; (void)krope; (void)Qd; (void)O1; (void)Win; (void)Wout; (void)Wgu; (void)Wd; (void)NIN; (void)xin; (void)Hx; (void)Oat; (void)Z; (void)x1b; (void)Hm; (void)Yr; (void)cnt; (void)outb

        if (L == 0 && IN(0)) { PHASE_PTRS; _Pragma("unroll 1") for (int rep = 0; rep < NREP(0); ++rep) phase_prologue(ka, ws, lds, G, bid, fresh_tid(wv)); SEAM(0); }

        if (IN(pb + 1)) {
            PHASE_PTRS;
            constexpr int KI = F8_IN ? 1024 : 2048;
            const bf16_t* ain = F8_IN ? (L ? (const bf16_t*)outb : (const bf16_t*)((unsigned char*)RC + 64 * MiB)) : xin;
            pg8::Gemm g{ain, Win, KI, KI, KI}; pg8::StaticOrder S; S.init(T_, NIN, G, bid, KI);
            pg8::EpiBf16 E{Hx, NIN, 0xffff};
            _Pragma("unroll 1") for (int rep = 0; rep < NREP(1); ++rep) pg8::gemm_phase<F8_IN != 0>(wv, lds, g, S, E, W8_SBYTE, 0x7f7f7f7f);
            SEAM(pb + 1);
        }
        if (IN(pb + 2)) {
            PHASE_PTRS;
            if (L == 0) { phase_prep_qk(Hx, INP(I_AQN), INP(I_AKN), ws + WS_WGU0 + 64 * MiB, G, bid, fresh_tid(wv));
                if (F8_ATTA) phase_vt8(Hx, ws + WS_WGU0 + 72 * MiB, lds, G, bid, fresh_tid(wv)); }
            else phase_prep_mla(Hx, krope, ws + WS_WD1 + 32 * MiB, G, bid, fresh_tid(wv));
            SEAM(pb + 2);
        }
        if (L == 1 && IN(pb + 3)) _Pragma("unroll 1") for (int rep = 0; rep < NREP(3); ++rep) {
            PHASE_PTRS;
#ifndef P3_ONLY
#define P3_ONLY -1
#endif
            if (P3_ONLY < 0 || P3_ONLY == 0) { pg8::Gemm g{Hx + 3072, (const bf16_t*)(ws + WS_WQUP), 512, IN1P, 512}; pg8::StaticOrder S; S.init(T_, 1536, G, bid, IN1P);
              pg8::EpiBf16 E{Qd, 1536, 0xffff}; pg8::gemm_phase<false>(wv, lds, g, S, E); }
            if (P3_ONLY < 0 || P3_ONLY == 1) { pg8::Gemm g{Hx + 3584, (const bf16_t*)(ws + WS_WKVUP), 256, IN1P, 256}; pg8::StaticOrder S; S.init(T_, 2048, G, bid, IN1P);
              if constexpr (F8_ATTD) { pg8::EpiKV8 E{ws + WS_WGU1 + 64 * MiB, ws + WS_WGU1 + 96 * MiB, RA, DBG_CHECK != 0}; pg8::gemm_phase<false>(wv, lds, g, S, E); }
              else { pg8::EpiBf16 E{RA, 2048, 0xffff}; pg8::gemm_phase<false>(wv, lds, g, S, E); } }
            if (rep + 1 == NREP(3)) SEAM(pb + 3);
        }
        if (IN(pb + 4)) {
            PHASE_PTRS;
            if (L == 0) {
                if (ATT_ONLY < 0 || ATT_ONLY == 0)
                _Pragma("unroll 1") for (int rep = 0; rep < NREPA(0); ++rep)
                for (int u = vcu; u < 1024; u += G) {
                    __syncthreads();
                    const int b = u >> 7, qb = u & 15, kvh = (u >> 6) & 1, gq = (u >> 4) & 3, h = kvh * 4 + gq;
                    if constexpr (F8_ATTA) {
                        d8::D8Args a; a.Q = Hx + (size_t)(b * SEQ + 256 * qb) * IN0 + h * 128; a.ldq = IN0;
                        a.K8 = ws + WS_WGU0 + 64 * MiB + (size_t)b * SEQ * 256 + kvh * 128; a.ldk = 256; a.Kr8 = nullptr;
                        a.Vt8 = ws + WS_WGU0 + 72 * MiB + (size_t)(b * 2 + kvh) * 128 * SEQ; a.ldvt = SEQ;
                        { const size_t eo = (size_t)(b * SEQ + 256 * qb) * DM + h * 128; a.O = F8_OUT ? (bf16_t*)((unsigned char*)Oat + eo) : Oat + eo; } a.ldo = DM; a.seq = SEQ; a.pos0 = 0;
                        d8::attn_dense8_body<2>(wv, a, (char*)lds_raw);
                    } else {
                    da::DArgs a; a.Q = Hx + (size_t)(b * SEQ + 256 * qb) * IN0 + h * 128; a.ldq = IN0;
                    a.K = Hx + (size_t)b * SEQ * IN0 + 1024 + kvh * 128; a.ldk = IN0; a.V = Hx + (size_t)b * SEQ * IN0 + 1280 + kvh * 128; a.ldv = IN0; a.Kr = nullptr;
                    { const size_t eo = (size_t)(b * SEQ + 256 * qb) * DM + h * 128; a.O = F8_OUT ? (bf16_t*)((unsigned char*)Oat + eo) : Oat + eo; } a.ldo = DM; a.seq = SEQ; a.pos0 = 0;
                    da::attn_dense_body<8, 1>(wv, a, (char*)lds_raw);
                    }
                }
                __syncthreads();
                if (ATT_ONLY < 0 || ATT_ONLY == 2)
                _Pragma("unroll 1") for (int rep = 0; rep < NREPA(2); ++rep)
                for (int it = vcu; it < 1024; it += G) {
                    const int tid2 = fresh_tid(wv), wid = __builtin_amdgcn_readfirstlane(tid2 >> 6), lane = tid2 & 63;
                    const int w = it * 8 + wid; LAS unsigned char* wl = lds + wid * da::SP_WAVE_LDS;
                    PolB pol; pol.init(Hx, Oat, w, lane); da::sparse_wave(pol, wl, lane);
                }
            } else {
                if (ATT_ONLY < 0 || ATT_ONLY == 1)
                _Pragma("unroll 1") for (int rep = 0; rep < NREPA(1); ++rep)
                for (int u = vcu; u < 1024; u += G) {
                    __syncthreads();
                    const int b = u >> 7, qb = u & 15, h = (u >> 4) & 7;
                    if constexpr (F8_ATTD) {
                        d8::D8Args a; a.Q = Qd + (size_t)(b * SEQ + 256 * qb) * 1536 + h * 192; a.ldq = 1536;
                        a.K8 = ws + WS_WGU1 + 64 * MiB + (size_t)b * SEQ * 1024 + h * 128; a.ldk = 1024; a.Kr8 = ws + WS_WD1 + 32 * MiB + (size_t)b * SEQ * 64;
                        a.Vt8 = ws + WS_WGU1 + 96 * MiB + (size_t)(b * 8 + h) * 128 * SEQ; a.ldvt = SEQ;
                        { const size_t eo = (size_t)(b * SEQ + 256 * qb) * DM + 1024 + h * 128; a.O = F8_OUT ? (bf16_t*)((unsigned char*)Oat + eo) : Oat + eo; } a.ldo = DM; a.seq = SEQ; a.pos0 = 256 * qb;
                        d8::attn_dense8_body<3>(wv, a, (char*)lds_raw);
                    } else {
                    da::DArgs a; a.Q = Qd + (size_t)(b * SEQ + 256 * qb) * 1536 + h * 192; a.ldq = 1536;
                    a.K = RA + (size_t)b * SEQ * DM + h * 256; a.ldk = DM; a.V = a.K + 128; a.ldv = DM; a.Kr = krope + (size_t)b * SEQ * 64;
                    { const size_t eo = (size_t)(b * SEQ + 256 * qb) * DM + 1024 + h * 128; a.O = F8_OUT ? (bf16_t*)((unsigned char*)Oat + eo) : Oat + eo; } a.ldo = DM; a.seq = SEQ; a.pos0 = 256 * qb;
                    da::attn_dense_body<12, 1>(wv, a, (char*)lds_raw);
                    }
                }
                __syncthreads();
                if (ATT_ONLY < 0 || ATT_ONLY == 3)
                _Pragma("unroll 1") for (int rep = 0; rep < NREPA(3); ++rep)
                for (int it = vcu; it < 1024; it += G) {
                    const int tid2 = fresh_tid(wv), wid = __builtin_amdgcn_readfirstlane(tid2 >> 6), lane = tid2 & 63;
                    const int w = it * 8 + wid; LAS unsigned char* wl = lds + wid * da::SP_WAVE_LDS;
                    PolC pol; pol.init(Hx, Oat, INP(I_RPB), (float*)((char*)wl + 16640), w, lane); da::sparse_wave(pol, wl, lane);
                }
            }
#if DBG_CHECK
            xcd_barrier(bar, fresh_tid(wv));
            dbg_attn_check(L, Hx, Qd, RA, krope, Oat, (float*)(ctl + CW_DBG), lds, bid, fresh_tid(wv));
            __syncthreads();
#endif
            SEAM(pb + 4);
        }
        if (IN(pb + 5)) {
            PHASE_PTRS;
            constexpr int KO = F8_OUT ? 1024 : 2048; constexpr int SXO = F8_OUT ? 0x7b7b7b7b : 0x7f7f7f7f;
            pg8::Gemm g{Oat, Wout, KO, KO, KO}; pg8::StaticOrder S; S.init(T_, DM, G, bid, KO);
            pg8::EpiBf16 E{RB, DM, 0xffff};
            _Pragma("unroll 1") for (int rep = 0; rep < NREP(5); ++rep) pg8::gemm_phase<F8_OUT != 0>(wv, lds, g, S, E, W8_SBYTE, SXO);
            SEAM(pb + 5);
        }
        if (IN(pb + 6)) {
            PHASE_PTRS;
            if (L == 0) { _Pragma("unroll 1") for (int rep = 0; rep < NREP(6); ++rep) phase_ln_router<true>(RB, INP(I_X), INP(I_LN1G0), INP(I_LN1B0), INP(I_RW), INP(I_RB), x1b, (unsigned char*)RC + 64 * MiB, tok_e, tok_p, tok_g, list, cnt, lds, G, bid, fresh_tid(wv), rep + 1 == NREP(6)); }
            else { _Pragma("unroll 1") for (int rep = 0; rep < NREP(6); ++rep) phase_ln_router<false>(RB, RC, INP(I_LN1G1), INP(I_LN1B1), INP(I_RW), INP(I_RB), x1b, outb  , tok_e, tok_p, tok_g, list, cnt, lds, G, bid, fresh_tid(wv), rep + 1 == NREP(6)); }
            SEAM(pb + 6);
        }
        if (IN(pb + 7)) {
            PHASE_PTRS;
            LAS int* pblk = (LAS int*)(lds + MOE_LDS); LAS int* tab = pblk + 64; LAS int* aux = tab + 32; LAS int* idx = aux + 64;
            const int tid = fresh_tid(wv);
            const int NB = moe_prefix(cnt, pblk, tid);
            const int n = moe_table<4>(cnt, pblk, tab, aux, NB, G, bid, tid);
            for (int i = 0; i < n; ++i) if (tid < 256) { const int e = aux[i * 3], rs = aux[i * 3 + 1], ce = aux[i * 3 + 2]; idx[i * 256 + tid] = list[(size_t)e * 65536 + min(rs + tid, ce - 1)]; }
            __syncthreads();
            constexpr int KG = F8_GU ? 1024 : 2048;
            const bf16_t* agu = F8_GU ? (L ? (const bf16_t*)outb : (const bf16_t*)((unsigned char*)RC + 64 * MiB)) : x1b;
            pg8::Gemm g{agu, Wgu, KG, KG, KG}; pg8::TableOrder<true> S{tab, idx, n, KG}; pg8::EpiSiluMul<F8_DOWN != 0> E{Hm};
            _Pragma("unroll 1") for (int rep = 0; rep < NREP(7); ++rep) pg8::gemm_phase<F8_GU != 0>(wv, lds, g, S, E, W8_SBYTE, 0x7f7f7f7f);
            SEAM(pb + 7);
        }
        if (IN(pb + 8)) {
            PHASE_PTRS;
            LAS int* pblk = (LAS int*)(lds + MOE_LDS); LAS int* tab = pblk + 64; LAS int* aux = tab + 32;
            const int tid = fresh_tid(wv);
            const int NB = moe_prefix(cnt, pblk, tid);
            const int n = moe_table<8>(cnt, pblk, tab, aux, NB, G, bid, tid);
            constexpr int KD = F8_DOWN ? 256 : 512;
            pg8::Gemm g{Hm, Wd, KD, KD, KD}; pg8::TableOrder<false> S{tab, nullptr, n, KD}; pg8::EpiBf16T<F8_YR != 0> E{Yr, DM, 7};
            _Pragma("unroll 1") for (int rep = 0; rep < NREP(8); ++rep) pg8::gemm_phase<F8_DOWN != 0>(wv, lds, g, S, E, W8_SBYTE, 0x7f7f7f7f);
            SEAM(pb + 8);
        }
        if (IN(pb + 9)) _Pragma("unroll 1") for (int rep = 0; rep < NREP(9); ++rep) {
            PHASE_PTRS;
            if (L == 0) phase_combine_ln<false>((const float*)(ctl + CW_DBG), x1b, Yr, tok_e, tok_p, tok_g, cnt, INP(I_LN2G0), INP(I_LN2B0), RC, outb, nullptr, lds, G, bid, fresh_tid(wv));
            else phase_combine_ln<true>((const float*)(ctl + CW_DBG), x1b, Yr, tok_e, tok_p, tok_g, cnt, INP(I_LN2G1), INP(I_LN2B1), nullptr, nullptr, (float*)outb, lds, G, bid, fresh_tid(wv));
            if (rep + 1 == NREP(9)) SEAM(pb + 9);
        }
    }
#undef IN
#undef SEAM
#undef INP
#undef PHASE_PTRS
}

extern "C" void kernel_launch(void* const* d_in, const int* in_sizes, int n_in, void* d_out, int out_size, void* d_ws, size_t ws_size, hipStream_t stream) {
    static int grid = 0;
    if (grid == 0) {
        if (n_in != 28 || out_size != T_ * DM || ws_size < WS_END) { fprintf(stderr, "kernel_launch: unexpected shapes: n_in %d out %d ws %zu (need %zu)\n", n_in, out_size, ws_size, (size_t)WS_END); grid = -1; return; }
        int dev = 0, cus = 0, per_cu = 0;
        if (hipGetDevice(&dev) != hipSuccess || hipDeviceGetAttribute(&cus, hipDeviceAttributeMultiprocessorCount, dev) != hipSuccess) { grid = -1; return; }
        if (hipFuncSetAttribute((const void*)fwd, hipFuncAttributeMaxDynamicSharedMemorySize, LDS_BYTES) != hipSuccess) { fprintf(stderr, "kernel_launch: hipFuncSetAttribute failed\n"); grid = -1; return; }
        if (hipOccupancyMaxActiveBlocksPerMultiprocessor(&per_cu, (const void*)fwd, NTHR, LDS_BYTES) != hipSuccess || per_cu < 1)
            fprintf(stderr, "kernel_launch: occupancy query reports %d workgroups per CU\n", per_cu);
        (void)hipGetLastError();
        grid = cus;
    }
    if (grid < 0) return;
    (void)hipMemsetAsync((char*)d_ws + WS_CTL, 0, CTL_ZERO_BYTES, stream);
    Params p{};
    for (int i = 0; i < 28; ++i) p.in[i] = (const float*)d_in[i];
    p.out = (float*)d_out; p.ws = (unsigned char*)d_ws;
#if N_LAUNCH_MODE == 1
    p.ph_lo = 0; p.ph_hi = N_PHASES;
    hipLaunchKernelGGL(fwd, dim3(grid), dim3(NTHR), LDS_BYTES, stream, p);
#else
    for (int k = 0; k < N_PHASES; ++k) { if (k == 3 || k == 10) continue; p.ph_lo = k; p.ph_hi = k + 1;
        hipLaunchKernelGGL(fwd, dim3(grid), dim3(NTHR), LDS_BYTES, stream, p); }
#endif
    const hipError_t le = hipPeekAtLastError();
    if (le != hipSuccess) fprintf(stderr, "kernel_launch: launch failed: %s\n", hipGetErrorName(le));
}
```

```cpp
#include <hip/hip_runtime.h>
#include <cstdio>
#include <cstdint>
#include <type_traits>

#ifndef N_LAUNCH_MODE
#define N_LAUNCH_MODE 1
#endif
#ifndef DBG_CHECK
#define DBG_CHECK 0
#endif
#ifndef DBG_TOL
#define DBG_TOL 0.3f
#endif
#ifndef F8_DOWN
#define F8_DOWN 1
#endif
#ifndef F8_GU
#define F8_GU 1
#endif
#ifndef F8_IN
#define F8_IN 1
#endif
#ifndef F8_OUT
#define F8_OUT 1
#endif
#ifndef F8_ATTA
#define F8_ATTA 1
#endif
#ifndef F8_ATTD
#define F8_ATTD 1
#endif
#ifndef F8_SPARSE
#define F8_SPARSE 1
#endif
#ifndef F8_YR
#define F8_YR 1
#endif

#define LAS __attribute__((address_space(3)))
typedef unsigned short bf16_t;
typedef short bf16x8 __attribute__((ext_vector_type(8)));
typedef short s16x4 __attribute__((ext_vector_type(4)));
typedef float f32x2 __attribute__((ext_vector_type(2)));
typedef float f32x4 __attribute__((ext_vector_type(4)));
typedef float f32x8 __attribute__((ext_vector_type(8)));
typedef float f32x16 __attribute__((ext_vector_type(16)));
typedef unsigned u32x2 __attribute__((ext_vector_type(2)));
typedef unsigned u32x4 __attribute__((ext_vector_type(4)));
typedef int i32x8 __attribute__((ext_vector_type(8)));
typedef _Float16 f16x8 __attribute__((ext_vector_type(8)));
typedef _Float16 f16x2 __attribute__((ext_vector_type(2)));
typedef int i32x4 __attribute__((ext_vector_type(4)));

constexpr int T_ = 32768, DM = 2048, SEQ = 4096, NBATCH = 8;
constexpr int IN0 = 4608, IN1 = 3904, IN1P = 4096;
constexpr int NE = 32, DE = 512, MAXBLK = 288;
constexpr float ALPHA = 1.4142135623730951f;
constexpr float LOG2E = 1.4426950408889634f;
constexpr int NTHR = 512;

constexpr size_t MiB = 1u << 20;
constexpr size_t WS_CTL = 0, CTL_ZERO_BYTES = 1 * MiB;
constexpr size_t WS_LIST = 1 * MiB;
constexpr size_t WS_TOKE = 9 * MiB;
constexpr size_t WS_TOKP = WS_TOKE + 256 * 1024;
constexpr size_t WS_TOKG = WS_TOKP + 256 * 1024;
constexpr size_t WS_RSTAT = WS_TOKG + 256 * 1024;
constexpr size_t WS_KROPE = 10 * MiB;
constexpr size_t WS_WIN0 = 16 * MiB, WS_WOUT0 = 34 * MiB, WS_WGU0 = 42 * MiB, WS_WD0 = 170 * MiB;
constexpr size_t WS_WIN1 = 234 * MiB, WS_WOUT1 = 250 * MiB, WS_WGU1 = 258 * MiB, WS_WD1 = 386 * MiB;
constexpr size_t WS_WQUP = 450 * MiB, WS_WKVUP = 452 * MiB;
constexpr size_t WS_RA = 454 * MiB, WS_RB = 582 * MiB, WS_RC = 870 * MiB, WS_END = 998 * MiB;
constexpr size_t OUT_QD = 0, OUT_O1 = 96 * MiB;
constexpr int CW_CNT = 64;
constexpr int CW_DBG = 512;
constexpr int CW_BAR = 4096;

constexpr int LDS_BYTES = 155648;
constexpr int MISC_OFF = LDS_BYTES - 64;

__device__ __forceinline__ unsigned cvtpk(float lo, float hi) { unsigned r; asm volatile("v_cvt_pk_bf16_f32 %0, %1, %2" : "=v"(r) : "v"(lo), "v"(hi)); return r; }
__device__ __forceinline__ float bf2f(unsigned short b) { return __uint_as_float(((unsigned)b) << 16); }
__device__ __forceinline__ float bflo(unsigned w) { return __uint_as_float(w << 16); }
__device__ __forceinline__ float bfhi(unsigned w) { return __uint_as_float(w & 0xffff0000u); }
__device__ __forceinline__ bf16_t f2bf(float f) { return (bf16_t)(cvtpk(f, f) & 0xffffu); }
__device__ __forceinline__ unsigned pk4_fp8(float a, float b, float c, float d) { int w = 0; w = __builtin_amdgcn_cvt_pk_fp8_f32(a, b, w, false); w = __builtin_amdgcn_cvt_pk_fp8_f32(c, d, w, true); return (unsigned)w; }
constexpr float O8_SCALE = 16.f;
__device__ __forceinline__ unsigned char f2fp8(float v) { return (unsigned char)(__builtin_amdgcn_cvt_pk_fp8_f32(v, v, 0, false) & 0xff); }
__device__ __forceinline__ float clamp8(float v) { return fminf(fmaxf(v, -400.f), 400.f); }
__device__ __forceinline__ int fresh_tid(int wv) { int l; asm volatile("v_mbcnt_lo_u32_b32 %0, -1, 0\n\tv_mbcnt_hi_u32_b32 %0, -1, %0" : "=v"(l)); return wv * 64 + l; }
__device__ __forceinline__ float fresh_zero() { float z; asm volatile("v_mov_b32 %0, 0" : "=v"(z)); return z; }
__device__ __forceinline__ float wave_sum(float v) {
    v += __int_as_float(__builtin_amdgcn_ds_swizzle(__float_as_int(v), (1 << 10) | 0x1f));
    v += __int_as_float(__builtin_amdgcn_ds_swizzle(__float_as_int(v), (2 << 10) | 0x1f));
    v += __int_as_float(__builtin_amdgcn_ds_swizzle(__float_as_int(v), (4 << 10) | 0x1f));
    v += __int_as_float(__builtin_amdgcn_ds_swizzle(__float_as_int(v), (8 << 10) | 0x1f));
    v += __int_as_float(__builtin_amdgcn_ds_swizzle(__float_as_int(v), (16 << 10) | 0x1f));
    auto rr = __builtin_amdgcn_permlane32_swap(__float_as_uint(v), __float_as_uint(v), false, false);
    return __uint_as_float(rr[0]) + __uint_as_float(rr[1]);
}
__device__ __forceinline__ float wave_max(float v) {
    v = fmaxf(v, __int_as_float(__builtin_amdgcn_ds_swizzle(__float_as_int(v), (1 << 10) | 0x1f)));
    v = fmaxf(v, __int_as_float(__builtin_amdgcn_ds_swizzle(__float_as_int(v), (2 << 10) | 0x1f)));
    v = fmaxf(v, __int_as_float(__builtin_amdgcn_ds_swizzle(__float_as_int(v), (4 << 10) | 0x1f)));
    v = fmaxf(v, __int_as_float(__builtin_amdgcn_ds_swizzle(__float_as_int(v), (8 << 10) | 0x1f)));
    v = fmaxf(v, __int_as_float(__builtin_amdgcn_ds_swizzle(__float_as_int(v), (16 << 10) | 0x1f)));
    auto rr = __builtin_amdgcn_permlane32_swap(__float_as_uint(v), __float_as_uint(v), false, false);
    return fmaxf(__uint_as_float(rr[0]), __uint_as_float(rr[1]));
}
__device__ __forceinline__ float inv_freq32(int i) { return __builtin_amdgcn_exp2f(-(float)i * 0.41524101186092029f); }
__device__ __forceinline__ void sincos_rev(float angle, float& s, float& c) {
    float rev = angle * 0.15915494309189535f; rev = rev - floorf(rev);
    s = __builtin_amdgcn_sinf(rev); c = __builtin_amdgcn_cosf(rev);
}

#define XB_TMO      128
#define XB_XCNT(j)  (256  + 64 * (j))
#define XB_XSUB(j)  (1280 + 64 * (j))
#define XB_XGEN(j)  (2304 + 64 * (j))
#define XB_TOP      3328
#define XB_TOPGEN   3392
#define XCD_BAR_WORDS 3456
#define XB_SPIN_CAP (1u << 20)
__device__ __forceinline__ unsigned xb_ld(unsigned* p)              { return __hip_atomic_load(p, __ATOMIC_RELAXED, __HIP_MEMORY_SCOPE_AGENT); }
__device__ __forceinline__ unsigned xb_add(unsigned* p, unsigned v) { return __hip_atomic_fetch_add(p, v, __ATOMIC_RELAXED, __HIP_MEMORY_SCOPE_AGENT); }
__device__ __forceinline__ unsigned xb_xcc_id() { return (unsigned)__builtin_amdgcn_s_getreg((3 << 11) | 20) & 0xFu; }
#define XB_SPIN(cond, bar) do { unsigned _sp = 0; while (cond) { __builtin_amdgcn_s_sleep(1); \
    if ((++_sp & 255u) == 0u) { if (xb_ld(&(bar)[XB_TMO])) break; if (_sp > XB_SPIN_CAP) { atomicAdd(&(bar)[XB_TMO], 1u); break; } } } } while (0)
struct XcdBarrier { unsigned* bar; unsigned x; volatile LAS unsigned* st; };
__device__ __forceinline__ XcdBarrier xcd_barrier_post(unsigned* bar, volatile LAS unsigned* st) {
    XcdBarrier b; b.bar = bar; b.x = xb_xcc_id(); b.st = st;
    if (threadIdx.x == 0) (void)xb_add(&bar[XB_XCNT(b.x)], 1u);
    return b;
}
__device__ __forceinline__ void xcd_barrier_complete(unsigned* bar, unsigned x, unsigned& nloc, unsigned& nx) {
    const unsigned G = gridDim.x * gridDim.y * gridDim.z;
    unsigned sum, cnt, mine, sp = 0u;
    for (;;) {
        sum = 0u; cnt = 0u; mine = 0u;
#pragma unroll
        for (unsigned j = 0; j < 16; ++j) { const unsigned c = xb_ld(&bar[XB_XCNT(j)]); sum += c; cnt += (c > 0u) ? 1u : 0u; mine = (j == x) ? c : mine; }
        if (sum == G) break;
        __builtin_amdgcn_s_sleep(1);
        if ((++sp & 255u) == 0u) { if (xb_ld(&bar[XB_TMO])) break; if (sp > XB_SPIN_CAP) { atomicAdd(&bar[XB_TMO], 1u); break; } }
    }
    nloc = mine > 0u ? mine : 1u; nx = cnt > 0u ? cnt : 1u;
}
__device__ __forceinline__ void xcd_barrier(const XcdBarrier& b, int tid_now) {
    asm volatile("s_waitcnt vmcnt(0)" ::: "memory");
    __syncthreads();
    if (tid_now == 0) {
        unsigned* bar = b.bar;
        __builtin_amdgcn_s_waitcnt(0);
        unsigned nloc = b.st[0], nx = b.st[1];
        if (nloc == 0u) { xcd_barrier_complete(bar, b.x, nloc, nx); b.st[0] = nloc; b.st[1] = nx; }
        const unsigned old = xb_add(&bar[XB_XSUB(b.x)], 1u);
        const unsigned gen = old / nloc;
        if (old + 1u == (gen + 1u) * nloc) {
            __builtin_amdgcn_fence(__ATOMIC_RELEASE, "agent");
            asm volatile("s_waitcnt vmcnt(0)" ::: "memory");
            const unsigned og = xb_add(&bar[XB_TOP], 1u);
            const unsigned tg = og / nx;
            if (og + 1u == (tg + 1u) * nx) xb_add(&bar[XB_TOPGEN], 1u);
            else XB_SPIN(xb_ld(&bar[XB_TOPGEN]) == tg, bar);
            __builtin_amdgcn_fence(__ATOMIC_ACQUIRE, "agent");
            xb_add(&bar[XB_XGEN(b.x)], 1u);
            asm volatile("s_waitcnt vmcnt(0)" ::: "memory");
        } else {
            XB_SPIN(xb_ld(&bar[XB_XGEN(b.x)]) == gen, bar);
            __builtin_amdgcn_fence(__ATOMIC_ACQUIRE, "agent");
            asm volatile("s_waitcnt vmcnt(0)" ::: "memory");
        }
    }
    __syncthreads();
}

namespace pg8 {
constexpr int BM = 256, BK = 64, HALF = 128, HTB = HALF * BK * 2, STAGE_BYTES = 8 * HTB, NXCD = 8, WGM = 8;
__device__ __forceinline__ int lds_byte(int r, int c) { const int st = (r >> 4) * 2 + (c >> 5), rr = r & 15, cc = c & 31, ob = rr * 64 + cc * 2; return st * 1024 + (ob ^ (((ob >> 9) & 1) << 5)); }
__device__ __forceinline__ void stage_rc(int b, int& R, int& C) { const int st = b / 1024, sb = b % 1024, swz = sb ^ (((sb >> 9) & 1) << 5); R = (st >> 1) * 16 + swz / 64; C = (st & 1) * 32 + (swz % 64) / 2; }
__device__ __forceinline__ int perm32(int rho) { const int n = rho >> 4, i = rho & 15; return 8 * (i >> 2) + 4 * n + (i & 3); }
struct Unit { int pm, pn, q; };
struct Gemm { const bf16_t* A; const bf16_t* Bt; int K, lda, ldb; };

struct StaticOrder {
    static constexpr bool GATHER = false;
    int nM, nN, nwg, G, c, lda;
    __device__ void init(int M, int N, int G_, int c_, int lda_) { nM = M / BM; nN = N / BM; nwg = nM * nN; G = G_; c = c_; lda = lda_; }
    __device__ __forceinline__ bool next(int i, Unit& u) const {
        const long L = (long)i * G + c; if (L >= nwg) return false;
        int wgid = (int)L; { const int q = nwg / NXCD, r = nwg % NXCD, xcd = wgid % NXCD, off = wgid / NXCD; wgid = (xcd < r ? xcd * (q + 1) : r * (q + 1) + (xcd - r) * q) + off; }
        const int nig = WGM * nN, gid = wgid / nig, fm = gid * WGM, gsz = (nM - fm) < WGM ? (nM - fm) : WGM;
        u.pm = fm + ((wgid % nig) % gsz); u.pn = (wgid % nig) / gsz; u.q = i; return true;
    }
    __device__ __forceinline__ void aoff(const Unit& u, const int (&R)[2], const int (&C)[2], unsigned (&o)[2][2]) const {
#pragma unroll
        for (int h = 0; h < 2; ++h)
#pragma unroll
            for (int i = 0; i < 2; ++i) o[h][i] = (unsigned)((u.pm * BM + h * HALF + R[i]) * lda + C[i]) * 2u;
    }
};
template <bool GATHER_> struct TableOrder {
    static constexpr bool GATHER = GATHER_;
    const LAS int* tab; const LAS int* idx; int n, lda;
    __device__ __forceinline__ bool next(int i, Unit& u) const { if (i >= n) return false; u.pm = tab[i]; u.pn = tab[16 + i]; u.q = i; return true; }
    __device__ __forceinline__ void aoff(const Unit& u, const int (&R)[2], const int (&C)[2], unsigned (&o)[2][2]) const {
#pragma unroll
        for (int h = 0; h < 2; ++h)
#pragma unroll
            for (int i = 0; i < 2; ++i) { const int row = GATHER ? idx[u.q * 256 + h * HALF + R[i]] : (u.pm * BM + h * HALF + R[i]); o[h][i] = (unsigned)(row * lda + C[i]) * 2u; }
    }
};

template <bool O8> struct EpiBf16T {
    static constexpr bool PERM = true;
    bf16_t* O; int ldc; int pnmask;
    __device__ __forceinline__ void operator()(const f32x4 (&acc)[2][2][4][2], const Unit& u, int wr, int wc, int fr, int fq) const {
        const int row0 = u.pm * BM + wr * 64 + fr; const int col0 = (u.pn & pnmask) * BM + wc * 32 + 8 * fq;
#pragma unroll
        for (int ai = 0; ai < 2; ++ai)
#pragma unroll
            for (int m = 0; m < 4; ++m) { const size_t eoff = (size_t)(row0 + ai * HALF + m * 16) * ldc + col0;
#pragma unroll
                for (int bj = 0; bj < 2; ++bj) { const f32x4 v0 = acc[ai][bj][m][0], v1 = acc[ai][bj][m][1];
                    if constexpr (O8) { u32x2 w; w.x = pk4_fp8(v0[0] * 16.f, v0[1] * 16.f, v0[2] * 16.f, v0[3] * 16.f); w.y = pk4_fp8(v1[0] * 16.f, v1[1] * 16.f, v1[2] * 16.f, v1[3] * 16.f);
                        *(u32x2*)((unsigned char*)O + eoff + bj * HALF) = w; }
                    else { u32x4 w; w.x = cvtpk(v0[0], v0[1]); w.y = cvtpk(v0[2], v0[3]); w.z = cvtpk(v1[0], v1[1]); w.w = cvtpk(v1[2], v1[3]);
                        *(u32x4*)(O + eoff + bj * HALF) = w; } } }
    }
};
typedef EpiBf16T<false> EpiBf16;
struct EpiRowScale {
    static constexpr bool PERM = true;
    bf16_t* O; int ldc; const float* rs; int which;
    __device__ __forceinline__ void operator()(const f32x4 (&acc)[2][2][4][2], const Unit& u, int wr, int wc, int fr, int fq) const {
        const int row0 = u.pm * BM + wr * 64 + fr; const int col0 = u.pn * BM + wc * 32 + 8 * fq;
#pragma unroll
        for (int ai = 0; ai < 2; ++ai)
#pragma unroll
            for (int m = 0; m < 4; ++m) { const int row = row0 + ai * HALF + m * 16; const float s = rs[row * 2 + which]; bf16_t* rowp = O + (size_t)row * ldc + col0;
#pragma unroll
                for (int bj = 0; bj < 2; ++bj) { const f32x4 v0 = acc[ai][bj][m][0] * s, v1 = acc[ai][bj][m][1] * s;
                    u32x4 w; w.x = cvtpk(v0[0], v0[1]); w.y = cvtpk(v0[2], v0[3]); w.z = cvtpk(v1[0], v1[1]); w.w = cvtpk(v1[2], v1[3]);
                    *(u32x4*)(rowp + bj * HALF) = w; } }
    }
};
struct EpiIn {
    static constexpr bool PERM = true;
    bf16_t* H; int ldh; unsigned char* K8; unsigned char* V8; int k_lo, v_lo, v_hi;
    __device__ __forceinline__ void operator()(const f32x4 (&acc)[2][2][4][2], const Unit& u, int wr, int wc, int fr, int fq) const {
        const int row0 = u.pm * BM + wr * 64 + fr; const int cw = wc * 32 + 8 * fq;
        const bool is8 = (u.pn >= k_lo && u.pn < v_hi);
        unsigned char* b8 = (u.pn < v_lo) ? K8 + (size_t)(u.pn - k_lo) * BM : V8 + (size_t)(u.pn - v_lo) * BM;
#pragma unroll
        for (int ai = 0; ai < 2; ++ai)
#pragma unroll
            for (int m = 0; m < 4; ++m) { const size_t row = (size_t)(row0 + ai * HALF + m * 16);
#pragma unroll
                for (int bj = 0; bj < 2; ++bj) { const f32x4 v0 = acc[ai][bj][m][0], v1 = acc[ai][bj][m][1];
                    if (is8) *(u32x2*)(b8 + row * 1024 + bj * HALF + cw) = (u32x2){pk4_fp8(v0[0], v0[1], v0[2], v0[3]), pk4_fp8(v1[0], v1[1], v1[2], v1[3])};
                    else { u32x4 w; w.x = cvtpk(v0[0], v0[1]); w.y = cvtpk(v0[2], v0[3]); w.z = cvtpk(v1[0], v1[1]); w.w = cvtpk(v1[2], v1[3]);
                        *(u32x4*)(H + row * ldh + u.pn * BM + bj * HALF + cw) = w; } } }
    }
};
struct EpiKV8 {
    static constexpr bool PERM = true;
    unsigned char* K8; unsigned char* Vt8; bf16_t* KV; bool wr_bf16;
    __device__ __forceinline__ void operator()(const f32x4 (&acc)[2][2][4][2], const Unit& u, int wr, int wc, int fr, int fq) const {
        const int row0 = u.pm * BM + wr * 64 + fr; const int c0 = wc * 32 + 8 * fq;
#pragma unroll
        for (int ai = 0; ai < 2; ++ai)
#pragma unroll
            for (int m = 0; m < 4; ++m) { const int row = row0 + ai * HALF + m * 16;
                { const f32x4 v0 = acc[ai][0][m][0], v1 = acc[ai][0][m][1];
                  *(u32x2*)(K8 + (size_t)row * 1024 + u.pn * 128 + c0) = (u32x2){pk4_fp8(v0[0], v0[1], v0[2], v0[3]), pk4_fp8(v1[0], v1[1], v1[2], v1[3])}; }
                { const f32x4 v0 = acc[ai][1][m][0], v1 = acc[ai][1][m][1]; const float vv[8] = {v0[0], v0[1], v0[2], v0[3], v1[0], v1[1], v1[2], v1[3]};
                  unsigned char* vp = Vt8 + ((size_t)((row >> 12) * 8 + u.pn) * 128 + c0) * SEQ + (row & (SEQ - 1));
#pragma unroll
                  for (int e = 0; e < 8; ++e) vp[(size_t)e * SEQ] = f2fp8(vv[e]); }
                if (wr_bf16) {
#pragma unroll
                    for (int bj = 0; bj < 2; ++bj) { const f32x4 v0 = acc[ai][bj][m][0], v1 = acc[ai][bj][m][1];
                        u32x4 w; w.x = cvtpk(v0[0], v0[1]); w.y = cvtpk(v0[2], v0[3]); w.z = cvtpk(v1[0], v1[1]); w.w = cvtpk(v1[2], v1[3]);
                        *(u32x4*)(KV + (size_t)row * DM + u.pn * BM + bj * HALF + c0) = w; } } }
    }
};
template <bool O8> struct EpiSiluMul {
    static constexpr bool PERM = true;
    bf16_t* O;
    __device__ __forceinline__ void operator()(const f32x4 (&acc)[2][2][4][2], const Unit& u, int wr, int wc, int fr, int fq) const {
        const int row0 = u.pm * BM + wr * 64 + fr; const int col0 = (u.pn & 3) * HALF + wc * 32 + 8 * fq;
#pragma unroll
        for (int ai = 0; ai < 2; ++ai)
#pragma unroll
            for (int m = 0; m < 4; ++m) { const size_t eoff = (size_t)(row0 + ai * HALF + m * 16) * DE + col0; float h[8];
#pragma unroll
                for (int n = 0; n < 2; ++n)
#pragma unroll
                    for (int j = 0; j < 4; ++j) { const float g = acc[ai][0][m][n][j], up = acc[ai][1][m][n][j];
                        const float sg = g * __builtin_amdgcn_rcpf(1.0f + __builtin_amdgcn_exp2f(-g * LOG2E)); h[n * 4 + j] = sg * up; }
                if constexpr (O8) { u32x2 w; w.x = pk4_fp8(clamp8(h[0]), clamp8(h[1]), clamp8(h[2]), clamp8(h[3])); w.y = pk4_fp8(clamp8(h[4]), clamp8(h[5]), clamp8(h[6]), clamp8(h[7]));
                    *(u32x2*)((unsigned char*)O + eoff) = w; }
                else { u32x4 w; w.x = cvtpk(h[0], h[1]); w.y = cvtpk(h[2], h[3]); w.z = cvtpk(h[4], h[5]); w.w = cvtpk(h[6], h[7]);
                    *(u32x4*)(O + eoff) = w; } }
    }
};
template <bool RES_F32> struct EpiResF32 {
    static constexpr bool PERM = false;
    float* Z; const void* res;
    __device__ __forceinline__ void operator()(const f32x4 (&acc)[2][2][4][2], const Unit& u, int wr, int wc, int fr, int fq) const {
        const int row0 = u.pm * BM + wr * 64 + fr, col0 = u.pn * BM + wc * 32 + 4 * fq;
        float ALPHA = 1.4142135623730951f; asm volatile("" : "+v"(ALPHA));
#pragma unroll
        for (int ai = 0; ai < 2; ++ai)
#pragma unroll
            for (int m = 0; m < 4; ++m) { const size_t off = (size_t)(row0 + ai * HALF + m * 16) * DM + col0;
#pragma unroll
                for (int bj = 0; bj < 2; ++bj)
#pragma unroll
                    for (int n = 0; n < 2; ++n) { f32x4 o = acc[ai][bj][m][n];
                        if constexpr (RES_F32) { const f32x4 rv = *(const f32x4*)((const float*)res + off + bj * HALF + n * 16); o += ALPHA * rv; }
                        else { const u32x2 rb = *(const u32x2*)((const bf16_t*)res + off + bj * HALF + n * 16);
                            o[0] += ALPHA * bflo(rb.x); o[1] += ALPHA * bfhi(rb.x); o[2] += ALPHA * bflo(rb.y); o[3] += ALPHA * bfhi(rb.y); }
                        *(f32x4*)(Z + off + bj * HALF + n * 16) = o; } }
    }
};

template <bool F8, class Epi, class Sched>
__device__ __forceinline__ void gemm_phase(int wv, LAS unsigned char* lds, const Gemm g, const Sched& S, const Epi& E, int sW = 0x7f7f7f7f, int sX = 0x7f7f7f7f) {
    constexpr bool GA = Sched::GATHER;
    const int tid = fresh_tid(wv), wid = __builtin_amdgcn_readfirstlane(tid >> 6), lane = tid & 63, wr = wid >> 2, wc = wid & 3, fr = lane & 15, fq = lane >> 4;
    int K = g.K; asm volatile("" : "+s"(K));
    const int nt = K / BK;
    int Rr[2], Cc[2]; unsigned voffA[2], voffB[2];
#pragma unroll
    for (int i = 0; i < 2; ++i) { int R, C; stage_rc(tid * 16 + i * 8192, R, C); Rr[i] = R; Cc[i] = C; const int Rb = Epi::PERM ? ((R & ~31) + perm32(R & 31)) : R;
        voffA[i] = (unsigned)(R * g.lda + C) * 2u; voffB[i] = (unsigned)(Rb * g.ldb + C) * 2u; }
    const size_t kstep = (size_t)(BK * 2);
    const size_t hstepA = (size_t)HALF * g.lda * 2, tstepA = 2 * hstepA;
    const size_t hstepB = (size_t)HALF * g.ldb * 2, tstepB = 2 * hstepB;
    const unsigned ldsw = (unsigned)wid * 1024u;
    const int aoff = lds_byte(wr * 64 + fr, fq * 8), boff = lds_byte(wc * 32 + fr, fq * 8);
#define PG8_SA(b, h) (((b) * 2 + (h)) * HTB)
#define PG8_SB(b, h) ((4 + (b) * 2 + (h)) * HTB)
#define PG8_STAGE(bufoff, gbase, voff) do { _Pragma("unroll") for (int _i = 0; _i < 2; ++_i) \
        __builtin_amdgcn_global_load_lds((const unsigned*)((const char*)(gbase) + (voff)[_i]), (LAS unsigned*)(lds + (bufoff) + ldsw + _i * 8192), 16, 0, 0); } while (0)
#define PG8_STAGE_A(bufoff, h, pbase, koff, goffs) do { if constexpr (GA) { PG8_STAGE(bufoff, gA + (koff), (goffs)[h]); } else { PG8_STAGE(bufoff, (pbase) + (h) * hstepA, voffA); } } while (0)
#define PG8_LD32(dst, off) do { const i32x4 _lo = *(const LAS i32x4*)(lds + (off)), _hi = *(const LAS i32x4*)(lds + (off) + 1024); dst = __builtin_shufflevector(_lo, _hi, 0, 1, 2, 3, 4, 5, 6, 7); } while (0)
#define PG8_LDA(dst, b, h) do { _Pragma("unroll") for (int m = 0; m < 4; ++m) PG8_LD32(dst[m], PG8_SA(b, h) + aoff + m * 2048); } while (0)
#define PG8_LDB(dst, b, h) do { _Pragma("unroll") for (int n = 0; n < 2; ++n) PG8_LD32(dst[n], PG8_SB(b, h) + boff + n * 2048); } while (0)
#define PG8_LOH(v) __builtin_bit_cast(bf16x8, __builtin_shufflevector(v, v, 0, 1, 2, 3))
#define PG8_HIH(v) __builtin_bit_cast(bf16x8, __builtin_shufflevector(v, v, 4, 5, 6, 7))
#define PG8_MMA(ai, bj, At, Bt) do { __builtin_amdgcn_s_setprio(1); \
        if constexpr (F8) { _Pragma("unroll") for (int m = 0; m < 4; ++m) _Pragma("unroll") for (int n = 0; n < 2; ++n) \
            asm volatile("v_mfma_scale_f32_16x16x128_f8f6f4 %0, %1, %2, %0, %3, %4 op_sel_hi:[0,0,0]" : "+v"(acc[ai][bj][m][n]) : "v"(Bt[n]), "v"(At[m]), "v"(sW), "v"(sX)); } \
        else { _Pragma("unroll") for (int m = 0; m < 4; ++m) _Pragma("unroll") for (int n = 0; n < 2; ++n) { \
            acc[ai][bj][m][n] = __builtin_amdgcn_mfma_f32_16x16x32_bf16(PG8_LOH(Bt[n]), PG8_LOH(At[m]), acc[ai][bj][m][n], 0, 0, 0); \
            acc[ai][bj][m][n] = __builtin_amdgcn_mfma_f32_16x16x32_bf16(PG8_HIH(Bt[n]), PG8_HIH(At[m]), acc[ai][bj][m][n], 0, 0, 0); } } \
        __builtin_amdgcn_s_setprio(0); } while (0)
#define PG8_WAIT_V(n) asm volatile("s_waitcnt vmcnt(" #n ")" ::: "memory")
#define PG8_WAIT_L(n) asm volatile("s_waitcnt lgkmcnt(" #n ")" ::: "memory")
#define PG8_BAR __builtin_amdgcn_s_barrier()
#define PG8_SCHED __builtin_amdgcn_sched_barrier(0)
    Unit cur, nxt; int ui = 0;
    if (!S.next(0, cur)) return;
    f32x4 acc[2][2][4][2];
#pragma unroll
    for (int a = 0; a < 2; ++a)
#pragma unroll
        for (int b = 0; b < 2; ++b)
#pragma unroll
            for (int m = 0; m < 4; ++m)
#pragma unroll
                for (int n = 0; n < 2; ++n) { const float zf = fresh_zero(); acc[a][b][m][n] = (f32x4){zf, zf, zf, zf}; }
    unsigned ca[2][2];
    if constexpr (GA) S.aoff(cur, Rr, Cc, ca);
    const char* gA = (const char*)g.A;
    const char* cA = gA + (GA ? (size_t)0 : (size_t)cur.pm * tstepA);
    const char* cB = (const char*)g.Bt + (size_t)cur.pn * tstepB;
    PG8_STAGE(PG8_SB(0, 0), cB, voffB); PG8_STAGE_A(PG8_SA(0, 0), 0, cA, 0, ca); PG8_STAGE(PG8_SB(0, 1), cB + hstepB, voffB); PG8_STAGE_A(PG8_SA(0, 1), 1, cA, 0, ca);
    if (wr == 1) PG8_BAR;
    PG8_WAIT_V(4); PG8_BAR;
    PG8_STAGE(PG8_SB(1, 0), cB + kstep, voffB); PG8_STAGE_A(PG8_SA(1, 0), 0, cA + kstep, kstep, ca); PG8_STAGE(PG8_SB(1, 1), cB + hstepB + kstep, voffB);
    PG8_WAIT_V(6); PG8_BAR;
    for (;;) {
        const bool has_next = S.next(ui + 1, nxt);
        const char* nA = (!GA && has_next) ? gA + (size_t)nxt.pm * tstepA : cA;
        const char* nB = has_next ? (const char*)g.Bt + (size_t)nxt.pn * tstepB : cB;
#pragma unroll 1
        for (int t = 0; t < nt; t += 2) {
            const bool last = (t == nt - 2);
            const size_t k1 = (size_t)(t + 1) * kstep, k2 = last ? (size_t)0 : (size_t)(t + 2) * kstep, k3 = k2 + kstep;
            const char* a1 = cA + k1;
            const char* a2 = last ? nA : cA + k2; const char* b2 = last ? nB : cB + (size_t)(t + 2) * kstep;
            const char* a3 = a2 + kstep; const char* b3 = b2 + kstep;
            i32x8 At[4], B0[2], B1[2];
            unsigned xa[2][2];
            if constexpr (GA) {
                if (last && has_next) { int R2[2], C2[2]; const int t2 = fresh_tid(wv); stage_rc(t2 * 16, R2[0], C2[0]); stage_rc(t2 * 16 + 8192, R2[1], C2[1]); S.aoff(nxt, R2, C2, xa); }
                else {
#pragma unroll
                    for (int h = 0; h < 2; ++h)
#pragma unroll
                        for (int i = 0; i < 2; ++i) xa[h][i] = ca[h][i];
                }
            }
            PG8_LDB(B0, 0, 0); PG8_SCHED; PG8_LDA(At, 0, 0); PG8_STAGE_A(PG8_SA(1, 1), 1, a1, k1, ca);
            PG8_WAIT_L(8); PG8_BAR; PG8_WAIT_L(0); PG8_MMA(0, 0, At, B0); PG8_BAR; PG8_SCHED;
            PG8_LDB(B1, 0, 1); PG8_STAGE(PG8_SB(0, 0), b2, voffB);
            PG8_BAR; PG8_WAIT_L(0); PG8_MMA(0, 1, At, B1); PG8_BAR;
            PG8_LDA(At, 0, 1); PG8_STAGE_A(PG8_SA(0, 0), 0, a2, k2, xa);
            PG8_BAR; PG8_WAIT_L(0); PG8_MMA(1, 0, At, B0); PG8_BAR; PG8_SCHED;
            PG8_STAGE(PG8_SB(0, 1), b2 + hstepB, voffB);
            PG8_WAIT_V(6); PG8_BAR; PG8_MMA(1, 1, At, B1); PG8_BAR;
            PG8_LDB(B0, 1, 0); PG8_SCHED; PG8_LDA(At, 1, 0); PG8_STAGE_A(PG8_SA(0, 1), 1, a2, k2, xa);
            PG8_WAIT_L(8); PG8_BAR; PG8_WAIT_L(0); PG8_MMA(0, 0, At, B0); PG8_BAR; PG8_SCHED;
            PG8_LDB(B1, 1, 1); PG8_STAGE(PG8_SB(1, 0), b3, voffB);
            PG8_BAR; PG8_WAIT_L(0); PG8_MMA(0, 1, At, B1); PG8_BAR;
            PG8_LDA(At, 1, 1); PG8_STAGE_A(PG8_SA(1, 0), 0, a3, k3, xa);
            PG8_BAR; PG8_WAIT_L(0); PG8_MMA(1, 0, At, B0); PG8_BAR; PG8_SCHED;
            PG8_STAGE(PG8_SB(1, 1), b3 + hstepB, voffB);
            PG8_WAIT_V(6); PG8_BAR; PG8_MMA(1, 1, At, B1); PG8_BAR;
        }
        if constexpr (F8) asm volatile("s_nop 7\n\ts_nop 7\n\ts_nop 7" ::: "memory");
        { const int l2 = fresh_tid(0); E(acc, cur, wr, wc, l2 & 15, l2 >> 4); }
        if (!has_next) break;
#pragma unroll
        for (int a = 0; a < 2; ++a)
#pragma unroll
            for (int b = 0; b < 2; ++b)
#pragma unroll
                for (int m = 0; m < 4; ++m)
#pragma unroll
                    for (int n = 0; n < 2; ++n) { const float zf = fresh_zero(); acc[a][b][m][n] = (f32x4){zf, zf, zf, zf}; }
        cur = nxt; cA = nA; cB = nB; ++ui;
        if constexpr (GA) { int R2[2], C2[2]; const int t2 = fresh_tid(wv); stage_rc(t2 * 16, R2[0], C2[0]); stage_rc(t2 * 16 + 8192, R2[1], C2[1]); S.aoff(cur, R2, C2, ca); }
    }
    PG8_WAIT_V(0);
    if (wr == 0) PG8_BAR;
    PG8_BAR;
#undef PG8_SA
#undef PG8_SB
#undef PG8_STAGE
#undef PG8_STAGE_A
#undef PG8_LDA
#undef PG8_LDB
#undef PG8_MMA
#undef PG8_LD32
#undef PG8_LOH
#undef PG8_HIH
#undef PG8_WAIT_V
#undef PG8_WAIT_L
#undef PG8_BAR
#undef PG8_SCHED
}
}

namespace da {
constexpr int KVBLK = 64;
constexpr float THR = 8.f;
constexpr int SHM_V = KVBLK * 128 * 2, SHM_K = KVBLK * 128 * 2, SHM_KR = KVBLK * 64 * 2;
constexpr int OFF_V = 0, OFF_K = 2 * SHM_V, OFF_WS = OFF_K + 2 * SHM_K, OFF_KR = OFF_WS + 8 * 64 * 4, OFF_QR = OFF_KR + 2 * SHM_KR, LDS_DENSE = OFF_QR + 8 * 4096;
#define KSWZ(row, colB) ((row) * 256 + ((colB) ^ (((row) & 7) << 4)))
#define KRSWZ(row, ch) ((row) * 128 + ((((ch) ^ ((row) >> 1)) & 7) << 4))
#define SBAR() __builtin_amdgcn_sched_barrier(0)
__device__ __forceinline__ int crow(int r, int hi) { return (r & 3) + 8 * (r >> 2) + 4 * hi; }
__device__ __forceinline__ int v_st(int k, int c) { const int kk = (k & ~0xC) | ((k & 4) << 1) | ((k & 8) >> 1); return ((kk >> 3) * 4 + (c >> 5)) * 512 + ((kk & 7) * 32 + (c & 31)) * 2; }
__device__ __forceinline__ int v_rd_base(int lane) { return ((lane & 3) << 3) | (((lane >> 2) & 3) << 6) | (((lane >> 4) & 1) << 5) | (((lane >> 5) & 1) << 8); }
constexpr int v_rd_off(int d0, int ks, int half) { return d0 * 512 + ks * 4096 + half * 2048; }
template <int OFF> __device__ __forceinline__ s16x4 tr_read(int vb) {
    s16x4 r; asm volatile("ds_read_b64_tr_b16 %0, %1 offset:%2" : "=&v"(r) : "v"(vb), "i"(OFF) : "memory"); return r;
}
template <int D0> __device__ __forceinline__ void pv_one(f32x16& od, int vb, bf16x8 pa0, bf16x8 pa1, bf16x8 pa2, bf16x8 pa3) {
    const s16x4 l0 = tr_read<v_rd_off(D0, 0, 0)>(vb), h0 = tr_read<v_rd_off(D0, 0, 1)>(vb), l1 = tr_read<v_rd_off(D0, 1, 0)>(vb), h1 = tr_read<v_rd_off(D0, 1, 1)>(vb);
    const s16x4 l2 = tr_read<v_rd_off(D0, 2, 0)>(vb), h2 = tr_read<v_rd_off(D0, 2, 1)>(vb), l3 = tr_read<v_rd_off(D0, 3, 0)>(vb), h3 = tr_read<v_rd_off(D0, 3, 1)>(vb);
    asm volatile("s_waitcnt lgkmcnt(0)" ::: "memory"); SBAR();
#define PK(L, H) (bf16x8){L[0], L[1], L[2], L[3], H[0], H[1], H[2], H[3]}
    od = __builtin_amdgcn_mfma_f32_32x32x16_bf16(pa0, PK(l0, h0), od, 0, 0, 0);
    od = __builtin_amdgcn_mfma_f32_32x32x16_bf16(pa1, PK(l1, h1), od, 0, 0, 0);
    od = __builtin_amdgcn_mfma_f32_32x32x16_bf16(pa2, PK(l2, h2), od, 0, 0, 0);
    od = __builtin_amdgcn_mfma_f32_32x32x16_bf16(pa3, PK(l3, h3), od, 0, 0, 0);
}
__device__ __forceinline__ void pv_d0(f32x16* o, int vb, bf16x8 pa0, bf16x8 pa1, bf16x8 pa2, bf16x8 pa3) {
    pv_one<0>(o[0], vb, pa0, pa1, pa2, pa3); pv_one<1>(o[1], vb, pa0, pa1, pa2, pa3); pv_one<2>(o[2], vb, pa0, pa1, pa2, pa3); pv_one<3>(o[3], vb, pa0, pa1, pa2, pa3);
}
template <int D0> __device__ __forceinline__ void pv_one32(f32x16& od, int vb, bf16x8 pa0, bf16x8 pa1) {
    const s16x4 l0 = tr_read<v_rd_off(D0, 0, 0)>(vb), h0 = tr_read<v_rd_off(D0, 0, 1)>(vb), l1 = tr_read<v_rd_off(D0, 1, 0)>(vb), h1 = tr_read<v_rd_off(D0, 1, 1)>(vb);
    asm volatile("s_waitcnt lgkmcnt(0)" ::: "memory"); SBAR();
    od = __builtin_amdgcn_mfma_f32_32x32x16_bf16(pa0, PK(l0, h0), od, 0, 0, 0);
    od = __builtin_amdgcn_mfma_f32_32x32x16_bf16(pa1, PK(l1, h1), od, 0, 0, 0);
}
#undef PK
#define PK4(P, BASE, OUT) do { unsigned a0 = cvtpk(P[BASE + 0], P[BASE + 1]), a1 = cvtpk(P[BASE + 2], P[BASE + 3]);   \
    unsigned b0 = cvtpk(P[BASE + 4], P[BASE + 5]), b1 = cvtpk(P[BASE + 6], P[BASE + 7]);                              \
    auto r0 = __builtin_amdgcn_permlane32_swap(a0, b0, false, false); auto r1 = __builtin_amdgcn_permlane32_swap(a1, b1, false, false); \
    u32x4 w = {r0[0], r1[0], r0[1], r1[1]}; OUT = *reinterpret_cast<bf16x8*>(&w); } while (0)

template <int NDQ> struct Cst { static constexpr float SCALE = (NDQ == 8) ? 0.088388347648318440f : 0.072168783648703220f; static constexpr float C = SCALE * LOG2E; };

template <int NDQ>
__device__ __forceinline__ void partialSM(f32x16& p0, f32x16& p1, float& m_reg, float& mn, float& alpha) {
    constexpr float C = Cst<NDQ>::C, SCALE = Cst<NDQ>::SCALE;
    float pmax = p0[0];
#pragma unroll
    for (int r = 1; r < 16; ++r) pmax = fmaxf(pmax, p0[r]);
#pragma unroll
    for (int r = 0; r < 16; ++r) pmax = fmaxf(pmax, p1[r]);
    { auto rr = __builtin_amdgcn_permlane32_swap(__float_as_uint(pmax), __float_as_uint(pmax), false, false);
      pmax = fmaxf(__uint_as_float(rr[0]), __uint_as_float(rr[1])); }
    if (__builtin_expect(__all(pmax - m_reg <= THR / SCALE), 1)) { mn = m_reg; alpha = 1.f; }
    else { mn = fmaxf(m_reg, pmax); alpha = __builtin_amdgcn_exp2f((m_reg - mn) * C); m_reg = mn; }
    const float mnC = -mn * C;
#pragma unroll
    for (int r = 0; r < 16; ++r) p0[r] = fmaf(p0[r], C, mnC);
#pragma unroll
    for (int r = 0; r < 16; ++r) p1[r] = fmaf(p1[r], C, mnC);
#pragma unroll
    for (int r = 0; r < 16; ++r) p0[r] = __builtin_amdgcn_exp2f(p0[r]);
}
__device__ __forceinline__ void finishSM(f32x16& p0, f32x16& p1, float alpha, float& l_reg, bf16x8& pa0, bf16x8& pa1, bf16x8& pa2, bf16x8& pa3) {
#pragma unroll
    for (int r = 0; r < 16; ++r) p1[r] = __builtin_amdgcn_exp2f(p1[r]);
    float ps = 0;
#pragma unroll
    for (int r = 0; r < 16; ++r) ps += p0[r];
#pragma unroll
    for (int r = 0; r < 16; ++r) ps += p1[r];
    { auto rr = __builtin_amdgcn_permlane32_swap(__float_as_uint(ps), __float_as_uint(ps), false, false);
      ps = __uint_as_float(rr[0]) + __uint_as_float(rr[1]); }
    l_reg = l_reg * alpha + ps;
    PK4(p0, 0, pa0); PK4(p0, 8, pa1); PK4(p1, 0, pa2); PK4(p1, 8, pa3);
}
template <int NDQ>
__device__ __forceinline__ void qkt(f32x16& p0, f32x16& p1, const char* Ks, const char* Krs, const bf16x8* qr, const char* qrl, int r32, int hi) {
    p0 = f32x16{}; p1 = f32x16{};
#pragma unroll
    for (int d0 = 0; d0 < 8; ++d0) { const int cb = (d0 * 16 + hi * 8) * 2;
        bf16x8 b0 = *reinterpret_cast<const bf16x8*>(Ks + KSWZ(r32, cb));
        bf16x8 b1 = *reinterpret_cast<const bf16x8*>(Ks + KSWZ(32 + r32, cb));
        p0 = __builtin_amdgcn_mfma_f32_32x32x16_bf16(b0, qr[d0], p0, 0, 0, 0);
        p1 = __builtin_amdgcn_mfma_f32_32x32x16_bf16(b1, qr[d0], p1, 0, 0, 0); }
    if constexpr (NDQ == 12) {
#pragma unroll
        for (int d0 = 0; d0 < 4; ++d0) { const int ch = d0 * 2 + hi;
            bf16x8 b0 = *reinterpret_cast<const bf16x8*>(Krs + KRSWZ(r32, ch));
            bf16x8 b1 = *reinterpret_cast<const bf16x8*>(Krs + KRSWZ(32 + r32, ch));
            const bf16x8 qf = *reinterpret_cast<const bf16x8*>(qrl + d0 * 1024);
            p0 = __builtin_amdgcn_mfma_f32_32x32x16_bf16(b0, qf, p0, 0, 0, 0);
            p1 = __builtin_amdgcn_mfma_f32_32x32x16_bf16(b1, qf, p1, 0, 0, 0); }
    }
}

struct DArgs { const bf16_t* Q; const bf16_t* K; const bf16_t* V; const bf16_t* Kr; bf16_t* O; int ldq, ldk, ldv, ldo; int seq; int pos0; };

template <int NDQ, int SDEPTH>
__device__ __forceinline__ void attn_dense_body(int wv, const DArgs a, char* lds) {
    const int tid = fresh_tid(wv), wid = tid >> 6, lane = tid & 63, r32 = lane & 31, hi = lane >> 5;
    char* V_lds = lds + OFF_V; char* K_lds = lds + OFF_K; char* Kr_lds = lds + OFF_KR;
    float* ws = (float*)(lds + OFF_WS) + wid * 64; float* li_l = ws; float* al_l = ws + 32;
    float m_reg = -1e30f, l_reg = 0; f32x16 o[4] = {}; bf16x8 qr[8];
    char* qrl = lds + OFF_QR + wid * 4096 + lane * 16;
    const bf16_t* Qw = a.Q + (long)(wid * 32 + r32) * a.ldq + hi * 8;
#pragma unroll
    for (int d0 = 0; d0 < 8; ++d0) qr[d0] = *reinterpret_cast<const bf16x8*>(Qw + d0 * 16);
    if constexpr (NDQ == 12) {
        const float pos = (float)(a.pos0 + wid * 32 + r32);
#pragma unroll
        for (int f = 0; f < 2; ++f) {
            const bf16x8 x1v = *reinterpret_cast<const bf16x8*>(Qw + (8 + f) * 16), x2v = *reinterpret_cast<const bf16x8*>(Qw + (10 + f) * 16); bf16x8 y1v, y2v;
#pragma unroll
            for (int j = 0; j < 8; ++j) { const int i = f * 16 + hi * 8 + j; float sn, cs; sincos_rev(pos * inv_freq32(i), sn, cs);
                const float x1 = bf2f((unsigned short)x1v[j]), x2 = bf2f((unsigned short)x2v[j]);
                y1v[j] = (short)f2bf(x1 * cs - x2 * sn); y2v[j] = (short)f2bf(x2 * cs + x1 * sn); }
            *reinterpret_cast<bf16x8*>(qrl + f * 1024) = y1v; *reinterpret_cast<bf16x8*>(qrl + (2 + f) * 1024) = y2v;
        }
    }
    const int sr = tid >> 4, sc = (tid & 15) * 8, vst0 = v_st(sr, sc), vst1 = v_st(32 + sr, sc);
    const int krr = tid >> 3, krc = tid & 7;
    const int vb0 = (int)(uintptr_t)V_lds + v_rd_base(lane);
    struct { bf16x8 vs0, vs1, ks0, ks1, kr; } sr_[SDEPTH];
#define SLOAD(i, k0) do { sr_[i].vs0 = *(const bf16x8*)(a.V + (long)((k0) + sr) * a.ldv + sc); sr_[i].vs1 = *(const bf16x8*)(a.V + (long)((k0) + 32 + sr) * a.ldv + sc); \
    sr_[i].ks0 = *(const bf16x8*)(a.K + (long)((k0) + sr) * a.ldk + sc); sr_[i].ks1 = *(const bf16x8*)(a.K + (long)((k0) + 32 + sr) * a.ldk + sc); \
    if constexpr (NDQ == 12) sr_[i].kr = *(const bf16x8*)(a.Kr + (long)((k0) + krr) * 64 + krc * 8); } while (0)
#define SWRITE(b, i) do { *(bf16x8*)(V_lds + (b) * SHM_V + vst0) = sr_[i].vs0; *(bf16x8*)(V_lds + (b) * SHM_V + vst1) = sr_[i].vs1; const int kc = sc * 2; \
    *(bf16x8*)(K_lds + (b) * SHM_K + KSWZ(sr, kc)) = sr_[i].ks0; *(bf16x8*)(K_lds + (b) * SHM_K + KSWZ(32 + sr, kc)) = sr_[i].ks1; \
    if constexpr (NDQ == 12) *(bf16x8*)(Kr_lds + (b) * SHM_KR + KRSWZ(krr, krc)) = sr_[i].kr; } while (0)
#define SWAIT() do { if constexpr (SDEPTH == 2) { if constexpr (NDQ == 12) asm volatile("s_waitcnt vmcnt(5)" ::: "memory"); else asm volatile("s_waitcnt vmcnt(4)" ::: "memory"); } else asm volatile("s_waitcnt vmcnt(0)" ::: "memory"); } while (0)
#define RESC(al) do { if (__any((al) < 1.f)) { if (hi == 0) al_l[r32] = (al); asm volatile("s_waitcnt lgkmcnt(0)" ::: "memory"); \
    _Pragma("unroll") for (int d = 0; d < 4; ++d) _Pragma("unroll") for (int r = 0; r < 16; ++r) o[d][r] *= al_l[crow(r, hi)]; } } while (0)
    f32x16 pA0, pA1, pB0, pB1; float mnA, mnB, alA, alB; bf16x8 pa0, pa1, pa2, pa3; const int NT = a.seq / KVBLK;
    constexpr int SE = 0, SO = SDEPTH - 1;
    SLOAD(SE, 0); asm volatile("s_waitcnt vmcnt(0)" ::: "memory"); SWRITE(0, SE); __syncthreads();
    qkt<NDQ>(pA0, pA1, K_lds, Kr_lds, qr, qrl, r32, hi); partialSM<NDQ>(pA0, pA1, m_reg, mnA, alA);
    SLOAD(SO, KVBLK); if constexpr (SDEPTH == 2) { if (2 < NT) SLOAD(SE, 2 * KVBLK); }
    SWAIT(); SWRITE(1, SO); __syncthreads();
#pragma unroll 1
    for (int j = 1; j + 1 < NT; j += 2) {
        SBAR(); qkt<NDQ>(pB0, pB1, K_lds + SHM_K, Kr_lds + SHM_KR, qr, qrl, r32, hi);
        finishSM(pA0, pA1, alA, l_reg, pa0, pa1, pa2, pa3); SBAR();
        SLOAD(SO, (j + SDEPTH) * KVBLK); SBAR();
        pv_d0(o, vb0, pa0, pa1, pa2, pa3); partialSM<NDQ>(pB0, pB1, m_reg, mnB, alB);
        __syncthreads(); SWAIT(); SWRITE(0, SE);
        RESC(alB); __syncthreads();
        SBAR(); qkt<NDQ>(pA0, pA1, K_lds, Kr_lds, qr, qrl, r32, hi);
        finishSM(pB0, pB1, alB, l_reg, pa0, pa1, pa2, pa3); SBAR();
        if (SDEPTH == 1 || j + 3 < NT) SLOAD(SE, (j + 1 + SDEPTH) * KVBLK); SBAR();
        pv_d0(o, vb0 + (int)SHM_V, pa0, pa1, pa2, pa3); partialSM<NDQ>(pA0, pA1, m_reg, mnA, alA);
        __syncthreads(); SWAIT(); SWRITE(1, SO);
        RESC(alA); __syncthreads();
    }
    SBAR(); qkt<NDQ>(pB0, pB1, K_lds + SHM_K, Kr_lds + SHM_KR, qr, qrl, r32, hi);
    finishSM(pA0, pA1, alA, l_reg, pa0, pa1, pa2, pa3); SBAR();
    pv_d0(o, vb0, pa0, pa1, pa2, pa3); partialSM<NDQ>(pB0, pB1, m_reg, mnB, alB);
    __syncthreads(); RESC(alB);
    finishSM(pB0, pB1, alB, l_reg, pa0, pa1, pa2, pa3); SBAR();
    pv_d0(o, vb0 + (int)SHM_V, pa0, pa1, pa2, pa3);
    if (hi == 0) li_l[r32] = l_reg; asm volatile("s_waitcnt lgkmcnt(0)" ::: "memory");
    float rli[16];
#pragma unroll
    for (int r = 0; r < 16; ++r) rli[r] = __builtin_amdgcn_rcpf(li_l[crow(r, hi)]);
    bf16_t* Ow = F8_OUT ? (bf16_t*)((unsigned char*)a.O + (long)(wid * 32) * a.ldo) : a.O + (long)(wid * 32) * a.ldo;
#pragma unroll
    for (int r = 0; r < 16; ++r) { const int orow = crow(r, hi);
#pragma unroll
        for (int d0 = 0; d0 < 4; ++d0) { if constexpr (F8_OUT) ((unsigned char*)Ow)[(long)orow * a.ldo + d0 * 32 + r32] = f2fp8(o[d0][r] * rli[r] * O8_SCALE); else Ow[(long)orow * a.ldo + d0 * 32 + r32] = f2bf(o[d0][r] * rli[r]); } }
#undef SLOAD
#undef SWRITE
#undef SWAIT
#undef RESC
}

constexpr int SP_WAVE_LDS = 18688;
template <class P>
__device__ __forceinline__ void sparse_wave(P& pol, LAS unsigned char* wll, int lane) {
    const int r32 = lane & 31, hi = lane >> 5;
    char* wl = (char*)wll;
    char* Kl = wl; char* Vl = wl + 8192; float* li_l = (float*)(wl + 16384); float* al_l = li_l + 32;
    bf16x8 qr[8];
    { const bf16_t* qp = pol.qptr(r32) + hi * 8;
#pragma unroll
      for (int d0 = 0; d0 < 8; ++d0) qr[d0] = *reinterpret_cast<const bf16x8*>(qp + d0 * 16); }
    asm volatile("s_waitcnt vmcnt(0)" ::: "memory");
    f32x16 o[4] = {}; float m_reg = -1e30f, l_reg = 0.f;
    const int krow0 = lane >> 4;
    const int kce = (((lane & 15) ^ (krow0 & 7)) * 8), kco = (((lane & 15) ^ ((4 + krow0) & 7)) * 8);
    const int vk0 = 8 * ((lane >> 4) & 1) + ((lane >> 2) & 3), vc0 = 32 * (lane >> 5) + 8 * (lane & 3);
    const int vb = (int)(uintptr_t)Vl + v_rd_base(lane);
    const int nt = pol.ntiles();
    typename P::TI ti, tn;
#define SP_DMA_K(T) do { _Pragma("unroll") for (int i = 0; i < 8; ++i) { const bf16_t* src = (T).k + (long)(4 * i + krow0) * (T).rs + ((i & 1) ? kco : kce); \
        __builtin_amdgcn_global_load_lds((const unsigned*)src, (LAS unsigned*)(wll + i * 1024), 16, 0, 0); } } while (0)
#define SP_DMA_V(T) do { _Pragma("unroll") for (int i = 0; i < 8; ++i) { const bf16_t* src = (T).v + (long)(16 * (i >> 2) + 4 * ((i >> 1) & 1) + vk0) * (T).rs + 64 * (i & 1) + vc0; \
        __builtin_amdgcn_global_load_lds((const unsigned*)src, (LAS unsigned*)(wll + 8192 + i * 1024), 16, 0, 0); } } while (0)
    pol.tile(0, ti);
    SP_DMA_K(ti); SP_DMA_V(ti);
#pragma unroll 1
    for (int j = 0; j < nt; ++j) {
        const bool more = (j + 1 < nt);
        if (more) pol.tile(j + 1, tn);
        asm volatile("s_waitcnt vmcnt(8)" ::: "memory");
        f32x16 p = f32x16{};
#pragma unroll
        for (int d0 = 0; d0 < 8; ++d0) { const int cb = (d0 * 16 + hi * 8) * 2;
            bf16x8 b0 = *reinterpret_cast<const bf16x8*>(Kl + KSWZ(r32, cb));
            p = __builtin_amdgcn_mfma_f32_32x32x16_bf16(b0, qr[d0], p, 0, 0, 0); }
        asm volatile("s_waitcnt lgkmcnt(0)" ::: "memory"); SBAR();
        if (more) SP_DMA_K(tn);
        SBAR();
        float pmax = -INFINITY;
#pragma unroll
        for (int r = 0; r < 16; ++r) { p[r] = pol.adj(ti, crow(r, hi), p[r]); pmax = fmaxf(pmax, p[r]); }
        { auto rr = __builtin_amdgcn_permlane32_swap(__float_as_uint(pmax), __float_as_uint(pmax), false, false);
          pmax = fmaxf(__uint_as_float(rr[0]), __uint_as_float(rr[1])); }
        const float mn = fmaxf(m_reg, pmax); const float alpha = __builtin_amdgcn_exp2f(m_reg - mn); m_reg = mn;
        float ps = 0.f;
#pragma unroll
        for (int r = 0; r < 16; ++r) { p[r] = __builtin_amdgcn_exp2f(p[r] - mn); ps += p[r]; }
        { auto rr = __builtin_amdgcn_permlane32_swap(__float_as_uint(ps), __float_as_uint(ps), false, false);
          ps = __uint_as_float(rr[0]) + __uint_as_float(rr[1]); }
        l_reg = l_reg * alpha + ps;
        if (__any(alpha < 1.f)) { if (hi == 0) al_l[r32] = alpha; asm volatile("s_waitcnt lgkmcnt(0)" ::: "memory");
#pragma unroll
            for (int d = 0; d < 4; ++d)
#pragma unroll
                for (int r = 0; r < 16; ++r) o[d][r] *= al_l[crow(r, hi)]; }
        bf16x8 pa0, pa1; PK4(p, 0, pa0); PK4(p, 8, pa1);
        SBAR();
        if (more) asm volatile("s_waitcnt vmcnt(8)" ::: "memory"); else asm volatile("s_waitcnt vmcnt(0)" ::: "memory");
        SBAR();
        pv_one32<0>(o[0], vb, pa0, pa1); pv_one32<1>(o[1], vb, pa0, pa1); pv_one32<2>(o[2], vb, pa0, pa1); pv_one32<3>(o[3], vb, pa0, pa1);
        SBAR();
        if (more) SP_DMA_V(tn);
        SBAR();
        ti = tn;
    }
#undef SP_DMA_K
#undef SP_DMA_V
    if (hi == 0) li_l[r32] = l_reg; asm volatile("s_waitcnt lgkmcnt(0)" ::: "memory");
#pragma unroll
    for (int r = 0; r < 16; ++r) { const int qn = crow(r, hi); const float rl = __builtin_amdgcn_rcpf(li_l[qn]); bf16_t* op = pol.optr(qn);
#pragma unroll
        for (int d0 = 0; d0 < 4; ++d0) { if constexpr (F8_OUT) ((unsigned char*)op)[d0 * 32 + r32] = f2fp8(o[d0][r] * rl * O8_SCALE); else op[d0 * 32 + r32] = f2bf(o[d0][r] * rl); } }
}
#undef PK4
}

#define SBAR() __builtin_amdgcn_sched_barrier(0)
namespace d8 {
constexpr int K8_BYTES = 64 * 128, KR8_BYTES = 64 * 64, VT_PITCH = 80, VT_BYTES = 128 * VT_PITCH;
constexpr int OFF_K8 = 0, OFF_KR8 = 2 * K8_BYTES, OFF_VT = OFF_KR8 + 2 * KR8_BYTES, OFF_WS8 = OFF_VT + 2 * VT_BYTES, LDS_D8 = OFF_WS8 + 8 * 64 * 4;
constexpr float THR8 = 4.f;
#define K8SWZ(row, ch) ((row) * 128 + ((((ch) ^ ((row) >> 1)) & 7) << 4))
#define KR8SWZ(row, ch) ((row) * 64 + ((((ch) ^ ((row) >> 2)) & 3) << 4))
__device__ __forceinline__ int krow_of(int a) { const int hi = a >> 5, j = a & 31; return da::crow(j & 15, hi) + 32 * (j >> 4); }
struct D8Args { const bf16_t* Q; const unsigned char* K8; const unsigned char* Kr8; const unsigned char* Vt8; bf16_t* O; int ldq, ldk, ldvt, ldo; int seq; int pos0; };
template <int NKS> struct Cst8 { static constexpr float SCALE = (NKS == 2) ? 0.088388347648318440f : 0.072168783648703220f; static constexpr float C = SCALE * LOG2E; };
#define D8_LD32(dst, p) do { const i32x4 _lo = *(const i32x4*)(p), _hi = *(const i32x4*)((p) + 16); dst = __builtin_shufflevector(_lo, _hi, 0, 1, 2, 3, 4, 5, 6, 7); } while (0)
#define D8_MX(a, b, c) __builtin_amdgcn_mfma_scale_f32_32x32x64_f8f6f4(a, b, c, 0, 0, 0, 0x7f7f7f7f, 0, 0x7f7f7f7f)
template <int NKS>
__device__ __forceinline__ void qkt8(f32x16& p0, f32x16& p1, const char* Ks, const char* Krs, const i32x8* qf, int r32, int hi) {
    p0 = f32x16{}; p1 = f32x16{};
#pragma unroll
    for (int sK = 0; sK < 2; ++sK) { i32x8 a0, a1; const int ch = 4 * sK + 2 * hi;
        { const i32x4 lo = *(const i32x4*)(Ks + K8SWZ(r32, ch)), hh = *(const i32x4*)(Ks + K8SWZ(r32, ch + 1)); a0 = __builtin_shufflevector(lo, hh, 0, 1, 2, 3, 4, 5, 6, 7); }
        { const i32x4 lo = *(const i32x4*)(Ks + K8SWZ(32 + r32, ch)), hh = *(const i32x4*)(Ks + K8SWZ(32 + r32, ch + 1)); a1 = __builtin_shufflevector(lo, hh, 0, 1, 2, 3, 4, 5, 6, 7); }
        p0 = D8_MX(a0, qf[sK], p0); p1 = D8_MX(a1, qf[sK], p1); }
    if constexpr (NKS == 3) { i32x8 a0, a1; const int ch = 2 * hi;
        { const i32x4 lo = *(const i32x4*)(Krs + KR8SWZ(r32, ch)), hh = *(const i32x4*)(Krs + KR8SWZ(r32, ch + 1)); a0 = __builtin_shufflevector(lo, hh, 0, 1, 2, 3, 4, 5, 6, 7); }
        { const i32x4 lo = *(const i32x4*)(Krs + KR8SWZ(32 + r32, ch)), hh = *(const i32x4*)(Krs + KR8SWZ(32 + r32, ch + 1)); a1 = __builtin_shufflevector(lo, hh, 0, 1, 2, 3, 4, 5, 6, 7); }
        p0 = D8_MX(a0, qf[2], p0); p1 = D8_MX(a1, qf[2], p1); }
}
template <int NKS>
__device__ __forceinline__ void partialSM8(f32x16& p0, f32x16& p1, float& m_reg, float& mn, float& alpha) {
    constexpr float C = Cst8<NKS>::C, SCALE = Cst8<NKS>::SCALE;
    float pmax = p0[0];
#pragma unroll
    for (int r = 1; r < 16; ++r) pmax = fmaxf(pmax, p0[r]);
#pragma unroll
    for (int r = 0; r < 16; ++r) pmax = fmaxf(pmax, p1[r]);
    { auto rr = __builtin_amdgcn_permlane32_swap(__float_as_uint(pmax), __float_as_uint(pmax), false, false);
      pmax = fmaxf(__uint_as_float(rr[0]), __uint_as_float(rr[1])); }
    if (__builtin_expect(__all(pmax - m_reg <= THR8 / SCALE), 1)) { mn = m_reg; alpha = 1.f; }
    else { mn = fmaxf(m_reg, pmax); alpha = __builtin_amdgcn_exp2f((m_reg - mn) * C); m_reg = mn; }
    const float mnC = -mn * C;
#pragma unroll
    for (int r = 0; r < 16; ++r) p0[r] = fmaf(p0[r], C, mnC);
#pragma unroll
    for (int r = 0; r < 16; ++r) p1[r] = fmaf(p1[r], C, mnC);
#pragma unroll
    for (int r = 0; r < 16; ++r) p0[r] = __builtin_amdgcn_exp2f(p0[r]);
}
__device__ __forceinline__ void finishSM8(f32x16& p0, f32x16& p1, float alpha, float& l_reg, i32x8& pa) {
#pragma unroll
    for (int r = 0; r < 16; ++r) p1[r] = __builtin_amdgcn_exp2f(p1[r]);
    float ps = 0;
#pragma unroll
    for (int r = 0; r < 16; ++r) ps += p0[r];
#pragma unroll
    for (int r = 0; r < 16; ++r) ps += p1[r];
    { auto rr = __builtin_amdgcn_permlane32_swap(__float_as_uint(ps), __float_as_uint(ps), false, false);
      ps = __uint_as_float(rr[0]) + __uint_as_float(rr[1]); }
    l_reg = l_reg * alpha + ps;
    pa = (i32x8){(int)pk4_fp8(p0[0], p0[1], p0[2], p0[3]), (int)pk4_fp8(p0[4], p0[5], p0[6], p0[7]), (int)pk4_fp8(p0[8], p0[9], p0[10], p0[11]), (int)pk4_fp8(p0[12], p0[13], p0[14], p0[15]),
                 (int)pk4_fp8(p1[0], p1[1], p1[2], p1[3]), (int)pk4_fp8(p1[4], p1[5], p1[6], p1[7]), (int)pk4_fp8(p1[8], p1[9], p1[10], p1[11]), (int)pk4_fp8(p1[12], p1[13], p1[14], p1[15])};
}
__device__ __forceinline__ void pv8(f32x16* o, const char* Vt, const i32x8 pa, int r32, int hi) {
#pragma unroll
    for (int d0 = 0; d0 < 4; ++d0) { const char* vp = Vt + (32 * d0 + r32) * VT_PITCH + 32 * hi; i32x8 bfr;
        { const i32x4 lo = *(const i32x4*)vp, hh = *(const i32x4*)(vp + 16); bfr = __builtin_shufflevector(lo, hh, 0, 1, 2, 3, 4, 5, 6, 7); }
        o[d0] = D8_MX(pa, bfr, o[d0]); }
}
template <int NKS>
__device__ __forceinline__ void attn_dense8_body(int wv, const D8Args a, char* lds) {
    const int tid = fresh_tid(wv), wid = tid >> 6, lane = tid & 63, r32 = lane & 31, hi = lane >> 5;
    char* K_lds = lds + OFF_K8; char* Kr_lds = lds + OFF_KR8; char* Vt_lds = lds + OFF_VT;
    float* ws = (float*)(lds + OFF_WS8) + wid * 64; float* li_l = ws; float* al_l = ws + 32;
    float m_reg = -1e30f, l_reg = 0; f32x16 o[4] = {}; i32x8 qf[NKS];
    { const bf16_t* Qw = a.Q + (long)(wid * 32 + r32) * a.ldq;
#pragma unroll
      for (int sK = 0; sK < 2; ++sK) { const bf16_t* qp = Qw + 64 * sK + 32 * hi; unsigned w[8];
#pragma unroll
          for (int c = 0; c < 4; ++c) { const u32x4 v = *(const u32x4*)(qp + 8 * c);
              w[2 * c] = pk4_fp8(bflo(v.x), bfhi(v.x), bflo(v.y), bfhi(v.y)); w[2 * c + 1] = pk4_fp8(bflo(v.z), bfhi(v.z), bflo(v.w), bfhi(v.w)); }
          qf[sK] = (i32x8){(int)w[0], (int)w[1], (int)w[2], (int)w[3], (int)w[4], (int)w[5], (int)w[6], (int)w[7]}; }
      if constexpr (NKS == 3) {
          const float pos = (float)(a.pos0 + wid * 32 + r32); const bf16_t* qp = Qw + 128; unsigned w[8];
#pragma unroll
          for (int c = 0; c < 4; ++c) { const u32x4 v1 = *(const u32x4*)(qp + 8 * c), v2 = *(const u32x4*)(qp + 32 + 8 * c);
              const unsigned a1[4] = {v1.x, v1.y, v1.z, v1.w}, a2[4] = {v2.x, v2.y, v2.z, v2.w}; float y[8];
#pragma unroll
              for (int e = 0; e < 8; ++e) { const int i = 8 * c + e; float sn, cs; sincos_rev(pos * inv_freq32(i), sn, cs);
                  const float x1 = (e & 1) ? bfhi(a1[e >> 1]) : bflo(a1[e >> 1]), x2 = (e & 1) ? bfhi(a2[e >> 1]) : bflo(a2[e >> 1]);
                  y[e] = hi ? (x2 * cs + x1 * sn) : (x1 * cs - x2 * sn); }
              w[2 * c] = pk4_fp8(y[0], y[1], y[2], y[3]); w[2 * c + 1] = pk4_fp8(y[4], y[5], y[6], y[7]); }
          qf[2] = (i32x8){(int)w[0], (int)w[1], (int)w[2], (int)w[3], (int)w[4], (int)w[5], (int)w[6], (int)w[7]}; } }
    const int ka = tid >> 3, kch = tid & 7, kdst = K8SWZ(krow_of(ka), kch);
    const int vc = tid >> 2, vq = tid & 3, vdst = vc * VT_PITCH + vq * 16;
    const int ra = (tid >> 2) & 63, rch = tid & 3, rdst = KR8SWZ(krow_of(ra), rch);
    struct { u32x4 k, v, r; } sr_[2];
#define SLOAD8(i, k0) do { sr_[i].k = *(const u32x4*)(a.K8 + (long)((k0) + ka) * a.ldk + kch * 16); sr_[i].v = *(const u32x4*)(a.Vt8 + (long)vc * a.ldvt + (k0) + vq * 16); \
    if constexpr (NKS == 3) sr_[i].r = *(const u32x4*)(a.Kr8 + (long)((k0) + ra) * 64 + rch * 16); } while (0)
#define SWRITE8(b, i) do { *(u32x4*)(K_lds + (b) * K8_BYTES + kdst) = sr_[i].k; *(u32x4*)(Vt_lds + (b) * VT_BYTES + vdst) = sr_[i].v; \
    if constexpr (NKS == 3) *(u32x4*)(Kr_lds + (b) * KR8_BYTES + rdst) = sr_[i].r; } while (0)
#define RESC8(al) do { if (__any((al) < 1.f)) { if (hi == 0) al_l[r32] = (al); asm volatile("s_waitcnt lgkmcnt(0)" ::: "memory"); \
    _Pragma("unroll") for (int d = 0; d < 4; ++d) _Pragma("unroll") for (int r = 0; r < 16; ++r) o[d][r] *= al_l[da::crow(r, hi)]; } } while (0)
    f32x16 pA0, pA1, pB0, pB1; float mnA, mnB, alA, alB; i32x8 pa; const int NT = a.seq / 64;
    SLOAD8(0, 0); asm volatile("s_waitcnt vmcnt(0)" ::: "memory"); SWRITE8(0, 0); __syncthreads();
    qkt8<NKS>(pA0, pA1, K_lds, Kr_lds, qf, r32, hi); partialSM8<NKS>(pA0, pA1, m_reg, mnA, alA);
    SLOAD8(1, 64); if (2 < NT) SLOAD8(0, 128);
    if constexpr (NKS == 3) asm volatile("s_waitcnt vmcnt(3)" ::: "memory"); else asm volatile("s_waitcnt vmcnt(2)" ::: "memory");
    SWRITE8(1, 1); __syncthreads();
#pragma unroll 1
    for (int j = 1; j + 1 < NT; j += 2) {
        SBAR(); qkt8<NKS>(pB0, pB1, K_lds + K8_BYTES, Kr_lds + KR8_BYTES, qf, r32, hi);
        finishSM8(pA0, pA1, alA, l_reg, pa); SBAR();
        SLOAD8(1, (j + 2) * 64); SBAR();
        pv8(o, Vt_lds, pa, r32, hi); partialSM8<NKS>(pB0, pB1, m_reg, mnB, alB);
        __syncthreads(); if constexpr (NKS == 3) asm volatile("s_waitcnt vmcnt(3)" ::: "memory"); else asm volatile("s_waitcnt vmcnt(2)" ::: "memory");
        SWRITE8(0, 0);
        RESC8(alB); __syncthreads();
        SBAR(); qkt8<NKS>(pA0, pA1, K_lds, Kr_lds, qf, r32, hi);
        finishSM8(pB0, pB1, alB, l_reg, pa); SBAR();
        if (j + 3 < NT) SLOAD8(0, (j + 3) * 64); SBAR();
        pv8(o, Vt_lds + VT_BYTES, pa, r32, hi); partialSM8<NKS>(pA0, pA1, m_reg, mnA, alA);
        __syncthreads(); if constexpr (NKS == 3) asm volatile("s_waitcnt vmcnt(3)" ::: "memory"); else asm volatile("s_waitcnt vmcnt(2)" ::: "memory");
        SWRITE8(1, 1);
        RESC8(alA); __syncthreads();
    }
    SBAR(); qkt8<NKS>(pB0, pB1, K_lds + K8_BYTES, Kr_lds + KR8_BYTES, qf, r32, hi);
    finishSM8(pA0, pA1, alA, l_reg, pa); SBAR();
    pv8(o, Vt_lds, pa, r32, hi); partialSM8<NKS>(pB0, pB1, m_reg, mnB, alB);
    __syncthreads(); RESC8(alB);
    finishSM8(pB0, pB1, alB, l_reg, pa); SBAR();
    pv8(o, Vt_lds + VT_BYTES, pa, r32, hi);
    if (hi == 0) li_l[r32] = l_reg; asm volatile("s_waitcnt lgkmcnt(0)" ::: "memory");
    float rli[16];
#pragma unroll
    for (int r = 0; r < 16; ++r) rli[r] = __builtin_amdgcn_rcpf(li_l[da::crow(r, hi)]);
    bf16_t* Ow = F8_OUT ? (bf16_t*)((unsigned char*)a.O + (long)(wid * 32) * a.ldo) : a.O + (long)(wid * 32) * a.ldo;
#pragma unroll
    for (int r = 0; r < 16; ++r) { const int orow = da::crow(r, hi);
#pragma unroll
        for (int d0 = 0; d0 < 4; ++d0) { if constexpr (F8_OUT) ((unsigned char*)Ow)[(long)orow * a.ldo + d0 * 32 + r32] = f2fp8(o[d0][r] * rli[r] * O8_SCALE); else Ow[(long)orow * a.ldo + d0 * 32 + r32] = f2bf(o[d0][r] * rli[r]); } }
#undef SLOAD8
#undef SWRITE8
#undef RESC8
}
template <class P>
__device__ __forceinline__ void sparse8_wave(P& pol, LAS unsigned char* wll, int lane) {
    const int r32 = lane & 31, hi = lane >> 5;
    char* wl = (char*)wll; char* Kl = wl; char* Vl = wl + 8192; float* li_l = (float*)(wl + 16384); float* al_l = li_l + 32;
    i32x8 qf[2];
    { const bf16_t* Qw = pol.qptr(r32);
#pragma unroll
      for (int sK = 0; sK < 2; ++sK) { const bf16_t* qp = Qw + 64 * sK + 32 * hi; unsigned w[8];
#pragma unroll
          for (int c = 0; c < 4; ++c) { const u32x4 v = *(const u32x4*)(qp + 8 * c);
              w[2 * c] = pk4_fp8(bflo(v.x), bfhi(v.x), bflo(v.y), bfhi(v.y)); w[2 * c + 1] = pk4_fp8(bflo(v.z), bfhi(v.z), bflo(v.w), bfhi(v.w)); }
          qf[sK] = (i32x8){(int)w[0], (int)w[1], (int)w[2], (int)w[3], (int)w[4], (int)w[5], (int)w[6], (int)w[7]}; } }
    asm volatile("s_waitcnt vmcnt(0)" ::: "memory");
    f32x16 o[4] = {}; float m_reg = -1e30f, l_reg = 0.f;
    int ksrc[8];
#pragma unroll
    for (int i = 0; i < 8; ++i) { const int ri = 8 * i + (lane >> 3), rr = ri & 31, hk = (rr >> 2) & 1, r = (rr & 3) + 4 * (rr >> 3), a = 32 * hk + r + 16 * (ri >> 5);
        ksrc[i] = (a << 8) | ((((lane & 7) ^ (ri >> 1)) & 7) << 4); }
    const int vcol0 = lane >> 2;
    const int nt = pol.ntiles();
    typename P::TI ti, tn;
#define SP8_DMA_K(T) do { _Pragma("unroll") for (int i = 0; i < 8; ++i) { const unsigned char* src = (T).k + (long)(ksrc[i] >> 8) * (T).rs + (ksrc[i] & 255); \
        __builtin_amdgcn_global_load_lds((const unsigned*)src, (LAS unsigned*)(wll + i * 1024), 16, 0, 0); } } while (0)
#define SP8_DMA_V(T) do { _Pragma("unroll") for (int i = 0; i < 8; ++i) { const int c = 16 * i + vcol0; const unsigned char* src = (T).v + (long)c * SEQ + ((((lane & 3) ^ (c >> 2)) & 3) << 4); \
        __builtin_amdgcn_global_load_lds((const unsigned*)src, (LAS unsigned*)(wll + 8192 + i * 1024), 16, 0, 0); } } while (0)
    pol.tile(0, ti);
    SP8_DMA_K(ti); SP8_DMA_V(ti);
#pragma unroll 1
    for (int j = 0; j < nt; ++j) {
        const bool more = (j + 1 < nt);
        if (more) pol.tile(j + 1, tn);
        asm volatile("s_waitcnt vmcnt(8)" ::: "memory");
        f32x16 p0 = f32x16{}, p1 = f32x16{};
#pragma unroll
        for (int sK = 0; sK < 2; ++sK) { i32x8 a0, a1; const int ch = 4 * sK + 2 * hi;
            { const i32x4 lo = *(const i32x4*)(Kl + K8SWZ(r32, ch)), hh = *(const i32x4*)(Kl + K8SWZ(r32, ch + 1)); a0 = __builtin_shufflevector(lo, hh, 0, 1, 2, 3, 4, 5, 6, 7); }
            { const i32x4 lo = *(const i32x4*)(Kl + K8SWZ(32 + r32, ch)), hh = *(const i32x4*)(Kl + K8SWZ(32 + r32, ch + 1)); a1 = __builtin_shufflevector(lo, hh, 0, 1, 2, 3, 4, 5, 6, 7); }
            p0 = D8_MX(a0, qf[sK], p0); p1 = D8_MX(a1, qf[sK], p1); }
        asm volatile("s_waitcnt lgkmcnt(0)" ::: "memory"); SBAR();
        if (more) SP8_DMA_K(tn);
        SBAR();
        float pmax = -INFINITY;
#pragma unroll
        for (int r = 0; r < 16; ++r) { p0[r] = pol.adj(ti, 32 * hi + r, p0[r]); p1[r] = pol.adj(ti, 32 * hi + 16 + r, p1[r]); pmax = fmaxf(pmax, fmaxf(p0[r], p1[r])); }
        { auto rr = __builtin_amdgcn_permlane32_swap(__float_as_uint(pmax), __float_as_uint(pmax), false, false);
          pmax = fmaxf(__uint_as_float(rr[0]), __uint_as_float(rr[1])); }
        const float mn = fmaxf(m_reg, pmax); const float alpha = __builtin_amdgcn_exp2f(m_reg - mn); m_reg = mn;
        float ps = 0.f;
#pragma unroll
        for (int r = 0; r < 16; ++r) { p0[r] = __builtin_amdgcn_exp2f(p0[r] - mn); p1[r] = __builtin_amdgcn_exp2f(p1[r] - mn); ps += p0[r] + p1[r]; }
        { auto rr = __builtin_amdgcn_permlane32_swap(__float_as_uint(ps), __float_as_uint(ps), false, false);
          ps = __uint_as_float(rr[0]) + __uint_as_float(rr[1]); }
        l_reg = l_reg * alpha + ps;
        if (__any(alpha < 1.f)) { if (hi == 0) al_l[r32] = alpha; asm volatile("s_waitcnt lgkmcnt(0)" ::: "memory");
#pragma unroll
            for (int d = 0; d < 4; ++d)
#pragma unroll
                for (int r = 0; r < 16; ++r) o[d][r] *= al_l[da::crow(r, hi)]; }
        const i32x8 pa = (i32x8){(int)pk4_fp8(p0[0], p0[1], p0[2], p0[3]), (int)pk4_fp8(p0[4], p0[5], p0[6], p0[7]), (int)pk4_fp8(p0[8], p0[9], p0[10], p0[11]), (int)pk4_fp8(p0[12], p0[13], p0[14], p0[15]),
                                 (int)pk4_fp8(p1[0], p1[1], p1[2], p1[3]), (int)pk4_fp8(p1[4], p1[5], p1[6], p1[7]), (int)pk4_fp8(p1[8], p1[9], p1[10], p1[11]), (int)pk4_fp8(p1[12], p1[13], p1[14], p1[15])};
        SBAR();
        if (more) asm volatile("s_waitcnt vmcnt(8)" ::: "memory"); else asm volatile("s_waitcnt vmcnt(0)" ::: "memory");
        SBAR();
#pragma unroll
        for (int d0 = 0; d0 < 4; ++d0) { const int c = 32 * d0 + r32; const char* vp = Vl + c * 64; const int sw = (c >> 2) & 3; i32x8 bfr;
            { const i32x4 lo = *(const i32x4*)(vp + (((2 * hi) ^ sw) << 4)), hh = *(const i32x4*)(vp + (((2 * hi + 1) ^ sw) << 4)); bfr = __builtin_shufflevector(lo, hh, 0, 1, 2, 3, 4, 5, 6, 7); }
            o[d0] = D8_MX(pa, bfr, o[d0]); }
        asm volatile("s_waitcnt lgkmcnt(0)" ::: "memory"); SBAR();
        if (more) SP8_DMA_V(tn);
        SBAR();
        ti = tn;
    }
#undef SP8_DMA_K
#undef SP8_DMA_V
    if (hi == 0) li_l[r32] = l_reg; asm volatile("s_waitcnt lgkmcnt(0)" ::: "memory");
#pragma unroll
    for (int r = 0; r < 16; ++r) { const int qn = da::crow(r, hi); const float rl = __builtin_amdgcn_rcpf(li_l[qn]); bf16_t* op = pol.optr(qn);
#pragma unroll
        for (int d0 = 0; d0 < 4; ++d0) { if constexpr (F8_OUT) ((unsigned char*)op)[d0 * 32 + r32] = f2fp8(o[d0][r] * rl * O8_SCALE); else op[d0 * 32 + r32] = f2bf(o[d0][r] * rl); } }
}
#undef D8_LD32
#undef D8_MX
}


struct PolB {
    struct TI { const bf16_t* k; const bf16_t* v; long rs; int kpos0; int iq; float cd; };
    const bf16_t* H0; bf16_t* O; int b, h, a, r16, myn; int lo3, n3, lo2, n2, lo1, n1; float slope2;
    __device__ __forceinline__ void init(const bf16_t* H0_, bf16_t* O_, int w, int lane) {
        H0 = H0_; O = O_; b = w >> 10; h = (w >> 7) & 7; const int wu = w & 127; a = wu >> 4; r16 = wu & 15; myn = lane & 31;
        lo3 = max(a - 2, 0); n3 = min(a + 2, 7) - lo3 + 1;
        lo2 = max(4 * a - 2, 0); n2 = min(4 * a + 5, 31) - lo2 + 1;
        lo1 = max(16 * a - 2, 0); n1 = min(16 * a + 17, 127) - lo1 + 1;
        slope2 = __builtin_amdgcn_exp2f(-(float)(h + 1)) * LOG2E;
    }
    __device__ __forceinline__ const bf16_t* qptr(int n) const { return H0 + (long)(b * SEQ + 512 * a + r16 + 16 * n) * IN0 + 1536 + h * 128; }
    __device__ __forceinline__ bf16_t* optr(int qn) const { const long e = (long)(b * SEQ + 512 * a + r16 + 16 * qn) * DM + 1024 + h * 128; return F8_OUT ? (bf16_t*)((unsigned char*)O + e) : O + e; }
    __device__ __forceinline__ int ntiles() const { return n3 + n2 + n1; }
    __device__ __forceinline__ void tile(int j, TI& ti) const {
        int dil, kt, rd;
        if (j < n3) { dil = 16; kt = lo3 + j; rd = r16; }
        else if (j < n3 + n2) { dil = 4; kt = lo2 + (j - n3); rd = r16 & 3; }
        else { dil = 1; kt = lo1 + (j - n3 - n2); rd = 0; }
        const long tok = (long)b * SEQ + dil * 32 * kt + rd;
        ti.k = H0 + tok * IN0 + 2560 + h * 128; ti.v = H0 + tok * IN0 + 3584 + h * 128; ti.rs = (long)dil * IN0;
        ti.kpos0 = 32 * kt; ti.iq = (512 * a + r16 + 16 * myn - rd) / dil; ti.cd = slope2 * (float)dil;
    }
    __device__ __forceinline__ float adj(const TI& ti, int kloc, float s) const {
        const int d = ti.kpos0 + kloc - ti.iq; const int ad = d < 0 ? -d : d;
        return ad <= 64 ? fmaf(s, 0.088388347648318440f * LOG2E, -ti.cd * (float)ad) : -INFINITY;
    }
};
struct PolC {
    struct TI { const bf16_t* k; const bf16_t* v; long rs; int kc0; int drow; };
    const bf16_t* H1; bf16_t* O; const float* tab; int b, h, r, a, r0, qc, c0;
    __device__ __forceinline__ void init(const bf16_t* H1_, bf16_t* O_, const float* rpb, float* tab_, int w, int lane) {
        H1 = H1_; O = O_; tab = tab_; b = w >> 10; h = (w >> 7) & 7; const int wu = w & 127; r = wu >> 1; a = wu & 1;
        r0 = min(max(r - 4, 0), 56); qc = 32 * a + (lane & 31); c0 = min(max(qc - 8, 0), 48);
        for (int idx = lane; idx < 480; idx += 64) { const int dr = idx >> 5, dc = idx & 31; tab_[idx] = dc < 31 ? rpb[h * 465 + dr * 31 + dc] * LOG2E : 0.f; }
        asm volatile("s_waitcnt vmcnt(0) lgkmcnt(0)" ::: "memory");
    }
    __device__ __forceinline__ const bf16_t* qptr(int n) const { return H1 + (long)(b * SEQ + 64 * r + 32 * a + n) * IN1P + h * 128; }
    __device__ __forceinline__ bf16_t* optr(int qn) const { const long e = (long)(b * SEQ + 64 * r + 32 * a + qn) * DM + h * 128; return F8_OUT ? (bf16_t*)((unsigned char*)O + e) : O + e; }
    __device__ __forceinline__ int ntiles() const { return 16; }
    __device__ __forceinline__ void tile(int j, TI& ti) const {
        const int kr = r0 + (j >> 1), ch = j & 1; const long tok = (long)b * SEQ + 64 * kr + 32 * ch;
        ti.k = H1 + tok * IN1P + 1024 + h * 128; ti.v = H1 + tok * IN1P + 2048 + h * 128; ti.rs = IN1P; ti.kc0 = 32 * ch; ti.drow = kr - r + 7;
    }
    __device__ __forceinline__ float adj(const TI& ti, int kloc, float s) const {
        const int kc = ti.kc0 + kloc; const int dc = min(max(kc - qc + 15, 0), 30);
        const float bias = tab[ti.drow * 32 + dc];
        return (kc >= c0 && kc < c0 + 16) ? fmaf(s, 0.088388347648318440f * LOG2E, bias) : -INFINITY;
    }
};

struct PolB8 {
    struct TI { const unsigned char* k; const unsigned char* v; long rs; int kpos0; int iq; float cd; };
    const bf16_t* H0; bf16_t* O; const unsigned char* K8; const unsigned char* Vt1; const unsigned char* Vt4; const unsigned char* Vt16;
    int b, h, a, r16, myn; int lo3, n3, lo2, n2, lo1, n1; float slope2;
    __device__ __forceinline__ void init(const bf16_t* H0_, bf16_t* O_, const unsigned char* K8_, const unsigned char* Vt1_, const unsigned char* Vt4_, const unsigned char* Vt16_, int w, int lane) {
        H0 = H0_; O = O_; K8 = K8_; Vt1 = Vt1_; Vt4 = Vt4_; Vt16 = Vt16_; b = w >> 10; h = (w >> 7) & 7; const int wu = w & 127; a = wu >> 4; r16 = wu & 15; myn = lane & 31;
        const int t = a >> 1; lo3 = max(t - 1, 0); n3 = min(t + 1, 3) - lo3 + 1;
        lo2 = max(2 * a - 1, 0); n2 = min(2 * a + 2, 15) - lo2 + 1;
        lo1 = max(8 * a - 1, 0); n1 = min(8 * a + 8, 63) - lo1 + 1;
        slope2 = __builtin_amdgcn_exp2f(-(float)(h + 1)) * LOG2E;
    }
    __device__ __forceinline__ const bf16_t* qptr(int n) const { return H0 + (long)(b * SEQ + 512 * a + r16 + 16 * n) * IN0 + 1536 + h * 128; }
    __device__ __forceinline__ bf16_t* optr(int qn) const { const long e = (long)(b * SEQ + 512 * a + r16 + 16 * qn) * DM + 1024 + h * 128; return F8_OUT ? (bf16_t*)((unsigned char*)O + e) : O + e; }
    __device__ __forceinline__ int ntiles() const { return n3 + n2 + n1; }
    __device__ __forceinline__ void tile(int j, TI& ti) const {
        int dil, kt, rd; const unsigned char* vt; int voff;
        if (j < n3) { dil = 16; kt = lo3 + j; rd = r16; vt = Vt16; voff = r16 * 256 + 64 * kt; }
        else if (j < n3 + n2) { dil = 4; kt = lo2 + (j - n3); rd = r16 & 3; vt = Vt4; voff = rd * 1024 + 64 * kt; }
        else { dil = 1; kt = lo1 + (j - n3 - n2); rd = 0; vt = Vt1; voff = 64 * kt; }
        const long tok = (long)b * SEQ + dil * 64 * kt + rd;
        ti.k = K8 + tok * 1024 + h * 128; ti.rs = (long)dil * 1024; ti.v = vt + (long)(b * 8 + h) * 128 * SEQ + voff;
        ti.kpos0 = 64 * kt; ti.iq = (512 * a + r16 + 16 * myn - rd) / dil; ti.cd = slope2 * (float)dil;
    }
    __device__ __forceinline__ float adj(const TI& ti, int kidx, float s) const {
        const int d = ti.kpos0 + kidx - ti.iq; const int ad = d < 0 ? -d : d;
        return ad <= 64 ? fmaf(s, 0.088388347648318440f * LOG2E, -ti.cd * (float)ad) : -INFINITY;
    }
};
struct PolC8 {
    struct TI { const unsigned char* k; const unsigned char* v; long rs; int drow; };
    const bf16_t* H1; bf16_t* O; const unsigned char* K8; const unsigned char* Vt; const float* tab; int b, h, r, a, r0, qc, c0;
    __device__ __forceinline__ void init(const bf16_t* H1_, bf16_t* O_, const unsigned char* K8_, const unsigned char* Vt_, const float* rpb, float* tab_, int w, int lane) {
        H1 = H1_; O = O_; K8 = K8_; Vt = Vt_; tab = tab_; b = w >> 10; h = (w >> 7) & 7; const int wu = w & 127; r = wu >> 1; a = wu & 1;
        r0 = min(max(r - 4, 0), 56); qc = 32 * a + (lane & 31); c0 = min(max(qc - 8, 0), 48);
        for (int idx = lane; idx < 480; idx += 64) { const int dr = idx >> 5, dc = idx & 31; tab_[idx] = dc < 31 ? rpb[h * 465 + dr * 31 + dc] * LOG2E : 0.f; }
        asm volatile("s_waitcnt vmcnt(0) lgkmcnt(0)" ::: "memory");
    }
    __device__ __forceinline__ const bf16_t* qptr(int n) const { return H1 + (long)(b * SEQ + 64 * r + 32 * a + n) * IN1P + h * 128; }
    __device__ __forceinline__ bf16_t* optr(int qn) const { const long e = (long)(b * SEQ + 64 * r + 32 * a + qn) * DM + h * 128; return F8_OUT ? (bf16_t*)((unsigned char*)O + e) : O + e; }
    __device__ __forceinline__ int ntiles() const { return 8; }
    __device__ __forceinline__ void tile(int j, TI& ti) const {
        const int kr = r0 + j; const long tok = (long)b * SEQ + 64 * kr;
        ti.k = K8 + tok * 1024 + h * 128; ti.rs = 1024; ti.v = Vt + (long)(b * 8 + h) * 128 * SEQ + 64 * kr; ti.drow = kr - r + 7;
    }
    __device__ __forceinline__ float adj(const TI& ti, int kc, float s) const {
        const int dc = min(max(kc - qc + 15, 0), 30);
        const float bias = tab[ti.drow * 32 + dc];
        return (kc >= c0 && kc < c0 + 16) ? fmaf(s, 0.088388347648318440f * LOG2E, bias) : -INFINITY;
    }
};

struct Params { const float* in[28]; float* out; unsigned char* ws; int ph_lo, ph_hi; };
enum { I_X = 0, I_RW = 1, I_RB = 2, I_WIN0 = 3, I_AQN = 4, I_AKN = 5, I_WOUT0 = 6, I_LN1G0 = 7, I_LN1B0 = 8, I_WG0 = 9, I_WU0 = 10, I_WD0 = 11, I_LN2G0 = 12, I_LN2B0 = 13,
       I_WIN1 = 14, I_RPB = 15, I_DQN = 16, I_WQUP = 17, I_DKVN = 18, I_WKVUP = 19, I_WOUT1 = 20, I_LN1G1 = 21, I_LN1B1 = 22, I_WG1 = 23, I_WU1 = 24, I_WD1 = 25, I_LN2G1 = 26, I_LN2B1 = 27 };

__device__ __forceinline__ void tr_tile(const float* __restrict__ src, int N, const float* __restrict__ ksc, bf16_t* __restrict__ dst, int ldd, int k0, int n0, int drow0, LAS unsigned* tl, int tid) {
    const int c4 = (tid & 15) * 4;
#pragma unroll
    for (int i = 0; i < 2; ++i) {
        const int kp = (tid >> 4) + 32 * i;
        const float* s0 = src + (size_t)(k0 + 2 * kp) * N + n0 + c4;
        f32x4 a = *(const f32x4*)s0, b = *(const f32x4*)(s0 + N);
        if (ksc) { const float sa = ksc[k0 + 2 * kp], sb = ksc[k0 + 2 * kp + 1]; a *= sa; b *= sb; }
#pragma unroll
        for (int j = 0; j < 4; ++j) tl[(c4 + j) * 65 + kp] = cvtpk(a[j], b[j]);
    }
    __syncthreads();
    const int n = tid >> 3, seg = tid & 7;
    unsigned w[8];
#pragma unroll
    for (int q = 0; q < 8; ++q) w[q] = tl[n * 65 + seg * 8 + q];
    u32x4* d = (u32x4*)(dst + (size_t)(drow0 + n) * ldd + k0 + seg * 16);
    d[0] = (u32x4){w[0], w[1], w[2], w[3]}; d[1] = (u32x4){w[4], w[5], w[6], w[7]};
    __syncthreads();
}
__device__ __forceinline__ void tr_tile8(const float* __restrict__ src, int N, const float* __restrict__ ksc, float wscale, unsigned char* __restrict__ dst, int ldd, int k0, int n0, int drow0, LAS unsigned* tl, int tid) {
    const int c4 = (tid & 15) * 4, kq = tid >> 4;
    const float* s0 = src + (size_t)(k0 + 4 * kq) * N + n0 + c4;
    f32x4 a = *(const f32x4*)s0, b = *(const f32x4*)(s0 + N), c = *(const f32x4*)(s0 + 2 * (size_t)N), d = *(const f32x4*)(s0 + 3 * (size_t)N);
    float sa = wscale, sb = wscale, sc = wscale, sd = wscale;
    if (ksc) { sa *= ksc[k0 + 4 * kq]; sb *= ksc[k0 + 4 * kq + 1]; sc *= ksc[k0 + 4 * kq + 2]; sd *= ksc[k0 + 4 * kq + 3]; }
#pragma unroll
    for (int j = 0; j < 4; ++j) tl[(c4 + j) * 33 + kq] = pk4_fp8(a[j] * sa, b[j] * sb, c[j] * sc, d[j] * sd);
    __syncthreads();
    const int n = tid >> 3, seg = tid & 7;
    unsigned w[4];
#pragma unroll
    for (int q = 0; q < 4; ++q) w[q] = tl[n * 33 + seg * 4 + q];
    *(u32x4*)(dst + (size_t)(drow0 + n) * ldd + k0 + seg * 16) = (u32x4){w[0], w[1], w[2], w[3]};
    __syncthreads();
}
struct TJob { const float* src; bf16_t* dst; const float* ksc; int K, N, ldd, gu; size_t sbs, dbs; int f8; };
constexpr float W8_SCALE = 64.f;
constexpr int W8_SBYTE = 0x79797979;
__device__ __forceinline__ void run_tjob(const TJob& jb, int t, LAS unsigned* tl, int tid) {
    const int ntn = jb.N / 64, ntk = jb.K / 128, per = ntn * ntk;
    const int bi = t / per, r = t % per, tk = r / ntn, tn = r % ntn;
    const int n0 = tn * 64;
    const int drow0 = jb.gu ? (256 * (n0 >> 7) + (jb.gu == 2 ? 128 : 0) + (n0 & 127)) : n0;
    if (jb.f8) tr_tile8(jb.src + (size_t)bi * jb.sbs, jb.N, jb.ksc, W8_SCALE, (unsigned char*)jb.dst + (size_t)bi * jb.dbs, jb.ldd, tk * 128, n0, drow0, tl, tid);
    else tr_tile(jb.src + (size_t)bi * jb.sbs, jb.N, jb.ksc, jb.dst + (size_t)bi * jb.dbs, jb.ldd, tk * 128, n0, drow0, tl, tid);
}
typedef __attribute__((address_space(4))) const unsigned long long kcu64_t;
#define PIN(i) ((const float*)(__attribute__((address_space(1))) const float*)ka[i])
__device__ __forceinline__ void phase_prologue(kcu64_t* ka, unsigned char* ws, LAS unsigned char* lds, int G, int bid, int tid) {
    LAS unsigned* tl = (LAS unsigned*)lds;
    constexpr int NJ = 12;
    const int cnts[NJ] = {16 * 72, 16 * 32, 4096, 4096, 4096, 16 * 61, 16 * 32, 4096, 4096, 4096, 4 * 24, 2 * 32};
    int total = 0;
#pragma unroll
    for (int j = 0; j < NJ; ++j) total += cnts[j];
    for (int t = bid; t < total; t += G) {
        int j = 0, base = 0;
#pragma unroll
        for (int q = 0; q < NJ - 1; ++q) if (t >= base + cnts[q] && j == q) { base += cnts[q]; j = q + 1; }
        const int tt = t - base;
        TJob jb;
        switch (j) {
            case 0: jb = TJob{PIN(I_WIN0), (bf16_t*)(ws + WS_WIN0), nullptr, 2048, IN0, 2048, 0, 0, 0, F8_IN}; break;
            case 1: jb = TJob{PIN(I_WOUT0), (bf16_t*)(ws + WS_WOUT0), nullptr, 2048, 2048, 2048, 0, 0, 0, F8_OUT}; break;
            case 2: jb = TJob{PIN(I_WG0), (bf16_t*)(ws + WS_WGU0), nullptr, 2048, 512, 2048, 1, (size_t)2048 * 512, (size_t)1024 * 2048, F8_GU}; break;
            case 3: jb = TJob{PIN(I_WU0), (bf16_t*)(ws + WS_WGU0), nullptr, 2048, 512, 2048, 2, (size_t)2048 * 512, (size_t)1024 * 2048, F8_GU}; break;
            case 4: jb = TJob{PIN(I_WD0), (bf16_t*)(ws + WS_WD0), nullptr, 512, 2048, 512, 0, (size_t)512 * 2048, (size_t)2048 * 512, F8_DOWN}; break;
            case 5: jb = TJob{PIN(I_WIN1), (bf16_t*)(ws + WS_WIN1), nullptr, 2048, IN1, 2048, 0, 0, 0, F8_IN}; break;
            case 6: jb = TJob{PIN(I_WOUT1), (bf16_t*)(ws + WS_WOUT1), nullptr, 2048, 2048, 2048, 0, 0, 0, F8_OUT}; break;
            case 7: jb = TJob{PIN(I_WG1), (bf16_t*)(ws + WS_WGU1), nullptr, 2048, 512, 2048, 1, (size_t)2048 * 512, (size_t)1024 * 2048, F8_GU}; break;
            case 8: jb = TJob{PIN(I_WU1), (bf16_t*)(ws + WS_WGU1), nullptr, 2048, 512, 2048, 2, (size_t)2048 * 512, (size_t)1024 * 2048, F8_GU}; break;
            case 9: jb = TJob{PIN(I_WD1), (bf16_t*)(ws + WS_WD1), nullptr, 512, 2048, 512, 0, (size_t)512 * 2048, (size_t)2048 * 512, F8_DOWN}; break;
            case 10: jb = TJob{PIN(I_WQUP), (bf16_t*)(ws + WS_WQUP), PIN(I_DQN), 512, 1536, 512, 0, 0, 0, 0}; break;
            default: jb = TJob{PIN(I_WKVUP), (bf16_t*)(ws + WS_WKVUP), PIN(I_DKVN), 256, 2048, 256, 0, 0, 0, 0}; break;
        }
        run_tjob(jb, tt, tl, tid);
    }
    { constexpr size_t ESZ = F8_IN ? 1 : 2;
      u32x4* z = (u32x4*)(ws + WS_WIN1 + (size_t)IN1 * 2048 * ESZ); const size_t n16 = (size_t)(IN1P - IN1) * 2048 * ESZ / 16;
      const unsigned zu = __float_as_uint(fresh_zero());
      for (size_t i = (size_t)bid * NTHR + tid; i < n16; i += (size_t)G * NTHR) z[i] = (u32x4){zu, zu, zu, zu}; }
    { const f32x8* xs = (const f32x8*)PIN(I_X); const size_t n8 = (size_t)T_ * DM / 8;
      if constexpr (F8_IN) { u32x2* xd = (u32x2*)(ws + WS_RC + 64 * MiB);
          for (size_t i = (size_t)bid * NTHR + tid; i < n8; i += (size_t)G * NTHR) { const f32x8 v = xs[i]; xd[i] = (u32x2){pk4_fp8(v[0], v[1], v[2], v[3]), pk4_fp8(v[4], v[5], v[6], v[7])}; } }
      else { u32x4* xd = (u32x4*)(ws + WS_RA);
          for (size_t i = (size_t)bid * NTHR + tid; i < n8; i += (size_t)G * NTHR) { const f32x8 v = xs[i];
              xd[i] = (u32x4){cvtpk(v[0], v[1]), cvtpk(v[2], v[3]), cvtpk(v[4], v[5]), cvtpk(v[6], v[7])}; } } }
}

__device__ __forceinline__ void phase_prep_qk(bf16_t* H0, const float* qn, const float* kn, unsigned char* K8, int G, int bid, int tid) {
    const int wid = __builtin_amdgcn_readfirstlane(tid >> 6), lane = tid & 63, i = lane & 31, half = lane >> 5;
    const float invf = inv_freq32(i);
    const int e0 = 64 * half + i, e1 = e0 + 32;
    const float gq0 = qn[e0], gq1 = qn[e1], gk0 = kn[e0], gk1 = kn[e1];
    for (int m = bid * 8 + wid; m < T_; m += G * 8) {
        const int s = m & (SEQ - 1); const int pos = half ? (s & 63) : (s >> 6);
        float sn, cs; sincos_rev((float)pos * invf, sn, cs);
        bf16_t* rowp = H0 + (size_t)m * IN0;
#pragma unroll
        for (int hh = 0; hh < 10; ++hh) {
            bf16_t* base = rowp + (hh < 8 ? hh * 128 : 1024 + (hh - 8) * 128);
            const float x0 = bf2f(base[e0]), x1 = bf2f(base[e1]);
            const float ss = wave_sum(x0 * x0 + x1 * x1);
            const float r = rsqrtf(ss * (1.0f / 128.0f) + 1e-6f);
            const float y0 = x0 * r * (hh < 8 ? gq0 : gk0), y1 = x1 * r * (hh < 8 ? gq1 : gk1);
            const float o0 = y0 * cs - y1 * sn, o1 = y1 * cs + y0 * sn;
            base[e0] = f2bf(o0); base[e1] = f2bf(o1);
            if (F8_ATTA && hh >= 8) { unsigned char* kp = K8 + (size_t)m * 256 + (hh - 8) * 128; kp[e0] = f2fp8(o0); kp[e1] = f2fp8(o1); }
        }
    }
}
__device__ __forceinline__ void phase_vt8(const bf16_t* H0, unsigned char* Vt8, LAS unsigned char* lds, int G, int bid, int tid) {
    const int t = tid >> 3, seg = tid & 7, c = tid >> 2, part = tid & 3;
    for (int u = bid; u < 1024; u += G) {
        const int b = u >> 7, kvh = (u >> 6) & 1, ch = u & 63;
        const bf16_t* src = H0 + (size_t)(b * SEQ + ch * 64 + t) * IN0 + 1280 + kvh * 128 + seg * 16;
        const u32x4 v0 = *(const u32x4*)src, v1 = *(const u32x4*)(src + 8);
        const unsigned w[8] = {v0.x, v0.y, v0.z, v0.w, v1.x, v1.y, v1.z, v1.w};
        __syncthreads();
#pragma unroll
        for (int j = 0; j < 8; ++j) { lds[(16 * seg + 2 * j) * 80 + t] = f2fp8(bflo(w[j])); lds[(16 * seg + 2 * j + 1) * 80 + t] = f2fp8(bfhi(w[j])); }
        __syncthreads();
        const u32x4 o = *(const LAS u32x4*)(lds + c * 80 + part * 16);
        *(u32x4*)(Vt8 + ((size_t)(b * 2 + kvh) * 128 + c) * SEQ + ch * 64 + part * 16) = o;
    }
    __syncthreads();
}
__device__ __forceinline__ void phase_k8_copy(const bf16_t* H, int ldh, int col0, unsigned char* K8, int G, int bid, int tid) {
    for (size_t i = (size_t)bid * NTHR + tid; i < (size_t)T_ * 128; i += (size_t)G * NTHR) { const size_t m = i >> 7; const int c = (int)(i & 127) * 8;
        const u32x4 v = *(const u32x4*)(H + m * ldh + col0 + c);
        *(u32x2*)(K8 + m * 1024 + c) = (u32x2){pk4_fp8(bflo(v.x), bfhi(v.x), bflo(v.y), bfhi(v.y)), pk4_fp8(bflo(v.z), bfhi(v.z), bflo(v.w), bfhi(v.w))}; }
}
__device__ __forceinline__ void tr4x4(unsigned w0, unsigned w1, unsigned w2, unsigned w3, unsigned (&o)[4]) {
    const unsigned a_lo = __builtin_amdgcn_perm(w1, w0, 0x05010400u), a_hi = __builtin_amdgcn_perm(w1, w0, 0x07030602u);
    const unsigned b_lo = __builtin_amdgcn_perm(w3, w2, 0x05010400u), b_hi = __builtin_amdgcn_perm(w3, w2, 0x07030602u);
    o[0] = __builtin_amdgcn_perm(b_lo, a_lo, 0x05040100u); o[1] = __builtin_amdgcn_perm(b_lo, a_lo, 0x07060302u);
    o[2] = __builtin_amdgcn_perm(b_hi, a_hi, 0x05040100u); o[3] = __builtin_amdgcn_perm(b_hi, a_hi, 0x07060302u);
}
template <bool DIL>
__device__ __forceinline__ void phase_vt_heads(const unsigned char* V8, unsigned char* Vt1, unsigned char* Vt4, unsigned char* Vt16, LAS unsigned char* lds, int G, int bid, int tid) {
    constexpr int PITCH = 272, IMG = 128 * PITCH;
    const int cb = tid & 31, tq = tid >> 5;
    for (int u = bid; u < 1024; u += G) {
        const int b = u >> 7, h = (u >> 4) & 7, ch = u & 15;
        const unsigned char* src = V8 + (size_t)(b * SEQ + 256 * ch) * 1024 + h * 128 + 4 * cb;
        __syncthreads();
#pragma unroll
        for (int k = 0; k < 4; ++k) { const int tg = tq + 16 * k;
            unsigned o[4];
            { const int t0 = 4 * tg;
              tr4x4(*(const unsigned*)(src + (size_t)(t0 + 0) * 1024), *(const unsigned*)(src + (size_t)(t0 + 1) * 1024), *(const unsigned*)(src + (size_t)(t0 + 2) * 1024), *(const unsigned*)(src + (size_t)(t0 + 3) * 1024), o);
#pragma unroll
              for (int j = 0; j < 4; ++j) *(LAS unsigned*)(lds + (4 * cb + j) * PITCH + 4 * tg) = o[j]; }
            if constexpr (DIL) {
                { const int r = tg & 3, g = tg >> 2; const int t0 = r + 16 * g;
                  tr4x4(*(const unsigned*)(src + (size_t)(t0 + 0) * 1024), *(const unsigned*)(src + (size_t)(t0 + 4) * 1024), *(const unsigned*)(src + (size_t)(t0 + 8) * 1024), *(const unsigned*)(src + (size_t)(t0 + 12) * 1024), o);
#pragma unroll
                  for (int j = 0; j < 4; ++j) *(LAS unsigned*)(lds + IMG + (4 * cb + j) * PITCH + r * 64 + 4 * g) = o[j]; }
                { const int cls = tg & 15, g = tg >> 4; const int t0 = cls + 64 * g;
                  tr4x4(*(const unsigned*)(src + (size_t)(t0 + 0) * 1024), *(const unsigned*)(src + (size_t)(t0 + 16) * 1024), *(const unsigned*)(src + (size_t)(t0 + 32) * 1024), *(const unsigned*)(src + (size_t)(t0 + 48) * 1024), o);
#pragma unroll
                  for (int j = 0; j < 4; ++j) *(LAS unsigned*)(lds + 2 * IMG + (4 * cb + j) * PITCH + cls * 16 + 4 * g) = o[j]; }
            }
        }
        __syncthreads();
        const size_t cbase = (size_t)(b * 8 + h) * 128;
#pragma unroll
        for (int k = 0; k < 4; ++k) { const int id = tid + NTHR * k, col = id >> 4, pc = id & 15;
            *(u32x4*)(Vt1 + (cbase + col) * SEQ + 256 * ch + pc * 16) = *(const LAS u32x4*)(lds + col * PITCH + pc * 16);
            if constexpr (DIL) {
                *(u32x4*)(Vt4 + (cbase + col) * SEQ + (pc >> 2) * 1024 + 64 * ch + (pc & 3) * 16) = *(const LAS u32x4*)(lds + IMG + col * PITCH + pc * 16);
                *(u32x4*)(Vt16 + (cbase + col) * SEQ + pc * 256 + 16 * ch) = *(const LAS u32x4*)(lds + 2 * IMG + col * PITCH + pc * 16); } }
    }
    __syncthreads();
}
__device__ __forceinline__ void phase_prep_mla(bf16_t* H1, bf16_t* krope, unsigned char* kr8, int G, int bid, int tid) {
    const int wid = __builtin_amdgcn_readfirstlane(tid >> 6), lane = tid & 63;
    const float invf = inv_freq32(lane & 31);
    for (int m = bid * 8 + wid; m < T_; m += G * 8) {
        bf16_t* rowp = H1 + (size_t)m * IN1P;
        const u32x4 a = *(const u32x4*)(rowp + 3072 + lane * 8);
        float ss = bflo(a.x) * bflo(a.x) + bfhi(a.x) * bfhi(a.x) + bflo(a.y) * bflo(a.y) + bfhi(a.y) * bfhi(a.y) + bflo(a.z) * bflo(a.z) + bfhi(a.z) * bfhi(a.z) + bflo(a.w) * bflo(a.w) + bfhi(a.w) * bfhi(a.w);
        ss = wave_sum(ss);
        const u32x2 c = *(const u32x2*)(rowp + 3584 + lane * 4);
        float s2 = bflo(c.x) * bflo(c.x) + bfhi(c.x) * bfhi(c.x) + bflo(c.y) * bflo(c.y) + bfhi(c.y) * bfhi(c.y);
        s2 = wave_sum(s2);
        const float rq = rsqrtf(ss * (1.0f / 512.0f) + 1e-6f), rkv = rsqrtf(s2 * (1.0f / 256.0f) + 1e-6f);
        *(u32x4*)(rowp + 3072 + lane * 8) = (u32x4){cvtpk(bflo(a.x) * rq, bfhi(a.x) * rq), cvtpk(bflo(a.y) * rq, bfhi(a.y) * rq), cvtpk(bflo(a.z) * rq, bfhi(a.z) * rq), cvtpk(bflo(a.w) * rq, bfhi(a.w) * rq)};
        *(u32x2*)(rowp + 3584 + lane * 4) = (u32x2){cvtpk(bflo(c.x) * rkv, bfhi(c.x) * rkv), cvtpk(bflo(c.y) * rkv, bfhi(c.y) * rkv)};
        if (lane < 32) { const float x1 = bf2f(rowp[3840 + lane]), x2 = bf2f(rowp[3840 + 32 + lane]);
            float sn, cs; sincos_rev((float)(m & (SEQ - 1)) * invf, sn, cs);
            const float o1 = x1 * cs - x2 * sn, o2 = x2 * cs + x1 * sn;
            krope[(size_t)m * 64 + lane] = f2bf(o1); krope[(size_t)m * 64 + 32 + lane] = f2bf(o2);
            if (F8_ATTD) { kr8[(size_t)m * 64 + lane] = f2fp8(o1); kr8[(size_t)m * 64 + 32 + lane] = f2fp8(o2); } }
    }
}

constexpr int LNR_PITCH = 2052;
constexpr int LNR_PART = 131584, LNR_SC = 147968, LNR_SEL = 150016, LNR_BLE = 152064, LNR_HIST = 153088;
template <bool RES_F32>
__device__ __forceinline__ void phase_ln_router(const bf16_t* mix, const void* res, const float* g, const float* bb, const float* rw, const float* rb, bf16_t* x1b, unsigned char* x1q,
                                                int* tok_e, int* tok_p, float* tok_g, int* list, unsigned* cnt, LAS unsigned char* lds, int G, int bid, int tid, bool commit = true) {
    const int wid = __builtin_amdgcn_readfirstlane(tid >> 6), lane = tid & 63;
    float ALPHA = 1.4142135623730951f; asm volatile("" : "+v"(ALPHA));
    LAS float* xs = (LAS float*)lds; LAS float* part = (LAS float*)(lds + LNR_PART); LAS float* scs = (LAS float*)(lds + LNR_SC); LAS float* sels = (LAS float*)(lds + LNR_SEL);
    LAS int* ble = (LAS int*)(lds + LNR_BLE); LAS int* hist = (LAS int*)(lds + LNR_HIST);
    f16x8 bw[8][2];
    { const float* rwp = rw + (size_t)(256 * wid + 8 * (lane >> 4)) * 32 + (lane & 15);
#pragma unroll
      for (int ks = 0; ks < 8; ++ks)
#pragma unroll
        for (int hf = 0; hf < 2; ++hf)
#pragma unroll
          for (int j = 0; j < 8; ++j) bw[ks][hf][j] = (_Float16)rwp[(32 * ks + j) * 32 + 16 * hf]; }
    typedef typename std::conditional<RES_F32, f32x4, u32x2>::type res_t;
    u32x2 mv[2][8]; res_t rv[2][8];
#define LNR_LOAD(tix_, rr) do { const size_t eo = ((size_t)(tix_) * 16 + 2 * wid + (rr)) * DM + 4 * lane; \
        _Pragma("unroll") for (int i = 0; i < 8; ++i) { mv[rr][i] = *(const u32x2*)(mix + eo + 256 * i); \
            if constexpr (RES_F32) rv[rr][i] = *(const res_t*)((const float*)res + eo + 256 * i); else rv[rr][i] = *(const res_t*)((const bf16_t*)res + eo + 256 * i); } } while (0)
    const int ntile = T_ / 16;
    int ntl = 0;
    if (bid < ntile) LNR_LOAD(bid, 0);
    const int lane0 = lane;
    for (int it = 0; bid + G * it < ntile; ++it) {
        const int tix = bid + G * it;
        int lane = lane0; asm volatile("" : "+v"(lane));
#pragma unroll
        for (int rr = 0; rr < 2; ++rr) {
            const int row = 2 * wid + rr; const size_t m = (size_t)tix * 16 + row;
            f32x4 zr[8]; float s = 0.f;
#pragma unroll
            for (int i = 0; i < 8; ++i) { const f32x4 mx = {bflo(mv[rr][i].x), bfhi(mv[rr][i].x), bflo(mv[rr][i].y), bfhi(mv[rr][i].y)}; f32x4 rx;
                if constexpr (RES_F32) rx = rv[rr][i]; else { const u32x2 rb2 = rv[rr][i]; rx = (f32x4){bflo(rb2.x), bfhi(rb2.x), bflo(rb2.y), bfhi(rb2.y)}; }
                zr[i] = ALPHA * rx + mx; s += (zr[i][0] + zr[i][1]) + (zr[i][2] + zr[i][3]); }
            if (rr == 0) { __builtin_amdgcn_sched_barrier(0); LNR_LOAD(tix, 1); __builtin_amdgcn_sched_barrier(0); }
            const float mean = wave_sum(s) * (1.0f / DM); float q = 0.f;
#pragma unroll
            for (int i = 0; i < 8; ++i) { const f32x4 d = zr[i] - mean; q += (d[0] * d[0] + d[1] * d[1]) + (d[2] * d[2] + d[3] * d[3]); }
            const float rstd = rsqrtf(wave_sum(q) * (1.0f / DM) + 1e-5f);
#pragma unroll
            for (int i = 0; i < 8; ++i) { const int col = 4 * lane + 256 * i; const f32x4 gv = *(const f32x4*)(g + col), bv = *(const f32x4*)(bb + col);
                const f32x4 y = (zr[i] - mean) * rstd * gv + bv;
                LAS f32x2* xp = (LAS f32x2*)(xs + row * LNR_PITCH + col); xp[0] = (f32x2){y[0], y[1]}; xp[1] = (f32x2){y[2], y[3]};
                *(u32x2*)(x1b + m * DM + col) = (u32x2){cvtpk(y[0], y[1]), cvtpk(y[2], y[3])};
                if constexpr (F8_GU) *(unsigned*)(x1q + m * DM + col) = pk4_fp8(y[0], y[1], y[2], y[3]);
                if (i & 1) asm volatile("" ::: "memory"); }
        }
        __builtin_amdgcn_sched_barrier(0);
        if (tix + G < ntile) LNR_LOAD(tix + G, 0);
        __builtin_amdgcn_sched_barrier(0);
        __syncthreads();
        { f32x4 acc0 = {0.f, 0.f, 0.f, 0.f}, acc1 = {0.f, 0.f, 0.f, 0.f}; const LAS float* xa = xs + (lane & 15) * LNR_PITCH + 256 * wid + 8 * (lane >> 4); const int e = lane & 15;
#pragma unroll
          for (int ks = 0; ks < 8; ++ks) { const f32x4 xa0 = *(const LAS f32x4*)(xa + 32 * ks), xa1 = *(const LAS f32x4*)(xa + 32 * ks + 4);
              const float xv[8] = {xa0[0], xa0[1], xa0[2], xa0[3], xa1[0], xa1[1], xa1[2], xa1[3]}; f16x8 ah, al;
#pragma unroll
              for (int j = 0; j < 8; ++j) { const _Float16 hh = (_Float16)xv[j]; ah[j] = hh; al[j] = (_Float16)(xv[j] - (float)hh); }
              acc0 = __builtin_amdgcn_mfma_f32_16x16x32_f16(ah, bw[ks][0], acc0, 0, 0, 0); acc1 = __builtin_amdgcn_mfma_f32_16x16x32_f16(ah, bw[ks][1], acc1, 0, 0, 0);
              acc0 = __builtin_amdgcn_mfma_f32_16x16x32_f16(al, bw[ks][0], acc0, 0, 0, 0); acc1 = __builtin_amdgcn_mfma_f32_16x16x32_f16(al, bw[ks][1], acc1, 0, 0, 0); }
          __builtin_amdgcn_sched_barrier(0);
          __builtin_amdgcn_sched_barrier(0);
#pragma unroll
          for (int r = 0; r < 4; ++r) { const int row = (lane >> 4) * 4 + r; part[(wid * 16 + row) * 32 + e] = acc0[r]; part[(wid * 16 + row) * 32 + 16 + e] = acc1[r]; } }
        __syncthreads();
        { const int row = tid >> 5, e = tid & 31; float lg = 0.f;
#pragma unroll
          for (int w = 0; w < 8; ++w) lg += part[(w * 16 + row) * 32 + e];
          const float sc = 1.0f / (1.0f + __expf(-lg)); scs[row * 32 + e] = sc; sels[row * 32 + e] = sc + rb[e]; }
        __syncthreads();
        if (tid < 16) { const int row = tid; float best = -INFINITY; int bg = 0;
            for (int gI = 0; gI < 8; ++gI) { const float a = sels[row * 32 + 4 * gI], b = sels[row * 32 + 4 * gI + 1], c = sels[row * 32 + 4 * gI + 2], d = sels[row * 32 + 4 * gI + 3];
                const float h1 = fmaxf(a, b), l1 = fminf(a, b), h2 = fmaxf(c, d), l2 = fminf(c, d); const float gs = fmaxf(h1, h2) + fmaxf(fminf(h1, h2), fmaxf(l1, l2));
                if (gs > best) { best = gs; bg = gI; } }
            const float v0 = sels[row * 32 + 4 * bg], v1 = sels[row * 32 + 4 * bg + 1], v2 = sels[row * 32 + 4 * bg + 2], v3 = sels[row * 32 + 4 * bg + 3];
            int i1 = 0; float b1v = v0; if (v1 > b1v) { b1v = v1; i1 = 1; } if (v2 > b1v) { b1v = v2; i1 = 2; } if (v3 > b1v) { b1v = v3; i1 = 3; }
            int i2 = -1; float b2v = -INFINITY;
            if (i1 != 0 && v0 > b2v) { b2v = v0; i2 = 0; } if (i1 != 1 && v1 > b2v) { b2v = v1; i2 = 1; } if (i1 != 2 && v2 > b2v) { b2v = v2; i2 = 2; } if (i1 != 3 && v3 > b2v) { b2v = v3; i2 = 3; }
            const int e1 = 4 * bg + i1, e2 = 4 * bg + i2; const float s1 = scs[row * 32 + e1], s2 = scs[row * 32 + e2]; const float inv = 1.0f / (s1 + s2);
            const int m = tix * 16 + row;
            tok_e[2 * m] = e1; tok_e[2 * m + 1] = e2; tok_g[2 * m] = s1 * inv; tok_g[2 * m + 1] = s2 * inv;
            ble[(it * 16 + row) * 2] = e1; ble[(it * 16 + row) * 2 + 1] = e2; }
        __syncthreads();
        ntl = it + 1;
    }
#undef LNR_LOAD
    const int nasg = commit ? ntl * 32 : 0;
    if (tid < 32) { int c = 0; for (int i = 0; i < nasg; ++i) c += (ble[i] == tid) ? 1 : 0;
        unsigned base = 0; if (c) base = __hip_atomic_fetch_add(cnt + tid, (unsigned)c, __ATOMIC_RELAXED, __HIP_MEMORY_SCOPE_AGENT);
        hist[tid] = (int)base; }
    __syncthreads();
    if (tid < 32) { int run = hist[tid];
        for (int i = 0; i < nasg; ++i) if (ble[i] == tid) { const int tr = i >> 1; const size_t m = (size_t)(bid + G * (tr >> 4)) * 16 + (tr & 15);
            list[(size_t)tid * 65536 + run] = (int)m; tok_p[2 * m + (i & 1)] = run; ++run; } }
    __syncthreads();
}

constexpr int MOE_LDS = 131072;
__device__ __forceinline__ int moe_prefix(const unsigned* cnt, LAS int* pblk, int tid) {
    if (tid == 0) { int acc = 0; for (int e = 0; e < NE; ++e) { pblk[e] = acc; acc += ((int)cnt[e] + 255) >> 8; } pblk[NE] = acc; }
    __syncthreads();
    return pblk[NE];
}
template <int NJ> __device__ __forceinline__ int moe_table(const unsigned* cnt, LAS int* pblk, LAS int* tab, LAS int* aux, int NB, int G, int bid, int tid) {
    const int NU = NB * NJ;
    if (tid < 16) { const int L = bid + G * tid;
        if (L < NU) { const int rb = L / NJ, j = L % NJ; int e = 0; for (int q = 1; q < NE; ++q) if (pblk[q] <= rb) e = q;
            tab[tid] = rb; tab[16 + tid] = NJ * e + j; aux[tid * 3] = e; aux[tid * 3 + 1] = (rb - pblk[e]) * 256; aux[tid * 3 + 2] = (int)cnt[e]; } }
    __syncthreads();
    int n = 0; for (int i = 0; i < 16; ++i) if (bid + G * i < NU) n = i + 1;
    return n;
}

template <bool FINAL>
__device__ __forceinline__ void phase_combine_ln(const float* dbg, const bf16_t* x1b, const bf16_t* Yr, const int* tok_e, const int* tok_p, const float* tok_g, const unsigned* cnt,
                                                 const float* g, const float* bb, bf16_t* xo, unsigned char* xq, float* fo, LAS unsigned char* lds, int G, int bid, int tid) {
    LAS int* pblk = (LAS int*)lds;
    moe_prefix(cnt, pblk, tid);
    const int wid = __builtin_amdgcn_readfirstlane(tid >> 6), lane = tid & 63;
    float ALPHA = 1.4142135623730951f; asm volatile("" : "+v"(ALPHA));
#if DBG_CHECK
    const bool dbg_bad = FINAL && (!(dbg[0] <= DBG_TOL * DBG_TOL * dbg[1]) || !(dbg[2] <= DBG_TOL * DBG_TOL * dbg[3]) || !(dbg[1] > 0.f) || !(dbg[3] > 0.f));
#endif
    for (int m = bid * 8 + wid; m < T_; m += G * 8) {
        const int e0 = tok_e[2 * m], e1 = tok_e[2 * m + 1];
        const size_t p0 = (size_t)pblk[e0] * 256 + tok_p[2 * m], p1 = (size_t)pblk[e1] * 256 + tok_p[2 * m + 1];
        const float g0 = tok_g[2 * m], g1 = tok_g[2 * m + 1];
        float v[32]; float s = 0.f;
#pragma unroll
        for (int i = 0; i < 4; ++i) { const int col = 8 * lane + 512 * i;
            const u32x4 xa = *(const u32x4*)(x1b + (size_t)m * DM + col);
            const unsigned xw[4] = {xa.x, xa.y, xa.z, xa.w};
            if constexpr (F8_YR) {
                const u32x2 ya = *(const u32x2*)((const unsigned char*)Yr + p0 * DM + col), yb = *(const u32x2*)((const unsigned char*)Yr + p1 * DM + col);
                const unsigned aw[2] = {ya.x, ya.y}, bw[2] = {yb.x, yb.y}; const float h0 = g0 * (1.0f / 16.0f), h1 = g1 * (1.0f / 16.0f);
#define CMB_PAIR(j, W, SEL) do { const f32x2 a2 = __builtin_amdgcn_cvt_pk_f32_fp8((int)aw[W], SEL), b2 = __builtin_amdgcn_cvt_pk_f32_fp8((int)bw[W], SEL); \
                    v[i * 8 + 2 * (j)] = ALPHA * bflo(xw[j]) + h0 * a2[0] + h1 * b2[0]; v[i * 8 + 2 * (j) + 1] = ALPHA * bfhi(xw[j]) + h0 * a2[1] + h1 * b2[1]; \
                    s += v[i * 8 + 2 * (j)] + v[i * 8 + 2 * (j) + 1]; } while (0)
                CMB_PAIR(0, 0, false); CMB_PAIR(1, 0, true); CMB_PAIR(2, 1, false); CMB_PAIR(3, 1, true);
#undef CMB_PAIR
            } else {
                const u32x4 ya = *(const u32x4*)(Yr + p0 * DM + col), yb = *(const u32x4*)(Yr + p1 * DM + col);
                const unsigned aw[4] = {ya.x, ya.y, ya.z, ya.w}, bw[4] = {yb.x, yb.y, yb.z, yb.w};
#pragma unroll
                for (int j = 0; j < 4; ++j) { v[i * 8 + 2 * j] = ALPHA * bflo(xw[j]) + g0 * bflo(aw[j]) + g1 * bflo(bw[j]); v[i * 8 + 2 * j + 1] = ALPHA * bfhi(xw[j]) + g0 * bfhi(aw[j]) + g1 * bfhi(bw[j]);
                    s += v[i * 8 + 2 * j] + v[i * 8 + 2 * j + 1]; }
            } }
        const float mean = wave_sum(s) * (1.0f / DM); float q = 0.f;
#pragma unroll
        for (int i = 0; i < 32; ++i) { const float d = v[i] - mean; q += d * d; }
        const float rstd = rsqrtf(wave_sum(q) * (1.0f / DM) + 1e-5f);
#pragma unroll
        for (int i = 0; i < 4; ++i) { const int col = 8 * lane + 512 * i;
            const f32x4 ga = *(const f32x4*)(g + col), gb = *(const f32x4*)(g + col + 4), ba = *(const f32x4*)(bb + col), bbv = *(const f32x4*)(bb + col + 4);
            float y[8];
#pragma unroll
            for (int j = 0; j < 4; ++j) { y[j] = (v[i * 8 + j] - mean) * rstd * ga[j] + ba[j]; y[4 + j] = (v[i * 8 + 4 + j] - mean) * rstd * gb[j] + bbv[j]; }
#if DBG_CHECK
            if (dbg_bad) { for (int j = 0; j < 8; ++j) y[j] = 0.f; }
#endif
            if constexpr (FINAL) { *(f32x4*)(fo + (size_t)m * DM + col) = (f32x4){y[0], y[1], y[2], y[3]}; *(f32x4*)(fo + (size_t)m * DM + col + 4) = (f32x4){y[4], y[5], y[6], y[7]}; }
            else { *(u32x4*)(xo + (size_t)m * DM + col) = (u32x4){cvtpk(y[0], y[1]), cvtpk(y[2], y[3]), cvtpk(y[4], y[5]), cvtpk(y[6], y[7])};
                if constexpr (F8_IN) *(u32x2*)(xq + (size_t)m * DM + col) = (u32x2){pk4_fp8(y[0], y[1], y[2], y[3]), pk4_fp8(y[4], y[5], y[6], y[7])}; } }
    }
}

#if DBG_CHECK
__device__ __forceinline__ void dbg_attn_check(int which, const bf16_t* Hx, const bf16_t* Qd, const bf16_t* KVd, const bf16_t* krope, const void* Oat, float* dbg, LAS unsigned char* lds, int bid, int tid) {
    const int wid = __builtin_amdgcn_readfirstlane(tid >> 6), lane = tid & 63;
    LAS float* sc = (LAS float*)lds + wid * 4096;
    LAS float* qs = (LAS float*)(lds + 131072) + wid * 192;
    const unsigned sid = (unsigned)(bid * 8 + wid);
    const int m = (int)((sid * 2654435761u) % (unsigned)T_), h = (int)(sid & 7u), b = m >> 12, pos = m & (SEQ - 1);
    const int DQ = which ? 192 : 128; const float scale = which ? 0.072168783648703220f : 0.088388347648318440f;
    for (int d = lane; d < DQ; d += 64) {
        float qv;
        if (which == 0) qv = bf2f(Hx[(size_t)m * IN0 + h * 128 + d]);
        else if (d < 128) qv = bf2f(Qd[(size_t)m * 1536 + h * 192 + d]);
        else { const int i = (d - 128) & 31; const float x1 = bf2f(Qd[(size_t)m * 1536 + h * 192 + 128 + i]), x2 = bf2f(Qd[(size_t)m * 1536 + h * 192 + 160 + i]);
            float sn, cs; sincos_rev((float)pos * inv_freq32(i), sn, cs); qv = (d < 160) ? (x1 * cs - x2 * sn) : (x2 * cs + x1 * sn); }
        qs[d] = qv; }
    asm volatile("s_waitcnt lgkmcnt(0)" ::: "memory");
    float mx = -INFINITY;
    for (int i = 0; i < 64; ++i) { const int j = lane + 64 * i; float dot = 0.f;
        if (which == 0) { const bf16_t* kp = Hx + (size_t)(b * SEQ + j) * IN0 + 1024 + (h >> 2) * 128; for (int d = 0; d < 128; ++d) dot += qs[d] * bf2f(kp[d]); }
        else { const bf16_t* kp = KVd + (size_t)(b * SEQ + j) * DM + h * 256; for (int d = 0; d < 128; ++d) dot += qs[d] * bf2f(kp[d]);
               const bf16_t* rp = krope + (size_t)(b * SEQ + j) * 64; for (int d = 0; d < 64; ++d) dot += qs[128 + d] * bf2f(rp[d]); }
        dot *= scale; sc[j] = dot; mx = fmaxf(mx, dot); }
    mx = wave_max(mx);
    float sum = 0.f;
    for (int i = 0; i < 64; ++i) { const int j = lane + 64 * i; const float pj = __expf(sc[j] - mx); sc[j] = pj; sum += pj; }
    sum = wave_sum(sum);
    asm volatile("s_waitcnt lgkmcnt(0)" ::: "memory");
    float e2 = 0.f, r2 = 0.f;
    for (int cc = 0; cc < 2; ++cc) { const int c = lane + 64 * cc; float acc = 0.f;
        for (int j = 0; j < SEQ; ++j) { const float vv = which == 0 ? bf2f(Hx[(size_t)(b * SEQ + j) * IN0 + 1280 + (h >> 2) * 128 + c]) : bf2f(KVd[(size_t)(b * SEQ + j) * DM + h * 256 + 128 + c]); acc += sc[j] * vv; }
        const float ref = acc / sum; const size_t eo = (size_t)m * DM + (which ? 1024 : 0) + h * 128 + c;
        float got; if (F8_OUT) { const unsigned char by = ((const unsigned char*)Oat)[eo]; const f32x2 g2 = __builtin_amdgcn_cvt_pk_f32_fp8((int)by, false); got = g2[0] * (1.0f / O8_SCALE); } else got = bf2f(((const bf16_t*)Oat)[eo]);
        e2 += (got - ref) * (got - ref); r2 += ref * ref; }
    e2 = wave_sum(e2); r2 = wave_sum(r2);
    if (lane == 0) { atomicAdd(dbg + 2 * which, e2); atomicAdd(dbg + 2 * which + 1, r2); }
}
#endif
#ifndef ATT_ONLY
#define ATT_ONLY -1
#endif
#ifndef REP_K
#define REP_K -1
#endif
#ifndef REP_ATT
#define REP_ATT -1
#endif
#define NREP(k) ((REP_K == (k)) ? 2 : 1)
#define NREPA(k) ((REP_ATT == (k)) ? 2 : 1)
constexpr int N_PHASES = 20;
__global__ void __launch_bounds__(NTHR, 2) fwd(Params p) {
    extern __shared__ __attribute__((aligned(16))) unsigned char lds_raw[];
    LAS unsigned char* lds = (LAS unsigned char*)lds_raw;
    const int tid0 = threadIdx.x, bid = blockIdx.x, G = gridDim.x;
    const int wv = __builtin_amdgcn_readfirstlane(tid0 >> 6);
    const int vcu = (G % 8 == 0) ? (bid % 8) * (G / 8) + bid / 8 : bid;
    unsigned* ctl = (unsigned*)(p.ws + WS_CTL);
    if (tid0 < 4) ((LAS unsigned*)(lds + MISC_OFF))[tid0] = 0u;
    __syncthreads();
    XcdBarrier bar; bar.bar = ctl + CW_BAR; bar.x = 0; bar.st = (volatile LAS unsigned*)(lds + MISC_OFF);
    if (N_LAUNCH_MODE == 1) bar = xcd_barrier_post(ctl + CW_BAR, (volatile LAS unsigned*)(lds + MISC_OFF));
    const int lo = p.ph_lo, hi = p.ph_hi;
#ifndef PH_ONLY
#define PH_ONLY -1
#endif
#define IN(k) ((PH_ONLY < 0 || (PH_ONLY % 10) == ((k) % 10)) && lo <= (k) && (k) < hi)
#define SEAM(k) do { if ((k) + 1 < hi) xcd_barrier(bar, fresh_tid(wv)); } while (0)

    for (int L = 0; L < 2; ++L) {
        const int pb = L * 10;
        typedef __attribute__((address_space(1))) unsigned char gu8;
        typedef __attribute__((address_space(1))) const float gcf;
        typedef __attribute__((address_space(4))) const unsigned long long kcu64;
#define INP(i) ((const float*)(gcf*)ka[i])
#define PHASE_PTRS \
        kcu64* ka = (kcu64*)__builtin_amdgcn_kernarg_segment_ptr(); asm volatile("" : "+s"(ka)); \
        unsigned char* ws = (unsigned char*)(gu8*)ka[29]; unsigned char* outb = (unsigned char*)(gu8*)ka[28]; \
        unsigned* ctl = (unsigned*)(ws + WS_CTL); \
        bf16_t* RA = (bf16_t*)(ws + WS_RA); bf16_t* RB = (bf16_t*)(ws + WS_RB); bf16_t* RC = (bf16_t*)(ws + WS_RC); \
        int* list = (int*)(ws + WS_LIST); int* tok_e = (int*)(ws + WS_TOKE); int* tok_p = (int*)(ws + WS_TOKP); float* tok_g = (float*)(ws + WS_TOKG); \
        bf16_t* krope = (bf16_t*)(ws + WS_KROPE); \
        bf16_t* Qd = (bf16_t*)(outb + OUT_QD); bf16_t* O1 = (bf16_t*)(outb + OUT_O1); \
        const bf16_t* Win = (const bf16_t*)(ws + (L ? WS_WIN1 : WS_WIN0)); const bf16_t* Wout = (const bf16_t*)(ws + (L ? WS_WOUT1 : WS_WOUT0)); \
        const bf16_t* Wgu = (const bf16_t*)(ws + (L ? WS_WGU1 : WS_WGU0)); const bf16_t* Wd = (const bf16_t*)(ws + (L ? WS_WD1 : WS_WD0)); \
        const int NIN = L ? IN1P : IN0; \
        const bf16_t* xin = L ? RC : RA; \
        bf16_t* Hx = RB; bf16_t* Oat = L ? O1 : RC; float* Z = (float*)RB; \
        bf16_t* x1b = RA; bf16_t* Hm = RC; bf16_t* Yr = RB; \
        unsigned* cnt = ctl + CW_CNT + L * 64; \
        (void)ctl; (void)RA; (void)RB; (void)RC; (void)list; (void)tok_e; (void)tok_p; (void)tok_g; (void)krope; (void)Qd; (void)O1; (void)Win; (void)Wout; (void)Wgu; (void)Wd; (void)NIN; (void)xin; (void)Hx; (void)Oat; (void)Z; (void)x1b; (void)Hm; (void)Yr; (void)cnt; (void)outb

        if (L == 0 && IN(0)) { PHASE_PTRS; _Pragma("unroll 1") for (int rep = 0; rep < NREP(0); ++rep) phase_prologue(ka, ws, lds, G, bid, fresh_tid(wv)); SEAM(0); }

        if (IN(pb + 1)) {
            PHASE_PTRS;
            constexpr int KI = F8_IN ? 1024 : 2048;
            const bf16_t* ain = F8_IN ? (L ? (const bf16_t*)outb : (const bf16_t*)((unsigned char*)RC + 64 * MiB)) : xin;
            pg8::Gemm g{ain, Win, KI, KI, KI}; pg8::StaticOrder S; S.init(T_, NIN, G, bid, KI);
            pg8::EpiIn E{Hx, NIN, L ? ws + WS_WGU0 + 64 * MiB : (unsigned char*)RA, L ? ws + WS_WD0 + 32 * MiB : ws + WS_WGU1 + 64 * MiB, F8_SPARSE ? (L ? 4 : 10) : 99, F8_SPARSE ? (L ? 8 : 14) : 99, F8_SPARSE ? (L ? 12 : 18) : 99};
            _Pragma("unroll 1") for (int rep = 0; rep < NREP(1); ++rep) pg8::gemm_phase<F8_IN != 0>(wv, lds, g, S, E, W8_SBYTE, 0x7f7f7f7f);
            SEAM(pb + 1);
        }
        if (IN(pb + 2)) {
            PHASE_PTRS;
            if (L == 0) { phase_prep_qk(Hx, INP(I_AQN), INP(I_AKN), ws + WS_WGU0 + 64 * MiB, G, bid, fresh_tid(wv));
                if (F8_ATTA) phase_vt8(Hx, ws + WS_WGU0 + 72 * MiB, lds, G, bid, fresh_tid(wv));
                if (F8_SPARSE) { unsigned char* ra8 = (unsigned char*)RA;
                    phase_vt_heads<true>(ws + WS_WGU1 + 64 * MiB, ra8 + 32 * MiB, ra8 + 64 * MiB, ra8 + 96 * MiB, lds, G, bid, fresh_tid(wv)); } }
            else { phase_prep_mla(Hx, krope, ws + WS_WD1 + 32 * MiB, G, bid, fresh_tid(wv));
                if (F8_SPARSE) { unsigned char* c8 = ws + WS_WGU0 + 64 * MiB;
                    phase_vt_heads<false>(ws + WS_WD0 + 32 * MiB, c8 + 32 * MiB, nullptr, nullptr, lds, G, bid, fresh_tid(wv)); } }
            SEAM(pb + 2);
        }
        if (L == 1 && IN(pb + 3)) _Pragma("unroll 1") for (int rep = 0; rep < NREP(3); ++rep) {
            PHASE_PTRS;
#ifndef P3_ONLY
#define P3_ONLY -1
#endif
            if (P3_ONLY < 0 || P3_ONLY == 0) { pg8::Gemm g{Hx + 3072, (const bf16_t*)(ws + WS_WQUP), 512, IN1P, 512}; pg8::StaticOrder S; S.init(T_, 1536, G, bid, IN1P);
              pg8::EpiBf16 E{Qd, 1536, 0xffff}; pg8::gemm_phase<false>(wv, lds, g, S, E); }
            if (P3_ONLY < 0 || P3_ONLY == 1) { pg8::Gemm g{Hx + 3584, (const bf16_t*)(ws + WS_WKVUP), 256, IN1P, 256}; pg8::StaticOrder S; S.init(T_, 2048, G, bid, IN1P);
              if constexpr (F8_ATTD) { pg8::EpiKV8 E{ws + WS_WGU1 + 64 * MiB, ws + WS_WGU1 + 96 * MiB, RA, DBG_CHECK != 0}; pg8::gemm_phase<false>(wv, lds, g, S, E); }
              else { pg8::EpiBf16 E{RA, 2048, 0xffff}; pg8::gemm_phase<false>(wv, lds, g, S, E); } }
            if (rep + 1 == NREP(3)) SEAM(pb + 3);
        }
        if (IN(pb + 4)) {
            PHASE_PTRS;
            if (L == 0) {
                if (ATT_ONLY < 0 || ATT_ONLY == 0)
                _Pragma("unroll 1") for (int rep = 0; rep < NREPA(0); ++rep)
                for (int u = vcu; u < 1024; u += G) {
                    __syncthreads();
                    const int b = u >> 7, qb = u & 15, kvh = (u >> 6) & 1, gq = (u >> 4) & 3, h = kvh * 4 + gq;
                    if constexpr (F8_ATTA) {
                        d8::D8Args a; a.Q = Hx + (size_t)(b * SEQ + 256 * qb) * IN0 + h * 128; a.ldq = IN0;
                        a.K8 = ws + WS_WGU0 + 64 * MiB + (size_t)b * SEQ * 256 + kvh * 128; a.ldk = 256; a.Kr8 = nullptr;
                        a.Vt8 = ws + WS_WGU0 + 72 * MiB + (size_t)(b * 2 + kvh) * 128 * SEQ; a.ldvt = SEQ;
                        { const size_t eo = (size_t)(b * SEQ + 256 * qb) * DM + h * 128; a.O = F8_OUT ? (bf16_t*)((unsigned char*)Oat + eo) : Oat + eo; } a.ldo = DM; a.seq = SEQ; a.pos0 = 0;
                        d8::attn_dense8_body<2>(wv, a, (char*)lds_raw);
                    } else {
                    da::DArgs a; a.Q = Hx + (size_t)(b * SEQ + 256 * qb) * IN0 + h * 128; a.ldq = IN0;
                    a.K = Hx + (size_t)b * SEQ * IN0 + 1024 + kvh * 128; a.ldk = IN0; a.V = Hx + (size_t)b * SEQ * IN0 + 1280 + kvh * 128; a.ldv = IN0; a.Kr = nullptr;
                    { const size_t eo = (size_t)(b * SEQ + 256 * qb) * DM + h * 128; a.O = F8_OUT ? (bf16_t*)((unsigned char*)Oat + eo) : Oat + eo; } a.ldo = DM; a.seq = SEQ; a.pos0 = 0;
                    da::attn_dense_body<8, 1>(wv, a, (char*)lds_raw);
                    }
                }
                __syncthreads();
                if (ATT_ONLY < 0 || ATT_ONLY == 2)
                _Pragma("unroll 1") for (int rep = 0; rep < NREPA(2); ++rep)
                for (int it = vcu; it < 1024; it += G) {
                    const int tid2 = fresh_tid(wv), wid = __builtin_amdgcn_readfirstlane(tid2 >> 6), lane = tid2 & 63;
                    const int w = it * 8 + wid; LAS unsigned char* wl = lds + wid * da::SP_WAVE_LDS;
                    if constexpr (F8_SPARSE) { const unsigned char* ra8 = (const unsigned char*)RA; PolB8 pol; pol.init(Hx, Oat, ra8, ra8 + 32 * MiB, ra8 + 64 * MiB, ra8 + 96 * MiB, w, lane); d8::sparse8_wave(pol, wl, lane); }
                    else { PolB pol; pol.init(Hx, Oat, w, lane); da::sparse_wave(pol, wl, lane); }
                }
            } else {
                if (ATT_ONLY < 0 || ATT_ONLY == 1)
                _Pragma("unroll 1") for (int rep = 0; rep < NREPA(1); ++rep)
                for (int u = vcu; u < 1024; u += G) {
                    __syncthreads();
                    const int b = u >> 7, qb = u & 15, h = (u >> 4) & 7;
                    if constexpr (F8_ATTD) {
                        d8::D8Args a; a.Q = Qd + (size_t)(b * SEQ + 256 * qb) * 1536 + h * 192; a.ldq = 1536;
                        a.K8 = ws + WS_WGU1 + 64 * MiB + (size_t)b * SEQ * 1024 + h * 128; a.ldk = 1024; a.Kr8 = ws + WS_WD1 + 32 * MiB + (size_t)b * SEQ * 64;
                        a.Vt8 = ws + WS_WGU1 + 96 * MiB + (size_t)(b * 8 + h) * 128 * SEQ; a.ldvt = SEQ;
                        { const size_t eo = (size_t)(b * SEQ + 256 * qb) * DM + 1024 + h * 128; a.O = F8_OUT ? (bf16_t*)((unsigned char*)Oat + eo) : Oat + eo; } a.ldo = DM; a.seq = SEQ; a.pos0 = 256 * qb;
                        d8::attn_dense8_body<3>(wv, a, (char*)lds_raw);
                    } else {
                    da::DArgs a; a.Q = Qd + (size_t)(b * SEQ + 256 * qb) * 1536 + h * 192; a.ldq = 1536;
                    a.K = RA + (size_t)b * SEQ * DM + h * 256; a.ldk = DM; a.V = a.K + 128; a.ldv = DM; a.Kr = krope + (size_t)b * SEQ * 64;
                    { const size_t eo = (size_t)(b * SEQ + 256 * qb) * DM + 1024 + h * 128; a.O = F8_OUT ? (bf16_t*)((unsigned char*)Oat + eo) : Oat + eo; } a.ldo = DM; a.seq = SEQ; a.pos0 = 256 * qb;
                    da::attn_dense_body<12, 1>(wv, a, (char*)lds_raw);
                    }
                }
                __syncthreads();
                if (ATT_ONLY < 0 || ATT_ONLY == 3)
                _Pragma("unroll 1") for (int rep = 0; rep < NREPA(3); ++rep)
                for (int it = vcu; it < 1024; it += G) {
                    const int tid2 = fresh_tid(wv), wid = __builtin_amdgcn_readfirstlane(tid2 >> 6), lane = tid2 & 63;
                    const int w = it * 8 + wid; LAS unsigned char* wl = lds + wid * da::SP_WAVE_LDS;
                    if constexpr (F8_SPARSE) { const unsigned char* c8 = ws + WS_WGU0 + 64 * MiB; PolC8 pol; pol.init(Hx, Oat, c8, c8 + 32 * MiB, INP(I_RPB), (float*)((char*)wl + 16640), w, lane); d8::sparse8_wave(pol, wl, lane); }
                    else { PolC pol; pol.init(Hx, Oat, INP(I_RPB), (float*)((char*)wl + 16640), w, lane); da::sparse_wave(pol, wl, lane); }
                }
            }
#if DBG_CHECK
            xcd_barrier(bar, fresh_tid(wv));
            dbg_attn_check(L, Hx, Qd, RA, krope, Oat, (float*)(ctl + CW_DBG), lds, bid, fresh_tid(wv));
            __syncthreads();
#endif
            SEAM(pb + 4);
        }
        if (IN(pb + 5)) {
            PHASE_PTRS;
            constexpr int KO = F8_OUT ? 1024 : 2048; constexpr int SXO = F8_OUT ? 0x7b7b7b7b : 0x7f7f7f7f;
            pg8::Gemm g{Oat, Wout, KO, KO, KO}; pg8::StaticOrder S; S.init(T_, DM, G, bid, KO);
            pg8::EpiBf16 E{RB, DM, 0xffff};
            _Pragma("unroll 1") for (int rep = 0; rep < NREP(5); ++rep) pg8::gemm_phase<F8_OUT != 0>(wv, lds, g, S, E, W8_SBYTE, SXO);
            SEAM(pb + 5);
        }
        if (IN(pb + 6)) {
            PHASE_PTRS;
            if (L == 0) { _Pragma("unroll 1") for (int rep = 0; rep < NREP(6); ++rep) phase_ln_router<true>(RB, INP(I_X), INP(I_LN1G0), INP(I_LN1B0), INP(I_RW), INP(I_RB), x1b, (unsigned char*)RC + 64 * MiB, tok_e, tok_p, tok_g, list, cnt, lds, G, bid, fresh_tid(wv), rep + 1 == NREP(6)); }
            else { _Pragma("unroll 1") for (int rep = 0; rep < NREP(6); ++rep) phase_ln_router<false>(RB, RC, INP(I_LN1G1), INP(I_LN1B1), INP(I_RW), INP(I_RB), x1b, outb  , tok_e, tok_p, tok_g, list, cnt, lds, G, bid, fresh_tid(wv), rep + 1 == NREP(6)); }
            SEAM(pb + 6);
        }
        if (IN(pb + 7)) {
            PHASE_PTRS;
            LAS int* pblk = (LAS int*)(lds + MOE_LDS); LAS int* tab = pblk + 64; LAS int* aux = tab + 32; LAS int* idx = aux + 64;
            const int tid = fresh_tid(wv);
            const int NB = moe_prefix(cnt, pblk, tid);
            const int n = moe_table<4>(cnt, pblk, tab, aux, NB, G, bid, tid);
            for (int i = 0; i < n; ++i) if (tid < 256) { const int e = aux[i * 3], rs = aux[i * 3 + 1], ce = aux[i * 3 + 2]; idx[i * 256 + tid] = list[(size_t)e * 65536 + min(rs + tid, ce - 1)]; }
            __syncthreads();
            constexpr int KG = F8_GU ? 1024 : 2048;
            const bf16_t* agu = F8_GU ? (L ? (const bf16_t*)outb : (const bf16_t*)((unsigned char*)RC + 64 * MiB)) : x1b;
            pg8::Gemm g{agu, Wgu, KG, KG, KG}; pg8::TableOrder<true> S{tab, idx, n, KG}; pg8::EpiSiluMul<F8_DOWN != 0> E{Hm};
            _Pragma("unroll 1") for (int rep = 0; rep < NREP(7); ++rep) pg8::gemm_phase<F8_GU != 0>(wv, lds, g, S, E, W8_SBYTE, 0x7f7f7f7f);
            SEAM(pb + 7);
        }
        if (IN(pb + 8)) {
            PHASE_PTRS;
            LAS int* pblk = (LAS int*)(lds + MOE_LDS); LAS int* tab = pblk + 64; LAS int* aux = tab + 32;
            const int tid = fresh_tid(wv);
            const int NB = moe_prefix(cnt, pblk, tid);
            const int n = moe_table<8>(cnt, pblk, tab, aux, NB, G, bid, tid);
            constexpr int KD = F8_DOWN ? 256 : 512;
            pg8::Gemm g{Hm, Wd, KD, KD, KD}; pg8::TableOrder<false> S{tab, nullptr, n, KD}; pg8::EpiBf16T<F8_YR != 0> E{Yr, DM, 7};
            _Pragma("unroll 1") for (int rep = 0; rep < NREP(8); ++rep) pg8::gemm_phase<F8_DOWN != 0>(wv, lds, g, S, E, W8_SBYTE, 0x7f7f7f7f);
            SEAM(pb + 8);
        }
        if (IN(pb + 9)) _Pragma("unroll 1") for (int rep = 0; rep < NREP(9); ++rep) {
            PHASE_PTRS;
            if (L == 0) phase_combine_ln<false>((const float*)(ctl + CW_DBG), x1b, Yr, tok_e, tok_p, tok_g, cnt, INP(I_LN2G0), INP(I_LN2B0), RC, outb, nullptr, lds, G, bid, fresh_tid(wv));
            else phase_combine_ln<true>((const float*)(ctl + CW_DBG), x1b, Yr, tok_e, tok_p, tok_g, cnt, INP(I_LN2G1), INP(I_LN2B1), nullptr, nullptr, (float*)outb, lds, G, bid, fresh_tid(wv));
            if (rep + 1 == NREP(9)) SEAM(pb + 9);
        }
    }
#undef IN
#undef SEAM
#undef INP
#undef PHASE_PTRS
}

extern "C" void kernel_launch(void* const* d_in, const int* in_sizes, int n_in, void* d_out, int out_size, void* d_ws, size_t ws_size, hipStream_t stream) {
    static int grid = 0;
    if (grid == 0) {
        if (n_in != 28 || out_size != T_ * DM || ws_size < WS_END) { fprintf(stderr, "kernel_launch: unexpected shapes: n_in %d out %d ws %zu (need %zu)\n", n_in, out_size, ws_size, (size_t)WS_END); grid = -1; return; }
        int dev = 0, cus = 0, per_cu = 0;
        if (hipGetDevice(&dev) != hipSuccess || hipDeviceGetAttribute(&cus, hipDeviceAttributeMultiprocessorCount, dev) != hipSuccess) { grid = -1; return; }
        if (hipFuncSetAttribute((const void*)fwd, hipFuncAttributeMaxDynamicSharedMemorySize, LDS_BYTES) != hipSuccess) { fprintf(stderr, "kernel_launch: hipFuncSetAttribute failed\n"); grid = -1; return; }
        if (hipOccupancyMaxActiveBlocksPerMultiprocessor(&per_cu, (const void*)fwd, NTHR, LDS_BYTES) != hipSuccess || per_cu < 1)
            fprintf(stderr, "kernel_launch: occupancy query reports %d workgroups per CU\n", per_cu);
        (void)hipGetLastError();
        grid = cus;
    }
    if (grid < 0) return;
    (void)hipMemsetAsync((char*)d_ws + WS_CTL, 0, CTL_ZERO_BYTES, stream);
    Params p{};
    for (int i = 0; i < 28; ++i) p.in[i] = (const float*)d_in[i];
    p.out = (float*)d_out; p.ws = (unsigned char*)d_ws;
#if N_LAUNCH_MODE == 1
    p.ph_lo = 0; p.ph_hi = N_PHASES;
    hipLaunchKernelGGL(fwd, dim3(grid), dim3(NTHR), LDS_BYTES, stream, p);
#else
    for (int k = 0; k < N_PHASES; ++k) { if (k == 3 || k == 10) continue; p.ph_lo = k; p.ph_hi = k + 1;
        hipLaunchKernelGGL(fwd, dim3(grid), dim3(NTHR), LDS_BYTES, stream, p); }
#endif
    const hipError_t le = hipPeekAtLastError();
    if (le != hipSuccess) fprintf(stderr, "kernel_launch: launch failed: %s\n", hipGetErrorName(le));
}
```

```cpp
#include <hip/hip_runtime.h>
#include <cstdio>
#include <cstdint>
#include <type_traits>

#ifndef N_LAUNCH_MODE
#define N_LAUNCH_MODE 1
#endif
#ifndef DBG_CHECK
#define DBG_CHECK 0
#endif
#ifndef DBG_TOL
#define DBG_TOL 0.3f
#endif
#ifndef F8_DOWN
#define F8_DOWN 1
#endif
#ifndef F8_GU
#define F8_GU 1
#endif
#ifndef F8_IN
#define F8_IN 1
#endif
#ifndef F8_OUT
#define F8_OUT 1
#endif
#ifndef F8_ATTA
#define F8_ATTA 1
#endif
#ifndef F8_ATTD
#define F8_ATTD 1
#endif
#ifndef F8_SPARSE
#define F8_SPARSE 1
#endif
#ifndef F8_YR
#define F8_YR 1
#endif

#define LAS __attribute__((address_space(3)))
typedef unsigned short bf16_t;
typedef short bf16x8 __attribute__((ext_vector_type(8)));
typedef short s16x4 __attribute__((ext_vector_type(4)));
typedef float f32x2 __attribute__((ext_vector_type(2)));
typedef float f32x4 __attribute__((ext_vector_type(4)));
typedef float f32x8 __attribute__((ext_vector_type(8)));
typedef float f32x16 __attribute__((ext_vector_type(16)));
typedef unsigned u32x2 __attribute__((ext_vector_type(2)));
typedef unsigned u32x4 __attribute__((ext_vector_type(4)));
typedef int i32x8 __attribute__((ext_vector_type(8)));
typedef _Float16 f16x8 __attribute__((ext_vector_type(8)));
typedef _Float16 f16x2 __attribute__((ext_vector_type(2)));
typedef int i32x4 __attribute__((ext_vector_type(4)));

constexpr int T_ = 32768, DM = 2048, SEQ = 4096, NBATCH = 8;
constexpr int IN0 = 4608, IN1 = 3904, IN1P = 4096;
constexpr int NE = 32, DE = 512, MAXBLK = 288;
constexpr float ALPHA = 1.4142135623730951f;
constexpr float LOG2E = 1.4426950408889634f;
constexpr int NTHR = 512;

constexpr size_t MiB = 1u << 20;
constexpr size_t WS_CTL = 0, CTL_ZERO_BYTES = 1 * MiB;
constexpr size_t WS_LIST = 1 * MiB;
constexpr size_t WS_TOKE = 9 * MiB;
constexpr size_t WS_TOKP = WS_TOKE + 256 * 1024;
constexpr size_t WS_TOKG = WS_TOKP + 256 * 1024;
constexpr size_t WS_RSTAT = WS_TOKG + 256 * 1024;
constexpr size_t WS_KROPE = 10 * MiB;
constexpr size_t WS_WIN0 = 16 * MiB, WS_WOUT0 = 34 * MiB, WS_WGU0 = 42 * MiB, WS_WD0 = 170 * MiB;
constexpr size_t WS_WIN1 = 234 * MiB, WS_WOUT1 = 250 * MiB, WS_WGU1 = 258 * MiB, WS_WD1 = 386 * MiB;
constexpr size_t WS_WQUP = 450 * MiB, WS_WKVUP = 452 * MiB;
constexpr size_t WS_RA = 454 * MiB, WS_RB = 582 * MiB, WS_RC = 870 * MiB, WS_END = 998 * MiB;
constexpr size_t OUT_QD = 0, OUT_O1 = 96 * MiB;
constexpr int CW_CNT = 64;
constexpr int CW_DBG = 512;
constexpr int CW_BAR = 4096;

constexpr int LDS_BYTES = 155648;
constexpr int MISC_OFF = LDS_BYTES - 64;

__device__ __forceinline__ unsigned cvtpk(float lo, float hi) { unsigned r; asm volatile("v_cvt_pk_bf16_f32 %0, %1, %2" : "=v"(r) : "v"(lo), "v"(hi)); return r; }
__device__ __forceinline__ float bf2f(unsigned short b) { return __uint_as_float(((unsigned)b) << 16); }
__device__ __forceinline__ float bflo(unsigned w) { return __uint_as_float(w << 16); }
__device__ __forceinline__ float bfhi(unsigned w) { return __uint_as_float(w & 0xffff0000u); }
__device__ __forceinline__ bf16_t f2bf(float f) { return (bf16_t)(cvtpk(f, f) & 0xffffu); }
__device__ __forceinline__ unsigned pk4_fp8(float a, float b, float c, float d) { int w = 0; w = __builtin_amdgcn_cvt_pk_fp8_f32(a, b, w, false); w = __builtin_amdgcn_cvt_pk_fp8_f32(c, d, w, true); return (unsigned)w; }
constexpr float O8_SCALE = 16.f;
__device__ __forceinline__ unsigned char f2fp8(float v) { return (unsigned char)(__builtin_amdgcn_cvt_pk_fp8_f32(v, v, 0, false) & 0xff); }
__device__ __forceinline__ float clamp8(float v) { return fminf(fmaxf(v, -400.f), 400.f); }
__device__ __forceinline__ int fresh_tid(int wv) { int l; asm volatile("v_mbcnt_lo_u32_b32 %0, -1, 0\n\tv_mbcnt_hi_u32_b32 %0, -1, %0" : "=v"(l)); return wv * 64 + l; }
__device__ __forceinline__ float fresh_zero() { float z; asm volatile("v_mov_b32 %0, 0" : "=v"(z)); return z; }
__device__ __forceinline__ float wave_sum(float v) {
    v += __int_as_float(__builtin_amdgcn_ds_swizzle(__float_as_int(v), (1 << 10) | 0x1f));
    v += __int_as_float(__builtin_amdgcn_ds_swizzle(__float_as_int(v), (2 << 10) | 0x1f));
    v += __int_as_float(__builtin_amdgcn_ds_swizzle(__float_as_int(v), (4 << 10) | 0x1f));
    v += __int_as_float(__builtin_amdgcn_ds_swizzle(__float_as_int(v), (8 << 10) | 0x1f));
    v += __int_as_float(__builtin_amdgcn_ds_swizzle(__float_as_int(v), (16 << 10) | 0x1f));
    auto rr = __builtin_amdgcn_permlane32_swap(__float_as_uint(v), __float_as_uint(v), false, false);
    return __uint_as_float(rr[0]) + __uint_as_float(rr[1]);
}
__device__ __forceinline__ float wave_max(float v) {
    v = fmaxf(v, __int_as_float(__builtin_amdgcn_ds_swizzle(__float_as_int(v), (1 << 10) | 0x1f)));
    v = fmaxf(v, __int_as_float(__builtin_amdgcn_ds_swizzle(__float_as_int(v), (2 << 10) | 0x1f)));
    v = fmaxf(v, __int_as_float(__builtin_amdgcn_ds_swizzle(__float_as_int(v), (4 << 10) | 0x1f)));
    v = fmaxf(v, __int_as_float(__builtin_amdgcn_ds_swizzle(__float_as_int(v), (8 << 10) | 0x1f)));
    v = fmaxf(v, __int_as_float(__builtin_amdgcn_ds_swizzle(__float_as_int(v), (16 << 10) | 0x1f)));
    auto rr = __builtin_amdgcn_permlane32_swap(__float_as_uint(v), __float_as_uint(v), false, false);
    return fmaxf(__uint_as_float(rr[0]), __uint_as_float(rr[1]));
}
__device__ __forceinline__ float inv_freq32(int i) { return __builtin_amdgcn_exp2f(-(float)i * 0.41524101186092029f); }
__device__ __forceinline__ void sincos_rev(float angle, float& s, float& c) {
    float rev = angle * 0.15915494309189535f; rev = rev - floorf(rev);
    s = __builtin_amdgcn_sinf(rev); c = __builtin_amdgcn_cosf(rev);
}

#define XB_TMO      128
#define XB_XCNT(j)  (256  + 64 * (j))
#define XB_XSUB(j)  (1280 + 64 * (j))
#define XB_XGEN(j)  (2304 + 64 * (j))
#define XB_TOP      3328
#define XB_TOPGEN   3392
#define XCD_BAR_WORDS 3456
#define XB_SPIN_CAP (1u << 20)
__device__ __forceinline__ unsigned xb_ld(unsigned* p)              { return __hip_atomic_load(p, __ATOMIC_RELAXED, __HIP_MEMORY_SCOPE_AGENT); }
__device__ __forceinline__ unsigned xb_add(unsigned* p, unsigned v) { return __hip_atomic_fetch_add(p, v, __ATOMIC_RELAXED, __HIP_MEMORY_SCOPE_AGENT); }
__device__ __forceinline__ unsigned xb_xcc_id() { return (unsigned)__builtin_amdgcn_s_getreg((3 << 11) | 20) & 0xFu; }
#define XB_SPIN(cond, bar) do { unsigned _sp = 0; while (cond) { __builtin_amdgcn_s_sleep(1); \
    if ((++_sp & 255u) == 0u) { if (xb_ld(&(bar)[XB_TMO])) break; if (_sp > XB_SPIN_CAP) { atomicAdd(&(bar)[XB_TMO], 1u); break; } } } } while (0)
struct XcdBarrier { unsigned* bar; unsigned x; volatile LAS unsigned* st; };
__device__ __forceinline__ XcdBarrier xcd_barrier_post(unsigned* bar, volatile LAS unsigned* st) {
    XcdBarrier b; b.bar = bar; b.x = xb_xcc_id(); b.st = st;
    if (threadIdx.x == 0) (void)xb_add(&bar[XB_XCNT(b.x)], 1u);
    return b;
}
__device__ __forceinline__ void xcd_barrier_complete(unsigned* bar, unsigned x, unsigned& nloc, unsigned& nx) {
    const unsigned G = gridDim.x * gridDim.y * gridDim.z;
    unsigned sum, cnt, mine, sp = 0u;
    for (;;) {
        sum = 0u; cnt = 0u; mine = 0u;
#pragma unroll
        for (unsigned j = 0; j < 16; ++j) { const unsigned c = xb_ld(&bar[XB_XCNT(j)]); sum += c; cnt += (c > 0u) ? 1u : 0u; mine = (j == x) ? c : mine; }
        if (sum == G) break;
        __builtin_amdgcn_s_sleep(1);
        if ((++sp & 255u) == 0u) { if (xb_ld(&bar[XB_TMO])) break; if (sp > XB_SPIN_CAP) { atomicAdd(&bar[XB_TMO], 1u); break; } }
    }
    nloc = mine > 0u ? mine : 1u; nx = cnt > 0u ? cnt : 1u;
}
__device__ __forceinline__ void xcd_barrier(const XcdBarrier& b, int tid_now) {
    asm volatile("s_waitcnt vmcnt(0)" ::: "memory");
    __syncthreads();
    if (tid_now == 0) {
        unsigned* bar = b.bar;
        __builtin_amdgcn_s_waitcnt(0);
        unsigned nloc = b.st[0], nx = b.st[1];
        if (nloc == 0u) { xcd_barrier_complete(bar, b.x, nloc, nx); b.st[0] = nloc; b.st[1] = nx; }
        const unsigned old = xb_add(&bar[XB_XSUB(b.x)], 1u);
        const unsigned gen = old / nloc;
        if (old + 1u == (gen + 1u) * nloc) {
            __builtin_amdgcn_fence(__ATOMIC_RELEASE, "agent");
            asm volatile("s_waitcnt vmcnt(0)" ::: "memory");
            const unsigned og = xb_add(&bar[XB_TOP], 1u);
            const unsigned tg = og / nx;
            if (og + 1u == (tg + 1u) * nx) xb_add(&bar[XB_TOPGEN], 1u);
            else XB_SPIN(xb_ld(&bar[XB_TOPGEN]) == tg, bar);
            __builtin_amdgcn_fence(__ATOMIC_ACQUIRE, "agent");
            xb_add(&bar[XB_XGEN(b.x)], 1u);
            asm volatile("s_waitcnt vmcnt(0)" ::: "memory");
        } else {
            XB_SPIN(xb_ld(&bar[XB_XGEN(b.x)]) == gen, bar);
            __builtin_amdgcn_fence(__ATOMIC_ACQUIRE, "agent");
            asm volatile("s_waitcnt vmcnt(0)" ::: "memory");
        }
    }
    __syncthreads();
}

namespace pg8 {
constexpr int BM = 256, BK = 64, HALF = 128, HTB = HALF * BK * 2, STAGE_BYTES = 8 * HTB, NXCD = 8, WGM = 8;
__device__ __forceinline__ int lds_byte(int r, int c) { const int st = (r >> 4) * 2 + (c >> 5), rr = r & 15, cc = c & 31, ob = rr * 64 + cc * 2; return st * 1024 + (ob ^ (((ob >> 9) & 1) << 5)); }
__device__ __forceinline__ void stage_rc(int b, int& R, int& C) { const int st = b / 1024, sb = b % 1024, swz = sb ^ (((sb >> 9) & 1) << 5); R = (st >> 1) * 16 + swz / 64; C = (st & 1) * 32 + (swz % 64) / 2; }
__device__ __forceinline__ int perm32(int rho) { const int n = rho >> 4, i = rho & 15; return 8 * (i >> 2) + 4 * n + (i & 3); }
struct Unit { int pm, pn, q; };
struct Gemm { const bf16_t* A; const bf16_t* Bt; int K, lda, ldb; };

struct StaticOrder {
    static constexpr bool GATHER = false;
    int nM, nN, nwg, G, c, lda;
    __device__ void init(int M, int N, int G_, int c_, int lda_) { nM = M / BM; nN = N / BM; nwg = nM * nN; G = G_; c = c_; lda = lda_; }
    __device__ __forceinline__ bool next(int i, Unit& u) const {
        const long L = (long)i * G + c; if (L >= nwg) return false;
        int wgid = (int)L; { const int q = nwg / NXCD, r = nwg % NXCD, xcd = wgid % NXCD, off = wgid / NXCD; wgid = (xcd < r ? xcd * (q + 1) : r * (q + 1) + (xcd - r) * q) + off; }
        const int nig = WGM * nN, gid = wgid / nig, fm = gid * WGM, gsz = (nM - fm) < WGM ? (nM - fm) : WGM;
        u.pm = fm + ((wgid % nig) % gsz); u.pn = (wgid % nig) / gsz; u.q = i; return true;
    }
    __device__ __forceinline__ void aoff(const Unit& u, const int (&R)[2], const int (&C)[2], unsigned (&o)[2][2]) const {
#pragma unroll
        for (int h = 0; h < 2; ++h)
#pragma unroll
            for (int i = 0; i < 2; ++i) o[h][i] = (unsigned)((u.pm * BM + h * HALF + R[i]) * lda + C[i]) * 2u;
    }
};
template <bool GATHER_> struct TableOrder {
    static constexpr bool GATHER = GATHER_;
    const LAS int* tab; const LAS int* idx; int n, lda;
    __device__ __forceinline__ bool next(int i, Unit& u) const { if (i >= n) return false; u.pm = tab[i]; u.pn = tab[16 + i]; u.q = i; return true; }
    __device__ __forceinline__ void aoff(const Unit& u, const int (&R)[2], const int (&C)[2], unsigned (&o)[2][2]) const {
#pragma unroll
        for (int h = 0; h < 2; ++h)
#pragma unroll
            for (int i = 0; i < 2; ++i) { const int row = GATHER ? idx[u.q * 256 + h * HALF + R[i]] : (u.pm * BM + h * HALF + R[i]); o[h][i] = (unsigned)(row * lda + C[i]) * 2u; }
    }
};

template <bool O8> struct EpiBf16T {
    static constexpr bool PERM = true;
    bf16_t* O; int ldc; int pnmask;
    __device__ __forceinline__ void operator()(const f32x4 (&acc)[2][2][4][2], const Unit& u, int wr, int wc, int fr, int fq) const {
        const int row0 = u.pm * BM + wr * 64 + fr; const int col0 = (u.pn & pnmask) * BM + wc * 32 + 8 * fq;
#pragma unroll
        for (int ai = 0; ai < 2; ++ai)
#pragma unroll
            for (int m = 0; m < 4; ++m) { const size_t eoff = (size_t)(row0 + ai * HALF + m * 16) * ldc + col0;
#pragma unroll
                for (int bj = 0; bj < 2; ++bj) { const f32x4 v0 = acc[ai][bj][m][0], v1 = acc[ai][bj][m][1];
                    if constexpr (O8) { u32x2 w; w.x = pk4_fp8(v0[0] * 16.f, v0[1] * 16.f, v0[2] * 16.f, v0[3] * 16.f); w.y = pk4_fp8(v1[0] * 16.f, v1[1] * 16.f, v1[2] * 16.f, v1[3] * 16.f);
                        *(u32x2*)((unsigned char*)O + eoff + bj * HALF) = w; }
                    else { u32x4 w; w.x = cvtpk(v0[0], v0[1]); w.y = cvtpk(v0[2], v0[3]); w.z = cvtpk(v1[0], v1[1]); w.w = cvtpk(v1[2], v1[3]);
                        *(u32x4*)(O + eoff + bj * HALF) = w; } } }
    }
};
typedef EpiBf16T<false> EpiBf16;
struct EpiRowScale {
    static constexpr bool PERM = true;
    bf16_t* O; int ldc; const float* rs; int which;
    __device__ __forceinline__ void operator()(const f32x4 (&acc)[2][2][4][2], const Unit& u, int wr, int wc, int fr, int fq) const {
        const int row0 = u.pm * BM + wr * 64 + fr; const int col0 = u.pn * BM + wc * 32 + 8 * fq;
#pragma unroll
        for (int ai = 0; ai < 2; ++ai)
#pragma unroll
            for (int m = 0; m < 4; ++m) { const int row = row0 + ai * HALF + m * 16; const float s = rs[row * 2 + which]; bf16_t* rowp = O + (size_t)row * ldc + col0;
#pragma unroll
                for (int bj = 0; bj < 2; ++bj) { const f32x4 v0 = acc[ai][bj][m][0] * s, v1 = acc[ai][bj][m][1] * s;
                    u32x4 w; w.x = cvtpk(v0[0], v0[1]); w.y = cvtpk(v0[2], v0[3]); w.z = cvtpk(v1[0], v1[1]); w.w = cvtpk(v1[2], v1[3]);
                    *(u32x4*)(rowp + bj * HALF) = w; } }
    }
};
struct EpiIn {
    static constexpr bool PERM = true;
    bf16_t* H; int ldh; unsigned char* K8; unsigned char* V8; int k_lo, v_lo, v_hi;
    __device__ __forceinline__ void operator()(const f32x4 (&acc)[2][2][4][2], const Unit& u, int wr, int wc, int fr, int fq) const {
        const int row0 = u.pm * BM + wr * 64 + fr; const int cw = wc * 32 + 8 * fq;
        const bool is8 = (u.pn >= k_lo && u.pn < v_hi);
        unsigned char* b8 = (u.pn < v_lo) ? K8 + (size_t)(u.pn - k_lo) * BM : V8 + (size_t)(u.pn - v_lo) * BM;
#pragma unroll
        for (int ai = 0; ai < 2; ++ai)
#pragma unroll
            for (int m = 0; m < 4; ++m) { const size_t row = (size_t)(row0 + ai * HALF + m * 16);
#pragma unroll
                for (int bj = 0; bj < 2; ++bj) { const f32x4 v0 = acc[ai][bj][m][0], v1 = acc[ai][bj][m][1];
                    if (is8) *(u32x2*)(b8 + row * 1024 + bj * HALF + cw) = (u32x2){pk4_fp8(v0[0], v0[1], v0[2], v0[3]), pk4_fp8(v1[0], v1[1], v1[2], v1[3])};
                    else { u32x4 w; w.x = cvtpk(v0[0], v0[1]); w.y = cvtpk(v0[2], v0[3]); w.z = cvtpk(v1[0], v1[1]); w.w = cvtpk(v1[2], v1[3]);
                        *(u32x4*)(H + row * ldh + u.pn * BM + bj * HALF + cw) = w; } } }
    }
};
struct EpiKV8 {
    static constexpr bool PERM = true;
    unsigned char* K8; unsigned char* Vt8; bf16_t* KV; bool wr_bf16;
    __device__ __forceinline__ void operator()(const f32x4 (&acc)[2][2][4][2], const Unit& u, int wr, int wc, int fr, int fq) const {
        const int row0 = u.pm * BM + wr * 64 + fr; const int c0 = wc * 32 + 8 * fq;
#pragma unroll
        for (int ai = 0; ai < 2; ++ai)
#pragma unroll
            for (int m = 0; m < 4; ++m) { const int row = row0 + ai * HALF + m * 16;
                { const f32x4 v0 = acc[ai][0][m][0], v1 = acc[ai][0][m][1];
                  *(u32x2*)(K8 + (size_t)row * 1024 + u.pn * 128 + c0) = (u32x2){pk4_fp8(v0[0], v0[1], v0[2], v0[3]), pk4_fp8(v1[0], v1[1], v1[2], v1[3])}; }
                { const f32x4 v0 = acc[ai][1][m][0], v1 = acc[ai][1][m][1]; const float vv[8] = {v0[0], v0[1], v0[2], v0[3], v1[0], v1[1], v1[2], v1[3]};
                  unsigned char* vp = Vt8 + ((size_t)((row >> 12) * 8 + u.pn) * 128 + c0) * SEQ + (row & (SEQ - 1));
#pragma unroll
                  for (int e = 0; e < 8; ++e) vp[(size_t)e * SEQ] = f2fp8(vv[e]); }
                if (wr_bf16) {
#pragma unroll
                    for (int bj = 0; bj < 2; ++bj) { const f32x4 v0 = acc[ai][bj][m][0], v1 = acc[ai][bj][m][1];
                        u32x4 w; w.x = cvtpk(v0[0], v0[1]); w.y = cvtpk(v0[2], v0[3]); w.z = cvtpk(v1[0], v1[1]); w.w = cvtpk(v1[2], v1[3]);
                        *(u32x4*)(KV + (size_t)row * DM + u.pn * BM + bj * HALF + c0) = w; } } }
    }
};
template <bool O8> struct EpiSiluMul {
    static constexpr bool PERM = true;
    bf16_t* O;
    __device__ __forceinline__ void operator()(const f32x4 (&acc)[2][2][4][2], const Unit& u, int wr, int wc, int fr, int fq) const {
        const int row0 = u.pm * BM + wr * 64 + fr; const int col0 = (u.pn & 3) * HALF + wc * 32 + 8 * fq;
#pragma unroll
        for (int ai = 0; ai < 2; ++ai)
#pragma unroll
            for (int m = 0; m < 4; ++m) { const size_t eoff = (size_t)(row0 + ai * HALF + m * 16) * DE + col0; float h[8];
#pragma unroll
                for (int n = 0; n < 2; ++n)
#pragma unroll
                    for (int j = 0; j < 4; ++j) { const float g = acc[ai][0][m][n][j], up = acc[ai][1][m][n][j];
                        const float sg = g * __builtin_amdgcn_rcpf(1.0f + __builtin_amdgcn_exp2f(-g * LOG2E)); h[n * 4 + j] = sg * up; }
                if constexpr (O8) { u32x2 w; w.x = pk4_fp8(clamp8(h[0]), clamp8(h[1]), clamp8(h[2]), clamp8(h[3])); w.y = pk4_fp8(clamp8(h[4]), clamp8(h[5]), clamp8(h[6]), clamp8(h[7]));
                    *(u32x2*)((unsigned char*)O + eoff) = w; }
                else { u32x4 w; w.x = cvtpk(h[0], h[1]); w.y = cvtpk(h[2], h[3]); w.z = cvtpk(h[4], h[5]); w.w = cvtpk(h[6], h[7]);
                    *(u32x4*)(O + eoff) = w; } }
    }
};
template <bool RES_F32> struct EpiResF32 {
    static constexpr bool PERM = false;
    float* Z; const void* res;
    __device__ __forceinline__ void operator()(const f32x4 (&acc)[2][2][4][2], const Unit& u, int wr, int wc, int fr, int fq) const {
        const int row0 = u.pm * BM + wr * 64 + fr, col0 = u.pn * BM + wc * 32 + 4 * fq;
        float ALPHA = 1.4142135623730951f; asm volatile("" : "+v"(ALPHA));
#pragma unroll
        for (int ai = 0; ai < 2; ++ai)
#pragma unroll
            for (int m = 0; m < 4; ++m) { const size_t off = (size_t)(row0 + ai * HALF + m * 16) * DM + col0;
#pragma unroll
                for (int bj = 0; bj < 2; ++bj)
#pragma unroll
                    for (int n = 0; n < 2; ++n) { f32x4 o = acc[ai][bj][m][n];
                        if constexpr (RES_F32) { const f32x4 rv = *(const f32x4*)((const float*)res + off + bj * HALF + n * 16); o += ALPHA * rv; }
                        else { const u32x2 rb = *(const u32x2*)((const bf16_t*)res + off + bj * HALF + n * 16);
                            o[0] += ALPHA * bflo(rb.x); o[1] += ALPHA * bfhi(rb.x); o[2] += ALPHA * bflo(rb.y); o[3] += ALPHA * bfhi(rb.y); }
                        *(f32x4*)(Z + off + bj * HALF + n * 16) = o; } }
    }
};

template <bool F8, class Epi, class Sched>
__device__ __forceinline__ void gemm_phase(int wv, LAS unsigned char* lds, const Gemm g, const Sched& S, const Epi& E, int sW = 0x7f7f7f7f, int sX = 0x7f7f7f7f) {
    constexpr bool GA = Sched::GATHER;
    const int tid = fresh_tid(wv), wid = __builtin_amdgcn_readfirstlane(tid >> 6), lane = tid & 63, wr = wid >> 2, wc = wid & 3, fr = lane & 15, fq = lane >> 4;
    int K = g.K; asm volatile("" : "+s"(K));
    const int nt = K / BK;
    int Rr[2], Cc[2]; unsigned voffA[2], voffB[2];
#pragma unroll
    for (int i = 0; i < 2; ++i) { int R, C; stage_rc(tid * 16 + i * 8192, R, C); Rr[i] = R; Cc[i] = C; const int Rb = Epi::PERM ? ((R & ~31) + perm32(R & 31)) : R;
        voffA[i] = (unsigned)(R * g.lda + C) * 2u; voffB[i] = (unsigned)(Rb * g.ldb + C) * 2u; }
    const size_t kstep = (size_t)(BK * 2);
    const size_t hstepA = (size_t)HALF * g.lda * 2, tstepA = 2 * hstepA;
    const size_t hstepB = (size_t)HALF * g.ldb * 2, tstepB = 2 * hstepB;
    const unsigned ldsw = (unsigned)wid * 1024u;
    const int aoff = lds_byte(wr * 64 + fr, fq * 8), boff = lds_byte(wc * 32 + fr, fq * 8);
#define PG8_SA(b, h) (((b) * 2 + (h)) * HTB)
#define PG8_SB(b, h) ((4 + (b) * 2 + (h)) * HTB)
#define PG8_STAGE(bufoff, gbase, voff) do { _Pragma("unroll") for (int _i = 0; _i < 2; ++_i) \
        __builtin_amdgcn_global_load_lds((const unsigned*)((const char*)(gbase) + (voff)[_i]), (LAS unsigned*)(lds + (bufoff) + ldsw + _i * 8192), 16, 0, 0); } while (0)
#define PG8_STAGE_A(bufoff, h, pbase, koff, goffs) do { if constexpr (GA) { PG8_STAGE(bufoff, gA + (koff), (goffs)[h]); } else { PG8_STAGE(bufoff, (pbase) + (h) * hstepA, voffA); } } while (0)
#define PG8_LD32(dst, off) do { const i32x4 _lo = *(const LAS i32x4*)(lds + (off)), _hi = *(const LAS i32x4*)(lds + (off) + 1024); dst = __builtin_shufflevector(_lo, _hi, 0, 1, 2, 3, 4, 5, 6, 7); } while (0)
#define PG8_LDA(dst, b, h) do { _Pragma("unroll") for (int m = 0; m < 4; ++m) PG8_LD32(dst[m], PG8_SA(b, h) + aoff + m * 2048); } while (0)
#define PG8_LDB(dst, b, h) do { _Pragma("unroll") for (int n = 0; n < 2; ++n) PG8_LD32(dst[n], PG8_SB(b, h) + boff + n * 2048); } while (0)
#define PG8_LOH(v) __builtin_bit_cast(bf16x8, __builtin_shufflevector(v, v, 0, 1, 2, 3))
#define PG8_HIH(v) __builtin_bit_cast(bf16x8, __builtin_shufflevector(v, v, 4, 5, 6, 7))
#define PG8_MMA(ai, bj, At, Bt) do { __builtin_amdgcn_s_setprio(1); \
        if constexpr (F8) { _Pragma("unroll") for (int m = 0; m < 4; ++m) _Pragma("unroll") for (int n = 0; n < 2; ++n) \
            asm volatile("v_mfma_scale_f32_16x16x128_f8f6f4 %0, %1, %2, %0, %3, %4 op_sel_hi:[0,0,0]" : "+v"(acc[ai][bj][m][n]) : "v"(Bt[n]), "v"(At[m]), "v"(sW), "v"(sX)); } \
        else { _Pragma("unroll") for (int m = 0; m < 4; ++m) _Pragma("unroll") for (int n = 0; n < 2; ++n) { \
            acc[ai][bj][m][n] = __builtin_amdgcn_mfma_f32_16x16x32_bf16(PG8_LOH(Bt[n]), PG8_LOH(At[m]), acc[ai][bj][m][n], 0, 0, 0); \
            acc[ai][bj][m][n] = __builtin_amdgcn_mfma_f32_16x16x32_bf16(PG8_HIH(Bt[n]), PG8_HIH(At[m]), acc[ai][bj][m][n], 0, 0, 0); } } \
        __builtin_amdgcn_s_setprio(0); } while (0)
#define PG8_WAIT_V(n) asm volatile("s_waitcnt vmcnt(" #n ")" ::: "memory")
#define PG8_WAIT_L(n) asm volatile("s_waitcnt lgkmcnt(" #n ")" ::: "memory")
#define PG8_BAR __builtin_amdgcn_s_barrier()
#define PG8_SCHED __builtin_amdgcn_sched_barrier(0)
    Unit cur, nxt; int ui = 0;
    if (!S.next(0, cur)) return;
    f32x4 acc[2][2][4][2];
#pragma unroll
    for (int a = 0; a < 2; ++a)
#pragma unroll
        for (int b = 0; b < 2; ++b)
#pragma unroll
            for (int m = 0; m < 4; ++m)
#pragma unroll
                for (int n = 0; n < 2; ++n) { const float zf = fresh_zero(); acc[a][b][m][n] = (f32x4){zf, zf, zf, zf}; }
    unsigned ca[2][2];
    if constexpr (GA) S.aoff(cur, Rr, Cc, ca);
    const char* gA = (const char*)g.A;
    const char* cA = gA + (GA ? (size_t)0 : (size_t)cur.pm * tstepA);
    const char* cB = (const char*)g.Bt + (size_t)cur.pn * tstepB;
    PG8_STAGE(PG8_SB(0, 0), cB, voffB); PG8_STAGE_A(PG8_SA(0, 0), 0, cA, 0, ca); PG8_STAGE(PG8_SB(0, 1), cB + hstepB, voffB); PG8_STAGE_A(PG8_SA(0, 1), 1, cA, 0, ca);
    if (wr == 1) PG8_BAR;
    PG8_WAIT_V(4); PG8_BAR;
    PG8_STAGE(PG8_SB(1, 0), cB + kstep, voffB); PG8_STAGE_A(PG8_SA(1, 0), 0, cA + kstep, kstep, ca); PG8_STAGE(PG8_SB(1, 1), cB + hstepB + kstep, voffB);
    PG8_WAIT_V(6); PG8_BAR;
    for (;;) {
        const bool has_next = S.next(ui + 1, nxt);
        const char* nA = (!GA && has_next) ? gA + (size_t)nxt.pm * tstepA : cA;
        const char* nB = has_next ? (const char*)g.Bt + (size_t)nxt.pn * tstepB : cB;
#pragma unroll 1
        for (int t = 0; t < nt; t += 2) {
            const bool last = (t == nt - 2);
            const size_t k1 = (size_t)(t + 1) * kstep, k2 = last ? (size_t)0 : (size_t)(t + 2) * kstep, k3 = k2 + kstep;
            const char* a1 = cA + k1;
            const char* a2 = last ? nA : cA + k2; const char* b2 = last ? nB : cB + (size_t)(t + 2) * kstep;
            const char* a3 = a2 + kstep; const char* b3 = b2 + kstep;
            i32x8 At[4], B0[2], B1[2];
            unsigned xa[2][2];
            if constexpr (GA) {
                if (last && has_next) { int R2[2], C2[2]; const int t2 = fresh_tid(wv); stage_rc(t2 * 16, R2[0], C2[0]); stage_rc(t2 * 16 + 8192, R2[1], C2[1]); S.aoff(nxt, R2, C2, xa); }
                else {
#pragma unroll
                    for (int h = 0; h < 2; ++h)
#pragma unroll
                        for (int i = 0; i < 2; ++i) xa[h][i] = ca[h][i];
                }
            }
            PG8_LDB(B0, 0, 0); PG8_SCHED; PG8_LDA(At, 0, 0); PG8_STAGE_A(PG8_SA(1, 1), 1, a1, k1, ca);
            PG8_WAIT_L(8); PG8_BAR; PG8_WAIT_L(0); PG8_MMA(0, 0, At, B0); PG8_BAR; PG8_SCHED;
            PG8_LDB(B1, 0, 1); PG8_STAGE(PG8_SB(0, 0), b2, voffB);
            PG8_BAR; PG8_WAIT_L(0); PG8_MMA(0, 1, At, B1); PG8_BAR;
            PG8_LDA(At, 0, 1); PG8_STAGE_A(PG8_SA(0, 0), 0, a2, k2, xa);
            PG8_BAR; PG8_WAIT_L(0); PG8_MMA(1, 0, At, B0); PG8_BAR; PG8_SCHED;
            PG8_STAGE(PG8_SB(0, 1), b2 + hstepB, voffB);
            PG8_WAIT_V(6); PG8_BAR; PG8_MMA(1, 1, At, B1); PG8_BAR;
            PG8_LDB(B0, 1, 0); PG8_SCHED; PG8_LDA(At, 1, 0); PG8_STAGE_A(PG8_SA(0, 1), 1, a2, k2, xa);
            PG8_WAIT_L(8); PG8_BAR; PG8_WAIT_L(0); PG8_MMA(0, 0, At, B0); PG8_BAR; PG8_SCHED;
            PG8_LDB(B1, 1, 1); PG8_STAGE(PG8_SB(1, 0), b3, voffB);
            PG8_BAR; PG8_WAIT_L(0); PG8_MMA(0, 1, At, B1); PG8_BAR;
            PG8_LDA(At, 1, 1); PG8_STAGE_A(PG8_SA(1, 0), 0, a3, k3, xa);
            PG8_BAR; PG8_WAIT_L(0); PG8_MMA(1, 0, At, B0); PG8_BAR; PG8_SCHED;
            PG8_STAGE(PG8_SB(1, 1), b3 + hstepB, voffB);
            PG8_WAIT_V(6); PG8_BAR; PG8_MMA(1, 1, At, B1); PG8_BAR;
        }
        if constexpr (F8) asm volatile("s_nop 7\n\ts_nop 7\n\ts_nop 7" ::: "memory");
        { const int l2 = fresh_tid(0); E(acc, cur, wr, wc, l2 & 15, l2 >> 4); }
        if (!has_next) break;
#pragma unroll
        for (int a = 0; a < 2; ++a)
#pragma unroll
            for (int b = 0; b < 2; ++b)
#pragma unroll
                for (int m = 0; m < 4; ++m)
#pragma unroll
                    for (int n = 0; n < 2; ++n) { const float zf = fresh_zero(); acc[a][b][m][n] = (f32x4){zf, zf, zf, zf}; }
        cur = nxt; cA = nA; cB = nB; ++ui;
        if constexpr (GA) { int R2[2], C2[2]; const int t2 = fresh_tid(wv); stage_rc(t2 * 16, R2[0], C2[0]); stage_rc(t2 * 16 + 8192, R2[1], C2[1]); S.aoff(cur, R2, C2, ca); }
    }
    PG8_WAIT_V(0);
    if (wr == 0) PG8_BAR;
    PG8_BAR;
#undef PG8_SA
#undef PG8_SB
#undef PG8_STAGE
#undef PG8_STAGE_A
#undef PG8_LDA
#undef PG8_LDB
#undef PG8_MMA
#undef PG8_LD32
#undef PG8_LOH
#undef PG8_HIH
#undef PG8_WAIT_V
#undef PG8_WAIT_L
#undef PG8_BAR
#undef PG8_SCHED
}
}

namespace da {
constexpr int KVBLK = 64;
constexpr float THR = 8.f;
constexpr int SHM_V = KVBLK * 128 * 2, SHM_K = KVBLK * 128 * 2, SHM_KR = KVBLK * 64 * 2;
constexpr int OFF_V = 0, OFF_K = 2 * SHM_V, OFF_WS = OFF_K + 2 * SHM_K, OFF_KR = OFF_WS + 8 * 64 * 4, OFF_QR = OFF_KR + 2 * SHM_KR, LDS_DENSE = OFF_QR + 8 * 4096;
#define KSWZ(row, colB) ((row) * 256 + ((colB) ^ (((row) & 7) << 4)))
#define KRSWZ(row, ch) ((row) * 128 + ((((ch) ^ ((row) >> 1)) & 7) << 4))
#define SBAR() __builtin_amdgcn_sched_barrier(0)
__device__ __forceinline__ int crow(int r, int hi) { return (r & 3) + 8 * (r >> 2) + 4 * hi; }
__device__ __forceinline__ int v_st(int k, int c) { const int kk = (k & ~0xC) | ((k & 4) << 1) | ((k & 8) >> 1); return ((kk >> 3) * 4 + (c >> 5)) * 512 + ((kk & 7) * 32 + (c & 31)) * 2; }
__device__ __forceinline__ int v_rd_base(int lane) { return ((lane & 3) << 3) | (((lane >> 2) & 3) << 6) | (((lane >> 4) & 1) << 5) | (((lane >> 5) & 1) << 8); }
constexpr int v_rd_off(int d0, int ks, int half) { return d0 * 512 + ks * 4096 + half * 2048; }
template <int OFF> __device__ __forceinline__ s16x4 tr_read(int vb) {
    s16x4 r; asm volatile("ds_read_b64_tr_b16 %0, %1 offset:%2" : "=&v"(r) : "v"(vb), "i"(OFF) : "memory"); return r;
}
template <int D0> __device__ __forceinline__ void pv_one(f32x16& od, int vb, bf16x8 pa0, bf16x8 pa1, bf16x8 pa2, bf16x8 pa3) {
    const s16x4 l0 = tr_read<v_rd_off(D0, 0, 0)>(vb), h0 = tr_read<v_rd_off(D0, 0, 1)>(vb), l1 = tr_read<v_rd_off(D0, 1, 0)>(vb), h1 = tr_read<v_rd_off(D0, 1, 1)>(vb);
    const s16x4 l2 = tr_read<v_rd_off(D0, 2, 0)>(vb), h2 = tr_read<v_rd_off(D0, 2, 1)>(vb), l3 = tr_read<v_rd_off(D0, 3, 0)>(vb), h3 = tr_read<v_rd_off(D0, 3, 1)>(vb);
    asm volatile("s_waitcnt lgkmcnt(0)" ::: "memory"); SBAR();
#define PK(L, H) (bf16x8){L[0], L[1], L[2], L[3], H[0], H[1], H[2], H[3]}
    od = __builtin_amdgcn_mfma_f32_32x32x16_bf16(pa0, PK(l0, h0), od, 0, 0, 0);
    od = __builtin_amdgcn_mfma_f32_32x32x16_bf16(pa1, PK(l1, h1), od, 0, 0, 0);
    od = __builtin_amdgcn_mfma_f32_32x32x16_bf16(pa2, PK(l2, h2), od, 0, 0, 0);
    od = __builtin_amdgcn_mfma_f32_32x32x16_bf16(pa3, PK(l3, h3), od, 0, 0, 0);
}
__device__ __forceinline__ void pv_d0(f32x16* o, int vb, bf16x8 pa0, bf16x8 pa1, bf16x8 pa2, bf16x8 pa3) {
    pv_one<0>(o[0], vb, pa0, pa1, pa2, pa3); pv_one<1>(o[1], vb, pa0, pa1, pa2, pa3); pv_one<2>(o[2], vb, pa0, pa1, pa2, pa3); pv_one<3>(o[3], vb, pa0, pa1, pa2, pa3);
}
template <int D0> __device__ __forceinline__ void pv_one32(f32x16& od, int vb, bf16x8 pa0, bf16x8 pa1) {
    const s16x4 l0 = tr_read<v_rd_off(D0, 0, 0)>(vb), h0 = tr_read<v_rd_off(D0, 0, 1)>(vb), l1 = tr_read<v_rd_off(D0, 1, 0)>(vb), h1 = tr_read<v_rd_off(D0, 1, 1)>(vb);
    asm volatile("s_waitcnt lgkmcnt(0)" ::: "memory"); SBAR();
    od = __builtin_amdgcn_mfma_f32_32x32x16_bf16(pa0, PK(l0, h0), od, 0, 0, 0);
    od = __builtin_amdgcn_mfma_f32_32x32x16_bf16(pa1, PK(l1, h1), od, 0, 0, 0);
}
#undef PK
#define PK4(P, BASE, OUT) do { unsigned a0 = cvtpk(P[BASE + 0], P[BASE + 1]), a1 = cvtpk(P[BASE + 2], P[BASE + 3]);   \
    unsigned b0 = cvtpk(P[BASE + 4], P[BASE + 5]), b1 = cvtpk(P[BASE + 6], P[BASE + 7]);                              \
    auto r0 = __builtin_amdgcn_permlane32_swap(a0, b0, false, false); auto r1 = __builtin_amdgcn_permlane32_swap(a1, b1, false, false); \
    u32x4 w = {r0[0], r1[0], r0[1], r1[1]}; OUT = *reinterpret_cast<bf16x8*>(&w); } while (0)

template <int NDQ> struct Cst { static constexpr float SCALE = (NDQ == 8) ? 0.088388347648318440f : 0.072168783648703220f; static constexpr float C = SCALE * LOG2E; };

template <int NDQ>
__device__ __forceinline__ void partialSM(f32x16& p0, f32x16& p1, float& m_reg, float& mn, float& alpha) {
    constexpr float C = Cst<NDQ>::C, SCALE = Cst<NDQ>::SCALE;
    float pmax = p0[0];
#pragma unroll
    for (int r = 1; r < 16; ++r) pmax = fmaxf(pmax, p0[r]);
#pragma unroll
    for (int r = 0; r < 16; ++r) pmax = fmaxf(pmax, p1[r]);
    { auto rr = __builtin_amdgcn_permlane32_swap(__float_as_uint(pmax), __float_as_uint(pmax), false, false);
      pmax = fmaxf(__uint_as_float(rr[0]), __uint_as_float(rr[1])); }
    if (__builtin_expect(__all(pmax - m_reg <= THR / SCALE), 1)) { mn = m_reg; alpha = 1.f; }
    else { mn = fmaxf(m_reg, pmax); alpha = __builtin_amdgcn_exp2f((m_reg - mn) * C); m_reg = mn; }
    const float mnC = -mn * C;
#pragma unroll
    for (int r = 0; r < 16; ++r) p0[r] = fmaf(p0[r], C, mnC);
#pragma unroll
    for (int r = 0; r < 16; ++r) p1[r] = fmaf(p1[r], C, mnC);
#pragma unroll
    for (int r = 0; r < 16; ++r) p0[r] = __builtin_amdgcn_exp2f(p0[r]);
}
__device__ __forceinline__ void finishSM(f32x16& p0, f32x16& p1, float alpha, float& l_reg, bf16x8& pa0, bf16x8& pa1, bf16x8& pa2, bf16x8& pa3) {
#pragma unroll
    for (int r = 0; r < 16; ++r) p1[r] = __builtin_amdgcn_exp2f(p1[r]);
    float ps = 0;
#pragma unroll
    for (int r = 0; r < 16; ++r) ps += p0[r];
#pragma unroll
    for (int r = 0; r < 16; ++r) ps += p1[r];
    { auto rr = __builtin_amdgcn_permlane32_swap(__float_as_uint(ps), __float_as_uint(ps), false, false);
      ps = __uint_as_float(rr[0]) + __uint_as_float(rr[1]); }
    l_reg = l_reg * alpha + ps;
    PK4(p0, 0, pa0); PK4(p0, 8, pa1); PK4(p1, 0, pa2); PK4(p1, 8, pa3);
}
template <int NDQ>
__device__ __forceinline__ void qkt(f32x16& p0, f32x16& p1, const char* Ks, const char* Krs, const bf16x8* qr, const char* qrl, int r32, int hi) {
    p0 = f32x16{}; p1 = f32x16{};
#pragma unroll
    for (int d0 = 0; d0 < 8; ++d0) { const int cb = (d0 * 16 + hi * 8) * 2;
        bf16x8 b0 = *reinterpret_cast<const bf16x8*>(Ks + KSWZ(r32, cb));
        bf16x8 b1 = *reinterpret_cast<const bf16x8*>(Ks + KSWZ(32 + r32, cb));
        p0 = __builtin_amdgcn_mfma_f32_32x32x16_bf16(b0, qr[d0], p0, 0, 0, 0);
        p1 = __builtin_amdgcn_mfma_f32_32x32x16_bf16(b1, qr[d0], p1, 0, 0, 0); }
    if constexpr (NDQ == 12) {
#pragma unroll
        for (int d0 = 0; d0 < 4; ++d0) { const int ch = d0 * 2 + hi;
            bf16x8 b0 = *reinterpret_cast<const bf16x8*>(Krs + KRSWZ(r32, ch));
            bf16x8 b1 = *reinterpret_cast<const bf16x8*>(Krs + KRSWZ(32 + r32, ch));
            const bf16x8 qf = *reinterpret_cast<const bf16x8*>(qrl + d0 * 1024);
            p0 = __builtin_amdgcn_mfma_f32_32x32x16_bf16(b0, qf, p0, 0, 0, 0);
            p1 = __builtin_amdgcn_mfma_f32_32x32x16_bf16(b1, qf, p1, 0, 0, 0); }
    }
}

struct DArgs { const bf16_t* Q; const bf16_t* K; const bf16_t* V; const bf16_t* Kr; bf16_t* O; int ldq, ldk, ldv, ldo; int seq; int pos0; };

template <int NDQ, int SDEPTH>
__device__ __forceinline__ void attn_dense_body(int wv, const DArgs a, char* lds) {
    const int tid = fresh_tid(wv), wid = tid >> 6, lane = tid & 63, r32 = lane & 31, hi = lane >> 5;
    char* V_lds = lds + OFF_V; char* K_lds = lds + OFF_K; char* Kr_lds = lds + OFF_KR;
    float* ws = (float*)(lds + OFF_WS) + wid * 64; float* li_l = ws; float* al_l = ws + 32;
    float m_reg = -1e30f, l_reg = 0; f32x16 o[4] = {}; bf16x8 qr[8];
    char* qrl = lds + OFF_QR + wid * 4096 + lane * 16;
    const bf16_t* Qw = a.Q + (long)(wid * 32 + r32) * a.ldq + hi * 8;
#pragma unroll
    for (int d0 = 0; d0 < 8; ++d0) qr[d0] = *reinterpret_cast<const bf16x8*>(Qw + d0 * 16);
    if constexpr (NDQ == 12) {
        const float pos = (float)(a.pos0 + wid * 32 + r32);
#pragma unroll
        for (int f = 0; f < 2; ++f) {
            const bf16x8 x1v = *reinterpret_cast<const bf16x8*>(Qw + (8 + f) * 16), x2v = *reinterpret_cast<const bf16x8*>(Qw + (10 + f) * 16); bf16x8 y1v, y2v;
#pragma unroll
            for (int j = 0; j < 8; ++j) { const int i = f * 16 + hi * 8 + j; float sn, cs; sincos_rev(pos * inv_freq32(i), sn, cs);
                const float x1 = bf2f((unsigned short)x1v[j]), x2 = bf2f((unsigned short)x2v[j]);
                y1v[j] = (short)f2bf(x1 * cs - x2 * sn); y2v[j] = (short)f2bf(x2 * cs + x1 * sn); }
            *reinterpret_cast<bf16x8*>(qrl + f * 1024) = y1v; *reinterpret_cast<bf16x8*>(qrl + (2 + f) * 1024) = y2v;
        }
    }
    const int sr = tid >> 4, sc = (tid & 15) * 8, vst0 = v_st(sr, sc), vst1 = v_st(32 + sr, sc);
    const int krr = tid >> 3, krc = tid & 7;
    const int vb0 = (int)(uintptr_t)V_lds + v_rd_base(lane);
    struct { bf16x8 vs0, vs1, ks0, ks1, kr; } sr_[SDEPTH];
#define SLOAD(i, k0) do { sr_[i].vs0 = *(const bf16x8*)(a.V + (long)((k0) + sr) * a.ldv + sc); sr_[i].vs1 = *(const bf16x8*)(a.V + (long)((k0) + 32 + sr) * a.ldv + sc); \
    sr_[i].ks0 = *(const bf16x8*)(a.K + (long)((k0) + sr) * a.ldk + sc); sr_[i].ks1 = *(const bf16x8*)(a.K + (long)((k0) + 32 + sr) * a.ldk + sc); \
    if constexpr (NDQ == 12) sr_[i].kr = *(const bf16x8*)(a.Kr + (long)((k0) + krr) * 64 + krc * 8); } while (0)
#define SWRITE(b, i) do { *(bf16x8*)(V_lds + (b) * SHM_V + vst0) = sr_[i].vs0; *(bf16x8*)(V_lds + (b) * SHM_V + vst1) = sr_[i].vs1; const int kc = sc * 2; \
    *(bf16x8*)(K_lds + (b) * SHM_K + KSWZ(sr, kc)) = sr_[i].ks0; *(bf16x8*)(K_lds + (b) * SHM_K + KSWZ(32 + sr, kc)) = sr_[i].ks1; \
    if constexpr (NDQ == 12) *(bf16x8*)(Kr_lds + (b) * SHM_KR + KRSWZ(krr, krc)) = sr_[i].kr; } while (0)
#define SWAIT() do { if constexpr (SDEPTH == 2) { if constexpr (NDQ == 12) asm volatile("s_waitcnt vmcnt(5)" ::: "memory"); else asm volatile("s_waitcnt vmcnt(4)" ::: "memory"); } else asm volatile("s_waitcnt vmcnt(0)" ::: "memory"); } while (0)
#define RESC(al) do { if (__any((al) < 1.f)) { if (hi == 0) al_l[r32] = (al); asm volatile("s_waitcnt lgkmcnt(0)" ::: "memory"); \
    _Pragma("unroll") for (int d = 0; d < 4; ++d) _Pragma("unroll") for (int r = 0; r < 16; ++r) o[d][r] *= al_l[crow(r, hi)]; } } while (0)
    f32x16 pA0, pA1, pB0, pB1; float mnA, mnB, alA, alB; bf16x8 pa0, pa1, pa2, pa3; const int NT = a.seq / KVBLK;
    constexpr int SE = 0, SO = SDEPTH - 1;
    SLOAD(SE, 0); asm volatile("s_waitcnt vmcnt(0)" ::: "memory"); SWRITE(0, SE); __syncthreads();
    qkt<NDQ>(pA0, pA1, K_lds, Kr_lds, qr, qrl, r32, hi); partialSM<NDQ>(pA0, pA1, m_reg, mnA, alA);
    SLOAD(SO, KVBLK); if constexpr (SDEPTH == 2) { if (2 < NT) SLOAD(SE, 2 * KVBLK); }
    SWAIT(); SWRITE(1, SO); __syncthreads();
#pragma unroll 1
    for (int j = 1; j + 1 < NT; j += 2) {
        SBAR(); qkt<NDQ>(pB0, pB1, K_lds + SHM_K, Kr_lds + SHM_KR, qr, qrl, r32, hi);
        finishSM(pA0, pA1, alA, l_reg, pa0, pa1, pa2, pa3); SBAR();
        SLOAD(SO, (j + SDEPTH) * KVBLK); SBAR();
        pv_d0(o, vb0, pa0, pa1, pa2, pa3); partialSM<NDQ>(pB0, pB1, m_reg, mnB, alB);
        __syncthreads(); SWAIT(); SWRITE(0, SE);
        RESC(alB); __syncthreads();
        SBAR(); qkt<NDQ>(pA0, pA1, K_lds, Kr_lds, qr, qrl, r32, hi);
        finishSM(pB0, pB1, alB, l_reg, pa0, pa1, pa2, pa3); SBAR();
        if (SDEPTH == 1 || j + 3 < NT) SLOAD(SE, (j + 1 + SDEPTH) * KVBLK); SBAR();
        pv_d0(o, vb0 + (int)SHM_V, pa0, pa1, pa2, pa3); partialSM<NDQ>(pA0, pA1, m_reg, mnA, alA);
        __syncthreads(); SWAIT(); SWRITE(1, SO);
        RESC(alA); __syncthreads();
    }
    SBAR(); qkt<NDQ>(pB0, pB1, K_lds + SHM_K, Kr_lds + SHM_KR, qr, qrl, r32, hi);
    finishSM(pA0, pA1, alA, l_reg, pa0, pa1, pa2, pa3); SBAR();
    pv_d0(o, vb0, pa0, pa1, pa2, pa3); partialSM<NDQ>(pB0, pB1, m_reg, mnB, alB);
    __syncthreads(); RESC(alB);
    finishSM(pB0, pB1, alB, l_reg, pa0, pa1, pa2, pa3); SBAR();
    pv_d0(o, vb0 + (int)SHM_V, pa0, pa1, pa2, pa3);
    if (hi == 0) li_l[r32] = l_reg; asm volatile("s_waitcnt lgkmcnt(0)" ::: "memory");
    float rli[16];
#pragma unroll
    for (int r = 0; r < 16; ++r) rli[r] = __builtin_amdgcn_rcpf(li_l[crow(r, hi)]);
    bf16_t* Ow = F8_OUT ? (bf16_t*)((unsigned char*)a.O + (long)(wid * 32) * a.ldo) : a.O + (long)(wid * 32) * a.ldo;
#pragma unroll
    for (int r = 0; r < 16; ++r) { const int orow = crow(r, hi);
#pragma unroll
        for (int d0 = 0; d0 < 4; ++d0) { if constexpr (F8_OUT) ((unsigned char*)Ow)[(long)orow * a.ldo + d0 * 32 + r32] = f2fp8(o[d0][r] * rli[r] * O8_SCALE); else Ow[(long)orow * a.ldo + d0 * 32 + r32] = f2bf(o[d0][r] * rli[r]); } }
#undef SLOAD
#undef SWRITE
#undef SWAIT
#undef RESC
}

constexpr int SP_WAVE_LDS = 18688;
template <class P>
__device__ __forceinline__ void sparse_wave(P& pol, LAS unsigned char* wll, int lane) {
    const int r32 = lane & 31, hi = lane >> 5;
    char* wl = (char*)wll;
    char* Kl = wl; char* Vl = wl + 8192; float* li_l = (float*)(wl + 16384); float* al_l = li_l + 32;
    bf16x8 qr[8];
    { const bf16_t* qp = pol.qptr(r32) + hi * 8;
#pragma unroll
      for (int d0 = 0; d0 < 8; ++d0) qr[d0] = *reinterpret_cast<const bf16x8*>(qp + d0 * 16); }
    asm volatile("s_waitcnt vmcnt(0)" ::: "memory");
    f32x16 o[4] = {}; float m_reg = -1e30f, l_reg = 0.f;
    const int krow0 = lane >> 4;
    const int kce = (((lane & 15) ^ (krow0 & 7)) * 8), kco = (((lane & 15) ^ ((4 + krow0) & 7)) * 8);
    const int vk0 = 8 * ((lane >> 4) & 1) + ((lane >> 2) & 3), vc0 = 32 * (lane >> 5) + 8 * (lane & 3);
    const int vb = (int)(uintptr_t)Vl + v_rd_base(lane);
    const int nt = pol.ntiles();
    typename P::TI ti, tn;
#define SP_DMA_K(T) do { _Pragma("unroll") for (int i = 0; i < 8; ++i) { const bf16_t* src = (T).k + (long)(4 * i + krow0) * (T).rs + ((i & 1) ? kco : kce); \
        __builtin_amdgcn_global_load_lds((const unsigned*)src, (LAS unsigned*)(wll + i * 1024), 16, 0, 0); } } while (0)
#define SP_DMA_V(T) do { _Pragma("unroll") for (int i = 0; i < 8; ++i) { const bf16_t* src = (T).v + (long)(16 * (i >> 2) + 4 * ((i >> 1) & 1) + vk0) * (T).rs + 64 * (i & 1) + vc0; \
        __builtin_amdgcn_global_load_lds((const unsigned*)src, (LAS unsigned*)(wll + 8192 + i * 1024), 16, 0, 0); } } while (0)
    pol.tile(0, ti);
    SP_DMA_K(ti); SP_DMA_V(ti);
#pragma unroll 1
    for (int j = 0; j < nt; ++j) {
        const bool more = (j + 1 < nt);
        if (more) pol.tile(j + 1, tn);
        asm volatile("s_waitcnt vmcnt(8)" ::: "memory");
        f32x16 p = f32x16{};
#pragma unroll
        for (int d0 = 0; d0 < 8; ++d0) { const int cb = (d0 * 16 + hi * 8) * 2;
            bf16x8 b0 = *reinterpret_cast<const bf16x8*>(Kl + KSWZ(r32, cb));
            p = __builtin_amdgcn_mfma_f32_32x32x16_bf16(b0, qr[d0], p, 0, 0, 0); }
        asm volatile("s_waitcnt lgkmcnt(0)" ::: "memory"); SBAR();
        if (more) SP_DMA_K(tn);
        SBAR();
        float pmax = -INFINITY;
#pragma unroll
        for (int r = 0; r < 16; ++r) { p[r] = pol.adj(ti, crow(r, hi), p[r]); pmax = fmaxf(pmax, p[r]); }
        { auto rr = __builtin_amdgcn_permlane32_swap(__float_as_uint(pmax), __float_as_uint(pmax), false, false);
          pmax = fmaxf(__uint_as_float(rr[0]), __uint_as_float(rr[1])); }
        const float mn = fmaxf(m_reg, pmax); const float alpha = __builtin_amdgcn_exp2f(m_reg - mn); m_reg = mn;
        float ps = 0.f;
#pragma unroll
        for (int r = 0; r < 16; ++r) { p[r] = __builtin_amdgcn_exp2f(p[r] - mn); ps += p[r]; }
        { auto rr = __builtin_amdgcn_permlane32_swap(__float_as_uint(ps), __float_as_uint(ps), false, false);
          ps = __uint_as_float(rr[0]) + __uint_as_float(rr[1]); }
        l_reg = l_reg * alpha + ps;
        if (__any(alpha < 1.f)) { if (hi == 0) al_l[r32] = alpha; asm volatile("s_waitcnt lgkmcnt(0)" ::: "memory");
#pragma unroll
            for (int d = 0; d < 4; ++d)
#pragma unroll
                for (int r = 0; r < 16; ++r) o[d][r] *= al_l[crow(r, hi)]; }
        bf16x8 pa0, pa1; PK4(p, 0, pa0); PK4(p, 8, pa1);
        SBAR();
        if (more) asm volatile("s_waitcnt vmcnt(8)" ::: "memory"); else asm volatile("s_waitcnt vmcnt(0)" ::: "memory");
        SBAR();
        pv_one32<0>(o[0], vb, pa0, pa1); pv_one32<1>(o[1], vb, pa0, pa1); pv_one32<2>(o[2], vb, pa0, pa1); pv_one32<3>(o[3], vb, pa0, pa1);
        SBAR();
        if (more) SP_DMA_V(tn);
        SBAR();
        ti = tn;
    }
#undef SP_DMA_K
#undef SP_DMA_V
    if (hi == 0) li_l[r32] = l_reg; asm volatile("s_waitcnt lgkmcnt(0)" ::: "memory");
#pragma unroll
    for (int r = 0; r < 16; ++r) { const int qn = crow(r, hi); const float rl = __builtin_amdgcn_rcpf(li_l[qn]); bf16_t* op = pol.optr(qn);
#pragma unroll
        for (int d0 = 0; d0 < 4; ++d0) { if constexpr (F8_OUT) ((unsigned char*)op)[d0 * 32 + r32] = f2fp8(o[d0][r] * rl * O8_SCALE); else op[d0 * 32 + r32] = f2bf(o[d0][r] * rl); } }
}
#undef PK4
}

#define SBAR() __builtin_amdgcn_sched_barrier(0)
namespace d8 {
constexpr int K8_BYTES = 64 * 128, KR8_BYTES = 64 * 64, VT_PITCH = 80, VT_BYTES = 128 * VT_PITCH;
constexpr int OFF_K8 = 0, OFF_KR8 = 2 * K8_BYTES, OFF_VT = OFF_KR8 + 2 * KR8_BYTES, OFF_WS8 = OFF_VT + 2 * VT_BYTES, LDS_D8 = OFF_WS8 + 8 * 64 * 4;
constexpr float THR8 = 4.f;
#define K8SWZ(row, ch) ((row) * 128 + ((((ch) ^ ((row) >> 1)) & 7) << 4))
#define KR8SWZ(row, ch) ((row) * 64 + ((((ch) ^ ((row) >> 2)) & 3) << 4))
__device__ __forceinline__ int krow_of(int a) { const int hi = a >> 5, j = a & 31; return da::crow(j & 15, hi) + 32 * (j >> 4); }
struct D8Args { const bf16_t* Q; const unsigned char* K8; const unsigned char* Kr8; const unsigned char* Vt8; bf16_t* O; int ldq, ldk, ldvt, ldo; int seq; int pos0; };
template <int NKS> struct Cst8 { static constexpr float SCALE = (NKS == 2) ? 0.088388347648318440f : 0.072168783648703220f; static constexpr float C = SCALE * LOG2E; };
#define D8_LD32(dst, p) do { const i32x4 _lo = *(const i32x4*)(p), _hi = *(const i32x4*)((p) + 16); dst = __builtin_shufflevector(_lo, _hi, 0, 1, 2, 3, 4, 5, 6, 7); } while (0)
#define D8_MX(a, b, c) __builtin_amdgcn_mfma_scale_f32_32x32x64_f8f6f4(a, b, c, 0, 0, 0, 0x7f7f7f7f, 0, 0x7f7f7f7f)
template <int NKS>
__device__ __forceinline__ void qkt8(f32x16& p0, f32x16& p1, const char* Ks, const char* Krs, const i32x8* qf, int r32, int hi) {
    p0 = f32x16{}; p1 = f32x16{};
#pragma unroll
    for (int sK = 0; sK < 2; ++sK) { i32x8 a0, a1; const int ch = 4 * sK + 2 * hi;
        { const i32x4 lo = *(const i32x4*)(Ks + K8SWZ(r32, ch)), hh = *(const i32x4*)(Ks + K8SWZ(r32, ch + 1)); a0 = __builtin_shufflevector(lo, hh, 0, 1, 2, 3, 4, 5, 6, 7); }
        { const i32x4 lo = *(const i32x4*)(Ks + K8SWZ(32 + r32, ch)), hh = *(const i32x4*)(Ks + K8SWZ(32 + r32, ch + 1)); a1 = __builtin_shufflevector(lo, hh, 0, 1, 2, 3, 4, 5, 6, 7); }
        p0 = D8_MX(a0, qf[sK], p0); p1 = D8_MX(a1, qf[sK], p1); }
    if constexpr (NKS == 3) { i32x8 a0, a1; const int ch = 2 * hi;
        { const i32x4 lo = *(const i32x4*)(Krs + KR8SWZ(r32, ch)), hh = *(const i32x4*)(Krs + KR8SWZ(r32, ch + 1)); a0 = __builtin_shufflevector(lo, hh, 0, 1, 2, 3, 4, 5, 6, 7); }
        { const i32x4 lo = *(const i32x4*)(Krs + KR8SWZ(32 + r32, ch)), hh = *(const i32x4*)(Krs + KR8SWZ(32 + r32, ch + 1)); a1 = __builtin_shufflevector(lo, hh, 0, 1, 2, 3, 4, 5, 6, 7); }
        p0 = D8_MX(a0, qf[2], p0); p1 = D8_MX(a1, qf[2], p1); }
}
template <int NKS>
__device__ __forceinline__ void partialSM8(f32x16& p0, f32x16& p1, float& m_reg, float& mn, float& alpha) {
    constexpr float C = Cst8<NKS>::C, SCALE = Cst8<NKS>::SCALE;
    float pmax = p0[0];
#pragma unroll
    for (int r = 1; r < 16; ++r) pmax = fmaxf(pmax, p0[r]);
#pragma unroll
    for (int r = 0; r < 16; ++r) pmax = fmaxf(pmax, p1[r]);
    { auto rr = __builtin_amdgcn_permlane32_swap(__float_as_uint(pmax), __float_as_uint(pmax), false, false);
      pmax = fmaxf(__uint_as_float(rr[0]), __uint_as_float(rr[1])); }
    if (__builtin_expect(__all(pmax - m_reg <= THR8 / SCALE), 1)) { mn = m_reg; alpha = 1.f; }
    else { mn = fmaxf(m_reg, pmax); alpha = __builtin_amdgcn_exp2f((m_reg - mn) * C); m_reg = mn; }
    const float mnC = -mn * C;
#pragma unroll
    for (int r = 0; r < 16; ++r) p0[r] = fmaf(p0[r], C, mnC);
#pragma unroll
    for (int r = 0; r < 16; ++r) p1[r] = fmaf(p1[r], C, mnC);
#pragma unroll
    for (int r = 0; r < 16; ++r) p0[r] = __builtin_amdgcn_exp2f(p0[r]);
}
__device__ __forceinline__ void finishSM8(f32x16& p0, f32x16& p1, float alpha, float& l_reg, i32x8& pa) {
#pragma unroll
    for (int r = 0; r < 16; ++r) p1[r] = __builtin_amdgcn_exp2f(p1[r]);
    float ps = 0;
#pragma unroll
    for (int r = 0; r < 16; ++r) ps += p0[r];
#pragma unroll
    for (int r = 0; r < 16; ++r) ps += p1[r];
    { auto rr = __builtin_amdgcn_permlane32_swap(__float_as_uint(ps), __float_as_uint(ps), false, false);
      ps = __uint_as_float(rr[0]) + __uint_as_float(rr[1]); }
    l_reg = l_reg * alpha + ps;
    pa = (i32x8){(int)pk4_fp8(p0[0], p0[1], p0[2], p0[3]), (int)pk4_fp8(p0[4], p0[5], p0[6], p0[7]), (int)pk4_fp8(p0[8], p0[9], p0[10], p0[11]), (int)pk4_fp8(p0[12], p0[13], p0[14], p0[15]),
                 (int)pk4_fp8(p1[0], p1[1], p1[2], p1[3]), (int)pk4_fp8(p1[4], p1[5], p1[6], p1[7]), (int)pk4_fp8(p1[8], p1[9], p1[10], p1[11]), (int)pk4_fp8(p1[12], p1[13], p1[14], p1[15])};
}
__device__ __forceinline__ void pv8(f32x16* o, const char* Vt, const i32x8 pa, int r32, int hi) {
#pragma unroll
    for (int d0 = 0; d0 < 4; ++d0) { const char* vp = Vt + (32 * d0 + r32) * VT_PITCH + 32 * hi; i32x8 bfr;
        { const i32x4 lo = *(const i32x4*)vp, hh = *(const i32x4*)(vp + 16); bfr = __builtin_shufflevector(lo, hh, 0, 1, 2, 3, 4, 5, 6, 7); }
        o[d0] = D8_MX(pa, bfr, o[d0]); }
}
template <int NKS>
__device__ __forceinline__ void attn_dense8_body(int wv, const D8Args a, char* lds) {
    const int tid = fresh_tid(wv), wid = tid >> 6, lane = tid & 63, r32 = lane & 31, hi = lane >> 5;
    char* K_lds = lds + OFF_K8; char* Kr_lds = lds + OFF_KR8; char* Vt_lds = lds + OFF_VT;
    float* ws = (float*)(lds + OFF_WS8) + wid * 64; float* li_l = ws; float* al_l = ws + 32;
    float m_reg = -1e30f, l_reg = 0; f32x16 o[4] = {}; i32x8 qf[NKS];
    { const bf16_t* Qw = a.Q + (long)(wid * 32 + r32) * a.ldq;
#pragma unroll
      for (int sK = 0; sK < 2; ++sK) { const bf16_t* qp = Qw + 64 * sK + 32 * hi; unsigned w[8];
#pragma unroll
          for (int c = 0; c < 4; ++c) { const u32x4 v = *(const u32x4*)(qp + 8 * c);
              w[2 * c] = pk4_fp8(bflo(v.x), bfhi(v.x), bflo(v.y), bfhi(v.y)); w[2 * c + 1] = pk4_fp8(bflo(v.z), bfhi(v.z), bflo(v.w), bfhi(v.w)); }
          qf[sK] = (i32x8){(int)w[0], (int)w[1], (int)w[2], (int)w[3], (int)w[4], (int)w[5], (int)w[6], (int)w[7]}; }
      if constexpr (NKS == 3) {
          const float pos = (float)(a.pos0 + wid * 32 + r32); const bf16_t* qp = Qw + 128; unsigned w[8];
#pragma unroll
          for (int c = 0; c < 4; ++c) { const u32x4 v1 = *(const u32x4*)(qp + 8 * c), v2 = *(const u32x4*)(qp + 32 + 8 * c);
              const unsigned a1[4] = {v1.x, v1.y, v1.z, v1.w}, a2[4] = {v2.x, v2.y, v2.z, v2.w}; float y[8];
#pragma unroll
              for (int e = 0; e < 8; ++e) { const int i = 8 * c + e; float sn, cs; sincos_rev(pos * inv_freq32(i), sn, cs);
                  const float x1 = (e & 1) ? bfhi(a1[e >> 1]) : bflo(a1[e >> 1]), x2 = (e & 1) ? bfhi(a2[e >> 1]) : bflo(a2[e >> 1]);
                  y[e] = hi ? (x2 * cs + x1 * sn) : (x1 * cs - x2 * sn); }
              w[2 * c] = pk4_fp8(y[0], y[1], y[2], y[3]); w[2 * c + 1] = pk4_fp8(y[4], y[5], y[6], y[7]); }
          qf[2] = (i32x8){(int)w[0], (int)w[1], (int)w[2], (int)w[3], (int)w[4], (int)w[5], (int)w[6], (int)w[7]}; } }
    const int ka = tid >> 3, kch = tid & 7, kdst = K8SWZ(krow_of(ka), kch);
    const int vc = tid >> 2, vq = tid & 3, vdst = vc * VT_PITCH + vq * 16;
    const int ra = (tid >> 2) & 63, rch = tid & 3, rdst = KR8SWZ(krow_of(ra), rch);
    struct { u32x4 k, v, r; } sr_[2];
#define SLOAD8(i, k0) do { sr_[i].k = *(const u32x4*)(a.K8 + (long)((k0) + ka) * a.ldk + kch * 16); sr_[i].v = *(const u32x4*)(a.Vt8 + (long)vc * a.ldvt + (k0) + vq * 16); \
    if constexpr (NKS == 3) sr_[i].r = *(const u32x4*)(a.Kr8 + (long)((k0) + ra) * 64 + rch * 16); } while (0)
#define SWRITE8(b, i) do { *(u32x4*)(K_lds + (b) * K8_BYTES + kdst) = sr_[i].k; *(u32x4*)(Vt_lds + (b) * VT_BYTES + vdst) = sr_[i].v; \
    if constexpr (NKS == 3) *(u32x4*)(Kr_lds + (b) * KR8_BYTES + rdst) = sr_[i].r; } while (0)
#define RESC8(al) do { if (__any((al) < 1.f)) { if (hi == 0) al_l[r32] = (al); asm volatile("s_waitcnt lgkmcnt(0)" ::: "memory"); \
    _Pragma("unroll") for (int d = 0; d < 4; ++d) _Pragma("unroll") for (int r = 0; r < 16; ++r) o[d][r] *= al_l[da::crow(r, hi)]; } } while (0)
    f32x16 pA0, pA1, pB0, pB1; float mnA, mnB, alA, alB; i32x8 pa; const int NT = a.seq / 64;
    SLOAD8(0, 0); asm volatile("s_waitcnt vmcnt(0)" ::: "memory"); SWRITE8(0, 0); __syncthreads();
    qkt8<NKS>(pA0, pA1, K_lds, Kr_lds, qf, r32, hi); partialSM8<NKS>(pA0, pA1, m_reg, mnA, alA);
    SLOAD8(1, 64); if (2 < NT) SLOAD8(0, 128);
    if constexpr (NKS == 3) asm volatile("s_waitcnt vmcnt(3)" ::: "memory"); else asm volatile("s_waitcnt vmcnt(2)" ::: "memory");
    SWRITE8(1, 1); __syncthreads();
#pragma unroll 1
    for (int j = 1; j + 1 < NT; j += 2) {
        SBAR(); qkt8<NKS>(pB0, pB1, K_lds + K8_BYTES, Kr_lds + KR8_BYTES, qf, r32, hi);
        finishSM8(pA0, pA1, alA, l_reg, pa); SBAR();
        SLOAD8(1, (j + 2) * 64); SBAR();
        pv8(o, Vt_lds, pa, r32, hi); partialSM8<NKS>(pB0, pB1, m_reg, mnB, alB);
        __syncthreads(); if constexpr (NKS == 3) asm volatile("s_waitcnt vmcnt(3)" ::: "memory"); else asm volatile("s_waitcnt vmcnt(2)" ::: "memory");
        SWRITE8(0, 0);
        RESC8(alB); __syncthreads();
        SBAR(); qkt8<NKS>(pA0, pA1, K_lds, Kr_lds, qf, r32, hi);
        finishSM8(pB0, pB1, alB, l_reg, pa); SBAR();
        if (j + 3 < NT) SLOAD8(0, (j + 3) * 64); SBAR();
        pv8(o, Vt_lds + VT_BYTES, pa, r32, hi); partialSM8<NKS>(pA0, pA1, m_reg, mnA, alA);
        __syncthreads(); if constexpr (NKS == 3) asm volatile("s_waitcnt vmcnt(3)" ::: "memory"); else asm volatile("s_waitcnt vmcnt(2)" ::: "memory");
        SWRITE8(1, 1);
        RESC8(alA); __syncthreads();
    }
    SBAR(); qkt8<NKS>(pB0, pB1, K_lds + K8_BYTES, Kr_lds + KR8_BYTES, qf, r32, hi);
    finishSM8(pA0, pA1, alA, l_reg, pa); SBAR();
    pv8(o, Vt_lds, pa, r32, hi); partialSM8<NKS>(pB0, pB1, m_reg, mnB, alB);
    __syncthreads(); RESC8(alB);
    finishSM8(pB0, pB1, alB, l_reg, pa); SBAR();
    pv8(o, Vt_lds + VT_BYTES, pa, r32, hi);
    if (hi == 0) li_l[r32] = l_reg; asm volatile("s_waitcnt lgkmcnt(0)" ::: "memory");
    float rli[16];
#pragma unroll
    for (int r = 0; r < 16; ++r) rli[r] = __builtin_amdgcn_rcpf(li_l[da::crow(r, hi)]);
    bf16_t* Ow = F8_OUT ? (bf16_t*)((unsigned char*)a.O + (long)(wid * 32) * a.ldo) : a.O + (long)(wid * 32) * a.ldo;
#pragma unroll
    for (int r = 0; r < 16; ++r) { const int orow = da::crow(r, hi);
#pragma unroll
        for (int d0 = 0; d0 < 4; ++d0) { if constexpr (F8_OUT) ((unsigned char*)Ow)[(long)orow * a.ldo + d0 * 32 + r32] = f2fp8(o[d0][r] * rli[r] * O8_SCALE); else Ow[(long)orow * a.ldo + d0 * 32 + r32] = f2bf(o[d0][r] * rli[r]); } }
#undef SLOAD8
#undef SWRITE8
#undef RESC8
}
template <class P>
__device__ __forceinline__ void sparse8_wave(P& pol, LAS unsigned char* wll, int lane) {
    const int r32 = lane & 31, hi = lane >> 5;
    char* wl = (char*)wll; char* Kl = wl; char* Vl = wl + 8192; float* li_l = (float*)(wl + 16384); float* al_l = li_l + 32;
    i32x8 qf[2];
    { const bf16_t* Qw = pol.qptr(r32);
#pragma unroll
      for (int sK = 0; sK < 2; ++sK) { const bf16_t* qp = Qw + 64 * sK + 32 * hi; unsigned w[8];
#pragma unroll
          for (int c = 0; c < 4; ++c) { const u32x4 v = *(const u32x4*)(qp + 8 * c);
              w[2 * c] = pk4_fp8(bflo(v.x), bfhi(v.x), bflo(v.y), bfhi(v.y)); w[2 * c + 1] = pk4_fp8(bflo(v.z), bfhi(v.z), bflo(v.w), bfhi(v.w)); }
          qf[sK] = (i32x8){(int)w[0], (int)w[1], (int)w[2], (int)w[3], (int)w[4], (int)w[5], (int)w[6], (int)w[7]}; } }
    asm volatile("s_waitcnt vmcnt(0)" ::: "memory");
    f32x16 o[4] = {}; float m_reg = -1e30f, l_reg = 0.f;
    int ksrc[8];
#pragma unroll
    for (int i = 0; i < 8; ++i) { const int ri = 8 * i + (lane >> 3), rr = ri & 31, hk = (rr >> 2) & 1, r = (rr & 3) + 4 * (rr >> 3), a = 32 * hk + r + 16 * (ri >> 5);
        ksrc[i] = (a << 8) | ((((lane & 7) ^ (ri >> 1)) & 7) << 4); }
    const int vcol0 = lane >> 2;
    const int nt = pol.ntiles();
    typename P::TI ti, tn;
#define SP8_DMA_K(T) do { _Pragma("unroll") for (int i = 0; i < 8; ++i) { const unsigned char* src = (T).k + (long)(ksrc[i] >> 8) * (T).rs + (ksrc[i] & 255); \
        __builtin_amdgcn_global_load_lds((const unsigned*)src, (LAS unsigned*)(wll + i * 1024), 16, 0, 0); } } while (0)
#define SP8_DMA_V(T) do { _Pragma("unroll") for (int i = 0; i < 8; ++i) { const int c = 16 * i + vcol0; const unsigned char* src = (T).v + (long)c * SEQ + ((((lane & 3) ^ (c >> 2)) & 3) << 4); \
        __builtin_amdgcn_global_load_lds((const unsigned*)src, (LAS unsigned*)(wll + 8192 + i * 1024), 16, 0, 0); } } while (0)
    pol.tile(0, ti);
    SP8_DMA_K(ti); SP8_DMA_V(ti);
#pragma unroll 1
    for (int j = 0; j < nt; ++j) {
        const bool more = (j + 1 < nt);
        if (more) pol.tile(j + 1, tn);
        asm volatile("s_waitcnt vmcnt(8)" ::: "memory");
        f32x16 p0 = f32x16{}, p1 = f32x16{};
#pragma unroll
        for (int sK = 0; sK < 2; ++sK) { i32x8 a0, a1; const int ch = 4 * sK + 2 * hi;
            { const i32x4 lo = *(const i32x4*)(Kl + K8SWZ(r32, ch)), hh = *(const i32x4*)(Kl + K8SWZ(r32, ch + 1)); a0 = __builtin_shufflevector(lo, hh, 0, 1, 2, 3, 4, 5, 6, 7); }
            { const i32x4 lo = *(const i32x4*)(Kl + K8SWZ(32 + r32, ch)), hh = *(const i32x4*)(Kl + K8SWZ(32 + r32, ch + 1)); a1 = __builtin_shufflevector(lo, hh, 0, 1, 2, 3, 4, 5, 6, 7); }
            p0 = D8_MX(a0, qf[sK], p0); p1 = D8_MX(a1, qf[sK], p1); }
        asm volatile("s_waitcnt lgkmcnt(0)" ::: "memory"); SBAR();
        if (more) SP8_DMA_K(tn);
        SBAR();
        float pmax = -INFINITY;
#pragma unroll
        for (int r = 0; r < 16; ++r) { p0[r] = pol.adj(ti, 32 * hi + r, p0[r]); p1[r] = pol.adj(ti, 32 * hi + 16 + r, p1[r]); pmax = fmaxf(pmax, fmaxf(p0[r], p1[r])); }
        { auto rr = __builtin_amdgcn_permlane32_swap(__float_as_uint(pmax), __float_as_uint(pmax), false, false);
          pmax = fmaxf(__uint_as_float(rr[0]), __uint_as_float(rr[1])); }
        const float mn = fmaxf(m_reg, pmax); const float alpha = __builtin_amdgcn_exp2f(m_reg - mn); m_reg = mn;
        float ps = 0.f;
#pragma unroll
        for (int r = 0; r < 16; ++r) { p0[r] = __builtin_amdgcn_exp2f(p0[r] - mn); p1[r] = __builtin_amdgcn_exp2f(p1[r] - mn); ps += p0[r] + p1[r]; }
        { auto rr = __builtin_amdgcn_permlane32_swap(__float_as_uint(ps), __float_as_uint(ps), false, false);
          ps = __uint_as_float(rr[0]) + __uint_as_float(rr[1]); }
        l_reg = l_reg * alpha + ps;
        if (__any(alpha < 1.f)) { if (hi == 0) al_l[r32] = alpha; asm volatile("s_waitcnt lgkmcnt(0)" ::: "memory");
#pragma unroll
            for (int d = 0; d < 4; ++d)
#pragma unroll
                for (int r = 0; r < 16; ++r) o[d][r] *= al_l[da::crow(r, hi)]; }
        const i32x8 pa = (i32x8){(int)pk4_fp8(p0[0], p0[1], p0[2], p0[3]), (int)pk4_fp8(p0[4], p0[5], p0[6], p0[7]), (int)pk4_fp8(p0[8], p0[9], p0[10], p0[11]), (int)pk4_fp8(p0[12], p0[13], p0[14], p0[15]),
                                 (int)pk4_fp8(p1[0], p1[1], p1[2], p1[3]), (int)pk4_fp8(p1[4], p1[5], p1[6], p1[7]), (int)pk4_fp8(p1[8], p1[9], p1[10], p1[11]), (int)pk4_fp8(p1[12], p1[13], p1[14], p1[15])};
        SBAR();
        if (more) asm volatile("s_waitcnt vmcnt(8)" ::: "memory"); else asm volatile("s_waitcnt vmcnt(0)" ::: "memory");
        SBAR();
#pragma unroll
        for (int d0 = 0; d0 < 4; ++d0) { const int c = 32 * d0 + r32; const char* vp = Vl + c * 64; const int sw = (c >> 2) & 3; i32x8 bfr;
            { const i32x4 lo = *(const i32x4*)(vp + (((2 * hi) ^ sw) << 4)), hh = *(const i32x4*)(vp + (((2 * hi + 1) ^ sw) << 4)); bfr = __builtin_shufflevector(lo, hh, 0, 1, 2, 3, 4, 5, 6, 7); }
            o[d0] = D8_MX(pa, bfr, o[d0]); }
        asm volatile("s_waitcnt lgkmcnt(0)" ::: "memory"); SBAR();
        if (more) SP8_DMA_V(tn);
        SBAR();
        ti = tn;
    }
#undef SP8_DMA_K
#undef SP8_DMA_V
    if (hi == 0) li_l[r32] = l_reg; asm volatile("s_waitcnt lgkmcnt(0)" ::: "memory");
#pragma unroll
    for (int r = 0; r < 16; ++r) { const int qn = da::crow(r, hi); const float rl = __builtin_amdgcn_rcpf(li_l[qn]); bf16_t* op = pol.optr(qn);
#pragma unroll
        for (int d0 = 0; d0 < 4; ++d0) { if constexpr (F8_OUT) ((unsigned char*)op)[d0 * 32 + r32] = f2fp8(o[d0][r] * rl * O8_SCALE); else op[d0 * 32 + r32] = f2bf(o[d0][r] * rl); } }
}
#undef D8_LD32
#undef D8_MX
}


struct PolB {
    struct TI { const bf16_t* k; const bf16_t* v; long rs; int kpos0; int iq; float cd; };
    const bf16_t* H0; bf16_t* O; int b, h, a, r16, myn; int lo3, n3, lo2, n2, lo1, n1; float slope2;
    __device__ __forceinline__ void init(const bf16_t* H0_, bf16_t* O_, int w, int lane) {
        H0 = H0_; O = O_; b = w >> 10; h = (w >> 7) & 7; const int wu = w & 127; a = wu >> 4; r16 = wu & 15; myn = lane & 31;
        lo3 = max(a - 2, 0); n3 = min(a + 2, 7) - lo3 + 1;
        lo2 = max(4 * a - 2, 0); n2 = min(4 * a + 5, 31) - lo2 + 1;
        lo1 = max(16 * a - 2, 0); n1 = min(16 * a + 17, 127) - lo1 + 1;
        slope2 = __builtin_amdgcn_exp2f(-(float)(h + 1)) * LOG2E;
    }
    __device__ __forceinline__ const bf16_t* qptr(int n) const { return H0 + (long)(b * SEQ + 512 * a + r16 + 16 * n) * IN0 + 1536 + h * 128; }
    __device__ __forceinline__ bf16_t* optr(int qn) const { const long e = (long)(b * SEQ + 512 * a + r16 + 16 * qn) * DM + 1024 + h * 128; return F8_OUT ? (bf16_t*)((unsigned char*)O + e) : O + e; }
    __device__ __forceinline__ int ntiles() const { return n3 + n2 + n1; }
    __device__ __forceinline__ void tile(int j, TI& ti) const {
        int dil, kt, rd;
        if (j < n3) { dil = 16; kt = lo3 + j; rd = r16; }
        else if (j < n3 + n2) { dil = 4; kt = lo2 + (j - n3); rd = r16 & 3; }
        else { dil = 1; kt = lo1 + (j - n3 - n2); rd = 0; }
        const long tok = (long)b * SEQ + dil * 32 * kt + rd;
        ti.k = H0 + tok * IN0 + 2560 + h * 128; ti.v = H0 + tok * IN0 + 3584 + h * 128; ti.rs = (long)dil * IN0;
        ti.kpos0 = 32 * kt; ti.iq = (512 * a + r16 + 16 * myn - rd) / dil; ti.cd = slope2 * (float)dil;
    }
    __device__ __forceinline__ float adj(const TI& ti, int kloc, float s) const {
        const int d = ti.kpos0 + kloc - ti.iq; const int ad = d < 0 ? -d : d;
        return ad <= 64 ? fmaf(s, 0.088388347648318440f * LOG2E, -ti.cd * (float)ad) : -INFINITY;
    }
};
struct PolC {
    struct TI { const bf16_t* k; const bf16_t* v; long rs; int kc0; int drow; };
    const bf16_t* H1; bf16_t* O; const float* tab; int b, h, r, a, r0, qc, c0;
    __device__ __forceinline__ void init(const bf16_t* H1_, bf16_t* O_, const float* rpb, float* tab_, int w, int lane) {
        H1 = H1_; O = O_; tab = tab_; b = w >> 10; h = (w >> 7) & 7; const int wu = w & 127; r = wu >> 1; a = wu & 1;
        r0 = min(max(r - 4, 0), 56); qc = 32 * a + (lane & 31); c0 = min(max(qc - 8, 0), 48);
        for (int idx = lane; idx < 480; idx += 64) { const int dr = idx >> 5, dc = idx & 31; tab_[idx] = dc < 31 ? rpb[h * 465 + dr * 31 + dc] * LOG2E : 0.f; }
        asm volatile("s_waitcnt vmcnt(0) lgkmcnt(0)" ::: "memory");
    }
    __device__ __forceinline__ const bf16_t* qptr(int n) const { return H1 + (long)(b * SEQ + 64 * r + 32 * a + n) * IN1P + h * 128; }
    __device__ __forceinline__ bf16_t* optr(int qn) const { const long e = (long)(b * SEQ + 64 * r + 32 * a + qn) * DM + h * 128; return F8_OUT ? (bf16_t*)((unsigned char*)O + e) : O + e; }
    __device__ __forceinline__ int ntiles() const { return 16; }
    __device__ __forceinline__ void tile(int j, TI& ti) const {
        const int kr = r0 + (j >> 1), ch = j & 1; const long tok = (long)b * SEQ + 64 * kr + 32 * ch;
        ti.k = H1 + tok * IN1P + 1024 + h * 128; ti.v = H1 + tok * IN1P + 2048 + h * 128; ti.rs = IN1P; ti.kc0 = 32 * ch; ti.drow = kr - r + 7;
    }
    __device__ __forceinline__ float adj(const TI& ti, int kloc, float s) const {
        const int kc = ti.kc0 + kloc; const int dc = min(max(kc - qc + 15, 0), 30);
        const float bias = tab[ti.drow * 32 + dc];
        return (kc >= c0 && kc < c0 + 16) ? fmaf(s, 0.088388347648318440f * LOG2E, bias) : -INFINITY;
    }
};

struct PolB8 {
    struct TI { const unsigned char* k; const unsigned char* v; long rs; int kpos0; int iq; float cd; };
    const bf16_t* H0; bf16_t* O; const unsigned char* K8; const unsigned char* Vt1; const unsigned char* Vt4; const unsigned char* Vt16;
    int b, h, a, r16, myn; int lo3, n3, lo2, n2, lo1, n1; float slope2;
    __device__ __forceinline__ void init(const bf16_t* H0_, bf16_t* O_, const unsigned char* K8_, const unsigned char* Vt1_, const unsigned char* Vt4_, const unsigned char* Vt16_, int w, int lane) {
        H0 = H0_; O = O_; K8 = K8_; Vt1 = Vt1_; Vt4 = Vt4_; Vt16 = Vt16_; b = w >> 10; h = (w >> 7) & 7; const int wu = w & 127; a = wu >> 4; r16 = wu & 15; myn = lane & 31;
        const int t = a >> 1; lo3 = max(t - 1, 0); n3 = min(t + 1, 3) - lo3 + 1;
        lo2 = max(2 * a - 1, 0); n2 = min(2 * a + 2, 15) - lo2 + 1;
        lo1 = max(8 * a - 1, 0); n1 = min(8 * a + 8, 63) - lo1 + 1;
        slope2 = __builtin_amdgcn_exp2f(-(float)(h + 1)) * LOG2E;
    }
    __device__ __forceinline__ const bf16_t* qptr(int n) const { return H0 + (long)(b * SEQ + 512 * a + r16 + 16 * n) * IN0 + 1536 + h * 128; }
    __device__ __forceinline__ bf16_t* optr(int qn) const { const long e = (long)(b * SEQ + 512 * a + r16 + 16 * qn) * DM + 1024 + h * 128; return F8_OUT ? (bf16_t*)((unsigned char*)O + e) : O + e; }
    __device__ __forceinline__ int ntiles() const { return n3 + n2 + n1; }
    __device__ __forceinline__ void tile(int j, TI& ti) const {
        int dil, kt, rd; const unsigned char* vt; int voff;
        if (j < n3) { dil = 16; kt = lo3 + j; rd = r16; vt = Vt16; voff = r16 * 256 + 64 * kt; }
        else if (j < n3 + n2) { dil = 4; kt = lo2 + (j - n3); rd = r16 & 3; vt = Vt4; voff = rd * 1024 + 64 * kt; }
        else { dil = 1; kt = lo1 + (j - n3 - n2); rd = 0; vt = Vt1; voff = 64 * kt; }
        const long tok = (long)b * SEQ + dil * 64 * kt + rd;
        ti.k = K8 + tok * 1024 + h * 128; ti.rs = (long)dil * 1024; ti.v = vt + (long)(b * 8 + h) * 128 * SEQ + voff;
        ti.kpos0 = 64 * kt; ti.iq = (512 * a + r16 + 16 * myn - rd) / dil; ti.cd = slope2 * (float)dil;
    }
    __device__ __forceinline__ float adj(const TI& ti, int kidx, float s) const {
        const int d = ti.kpos0 + kidx - ti.iq; const int ad = d < 0 ? -d : d;
        return ad <= 64 ? fmaf(s, 0.088388347648318440f * LOG2E, -ti.cd * (float)ad) : -INFINITY;
    }
};
struct PolC8 {
    struct TI { const unsigned char* k; const unsigned char* v; long rs; int drow; };
    const bf16_t* H1; bf16_t* O; const unsigned char* K8; const unsigned char* Vt; const float* tab; int b, h, r, a, r0, qc, c0;
    __device__ __forceinline__ void init(const bf16_t* H1_, bf16_t* O_, const unsigned char* K8_, const unsigned char* Vt_, const float* rpb, float* tab_, int w, int lane) {
        H1 = H1_; O = O_; K8 = K8_; Vt = Vt_; tab = tab_; b = w >> 10; h = (w >> 7) & 7; const int wu = w & 127; r = wu >> 1; a = wu & 1;
        r0 = min(max(r - 4, 0), 56); qc = 32 * a + (lane & 31); c0 = min(max(qc - 8, 0), 48);
        for (int idx = lane; idx < 480; idx += 64) { const int dr = idx >> 5, dc = idx & 31; tab_[idx] = dc < 31 ? rpb[h * 465 + dr * 31 + dc] * LOG2E : 0.f; }
        asm volatile("s_waitcnt vmcnt(0) lgkmcnt(0)" ::: "memory");
    }
    __device__ __forceinline__ const bf16_t* qptr(int n) const { return H1 + (long)(b * SEQ + 64 * r + 32 * a + n) * IN1P + h * 128; }
    __device__ __forceinline__ bf16_t* optr(int qn) const { const long e = (long)(b * SEQ + 64 * r + 32 * a + qn) * DM + h * 128; return F8_OUT ? (bf16_t*)((unsigned char*)O + e) : O + e; }
    __device__ __forceinline__ int ntiles() const { return 8; }
    __device__ __forceinline__ void tile(int j, TI& ti) const {
        const int kr = r0 + j; const long tok = (long)b * SEQ + 64 * kr;
        ti.k = K8 + tok * 1024 + h * 128; ti.rs = 1024; ti.v = Vt + (long)(b * 8 + h) * 128 * SEQ + 64 * kr; ti.drow = kr - r + 7;
    }
    __device__ __forceinline__ float adj(const TI& ti, int kc, float s) const {
        const int dc = min(max(kc - qc + 15, 0), 30);
        const float bias = tab[ti.drow * 32 + dc];
        return (kc >= c0 && kc < c0 + 16) ? fmaf(s, 0.088388347648318440f * LOG2E, bias) : -INFINITY;
    }
};

struct Params { const float* in[28]; float* out; unsigned char* ws; int ph_lo, ph_hi; };
enum { I_X = 0, I_RW = 1, I_RB = 2, I_WIN0 = 3, I_AQN = 4, I_AKN = 5, I_WOUT0 = 6, I_LN1G0 = 7, I_LN1B0 = 8, I_WG0 = 9, I_WU0 = 10, I_WD0 = 11, I_LN2G0 = 12, I_LN2B0 = 13,
       I_WIN1 = 14, I_RPB = 15, I_DQN = 16, I_WQUP = 17, I_DKVN = 18, I_WKVUP = 19, I_WOUT1 = 20, I_LN1G1 = 21, I_LN1B1 = 22, I_WG1 = 23, I_WU1 = 24, I_WD1 = 25, I_LN2G1 = 26, I_LN2B1 = 27 };

__device__ __forceinline__ void tr_tile(const float* __restrict__ src, int N, const float* __restrict__ ksc, bf16_t* __restrict__ dst, int ldd, int k0, int n0, int drow0, LAS unsigned* tl, int tid) {
    const int c4 = (tid & 15) * 4;
#pragma unroll
    for (int i = 0; i < 2; ++i) {
        const int kp = (tid >> 4) + 32 * i;
        const float* s0 = src + (size_t)(k0 + 2 * kp) * N + n0 + c4;
        f32x4 a = *(const f32x4*)s0, b = *(const f32x4*)(s0 + N);
        if (ksc) { const float sa = ksc[k0 + 2 * kp], sb = ksc[k0 + 2 * kp + 1]; a *= sa; b *= sb; }
#pragma unroll
        for (int j = 0; j < 4; ++j) tl[(c4 + j) * 65 + kp] = cvtpk(a[j], b[j]);
    }
    __syncthreads();
    const int n = tid >> 3, seg = tid & 7;
    unsigned w[8];
#pragma unroll
    for (int q = 0; q < 8; ++q) w[q] = tl[n * 65 + seg * 8 + q];
    u32x4* d = (u32x4*)(dst + (size_t)(drow0 + n) * ldd + k0 + seg * 16);
    d[0] = (u32x4){w[0], w[1], w[2], w[3]}; d[1] = (u32x4){w[4], w[5], w[6], w[7]};
    __syncthreads();
}
__device__ __forceinline__ void tr_tile8(const float* __restrict__ src, int N, const float* __restrict__ ksc, float wscale, unsigned char* __restrict__ dst, int ldd, int k0, int n0, int drow0, LAS unsigned* tl, int tid) {
    const int c4 = (tid & 15) * 4, kq = tid >> 4;
    const float* s0 = src + (size_t)(k0 + 4 * kq) * N + n0 + c4;
    f32x4 a = *(const f32x4*)s0, b = *(const f32x4*)(s0 + N), c = *(const f32x4*)(s0 + 2 * (size_t)N), d = *(const f32x4*)(s0 + 3 * (size_t)N);
    float sa = wscale, sb = wscale, sc = wscale, sd = wscale;
    if (ksc) { sa *= ksc[k0 + 4 * kq]; sb *= ksc[k0 + 4 * kq + 1]; sc *= ksc[k0 + 4 * kq + 2]; sd *= ksc[k0 + 4 * kq + 3]; }
#pragma unroll
    for (int j = 0; j < 4; ++j) tl[(c4 + j) * 33 + kq] = pk4_fp8(a[j] * sa, b[j] * sb, c[j] * sc, d[j] * sd);
    __syncthreads();
    const int n = tid >> 3, seg = tid & 7;
    unsigned w[4];
#pragma unroll
    for (int q = 0; q < 4; ++q) w[q] = tl[n * 33 + seg * 4 + q];
    *(u32x4*)(dst + (size_t)(drow0 + n) * ldd + k0 + seg * 16) = (u32x4){w[0], w[1], w[2], w[3]};
    __syncthreads();
}
struct TJob { const float* src; bf16_t* dst; const float* ksc; int K, N, ldd, gu; size_t sbs, dbs; int f8; };
constexpr float W8_SCALE = 64.f;
constexpr int W8_SBYTE = 0x79797979;
__device__ __forceinline__ void run_tjob(const TJob& jb, int t, LAS unsigned* tl, int tid) {
    const int ntn = jb.N / 64, ntk = jb.K / 128, per = ntn * ntk;
    const int bi = t / per, r = t % per, tk = r / ntn, tn = r % ntn;
    const int n0 = tn * 64;
    const int drow0 = jb.gu ? (256 * (n0 >> 7) + (jb.gu == 2 ? 128 : 0) + (n0 & 127)) : n0;
    if (jb.f8) tr_tile8(jb.src + (size_t)bi * jb.sbs, jb.N, jb.ksc, W8_SCALE, (unsigned char*)jb.dst + (size_t)bi * jb.dbs, jb.ldd, tk * 128, n0, drow0, tl, tid);
    else tr_tile(jb.src + (size_t)bi * jb.sbs, jb.N, jb.ksc, jb.dst + (size_t)bi * jb.dbs, jb.ldd, tk * 128, n0, drow0, tl, tid);
}
typedef __attribute__((address_space(4))) const unsigned long long kcu64_t;
#define PIN(i) ((const float*)(__attribute__((address_space(1))) const float*)ka[i])
__device__ __forceinline__ void phase_prologue(kcu64_t* ka, unsigned char* ws, LAS unsigned char* lds, int G, int bid, int tid) {
    LAS unsigned* tl = (LAS unsigned*)lds;
    constexpr int NJ = 12;
    const int cnts[NJ] = {16 * 72, 16 * 32, 4096, 4096, 4096, 16 * 61, 16 * 32, 4096, 4096, 4096, 4 * 24, 2 * 32};
    int total = 0;
#pragma unroll
    for (int j = 0; j < NJ; ++j) total += cnts[j];
    for (int t = bid; t < total; t += G) {
        int j = 0, base = 0;
#pragma unroll
        for (int q = 0; q < NJ - 1; ++q) if (t >= base + cnts[q] && j == q) { base += cnts[q]; j = q + 1; }
        const int tt = t - base;
        TJob jb;
        switch (j) {
            case 0: jb = TJob{PIN(I_WIN0), (bf16_t*)(ws + WS_WIN0), nullptr, 2048, IN0, 2048, 0, 0, 0, F8_IN}; break;
            case 1: jb = TJob{PIN(I_WOUT0), (bf16_t*)(ws + WS_WOUT0), nullptr, 2048, 2048, 2048, 0, 0, 0, F8_OUT}; break;
            case 2: jb = TJob{PIN(I_WG0), (bf16_t*)(ws + WS_WGU0), nullptr, 2048, 512, 2048, 1, (size_t)2048 * 512, (size_t)1024 * 2048, F8_GU}; break;
            case 3: jb = TJob{PIN(I_WU0), (bf16_t*)(ws + WS_WGU0), nullptr, 2048, 512, 2048, 2, (size_t)2048 * 512, (size_t)1024 * 2048, F8_GU}; break;
            case 4: jb = TJob{PIN(I_WD0), (bf16_t*)(ws + WS_WD0), nullptr, 512, 2048, 512, 0, (size_t)512 * 2048, (size_t)2048 * 512, F8_DOWN}; break;
            case 5: jb = TJob{PIN(I_WIN1), (bf16_t*)(ws + WS_WIN1), nullptr, 2048, IN1, 2048, 0, 0, 0, F8_IN}; break;
            case 6: jb = TJob{PIN(I_WOUT1), (bf16_t*)(ws + WS_WOUT1), nullptr, 2048, 2048, 2048, 0, 0, 0, F8_OUT}; break;
            case 7: jb = TJob{PIN(I_WG1), (bf16_t*)(ws + WS_WGU1), nullptr, 2048, 512, 2048, 1, (size_t)2048 * 512, (size_t)1024 * 2048, F8_GU}; break;
            case 8: jb = TJob{PIN(I_WU1), (bf16_t*)(ws + WS_WGU1), nullptr, 2048, 512, 2048, 2, (size_t)2048 * 512, (size_t)1024 * 2048, F8_GU}; break;
            case 9: jb = TJob{PIN(I_WD1), (bf16_t*)(ws + WS_WD1), nullptr, 512, 2048, 512, 0, (size_t)512 * 2048, (size_t)2048 * 512, F8_DOWN}; break;
            case 10: jb = TJob{PIN(I_WQUP), (bf16_t*)(ws + WS_WQUP), PIN(I_DQN), 512, 1536, 512, 0, 0, 0, 0}; break;
            default: jb = TJob{PIN(I_WKVUP), (bf16_t*)(ws + WS_WKVUP), PIN(I_DKVN), 256, 2048, 256, 0, 0, 0, 0}; break;
        }
        run_tjob(jb, tt, tl, tid);
    }
    { constexpr size_t ESZ = F8_IN ? 1 : 2;
      u32x4* z = (u32x4*)(ws + WS_WIN1 + (size_t)IN1 * 2048 * ESZ); const size_t n16 = (size_t)(IN1P - IN1) * 2048 * ESZ / 16;
      const unsigned zu = __float_as_uint(fresh_zero());
      for (size_t i = (size_t)bid * NTHR + tid; i < n16; i += (size_t)G * NTHR) z[i] = (u32x4){zu, zu, zu, zu}; }
    { const f32x8* xs = (const f32x8*)PIN(I_X); const size_t n8 = (size_t)T_ * DM / 8;
      if constexpr (F8_IN) { u32x2* xd = (u32x2*)(ws + WS_RC + 64 * MiB);
          for (size_t i = (size_t)bid * NTHR + tid; i < n8; i += (size_t)G * NTHR) { const f32x8 v = xs[i]; xd[i] = (u32x2){pk4_fp8(v[0], v[1], v[2], v[3]), pk4_fp8(v[4], v[5], v[6], v[7])}; } }
      else { u32x4* xd = (u32x4*)(ws + WS_RA);
          for (size_t i = (size_t)bid * NTHR + tid; i < n8; i += (size_t)G * NTHR) { const f32x8 v = xs[i];
              xd[i] = (u32x4){cvtpk(v[0], v[1]), cvtpk(v[2], v[3]), cvtpk(v[4], v[5]), cvtpk(v[6], v[7])}; } } }
}

template <int X> __device__ __forceinline__ float swzf(float v) { return __int_as_float(__builtin_amdgcn_ds_swizzle(__float_as_int(v), (X << 10) | 0x1f)); }
template <int X> __device__ __forceinline__ unsigned swzu(unsigned v) { return (unsigned)__builtin_amdgcn_ds_swizzle((int)v, (X << 10) | 0x1f); }
__device__ __forceinline__ void phase_prep_qk(bf16_t* H0, const float* qn, const float* kn, unsigned char* K8, int G, int bid, int tid) {
    const int wid = __builtin_amdgcn_readfirstlane(tid >> 6), lane = tid & 63;
    const int cch = lane & 15, half = cch >> 3, ci = cch & 7; const bool isx2 = ci >= 4;
    float gqo[8], gqp[8], gko[8], gkp[8], invf[8];
#pragma unroll
    for (int j = 0; j < 8; ++j) { gqo[j] = qn[8 * cch + j]; gqp[j] = qn[8 * (cch ^ 4) + j]; gko[j] = kn[8 * cch + j]; gkp[j] = kn[8 * (cch ^ 4) + j]; invf[j] = inv_freq32(8 * (ci & 3) + j); }
    for (int m = bid * 8 + wid; m < T_; m += G * 8) {
        const int sq = m & (SEQ - 1); const float pos = (float)(half ? (sq & 63) : (sq >> 6));
        float sn[8], cs[8];
#pragma unroll
        for (int j = 0; j < 8; ++j) sincos_rev(pos * invf[j], sn[j], cs[j]);
        bf16_t* rowp = H0 + (size_t)m * IN0;
#pragma unroll
        for (int p = 0; p < 3; ++p) {
            if (p < 2 || lane < 32) {
                const int hh = 4 * p + (lane >> 4); const bool isq = hh < 8;
                bf16_t* cp = rowp + (isq ? hh * 128 : 1024 + (hh - 8) * 128) + 8 * cch;
                const u32x4 raw = *(const u32x4*)cp;
                const unsigned rw4[4] = {raw.x, raw.y, raw.z, raw.w}; float x[8], xp[8]; float ss = 0.f;
#pragma unroll
                for (int q = 0; q < 4; ++q) { x[2 * q] = bflo(rw4[q]); x[2 * q + 1] = bfhi(rw4[q]); ss += x[2 * q] * x[2 * q] + x[2 * q + 1] * x[2 * q + 1];
                    const unsigned pw = swzu<4>(rw4[q]); xp[2 * q] = bflo(pw); xp[2 * q + 1] = bfhi(pw); }
                ss += swzf<1>(ss); ss += swzf<2>(ss); ss += swzf<4>(ss); ss += swzf<8>(ss);
                const float r = rsqrtf(ss * (1.0f / 128.0f) + 1e-6f);
                float o[8];
#pragma unroll
                for (int j = 0; j < 8; ++j) { const float yo = x[j] * r * (isq ? gqo[j] : gko[j]), yp = xp[j] * r * (isq ? gqp[j] : gkp[j]);
                    o[j] = isx2 ? (yo * cs[j] + yp * sn[j]) : (yo * cs[j] - yp * sn[j]); }
                *(u32x4*)cp = (u32x4){cvtpk(o[0], o[1]), cvtpk(o[2], o[3]), cvtpk(o[4], o[5]), cvtpk(o[6], o[7])};
                if (F8_ATTA && !isq) *(u32x2*)(K8 + (size_t)m * 256 + (hh - 8) * 128 + 8 * cch) = (u32x2){pk4_fp8(o[0], o[1], o[2], o[3]), pk4_fp8(o[4], o[5], o[6], o[7])};
            }
        }
    }
}
__device__ __forceinline__ void phase_vt8(const bf16_t* H0, unsigned char* Vt8, LAS unsigned char* lds, int G, int bid, int tid) {
    const int t = tid >> 3, seg = tid & 7, c = tid >> 2, part = tid & 3;
    for (int u = bid; u < 1024; u += G) {
        const int b = u >> 7, kvh = (u >> 6) & 1, ch = u & 63;
        const bf16_t* src = H0 + (size_t)(b * SEQ + ch * 64 + t) * IN0 + 1280 + kvh * 128 + seg * 16;
        const u32x4 v0 = *(const u32x4*)src, v1 = *(const u32x4*)(src + 8);
        const unsigned w[8] = {v0.x, v0.y, v0.z, v0.w, v1.x, v1.y, v1.z, v1.w};
        __syncthreads();
#pragma unroll
        for (int j = 0; j < 8; ++j) { lds[(16 * seg + 2 * j) * 80 + t] = f2fp8(bflo(w[j])); lds[(16 * seg + 2 * j + 1) * 80 + t] = f2fp8(bfhi(w[j])); }
        __syncthreads();
        const u32x4 o = *(const LAS u32x4*)(lds + c * 80 + part * 16);
        *(u32x4*)(Vt8 + ((size_t)(b * 2 + kvh) * 128 + c) * SEQ + ch * 64 + part * 16) = o;
    }
    __syncthreads();
}
__device__ __forceinline__ void phase_k8_copy(const bf16_t* H, int ldh, int col0, unsigned char* K8, int G, int bid, int tid) {
    for (size_t i = (size_t)bid * NTHR + tid; i < (size_t)T_ * 128; i += (size_t)G * NTHR) { const size_t m = i >> 7; const int c = (int)(i & 127) * 8;
        const u32x4 v = *(const u32x4*)(H + m * ldh + col0 + c);
        *(u32x2*)(K8 + m * 1024 + c) = (u32x2){pk4_fp8(bflo(v.x), bfhi(v.x), bflo(v.y), bfhi(v.y)), pk4_fp8(bflo(v.z), bfhi(v.z), bflo(v.w), bfhi(v.w))}; }
}
__device__ __forceinline__ void tr4x4(unsigned w0, unsigned w1, unsigned w2, unsigned w3, unsigned (&o)[4]) {
    const unsigned a_lo = __builtin_amdgcn_perm(w1, w0, 0x05010400u), a_hi = __builtin_amdgcn_perm(w1, w0, 0x07030602u);
    const unsigned b_lo = __builtin_amdgcn_perm(w3, w2, 0x05010400u), b_hi = __builtin_amdgcn_perm(w3, w2, 0x07030602u);
    o[0] = __builtin_amdgcn_perm(b_lo, a_lo, 0x05040100u); o[1] = __builtin_amdgcn_perm(b_lo, a_lo, 0x07060302u);
    o[2] = __builtin_amdgcn_perm(b_hi, a_hi, 0x05040100u); o[3] = __builtin_amdgcn_perm(b_hi, a_hi, 0x07060302u);
}
template <bool DIL>
__device__ __forceinline__ void phase_vt_heads(const unsigned char* V8, unsigned char* Vt1, unsigned char* Vt4, unsigned char* Vt16, LAS unsigned char* lds, int G, int bid, int tid) {
    constexpr int PITCH = 272, IMG = 128 * PITCH;
    const int cb = tid & 31, tq = tid >> 5;
    for (int u = bid; u < 1024; u += G) {
        const int b = u >> 7, h = (u >> 4) & 7, ch = u & 15;
        const unsigned char* src = V8 + (size_t)(b * SEQ + 256 * ch) * 1024 + h * 128 + 4 * cb;
        __syncthreads();
#pragma unroll
        for (int k = 0; k < 4; ++k) { const int tg = tq + 16 * k;
            unsigned o[4];
            { const int t0 = 4 * tg;
              tr4x4(*(const unsigned*)(src + (size_t)(t0 + 0) * 1024), *(const unsigned*)(src + (size_t)(t0 + 1) * 1024), *(const unsigned*)(src + (size_t)(t0 + 2) * 1024), *(const unsigned*)(src + (size_t)(t0 + 3) * 1024), o);
#pragma unroll
              for (int j = 0; j < 4; ++j) *(LAS unsigned*)(lds + (4 * cb + j) * PITCH + 4 * tg) = o[j]; }
            if constexpr (DIL) {
                { const int r = tg & 3, g = tg >> 2; const int t0 = r + 16 * g;
                  tr4x4(*(const unsigned*)(src + (size_t)(t0 + 0) * 1024), *(const unsigned*)(src + (size_t)(t0 + 4) * 1024), *(const unsigned*)(src + (size_t)(t0 + 8) * 1024), *(const unsigned*)(src + (size_t)(t0 + 12) * 1024), o);
#pragma unroll
                  for (int j = 0; j < 4; ++j) *(LAS unsigned*)(lds + IMG + (4 * cb + j) * PITCH + r * 64 + 4 * g) = o[j]; }
                { const int cls = tg & 15, g = tg >> 4; const int t0 = cls + 64 * g;
                  tr4x4(*(const unsigned*)(src + (size_t)(t0 + 0) * 1024), *(const unsigned*)(src + (size_t)(t0 + 16) * 1024), *(const unsigned*)(src + (size_t)(t0 + 32) * 1024), *(const unsigned*)(src + (size_t)(t0 + 48) * 1024), o);
#pragma unroll
                  for (int j = 0; j < 4; ++j) *(LAS unsigned*)(lds + 2 * IMG + (4 * cb + j) * PITCH + cls * 16 + 4 * g) = o[j]; }
            }
        }
        __syncthreads();
        const size_t cbase = (size_t)(b * 8 + h) * 128;
#pragma unroll
        for (int k = 0; k < 4; ++k) { const int id = tid + NTHR * k, col = id >> 4, pc = id & 15;
            *(u32x4*)(Vt1 + (cbase + col) * SEQ + 256 * ch + pc * 16) = *(const LAS u32x4*)(lds + col * PITCH + pc * 16);
            if constexpr (DIL) {
                *(u32x4*)(Vt4 + (cbase + col) * SEQ + (pc >> 2) * 1024 + 64 * ch + (pc & 3) * 16) = *(const LAS u32x4*)(lds + IMG + col * PITCH + pc * 16);
                *(u32x4*)(Vt16 + (cbase + col) * SEQ + pc * 256 + 16 * ch) = *(const LAS u32x4*)(lds + 2 * IMG + col * PITCH + pc * 16); } }
    }
    __syncthreads();
}
__device__ __forceinline__ void phase_prep_mla(bf16_t* H1, bf16_t* krope, unsigned char* kr8, int G, int bid, int tid) {
    const int wid = __builtin_amdgcn_readfirstlane(tid >> 6), lane = tid & 63;
    const float invf = inv_freq32(lane & 31);
    for (int m = bid * 8 + wid; m < T_; m += G * 8) {
        bf16_t* rowp = H1 + (size_t)m * IN1P;
        const u32x4 a = *(const u32x4*)(rowp + 3072 + lane * 8);
        float ss = bflo(a.x) * bflo(a.x) + bfhi(a.x) * bfhi(a.x) + bflo(a.y) * bflo(a.y) + bfhi(a.y) * bfhi(a.y) + bflo(a.z) * bflo(a.z) + bfhi(a.z) * bfhi(a.z) + bflo(a.w) * bflo(a.w) + bfhi(a.w) * bfhi(a.w);
        ss = wave_sum(ss);
        const u32x2 c = *(const u32x2*)(rowp + 3584 + lane * 4);
        float s2 = bflo(c.x) * bflo(c.x) + bfhi(c.x) * bfhi(c.x) + bflo(c.y) * bflo(c.y) + bfhi(c.y) * bfhi(c.y);
        s2 = wave_sum(s2);
        const float rq = rsqrtf(ss * (1.0f / 512.0f) + 1e-6f), rkv = rsqrtf(s2 * (1.0f / 256.0f) + 1e-6f);
        *(u32x4*)(rowp + 3072 + lane * 8) = (u32x4){cvtpk(bflo(a.x) * rq, bfhi(a.x) * rq), cvtpk(bflo(a.y) * rq, bfhi(a.y) * rq), cvtpk(bflo(a.z) * rq, bfhi(a.z) * rq), cvtpk(bflo(a.w) * rq, bfhi(a.w) * rq)};
        *(u32x2*)(rowp + 3584 + lane * 4) = (u32x2){cvtpk(bflo(c.x) * rkv, bfhi(c.x) * rkv), cvtpk(bflo(c.y) * rkv, bfhi(c.y) * rkv)};
        if (lane < 32) { const float x1 = bf2f(rowp[3840 + lane]), x2 = bf2f(rowp[3840 + 32 + lane]);
            float sn, cs; sincos_rev((float)(m & (SEQ - 1)) * invf, sn, cs);
            const float o1 = x1 * cs - x2 * sn, o2 = x2 * cs + x1 * sn;
            krope[(size_t)m * 64 + lane] = f2bf(o1); krope[(size_t)m * 64 + 32 + lane] = f2bf(o2);
            if (F8_ATTD) { kr8[(size_t)m * 64 + lane] = f2fp8(o1); kr8[(size_t)m * 64 + 32 + lane] = f2fp8(o2); } }
    }
}

constexpr int LNR_PITCH = 2052;
constexpr int LNR_PART = 131584, LNR_SC = 147968, LNR_SEL = 150016, LNR_BLE = 152064, LNR_HIST = 153088;
template <bool RES_F32>
__device__ __forceinline__ void phase_ln_router(const bf16_t* mix, const void* res, const float* g, const float* bb, const float* rw, const float* rb, bf16_t* x1b, unsigned char* x1q,
                                                int* tok_e, int* tok_p, float* tok_g, int* list, unsigned* cnt, LAS unsigned char* lds, int G, int bid, int tid, bool commit = true) {
    const int wid = __builtin_amdgcn_readfirstlane(tid >> 6), lane = tid & 63;
    float ALPHA = 1.4142135623730951f; asm volatile("" : "+v"(ALPHA));
    LAS float* xs = (LAS float*)lds; LAS float* part = (LAS float*)(lds + LNR_PART); LAS float* scs = (LAS float*)(lds + LNR_SC); LAS float* sels = (LAS float*)(lds + LNR_SEL);
    LAS int* ble = (LAS int*)(lds + LNR_BLE); LAS int* hist = (LAS int*)(lds + LNR_HIST);
    f16x8 bw[8][2];
    { const float* rwp = rw + (size_t)(256 * wid + 8 * (lane >> 4)) * 32 + (lane & 15);
#pragma unroll
      for (int ks = 0; ks < 8; ++ks)
#pragma unroll
        for (int hf = 0; hf < 2; ++hf)
#pragma unroll
          for (int j = 0; j < 8; ++j) bw[ks][hf][j] = (_Float16)rwp[(32 * ks + j) * 32 + 16 * hf]; }
    typedef typename std::conditional<RES_F32, f32x4, u32x2>::type res_t;
    u32x2 mv[2][8]; res_t rv[2][8];
#define LNR_LOAD(tix_, rr) do { const size_t eo = ((size_t)(tix_) * 16 + 2 * wid + (rr)) * DM + 4 * lane; \
        _Pragma("unroll") for (int i = 0; i < 8; ++i) { mv[rr][i] = *(const u32x2*)(mix + eo + 256 * i); \
            if constexpr (RES_F32) rv[rr][i] = *(const res_t*)((const float*)res + eo + 256 * i); else rv[rr][i] = *(const res_t*)((const bf16_t*)res + eo + 256 * i); } } while (0)
    const int ntile = T_ / 16;
    int ntl = 0;
    if (bid < ntile) LNR_LOAD(bid, 0);
    const int lane0 = lane;
    for (int it = 0; bid + G * it < ntile; ++it) {
        const int tix = bid + G * it;
        int lane = lane0; asm volatile("" : "+v"(lane));
#pragma unroll
        for (int rr = 0; rr < 2; ++rr) {
            const int row = 2 * wid + rr; const size_t m = (size_t)tix * 16 + row;
            f32x4 zr[8]; float s = 0.f;
#pragma unroll
            for (int i = 0; i < 8; ++i) { const f32x4 mx = {bflo(mv[rr][i].x), bfhi(mv[rr][i].x), bflo(mv[rr][i].y), bfhi(mv[rr][i].y)}; f32x4 rx;
                if constexpr (RES_F32) rx = rv[rr][i]; else { const u32x2 rb2 = rv[rr][i]; rx = (f32x4){bflo(rb2.x), bfhi(rb2.x), bflo(rb2.y), bfhi(rb2.y)}; }
                zr[i] = ALPHA * rx + mx; s += (zr[i][0] + zr[i][1]) + (zr[i][2] + zr[i][3]); }
            if (rr == 0) { __builtin_amdgcn_sched_barrier(0); LNR_LOAD(tix, 1); __builtin_amdgcn_sched_barrier(0); }
            const float mean = wave_sum(s) * (1.0f / DM); float q = 0.f;
#pragma unroll
            for (int i = 0; i < 8; ++i) { const f32x4 d = zr[i] - mean; q += (d[0] * d[0] + d[1] * d[1]) + (d[2] * d[2] + d[3] * d[3]); }
            const float rstd = rsqrtf(wave_sum(q) * (1.0f / DM) + 1e-5f);
#pragma unroll
            for (int i = 0; i < 8; ++i) { const int col = 4 * lane + 256 * i; const f32x4 gv = *(const f32x4*)(g + col), bv = *(const f32x4*)(bb + col);
                const f32x4 y = (zr[i] - mean) * rstd * gv + bv;
                LAS f32x2* xp = (LAS f32x2*)(xs + row * LNR_PITCH + col); xp[0] = (f32x2){y[0], y[1]}; xp[1] = (f32x2){y[2], y[3]};
                *(u32x2*)(x1b + m * DM + col) = (u32x2){cvtpk(y[0], y[1]), cvtpk(y[2], y[3])};
                if constexpr (F8_GU) *(unsigned*)(x1q + m * DM + col) = pk4_fp8(y[0], y[1], y[2], y[3]);
                if (i & 1) asm volatile("" ::: "memory"); }
        }
        __builtin_amdgcn_sched_barrier(0);
        if (tix + G < ntile) LNR_LOAD(tix + G, 0);
        __builtin_amdgcn_sched_barrier(0);
        __syncthreads();
        { f32x4 acc0 = {0.f, 0.f, 0.f, 0.f}, acc1 = {0.f, 0.f, 0.f, 0.f}; const LAS float* xa = xs + (lane & 15) * LNR_PITCH + 256 * wid + 8 * (lane >> 4); const int e = lane & 15;
#pragma unroll
          for (int ks = 0; ks < 8; ++ks) { const f32x4 xa0 = *(const LAS f32x4*)(xa + 32 * ks), xa1 = *(const LAS f32x4*)(xa + 32 * ks + 4);
              const float xv[8] = {xa0[0], xa0[1], xa0[2], xa0[3], xa1[0], xa1[1], xa1[2], xa1[3]}; f16x8 ah, al;
#pragma unroll
              for (int j = 0; j < 8; ++j) { const _Float16 hh = (_Float16)xv[j]; ah[j] = hh; al[j] = (_Float16)(xv[j] - (float)hh); }
              acc0 = __builtin_amdgcn_mfma_f32_16x16x32_f16(ah, bw[ks][0], acc0, 0, 0, 0); acc1 = __builtin_amdgcn_mfma_f32_16x16x32_f16(ah, bw[ks][1], acc1, 0, 0, 0);
              acc0 = __builtin_amdgcn_mfma_f32_16x16x32_f16(al, bw[ks][0], acc0, 0, 0, 0); acc1 = __builtin_amdgcn_mfma_f32_16x16x32_f16(al, bw[ks][1], acc1, 0, 0, 0); }
          __builtin_amdgcn_sched_barrier(0);
          __builtin_amdgcn_sched_barrier(0);
#pragma unroll
          for (int r = 0; r < 4; ++r) { const int row = (lane >> 4) * 4 + r; part[(wid * 16 + row) * 32 + e] = acc0[r]; part[(wid * 16 + row) * 32 + 16 + e] = acc1[r]; } }
        __syncthreads();
        { const int row = tid >> 5, e = tid & 31; float lg = 0.f;
#pragma unroll
          for (int w = 0; w < 8; ++w) lg += part[(w * 16 + row) * 32 + e];
          const float sc = 1.0f / (1.0f + __expf(-lg)); scs[row * 32 + e] = sc; sels[row * 32 + e] = sc + rb[e]; }
        __syncthreads();
        if (tid < 16) { const int row = tid; float best = -INFINITY; int bg = 0;
            for (int gI = 0; gI < 8; ++gI) { const float a = sels[row * 32 + 4 * gI], b = sels[row * 32 + 4 * gI + 1], c = sels[row * 32 + 4 * gI + 2], d = sels[row * 32 + 4 * gI + 3];
                const float h1 = fmaxf(a, b), l1 = fminf(a, b), h2 = fmaxf(c, d), l2 = fminf(c, d); const float gs = fmaxf(h1, h2) + fmaxf(fminf(h1, h2), fmaxf(l1, l2));
                if (gs > best) { best = gs; bg = gI; } }
            const float v0 = sels[row * 32 + 4 * bg], v1 = sels[row * 32 + 4 * bg + 1], v2 = sels[row * 32 + 4 * bg + 2], v3 = sels[row * 32 + 4 * bg + 3];
            int i1 = 0; float b1v = v0; if (v1 > b1v) { b1v = v1; i1 = 1; } if (v2 > b1v) { b1v = v2; i1 = 2; } if (v3 > b1v) { b1v = v3; i1 = 3; }
            int i2 = -1; float b2v = -INFINITY;
            if (i1 != 0 && v0 > b2v) { b2v = v0; i2 = 0; } if (i1 != 1 && v1 > b2v) { b2v = v1; i2 = 1; } if (i1 != 2 && v2 > b2v) { b2v = v2; i2 = 2; } if (i1 != 3 && v3 > b2v) { b2v = v3; i2 = 3; }
            const int e1 = 4 * bg + i1, e2 = 4 * bg + i2; const float s1 = scs[row * 32 + e1], s2 = scs[row * 32 + e2]; const float inv = 1.0f / (s1 + s2);
            const int m = tix * 16 + row;
            tok_e[2 * m] = e1; tok_e[2 * m + 1] = e2; tok_g[2 * m] = s1 * inv; tok_g[2 * m + 1] = s2 * inv;
            ble[(it * 16 + row) * 2] = e1; ble[(it * 16 + row) * 2 + 1] = e2; }
        __syncthreads();
        ntl = it + 1;
    }
#undef LNR_LOAD
    const int nasg = commit ? ntl * 32 : 0;
    if (tid < 32) { int c = 0; for (int i = 0; i < nasg; ++i) c += (ble[i] == tid) ? 1 : 0;
        unsigned base = 0; if (c) base = __hip_atomic_fetch_add(cnt + tid, (unsigned)c, __ATOMIC_RELAXED, __HIP_MEMORY_SCOPE_AGENT);
        hist[tid] = (int)base; }
    __syncthreads();
    if (tid < 32) { int run = hist[tid];
        for (int i = 0; i < nasg; ++i) if (ble[i] == tid) { const int tr = i >> 1; const size_t m = (size_t)(bid + G * (tr >> 4)) * 16 + (tr & 15);
            list[(size_t)tid * 65536 + run] = (int)m; tok_p[2 * m + (i & 1)] = run; ++run; } }
    __syncthreads();
}

constexpr int MOE_LDS = 131072;
__device__ __forceinline__ int moe_prefix(const unsigned* cnt, LAS int* pblk, int tid) {
    if (tid == 0) { int acc = 0; for (int e = 0; e < NE; ++e) { pblk[e] = acc; acc += ((int)cnt[e] + 255) >> 8; } pblk[NE] = acc; }
    __syncthreads();
    return pblk[NE];
}
template <int NJ> __device__ __forceinline__ int moe_table(const unsigned* cnt, LAS int* pblk, LAS int* tab, LAS int* aux, int NB, int G, int bid, int tid) {
    const int NU = NB * NJ;
    if (tid < 16) { const int L = bid + G * tid;
        if (L < NU) { const int rb = L / NJ, j = L % NJ; int e = 0; for (int q = 1; q < NE; ++q) if (pblk[q] <= rb) e = q;
            tab[tid] = rb; tab[16 + tid] = NJ * e + j; aux[tid * 3] = e; aux[tid * 3 + 1] = (rb - pblk[e]) * 256; aux[tid * 3 + 2] = (int)cnt[e]; } }
    __syncthreads();
    int n = 0; for (int i = 0; i < 16; ++i) if (bid + G * i < NU) n = i + 1;
    return n;
}

template <bool FINAL>
__device__ __forceinline__ void phase_combine_ln(const float* dbg, const bf16_t* x1b, const bf16_t* Yr, const int* tok_e, const int* tok_p, const float* tok_g, const unsigned* cnt,
                                                 const float* g, const float* bb, bf16_t* xo, unsigned char* xq, float* fo, LAS unsigned char* lds, int G, int bid, int tid) {
    LAS int* pblk = (LAS int*)lds;
    moe_prefix(cnt, pblk, tid);
    const int wid = __builtin_amdgcn_readfirstlane(tid >> 6), lane = tid & 63;
    float ALPHA = 1.4142135623730951f; asm volatile("" : "+v"(ALPHA));
#if DBG_CHECK
    const bool dbg_bad = FINAL && (!(dbg[0] <= DBG_TOL * DBG_TOL * dbg[1]) || !(dbg[2] <= DBG_TOL * DBG_TOL * dbg[3]) || !(dbg[1] > 0.f) || !(dbg[3] > 0.f) ||
                                    !(dbg[4] <= DBG_TOL * DBG_TOL * dbg[5]) || !(dbg[6] <= DBG_TOL * DBG_TOL * dbg[7]) || !(dbg[5] > 0.f) || !(dbg[7] > 0.f));
#endif
    for (int m = bid * 8 + wid; m < T_; m += G * 8) {
        const int e0 = tok_e[2 * m], e1 = tok_e[2 * m + 1];
        const size_t p0 = (size_t)pblk[e0] * 256 + tok_p[2 * m], p1 = (size_t)pblk[e1] * 256 + tok_p[2 * m + 1];
        const float g0 = tok_g[2 * m], g1 = tok_g[2 * m + 1];
        float v[32]; float s = 0.f;
#pragma unroll
        for (int i = 0; i < 4; ++i) { const int col = 8 * lane + 512 * i;
            const u32x4 xa = *(const u32x4*)(x1b + (size_t)m * DM + col);
            const unsigned xw[4] = {xa.x, xa.y, xa.z, xa.w};
            if constexpr (F8_YR) {
                const u32x2 ya = *(const u32x2*)((const unsigned char*)Yr + p0 * DM + col), yb = *(const u32x2*)((const unsigned char*)Yr + p1 * DM + col);
                const unsigned aw[2] = {ya.x, ya.y}, bw[2] = {yb.x, yb.y}; const float h0 = g0 * (1.0f / 16.0f), h1 = g1 * (1.0f / 16.0f);
#define CMB_PAIR(j, W, SEL) do { const f32x2 a2 = __builtin_amdgcn_cvt_pk_f32_fp8((int)aw[W], SEL), b2 = __builtin_amdgcn_cvt_pk_f32_fp8((int)bw[W], SEL); \
                    v[i * 8 + 2 * (j)] = ALPHA * bflo(xw[j]) + h0 * a2[0] + h1 * b2[0]; v[i * 8 + 2 * (j) + 1] = ALPHA * bfhi(xw[j]) + h0 * a2[1] + h1 * b2[1]; \
                    s += v[i * 8 + 2 * (j)] + v[i * 8 + 2 * (j) + 1]; } while (0)
                CMB_PAIR(0, 0, false); CMB_PAIR(1, 0, true); CMB_PAIR(2, 1, false); CMB_PAIR(3, 1, true);
#undef CMB_PAIR
            } else {
                const u32x4 ya = *(const u32x4*)(Yr + p0 * DM + col), yb = *(const u32x4*)(Yr + p1 * DM + col);
                const unsigned aw[4] = {ya.x, ya.y, ya.z, ya.w}, bw[4] = {yb.x, yb.y, yb.z, yb.w};
#pragma unroll
                for (int j = 0; j < 4; ++j) { v[i * 8 + 2 * j] = ALPHA * bflo(xw[j]) + g0 * bflo(aw[j]) + g1 * bflo(bw[j]); v[i * 8 + 2 * j + 1] = ALPHA * bfhi(xw[j]) + g0 * bfhi(aw[j]) + g1 * bfhi(bw[j]);
                    s += v[i * 8 + 2 * j] + v[i * 8 + 2 * j + 1]; }
            } }
        const float mean = wave_sum(s) * (1.0f / DM); float q = 0.f;
#pragma unroll
        for (int i = 0; i < 32; ++i) { const float d = v[i] - mean; q += d * d; }
        const float rstd = rsqrtf(wave_sum(q) * (1.0f / DM) + 1e-5f);
#pragma unroll
        for (int i = 0; i < 4; ++i) { const int col = 8 * lane + 512 * i;
            const f32x4 ga = *(const f32x4*)(g + col), gb = *(const f32x4*)(g + col + 4), ba = *(const f32x4*)(bb + col), bbv = *(const f32x4*)(bb + col + 4);
            float y[8];
#pragma unroll
            for (int j = 0; j < 4; ++j) { y[j] = (v[i * 8 + j] - mean) * rstd * ga[j] + ba[j]; y[4 + j] = (v[i * 8 + 4 + j] - mean) * rstd * gb[j] + bbv[j]; }
#if DBG_CHECK
            if (dbg_bad) { for (int j = 0; j < 8; ++j) y[j] = 0.f; }
#endif
            if constexpr (FINAL) { *(f32x4*)(fo + (size_t)m * DM + col) = (f32x4){y[0], y[1], y[2], y[3]}; *(f32x4*)(fo + (size_t)m * DM + col + 4) = (f32x4){y[4], y[5], y[6], y[7]}; }
            else { *(u32x4*)(xo + (size_t)m * DM + col) = (u32x4){cvtpk(y[0], y[1]), cvtpk(y[2], y[3]), cvtpk(y[4], y[5]), cvtpk(y[6], y[7])};
                if constexpr (F8_IN) *(u32x2*)(xq + (size_t)m * DM + col) = (u32x2){pk4_fp8(y[0], y[1], y[2], y[3]), pk4_fp8(y[4], y[5], y[6], y[7])}; } }
    }
}

#if DBG_CHECK
__device__ __forceinline__ void dbg_attn_check(int which, const bf16_t* Hx, const bf16_t* Qd, const bf16_t* KVd, const bf16_t* krope, const void* Oat, float* dbg, LAS unsigned char* lds, int bid, int tid) {
    const int wid = __builtin_amdgcn_readfirstlane(tid >> 6), lane = tid & 63;
    LAS float* sc = (LAS float*)lds + wid * 4096;
    LAS float* qs = (LAS float*)(lds + 131072) + wid * 192;
    const unsigned sid = (unsigned)(bid * 8 + wid);
    const int m = (int)((sid * 2654435761u) % (unsigned)T_), h = (int)(sid & 7u), b = m >> 12, pos = m & (SEQ - 1);
    const int DQ = which ? 192 : 128; const float scale = which ? 0.072168783648703220f : 0.088388347648318440f;
    for (int d = lane; d < DQ; d += 64) {
        float qv;
        if (which == 0) qv = bf2f(Hx[(size_t)m * IN0 + h * 128 + d]);
        else if (d < 128) qv = bf2f(Qd[(size_t)m * 1536 + h * 192 + d]);
        else { const int i = (d - 128) & 31; const float x1 = bf2f(Qd[(size_t)m * 1536 + h * 192 + 128 + i]), x2 = bf2f(Qd[(size_t)m * 1536 + h * 192 + 160 + i]);
            float sn, cs; sincos_rev((float)pos * inv_freq32(i), sn, cs); qv = (d < 160) ? (x1 * cs - x2 * sn) : (x2 * cs + x1 * sn); }
        qs[d] = qv; }
    asm volatile("s_waitcnt lgkmcnt(0)" ::: "memory");
    float mx = -INFINITY;
    for (int i = 0; i < 64; ++i) { const int j = lane + 64 * i; float dot = 0.f;
        if (which == 0) { const bf16_t* kp = Hx + (size_t)(b * SEQ + j) * IN0 + 1024 + (h >> 2) * 128; for (int d = 0; d < 128; ++d) dot += qs[d] * bf2f(kp[d]); }
        else { const bf16_t* kp = KVd + (size_t)(b * SEQ + j) * DM + h * 256; for (int d = 0; d < 128; ++d) dot += qs[d] * bf2f(kp[d]);
               const bf16_t* rp = krope + (size_t)(b * SEQ + j) * 64; for (int d = 0; d < 64; ++d) dot += qs[128 + d] * bf2f(rp[d]); }
        dot *= scale; sc[j] = dot; mx = fmaxf(mx, dot); }
    mx = wave_max(mx);
    float sum = 0.f;
    for (int i = 0; i < 64; ++i) { const int j = lane + 64 * i; const float pj = __expf(sc[j] - mx); sc[j] = pj; sum += pj; }
    sum = wave_sum(sum);
    asm volatile("s_waitcnt lgkmcnt(0)" ::: "memory");
    float e2 = 0.f, r2 = 0.f;
    for (int cc = 0; cc < 2; ++cc) { const int c = lane + 64 * cc; float acc = 0.f;
        for (int j = 0; j < SEQ; ++j) { const float vv = which == 0 ? bf2f(Hx[(size_t)(b * SEQ + j) * IN0 + 1280 + (h >> 2) * 128 + c]) : bf2f(KVd[(size_t)(b * SEQ + j) * DM + h * 256 + 128 + c]); acc += sc[j] * vv; }
        const float ref = acc / sum; const size_t eo = (size_t)m * DM + (which ? 1024 : 0) + h * 128 + c;
        float got; if (F8_OUT) { const unsigned char by = ((const unsigned char*)Oat)[eo]; const f32x2 g2 = __builtin_amdgcn_cvt_pk_f32_fp8((int)by, false); got = g2[0] * (1.0f / O8_SCALE); } else got = bf2f(((const bf16_t*)Oat)[eo]);
        e2 += (got - ref) * (got - ref); r2 += ref * ref; }
    e2 = wave_sum(e2); r2 = wave_sum(r2);
    if (lane == 0) { atomicAdd(dbg + 2 * which, e2); atomicAdd(dbg + 2 * which + 1, r2); }
}
#endif
#if DBG_CHECK
__device__ __forceinline__ void dbg_prep_check(int L, const float* xf, const bf16_t* xb2, const float* win, const float* gq, const float* gk, const bf16_t* H, const bf16_t* krope, float* dbg, LAS unsigned char* lds, int bid, int tid) {
    const int wid = __builtin_amdgcn_readfirstlane(tid >> 6), lane = tid & 63;
    const unsigned sid = (unsigned)(bid * 8 + wid);
    const int m = (int)((sid * 2246822519u) % (unsigned)T_); const int sq = m & (SEQ - 1);
    float e2 = 0.f, r2 = 0.f;
    if (L == 0) {
        const int hh = (int)(sid % 10u); const int colbase = hh < 8 ? hh * 128 : 1024 + (hh - 8) * 128; const float* gain = hh < 8 ? gq : gk;
        float a0 = 0.f, a1 = 0.f;
        for (int k = 0; k < DM; ++k) { const float xv = xf[(size_t)m * DM + k]; a0 += xv * win[(size_t)k * IN0 + colbase + lane]; a1 += xv * win[(size_t)k * IN0 + colbase + 64 + lane]; }
        const float ms = wave_sum(a0 * a0 + a1 * a1) * (1.0f / 128.0f); const float r = rsqrtf(ms + 1e-6f);
        const float y0 = a0 * r * gain[lane], y1 = a1 * r * gain[64 + lane];
        LAS float* ys = (LAS float*)lds + wid * 128; ys[lane] = y0; ys[64 + lane] = y1; asm volatile("s_waitcnt lgkmcnt(0)" ::: "memory");
#pragma unroll
        for (int q = 0; q < 2; ++q) { const int e = lane + 64 * q, hf = e >> 6, i = e & 31; const bool x2p = (e & 32) != 0;
            const float pos = (float)(hf ? (sq & 63) : (sq >> 6)); float sn, cs; sincos_rev(pos * inv_freq32(i), sn, cs);
            const float mine = ys[e], other = ys[e ^ 32];
            const float ref = x2p ? (mine * cs + other * sn) : (mine * cs - other * sn);
            const float got = bf2f(H[(size_t)m * IN0 + colbase + e]);
            e2 += (got - ref) * (got - ref); r2 += ref * ref; }
    } else {
        float acq[8] = {0.f, 0.f, 0.f, 0.f, 0.f, 0.f, 0.f, 0.f}; float akr = 0.f;
        for (int k = 0; k < DM; ++k) { const float xv = bf2f(xb2[(size_t)m * DM + k]); const float* wr = win + (size_t)k * IN1;
#pragma unroll
            for (int j = 0; j < 8; ++j) acq[j] += xv * wr[3072 + lane + 64 * j];
            akr += xv * wr[3840 + lane]; }
        float ss = 0.f;
#pragma unroll
        for (int j = 0; j < 8; ++j) ss += acq[j] * acq[j];
        const float r = rsqrtf(wave_sum(ss) * (1.0f / 512.0f) + 1e-6f);
#pragma unroll
        for (int j = 0; j < 8; ++j) { const float ref = acq[j] * r; const float got = bf2f(H[(size_t)m * IN1P + 3072 + lane + 64 * j]); e2 += (got - ref) * (got - ref); r2 += ref * ref; }
        LAS float* ys = (LAS float*)lds + wid * 128; ys[lane] = akr; asm volatile("s_waitcnt lgkmcnt(0)" ::: "memory");
        { const int i = lane & 31; float sn, cs; sincos_rev((float)sq * inv_freq32(i), sn, cs); const float mine = ys[lane], other = ys[lane ^ 32];
          const float ref = (lane & 32) ? (mine * cs + other * sn) : (mine * cs - other * sn); const float got = bf2f(krope[(size_t)m * 64 + lane]);
          e2 += (got - ref) * (got - ref); r2 += ref * ref; }
    }
    e2 = wave_sum(e2); r2 = wave_sum(r2);
    if (lane == 0) { atomicAdd(dbg + 4 + 2 * L, e2); atomicAdd(dbg + 5 + 2 * L, r2); }
}
#endif
#ifndef ATT_ONLY
#define ATT_ONLY -1
#endif
#ifndef REP_K
#define REP_K -1
#endif
#ifndef REP_ATT
#define REP_ATT -1
#endif
#define NREP(k) ((REP_K == (k)) ? 2 : 1)
#define NREPA(k) ((REP_ATT == (k)) ? 2 : 1)
constexpr int N_PHASES = 20;
__global__ void __launch_bounds__(NTHR, 2) fwd(Params p) {
    extern __shared__ __attribute__((aligned(16))) unsigned char lds_raw[];
    LAS unsigned char* lds = (LAS unsigned char*)lds_raw;
    const int tid0 = threadIdx.x, bid = blockIdx.x, G = gridDim.x;
    const int wv = __builtin_amdgcn_readfirstlane(tid0 >> 6);
    const int vcu = (G % 8 == 0) ? (bid % 8) * (G / 8) + bid / 8 : bid;
    unsigned* ctl = (unsigned*)(p.ws + WS_CTL);
    if (tid0 < 4) ((LAS unsigned*)(lds + MISC_OFF))[tid0] = 0u;
    __syncthreads();
    XcdBarrier bar; bar.bar = ctl + CW_BAR; bar.x = 0; bar.st = (volatile LAS unsigned*)(lds + MISC_OFF);
    if (N_LAUNCH_MODE == 1) bar = xcd_barrier_post(ctl + CW_BAR, (volatile LAS unsigned*)(lds + MISC_OFF));
    const int lo = p.ph_lo, hi = p.ph_hi;
#ifndef PH_ONLY
#define PH_ONLY -1
#endif
#define IN(k) ((PH_ONLY < 0 || (PH_ONLY % 10) == ((k) % 10)) && lo <= (k) && (k) < hi)
#define SEAM(k) do { if ((k) + 1 < hi) xcd_barrier(bar, fresh_tid(wv)); } while (0)

    for (int L = 0; L < 2; ++L) {
        const int pb = L * 10;
        typedef __attribute__((address_space(1))) unsigned char gu8;
        typedef __attribute__((address_space(1))) const float gcf;
        typedef __attribute__((address_space(4))) const unsigned long long kcu64;
#define INP(i) ((const float*)(gcf*)ka[i])
#define PHASE_PTRS \
        kcu64* ka = (kcu64*)__builtin_amdgcn_kernarg_segment_ptr(); asm volatile("" : "+s"(ka)); \
        unsigned char* ws = (unsigned char*)(gu8*)ka[29]; unsigned char* outb = (unsigned char*)(gu8*)ka[28]; \
        unsigned* ctl = (unsigned*)(ws + WS_CTL); \
        bf16_t* RA = (bf16_t*)(ws + WS_RA); bf16_t* RB = (bf16_t*)(ws + WS_RB); bf16_t* RC = (bf16_t*)(ws + WS_RC); \
        int* list = (int*)(ws + WS_LIST); int* tok_e = (int*)(ws + WS_TOKE); int* tok_p = (int*)(ws + WS_TOKP); float* tok_g = (float*)(ws + WS_TOKG); \
        bf16_t* krope = (bf16_t*)(ws + WS_KROPE); \
        bf16_t* Qd = (bf16_t*)(outb + OUT_QD); bf16_t* O1 = (bf16_t*)(outb + OUT_O1); \
        const bf16_t* Win = (const bf16_t*)(ws + (L ? WS_WIN1 : WS_WIN0)); const bf16_t* Wout = (const bf16_t*)(ws + (L ? WS_WOUT1 : WS_WOUT0)); \
        const bf16_t* Wgu = (const bf16_t*)(ws + (L ? WS_WGU1 : WS_WGU0)); const bf16_t* Wd = (const bf16_t*)(ws + (L ? WS_WD1 : WS_WD0)); \
        const int NIN = L ? IN1P : IN0; \
        const bf16_t* xin = L ? RC : RA; \
        bf16_t* Hx = RB; bf16_t* Oat = L ? O1 : RC; float* Z = (float*)RB; \
        bf16_t* x1b = RA; bf16_t* Hm = RC; bf16_t* Yr = RB; \
        unsigned* cnt = ctl + CW_CNT + L * 64; \
        (void)ctl; (void)RA; (void)RB; (void)RC; (void)list; (void)tok_e; (void)tok_p; (void)tok_g; (void)krope; (void)Qd; (void)O1; (void)Win; (void)Wout; (void)Wgu; (void)Wd; (void)NIN; (void)xin; (void)Hx; (void)Oat; (void)Z; (void)x1b; (void)Hm; (void)Yr; (void)cnt; (void)outb

        if (L == 0 && IN(0)) { PHASE_PTRS; _Pragma("unroll 1") for (int rep = 0; rep < NREP(0); ++rep) phase_prologue(ka, ws, lds, G, bid, fresh_tid(wv)); SEAM(0); }

        if (IN(pb + 1)) {
            PHASE_PTRS;
            constexpr int KI = F8_IN ? 1024 : 2048;
            const bf16_t* ain = F8_IN ? (L ? (const bf16_t*)outb : (const bf16_t*)((unsigned char*)RC + 64 * MiB)) : xin;
            pg8::Gemm g{ain, Win, KI, KI, KI}; pg8::StaticOrder S; S.init(T_, NIN, G, bid, KI);
            pg8::EpiIn E{Hx, NIN, L ? ws + WS_WGU0 + 64 * MiB : (unsigned char*)RA, L ? ws + WS_WD0 + 32 * MiB : ws + WS_WGU1 + 64 * MiB, F8_SPARSE ? (L ? 4 : 10) : 99, F8_SPARSE ? (L ? 8 : 14) : 99, F8_SPARSE ? (L ? 12 : 18) : 99};
            _Pragma("unroll 1") for (int rep = 0; rep < NREP(1); ++rep) pg8::gemm_phase<F8_IN != 0>(wv, lds, g, S, E, W8_SBYTE, 0x7f7f7f7f);
            SEAM(pb + 1);
        }
        if (IN(pb + 2)) {
            PHASE_PTRS;
            if (L == 0) { phase_prep_qk(Hx, INP(I_AQN), INP(I_AKN), ws + WS_WGU0 + 64 * MiB, G, bid, fresh_tid(wv));
                if (F8_ATTA) phase_vt8(Hx, ws + WS_WGU0 + 72 * MiB, lds, G, bid, fresh_tid(wv));
                if (F8_SPARSE) { unsigned char* ra8 = (unsigned char*)RA;
                    phase_vt_heads<true>(ws + WS_WGU1 + 64 * MiB, ra8 + 32 * MiB, ra8 + 64 * MiB, ra8 + 96 * MiB, lds, G, bid, fresh_tid(wv)); } }
            else { phase_prep_mla(Hx, krope, ws + WS_WD1 + 32 * MiB, G, bid, fresh_tid(wv));
                if (F8_SPARSE) { unsigned char* c8 = ws + WS_WGU0 + 64 * MiB;
                    phase_vt_heads<false>(ws + WS_WD0 + 32 * MiB, c8 + 32 * MiB, nullptr, nullptr, lds, G, bid, fresh_tid(wv)); } }
#if DBG_CHECK
            xcd_barrier(bar, fresh_tid(wv));
            dbg_prep_check(L, INP(I_X), RC, INP(L ? I_WIN1 : I_WIN0), INP(I_AQN), INP(I_AKN), Hx, krope, (float*)(ctl + CW_DBG), lds, bid, fresh_tid(wv));
            __syncthreads();
#endif
            SEAM(pb + 2);
        }
        if (L == 1 && IN(pb + 3)) _Pragma("unroll 1") for (int rep = 0; rep < NREP(3); ++rep) {
            PHASE_PTRS;
#ifndef P3_ONLY
#define P3_ONLY -1
#endif
            if (P3_ONLY < 0 || P3_ONLY == 0) { pg8::Gemm g{Hx + 3072, (const bf16_t*)(ws + WS_WQUP), 512, IN1P, 512}; pg8::StaticOrder S; S.init(T_, 1536, G, bid, IN1P);
              pg8::EpiBf16 E{Qd, 1536, 0xffff}; pg8::gemm_phase<false>(wv, lds, g, S, E); }
            if (P3_ONLY < 0 || P3_ONLY == 1) { pg8::Gemm g{Hx + 3584, (const bf16_t*)(ws + WS_WKVUP), 256, IN1P, 256}; pg8::StaticOrder S; S.init(T_, 2048, G, bid, IN1P);
              if constexpr (F8_ATTD) { pg8::EpiKV8 E{ws + WS_WGU1 + 64 * MiB, ws + WS_WGU1 + 96 * MiB, RA, DBG_CHECK != 0}; pg8::gemm_phase<false>(wv, lds, g, S, E); }
              else { pg8::EpiBf16 E{RA, 2048, 0xffff}; pg8::gemm_phase<false>(wv, lds, g, S, E); } }
            if (rep + 1 == NREP(3)) SEAM(pb + 3);
        }
        if (IN(pb + 4)) {
            PHASE_PTRS;
            if (L == 0) {
                if (ATT_ONLY < 0 || ATT_ONLY == 0)
                _Pragma("unroll 1") for (int rep = 0; rep < NREPA(0); ++rep)
                for (int u = vcu; u < 1024; u += G) {
                    __syncthreads();
                    const int b = u >> 7, qb = u & 15, kvh = (u >> 6) & 1, gq = (u >> 4) & 3, h = kvh * 4 + gq;
                    if constexpr (F8_ATTA) {
                        d8::D8Args a; a.Q = Hx + (size_t)(b * SEQ + 256 * qb) * IN0 + h * 128; a.ldq = IN0;
                        a.K8 = ws + WS_WGU0 + 64 * MiB + (size_t)b * SEQ * 256 + kvh * 128; a.ldk = 256; a.Kr8 = nullptr;
                        a.Vt8 = ws + WS_WGU0 + 72 * MiB + (size_t)(b * 2 + kvh) * 128 * SEQ; a.ldvt = SEQ;
                        { const size_t eo = (size_t)(b * SEQ + 256 * qb) * DM + h * 128; a.O = F8_OUT ? (bf16_t*)((unsigned char*)Oat + eo) : Oat + eo; } a.ldo = DM; a.seq = SEQ; a.pos0 = 0;
                        d8::attn_dense8_body<2>(wv, a, (char*)lds_raw);
                    } else {
                    da::DArgs a; a.Q = Hx + (size_t)(b * SEQ + 256 * qb) * IN0 + h * 128; a.ldq = IN0;
                    a.K = Hx + (size_t)b * SEQ * IN0 + 1024 + kvh * 128; a.ldk = IN0; a.V = Hx + (size_t)b * SEQ * IN0 + 1280 + kvh * 128; a.ldv = IN0; a.Kr = nullptr;
                    { const size_t eo = (size_t)(b * SEQ + 256 * qb) * DM + h * 128; a.O = F8_OUT ? (bf16_t*)((unsigned char*)Oat + eo) : Oat + eo; } a.ldo = DM; a.seq = SEQ; a.pos0 = 0;
                    da::attn_dense_body<8, 1>(wv, a, (char*)lds_raw);
                    }
                }
                __syncthreads();
                if (ATT_ONLY < 0 || ATT_ONLY == 2)
                _Pragma("unroll 1") for (int rep = 0; rep < NREPA(2); ++rep)
                for (int it = vcu; it < 1024; it += G) {
                    const int tid2 = fresh_tid(wv), wid = __builtin_amdgcn_readfirstlane(tid2 >> 6), lane = tid2 & 63;
                    const int w = it * 8 + wid; LAS unsigned char* wl = lds + wid * da::SP_WAVE_LDS;
                    if constexpr (F8_SPARSE) { const unsigned char* ra8 = (const unsigned char*)RA; PolB8 pol; pol.init(Hx, Oat, ra8, ra8 + 32 * MiB, ra8 + 64 * MiB, ra8 + 96 * MiB, w, lane); d8::sparse8_wave(pol, wl, lane); }
                    else { PolB pol; pol.init(Hx, Oat, w, lane); da::sparse_wave(pol, wl, lane); }
                }
            } else {
                if (ATT_ONLY < 0 || ATT_ONLY == 1)
                _Pragma("unroll 1") for (int rep = 0; rep < NREPA(1); ++rep)
                for (int u = vcu; u < 1024; u += G) {
                    __syncthreads();
                    const int b = u >> 7, qb = u & 15, h = (u >> 4) & 7;
                    if constexpr (F8_ATTD) {
                        d8::D8Args a; a.Q = Qd + (size_t)(b * SEQ + 256 * qb) * 1536 + h * 192; a.ldq = 1536;
                        a.K8 = ws + WS_WGU1 + 64 * MiB + (size_t)b * SEQ * 1024 + h * 128; a.ldk = 1024; a.Kr8 = ws + WS_WD1 + 32 * MiB + (size_t)b * SEQ * 64;
                        a.Vt8 = ws + WS_WGU1 + 96 * MiB + (size_t)(b * 8 + h) * 128 * SEQ; a.ldvt = SEQ;
                        { const size_t eo = (size_t)(b * SEQ + 256 * qb) * DM + 1024 + h * 128; a.O = F8_OUT ? (bf16_t*)((unsigned char*)Oat + eo) : Oat + eo; } a.ldo = DM; a.seq = SEQ; a.pos0 = 256 * qb;
                        d8::attn_dense8_body<3>(wv, a, (char*)lds_raw);
                    } else {
                    da::DArgs a; a.Q = Qd + (size_t)(b * SEQ + 256 * qb) * 1536 + h * 192; a.ldq = 1536;
                    a.K = RA + (size_t)b * SEQ * DM + h * 256; a.ldk = DM; a.V = a.K + 128; a.ldv = DM; a.Kr = krope + (size_t)b * SEQ * 64;
                    { const size_t eo = (size_t)(b * SEQ + 256 * qb) * DM + 1024 + h * 128; a.O = F8_OUT ? (bf16_t*)((unsigned char*)Oat + eo) : Oat + eo; } a.ldo = DM; a.seq = SEQ; a.pos0 = 256 * qb;
                    da::attn_dense_body<12, 1>(wv, a, (char*)lds_raw);
                    }
                }
                __syncthreads();
                if (ATT_ONLY < 0 || ATT_ONLY == 3)
                _Pragma("unroll 1") for (int rep = 0; rep < NREPA(3); ++rep)
                for (int it = vcu; it < 1024; it += G) {
                    const int tid2 = fresh_tid(wv), wid = __builtin_amdgcn_readfirstlane(tid2 >> 6), lane = tid2 & 63;
                    const int w = it * 8 + wid; LAS unsigned char* wl = lds + wid * da::SP_WAVE_LDS;
                    if constexpr (F8_SPARSE) { const unsigned char* c8 = ws + WS_WGU0 + 64 * MiB; PolC8 pol; pol.init(Hx, Oat, c8, c8 + 32 * MiB, INP(I_RPB), (float*)((char*)wl + 16640), w, lane); d8::sparse8_wave(pol, wl, lane); }
                    else { PolC pol; pol.init(Hx, Oat, INP(I_RPB), (float*)((char*)wl + 16640), w, lane); da::sparse_wave(pol, wl, lane); }
                }
            }
#if DBG_CHECK
            xcd_barrier(bar, fresh_tid(wv));
            dbg_attn_check(L, Hx, Qd, RA, krope, Oat, (float*)(ctl + CW_DBG), lds, bid, fresh_tid(wv));
            __syncthreads();
#endif
            SEAM(pb + 4);
        }
        if (IN(pb + 5)) {
            PHASE_PTRS;
            constexpr int KO = F8_OUT ? 1024 : 2048; constexpr int SXO = F8_OUT ? 0x7b7b7b7b : 0x7f7f7f7f;
            pg8::Gemm g{Oat, Wout, KO, KO, KO}; pg8::StaticOrder S; S.init(T_, DM, G, bid, KO);
            pg8::EpiBf16 E{RB, DM, 0xffff};
            _Pragma("unroll 1") for (int rep = 0; rep < NREP(5); ++rep) pg8::gemm_phase<F8_OUT != 0>(wv, lds, g, S, E, W8_SBYTE, SXO);
            SEAM(pb + 5);
        }
        if (IN(pb + 6)) {
            PHASE_PTRS;
            if (L == 0) { _Pragma("unroll 1") for (int rep = 0; rep < NREP(6); ++rep) phase_ln_router<true>(RB, INP(I_X), INP(I_LN1G0), INP(I_LN1B0), INP(I_RW), INP(I_RB), x1b, (unsigned char*)RC + 64 * MiB, tok_e, tok_p, tok_g, list, cnt, lds, G, bid, fresh_tid(wv), rep + 1 == NREP(6)); }
            else { _Pragma("unroll 1") for (int rep = 0; rep < NREP(6); ++rep) phase_ln_router<false>(RB, RC, INP(I_LN1G1), INP(I_LN1B1), INP(I_RW), INP(I_RB), x1b, outb  , tok_e, tok_p, tok_g, list, cnt, lds, G, bid, fresh_tid(wv), rep + 1 == NREP(6)); }
            SEAM(pb + 6);
        }
        if (IN(pb + 7)) {
            PHASE_PTRS;
            LAS int* pblk = (LAS int*)(lds + MOE_LDS); LAS int* tab = pblk + 64; LAS int* aux = tab + 32; LAS int* idx = aux + 64;
            const int tid = fresh_tid(wv);
            const int NB = moe_prefix(cnt, pblk, tid);
            const int n = moe_table<4>(cnt, pblk, tab, aux, NB, G, bid, tid);
            for (int i = 0; i < n; ++i) if (tid < 256) { const int e = aux[i * 3], rs = aux[i * 3 + 1], ce = aux[i * 3 + 2]; idx[i * 256 + tid] = list[(size_t)e * 65536 + min(rs + tid, ce - 1)]; }
            __syncthreads();
            constexpr int KG = F8_GU ? 1024 : 2048;
            const bf16_t* agu = F8_GU ? (L ? (const bf16_t*)outb : (const bf16_t*)((unsigned char*)RC + 64 * MiB)) : x1b;
            pg8::Gemm g{agu, Wgu, KG, KG, KG}; pg8::TableOrder<true> S{tab, idx, n, KG}; pg8::EpiSiluMul<F8_DOWN != 0> E{Hm};
            _Pragma("unroll 1") for (int rep = 0; rep < NREP(7); ++rep) pg8::gemm_phase<F8_GU != 0>(wv, lds, g, S, E, W8_SBYTE, 0x7f7f7f7f);
            SEAM(pb + 7);
        }
        if (IN(pb + 8)) {
            PHASE_PTRS;
            LAS int* pblk = (LAS int*)(lds + MOE_LDS); LAS int* tab = pblk + 64; LAS int* aux = tab + 32;
            const int tid = fresh_tid(wv);
            const int NB = moe_prefix(cnt, pblk, tid);
            const int n = moe_table<8>(cnt, pblk, tab, aux, NB, G, bid, tid);
            constexpr int KD = F8_DOWN ? 256 : 512;
            pg8::Gemm g{Hm, Wd, KD, KD, KD}; pg8::TableOrder<false> S{tab, nullptr, n, KD}; pg8::EpiBf16T<F8_YR != 0> E{Yr, DM, 7};
            _Pragma("unroll 1") for (int rep = 0; rep < NREP(8); ++rep) pg8::gemm_phase<F8_DOWN != 0>(wv, lds, g, S, E, W8_SBYTE, 0x7f7f7f7f);
            SEAM(pb + 8);
        }
        if (IN(pb + 9)) _Pragma("unroll 1") for (int rep = 0; rep < NREP(9); ++rep) {
            PHASE_PTRS;
            if (L == 0) phase_combine_ln<false>((const float*)(ctl + CW_DBG), x1b, Yr, tok_e, tok_p, tok_g, cnt, INP(I_LN2G0), INP(I_LN2B0), RC, outb, nullptr, lds, G, bid, fresh_tid(wv));
            else phase_combine_ln<true>((const float*)(ctl + CW_DBG), x1b, Yr, tok_e, tok_p, tok_g, cnt, INP(I_LN2G1), INP(I_LN2B1), nullptr, nullptr, (float*)outb, lds, G, bid, fresh_tid(wv));
            if (rep + 1 == NREP(9)) SEAM(pb + 9);
        }
    }
#undef IN
#undef SEAM
#undef INP
#undef PHASE_PTRS
}

extern "C" void kernel_launch(void* const* d_in, const int* in_sizes, int n_in, void* d_out, int out_size, void* d_ws, size_t ws_size, hipStream_t stream) {
    static int grid = 0;
    if (grid == 0) {
        if (n_in != 28 || out_size != T_ * DM || ws_size < WS_END) { fprintf(stderr, "kernel_launch: unexpected shapes: n_in %d out %d ws %zu (need %zu)\n", n_in, out_size, ws_size, (size_t)WS_END); grid = -1; return; }
        int dev = 0, cus = 0, per_cu = 0;
        if (hipGetDevice(&dev) != hipSuccess || hipDeviceGetAttribute(&cus, hipDeviceAttributeMultiprocessorCount, dev) != hipSuccess) { grid = -1; return; }
        if (hipFuncSetAttribute((const void*)fwd, hipFuncAttributeMaxDynamicSharedMemorySize, LDS_BYTES) != hipSuccess) { fprintf(stderr, "kernel_launch: hipFuncSetAttribute failed\n"); grid = -1; return; }
        if (hipOccupancyMaxActiveBlocksPerMultiprocessor(&per_cu, (const void*)fwd, NTHR, LDS_BYTES) != hipSuccess || per_cu < 1)
            fprintf(stderr, "kernel_launch: occupancy query reports %d workgroups per CU\n", per_cu);
        (void)hipGetLastError();
        grid = cus;
    }
    if (grid < 0) return;
    (void)hipMemsetAsync((char*)d_ws + WS_CTL, 0, CTL_ZERO_BYTES, stream);
    Params p{};
    for (int i = 0; i < 28; ++i) p.in[i] = (const float*)d_in[i];
    p.out = (float*)d_out; p.ws = (unsigned char*)d_ws;
#if N_LAUNCH_MODE == 1
    p.ph_lo = 0; p.ph_hi = N_PHASES;
    hipLaunchKernelGGL(fwd, dim3(grid), dim3(NTHR), LDS_BYTES, stream, p);
#else
    for (int k = 0; k < N_PHASES; ++k) { if (k == 3 || k == 10) continue; p.ph_lo = k; p.ph_hi = k + 1;
        hipLaunchKernelGGL(fwd, dim3(grid), dim3(NTHR), LDS_BYTES, stream, p); }
#endif
    const hipError_t le = hipPeekAtLastError();
    if (le != hipSuccess) fprintf(stderr, "kernel_launch: launch failed: %s\n", hipGetErrorName(le));
}
```

```cpp
#include <hip/hip_runtime.h>
#include <cstdio>
#include <cstdint>
#include <type_traits>

#ifndef N_LAUNCH_MODE
#define N_LAUNCH_MODE 1
#endif
#ifndef DBG_CHECK
#define DBG_CHECK 0
#define NBR_COOP 1
#define F8_MIX 1
#define D8_DMA_A 1
#define D8_DMA_D 1
#define D8_MACC_D 1
#endif
#ifndef DBG_TOL_SP
#define DBG_TOL_SP 0.08f
#endif
#ifndef DBG_TOL
#define DBG_TOL 0.3f
#endif
#ifndef F8_DOWN
#define F8_DOWN 1
#endif
#ifndef F8_GU
#define F8_GU 1
#endif
#ifndef F8_IN
#define F8_IN 1
#endif
#ifndef F8_OUT
#define F8_OUT 1
#endif
#ifndef F8_ATTA
#define F8_ATTA 1
#endif
#ifndef F8_ATTD
#define F8_ATTD 1
#endif
#ifndef F8_SPARSE
#define F8_SPARSE 1
#endif
#ifndef GEMM_SKEW
#define GEMM_SKEW 0
#endif
#ifndef F8_YR
#define F8_YR 1
#endif

#define LAS __attribute__((address_space(3)))
typedef unsigned short bf16_t;
typedef short bf16x8 __attribute__((ext_vector_type(8)));
typedef short s16x4 __attribute__((ext_vector_type(4)));
typedef float f32x2 __attribute__((ext_vector_type(2)));
typedef float f32x4 __attribute__((ext_vector_type(4)));
typedef float f32x8 __attribute__((ext_vector_type(8)));
typedef float f32x16 __attribute__((ext_vector_type(16)));
typedef unsigned u32x2 __attribute__((ext_vector_type(2)));
typedef unsigned u32x4 __attribute__((ext_vector_type(4)));
typedef int i32x8 __attribute__((ext_vector_type(8)));
typedef _Float16 f16x8 __attribute__((ext_vector_type(8)));
typedef _Float16 f16x2 __attribute__((ext_vector_type(2)));
typedef int i32x4 __attribute__((ext_vector_type(4)));

constexpr int T_ = 32768, DM = 2048, SEQ = 4096, NBATCH = 8;
constexpr int IN0 = 4608, IN1 = 3904, IN1P = 4096;
constexpr int NE = 32, DE = 512, MAXBLK = 288;
constexpr float ALPHA = 1.4142135623730951f;
constexpr float LOG2E = 1.4426950408889634f;
constexpr int NTHR = 512;

constexpr size_t MiB = 1u << 20;
constexpr size_t WS_CTL = 0, CTL_ZERO_BYTES = 1 * MiB;
constexpr size_t WS_LIST = 1 * MiB;
constexpr size_t WS_TOKE = 9 * MiB;
constexpr size_t WS_TOKP = WS_TOKE + 256 * 1024;
constexpr size_t WS_TOKG = WS_TOKP + 256 * 1024;
constexpr size_t WS_RSTAT = WS_TOKG + 256 * 1024;
constexpr size_t WS_KROPE = 10 * MiB;
constexpr size_t WS_WIN0 = 16 * MiB, WS_WOUT0 = 34 * MiB, WS_WGU0 = 42 * MiB, WS_WD0 = 170 * MiB;
constexpr size_t WS_WIN1 = 234 * MiB, WS_WOUT1 = 250 * MiB, WS_WGU1 = 258 * MiB, WS_WD1 = 386 * MiB;
constexpr size_t WS_WQUP = 450 * MiB, WS_WKVUP = 452 * MiB;
constexpr size_t WS_RA = 454 * MiB, WS_RB = 582 * MiB, WS_RC = 870 * MiB, WS_END = 998 * MiB;
constexpr size_t OUT_QD = 0, OUT_O1 = 96 * MiB;
constexpr int CW_CNT = 64;
constexpr int CW_DBG = 512;
constexpr int CW_BAR = 4096;

constexpr int LDS_BYTES = 155648;
constexpr int MISC_OFF = LDS_BYTES - 64;

__device__ __forceinline__ unsigned cvtpk(float lo, float hi) { unsigned r; asm volatile("v_cvt_pk_bf16_f32 %0, %1, %2" : "=v"(r) : "v"(lo), "v"(hi)); return r; }
__device__ __forceinline__ float bf2f(unsigned short b) { return __uint_as_float(((unsigned)b) << 16); }
__device__ __forceinline__ float bflo(unsigned w) { return __uint_as_float(w << 16); }
__device__ __forceinline__ float bfhi(unsigned w) { return __uint_as_float(w & 0xffff0000u); }
__device__ __forceinline__ bf16_t f2bf(float f) { return (bf16_t)(cvtpk(f, f) & 0xffffu); }
__device__ __forceinline__ unsigned pk4_fp8(float a, float b, float c, float d) { int w = (int)__float_as_uint(a);
    w = __builtin_amdgcn_cvt_pk_fp8_f32(a, b, w, false); w = __builtin_amdgcn_cvt_pk_fp8_f32(c, d, w, true); return (unsigned)w; }
constexpr float O8_SCALE = 16.f;
__device__ __forceinline__ unsigned char f2fp8(float v) { return (unsigned char)(__builtin_amdgcn_cvt_pk_fp8_f32(v, v, (int)__float_as_uint(v), false) & 0xff); }
__device__ __forceinline__ float clamp8(float v) { return fminf(fmaxf(v, -400.f), 400.f); }
__device__ __forceinline__ int fresh_tid(int wv) { int l; asm volatile("v_mbcnt_lo_u32_b32 %0, -1, 0\n\tv_mbcnt_hi_u32_b32 %0, -1, %0" : "=v"(l)); return wv * 64 + l; }
__device__ __forceinline__ float fresh_zero() { float z; asm volatile("v_mov_b32 %0, 0" : "=v"(z)); return z; }
__device__ __forceinline__ float wave_sum(float v) {
    v += __int_as_float(__builtin_amdgcn_ds_swizzle(__float_as_int(v), (1 << 10) | 0x1f));
    v += __int_as_float(__builtin_amdgcn_ds_swizzle(__float_as_int(v), (2 << 10) | 0x1f));
    v += __int_as_float(__builtin_amdgcn_ds_swizzle(__float_as_int(v), (4 << 10) | 0x1f));
    v += __int_as_float(__builtin_amdgcn_ds_swizzle(__float_as_int(v), (8 << 10) | 0x1f));
    v += __int_as_float(__builtin_amdgcn_ds_swizzle(__float_as_int(v), (16 << 10) | 0x1f));
    auto rr = __builtin_amdgcn_permlane32_swap(__float_as_uint(v), __float_as_uint(v), false, false);
    return __uint_as_float(rr[0]) + __uint_as_float(rr[1]);
}
__device__ __forceinline__ float wave_max(float v) {
    v = fmaxf(v, __int_as_float(__builtin_amdgcn_ds_swizzle(__float_as_int(v), (1 << 10) | 0x1f)));
    v = fmaxf(v, __int_as_float(__builtin_amdgcn_ds_swizzle(__float_as_int(v), (2 << 10) | 0x1f)));
    v = fmaxf(v, __int_as_float(__builtin_amdgcn_ds_swizzle(__float_as_int(v), (4 << 10) | 0x1f)));
    v = fmaxf(v, __int_as_float(__builtin_amdgcn_ds_swizzle(__float_as_int(v), (8 << 10) | 0x1f)));
    v = fmaxf(v, __int_as_float(__builtin_amdgcn_ds_swizzle(__float_as_int(v), (16 << 10) | 0x1f)));
    auto rr = __builtin_amdgcn_permlane32_swap(__float_as_uint(v), __float_as_uint(v), false, false);
    return fmaxf(__uint_as_float(rr[0]), __uint_as_float(rr[1]));
}
__device__ __forceinline__ float inv_freq32(int i) { return __builtin_amdgcn_exp2f(-(float)i * 0.41524101186092029f); }
__device__ __forceinline__ void sincos_rev(float angle, float& s, float& c) {
    float rev = angle * 0.15915494309189535f; rev = rev - floorf(rev);
    s = __builtin_amdgcn_sinf(rev); c = __builtin_amdgcn_cosf(rev);
}

#define XB_TMO      128
#define XB_XCNT(j)  (256  + 64 * (j))
#define XB_XSUB(j)  (1280 + 64 * (j))
#define XB_XGEN(j)  (2304 + 64 * (j))
#define XB_TOP      3328
#define XB_TOPGEN   3392
#define XCD_BAR_WORDS 3456
#define XB_SPIN_CAP (1u << 20)
__device__ __forceinline__ unsigned xb_ld(unsigned* p)              { return __hip_atomic_load(p, __ATOMIC_RELAXED, __HIP_MEMORY_SCOPE_AGENT); }
__device__ __forceinline__ unsigned xb_add(unsigned* p, unsigned v) { return __hip_atomic_fetch_add(p, v, __ATOMIC_RELAXED, __HIP_MEMORY_SCOPE_AGENT); }
__device__ __forceinline__ unsigned xb_xcc_id() { return (unsigned)__builtin_amdgcn_s_getreg((3 << 11) | 20) & 0xFu; }
#define XB_SPIN(cond, bar) do { unsigned _sp = 0; while (cond) { __builtin_amdgcn_s_sleep(1); \
    if ((++_sp & 255u) == 0u) { if (xb_ld(&(bar)[XB_TMO])) break; if (_sp > XB_SPIN_CAP) { atomicAdd(&(bar)[XB_TMO], 1u); break; } } } } while (0)
struct XcdBarrier { unsigned* bar; unsigned x; volatile LAS unsigned* st; };
__device__ __forceinline__ XcdBarrier xcd_barrier_post(unsigned* bar, volatile LAS unsigned* st) {
    XcdBarrier b; b.bar = bar; b.x = xb_xcc_id(); b.st = st;
    if (threadIdx.x == 0) (void)xb_add(&bar[XB_XCNT(b.x)], 1u);
    return b;
}
__device__ __forceinline__ void xcd_barrier_complete(unsigned* bar, unsigned x, unsigned& nloc, unsigned& nx) {
    const unsigned G = gridDim.x * gridDim.y * gridDim.z;
    unsigned sum, cnt, mine, sp = 0u;
    for (;;) {
        sum = 0u; cnt = 0u; mine = 0u;
#pragma unroll
        for (unsigned j = 0; j < 16; ++j) { const unsigned c = xb_ld(&bar[XB_XCNT(j)]); sum += c; cnt += (c > 0u) ? 1u : 0u; mine = (j == x) ? c : mine; }
        if (sum == G) break;
        __builtin_amdgcn_s_sleep(1);
        if ((++sp & 255u) == 0u) { if (xb_ld(&bar[XB_TMO])) break; if (sp > XB_SPIN_CAP) { atomicAdd(&bar[XB_TMO], 1u); break; } }
    }
    nloc = mine > 0u ? mine : 1u; nx = cnt > 0u ? cnt : 1u;
}
__device__ __forceinline__ void xcd_barrier(const XcdBarrier& b, int tid_now) {
    asm volatile("s_waitcnt vmcnt(0)" ::: "memory");
    __syncthreads();
    if (tid_now == 0) {
        unsigned* bar = b.bar;
        __builtin_amdgcn_s_waitcnt(0);
        unsigned nloc = b.st[0], nx = b.st[1];
        if (nloc == 0u) { xcd_barrier_complete(bar, b.x, nloc, nx); b.st[0] = nloc; b.st[1] = nx; }
        const unsigned old = xb_add(&bar[XB_XSUB(b.x)], 1u);
        const unsigned gen = old / nloc;
        if (old + 1u == (gen + 1u) * nloc) {
            __builtin_amdgcn_fence(__ATOMIC_RELEASE, "agent");
            asm volatile("s_waitcnt vmcnt(0)" ::: "memory");
            const unsigned og = xb_add(&bar[XB_TOP], 1u);
            const unsigned tg = og / nx;
            if (og + 1u == (tg + 1u) * nx) xb_add(&bar[XB_TOPGEN], 1u);
            else XB_SPIN(xb_ld(&bar[XB_TOPGEN]) == tg, bar);
            __builtin_amdgcn_fence(__ATOMIC_ACQUIRE, "agent");
            xb_add(&bar[XB_XGEN(b.x)], 1u);
            asm volatile("s_waitcnt vmcnt(0)" ::: "memory");
        } else {
            XB_SPIN(xb_ld(&bar[XB_XGEN(b.x)]) == gen, bar);
            __builtin_amdgcn_fence(__ATOMIC_ACQUIRE, "agent");
            asm volatile("s_waitcnt vmcnt(0)" ::: "memory");
        }
    }
    __syncthreads();
}

namespace pg8 {
constexpr int BM = 256, BK = 64, HALF = 128, HTB = HALF * BK * 2, STAGE_BYTES = 8 * HTB, NXCD = 8, WGM = 8;
__device__ __forceinline__ int lds_byte(int r, int c) { const int st = (r >> 4) * 2 + (c >> 5), rr = r & 15, cc = c & 31, ob = rr * 64 + cc * 2; return st * 1024 + (ob ^ (((ob >> 9) & 1) << 5)); }
__device__ __forceinline__ void stage_rc(int b, int& R, int& C) { const int st = b / 1024, sb = b % 1024, swz = sb ^ (((sb >> 9) & 1) << 5); R = (st >> 1) * 16 + swz / 64; C = (st & 1) * 32 + (swz % 64) / 2; }
__device__ __forceinline__ int perm32(int rho) { const int n = rho >> 4, i = rho & 15; return 8 * (i >> 2) + 4 * n + (i & 3); }
struct Unit { int pm, pn, q; };
struct Gemm { const bf16_t* A; const bf16_t* Bt; int K, lda, ldb; };

struct StaticOrder {
    static constexpr bool GATHER = false;
    int nM, nN, nwg, G, c, lda;
    __device__ void init(int M, int N, int G_, int c_, int lda_) { nM = M / BM; nN = N / BM; nwg = nM * nN; G = G_; c = c_; lda = lda_; }
    __device__ __forceinline__ bool next(int i, Unit& u) const {
        const long L = (long)i * G + c; if (L >= nwg) return false;
        int wgid = (int)L; { const int q = nwg / NXCD, r = nwg % NXCD, xcd = wgid % NXCD, off = wgid / NXCD; wgid = (xcd < r ? xcd * (q + 1) : r * (q + 1) + (xcd - r) * q) + off; }
        const int nig = WGM * nN, gid = wgid / nig, fm = gid * WGM, gsz = (nM - fm) < WGM ? (nM - fm) : WGM;
        u.pm = fm + ((wgid % nig) % gsz); u.pn = (wgid % nig) / gsz; u.q = i; return true;
    }
    __device__ __forceinline__ void aoff(const Unit& u, const int (&R)[2], const int (&C)[2], unsigned (&o)[2][2]) const {
#pragma unroll
        for (int h = 0; h < 2; ++h)
#pragma unroll
            for (int i = 0; i < 2; ++i) o[h][i] = (unsigned)((u.pm * BM + h * HALF + R[i]) * lda + C[i]) * 2u;
    }
};
template <bool GATHER_> struct TableOrder {
    static constexpr bool GATHER = GATHER_;
    const LAS int* tab; const LAS int* idx; int n, lda;
    __device__ __forceinline__ bool next(int i, Unit& u) const { if (i >= n) return false; u.pm = tab[i]; u.pn = tab[16 + i]; u.q = i; return true; }
    __device__ __forceinline__ void aoff(const Unit& u, const int (&R)[2], const int (&C)[2], unsigned (&o)[2][2]) const {
#pragma unroll
        for (int h = 0; h < 2; ++h)
#pragma unroll
            for (int i = 0; i < 2; ++i) { const int row = GATHER ? idx[u.q * 256 + h * HALF + R[i]] : (u.pm * BM + h * HALF + R[i]); o[h][i] = (unsigned)(row * lda + C[i]) * 2u; }
    }
};

template <bool O8> struct EpiBf16T {
    static constexpr bool PERM = true;
    bf16_t* O; int ldc; int pnmask;
    __device__ __forceinline__ void operator()(const f32x4 (&acc)[2][2][4][2], const Unit& u, int wr, int wc, int fr, int fq) const {
        const int row0 = u.pm * BM + wr * 64 + fr; const int col0 = (u.pn & pnmask) * BM + wc * 32 + 8 * fq;
#pragma unroll
        for (int ai = 0; ai < 2; ++ai)
#pragma unroll
            for (int m = 0; m < 4; ++m) { const size_t eoff = (size_t)(row0 + ai * HALF + m * 16) * ldc + col0;
#pragma unroll
                for (int bj = 0; bj < 2; ++bj) { const f32x4 v0 = acc[ai][bj][m][0], v1 = acc[ai][bj][m][1];
                    if constexpr (O8) { u32x2 w; w.x = pk4_fp8(v0[0] * 16.f, v0[1] * 16.f, v0[2] * 16.f, v0[3] * 16.f); w.y = pk4_fp8(v1[0] * 16.f, v1[1] * 16.f, v1[2] * 16.f, v1[3] * 16.f);
                        *(u32x2*)((unsigned char*)O + eoff + bj * HALF) = w; }
                    else { u32x4 w; w.x = cvtpk(v0[0], v0[1]); w.y = cvtpk(v0[2], v0[3]); w.z = cvtpk(v1[0], v1[1]); w.w = cvtpk(v1[2], v1[3]);
                        *(u32x4*)(O + eoff + bj * HALF) = w; } } }
    }
};
typedef EpiBf16T<false> EpiBf16;
struct EpiRowScale {
    static constexpr bool PERM = true;
    bf16_t* O; int ldc; const float* rs; int which;
    __device__ __forceinline__ void operator()(const f32x4 (&acc)[2][2][4][2], const Unit& u, int wr, int wc, int fr, int fq) const {
        const int row0 = u.pm * BM + wr * 64 + fr; const int col0 = u.pn * BM + wc * 32 + 8 * fq;
#pragma unroll
        for (int ai = 0; ai < 2; ++ai)
#pragma unroll
            for (int m = 0; m < 4; ++m) { const int row = row0 + ai * HALF + m * 16; const float s = rs[row * 2 + which]; bf16_t* rowp = O + (size_t)row * ldc + col0;
#pragma unroll
                for (int bj = 0; bj < 2; ++bj) { const f32x4 v0 = acc[ai][bj][m][0] * s, v1 = acc[ai][bj][m][1] * s;
                    u32x4 w; w.x = cvtpk(v0[0], v0[1]); w.y = cvtpk(v0[2], v0[3]); w.z = cvtpk(v1[0], v1[1]); w.w = cvtpk(v1[2], v1[3]);
                    *(u32x4*)(rowp + bj * HALF) = w; } }
    }
};
struct EpiIn {
    static constexpr bool PERM = true;
    bf16_t* H; int ldh; unsigned char* K8; unsigned char* V8; int k_lo, v_lo, v_hi;
    __device__ __forceinline__ void operator()(const f32x4 (&acc)[2][2][4][2], const Unit& u, int wr, int wc, int fr, int fq) const {
        const int row0 = u.pm * BM + wr * 64 + fr; const int cw = wc * 32 + 8 * fq;
        const bool is8 = (u.pn >= k_lo && u.pn < v_hi);
        unsigned char* b8 = (u.pn < v_lo) ? K8 + (size_t)(u.pn - k_lo) * BM : V8 + (size_t)(u.pn - v_lo) * BM;
#pragma unroll
        for (int ai = 0; ai < 2; ++ai)
#pragma unroll
            for (int m = 0; m < 4; ++m) { const size_t row = (size_t)(row0 + ai * HALF + m * 16);
#pragma unroll
                for (int bj = 0; bj < 2; ++bj) { const f32x4 v0 = acc[ai][bj][m][0], v1 = acc[ai][bj][m][1];
                    if (is8) *(u32x2*)(b8 + row * 1024 + bj * HALF + cw) = (u32x2){pk4_fp8(v0[0], v0[1], v0[2], v0[3]), pk4_fp8(v1[0], v1[1], v1[2], v1[3])};
                    else { u32x4 w; w.x = cvtpk(v0[0], v0[1]); w.y = cvtpk(v0[2], v0[3]); w.z = cvtpk(v1[0], v1[1]); w.w = cvtpk(v1[2], v1[3]);
                        *(u32x4*)(H + row * ldh + u.pn * BM + bj * HALF + cw) = w; } } }
    }
};
struct EpiNull { static constexpr bool PERM = true; float* sink;
    __device__ __forceinline__ void operator()(const f32x4 (&acc)[2][2][4][2], const Unit& u, int wr, int wc, int fr, int fq) const {
        float s = 0.f;
#pragma unroll
        for (int ai = 0; ai < 2; ++ai)
#pragma unroll
            for (int bj = 0; bj < 2; ++bj)
#pragma unroll
                for (int m = 0; m < 4; ++m)
#pragma unroll
                    for (int n = 0; n < 2; ++n) s += acc[ai][bj][m][n][0] + acc[ai][bj][m][n][1] + acc[ai][bj][m][n][2] + acc[ai][bj][m][n][3];
        if (s == 123.456f) sink[0] = s; } };
struct EpiKV8 {
    static constexpr bool PERM = true;
    unsigned char* K8; unsigned char* Vt8; bf16_t* KV; bool wr_bf16;
    __device__ __forceinline__ void operator()(const f32x4 (&acc)[2][2][4][2], const Unit& u, int wr, int wc, int fr, int fq) const {
        const int row0 = u.pm * BM + wr * 64 + fr; const int c0 = wc * 32 + 8 * fq;
#pragma unroll
        for (int ai = 0; ai < 2; ++ai)
#pragma unroll
            for (int m = 0; m < 4; ++m) { const int row = row0 + ai * HALF + m * 16;
                { const f32x4 v0 = acc[ai][0][m][0], v1 = acc[ai][0][m][1];
                  *(u32x2*)(K8 + (size_t)row * 1024 + u.pn * 128 + c0) = (u32x2){pk4_fp8(v0[0], v0[1], v0[2], v0[3]), pk4_fp8(v1[0], v1[1], v1[2], v1[3])}; }
                { const f32x4 v0 = acc[ai][1][m][0], v1 = acc[ai][1][m][1]; const float vv[8] = {v0[0], v0[1], v0[2], v0[3], v1[0], v1[1], v1[2], v1[3]};
                  unsigned char* vp = Vt8 + ((size_t)((row >> 12) * 8 + u.pn) * 128 + c0) * SEQ + (row & (SEQ - 1));
#pragma unroll
                  for (int e = 0; e < 8; ++e) vp[(size_t)e * SEQ] = f2fp8(vv[e]); }
                if (wr_bf16) {
#pragma unroll
                    for (int bj = 0; bj < 2; ++bj) { const f32x4 v0 = acc[ai][bj][m][0], v1 = acc[ai][bj][m][1];
                        u32x4 w; w.x = cvtpk(v0[0], v0[1]); w.y = cvtpk(v0[2], v0[3]); w.z = cvtpk(v1[0], v1[1]); w.w = cvtpk(v1[2], v1[3]);
                        *(u32x4*)(KV + (size_t)row * DM + u.pn * BM + bj * HALF + c0) = w; } } }
    }
};
template <bool O8> struct EpiSiluMul {
    static constexpr bool PERM = true;
    bf16_t* O;
    __device__ __forceinline__ void operator()(const f32x4 (&acc)[2][2][4][2], const Unit& u, int wr, int wc, int fr, int fq) const {
        const int row0 = u.pm * BM + wr * 64 + fr; const int col0 = (u.pn & 3) * HALF + wc * 32 + 8 * fq;
#pragma unroll
        for (int ai = 0; ai < 2; ++ai)
#pragma unroll
            for (int m = 0; m < 4; ++m) { const size_t eoff = (size_t)(row0 + ai * HALF + m * 16) * DE + col0; float h[8];
#pragma unroll
                for (int n = 0; n < 2; ++n)
#pragma unroll
                    for (int j = 0; j < 4; ++j) { const float g = acc[ai][0][m][n][j], up = acc[ai][1][m][n][j];
                        const float sg = g * __builtin_amdgcn_rcpf(1.0f + __builtin_amdgcn_exp2f(-g * LOG2E)); h[n * 4 + j] = sg * up; }
                if constexpr (O8) { u32x2 w; w.x = pk4_fp8(clamp8(h[0]), clamp8(h[1]), clamp8(h[2]), clamp8(h[3])); w.y = pk4_fp8(clamp8(h[4]), clamp8(h[5]), clamp8(h[6]), clamp8(h[7]));
                    *(u32x2*)((unsigned char*)O + eoff) = w; }
                else { u32x4 w; w.x = cvtpk(h[0], h[1]); w.y = cvtpk(h[2], h[3]); w.z = cvtpk(h[4], h[5]); w.w = cvtpk(h[6], h[7]);
                    *(u32x4*)(O + eoff) = w; } }
    }
};
template <bool RES_F32> struct EpiResF32 {
    static constexpr bool PERM = false;
    float* Z; const void* res;
    __device__ __forceinline__ void operator()(const f32x4 (&acc)[2][2][4][2], const Unit& u, int wr, int wc, int fr, int fq) const {
        const int row0 = u.pm * BM + wr * 64 + fr, col0 = u.pn * BM + wc * 32 + 4 * fq;
        float ALPHA = 1.4142135623730951f; asm volatile("" : "+v"(ALPHA));
#pragma unroll
        for (int ai = 0; ai < 2; ++ai)
#pragma unroll
            for (int m = 0; m < 4; ++m) { const size_t off = (size_t)(row0 + ai * HALF + m * 16) * DM + col0;
#pragma unroll
                for (int bj = 0; bj < 2; ++bj)
#pragma unroll
                    for (int n = 0; n < 2; ++n) { f32x4 o = acc[ai][bj][m][n];
                        if constexpr (RES_F32) { const f32x4 rv = *(const f32x4*)((const float*)res + off + bj * HALF + n * 16); o += ALPHA * rv; }
                        else { const u32x2 rb = *(const u32x2*)((const bf16_t*)res + off + bj * HALF + n * 16);
                            o[0] += ALPHA * bflo(rb.x); o[1] += ALPHA * bfhi(rb.x); o[2] += ALPHA * bflo(rb.y); o[3] += ALPHA * bfhi(rb.y); }
                        *(f32x4*)(Z + off + bj * HALF + n * 16) = o; } }
    }
};

template <bool F8, class Epi, class Sched>
__device__ __forceinline__ void gemm_phase(int wv, LAS unsigned char* lds, const Gemm g, const Sched& S, const Epi& E, float oscale = 1.0f) {
    constexpr bool GA = Sched::GATHER;
    const int tid = fresh_tid(wv), wid = __builtin_amdgcn_readfirstlane(tid >> 6), lane = tid & 63, wr = wid >> 2, wc = wid & 3, fr = lane & 15, fq = lane >> 4;
    int K = g.K; asm volatile("" : "+s"(K));
    const int nt = K / BK;
    int Rr[2], Cc[2]; unsigned voffA[2], voffB[2];
#pragma unroll
    for (int i = 0; i < 2; ++i) { int R, C; stage_rc(tid * 16 + i * 8192, R, C); Rr[i] = R; Cc[i] = C; const int Rb = Epi::PERM ? ((R & ~31) + perm32(R & 31)) : R;
        voffA[i] = (unsigned)(R * g.lda + C) * 2u; voffB[i] = (unsigned)(Rb * g.ldb + C) * 2u; }
    const size_t kstep = (size_t)(BK * 2);
    const size_t hstepA = (size_t)HALF * g.lda * 2, tstepA = 2 * hstepA;
    const size_t hstepB = (size_t)HALF * g.ldb * 2, tstepB = 2 * hstepB;
    const unsigned ldsw = (unsigned)wid * 1024u;
    const int aoff = lds_byte(wr * 64 + fr, fq * 8), boff = lds_byte(wc * 32 + fr, fq * 8);
#define PG8_SA(b, h) (((b) * 2 + (h)) * HTB)
#define PG8_SB(b, h) ((4 + (b) * 2 + (h)) * HTB)
#define PG8_STAGE(bufoff, gbase, voff) do { _Pragma("unroll") for (int _i = 0; _i < 2; ++_i) \
        __builtin_amdgcn_global_load_lds((const unsigned*)((const char*)(gbase) + (voff)[_i]), (LAS unsigned*)(lds + (bufoff) + ldsw + _i * 8192), 16, 0, 0); } while (0)
#define PG8_STAGE_A(bufoff, h, pbase, koff, goffs) do { if constexpr (GA) { PG8_STAGE(bufoff, gA + (koff), (goffs)[h]); } else { PG8_STAGE(bufoff, (pbase) + (h) * hstepA, voffA); } } while (0)
#define PG8_LD32(dst, off) do { const i32x4 _lo = *(const LAS i32x4*)(lds + (off)), _hi = *(const LAS i32x4*)(lds + (off) + 1024); dst = __builtin_shufflevector(_lo, _hi, 0, 1, 2, 3, 4, 5, 6, 7); } while (0)
#define PG8_LDA(dst, b, h) do { _Pragma("unroll") for (int m = 0; m < 4; ++m) PG8_LD32(dst[m], PG8_SA(b, h) + aoff + m * 2048); } while (0)
#define PG8_LDB(dst, b, h) do { _Pragma("unroll") for (int n = 0; n < 2; ++n) PG8_LD32(dst[n], PG8_SB(b, h) + boff + n * 2048); } while (0)
#define PG8_LOH(v) __builtin_bit_cast(bf16x8, __builtin_shufflevector(v, v, 0, 1, 2, 3))
#define PG8_HIH(v) __builtin_bit_cast(bf16x8, __builtin_shufflevector(v, v, 4, 5, 6, 7))
#define PG8_MMA(ai, bj, At, Bt) do { __builtin_amdgcn_s_setprio(1); \
        if constexpr (F8) { _Pragma("unroll") for (int m = 0; m < 4; ++m) _Pragma("unroll") for (int n = 0; n < 2; ++n) \
            asm volatile("v_mfma_f32_16x16x128_f8f6f4 %0, %1, %2, %0" : "+v"(acc[ai][bj][m][n]) : "v"(Bt[n]), "v"(At[m])); } \
        else { _Pragma("unroll") for (int m = 0; m < 4; ++m) _Pragma("unroll") for (int n = 0; n < 2; ++n) { \
            acc[ai][bj][m][n] = __builtin_amdgcn_mfma_f32_16x16x32_bf16(PG8_LOH(Bt[n]), PG8_LOH(At[m]), acc[ai][bj][m][n], 0, 0, 0); \
            acc[ai][bj][m][n] = __builtin_amdgcn_mfma_f32_16x16x32_bf16(PG8_HIH(Bt[n]), PG8_HIH(At[m]), acc[ai][bj][m][n], 0, 0, 0); } } \
        __builtin_amdgcn_s_setprio(0); } while (0)
#define PG8_WAIT_V(n) asm volatile("s_waitcnt vmcnt(" #n ")" ::: "memory")
#define PG8_WAIT_L(n) asm volatile("s_waitcnt lgkmcnt(" #n ")" ::: "memory")
#define PG8_BAR __builtin_amdgcn_s_barrier()
#define PG8_SCHED __builtin_amdgcn_sched_barrier(0)
    Unit cur, nxt; int ui = 0;
    if (!S.next(0, cur)) return;
    if (GEMM_SKEW > 0) { const unsigned long long t0 = __builtin_amdgcn_s_memrealtime(); const unsigned long long dl = (unsigned long long)((blockIdx.x >> 3) & 3) * GEMM_SKEW;
        while (__builtin_amdgcn_s_memrealtime() - t0 < dl) __builtin_amdgcn_s_sleep(8); }
    f32x4 acc[2][2][4][2];
#pragma unroll
    for (int a = 0; a < 2; ++a)
#pragma unroll
        for (int b = 0; b < 2; ++b)
#pragma unroll
            for (int m = 0; m < 4; ++m)
#pragma unroll
                for (int n = 0; n < 2; ++n) { const float zf = fresh_zero(); acc[a][b][m][n] = (f32x4){zf, zf, zf, zf}; }
    unsigned ca[2][2];
    if constexpr (GA) S.aoff(cur, Rr, Cc, ca);
    const char* gA = (const char*)g.A;
    const char* cA = gA + (GA ? (size_t)0 : (size_t)cur.pm * tstepA);
    const char* cB = (const char*)g.Bt + (size_t)cur.pn * tstepB;
    PG8_STAGE(PG8_SB(0, 0), cB, voffB); PG8_STAGE_A(PG8_SA(0, 0), 0, cA, 0, ca); PG8_STAGE(PG8_SB(0, 1), cB + hstepB, voffB); PG8_STAGE_A(PG8_SA(0, 1), 1, cA, 0, ca);
    if (wr == 1) PG8_BAR;
    PG8_WAIT_V(4); PG8_BAR;
    PG8_STAGE(PG8_SB(1, 0), cB + kstep, voffB); PG8_STAGE_A(PG8_SA(1, 0), 0, cA + kstep, kstep, ca); PG8_STAGE(PG8_SB(1, 1), cB + hstepB + kstep, voffB);
    PG8_WAIT_V(6); PG8_BAR;
    for (;;) {
        const bool has_next = S.next(ui + 1, nxt);
        const char* nA = (!GA && has_next) ? gA + (size_t)nxt.pm * tstepA : cA;
        const char* nB = has_next ? (const char*)g.Bt + (size_t)nxt.pn * tstepB : cB;
#pragma unroll 1
        for (int t = 0; t < nt; t += 2) {
            const bool last = (t == nt - 2);
            const size_t k1 = (size_t)(t + 1) * kstep, k2 = last ? (size_t)0 : (size_t)(t + 2) * kstep, k3 = k2 + kstep;
            const char* a1 = cA + k1;
            const char* a2 = last ? nA : cA + k2; const char* b2 = last ? nB : cB + (size_t)(t + 2) * kstep;
            const char* a3 = a2 + kstep; const char* b3 = b2 + kstep;
            i32x8 At[4], B0[2], B1[2];
            unsigned xa[2][2];
            if constexpr (GA) {
                if (last && has_next) { int R2[2], C2[2]; const int t2 = fresh_tid(wv); stage_rc(t2 * 16, R2[0], C2[0]); stage_rc(t2 * 16 + 8192, R2[1], C2[1]); S.aoff(nxt, R2, C2, xa); }
                else {
#pragma unroll
                    for (int h = 0; h < 2; ++h)
#pragma unroll
                        for (int i = 0; i < 2; ++i) xa[h][i] = ca[h][i];
                }
            }
            PG8_LDB(B0, 0, 0); PG8_SCHED; PG8_LDA(At, 0, 0); PG8_STAGE_A(PG8_SA(1, 1), 1, a1, k1, ca);
            PG8_WAIT_L(8); PG8_BAR; PG8_WAIT_L(0); PG8_MMA(0, 0, At, B0); PG8_BAR; PG8_SCHED;
            PG8_LDB(B1, 0, 1); PG8_STAGE(PG8_SB(0, 0), b2, voffB);
            PG8_BAR; PG8_WAIT_L(0); PG8_MMA(0, 1, At, B1); PG8_BAR;
            PG8_LDA(At, 0, 1); PG8_STAGE_A(PG8_SA(0, 0), 0, a2, k2, xa);
            PG8_BAR; PG8_WAIT_L(0); PG8_MMA(1, 0, At, B0); PG8_BAR; PG8_SCHED;
            PG8_STAGE(PG8_SB(0, 1), b2 + hstepB, voffB);
            PG8_WAIT_V(6); PG8_BAR; PG8_MMA(1, 1, At, B1); PG8_BAR;
            PG8_LDB(B0, 1, 0); PG8_SCHED; PG8_LDA(At, 1, 0); PG8_STAGE_A(PG8_SA(0, 1), 1, a2, k2, xa);
            PG8_WAIT_L(8); PG8_BAR; PG8_WAIT_L(0); PG8_MMA(0, 0, At, B0); PG8_BAR; PG8_SCHED;
            PG8_LDB(B1, 1, 1); PG8_STAGE(PG8_SB(1, 0), b3, voffB);
            PG8_BAR; PG8_WAIT_L(0); PG8_MMA(0, 1, At, B1); PG8_BAR;
            PG8_LDA(At, 1, 1); PG8_STAGE_A(PG8_SA(1, 0), 0, a3, k3, xa);
            PG8_BAR; PG8_WAIT_L(0); PG8_MMA(1, 0, At, B0); PG8_BAR; PG8_SCHED;
            PG8_STAGE(PG8_SB(1, 1), b3 + hstepB, voffB);
            PG8_WAIT_V(6); PG8_BAR; PG8_MMA(1, 1, At, B1); PG8_BAR;
        }
        if constexpr (F8) { asm volatile("s_nop 7\n\ts_nop 7\n\ts_nop 7" ::: "memory");
#pragma unroll
            for (int a = 0; a < 2; ++a)
#pragma unroll
                for (int b = 0; b < 2; ++b)
#pragma unroll
                    for (int m = 0; m < 4; ++m)
#pragma unroll
                        for (int n = 0; n < 2; ++n) acc[a][b][m][n] *= oscale; }
        { const int l2 = fresh_tid(0); E(acc, cur, wr, wc, l2 & 15, l2 >> 4); }
        if (!has_next) break;
#pragma unroll
        for (int a = 0; a < 2; ++a)
#pragma unroll
            for (int b = 0; b < 2; ++b)
#pragma unroll
                for (int m = 0; m < 4; ++m)
#pragma unroll
                    for (int n = 0; n < 2; ++n) { const float zf = fresh_zero(); acc[a][b][m][n] = (f32x4){zf, zf, zf, zf}; }
        cur = nxt; cA = nA; cB = nB; ++ui;
        if constexpr (GA) { int R2[2], C2[2]; const int t2 = fresh_tid(wv); stage_rc(t2 * 16, R2[0], C2[0]); stage_rc(t2 * 16 + 8192, R2[1], C2[1]); S.aoff(cur, R2, C2, ca); }
    }
    PG8_WAIT_V(0);
    if (wr == 0) PG8_BAR;
    PG8_BAR;
#undef PG8_SA
#undef PG8_SB
#undef PG8_STAGE
#undef PG8_STAGE_A
#undef PG8_LDA
#undef PG8_LDB
#undef PG8_MMA
#undef PG8_LD32
#undef PG8_LOH
#undef PG8_HIH
#undef PG8_WAIT_V
#undef PG8_WAIT_L
#undef PG8_BAR
#undef PG8_SCHED
}
}

namespace da {
constexpr int KVBLK = 64;
constexpr float THR = 8.f;
constexpr int SHM_V = KVBLK * 128 * 2, SHM_K = KVBLK * 128 * 2, SHM_KR = KVBLK * 64 * 2;
constexpr int OFF_V = 0, OFF_K = 2 * SHM_V, OFF_WS = OFF_K + 2 * SHM_K, OFF_KR = OFF_WS + 8 * 64 * 4, OFF_QR = OFF_KR + 2 * SHM_KR, LDS_DENSE = OFF_QR + 8 * 4096;
#define KSWZ(row, colB) ((row) * 256 + ((colB) ^ (((row) & 7) << 4)))
#define KRSWZ(row, ch) ((row) * 128 + ((((ch) ^ ((row) >> 1)) & 7) << 4))
#define SBAR() __builtin_amdgcn_sched_barrier(0)
__device__ __forceinline__ int crow(int r, int hi) { return (r & 3) + 8 * (r >> 2) + 4 * hi; }
__device__ __forceinline__ int v_st(int k, int c) { const int kk = (k & ~0xC) | ((k & 4) << 1) | ((k & 8) >> 1); return ((kk >> 3) * 4 + (c >> 5)) * 512 + ((kk & 7) * 32 + (c & 31)) * 2; }
__device__ __forceinline__ int v_rd_base(int lane) { return ((lane & 3) << 3) | (((lane >> 2) & 3) << 6) | (((lane >> 4) & 1) << 5) | (((lane >> 5) & 1) << 8); }
constexpr int v_rd_off(int d0, int ks, int half) { return d0 * 512 + ks * 4096 + half * 2048; }
template <int OFF> __device__ __forceinline__ s16x4 tr_read(int vb) {
    s16x4 r; asm volatile("ds_read_b64_tr_b16 %0, %1 offset:%2" : "=&v"(r) : "v"(vb), "i"(OFF) : "memory"); return r;
}
template <int D0> __device__ __forceinline__ void pv_one(f32x16& od, int vb, bf16x8 pa0, bf16x8 pa1, bf16x8 pa2, bf16x8 pa3) {
    const s16x4 l0 = tr_read<v_rd_off(D0, 0, 0)>(vb), h0 = tr_read<v_rd_off(D0, 0, 1)>(vb), l1 = tr_read<v_rd_off(D0, 1, 0)>(vb), h1 = tr_read<v_rd_off(D0, 1, 1)>(vb);
    const s16x4 l2 = tr_read<v_rd_off(D0, 2, 0)>(vb), h2 = tr_read<v_rd_off(D0, 2, 1)>(vb), l3 = tr_read<v_rd_off(D0, 3, 0)>(vb), h3 = tr_read<v_rd_off(D0, 3, 1)>(vb);
    asm volatile("s_waitcnt lgkmcnt(0)" ::: "memory"); SBAR();
#define PK(L, H) (bf16x8){L[0], L[1], L[2], L[3], H[0], H[1], H[2], H[3]}
    od = __builtin_amdgcn_mfma_f32_32x32x16_bf16(pa0, PK(l0, h0), od, 0, 0, 0);
    od = __builtin_amdgcn_mfma_f32_32x32x16_bf16(pa1, PK(l1, h1), od, 0, 0, 0);
    od = __builtin_amdgcn_mfma_f32_32x32x16_bf16(pa2, PK(l2, h2), od, 0, 0, 0);
    od = __builtin_amdgcn_mfma_f32_32x32x16_bf16(pa3, PK(l3, h3), od, 0, 0, 0);
}
__device__ __forceinline__ void pv_d0(f32x16* o, int vb, bf16x8 pa0, bf16x8 pa1, bf16x8 pa2, bf16x8 pa3) {
    pv_one<0>(o[0], vb, pa0, pa1, pa2, pa3); pv_one<1>(o[1], vb, pa0, pa1, pa2, pa3); pv_one<2>(o[2], vb, pa0, pa1, pa2, pa3); pv_one<3>(o[3], vb, pa0, pa1, pa2, pa3);
}
template <int D0> __device__ __forceinline__ void pv_one32(f32x16& od, int vb, bf16x8 pa0, bf16x8 pa1) {
    const s16x4 l0 = tr_read<v_rd_off(D0, 0, 0)>(vb), h0 = tr_read<v_rd_off(D0, 0, 1)>(vb), l1 = tr_read<v_rd_off(D0, 1, 0)>(vb), h1 = tr_read<v_rd_off(D0, 1, 1)>(vb);
    asm volatile("s_waitcnt lgkmcnt(0)" ::: "memory"); SBAR();
    od = __builtin_amdgcn_mfma_f32_32x32x16_bf16(pa0, PK(l0, h0), od, 0, 0, 0);
    od = __builtin_amdgcn_mfma_f32_32x32x16_bf16(pa1, PK(l1, h1), od, 0, 0, 0);
}
#undef PK
#define PK4(P, BASE, OUT) do { unsigned a0 = cvtpk(P[BASE + 0], P[BASE + 1]), a1 = cvtpk(P[BASE + 2], P[BASE + 3]);   \
    unsigned b0 = cvtpk(P[BASE + 4], P[BASE + 5]), b1 = cvtpk(P[BASE + 6], P[BASE + 7]);                              \
    auto r0 = __builtin_amdgcn_permlane32_swap(a0, b0, false, false); auto r1 = __builtin_amdgcn_permlane32_swap(a1, b1, false, false); \
    u32x4 w = {r0[0], r1[0], r0[1], r1[1]}; OUT = *reinterpret_cast<bf16x8*>(&w); } while (0)

template <int NDQ> struct Cst { static constexpr float SCALE = (NDQ == 8) ? 0.088388347648318440f : 0.072168783648703220f; static constexpr float C = SCALE * LOG2E; };

template <int NDQ>
__device__ __forceinline__ void partialSM(f32x16& p0, f32x16& p1, float& m_reg, float& mn, float& alpha) {
    constexpr float C = Cst<NDQ>::C, SCALE = Cst<NDQ>::SCALE;
    float pmax = p0[0];
#pragma unroll
    for (int r = 1; r < 16; ++r) pmax = fmaxf(pmax, p0[r]);
#pragma unroll
    for (int r = 0; r < 16; ++r) pmax = fmaxf(pmax, p1[r]);
    { auto rr = __builtin_amdgcn_permlane32_swap(__float_as_uint(pmax), __float_as_uint(pmax), false, false);
      pmax = fmaxf(__uint_as_float(rr[0]), __uint_as_float(rr[1])); }
    if (__builtin_expect(__all(pmax - m_reg <= THR / SCALE), 1)) { mn = m_reg; alpha = 1.f; }
    else { mn = fmaxf(m_reg, pmax); alpha = __builtin_amdgcn_exp2f((m_reg - mn) * C); m_reg = mn; }
    const float mnC = -mn * C;
#pragma unroll
    for (int r = 0; r < 16; ++r) p0[r] = fmaf(p0[r], C, mnC);
#pragma unroll
    for (int r = 0; r < 16; ++r) p1[r] = fmaf(p1[r], C, mnC);
#pragma unroll
    for (int r = 0; r < 16; ++r) p0[r] = __builtin_amdgcn_exp2f(p0[r]);
}
__device__ __forceinline__ void finishSM(f32x16& p0, f32x16& p1, float alpha, float& l_reg, bf16x8& pa0, bf16x8& pa1, bf16x8& pa2, bf16x8& pa3) {
#pragma unroll
    for (int r = 0; r < 16; ++r) p1[r] = __builtin_amdgcn_exp2f(p1[r]);
    float ps = 0;
#pragma unroll
    for (int r = 0; r < 16; ++r) ps += p0[r];
#pragma unroll
    for (int r = 0; r < 16; ++r) ps += p1[r];
    { auto rr = __builtin_amdgcn_permlane32_swap(__float_as_uint(ps), __float_as_uint(ps), false, false);
      ps = __uint_as_float(rr[0]) + __uint_as_float(rr[1]); }
    l_reg = l_reg * alpha + ps;
    PK4(p0, 0, pa0); PK4(p0, 8, pa1); PK4(p1, 0, pa2); PK4(p1, 8, pa3);
}
template <int NDQ>
__device__ __forceinline__ void qkt(f32x16& p0, f32x16& p1, const char* Ks, const char* Krs, const bf16x8* qr, const char* qrl, int r32, int hi) {
    p0 = f32x16{}; p1 = f32x16{};
#pragma unroll
    for (int d0 = 0; d0 < 8; ++d0) { const int cb = (d0 * 16 + hi * 8) * 2;
        bf16x8 b0 = *reinterpret_cast<const bf16x8*>(Ks + KSWZ(r32, cb));
        bf16x8 b1 = *reinterpret_cast<const bf16x8*>(Ks + KSWZ(32 + r32, cb));
        p0 = __builtin_amdgcn_mfma_f32_32x32x16_bf16(b0, qr[d0], p0, 0, 0, 0);
        p1 = __builtin_amdgcn_mfma_f32_32x32x16_bf16(b1, qr[d0], p1, 0, 0, 0); }
    if constexpr (NDQ == 12) {
#pragma unroll
        for (int d0 = 0; d0 < 4; ++d0) { const int ch = d0 * 2 + hi;
            bf16x8 b0 = *reinterpret_cast<const bf16x8*>(Krs + KRSWZ(r32, ch));
            bf16x8 b1 = *reinterpret_cast<const bf16x8*>(Krs + KRSWZ(32 + r32, ch));
            const bf16x8 qf = *reinterpret_cast<const bf16x8*>(qrl + d0 * 1024);
            p0 = __builtin_amdgcn_mfma_f32_32x32x16_bf16(b0, qf, p0, 0, 0, 0);
            p1 = __builtin_amdgcn_mfma_f32_32x32x16_bf16(b1, qf, p1, 0, 0, 0); }
    }
}

struct DArgs { const bf16_t* Q; const bf16_t* K; const bf16_t* V; const bf16_t* Kr; bf16_t* O; int ldq, ldk, ldv, ldo; int seq; int pos0; };

template <int NDQ, int SDEPTH>
__device__ __forceinline__ void attn_dense_body(int wv, const DArgs a, char* lds) {
    const int tid = fresh_tid(wv), wid = tid >> 6, lane = tid & 63, r32 = lane & 31, hi = lane >> 5;
    char* V_lds = lds + OFF_V; char* K_lds = lds + OFF_K; char* Kr_lds = lds + OFF_KR;
    float* ws = (float*)(lds + OFF_WS) + wid * 64; float* li_l = ws; float* al_l = ws + 32;
    float m_reg = -1e30f, l_reg = 0; f32x16 o[4] = {}; bf16x8 qr[8];
    char* qrl = lds + OFF_QR + wid * 4096 + lane * 16;
    const bf16_t* Qw = a.Q + (long)(wid * 32 + r32) * a.ldq + hi * 8;
#pragma unroll
    for (int d0 = 0; d0 < 8; ++d0) qr[d0] = *reinterpret_cast<const bf16x8*>(Qw + d0 * 16);
    if constexpr (NDQ == 12) {
        const float pos = (float)(a.pos0 + wid * 32 + r32);
#pragma unroll
        for (int f = 0; f < 2; ++f) {
            const bf16x8 x1v = *reinterpret_cast<const bf16x8*>(Qw + (8 + f) * 16), x2v = *reinterpret_cast<const bf16x8*>(Qw + (10 + f) * 16); bf16x8 y1v, y2v;
#pragma unroll
            for (int j = 0; j < 8; ++j) { const int i = f * 16 + hi * 8 + j; float sn, cs; sincos_rev(pos * inv_freq32(i), sn, cs);
                const float x1 = bf2f((unsigned short)x1v[j]), x2 = bf2f((unsigned short)x2v[j]);
                y1v[j] = (short)f2bf(x1 * cs - x2 * sn); y2v[j] = (short)f2bf(x2 * cs + x1 * sn); }
            *reinterpret_cast<bf16x8*>(qrl + f * 1024) = y1v; *reinterpret_cast<bf16x8*>(qrl + (2 + f) * 1024) = y2v;
        }
    }
    const int sr = tid >> 4, sc = (tid & 15) * 8, vst0 = v_st(sr, sc), vst1 = v_st(32 + sr, sc);
    const int krr = tid >> 3, krc = tid & 7;
    const int vb0 = (int)(uintptr_t)V_lds + v_rd_base(lane);
    struct { bf16x8 vs0, vs1, ks0, ks1, kr; } sr_[SDEPTH];
#define SLOAD(i, k0) do { sr_[i].vs0 = *(const bf16x8*)(a.V + (long)((k0) + sr) * a.ldv + sc); sr_[i].vs1 = *(const bf16x8*)(a.V + (long)((k0) + 32 + sr) * a.ldv + sc); \
    sr_[i].ks0 = *(const bf16x8*)(a.K + (long)((k0) + sr) * a.ldk + sc); sr_[i].ks1 = *(const bf16x8*)(a.K + (long)((k0) + 32 + sr) * a.ldk + sc); \
    if constexpr (NDQ == 12) sr_[i].kr = *(const bf16x8*)(a.Kr + (long)((k0) + krr) * 64 + krc * 8); } while (0)
#define SWRITE(b, i) do { *(bf16x8*)(V_lds + (b) * SHM_V + vst0) = sr_[i].vs0; *(bf16x8*)(V_lds + (b) * SHM_V + vst1) = sr_[i].vs1; const int kc = sc * 2; \
    *(bf16x8*)(K_lds + (b) * SHM_K + KSWZ(sr, kc)) = sr_[i].ks0; *(bf16x8*)(K_lds + (b) * SHM_K + KSWZ(32 + sr, kc)) = sr_[i].ks1; \
    if constexpr (NDQ == 12) *(bf16x8*)(Kr_lds + (b) * SHM_KR + KRSWZ(krr, krc)) = sr_[i].kr; } while (0)
#define SWAIT() do { if constexpr (SDEPTH == 2) { if constexpr (NDQ == 12) asm volatile("s_waitcnt vmcnt(5)" ::: "memory"); else asm volatile("s_waitcnt vmcnt(4)" ::: "memory"); } else asm volatile("s_waitcnt vmcnt(0)" ::: "memory"); } while (0)
#define RESC(al) do { if (__any((al) < 1.f)) { if (hi == 0) al_l[r32] = (al); asm volatile("s_waitcnt lgkmcnt(0)" ::: "memory"); \
    _Pragma("unroll") for (int d = 0; d < 4; ++d) _Pragma("unroll") for (int r = 0; r < 16; ++r) o[d][r] *= al_l[crow(r, hi)]; } } while (0)
    f32x16 pA0, pA1, pB0, pB1; float mnA, mnB, alA, alB; bf16x8 pa0, pa1, pa2, pa3; const int NT = a.seq / KVBLK;
    constexpr int SE = 0, SO = SDEPTH - 1;
    SLOAD(SE, 0); asm volatile("s_waitcnt vmcnt(0)" ::: "memory"); SWRITE(0, SE); __syncthreads();
    qkt<NDQ>(pA0, pA1, K_lds, Kr_lds, qr, qrl, r32, hi); partialSM<NDQ>(pA0, pA1, m_reg, mnA, alA);
    SLOAD(SO, KVBLK); if constexpr (SDEPTH == 2) { if (2 < NT) SLOAD(SE, 2 * KVBLK); }
    SWAIT(); SWRITE(1, SO); __syncthreads();
#pragma unroll 1
    for (int j = 1; j + 1 < NT; j += 2) {
        SBAR(); qkt<NDQ>(pB0, pB1, K_lds + SHM_K, Kr_lds + SHM_KR, qr, qrl, r32, hi);
        finishSM(pA0, pA1, alA, l_reg, pa0, pa1, pa2, pa3); SBAR();
        SLOAD(SO, (j + SDEPTH) * KVBLK); SBAR();
        pv_d0(o, vb0, pa0, pa1, pa2, pa3); partialSM<NDQ>(pB0, pB1, m_reg, mnB, alB);
        __syncthreads(); SWAIT(); SWRITE(0, SE);
        RESC(alB); __syncthreads();
        SBAR(); qkt<NDQ>(pA0, pA1, K_lds, Kr_lds, qr, qrl, r32, hi);
        finishSM(pB0, pB1, alB, l_reg, pa0, pa1, pa2, pa3); SBAR();
        if (SDEPTH == 1 || j + 3 < NT) SLOAD(SE, (j + 1 + SDEPTH) * KVBLK); SBAR();
        pv_d0(o, vb0 + (int)SHM_V, pa0, pa1, pa2, pa3); partialSM<NDQ>(pA0, pA1, m_reg, mnA, alA);
        __syncthreads(); SWAIT(); SWRITE(1, SO);
        RESC(alA); __syncthreads();
    }
    SBAR(); qkt<NDQ>(pB0, pB1, K_lds + SHM_K, Kr_lds + SHM_KR, qr, qrl, r32, hi);
    finishSM(pA0, pA1, alA, l_reg, pa0, pa1, pa2, pa3); SBAR();
    pv_d0(o, vb0, pa0, pa1, pa2, pa3); partialSM<NDQ>(pB0, pB1, m_reg, mnB, alB);
    __syncthreads(); RESC(alB);
    finishSM(pB0, pB1, alB, l_reg, pa0, pa1, pa2, pa3); SBAR();
    pv_d0(o, vb0 + (int)SHM_V, pa0, pa1, pa2, pa3);
    if (hi == 0) li_l[r32] = l_reg; asm volatile("s_waitcnt lgkmcnt(0)" ::: "memory");
    float rli[16];
#pragma unroll
    for (int r = 0; r < 16; ++r) rli[r] = __builtin_amdgcn_rcpf(li_l[crow(r, hi)]);
    bf16_t* Ow = F8_OUT ? (bf16_t*)((unsigned char*)a.O + (long)(wid * 32) * a.ldo) : a.O + (long)(wid * 32) * a.ldo;
#pragma unroll
    for (int r = 0; r < 16; ++r) { const int orow = crow(r, hi);
#pragma unroll
        for (int d0 = 0; d0 < 4; ++d0) { if constexpr (F8_OUT) ((unsigned char*)Ow)[(long)orow * a.ldo + d0 * 32 + r32] = f2fp8(o[d0][r] * rli[r] * O8_SCALE); else Ow[(long)orow * a.ldo + d0 * 32 + r32] = f2bf(o[d0][r] * rli[r]); } }
#undef SLOAD
#undef SWRITE
#undef SWAIT
#undef RESC
}

constexpr int SP_WAVE_LDS = 18688;
template <class P>
__device__ __forceinline__ void sparse_wave(P& pol, LAS unsigned char* wll, int lane) {
    const int r32 = lane & 31, hi = lane >> 5;
    char* wl = (char*)wll;
    char* Kl = wl; char* Vl = wl + 8192; float* li_l = (float*)(wl + 16384); float* al_l = li_l + 32;
    bf16x8 qr[8];
    { const bf16_t* qp = pol.qptr(r32) + hi * 8;
#pragma unroll
      for (int d0 = 0; d0 < 8; ++d0) qr[d0] = *reinterpret_cast<const bf16x8*>(qp + d0 * 16); }
    asm volatile("s_waitcnt vmcnt(0)" ::: "memory");
    f32x16 o[4] = {}; float m_reg = -1e30f, l_reg = 0.f;
    const int krow0 = lane >> 4;
    const int kce = (((lane & 15) ^ (krow0 & 7)) * 8), kco = (((lane & 15) ^ ((4 + krow0) & 7)) * 8);
    const int vk0 = 8 * ((lane >> 4) & 1) + ((lane >> 2) & 3), vc0 = 32 * (lane >> 5) + 8 * (lane & 3);
    const int vb = (int)(uintptr_t)Vl + v_rd_base(lane);
    const int nt = pol.ntiles();
    typename P::TI ti, tn;
#define SP_DMA_K(T) do { _Pragma("unroll") for (int i = 0; i < 8; ++i) { const bf16_t* src = (T).k + (long)(4 * i + krow0) * (T).rs + ((i & 1) ? kco : kce); \
        __builtin_amdgcn_global_load_lds((const unsigned*)src, (LAS unsigned*)(wll + i * 1024), 16, 0, 0); } } while (0)
#define SP_DMA_V(T) do { _Pragma("unroll") for (int i = 0; i < 8; ++i) { const bf16_t* src = (T).v + (long)(16 * (i >> 2) + 4 * ((i >> 1) & 1) + vk0) * (T).rs + 64 * (i & 1) + vc0; \
        __builtin_amdgcn_global_load_lds((const unsigned*)src, (LAS unsigned*)(wll + 8192 + i * 1024), 16, 0, 0); } } while (0)
    pol.tile(0, ti);
    SP_DMA_K(ti); SP_DMA_V(ti);
#pragma unroll 1
    for (int j = 0; j < nt; ++j) {
        const bool more = (j + 1 < nt);
        if (more) pol.tile(j + 1, tn);
        asm volatile("s_waitcnt vmcnt(8)" ::: "memory");
        f32x16 p = f32x16{};
#pragma unroll
        for (int d0 = 0; d0 < 8; ++d0) { const int cb = (d0 * 16 + hi * 8) * 2;
            bf16x8 b0 = *reinterpret_cast<const bf16x8*>(Kl + KSWZ(r32, cb));
            p = __builtin_amdgcn_mfma_f32_32x32x16_bf16(b0, qr[d0], p, 0, 0, 0); }
        asm volatile("s_waitcnt lgkmcnt(0)" ::: "memory"); SBAR();
        if (more) SP_DMA_K(tn);
        SBAR();
        float pmax = -INFINITY;
#pragma unroll
        for (int r = 0; r < 16; ++r) { p[r] = pol.adj(ti, crow(r, hi), p[r]); pmax = fmaxf(pmax, p[r]); }
        { auto rr = __builtin_amdgcn_permlane32_swap(__float_as_uint(pmax), __float_as_uint(pmax), false, false);
          pmax = fmaxf(__uint_as_float(rr[0]), __uint_as_float(rr[1])); }
        const float mn = fmaxf(m_reg, pmax); const float alpha = __builtin_amdgcn_exp2f(m_reg - mn); m_reg = mn;
        float ps = 0.f;
#pragma unroll
        for (int r = 0; r < 16; ++r) { p[r] = __builtin_amdgcn_exp2f(p[r] - mn); ps += p[r]; }
        { auto rr = __builtin_amdgcn_permlane32_swap(__float_as_uint(ps), __float_as_uint(ps), false, false);
          ps = __uint_as_float(rr[0]) + __uint_as_float(rr[1]); }
        l_reg = l_reg * alpha + ps;
        if (__any(alpha < 1.f)) { if (hi == 0) al_l[r32] = alpha; asm volatile("s_waitcnt lgkmcnt(0)" ::: "memory");
#pragma unroll
            for (int d = 0; d < 4; ++d)
#pragma unroll
                for (int r = 0; r < 16; ++r) o[d][r] *= al_l[crow(r, hi)]; }
        bf16x8 pa0, pa1; PK4(p, 0, pa0); PK4(p, 8, pa1);
        SBAR();
        if (more) asm volatile("s_waitcnt vmcnt(8)" ::: "memory"); else asm volatile("s_waitcnt vmcnt(0)" ::: "memory");
        SBAR();
        pv_one32<0>(o[0], vb, pa0, pa1); pv_one32<1>(o[1], vb, pa0, pa1); pv_one32<2>(o[2], vb, pa0, pa1); pv_one32<3>(o[3], vb, pa0, pa1);
        SBAR();
        if (more) SP_DMA_V(tn);
        SBAR();
        ti = tn;
    }
#undef SP_DMA_K
#undef SP_DMA_V
    if (hi == 0) li_l[r32] = l_reg; asm volatile("s_waitcnt lgkmcnt(0)" ::: "memory");
#pragma unroll
    for (int r = 0; r < 16; ++r) { const int qn = crow(r, hi); const float rl = __builtin_amdgcn_rcpf(li_l[qn]); bf16_t* op = pol.optr(qn);
#pragma unroll
        for (int d0 = 0; d0 < 4; ++d0) { if constexpr (F8_OUT) ((unsigned char*)op)[d0 * 32 + r32] = f2fp8(o[d0][r] * rl * O8_SCALE); else op[d0 * 32 + r32] = f2bf(o[d0][r] * rl); } }
}
#undef PK4
}

#define SBAR() __builtin_amdgcn_sched_barrier(0)
namespace d8 {
constexpr int K8_BYTES = 64 * 128, KR8_BYTES = 64 * 64, VT_PITCH = 80, VT_BYTES = 128 * VT_PITCH;
constexpr int OFF_K8 = 0, OFF_KR8 = 2 * K8_BYTES, OFF_VT = OFF_KR8 + 2 * KR8_BYTES, OFF_WS8 = OFF_VT + 2 * VT_BYTES, LDS_D8 = OFF_WS8 + 8 * 64 * 4;
constexpr float THR8 = 4.f;
#define K8SWZ(row, ch) ((row) * 128 + ((((ch) ^ ((row) >> 1)) & 7) << 4))
#define KR8SWZ(row, ch) ((row) * 64 + ((((ch) ^ ((row) >> 2)) & 3) << 4))
__device__ __forceinline__ int krow_of(int a) { const int hi = a >> 5, j = a & 31; return da::crow(j & 15, hi) + 32 * (j >> 4); }
struct D8Args { const bf16_t* Q; const unsigned char* K8; const unsigned char* Kr8; const unsigned char* Vt8; bf16_t* O; int ldq, ldk, ldvt, ldo; int seq; int pos0; };
template <int NKS> struct Cst8 { static constexpr float SCALE = (NKS == 2) ? 0.088388347648318440f : 0.072168783648703220f; static constexpr float C = SCALE * LOG2E; };
#define D8_LD32(dst, p) do { const i32x4 _lo = *(const i32x4*)(p), _hi = *(const i32x4*)((p) + 16); dst = __builtin_shufflevector(_lo, _hi, 0, 1, 2, 3, 4, 5, 6, 7); } while (0)
#define D8_MX(a, b, c) __builtin_amdgcn_mfma_scale_f32_32x32x64_f8f6f4(a, b, c, 0, 0, 0, 0, 0, 0)
template <int NKS, bool MACC = (NKS == 2)>
__device__ __forceinline__ void qkt8(f32x16& p0, f32x16& p1, const f32x16& mneg, const char* Ks, const char* Krs, const i32x8* qf, int r32, int hi) {
    i32x8 a0[2], a1[2];
#pragma unroll
    for (int sK = 0; sK < 2; ++sK) { const int ch = 4 * sK + 2 * hi;
        { const i32x4 lo = *(const i32x4*)(Ks + K8SWZ(r32, ch)), hh = *(const i32x4*)(Ks + K8SWZ(r32, ch + 1)); a0[sK] = __builtin_shufflevector(lo, hh, 0, 1, 2, 3, 4, 5, 6, 7); }
        { const i32x4 lo = *(const i32x4*)(Ks + K8SWZ(32 + r32, ch)), hh = *(const i32x4*)(Ks + K8SWZ(32 + r32, ch + 1)); a1[sK] = __builtin_shufflevector(lo, hh, 0, 1, 2, 3, 4, 5, 6, 7); } }
    asm volatile("s_waitcnt lgkmcnt(0)" ::: "memory"); SBAR();
    if constexpr (MACC) {
        asm volatile("v_mfma_f32_32x32x64_f8f6f4 %0, %1, %2, %3" : "=&v"(p0) : "v"(a0[0]), "v"(qf[0]), "v"(mneg));
        asm volatile("v_mfma_f32_32x32x64_f8f6f4 %0, %1, %2, %3" : "=&v"(p1) : "v"(a1[0]), "v"(qf[0]), "v"(mneg)); }
    else { p0 = f32x16{}; p1 = f32x16{}; p0 = D8_MX(a0[0], qf[0], p0); p1 = D8_MX(a1[0], qf[0], p1); }
    if constexpr (NKS == 3) { i32x8 r0, r1; const int ch = 2 * hi;
        { const i32x4 lo = *(const i32x4*)(Krs + KR8SWZ(r32, ch)), hh = *(const i32x4*)(Krs + KR8SWZ(r32, ch + 1)); r0 = __builtin_shufflevector(lo, hh, 0, 1, 2, 3, 4, 5, 6, 7); }
        { const i32x4 lo = *(const i32x4*)(Krs + KR8SWZ(32 + r32, ch)), hh = *(const i32x4*)(Krs + KR8SWZ(32 + r32, ch + 1)); r1 = __builtin_shufflevector(lo, hh, 0, 1, 2, 3, 4, 5, 6, 7); }
        p0 = D8_MX(a0[1], qf[1], p0); p1 = D8_MX(a1[1], qf[1], p1);
        p0 = D8_MX(r0, qf[2], p0); p1 = D8_MX(r1, qf[2], p1); }
    else { p0 = D8_MX(a0[1], qf[1], p0); p1 = D8_MX(a1[1], qf[1], p1); }
}
template <bool FIRST, bool SPLAT = false>
__device__ __forceinline__ void partialSM8(f32x16& p0, f32x16& p1, float& m_reg, f32x16& mneg, float& alpha) {
    float pmax = p0[0];
#pragma unroll
    for (int r = 1; r < 16; ++r) pmax = fmaxf(pmax, p0[r]);
#pragma unroll
    for (int r = 0; r < 16; ++r) pmax = fmaxf(pmax, p1[r]);
    { auto rr = __builtin_amdgcn_permlane32_swap(__float_as_uint(pmax), __float_as_uint(pmax), false, false);
      pmax = fmaxf(__uint_as_float(rr[0]), __uint_as_float(rr[1])); }
    if (!FIRST && __builtin_expect(__all(pmax <= THR8 * LOG2E), 1)) { alpha = 1.f; }
    else { const float delta = FIRST ? pmax : fmaxf(pmax, 0.f); alpha = FIRST ? 1.f : __builtin_amdgcn_exp2f(-delta); m_reg += delta;
#pragma unroll
        for (int r = 0; r < 16; ++r) { p0[r] -= delta; p1[r] -= delta; }
        if constexpr (!SPLAT) { const float nm = -m_reg;
#pragma unroll
            for (int r = 0; r < 16; ++r) mneg[r] = nm; } }
    if constexpr (SPLAT) { float nm = -m_reg; asm volatile("" : "+v"(nm));
#pragma unroll
        for (int r = 0; r < 16; ++r) mneg[r] = nm; }
#pragma unroll
    for (int r = 0; r < 16; ++r) p0[r] = __builtin_amdgcn_exp2f(p0[r]);
}
template <int NKS>
__device__ __forceinline__ void partialSM8z(f32x16& p0, f32x16& p1, float& m_reg, float& alpha) {
    constexpr float C = Cst8<NKS>::C, SCALE = Cst8<NKS>::SCALE; float mn;
    float pmax = p0[0];
#pragma unroll
    for (int r = 1; r < 16; ++r) pmax = fmaxf(pmax, p0[r]);
#pragma unroll
    for (int r = 0; r < 16; ++r) pmax = fmaxf(pmax, p1[r]);
    { auto rr = __builtin_amdgcn_permlane32_swap(__float_as_uint(pmax), __float_as_uint(pmax), false, false);
      pmax = fmaxf(__uint_as_float(rr[0]), __uint_as_float(rr[1])); }
    if (__builtin_expect(__all(pmax - m_reg <= THR8 / SCALE), 1)) { mn = m_reg; alpha = 1.f; }
    else { mn = fmaxf(m_reg, pmax); alpha = __builtin_amdgcn_exp2f((m_reg - mn) * C); m_reg = mn; }
    const float mnC = -mn * C;
#pragma unroll
    for (int r = 0; r < 16; ++r) p0[r] = fmaf(p0[r], C, mnC);
#pragma unroll
    for (int r = 0; r < 16; ++r) p1[r] = fmaf(p1[r], C, mnC);
#pragma unroll
    for (int r = 0; r < 16; ++r) p0[r] = __builtin_amdgcn_exp2f(p0[r]);
}
__device__ __forceinline__ void finishSM8n(f32x16& p0, f32x16& p1, i32x8& pa) {
#pragma unroll
    for (int r = 0; r < 16; ++r) p1[r] = __builtin_amdgcn_exp2f(p1[r]);
    pa = (i32x8){(int)pk4_fp8(p0[0], p0[1], p0[2], p0[3]), (int)pk4_fp8(p0[4], p0[5], p0[6], p0[7]), (int)pk4_fp8(p0[8], p0[9], p0[10], p0[11]), (int)pk4_fp8(p0[12], p0[13], p0[14], p0[15]),
                 (int)pk4_fp8(p1[0], p1[1], p1[2], p1[3]), (int)pk4_fp8(p1[4], p1[5], p1[6], p1[7]), (int)pk4_fp8(p1[8], p1[9], p1[10], p1[11]), (int)pk4_fp8(p1[12], p1[13], p1[14], p1[15])};
}
__device__ __forceinline__ void finishSM8(f32x16& p0, f32x16& p1, float alpha, float& l_reg, i32x8& pa) {
#pragma unroll
    for (int r = 0; r < 16; ++r) p1[r] = __builtin_amdgcn_exp2f(p1[r]);
    float ps = 0;
#pragma unroll
    for (int r = 0; r < 16; ++r) ps += p0[r];
#pragma unroll
    for (int r = 0; r < 16; ++r) ps += p1[r];
    { auto rr = __builtin_amdgcn_permlane32_swap(__float_as_uint(ps), __float_as_uint(ps), false, false);
      ps = __uint_as_float(rr[0]) + __uint_as_float(rr[1]); }
    l_reg = l_reg * alpha + ps;
    pa = (i32x8){(int)pk4_fp8(p0[0], p0[1], p0[2], p0[3]), (int)pk4_fp8(p0[4], p0[5], p0[6], p0[7]), (int)pk4_fp8(p0[8], p0[9], p0[10], p0[11]), (int)pk4_fp8(p0[12], p0[13], p0[14], p0[15]),
                 (int)pk4_fp8(p1[0], p1[1], p1[2], p1[3]), (int)pk4_fp8(p1[4], p1[5], p1[6], p1[7]), (int)pk4_fp8(p1[8], p1[9], p1[10], p1[11]), (int)pk4_fp8(p1[12], p1[13], p1[14], p1[15])};
}
__device__ __forceinline__ void pv8(f32x16* o, const char* Vt, const i32x8 pa, int r32, int hi) {
    i32x8 bfr[4];
#pragma unroll
    for (int d0 = 0; d0 < 4; ++d0) { const char* vp = Vt + (32 * d0 + r32) * VT_PITCH + 32 * hi;
        const i32x4 lo = *(const i32x4*)vp, hh = *(const i32x4*)(vp + 16); bfr[d0] = __builtin_shufflevector(lo, hh, 0, 1, 2, 3, 4, 5, 6, 7); }
    asm volatile("s_waitcnt lgkmcnt(0)" ::: "memory"); SBAR();
#pragma unroll
    for (int d0 = 0; d0 < 4; ++d0) o[d0] = D8_MX(pa, bfr[d0], o[d0]);
}
#define D8Q(P0, P1, KS, KRS, QF, R32, HI) do { if constexpr (VAR == 3) { P0 = f32x16{}; P1 = f32x16{}; } else qkt8<NKS>(P0, P1, mneg, KS, KRS, QF, R32, HI); } while (0)
#define D8P(FIRST, P0, P1, MR, AL) do { if constexpr (VAR == 1) { AL = 1.f; } else if constexpr (NKS == 2) partialSM8<FIRST>(P0, P1, MR, mneg, AL); else partialSM8z<NKS>(P0, P1, MR, AL); } while (0)
#define D8F(P0, P1, AL, LR, PA) do { if constexpr (VAR == 1) { PA = (i32x8){(int)pk4_fp8(P0[0], P0[1], P0[2], P0[3]), (int)pk4_fp8(P0[4], P0[5], P0[6], P0[7]), (int)pk4_fp8(P0[8], P0[9], P0[10], P0[11]), (int)pk4_fp8(P0[12], P0[13], P0[14], P0[15]), \
        (int)pk4_fp8(P1[0], P1[1], P1[2], P1[3]), (int)pk4_fp8(P1[4], P1[5], P1[6], P1[7]), (int)pk4_fp8(P1[8], P1[9], P1[10], P1[11]), (int)pk4_fp8(P1[12], P1[13], P1[14], P1[15])}; LR += 1.f; } else finishSM8(P0, P1, AL, LR, PA); } while (0)
#define D8V(O, VT, PA, R32, HI) do { if constexpr (VAR != 3) pv8(O, VT, PA, R32, HI); } while (0)
template <int NKS, int VAR = 0>
__device__ __forceinline__ void attn_dense8_body(int wv, const D8Args a, char* lds) {
    const int tid = fresh_tid(wv), wid = tid >> 6, lane = tid & 63, r32 = lane & 31, hi = lane >> 5;
    char* K_lds = lds + OFF_K8; char* Kr_lds = lds + OFF_KR8; char* Vt_lds = lds + OFF_VT;
    float* ws = (float*)(lds + OFF_WS8) + wid * 64; float* li_l = ws; float* al_l = ws + 32;
    float m_reg = (NKS == 2) ? 0.f : -1e30f, l_reg = 0; f32x16 o[4] = {}; i32x8 qf[NKS]; f32x16 mneg = {};
    constexpr float QC = (NKS == 2) ? Cst8<NKS>::C : 1.0f;
    { const bf16_t* Qw = a.Q + (long)(wid * 32 + r32) * a.ldq;
#pragma unroll
      for (int sK = 0; sK < 2; ++sK) { const bf16_t* qp = Qw + 64 * sK + 32 * hi; unsigned w[8];
#pragma unroll
          for (int c = 0; c < 4; ++c) { const u32x4 v = *(const u32x4*)(qp + 8 * c);
              w[2 * c] = pk4_fp8(bflo(v.x) * QC, bfhi(v.x) * QC, bflo(v.y) * QC, bfhi(v.y) * QC); w[2 * c + 1] = pk4_fp8(bflo(v.z) * QC, bfhi(v.z) * QC, bflo(v.w) * QC, bfhi(v.w) * QC); }
          qf[sK] = (i32x8){(int)w[0], (int)w[1], (int)w[2], (int)w[3], (int)w[4], (int)w[5], (int)w[6], (int)w[7]}; }
      if constexpr (NKS == 3) {
          const float pos = (float)(a.pos0 + wid * 32 + r32); const bf16_t* qp = Qw + 128; unsigned w[8];
#pragma unroll
          for (int c = 0; c < 4; ++c) { const u32x4 v1 = *(const u32x4*)(qp + 8 * c), v2 = *(const u32x4*)(qp + 32 + 8 * c);
              const unsigned a1[4] = {v1.x, v1.y, v1.z, v1.w}, a2[4] = {v2.x, v2.y, v2.z, v2.w}; float y[8];
#pragma unroll
              for (int e = 0; e < 8; ++e) { const int i = 8 * c + e; float sn, cs; sincos_rev(pos * inv_freq32(i), sn, cs);
                  const float x1 = (e & 1) ? bfhi(a1[e >> 1]) : bflo(a1[e >> 1]), x2 = (e & 1) ? bfhi(a2[e >> 1]) : bflo(a2[e >> 1]);
                  y[e] = (hi ? (x2 * cs + x1 * sn) : (x1 * cs - x2 * sn)) * QC; }
              w[2 * c] = pk4_fp8(y[0], y[1], y[2], y[3]); w[2 * c + 1] = pk4_fp8(y[4], y[5], y[6], y[7]); }
          qf[2] = (i32x8){(int)w[0], (int)w[1], (int)w[2], (int)w[3], (int)w[4], (int)w[5], (int)w[6], (int)w[7]}; } }
    const int ka = tid >> 3, kch = tid & 7, kdst = K8SWZ(krow_of(ka), kch);
    const int vc = tid >> 2, vq = tid & 3, vdst = vc * VT_PITCH + vq * 16;
    const int ra = (tid >> 2) & 63, rch = tid & 3, rdst = KR8SWZ(krow_of(ra), rch);
    struct { u32x4 k, v, r; } sr_[2];
    if constexpr (VAR == 2) { sr_[0].k = sr_[0].v = sr_[0].r = sr_[1].k = sr_[1].v = sr_[1].r = (u32x4){0x38383838u, 0x38383838u, 0x38383838u, 0x38383838u}; }
#define SLOAD8(i, k0) do { if constexpr (VAR == 2) break; sr_[i].k = *(const u32x4*)(a.K8 + (long)((k0) + ka) * a.ldk + kch * 16); sr_[i].v = *(const u32x4*)(a.Vt8 + (long)vc * a.ldvt + (k0) + vq * 16); \
    if constexpr (NKS == 3) sr_[i].r = *(const u32x4*)(a.Kr8 + (long)((k0) + ra) * 64 + rch * 16); } while (0)
#define SWRITE8(b, i) do { if constexpr (VAR == 4) break; *(u32x4*)(K_lds + (b) * K8_BYTES + kdst) = sr_[i].k; *(u32x4*)(Vt_lds + (b) * VT_BYTES + vdst) = sr_[i].v; \
    if constexpr (NKS == 3) *(u32x4*)(Kr_lds + (b) * KR8_BYTES + rdst) = sr_[i].r; } while (0)
#define RESC8(al) do { if (__any((al) < 1.f)) { if (hi == 0) al_l[r32] = (al); asm volatile("s_waitcnt lgkmcnt(0)" ::: "memory"); \
    _Pragma("unroll") for (int d = 0; d < 4; ++d) _Pragma("unroll") for (int r = 0; r < 16; ++r) o[d][r] *= al_l[da::crow(r, hi)]; } } while (0)
    f32x16 pA0, pA1, pB0, pB1; float alA, alB; i32x8 pa; const int NT = a.seq / 64;
    SLOAD8(0, 0); asm volatile("s_waitcnt vmcnt(0)" ::: "memory"); SWRITE8(0, 0); __syncthreads();
    D8Q(pA0, pA1, K_lds, Kr_lds, qf, r32, hi); D8P(true, pA0, pA1, m_reg, alA);
    SLOAD8(1, 64); if (2 < NT) SLOAD8(0, 128);
    if constexpr (NKS == 3) asm volatile("s_waitcnt vmcnt(3)" ::: "memory"); else asm volatile("s_waitcnt vmcnt(2)" ::: "memory");
    SWRITE8(1, 1); __syncthreads();
#pragma unroll 1
    for (int j = 1; j + 1 < NT; j += 2) {
        SBAR(); D8Q(pB0, pB1, K_lds + K8_BYTES, Kr_lds + KR8_BYTES, qf, r32, hi);
        D8F(pA0, pA1, alA, l_reg, pa); SBAR();
        SLOAD8(1, (j + 2) * 64); SBAR();
        D8V(o, Vt_lds, pa, r32, hi); D8P(false, pB0, pB1, m_reg, alB);
        __syncthreads(); if constexpr (NKS == 3) asm volatile("s_waitcnt vmcnt(3)" ::: "memory"); else asm volatile("s_waitcnt vmcnt(2)" ::: "memory");
        SWRITE8(0, 0);
        RESC8(alB); __syncthreads();
        SBAR(); D8Q(pA0, pA1, K_lds, Kr_lds, qf, r32, hi);
        D8F(pB0, pB1, alB, l_reg, pa); SBAR();
        if (j + 3 < NT) SLOAD8(0, (j + 3) * 64); SBAR();
        D8V(o, Vt_lds + VT_BYTES, pa, r32, hi); D8P(false, pA0, pA1, m_reg, alA);
        __syncthreads(); if constexpr (NKS == 3) asm volatile("s_waitcnt vmcnt(3)" ::: "memory"); else asm volatile("s_waitcnt vmcnt(2)" ::: "memory");
        SWRITE8(1, 1);
        RESC8(alA); __syncthreads();
    }
    SBAR(); D8Q(pB0, pB1, K_lds + K8_BYTES, Kr_lds + KR8_BYTES, qf, r32, hi);
    D8F(pA0, pA1, alA, l_reg, pa); SBAR();
    D8V(o, Vt_lds, pa, r32, hi); D8P(false, pB0, pB1, m_reg, alB);
    __syncthreads(); RESC8(alB);
    D8F(pB0, pB1, alB, l_reg, pa); SBAR();
    D8V(o, Vt_lds + VT_BYTES, pa, r32, hi);
    const int tid_e = fresh_tid(wv), wid_e = tid_e >> 6, r32e = tid_e & 31, hie = (tid_e >> 5) & 1;
    float* li_e = (float*)(lds + OFF_WS8) + wid_e * 64;
    if (hie == 0) li_e[r32e] = l_reg; asm volatile("s_waitcnt lgkmcnt(0)" ::: "memory");
    float rli[16];
#pragma unroll
    for (int r = 0; r < 16; ++r) rli[r] = __builtin_amdgcn_rcpf(li_e[da::crow(r, hie)]);
    bf16_t* Ow = F8_OUT ? (bf16_t*)((unsigned char*)a.O + (long)(wid_e * 32) * a.ldo) : a.O + (long)(wid_e * 32) * a.ldo;
#pragma unroll
    for (int r = 0; r < 16; ++r) { const int orow = da::crow(r, hie); const int r32 = r32e;
#pragma unroll
        for (int d0 = 0; d0 < 4; ++d0) { if constexpr (F8_OUT) ((unsigned char*)Ow)[(long)orow * a.ldo + d0 * 32 + r32] = f2fp8(o[d0][r] * rli[r] * O8_SCALE); else Ow[(long)orow * a.ldo + d0 * 32 + r32] = f2bf(o[d0][r] * rli[r]); } }
#undef SLOAD8
#undef SWRITE8
#undef RESC8
}
constexpr int DM_K = 0, DM_KR = 6 * K8_BYTES, DM_VT = DM_KR + 6 * KR8_BYTES, DM_WS = DM_VT + 6 * K8_BYTES, LDS_D8DMA = DM_WS + 8 * 64 * 4;
__device__ __forceinline__ void pv8s(f32x16* o, const char* Vl, const i32x8 pa, int r32, int hi) {
    i32x8 bfr[4];
#pragma unroll
    for (int d0 = 0; d0 < 4; ++d0) { const int c = 32 * d0 + r32; const char* vp = Vl + c * 64; const int sw = (c >> 2) & 3;
        const i32x4 lo = *(const i32x4*)(vp + (((2 * hi) ^ sw) << 4)), hh = *(const i32x4*)(vp + (((2 * hi + 1) ^ sw) << 4)); bfr[d0] = __builtin_shufflevector(lo, hh, 0, 1, 2, 3, 4, 5, 6, 7); }
    asm volatile("s_waitcnt lgkmcnt(0)" ::: "memory"); SBAR();
#pragma unroll
    for (int d0 = 0; d0 < 4; ++d0) o[d0] = D8_MX(pa, bfr[d0], o[d0]);
}
#define LDS16(off) (*(const LAS i32x4*)(ldsl + (off)))
template <int NKS, bool MACC>
__device__ __forceinline__ void qkt8d(f32x16& p0, f32x16& p1, const f32x16& mneg, LAS unsigned char* ldsl, int kb, int rb, const i32x8* qf) {
    i32x8 a0[2], a1[2];
#pragma unroll
    for (int sK = 0; sK < 2; ++sK) {
        { const i32x4 lo = LDS16(kb ^ (64 * sK)), hh = LDS16(kb ^ (64 * sK + 16)); a0[sK] = __builtin_shufflevector(lo, hh, 0, 1, 2, 3, 4, 5, 6, 7); }
        { const i32x4 lo = LDS16((kb ^ (64 * sK)) + 4096), hh = LDS16((kb ^ (64 * sK + 16)) + 4096); a1[sK] = __builtin_shufflevector(lo, hh, 0, 1, 2, 3, 4, 5, 6, 7); } }
    asm volatile("s_waitcnt lgkmcnt(0)" ::: "memory"); SBAR();
    if constexpr (MACC) {
        asm volatile("v_mfma_f32_32x32x64_f8f6f4 %0, %1, %2, %3" : "=&v"(p0) : "v"(a0[0]), "v"(qf[0]), "v"(mneg));
        asm volatile("v_mfma_f32_32x32x64_f8f6f4 %0, %1, %2, %3" : "=&v"(p1) : "v"(a1[0]), "v"(qf[0]), "v"(mneg)); }
    else { p0 = f32x16{}; p1 = f32x16{}; p0 = D8_MX(a0[0], qf[0], p0); p1 = D8_MX(a1[0], qf[0], p1); }
    if constexpr (NKS == 3) { i32x8 r0, r1;
        { const i32x4 lo = LDS16(rb), hh = LDS16(rb ^ 16); r0 = __builtin_shufflevector(lo, hh, 0, 1, 2, 3, 4, 5, 6, 7); }
        { const i32x4 lo = LDS16(rb + 2048), hh = LDS16((rb ^ 16) + 2048); r1 = __builtin_shufflevector(lo, hh, 0, 1, 2, 3, 4, 5, 6, 7); }
        p0 = D8_MX(a0[1], qf[1], p0); p1 = D8_MX(a1[1], qf[1], p1);
        p0 = D8_MX(r0, qf[2], p0); p1 = D8_MX(r1, qf[2], p1); }
    else { p0 = D8_MX(a0[1], qf[1], p0); p1 = D8_MX(a1[1], qf[1], p1); }
    if constexpr (MACC) asm volatile("" : "+v"(p1), "+v"(p0) : "v"(mneg));
}
__device__ __forceinline__ void pv8d(f32x16* o, LAS unsigned char* ldsl, int vb, const i32x8 pa) {
    i32x8 bfr[4];
#pragma unroll
    for (int d0 = 0; d0 < 4; ++d0) { const i32x4 lo = LDS16(vb + d0 * 2048), hh = LDS16((vb ^ 16) + d0 * 2048); bfr[d0] = __builtin_shufflevector(lo, hh, 0, 1, 2, 3, 4, 5, 6, 7); }
    asm volatile("s_waitcnt lgkmcnt(0)" ::: "memory"); SBAR();
#pragma unroll
    for (int d0 = 0; d0 < 4; ++d0) o[d0] = D8_MX(pa, bfr[d0], o[d0]);
}
template <int NKS, bool MACC>
__device__ __forceinline__ void attn_dense8_dma(int wv, const D8Args a, LAS unsigned char* ldsl) {
    constexpr int VAR = 0;
    constexpr bool LSUM = (NKS == 2);
    const int tid = fresh_tid(wv), wid = __builtin_amdgcn_readfirstlane(tid >> 6), lane = tid & 63, r32 = lane & 31, hi = lane >> 5;
    char* lds = (char*)ldsl;
    float m_reg = MACC ? 0.f : -1e30f, l_reg = 0; f32x16 o[4] = {}; i32x8 qf[NKS]; f32x16 mneg = {}; f32x16 lacc = {};
    const i32x8 ones8 = (i32x8){0x38383838, 0x38383838, 0x38383838, 0x38383838, 0x38383838, 0x38383838, 0x38383838, 0x38383838};
    constexpr float QC = MACC ? Cst8<NKS>::C : 1.0f;
    { const bf16_t* Qw = a.Q + (long)(wid * 32 + r32) * a.ldq;
#pragma unroll
      for (int sK = 0; sK < 2; ++sK) { const bf16_t* qp = Qw + 64 * sK + 32 * hi; unsigned w[8];
#pragma unroll
          for (int c = 0; c < 4; ++c) { const u32x4 v = *(const u32x4*)(qp + 8 * c);
              w[2 * c] = pk4_fp8(bflo(v.x) * QC, bfhi(v.x) * QC, bflo(v.y) * QC, bfhi(v.y) * QC); w[2 * c + 1] = pk4_fp8(bflo(v.z) * QC, bfhi(v.z) * QC, bflo(v.w) * QC, bfhi(v.w) * QC); }
          qf[sK] = (i32x8){(int)w[0], (int)w[1], (int)w[2], (int)w[3], (int)w[4], (int)w[5], (int)w[6], (int)w[7]}; }
      if constexpr (NKS == 3) {
          const float pos = (float)(a.pos0 + wid * 32 + r32); const bf16_t* qp = Qw + 128; unsigned w[8];
#pragma unroll
          for (int c = 0; c < 4; ++c) { const u32x4 v1 = *(const u32x4*)(qp + 8 * c), v2 = *(const u32x4*)(qp + 32 + 8 * c);
              const unsigned a1[4] = {v1.x, v1.y, v1.z, v1.w}, a2[4] = {v2.x, v2.y, v2.z, v2.w}; float y[8];
#pragma unroll
              for (int e = 0; e < 8; ++e) { const int i = 8 * c + e; float sn, cs; sincos_rev(pos * inv_freq32(i), sn, cs);
                  const float x1 = (e & 1) ? bfhi(a1[e >> 1]) : bflo(a1[e >> 1]), x2 = (e & 1) ? bfhi(a2[e >> 1]) : bflo(a2[e >> 1]);
                  y[e] = (hi ? (x2 * cs + x1 * sn) : (x1 * cs - x2 * sn)) * QC; }
              w[2 * c] = pk4_fp8(y[0], y[1], y[2], y[3]); w[2 * c + 1] = pk4_fp8(y[4], y[5], y[6], y[7]); }
          qf[2] = (i32x8){(int)w[0], (int)w[1], (int)w[2], (int)w[3], (int)w[4], (int)w[5], (int)w[6], (int)w[7]}; } }
    const unsigned char* ksrc; const unsigned char* vsrc; const unsigned char* rsrc = nullptr;
    { const int ri = 8 * wid + (lane >> 3), hk = (ri >> 2) & 1, ka = 32 * hk + (ri & 3) + 4 * ((ri >> 3) & 3) + 16 * (ri >> 5), kch = ((lane & 7) ^ (ri >> 1)) & 7;
      ksrc = a.K8 + (long)ka * a.ldk + kch * 16;
      const int vc = 16 * wid + (lane >> 2), vp = ((lane & 3) ^ (vc >> 2)) & 3; vsrc = a.Vt8 + (long)vc * a.ldvt + vp * 16;
      if constexpr (NKS == 3) { const int rr = 16 * (wid & 3) + (lane >> 2), rh = (rr >> 2) & 1, ra = 32 * rh + (rr & 3) + 4 * ((rr >> 3) & 3) + 16 * (rr >> 5), rch = ((lane & 3) ^ (rr >> 2)) & 3;
          rsrc = a.Kr8 + (long)ra * 64 + rch * 16; } }
#define D8_DMA2(k0, sb) do { _Pragma("unroll") for (int t_ = 0; t_ < 2; ++t_) { \
      __builtin_amdgcn_global_load_lds((const unsigned*)(ksrc + (long)((k0) + 64 * t_) * a.ldk), (LAS unsigned*)(ldsl + DM_K + (2 * (sb) + t_) * K8_BYTES + wid * 1024), 16, 0, 0); \
      __builtin_amdgcn_global_load_lds((const unsigned*)(vsrc + ((k0) + 64 * t_)), (LAS unsigned*)(ldsl + DM_VT + (2 * (sb) + t_) * K8_BYTES + wid * 1024), 16, 0, 0); } \
      if constexpr (NKS == 3) __builtin_amdgcn_global_load_lds((const unsigned*)(rsrc + (long)((k0) + 64 * (wid >> 2)) * 64), (LAS unsigned*)(ldsl + DM_KR + (2 * (sb) + (wid >> 2)) * KR8_BYTES + (wid & 3) * 1024), 16, 0, 0); } while (0)
#define RESC8(al) do { if (__any((al) < 1.f)) { if (hi == 0) al_l[r32] = (al); asm volatile("s_waitcnt lgkmcnt(0)" ::: "memory"); \
    _Pragma("unroll") for (int d = 0; d < 4; ++d) _Pragma("unroll") for (int r = 0; r < 16; ++r) o[d][r] *= al_l[da::crow(r, hi)]; \
    if constexpr (LSUM) { _Pragma("unroll") for (int r = 0; r < 16; ++r) lacc[r] *= al_l[da::crow(r, hi)]; } } } while (0)
#define D8Qm(P0, P1, b) qkt8d<NKS, MACC>(P0, P1, mneg, ldsl, kb0 + (b) * K8_BYTES, rb0 + (b) * KR8_BYTES, qf)
#define D8Vm(b) do { pv8d(o, ldsl, vb0 + (b) * K8_BYTES, pa); if constexpr (LSUM) lacc = D8_MX(pa, ones8, lacc); } while (0)
#define D8Fm(P0, P1, AL) do { if constexpr (LSUM) finishSM8n(P0, P1, pa); else finishSM8(P0, P1, AL, l_reg, pa); } while (0)
#define D8Pm(FIRST, P0, P1, AL) do { if constexpr (MACC) partialSM8<FIRST, (NKS == 3)>(P0, P1, m_reg, mneg, AL); else partialSM8z<NKS>(P0, P1, m_reg, AL); } while (0)
#define D8_TOP() do { asm volatile("s_waitcnt vmcnt(0)" ::: "memory"); __syncthreads(); } while (0)
    float* al_l = (float*)(lds + DM_WS) + wid * 64 + 32;
    const int kb0 = DM_K + r32 * 128 + ((((r32 >> 1) & 7) << 4) ^ (32 * hi)), rb0 = DM_KR + r32 * 64 + ((((r32 >> 2) & 3) << 4) ^ (32 * hi)), vb0 = DM_VT + r32 * 64 + ((((r32 >> 2) & 3) << 4) ^ (32 * hi));
    f32x16 pA0, pA1, pB0, pB1; float alA, alB; i32x8 pa;
    const int NS = a.seq / 128;
    D8_DMA2(0, 0);
    D8_TOP(); D8_DMA2(128, 1);
    D8Qm(pA0, pA1, 0); D8Pm(true, pA0, pA1, alA); RESC8(alA);
    SBAR(); D8Qm(pB0, pB1, 1);
    D8Fm(pA0, pA1, alA); SBAR();
    D8Vm(0); D8Pm(false, pB0, pB1, alB);
    RESC8(alB);
    int sb = 1, sbp = 0, sbn = 2;
#pragma unroll 1
    for (int J = 1; J < NS; ++J) {
        D8_TOP(); if (J + 1 < NS) D8_DMA2((J + 1) * 128, sbn);
        SBAR(); D8Qm(pA0, pA1, 2 * sb);
        D8Fm(pB0, pB1, alB); SBAR();
        D8Vm(2 * sbp + 1); D8Pm(false, pA0, pA1, alA);
        RESC8(alA);
        SBAR(); D8Qm(pB0, pB1, 2 * sb + 1);
        D8Fm(pA0, pA1, alA); SBAR();
        D8Vm(2 * sb); D8Pm(false, pB0, pB1, alB);
        RESC8(alB);
        { const int t = sbp; sbp = sb; sb = sbn; sbn = t; }
    }
    D8Fm(pB0, pB1, alB); SBAR();
    D8Vm(2 * sbp + 1);
    const int tid_e = fresh_tid(wv), wid_e = tid_e >> 6, r32e = tid_e & 31, hie = (tid_e >> 5) & 1;
    float* li_e = (float*)(lds + DM_WS) + wid_e * 64;
    float rli[16];
    if constexpr (LSUM) {
#pragma unroll
        for (int r = 0; r < 16; ++r) rli[r] = __builtin_amdgcn_rcpf(lacc[r]); (void)li_e; }
    else { if (hie == 0) li_e[r32e] = l_reg; asm volatile("s_waitcnt lgkmcnt(0)" ::: "memory");
#pragma unroll
        for (int r = 0; r < 16; ++r) rli[r] = __builtin_amdgcn_rcpf(li_e[da::crow(r, hie)]); }
    bf16_t* Ow = F8_OUT ? (bf16_t*)((unsigned char*)a.O + (long)(wid_e * 32) * a.ldo) : a.O + (long)(wid_e * 32) * a.ldo;
#pragma unroll
    for (int r = 0; r < 16; ++r) { const int orow = da::crow(r, hie);
#pragma unroll
        for (int d0 = 0; d0 < 4; ++d0) { if constexpr (F8_OUT) ((unsigned char*)Ow)[(long)orow * a.ldo + d0 * 32 + r32e] = f2fp8(o[d0][r] * rli[r] * O8_SCALE); else Ow[(long)orow * a.ldo + d0 * 32 + r32e] = f2bf(o[d0][r] * rli[r]); } }
#undef D8_DMA2
#undef RESC8
#undef D8Qm
#undef D8Vm
#undef D8Fm
#undef D8Pm
#undef D8_TOP
}
template <class P>
__device__ __forceinline__ void sparse8_wave(P& pol, LAS unsigned char* wll, int lane) {
    const int r32 = lane & 31, hi = lane >> 5;
    char* wl = (char*)wll; char* Kl = wl; char* Vl = wl + 8192; float* li_l = (float*)(wl + 16384); float* al_l = li_l + 32;
    constexpr float QCS = 0.088388347648318440f * LOG2E;
    i32x8 qf[2];
    { const bf16_t* Qw = pol.qptr(r32);
#pragma unroll
      for (int sK = 0; sK < 2; ++sK) { const bf16_t* qp = Qw + 64 * sK + 32 * hi; unsigned w[8];
#pragma unroll
          for (int c = 0; c < 4; ++c) { const u32x4 v = *(const u32x4*)(qp + 8 * c);
              w[2 * c] = pk4_fp8(bflo(v.x) * QCS, bfhi(v.x) * QCS, bflo(v.y) * QCS, bfhi(v.y) * QCS); w[2 * c + 1] = pk4_fp8(bflo(v.z) * QCS, bfhi(v.z) * QCS, bflo(v.w) * QCS, bfhi(v.w) * QCS); }
          qf[sK] = (i32x8){(int)w[0], (int)w[1], (int)w[2], (int)w[3], (int)w[4], (int)w[5], (int)w[6], (int)w[7]}; } }
    asm volatile("s_waitcnt vmcnt(0)" ::: "memory");
    f32x16 o[4] = {}; float m_reg = 0.f, l_reg = 0.f; f32x16 mneg = {};
    const int a0k = 32 * ((lane >> 5) & 1) + ((lane >> 3) & 3), che = (((lane & 7) ^ (lane >> 4)) & 7) << 4, cho = che ^ 64;
    const int vcol0 = lane >> 2; const unsigned voff = (unsigned)vcol0 * SEQ + ((((lane & 3) ^ (vcol0 >> 2)) & 3) << 4);
    const int nt = pol.ntiles();
    typename P::TI ti, tn;
#define SP8_UNI(p) ((const unsigned char*)(((unsigned long long)(unsigned)__builtin_amdgcn_readfirstlane((int)((unsigned long long)(p) >> 32)) << 32) | (unsigned)__builtin_amdgcn_readfirstlane((int)(unsigned long long)(p))))
#define SP8_DMA_K(T) do { const unsigned char* kb_ = SP8_UNI((T).k); const unsigned rs_ = (unsigned)__builtin_amdgcn_readfirstlane((int)(T).rs); const unsigned ko_ = (unsigned)a0k * rs_; \
        _Pragma("unroll") for (int i = 0; i < 8; ++i) { const unsigned char* src = kb_ + (unsigned long long)((4 * (i & 3) + 16 * (i >> 2)) * rs_) + (ko_ + (unsigned)((i & 1) ? cho : che)); \
        __builtin_amdgcn_global_load_lds((const unsigned*)src, (LAS unsigned*)(wll + i * 1024), 16, 0, 0); } } while (0)
#define SP8_DMA_V(T) do { const unsigned char* vb_ = SP8_UNI((T).v); \
        _Pragma("unroll") for (int i = 0; i < 8; ++i) { const unsigned char* src = vb_ + (unsigned long long)(16 * i) * SEQ + voff; \
        __builtin_amdgcn_global_load_lds((const unsigned*)src, (LAS unsigned*)(wll + 8192 + i * 1024), 16, 0, 0); } } while (0)
    pol.tile(0, ti);
    SP8_DMA_K(ti); SP8_DMA_V(ti);
#pragma unroll 1
    for (int j = 0; j < nt; ++j) {
        const bool more = (j + 1 < nt);
        if (more) pol.tile(j + 1, tn);
        asm volatile("s_waitcnt vmcnt(8)" ::: "memory");
        f32x16 p0, p1;
        { i32x8 a0[2], a1[2];
#pragma unroll
          for (int sK = 0; sK < 2; ++sK) { const int ch = 4 * sK + 2 * hi;
            { const i32x4 lo = *(const i32x4*)(Kl + K8SWZ(r32, ch)), hh = *(const i32x4*)(Kl + K8SWZ(r32, ch + 1)); a0[sK] = __builtin_shufflevector(lo, hh, 0, 1, 2, 3, 4, 5, 6, 7); }
            { const i32x4 lo = *(const i32x4*)(Kl + K8SWZ(32 + r32, ch)), hh = *(const i32x4*)(Kl + K8SWZ(32 + r32, ch + 1)); a1[sK] = __builtin_shufflevector(lo, hh, 0, 1, 2, 3, 4, 5, 6, 7); } }
          asm volatile("s_waitcnt lgkmcnt(0)" ::: "memory"); SBAR();
          if (more) SP8_DMA_K(tn);
          SBAR();
          if constexpr (P::SPLAT) { float nm = -m_reg; asm volatile("" : "+v"(nm));
#pragma unroll
              for (int r = 0; r < 16; ++r) mneg[r] = nm; }
          asm volatile("v_mfma_f32_32x32x64_f8f6f4 %0, %1, %2, %3" : "=&v"(p0) : "v"(a0[0]), "v"(qf[0]), "v"(mneg));
          asm volatile("v_mfma_f32_32x32x64_f8f6f4 %0, %1, %2, %3" : "=&v"(p1) : "v"(a1[0]), "v"(qf[0]), "v"(mneg));
          p0 = D8_MX(a0[1], qf[1], p0); p1 = D8_MX(a1[1], qf[1], p1);
          asm volatile("" : "+v"(p1), "+v"(p0) : "v"(mneg)); }
        float pmax = -INFINITY;
#pragma unroll
        for (int r = 0; r < 16; ++r) { p0[r] = pol.adj(ti, r, p0[r]); p1[r] = pol.adj(ti, 16 + r, p1[r]); pmax = fmaxf(pmax, fmaxf(p0[r], p1[r])); }
        { auto rr = __builtin_amdgcn_permlane32_swap(__float_as_uint(pmax), __float_as_uint(pmax), false, false);
          pmax = fmaxf(__uint_as_float(rr[0]), __uint_as_float(rr[1])); }
        float alpha = 1.f;
        { const bool first = (l_reg == 0.f) && (pmax > -INFINITY);
          const float delta = first ? pmax : (pmax > THR8 * LOG2E ? pmax : 0.f);
          if (__any(delta != 0.f)) { alpha = first ? 1.f : __builtin_amdgcn_exp2f(-delta); m_reg += delta;
#pragma unroll
              for (int r = 0; r < 16; ++r) { p0[r] -= delta; p1[r] -= delta; }
              if constexpr (!P::SPLAT) { const float nm = -m_reg;
#pragma unroll
                  for (int r = 0; r < 16; ++r) mneg[r] = nm; }
              if (hi == 0) al_l[r32] = alpha; asm volatile("s_waitcnt lgkmcnt(0)" ::: "memory");
#pragma unroll
              for (int d = 0; d < 4; ++d)
#pragma unroll
                  for (int r = 0; r < 16; ++r) o[d][r] *= al_l[da::crow(r, hi)]; } }
        float ps = 0.f;
#pragma unroll
        for (int r = 0; r < 16; ++r) { p0[r] = __builtin_amdgcn_exp2f(p0[r]); p1[r] = __builtin_amdgcn_exp2f(p1[r]); ps += p0[r] + p1[r]; }
        { auto rr = __builtin_amdgcn_permlane32_swap(__float_as_uint(ps), __float_as_uint(ps), false, false);
          ps = __uint_as_float(rr[0]) + __uint_as_float(rr[1]); }
        l_reg = l_reg * alpha + ps;
        const i32x8 pa = (i32x8){(int)pk4_fp8(p0[0], p0[1], p0[2], p0[3]), (int)pk4_fp8(p0[4], p0[5], p0[6], p0[7]), (int)pk4_fp8(p0[8], p0[9], p0[10], p0[11]), (int)pk4_fp8(p0[12], p0[13], p0[14], p0[15]),
                                 (int)pk4_fp8(p1[0], p1[1], p1[2], p1[3]), (int)pk4_fp8(p1[4], p1[5], p1[6], p1[7]), (int)pk4_fp8(p1[8], p1[9], p1[10], p1[11]), (int)pk4_fp8(p1[12], p1[13], p1[14], p1[15])};
        SBAR();
        if (more) asm volatile("s_waitcnt vmcnt(8)" ::: "memory"); else asm volatile("s_waitcnt vmcnt(0)" ::: "memory");
        SBAR();
        { i32x8 bfr[4];
#pragma unroll
          for (int d0 = 0; d0 < 4; ++d0) { const int c = 32 * d0 + r32; const char* vp = Vl + c * 64; const int sw = (c >> 2) & 3;
            const i32x4 lo = *(const i32x4*)(vp + (((2 * hi) ^ sw) << 4)), hh = *(const i32x4*)(vp + (((2 * hi + 1) ^ sw) << 4)); bfr[d0] = __builtin_shufflevector(lo, hh, 0, 1, 2, 3, 4, 5, 6, 7); }
          asm volatile("s_waitcnt lgkmcnt(0)" ::: "memory"); SBAR();
          if (more) SP8_DMA_V(tn);
          SBAR();
#pragma unroll
          for (int d0 = 0; d0 < 4; ++d0) o[d0] = D8_MX(pa, bfr[d0], o[d0]); }
        ti = tn;
    }
#undef SP8_DMA_K
#undef SP8_DMA_V
#undef SP8_UNI
    if (hi == 0) li_l[r32] = l_reg; asm volatile("s_waitcnt lgkmcnt(0)" ::: "memory");
#pragma unroll
    for (int r = 0; r < 16; ++r) { const int qn = da::crow(r, hi); const float rl = __builtin_amdgcn_rcpf(li_l[qn]); bf16_t* op = pol.optr(qn);
#pragma unroll
        for (int d0 = 0; d0 < 4; ++d0) { if constexpr (F8_OUT) ((unsigned char*)op)[d0 * 32 + r32] = f2fp8(o[d0][r] * rl * O8_SCALE); else op[d0 * 32 + r32] = f2bf(o[d0][r] * rl); } }
}
#undef D8Q
#undef D8P
#undef D8F
#undef D8V
#undef D8_LD32
#undef D8_MX
}


struct PolB {
    struct TI { const bf16_t* k; const bf16_t* v; long rs; int kpos0; int iq; float cd; };
    const bf16_t* H0; bf16_t* O; int b, h, a, r16, myn; int lo3, n3, lo2, n2, lo1, n1; float slope2;
    __device__ __forceinline__ void init(const bf16_t* H0_, bf16_t* O_, int w, int lane) {
        H0 = H0_; O = O_; b = w >> 10; h = (w >> 7) & 7; const int wu = w & 127; a = wu >> 4; r16 = wu & 15; myn = lane & 31;
        lo3 = max(a - 2, 0); n3 = min(a + 2, 7) - lo3 + 1;
        lo2 = max(4 * a - 2, 0); n2 = min(4 * a + 5, 31) - lo2 + 1;
        lo1 = max(16 * a - 2, 0); n1 = min(16 * a + 17, 127) - lo1 + 1;
        slope2 = __builtin_amdgcn_exp2f(-(float)(h + 1)) * LOG2E;
    }
    __device__ __forceinline__ const bf16_t* qptr(int n) const { return H0 + (long)(b * SEQ + 512 * a + r16 + 16 * n) * IN0 + 1536 + h * 128; }
    __device__ __forceinline__ bf16_t* optr(int qn) const { const long e = (long)(b * SEQ + 512 * a + r16 + 16 * qn) * DM + 1024 + h * 128; return F8_OUT ? (bf16_t*)((unsigned char*)O + e) : O + e; }
    __device__ __forceinline__ int ntiles() const { return n3 + n2 + n1; }
    __device__ __forceinline__ void tile(int j, TI& ti) const {
        int dil, kt, rd;
        if (j < n3) { dil = 16; kt = lo3 + j; rd = r16; }
        else if (j < n3 + n2) { dil = 4; kt = lo2 + (j - n3); rd = r16 & 3; }
        else { dil = 1; kt = lo1 + (j - n3 - n2); rd = 0; }
        const long tok = (long)b * SEQ + dil * 32 * kt + rd;
        ti.k = H0 + tok * IN0 + 2560 + h * 128; ti.v = H0 + tok * IN0 + 3584 + h * 128; ti.rs = (long)dil * IN0;
        ti.kpos0 = 32 * kt; ti.iq = (512 * a + r16 + 16 * myn - rd) / dil; ti.cd = slope2 * (float)dil;
    }
    __device__ __forceinline__ float adj(const TI& ti, int kloc, float s) const {
        const int d = ti.kpos0 + kloc - ti.iq; const int ad = d < 0 ? -d : d;
        return ad <= 64 ? fmaf(s, 0.088388347648318440f * LOG2E, -ti.cd * (float)ad) : -INFINITY;
    }
};
struct PolC {
    struct TI { const bf16_t* k; const bf16_t* v; long rs; int kc0; int drow; };
    const bf16_t* H1; bf16_t* O; const float* tab; int b, h, r, a, r0, qc, c0;
    __device__ __forceinline__ void init(const bf16_t* H1_, bf16_t* O_, const float* rpb, float* tab_, int w, int lane) {
        H1 = H1_; O = O_; tab = tab_; b = w >> 10; h = (w >> 7) & 7; const int wu = w & 127; r = wu >> 1; a = wu & 1;
        r0 = min(max(r - 4, 0), 56); qc = 32 * a + (lane & 31); c0 = min(max(qc - 8, 0), 48);
        for (int idx = lane; idx < 480; idx += 64) { const int dr = idx >> 5, dc = idx & 31; tab_[idx] = dc < 31 ? rpb[h * 465 + dr * 31 + dc] * LOG2E : 0.f; }
        asm volatile("s_waitcnt vmcnt(0) lgkmcnt(0)" ::: "memory");
    }
    __device__ __forceinline__ const bf16_t* qptr(int n) const { return H1 + (long)(b * SEQ + 64 * r + 32 * a + n) * IN1P + h * 128; }
    __device__ __forceinline__ bf16_t* optr(int qn) const { const long e = (long)(b * SEQ + 64 * r + 32 * a + qn) * DM + h * 128; return F8_OUT ? (bf16_t*)((unsigned char*)O + e) : O + e; }
    __device__ __forceinline__ int ntiles() const { return 16; }
    __device__ __forceinline__ void tile(int j, TI& ti) const {
        const int kr = r0 + (j >> 1), ch = j & 1; const long tok = (long)b * SEQ + 64 * kr + 32 * ch;
        ti.k = H1 + tok * IN1P + 1024 + h * 128; ti.v = H1 + tok * IN1P + 2048 + h * 128; ti.rs = IN1P; ti.kc0 = 32 * ch; ti.drow = kr - r + 7;
    }
    __device__ __forceinline__ float adj(const TI& ti, int kloc, float s) const {
        const int kc = ti.kc0 + kloc; const int dc = min(max(kc - qc + 15, 0), 30);
        const float bias = tab[ti.drow * 32 + dc];
        return (kc >= c0 && kc < c0 + 16) ? fmaf(s, 0.088388347648318440f * LOG2E, bias) : -INFINITY;
    }
};

struct PolB8 {
    static constexpr bool SPLAT = false;
    struct TI { const unsigned char* k; const unsigned char* v; long rs; float fb; float ncd; };
    const bf16_t* H0; bf16_t* O; const unsigned char* K8; const unsigned char* Vt1; const unsigned char* Vt4; const unsigned char* Vt16;
    int b, h, a, r16, myn, hi32; int lo3, n3, lo2, n2, lo1, n1; float slope2;
    __device__ __forceinline__ void init(const bf16_t* H0_, bf16_t* O_, const unsigned char* K8_, const unsigned char* Vt1_, const unsigned char* Vt4_, const unsigned char* Vt16_, int w, int lane) {
        H0 = H0_; O = O_; K8 = K8_; Vt1 = Vt1_; Vt4 = Vt4_; Vt16 = Vt16_; b = w >> 10; h = (w >> 7) & 7; const int wu = w & 127; a = wu >> 4; r16 = wu & 15; myn = lane & 31; hi32 = 32 * (lane >> 5);
        const int t = a >> 1; lo3 = max(t - 1, 0); n3 = min(t + 1, 3) - lo3 + 1;
        lo2 = max(2 * a - 1, 0); n2 = min(2 * a + 2, 15) - lo2 + 1;
        lo1 = max(8 * a - 1, 0); n1 = min(8 * a + 8, 63) - lo1 + 1;
        slope2 = __builtin_amdgcn_exp2f(-(float)(h + 1)) * LOG2E;
    }
    __device__ __forceinline__ const bf16_t* qptr(int n) const { return H0 + (long)(b * SEQ + 512 * a + r16 + 16 * n) * IN0 + 1536 + h * 128; }
    __device__ __forceinline__ bf16_t* optr(int qn) const { const long e = (long)(b * SEQ + 512 * a + r16 + 16 * qn) * DM + 1024 + h * 128; return F8_OUT ? (bf16_t*)((unsigned char*)O + e) : O + e; }
    __device__ __forceinline__ int ntiles() const { return n3 + n2 + n1; }
    __device__ __forceinline__ void tile(int j, TI& ti) const {
        int dil, kt, rd; const unsigned char* vt; int voff;
        if (j < n3) { dil = 16; kt = lo3 + j; rd = r16; vt = Vt16; voff = r16 * 256 + 64 * kt; }
        else if (j < n3 + n2) { dil = 4; kt = lo2 + (j - n3); rd = r16 & 3; vt = Vt4; voff = rd * 1024 + 64 * kt; }
        else { dil = 1; kt = lo1 + (j - n3 - n2); rd = 0; vt = Vt1; voff = 64 * kt; }
        const long tok = (long)b * SEQ + dil * 64 * kt + rd;
        ti.k = K8 + tok * 1024 + h * 128; ti.rs = (long)dil * 1024; ti.v = vt + (long)(b * 8 + h) * 128 * SEQ + voff;
        ti.fb = (float)(64 * kt + hi32 - (512 * a + r16 + 16 * myn - rd) / dil); ti.ncd = -slope2 * (float)dil;
    }
    __device__ __forceinline__ float adj(const TI& ti, int slot, float s) const {
        const float fd = ti.fb + (float)slot;
        return __builtin_fabsf(fd) <= 64.f ? fmaf(__builtin_fabsf(fd), ti.ncd, s) : -INFINITY;
    }
};
struct PolC8 {
    static constexpr bool SPLAT = true;
    struct TI { const unsigned char* k; const unsigned char* v; long rs; const float* tp; };
    const bf16_t* H1; bf16_t* O; const unsigned char* K8; const unsigned char* Vt; const float* tab0; int b, h, r, a, r0; int vmask;
    __device__ __forceinline__ void init(const bf16_t* H1_, bf16_t* O_, const unsigned char* K8_, const unsigned char* Vt_, const float* rpb, float* tab_, int w, int lane) {
        H1 = H1_; O = O_; K8 = K8_; Vt = Vt_; b = w >> 10; h = (w >> 7) & 7; const int wu = w & 127; r = wu >> 1; a = wu & 1;
        r0 = min(max(r - 4, 0), 56); const int qc = 32 * a + (lane & 31), c0 = min(max(qc - 8, 0), 48), hi32 = 32 * (lane >> 5);
        { const int lo = c0 - hi32; const unsigned m16 = 0xffffu; vmask = lo >= 32 || lo <= -16 ? 0 : (int)(lo >= 0 ? (m16 << lo) : (m16 >> (-lo))); }
        tab0 = tab_ + (hi32 - qc + 15);
        { float tv[8];
#pragma unroll
          for (int q = 0; q < 8; ++q) { const int idx = lane + 64 * q, dr = min(idx >> 5, 14), dc = idx & 31; tv[q] = rpb[h * 465 + dr * 31 + min(dc, 30)]; }
#pragma unroll
          for (int q = 0; q < 8; ++q) { const int idx = lane + 64 * q, dc = idx & 31; const float v = dc < 31 ? tv[q] * LOG2E : 0.f; if (idx < 480) tab_[idx] = v; } }
        asm volatile("s_waitcnt vmcnt(0) lgkmcnt(0)" ::: "memory");
    }
    __device__ __forceinline__ const bf16_t* qptr(int n) const { return H1 + (long)(b * SEQ + 64 * r + 32 * a + n) * IN1P + h * 128; }
    __device__ __forceinline__ bf16_t* optr(int qn) const { const long e = (long)(b * SEQ + 64 * r + 32 * a + qn) * DM + h * 128; return F8_OUT ? (bf16_t*)((unsigned char*)O + e) : O + e; }
    __device__ __forceinline__ int ntiles() const { return 8; }
    __device__ __forceinline__ void tile(int j, TI& ti) const {
        const int kr = r0 + j; const long tok = (long)b * SEQ + 64 * kr;
        ti.k = K8 + tok * 1024 + h * 128; ti.rs = 1024; ti.v = Vt + (long)(b * 8 + h) * 128 * SEQ + 64 * kr; ti.tp = tab0 + (kr - r + 7) * 32;
    }
    __device__ __forceinline__ float adjp(const float* tp, int slot, float s) const {
        const float v = s + tp[slot]; const int t = __builtin_amdgcn_sbfe(vmask, slot, 1);
        return __uint_as_float((__float_as_uint(v) & (unsigned)t) | (0xff800000u & ~(unsigned)t));
    }
    __device__ __forceinline__ float adj(const TI& ti, int slot, float s) const {
        const float v = s + ti.tp[slot];
        const int t = __builtin_amdgcn_sbfe(vmask, slot, 1);
        return __uint_as_float((__float_as_uint(v) & (unsigned)t) | (0xff800000u & ~(unsigned)t));
    }
};

#define D8_MXC(a, b, c) __builtin_amdgcn_mfma_scale_f32_32x32x64_f8f6f4(a, b, c, 0, 0, 0, 0, 0, 0)
constexpr int NC_BUF = 16384, NC_WS = 3 * NC_BUF, NC_WAVE = 2304;
__device__ __forceinline__ void nbr8_coop(PolC8& pol, LAS unsigned char* lbase, int wid, int lane) {
    const int r32 = lane & 31, hi = lane >> 5;
    char* lb = (char*)lbase; float* li_l = (float*)(lb + NC_WS + wid * NC_WAVE); float* al_l = li_l + 32;
    constexpr float QCS = 0.088388347648318440f * LOG2E;
    i32x8 qf[2];
    { const bf16_t* Qw = pol.qptr(r32);
#pragma unroll
      for (int sK = 0; sK < 2; ++sK) { const bf16_t* qp = Qw + 64 * sK + 32 * hi; unsigned w[8];
#pragma unroll
          for (int c = 0; c < 4; ++c) { const u32x4 v = *(const u32x4*)(qp + 8 * c);
              w[2 * c] = pk4_fp8(bflo(v.x) * QCS, bfhi(v.x) * QCS, bflo(v.y) * QCS, bfhi(v.y) * QCS); w[2 * c + 1] = pk4_fp8(bflo(v.z) * QCS, bfhi(v.z) * QCS, bflo(v.w) * QCS, bfhi(v.w) * QCS); }
          qf[sK] = (i32x8){(int)w[0], (int)w[1], (int)w[2], (int)w[3], (int)w[4], (int)w[5], (int)w[6], (int)w[7]}; } }
    f32x16 o[4] = {}; float m_reg = 0.f, l_reg = 0.f; f32x16 mneg = {};
    const int R0 = pol.r & ~3, klo = min(max(R0 - 4, 0), 56), khi = min(max(R0 - 1, 0), 56) + 7;
    const unsigned char* ksrc; const unsigned char* vsrc;
    { const int ri = 8 * wid + (lane >> 3), hk = (ri >> 2) & 1, ka = 32 * hk + (ri & 3) + 4 * ((ri >> 3) & 3) + 16 * (ri >> 5), kch = ((lane & 7) ^ (ri >> 1)) & 7;
      ksrc = pol.K8 + ((long)pol.b * SEQ + ka) * 1024 + pol.h * 128 + kch * 16;
      const int vc = 16 * wid + (lane >> 2), vp = ((lane & 3) ^ (vc >> 2)) & 3; vsrc = pol.Vt + ((long)(pol.b * 8 + pol.h) * 128 + vc) * SEQ + vp * 16; }
#define NC_DMA(kr, bf) do { __builtin_amdgcn_global_load_lds((const unsigned*)(ksrc + (long)(kr) * 65536), (LAS unsigned*)(lbase + (bf) * NC_BUF + wid * 1024), 16, 0, 0); \
        __builtin_amdgcn_global_load_lds((const unsigned*)(vsrc + (kr) * 64), (LAS unsigned*)(lbase + (bf) * NC_BUF + 8192 + wid * 1024), 16, 0, 0); } while (0)
    asm volatile("s_waitcnt vmcnt(0)" ::: "memory");
    NC_DMA(klo, 0); NC_DMA(klo + 1, 1);
    int bi = 0;
#pragma unroll 1
    for (int t = klo; t <= khi; ++t) {
        if (t + 1 <= khi) asm volatile("s_waitcnt vmcnt(2)" ::: "memory"); else asm volatile("s_waitcnt vmcnt(0)" ::: "memory");
        __syncthreads();
        if (t + 2 <= khi) { const int bn = bi == 0 ? 2 : bi - 1; NC_DMA(t + 2, bn); }
        if (t >= pol.r0 && t < pol.r0 + 8) {
            const char* Kl = lb + bi * NC_BUF; const char* Vl = Kl + 8192; const float* tp = pol.tab0 + (t - pol.r + 7) * 32;
            f32x16 p0, p1;
            { i32x8 a0[2], a1[2];
#pragma unroll
              for (int sK = 0; sK < 2; ++sK) { const int ch = 4 * sK + 2 * hi;
                { const i32x4 lo = *(const i32x4*)(Kl + K8SWZ(r32, ch)), hh = *(const i32x4*)(Kl + K8SWZ(r32, ch + 1)); a0[sK] = __builtin_shufflevector(lo, hh, 0, 1, 2, 3, 4, 5, 6, 7); }
                { const i32x4 lo = *(const i32x4*)(Kl + K8SWZ(32 + r32, ch)), hh = *(const i32x4*)(Kl + K8SWZ(32 + r32, ch + 1)); a1[sK] = __builtin_shufflevector(lo, hh, 0, 1, 2, 3, 4, 5, 6, 7); } }
              asm volatile("s_waitcnt lgkmcnt(0)" ::: "memory"); SBAR();
              { float nm = -m_reg; asm volatile("" : "+v"(nm));
#pragma unroll
                for (int r = 0; r < 16; ++r) mneg[r] = nm; }
              asm volatile("v_mfma_f32_32x32x64_f8f6f4 %0, %1, %2, %3" : "=&v"(p0) : "v"(a0[0]), "v"(qf[0]), "v"(mneg));
              asm volatile("v_mfma_f32_32x32x64_f8f6f4 %0, %1, %2, %3" : "=&v"(p1) : "v"(a1[0]), "v"(qf[0]), "v"(mneg));
              p0 = D8_MXC(a0[1], qf[1], p0); p1 = D8_MXC(a1[1], qf[1], p1);
              asm volatile("" : "+v"(p1), "+v"(p0) : "v"(mneg)); }
            float pmax = -INFINITY;
#pragma unroll
            for (int r = 0; r < 16; ++r) { p0[r] = pol.adjp(tp, r, p0[r]); p1[r] = pol.adjp(tp, 16 + r, p1[r]); pmax = fmaxf(pmax, fmaxf(p0[r], p1[r])); }
            { auto rr = __builtin_amdgcn_permlane32_swap(__float_as_uint(pmax), __float_as_uint(pmax), false, false);
              pmax = fmaxf(__uint_as_float(rr[0]), __uint_as_float(rr[1])); }
            float alpha = 1.f;
            { const bool first = (l_reg == 0.f) && (pmax > -INFINITY);
              const float delta = first ? pmax : (pmax > d8::THR8 * LOG2E ? pmax : 0.f);
              if (__any(delta != 0.f)) { alpha = first ? 1.f : __builtin_amdgcn_exp2f(-delta); m_reg += delta;
#pragma unroll
                  for (int r = 0; r < 16; ++r) { p0[r] -= delta; p1[r] -= delta; }
                  if (hi == 0) al_l[r32] = alpha; asm volatile("s_waitcnt lgkmcnt(0)" ::: "memory");
#pragma unroll
                  for (int d = 0; d < 4; ++d)
#pragma unroll
                      for (int r = 0; r < 16; ++r) o[d][r] *= al_l[da::crow(r, hi)]; } }
            float ps = 0.f;
#pragma unroll
            for (int r = 0; r < 16; ++r) { p0[r] = __builtin_amdgcn_exp2f(p0[r]); p1[r] = __builtin_amdgcn_exp2f(p1[r]); ps += p0[r] + p1[r]; }
            { auto rr = __builtin_amdgcn_permlane32_swap(__float_as_uint(ps), __float_as_uint(ps), false, false);
              ps = __uint_as_float(rr[0]) + __uint_as_float(rr[1]); }
            l_reg = l_reg * alpha + ps;
            const i32x8 pa = (i32x8){(int)pk4_fp8(p0[0], p0[1], p0[2], p0[3]), (int)pk4_fp8(p0[4], p0[5], p0[6], p0[7]), (int)pk4_fp8(p0[8], p0[9], p0[10], p0[11]), (int)pk4_fp8(p0[12], p0[13], p0[14], p0[15]),
                                     (int)pk4_fp8(p1[0], p1[1], p1[2], p1[3]), (int)pk4_fp8(p1[4], p1[5], p1[6], p1[7]), (int)pk4_fp8(p1[8], p1[9], p1[10], p1[11]), (int)pk4_fp8(p1[12], p1[13], p1[14], p1[15])};
            SBAR();
            { i32x8 bfr[4];
#pragma unroll
              for (int d0 = 0; d0 < 4; ++d0) { const int c = 32 * d0 + r32; const char* vp = Vl + c * 64; const int sw = (c >> 2) & 3;
                const i32x4 lo = *(const i32x4*)(vp + (((2 * hi) ^ sw) << 4)), hh = *(const i32x4*)(vp + (((2 * hi + 1) ^ sw) << 4)); bfr[d0] = __builtin_shufflevector(lo, hh, 0, 1, 2, 3, 4, 5, 6, 7); }
              asm volatile("s_waitcnt lgkmcnt(0)" ::: "memory"); SBAR();
#pragma unroll
              for (int d0 = 0; d0 < 4; ++d0) o[d0] = D8_MXC(pa, bfr[d0], o[d0]); }
        }
        bi = bi == 2 ? 0 : bi + 1;
    }
#undef NC_DMA
    if (hi == 0) li_l[r32] = l_reg; asm volatile("s_waitcnt lgkmcnt(0)" ::: "memory");
#pragma unroll
    for (int r = 0; r < 16; ++r) { const int qn = da::crow(r, hi); const float rl = __builtin_amdgcn_rcpf(li_l[qn]); bf16_t* op = pol.optr(qn);
#pragma unroll
        for (int d0 = 0; d0 < 4; ++d0) { if constexpr (F8_OUT) ((unsigned char*)op)[d0 * 32 + r32] = f2fp8(o[d0][r] * rl * O8_SCALE); else op[d0 * 32 + r32] = f2bf(o[d0][r] * rl); } }
}

struct Params { const float* in[28]; float* out; unsigned char* ws; int ph_lo, ph_hi; };
enum { I_X = 0, I_RW = 1, I_RB = 2, I_WIN0 = 3, I_AQN = 4, I_AKN = 5, I_WOUT0 = 6, I_LN1G0 = 7, I_LN1B0 = 8, I_WG0 = 9, I_WU0 = 10, I_WD0 = 11, I_LN2G0 = 12, I_LN2B0 = 13,
       I_WIN1 = 14, I_RPB = 15, I_DQN = 16, I_WQUP = 17, I_DKVN = 18, I_WKVUP = 19, I_WOUT1 = 20, I_LN1G1 = 21, I_LN1B1 = 22, I_WG1 = 23, I_WU1 = 24, I_WD1 = 25, I_LN2G1 = 26, I_LN2B1 = 27 };

__device__ __forceinline__ void tr_tile(const float* __restrict__ src, int N, const float* __restrict__ ksc, bf16_t* __restrict__ dst, int ldd, int k0, int n0, int drow0, LAS unsigned* tl, int tid) {
    const int c4 = (tid & 15) * 4;
#pragma unroll
    for (int i = 0; i < 2; ++i) {
        const int kp = (tid >> 4) + 32 * i;
        const float* s0 = src + (size_t)(k0 + 2 * kp) * N + n0 + c4;
        f32x4 a = *(const f32x4*)s0, b = *(const f32x4*)(s0 + N);
        if (ksc) { const float sa = ksc[k0 + 2 * kp], sb = ksc[k0 + 2 * kp + 1]; a *= sa; b *= sb; }
#pragma unroll
        for (int j = 0; j < 4; ++j) tl[(c4 + j) * 65 + kp] = cvtpk(a[j], b[j]);
    }
    __syncthreads();
    const int n = tid >> 3, seg = tid & 7;
    unsigned w[8];
#pragma unroll
    for (int q = 0; q < 8; ++q) w[q] = tl[n * 65 + seg * 8 + q];
    u32x4* d = (u32x4*)(dst + (size_t)(drow0 + n) * ldd + k0 + seg * 16);
    d[0] = (u32x4){w[0], w[1], w[2], w[3]}; d[1] = (u32x4){w[4], w[5], w[6], w[7]};
    __syncthreads();
}
__device__ __forceinline__ void tr_tile8(const float* __restrict__ src, int N, const float* __restrict__ ksc, float wscale, unsigned char* __restrict__ dst, int ldd, int k0, int n0, int drow0, LAS unsigned* tl, int tid) {
    const int c4 = (tid & 15) * 4, kq = tid >> 4;
    const float* s0 = src + (size_t)(k0 + 4 * kq) * N + n0 + c4;
    f32x4 a = *(const f32x4*)s0, b = *(const f32x4*)(s0 + N), c = *(const f32x4*)(s0 + 2 * (size_t)N), d = *(const f32x4*)(s0 + 3 * (size_t)N);
    float sa = wscale, sb = wscale, sc = wscale, sd = wscale;
    if (ksc) { sa *= ksc[k0 + 4 * kq]; sb *= ksc[k0 + 4 * kq + 1]; sc *= ksc[k0 + 4 * kq + 2]; sd *= ksc[k0 + 4 * kq + 3]; }
#pragma unroll
    for (int j = 0; j < 4; ++j) tl[(c4 + j) * 33 + kq] = pk4_fp8(a[j] * sa, b[j] * sb, c[j] * sc, d[j] * sd);
    __syncthreads();
    const int n = tid >> 3, seg = tid & 7;
    unsigned w[4];
#pragma unroll
    for (int q = 0; q < 4; ++q) w[q] = tl[n * 33 + seg * 4 + q];
    *(u32x4*)(dst + (size_t)(drow0 + n) * ldd + k0 + seg * 16) = (u32x4){w[0], w[1], w[2], w[3]};
    __syncthreads();
}
struct TJob { const float* src; bf16_t* dst; const float* ksc; int K, N, ldd, gu; size_t sbs, dbs; int f8; };
constexpr float W8_SCALE = 64.f;
constexpr int W8_SBYTE = 0x79797979;
__device__ __forceinline__ void run_tjob(const TJob& jb, int t, LAS unsigned* tl, int tid) {
    const int ntn = jb.N / 64, ntk = jb.K / 128, per = ntn * ntk;
    const int bi = t / per, r = t % per, tk = r / ntn, tn = r % ntn;
    const int n0 = tn * 64;
    const int drow0 = jb.gu ? (256 * (n0 >> 7) + (jb.gu == 2 ? 128 : 0) + (n0 & 127)) : n0;
    if (jb.f8) tr_tile8(jb.src + (size_t)bi * jb.sbs, jb.N, jb.ksc, W8_SCALE, (unsigned char*)jb.dst + (size_t)bi * jb.dbs, jb.ldd, tk * 128, n0, drow0, tl, tid);
    else tr_tile(jb.src + (size_t)bi * jb.sbs, jb.N, jb.ksc, jb.dst + (size_t)bi * jb.dbs, jb.ldd, tk * 128, n0, drow0, tl, tid);
}
typedef __attribute__((address_space(4))) const unsigned long long kcu64_t;
#define PIN(i) ((const float*)(__attribute__((address_space(1))) const float*)ka[i])
__device__ __forceinline__ void phase_prologue(kcu64_t* ka, unsigned char* ws, LAS unsigned char* lds, int G, int bid, int tid) {
    LAS unsigned* tl = (LAS unsigned*)lds;
    constexpr int NJ = 12;
    const int cnts[NJ] = {16 * 72, 16 * 32, 4096, 4096, 4096, 16 * 61, 16 * 32, 4096, 4096, 4096, 4 * 24, 2 * 32};
    int total = 0;
#pragma unroll
    for (int j = 0; j < NJ; ++j) total += cnts[j];
    for (int t = bid; t < total; t += G) {
        int j = 0, base = 0;
#pragma unroll
        for (int q = 0; q < NJ - 1; ++q) if (t >= base + cnts[q] && j == q) { base += cnts[q]; j = q + 1; }
        const int tt = t - base;
        TJob jb;
        switch (j) {
            case 0: jb = TJob{PIN(I_WIN0), (bf16_t*)(ws + WS_WIN0), nullptr, 2048, IN0, 2048, 0, 0, 0, F8_IN}; break;
            case 1: jb = TJob{PIN(I_WOUT0), (bf16_t*)(ws + WS_WOUT0), nullptr, 2048, 2048, 2048, 0, 0, 0, F8_OUT}; break;
            case 2: jb = TJob{PIN(I_WG0), (bf16_t*)(ws + WS_WGU0), nullptr, 2048, 512, 2048, 1, (size_t)2048 * 512, (size_t)1024 * 2048, F8_GU}; break;
            case 3: jb = TJob{PIN(I_WU0), (bf16_t*)(ws + WS_WGU0), nullptr, 2048, 512, 2048, 2, (size_t)2048 * 512, (size_t)1024 * 2048, F8_GU}; break;
            case 4: jb = TJob{PIN(I_WD0), (bf16_t*)(ws + WS_WD0), nullptr, 512, 2048, 512, 0, (size_t)512 * 2048, (size_t)2048 * 512, F8_DOWN}; break;
            case 5: jb = TJob{PIN(I_WIN1), (bf16_t*)(ws + WS_WIN1), nullptr, 2048, IN1, 2048, 0, 0, 0, F8_IN}; break;
            case 6: jb = TJob{PIN(I_WOUT1), (bf16_t*)(ws + WS_WOUT1), nullptr, 2048, 2048, 2048, 0, 0, 0, F8_OUT}; break;
            case 7: jb = TJob{PIN(I_WG1), (bf16_t*)(ws + WS_WGU1), nullptr, 2048, 512, 2048, 1, (size_t)2048 * 512, (size_t)1024 * 2048, F8_GU}; break;
            case 8: jb = TJob{PIN(I_WU1), (bf16_t*)(ws + WS_WGU1), nullptr, 2048, 512, 2048, 2, (size_t)2048 * 512, (size_t)1024 * 2048, F8_GU}; break;
            case 9: jb = TJob{PIN(I_WD1), (bf16_t*)(ws + WS_WD1), nullptr, 512, 2048, 512, 0, (size_t)512 * 2048, (size_t)2048 * 512, F8_DOWN}; break;
            case 10: jb = TJob{PIN(I_WQUP), (bf16_t*)(ws + WS_WQUP), PIN(I_DQN), 512, 1536, 512, 0, 0, 0, 0}; break;
            default: jb = TJob{PIN(I_WKVUP), (bf16_t*)(ws + WS_WKVUP), PIN(I_DKVN), 256, 2048, 256, 0, 0, 0, 0}; break;
        }
        run_tjob(jb, tt, tl, tid);
    }
    { constexpr size_t ESZ = F8_IN ? 1 : 2;
      u32x4* z = (u32x4*)(ws + WS_WIN1 + (size_t)IN1 * 2048 * ESZ); const size_t n16 = (size_t)(IN1P - IN1) * 2048 * ESZ / 16;
      const unsigned zu = __float_as_uint(fresh_zero());
      for (size_t i = (size_t)bid * NTHR + tid; i < n16; i += (size_t)G * NTHR) z[i] = (u32x4){zu, zu, zu, zu}; }
    { const f32x8* xs = (const f32x8*)PIN(I_X); const size_t n8 = (size_t)T_ * DM / 8;
      if constexpr (F8_IN) { u32x2* xd = (u32x2*)(ws + WS_RC + 64 * MiB);
          for (size_t i = (size_t)bid * NTHR + tid; i < n8; i += (size_t)G * NTHR) { const f32x8 v = xs[i]; xd[i] = (u32x2){pk4_fp8(v[0], v[1], v[2], v[3]), pk4_fp8(v[4], v[5], v[6], v[7])}; } }
      else { u32x4* xd = (u32x4*)(ws + WS_RA);
          for (size_t i = (size_t)bid * NTHR + tid; i < n8; i += (size_t)G * NTHR) { const f32x8 v = xs[i];
              xd[i] = (u32x4){cvtpk(v[0], v[1]), cvtpk(v[2], v[3]), cvtpk(v[4], v[5]), cvtpk(v[6], v[7])}; } } }
}

template <int X> __device__ __forceinline__ float swzf(float v) { return __int_as_float(__builtin_amdgcn_ds_swizzle(__float_as_int(v), (X << 10) | 0x1f)); }
template <int X> __device__ __forceinline__ unsigned swzu(unsigned v) { return (unsigned)__builtin_amdgcn_ds_swizzle((int)v, (X << 10) | 0x1f); }
__device__ __forceinline__ void phase_prep_qk(bf16_t* H0, const float* qn, const float* kn, unsigned char* K8, int G, int bid, int tid) {
    const int wid = __builtin_amdgcn_readfirstlane(tid >> 6), lane = tid & 63;
    const int cch = lane & 15, half = cch >> 3, ci = cch & 7; const bool isx2 = ci >= 4;
    float gqo[8], gqp[8], gko[8], gkp[8], invf[8];
#pragma unroll
    for (int j = 0; j < 8; ++j) { gqo[j] = qn[8 * cch + j]; gqp[j] = qn[8 * (cch ^ 4) + j]; gko[j] = kn[8 * cch + j]; gkp[j] = kn[8 * (cch ^ 4) + j]; invf[j] = inv_freq32(8 * (ci & 3) + j); }
    const int mstep = G * 8, m0 = bid * 8 + wid;
    u32x4 rawc[3], rawn[3];
#define PQK_LOAD(mm, R) do { const bf16_t* rp_ = H0 + (size_t)(mm) * IN0; _Pragma("unroll") for (int p = 0; p < 3; ++p) { if (p < 2 || lane < 32) { const int hh = 4 * p + (lane >> 4); \
        (R)[p] = *(const u32x4*)(rp_ + (hh < 8 ? hh * 128 : 1024 + (hh - 8) * 128) + 8 * cch); } } } while (0)
    rawc[2] = (u32x4){0u, 0u, 0u, 0u}; rawn[2] = rawc[2];
    if (m0 < T_) PQK_LOAD(m0, rawc);
    rawn[0] = rawc[0]; rawn[1] = rawc[1];
    for (int m = m0; m < T_; m += mstep) {
        if (m + mstep < T_) PQK_LOAD(m + mstep, rawn);
        const int sq = m & (SEQ - 1); const float pos = (float)(half ? (sq & 63) : (sq >> 6));
        float sn[8], cs[8];
#pragma unroll
        for (int j = 0; j < 8; ++j) sincos_rev(pos * invf[j], sn[j], cs[j]);
        bf16_t* rowp = H0 + (size_t)m * IN0;
#pragma unroll
        for (int p = 0; p < 3; ++p) {
            if (p < 2 || lane < 32) {
                const int hh = 4 * p + (lane >> 4); const bool isq = hh < 8;
                bf16_t* cp = rowp + (isq ? hh * 128 : 1024 + (hh - 8) * 128) + 8 * cch;
                const u32x4 raw = rawc[p];
                const unsigned rw4[4] = {raw.x, raw.y, raw.z, raw.w}; float x[8], xp[8]; float ss = 0.f;
#pragma unroll
                for (int q = 0; q < 4; ++q) { x[2 * q] = bflo(rw4[q]); x[2 * q + 1] = bfhi(rw4[q]); ss += x[2 * q] * x[2 * q] + x[2 * q + 1] * x[2 * q + 1];
                    const unsigned pw = swzu<4>(rw4[q]); xp[2 * q] = bflo(pw); xp[2 * q + 1] = bfhi(pw); }
                ss += swzf<1>(ss); ss += swzf<2>(ss); ss += swzf<4>(ss); ss += swzf<8>(ss);
                const float r = rsqrtf(ss * (1.0f / 128.0f) + 1e-6f);
                float o[8];
#pragma unroll
                for (int j = 0; j < 8; ++j) { const float yo = x[j] * r * (isq ? gqo[j] : gko[j]), yp = xp[j] * r * (isq ? gqp[j] : gkp[j]);
                    o[j] = isx2 ? (yo * cs[j] + yp * sn[j]) : (yo * cs[j] - yp * sn[j]); }
                *(u32x4*)cp = (u32x4){cvtpk(o[0], o[1]), cvtpk(o[2], o[3]), cvtpk(o[4], o[5]), cvtpk(o[6], o[7])};
                if (F8_ATTA && !isq) *(u32x2*)(K8 + (size_t)m * 256 + (hh - 8) * 128 + 8 * cch) = (u32x2){pk4_fp8(o[0], o[1], o[2], o[3]), pk4_fp8(o[4], o[5], o[6], o[7])};
            }
        }
        rawc[0] = rawn[0]; rawc[1] = rawn[1]; rawc[2] = rawn[2];
    }
#undef PQK_LOAD
}
__device__ __forceinline__ void phase_vt8(const bf16_t* H0, unsigned char* Vt8, LAS unsigned char* lds, int G, int bid, int tid) {
    const int t = tid >> 3, seg = tid & 7, c = tid >> 2, part = tid & 3;
    for (int u = bid; u < 1024; u += G) {
        const int b = u >> 7, kvh = (u >> 6) & 1, ch = u & 63;
        const bf16_t* src = H0 + (size_t)(b * SEQ + ch * 64 + t) * IN0 + 1280 + kvh * 128 + seg * 16;
        const u32x4 v0 = *(const u32x4*)src, v1 = *(const u32x4*)(src + 8);
        const unsigned w[8] = {v0.x, v0.y, v0.z, v0.w, v1.x, v1.y, v1.z, v1.w};
        __syncthreads();
#pragma unroll
        for (int j = 0; j < 8; ++j) { lds[(16 * seg + 2 * j) * 80 + t] = f2fp8(bflo(w[j])); lds[(16 * seg + 2 * j + 1) * 80 + t] = f2fp8(bfhi(w[j])); }
        __syncthreads();
        const u32x4 o = *(const LAS u32x4*)(lds + c * 80 + part * 16);
        *(u32x4*)(Vt8 + ((size_t)(b * 2 + kvh) * 128 + c) * SEQ + ch * 64 + part * 16) = o;
    }
    __syncthreads();
}
__device__ __forceinline__ void phase_k8_copy(const bf16_t* H, int ldh, int col0, unsigned char* K8, int G, int bid, int tid) {
    for (size_t i = (size_t)bid * NTHR + tid; i < (size_t)T_ * 128; i += (size_t)G * NTHR) { const size_t m = i >> 7; const int c = (int)(i & 127) * 8;
        const u32x4 v = *(const u32x4*)(H + m * ldh + col0 + c);
        *(u32x2*)(K8 + m * 1024 + c) = (u32x2){pk4_fp8(bflo(v.x), bfhi(v.x), bflo(v.y), bfhi(v.y)), pk4_fp8(bflo(v.z), bfhi(v.z), bflo(v.w), bfhi(v.w))}; }
}
__device__ __forceinline__ void tr4x4(unsigned w0, unsigned w1, unsigned w2, unsigned w3, unsigned (&o)[4]) {
    const unsigned a_lo = __builtin_amdgcn_perm(w1, w0, 0x05010400u), a_hi = __builtin_amdgcn_perm(w1, w0, 0x07030602u);
    const unsigned b_lo = __builtin_amdgcn_perm(w3, w2, 0x05010400u), b_hi = __builtin_amdgcn_perm(w3, w2, 0x07030602u);
    o[0] = __builtin_amdgcn_perm(b_lo, a_lo, 0x05040100u); o[1] = __builtin_amdgcn_perm(b_lo, a_lo, 0x07060302u);
    o[2] = __builtin_amdgcn_perm(b_hi, a_hi, 0x05040100u); o[3] = __builtin_amdgcn_perm(b_hi, a_hi, 0x07060302u);
}
template <bool DIL>
__device__ __forceinline__ void phase_vt_heads(const unsigned char* V8, unsigned char* Vt1, unsigned char* Vt4, unsigned char* Vt16, LAS unsigned char* lds, int G, int bid, int tid) {
    constexpr int PITCH = 272, IMG = 128 * PITCH;
    const int cb = tid & 31, tq = tid >> 5;
    for (int u = bid; u < 1024; u += G) {
        const int b = u >> 7, h = (u >> 4) & 7, ch = u & 15;
        const unsigned char* src = V8 + (size_t)(b * SEQ + 256 * ch) * 1024 + h * 128 + 4 * cb;
        __syncthreads();
#pragma unroll
        for (int k = 0; k < 4; ++k) { const int tg = tq + 16 * k;
            unsigned o[4];
            { const int t0 = 4 * tg;
              tr4x4(*(const unsigned*)(src + (size_t)(t0 + 0) * 1024), *(const unsigned*)(src + (size_t)(t0 + 1) * 1024), *(const unsigned*)(src + (size_t)(t0 + 2) * 1024), *(const unsigned*)(src + (size_t)(t0 + 3) * 1024), o);
#pragma unroll
              for (int j = 0; j < 4; ++j) *(LAS unsigned*)(lds + (4 * cb + j) * PITCH + 4 * tg) = o[j]; }
            if constexpr (DIL) {
                { const int r = tg & 3, g = tg >> 2; const int t0 = r + 16 * g;
                  tr4x4(*(const unsigned*)(src + (size_t)(t0 + 0) * 1024), *(const unsigned*)(src + (size_t)(t0 + 4) * 1024), *(const unsigned*)(src + (size_t)(t0 + 8) * 1024), *(const unsigned*)(src + (size_t)(t0 + 12) * 1024), o);
#pragma unroll
                  for (int j = 0; j < 4; ++j) *(LAS unsigned*)(lds + IMG + (4 * cb + j) * PITCH + r * 64 + 4 * g) = o[j]; }
                { const int cls = tg & 15, g = tg >> 4; const int t0 = cls + 64 * g;
                  tr4x4(*(const unsigned*)(src + (size_t)(t0 + 0) * 1024), *(const unsigned*)(src + (size_t)(t0 + 16) * 1024), *(const unsigned*)(src + (size_t)(t0 + 32) * 1024), *(const unsigned*)(src + (size_t)(t0 + 48) * 1024), o);
#pragma unroll
                  for (int j = 0; j < 4; ++j) *(LAS unsigned*)(lds + 2 * IMG + (4 * cb + j) * PITCH + cls * 16 + 4 * g) = o[j]; }
            }
        }
        __syncthreads();
        const size_t cbase = (size_t)(b * 8 + h) * 128;
#pragma unroll
        for (int k = 0; k < 4; ++k) { const int id = tid + NTHR * k, col = id >> 4, pc = id & 15;
            *(u32x4*)(Vt1 + (cbase + col) * SEQ + 256 * ch + pc * 16) = *(const LAS u32x4*)(lds + col * PITCH + pc * 16);
            if constexpr (DIL) {
                *(u32x4*)(Vt4 + (cbase + col) * SEQ + (pc >> 2) * 1024 + 64 * ch + (pc & 3) * 16) = *(const LAS u32x4*)(lds + IMG + col * PITCH + pc * 16);
                *(u32x4*)(Vt16 + (cbase + col) * SEQ + pc * 256 + 16 * ch) = *(const LAS u32x4*)(lds + 2 * IMG + col * PITCH + pc * 16); } }
    }
    __syncthreads();
}
__device__ __forceinline__ void phase_prep_mla(bf16_t* H1, bf16_t* krope, unsigned char* kr8, int G, int bid, int tid) {
    const int wid = __builtin_amdgcn_readfirstlane(tid >> 6), lane = tid & 63;
    const float invf = inv_freq32(lane & 31);
    for (int m = bid * 8 + wid; m < T_; m += G * 8) {
        bf16_t* rowp = H1 + (size_t)m * IN1P;
        const u32x4 a = *(const u32x4*)(rowp + 3072 + lane * 8);
        float ss = bflo(a.x) * bflo(a.x) + bfhi(a.x) * bfhi(a.x) + bflo(a.y) * bflo(a.y) + bfhi(a.y) * bfhi(a.y) + bflo(a.z) * bflo(a.z) + bfhi(a.z) * bfhi(a.z) + bflo(a.w) * bflo(a.w) + bfhi(a.w) * bfhi(a.w);
        ss = wave_sum(ss);
        const u32x2 c = *(const u32x2*)(rowp + 3584 + lane * 4);
        float s2 = bflo(c.x) * bflo(c.x) + bfhi(c.x) * bfhi(c.x) + bflo(c.y) * bflo(c.y) + bfhi(c.y) * bfhi(c.y);
        s2 = wave_sum(s2);
        const float rq = rsqrtf(ss * (1.0f / 512.0f) + 1e-6f), rkv = rsqrtf(s2 * (1.0f / 256.0f) + 1e-6f);
        *(u32x4*)(rowp + 3072 + lane * 8) = (u32x4){cvtpk(bflo(a.x) * rq, bfhi(a.x) * rq), cvtpk(bflo(a.y) * rq, bfhi(a.y) * rq), cvtpk(bflo(a.z) * rq, bfhi(a.z) * rq), cvtpk(bflo(a.w) * rq, bfhi(a.w) * rq)};
        *(u32x2*)(rowp + 3584 + lane * 4) = (u32x2){cvtpk(bflo(c.x) * rkv, bfhi(c.x) * rkv), cvtpk(bflo(c.y) * rkv, bfhi(c.y) * rkv)};
        if (lane < 32) { const float x1 = bf2f(rowp[3840 + lane]), x2 = bf2f(rowp[3840 + 32 + lane]);
            float sn, cs; sincos_rev((float)(m & (SEQ - 1)) * invf, sn, cs);
            const float o1 = x1 * cs - x2 * sn, o2 = x2 * cs + x1 * sn;
            krope[(size_t)m * 64 + lane] = f2bf(o1); krope[(size_t)m * 64 + 32 + lane] = f2bf(o2);
            if (F8_ATTD) { kr8[(size_t)m * 64 + lane] = f2fp8(o1); kr8[(size_t)m * 64 + 32 + lane] = f2fp8(o2); } }
    }
}

constexpr int LNR_PITCH = 2052;
constexpr int LNR_PART = 131584, LNR_SC = 147968, LNR_SEL = 150016, LNR_BLE = 152064, LNR_HIST = 153088;
template <bool RES_F32>
__device__ __forceinline__ void phase_ln_router(const bf16_t* mix, const void* res, const float* g, const float* bb, const float* rw, const float* rb, bf16_t* x1b, unsigned char* x1q,
                                                int* tok_e, int* tok_p, float* tok_g, int* list, unsigned* cnt, LAS unsigned char* lds, int G, int bid, int tid, bool commit = true) {
    const int wid = __builtin_amdgcn_readfirstlane(tid >> 6), lane = tid & 63;
    float ALPHA = 1.4142135623730951f; asm volatile("" : "+v"(ALPHA));
    LAS float* xs = (LAS float*)lds; LAS float* part = (LAS float*)(lds + LNR_PART); LAS float* scs = (LAS float*)(lds + LNR_SC); LAS float* sels = (LAS float*)(lds + LNR_SEL);
    LAS int* ble = (LAS int*)(lds + LNR_BLE); LAS int* hist = (LAS int*)(lds + LNR_HIST);
    f16x8 bw[8][2];
    { const float* rwp = rw + (size_t)(256 * wid + 8 * (lane >> 4)) * 32 + (lane & 15);
#pragma unroll
      for (int ks = 0; ks < 8; ++ks)
#pragma unroll
        for (int hf = 0; hf < 2; ++hf)
#pragma unroll
          for (int j = 0; j < 8; ++j) bw[ks][hf][j] = (_Float16)rwp[(32 * ks + j) * 32 + 16 * hf]; }
    typedef typename std::conditional<RES_F32, f32x4, u32x2>::type res_t;
    typedef typename std::conditional<F8_MIX != 0, unsigned, u32x2>::type mix_t;
    mix_t mv[2][8]; res_t rv[2][8];
#define LNR_LOAD(tix_, rr) do { const size_t eo = ((size_t)(tix_) * 16 + 2 * wid + (rr)) * DM + 4 * lane; \
        _Pragma("unroll") for (int i = 0; i < 8; ++i) { if constexpr (F8_MIX != 0) mv[rr][i] = *(const mix_t*)((const unsigned char*)mix + eo + 256 * i); else mv[rr][i] = *(const mix_t*)(mix + eo + 256 * i); \
            if constexpr (RES_F32) rv[rr][i] = *(const res_t*)((const float*)res + eo + 256 * i); else rv[rr][i] = *(const res_t*)((const bf16_t*)res + eo + 256 * i); } } while (0)
    const int ntile = T_ / 16;
    int ntl = 0;
    if (bid < ntile) LNR_LOAD(bid, 0);
    const int lane0 = lane;
    for (int it = 0; bid + G * it < ntile; ++it) {
        const int tix = bid + G * it;
        int lane = lane0; asm volatile("" : "+v"(lane));
#pragma unroll
        for (int rr = 0; rr < 2; ++rr) {
            const int row = 2 * wid + rr; const size_t m = (size_t)tix * 16 + row;
            f32x4 zr[8]; float s = 0.f;
#pragma unroll
            for (int i = 0; i < 8; ++i) { f32x4 mx;
                if constexpr (F8_MIX != 0) { const int mw = (int)*(const unsigned*)&mv[rr][i]; const f32x2 m0 = __builtin_amdgcn_cvt_pk_f32_fp8(mw, false), m1 = __builtin_amdgcn_cvt_pk_f32_fp8(mw, true);
                    mx = (f32x4){m0[0], m0[1], m1[0], m1[1]} * (1.0f / 16.f); }
                else { const u32x2 mb = *(const u32x2*)&mv[rr][i]; mx = (f32x4){bflo(mb.x), bfhi(mb.x), bflo(mb.y), bfhi(mb.y)}; }
                f32x4 rx;
                if constexpr (RES_F32) rx = rv[rr][i]; else { const u32x2 rb2 = rv[rr][i]; rx = (f32x4){bflo(rb2.x), bfhi(rb2.x), bflo(rb2.y), bfhi(rb2.y)}; }
                zr[i] = ALPHA * rx + mx; s += (zr[i][0] + zr[i][1]) + (zr[i][2] + zr[i][3]); }
            if (rr == 0) { __builtin_amdgcn_sched_barrier(0); LNR_LOAD(tix, 1); __builtin_amdgcn_sched_barrier(0); }
            const float mean = wave_sum(s) * (1.0f / DM); float q = 0.f;
#pragma unroll
            for (int i = 0; i < 8; ++i) { const f32x4 d = zr[i] - mean; q += (d[0] * d[0] + d[1] * d[1]) + (d[2] * d[2] + d[3] * d[3]); }
            const float rstd = rsqrtf(wave_sum(q) * (1.0f / DM) + 1e-5f);
#pragma unroll
            for (int i = 0; i < 8; ++i) { const int col = 4 * lane + 256 * i; const f32x4 gv = *(const f32x4*)(g + col), bv = *(const f32x4*)(bb + col);
                const f32x4 y = (zr[i] - mean) * rstd * gv + bv;
                LAS f32x2* xp = (LAS f32x2*)(xs + row * LNR_PITCH + col); xp[0] = (f32x2){y[0], y[1]}; xp[1] = (f32x2){y[2], y[3]};
                *(u32x2*)(x1b + m * DM + col) = (u32x2){cvtpk(y[0], y[1]), cvtpk(y[2], y[3])};
                if constexpr (F8_GU) *(unsigned*)(x1q + m * DM + col) = pk4_fp8(y[0], y[1], y[2], y[3]);
                if (i & 1) asm volatile("" ::: "memory"); }
        }
        __builtin_amdgcn_sched_barrier(0);
        if (tix + G < ntile) LNR_LOAD(tix + G, 0);
        __builtin_amdgcn_sched_barrier(0);
        __syncthreads();
        { f32x4 acc0 = {0.f, 0.f, 0.f, 0.f}, acc1 = {0.f, 0.f, 0.f, 0.f}; const LAS float* xa = xs + (lane & 15) * LNR_PITCH + 256 * wid + 8 * (lane >> 4); const int e = lane & 15;
#pragma unroll
          for (int ks = 0; ks < 8; ++ks) { const f32x4 xa0 = *(const LAS f32x4*)(xa + 32 * ks), xa1 = *(const LAS f32x4*)(xa + 32 * ks + 4);
              const float xv[8] = {xa0[0], xa0[1], xa0[2], xa0[3], xa1[0], xa1[1], xa1[2], xa1[3]}; f16x8 ah, al;
#pragma unroll
              for (int j = 0; j < 8; ++j) { const _Float16 hh = (_Float16)xv[j]; ah[j] = hh; al[j] = (_Float16)(xv[j] - (float)hh); }
              acc0 = __builtin_amdgcn_mfma_f32_16x16x32_f16(ah, bw[ks][0], acc0, 0, 0, 0); acc1 = __builtin_amdgcn_mfma_f32_16x16x32_f16(ah, bw[ks][1], acc1, 0, 0, 0);
              acc0 = __builtin_amdgcn_mfma_f32_16x16x32_f16(al, bw[ks][0], acc0, 0, 0, 0); acc1 = __builtin_amdgcn_mfma_f32_16x16x32_f16(al, bw[ks][1], acc1, 0, 0, 0); }
          __builtin_amdgcn_sched_barrier(0);
          __builtin_amdgcn_sched_barrier(0);
#pragma unroll
          for (int r = 0; r < 4; ++r) { const int row = (lane >> 4) * 4 + r; part[(wid * 16 + row) * 32 + e] = acc0[r]; part[(wid * 16 + row) * 32 + 16 + e] = acc1[r]; } }
        __syncthreads();
        { const int row = tid >> 5, e = tid & 31; float lg = 0.f;
#pragma unroll
          for (int w = 0; w < 8; ++w) lg += part[(w * 16 + row) * 32 + e];
          const float sc = 1.0f / (1.0f + __expf(-lg)); scs[row * 32 + e] = sc; sels[row * 32 + e] = sc + rb[e]; }
        __syncthreads();
        if (tid < 16) { const int row = tid; float best = -INFINITY; int bg = 0;
            for (int gI = 0; gI < 8; ++gI) { const float a = sels[row * 32 + 4 * gI], b = sels[row * 32 + 4 * gI + 1], c = sels[row * 32 + 4 * gI + 2], d = sels[row * 32 + 4 * gI + 3];
                const float h1 = fmaxf(a, b), l1 = fminf(a, b), h2 = fmaxf(c, d), l2 = fminf(c, d); const float gs = fmaxf(h1, h2) + fmaxf(fminf(h1, h2), fmaxf(l1, l2));
                if (gs > best) { best = gs; bg = gI; } }
            const float v0 = sels[row * 32 + 4 * bg], v1 = sels[row * 32 + 4 * bg + 1], v2 = sels[row * 32 + 4 * bg + 2], v3 = sels[row * 32 + 4 * bg + 3];
            int i1 = 0; float b1v = v0; if (v1 > b1v) { b1v = v1; i1 = 1; } if (v2 > b1v) { b1v = v2; i1 = 2; } if (v3 > b1v) { b1v = v3; i1 = 3; }
            int i2 = -1; float b2v = -INFINITY;
            if (i1 != 0 && v0 > b2v) { b2v = v0; i2 = 0; } if (i1 != 1 && v1 > b2v) { b2v = v1; i2 = 1; } if (i1 != 2 && v2 > b2v) { b2v = v2; i2 = 2; } if (i1 != 3 && v3 > b2v) { b2v = v3; i2 = 3; }
            const int e1 = 4 * bg + i1, e2 = 4 * bg + i2; const float s1 = scs[row * 32 + e1], s2 = scs[row * 32 + e2]; const float inv = 1.0f / (s1 + s2);
            const int m = tix * 16 + row;
            tok_e[2 * m] = e1; tok_e[2 * m + 1] = e2; tok_g[2 * m] = s1 * inv; tok_g[2 * m + 1] = s2 * inv;
            ble[(it * 16 + row) * 2] = e1; ble[(it * 16 + row) * 2 + 1] = e2; }
        __syncthreads();
        ntl = it + 1;
    }
#undef LNR_LOAD
    const int nasg = commit ? ntl * 32 : 0;
    if (tid < 32) { int c = 0; for (int i = 0; i < nasg; ++i) c += (ble[i] == tid) ? 1 : 0;
        unsigned base = 0; if (c) base = __hip_atomic_fetch_add(cnt + tid, (unsigned)c, __ATOMIC_RELAXED, __HIP_MEMORY_SCOPE_AGENT);
        hist[tid] = (int)base; }
    __syncthreads();
    if (tid < 32) { int run = hist[tid];
        for (int i = 0; i < nasg; ++i) if (ble[i] == tid) { const int tr = i >> 1; const size_t m = (size_t)(bid + G * (tr >> 4)) * 16 + (tr & 15);
            list[(size_t)tid * 65536 + run] = (int)m; tok_p[2 * m + (i & 1)] = run; ++run; } }
    __syncthreads();
}

constexpr int MOE_LDS = 131072;
__device__ __forceinline__ int moe_prefix(const unsigned* cnt, LAS int* pblk, int tid) {
    if (tid == 0) { int acc = 0; for (int e = 0; e < NE; ++e) { pblk[e] = acc; acc += ((int)cnt[e] + 255) >> 8; } pblk[NE] = acc; }
    __syncthreads();
    return pblk[NE];
}
template <int NJ> __device__ __forceinline__ int moe_table(const unsigned* cnt, LAS int* pblk, LAS int* tab, LAS int* aux, int NB, int G, int bid, int tid) {
    const int NU = NB * NJ;
    if (tid < 16) { const int L = bid + G * tid;
        if (L < NU) { const int rb = L / NJ, j = L % NJ; int e = 0; for (int q = 1; q < NE; ++q) if (pblk[q] <= rb) e = q;
            tab[tid] = rb; tab[16 + tid] = NJ * e + j; aux[tid * 3] = e; aux[tid * 3 + 1] = (rb - pblk[e]) * 256; aux[tid * 3 + 2] = (int)cnt[e]; } }
    __syncthreads();
    int n = 0; for (int i = 0; i < 16; ++i) if (bid + G * i < NU) n = i + 1;
    return n;
}

template <bool FINAL>
__device__ __forceinline__ void phase_combine_ln(const float* dbg, const bf16_t* x1b, const bf16_t* Yr, const int* tok_e, const int* tok_p, const float* tok_g, const unsigned* cnt,
                                                 const float* g, const float* bb, bf16_t* xo, unsigned char* xq, float* fo, LAS unsigned char* lds, int G, int bid, int tid) {
    LAS int* pblk = (LAS int*)lds;
    moe_prefix(cnt, pblk, tid);
    const int wid = __builtin_amdgcn_readfirstlane(tid >> 6), lane = tid & 63;
    float ALPHA = 1.4142135623730951f; asm volatile("" : "+v"(ALPHA));
#if DBG_CHECK
    const bool dbg_bad = FINAL && (!(dbg[0] <= DBG_TOL * DBG_TOL * dbg[1]) || !(dbg[2] <= DBG_TOL * DBG_TOL * dbg[3]) || !(dbg[1] > 0.f) || !(dbg[3] > 0.f) ||
                                    !(dbg[4] <= DBG_TOL * DBG_TOL * dbg[5]) || !(dbg[6] <= DBG_TOL * DBG_TOL * dbg[7]) || !(dbg[5] > 0.f) || !(dbg[7] > 0.f) ||
                                    !(dbg[8] <= DBG_TOL_SP * DBG_TOL_SP * dbg[9]) || !(dbg[10] <= DBG_TOL_SP * DBG_TOL_SP * dbg[11]) || !(dbg[9] > 0.f) || !(dbg[11] > 0.f));
#endif
    static_assert(F8_YR, "the pipelined combine reads e4m3 expert rows");
    struct Meta { size_t p0, p1; float h0, h1; };
    struct Rows { u32x4 xa[4]; u32x2 ya[4], yb[4]; };
#define CMB_META(mm, M) do { const int _e0 = tok_e[2 * (mm)], _e1 = tok_e[2 * (mm) + 1]; (M).p0 = (size_t)pblk[_e0] * 256 + tok_p[2 * (mm)]; (M).p1 = (size_t)pblk[_e1] * 256 + tok_p[2 * (mm) + 1]; \
        (M).h0 = tok_g[2 * (mm)] * (1.0f / 16.0f); (M).h1 = tok_g[2 * (mm) + 1] * (1.0f / 16.0f); } while (0)
#define CMB_ROWS(mm, M, R) do { _Pragma("unroll") for (int i = 0; i < 4; ++i) { const int col = 8 * lane + 512 * i; (R).xa[i] = *(const u32x4*)(x1b + (size_t)(mm) * DM + col); \
        (R).ya[i] = *(const u32x2*)((const unsigned char*)Yr + (M).p0 * DM + col); (R).yb[i] = *(const u32x2*)((const unsigned char*)Yr + (M).p1 * DM + col); } } while (0)
    const int mstep = G * 8, m0 = bid * 8 + wid;
    Meta Mc, Mn; Rows Rc, Rn;
    Mc.p0 = Mc.p1 = 0; Mc.h0 = Mc.h1 = 0.f; Mn = Mc;
    if (m0 < T_) { CMB_META(m0, Mc); CMB_ROWS(m0, Mc, Rc); }
    if (m0 + mstep < T_) CMB_META(m0 + mstep, Mn);
    Rn = Rc;
    for (int m = m0; m < T_; m += mstep) {
        Meta Mnn = Mn;
        if (m + mstep < T_) CMB_ROWS(m + mstep, Mn, Rn);
        if (m + 2 * mstep < T_) CMB_META(m + 2 * mstep, Mnn);
        const float h0 = Mc.h0, h1 = Mc.h1;
        float v[32]; float s = 0.f;
#pragma unroll
        for (int i = 0; i < 4; ++i) {
            const unsigned xw[4] = {Rc.xa[i].x, Rc.xa[i].y, Rc.xa[i].z, Rc.xa[i].w}; const unsigned aw[2] = {Rc.ya[i].x, Rc.ya[i].y}, bw[2] = {Rc.yb[i].x, Rc.yb[i].y};
#define CMB_PAIR(j, W, SEL) do { const f32x2 a2 = __builtin_amdgcn_cvt_pk_f32_fp8((int)aw[W], SEL), b2 = __builtin_amdgcn_cvt_pk_f32_fp8((int)bw[W], SEL); \
                    v[i * 8 + 2 * (j)] = ALPHA * bflo(xw[j]) + h0 * a2[0] + h1 * b2[0]; v[i * 8 + 2 * (j) + 1] = ALPHA * bfhi(xw[j]) + h0 * a2[1] + h1 * b2[1]; \
                    s += v[i * 8 + 2 * (j)] + v[i * 8 + 2 * (j) + 1]; } while (0)
            CMB_PAIR(0, 0, false); CMB_PAIR(1, 0, true); CMB_PAIR(2, 1, false); CMB_PAIR(3, 1, true);
#undef CMB_PAIR
        }
        Mc = Mn; Mn = Mnn; Rc = Rn;
        const float mean = wave_sum(s) * (1.0f / DM); float q = 0.f;
#pragma unroll
        for (int i = 0; i < 32; ++i) { const float d = v[i] - mean; q += d * d; }
        const float rstd = rsqrtf(wave_sum(q) * (1.0f / DM) + 1e-5f);
#pragma unroll
        for (int i = 0; i < 4; ++i) { const int col = 8 * lane + 512 * i;
            const f32x4 ga = *(const f32x4*)(g + col), gb = *(const f32x4*)(g + col + 4), ba = *(const f32x4*)(bb + col), bbv = *(const f32x4*)(bb + col + 4);
            float y[8];
#pragma unroll
            for (int j = 0; j < 4; ++j) { y[j] = (v[i * 8 + j] - mean) * rstd * ga[j] + ba[j]; y[4 + j] = (v[i * 8 + 4 + j] - mean) * rstd * gb[j] + bbv[j]; }
#if DBG_CHECK
            if (dbg_bad) { for (int j = 0; j < 8; ++j) y[j] = 0.f; }
#endif
            if constexpr (FINAL) { *(f32x4*)(fo + (size_t)m * DM + col) = (f32x4){y[0], y[1], y[2], y[3]}; *(f32x4*)(fo + (size_t)m * DM + col + 4) = (f32x4){y[4], y[5], y[6], y[7]}; }
            else { *(u32x4*)(xo + (size_t)m * DM + col) = (u32x4){cvtpk(y[0], y[1]), cvtpk(y[2], y[3]), cvtpk(y[4], y[5]), cvtpk(y[6], y[7])};
                if constexpr (F8_IN) *(u32x2*)(xq + (size_t)m * DM + col) = (u32x2){pk4_fp8(y[0], y[1], y[2], y[3]), pk4_fp8(y[4], y[5], y[6], y[7])}; } }
    }
#undef CMB_META
#undef CMB_ROWS
}

#if DBG_CHECK
__device__ __forceinline__ void dbg_attn_check(int which, const bf16_t* Hx, const bf16_t* Qd, const bf16_t* KVd, const bf16_t* krope, const void* Oat, float* dbg, LAS unsigned char* lds, int bid, int tid) {
    const int wid = __builtin_amdgcn_readfirstlane(tid >> 6), lane = tid & 63;
    LAS float* sc = (LAS float*)lds + wid * 4096;
    LAS float* qs = (LAS float*)(lds + 131072) + wid * 192;
    const unsigned sid = (unsigned)(bid * 8 + wid);
    const int m = (int)((sid * 2654435761u) % (unsigned)T_), h = (int)(sid & 7u), b = m >> 12, pos = m & (SEQ - 1);
    const int DQ = which ? 192 : 128; const float scale = which ? 0.072168783648703220f : 0.088388347648318440f;
    for (int d = lane; d < DQ; d += 64) {
        float qv;
        if (which == 0) qv = bf2f(Hx[(size_t)m * IN0 + h * 128 + d]);
        else if (d < 128) qv = bf2f(Qd[(size_t)m * 1536 + h * 192 + d]);
        else { const int i = (d - 128) & 31; const float x1 = bf2f(Qd[(size_t)m * 1536 + h * 192 + 128 + i]), x2 = bf2f(Qd[(size_t)m * 1536 + h * 192 + 160 + i]);
            float sn, cs; sincos_rev((float)pos * inv_freq32(i), sn, cs); qv = (d < 160) ? (x1 * cs - x2 * sn) : (x2 * cs + x1 * sn); }
        qs[d] = qv; }
    asm volatile("s_waitcnt lgkmcnt(0)" ::: "memory");
    float mx = -INFINITY;
    for (int i = 0; i < 64; ++i) { const int j = lane + 64 * i; float dot = 0.f;
        if (which == 0) { const bf16_t* kp = Hx + (size_t)(b * SEQ + j) * IN0 + 1024 + (h >> 2) * 128; for (int d = 0; d < 128; ++d) dot += qs[d] * bf2f(kp[d]); }
        else { const bf16_t* kp = KVd + (size_t)(b * SEQ + j) * DM + h * 256; for (int d = 0; d < 128; ++d) dot += qs[d] * bf2f(kp[d]);
               const bf16_t* rp = krope + (size_t)(b * SEQ + j) * 64; for (int d = 0; d < 64; ++d) dot += qs[128 + d] * bf2f(rp[d]); }
        dot *= scale; sc[j] = dot; mx = fmaxf(mx, dot); }
    mx = wave_max(mx);
    float sum = 0.f;
    for (int i = 0; i < 64; ++i) { const int j = lane + 64 * i; const float pj = __expf(sc[j] - mx); sc[j] = pj; sum += pj; }
    sum = wave_sum(sum);
    asm volatile("s_waitcnt lgkmcnt(0)" ::: "memory");
    float e2 = 0.f, r2 = 0.f;
    for (int cc = 0; cc < 2; ++cc) { const int c = lane + 64 * cc; float acc = 0.f;
        for (int j = 0; j < SEQ; ++j) { const float vv = which == 0 ? bf2f(Hx[(size_t)(b * SEQ + j) * IN0 + 1280 + (h >> 2) * 128 + c]) : bf2f(KVd[(size_t)(b * SEQ + j) * DM + h * 256 + 128 + c]); acc += sc[j] * vv; }
        const float ref = acc / sum; const size_t eo = (size_t)m * DM + (which ? 1024 : 0) + h * 128 + c;
        float got; if (F8_OUT) { const unsigned char by = ((const unsigned char*)Oat)[eo]; const f32x2 g2 = __builtin_amdgcn_cvt_pk_f32_fp8((int)by, false); got = g2[0] * (1.0f / O8_SCALE); } else got = bf2f(((const bf16_t*)Oat)[eo]);
        e2 += (got - ref) * (got - ref); r2 += ref * ref; }
    e2 = wave_sum(e2); r2 = wave_sum(r2);
    if (lane == 0) { atomicAdd(dbg + 2 * which, e2); atomicAdd(dbg + 2 * which + 1, r2); }
}
#endif
#if DBG_CHECK
__device__ __forceinline__ void dbg_sparse_check(int L, const bf16_t* Hx, const unsigned char* K8r, const unsigned char* V8r, const float* rpb, const void* Oat, float* dbg, LAS unsigned char* lds, int bid, int tid) {
    const int wid = __builtin_amdgcn_readfirstlane(tid >> 6), lane = tid & 63;
    LAS float* sc = (LAS float*)lds + wid * 1024; LAS int* kt = (LAS int*)(lds + 65536) + wid * 1024; LAS float* qs = (LAS float*)(lds + 131072) + wid * 128;
    const unsigned sid = (unsigned)(bid * 8 + wid);
    const int m = (int)((sid * 2654435761u + 12345u) % (unsigned)T_), h = (int)((sid >> 3) & 7u), b = m >> 12, pos = m & (SEQ - 1);
    const int ldh = L ? IN1P : IN0, qoff = L ? h * 128 : 1536 + h * 128;
    for (int d = lane; d < 128; d += 64) qs[d] = bf2f(Hx[(size_t)m * ldh + qoff + d]);
    int nk;
    if (L == 0) { nk = 387; const float slope = __builtin_amdgcn_exp2f(-(float)(h + 1));
        for (int idx = lane; idx < nk; idx += 64) { const int br = idx / 129, dd = idx % 129 - 64, dil = br == 0 ? 1 : (br == 1 ? 4 : 16), rd = pos % dil, kd = pos / dil + dd;
            const bool ok = kd >= 0 && kd < SEQ / dil; kt[idx] = ok ? b * SEQ + kd * dil + rd : -1; sc[idx] = -slope * (float)dil * (float)(dd < 0 ? -dd : dd); } }
    else { nk = 128; const int r = pos >> 6, qc = pos & 63, r0 = min(max(r - 4, 0), 56), c0 = min(max(qc - 8, 0), 48);
        for (int idx = lane; idx < nk; idx += 64) { const int kr = r0 + (idx >> 4), kc = c0 + (idx & 15); kt[idx] = b * SEQ + kr * 64 + kc; sc[idx] = rpb[h * 465 + (kr - r + 7) * 31 + (kc - qc + 15)]; } }
    asm volatile("s_waitcnt lgkmcnt(0)" ::: "memory");
    float mx = -INFINITY;
    for (int idx = lane; idx < nk; idx += 64) { float sv = -INFINITY; const int t = kt[idx];
        if (t >= 0) { const unsigned char* kp = K8r + (size_t)t * 1024 + h * 128; float dot = 0.f;
            for (int d = 0; d < 128; ++d) { const f32x2 kv = __builtin_amdgcn_cvt_pk_f32_fp8((int)kp[d], false); dot += qs[d] * kv[0]; }
            sv = dot * 0.088388347648318440f + sc[idx]; }
        sc[idx] = sv; mx = fmaxf(mx, sv); }
    mx = wave_max(mx);
    float sum = 0.f;
    for (int idx = lane; idx < nk; idx += 64) { const float pj = __expf(sc[idx] - mx); sc[idx] = pj; sum += pj; }
    sum = wave_sum(sum);
    asm volatile("s_waitcnt lgkmcnt(0)" ::: "memory");
    float e2 = 0.f, r2 = 0.f;
    for (int cc = 0; cc < 2; ++cc) { const int c = lane + 64 * cc; float acc = 0.f;
        for (int idx = 0; idx < nk; ++idx) { const int t = kt[idx]; if (t >= 0) { const f32x2 vv = __builtin_amdgcn_cvt_pk_f32_fp8((int)V8r[(size_t)t * 1024 + h * 128 + c], false); acc += sc[idx] * vv[0]; } }
        const float ref = acc / sum; const size_t eo = (size_t)m * DM + (L ? 0 : 1024) + h * 128 + c;
        float got; if (F8_OUT) { const unsigned char by = ((const unsigned char*)Oat)[eo]; const f32x2 g2 = __builtin_amdgcn_cvt_pk_f32_fp8((int)by, false); got = g2[0] * (1.0f / O8_SCALE); } else got = bf2f(((const bf16_t*)Oat)[eo]);
        e2 += (got - ref) * (got - ref); r2 += ref * ref; }
    e2 = wave_sum(e2); r2 = wave_sum(r2);
    if (lane == 0) { atomicAdd(dbg + 8 + 2 * L, e2); atomicAdd(dbg + 9 + 2 * L, r2); }
}
#endif
#if DBG_CHECK
__device__ __forceinline__ void dbg_prep_check(int L, const float* xf, const bf16_t* xb2, const float* win, const float* gq, const float* gk, const bf16_t* H, const bf16_t* krope, float* dbg, LAS unsigned char* lds, int bid, int tid) {
    const int wid = __builtin_amdgcn_readfirstlane(tid >> 6), lane = tid & 63;
    const unsigned sid = (unsigned)(bid * 8 + wid);
    const int m = (int)((sid * 2246822519u) % (unsigned)T_); const int sq = m & (SEQ - 1);
    float e2 = 0.f, r2 = 0.f;
    if (L == 0) {
        const int hh = (int)(sid % 10u); const int colbase = hh < 8 ? hh * 128 : 1024 + (hh - 8) * 128; const float* gain = hh < 8 ? gq : gk;
        float a0 = 0.f, a1 = 0.f;
        for (int k = 0; k < DM; ++k) { const float xv = xf[(size_t)m * DM + k]; a0 += xv * win[(size_t)k * IN0 + colbase + lane]; a1 += xv * win[(size_t)k * IN0 + colbase + 64 + lane]; }
        const float ms = wave_sum(a0 * a0 + a1 * a1) * (1.0f / 128.0f); const float r = rsqrtf(ms + 1e-6f);
        const float y0 = a0 * r * gain[lane], y1 = a1 * r * gain[64 + lane];
        LAS float* ys = (LAS float*)lds + wid * 128; ys[lane] = y0; ys[64 + lane] = y1; asm volatile("s_waitcnt lgkmcnt(0)" ::: "memory");
#pragma unroll
        for (int q = 0; q < 2; ++q) { const int e = lane + 64 * q, hf = e >> 6, i = e & 31; const bool x2p = (e & 32) != 0;
            const float pos = (float)(hf ? (sq & 63) : (sq >> 6)); float sn, cs; sincos_rev(pos * inv_freq32(i), sn, cs);
            const float mine = ys[e], other = ys[e ^ 32];
            const float ref = x2p ? (mine * cs + other * sn) : (mine * cs - other * sn);
            const float got = bf2f(H[(size_t)m * IN0 + colbase + e]);
            e2 += (got - ref) * (got - ref); r2 += ref * ref; }
    } else {
        float acq[8] = {0.f, 0.f, 0.f, 0.f, 0.f, 0.f, 0.f, 0.f}; float akr = 0.f;
        for (int k = 0; k < DM; ++k) { const float xv = bf2f(xb2[(size_t)m * DM + k]); const float* wr = win + (size_t)k * IN1;
#pragma unroll
            for (int j = 0; j < 8; ++j) acq[j] += xv * wr[3072 + lane + 64 * j];
            akr += xv * wr[3840 + lane]; }
        float ss = 0.f;
#pragma unroll
        for (int j = 0; j < 8; ++j) ss += acq[j] * acq[j];
        const float r = rsqrtf(wave_sum(ss) * (1.0f / 512.0f) + 1e-6f);
#pragma unroll
        for (int j = 0; j < 8; ++j) { const float ref = acq[j] * r; const float got = bf2f(H[(size_t)m * IN1P + 3072 + lane + 64 * j]); e2 += (got - ref) * (got - ref); r2 += ref * ref; }
        LAS float* ys = (LAS float*)lds + wid * 128; ys[lane] = akr; asm volatile("s_waitcnt lgkmcnt(0)" ::: "memory");
        { const int i = lane & 31; float sn, cs; sincos_rev((float)sq * inv_freq32(i), sn, cs); const float mine = ys[lane], other = ys[lane ^ 32];
          const float ref = (lane & 32) ? (mine * cs + other * sn) : (mine * cs - other * sn); const float got = bf2f(krope[(size_t)m * 64 + lane]);
          e2 += (got - ref) * (got - ref); r2 += ref * ref; }
    }
    e2 = wave_sum(e2); r2 = wave_sum(r2);
    if (lane == 0) { atomicAdd(dbg + 4 + 2 * L, e2); atomicAdd(dbg + 5 + 2 * L, r2); }
}
#endif
#ifndef ATT_ONLY
#define ATT_ONLY -1
#endif
#ifndef REP_K
#define REP_K -1
#endif
#ifndef REP_NULL
#define REP_NULL -1
#endif
#ifndef ABL_ATT
#define ABL_ATT -1
#endif
#ifndef REP_ATT
#define REP_ATT -1
#endif
#define NREP(k) ((REP_K == (k)) ? 2 : 1)
#define NREPA(k) ((REP_ATT == (k)) ? 2 : 1)
constexpr int N_PHASES = 20;
__global__ void __launch_bounds__(NTHR, 2) fwd(Params p) {
    extern __shared__ __attribute__((aligned(16))) unsigned char lds_raw[];
    LAS unsigned char* lds = (LAS unsigned char*)lds_raw;
    const int tid0 = threadIdx.x, bid = blockIdx.x, G = gridDim.x;
    const int wv = __builtin_amdgcn_readfirstlane(tid0 >> 6);
    const int vcu = (G % 8 == 0) ? (bid % 8) * (G / 8) + bid / 8 : bid;
    unsigned* ctl = (unsigned*)(p.ws + WS_CTL);
    if (tid0 < 4) ((LAS unsigned*)(lds + MISC_OFF))[tid0] = 0u;
    __syncthreads();
    XcdBarrier bar; bar.bar = ctl + CW_BAR; bar.x = 0; bar.st = (volatile LAS unsigned*)(lds + MISC_OFF);
    if (N_LAUNCH_MODE == 1) bar = xcd_barrier_post(ctl + CW_BAR, (volatile LAS unsigned*)(lds + MISC_OFF));
    const int lo = p.ph_lo, hi = p.ph_hi;
#ifndef PH_ONLY
#define PH_ONLY -1
#endif
#define IN(k) ((PH_ONLY < 0 || (PH_ONLY % 10) == ((k) % 10)) && lo <= (k) && (k) < hi)
#define SEAM(k) do { if ((k) + 1 < hi) xcd_barrier(bar, fresh_tid(wv)); } while (0)

    for (int L = 0; L < 2; ++L) {
        const int pb = L * 10;
        typedef __attribute__((address_space(1))) unsigned char gu8;
        typedef __attribute__((address_space(1))) const float gcf;
        typedef __attribute__((address_space(4))) const unsigned long long kcu64;
#define INP(i) ((const float*)(gcf*)ka[i])
#define PHASE_PTRS \
        kcu64* ka = (kcu64*)__builtin_amdgcn_kernarg_segment_ptr(); asm volatile("" : "+s"(ka)); \
        unsigned char* ws = (unsigned char*)(gu8*)ka[29]; unsigned char* outb = (unsigned char*)(gu8*)ka[28]; \
        unsigned* ctl = (unsigned*)(ws + WS_CTL); \
        bf16_t* RA = (bf16_t*)(ws + WS_RA); bf16_t* RB = (bf16_t*)(ws + WS_RB); bf16_t* RC = (bf16_t*)(ws + WS_RC); \
        int* list = (int*)(ws + WS_LIST); int* tok_e = (int*)(ws + WS_TOKE); int* tok_p = (int*)(ws + WS_TOKP); float* tok_g = (float*)(ws + WS_TOKG); \
        bf16_t* krope = (bf16_t*)(ws + WS_KROPE); \
        bf16_t* Qd = (bf16_t*)(outb + OUT_QD); bf16_t* O1 = (bf16_t*)(outb + OUT_O1); \
        const bf16_t* Win = (const bf16_t*)(ws + (L ? WS_WIN1 : WS_WIN0)); const bf16_t* Wout = (const bf16_t*)(ws + (L ? WS_WOUT1 : WS_WOUT0)); \
        const bf16_t* Wgu = (const bf16_t*)(ws + (L ? WS_WGU1 : WS_WGU0)); const bf16_t* Wd = (const bf16_t*)(ws + (L ? WS_WD1 : WS_WD0)); \
        const int NIN = L ? IN1P : IN0; \
        const bf16_t* xin = L ? RC : RA; \
        bf16_t* Hx = RB; bf16_t* Oat = L ? O1 : RC; float* Z = (float*)RB; \
        bf16_t* x1b = RA; bf16_t* Hm = RC; bf16_t* Yr = RB; \
        unsigned* cnt = ctl + CW_CNT + L * 64; \
        (void)ctl; (void)RA; (void)RB; (void)RC; (void)list; (void)tok_e; (void)tok_p; (void)tok_g; (void)krope; (void)Qd; (void)O1; (void)Win; (void)Wout; (void)Wgu; (void)Wd; (void)NIN; (void)xin; (void)Hx; (void)Oat; (void)Z; (void)x1b; (void)Hm; (void)Yr; (void)cnt; (void)outb

        if (L == 0 && IN(0)) { PHASE_PTRS; _Pragma("unroll 1") for (int rep = 0; rep < NREP(0); ++rep) phase_prologue(ka, ws, lds, G, bid, fresh_tid(wv)); SEAM(0); }

        if (IN(pb + 1)) {
            PHASE_PTRS;
            constexpr int KI = F8_IN ? 1024 : 2048;
            const bf16_t* ain = F8_IN ? (L ? (const bf16_t*)outb : (const bf16_t*)((unsigned char*)RC + 64 * MiB)) : xin;
            pg8::Gemm g{ain, Win, KI, KI, KI}; pg8::StaticOrder S; S.init(T_, NIN, G, bid, KI);
            pg8::EpiIn E{Hx, NIN, L ? ws + WS_WGU0 + 64 * MiB : (unsigned char*)RA, L ? ws + WS_WD0 + 32 * MiB : ws + WS_WGU1 + 64 * MiB, F8_SPARSE ? (L ? 4 : 10) : 99, F8_SPARSE ? (L ? 8 : 14) : 99, F8_SPARSE ? (L ? 12 : 18) : 99};
            _Pragma("unroll 1") for (int rep = 0; rep < NREP(1); ++rep) pg8::gemm_phase<F8_IN != 0>(wv, lds, g, S, E, F8_IN ? 1.0f / W8_SCALE : 1.0f);
#if REP_NULL == 1
            { pg8::EpiNull EN{(float*)(ctl + CW_DBG + 32)}; pg8::gemm_phase<F8_IN != 0>(wv, lds, g, S, EN, 1.0f / W8_SCALE); }
#endif
            SEAM(pb + 1);
        }
        if (IN(pb + 2)) {
            PHASE_PTRS;
            if (L == 0) { phase_prep_qk(Hx, INP(I_AQN), INP(I_AKN), ws + WS_WGU0 + 64 * MiB, G, bid, fresh_tid(wv));
                _Pragma("unroll 1") for (int rep = 0; rep < NREP(2); ++rep) {
                if (F8_ATTA) phase_vt8(Hx, ws + WS_WGU0 + 72 * MiB, lds, G, bid, fresh_tid(wv));
                if (F8_SPARSE) { unsigned char* ra8 = (unsigned char*)RA;
                    phase_vt_heads<true>(ws + WS_WGU1 + 64 * MiB, ra8 + 32 * MiB, ra8 + 64 * MiB, ra8 + 96 * MiB, lds, G, bid, fresh_tid(wv)); } } }
            else { phase_prep_mla(Hx, krope, ws + WS_WD1 + 32 * MiB, G, bid, fresh_tid(wv));
                if (F8_SPARSE) { unsigned char* c8 = ws + WS_WGU0 + 64 * MiB;
                    _Pragma("unroll 1") for (int rep = 0; rep < NREP(2); ++rep) phase_vt_heads<false>(ws + WS_WD0 + 32 * MiB, c8 + 32 * MiB, nullptr, nullptr, lds, G, bid, fresh_tid(wv)); } }
#if DBG_CHECK
            xcd_barrier(bar, fresh_tid(wv));
            dbg_prep_check(L, INP(I_X), RC, INP(L ? I_WIN1 : I_WIN0), INP(I_AQN), INP(I_AKN), Hx, krope, (float*)(ctl + CW_DBG), lds, bid, fresh_tid(wv));
            __syncthreads();
#endif
            SEAM(pb + 2);
        }
        if (L == 1 && IN(pb + 3)) _Pragma("unroll 1") for (int rep = 0; rep < NREP(3); ++rep) {
            PHASE_PTRS;
#ifndef P3_ONLY
#define P3_ONLY -1
#endif
            if (P3_ONLY < 0 || P3_ONLY == 0) { pg8::Gemm g{Hx + 3072, (const bf16_t*)(ws + WS_WQUP), 512, IN1P, 512}; pg8::StaticOrder S; S.init(T_, 1536, G, bid, IN1P);
              pg8::EpiBf16 E{Qd, 1536, 0xffff}; pg8::gemm_phase<false>(wv, lds, g, S, E); }
            if (P3_ONLY < 0 || P3_ONLY == 1) { pg8::Gemm g{Hx + 3584, (const bf16_t*)(ws + WS_WKVUP), 256, IN1P, 256}; pg8::StaticOrder S; S.init(T_, 2048, G, bid, IN1P);
              if constexpr (F8_ATTD) { pg8::EpiKV8 E{ws + WS_WGU1 + 64 * MiB, ws + WS_WGU1 + 96 * MiB, RA, DBG_CHECK != 0}; pg8::gemm_phase<false>(wv, lds, g, S, E); }
              else { pg8::EpiBf16 E{RA, 2048, 0xffff}; pg8::gemm_phase<false>(wv, lds, g, S, E); } }
            if (rep + 1 == NREP(3)) SEAM(pb + 3);
        }
        if (IN(pb + 4)) {
            PHASE_PTRS;
            if (L == 0) {
                if (ATT_ONLY < 0 || ATT_ONLY == 0)
                _Pragma("unroll 1") for (int rep = 0; rep < NREPA(0); ++rep)
                for (int u = vcu; u < 1024; u += G) {
                    __syncthreads();
                    const int b = u >> 7, qb = u & 15, kvh = (u >> 6) & 1, gq = (u >> 4) & 3, h = kvh * 4 + gq;
                    if constexpr (F8_ATTA) {
                        d8::D8Args a; a.Q = Hx + (size_t)(b * SEQ + 256 * qb) * IN0 + h * 128; a.ldq = IN0;
                        a.K8 = ws + WS_WGU0 + 64 * MiB + (size_t)b * SEQ * 256 + kvh * 128; a.ldk = 256; a.Kr8 = nullptr;
                        a.Vt8 = ws + WS_WGU0 + 72 * MiB + (size_t)(b * 2 + kvh) * 128 * SEQ; a.ldvt = SEQ;
                        { const size_t eo = (size_t)(b * SEQ + 256 * qb) * DM + h * 128; a.O = F8_OUT ? (bf16_t*)((unsigned char*)Oat + eo) : Oat + eo; } a.ldo = DM; a.seq = SEQ; a.pos0 = 0;
                        if (D8_DMA_A) d8::attn_dense8_dma<2, true>(wv, a, lds); else d8::attn_dense8_body<2>(wv, a, (char*)lds_raw);
                    } else {
                    da::DArgs a; a.Q = Hx + (size_t)(b * SEQ + 256 * qb) * IN0 + h * 128; a.ldq = IN0;
                    a.K = Hx + (size_t)b * SEQ * IN0 + 1024 + kvh * 128; a.ldk = IN0; a.V = Hx + (size_t)b * SEQ * IN0 + 1280 + kvh * 128; a.ldv = IN0; a.Kr = nullptr;
                    { const size_t eo = (size_t)(b * SEQ + 256 * qb) * DM + h * 128; a.O = F8_OUT ? (bf16_t*)((unsigned char*)Oat + eo) : Oat + eo; } a.ldo = DM; a.seq = SEQ; a.pos0 = 0;
                    da::attn_dense_body<8, 1>(wv, a, (char*)lds_raw);
                    }
                }
                __syncthreads();
                if (ATT_ONLY < 0 || ATT_ONLY == 2)
                _Pragma("unroll 1") for (int rep = 0; rep < NREPA(2); ++rep)
                for (int it = vcu; it < 1024; it += G) {
                    const int tid2 = fresh_tid(wv), wid = __builtin_amdgcn_readfirstlane(tid2 >> 6), lane = tid2 & 63;
                    const int w = it * 8 + wid; LAS unsigned char* wl = lds + wid * da::SP_WAVE_LDS;
                    if constexpr (F8_SPARSE) { const unsigned char* ra8 = (const unsigned char*)RA; PolB8 pol; pol.init(Hx, Oat, ra8, ra8 + 32 * MiB, ra8 + 64 * MiB, ra8 + 96 * MiB, w, lane); d8::sparse8_wave(pol, wl, lane); }
                    else { PolB pol; pol.init(Hx, Oat, w, lane); da::sparse_wave(pol, wl, lane); }
                }
            } else {
                if (ATT_ONLY < 0 || ATT_ONLY == 1)
                _Pragma("unroll 1") for (int rep = 0; rep < NREPA(1); ++rep)
                for (int u = vcu; u < 1024; u += G) {
                    __syncthreads();
                    const int b = u >> 7, qb = u & 15, h = (u >> 4) & 7;
                    if constexpr (F8_ATTD) {
                        d8::D8Args a; a.Q = Qd + (size_t)(b * SEQ + 256 * qb) * 1536 + h * 192; a.ldq = 1536;
                        a.K8 = ws + WS_WGU1 + 64 * MiB + (size_t)b * SEQ * 1024 + h * 128; a.ldk = 1024; a.Kr8 = ws + WS_WD1 + 32 * MiB + (size_t)b * SEQ * 64;
                        a.Vt8 = ws + WS_WGU1 + 96 * MiB + (size_t)(b * 8 + h) * 128 * SEQ; a.ldvt = SEQ;
                        { const size_t eo = (size_t)(b * SEQ + 256 * qb) * DM + 1024 + h * 128; a.O = F8_OUT ? (bf16_t*)((unsigned char*)Oat + eo) : Oat + eo; } a.ldo = DM; a.seq = SEQ; a.pos0 = 256 * qb;
                        if (D8_DMA_D) d8::attn_dense8_dma<3, D8_MACC_D != 0>(wv, a, lds); else d8::attn_dense8_body<3>(wv, a, (char*)lds_raw);
                    } else {
                    da::DArgs a; a.Q = Qd + (size_t)(b * SEQ + 256 * qb) * 1536 + h * 192; a.ldq = 1536;
                    a.K = RA + (size_t)b * SEQ * DM + h * 256; a.ldk = DM; a.V = a.K + 128; a.ldv = DM; a.Kr = krope + (size_t)b * SEQ * 64;
                    { const size_t eo = (size_t)(b * SEQ + 256 * qb) * DM + 1024 + h * 128; a.O = F8_OUT ? (bf16_t*)((unsigned char*)Oat + eo) : Oat + eo; } a.ldo = DM; a.seq = SEQ; a.pos0 = 256 * qb;
                    da::attn_dense_body<12, 1>(wv, a, (char*)lds_raw);
                    }
                }
                __syncthreads();
                if (ATT_ONLY < 0 || ATT_ONLY == 3)
                _Pragma("unroll 1") for (int rep = 0; rep < NREPA(3); ++rep)
                for (int it = vcu; it < 1024; it += G) {
                    const int tid2 = fresh_tid(wv), wid = __builtin_amdgcn_readfirstlane(tid2 >> 6), lane = tid2 & 63;
                    const int w = it * 8 + wid; LAS unsigned char* wl = lds + wid * da::SP_WAVE_LDS;
                    if constexpr (F8_SPARSE) { const unsigned char* c8 = ws + WS_WGU0 + 64 * MiB; PolC8 pol; if (NBR_COOP) { __syncthreads(); pol.init(Hx, Oat, c8, c8 + 32 * MiB, INP(I_RPB), (float*)((char*)lds + NC_WS + wid * NC_WAVE + 256), w, lane); nbr8_coop(pol, lds, wid, lane); }
                        else { pol.init(Hx, Oat, c8, c8 + 32 * MiB, INP(I_RPB), (float*)((char*)wl + 16640), w, lane); d8::sparse8_wave(pol, wl, lane); } }
                    else { PolC pol; pol.init(Hx, Oat, INP(I_RPB), (float*)((char*)wl + 16640), w, lane); da::sparse_wave(pol, wl, lane); }
                }
            }
#if DBG_CHECK
            xcd_barrier(bar, fresh_tid(wv));
            dbg_attn_check(L, Hx, Qd, RA, krope, Oat, (float*)(ctl + CW_DBG), lds, bid, fresh_tid(wv));
            __syncthreads();
            if (L == 0) dbg_sparse_check(0, Hx, (const unsigned char*)RA, ws + WS_WGU1 + 64 * MiB, INP(I_RPB), Oat, (float*)(ctl + CW_DBG), lds, bid, fresh_tid(wv));
            else dbg_sparse_check(1, Hx, ws + WS_WGU0 + 64 * MiB, ws + WS_WD0 + 32 * MiB, INP(I_RPB), Oat, (float*)(ctl + CW_DBG), lds, bid, fresh_tid(wv));
            __syncthreads();
#endif
            SEAM(pb + 4);
        }
        if (IN(pb + 5)) {
            PHASE_PTRS;
            constexpr int KO = F8_OUT ? 1024 : 2048;
            pg8::Gemm g{Oat, Wout, KO, KO, KO}; pg8::StaticOrder S; S.init(T_, DM, G, bid, KO);
            pg8::EpiBf16T<F8_MIX != 0> E{RB, DM, 0xffff};
            _Pragma("unroll 1") for (int rep = 0; rep < NREP(5); ++rep) pg8::gemm_phase<F8_OUT != 0>(wv, lds, g, S, E, F8_OUT ? 1.0f / (W8_SCALE * O8_SCALE) : 1.0f);
            SEAM(pb + 5);
        }
        if (IN(pb + 6)) {
            PHASE_PTRS;
            if (L == 0) { _Pragma("unroll 1") for (int rep = 0; rep < NREP(6); ++rep) phase_ln_router<true>(RB, INP(I_X), INP(I_LN1G0), INP(I_LN1B0), INP(I_RW), INP(I_RB), x1b, (unsigned char*)RC + 64 * MiB, tok_e, tok_p, tok_g, list, cnt, lds, G, bid, fresh_tid(wv), rep + 1 == NREP(6)); }
            else { _Pragma("unroll 1") for (int rep = 0; rep < NREP(6); ++rep) phase_ln_router<false>(RB, RC, INP(I_LN1G1), INP(I_LN1B1), INP(I_RW), INP(I_RB), x1b, outb  , tok_e, tok_p, tok_g, list, cnt, lds, G, bid, fresh_tid(wv), rep + 1 == NREP(6)); }
            SEAM(pb + 6);
        }
        if (IN(pb + 7)) {
            PHASE_PTRS;
            LAS int* pblk = (LAS int*)(lds + MOE_LDS); LAS int* tab = pblk + 64; LAS int* aux = tab + 32; LAS int* idx = aux + 64;
            const int tid = fresh_tid(wv);
            const int NB = moe_prefix(cnt, pblk, tid);
            const int n = moe_table<4>(cnt, pblk, tab, aux, NB, G, vcu, tid);
            for (int i = 0; i < n; ++i) if (tid < 256) { const int e = aux[i * 3], rs = aux[i * 3 + 1], ce = aux[i * 3 + 2]; idx[i * 256 + tid] = list[(size_t)e * 65536 + min(rs + tid, ce - 1)]; }
            __syncthreads();
            constexpr int KG = F8_GU ? 1024 : 2048;
            const bf16_t* agu = F8_GU ? (L ? (const bf16_t*)outb : (const bf16_t*)((unsigned char*)RC + 64 * MiB)) : x1b;
            pg8::Gemm g{agu, Wgu, KG, KG, KG}; pg8::TableOrder<true> S{tab, idx, n, KG}; pg8::EpiSiluMul<F8_DOWN != 0> E{Hm};
            _Pragma("unroll 1") for (int rep = 0; rep < NREP(7); ++rep) pg8::gemm_phase<F8_GU != 0>(wv, lds, g, S, E, F8_GU ? 1.0f / W8_SCALE : 1.0f);
            SEAM(pb + 7);
        }
        if (IN(pb + 8)) {
            PHASE_PTRS;
            LAS int* pblk = (LAS int*)(lds + MOE_LDS); LAS int* tab = pblk + 64; LAS int* aux = tab + 32;
            const int tid = fresh_tid(wv);
            const int NB = moe_prefix(cnt, pblk, tid);
            const int n = moe_table<8>(cnt, pblk, tab, aux, NB, G, vcu, tid);
            constexpr int KD = F8_DOWN ? 256 : 512;
            pg8::Gemm g{Hm, Wd, KD, KD, KD}; pg8::TableOrder<false> S{tab, nullptr, n, KD}; pg8::EpiBf16T<F8_YR != 0> E{Yr, DM, 7};
            _Pragma("unroll 1") for (int rep = 0; rep < NREP(8); ++rep) pg8::gemm_phase<F8_DOWN != 0>(wv, lds, g, S, E, F8_DOWN ? 1.0f / W8_SCALE : 1.0f);
            SEAM(pb + 8);
        }
        if (IN(pb + 9)) _Pragma("unroll 1") for (int rep = 0; rep < NREP(9); ++rep) {
            PHASE_PTRS;
            if (L == 0) phase_combine_ln<false>((const float*)(ctl + CW_DBG), x1b, Yr, tok_e, tok_p, tok_g, cnt, INP(I_LN2G0), INP(I_LN2B0), RC, outb, nullptr, lds, G, bid, fresh_tid(wv));
            else phase_combine_ln<true>((const float*)(ctl + CW_DBG), x1b, Yr, tok_e, tok_p, tok_g, cnt, INP(I_LN2G1), INP(I_LN2B1), nullptr, nullptr, (float*)outb, lds, G, bid, fresh_tid(wv));
            if (rep + 1 == NREP(9)) SEAM(pb + 9);
        }
    }
#undef IN
#undef SEAM
#undef INP
#undef PHASE_PTRS
}

extern "C" void kernel_launch(void* const* d_in, const int* in_sizes, int n_in, void* d_out, int out_size, void* d_ws, size_t ws_size, hipStream_t stream) {
    static int grid = 0;
    if (grid == 0) {
        if (n_in != 28 || out_size != T_ * DM || ws_size < WS_END) { fprintf(stderr, "kernel_launch: unexpected shapes: n_in %d out %d ws %zu (need %zu)\n", n_in, out_size, ws_size, (size_t)WS_END); grid = -1; return; }
        int dev = 0, cus = 0, per_cu = 0;
        if (hipGetDevice(&dev) != hipSuccess || hipDeviceGetAttribute(&cus, hipDeviceAttributeMultiprocessorCount, dev) != hipSuccess) { grid = -1; return; }
        if (hipFuncSetAttribute((const void*)fwd, hipFuncAttributeMaxDynamicSharedMemorySize, LDS_BYTES) != hipSuccess) { fprintf(stderr, "kernel_launch: hipFuncSetAttribute failed\n"); grid = -1; return; }
        if (hipOccupancyMaxActiveBlocksPerMultiprocessor(&per_cu, (const void*)fwd, NTHR, LDS_BYTES) != hipSuccess || per_cu < 1)
            fprintf(stderr, "kernel_launch: occupancy query reports %d workgroups per CU\n", per_cu);
        (void)hipGetLastError();
        grid = cus;
    }
    if (grid < 0) return;
    (void)hipMemsetAsync((char*)d_ws + WS_CTL, 0, CTL_ZERO_BYTES, stream);
    Params p{};
    for (int i = 0; i < 28; ++i) p.in[i] = (const float*)d_in[i];
    p.out = (float*)d_out; p.ws = (unsigned char*)d_ws;
#if N_LAUNCH_MODE == 1
    p.ph_lo = 0; p.ph_hi = N_PHASES;
    hipLaunchKernelGGL(fwd, dim3(grid), dim3(NTHR), LDS_BYTES, stream, p);
#else
    for (int k = 0; k < N_PHASES; ++k) { if (k == 3 || k == 10) continue; p.ph_lo = k; p.ph_hi = k + 1;
        hipLaunchKernelGGL(fwd, dim3(grid), dim3(NTHR), LDS_BYTES, stream, p); }
#endif
    const hipError_t le = hipPeekAtLastError();
    if (le != hipSuccess) fprintf(stderr, "kernel_launch: launch failed: %s\n", hipGetErrorName(le));
}
```

```cpp
#include <hip/hip_runtime.h>
#include <cstdio>
#include <cstdint>
#include <type_traits>

#ifndef N_LAUNCH_MODE
#define N_LAUNCH_MODE 1
#endif
#ifndef DBG_CHECK
#define DBG_CHECK 0
#define F8_P3 1
#define F8_MIX 1
#define D8_DMA_A 1
#define D8_DMA_D 1
#define D8_MACC_D 1
#endif
#ifndef DBG_TOL_SP
#define DBG_TOL_SP 0.08f
#endif
#ifndef DBG_TOL
#define DBG_TOL 0.3f
#endif
#ifndef F8_DOWN
#define F8_DOWN 1
#endif
#ifndef F8_GU
#define F8_GU 1
#endif
#ifndef F8_IN
#define F8_IN 1
#endif
#ifndef F8_OUT
#define F8_OUT 1
#endif
#ifndef F8_ATTA
#define F8_ATTA 1
#endif
#ifndef F8_ATTD
#define F8_ATTD 1
#endif
#ifndef F8_SPARSE
#define F8_SPARSE 1
#endif
#ifndef GEMM_SKEW
#define GEMM_SKEW 0
#endif
#ifndef F8_YR
#define F8_YR 1
#endif

#define LAS __attribute__((address_space(3)))
typedef unsigned short bf16_t;
typedef short bf16x8 __attribute__((ext_vector_type(8)));
typedef short s16x4 __attribute__((ext_vector_type(4)));
typedef float f32x2 __attribute__((ext_vector_type(2)));
typedef float f32x4 __attribute__((ext_vector_type(4)));
typedef float f32x8 __attribute__((ext_vector_type(8)));
typedef float f32x16 __attribute__((ext_vector_type(16)));
typedef unsigned u32x2 __attribute__((ext_vector_type(2)));
typedef unsigned u32x4 __attribute__((ext_vector_type(4)));
typedef int i32x8 __attribute__((ext_vector_type(8)));
typedef _Float16 f16x8 __attribute__((ext_vector_type(8)));
typedef _Float16 f16x2 __attribute__((ext_vector_type(2)));
typedef int i32x4 __attribute__((ext_vector_type(4)));

constexpr int T_ = 32768, DM = 2048, SEQ = 4096, NBATCH = 8;
constexpr int IN0 = 4608, IN1 = 3904, IN1P = 4096;
constexpr int NE = 32, DE = 512, MAXBLK = 288;
constexpr float ALPHA = 1.4142135623730951f;
constexpr float LOG2E = 1.4426950408889634f;
constexpr int NTHR = 512;

constexpr size_t MiB = 1u << 20;
constexpr size_t WS_CTL = 0, CTL_ZERO_BYTES = 1 * MiB;
constexpr size_t WS_LIST = 1 * MiB;
constexpr size_t WS_TOKE = 9 * MiB;
constexpr size_t WS_TOKP = WS_TOKE + 256 * 1024;
constexpr size_t WS_TOKG = WS_TOKP + 256 * 1024;
constexpr size_t WS_RSTAT = WS_TOKG + 256 * 1024;
constexpr size_t WS_KROPE = 10 * MiB;
constexpr size_t WS_WIN0 = 16 * MiB, WS_WOUT0 = 34 * MiB, WS_WGU0 = 42 * MiB, WS_WD0 = 170 * MiB;
constexpr size_t WS_WIN1 = 234 * MiB, WS_WOUT1 = 250 * MiB, WS_WGU1 = 258 * MiB, WS_WD1 = 386 * MiB;
constexpr size_t WS_WQUP = 450 * MiB, WS_WKVUP = 452 * MiB;
constexpr size_t WS_RA = 454 * MiB, WS_RB = 582 * MiB, WS_RC = 870 * MiB, WS_END = 998 * MiB;
constexpr size_t OUT_QD = 0, OUT_O1 = 96 * MiB;
constexpr int CW_CNT = 64;
constexpr int CW_DBG = 512;
constexpr int CW_BAR = 4096;

constexpr int LDS_BYTES = 155648;
constexpr int MISC_OFF = LDS_BYTES - 64;

__device__ __forceinline__ unsigned cvtpk(float lo, float hi) { unsigned r; asm volatile("v_cvt_pk_bf16_f32 %0, %1, %2" : "=v"(r) : "v"(lo), "v"(hi)); return r; }
__device__ __forceinline__ float bf2f(unsigned short b) { return __uint_as_float(((unsigned)b) << 16); }
__device__ __forceinline__ float bflo(unsigned w) { return __uint_as_float(w << 16); }
__device__ __forceinline__ float bfhi(unsigned w) { return __uint_as_float(w & 0xffff0000u); }
__device__ __forceinline__ bf16_t f2bf(float f) { return (bf16_t)(cvtpk(f, f) & 0xffffu); }
__device__ __forceinline__ unsigned pk4_fp8(float a, float b, float c, float d) { int w = (int)__float_as_uint(a);
    w = __builtin_amdgcn_cvt_pk_fp8_f32(a, b, w, false); w = __builtin_amdgcn_cvt_pk_fp8_f32(c, d, w, true); return (unsigned)w; }
constexpr float O8_SCALE = 16.f;
__device__ __forceinline__ unsigned char f2fp8(float v) { return (unsigned char)(__builtin_amdgcn_cvt_pk_fp8_f32(v, v, (int)__float_as_uint(v), false) & 0xff); }
__device__ __forceinline__ float clamp8(float v) { return fminf(fmaxf(v, -400.f), 400.f); }
__device__ __forceinline__ int fresh_tid(int wv) { int l; asm volatile("v_mbcnt_lo_u32_b32 %0, -1, 0\n\tv_mbcnt_hi_u32_b32 %0, -1, %0" : "=v"(l)); return wv * 64 + l; }
__device__ __forceinline__ float fresh_zero() { float z; asm volatile("v_mov_b32 %0, 0" : "=v"(z)); return z; }
__device__ __forceinline__ float wave_sum(float v) {
    v += __int_as_float(__builtin_amdgcn_ds_swizzle(__float_as_int(v), (1 << 10) | 0x1f));
    v += __int_as_float(__builtin_amdgcn_ds_swizzle(__float_as_int(v), (2 << 10) | 0x1f));
    v += __int_as_float(__builtin_amdgcn_ds_swizzle(__float_as_int(v), (4 << 10) | 0x1f));
    v += __int_as_float(__builtin_amdgcn_ds_swizzle(__float_as_int(v), (8 << 10) | 0x1f));
    v += __int_as_float(__builtin_amdgcn_ds_swizzle(__float_as_int(v), (16 << 10) | 0x1f));
    auto rr = __builtin_amdgcn_permlane32_swap(__float_as_uint(v), __float_as_uint(v), false, false);
    return __uint_as_float(rr[0]) + __uint_as_float(rr[1]);
}
__device__ __forceinline__ float wave_max(float v) {
    v = fmaxf(v, __int_as_float(__builtin_amdgcn_ds_swizzle(__float_as_int(v), (1 << 10) | 0x1f)));
    v = fmaxf(v, __int_as_float(__builtin_amdgcn_ds_swizzle(__float_as_int(v), (2 << 10) | 0x1f)));
    v = fmaxf(v, __int_as_float(__builtin_amdgcn_ds_swizzle(__float_as_int(v), (4 << 10) | 0x1f)));
    v = fmaxf(v, __int_as_float(__builtin_amdgcn_ds_swizzle(__float_as_int(v), (8 << 10) | 0x1f)));
    v = fmaxf(v, __int_as_float(__builtin_amdgcn_ds_swizzle(__float_as_int(v), (16 << 10) | 0x1f)));
    auto rr = __builtin_amdgcn_permlane32_swap(__float_as_uint(v), __float_as_uint(v), false, false);
    return fmaxf(__uint_as_float(rr[0]), __uint_as_float(rr[1]));
}
__device__ __forceinline__ float inv_freq32(int i) { return __builtin_amdgcn_exp2f(-(float)i * 0.41524101186092029f); }
__device__ __forceinline__ void sincos_rev(float angle, float& s, float& c) {
    float rev = angle * 0.15915494309189535f; rev = rev - floorf(rev);
    s = __builtin_amdgcn_sinf(rev); c = __builtin_amdgcn_cosf(rev);
}

#define XB_TMO      128
#define XB_XCNT(j)  (256  + 64 * (j))
#define XB_XSUB(j)  (1280 + 64 * (j))
#define XB_XGEN(j)  (2304 + 64 * (j))
#define XB_TOP      3328
#define XB_TOPGEN   3392
#define XCD_BAR_WORDS 3456
#define XB_SPIN_CAP (1u << 20)
__device__ __forceinline__ unsigned xb_ld(unsigned* p)              { return __hip_atomic_load(p, __ATOMIC_RELAXED, __HIP_MEMORY_SCOPE_AGENT); }
__device__ __forceinline__ unsigned xb_add(unsigned* p, unsigned v) { return __hip_atomic_fetch_add(p, v, __ATOMIC_RELAXED, __HIP_MEMORY_SCOPE_AGENT); }
__device__ __forceinline__ unsigned xb_xcc_id() { return (unsigned)__builtin_amdgcn_s_getreg((3 << 11) | 20) & 0xFu; }
#define XB_SPIN(cond, bar) do { unsigned _sp = 0; while (cond) { __builtin_amdgcn_s_sleep(1); \
    if ((++_sp & 255u) == 0u) { if (xb_ld(&(bar)[XB_TMO])) break; if (_sp > XB_SPIN_CAP) { atomicAdd(&(bar)[XB_TMO], 1u); break; } } } } while (0)
struct XcdBarrier { unsigned* bar; unsigned x; volatile LAS unsigned* st; };
__device__ __forceinline__ XcdBarrier xcd_barrier_post(unsigned* bar, volatile LAS unsigned* st) {
    XcdBarrier b; b.bar = bar; b.x = xb_xcc_id(); b.st = st;
    if (threadIdx.x == 0) (void)xb_add(&bar[XB_XCNT(b.x)], 1u);
    return b;
}
__device__ __forceinline__ void xcd_barrier_complete(unsigned* bar, unsigned x, unsigned& nloc, unsigned& nx) {
    const unsigned G = gridDim.x * gridDim.y * gridDim.z;
    unsigned sum, cnt, mine, sp = 0u;
    for (;;) {
        sum = 0u; cnt = 0u; mine = 0u;
#pragma unroll
        for (unsigned j = 0; j < 16; ++j) { const unsigned c = xb_ld(&bar[XB_XCNT(j)]); sum += c; cnt += (c > 0u) ? 1u : 0u; mine = (j == x) ? c : mine; }
        if (sum == G) break;
        __builtin_amdgcn_s_sleep(1);
        if ((++sp & 255u) == 0u) { if (xb_ld(&bar[XB_TMO])) break; if (sp > XB_SPIN_CAP) { atomicAdd(&bar[XB_TMO], 1u); break; } }
    }
    nloc = mine > 0u ? mine : 1u; nx = cnt > 0u ? cnt : 1u;
}
__device__ __forceinline__ void xcd_barrier(const XcdBarrier& b, int tid_now) {
    asm volatile("s_waitcnt vmcnt(0)" ::: "memory");
    __syncthreads();
    if (tid_now == 0) {
        unsigned* bar = b.bar;
        __builtin_amdgcn_s_waitcnt(0);
        unsigned nloc = b.st[0], nx = b.st[1];
        if (nloc == 0u) { xcd_barrier_complete(bar, b.x, nloc, nx); b.st[0] = nloc; b.st[1] = nx; }
        const unsigned old = xb_add(&bar[XB_XSUB(b.x)], 1u);
        const unsigned gen = old / nloc;
        if (old + 1u == (gen + 1u) * nloc) {
            __builtin_amdgcn_fence(__ATOMIC_RELEASE, "agent");
            asm volatile("s_waitcnt vmcnt(0)" ::: "memory");
            const unsigned og = xb_add(&bar[XB_TOP], 1u);
            const unsigned tg = og / nx;
            if (og + 1u == (tg + 1u) * nx) xb_add(&bar[XB_TOPGEN], 1u);
            else XB_SPIN(xb_ld(&bar[XB_TOPGEN]) == tg, bar);
            __builtin_amdgcn_fence(__ATOMIC_ACQUIRE, "agent");
            xb_add(&bar[XB_XGEN(b.x)], 1u);
            asm volatile("s_waitcnt vmcnt(0)" ::: "memory");
        } else {
            XB_SPIN(xb_ld(&bar[XB_XGEN(b.x)]) == gen, bar);
            __builtin_amdgcn_fence(__ATOMIC_ACQUIRE, "agent");
            asm volatile("s_waitcnt vmcnt(0)" ::: "memory");
        }
    }
    __syncthreads();
}

namespace pg8 {
constexpr int BM = 256, BK = 64, HALF = 128, HTB = HALF * BK * 2, STAGE_BYTES = 8 * HTB, NXCD = 8, WGM = 8;
__device__ __forceinline__ int lds_byte(int r, int c) { const int st = (r >> 4) * 2 + (c >> 5), rr = r & 15, cc = c & 31, ob = rr * 64 + cc * 2; return st * 1024 + (ob ^ (((ob >> 9) & 1) << 5)); }
__device__ __forceinline__ void stage_rc(int b, int& R, int& C) { const int st = b / 1024, sb = b % 1024, swz = sb ^ (((sb >> 9) & 1) << 5); R = (st >> 1) * 16 + swz / 64; C = (st & 1) * 32 + (swz % 64) / 2; }
__device__ __forceinline__ int perm32(int rho) { const int n = rho >> 4, i = rho & 15; return 8 * (i >> 2) + 4 * n + (i & 3); }
struct Unit { int pm, pn, q; };
struct Gemm { const bf16_t* A; const bf16_t* Bt; int K, lda, ldb; };

struct StaticOrder {
    static constexpr bool GATHER = false;
    int nM, nN, nwg, G, c, lda;
    __device__ void init(int M, int N, int G_, int c_, int lda_) { nM = M / BM; nN = N / BM; nwg = nM * nN; G = G_; c = c_; lda = lda_; }
    __device__ __forceinline__ bool next(int i, Unit& u) const {
        const long L = (long)i * G + c; if (L >= nwg) return false;
        int wgid = (int)L; { const int q = nwg / NXCD, r = nwg % NXCD, xcd = wgid % NXCD, off = wgid / NXCD; wgid = (xcd < r ? xcd * (q + 1) : r * (q + 1) + (xcd - r) * q) + off; }
        const int nig = WGM * nN, gid = wgid / nig, fm = gid * WGM, gsz = (nM - fm) < WGM ? (nM - fm) : WGM;
        u.pm = fm + ((wgid % nig) % gsz); u.pn = (wgid % nig) / gsz; u.q = i; return true;
    }
    __device__ __forceinline__ void aoff(const Unit& u, const int (&R)[2], const int (&C)[2], unsigned (&o)[2][2]) const {
#pragma unroll
        for (int h = 0; h < 2; ++h)
#pragma unroll
            for (int i = 0; i < 2; ++i) o[h][i] = (unsigned)((u.pm * BM + h * HALF + R[i]) * lda + C[i]) * 2u;
    }
};
template <bool GATHER_> struct TableOrder {
    static constexpr bool GATHER = GATHER_;
    const LAS int* tab; const LAS int* idx; int n, lda;
    __device__ __forceinline__ bool next(int i, Unit& u) const { if (i >= n) return false; u.pm = tab[i]; u.pn = tab[16 + i]; u.q = i; return true; }
    __device__ __forceinline__ void aoff(const Unit& u, const int (&R)[2], const int (&C)[2], unsigned (&o)[2][2]) const {
#pragma unroll
        for (int h = 0; h < 2; ++h)
#pragma unroll
            for (int i = 0; i < 2; ++i) { const int row = GATHER ? idx[u.q * 256 + h * HALF + R[i]] : (u.pm * BM + h * HALF + R[i]); o[h][i] = (unsigned)(row * lda + C[i]) * 2u; }
    }
};

template <bool O8> struct EpiBf16T {
    static constexpr bool PERM = true;
    bf16_t* O; int ldc; int pnmask;
    __device__ __forceinline__ void operator()(const f32x4 (&acc)[2][2][4][2], const Unit& u, int wr, int wc, int fr, int fq) const {
        const int row0 = u.pm * BM + wr * 64 + fr; const int col0 = (u.pn & pnmask) * BM + wc * 32 + 8 * fq;
#pragma unroll
        for (int ai = 0; ai < 2; ++ai)
#pragma unroll
            for (int m = 0; m < 4; ++m) { const size_t eoff = (size_t)(row0 + ai * HALF + m * 16) * ldc + col0;
#pragma unroll
                for (int bj = 0; bj < 2; ++bj) { const f32x4 v0 = acc[ai][bj][m][0], v1 = acc[ai][bj][m][1];
                    if constexpr (O8) { u32x2 w; w.x = pk4_fp8(v0[0] * 16.f, v0[1] * 16.f, v0[2] * 16.f, v0[3] * 16.f); w.y = pk4_fp8(v1[0] * 16.f, v1[1] * 16.f, v1[2] * 16.f, v1[3] * 16.f);
                        *(u32x2*)((unsigned char*)O + eoff + bj * HALF) = w; }
                    else { u32x4 w; w.x = cvtpk(v0[0], v0[1]); w.y = cvtpk(v0[2], v0[3]); w.z = cvtpk(v1[0], v1[1]); w.w = cvtpk(v1[2], v1[3]);
                        *(u32x4*)(O + eoff + bj * HALF) = w; } } }
    }
};
typedef EpiBf16T<false> EpiBf16;
struct EpiRowScale {
    static constexpr bool PERM = true;
    bf16_t* O; int ldc; const float* rs; int which;
    __device__ __forceinline__ void operator()(const f32x4 (&acc)[2][2][4][2], const Unit& u, int wr, int wc, int fr, int fq) const {
        const int row0 = u.pm * BM + wr * 64 + fr; const int col0 = u.pn * BM + wc * 32 + 8 * fq;
#pragma unroll
        for (int ai = 0; ai < 2; ++ai)
#pragma unroll
            for (int m = 0; m < 4; ++m) { const int row = row0 + ai * HALF + m * 16; const float s = rs[row * 2 + which]; bf16_t* rowp = O + (size_t)row * ldc + col0;
#pragma unroll
                for (int bj = 0; bj < 2; ++bj) { const f32x4 v0 = acc[ai][bj][m][0] * s, v1 = acc[ai][bj][m][1] * s;
                    u32x4 w; w.x = cvtpk(v0[0], v0[1]); w.y = cvtpk(v0[2], v0[3]); w.z = cvtpk(v1[0], v1[1]); w.w = cvtpk(v1[2], v1[3]);
                    *(u32x4*)(rowp + bj * HALF) = w; } }
    }
};
struct EpiIn {
    static constexpr bool PERM = true;
    bf16_t* H; int ldh; unsigned char* K8; unsigned char* V8; int k_lo, v_lo, v_hi;
    __device__ __forceinline__ void operator()(const f32x4 (&acc)[2][2][4][2], const Unit& u, int wr, int wc, int fr, int fq) const {
        const int row0 = u.pm * BM + wr * 64 + fr; const int cw = wc * 32 + 8 * fq;
        const bool is8 = (u.pn >= k_lo && u.pn < v_hi);
        unsigned char* b8 = (u.pn < v_lo) ? K8 + (size_t)(u.pn - k_lo) * BM : V8 + (size_t)(u.pn - v_lo) * BM;
#pragma unroll
        for (int ai = 0; ai < 2; ++ai)
#pragma unroll
            for (int m = 0; m < 4; ++m) { const size_t row = (size_t)(row0 + ai * HALF + m * 16);
#pragma unroll
                for (int bj = 0; bj < 2; ++bj) { const f32x4 v0 = acc[ai][bj][m][0], v1 = acc[ai][bj][m][1];
                    if (is8) *(u32x2*)(b8 + row * 1024 + bj * HALF + cw) = (u32x2){pk4_fp8(v0[0], v0[1], v0[2], v0[3]), pk4_fp8(v1[0], v1[1], v1[2], v1[3])};
                    else { u32x4 w; w.x = cvtpk(v0[0], v0[1]); w.y = cvtpk(v0[2], v0[3]); w.z = cvtpk(v1[0], v1[1]); w.w = cvtpk(v1[2], v1[3]);
                        *(u32x4*)(H + row * ldh + u.pn * BM + bj * HALF + cw) = w; } } }
    }
};
struct EpiNull { static constexpr bool PERM = true; float* sink;
    __device__ __forceinline__ void operator()(const f32x4 (&acc)[2][2][4][2], const Unit& u, int wr, int wc, int fr, int fq) const {
        float s = 0.f;
#pragma unroll
        for (int ai = 0; ai < 2; ++ai)
#pragma unroll
            for (int bj = 0; bj < 2; ++bj)
#pragma unroll
                for (int m = 0; m < 4; ++m)
#pragma unroll
                    for (int n = 0; n < 2; ++n) s += acc[ai][bj][m][n][0] + acc[ai][bj][m][n][1] + acc[ai][bj][m][n][2] + acc[ai][bj][m][n][3];
        if (s == 123.456f) sink[0] = s; } };
struct EpiKV8 {
    static constexpr bool PERM = true;
    unsigned char* K8; unsigned char* Vt8; bf16_t* KV; bool wr_bf16;
    __device__ __forceinline__ void operator()(const f32x4 (&acc)[2][2][4][2], const Unit& u, int wr, int wc, int fr, int fq) const {
        const int row0 = u.pm * BM + wr * 64 + fr; const int c0 = wc * 32 + 8 * fq;
#pragma unroll
        for (int ai = 0; ai < 2; ++ai)
#pragma unroll
            for (int m = 0; m < 4; ++m) { const int row = row0 + ai * HALF + m * 16;
                { const f32x4 v0 = acc[ai][0][m][0], v1 = acc[ai][0][m][1];
                  *(u32x2*)(K8 + (size_t)row * 1024 + u.pn * 128 + c0) = (u32x2){pk4_fp8(v0[0], v0[1], v0[2], v0[3]), pk4_fp8(v1[0], v1[1], v1[2], v1[3])}; }
                { const f32x4 v0 = acc[ai][1][m][0], v1 = acc[ai][1][m][1]; const float vv[8] = {v0[0], v0[1], v0[2], v0[3], v1[0], v1[1], v1[2], v1[3]};
                  unsigned char* vp = Vt8 + ((size_t)((row >> 12) * 8 + u.pn) * 128 + c0) * SEQ + (row & (SEQ - 1));
#pragma unroll
                  for (int e = 0; e < 8; ++e) vp[(size_t)e * SEQ] = f2fp8(vv[e]); }
                if (wr_bf16) {
#pragma unroll
                    for (int bj = 0; bj < 2; ++bj) { const f32x4 v0 = acc[ai][bj][m][0], v1 = acc[ai][bj][m][1];
                        u32x4 w; w.x = cvtpk(v0[0], v0[1]); w.y = cvtpk(v0[2], v0[3]); w.z = cvtpk(v1[0], v1[1]); w.w = cvtpk(v1[2], v1[3]);
                        *(u32x4*)(KV + (size_t)row * DM + u.pn * BM + bj * HALF + c0) = w; } } }
    }
};
template <bool O8> struct EpiSiluMul {
    static constexpr bool PERM = true;
    bf16_t* O;
    __device__ __forceinline__ void operator()(const f32x4 (&acc)[2][2][4][2], const Unit& u, int wr, int wc, int fr, int fq) const {
        const int row0 = u.pm * BM + wr * 64 + fr; const int col0 = (u.pn & 3) * HALF + wc * 32 + 8 * fq;
#pragma unroll
        for (int ai = 0; ai < 2; ++ai)
#pragma unroll
            for (int m = 0; m < 4; ++m) { const size_t eoff = (size_t)(row0 + ai * HALF + m * 16) * DE + col0; float h[8];
#pragma unroll
                for (int n = 0; n < 2; ++n)
#pragma unroll
                    for (int j = 0; j < 4; ++j) { const float g = acc[ai][0][m][n][j], up = acc[ai][1][m][n][j];
                        const float sg = g * __builtin_amdgcn_rcpf(1.0f + __builtin_amdgcn_exp2f(-g * LOG2E)); h[n * 4 + j] = sg * up; }
                if constexpr (O8) { u32x2 w; w.x = pk4_fp8(clamp8(h[0]), clamp8(h[1]), clamp8(h[2]), clamp8(h[3])); w.y = pk4_fp8(clamp8(h[4]), clamp8(h[5]), clamp8(h[6]), clamp8(h[7]));
                    *(u32x2*)((unsigned char*)O + eoff) = w; }
                else { u32x4 w; w.x = cvtpk(h[0], h[1]); w.y = cvtpk(h[2], h[3]); w.z = cvtpk(h[4], h[5]); w.w = cvtpk(h[6], h[7]);
                    *(u32x4*)(O + eoff) = w; } }
    }
};
template <bool RES_F32> struct EpiResF32 {
    static constexpr bool PERM = false;
    float* Z; const void* res;
    __device__ __forceinline__ void operator()(const f32x4 (&acc)[2][2][4][2], const Unit& u, int wr, int wc, int fr, int fq) const {
        const int row0 = u.pm * BM + wr * 64 + fr, col0 = u.pn * BM + wc * 32 + 4 * fq;
        float ALPHA = 1.4142135623730951f; asm volatile("" : "+v"(ALPHA));
#pragma unroll
        for (int ai = 0; ai < 2; ++ai)
#pragma unroll
            for (int m = 0; m < 4; ++m) { const size_t off = (size_t)(row0 + ai * HALF + m * 16) * DM + col0;
#pragma unroll
                for (int bj = 0; bj < 2; ++bj)
#pragma unroll
                    for (int n = 0; n < 2; ++n) { f32x4 o = acc[ai][bj][m][n];
                        if constexpr (RES_F32) { const f32x4 rv = *(const f32x4*)((const float*)res + off + bj * HALF + n * 16); o += ALPHA * rv; }
                        else { const u32x2 rb = *(const u32x2*)((const bf16_t*)res + off + bj * HALF + n * 16);
                            o[0] += ALPHA * bflo(rb.x); o[1] += ALPHA * bfhi(rb.x); o[2] += ALPHA * bflo(rb.y); o[3] += ALPHA * bfhi(rb.y); }
                        *(f32x4*)(Z + off + bj * HALF + n * 16) = o; } }
    }
};

template <bool F8, class Epi, class Sched>
__device__ __forceinline__ void gemm_phase(int wv, LAS unsigned char* lds, const Gemm g, const Sched& S, const Epi& E, float oscale = 1.0f) {
    constexpr bool GA = Sched::GATHER;
    const int tid = fresh_tid(wv), wid = __builtin_amdgcn_readfirstlane(tid >> 6), lane = tid & 63, wr = wid >> 2, wc = wid & 3, fr = lane & 15, fq = lane >> 4;
    int K = g.K; asm volatile("" : "+s"(K));
    const int nt = K / BK;
    int Rr[2], Cc[2]; unsigned voffA[2], voffB[2];
#pragma unroll
    for (int i = 0; i < 2; ++i) { int R, C; stage_rc(tid * 16 + i * 8192, R, C); Rr[i] = R; Cc[i] = C; const int Rb = Epi::PERM ? ((R & ~31) + perm32(R & 31)) : R;
        voffA[i] = (unsigned)(R * g.lda + C) * 2u; voffB[i] = (unsigned)(Rb * g.ldb + C) * 2u; }
    const size_t kstep = (size_t)(BK * 2);
    const size_t hstepA = (size_t)HALF * g.lda * 2, tstepA = 2 * hstepA;
    const size_t hstepB = (size_t)HALF * g.ldb * 2, tstepB = 2 * hstepB;
    const unsigned ldsw = (unsigned)wid * 1024u;
    const int aoff = lds_byte(wr * 64 + fr, fq * 8), boff = lds_byte(wc * 32 + fr, fq * 8);
#define PG8_SA(b, h) (((b) * 2 + (h)) * HTB)
#define PG8_SB(b, h) ((4 + (b) * 2 + (h)) * HTB)
#define PG8_STAGE(bufoff, gbase, voff) do { _Pragma("unroll") for (int _i = 0; _i < 2; ++_i) \
        __builtin_amdgcn_global_load_lds((const unsigned*)((const char*)(gbase) + (voff)[_i]), (LAS unsigned*)(lds + (bufoff) + ldsw + _i * 8192), 16, 0, 0); } while (0)
#define PG8_STAGE_A(bufoff, h, pbase, koff, goffs) do { if constexpr (GA) { PG8_STAGE(bufoff, gA + (koff), (goffs)[h]); } else { PG8_STAGE(bufoff, (pbase) + (h) * hstepA, voffA); } } while (0)
#define PG8_LD32(dst, off) do { const i32x4 _lo = *(const LAS i32x4*)(lds + (off)), _hi = *(const LAS i32x4*)(lds + (off) + 1024); dst = __builtin_shufflevector(_lo, _hi, 0, 1, 2, 3, 4, 5, 6, 7); } while (0)
#define PG8_LDA(dst, b, h) do { _Pragma("unroll") for (int m = 0; m < 4; ++m) PG8_LD32(dst[m], PG8_SA(b, h) + aoff + m * 2048); } while (0)
#define PG8_LDB(dst, b, h) do { _Pragma("unroll") for (int n = 0; n < 2; ++n) PG8_LD32(dst[n], PG8_SB(b, h) + boff + n * 2048); } while (0)
#define PG8_LOH(v) __builtin_bit_cast(bf16x8, __builtin_shufflevector(v, v, 0, 1, 2, 3))
#define PG8_HIH(v) __builtin_bit_cast(bf16x8, __builtin_shufflevector(v, v, 4, 5, 6, 7))
#define PG8_MMA(ai, bj, At, Bt) do { __builtin_amdgcn_s_setprio(1); \
        if constexpr (F8) { _Pragma("unroll") for (int m = 0; m < 4; ++m) _Pragma("unroll") for (int n = 0; n < 2; ++n) \
            asm volatile("v_mfma_f32_16x16x128_f8f6f4 %0, %1, %2, %0" : "+v"(acc[ai][bj][m][n]) : "v"(Bt[n]), "v"(At[m])); } \
        else { _Pragma("unroll") for (int m = 0; m < 4; ++m) _Pragma("unroll") for (int n = 0; n < 2; ++n) { \
            acc[ai][bj][m][n] = __builtin_amdgcn_mfma_f32_16x16x32_bf16(PG8_LOH(Bt[n]), PG8_LOH(At[m]), acc[ai][bj][m][n], 0, 0, 0); \
            acc[ai][bj][m][n] = __builtin_amdgcn_mfma_f32_16x16x32_bf16(PG8_HIH(Bt[n]), PG8_HIH(At[m]), acc[ai][bj][m][n], 0, 0, 0); } } \
        __builtin_amdgcn_s_setprio(0); } while (0)
#define PG8_WAIT_V(n) asm volatile("s_waitcnt vmcnt(" #n ")" ::: "memory")
#define PG8_WAIT_L(n) asm volatile("s_waitcnt lgkmcnt(" #n ")" ::: "memory")
#define PG8_BAR __builtin_amdgcn_s_barrier()
#define PG8_SCHED __builtin_amdgcn_sched_barrier(0)
    Unit cur, nxt; int ui = 0;
    if (!S.next(0, cur)) return;
    if (GEMM_SKEW > 0) { const unsigned long long t0 = __builtin_amdgcn_s_memrealtime(); const unsigned long long dl = (unsigned long long)((blockIdx.x >> 3) & 3) * GEMM_SKEW;
        while (__builtin_amdgcn_s_memrealtime() - t0 < dl) __builtin_amdgcn_s_sleep(8); }
    f32x4 acc[2][2][4][2];
#pragma unroll
    for (int a = 0; a < 2; ++a)
#pragma unroll
        for (int b = 0; b < 2; ++b)
#pragma unroll
            for (int m = 0; m < 4; ++m)
#pragma unroll
                for (int n = 0; n < 2; ++n) { const float zf = fresh_zero(); acc[a][b][m][n] = (f32x4){zf, zf, zf, zf}; }
    unsigned ca[2][2];
    if constexpr (GA) S.aoff(cur, Rr, Cc, ca);
    const char* gA = (const char*)g.A;
    const char* cA = gA + (GA ? (size_t)0 : (size_t)cur.pm * tstepA);
    const char* cB = (const char*)g.Bt + (size_t)cur.pn * tstepB;
    PG8_STAGE(PG8_SB(0, 0), cB, voffB); PG8_STAGE_A(PG8_SA(0, 0), 0, cA, 0, ca); PG8_STAGE(PG8_SB(0, 1), cB + hstepB, voffB); PG8_STAGE_A(PG8_SA(0, 1), 1, cA, 0, ca);
    if (wr == 1) PG8_BAR;
    PG8_WAIT_V(4); PG8_BAR;
    PG8_STAGE(PG8_SB(1, 0), cB + kstep, voffB); PG8_STAGE_A(PG8_SA(1, 0), 0, cA + kstep, kstep, ca); PG8_STAGE(PG8_SB(1, 1), cB + hstepB + kstep, voffB);
    PG8_WAIT_V(6); PG8_BAR;
    for (;;) {
        const bool has_next = S.next(ui + 1, nxt);
        const char* nA = (!GA && has_next) ? gA + (size_t)nxt.pm * tstepA : cA;
        const char* nB = has_next ? (const char*)g.Bt + (size_t)nxt.pn * tstepB : cB;
#pragma unroll 1
        for (int t = 0; t < nt; t += 2) {
            const bool last = (t == nt - 2);
            const size_t k1 = (size_t)(t + 1) * kstep, k2 = last ? (size_t)0 : (size_t)(t + 2) * kstep, k3 = k2 + kstep;
            const char* a1 = cA + k1;
            const char* a2 = last ? nA : cA + k2; const char* b2 = last ? nB : cB + (size_t)(t + 2) * kstep;
            const char* a3 = a2 + kstep; const char* b3 = b2 + kstep;
            i32x8 At[4], B0[2], B1[2];
            unsigned xa[2][2];
            if constexpr (GA) {
                if (last && has_next) { int R2[2], C2[2]; const int t2 = fresh_tid(wv); stage_rc(t2 * 16, R2[0], C2[0]); stage_rc(t2 * 16 + 8192, R2[1], C2[1]); S.aoff(nxt, R2, C2, xa); }
                else {
#pragma unroll
                    for (int h = 0; h < 2; ++h)
#pragma unroll
                        for (int i = 0; i < 2; ++i) xa[h][i] = ca[h][i];
                }
            }
            PG8_LDB(B0, 0, 0); PG8_SCHED; PG8_LDA(At, 0, 0); PG8_STAGE_A(PG8_SA(1, 1), 1, a1, k1, ca);
            PG8_WAIT_L(8); PG8_BAR; PG8_WAIT_L(0); PG8_MMA(0, 0, At, B0); PG8_BAR; PG8_SCHED;
            PG8_LDB(B1, 0, 1); PG8_STAGE(PG8_SB(0, 0), b2, voffB);
            PG8_BAR; PG8_WAIT_L(0); PG8_MMA(0, 1, At, B1); PG8_BAR;
            PG8_LDA(At, 0, 1); PG8_STAGE_A(PG8_SA(0, 0), 0, a2, k2, xa);
            PG8_BAR; PG8_WAIT_L(0); PG8_MMA(1, 0, At, B0); PG8_BAR; PG8_SCHED;
            PG8_STAGE(PG8_SB(0, 1), b2 + hstepB, voffB);
            PG8_WAIT_V(6); PG8_BAR; PG8_MMA(1, 1, At, B1); PG8_BAR;
            PG8_LDB(B0, 1, 0); PG8_SCHED; PG8_LDA(At, 1, 0); PG8_STAGE_A(PG8_SA(0, 1), 1, a2, k2, xa);
            PG8_WAIT_L(8); PG8_BAR; PG8_WAIT_L(0); PG8_MMA(0, 0, At, B0); PG8_BAR; PG8_SCHED;
            PG8_LDB(B1, 1, 1); PG8_STAGE(PG8_SB(1, 0), b3, voffB);
            PG8_BAR; PG8_WAIT_L(0); PG8_MMA(0, 1, At, B1); PG8_BAR;
            PG8_LDA(At, 1, 1); PG8_STAGE_A(PG8_SA(1, 0), 0, a3, k3, xa);
            PG8_BAR; PG8_WAIT_L(0); PG8_MMA(1, 0, At, B0); PG8_BAR; PG8_SCHED;
            PG8_STAGE(PG8_SB(1, 1), b3 + hstepB, voffB);
            PG8_WAIT_V(6); PG8_BAR; PG8_MMA(1, 1, At, B1); PG8_BAR;
        }
        if constexpr (F8) { asm volatile("s_nop 7\n\ts_nop 7\n\ts_nop 7" ::: "memory");
#pragma unroll
            for (int a = 0; a < 2; ++a)
#pragma unroll
                for (int b = 0; b < 2; ++b)
#pragma unroll
                    for (int m = 0; m < 4; ++m)
#pragma unroll
                        for (int n = 0; n < 2; ++n) acc[a][b][m][n] *= oscale; }
        { const int l2 = fresh_tid(0); E(acc, cur, wr, wc, l2 & 15, l2 >> 4); }
        if (!has_next) break;
#pragma unroll
        for (int a = 0; a < 2; ++a)
#pragma unroll
            for (int b = 0; b < 2; ++b)
#pragma unroll
                for (int m = 0; m < 4; ++m)
#pragma unroll
                    for (int n = 0; n < 2; ++n) { const float zf = fresh_zero(); acc[a][b][m][n] = (f32x4){zf, zf, zf, zf}; }
        cur = nxt; cA = nA; cB = nB; ++ui;
        if constexpr (GA) { int R2[2], C2[2]; const int t2 = fresh_tid(wv); stage_rc(t2 * 16, R2[0], C2[0]); stage_rc(t2 * 16 + 8192, R2[1], C2[1]); S.aoff(cur, R2, C2, ca); }
    }
    PG8_WAIT_V(0);
    if (wr == 0) PG8_BAR;
    PG8_BAR;
#undef PG8_SA
#undef PG8_SB
#undef PG8_STAGE
#undef PG8_STAGE_A
#undef PG8_LDA
#undef PG8_LDB
#undef PG8_MMA
#undef PG8_LD32
#undef PG8_LOH
#undef PG8_HIH
#undef PG8_WAIT_V
#undef PG8_WAIT_L
#undef PG8_BAR
#undef PG8_SCHED
}
}

namespace da {
constexpr int KVBLK = 64;
constexpr float THR = 8.f;
constexpr int SHM_V = KVBLK * 128 * 2, SHM_K = KVBLK * 128 * 2, SHM_KR = KVBLK * 64 * 2;
constexpr int OFF_V = 0, OFF_K = 2 * SHM_V, OFF_WS = OFF_K + 2 * SHM_K, OFF_KR = OFF_WS + 8 * 64 * 4, OFF_QR = OFF_KR + 2 * SHM_KR, LDS_DENSE = OFF_QR + 8 * 4096;
#define KSWZ(row, colB) ((row) * 256 + ((colB) ^ (((row) & 7) << 4)))
#define KRSWZ(row, ch) ((row) * 128 + ((((ch) ^ ((row) >> 1)) & 7) << 4))
#define SBAR() __builtin_amdgcn_sched_barrier(0)
__device__ __forceinline__ int crow(int r, int hi) { return (r & 3) + 8 * (r >> 2) + 4 * hi; }
__device__ __forceinline__ int v_st(int k, int c) { const int kk = (k & ~0xC) | ((k & 4) << 1) | ((k & 8) >> 1); return ((kk >> 3) * 4 + (c >> 5)) * 512 + ((kk & 7) * 32 + (c & 31)) * 2; }
__device__ __forceinline__ int v_rd_base(int lane) { return ((lane & 3) << 3) | (((lane >> 2) & 3) << 6) | (((lane >> 4) & 1) << 5) | (((lane >> 5) & 1) << 8); }
constexpr int v_rd_off(int d0, int ks, int half) { return d0 * 512 + ks * 4096 + half * 2048; }
template <int OFF> __device__ __forceinline__ s16x4 tr_read(int vb) {
    s16x4 r; asm volatile("ds_read_b64_tr_b16 %0, %1 offset:%2" : "=&v"(r) : "v"(vb), "i"(OFF) : "memory"); return r;
}
template <int D0> __device__ __forceinline__ void pv_one(f32x16& od, int vb, bf16x8 pa0, bf16x8 pa1, bf16x8 pa2, bf16x8 pa3) {
    const s16x4 l0 = tr_read<v_rd_off(D0, 0, 0)>(vb), h0 = tr_read<v_rd_off(D0, 0, 1)>(vb), l1 = tr_read<v_rd_off(D0, 1, 0)>(vb), h1 = tr_read<v_rd_off(D0, 1, 1)>(vb);
    const s16x4 l2 = tr_read<v_rd_off(D0, 2, 0)>(vb), h2 = tr_read<v_rd_off(D0, 2, 1)>(vb), l3 = tr_read<v_rd_off(D0, 3, 0)>(vb), h3 = tr_read<v_rd_off(D0, 3, 1)>(vb);
    asm volatile("s_waitcnt lgkmcnt(0)" ::: "memory"); SBAR();
#define PK(L, H) (bf16x8){L[0], L[1], L[2], L[3], H[0], H[1], H[2], H[3]}
    od = __builtin_amdgcn_mfma_f32_32x32x16_bf16(pa0, PK(l0, h0), od, 0, 0, 0);
    od = __builtin_amdgcn_mfma_f32_32x32x16_bf16(pa1, PK(l1, h1), od, 0, 0, 0);
    od = __builtin_amdgcn_mfma_f32_32x32x16_bf16(pa2, PK(l2, h2), od, 0, 0, 0);
    od = __builtin_amdgcn_mfma_f32_32x32x16_bf16(pa3, PK(l3, h3), od, 0, 0, 0);
}
__device__ __forceinline__ void pv_d0(f32x16* o, int vb, bf16x8 pa0, bf16x8 pa1, bf16x8 pa2, bf16x8 pa3) {
    pv_one<0>(o[0], vb, pa0, pa1, pa2, pa3); pv_one<1>(o[1], vb, pa0, pa1, pa2, pa3); pv_one<2>(o[2], vb, pa0, pa1, pa2, pa3); pv_one<3>(o[3], vb, pa0, pa1, pa2, pa3);
}
template <int D0> __device__ __forceinline__ void pv_one32(f32x16& od, int vb, bf16x8 pa0, bf16x8 pa1) {
    const s16x4 l0 = tr_read<v_rd_off(D0, 0, 0)>(vb), h0 = tr_read<v_rd_off(D0, 0, 1)>(vb), l1 = tr_read<v_rd_off(D0, 1, 0)>(vb), h1 = tr_read<v_rd_off(D0, 1, 1)>(vb);
    asm volatile("s_waitcnt lgkmcnt(0)" ::: "memory"); SBAR();
    od = __builtin_amdgcn_mfma_f32_32x32x16_bf16(pa0, PK(l0, h0), od, 0, 0, 0);
    od = __builtin_amdgcn_mfma_f32_32x32x16_bf16(pa1, PK(l1, h1), od, 0, 0, 0);
}
#undef PK
#define PK4(P, BASE, OUT) do { unsigned a0 = cvtpk(P[BASE + 0], P[BASE + 1]), a1 = cvtpk(P[BASE + 2], P[BASE + 3]);   \
    unsigned b0 = cvtpk(P[BASE + 4], P[BASE + 5]), b1 = cvtpk(P[BASE + 6], P[BASE + 7]);                              \
    auto r0 = __builtin_amdgcn_permlane32_swap(a0, b0, false, false); auto r1 = __builtin_amdgcn_permlane32_swap(a1, b1, false, false); \
    u32x4 w = {r0[0], r1[0], r0[1], r1[1]}; OUT = *reinterpret_cast<bf16x8*>(&w); } while (0)

template <int NDQ> struct Cst { static constexpr float SCALE = (NDQ == 8) ? 0.088388347648318440f : 0.072168783648703220f; static constexpr float C = SCALE * LOG2E; };

template <int NDQ>
__device__ __forceinline__ void partialSM(f32x16& p0, f32x16& p1, float& m_reg, float& mn, float& alpha) {
    constexpr float C = Cst<NDQ>::C, SCALE = Cst<NDQ>::SCALE;
    float pmax = p0[0];
#pragma unroll
    for (int r = 1; r < 16; ++r) pmax = fmaxf(pmax, p0[r]);
#pragma unroll
    for (int r = 0; r < 16; ++r) pmax = fmaxf(pmax, p1[r]);
    { auto rr = __builtin_amdgcn_permlane32_swap(__float_as_uint(pmax), __float_as_uint(pmax), false, false);
      pmax = fmaxf(__uint_as_float(rr[0]), __uint_as_float(rr[1])); }
    if (__builtin_expect(__all(pmax - m_reg <= THR / SCALE), 1)) { mn = m_reg; alpha = 1.f; }
    else { mn = fmaxf(m_reg, pmax); alpha = __builtin_amdgcn_exp2f((m_reg - mn) * C); m_reg = mn; }
    const float mnC = -mn * C;
#pragma unroll
    for (int r = 0; r < 16; ++r) p0[r] = fmaf(p0[r], C, mnC);
#pragma unroll
    for (int r = 0; r < 16; ++r) p1[r] = fmaf(p1[r], C, mnC);
#pragma unroll
    for (int r = 0; r < 16; ++r) p0[r] = __builtin_amdgcn_exp2f(p0[r]);
}
__device__ __forceinline__ void finishSM(f32x16& p0, f32x16& p1, float alpha, float& l_reg, bf16x8& pa0, bf16x8& pa1, bf16x8& pa2, bf16x8& pa3) {
#pragma unroll
    for (int r = 0; r < 16; ++r) p1[r] = __builtin_amdgcn_exp2f(p1[r]);
    float ps = 0;
#pragma unroll
    for (int r = 0; r < 16; ++r) ps += p0[r];
#pragma unroll
    for (int r = 0; r < 16; ++r) ps += p1[r];
    { auto rr = __builtin_amdgcn_permlane32_swap(__float_as_uint(ps), __float_as_uint(ps), false, false);
      ps = __uint_as_float(rr[0]) + __uint_as_float(rr[1]); }
    l_reg = l_reg * alpha + ps;
    PK4(p0, 0, pa0); PK4(p0, 8, pa1); PK4(p1, 0, pa2); PK4(p1, 8, pa3);
}
template <int NDQ>
__device__ __forceinline__ void qkt(f32x16& p0, f32x16& p1, const char* Ks, const char* Krs, const bf16x8* qr, const char* qrl, int r32, int hi) {
    p0 = f32x16{}; p1 = f32x16{};
#pragma unroll
    for (int d0 = 0; d0 < 8; ++d0) { const int cb = (d0 * 16 + hi * 8) * 2;
        bf16x8 b0 = *reinterpret_cast<const bf16x8*>(Ks + KSWZ(r32, cb));
        bf16x8 b1 = *reinterpret_cast<const bf16x8*>(Ks + KSWZ(32 + r32, cb));
        p0 = __builtin_amdgcn_mfma_f32_32x32x16_bf16(b0, qr[d0], p0, 0, 0, 0);
        p1 = __builtin_amdgcn_mfma_f32_32x32x16_bf16(b1, qr[d0], p1, 0, 0, 0); }
    if constexpr (NDQ == 12) {
#pragma unroll
        for (int d0 = 0; d0 < 4; ++d0) { const int ch = d0 * 2 + hi;
            bf16x8 b0 = *reinterpret_cast<const bf16x8*>(Krs + KRSWZ(r32, ch));
            bf16x8 b1 = *reinterpret_cast<const bf16x8*>(Krs + KRSWZ(32 + r32, ch));
            const bf16x8 qf = *reinterpret_cast<const bf16x8*>(qrl + d0 * 1024);
            p0 = __builtin_amdgcn_mfma_f32_32x32x16_bf16(b0, qf, p0, 0, 0, 0);
            p1 = __builtin_amdgcn_mfma_f32_32x32x16_bf16(b1, qf, p1, 0, 0, 0); }
    }
}

struct DArgs { const bf16_t* Q; const bf16_t* K; const bf16_t* V; const bf16_t* Kr; bf16_t* O; int ldq, ldk, ldv, ldo; int seq; int pos0; };

template <int NDQ, int SDEPTH>
__device__ __forceinline__ void attn_dense_body(int wv, const DArgs a, char* lds) {
    const int tid = fresh_tid(wv), wid = tid >> 6, lane = tid & 63, r32 = lane & 31, hi = lane >> 5;
    char* V_lds = lds + OFF_V; char* K_lds = lds + OFF_K; char* Kr_lds = lds + OFF_KR;
    float* ws = (float*)(lds + OFF_WS) + wid * 64; float* li_l = ws; float* al_l = ws + 32;
    float m_reg = -1e30f, l_reg = 0; f32x16 o[4] = {}; bf16x8 qr[8];
    char* qrl = lds + OFF_QR + wid * 4096 + lane * 16;
    const bf16_t* Qw = a.Q + (long)(wid * 32 + r32) * a.ldq + hi * 8;
#pragma unroll
    for (int d0 = 0; d0 < 8; ++d0) qr[d0] = *reinterpret_cast<const bf16x8*>(Qw + d0 * 16);
    if constexpr (NDQ == 12) {
        const float pos = (float)(a.pos0 + wid * 32 + r32);
#pragma unroll
        for (int f = 0; f < 2; ++f) {
            const bf16x8 x1v = *reinterpret_cast<const bf16x8*>(Qw + (8 + f) * 16), x2v = *reinterpret_cast<const bf16x8*>(Qw + (10 + f) * 16); bf16x8 y1v, y2v;
#pragma unroll
            for (int j = 0; j < 8; ++j) { const int i = f * 16 + hi * 8 + j; float sn, cs; sincos_rev(pos * inv_freq32(i), sn, cs);
                const float x1 = bf2f((unsigned short)x1v[j]), x2 = bf2f((unsigned short)x2v[j]);
                y1v[j] = (short)f2bf(x1 * cs - x2 * sn); y2v[j] = (short)f2bf(x2 * cs + x1 * sn); }
            *reinterpret_cast<bf16x8*>(qrl + f * 1024) = y1v; *reinterpret_cast<bf16x8*>(qrl + (2 + f) * 1024) = y2v;
        }
    }
    const int sr = tid >> 4, sc = (tid & 15) * 8, vst0 = v_st(sr, sc), vst1 = v_st(32 + sr, sc);
    const int krr = tid >> 3, krc = tid & 7;
    const int vb0 = (int)(uintptr_t)V_lds + v_rd_base(lane);
    struct { bf16x8 vs0, vs1, ks0, ks1, kr; } sr_[SDEPTH];
#define SLOAD(i, k0) do { sr_[i].vs0 = *(const bf16x8*)(a.V + (long)((k0) + sr) * a.ldv + sc); sr_[i].vs1 = *(const bf16x8*)(a.V + (long)((k0) + 32 + sr) * a.ldv + sc); \
    sr_[i].ks0 = *(const bf16x8*)(a.K + (long)((k0) + sr) * a.ldk + sc); sr_[i].ks1 = *(const bf16x8*)(a.K + (long)((k0) + 32 + sr) * a.ldk + sc); \
    if constexpr (NDQ == 12) sr_[i].kr = *(const bf16x8*)(a.Kr + (long)((k0) + krr) * 64 + krc * 8); } while (0)
#define SWRITE(b, i) do { *(bf16x8*)(V_lds + (b) * SHM_V + vst0) = sr_[i].vs0; *(bf16x8*)(V_lds + (b) * SHM_V + vst1) = sr_[i].vs1; const int kc = sc * 2; \
    *(bf16x8*)(K_lds + (b) * SHM_K + KSWZ(sr, kc)) = sr_[i].ks0; *(bf16x8*)(K_lds + (b) * SHM_K + KSWZ(32 + sr, kc)) = sr_[i].ks1; \
    if constexpr (NDQ == 12) *(bf16x8*)(Kr_lds + (b) * SHM_KR + KRSWZ(krr, krc)) = sr_[i].kr; } while (0)
#define SWAIT() do { if constexpr (SDEPTH == 2) { if constexpr (NDQ == 12) asm volatile("s_waitcnt vmcnt(5)" ::: "memory"); else asm volatile("s_waitcnt vmcnt(4)" ::: "memory"); } else asm volatile("s_waitcnt vmcnt(0)" ::: "memory"); } while (0)
#define RESC(al) do { if (__any((al) < 1.f)) { if (hi == 0) al_l[r32] = (al); asm volatile("s_waitcnt lgkmcnt(0)" ::: "memory"); \
    _Pragma("unroll") for (int d = 0; d < 4; ++d) _Pragma("unroll") for (int r = 0; r < 16; ++r) o[d][r] *= al_l[crow(r, hi)]; } } while (0)
    f32x16 pA0, pA1, pB0, pB1; float mnA, mnB, alA, alB; bf16x8 pa0, pa1, pa2, pa3; const int NT = a.seq / KVBLK;
    constexpr int SE = 0, SO = SDEPTH - 1;
    SLOAD(SE, 0); asm volatile("s_waitcnt vmcnt(0)" ::: "memory"); SWRITE(0, SE); __syncthreads();
    qkt<NDQ>(pA0, pA1, K_lds, Kr_lds, qr, qrl, r32, hi); partialSM<NDQ>(pA0, pA1, m_reg, mnA, alA);
    SLOAD(SO, KVBLK); if constexpr (SDEPTH == 2) { if (2 < NT) SLOAD(SE, 2 * KVBLK); }
    SWAIT(); SWRITE(1, SO); __syncthreads();
#pragma unroll 1
    for (int j = 1; j + 1 < NT; j += 2) {
        SBAR(); qkt<NDQ>(pB0, pB1, K_lds + SHM_K, Kr_lds + SHM_KR, qr, qrl, r32, hi);
        finishSM(pA0, pA1, alA, l_reg, pa0, pa1, pa2, pa3); SBAR();
        SLOAD(SO, (j + SDEPTH) * KVBLK); SBAR();
        pv_d0(o, vb0, pa0, pa1, pa2, pa3); partialSM<NDQ>(pB0, pB1, m_reg, mnB, alB);
        __syncthreads(); SWAIT(); SWRITE(0, SE);
        RESC(alB); __syncthreads();
        SBAR(); qkt<NDQ>(pA0, pA1, K_lds, Kr_lds, qr, qrl, r32, hi);
        finishSM(pB0, pB1, alB, l_reg, pa0, pa1, pa2, pa3); SBAR();
        if (SDEPTH == 1 || j + 3 < NT) SLOAD(SE, (j + 1 + SDEPTH) * KVBLK); SBAR();
        pv_d0(o, vb0 + (int)SHM_V, pa0, pa1, pa2, pa3); partialSM<NDQ>(pA0, pA1, m_reg, mnA, alA);
        __syncthreads(); SWAIT(); SWRITE(1, SO);
        RESC(alA); __syncthreads();
    }
    SBAR(); qkt<NDQ>(pB0, pB1, K_lds + SHM_K, Kr_lds + SHM_KR, qr, qrl, r32, hi);
    finishSM(pA0, pA1, alA, l_reg, pa0, pa1, pa2, pa3); SBAR();
    pv_d0(o, vb0, pa0, pa1, pa2, pa3); partialSM<NDQ>(pB0, pB1, m_reg, mnB, alB);
    __syncthreads(); RESC(alB);
    finishSM(pB0, pB1, alB, l_reg, pa0, pa1, pa2, pa3); SBAR();
    pv_d0(o, vb0 + (int)SHM_V, pa0, pa1, pa2, pa3);
    if (hi == 0) li_l[r32] = l_reg; asm volatile("s_waitcnt lgkmcnt(0)" ::: "memory");
    float rli[16];
#pragma unroll
    for (int r = 0; r < 16; ++r) rli[r] = __builtin_amdgcn_rcpf(li_l[crow(r, hi)]);
    bf16_t* Ow = F8_OUT ? (bf16_t*)((unsigned char*)a.O + (long)(wid * 32) * a.ldo) : a.O + (long)(wid * 32) * a.ldo;
#pragma unroll
    for (int r = 0; r < 16; ++r) { const int orow = crow(r, hi);
#pragma unroll
        for (int d0 = 0; d0 < 4; ++d0) { if constexpr (F8_OUT) ((unsigned char*)Ow)[(long)orow * a.ldo + d0 * 32 + r32] = f2fp8(o[d0][r] * rli[r] * O8_SCALE); else Ow[(long)orow * a.ldo + d0 * 32 + r32] = f2bf(o[d0][r] * rli[r]); } }
#undef SLOAD
#undef SWRITE
#undef SWAIT
#undef RESC
}

constexpr int SP_WAVE_LDS = 18688;
template <class P>
__device__ __forceinline__ void sparse_wave(P& pol, LAS unsigned char* wll, int lane) {
    const int r32 = lane & 31, hi = lane >> 5;
    char* wl = (char*)wll;
    char* Kl = wl; char* Vl = wl + 8192; float* li_l = (float*)(wl + 16384); float* al_l = li_l + 32;
    bf16x8 qr[8];
    { const bf16_t* qp = pol.qptr(r32) + hi * 8;
#pragma unroll
      for (int d0 = 0; d0 < 8; ++d0) qr[d0] = *reinterpret_cast<const bf16x8*>(qp + d0 * 16); }
    asm volatile("s_waitcnt vmcnt(0)" ::: "memory");
    f32x16 o[4] = {}; float m_reg = -1e30f, l_reg = 0.f;
    const int krow0 = lane >> 4;
    const int kce = (((lane & 15) ^ (krow0 & 7)) * 8), kco = (((lane & 15) ^ ((4 + krow0) & 7)) * 8);
    const int vk0 = 8 * ((lane >> 4) & 1) + ((lane >> 2) & 3), vc0 = 32 * (lane >> 5) + 8 * (lane & 3);
    const int vb = (int)(uintptr_t)Vl + v_rd_base(lane);
    const int nt = pol.ntiles();
    typename P::TI ti, tn;
#define SP_DMA_K(T) do { _Pragma("unroll") for (int i = 0; i < 8; ++i) { const bf16_t* src = (T).k + (long)(4 * i + krow0) * (T).rs + ((i & 1) ? kco : kce); \
        __builtin_amdgcn_global_load_lds((const unsigned*)src, (LAS unsigned*)(wll + i * 1024), 16, 0, 0); } } while (0)
#define SP_DMA_V(T) do { _Pragma("unroll") for (int i = 0; i < 8; ++i) { const bf16_t* src = (T).v + (long)(16 * (i >> 2) + 4 * ((i >> 1) & 1) + vk0) * (T).rs + 64 * (i & 1) + vc0; \
        __builtin_amdgcn_global_load_lds((const unsigned*)src, (LAS unsigned*)(wll + 8192 + i * 1024), 16, 0, 0); } } while (0)
    pol.tile(0, ti);
    SP_DMA_K(ti); SP_DMA_V(ti);
#pragma unroll 1
    for (int j = 0; j < nt; ++j) {
        const bool more = (j + 1 < nt);
        if (more) pol.tile(j + 1, tn);
        asm volatile("s_waitcnt vmcnt(8)" ::: "memory");
        f32x16 p = f32x16{};
#pragma unroll
        for (int d0 = 0; d0 < 8; ++d0) { const int cb = (d0 * 16 + hi * 8) * 2;
            bf16x8 b0 = *reinterpret_cast<const bf16x8*>(Kl + KSWZ(r32, cb));
            p = __builtin_amdgcn_mfma_f32_32x32x16_bf16(b0, qr[d0], p, 0, 0, 0); }
        asm volatile("s_waitcnt lgkmcnt(0)" ::: "memory"); SBAR();
        if (more) SP_DMA_K(tn);
        SBAR();
        float pmax = -INFINITY;
#pragma unroll
        for (int r = 0; r < 16; ++r) { p[r] = pol.adj(ti, crow(r, hi), p[r]); pmax = fmaxf(pmax, p[r]); }
        { auto rr = __builtin_amdgcn_permlane32_swap(__float_as_uint(pmax), __float_as_uint(pmax), false, false);
          pmax = fmaxf(__uint_as_float(rr[0]), __uint_as_float(rr[1])); }
        const float mn = fmaxf(m_reg, pmax); const float alpha = __builtin_amdgcn_exp2f(m_reg - mn); m_reg = mn;
        float ps = 0.f;
#pragma unroll
        for (int r = 0; r < 16; ++r) { p[r] = __builtin_amdgcn_exp2f(p[r] - mn); ps += p[r]; }
        { auto rr = __builtin_amdgcn_permlane32_swap(__float_as_uint(ps), __float_as_uint(ps), false, false);
          ps = __uint_as_float(rr[0]) + __uint_as_float(rr[1]); }
        l_reg = l_reg * alpha + ps;
        if (__any(alpha < 1.f)) { if (hi == 0) al_l[r32] = alpha; asm volatile("s_waitcnt lgkmcnt(0)" ::: "memory");
#pragma unroll
            for (int d = 0; d < 4; ++d)
#pragma unroll
                for (int r = 0; r < 16; ++r) o[d][r] *= al_l[crow(r, hi)]; }
        bf16x8 pa0, pa1; PK4(p, 0, pa0); PK4(p, 8, pa1);
        SBAR();
        if (more) asm volatile("s_waitcnt vmcnt(8)" ::: "memory"); else asm volatile("s_waitcnt vmcnt(0)" ::: "memory");
        SBAR();
        pv_one32<0>(o[0], vb, pa0, pa1); pv_one32<1>(o[1], vb, pa0, pa1); pv_one32<2>(o[2], vb, pa0, pa1); pv_one32<3>(o[3], vb, pa0, pa1);
        SBAR();
        if (more) SP_DMA_V(tn);
        SBAR();
        ti = tn;
    }
#undef SP_DMA_K
#undef SP_DMA_V
    if (hi == 0) li_l[r32] = l_reg; asm volatile("s_waitcnt lgkmcnt(0)" ::: "memory");
#pragma unroll
    for (int r = 0; r < 16; ++r) { const int qn = crow(r, hi); const float rl = __builtin_amdgcn_rcpf(li_l[qn]); bf16_t* op = pol.optr(qn);
#pragma unroll
        for (int d0 = 0; d0 < 4; ++d0) { if constexpr (F8_OUT) ((unsigned char*)op)[d0 * 32 + r32] = f2fp8(o[d0][r] * rl * O8_SCALE); else op[d0 * 32 + r32] = f2bf(o[d0][r] * rl); } }
}
#undef PK4
}

#define SBAR() __builtin_amdgcn_sched_barrier(0)
namespace d8 {
constexpr int K8_BYTES = 64 * 128, KR8_BYTES = 64 * 64, VT_PITCH = 80, VT_BYTES = 128 * VT_PITCH;
constexpr int OFF_K8 = 0, OFF_KR8 = 2 * K8_BYTES, OFF_VT = OFF_KR8 + 2 * KR8_BYTES, OFF_WS8 = OFF_VT + 2 * VT_BYTES, LDS_D8 = OFF_WS8 + 8 * 64 * 4;
constexpr float THR8 = 4.f;
#define K8SWZ(row, ch) ((row) * 128 + ((((ch) ^ ((row) >> 1)) & 7) << 4))
#define KR8SWZ(row, ch) ((row) * 64 + ((((ch) ^ ((row) >> 2)) & 3) << 4))
__device__ __forceinline__ int krow_of(int a) { const int hi = a >> 5, j = a & 31; return da::crow(j & 15, hi) + 32 * (j >> 4); }
struct D8Args { const bf16_t* Q; const unsigned char* K8; const unsigned char* Kr8; const unsigned char* Vt8; bf16_t* O; int ldq, ldk, ldvt, ldo; int seq; int pos0; };
template <int NKS> struct Cst8 { static constexpr float SCALE = (NKS == 2) ? 0.088388347648318440f : 0.072168783648703220f; static constexpr float C = SCALE * LOG2E; };
#define D8_LD32(dst, p) do { const i32x4 _lo = *(const i32x4*)(p), _hi = *(const i32x4*)((p) + 16); dst = __builtin_shufflevector(_lo, _hi, 0, 1, 2, 3, 4, 5, 6, 7); } while (0)
#define D8_MX(a, b, c) __builtin_amdgcn_mfma_scale_f32_32x32x64_f8f6f4(a, b, c, 0, 0, 0, 0, 0, 0)
template <int NKS, bool MACC = (NKS == 2)>
__device__ __forceinline__ void qkt8(f32x16& p0, f32x16& p1, const f32x16& mneg, const char* Ks, const char* Krs, const i32x8* qf, int r32, int hi) {
    i32x8 a0[2], a1[2];
#pragma unroll
    for (int sK = 0; sK < 2; ++sK) { const int ch = 4 * sK + 2 * hi;
        { const i32x4 lo = *(const i32x4*)(Ks + K8SWZ(r32, ch)), hh = *(const i32x4*)(Ks + K8SWZ(r32, ch + 1)); a0[sK] = __builtin_shufflevector(lo, hh, 0, 1, 2, 3, 4, 5, 6, 7); }
        { const i32x4 lo = *(const i32x4*)(Ks + K8SWZ(32 + r32, ch)), hh = *(const i32x4*)(Ks + K8SWZ(32 + r32, ch + 1)); a1[sK] = __builtin_shufflevector(lo, hh, 0, 1, 2, 3, 4, 5, 6, 7); } }
    asm volatile("s_waitcnt lgkmcnt(0)" ::: "memory"); SBAR();
    if constexpr (MACC) {
        asm volatile("v_mfma_f32_32x32x64_f8f6f4 %0, %1, %2, %3" : "=&v"(p0) : "v"(a0[0]), "v"(qf[0]), "v"(mneg));
        asm volatile("v_mfma_f32_32x32x64_f8f6f4 %0, %1, %2, %3" : "=&v"(p1) : "v"(a1[0]), "v"(qf[0]), "v"(mneg)); }
    else { p0 = f32x16{}; p1 = f32x16{}; p0 = D8_MX(a0[0], qf[0], p0); p1 = D8_MX(a1[0], qf[0], p1); }
    if constexpr (NKS == 3) { i32x8 r0, r1; const int ch = 2 * hi;
        { const i32x4 lo = *(const i32x4*)(Krs + KR8SWZ(r32, ch)), hh = *(const i32x4*)(Krs + KR8SWZ(r32, ch + 1)); r0 = __builtin_shufflevector(lo, hh, 0, 1, 2, 3, 4, 5, 6, 7); }
        { const i32x4 lo = *(const i32x4*)(Krs + KR8SWZ(32 + r32, ch)), hh = *(const i32x4*)(Krs + KR8SWZ(32 + r32, ch + 1)); r1 = __builtin_shufflevector(lo, hh, 0, 1, 2, 3, 4, 5, 6, 7); }
        p0 = D8_MX(a0[1], qf[1], p0); p1 = D8_MX(a1[1], qf[1], p1);
        p0 = D8_MX(r0, qf[2], p0); p1 = D8_MX(r1, qf[2], p1); }
    else { p0 = D8_MX(a0[1], qf[1], p0); p1 = D8_MX(a1[1], qf[1], p1); }
}
template <bool FIRST, bool SPLAT = false>
__device__ __forceinline__ void partialSM8(f32x16& p0, f32x16& p1, float& m_reg, f32x16& mneg, float& alpha) {
    float pmax = p0[0];
#pragma unroll
    for (int r = 1; r < 16; ++r) pmax = fmaxf(pmax, p0[r]);
#pragma unroll
    for (int r = 0; r < 16; ++r) pmax = fmaxf(pmax, p1[r]);
    { auto rr = __builtin_amdgcn_permlane32_swap(__float_as_uint(pmax), __float_as_uint(pmax), false, false);
      pmax = fmaxf(__uint_as_float(rr[0]), __uint_as_float(rr[1])); }
    if (!FIRST && __builtin_expect(__all(pmax <= THR8 * LOG2E), 1)) { alpha = 1.f; }
    else { const float delta = FIRST ? pmax : fmaxf(pmax, 0.f); alpha = FIRST ? 1.f : __builtin_amdgcn_exp2f(-delta); m_reg += delta;
#pragma unroll
        for (int r = 0; r < 16; ++r) { p0[r] -= delta; p1[r] -= delta; }
        if constexpr (!SPLAT) { const float nm = -m_reg;
#pragma unroll
            for (int r = 0; r < 16; ++r) mneg[r] = nm; } }
    if constexpr (SPLAT) { float nm = -m_reg; asm volatile("" : "+v"(nm));
#pragma unroll
        for (int r = 0; r < 16; ++r) mneg[r] = nm; }
#pragma unroll
    for (int r = 0; r < 16; ++r) p0[r] = __builtin_amdgcn_exp2f(p0[r]);
}
template <int NKS>
__device__ __forceinline__ void partialSM8z(f32x16& p0, f32x16& p1, float& m_reg, float& alpha) {
    constexpr float C = Cst8<NKS>::C, SCALE = Cst8<NKS>::SCALE; float mn;
    float pmax = p0[0];
#pragma unroll
    for (int r = 1; r < 16; ++r) pmax = fmaxf(pmax, p0[r]);
#pragma unroll
    for (int r = 0; r < 16; ++r) pmax = fmaxf(pmax, p1[r]);
    { auto rr = __builtin_amdgcn_permlane32_swap(__float_as_uint(pmax), __float_as_uint(pmax), false, false);
      pmax = fmaxf(__uint_as_float(rr[0]), __uint_as_float(rr[1])); }
    if (__builtin_expect(__all(pmax - m_reg <= THR8 / SCALE), 1)) { mn = m_reg; alpha = 1.f; }
    else { mn = fmaxf(m_reg, pmax); alpha = __builtin_amdgcn_exp2f((m_reg - mn) * C); m_reg = mn; }
    const float mnC = -mn * C;
#pragma unroll
    for (int r = 0; r < 16; ++r) p0[r] = fmaf(p0[r], C, mnC);
#pragma unroll
    for (int r = 0; r < 16; ++r) p1[r] = fmaf(p1[r], C, mnC);
#pragma unroll
    for (int r = 0; r < 16; ++r) p0[r] = __builtin_amdgcn_exp2f(p0[r]);
}
__device__ __forceinline__ void finishSM8n(f32x16& p0, f32x16& p1, i32x8& pa) {
#pragma unroll
    for (int r = 0; r < 16; ++r) p1[r] = __builtin_amdgcn_exp2f(p1[r]);
    pa = (i32x8){(int)pk4_fp8(p0[0], p0[1], p0[2], p0[3]), (int)pk4_fp8(p0[4], p0[5], p0[6], p0[7]), (int)pk4_fp8(p0[8], p0[9], p0[10], p0[11]), (int)pk4_fp8(p0[12], p0[13], p0[14], p0[15]),
                 (int)pk4_fp8(p1[0], p1[1], p1[2], p1[3]), (int)pk4_fp8(p1[4], p1[5], p1[6], p1[7]), (int)pk4_fp8(p1[8], p1[9], p1[10], p1[11]), (int)pk4_fp8(p1[12], p1[13], p1[14], p1[15])};
}
__device__ __forceinline__ void finishSM8(f32x16& p0, f32x16& p1, float alpha, float& l_reg, i32x8& pa) {
#pragma unroll
    for (int r = 0; r < 16; ++r) p1[r] = __builtin_amdgcn_exp2f(p1[r]);
    float ps = 0;
#pragma unroll
    for (int r = 0; r < 16; ++r) ps += p0[r];
#pragma unroll
    for (int r = 0; r < 16; ++r) ps += p1[r];
    { auto rr = __builtin_amdgcn_permlane32_swap(__float_as_uint(ps), __float_as_uint(ps), false, false);
      ps = __uint_as_float(rr[0]) + __uint_as_float(rr[1]); }
    l_reg = l_reg * alpha + ps;
    pa = (i32x8){(int)pk4_fp8(p0[0], p0[1], p0[2], p0[3]), (int)pk4_fp8(p0[4], p0[5], p0[6], p0[7]), (int)pk4_fp8(p0[8], p0[9], p0[10], p0[11]), (int)pk4_fp8(p0[12], p0[13], p0[14], p0[15]),
                 (int)pk4_fp8(p1[0], p1[1], p1[2], p1[3]), (int)pk4_fp8(p1[4], p1[5], p1[6], p1[7]), (int)pk4_fp8(p1[8], p1[9], p1[10], p1[11]), (int)pk4_fp8(p1[12], p1[13], p1[14], p1[15])};
}
__device__ __forceinline__ void pv8(f32x16* o, const char* Vt, const i32x8 pa, int r32, int hi) {
    i32x8 bfr[4];
#pragma unroll
    for (int d0 = 0; d0 < 4; ++d0) { const char* vp = Vt + (32 * d0 + r32) * VT_PITCH + 32 * hi;
        const i32x4 lo = *(const i32x4*)vp, hh = *(const i32x4*)(vp + 16); bfr[d0] = __builtin_shufflevector(lo, hh, 0, 1, 2, 3, 4, 5, 6, 7); }
    asm volatile("s_waitcnt lgkmcnt(0)" ::: "memory"); SBAR();
#pragma unroll
    for (int d0 = 0; d0 < 4; ++d0) o[d0] = D8_MX(pa, bfr[d0], o[d0]);
}
#define D8Q(P0, P1, KS, KRS, QF, R32, HI) do { if constexpr (VAR == 3) { P0 = f32x16{}; P1 = f32x16{}; } else qkt8<NKS>(P0, P1, mneg, KS, KRS, QF, R32, HI); } while (0)
#define D8P(FIRST, P0, P1, MR, AL) do { if constexpr (VAR == 1) { AL = 1.f; } else if constexpr (NKS == 2) partialSM8<FIRST>(P0, P1, MR, mneg, AL); else partialSM8z<NKS>(P0, P1, MR, AL); } while (0)
#define D8F(P0, P1, AL, LR, PA) do { if constexpr (VAR == 1) { PA = (i32x8){(int)pk4_fp8(P0[0], P0[1], P0[2], P0[3]), (int)pk4_fp8(P0[4], P0[5], P0[6], P0[7]), (int)pk4_fp8(P0[8], P0[9], P0[10], P0[11]), (int)pk4_fp8(P0[12], P0[13], P0[14], P0[15]), \
        (int)pk4_fp8(P1[0], P1[1], P1[2], P1[3]), (int)pk4_fp8(P1[4], P1[5], P1[6], P1[7]), (int)pk4_fp8(P1[8], P1[9], P1[10], P1[11]), (int)pk4_fp8(P1[12], P1[13], P1[14], P1[15])}; LR += 1.f; } else finishSM8(P0, P1, AL, LR, PA); } while (0)
#define D8V(O, VT, PA, R32, HI) do { if constexpr (VAR != 3) pv8(O, VT, PA, R32, HI); } while (0)
template <int NKS, int VAR = 0>
__device__ __forceinline__ void attn_dense8_body(int wv, const D8Args a, char* lds) {
    const int tid = fresh_tid(wv), wid = tid >> 6, lane = tid & 63, r32 = lane & 31, hi = lane >> 5;
    char* K_lds = lds + OFF_K8; char* Kr_lds = lds + OFF_KR8; char* Vt_lds = lds + OFF_VT;
    float* ws = (float*)(lds + OFF_WS8) + wid * 64; float* li_l = ws; float* al_l = ws + 32;
    float m_reg = (NKS == 2) ? 0.f : -1e30f, l_reg = 0; f32x16 o[4] = {}; i32x8 qf[NKS]; f32x16 mneg = {};
    constexpr float QC = (NKS == 2) ? Cst8<NKS>::C : 1.0f;
    { const bf16_t* Qw = a.Q + (long)(wid * 32 + r32) * a.ldq;
#pragma unroll
      for (int sK = 0; sK < 2; ++sK) { const bf16_t* qp = Qw + 64 * sK + 32 * hi; unsigned w[8];
#pragma unroll
          for (int c = 0; c < 4; ++c) { const u32x4 v = *(const u32x4*)(qp + 8 * c);
              w[2 * c] = pk4_fp8(bflo(v.x) * QC, bfhi(v.x) * QC, bflo(v.y) * QC, bfhi(v.y) * QC); w[2 * c + 1] = pk4_fp8(bflo(v.z) * QC, bfhi(v.z) * QC, bflo(v.w) * QC, bfhi(v.w) * QC); }
          qf[sK] = (i32x8){(int)w[0], (int)w[1], (int)w[2], (int)w[3], (int)w[4], (int)w[5], (int)w[6], (int)w[7]}; }
      if constexpr (NKS == 3) {
          const float pos = (float)(a.pos0 + wid * 32 + r32); const bf16_t* qp = Qw + 128; unsigned w[8];
#pragma unroll
          for (int c = 0; c < 4; ++c) { const u32x4 v1 = *(const u32x4*)(qp + 8 * c), v2 = *(const u32x4*)(qp + 32 + 8 * c);
              const unsigned a1[4] = {v1.x, v1.y, v1.z, v1.w}, a2[4] = {v2.x, v2.y, v2.z, v2.w}; float y[8];
#pragma unroll
              for (int e = 0; e < 8; ++e) { const int i = 8 * c + e; float sn, cs; sincos_rev(pos * inv_freq32(i), sn, cs);
                  const float x1 = (e & 1) ? bfhi(a1[e >> 1]) : bflo(a1[e >> 1]), x2 = (e & 1) ? bfhi(a2[e >> 1]) : bflo(a2[e >> 1]);
                  y[e] = (hi ? (x2 * cs + x1 * sn) : (x1 * cs - x2 * sn)) * QC; }
              w[2 * c] = pk4_fp8(y[0], y[1], y[2], y[3]); w[2 * c + 1] = pk4_fp8(y[4], y[5], y[6], y[7]); }
          qf[2] = (i32x8){(int)w[0], (int)w[1], (int)w[2], (int)w[3], (int)w[4], (int)w[5], (int)w[6], (int)w[7]}; } }
    const int ka = tid >> 3, kch = tid & 7, kdst = K8SWZ(krow_of(ka), kch);
    const int vc = tid >> 2, vq = tid & 3, vdst = vc * VT_PITCH + vq * 16;
    const int ra = (tid >> 2) & 63, rch = tid & 3, rdst = KR8SWZ(krow_of(ra), rch);
    struct { u32x4 k, v, r; } sr_[2];
    if constexpr (VAR == 2) { sr_[0].k = sr_[0].v = sr_[0].r = sr_[1].k = sr_[1].v = sr_[1].r = (u32x4){0x38383838u, 0x38383838u, 0x38383838u, 0x38383838u}; }
#define SLOAD8(i, k0) do { if constexpr (VAR == 2) break; sr_[i].k = *(const u32x4*)(a.K8 + (long)((k0) + ka) * a.ldk + kch * 16); sr_[i].v = *(const u32x4*)(a.Vt8 + (long)vc * a.ldvt + (k0) + vq * 16); \
    if constexpr (NKS == 3) sr_[i].r = *(const u32x4*)(a.Kr8 + (long)((k0) + ra) * 64 + rch * 16); } while (0)
#define SWRITE8(b, i) do { if constexpr (VAR == 4) break; *(u32x4*)(K_lds + (b) * K8_BYTES + kdst) = sr_[i].k; *(u32x4*)(Vt_lds + (b) * VT_BYTES + vdst) = sr_[i].v; \
    if constexpr (NKS == 3) *(u32x4*)(Kr_lds + (b) * KR8_BYTES + rdst) = sr_[i].r; } while (0)
#define RESC8(al) do { if (__any((al) < 1.f)) { if (hi == 0) al_l[r32] = (al); asm volatile("s_waitcnt lgkmcnt(0)" ::: "memory"); \
    _Pragma("unroll") for (int d = 0; d < 4; ++d) _Pragma("unroll") for (int r = 0; r < 16; ++r) o[d][r] *= al_l[da::crow(r, hi)]; } } while (0)
    f32x16 pA0, pA1, pB0, pB1; float alA, alB; i32x8 pa; const int NT = a.seq / 64;
    SLOAD8(0, 0); asm volatile("s_waitcnt vmcnt(0)" ::: "memory"); SWRITE8(0, 0); __syncthreads();
    D8Q(pA0, pA1, K_lds, Kr_lds, qf, r32, hi); D8P(true, pA0, pA1, m_reg, alA);
    SLOAD8(1, 64); if (2 < NT) SLOAD8(0, 128);
    if constexpr (NKS == 3) asm volatile("s_waitcnt vmcnt(3)" ::: "memory"); else asm volatile("s_waitcnt vmcnt(2)" ::: "memory");
    SWRITE8(1, 1); __syncthreads();
#pragma unroll 1
    for (int j = 1; j + 1 < NT; j += 2) {
        SBAR(); D8Q(pB0, pB1, K_lds + K8_BYTES, Kr_lds + KR8_BYTES, qf, r32, hi);
        D8F(pA0, pA1, alA, l_reg, pa); SBAR();
        SLOAD8(1, (j + 2) * 64); SBAR();
        D8V(o, Vt_lds, pa, r32, hi); D8P(false, pB0, pB1, m_reg, alB);
        __syncthreads(); if constexpr (NKS == 3) asm volatile("s_waitcnt vmcnt(3)" ::: "memory"); else asm volatile("s_waitcnt vmcnt(2)" ::: "memory");
        SWRITE8(0, 0);
        RESC8(alB); __syncthreads();
        SBAR(); D8Q(pA0, pA1, K_lds, Kr_lds, qf, r32, hi);
        D8F(pB0, pB1, alB, l_reg, pa); SBAR();
        if (j + 3 < NT) SLOAD8(0, (j + 3) * 64); SBAR();
        D8V(o, Vt_lds + VT_BYTES, pa, r32, hi); D8P(false, pA0, pA1, m_reg, alA);
        __syncthreads(); if constexpr (NKS == 3) asm volatile("s_waitcnt vmcnt(3)" ::: "memory"); else asm volatile("s_waitcnt vmcnt(2)" ::: "memory");
        SWRITE8(1, 1);
        RESC8(alA); __syncthreads();
    }
    SBAR(); D8Q(pB0, pB1, K_lds + K8_BYTES, Kr_lds + KR8_BYTES, qf, r32, hi);
    D8F(pA0, pA1, alA, l_reg, pa); SBAR();
    D8V(o, Vt_lds, pa, r32, hi); D8P(false, pB0, pB1, m_reg, alB);
    __syncthreads(); RESC8(alB);
    D8F(pB0, pB1, alB, l_reg, pa); SBAR();
    D8V(o, Vt_lds + VT_BYTES, pa, r32, hi);
    const int tid_e = fresh_tid(wv), wid_e = tid_e >> 6, r32e = tid_e & 31, hie = (tid_e >> 5) & 1;
    float* li_e = (float*)(lds + OFF_WS8) + wid_e * 64;
    if (hie == 0) li_e[r32e] = l_reg; asm volatile("s_waitcnt lgkmcnt(0)" ::: "memory");
    float rli[16];
#pragma unroll
    for (int r = 0; r < 16; ++r) rli[r] = __builtin_amdgcn_rcpf(li_e[da::crow(r, hie)]);
    bf16_t* Ow = F8_OUT ? (bf16_t*)((unsigned char*)a.O + (long)(wid_e * 32) * a.ldo) : a.O + (long)(wid_e * 32) * a.ldo;
#pragma unroll
    for (int r = 0; r < 16; ++r) { const int orow = da::crow(r, hie); const int r32 = r32e;
#pragma unroll
        for (int d0 = 0; d0 < 4; ++d0) { if constexpr (F8_OUT) ((unsigned char*)Ow)[(long)orow * a.ldo + d0 * 32 + r32] = f2fp8(o[d0][r] * rli[r] * O8_SCALE); else Ow[(long)orow * a.ldo + d0 * 32 + r32] = f2bf(o[d0][r] * rli[r]); } }
#undef SLOAD8
#undef SWRITE8
#undef RESC8
}
constexpr int DM_K = 0, DM_KR = 6 * K8_BYTES, DM_VT = DM_KR + 6 * KR8_BYTES, DM_WS = DM_VT + 6 * K8_BYTES, LDS_D8DMA = DM_WS + 8 * 64 * 4;
__device__ __forceinline__ void pv8s(f32x16* o, const char* Vl, const i32x8 pa, int r32, int hi) {
    i32x8 bfr[4];
#pragma unroll
    for (int d0 = 0; d0 < 4; ++d0) { const int c = 32 * d0 + r32; const char* vp = Vl + c * 64; const int sw = (c >> 2) & 3;
        const i32x4 lo = *(const i32x4*)(vp + (((2 * hi) ^ sw) << 4)), hh = *(const i32x4*)(vp + (((2 * hi + 1) ^ sw) << 4)); bfr[d0] = __builtin_shufflevector(lo, hh, 0, 1, 2, 3, 4, 5, 6, 7); }
    asm volatile("s_waitcnt lgkmcnt(0)" ::: "memory"); SBAR();
#pragma unroll
    for (int d0 = 0; d0 < 4; ++d0) o[d0] = D8_MX(pa, bfr[d0], o[d0]);
}
#define LDS16(off) (*(const LAS i32x4*)(ldsl + (off)))
template <int NKS, bool MACC>
__device__ __forceinline__ void qkt8d(f32x16& p0, f32x16& p1, const f32x16& mneg, LAS unsigned char* ldsl, int kb, int rb, const i32x8* qf) {
    i32x8 a0[2], a1[2];
#pragma unroll
    for (int sK = 0; sK < 2; ++sK) {
        { const i32x4 lo = LDS16(kb ^ (64 * sK)), hh = LDS16(kb ^ (64 * sK + 16)); a0[sK] = __builtin_shufflevector(lo, hh, 0, 1, 2, 3, 4, 5, 6, 7); }
        { const i32x4 lo = LDS16((kb ^ (64 * sK)) + 4096), hh = LDS16((kb ^ (64 * sK + 16)) + 4096); a1[sK] = __builtin_shufflevector(lo, hh, 0, 1, 2, 3, 4, 5, 6, 7); } }
    asm volatile("s_waitcnt lgkmcnt(0)" ::: "memory"); SBAR();
    if constexpr (MACC) {
        asm volatile("v_mfma_f32_32x32x64_f8f6f4 %0, %1, %2, %3" : "=&v"(p0) : "v"(a0[0]), "v"(qf[0]), "v"(mneg));
        asm volatile("v_mfma_f32_32x32x64_f8f6f4 %0, %1, %2, %3" : "=&v"(p1) : "v"(a1[0]), "v"(qf[0]), "v"(mneg)); }
    else { p0 = f32x16{}; p1 = f32x16{}; p0 = D8_MX(a0[0], qf[0], p0); p1 = D8_MX(a1[0], qf[0], p1); }
    if constexpr (NKS == 3) { i32x8 r0, r1;
        { const i32x4 lo = LDS16(rb), hh = LDS16(rb ^ 16); r0 = __builtin_shufflevector(lo, hh, 0, 1, 2, 3, 4, 5, 6, 7); }
        { const i32x4 lo = LDS16(rb + 2048), hh = LDS16((rb ^ 16) + 2048); r1 = __builtin_shufflevector(lo, hh, 0, 1, 2, 3, 4, 5, 6, 7); }
        p0 = D8_MX(a0[1], qf[1], p0); p1 = D8_MX(a1[1], qf[1], p1);
        p0 = D8_MX(r0, qf[2], p0); p1 = D8_MX(r1, qf[2], p1); }
    else { p0 = D8_MX(a0[1], qf[1], p0); p1 = D8_MX(a1[1], qf[1], p1); }
    if constexpr (MACC) asm volatile("" : "+v"(p1), "+v"(p0) : "v"(mneg));
}
__device__ __forceinline__ void pv8d(f32x16* o, LAS unsigned char* ldsl, int vb, const i32x8 pa) {
    i32x8 bfr[4];
#pragma unroll
    for (int d0 = 0; d0 < 4; ++d0) { const i32x4 lo = LDS16(vb + d0 * 2048), hh = LDS16((vb ^ 16) + d0 * 2048); bfr[d0] = __builtin_shufflevector(lo, hh, 0, 1, 2, 3, 4, 5, 6, 7); }
    asm volatile("s_waitcnt lgkmcnt(0)" ::: "memory"); SBAR();
#pragma unroll
    for (int d0 = 0; d0 < 4; ++d0) o[d0] = D8_MX(pa, bfr[d0], o[d0]);
}
template <int NKS, bool MACC>
__device__ __forceinline__ void attn_dense8_dma(int wv, const D8Args a, LAS unsigned char* ldsl) {
    constexpr int VAR = 0;
    constexpr bool LSUM = (NKS == 2);
    const int tid = fresh_tid(wv), wid = __builtin_amdgcn_readfirstlane(tid >> 6), lane = tid & 63, r32 = lane & 31, hi = lane >> 5;
    char* lds = (char*)ldsl;
    float m_reg = MACC ? 0.f : -1e30f, l_reg = 0; f32x16 o[4] = {}; i32x8 qf[NKS]; f32x16 mneg = {}; f32x16 lacc = {};
    const i32x8 ones8 = (i32x8){0x38383838, 0x38383838, 0x38383838, 0x38383838, 0x38383838, 0x38383838, 0x38383838, 0x38383838};
    constexpr float QC = MACC ? Cst8<NKS>::C : 1.0f;
    { const bf16_t* Qw = a.Q + (long)(wid * 32 + r32) * a.ldq;
#pragma unroll
      for (int sK = 0; sK < 2; ++sK) { const bf16_t* qp = Qw + 64 * sK + 32 * hi; unsigned w[8];
#pragma unroll
          for (int c = 0; c < 4; ++c) { const u32x4 v = *(const u32x4*)(qp + 8 * c);
              w[2 * c] = pk4_fp8(bflo(v.x) * QC, bfhi(v.x) * QC, bflo(v.y) * QC, bfhi(v.y) * QC); w[2 * c + 1] = pk4_fp8(bflo(v.z) * QC, bfhi(v.z) * QC, bflo(v.w) * QC, bfhi(v.w) * QC); }
          qf[sK] = (i32x8){(int)w[0], (int)w[1], (int)w[2], (int)w[3], (int)w[4], (int)w[5], (int)w[6], (int)w[7]}; }
      if constexpr (NKS == 3) {
          const float pos = (float)(a.pos0 + wid * 32 + r32); const bf16_t* qp = Qw + 128; unsigned w[8];
#pragma unroll
          for (int c = 0; c < 4; ++c) { const u32x4 v1 = *(const u32x4*)(qp + 8 * c), v2 = *(const u32x4*)(qp + 32 + 8 * c);
              const unsigned a1[4] = {v1.x, v1.y, v1.z, v1.w}, a2[4] = {v2.x, v2.y, v2.z, v2.w}; float y[8];
#pragma unroll
              for (int e = 0; e < 8; ++e) { const int i = 8 * c + e; float sn, cs; sincos_rev(pos * inv_freq32(i), sn, cs);
                  const float x1 = (e & 1) ? bfhi(a1[e >> 1]) : bflo(a1[e >> 1]), x2 = (e & 1) ? bfhi(a2[e >> 1]) : bflo(a2[e >> 1]);
                  y[e] = (hi ? (x2 * cs + x1 * sn) : (x1 * cs - x2 * sn)) * QC; }
              w[2 * c] = pk4_fp8(y[0], y[1], y[2], y[3]); w[2 * c + 1] = pk4_fp8(y[4], y[5], y[6], y[7]); }
          qf[2] = (i32x8){(int)w[0], (int)w[1], (int)w[2], (int)w[3], (int)w[4], (int)w[5], (int)w[6], (int)w[7]}; } }
    const unsigned char* ksrc; const unsigned char* vsrc; const unsigned char* rsrc = nullptr;
    { const int ri = 8 * wid + (lane >> 3), hk = (ri >> 2) & 1, ka = 32 * hk + (ri & 3) + 4 * ((ri >> 3) & 3) + 16 * (ri >> 5), kch = ((lane & 7) ^ (ri >> 1)) & 7;
      ksrc = a.K8 + (long)ka * a.ldk + kch * 16;
      const int vc = 16 * wid + (lane >> 2), vp = ((lane & 3) ^ (vc >> 2)) & 3; vsrc = a.Vt8 + (long)vc * a.ldvt + vp * 16;
      if constexpr (NKS == 3) { const int rr = 16 * (wid & 3) + (lane >> 2), rh = (rr >> 2) & 1, ra = 32 * rh + (rr & 3) + 4 * ((rr >> 3) & 3) + 16 * (rr >> 5), rch = ((lane & 3) ^ (rr >> 2)) & 3;
          rsrc = a.Kr8 + (long)ra * 64 + rch * 16; } }
#define D8_DMA2(k0, sb) do { _Pragma("unroll") for (int t_ = 0; t_ < 2; ++t_) { \
      __builtin_amdgcn_global_load_lds((const unsigned*)(ksrc + (long)((k0) + 64 * t_) * a.ldk), (LAS unsigned*)(ldsl + DM_K + (2 * (sb) + t_) * K8_BYTES + wid * 1024), 16, 0, 0); \
      __builtin_amdgcn_global_load_lds((const unsigned*)(vsrc + ((k0) + 64 * t_)), (LAS unsigned*)(ldsl + DM_VT + (2 * (sb) + t_) * K8_BYTES + wid * 1024), 16, 0, 0); } \
      if constexpr (NKS == 3) __builtin_amdgcn_global_load_lds((const unsigned*)(rsrc + (long)((k0) + 64 * (wid >> 2)) * 64), (LAS unsigned*)(ldsl + DM_KR + (2 * (sb) + (wid >> 2)) * KR8_BYTES + (wid & 3) * 1024), 16, 0, 0); } while (0)
#define RESC8(al) do { if (__any((al) < 1.f)) { if (hi == 0) al_l[r32] = (al); asm volatile("s_waitcnt lgkmcnt(0)" ::: "memory"); \
    _Pragma("unroll") for (int d = 0; d < 4; ++d) _Pragma("unroll") for (int r = 0; r < 16; ++r) o[d][r] *= al_l[da::crow(r, hi)]; \
    if constexpr (LSUM) { _Pragma("unroll") for (int r = 0; r < 16; ++r) lacc[r] *= al_l[da::crow(r, hi)]; } } } while (0)
#define D8Qm(P0, P1, b) qkt8d<NKS, MACC>(P0, P1, mneg, ldsl, kb0 + (b) * K8_BYTES, rb0 + (b) * KR8_BYTES, qf)
#define D8Vm(b) do { pv8d(o, ldsl, vb0 + (b) * K8_BYTES, pa); if constexpr (LSUM) lacc = D8_MX(pa, ones8, lacc); } while (0)
#define D8Fm(P0, P1, AL) do { if constexpr (LSUM) finishSM8n(P0, P1, pa); else finishSM8(P0, P1, AL, l_reg, pa); } while (0)
#define D8Pm(FIRST, P0, P1, AL) do { if constexpr (MACC) partialSM8<FIRST, (NKS == 3)>(P0, P1, m_reg, mneg, AL); else partialSM8z<NKS>(P0, P1, m_reg, AL); } while (0)
#define D8_TOP() do { asm volatile("s_waitcnt vmcnt(0)" ::: "memory"); __syncthreads(); } while (0)
    float* al_l = (float*)(lds + DM_WS) + wid * 64 + 32;
    const int kb0 = DM_K + r32 * 128 + ((((r32 >> 1) & 7) << 4) ^ (32 * hi)), rb0 = DM_KR + r32 * 64 + ((((r32 >> 2) & 3) << 4) ^ (32 * hi)), vb0 = DM_VT + r32 * 64 + ((((r32 >> 2) & 3) << 4) ^ (32 * hi));
    f32x16 pA0, pA1, pB0, pB1; float alA, alB; i32x8 pa;
    const int NS = a.seq / 128;
    D8_DMA2(0, 0);
    D8_TOP(); D8_DMA2(128, 1);
    D8Qm(pA0, pA1, 0); D8Pm(true, pA0, pA1, alA); RESC8(alA);
    SBAR(); D8Qm(pB0, pB1, 1);
    D8Fm(pA0, pA1, alA); SBAR();
    D8Vm(0); D8Pm(false, pB0, pB1, alB);
    RESC8(alB);
    int sb = 1, sbp = 0, sbn = 2;
#pragma unroll 1
    for (int J = 1; J < NS; ++J) {
        D8_TOP(); if (J + 1 < NS) D8_DMA2((J + 1) * 128, sbn);
        SBAR(); D8Qm(pA0, pA1, 2 * sb);
        D8Fm(pB0, pB1, alB); SBAR();
        D8Vm(2 * sbp + 1); D8Pm(false, pA0, pA1, alA);
        RESC8(alA);
        SBAR(); D8Qm(pB0, pB1, 2 * sb + 1);
        D8Fm(pA0, pA1, alA); SBAR();
        D8Vm(2 * sb); D8Pm(false, pB0, pB1, alB);
        RESC8(alB);
        { const int t = sbp; sbp = sb; sb = sbn; sbn = t; }
    }
    D8Fm(pB0, pB1, alB); SBAR();
    D8Vm(2 * sbp + 1);
    const int tid_e = fresh_tid(wv), wid_e = tid_e >> 6, r32e = tid_e & 31, hie = (tid_e >> 5) & 1;
    float* li_e = (float*)(lds + DM_WS) + wid_e * 64;
    float rli[16];
    if constexpr (LSUM) {
#pragma unroll
        for (int r = 0; r < 16; ++r) rli[r] = __builtin_amdgcn_rcpf(lacc[r]); (void)li_e; }
    else { if (hie == 0) li_e[r32e] = l_reg; asm volatile("s_waitcnt lgkmcnt(0)" ::: "memory");
#pragma unroll
        for (int r = 0; r < 16; ++r) rli[r] = __builtin_amdgcn_rcpf(li_e[da::crow(r, hie)]); }
    bf16_t* Ow = F8_OUT ? (bf16_t*)((unsigned char*)a.O + (long)(wid_e * 32) * a.ldo) : a.O + (long)(wid_e * 32) * a.ldo;
#pragma unroll
    for (int r = 0; r < 16; ++r) { const int orow = da::crow(r, hie);
#pragma unroll
        for (int d0 = 0; d0 < 4; ++d0) { if constexpr (F8_OUT) ((unsigned char*)Ow)[(long)orow * a.ldo + d0 * 32 + r32e] = f2fp8(o[d0][r] * rli[r] * O8_SCALE); else Ow[(long)orow * a.ldo + d0 * 32 + r32e] = f2bf(o[d0][r] * rli[r]); } }
#undef D8_DMA2
#undef RESC8
#undef D8Qm
#undef D8Vm
#undef D8Fm
#undef D8Pm
#undef D8_TOP
}
template <class P>
__device__ __forceinline__ void sparse8_wave(P& pol, LAS unsigned char* wll, int lane) {
    const int r32 = lane & 31, hi = lane >> 5;
    char* wl = (char*)wll; char* Kl = wl; char* Vl = wl + 8192; float* li_l = (float*)(wl + 16384); float* al_l = li_l + 32;
    constexpr float QCS = 0.088388347648318440f * LOG2E;
    i32x8 qf[2];
    { const bf16_t* Qw = pol.qptr(r32);
#pragma unroll
      for (int sK = 0; sK < 2; ++sK) { const bf16_t* qp = Qw + 64 * sK + 32 * hi; unsigned w[8];
#pragma unroll
          for (int c = 0; c < 4; ++c) { const u32x4 v = *(const u32x4*)(qp + 8 * c);
              w[2 * c] = pk4_fp8(bflo(v.x) * QCS, bfhi(v.x) * QCS, bflo(v.y) * QCS, bfhi(v.y) * QCS); w[2 * c + 1] = pk4_fp8(bflo(v.z) * QCS, bfhi(v.z) * QCS, bflo(v.w) * QCS, bfhi(v.w) * QCS); }
          qf[sK] = (i32x8){(int)w[0], (int)w[1], (int)w[2], (int)w[3], (int)w[4], (int)w[5], (int)w[6], (int)w[7]}; } }
    asm volatile("s_waitcnt vmcnt(0)" ::: "memory");
    f32x16 o[4] = {}; float m_reg = 0.f, l_reg = 0.f; f32x16 mneg = {};
    const int a0k = 32 * ((lane >> 5) & 1) + ((lane >> 3) & 3), che = (((lane & 7) ^ (lane >> 4)) & 7) << 4, cho = che ^ 64;
    const int vcol0 = lane >> 2; const unsigned voff = (unsigned)vcol0 * SEQ + ((((lane & 3) ^ (vcol0 >> 2)) & 3) << 4);
    const int nt = pol.ntiles();
    typename P::TI ti, tn;
#define SP8_UNI(p) ((const unsigned char*)(((unsigned long long)(unsigned)__builtin_amdgcn_readfirstlane((int)((unsigned long long)(p) >> 32)) << 32) | (unsigned)__builtin_amdgcn_readfirstlane((int)(unsigned long long)(p))))
#define SP8_DMA_K(T) do { const unsigned char* kb_ = SP8_UNI((T).k); const unsigned rs_ = (unsigned)__builtin_amdgcn_readfirstlane((int)(T).rs); const unsigned ko_ = (unsigned)a0k * rs_; \
        _Pragma("unroll") for (int i = 0; i < 8; ++i) { const unsigned char* src = kb_ + (unsigned long long)((4 * (i & 3) + 16 * (i >> 2)) * rs_) + (ko_ + (unsigned)((i & 1) ? cho : che)); \
        __builtin_amdgcn_global_load_lds((const unsigned*)src, (LAS unsigned*)(wll + i * 1024), 16, 0, 0); } } while (0)
#define SP8_DMA_V(T) do { const unsigned char* vb_ = SP8_UNI((T).v); \
        _Pragma("unroll") for (int i = 0; i < 8; ++i) { const unsigned char* src = vb_ + (unsigned long long)(16 * i) * SEQ + voff; \
        __builtin_amdgcn_global_load_lds((const unsigned*)src, (LAS unsigned*)(wll + 8192 + i * 1024), 16, 0, 0); } } while (0)
    pol.tile(0, ti);
    SP8_DMA_K(ti); SP8_DMA_V(ti);
#pragma unroll 1
    for (int j = 0; j < nt; ++j) {
        const bool more = (j + 1 < nt);
        if (more) pol.tile(j + 1, tn);
        asm volatile("s_waitcnt vmcnt(8)" ::: "memory");
        f32x16 p0, p1;
        { i32x8 a0[2], a1[2];
#pragma unroll
          for (int sK = 0; sK < 2; ++sK) { const int ch = 4 * sK + 2 * hi;
            { const i32x4 lo = *(const i32x4*)(Kl + K8SWZ(r32, ch)), hh = *(const i32x4*)(Kl + K8SWZ(r32, ch + 1)); a0[sK] = __builtin_shufflevector(lo, hh, 0, 1, 2, 3, 4, 5, 6, 7); }
            { const i32x4 lo = *(const i32x4*)(Kl + K8SWZ(32 + r32, ch)), hh = *(const i32x4*)(Kl + K8SWZ(32 + r32, ch + 1)); a1[sK] = __builtin_shufflevector(lo, hh, 0, 1, 2, 3, 4, 5, 6, 7); } }
          asm volatile("s_waitcnt lgkmcnt(0)" ::: "memory"); SBAR();
          if (more) SP8_DMA_K(tn);
          SBAR();
          if constexpr (P::SPLAT) { float nm = -m_reg; asm volatile("" : "+v"(nm));
#pragma unroll
              for (int r = 0; r < 16; ++r) mneg[r] = nm; }
          asm volatile("v_mfma_f32_32x32x64_f8f6f4 %0, %1, %2, %3" : "=&v"(p0) : "v"(a0[0]), "v"(qf[0]), "v"(mneg));
          asm volatile("v_mfma_f32_32x32x64_f8f6f4 %0, %1, %2, %3" : "=&v"(p1) : "v"(a1[0]), "v"(qf[0]), "v"(mneg));
          p0 = D8_MX(a0[1], qf[1], p0); p1 = D8_MX(a1[1], qf[1], p1);
          asm volatile("" : "+v"(p1), "+v"(p0) : "v"(mneg)); }
        float pmax = -INFINITY;
#pragma unroll
        for (int r = 0; r < 16; ++r) { p0[r] = pol.adj(ti, r, p0[r]); p1[r] = pol.adj(ti, 16 + r, p1[r]); pmax = fmaxf(pmax, fmaxf(p0[r], p1[r])); }
        { auto rr = __builtin_amdgcn_permlane32_swap(__float_as_uint(pmax), __float_as_uint(pmax), false, false);
          pmax = fmaxf(__uint_as_float(rr[0]), __uint_as_float(rr[1])); }
        float alpha = 1.f;
        { const bool first = (l_reg == 0.f) && (pmax > -INFINITY);
          const float delta = first ? pmax : (pmax > THR8 * LOG2E ? pmax : 0.f);
          if (__any(delta != 0.f)) { alpha = first ? 1.f : __builtin_amdgcn_exp2f(-delta); m_reg += delta;
#pragma unroll
              for (int r = 0; r < 16; ++r) { p0[r] -= delta; p1[r] -= delta; }
              if constexpr (!P::SPLAT) { const float nm = -m_reg;
#pragma unroll
                  for (int r = 0; r < 16; ++r) mneg[r] = nm; }
              if (hi == 0) al_l[r32] = alpha; asm volatile("s_waitcnt lgkmcnt(0)" ::: "memory");
#pragma unroll
              for (int d = 0; d < 4; ++d)
#pragma unroll
                  for (int r = 0; r < 16; ++r) o[d][r] *= al_l[da::crow(r, hi)]; } }
        float ps = 0.f;
#pragma unroll
        for (int r = 0; r < 16; ++r) { p0[r] = __builtin_amdgcn_exp2f(p0[r]); p1[r] = __builtin_amdgcn_exp2f(p1[r]); ps += p0[r] + p1[r]; }
        { auto rr = __builtin_amdgcn_permlane32_swap(__float_as_uint(ps), __float_as_uint(ps), false, false);
          ps = __uint_as_float(rr[0]) + __uint_as_float(rr[1]); }
        l_reg = l_reg * alpha + ps;
        const i32x8 pa = (i32x8){(int)pk4_fp8(p0[0], p0[1], p0[2], p0[3]), (int)pk4_fp8(p0[4], p0[5], p0[6], p0[7]), (int)pk4_fp8(p0[8], p0[9], p0[10], p0[11]), (int)pk4_fp8(p0[12], p0[13], p0[14], p0[15]),
                                 (int)pk4_fp8(p1[0], p1[1], p1[2], p1[3]), (int)pk4_fp8(p1[4], p1[5], p1[6], p1[7]), (int)pk4_fp8(p1[8], p1[9], p1[10], p1[11]), (int)pk4_fp8(p1[12], p1[13], p1[14], p1[15])};
        SBAR();
        if (more) asm volatile("s_waitcnt vmcnt(8)" ::: "memory"); else asm volatile("s_waitcnt vmcnt(0)" ::: "memory");
        SBAR();
        { i32x8 bfr[4];
#pragma unroll
          for (int d0 = 0; d0 < 4; ++d0) { const int c = 32 * d0 + r32; const char* vp = Vl + c * 64; const int sw = (c >> 2) & 3;
            const i32x4 lo = *(const i32x4*)(vp + (((2 * hi) ^ sw) << 4)), hh = *(const i32x4*)(vp + (((2 * hi + 1) ^ sw) << 4)); bfr[d0] = __builtin_shufflevector(lo, hh, 0, 1, 2, 3, 4, 5, 6, 7); }
          asm volatile("s_waitcnt lgkmcnt(0)" ::: "memory"); SBAR();
          if (more) SP8_DMA_V(tn);
          SBAR();
#pragma unroll
          for (int d0 = 0; d0 < 4; ++d0) o[d0] = D8_MX(pa, bfr[d0], o[d0]); }
        ti = tn;
    }
#undef SP8_DMA_K
#undef SP8_DMA_V
#undef SP8_UNI
    if (hi == 0) li_l[r32] = l_reg; asm volatile("s_waitcnt lgkmcnt(0)" ::: "memory");
#pragma unroll
    for (int r = 0; r < 16; ++r) { const int qn = da::crow(r, hi); const float rl = __builtin_amdgcn_rcpf(li_l[qn]); bf16_t* op = pol.optr(qn);
#pragma unroll
        for (int d0 = 0; d0 < 4; ++d0) { if constexpr (F8_OUT) ((unsigned char*)op)[d0 * 32 + r32] = f2fp8(o[d0][r] * rl * O8_SCALE); else op[d0 * 32 + r32] = f2bf(o[d0][r] * rl); } }
}
#undef D8Q
#undef D8P
#undef D8F
#undef D8V
#undef D8_LD32
#undef D8_MX
}


struct PolB {
    struct TI { const bf16_t* k; const bf16_t* v; long rs; int kpos0; int iq; float cd; };
    const bf16_t* H0; bf16_t* O; int b, h, a, r16, myn; int lo3, n3, lo2, n2, lo1, n1; float slope2;
    __device__ __forceinline__ void init(const bf16_t* H0_, bf16_t* O_, int w, int lane) {
        H0 = H0_; O = O_; b = w >> 10; h = (w >> 7) & 7; const int wu = w & 127; a = wu >> 4; r16 = wu & 15; myn = lane & 31;
        lo3 = max(a - 2, 0); n3 = min(a + 2, 7) - lo3 + 1;
        lo2 = max(4 * a - 2, 0); n2 = min(4 * a + 5, 31) - lo2 + 1;
        lo1 = max(16 * a - 2, 0); n1 = min(16 * a + 17, 127) - lo1 + 1;
        slope2 = __builtin_amdgcn_exp2f(-(float)(h + 1)) * LOG2E;
    }
    __device__ __forceinline__ const bf16_t* qptr(int n) const { return H0 + (long)(b * SEQ + 512 * a + r16 + 16 * n) * IN0 + 1536 + h * 128; }
    __device__ __forceinline__ bf16_t* optr(int qn) const { const long e = (long)(b * SEQ + 512 * a + r16 + 16 * qn) * DM + 1024 + h * 128; return F8_OUT ? (bf16_t*)((unsigned char*)O + e) : O + e; }
    __device__ __forceinline__ int ntiles() const { return n3 + n2 + n1; }
    __device__ __forceinline__ void tile(int j, TI& ti) const {
        int dil, kt, rd;
        if (j < n3) { dil = 16; kt = lo3 + j; rd = r16; }
        else if (j < n3 + n2) { dil = 4; kt = lo2 + (j - n3); rd = r16 & 3; }
        else { dil = 1; kt = lo1 + (j - n3 - n2); rd = 0; }
        const long tok = (long)b * SEQ + dil * 32 * kt + rd;
        ti.k = H0 + tok * IN0 + 2560 + h * 128; ti.v = H0 + tok * IN0 + 3584 + h * 128; ti.rs = (long)dil * IN0;
        ti.kpos0 = 32 * kt; ti.iq = (512 * a + r16 + 16 * myn - rd) / dil; ti.cd = slope2 * (float)dil;
    }
    __device__ __forceinline__ float adj(const TI& ti, int kloc, float s) const {
        const int d = ti.kpos0 + kloc - ti.iq; const int ad = d < 0 ? -d : d;
        return ad <= 64 ? fmaf(s, 0.088388347648318440f * LOG2E, -ti.cd * (float)ad) : -INFINITY;
    }
};
struct PolC {
    struct TI { const bf16_t* k; const bf16_t* v; long rs; int kc0; int drow; };
    const bf16_t* H1; bf16_t* O; const float* tab; int b, h, r, a, r0, qc, c0;
    __device__ __forceinline__ void init(const bf16_t* H1_, bf16_t* O_, const float* rpb, float* tab_, int w, int lane) {
        H1 = H1_; O = O_; tab = tab_; b = w >> 10; h = (w >> 7) & 7; const int wu = w & 127; r = wu >> 1; a = wu & 1;
        r0 = min(max(r - 4, 0), 56); qc = 32 * a + (lane & 31); c0 = min(max(qc - 8, 0), 48);
        for (int idx = lane; idx < 480; idx += 64) { const int dr = idx >> 5, dc = idx & 31; tab_[idx] = dc < 31 ? rpb[h * 465 + dr * 31 + dc] * LOG2E : 0.f; }
        asm volatile("s_waitcnt vmcnt(0) lgkmcnt(0)" ::: "memory");
    }
    __device__ __forceinline__ const bf16_t* qptr(int n) const { return H1 + (long)(b * SEQ + 64 * r + 32 * a + n) * IN1P + h * 128; }
    __device__ __forceinline__ bf16_t* optr(int qn) const { const long e = (long)(b * SEQ + 64 * r + 32 * a + qn) * DM + h * 128; return F8_OUT ? (bf16_t*)((unsigned char*)O + e) : O + e; }
    __device__ __forceinline__ int ntiles() const { return 16; }
    __device__ __forceinline__ void tile(int j, TI& ti) const {
        const int kr = r0 + (j >> 1), ch = j & 1; const long tok = (long)b * SEQ + 64 * kr + 32 * ch;
        ti.k = H1 + tok * IN1P + 1024 + h * 128; ti.v = H1 + tok * IN1P + 2048 + h * 128; ti.rs = IN1P; ti.kc0 = 32 * ch; ti.drow = kr - r + 7;
    }
    __device__ __forceinline__ float adj(const TI& ti, int kloc, float s) const {
        const int kc = ti.kc0 + kloc; const int dc = min(max(kc - qc + 15, 0), 30);
        const float bias = tab[ti.drow * 32 + dc];
        return (kc >= c0 && kc < c0 + 16) ? fmaf(s, 0.088388347648318440f * LOG2E, bias) : -INFINITY;
    }
};

struct PolB8 {
    static constexpr bool SPLAT = false;
    struct TI { const unsigned char* k; const unsigned char* v; long rs; float fb; float ncd; };
    const bf16_t* H0; bf16_t* O; const unsigned char* K8; const unsigned char* Vt1; const unsigned char* Vt4; const unsigned char* Vt16;
    int b, h, a, r16, myn, hi32; int lo3, n3, lo2, n2, lo1, n1; float slope2;
    __device__ __forceinline__ void init(const bf16_t* H0_, bf16_t* O_, const unsigned char* K8_, const unsigned char* Vt1_, const unsigned char* Vt4_, const unsigned char* Vt16_, int w, int lane) {
        H0 = H0_; O = O_; K8 = K8_; Vt1 = Vt1_; Vt4 = Vt4_; Vt16 = Vt16_; b = w >> 10; h = (w >> 7) & 7; const int wu = w & 127; a = wu >> 4; r16 = wu & 15; myn = lane & 31; hi32 = 32 * (lane >> 5);
        const int t = a >> 1; lo3 = max(t - 1, 0); n3 = min(t + 1, 3) - lo3 + 1;
        lo2 = max(2 * a - 1, 0); n2 = min(2 * a + 2, 15) - lo2 + 1;
        lo1 = max(8 * a - 1, 0); n1 = min(8 * a + 8, 63) - lo1 + 1;
        slope2 = __builtin_amdgcn_exp2f(-(float)(h + 1)) * LOG2E;
    }
    __device__ __forceinline__ const bf16_t* qptr(int n) const { return H0 + (long)(b * SEQ + 512 * a + r16 + 16 * n) * IN0 + 1536 + h * 128; }
    __device__ __forceinline__ bf16_t* optr(int qn) const { const long e = (long)(b * SEQ + 512 * a + r16 + 16 * qn) * DM + 1024 + h * 128; return F8_OUT ? (bf16_t*)((unsigned char*)O + e) : O + e; }
    __device__ __forceinline__ int ntiles() const { return n3 + n2 + n1; }
    __device__ __forceinline__ void tile(int j, TI& ti) const {
        int dil, kt, rd; const unsigned char* vt; int voff;
        if (j < n3) { dil = 16; kt = lo3 + j; rd = r16; vt = Vt16; voff = r16 * 256 + 64 * kt; }
        else if (j < n3 + n2) { dil = 4; kt = lo2 + (j - n3); rd = r16 & 3; vt = Vt4; voff = rd * 1024 + 64 * kt; }
        else { dil = 1; kt = lo1 + (j - n3 - n2); rd = 0; vt = Vt1; voff = 64 * kt; }
        const long tok = (long)b * SEQ + dil * 64 * kt + rd;
        ti.k = K8 + tok * 1024 + h * 128; ti.rs = (long)dil * 1024; ti.v = vt + (long)(b * 8 + h) * 128 * SEQ + voff;
        ti.fb = (float)(64 * kt + hi32 - (512 * a + r16 + 16 * myn - rd) / dil); ti.ncd = -slope2 * (float)dil;
    }
    __device__ __forceinline__ float adj(const TI& ti, int slot, float s) const {
        const float fd = ti.fb + (float)slot;
        return __builtin_fabsf(fd) <= 64.f ? fmaf(__builtin_fabsf(fd), ti.ncd, s) : -INFINITY;
    }
};
struct PolC8 {
    static constexpr bool SPLAT = true;
    struct TI { const unsigned char* k; const unsigned char* v; long rs; const float* tp; };
    const bf16_t* H1; bf16_t* O; const unsigned char* K8; const unsigned char* Vt; const float* tab0; int b, h, r, a, r0; int vmask;
    __device__ __forceinline__ void init(const bf16_t* H1_, bf16_t* O_, const unsigned char* K8_, const unsigned char* Vt_, const float* rpb, float* tab_, int w, int lane) {
        H1 = H1_; O = O_; K8 = K8_; Vt = Vt_; b = w >> 10; h = (w >> 7) & 7; const int wu = w & 127; r = wu >> 1; a = wu & 1;
        r0 = min(max(r - 4, 0), 56); const int qc = 32 * a + (lane & 31), c0 = min(max(qc - 8, 0), 48), hi32 = 32 * (lane >> 5);
        { const int lo = c0 - hi32; const unsigned m16 = 0xffffu; vmask = lo >= 32 || lo <= -16 ? 0 : (int)(lo >= 0 ? (m16 << lo) : (m16 >> (-lo))); }
        tab0 = tab_ + (hi32 - qc + 15);
        { float tv[8];
#pragma unroll
          for (int q = 0; q < 8; ++q) { const int idx = lane + 64 * q, dr = min(idx >> 5, 14), dc = idx & 31; tv[q] = rpb[h * 465 + dr * 31 + min(dc, 30)]; }
#pragma unroll
          for (int q = 0; q < 8; ++q) { const int idx = lane + 64 * q, dc = idx & 31; const float v = dc < 31 ? tv[q] * LOG2E : 0.f; if (idx < 480) tab_[idx] = v; } }
        asm volatile("s_waitcnt vmcnt(0) lgkmcnt(0)" ::: "memory");
    }
    __device__ __forceinline__ const bf16_t* qptr(int n) const { return H1 + (long)(b * SEQ + 64 * r + 32 * a + n) * IN1P + h * 128; }
    __device__ __forceinline__ bf16_t* optr(int qn) const { const long e = (long)(b * SEQ + 64 * r + 32 * a + qn) * DM + h * 128; return F8_OUT ? (bf16_t*)((unsigned char*)O + e) : O + e; }
    __device__ __forceinline__ int ntiles() const { return 8; }
    __device__ __forceinline__ void tile(int j, TI& ti) const {
        const int kr = r0 + j; const long tok = (long)b * SEQ + 64 * kr;
        ti.k = K8 + tok * 1024 + h * 128; ti.rs = 1024; ti.v = Vt + (long)(b * 8 + h) * 128 * SEQ + 64 * kr; ti.tp = tab0 + (kr - r + 7) * 32;
    }
    __device__ __forceinline__ float adj(const TI& ti, int slot, float s) const {
        const float v = s + ti.tp[slot];
        const int t = __builtin_amdgcn_sbfe(vmask, slot, 1);
        return __uint_as_float((__float_as_uint(v) & (unsigned)t) | (0xff800000u & ~(unsigned)t));
    }
};

struct Params { const float* in[28]; float* out; unsigned char* ws; int ph_lo, ph_hi; };
enum { I_X = 0, I_RW = 1, I_RB = 2, I_WIN0 = 3, I_AQN = 4, I_AKN = 5, I_WOUT0 = 6, I_LN1G0 = 7, I_LN1B0 = 8, I_WG0 = 9, I_WU0 = 10, I_WD0 = 11, I_LN2G0 = 12, I_LN2B0 = 13,
       I_WIN1 = 14, I_RPB = 15, I_DQN = 16, I_WQUP = 17, I_DKVN = 18, I_WKVUP = 19, I_WOUT1 = 20, I_LN1G1 = 21, I_LN1B1 = 22, I_WG1 = 23, I_WU1 = 24, I_WD1 = 25, I_LN2G1 = 26, I_LN2B1 = 27 };

__device__ __forceinline__ void tr_tile(const float* __restrict__ src, int N, const float* __restrict__ ksc, bf16_t* __restrict__ dst, int ldd, int k0, int n0, int drow0, LAS unsigned* tl, int tid) {
    const int c4 = (tid & 15) * 4;
#pragma unroll
    for (int i = 0; i < 2; ++i) {
        const int kp = (tid >> 4) + 32 * i;
        const float* s0 = src + (size_t)(k0 + 2 * kp) * N + n0 + c4;
        f32x4 a = *(const f32x4*)s0, b = *(const f32x4*)(s0 + N);
        if (ksc) { const float sa = ksc[k0 + 2 * kp], sb = ksc[k0 + 2 * kp + 1]; a *= sa; b *= sb; }
#pragma unroll
        for (int j = 0; j < 4; ++j) tl[(c4 + j) * 65 + kp] = cvtpk(a[j], b[j]);
    }
    __syncthreads();
    const int n = tid >> 3, seg = tid & 7;
    unsigned w[8];
#pragma unroll
    for (int q = 0; q < 8; ++q) w[q] = tl[n * 65 + seg * 8 + q];
    u32x4* d = (u32x4*)(dst + (size_t)(drow0 + n) * ldd + k0 + seg * 16);
    d[0] = (u32x4){w[0], w[1], w[2], w[3]}; d[1] = (u32x4){w[4], w[5], w[6], w[7]};
    __syncthreads();
}
__device__ __forceinline__ void tr_tile8(const float* __restrict__ src, int N, const float* __restrict__ ksc, float wscale, unsigned char* __restrict__ dst, int ldd, int k0, int n0, int drow0, LAS unsigned* tl, int tid) {
    const int c4 = (tid & 15) * 4, kq = tid >> 4;
    const float* s0 = src + (size_t)(k0 + 4 * kq) * N + n0 + c4;
    f32x4 a = *(const f32x4*)s0, b = *(const f32x4*)(s0 + N), c = *(const f32x4*)(s0 + 2 * (size_t)N), d = *(const f32x4*)(s0 + 3 * (size_t)N);
    float sa = wscale, sb = wscale, sc = wscale, sd = wscale;
    if (ksc) { sa *= ksc[k0 + 4 * kq]; sb *= ksc[k0 + 4 * kq + 1]; sc *= ksc[k0 + 4 * kq + 2]; sd *= ksc[k0 + 4 * kq + 3]; }
#pragma unroll
    for (int j = 0; j < 4; ++j) tl[(c4 + j) * 33 + kq] = pk4_fp8(a[j] * sa, b[j] * sb, c[j] * sc, d[j] * sd);
    __syncthreads();
    const int n = tid >> 3, seg = tid & 7;
    unsigned w[4];
#pragma unroll
    for (int q = 0; q < 4; ++q) w[q] = tl[n * 33 + seg * 4 + q];
    *(u32x4*)(dst + (size_t)(drow0 + n) * ldd + k0 + seg * 16) = (u32x4){w[0], w[1], w[2], w[3]};
    __syncthreads();
}
struct TJob { const float* src; bf16_t* dst; const float* ksc; int K, N, ldd, gu; size_t sbs, dbs; int f8; };
constexpr float W8_SCALE = 64.f;
constexpr int W8_SBYTE = 0x79797979;
__device__ __forceinline__ void run_tjob(const TJob& jb, int t, LAS unsigned* tl, int tid) {
    const int ntn = jb.N / 64, ntk = jb.K / 128, per = ntn * ntk;
    const int bi = t / per, r = t % per, tk = r / ntn, tn = r % ntn;
    const int n0 = tn * 64;
    const int drow0 = jb.gu ? (256 * (n0 >> 7) + (jb.gu == 2 ? 128 : 0) + (n0 & 127)) : n0;
    if (jb.f8) tr_tile8(jb.src + (size_t)bi * jb.sbs, jb.N, jb.ksc, W8_SCALE, (unsigned char*)jb.dst + (size_t)bi * jb.dbs, jb.ldd, tk * 128, n0, drow0, tl, tid);
    else tr_tile(jb.src + (size_t)bi * jb.sbs, jb.N, jb.ksc, jb.dst + (size_t)bi * jb.dbs, jb.ldd, tk * 128, n0, drow0, tl, tid);
}
typedef __attribute__((address_space(4))) const unsigned long long kcu64_t;
#define PIN(i) ((const float*)(__attribute__((address_space(1))) const float*)ka[i])
__device__ __forceinline__ void phase_prologue(kcu64_t* ka, unsigned char* ws, LAS unsigned char* lds, int G, int bid, int tid) {
    LAS unsigned* tl = (LAS unsigned*)lds;
    constexpr int NJ = 12;
    const int cnts[NJ] = {16 * 72, 16 * 32, 4096, 4096, 4096, 16 * 61, 16 * 32, 4096, 4096, 4096, 4 * 24, 2 * 32};
    int total = 0;
#pragma unroll
    for (int j = 0; j < NJ; ++j) total += cnts[j];
    for (int t = bid; t < total; t += G) {
        int j = 0, base = 0;
#pragma unroll
        for (int q = 0; q < NJ - 1; ++q) if (t >= base + cnts[q] && j == q) { base += cnts[q]; j = q + 1; }
        const int tt = t - base;
        TJob jb;
        switch (j) {
            case 0: jb = TJob{PIN(I_WIN0), (bf16_t*)(ws + WS_WIN0), nullptr, 2048, IN0, 2048, 0, 0, 0, F8_IN}; break;
            case 1: jb = TJob{PIN(I_WOUT0), (bf16_t*)(ws + WS_WOUT0), nullptr, 2048, 2048, 2048, 0, 0, 0, F8_OUT}; break;
            case 2: jb = TJob{PIN(I_WG0), (bf16_t*)(ws + WS_WGU0), nullptr, 2048, 512, 2048, 1, (size_t)2048 * 512, (size_t)1024 * 2048, F8_GU}; break;
            case 3: jb = TJob{PIN(I_WU0), (bf16_t*)(ws + WS_WGU0), nullptr, 2048, 512, 2048, 2, (size_t)2048 * 512, (size_t)1024 * 2048, F8_GU}; break;
            case 4: jb = TJob{PIN(I_WD0), (bf16_t*)(ws + WS_WD0), nullptr, 512, 2048, 512, 0, (size_t)512 * 2048, (size_t)2048 * 512, F8_DOWN}; break;
            case 5: jb = TJob{PIN(I_WIN1), (bf16_t*)(ws + WS_WIN1), nullptr, 2048, IN1, 2048, 0, 0, 0, F8_IN}; break;
            case 6: jb = TJob{PIN(I_WOUT1), (bf16_t*)(ws + WS_WOUT1), nullptr, 2048, 2048, 2048, 0, 0, 0, F8_OUT}; break;
            case 7: jb = TJob{PIN(I_WG1), (bf16_t*)(ws + WS_WGU1), nullptr, 2048, 512, 2048, 1, (size_t)2048 * 512, (size_t)1024 * 2048, F8_GU}; break;
            case 8: jb = TJob{PIN(I_WU1), (bf16_t*)(ws + WS_WGU1), nullptr, 2048, 512, 2048, 2, (size_t)2048 * 512, (size_t)1024 * 2048, F8_GU}; break;
            case 9: jb = TJob{PIN(I_WD1), (bf16_t*)(ws + WS_WD1), nullptr, 512, 2048, 512, 0, (size_t)512 * 2048, (size_t)2048 * 512, F8_DOWN}; break;
            case 10: jb = TJob{PIN(I_WQUP), (bf16_t*)(ws + WS_WQUP), PIN(I_DQN), 512, 1536, 512, 0, 0, 0, F8_P3}; break;
            default: jb = TJob{PIN(I_WKVUP), (bf16_t*)(ws + WS_WKVUP), PIN(I_DKVN), 256, 2048, 256, 0, 0, 0, F8_P3}; break;
        }
        run_tjob(jb, tt, tl, tid);
    }
    { constexpr size_t ESZ = F8_IN ? 1 : 2;
      u32x4* z = (u32x4*)(ws + WS_WIN1 + (size_t)IN1 * 2048 * ESZ); const size_t n16 = (size_t)(IN1P - IN1) * 2048 * ESZ / 16;
      const unsigned zu = __float_as_uint(fresh_zero());
      for (size_t i = (size_t)bid * NTHR + tid; i < n16; i += (size_t)G * NTHR) z[i] = (u32x4){zu, zu, zu, zu}; }
    { const f32x8* xs = (const f32x8*)PIN(I_X); const size_t n8 = (size_t)T_ * DM / 8;
      if constexpr (F8_IN) { u32x2* xd = (u32x2*)(ws + WS_RC + 64 * MiB);
          for (size_t i = (size_t)bid * NTHR + tid; i < n8; i += (size_t)G * NTHR) { const f32x8 v = xs[i]; xd[i] = (u32x2){pk4_fp8(v[0], v[1], v[2], v[3]), pk4_fp8(v[4], v[5], v[6], v[7])}; } }
      else { u32x4* xd = (u32x4*)(ws + WS_RA);
          for (size_t i = (size_t)bid * NTHR + tid; i < n8; i += (size_t)G * NTHR) { const f32x8 v = xs[i];
              xd[i] = (u32x4){cvtpk(v[0], v[1]), cvtpk(v[2], v[3]), cvtpk(v[4], v[5]), cvtpk(v[6], v[7])}; } } }
}

template <int X> __device__ __forceinline__ float swzf(float v) { return __int_as_float(__builtin_amdgcn_ds_swizzle(__float_as_int(v), (X << 10) | 0x1f)); }
template <int X> __device__ __forceinline__ unsigned swzu(unsigned v) { return (unsigned)__builtin_amdgcn_ds_swizzle((int)v, (X << 10) | 0x1f); }
__device__ __forceinline__ void phase_prep_qk(bf16_t* H0, const float* qn, const float* kn, unsigned char* K8, int G, int bid, int tid) {
    const int wid = __builtin_amdgcn_readfirstlane(tid >> 6), lane = tid & 63;
    const int cch = lane & 15, half = cch >> 3, ci = cch & 7; const bool isx2 = ci >= 4;
    float gqo[8], gqp[8], gko[8], gkp[8], invf[8];
#pragma unroll
    for (int j = 0; j < 8; ++j) { gqo[j] = qn[8 * cch + j]; gqp[j] = qn[8 * (cch ^ 4) + j]; gko[j] = kn[8 * cch + j]; gkp[j] = kn[8 * (cch ^ 4) + j]; invf[j] = inv_freq32(8 * (ci & 3) + j); }
    const int mstep = G * 8, m0 = bid * 8 + wid;
    u32x4 rawc[3], rawn[3];
#define PQK_LOAD(mm, R) do { const bf16_t* rp_ = H0 + (size_t)(mm) * IN0; _Pragma("unroll") for (int p = 0; p < 3; ++p) { if (p < 2 || lane < 32) { const int hh = 4 * p + (lane >> 4); \
        (R)[p] = *(const u32x4*)(rp_ + (hh < 8 ? hh * 128 : 1024 + (hh - 8) * 128) + 8 * cch); } } } while (0)
    rawc[2] = (u32x4){0u, 0u, 0u, 0u}; rawn[2] = rawc[2];
    if (m0 < T_) PQK_LOAD(m0, rawc);
    rawn[0] = rawc[0]; rawn[1] = rawc[1];
    for (int m = m0; m < T_; m += mstep) {
        if (m + mstep < T_) PQK_LOAD(m + mstep, rawn);
        const int sq = m & (SEQ - 1); const float pos = (float)(half ? (sq & 63) : (sq >> 6));
        float sn[8], cs[8];
#pragma unroll
        for (int j = 0; j < 8; ++j) sincos_rev(pos * invf[j], sn[j], cs[j]);
        bf16_t* rowp = H0 + (size_t)m * IN0;
#pragma unroll
        for (int p = 0; p < 3; ++p) {
            if (p < 2 || lane < 32) {
                const int hh = 4 * p + (lane >> 4); const bool isq = hh < 8;
                bf16_t* cp = rowp + (isq ? hh * 128 : 1024 + (hh - 8) * 128) + 8 * cch;
                const u32x4 raw = rawc[p];
                const unsigned rw4[4] = {raw.x, raw.y, raw.z, raw.w}; float x[8], xp[8]; float ss = 0.f;
#pragma unroll
                for (int q = 0; q < 4; ++q) { x[2 * q] = bflo(rw4[q]); x[2 * q + 1] = bfhi(rw4[q]); ss += x[2 * q] * x[2 * q] + x[2 * q + 1] * x[2 * q + 1];
                    const unsigned pw = swzu<4>(rw4[q]); xp[2 * q] = bflo(pw); xp[2 * q + 1] = bfhi(pw); }
                ss += swzf<1>(ss); ss += swzf<2>(ss); ss += swzf<4>(ss); ss += swzf<8>(ss);
                const float r = rsqrtf(ss * (1.0f / 128.0f) + 1e-6f);
                float o[8];
#pragma unroll
                for (int j = 0; j < 8; ++j) { const float yo = x[j] * r * (isq ? gqo[j] : gko[j]), yp = xp[j] * r * (isq ? gqp[j] : gkp[j]);
                    o[j] = isx2 ? (yo * cs[j] + yp * sn[j]) : (yo * cs[j] - yp * sn[j]); }
                *(u32x4*)cp = (u32x4){cvtpk(o[0], o[1]), cvtpk(o[2], o[3]), cvtpk(o[4], o[5]), cvtpk(o[6], o[7])};
                if (F8_ATTA && !isq) *(u32x2*)(K8 + (size_t)m * 256 + (hh - 8) * 128 + 8 * cch) = (u32x2){pk4_fp8(o[0], o[1], o[2], o[3]), pk4_fp8(o[4], o[5], o[6], o[7])};
            }
        }
        rawc[0] = rawn[0]; rawc[1] = rawn[1]; rawc[2] = rawn[2];
    }
#undef PQK_LOAD
}
__device__ __forceinline__ void phase_vt8(const bf16_t* H0, unsigned char* Vt8, LAS unsigned char* lds, int G, int bid, int tid) {
    const int t = tid >> 3, seg = tid & 7, c = tid >> 2, part = tid & 3;
    for (int u = bid; u < 1024; u += G) {
        const int b = u >> 7, kvh = (u >> 6) & 1, ch = u & 63;
        const bf16_t* src = H0 + (size_t)(b * SEQ + ch * 64 + t) * IN0 + 1280 + kvh * 128 + seg * 16;
        const u32x4 v0 = *(const u32x4*)src, v1 = *(const u32x4*)(src + 8);
        const unsigned w[8] = {v0.x, v0.y, v0.z, v0.w, v1.x, v1.y, v1.z, v1.w};
        __syncthreads();
#pragma unroll
        for (int j = 0; j < 8; ++j) { lds[(16 * seg + 2 * j) * 80 + t] = f2fp8(bflo(w[j])); lds[(16 * seg + 2 * j + 1) * 80 + t] = f2fp8(bfhi(w[j])); }
        __syncthreads();
        const u32x4 o = *(const LAS u32x4*)(lds + c * 80 + part * 16);
        *(u32x4*)(Vt8 + ((size_t)(b * 2 + kvh) * 128 + c) * SEQ + ch * 64 + part * 16) = o;
    }
    __syncthreads();
}
__device__ __forceinline__ void phase_k8_copy(const bf16_t* H, int ldh, int col0, unsigned char* K8, int G, int bid, int tid) {
    for (size_t i = (size_t)bid * NTHR + tid; i < (size_t)T_ * 128; i += (size_t)G * NTHR) { const size_t m = i >> 7; const int c = (int)(i & 127) * 8;
        const u32x4 v = *(const u32x4*)(H + m * ldh + col0 + c);
        *(u32x2*)(K8 + m * 1024 + c) = (u32x2){pk4_fp8(bflo(v.x), bfhi(v.x), bflo(v.y), bfhi(v.y)), pk4_fp8(bflo(v.z), bfhi(v.z), bflo(v.w), bfhi(v.w))}; }
}
__device__ __forceinline__ void tr4x4(unsigned w0, unsigned w1, unsigned w2, unsigned w3, unsigned (&o)[4]) {
    const unsigned a_lo = __builtin_amdgcn_perm(w1, w0, 0x05010400u), a_hi = __builtin_amdgcn_perm(w1, w0, 0x07030602u);
    const unsigned b_lo = __builtin_amdgcn_perm(w3, w2, 0x05010400u), b_hi = __builtin_amdgcn_perm(w3, w2, 0x07030602u);
    o[0] = __builtin_amdgcn_perm(b_lo, a_lo, 0x05040100u); o[1] = __builtin_amdgcn_perm(b_lo, a_lo, 0x07060302u);
    o[2] = __builtin_amdgcn_perm(b_hi, a_hi, 0x05040100u); o[3] = __builtin_amdgcn_perm(b_hi, a_hi, 0x07060302u);
}
template <bool DIL>
__device__ __forceinline__ void phase_vt_heads(const unsigned char* V8, unsigned char* Vt1, unsigned char* Vt4, unsigned char* Vt16, LAS unsigned char* lds, int G, int bid, int tid) {
    constexpr int PITCH = 272, IMG = 128 * PITCH;
    const int cb = tid & 31, tq = tid >> 5;
    for (int u = bid; u < 1024; u += G) {
        const int b = u >> 7, h = (u >> 4) & 7, ch = u & 15;
        const unsigned char* src = V8 + (size_t)(b * SEQ + 256 * ch) * 1024 + h * 128 + 4 * cb;
        __syncthreads();
#pragma unroll
        for (int k = 0; k < 4; ++k) { const int tg = tq + 16 * k;
            unsigned o[4];
            { const int t0 = 4 * tg;
              tr4x4(*(const unsigned*)(src + (size_t)(t0 + 0) * 1024), *(const unsigned*)(src + (size_t)(t0 + 1) * 1024), *(const unsigned*)(src + (size_t)(t0 + 2) * 1024), *(const unsigned*)(src + (size_t)(t0 + 3) * 1024), o);
#pragma unroll
              for (int j = 0; j < 4; ++j) *(LAS unsigned*)(lds + (4 * cb + j) * PITCH + 4 * tg) = o[j]; }
            if constexpr (DIL) {
                { const int r = tg & 3, g = tg >> 2; const int t0 = r + 16 * g;
                  tr4x4(*(const unsigned*)(src + (size_t)(t0 + 0) * 1024), *(const unsigned*)(src + (size_t)(t0 + 4) * 1024), *(const unsigned*)(src + (size_t)(t0 + 8) * 1024), *(const unsigned*)(src + (size_t)(t0 + 12) * 1024), o);
#pragma unroll
                  for (int j = 0; j < 4; ++j) *(LAS unsigned*)(lds + IMG + (4 * cb + j) * PITCH + r * 64 + 4 * g) = o[j]; }
                { const int cls = tg & 15, g = tg >> 4; const int t0 = cls + 64 * g;
                  tr4x4(*(const unsigned*)(src + (size_t)(t0 + 0) * 1024), *(const unsigned*)(src + (size_t)(t0 + 16) * 1024), *(const unsigned*)(src + (size_t)(t0 + 32) * 1024), *(const unsigned*)(src + (size_t)(t0 + 48) * 1024), o);
#pragma unroll
                  for (int j = 0; j < 4; ++j) *(LAS unsigned*)(lds + 2 * IMG + (4 * cb + j) * PITCH + cls * 16 + 4 * g) = o[j]; }
            }
        }
        __syncthreads();
        const size_t cbase = (size_t)(b * 8 + h) * 128;
#pragma unroll
        for (int k = 0; k < 4; ++k) { const int id = tid + NTHR * k, col = id >> 4, pc = id & 15;
            *(u32x4*)(Vt1 + (cbase + col) * SEQ + 256 * ch + pc * 16) = *(const LAS u32x4*)(lds + col * PITCH + pc * 16);
            if constexpr (DIL) {
                *(u32x4*)(Vt4 + (cbase + col) * SEQ + (pc >> 2) * 1024 + 64 * ch + (pc & 3) * 16) = *(const LAS u32x4*)(lds + IMG + col * PITCH + pc * 16);
                *(u32x4*)(Vt16 + (cbase + col) * SEQ + pc * 256 + 16 * ch) = *(const LAS u32x4*)(lds + 2 * IMG + col * PITCH + pc * 16); } }
    }
    __syncthreads();
}
__device__ __forceinline__ void phase_prep_mla(bf16_t* H1, bf16_t* krope, unsigned char* kr8, int G, int bid, int tid) {
    const int wid = __builtin_amdgcn_readfirstlane(tid >> 6), lane = tid & 63;
    const float invf = inv_freq32(lane & 31);
    for (int m = bid * 8 + wid; m < T_; m += G * 8) {
        bf16_t* rowp = H1 + (size_t)m * IN1P;
        const u32x4 a = *(const u32x4*)(rowp + 3072 + lane * 8);
        float ss = bflo(a.x) * bflo(a.x) + bfhi(a.x) * bfhi(a.x) + bflo(a.y) * bflo(a.y) + bfhi(a.y) * bfhi(a.y) + bflo(a.z) * bflo(a.z) + bfhi(a.z) * bfhi(a.z) + bflo(a.w) * bflo(a.w) + bfhi(a.w) * bfhi(a.w);
        ss = wave_sum(ss);
        const u32x2 c = *(const u32x2*)(rowp + 3584 + lane * 4);
        float s2 = bflo(c.x) * bflo(c.x) + bfhi(c.x) * bfhi(c.x) + bflo(c.y) * bflo(c.y) + bfhi(c.y) * bfhi(c.y);
        s2 = wave_sum(s2);
        const float rq = rsqrtf(ss * (1.0f / 512.0f) + 1e-6f), rkv = rsqrtf(s2 * (1.0f / 256.0f) + 1e-6f);
        if constexpr (F8_P3 != 0) {
            *(u32x2*)((unsigned char*)(rowp + 3072) + lane * 8) = (u32x2){pk4_fp8(bflo(a.x) * rq, bfhi(a.x) * rq, bflo(a.y) * rq, bfhi(a.y) * rq), pk4_fp8(bflo(a.z) * rq, bfhi(a.z) * rq, bflo(a.w) * rq, bfhi(a.w) * rq)};
            *(unsigned*)((unsigned char*)(rowp + 3584) + lane * 4) = pk4_fp8(bflo(c.x) * rkv, bfhi(c.x) * rkv, bflo(c.y) * rkv, bfhi(c.y) * rkv); }
        else {
        *(u32x4*)(rowp + 3072 + lane * 8) = (u32x4){cvtpk(bflo(a.x) * rq, bfhi(a.x) * rq), cvtpk(bflo(a.y) * rq, bfhi(a.y) * rq), cvtpk(bflo(a.z) * rq, bfhi(a.z) * rq), cvtpk(bflo(a.w) * rq, bfhi(a.w) * rq)};
        *(u32x2*)(rowp + 3584 + lane * 4) = (u32x2){cvtpk(bflo(c.x) * rkv, bfhi(c.x) * rkv), cvtpk(bflo(c.y) * rkv, bfhi(c.y) * rkv)}; }
        if (lane < 32) { const float x1 = bf2f(rowp[3840 + lane]), x2 = bf2f(rowp[3840 + 32 + lane]);
            float sn, cs; sincos_rev((float)(m & (SEQ - 1)) * invf, sn, cs);
            const float o1 = x1 * cs - x2 * sn, o2 = x2 * cs + x1 * sn;
            krope[(size_t)m * 64 + lane] = f2bf(o1); krope[(size_t)m * 64 + 32 + lane] = f2bf(o2);
            if (F8_ATTD) { kr8[(size_t)m * 64 + lane] = f2fp8(o1); kr8[(size_t)m * 64 + 32 + lane] = f2fp8(o2); } }
    }
}

constexpr int LNR_PITCH = 2052;
constexpr int LNR_PART = 131584, LNR_SC = 147968, LNR_SEL = 150016, LNR_BLE = 152064, LNR_HIST = 153088;
template <bool RES_F32>
__device__ __forceinline__ void phase_ln_router(const bf16_t* mix, const void* res, const float* g, const float* bb, const float* rw, const float* rb, bf16_t* x1b, unsigned char* x1q,
                                                int* tok_e, int* tok_p, float* tok_g, int* list, unsigned* cnt, LAS unsigned char* lds, int G, int bid, int tid, bool commit = true) {
    const int wid = __builtin_amdgcn_readfirstlane(tid >> 6), lane = tid & 63;
    float ALPHA = 1.4142135623730951f; asm volatile("" : "+v"(ALPHA));
    LAS float* xs = (LAS float*)lds; LAS float* part = (LAS float*)(lds + LNR_PART); LAS float* scs = (LAS float*)(lds + LNR_SC); LAS float* sels = (LAS float*)(lds + LNR_SEL);
    LAS int* ble = (LAS int*)(lds + LNR_BLE); LAS int* hist = (LAS int*)(lds + LNR_HIST);
    f16x8 bw[8][2];
    { const float* rwp = rw + (size_t)(256 * wid + 8 * (lane >> 4)) * 32 + (lane & 15);
#pragma unroll
      for (int ks = 0; ks < 8; ++ks)
#pragma unroll
        for (int hf = 0; hf < 2; ++hf)
#pragma unroll
          for (int j = 0; j < 8; ++j) bw[ks][hf][j] = (_Float16)rwp[(32 * ks + j) * 32 + 16 * hf]; }
    typedef typename std::conditional<RES_F32, f32x4, u32x2>::type res_t;
    typedef typename std::conditional<F8_MIX != 0, unsigned, u32x2>::type mix_t;
    mix_t mv[2][8]; res_t rv[2][8];
#define LNR_LOAD(tix_, rr) do { const size_t eo = ((size_t)(tix_) * 16 + 2 * wid + (rr)) * DM + 4 * lane; \
        _Pragma("unroll") for (int i = 0; i < 8; ++i) { if constexpr (F8_MIX != 0) mv[rr][i] = *(const mix_t*)((const unsigned char*)mix + eo + 256 * i); else mv[rr][i] = *(const mix_t*)(mix + eo + 256 * i); \
            if constexpr (RES_F32) rv[rr][i] = *(const res_t*)((const float*)res + eo + 256 * i); else rv[rr][i] = *(const res_t*)((const bf16_t*)res + eo + 256 * i); } } while (0)
    const int ntile = T_ / 16;
    int ntl = 0;
    if (bid < ntile) LNR_LOAD(bid, 0);
    const int lane0 = lane;
    for (int it = 0; bid + G * it < ntile; ++it) {
        const int tix = bid + G * it;
        int lane = lane0; asm volatile("" : "+v"(lane));
#pragma unroll
        for (int rr = 0; rr < 2; ++rr) {
            const int row = 2 * wid + rr; const size_t m = (size_t)tix * 16 + row;
            f32x4 zr[8]; float s = 0.f;
#pragma unroll
            for (int i = 0; i < 8; ++i) { f32x4 mx;
                if constexpr (F8_MIX != 0) { const int mw = (int)*(const unsigned*)&mv[rr][i]; const f32x2 m0 = __builtin_amdgcn_cvt_pk_f32_fp8(mw, false), m1 = __builtin_amdgcn_cvt_pk_f32_fp8(mw, true);
                    mx = (f32x4){m0[0], m0[1], m1[0], m1[1]} * (1.0f / 16.f); }
                else { const u32x2 mb = *(const u32x2*)&mv[rr][i]; mx = (f32x4){bflo(mb.x), bfhi(mb.x), bflo(mb.y), bfhi(mb.y)}; }
                f32x4 rx;
                if constexpr (RES_F32) rx = rv[rr][i]; else { const u32x2 rb2 = rv[rr][i]; rx = (f32x4){bflo(rb2.x), bfhi(rb2.x), bflo(rb2.y), bfhi(rb2.y)}; }
                zr[i] = ALPHA * rx + mx; s += (zr[i][0] + zr[i][1]) + (zr[i][2] + zr[i][3]); }
            if (rr == 0) { __builtin_amdgcn_sched_barrier(0); LNR_LOAD(tix, 1); __builtin_amdgcn_sched_barrier(0); }
            const float mean = wave_sum(s) * (1.0f / DM); float q = 0.f;
#pragma unroll
            for (int i = 0; i < 8; ++i) { const f32x4 d = zr[i] - mean; q += (d[0] * d[0] + d[1] * d[1]) + (d[2] * d[2] + d[3] * d[3]); }
            const float rstd = rsqrtf(wave_sum(q) * (1.0f / DM) + 1e-5f);
#pragma unroll
            for (int i = 0; i < 8; ++i) { const int col = 4 * lane + 256 * i; const f32x4 gv = *(const f32x4*)(g + col), bv = *(const f32x4*)(bb + col);
                const f32x4 y = (zr[i] - mean) * rstd * gv + bv;
                LAS f32x2* xp = (LAS f32x2*)(xs + row * LNR_PITCH + col); xp[0] = (f32x2){y[0], y[1]}; xp[1] = (f32x2){y[2], y[3]};
                *(u32x2*)(x1b + m * DM + col) = (u32x2){cvtpk(y[0], y[1]), cvtpk(y[2], y[3])};
                if constexpr (F8_GU) *(unsigned*)(x1q + m * DM + col) = pk4_fp8(y[0], y[1], y[2], y[3]);
                if (i & 1) asm volatile("" ::: "memory"); }
        }
        __builtin_amdgcn_sched_barrier(0);
        if (tix + G < ntile) LNR_LOAD(tix + G, 0);
        __builtin_amdgcn_sched_barrier(0);
        __syncthreads();
        { f32x4 acc0 = {0.f, 0.f, 0.f, 0.f}, acc1 = {0.f, 0.f, 0.f, 0.f}; const LAS float* xa = xs + (lane & 15) * LNR_PITCH + 256 * wid + 8 * (lane >> 4); const int e = lane & 15;
#pragma unroll
          for (int ks = 0; ks < 8; ++ks) { const f32x4 xa0 = *(const LAS f32x4*)(xa + 32 * ks), xa1 = *(const LAS f32x4*)(xa + 32 * ks + 4);
              const float xv[8] = {xa0[0], xa0[1], xa0[2], xa0[3], xa1[0], xa1[1], xa1[2], xa1[3]}; f16x8 ah, al;
#pragma unroll
              for (int j = 0; j < 8; ++j) { const _Float16 hh = (_Float16)xv[j]; ah[j] = hh; al[j] = (_Float16)(xv[j] - (float)hh); }
              acc0 = __builtin_amdgcn_mfma_f32_16x16x32_f16(ah, bw[ks][0], acc0, 0, 0, 0); acc1 = __builtin_amdgcn_mfma_f32_16x16x32_f16(ah, bw[ks][1], acc1, 0, 0, 0);
              acc0 = __builtin_amdgcn_mfma_f32_16x16x32_f16(al, bw[ks][0], acc0, 0, 0, 0); acc1 = __builtin_amdgcn_mfma_f32_16x16x32_f16(al, bw[ks][1], acc1, 0, 0, 0); }
          __builtin_amdgcn_sched_barrier(0);
          __builtin_amdgcn_sched_barrier(0);
#pragma unroll
          for (int r = 0; r < 4; ++r) { const int row = (lane >> 4) * 4 + r; part[(wid * 16 + row) * 32 + e] = acc0[r]; part[(wid * 16 + row) * 32 + 16 + e] = acc1[r]; } }
        __syncthreads();
        { const int row = tid >> 5, e = tid & 31; float lg = 0.f;
#pragma unroll
          for (int w = 0; w < 8; ++w) lg += part[(w * 16 + row) * 32 + e];
          const float sc = 1.0f / (1.0f + __expf(-lg)); scs[row * 32 + e] = sc; sels[row * 32 + e] = sc + rb[e]; }
        __syncthreads();
        if (tid < 16) { const int row = tid; float best = -INFINITY; int bg = 0;
            for (int gI = 0; gI < 8; ++gI) { const float a = sels[row * 32 + 4 * gI], b = sels[row * 32 + 4 * gI + 1], c = sels[row * 32 + 4 * gI + 2], d = sels[row * 32 + 4 * gI + 3];
                const float h1 = fmaxf(a, b), l1 = fminf(a, b), h2 = fmaxf(c, d), l2 = fminf(c, d); const float gs = fmaxf(h1, h2) + fmaxf(fminf(h1, h2), fmaxf(l1, l2));
                if (gs > best) { best = gs; bg = gI; } }
            const float v0 = sels[row * 32 + 4 * bg], v1 = sels[row * 32 + 4 * bg + 1], v2 = sels[row * 32 + 4 * bg + 2], v3 = sels[row * 32 + 4 * bg + 3];
            int i1 = 0; float b1v = v0; if (v1 > b1v) { b1v = v1; i1 = 1; } if (v2 > b1v) { b1v = v2; i1 = 2; } if (v3 > b1v) { b1v = v3; i1 = 3; }
            int i2 = -1; float b2v = -INFINITY;
            if (i1 != 0 && v0 > b2v) { b2v = v0; i2 = 0; } if (i1 != 1 && v1 > b2v) { b2v = v1; i2 = 1; } if (i1 != 2 && v2 > b2v) { b2v = v2; i2 = 2; } if (i1 != 3 && v3 > b2v) { b2v = v3; i2 = 3; }
            const int e1 = 4 * bg + i1, e2 = 4 * bg + i2; const float s1 = scs[row * 32 + e1], s2 = scs[row * 32 + e2]; const float inv = 1.0f / (s1 + s2);
            const int m = tix * 16 + row;
            tok_e[2 * m] = e1; tok_e[2 * m + 1] = e2; tok_g[2 * m] = s1 * inv; tok_g[2 * m + 1] = s2 * inv;
            ble[(it * 16 + row) * 2] = e1; ble[(it * 16 + row) * 2 + 1] = e2; }
        __syncthreads();
        ntl = it + 1;
    }
#undef LNR_LOAD
    const int nasg = commit ? ntl * 32 : 0;
    if (tid < 32) { int c = 0; for (int i = 0; i < nasg; ++i) c += (ble[i] == tid) ? 1 : 0;
        unsigned base = 0; if (c) base = __hip_atomic_fetch_add(cnt + tid, (unsigned)c, __ATOMIC_RELAXED, __HIP_MEMORY_SCOPE_AGENT);
        hist[tid] = (int)base; }
    __syncthreads();
    if (tid < 32) { int run = hist[tid];
        for (int i = 0; i < nasg; ++i) if (ble[i] == tid) { const int tr = i >> 1; const size_t m = (size_t)(bid + G * (tr >> 4)) * 16 + (tr & 15);
            list[(size_t)tid * 65536 + run] = (int)m; tok_p[2 * m + (i & 1)] = run; ++run; } }
    __syncthreads();
}

constexpr int MOE_LDS = 131072;
__device__ __forceinline__ int moe_prefix(const unsigned* cnt, LAS int* pblk, int tid) {
    if (tid == 0) { int acc = 0; for (int e = 0; e < NE; ++e) { pblk[e] = acc; acc += ((int)cnt[e] + 255) >> 8; } pblk[NE] = acc; }
    __syncthreads();
    return pblk[NE];
}
template <int NJ> __device__ __forceinline__ int moe_table(const unsigned* cnt, LAS int* pblk, LAS int* tab, LAS int* aux, int NB, int G, int bid, int tid) {
    const int NU = NB * NJ;
    if (tid < 16) { const int L = bid + G * tid;
        if (L < NU) { const int rb = L / NJ, j = L % NJ; int e = 0; for (int q = 1; q < NE; ++q) if (pblk[q] <= rb) e = q;
            tab[tid] = rb; tab[16 + tid] = NJ * e + j; aux[tid * 3] = e; aux[tid * 3 + 1] = (rb - pblk[e]) * 256; aux[tid * 3 + 2] = (int)cnt[e]; } }
    __syncthreads();
    int n = 0; for (int i = 0; i < 16; ++i) if (bid + G * i < NU) n = i + 1;
    return n;
}

template <bool FINAL>
__device__ __forceinline__ void phase_combine_ln(const float* dbg, const bf16_t* x1b, const bf16_t* Yr, const int* tok_e, const int* tok_p, const float* tok_g, const unsigned* cnt,
                                                 const float* g, const float* bb, bf16_t* xo, unsigned char* xq, float* fo, LAS unsigned char* lds, int G, int bid, int tid) {
    LAS int* pblk = (LAS int*)lds;
    moe_prefix(cnt, pblk, tid);
    const int wid = __builtin_amdgcn_readfirstlane(tid >> 6), lane = tid & 63;
    float ALPHA = 1.4142135623730951f; asm volatile("" : "+v"(ALPHA));
#if DBG_CHECK
    const bool dbg_bad = FINAL && (!(dbg[0] <= DBG_TOL * DBG_TOL * dbg[1]) || !(dbg[2] <= DBG_TOL * DBG_TOL * dbg[3]) || !(dbg[1] > 0.f) || !(dbg[3] > 0.f) ||
                                    !(dbg[4] <= DBG_TOL * DBG_TOL * dbg[5]) || !(dbg[6] <= DBG_TOL * DBG_TOL * dbg[7]) || !(dbg[5] > 0.f) || !(dbg[7] > 0.f) ||
                                    !(dbg[8] <= DBG_TOL_SP * DBG_TOL_SP * dbg[9]) || !(dbg[10] <= DBG_TOL_SP * DBG_TOL_SP * dbg[11]) || !(dbg[9] > 0.f) || !(dbg[11] > 0.f));
#endif
    static_assert(F8_YR, "the pipelined combine reads e4m3 expert rows");
    struct Meta { size_t p0, p1; float h0, h1; };
    struct Rows { u32x4 xa[4]; u32x2 ya[4], yb[4]; };
#define CMB_META(mm, M) do { const int _e0 = tok_e[2 * (mm)], _e1 = tok_e[2 * (mm) + 1]; (M).p0 = (size_t)pblk[_e0] * 256 + tok_p[2 * (mm)]; (M).p1 = (size_t)pblk[_e1] * 256 + tok_p[2 * (mm) + 1]; \
        (M).h0 = tok_g[2 * (mm)] * (1.0f / 16.0f); (M).h1 = tok_g[2 * (mm) + 1] * (1.0f / 16.0f); } while (0)
#define CMB_ROWS(mm, M, R) do { _Pragma("unroll") for (int i = 0; i < 4; ++i) { const int col = 8 * lane + 512 * i; (R).xa[i] = *(const u32x4*)(x1b + (size_t)(mm) * DM + col); \
        (R).ya[i] = *(const u32x2*)((const unsigned char*)Yr + (M).p0 * DM + col); (R).yb[i] = *(const u32x2*)((const unsigned char*)Yr + (M).p1 * DM + col); } } while (0)
    const int mstep = G * 8, m0 = bid * 8 + wid;
    Meta Mc, Mn; Rows Rc, Rn;
    Mc.p0 = Mc.p1 = 0; Mc.h0 = Mc.h1 = 0.f; Mn = Mc;
    if (m0 < T_) { CMB_META(m0, Mc); CMB_ROWS(m0, Mc, Rc); }
    if (m0 + mstep < T_) CMB_META(m0 + mstep, Mn);
    Rn = Rc;
    for (int m = m0; m < T_; m += mstep) {
        Meta Mnn = Mn;
        if (m + mstep < T_) CMB_ROWS(m + mstep, Mn, Rn);
        if (m + 2 * mstep < T_) CMB_META(m + 2 * mstep, Mnn);
        const float h0 = Mc.h0, h1 = Mc.h1;
        float v[32]; float s = 0.f;
#pragma unroll
        for (int i = 0; i < 4; ++i) {
            const unsigned xw[4] = {Rc.xa[i].x, Rc.xa[i].y, Rc.xa[i].z, Rc.xa[i].w}; const unsigned aw[2] = {Rc.ya[i].x, Rc.ya[i].y}, bw[2] = {Rc.yb[i].x, Rc.yb[i].y};
#define CMB_PAIR(j, W, SEL) do { const f32x2 a2 = __builtin_amdgcn_cvt_pk_f32_fp8((int)aw[W], SEL), b2 = __builtin_amdgcn_cvt_pk_f32_fp8((int)bw[W], SEL); \
                    v[i * 8 + 2 * (j)] = ALPHA * bflo(xw[j]) + h0 * a2[0] + h1 * b2[0]; v[i * 8 + 2 * (j) + 1] = ALPHA * bfhi(xw[j]) + h0 * a2[1] + h1 * b2[1]; \
                    s += v[i * 8 + 2 * (j)] + v[i * 8 + 2 * (j) + 1]; } while (0)
            CMB_PAIR(0, 0, false); CMB_PAIR(1, 0, true); CMB_PAIR(2, 1, false); CMB_PAIR(3, 1, true);
#undef CMB_PAIR
        }
        Mc = Mn; Mn = Mnn; Rc = Rn;
        const float mean = wave_sum(s) * (1.0f / DM); float q = 0.f;
#pragma unroll
        for (int i = 0; i < 32; ++i) { const float d = v[i] - mean; q += d * d; }
        const float rstd = rsqrtf(wave_sum(q) * (1.0f / DM) + 1e-5f);
#pragma unroll
        for (int i = 0; i < 4; ++i) { const int col = 8 * lane + 512 * i;
            const f32x4 ga = *(const f32x4*)(g + col), gb = *(const f32x4*)(g + col + 4), ba = *(const f32x4*)(bb + col), bbv = *(const f32x4*)(bb + col + 4);
            float y[8];
#pragma unroll
            for (int j = 0; j < 4; ++j) { y[j] = (v[i * 8 + j] - mean) * rstd * ga[j] + ba[j]; y[4 + j] = (v[i * 8 + 4 + j] - mean) * rstd * gb[j] + bbv[j]; }
#if DBG_CHECK
            if (dbg_bad) { for (int j = 0; j < 8; ++j) y[j] = 0.f; }
#endif
            if constexpr (FINAL) { *(f32x4*)(fo + (size_t)m * DM + col) = (f32x4){y[0], y[1], y[2], y[3]}; *(f32x4*)(fo + (size_t)m * DM + col + 4) = (f32x4){y[4], y[5], y[6], y[7]}; }
            else { *(u32x4*)(xo + (size_t)m * DM + col) = (u32x4){cvtpk(y[0], y[1]), cvtpk(y[2], y[3]), cvtpk(y[4], y[5]), cvtpk(y[6], y[7])};
                if constexpr (F8_IN) *(u32x2*)(xq + (size_t)m * DM + col) = (u32x2){pk4_fp8(y[0], y[1], y[2], y[3]), pk4_fp8(y[4], y[5], y[6], y[7])}; } }
    }
#undef CMB_META
#undef CMB_ROWS
}

#if DBG_CHECK
__device__ __forceinline__ void dbg_attn_check(int which, const bf16_t* Hx, const bf16_t* Qd, const bf16_t* KVd, const bf16_t* krope, const void* Oat, float* dbg, LAS unsigned char* lds, int bid, int tid) {
    const int wid = __builtin_amdgcn_readfirstlane(tid >> 6), lane = tid & 63;
    LAS float* sc = (LAS float*)lds + wid * 4096;
    LAS float* qs = (LAS float*)(lds + 131072) + wid * 192;
    const unsigned sid = (unsigned)(bid * 8 + wid);
    const int m = (int)((sid * 2654435761u) % (unsigned)T_), h = (int)(sid & 7u), b = m >> 12, pos = m & (SEQ - 1);
    const int DQ = which ? 192 : 128; const float scale = which ? 0.072168783648703220f : 0.088388347648318440f;
    for (int d = lane; d < DQ; d += 64) {
        float qv;
        if (which == 0) qv = bf2f(Hx[(size_t)m * IN0 + h * 128 + d]);
        else if (d < 128) qv = bf2f(Qd[(size_t)m * 1536 + h * 192 + d]);
        else { const int i = (d - 128) & 31; const float x1 = bf2f(Qd[(size_t)m * 1536 + h * 192 + 128 + i]), x2 = bf2f(Qd[(size_t)m * 1536 + h * 192 + 160 + i]);
            float sn, cs; sincos_rev((float)pos * inv_freq32(i), sn, cs); qv = (d < 160) ? (x1 * cs - x2 * sn) : (x2 * cs + x1 * sn); }
        qs[d] = qv; }
    asm volatile("s_waitcnt lgkmcnt(0)" ::: "memory");
    float mx = -INFINITY;
    for (int i = 0; i < 64; ++i) { const int j = lane + 64 * i; float dot = 0.f;
        if (which == 0) { const bf16_t* kp = Hx + (size_t)(b * SEQ + j) * IN0 + 1024 + (h >> 2) * 128; for (int d = 0; d < 128; ++d) dot += qs[d] * bf2f(kp[d]); }
        else { const bf16_t* kp = KVd + (size_t)(b * SEQ + j) * DM + h * 256; for (int d = 0; d < 128; ++d) dot += qs[d] * bf2f(kp[d]);
               const bf16_t* rp = krope + (size_t)(b * SEQ + j) * 64; for (int d = 0; d < 64; ++d) dot += qs[128 + d] * bf2f(rp[d]); }
        dot *= scale; sc[j] = dot; mx = fmaxf(mx, dot); }
    mx = wave_max(mx);
    float sum = 0.f;
    for (int i = 0; i < 64; ++i) { const int j = lane + 64 * i; const float pj = __expf(sc[j] - mx); sc[j] = pj; sum += pj; }
    sum = wave_sum(sum);
    asm volatile("s_waitcnt lgkmcnt(0)" ::: "memory");
    float e2 = 0.f, r2 = 0.f;
    for (int cc = 0; cc < 2; ++cc) { const int c = lane + 64 * cc; float acc = 0.f;
        for (int j = 0; j < SEQ; ++j) { const float vv = which == 0 ? bf2f(Hx[(size_t)(b * SEQ + j) * IN0 + 1280 + (h >> 2) * 128 + c]) : bf2f(KVd[(size_t)(b * SEQ + j) * DM + h * 256 + 128 + c]); acc += sc[j] * vv; }
        const float ref = acc / sum; const size_t eo = (size_t)m * DM + (which ? 1024 : 0) + h * 128 + c;
        float got; if (F8_OUT) { const unsigned char by = ((const unsigned char*)Oat)[eo]; const f32x2 g2 = __builtin_amdgcn_cvt_pk_f32_fp8((int)by, false); got = g2[0] * (1.0f / O8_SCALE); } else got = bf2f(((const bf16_t*)Oat)[eo]);
        e2 += (got - ref) * (got - ref); r2 += ref * ref; }
    e2 = wave_sum(e2); r2 = wave_sum(r2);
    if (lane == 0) { atomicAdd(dbg + 2 * which, e2); atomicAdd(dbg + 2 * which + 1, r2); }
}
#endif
#if DBG_CHECK
__device__ __forceinline__ void dbg_sparse_check(int L, const bf16_t* Hx, const unsigned char* K8r, const unsigned char* V8r, const float* rpb, const void* Oat, float* dbg, LAS unsigned char* lds, int bid, int tid) {
    const int wid = __builtin_amdgcn_readfirstlane(tid >> 6), lane = tid & 63;
    LAS float* sc = (LAS float*)lds + wid * 1024; LAS int* kt = (LAS int*)(lds + 65536) + wid * 1024; LAS float* qs = (LAS float*)(lds + 131072) + wid * 128;
    const unsigned sid = (unsigned)(bid * 8 + wid);
    const int m = (int)((sid * 2654435761u + 12345u) % (unsigned)T_), h = (int)((sid >> 3) & 7u), b = m >> 12, pos = m & (SEQ - 1);
    const int ldh = L ? IN1P : IN0, qoff = L ? h * 128 : 1536 + h * 128;
    for (int d = lane; d < 128; d += 64) qs[d] = bf2f(Hx[(size_t)m * ldh + qoff + d]);
    int nk;
    if (L == 0) { nk = 387; const float slope = __builtin_amdgcn_exp2f(-(float)(h + 1));
        for (int idx = lane; idx < nk; idx += 64) { const int br = idx / 129, dd = idx % 129 - 64, dil = br == 0 ? 1 : (br == 1 ? 4 : 16), rd = pos % dil, kd = pos / dil + dd;
            const bool ok = kd >= 0 && kd < SEQ / dil; kt[idx] = ok ? b * SEQ + kd * dil + rd : -1; sc[idx] = -slope * (float)dil * (float)(dd < 0 ? -dd : dd); } }
    else { nk = 128; const int r = pos >> 6, qc = pos & 63, r0 = min(max(r - 4, 0), 56), c0 = min(max(qc - 8, 0), 48);
        for (int idx = lane; idx < nk; idx += 64) { const int kr = r0 + (idx >> 4), kc = c0 + (idx & 15); kt[idx] = b * SEQ + kr * 64 + kc; sc[idx] = rpb[h * 465 + (kr - r + 7) * 31 + (kc - qc + 15)]; } }
    asm volatile("s_waitcnt lgkmcnt(0)" ::: "memory");
    float mx = -INFINITY;
    for (int idx = lane; idx < nk; idx += 64) { float sv = -INFINITY; const int t = kt[idx];
        if (t >= 0) { const unsigned char* kp = K8r + (size_t)t * 1024 + h * 128; float dot = 0.f;
            for (int d = 0; d < 128; ++d) { const f32x2 kv = __builtin_amdgcn_cvt_pk_f32_fp8((int)kp[d], false); dot += qs[d] * kv[0]; }
            sv = dot * 0.088388347648318440f + sc[idx]; }
        sc[idx] = sv; mx = fmaxf(mx, sv); }
    mx = wave_max(mx);
    float sum = 0.f;
    for (int idx = lane; idx < nk; idx += 64) { const float pj = __expf(sc[idx] - mx); sc[idx] = pj; sum += pj; }
    sum = wave_sum(sum);
    asm volatile("s_waitcnt lgkmcnt(0)" ::: "memory");
    float e2 = 0.f, r2 = 0.f;
    for (int cc = 0; cc < 2; ++cc) { const int c = lane + 64 * cc; float acc = 0.f;
        for (int idx = 0; idx < nk; ++idx) { const int t = kt[idx]; if (t >= 0) { const f32x2 vv = __builtin_amdgcn_cvt_pk_f32_fp8((int)V8r[(size_t)t * 1024 + h * 128 + c], false); acc += sc[idx] * vv[0]; } }
        const float ref = acc / sum; const size_t eo = (size_t)m * DM + (L ? 0 : 1024) + h * 128 + c;
        float got; if (F8_OUT) { const unsigned char by = ((const unsigned char*)Oat)[eo]; const f32x2 g2 = __builtin_amdgcn_cvt_pk_f32_fp8((int)by, false); got = g2[0] * (1.0f / O8_SCALE); } else got = bf2f(((const bf16_t*)Oat)[eo]);
        e2 += (got - ref) * (got - ref); r2 += ref * ref; }
    e2 = wave_sum(e2); r2 = wave_sum(r2);
    if (lane == 0) { atomicAdd(dbg + 8 + 2 * L, e2); atomicAdd(dbg + 9 + 2 * L, r2); }
}
#endif
#if DBG_CHECK
__device__ __forceinline__ void dbg_prep_check(int L, const float* xf, const bf16_t* xb2, const float* win, const float* gq, const float* gk, const bf16_t* H, const bf16_t* krope, float* dbg, LAS unsigned char* lds, int bid, int tid) {
    const int wid = __builtin_amdgcn_readfirstlane(tid >> 6), lane = tid & 63;
    const unsigned sid = (unsigned)(bid * 8 + wid);
    const int m = (int)((sid * 2246822519u) % (unsigned)T_); const int sq = m & (SEQ - 1);
    float e2 = 0.f, r2 = 0.f;
    if (L == 0) {
        const int hh = (int)(sid % 10u); const int colbase = hh < 8 ? hh * 128 : 1024 + (hh - 8) * 128; const float* gain = hh < 8 ? gq : gk;
        float a0 = 0.f, a1 = 0.f;
        for (int k = 0; k < DM; ++k) { const float xv = xf[(size_t)m * DM + k]; a0 += xv * win[(size_t)k * IN0 + colbase + lane]; a1 += xv * win[(size_t)k * IN0 + colbase + 64 + lane]; }
        const float ms = wave_sum(a0 * a0 + a1 * a1) * (1.0f / 128.0f); const float r = rsqrtf(ms + 1e-6f);
        const float y0 = a0 * r * gain[lane], y1 = a1 * r * gain[64 + lane];
        LAS float* ys = (LAS float*)lds + wid * 128; ys[lane] = y0; ys[64 + lane] = y1; asm volatile("s_waitcnt lgkmcnt(0)" ::: "memory");
#pragma unroll
        for (int q = 0; q < 2; ++q) { const int e = lane + 64 * q, hf = e >> 6, i = e & 31; const bool x2p = (e & 32) != 0;
            const float pos = (float)(hf ? (sq & 63) : (sq >> 6)); float sn, cs; sincos_rev(pos * inv_freq32(i), sn, cs);
            const float mine = ys[e], other = ys[e ^ 32];
            const float ref = x2p ? (mine * cs + other * sn) : (mine * cs - other * sn);
            const float got = bf2f(H[(size_t)m * IN0 + colbase + e]);
            e2 += (got - ref) * (got - ref); r2 += ref * ref; }
    } else {
        float acq[8] = {0.f, 0.f, 0.f, 0.f, 0.f, 0.f, 0.f, 0.f}; float akr = 0.f;
        for (int k = 0; k < DM; ++k) { const float xv = bf2f(xb2[(size_t)m * DM + k]); const float* wr = win + (size_t)k * IN1;
#pragma unroll
            for (int j = 0; j < 8; ++j) acq[j] += xv * wr[3072 + lane + 64 * j];
            akr += xv * wr[3840 + lane]; }
        float ss = 0.f;
#pragma unroll
        for (int j = 0; j < 8; ++j) ss += acq[j] * acq[j];
        const float r = rsqrtf(wave_sum(ss) * (1.0f / 512.0f) + 1e-6f);
#pragma unroll
        for (int j = 0; j < 8; ++j) { const float ref = acq[j] * r; float got; if (F8_P3) { const f32x2 g2 = __builtin_amdgcn_cvt_pk_f32_fp8((int)((const unsigned char*)(H + (size_t)m * IN1P + 3072))[lane + 64 * j], false); got = g2[0]; } else got = bf2f(H[(size_t)m * IN1P + 3072 + lane + 64 * j]);
            e2 += (got - ref) * (got - ref); r2 += ref * ref; }
        LAS float* ys = (LAS float*)lds + wid * 128; ys[lane] = akr; asm volatile("s_waitcnt lgkmcnt(0)" ::: "memory");
        { const int i = lane & 31; float sn, cs; sincos_rev((float)sq * inv_freq32(i), sn, cs); const float mine = ys[lane], other = ys[lane ^ 32];
          const float ref = (lane & 32) ? (mine * cs + other * sn) : (mine * cs - other * sn); const float got = bf2f(krope[(size_t)m * 64 + lane]);
          e2 += (got - ref) * (got - ref); r2 += ref * ref; }
    }
    e2 = wave_sum(e2); r2 = wave_sum(r2);
    if (lane == 0) { atomicAdd(dbg + 4 + 2 * L, e2); atomicAdd(dbg + 5 + 2 * L, r2); }
}
#endif
#ifndef ATT_ONLY
#define ATT_ONLY -1
#endif
#ifndef REP_K
#define REP_K -1
#endif
#ifndef REP_NULL
#define REP_NULL -1
#endif
#ifndef ABL_ATT
#define ABL_ATT -1
#endif
#ifndef REP_ATT
#define REP_ATT -1
#endif
#define NREP(k) ((REP_K == (k)) ? 2 : 1)
#define NREPA(k) ((REP_ATT == (k)) ? 2 : 1)
constexpr int N_PHASES = 20;
__global__ void __launch_bounds__(NTHR, 2) fwd(Params p) {
    extern __shared__ __attribute__((aligned(16))) unsigned char lds_raw[];
    LAS unsigned char* lds = (LAS unsigned char*)lds_raw;
    const int tid0 = threadIdx.x, bid = blockIdx.x, G = gridDim.x;
    const int wv = __builtin_amdgcn_readfirstlane(tid0 >> 6);
    const int vcu = (G % 8 == 0) ? (bid % 8) * (G / 8) + bid / 8 : bid;
    unsigned* ctl = (unsigned*)(p.ws + WS_CTL);
    if (tid0 < 4) ((LAS unsigned*)(lds + MISC_OFF))[tid0] = 0u;
    __syncthreads();
    XcdBarrier bar; bar.bar = ctl + CW_BAR; bar.x = 0; bar.st = (volatile LAS unsigned*)(lds + MISC_OFF);
    if (N_LAUNCH_MODE == 1) bar = xcd_barrier_post(ctl + CW_BAR, (volatile LAS unsigned*)(lds + MISC_OFF));
    const int lo = p.ph_lo, hi = p.ph_hi;
#ifndef PH_ONLY
#define PH_ONLY -1
#endif
#define IN(k) ((PH_ONLY < 0 || (PH_ONLY % 10) == ((k) % 10)) && lo <= (k) && (k) < hi)
#define SEAM(k) do { if ((k) + 1 < hi) xcd_barrier(bar, fresh_tid(wv)); } while (0)

    for (int L = 0; L < 2; ++L) {
        const int pb = L * 10;
        typedef __attribute__((address_space(1))) unsigned char gu8;
        typedef __attribute__((address_space(1))) const float gcf;
        typedef __attribute__((address_space(4))) const unsigned long long kcu64;
#define INP(i) ((const float*)(gcf*)ka[i])
#define PHASE_PTRS \
        kcu64* ka = (kcu64*)__builtin_amdgcn_kernarg_segment_ptr(); asm volatile("" : "+s"(ka)); \
        unsigned char* ws = (unsigned char*)(gu8*)ka[29]; unsigned char* outb = (unsigned char*)(gu8*)ka[28]; \
        unsigned* ctl = (unsigned*)(ws + WS_CTL); \
        bf16_t* RA = (bf16_t*)(ws + WS_RA); bf16_t* RB = (bf16_t*)(ws + WS_RB); bf16_t* RC = (bf16_t*)(ws + WS_RC); \
        int* list = (int*)(ws + WS_LIST); int* tok_e = (int*)(ws + WS_TOKE); int* tok_p = (int*)(ws + WS_TOKP); float* tok_g = (float*)(ws + WS_TOKG); \
        bf16_t* krope = (bf16_t*)(ws + WS_KROPE); \
        bf16_t* Qd = (bf16_t*)(outb + OUT_QD); bf16_t* O1 = (bf16_t*)(outb + OUT_O1); \
        const bf16_t* Win = (const bf16_t*)(ws + (L ? WS_WIN1 : WS_WIN0)); const bf16_t* Wout = (const bf16_t*)(ws + (L ? WS_WOUT1 : WS_WOUT0)); \
        const bf16_t* Wgu = (const bf16_t*)(ws + (L ? WS_WGU1 : WS_WGU0)); const bf16_t* Wd = (const bf16_t*)(ws + (L ? WS_WD1 : WS_WD0)); \
        const int NIN = L ? IN1P : IN0; \
        const bf16_t* xin = L ? RC : RA; \
        bf16_t* Hx = RB; bf16_t* Oat = L ? O1 : RC; float* Z = (float*)RB; \
        bf16_t* x1b = RA; bf16_t* Hm = RC; bf16_t* Yr = RB; \
        unsigned* cnt = ctl + CW_CNT + L * 64; \
        (void)ctl; (void)RA; (void)RB; (void)RC; (void)list; (void)tok_e; (void)tok_p; (void)tok_g; (void)krope; (void)Qd; (void)O1; (void)Win; (void)Wout; (void)Wgu; (void)Wd; (void)NIN; (void)xin; (void)Hx; (void)Oat; (void)Z; (void)x1b; (void)Hm; (void)Yr; (void)cnt; (void)outb

        if (L == 0 && IN(0)) { PHASE_PTRS; _Pragma("unroll 1") for (int rep = 0; rep < NREP(0); ++rep) phase_prologue(ka, ws, lds, G, bid, fresh_tid(wv)); SEAM(0); }

        if (IN(pb + 1)) {
            PHASE_PTRS;
            constexpr int KI = F8_IN ? 1024 : 2048;
            const bf16_t* ain = F8_IN ? (L ? (const bf16_t*)outb : (const bf16_t*)((unsigned char*)RC + 64 * MiB)) : xin;
            pg8::Gemm g{ain, Win, KI, KI, KI}; pg8::StaticOrder S; S.init(T_, NIN, G, bid, KI);
            pg8::EpiIn E{Hx, NIN, L ? ws + WS_WGU0 + 64 * MiB : (unsigned char*)RA, L ? ws + WS_WD0 + 32 * MiB : ws + WS_WGU1 + 64 * MiB, F8_SPARSE ? (L ? 4 : 10) : 99, F8_SPARSE ? (L ? 8 : 14) : 99, F8_SPARSE ? (L ? 12 : 18) : 99};
            _Pragma("unroll 1") for (int rep = 0; rep < NREP(1); ++rep) pg8::gemm_phase<F8_IN != 0>(wv, lds, g, S, E, F8_IN ? 1.0f / W8_SCALE : 1.0f);
#if REP_NULL == 1
            { pg8::EpiNull EN{(float*)(ctl + CW_DBG + 32)}; pg8::gemm_phase<F8_IN != 0>(wv, lds, g, S, EN, 1.0f / W8_SCALE); }
#endif
            SEAM(pb + 1);
        }
        if (IN(pb + 2)) {
            PHASE_PTRS;
            if (L == 0) { phase_prep_qk(Hx, INP(I_AQN), INP(I_AKN), ws + WS_WGU0 + 64 * MiB, G, bid, fresh_tid(wv));
                _Pragma("unroll 1") for (int rep = 0; rep < NREP(2); ++rep) {
                if (F8_ATTA) phase_vt8(Hx, ws + WS_WGU0 + 72 * MiB, lds, G, bid, fresh_tid(wv));
                if (F8_SPARSE) { unsigned char* ra8 = (unsigned char*)RA;
                    phase_vt_heads<true>(ws + WS_WGU1 + 64 * MiB, ra8 + 32 * MiB, ra8 + 64 * MiB, ra8 + 96 * MiB, lds, G, bid, fresh_tid(wv)); } } }
            else { phase_prep_mla(Hx, krope, ws + WS_WD1 + 32 * MiB, G, bid, fresh_tid(wv));
                if (F8_SPARSE) { unsigned char* c8 = ws + WS_WGU0 + 64 * MiB;
                    _Pragma("unroll 1") for (int rep = 0; rep < NREP(2); ++rep) phase_vt_heads<false>(ws + WS_WD0 + 32 * MiB, c8 + 32 * MiB, nullptr, nullptr, lds, G, bid, fresh_tid(wv)); } }
#if DBG_CHECK
            xcd_barrier(bar, fresh_tid(wv));
            dbg_prep_check(L, INP(I_X), RC, INP(L ? I_WIN1 : I_WIN0), INP(I_AQN), INP(I_AKN), Hx, krope, (float*)(ctl + CW_DBG), lds, bid, fresh_tid(wv));
            __syncthreads();
#endif
            SEAM(pb + 2);
        }
        if (L == 1 && IN(pb + 3)) _Pragma("unroll 1") for (int rep = 0; rep < NREP(3); ++rep) {
            PHASE_PTRS;
#ifndef P3_ONLY
#define P3_ONLY -1
#endif
            if (P3_ONLY < 0 || P3_ONLY == 0) { constexpr int KQ = F8_P3 ? 256 : 512; pg8::Gemm g{Hx + 3072, (const bf16_t*)(ws + WS_WQUP), KQ, IN1P, KQ}; pg8::StaticOrder S; S.init(T_, 1536, G, bid, IN1P);
              pg8::EpiBf16 E{Qd, 1536, 0xffff}; pg8::gemm_phase<F8_P3 != 0>(wv, lds, g, S, E, F8_P3 ? 1.0f / W8_SCALE : 1.0f); }
            if (P3_ONLY < 0 || P3_ONLY == 1) { constexpr int KV = F8_P3 ? 128 : 256; pg8::Gemm g{Hx + 3584, (const bf16_t*)(ws + WS_WKVUP), KV, IN1P, KV}; pg8::StaticOrder S; S.init(T_, 2048, G, bid, IN1P);
              if constexpr (F8_ATTD) { pg8::EpiKV8 E{ws + WS_WGU1 + 64 * MiB, ws + WS_WGU1 + 96 * MiB, RA, DBG_CHECK != 0}; pg8::gemm_phase<F8_P3 != 0>(wv, lds, g, S, E, F8_P3 ? 1.0f / W8_SCALE : 1.0f); }
              else { pg8::EpiBf16 E{RA, 2048, 0xffff}; pg8::gemm_phase<false>(wv, lds, g, S, E); } }
            if (rep + 1 == NREP(3)) SEAM(pb + 3);
        }
        if (IN(pb + 4)) {
            PHASE_PTRS;
            if (L == 0) {
                if (ATT_ONLY < 0 || ATT_ONLY == 0)
                _Pragma("unroll 1") for (int rep = 0; rep < NREPA(0); ++rep)
                for (int u = vcu; u < 1024; u += G) {
                    __syncthreads();
                    const int b = u >> 7, qb = u & 15, kvh = (u >> 6) & 1, gq = (u >> 4) & 3, h = kvh * 4 + gq;
                    if constexpr (F8_ATTA) {
                        d8::D8Args a; a.Q = Hx + (size_t)(b * SEQ + 256 * qb) * IN0 + h * 128; a.ldq = IN0;
                        a.K8 = ws + WS_WGU0 + 64 * MiB + (size_t)b * SEQ * 256 + kvh * 128; a.ldk = 256; a.Kr8 = nullptr;
                        a.Vt8 = ws + WS_WGU0 + 72 * MiB + (size_t)(b * 2 + kvh) * 128 * SEQ; a.ldvt = SEQ;
                        { const size_t eo = (size_t)(b * SEQ + 256 * qb) * DM + h * 128; a.O = F8_OUT ? (bf16_t*)((unsigned char*)Oat + eo) : Oat + eo; } a.ldo = DM; a.seq = SEQ; a.pos0 = 0;
                        if (D8_DMA_A) d8::attn_dense8_dma<2, true>(wv, a, lds); else d8::attn_dense8_body<2>(wv, a, (char*)lds_raw);
                    } else {
                    da::DArgs a; a.Q = Hx + (size_t)(b * SEQ + 256 * qb) * IN0 + h * 128; a.ldq = IN0;
                    a.K = Hx + (size_t)b * SEQ * IN0 + 1024 + kvh * 128; a.ldk = IN0; a.V = Hx + (size_t)b * SEQ * IN0 + 1280 + kvh * 128; a.ldv = IN0; a.Kr = nullptr;
                    { const size_t eo = (size_t)(b * SEQ + 256 * qb) * DM + h * 128; a.O = F8_OUT ? (bf16_t*)((unsigned char*)Oat + eo) : Oat + eo; } a.ldo = DM; a.seq = SEQ; a.pos0 = 0;
                    da::attn_dense_body<8, 1>(wv, a, (char*)lds_raw);
                    }
                }
                __syncthreads();
                if (ATT_ONLY < 0 || ATT_ONLY == 2)
                _Pragma("unroll 1") for (int rep = 0; rep < NREPA(2); ++rep)
                for (int it = vcu; it < 1024; it += G) {
                    const int tid2 = fresh_tid(wv), wid = __builtin_amdgcn_readfirstlane(tid2 >> 6), lane = tid2 & 63;
                    const int w = it * 8 + wid; LAS unsigned char* wl = lds + wid * da::SP_WAVE_LDS;
                    if constexpr (F8_SPARSE) { const unsigned char* ra8 = (const unsigned char*)RA; PolB8 pol; pol.init(Hx, Oat, ra8, ra8 + 32 * MiB, ra8 + 64 * MiB, ra8 + 96 * MiB, w, lane); d8::sparse8_wave(pol, wl, lane); }
                    else { PolB pol; pol.init(Hx, Oat, w, lane); da::sparse_wave(pol, wl, lane); }
                }
            } else {
                if (ATT_ONLY < 0 || ATT_ONLY == 1)
                _Pragma("unroll 1") for (int rep = 0; rep < NREPA(1); ++rep)
                for (int u = vcu; u < 1024; u += G) {
                    __syncthreads();
                    const int b = u >> 7, qb = u & 15, h = (u >> 4) & 7;
                    if constexpr (F8_ATTD) {
                        d8::D8Args a; a.Q = Qd + (size_t)(b * SEQ + 256 * qb) * 1536 + h * 192; a.ldq = 1536;
                        a.K8 = ws + WS_WGU1 + 64 * MiB + (size_t)b * SEQ * 1024 + h * 128; a.ldk = 1024; a.Kr8 = ws + WS_WD1 + 32 * MiB + (size_t)b * SEQ * 64;
                        a.Vt8 = ws + WS_WGU1 + 96 * MiB + (size_t)(b * 8 + h) * 128 * SEQ; a.ldvt = SEQ;
                        { const size_t eo = (size_t)(b * SEQ + 256 * qb) * DM + 1024 + h * 128; a.O = F8_OUT ? (bf16_t*)((unsigned char*)Oat + eo) : Oat + eo; } a.ldo = DM; a.seq = SEQ; a.pos0 = 256 * qb;
                        if (D8_DMA_D) d8::attn_dense8_dma<3, D8_MACC_D != 0>(wv, a, lds); else d8::attn_dense8_body<3>(wv, a, (char*)lds_raw);
                    } else {
                    da::DArgs a; a.Q = Qd + (size_t)(b * SEQ + 256 * qb) * 1536 + h * 192; a.ldq = 1536;
                    a.K = RA + (size_t)b * SEQ * DM + h * 256; a.ldk = DM; a.V = a.K + 128; a.ldv = DM; a.Kr = krope + (size_t)b * SEQ * 64;
                    { const size_t eo = (size_t)(b * SEQ + 256 * qb) * DM + 1024 + h * 128; a.O = F8_OUT ? (bf16_t*)((unsigned char*)Oat + eo) : Oat + eo; } a.ldo = DM; a.seq = SEQ; a.pos0 = 256 * qb;
                    da::attn_dense_body<12, 1>(wv, a, (char*)lds_raw);
                    }
                }
                __syncthreads();
                if (ATT_ONLY < 0 || ATT_ONLY == 3)
                _Pragma("unroll 1") for (int rep = 0; rep < NREPA(3); ++rep)
                for (int it = vcu; it < 1024; it += G) {
                    const int tid2 = fresh_tid(wv), wid = __builtin_amdgcn_readfirstlane(tid2 >> 6), lane = tid2 & 63;
                    const int w = it * 8 + wid; LAS unsigned char* wl = lds + wid * da::SP_WAVE_LDS;
                    if constexpr (F8_SPARSE) { const unsigned char* c8 = ws + WS_WGU0 + 64 * MiB; PolC8 pol; pol.init(Hx, Oat, c8, c8 + 32 * MiB, INP(I_RPB), (float*)((char*)wl + 16640), w, lane); d8::sparse8_wave(pol, wl, lane); }
                    else { PolC pol; pol.init(Hx, Oat, INP(I_RPB), (float*)((char*)wl + 16640), w, lane); da::sparse_wave(pol, wl, lane); }
                }
            }
#if DBG_CHECK
            xcd_barrier(bar, fresh_tid(wv));
            dbg_attn_check(L, Hx, Qd, RA, krope, Oat, (float*)(ctl + CW_DBG), lds, bid, fresh_tid(wv));
            __syncthreads();
            if (L == 0) dbg_sparse_check(0, Hx, (const unsigned char*)RA, ws + WS_WGU1 + 64 * MiB, INP(I_RPB), Oat, (float*)(ctl + CW_DBG), lds, bid, fresh_tid(wv));
            else dbg_sparse_check(1, Hx, ws + WS_WGU0 + 64 * MiB, ws + WS_WD0 + 32 * MiB, INP(I_RPB), Oat, (float*)(ctl + CW_DBG), lds, bid, fresh_tid(wv));
            __syncthreads();
#endif
            SEAM(pb + 4);
        }
        if (IN(pb + 5)) {
            PHASE_PTRS;
            constexpr int KO = F8_OUT ? 1024 : 2048;
            pg8::Gemm g{Oat, Wout, KO, KO, KO}; pg8::StaticOrder S; S.init(T_, DM, G, bid, KO);
            pg8::EpiBf16T<F8_MIX != 0> E{RB, DM, 0xffff};
            _Pragma("unroll 1") for (int rep = 0; rep < NREP(5); ++rep) pg8::gemm_phase<F8_OUT != 0>(wv, lds, g, S, E, F8_OUT ? 1.0f / (W8_SCALE * O8_SCALE) : 1.0f);
            SEAM(pb + 5);
        }
        if (IN(pb + 6)) {
            PHASE_PTRS;
            if (L == 0) { _Pragma("unroll 1") for (int rep = 0; rep < NREP(6); ++rep) phase_ln_router<true>(RB, INP(I_X), INP(I_LN1G0), INP(I_LN1B0), INP(I_RW), INP(I_RB), x1b, (unsigned char*)RC + 64 * MiB, tok_e, tok_p, tok_g, list, cnt, lds, G, bid, fresh_tid(wv), rep + 1 == NREP(6)); }
            else { _Pragma("unroll 1") for (int rep = 0; rep < NREP(6); ++rep) phase_ln_router<false>(RB, RC, INP(I_LN1G1), INP(I_LN1B1), INP(I_RW), INP(I_RB), x1b, outb  , tok_e, tok_p, tok_g, list, cnt, lds, G, bid, fresh_tid(wv), rep + 1 == NREP(6)); }
            SEAM(pb + 6);
        }
        if (IN(pb + 7)) {
            PHASE_PTRS;
            LAS int* pblk = (LAS int*)(lds + MOE_LDS); LAS int* tab = pblk + 64; LAS int* aux = tab + 32; LAS int* idx = aux + 64;
            const int tid = fresh_tid(wv);
            const int NB = moe_prefix(cnt, pblk, tid);
            const int n = moe_table<4>(cnt, pblk, tab, aux, NB, G, vcu, tid);
            for (int i = 0; i < n; ++i) if (tid < 256) { const int e = aux[i * 3], rs = aux[i * 3 + 1], ce = aux[i * 3 + 2]; idx[i * 256 + tid] = list[(size_t)e * 65536 + min(rs + tid, ce - 1)]; }
            __syncthreads();
            constexpr int KG = F8_GU ? 1024 : 2048;
            const bf16_t* agu = F8_GU ? (L ? (const bf16_t*)outb : (const bf16_t*)((unsigned char*)RC + 64 * MiB)) : x1b;
            pg8::Gemm g{agu, Wgu, KG, KG, KG}; pg8::TableOrder<true> S{tab, idx, n, KG}; pg8::EpiSiluMul<F8_DOWN != 0> E{Hm};
            _Pragma("unroll 1") for (int rep = 0; rep < NREP(7); ++rep) pg8::gemm_phase<F8_GU != 0>(wv, lds, g, S, E, F8_GU ? 1.0f / W8_SCALE : 1.0f);
            SEAM(pb + 7);
        }
        if (IN(pb + 8)) {
            PHASE_PTRS;
            LAS int* pblk = (LAS int*)(lds + MOE_LDS); LAS int* tab = pblk + 64; LAS int* aux = tab + 32;
            const int tid = fresh_tid(wv);
            const int NB = moe_prefix(cnt, pblk, tid);
            const int n = moe_table<8>(cnt, pblk, tab, aux, NB, G, vcu, tid);
            constexpr int KD = F8_DOWN ? 256 : 512;
            pg8::Gemm g{Hm, Wd, KD, KD, KD}; pg8::TableOrder<false> S{tab, nullptr, n, KD}; pg8::EpiBf16T<F8_YR != 0> E{Yr, DM, 7};
            _Pragma("unroll 1") for (int rep = 0; rep < NREP(8); ++rep) pg8::gemm_phase<F8_DOWN != 0>(wv, lds, g, S, E, F8_DOWN ? 1.0f / W8_SCALE : 1.0f);
            SEAM(pb + 8);
        }
        if (IN(pb + 9)) _Pragma("unroll 1") for (int rep = 0; rep < NREP(9); ++rep) {
            PHASE_PTRS;
            if (L == 0) phase_combine_ln<false>((const float*)(ctl + CW_DBG), x1b, Yr, tok_e, tok_p, tok_g, cnt, INP(I_LN2G0), INP(I_LN2B0), RC, outb, nullptr, lds, G, bid, fresh_tid(wv));
            else phase_combine_ln<true>((const float*)(ctl + CW_DBG), x1b, Yr, tok_e, tok_p, tok_g, cnt, INP(I_LN2G1), INP(I_LN2B1), nullptr, nullptr, (float*)outb, lds, G, bid, fresh_tid(wv));
            if (rep + 1 == NREP(9)) SEAM(pb + 9);
        }
    }
#undef IN
#undef SEAM
#undef INP
#undef PHASE_PTRS
}

extern "C" void kernel_launch(void* const* d_in, const int* in_sizes, int n_in, void* d_out, int out_size, void* d_ws, size_t ws_size, hipStream_t stream) {
    static int grid = 0;
    if (grid == 0) {
        if (n_in != 28 || out_size != T_ * DM || ws_size < WS_END) { fprintf(stderr, "kernel_launch: unexpected shapes: n_in %d out %d ws %zu (need %zu)\n", n_in, out_size, ws_size, (size_t)WS_END); grid = -1; return; }
        int dev = 0, cus = 0, per_cu = 0;
        if (hipGetDevice(&dev) != hipSuccess || hipDeviceGetAttribute(&cus, hipDeviceAttributeMultiprocessorCount, dev) != hipSuccess) { grid = -1; return; }
        if (hipFuncSetAttribute((const void*)fwd, hipFuncAttributeMaxDynamicSharedMemorySize, LDS_BYTES) != hipSuccess) { fprintf(stderr, "kernel_launch: hipFuncSetAttribute failed\n"); grid = -1; return; }
        if (hipOccupancyMaxActiveBlocksPerMultiprocessor(&per_cu, (const void*)fwd, NTHR, LDS_BYTES) != hipSuccess || per_cu < 1)
            fprintf(stderr, "kernel_launch: occupancy query reports %d workgroups per CU\n", per_cu);
        (void)hipGetLastError();
        grid = cus;
    }
    if (grid < 0) return;
    (void)hipMemsetAsync((char*)d_ws + WS_CTL, 0, CTL_ZERO_BYTES, stream);
    Params p{};
    for (int i = 0; i < 28; ++i) p.in[i] = (const float*)d_in[i];
    p.out = (float*)d_out; p.ws = (unsigned char*)d_ws;
#if N_LAUNCH_MODE == 1
    p.ph_lo = 0; p.ph_hi = N_PHASES;
    hipLaunchKernelGGL(fwd, dim3(grid), dim3(NTHR), LDS_BYTES, stream, p);
#else
    for (int k = 0; k < N_PHASES; ++k) { if (k == 3 || k == 10) continue; p.ph_lo = k; p.ph_hi = k + 1;
        hipLaunchKernelGGL(fwd, dim3(grid), dim3(NTHR), LDS_BYTES, stream, p); }
#endif
    const hipError_t le = hipPeekAtLastError();
    if (le != hipSuccess) fprintf(stderr, "kernel_launch: launch failed: %s\n", hipGetErrorName(le));
}
```

```cpp
#include <hip/hip_runtime.h>
#include <cstdio>
#include <cstdint>
#include <type_traits>

#ifndef N_LAUNCH_MODE
#define N_LAUNCH_MODE 1
#endif
#ifndef DBG_CHECK
#define DBG_CHECK 0
#define F8_P3 1
#define F8_MIX 1
#define D8_DMA_A 1
#define D8_DMA_D 1
#define D8_MACC_D 1
#endif
#ifndef DBG_TOL_SP
#define DBG_TOL_SP 0.08f
#endif
#ifndef DBG_TOL
#define DBG_TOL 0.3f
#endif
#ifndef F8_DOWN
#define F8_DOWN 1
#endif
#ifndef F8_GU
#define F8_GU 1
#endif
#ifndef F8_IN
#define F8_IN 1
#endif
#ifndef F8_OUT
#define F8_OUT 1
#endif
#ifndef F8_ATTA
#define F8_ATTA 1
#endif
#ifndef F8_ATTD
#define F8_ATTD 1
#endif
#ifndef F8_SPARSE
#define F8_SPARSE 1
#endif
#ifndef GEMM_SKEW
#define GEMM_SKEW 0
#endif
#ifndef F8_YR
#define F8_YR 1
#endif

#define LAS __attribute__((address_space(3)))
typedef unsigned short bf16_t;
typedef short bf16x8 __attribute__((ext_vector_type(8)));
typedef short s16x4 __attribute__((ext_vector_type(4)));
typedef float f32x2 __attribute__((ext_vector_type(2)));
typedef float f32x4 __attribute__((ext_vector_type(4)));
typedef float f32x8 __attribute__((ext_vector_type(8)));
typedef float f32x16 __attribute__((ext_vector_type(16)));
typedef unsigned u32x2 __attribute__((ext_vector_type(2)));
typedef unsigned u32x4 __attribute__((ext_vector_type(4)));
typedef int i32x8 __attribute__((ext_vector_type(8)));
typedef _Float16 f16x8 __attribute__((ext_vector_type(8)));
typedef _Float16 f16x2 __attribute__((ext_vector_type(2)));
typedef int i32x4 __attribute__((ext_vector_type(4)));

constexpr int T_ = 32768, DM = 2048, SEQ = 4096, NBATCH = 8;
constexpr int IN0 = 4608, IN1 = 3904, IN1P = 4096;
constexpr int NE = 32, DE = 512, MAXBLK = 288;
constexpr float ALPHA = 1.4142135623730951f;
constexpr float LOG2E = 1.4426950408889634f;
constexpr int NTHR = 512;

constexpr size_t MiB = 1u << 20;
constexpr size_t WS_CTL = 0, CTL_ZERO_BYTES = 1 * MiB;
constexpr size_t WS_LIST = 1 * MiB;
constexpr size_t WS_TOKE = 9 * MiB;
constexpr size_t WS_TOKP = WS_TOKE + 256 * 1024;
constexpr size_t WS_TOKG = WS_TOKP + 256 * 1024;
constexpr size_t WS_RSTAT = WS_TOKG + 256 * 1024;
constexpr size_t WS_KROPE = 10 * MiB;
constexpr size_t WS_WIN0 = 16 * MiB, WS_WOUT0 = 34 * MiB, WS_WGU0 = 42 * MiB, WS_WD0 = 170 * MiB;
constexpr size_t WS_WIN1 = 234 * MiB, WS_WOUT1 = 250 * MiB, WS_WGU1 = 258 * MiB, WS_WD1 = 386 * MiB;
constexpr size_t WS_WQUP = 450 * MiB, WS_WKVUP = 452 * MiB;
constexpr size_t WS_RA = 454 * MiB, WS_RB = 582 * MiB, WS_RC = 870 * MiB, WS_END = 998 * MiB;
constexpr size_t OUT_QD = 0, OUT_O1 = 96 * MiB;
constexpr int CW_CNT = 64;
constexpr int CW_DBG = 512;
constexpr int CW_BAR = 4096;

constexpr int LDS_BYTES = 155648;
constexpr int MISC_OFF = LDS_BYTES - 64;

__device__ __forceinline__ unsigned cvtpk(float lo, float hi) { unsigned r; asm volatile("v_cvt_pk_bf16_f32 %0, %1, %2" : "=v"(r) : "v"(lo), "v"(hi)); return r; }
__device__ __forceinline__ float bf2f(unsigned short b) { return __uint_as_float(((unsigned)b) << 16); }
__device__ __forceinline__ float bflo(unsigned w) { return __uint_as_float(w << 16); }
__device__ __forceinline__ float bfhi(unsigned w) { return __uint_as_float(w & 0xffff0000u); }
__device__ __forceinline__ bf16_t f2bf(float f) { return (bf16_t)(cvtpk(f, f) & 0xffffu); }
__device__ __forceinline__ unsigned pk4_fp8(float a, float b, float c, float d) { int w = (int)__float_as_uint(a);
    w = __builtin_amdgcn_cvt_pk_fp8_f32(a, b, w, false); w = __builtin_amdgcn_cvt_pk_fp8_f32(c, d, w, true); return (unsigned)w; }
constexpr float O8_SCALE = 16.f;
__device__ __forceinline__ unsigned char f2fp8(float v) { return (unsigned char)(__builtin_amdgcn_cvt_pk_fp8_f32(v, v, (int)__float_as_uint(v), false) & 0xff); }
__device__ __forceinline__ float clamp8(float v) { return fminf(fmaxf(v, -400.f), 400.f); }
__device__ __forceinline__ int fresh_tid(int wv) { int l; asm volatile("v_mbcnt_lo_u32_b32 %0, -1, 0\n\tv_mbcnt_hi_u32_b32 %0, -1, %0" : "=v"(l)); return wv * 64 + l; }
__device__ __forceinline__ float fresh_zero() { float z; asm volatile("v_mov_b32 %0, 0" : "=v"(z)); return z; }
__device__ __forceinline__ float wave_sum(float v) {
    v += __int_as_float(__builtin_amdgcn_ds_swizzle(__float_as_int(v), (1 << 10) | 0x1f));
    v += __int_as_float(__builtin_amdgcn_ds_swizzle(__float_as_int(v), (2 << 10) | 0x1f));
    v += __int_as_float(__builtin_amdgcn_ds_swizzle(__float_as_int(v), (4 << 10) | 0x1f));
    v += __int_as_float(__builtin_amdgcn_ds_swizzle(__float_as_int(v), (8 << 10) | 0x1f));
    v += __int_as_float(__builtin_amdgcn_ds_swizzle(__float_as_int(v), (16 << 10) | 0x1f));
    auto rr = __builtin_amdgcn_permlane32_swap(__float_as_uint(v), __float_as_uint(v), false, false);
    return __uint_as_float(rr[0]) + __uint_as_float(rr[1]);
}
__device__ __forceinline__ float wave_max(float v) {
    v = fmaxf(v, __int_as_float(__builtin_amdgcn_ds_swizzle(__float_as_int(v), (1 << 10) | 0x1f)));
    v = fmaxf(v, __int_as_float(__builtin_amdgcn_ds_swizzle(__float_as_int(v), (2 << 10) | 0x1f)));
    v = fmaxf(v, __int_as_float(__builtin_amdgcn_ds_swizzle(__float_as_int(v), (4 << 10) | 0x1f)));
    v = fmaxf(v, __int_as_float(__builtin_amdgcn_ds_swizzle(__float_as_int(v), (8 << 10) | 0x1f)));
    v = fmaxf(v, __int_as_float(__builtin_amdgcn_ds_swizzle(__float_as_int(v), (16 << 10) | 0x1f)));
    auto rr = __builtin_amdgcn_permlane32_swap(__float_as_uint(v), __float_as_uint(v), false, false);
    return fmaxf(__uint_as_float(rr[0]), __uint_as_float(rr[1]));
}
__device__ __forceinline__ float inv_freq32(int i) { return __builtin_amdgcn_exp2f(-(float)i * 0.41524101186092029f); }
__device__ __forceinline__ void sincos_rev(float angle, float& s, float& c) {
    float rev = angle * 0.15915494309189535f; rev = rev - floorf(rev);
    s = __builtin_amdgcn_sinf(rev); c = __builtin_amdgcn_cosf(rev);
}

#define XB_TMO      128
#define XB_XCNT(j)  (256  + 64 * (j))
#define XB_XSUB(j)  (1280 + 64 * (j))
#define XB_XGEN(j)  (2304 + 64 * (j))
#define XB_TOP      3328
#define XB_TOPGEN   3392
#define XCD_BAR_WORDS 3456
#define XB_SPIN_CAP (1u << 20)
__device__ __forceinline__ unsigned xb_ld(unsigned* p)              { return __hip_atomic_load(p, __ATOMIC_RELAXED, __HIP_MEMORY_SCOPE_AGENT); }
__device__ __forceinline__ unsigned xb_add(unsigned* p, unsigned v) { return __hip_atomic_fetch_add(p, v, __ATOMIC_RELAXED, __HIP_MEMORY_SCOPE_AGENT); }
__device__ __forceinline__ unsigned xb_xcc_id() { return (unsigned)__builtin_amdgcn_s_getreg((3 << 11) | 20) & 0xFu; }
#define XB_SPIN(cond, bar) do { unsigned _sp = 0; while (cond) { __builtin_amdgcn_s_sleep(1); \
    if ((++_sp & 255u) == 0u) { if (xb_ld(&(bar)[XB_TMO])) break; if (_sp > XB_SPIN_CAP) { atomicAdd(&(bar)[XB_TMO], 1u); break; } } } } while (0)
struct XcdBarrier { unsigned* bar; unsigned x; volatile LAS unsigned* st; };
__device__ __forceinline__ XcdBarrier xcd_barrier_post(unsigned* bar, volatile LAS unsigned* st) {
    XcdBarrier b; b.bar = bar; b.x = xb_xcc_id(); b.st = st;
    if (threadIdx.x == 0) (void)xb_add(&bar[XB_XCNT(b.x)], 1u);
    return b;
}
__device__ __forceinline__ void xcd_barrier_complete(unsigned* bar, unsigned x, unsigned& nloc, unsigned& nx) {
    const unsigned G = gridDim.x * gridDim.y * gridDim.z;
    unsigned sum, cnt, mine, sp = 0u;
    for (;;) {
        sum = 0u; cnt = 0u; mine = 0u;
#pragma unroll
        for (unsigned j = 0; j < 16; ++j) { const unsigned c = xb_ld(&bar[XB_XCNT(j)]); sum += c; cnt += (c > 0u) ? 1u : 0u; mine = (j == x) ? c : mine; }
        if (sum == G) break;
        __builtin_amdgcn_s_sleep(1);
        if ((++sp & 255u) == 0u) { if (xb_ld(&bar[XB_TMO])) break; if (sp > XB_SPIN_CAP) { atomicAdd(&bar[XB_TMO], 1u); break; } }
    }
    nloc = mine > 0u ? mine : 1u; nx = cnt > 0u ? cnt : 1u;
}
__device__ __forceinline__ void xcd_barrier(const XcdBarrier& b, int tid_now) {
    asm volatile("s_waitcnt vmcnt(0)" ::: "memory");
    __syncthreads();
    if (tid_now == 0) {
        unsigned* bar = b.bar;
        __builtin_amdgcn_s_waitcnt(0);
        unsigned nloc = b.st[0], nx = b.st[1];
        if (nloc == 0u) { xcd_barrier_complete(bar, b.x, nloc, nx); b.st[0] = nloc; b.st[1] = nx; }
        const unsigned old = xb_add(&bar[XB_XSUB(b.x)], 1u);
        const unsigned gen = old / nloc;
        if (old + 1u == (gen + 1u) * nloc) {
            __builtin_amdgcn_fence(__ATOMIC_RELEASE, "agent");
            asm volatile("s_waitcnt vmcnt(0)" ::: "memory");
            const unsigned og = xb_add(&bar[XB_TOP], 1u);
            const unsigned tg = og / nx;
            if (og + 1u == (tg + 1u) * nx) xb_add(&bar[XB_TOPGEN], 1u);
            else XB_SPIN(xb_ld(&bar[XB_TOPGEN]) == tg, bar);
            __builtin_amdgcn_fence(__ATOMIC_ACQUIRE, "agent");
            xb_add(&bar[XB_XGEN(b.x)], 1u);
            asm volatile("s_waitcnt vmcnt(0)" ::: "memory");
        } else {
            XB_SPIN(xb_ld(&bar[XB_XGEN(b.x)]) == gen, bar);
            __builtin_amdgcn_fence(__ATOMIC_ACQUIRE, "agent");
            asm volatile("s_waitcnt vmcnt(0)" ::: "memory");
        }
    }
    __syncthreads();
}

namespace pg8 {
constexpr int BM = 256, BK = 64, HALF = 128, HTB = HALF * BK * 2, STAGE_BYTES = 8 * HTB, NXCD = 8, WGM = 8;
__device__ __forceinline__ int lds_byte(int r, int c) { const int st = (r >> 4) * 2 + (c >> 5), rr = r & 15, cc = c & 31, ob = rr * 64 + cc * 2; return st * 1024 + (ob ^ (((ob >> 9) & 1) << 5)); }
__device__ __forceinline__ void stage_rc(int b, int& R, int& C) { const int st = b / 1024, sb = b % 1024, swz = sb ^ (((sb >> 9) & 1) << 5); R = (st >> 1) * 16 + swz / 64; C = (st & 1) * 32 + (swz % 64) / 2; }
__device__ __forceinline__ int perm32(int rho) { const int n = rho >> 4, i = rho & 15; return 8 * (i >> 2) + 4 * n + (i & 3); }
struct Unit { int pm, pn, q; };
struct Gemm { const bf16_t* A; const bf16_t* Bt; int K, lda, ldb; };

struct StaticOrder {
    static constexpr bool GATHER = false;
    int nM, nN, nwg, G, c, lda;
    __device__ void init(int M, int N, int G_, int c_, int lda_) { nM = M / BM; nN = N / BM; nwg = nM * nN; G = G_; c = c_; lda = lda_; }
    __device__ __forceinline__ bool next(int i, Unit& u) const {
        const long L = (long)i * G + c; if (L >= nwg) return false;
        int wgid = (int)L; { const int q = nwg / NXCD, r = nwg % NXCD, xcd = wgid % NXCD, off = wgid / NXCD; wgid = (xcd < r ? xcd * (q + 1) : r * (q + 1) + (xcd - r) * q) + off; }
        const int nig = WGM * nN, gid = wgid / nig, fm = gid * WGM, gsz = (nM - fm) < WGM ? (nM - fm) : WGM;
        u.pm = fm + ((wgid % nig) % gsz); u.pn = (wgid % nig) / gsz; u.q = i; return true;
    }
    __device__ __forceinline__ void aoff(const Unit& u, const int (&R)[2], const int (&C)[2], unsigned (&o)[2][2]) const {
#pragma unroll
        for (int h = 0; h < 2; ++h)
#pragma unroll
            for (int i = 0; i < 2; ++i) o[h][i] = (unsigned)((u.pm * BM + h * HALF + R[i]) * lda + C[i]) * 2u;
    }
};
template <bool GATHER_> struct TableOrder {
    static constexpr bool GATHER = GATHER_;
    const LAS int* tab; const LAS int* idx; int n, lda;
    __device__ __forceinline__ bool next(int i, Unit& u) const { if (i >= n) return false; u.pm = tab[i]; u.pn = tab[16 + i]; u.q = i; return true; }
    __device__ __forceinline__ void aoff(const Unit& u, const int (&R)[2], const int (&C)[2], unsigned (&o)[2][2]) const {
#pragma unroll
        for (int h = 0; h < 2; ++h)
#pragma unroll
            for (int i = 0; i < 2; ++i) { const int row = GATHER ? idx[u.q * 256 + h * HALF + R[i]] : (u.pm * BM + h * HALF + R[i]); o[h][i] = (unsigned)(row * lda + C[i]) * 2u; }
    }
};

template <bool O8> struct EpiBf16T {
    static constexpr bool PERM = true;
    bf16_t* O; int ldc; int pnmask;
    __device__ __forceinline__ void operator()(const f32x4 (&acc)[2][2][4][2], const Unit& u, int wr, int wc, int fr, int fq) const {
        const int row0 = u.pm * BM + wr * 64 + fr; const int col0 = (u.pn & pnmask) * BM + wc * 32 + 8 * fq;
#pragma unroll
        for (int ai = 0; ai < 2; ++ai)
#pragma unroll
            for (int m = 0; m < 4; ++m) { const size_t eoff = (size_t)(row0 + ai * HALF + m * 16) * ldc + col0;
#pragma unroll
                for (int bj = 0; bj < 2; ++bj) { const f32x4 v0 = acc[ai][bj][m][0], v1 = acc[ai][bj][m][1];
                    if constexpr (O8) { u32x2 w; w.x = pk4_fp8(v0[0] * 16.f, v0[1] * 16.f, v0[2] * 16.f, v0[3] * 16.f); w.y = pk4_fp8(v1[0] * 16.f, v1[1] * 16.f, v1[2] * 16.f, v1[3] * 16.f);
                        *(u32x2*)((unsigned char*)O + eoff + bj * HALF) = w; }
                    else { u32x4 w; w.x = cvtpk(v0[0], v0[1]); w.y = cvtpk(v0[2], v0[3]); w.z = cvtpk(v1[0], v1[1]); w.w = cvtpk(v1[2], v1[3]);
                        *(u32x4*)(O + eoff + bj * HALF) = w; } } }
    }
};
typedef EpiBf16T<false> EpiBf16;
struct EpiRowScale {
    static constexpr bool PERM = true;
    bf16_t* O; int ldc; const float* rs; int which;
    __device__ __forceinline__ void operator()(const f32x4 (&acc)[2][2][4][2], const Unit& u, int wr, int wc, int fr, int fq) const {
        const int row0 = u.pm * BM + wr * 64 + fr; const int col0 = u.pn * BM + wc * 32 + 8 * fq;
#pragma unroll
        for (int ai = 0; ai < 2; ++ai)
#pragma unroll
            for (int m = 0; m < 4; ++m) { const int row = row0 + ai * HALF + m * 16; const float s = rs[row * 2 + which]; bf16_t* rowp = O + (size_t)row * ldc + col0;
#pragma unroll
                for (int bj = 0; bj < 2; ++bj) { const f32x4 v0 = acc[ai][bj][m][0] * s, v1 = acc[ai][bj][m][1] * s;
                    u32x4 w; w.x = cvtpk(v0[0], v0[1]); w.y = cvtpk(v0[2], v0[3]); w.z = cvtpk(v1[0], v1[1]); w.w = cvtpk(v1[2], v1[3]);
                    *(u32x4*)(rowp + bj * HALF) = w; } }
    }
};
struct EpiIn {
    static constexpr bool PERM = true;
    bf16_t* H; int ldh; unsigned char* K8; unsigned char* V8; int k_lo, v_lo, v_hi;
    __device__ __forceinline__ void operator()(const f32x4 (&acc)[2][2][4][2], const Unit& u, int wr, int wc, int fr, int fq) const {
        const int row0 = u.pm * BM + wr * 64 + fr; const int cw = wc * 32 + 8 * fq;
        const bool is8 = (u.pn >= k_lo && u.pn < v_hi);
        unsigned char* b8 = (u.pn < v_lo) ? K8 + (size_t)(u.pn - k_lo) * BM : V8 + (size_t)(u.pn - v_lo) * BM;
#pragma unroll
        for (int ai = 0; ai < 2; ++ai)
#pragma unroll
            for (int m = 0; m < 4; ++m) { const size_t row = (size_t)(row0 + ai * HALF + m * 16);
#pragma unroll
                for (int bj = 0; bj < 2; ++bj) { const f32x4 v0 = acc[ai][bj][m][0], v1 = acc[ai][bj][m][1];
                    if (is8) *(u32x2*)(b8 + row * 1024 + bj * HALF + cw) = (u32x2){pk4_fp8(v0[0], v0[1], v0[2], v0[3]), pk4_fp8(v1[0], v1[1], v1[2], v1[3])};
                    else { u32x4 w; w.x = cvtpk(v0[0], v0[1]); w.y = cvtpk(v0[2], v0[3]); w.z = cvtpk(v1[0], v1[1]); w.w = cvtpk(v1[2], v1[3]);
                        *(u32x4*)(H + row * ldh + u.pn * BM + bj * HALF + cw) = w; } } }
    }
};
struct EpiNull { static constexpr bool PERM = true; float* sink;
    __device__ __forceinline__ void operator()(const f32x4 (&acc)[2][2][4][2], const Unit& u, int wr, int wc, int fr, int fq) const {
        float s = 0.f;
#pragma unroll
        for (int ai = 0; ai < 2; ++ai)
#pragma unroll
            for (int bj = 0; bj < 2; ++bj)
#pragma unroll
                for (int m = 0; m < 4; ++m)
#pragma unroll
                    for (int n = 0; n < 2; ++n) s += acc[ai][bj][m][n][0] + acc[ai][bj][m][n][1] + acc[ai][bj][m][n][2] + acc[ai][bj][m][n][3];
        if (s == 123.456f) sink[0] = s; } };
struct EpiKV8 {
    static constexpr bool PERM = true;
    unsigned char* K8; unsigned char* Vt8; bf16_t* KV; bool wr_bf16;
    __device__ __forceinline__ void operator()(const f32x4 (&acc)[2][2][4][2], const Unit& u, int wr, int wc, int fr, int fq) const {
        const int row0 = u.pm * BM + wr * 64 + fr; const int c0 = wc * 32 + 8 * fq;
#pragma unroll
        for (int ai = 0; ai < 2; ++ai)
#pragma unroll
            for (int m = 0; m < 4; ++m) { const int row = row0 + ai * HALF + m * 16;
                { const f32x4 v0 = acc[ai][0][m][0], v1 = acc[ai][0][m][1];
                  *(u32x2*)(K8 + (size_t)row * 1024 + u.pn * 128 + c0) = (u32x2){pk4_fp8(v0[0], v0[1], v0[2], v0[3]), pk4_fp8(v1[0], v1[1], v1[2], v1[3])}; }
                { const f32x4 v0 = acc[ai][1][m][0], v1 = acc[ai][1][m][1]; const float vv[8] = {v0[0], v0[1], v0[2], v0[3], v1[0], v1[1], v1[2], v1[3]};
                  unsigned char* vp = Vt8 + ((size_t)((row >> 12) * 8 + u.pn) * 128 + c0) * SEQ + (row & (SEQ - 1));
#pragma unroll
                  for (int e = 0; e < 8; ++e) vp[(size_t)e * SEQ] = f2fp8(vv[e]); }
                if (wr_bf16) {
#pragma unroll
                    for (int bj = 0; bj < 2; ++bj) { const f32x4 v0 = acc[ai][bj][m][0], v1 = acc[ai][bj][m][1];
                        u32x4 w; w.x = cvtpk(v0[0], v0[1]); w.y = cvtpk(v0[2], v0[3]); w.z = cvtpk(v1[0], v1[1]); w.w = cvtpk(v1[2], v1[3]);
                        *(u32x4*)(KV + (size_t)row * DM + u.pn * BM + bj * HALF + c0) = w; } } }
    }
};
template <bool O8> struct EpiSiluMul {
    static constexpr bool PERM = true;
    bf16_t* O;
    __device__ __forceinline__ void operator()(const f32x4 (&acc)[2][2][4][2], const Unit& u, int wr, int wc, int fr, int fq) const {
        const int row0 = u.pm * BM + wr * 64 + fr; const int col0 = (u.pn & 3) * HALF + wc * 32 + 8 * fq;
#pragma unroll
        for (int ai = 0; ai < 2; ++ai)
#pragma unroll
            for (int m = 0; m < 4; ++m) { const size_t eoff = (size_t)(row0 + ai * HALF + m * 16) * DE + col0; float h[8];
#pragma unroll
                for (int n = 0; n < 2; ++n)
#pragma unroll
                    for (int j = 0; j < 4; ++j) { const float g = acc[ai][0][m][n][j], up = acc[ai][1][m][n][j];
                        const float sg = g * __builtin_amdgcn_rcpf(1.0f + __builtin_amdgcn_exp2f(-g * LOG2E)); h[n * 4 + j] = sg * up; }
                if constexpr (O8) { u32x2 w; w.x = pk4_fp8(clamp8(h[0]), clamp8(h[1]), clamp8(h[2]), clamp8(h[3])); w.y = pk4_fp8(clamp8(h[4]), clamp8(h[5]), clamp8(h[6]), clamp8(h[7]));
                    *(u32x2*)((unsigned char*)O + eoff) = w; }
                else { u32x4 w; w.x = cvtpk(h[0], h[1]); w.y = cvtpk(h[2], h[3]); w.z = cvtpk(h[4], h[5]); w.w = cvtpk(h[6], h[7]);
                    *(u32x4*)(O + eoff) = w; } }
    }
};
template <bool RES_F32> struct EpiResF32 {
    static constexpr bool PERM = false;
    float* Z; const void* res;
    __device__ __forceinline__ void operator()(const f32x4 (&acc)[2][2][4][2], const Unit& u, int wr, int wc, int fr, int fq) const {
        const int row0 = u.pm * BM + wr * 64 + fr, col0 = u.pn * BM + wc * 32 + 4 * fq;
        float ALPHA = 1.4142135623730951f; asm volatile("" : "+v"(ALPHA));
#pragma unroll
        for (int ai = 0; ai < 2; ++ai)
#pragma unroll
            for (int m = 0; m < 4; ++m) { const size_t off = (size_t)(row0 + ai * HALF + m * 16) * DM + col0;
#pragma unroll
                for (int bj = 0; bj < 2; ++bj)
#pragma unroll
                    for (int n = 0; n < 2; ++n) { f32x4 o = acc[ai][bj][m][n];
                        if constexpr (RES_F32) { const f32x4 rv = *(const f32x4*)((const float*)res + off + bj * HALF + n * 16); o += ALPHA * rv; }
                        else { const u32x2 rb = *(const u32x2*)((const bf16_t*)res + off + bj * HALF + n * 16);
                            o[0] += ALPHA * bflo(rb.x); o[1] += ALPHA * bfhi(rb.x); o[2] += ALPHA * bflo(rb.y); o[3] += ALPHA * bfhi(rb.y); }
                        *(f32x4*)(Z + off + bj * HALF + n * 16) = o; } }
    }
};

template <bool F8, class Epi, class Sched>
__device__ __forceinline__ void gemm_phase(int wv, LAS unsigned char* lds, const Gemm g, const Sched& S, const Epi& E, float oscale = 1.0f) {
    constexpr bool GA = Sched::GATHER;
    const int tid = fresh_tid(wv), wid = __builtin_amdgcn_readfirstlane(tid >> 6), lane = tid & 63, wr = wid >> 2, wc = wid & 3, fr = lane & 15, fq = lane >> 4;
    int K = g.K; asm volatile("" : "+s"(K));
    const int nt = K / BK;
    int Rr[2], Cc[2]; unsigned voffA[2], voffB[2];
#pragma unroll
    for (int i = 0; i < 2; ++i) { int R, C; stage_rc(tid * 16 + i * 8192, R, C); Rr[i] = R; Cc[i] = C; const int Rb = Epi::PERM ? ((R & ~31) + perm32(R & 31)) : R;
        voffA[i] = (unsigned)(R * g.lda + C) * 2u; voffB[i] = (unsigned)(Rb * g.ldb + C) * 2u; }
    const size_t kstep = (size_t)(BK * 2);
    const size_t hstepA = (size_t)HALF * g.lda * 2, tstepA = 2 * hstepA;
    const size_t hstepB = (size_t)HALF * g.ldb * 2, tstepB = 2 * hstepB;
    const unsigned ldsw = (unsigned)wid * 1024u;
    const int aoff = lds_byte(wr * 64 + fr, fq * 8), boff = lds_byte(wc * 32 + fr, fq * 8);
#define PG8_SA(b, h) (((b) * 2 + (h)) * HTB)
#define PG8_SB(b, h) ((4 + (b) * 2 + (h)) * HTB)
#define PG8_STAGE(bufoff, gbase, voff) do { _Pragma("unroll") for (int _i = 0; _i < 2; ++_i) \
        __builtin_amdgcn_global_load_lds((const unsigned*)((const char*)(gbase) + (voff)[_i]), (LAS unsigned*)(lds + (bufoff) + ldsw + _i * 8192), 16, 0, 0); } while (0)
#define PG8_STAGE_A(bufoff, h, pbase, koff, goffs) do { if constexpr (GA) { PG8_STAGE(bufoff, gA + (koff), (goffs)[h]); } else { PG8_STAGE(bufoff, (pbase) + (h) * hstepA, voffA); } } while (0)
#define PG8_LD32(dst, off) do { const i32x4 _lo = *(const LAS i32x4*)(lds + (off)), _hi = *(const LAS i32x4*)(lds + (off) + 1024); dst = __builtin_shufflevector(_lo, _hi, 0, 1, 2, 3, 4, 5, 6, 7); } while (0)
#define PG8_LDA(dst, b, h) do { _Pragma("unroll") for (int m = 0; m < 4; ++m) PG8_LD32(dst[m], PG8_SA(b, h) + aoff + m * 2048); } while (0)
#define PG8_LDB(dst, b, h) do { _Pragma("unroll") for (int n = 0; n < 2; ++n) PG8_LD32(dst[n], PG8_SB(b, h) + boff + n * 2048); } while (0)
#define PG8_LOH(v) __builtin_bit_cast(bf16x8, __builtin_shufflevector(v, v, 0, 1, 2, 3))
#define PG8_HIH(v) __builtin_bit_cast(bf16x8, __builtin_shufflevector(v, v, 4, 5, 6, 7))
#define PG8_MMA(ai, bj, At, Bt) do { __builtin_amdgcn_s_setprio(1); \
        if constexpr (F8) { _Pragma("unroll") for (int m = 0; m < 4; ++m) _Pragma("unroll") for (int n = 0; n < 2; ++n) \
            asm volatile("v_mfma_f32_16x16x128_f8f6f4 %0, %1, %2, %0" : "+v"(acc[ai][bj][m][n]) : "v"(Bt[n]), "v"(At[m])); } \
        else { _Pragma("unroll") for (int m = 0; m < 4; ++m) _Pragma("unroll") for (int n = 0; n < 2; ++n) { \
            acc[ai][bj][m][n] = __builtin_amdgcn_mfma_f32_16x16x32_bf16(PG8_LOH(Bt[n]), PG8_LOH(At[m]), acc[ai][bj][m][n], 0, 0, 0); \
            acc[ai][bj][m][n] = __builtin_amdgcn_mfma_f32_16x16x32_bf16(PG8_HIH(Bt[n]), PG8_HIH(At[m]), acc[ai][bj][m][n], 0, 0, 0); } } \
        __builtin_amdgcn_s_setprio(0); } while (0)
#define PG8_WAIT_V(n) asm volatile("s_waitcnt vmcnt(" #n ")" ::: "memory")
#define PG8_WAIT_L(n) asm volatile("s_waitcnt lgkmcnt(" #n ")" ::: "memory")
#define PG8_BAR __builtin_amdgcn_s_barrier()
#define PG8_SCHED __builtin_amdgcn_sched_barrier(0)
    Unit cur, nxt; int ui = 0;
    if (!S.next(0, cur)) return;
    if (GEMM_SKEW > 0) { const unsigned long long t0 = __builtin_amdgcn_s_memrealtime(); const unsigned long long dl = (unsigned long long)((blockIdx.x >> 3) & 3) * GEMM_SKEW;
        while (__builtin_amdgcn_s_memrealtime() - t0 < dl) __builtin_amdgcn_s_sleep(8); }
    f32x4 acc[2][2][4][2];
#pragma unroll
    for (int a = 0; a < 2; ++a)
#pragma unroll
        for (int b = 0; b < 2; ++b)
#pragma unroll
            for (int m = 0; m < 4; ++m)
#pragma unroll
                for (int n = 0; n < 2; ++n) { const float zf = fresh_zero(); acc[a][b][m][n] = (f32x4){zf, zf, zf, zf}; }
    unsigned ca[2][2];
    if constexpr (GA) S.aoff(cur, Rr, Cc, ca);
    const char* gA = (const char*)g.A;
    const char* cA = gA + (GA ? (size_t)0 : (size_t)cur.pm * tstepA);
    const char* cB = (const char*)g.Bt + (size_t)cur.pn * tstepB;
    PG8_STAGE(PG8_SB(0, 0), cB, voffB); PG8_STAGE_A(PG8_SA(0, 0), 0, cA, 0, ca); PG8_STAGE(PG8_SB(0, 1), cB + hstepB, voffB); PG8_STAGE_A(PG8_SA(0, 1), 1, cA, 0, ca);
    if (wr == 1) PG8_BAR;
    PG8_WAIT_V(4); PG8_BAR;
    PG8_STAGE(PG8_SB(1, 0), cB + kstep, voffB); PG8_STAGE_A(PG8_SA(1, 0), 0, cA + kstep, kstep, ca); PG8_STAGE(PG8_SB(1, 1), cB + hstepB + kstep, voffB);
    PG8_WAIT_V(6); PG8_BAR;
    for (;;) {
        const bool has_next = S.next(ui + 1, nxt);
        const char* nA = (!GA && has_next) ? gA + (size_t)nxt.pm * tstepA : cA;
        const char* nB = has_next ? (const char*)g.Bt + (size_t)nxt.pn * tstepB : cB;
#pragma unroll 1
        for (int t = 0; t < nt; t += 2) {
            const bool last = (t == nt - 2);
            const size_t k1 = (size_t)(t + 1) * kstep, k2 = last ? (size_t)0 : (size_t)(t + 2) * kstep, k3 = k2 + kstep;
            const char* a1 = cA + k1;
            const char* a2 = last ? nA : cA + k2; const char* b2 = last ? nB : cB + (size_t)(t + 2) * kstep;
            const char* a3 = a2 + kstep; const char* b3 = b2 + kstep;
            i32x8 At[4], B0[2], B1[2];
            unsigned xa[2][2];
            if constexpr (GA) {
                if (last && has_next) { int R2[2], C2[2]; const int t2 = fresh_tid(wv); stage_rc(t2 * 16, R2[0], C2[0]); stage_rc(t2 * 16 + 8192, R2[1], C2[1]); S.aoff(nxt, R2, C2, xa); }
                else {
#pragma unroll
                    for (int h = 0; h < 2; ++h)
#pragma unroll
                        for (int i = 0; i < 2; ++i) xa[h][i] = ca[h][i];
                }
            }
            PG8_LDB(B0, 0, 0); PG8_SCHED; PG8_LDA(At, 0, 0); PG8_STAGE_A(PG8_SA(1, 1), 1, a1, k1, ca);
            PG8_WAIT_L(8); PG8_BAR; PG8_WAIT_L(0); PG8_MMA(0, 0, At, B0); PG8_BAR; PG8_SCHED;
            PG8_LDB(B1, 0, 1); PG8_STAGE(PG8_SB(0, 0), b2, voffB);
            PG8_BAR; PG8_WAIT_L(0); PG8_MMA(0, 1, At, B1); PG8_BAR;
            PG8_LDA(At, 0, 1); PG8_STAGE_A(PG8_SA(0, 0), 0, a2, k2, xa);
            PG8_BAR; PG8_WAIT_L(0); PG8_MMA(1, 0, At, B0); PG8_BAR; PG8_SCHED;
            PG8_STAGE(PG8_SB(0, 1), b2 + hstepB, voffB);
            PG8_WAIT_V(6); PG8_BAR; PG8_MMA(1, 1, At, B1); PG8_BAR;
            PG8_LDB(B0, 1, 0); PG8_SCHED; PG8_LDA(At, 1, 0); PG8_STAGE_A(PG8_SA(0, 1), 1, a2, k2, xa);
            PG8_WAIT_L(8); PG8_BAR; PG8_WAIT_L(0); PG8_MMA(0, 0, At, B0); PG8_BAR; PG8_SCHED;
            PG8_LDB(B1, 1, 1); PG8_STAGE(PG8_SB(1, 0), b3, voffB);
            PG8_BAR; PG8_WAIT_L(0); PG8_MMA(0, 1, At, B1); PG8_BAR;
            PG8_LDA(At, 1, 1); PG8_STAGE_A(PG8_SA(1, 0), 0, a3, k3, xa);
            PG8_BAR; PG8_WAIT_L(0); PG8_MMA(1, 0, At, B0); PG8_BAR; PG8_SCHED;
            PG8_STAGE(PG8_SB(1, 1), b3 + hstepB, voffB);
            PG8_WAIT_V(6); PG8_BAR; PG8_MMA(1, 1, At, B1); PG8_BAR;
        }
        if constexpr (F8) { asm volatile("s_nop 7\n\ts_nop 7\n\ts_nop 7" ::: "memory");
#pragma unroll
            for (int a = 0; a < 2; ++a)
#pragma unroll
                for (int b = 0; b < 2; ++b)
#pragma unroll
                    for (int m = 0; m < 4; ++m)
#pragma unroll
                        for (int n = 0; n < 2; ++n) acc[a][b][m][n] *= oscale; }
        { const int l2 = fresh_tid(0); E(acc, cur, wr, wc, l2 & 15, l2 >> 4); }
        if (!has_next) break;
#pragma unroll
        for (int a = 0; a < 2; ++a)
#pragma unroll
            for (int b = 0; b < 2; ++b)
#pragma unroll
                for (int m = 0; m < 4; ++m)
#pragma unroll
                    for (int n = 0; n < 2; ++n) { const float zf = fresh_zero(); acc[a][b][m][n] = (f32x4){zf, zf, zf, zf}; }
        cur = nxt; cA = nA; cB = nB; ++ui;
        if constexpr (GA) { int R2[2], C2[2]; const int t2 = fresh_tid(wv); stage_rc(t2 * 16, R2[0], C2[0]); stage_rc(t2 * 16 + 8192, R2[1], C2[1]); S.aoff(cur, R2, C2, ca); }
    }
    PG8_WAIT_V(0);
    if (wr == 0) PG8_BAR;
    PG8_BAR;
#undef PG8_SA
#undef PG8_SB
#undef PG8_STAGE
#undef PG8_STAGE_A
#undef PG8_LDA
#undef PG8_LDB
#undef PG8_MMA
#undef PG8_LD32
#undef PG8_LOH
#undef PG8_HIH
#undef PG8_WAIT_V
#undef PG8_WAIT_L
#undef PG8_BAR
#undef PG8_SCHED
}
}

namespace da {
constexpr int KVBLK = 64;
constexpr float THR = 8.f;
constexpr int SHM_V = KVBLK * 128 * 2, SHM_K = KVBLK * 128 * 2, SHM_KR = KVBLK * 64 * 2;
constexpr int OFF_V = 0, OFF_K = 2 * SHM_V, OFF_WS = OFF_K + 2 * SHM_K, OFF_KR = OFF_WS + 8 * 64 * 4, OFF_QR = OFF_KR + 2 * SHM_KR, LDS_DENSE = OFF_QR + 8 * 4096;
#define KSWZ(row, colB) ((row) * 256 + ((colB) ^ (((row) & 7) << 4)))
#define KRSWZ(row, ch) ((row) * 128 + ((((ch) ^ ((row) >> 1)) & 7) << 4))
#define SBAR() __builtin_amdgcn_sched_barrier(0)
__device__ __forceinline__ int crow(int r, int hi) { return (r & 3) + 8 * (r >> 2) + 4 * hi; }
__device__ __forceinline__ int v_st(int k, int c) { const int kk = (k & ~0xC) | ((k & 4) << 1) | ((k & 8) >> 1); return ((kk >> 3) * 4 + (c >> 5)) * 512 + ((kk & 7) * 32 + (c & 31)) * 2; }
__device__ __forceinline__ int v_rd_base(int lane) { return ((lane & 3) << 3) | (((lane >> 2) & 3) << 6) | (((lane >> 4) & 1) << 5) | (((lane >> 5) & 1) << 8); }
constexpr int v_rd_off(int d0, int ks, int half) { return d0 * 512 + ks * 4096 + half * 2048; }
template <int OFF> __device__ __forceinline__ s16x4 tr_read(int vb) {
    s16x4 r; asm volatile("ds_read_b64_tr_b16 %0, %1 offset:%2" : "=&v"(r) : "v"(vb), "i"(OFF) : "memory"); return r;
}
template <int D0> __device__ __forceinline__ void pv_one(f32x16& od, int vb, bf16x8 pa0, bf16x8 pa1, bf16x8 pa2, bf16x8 pa3) {
    const s16x4 l0 = tr_read<v_rd_off(D0, 0, 0)>(vb), h0 = tr_read<v_rd_off(D0, 0, 1)>(vb), l1 = tr_read<v_rd_off(D0, 1, 0)>(vb), h1 = tr_read<v_rd_off(D0, 1, 1)>(vb);
    const s16x4 l2 = tr_read<v_rd_off(D0, 2, 0)>(vb), h2 = tr_read<v_rd_off(D0, 2, 1)>(vb), l3 = tr_read<v_rd_off(D0, 3, 0)>(vb), h3 = tr_read<v_rd_off(D0, 3, 1)>(vb);
    asm volatile("s_waitcnt lgkmcnt(0)" ::: "memory"); SBAR();
#define PK(L, H) (bf16x8){L[0], L[1], L[2], L[3], H[0], H[1], H[2], H[3]}
    od = __builtin_amdgcn_mfma_f32_32x32x16_bf16(pa0, PK(l0, h0), od, 0, 0, 0);
    od = __builtin_amdgcn_mfma_f32_32x32x16_bf16(pa1, PK(l1, h1), od, 0, 0, 0);
    od = __builtin_amdgcn_mfma_f32_32x32x16_bf16(pa2, PK(l2, h2), od, 0, 0, 0);
    od = __builtin_amdgcn_mfma_f32_32x32x16_bf16(pa3, PK(l3, h3), od, 0, 0, 0);
}
__device__ __forceinline__ void pv_d0(f32x16* o, int vb, bf16x8 pa0, bf16x8 pa1, bf16x8 pa2, bf16x8 pa3) {
    pv_one<0>(o[0], vb, pa0, pa1, pa2, pa3); pv_one<1>(o[1], vb, pa0, pa1, pa2, pa3); pv_one<2>(o[2], vb, pa0, pa1, pa2, pa3); pv_one<3>(o[3], vb, pa0, pa1, pa2, pa3);
}
template <int D0> __device__ __forceinline__ void pv_one32(f32x16& od, int vb, bf16x8 pa0, bf16x8 pa1) {
    const s16x4 l0 = tr_read<v_rd_off(D0, 0, 0)>(vb), h0 = tr_read<v_rd_off(D0, 0, 1)>(vb), l1 = tr_read<v_rd_off(D0, 1, 0)>(vb), h1 = tr_read<v_rd_off(D0, 1, 1)>(vb);
    asm volatile("s_waitcnt lgkmcnt(0)" ::: "memory"); SBAR();
    od = __builtin_amdgcn_mfma_f32_32x32x16_bf16(pa0, PK(l0, h0), od, 0, 0, 0);
    od = __builtin_amdgcn_mfma_f32_32x32x16_bf16(pa1, PK(l1, h1), od, 0, 0, 0);
}
#undef PK
#define PK4(P, BASE, OUT) do { unsigned a0 = cvtpk(P[BASE + 0], P[BASE + 1]), a1 = cvtpk(P[BASE + 2], P[BASE + 3]);   \
    unsigned b0 = cvtpk(P[BASE + 4], P[BASE + 5]), b1 = cvtpk(P[BASE + 6], P[BASE + 7]);                              \
    auto r0 = __builtin_amdgcn_permlane32_swap(a0, b0, false, false); auto r1 = __builtin_amdgcn_permlane32_swap(a1, b1, false, false); \
    u32x4 w = {r0[0], r1[0], r0[1], r1[1]}; OUT = *reinterpret_cast<bf16x8*>(&w); } while (0)

template <int NDQ> struct Cst { static constexpr float SCALE = (NDQ == 8) ? 0.088388347648318440f : 0.072168783648703220f; static constexpr float C = SCALE * LOG2E; };

template <int NDQ>
__device__ __forceinline__ void partialSM(f32x16& p0, f32x16& p1, float& m_reg, float& mn, float& alpha) {
    constexpr float C = Cst<NDQ>::C, SCALE = Cst<NDQ>::SCALE;
    float pmax = p0[0];
#pragma unroll
    for (int r = 1; r < 16; ++r) pmax = fmaxf(pmax, p0[r]);
#pragma unroll
    for (int r = 0; r < 16; ++r) pmax = fmaxf(pmax, p1[r]);
    { auto rr = __builtin_amdgcn_permlane32_swap(__float_as_uint(pmax), __float_as_uint(pmax), false, false);
      pmax = fmaxf(__uint_as_float(rr[0]), __uint_as_float(rr[1])); }
    if (__builtin_expect(__all(pmax - m_reg <= THR / SCALE), 1)) { mn = m_reg; alpha = 1.f; }
    else { mn = fmaxf(m_reg, pmax); alpha = __builtin_amdgcn_exp2f((m_reg - mn) * C); m_reg = mn; }
    const float mnC = -mn * C;
#pragma unroll
    for (int r = 0; r < 16; ++r) p0[r] = fmaf(p0[r], C, mnC);
#pragma unroll
    for (int r = 0; r < 16; ++r) p1[r] = fmaf(p1[r], C, mnC);
#pragma unroll
    for (int r = 0; r < 16; ++r) p0[r] = __builtin_amdgcn_exp2f(p0[r]);
}
__device__ __forceinline__ void finishSM(f32x16& p0, f32x16& p1, float alpha, float& l_reg, bf16x8& pa0, bf16x8& pa1, bf16x8& pa2, bf16x8& pa3) {
#pragma unroll
    for (int r = 0; r < 16; ++r) p1[r] = __builtin_amdgcn_exp2f(p1[r]);
    float ps = 0;
#pragma unroll
    for (int r = 0; r < 16; ++r) ps += p0[r];
#pragma unroll
    for (int r = 0; r < 16; ++r) ps += p1[r];
    { auto rr = __builtin_amdgcn_permlane32_swap(__float_as_uint(ps), __float_as_uint(ps), false, false);
      ps = __uint_as_float(rr[0]) + __uint_as_float(rr[1]); }
    l_reg = l_reg * alpha + ps;
    PK4(p0, 0, pa0); PK4(p0, 8, pa1); PK4(p1, 0, pa2); PK4(p1, 8, pa3);
}
template <int NDQ>
__device__ __forceinline__ void qkt(f32x16& p0, f32x16& p1, const char* Ks, const char* Krs, const bf16x8* qr, const char* qrl, int r32, int hi) {
    p0 = f32x16{}; p1 = f32x16{};
#pragma unroll
    for (int d0 = 0; d0 < 8; ++d0) { const int cb = (d0 * 16 + hi * 8) * 2;
        bf16x8 b0 = *reinterpret_cast<const bf16x8*>(Ks + KSWZ(r32, cb));
        bf16x8 b1 = *reinterpret_cast<const bf16x8*>(Ks + KSWZ(32 + r32, cb));
        p0 = __builtin_amdgcn_mfma_f32_32x32x16_bf16(b0, qr[d0], p0, 0, 0, 0);
        p1 = __builtin_amdgcn_mfma_f32_32x32x16_bf16(b1, qr[d0], p1, 0, 0, 0); }
    if constexpr (NDQ == 12) {
#pragma unroll
        for (int d0 = 0; d0 < 4; ++d0) { const int ch = d0 * 2 + hi;
            bf16x8 b0 = *reinterpret_cast<const bf16x8*>(Krs + KRSWZ(r32, ch));
            bf16x8 b1 = *reinterpret_cast<const bf16x8*>(Krs + KRSWZ(32 + r32, ch));
            const bf16x8 qf = *reinterpret_cast<const bf16x8*>(qrl + d0 * 1024);
            p0 = __builtin_amdgcn_mfma_f32_32x32x16_bf16(b0, qf, p0, 0, 0, 0);
            p1 = __builtin_amdgcn_mfma_f32_32x32x16_bf16(b1, qf, p1, 0, 0, 0); }
    }
}

struct DArgs { const bf16_t* Q; const bf16_t* K; const bf16_t* V; const bf16_t* Kr; bf16_t* O; int ldq, ldk, ldv, ldo; int seq; int pos0; };

template <int NDQ, int SDEPTH>
__device__ __forceinline__ void attn_dense_body(int wv, const DArgs a, char* lds) {
    const int tid = fresh_tid(wv), wid = tid >> 6, lane = tid & 63, r32 = lane & 31, hi = lane >> 5;
    char* V_lds = lds + OFF_V; char* K_lds = lds + OFF_K; char* Kr_lds = lds + OFF_KR;
    float* ws = (float*)(lds + OFF_WS) + wid * 64; float* li_l = ws; float* al_l = ws + 32;
    float m_reg = -1e30f, l_reg = 0; f32x16 o[4] = {}; bf16x8 qr[8];
    char* qrl = lds + OFF_QR + wid * 4096 + lane * 16;
    const bf16_t* Qw = a.Q + (long)(wid * 32 + r32) * a.ldq + hi * 8;
#pragma unroll
    for (int d0 = 0; d0 < 8; ++d0) qr[d0] = *reinterpret_cast<const bf16x8*>(Qw + d0 * 16);
    if constexpr (NDQ == 12) {
        const float pos = (float)(a.pos0 + wid * 32 + r32);
#pragma unroll
        for (int f = 0; f < 2; ++f) {
            const bf16x8 x1v = *reinterpret_cast<const bf16x8*>(Qw + (8 + f) * 16), x2v = *reinterpret_cast<const bf16x8*>(Qw + (10 + f) * 16); bf16x8 y1v, y2v;
#pragma unroll
            for (int j = 0; j < 8; ++j) { const int i = f * 16 + hi * 8 + j; float sn, cs; sincos_rev(pos * inv_freq32(i), sn, cs);
                const float x1 = bf2f((unsigned short)x1v[j]), x2 = bf2f((unsigned short)x2v[j]);
                y1v[j] = (short)f2bf(x1 * cs - x2 * sn); y2v[j] = (short)f2bf(x2 * cs + x1 * sn); }
            *reinterpret_cast<bf16x8*>(qrl + f * 1024) = y1v; *reinterpret_cast<bf16x8*>(qrl + (2 + f) * 1024) = y2v;
        }
    }
    const int sr = tid >> 4, sc = (tid & 15) * 8, vst0 = v_st(sr, sc), vst1 = v_st(32 + sr, sc);
    const int krr = tid >> 3, krc = tid & 7;
    const int vb0 = (int)(uintptr_t)V_lds + v_rd_base(lane);
    struct { bf16x8 vs0, vs1, ks0, ks1, kr; } sr_[SDEPTH];
#define SLOAD(i, k0) do { sr_[i].vs0 = *(const bf16x8*)(a.V + (long)((k0) + sr) * a.ldv + sc); sr_[i].vs1 = *(const bf16x8*)(a.V + (long)((k0) + 32 + sr) * a.ldv + sc); \
    sr_[i].ks0 = *(const bf16x8*)(a.K + (long)((k0) + sr) * a.ldk + sc); sr_[i].ks1 = *(const bf16x8*)(a.K + (long)((k0) + 32 + sr) * a.ldk + sc); \
    if constexpr (NDQ == 12) sr_[i].kr = *(const bf16x8*)(a.Kr + (long)((k0) + krr) * 64 + krc * 8); } while (0)
#define SWRITE(b, i) do { *(bf16x8*)(V_lds + (b) * SHM_V + vst0) = sr_[i].vs0; *(bf16x8*)(V_lds + (b) * SHM_V + vst1) = sr_[i].vs1; const int kc = sc * 2; \
    *(bf16x8*)(K_lds + (b) * SHM_K + KSWZ(sr, kc)) = sr_[i].ks0; *(bf16x8*)(K_lds + (b) * SHM_K + KSWZ(32 + sr, kc)) = sr_[i].ks1; \
    if constexpr (NDQ == 12) *(bf16x8*)(Kr_lds + (b) * SHM_KR + KRSWZ(krr, krc)) = sr_[i].kr; } while (0)
#define SWAIT() do { if constexpr (SDEPTH == 2) { if constexpr (NDQ == 12) asm volatile("s_waitcnt vmcnt(5)" ::: "memory"); else asm volatile("s_waitcnt vmcnt(4)" ::: "memory"); } else asm volatile("s_waitcnt vmcnt(0)" ::: "memory"); } while (0)
#define RESC(al) do { if (__any((al) < 1.f)) { if (hi == 0) al_l[r32] = (al); asm volatile("s_waitcnt lgkmcnt(0)" ::: "memory"); \
    _Pragma("unroll") for (int d = 0; d < 4; ++d) _Pragma("unroll") for (int r = 0; r < 16; ++r) o[d][r] *= al_l[crow(r, hi)]; } } while (0)
    f32x16 pA0, pA1, pB0, pB1; float mnA, mnB, alA, alB; bf16x8 pa0, pa1, pa2, pa3; const int NT = a.seq / KVBLK;
    constexpr int SE = 0, SO = SDEPTH - 1;
    SLOAD(SE, 0); asm volatile("s_waitcnt vmcnt(0)" ::: "memory"); SWRITE(0, SE); __syncthreads();
    qkt<NDQ>(pA0, pA1, K_lds, Kr_lds, qr, qrl, r32, hi); partialSM<NDQ>(pA0, pA1, m_reg, mnA, alA);
    SLOAD(SO, KVBLK); if constexpr (SDEPTH == 2) { if (2 < NT) SLOAD(SE, 2 * KVBLK); }
    SWAIT(); SWRITE(1, SO); __syncthreads();
#pragma unroll 1
    for (int j = 1; j + 1 < NT; j += 2) {
        SBAR(); qkt<NDQ>(pB0, pB1, K_lds + SHM_K, Kr_lds + SHM_KR, qr, qrl, r32, hi);
        finishSM(pA0, pA1, alA, l_reg, pa0, pa1, pa2, pa3); SBAR();
        SLOAD(SO, (j + SDEPTH) * KVBLK); SBAR();
        pv_d0(o, vb0, pa0, pa1, pa2, pa3); partialSM<NDQ>(pB0, pB1, m_reg, mnB, alB);
        __syncthreads(); SWAIT(); SWRITE(0, SE);
        RESC(alB); __syncthreads();
        SBAR(); qkt<NDQ>(pA0, pA1, K_lds, Kr_lds, qr, qrl, r32, hi);
        finishSM(pB0, pB1, alB, l_reg, pa0, pa1, pa2, pa3); SBAR();
        if (SDEPTH == 1 || j + 3 < NT) SLOAD(SE, (j + 1 + SDEPTH) * KVBLK); SBAR();
        pv_d0(o, vb0 + (int)SHM_V, pa0, pa1, pa2, pa3); partialSM<NDQ>(pA0, pA1, m_reg, mnA, alA);
        __syncthreads(); SWAIT(); SWRITE(1, SO);
        RESC(alA); __syncthreads();
    }
    SBAR(); qkt<NDQ>(pB0, pB1, K_lds + SHM_K, Kr_lds + SHM_KR, qr, qrl, r32, hi);
    finishSM(pA0, pA1, alA, l_reg, pa0, pa1, pa2, pa3); SBAR();
    pv_d0(o, vb0, pa0, pa1, pa2, pa3); partialSM<NDQ>(pB0, pB1, m_reg, mnB, alB);
    __syncthreads(); RESC(alB);
    finishSM(pB0, pB1, alB, l_reg, pa0, pa1, pa2, pa3); SBAR();
    pv_d0(o, vb0 + (int)SHM_V, pa0, pa1, pa2, pa3);
    if (hi == 0) li_l[r32] = l_reg; asm volatile("s_waitcnt lgkmcnt(0)" ::: "memory");
    float rli[16];
#pragma unroll
    for (int r = 0; r < 16; ++r) rli[r] = __builtin_amdgcn_rcpf(li_l[crow(r, hi)]);
    bf16_t* Ow = F8_OUT ? (bf16_t*)((unsigned char*)a.O + (long)(wid * 32) * a.ldo) : a.O + (long)(wid * 32) * a.ldo;
#pragma unroll
    for (int r = 0; r < 16; ++r) { const int orow = crow(r, hi);
#pragma unroll
        for (int d0 = 0; d0 < 4; ++d0) { if constexpr (F8_OUT) ((unsigned char*)Ow)[(long)orow * a.ldo + d0 * 32 + r32] = f2fp8(o[d0][r] * rli[r] * O8_SCALE); else Ow[(long)orow * a.ldo + d0 * 32 + r32] = f2bf(o[d0][r] * rli[r]); } }
#undef SLOAD
#undef SWRITE
#undef SWAIT
#undef RESC
}

constexpr int SP_WAVE_LDS = 18688;
template <class P>
__device__ __forceinline__ void sparse_wave(P& pol, LAS unsigned char* wll, int lane) {
    const int r32 = lane & 31, hi = lane >> 5;
    char* wl = (char*)wll;
    char* Kl = wl; char* Vl = wl + 8192; float* li_l = (float*)(wl + 16384); float* al_l = li_l + 32;
    bf16x8 qr[8];
    { const bf16_t* qp = pol.qptr(r32) + hi * 8;
#pragma unroll
      for (int d0 = 0; d0 < 8; ++d0) qr[d0] = *reinterpret_cast<const bf16x8*>(qp + d0 * 16); }
    asm volatile("s_waitcnt vmcnt(0)" ::: "memory");
    f32x16 o[4] = {}; float m_reg = -1e30f, l_reg = 0.f;
    const int krow0 = lane >> 4;
    const int kce = (((lane & 15) ^ (krow0 & 7)) * 8), kco = (((lane & 15) ^ ((4 + krow0) & 7)) * 8);
    const int vk0 = 8 * ((lane >> 4) & 1) + ((lane >> 2) & 3), vc0 = 32 * (lane >> 5) + 8 * (lane & 3);
    const int vb = (int)(uintptr_t)Vl + v_rd_base(lane);
    const int nt = pol.ntiles();
    typename P::TI ti, tn;
#define SP_DMA_K(T) do { _Pragma("unroll") for (int i = 0; i < 8; ++i) { const bf16_t* src = (T).k + (long)(4 * i + krow0) * (T).rs + ((i & 1) ? kco : kce); \
        __builtin_amdgcn_global_load_lds((const unsigned*)src, (LAS unsigned*)(wll + i * 1024), 16, 0, 0); } } while (0)
#define SP_DMA_V(T) do { _Pragma("unroll") for (int i = 0; i < 8; ++i) { const bf16_t* src = (T).v + (long)(16 * (i >> 2) + 4 * ((i >> 1) & 1) + vk0) * (T).rs + 64 * (i & 1) + vc0; \
        __builtin_amdgcn_global_load_lds((const unsigned*)src, (LAS unsigned*)(wll + 8192 + i * 1024), 16, 0, 0); } } while (0)
    pol.tile(0, ti);
    SP_DMA_K(ti); SP_DMA_V(ti);
#pragma unroll 1
    for (int j = 0; j < nt; ++j) {
        const bool more = (j + 1 < nt);
        if (more) pol.tile(j + 1, tn);
        asm volatile("s_waitcnt vmcnt(8)" ::: "memory");
        f32x16 p = f32x16{};
#pragma unroll
        for (int d0 = 0; d0 < 8; ++d0) { const int cb = (d0 * 16 + hi * 8) * 2;
            bf16x8 b0 = *reinterpret_cast<const bf16x8*>(Kl + KSWZ(r32, cb));
            p = __builtin_amdgcn_mfma_f32_32x32x16_bf16(b0, qr[d0], p, 0, 0, 0); }
        asm volatile("s_waitcnt lgkmcnt(0)" ::: "memory"); SBAR();
        if (more) SP_DMA_K(tn);
        SBAR();
        float pmax = -INFINITY;
#pragma unroll
        for (int r = 0; r < 16; ++r) { p[r] = pol.adj(ti, crow(r, hi), p[r]); pmax = fmaxf(pmax, p[r]); }
        { auto rr = __builtin_amdgcn_permlane32_swap(__float_as_uint(pmax), __float_as_uint(pmax), false, false);
          pmax = fmaxf(__uint_as_float(rr[0]), __uint_as_float(rr[1])); }
        const float mn = fmaxf(m_reg, pmax); const float alpha = __builtin_amdgcn_exp2f(m_reg - mn); m_reg = mn;
        float ps = 0.f;
#pragma unroll
        for (int r = 0; r < 16; ++r) { p[r] = __builtin_amdgcn_exp2f(p[r] - mn); ps += p[r]; }
        { auto rr = __builtin_amdgcn_permlane32_swap(__float_as_uint(ps), __float_as_uint(ps), false, false);
          ps = __uint_as_float(rr[0]) + __uint_as_float(rr[1]); }
        l_reg = l_reg * alpha + ps;
        if (__any(alpha < 1.f)) { if (hi == 0) al_l[r32] = alpha; asm volatile("s_waitcnt lgkmcnt(0)" ::: "memory");
#pragma unroll
            for (int d = 0; d < 4; ++d)
#pragma unroll
                for (int r = 0; r < 16; ++r) o[d][r] *= al_l[crow(r, hi)]; }
        bf16x8 pa0, pa1; PK4(p, 0, pa0); PK4(p, 8, pa1);
        SBAR();
        if (more) asm volatile("s_waitcnt vmcnt(8)" ::: "memory"); else asm volatile("s_waitcnt vmcnt(0)" ::: "memory");
        SBAR();
        pv_one32<0>(o[0], vb, pa0, pa1); pv_one32<1>(o[1], vb, pa0, pa1); pv_one32<2>(o[2], vb, pa0, pa1); pv_one32<3>(o[3], vb, pa0, pa1);
        SBAR();
        if (more) SP_DMA_V(tn);
        SBAR();
        ti = tn;
    }
#undef SP_DMA_K
#undef SP_DMA_V
    if (hi == 0) li_l[r32] = l_reg; asm volatile("s_waitcnt lgkmcnt(0)" ::: "memory");
#pragma unroll
    for (int r = 0; r < 16; ++r) { const int qn = crow(r, hi); const float rl = __builtin_amdgcn_rcpf(li_l[qn]); bf16_t* op = pol.optr(qn);
#pragma unroll
        for (int d0 = 0; d0 < 4; ++d0) { if constexpr (F8_OUT) ((unsigned char*)op)[d0 * 32 + r32] = f2fp8(o[d0][r] * rl * O8_SCALE); else op[d0 * 32 + r32] = f2bf(o[d0][r] * rl); } }
}
#undef PK4
}

#define SBAR() __builtin_amdgcn_sched_barrier(0)
namespace d8 {
constexpr int K8_BYTES = 64 * 128, KR8_BYTES = 64 * 64, VT_PITCH = 80, VT_BYTES = 128 * VT_PITCH;
constexpr int OFF_K8 = 0, OFF_KR8 = 2 * K8_BYTES, OFF_VT = OFF_KR8 + 2 * KR8_BYTES, OFF_WS8 = OFF_VT + 2 * VT_BYTES, LDS_D8 = OFF_WS8 + 8 * 64 * 4;
constexpr float THR8 = 4.f;
#define K8SWZ(row, ch) ((row) * 128 + ((((ch) ^ ((row) >> 1)) & 7) << 4))
#define KR8SWZ(row, ch) ((row) * 64 + ((((ch) ^ ((row) >> 2)) & 3) << 4))
__device__ __forceinline__ int krow_of(int a) { const int hi = a >> 5, j = a & 31; return da::crow(j & 15, hi) + 32 * (j >> 4); }
struct D8Args { const bf16_t* Q; const unsigned char* K8; const unsigned char* Kr8; const unsigned char* Vt8; bf16_t* O; int ldq, ldk, ldvt, ldo; int seq; int pos0; };
template <int NKS> struct Cst8 { static constexpr float SCALE = (NKS == 2) ? 0.088388347648318440f : 0.072168783648703220f; static constexpr float C = SCALE * LOG2E; };
#define D8_LD32(dst, p) do { const i32x4 _lo = *(const i32x4*)(p), _hi = *(const i32x4*)((p) + 16); dst = __builtin_shufflevector(_lo, _hi, 0, 1, 2, 3, 4, 5, 6, 7); } while (0)
#define D8_MX(a, b, c) __builtin_amdgcn_mfma_scale_f32_32x32x64_f8f6f4(a, b, c, 0, 0, 0, 0, 0, 0)
template <int NKS, bool MACC = (NKS == 2)>
__device__ __forceinline__ void qkt8(f32x16& p0, f32x16& p1, const f32x16& mneg, const char* Ks, const char* Krs, const i32x8* qf, int r32, int hi) {
    i32x8 a0[2], a1[2];
#pragma unroll
    for (int sK = 0; sK < 2; ++sK) { const int ch = 4 * sK + 2 * hi;
        { const i32x4 lo = *(const i32x4*)(Ks + K8SWZ(r32, ch)), hh = *(const i32x4*)(Ks + K8SWZ(r32, ch + 1)); a0[sK] = __builtin_shufflevector(lo, hh, 0, 1, 2, 3, 4, 5, 6, 7); }
        { const i32x4 lo = *(const i32x4*)(Ks + K8SWZ(32 + r32, ch)), hh = *(const i32x4*)(Ks + K8SWZ(32 + r32, ch + 1)); a1[sK] = __builtin_shufflevector(lo, hh, 0, 1, 2, 3, 4, 5, 6, 7); } }
    asm volatile("s_waitcnt lgkmcnt(0)" ::: "memory"); SBAR();
    if constexpr (MACC) {
        asm volatile("v_mfma_f32_32x32x64_f8f6f4 %0, %1, %2, %3" : "=&v"(p0) : "v"(a0[0]), "v"(qf[0]), "v"(mneg));
        asm volatile("v_mfma_f32_32x32x64_f8f6f4 %0, %1, %2, %3" : "=&v"(p1) : "v"(a1[0]), "v"(qf[0]), "v"(mneg)); }
    else { p0 = f32x16{}; p1 = f32x16{}; p0 = D8_MX(a0[0], qf[0], p0); p1 = D8_MX(a1[0], qf[0], p1); }
    if constexpr (NKS == 3) { i32x8 r0, r1; const int ch = 2 * hi;
        { const i32x4 lo = *(const i32x4*)(Krs + KR8SWZ(r32, ch)), hh = *(const i32x4*)(Krs + KR8SWZ(r32, ch + 1)); r0 = __builtin_shufflevector(lo, hh, 0, 1, 2, 3, 4, 5, 6, 7); }
        { const i32x4 lo = *(const i32x4*)(Krs + KR8SWZ(32 + r32, ch)), hh = *(const i32x4*)(Krs + KR8SWZ(32 + r32, ch + 1)); r1 = __builtin_shufflevector(lo, hh, 0, 1, 2, 3, 4, 5, 6, 7); }
        p0 = D8_MX(a0[1], qf[1], p0); p1 = D8_MX(a1[1], qf[1], p1);
        p0 = D8_MX(r0, qf[2], p0); p1 = D8_MX(r1, qf[2], p1); }
    else { p0 = D8_MX(a0[1], qf[1], p0); p1 = D8_MX(a1[1], qf[1], p1); }
}
template <bool FIRST, bool SPLAT = false>
__device__ __forceinline__ void partialSM8(f32x16& p0, f32x16& p1, float& m_reg, f32x16& mneg, float& alpha) {
    float pmax = p0[0];
#pragma unroll
    for (int r = 1; r < 16; ++r) pmax = fmaxf(pmax, p0[r]);
#pragma unroll
    for (int r = 0; r < 16; ++r) pmax = fmaxf(pmax, p1[r]);
    { auto rr = __builtin_amdgcn_permlane32_swap(__float_as_uint(pmax), __float_as_uint(pmax), false, false);
      pmax = fmaxf(__uint_as_float(rr[0]), __uint_as_float(rr[1])); }
    if (!FIRST && __builtin_expect(__all(pmax <= THR8 * LOG2E), 1)) { alpha = 1.f; }
    else { const float delta = FIRST ? pmax : fmaxf(pmax, 0.f); alpha = FIRST ? 1.f : __builtin_amdgcn_exp2f(-delta); m_reg += delta;
#pragma unroll
        for (int r = 0; r < 16; ++r) { p0[r] -= delta; p1[r] -= delta; }
        if constexpr (!SPLAT) { const float nm = -m_reg;
#pragma unroll
            for (int r = 0; r < 16; ++r) mneg[r] = nm; } }
    if constexpr (SPLAT) { float nm = -m_reg; asm volatile("" : "+v"(nm));
#pragma unroll
        for (int r = 0; r < 16; ++r) mneg[r] = nm; }
#pragma unroll
    for (int r = 0; r < 16; ++r) p0[r] = __builtin_amdgcn_exp2f(p0[r]);
}
template <int NKS>
__device__ __forceinline__ void partialSM8z(f32x16& p0, f32x16& p1, float& m_reg, float& alpha) {
    constexpr float C = Cst8<NKS>::C, SCALE = Cst8<NKS>::SCALE; float mn;
    float pmax = p0[0];
#pragma unroll
    for (int r = 1; r < 16; ++r) pmax = fmaxf(pmax, p0[r]);
#pragma unroll
    for (int r = 0; r < 16; ++r) pmax = fmaxf(pmax, p1[r]);
    { auto rr = __builtin_amdgcn_permlane32_swap(__float_as_uint(pmax), __float_as_uint(pmax), false, false);
      pmax = fmaxf(__uint_as_float(rr[0]), __uint_as_float(rr[1])); }
    if (__builtin_expect(__all(pmax - m_reg <= THR8 / SCALE), 1)) { mn = m_reg; alpha = 1.f; }
    else { mn = fmaxf(m_reg, pmax); alpha = __builtin_amdgcn_exp2f((m_reg - mn) * C); m_reg = mn; }
    const float mnC = -mn * C;
#pragma unroll
    for (int r = 0; r < 16; ++r) p0[r] = fmaf(p0[r], C, mnC);
#pragma unroll
    for (int r = 0; r < 16; ++r) p1[r] = fmaf(p1[r], C, mnC);
#pragma unroll
    for (int r = 0; r < 16; ++r) p0[r] = __builtin_amdgcn_exp2f(p0[r]);
}
__device__ __forceinline__ void finishSM8n(f32x16& p0, f32x16& p1, i32x8& pa) {
#pragma unroll
    for (int r = 0; r < 16; ++r) p1[r] = __builtin_amdgcn_exp2f(p1[r]);
    pa = (i32x8){(int)pk4_fp8(p0[0], p0[1], p0[2], p0[3]), (int)pk4_fp8(p0[4], p0[5], p0[6], p0[7]), (int)pk4_fp8(p0[8], p0[9], p0[10], p0[11]), (int)pk4_fp8(p0[12], p0[13], p0[14], p0[15]),
                 (int)pk4_fp8(p1[0], p1[1], p1[2], p1[3]), (int)pk4_fp8(p1[4], p1[5], p1[6], p1[7]), (int)pk4_fp8(p1[8], p1[9], p1[10], p1[11]), (int)pk4_fp8(p1[12], p1[13], p1[14], p1[15])};
}
__device__ __forceinline__ void finishSM8(f32x16& p0, f32x16& p1, float alpha, float& l_reg, i32x8& pa) {
#pragma unroll
    for (int r = 0; r < 16; ++r) p1[r] = __builtin_amdgcn_exp2f(p1[r]);
    float ps = 0;
#pragma unroll
    for (int r = 0; r < 16; ++r) ps += p0[r];
#pragma unroll
    for (int r = 0; r < 16; ++r) ps += p1[r];
    { auto rr = __builtin_amdgcn_permlane32_swap(__float_as_uint(ps), __float_as_uint(ps), false, false);
      ps = __uint_as_float(rr[0]) + __uint_as_float(rr[1]); }
    l_reg = l_reg * alpha + ps;
    pa = (i32x8){(int)pk4_fp8(p0[0], p0[1], p0[2], p0[3]), (int)pk4_fp8(p0[4], p0[5], p0[6], p0[7]), (int)pk4_fp8(p0[8], p0[9], p0[10], p0[11]), (int)pk4_fp8(p0[12], p0[13], p0[14], p0[15]),
                 (int)pk4_fp8(p1[0], p1[1], p1[2], p1[3]), (int)pk4_fp8(p1[4], p1[5], p1[6], p1[7]), (int)pk4_fp8(p1[8], p1[9], p1[10], p1[11]), (int)pk4_fp8(p1[12], p1[13], p1[14], p1[15])};
}
__device__ __forceinline__ void pv8(f32x16* o, const char* Vt, const i32x8 pa, int r32, int hi) {
    i32x8 bfr[4];
#pragma unroll
    for (int d0 = 0; d0 < 4; ++d0) { const char* vp = Vt + (32 * d0 + r32) * VT_PITCH + 32 * hi;
        const i32x4 lo = *(const i32x4*)vp, hh = *(const i32x4*)(vp + 16); bfr[d0] = __builtin_shufflevector(lo, hh, 0, 1, 2, 3, 4, 5, 6, 7); }
    asm volatile("s_waitcnt lgkmcnt(0)" ::: "memory"); SBAR();
#pragma unroll
    for (int d0 = 0; d0 < 4; ++d0) o[d0] = D8_MX(pa, bfr[d0], o[d0]);
}
#define D8Q(P0, P1, KS, KRS, QF, R32, HI) do { if constexpr (VAR == 3) { P0 = f32x16{}; P1 = f32x16{}; } else qkt8<NKS>(P0, P1, mneg, KS, KRS, QF, R32, HI); } while (0)
#define D8P(FIRST, P0, P1, MR, AL) do { if constexpr (VAR == 1) { AL = 1.f; } else if constexpr (NKS == 2) partialSM8<FIRST>(P0, P1, MR, mneg, AL); else partialSM8z<NKS>(P0, P1, MR, AL); } while (0)
#define D8F(P0, P1, AL, LR, PA) do { if constexpr (VAR == 1) { PA = (i32x8){(int)pk4_fp8(P0[0], P0[1], P0[2], P0[3]), (int)pk4_fp8(P0[4], P0[5], P0[6], P0[7]), (int)pk4_fp8(P0[8], P0[9], P0[10], P0[11]), (int)pk4_fp8(P0[12], P0[13], P0[14], P0[15]), \
        (int)pk4_fp8(P1[0], P1[1], P1[2], P1[3]), (int)pk4_fp8(P1[4], P1[5], P1[6], P1[7]), (int)pk4_fp8(P1[8], P1[9], P1[10], P1[11]), (int)pk4_fp8(P1[12], P1[13], P1[14], P1[15])}; LR += 1.f; } else finishSM8(P0, P1, AL, LR, PA); } while (0)
#define D8V(O, VT, PA, R32, HI) do { if constexpr (VAR != 3) pv8(O, VT, PA, R32, HI); } while (0)
template <int NKS, int VAR = 0>
__device__ __forceinline__ void attn_dense8_body(int wv, const D8Args a, char* lds) {
    const int tid = fresh_tid(wv), wid = tid >> 6, lane = tid & 63, r32 = lane & 31, hi = lane >> 5;
    char* K_lds = lds + OFF_K8; char* Kr_lds = lds + OFF_KR8; char* Vt_lds = lds + OFF_VT;
    float* ws = (float*)(lds + OFF_WS8) + wid * 64; float* li_l = ws; float* al_l = ws + 32;
    float m_reg = (NKS == 2) ? 0.f : -1e30f, l_reg = 0; f32x16 o[4] = {}; i32x8 qf[NKS]; f32x16 mneg = {};
    constexpr float QC = (NKS == 2) ? Cst8<NKS>::C : 1.0f;
    { const bf16_t* Qw = a.Q + (long)(wid * 32 + r32) * a.ldq;
#pragma unroll
      for (int sK = 0; sK < 2; ++sK) { const bf16_t* qp = Qw + 64 * sK + 32 * hi; unsigned w[8];
#pragma unroll
          for (int c = 0; c < 4; ++c) { const u32x4 v = *(const u32x4*)(qp + 8 * c);
              w[2 * c] = pk4_fp8(bflo(v.x) * QC, bfhi(v.x) * QC, bflo(v.y) * QC, bfhi(v.y) * QC); w[2 * c + 1] = pk4_fp8(bflo(v.z) * QC, bfhi(v.z) * QC, bflo(v.w) * QC, bfhi(v.w) * QC); }
          qf[sK] = (i32x8){(int)w[0], (int)w[1], (int)w[2], (int)w[3], (int)w[4], (int)w[5], (int)w[6], (int)w[7]}; }
      if constexpr (NKS == 3) {
          const float pos = (float)(a.pos0 + wid * 32 + r32); const bf16_t* qp = Qw + 128; unsigned w[8];
#pragma unroll
          for (int c = 0; c < 4; ++c) { const u32x4 v1 = *(const u32x4*)(qp + 8 * c), v2 = *(const u32x4*)(qp + 32 + 8 * c);
              const unsigned a1[4] = {v1.x, v1.y, v1.z, v1.w}, a2[4] = {v2.x, v2.y, v2.z, v2.w}; float y[8];
#pragma unroll
              for (int e = 0; e < 8; ++e) { const int i = 8 * c + e; float sn, cs; sincos_rev(pos * inv_freq32(i), sn, cs);
                  const float x1 = (e & 1) ? bfhi(a1[e >> 1]) : bflo(a1[e >> 1]), x2 = (e & 1) ? bfhi(a2[e >> 1]) : bflo(a2[e >> 1]);
                  y[e] = (hi ? (x2 * cs + x1 * sn) : (x1 * cs - x2 * sn)) * QC; }
              w[2 * c] = pk4_fp8(y[0], y[1], y[2], y[3]); w[2 * c + 1] = pk4_fp8(y[4], y[5], y[6], y[7]); }
          qf[2] = (i32x8){(int)w[0], (int)w[1], (int)w[2], (int)w[3], (int)w[4], (int)w[5], (int)w[6], (int)w[7]}; } }
    const int ka = tid >> 3, kch = tid & 7, kdst = K8SWZ(krow_of(ka), kch);
    const int vc = tid >> 2, vq = tid & 3, vdst = vc * VT_PITCH + vq * 16;
    const int ra = (tid >> 2) & 63, rch = tid & 3, rdst = KR8SWZ(krow_of(ra), rch);
    struct { u32x4 k, v, r; } sr_[2];
    if constexpr (VAR == 2) { sr_[0].k = sr_[0].v = sr_[0].r = sr_[1].k = sr_[1].v = sr_[1].r = (u32x4){0x38383838u, 0x38383838u, 0x38383838u, 0x38383838u}; }
#define SLOAD8(i, k0) do { if constexpr (VAR == 2) break; sr_[i].k = *(const u32x4*)(a.K8 + (long)((k0) + ka) * a.ldk + kch * 16); sr_[i].v = *(const u32x4*)(a.Vt8 + (long)vc * a.ldvt + (k0) + vq * 16); \
    if constexpr (NKS == 3) sr_[i].r = *(const u32x4*)(a.Kr8 + (long)((k0) + ra) * 64 + rch * 16); } while (0)
#define SWRITE8(b, i) do { if constexpr (VAR == 4) break; *(u32x4*)(K_lds + (b) * K8_BYTES + kdst) = sr_[i].k; *(u32x4*)(Vt_lds + (b) * VT_BYTES + vdst) = sr_[i].v; \
    if constexpr (NKS == 3) *(u32x4*)(Kr_lds + (b) * KR8_BYTES + rdst) = sr_[i].r; } while (0)
#define RESC8(al) do { if (__any((al) < 1.f)) { if (hi == 0) al_l[r32] = (al); asm volatile("s_waitcnt lgkmcnt(0)" ::: "memory"); \
    _Pragma("unroll") for (int d = 0; d < 4; ++d) _Pragma("unroll") for (int r = 0; r < 16; ++r) o[d][r] *= al_l[da::crow(r, hi)]; } } while (0)
    f32x16 pA0, pA1, pB0, pB1; float alA, alB; i32x8 pa; const int NT = a.seq / 64;
    SLOAD8(0, 0); asm volatile("s_waitcnt vmcnt(0)" ::: "memory"); SWRITE8(0, 0); __syncthreads();
    D8Q(pA0, pA1, K_lds, Kr_lds, qf, r32, hi); D8P(true, pA0, pA1, m_reg, alA);
    SLOAD8(1, 64); if (2 < NT) SLOAD8(0, 128);
    if constexpr (NKS == 3) asm volatile("s_waitcnt vmcnt(3)" ::: "memory"); else asm volatile("s_waitcnt vmcnt(2)" ::: "memory");
    SWRITE8(1, 1); __syncthreads();
#pragma unroll 1
    for (int j = 1; j + 1 < NT; j += 2) {
        SBAR(); D8Q(pB0, pB1, K_lds + K8_BYTES, Kr_lds + KR8_BYTES, qf, r32, hi);
        D8F(pA0, pA1, alA, l_reg, pa); SBAR();
        SLOAD8(1, (j + 2) * 64); SBAR();
        D8V(o, Vt_lds, pa, r32, hi); D8P(false, pB0, pB1, m_reg, alB);
        __syncthreads(); if constexpr (NKS == 3) asm volatile("s_waitcnt vmcnt(3)" ::: "memory"); else asm volatile("s_waitcnt vmcnt(2)" ::: "memory");
        SWRITE8(0, 0);
        RESC8(alB); __syncthreads();
        SBAR(); D8Q(pA0, pA1, K_lds, Kr_lds, qf, r32, hi);
        D8F(pB0, pB1, alB, l_reg, pa); SBAR();
        if (j + 3 < NT) SLOAD8(0, (j + 3) * 64); SBAR();
        D8V(o, Vt_lds + VT_BYTES, pa, r32, hi); D8P(false, pA0, pA1, m_reg, alA);
        __syncthreads(); if constexpr (NKS == 3) asm volatile("s_waitcnt vmcnt(3)" ::: "memory"); else asm volatile("s_waitcnt vmcnt(2)" ::: "memory");
        SWRITE8(1, 1);
        RESC8(alA); __syncthreads();
    }
    SBAR(); D8Q(pB0, pB1, K_lds + K8_BYTES, Kr_lds + KR8_BYTES, qf, r32, hi);
    D8F(pA0, pA1, alA, l_reg, pa); SBAR();
    D8V(o, Vt_lds, pa, r32, hi); D8P(false, pB0, pB1, m_reg, alB);
    __syncthreads(); RESC8(alB);
    D8F(pB0, pB1, alB, l_reg, pa); SBAR();
    D8V(o, Vt_lds + VT_BYTES, pa, r32, hi);
    const int tid_e = fresh_tid(wv), wid_e = tid_e >> 6, r32e = tid_e & 31, hie = (tid_e >> 5) & 1;
    float* li_e = (float*)(lds + OFF_WS8) + wid_e * 64;
    if (hie == 0) li_e[r32e] = l_reg; asm volatile("s_waitcnt lgkmcnt(0)" ::: "memory");
    float rli[16];
#pragma unroll
    for (int r = 0; r < 16; ++r) rli[r] = __builtin_amdgcn_rcpf(li_e[da::crow(r, hie)]);
    bf16_t* Ow = F8_OUT ? (bf16_t*)((unsigned char*)a.O + (long)(wid_e * 32) * a.ldo) : a.O + (long)(wid_e * 32) * a.ldo;
#pragma unroll
    for (int r = 0; r < 16; ++r) { const int orow = da::crow(r, hie); const int r32 = r32e;
#pragma unroll
        for (int d0 = 0; d0 < 4; ++d0) { if constexpr (F8_OUT) ((unsigned char*)Ow)[(long)orow * a.ldo + d0 * 32 + r32] = f2fp8(o[d0][r] * rli[r] * O8_SCALE); else Ow[(long)orow * a.ldo + d0 * 32 + r32] = f2bf(o[d0][r] * rli[r]); } }
#undef SLOAD8
#undef SWRITE8
#undef RESC8
}
constexpr int DM_K = 0, DM_KR = 6 * K8_BYTES, DM_VT = DM_KR + 6 * KR8_BYTES, DM_WS = DM_VT + 6 * K8_BYTES, LDS_D8DMA = DM_WS + 8 * 64 * 4;
__device__ __forceinline__ void pv8s(f32x16* o, const char* Vl, const i32x8 pa, int r32, int hi) {
    i32x8 bfr[4];
#pragma unroll
    for (int d0 = 0; d0 < 4; ++d0) { const int c = 32 * d0 + r32; const char* vp = Vl + c * 64; const int sw = (c >> 2) & 3;
        const i32x4 lo = *(const i32x4*)(vp + (((2 * hi) ^ sw) << 4)), hh = *(const i32x4*)(vp + (((2 * hi + 1) ^ sw) << 4)); bfr[d0] = __builtin_shufflevector(lo, hh, 0, 1, 2, 3, 4, 5, 6, 7); }
    asm volatile("s_waitcnt lgkmcnt(0)" ::: "memory"); SBAR();
#pragma unroll
    for (int d0 = 0; d0 < 4; ++d0) o[d0] = D8_MX(pa, bfr[d0], o[d0]);
}
#define LDS16(off) (*(const LAS i32x4*)(ldsl + (off)))
template <int NKS, bool MACC>
__device__ __forceinline__ void qkt8d(f32x16& p0, f32x16& p1, const f32x16& mneg, LAS unsigned char* ldsl, int kb, int rb, const i32x8* qf) {
    i32x8 a0[2], a1[2];
#pragma unroll
    for (int sK = 0; sK < 2; ++sK) {
        { const i32x4 lo = LDS16(kb ^ (64 * sK)), hh = LDS16(kb ^ (64 * sK + 16)); a0[sK] = __builtin_shufflevector(lo, hh, 0, 1, 2, 3, 4, 5, 6, 7); }
        { const i32x4 lo = LDS16((kb ^ (64 * sK)) + 4096), hh = LDS16((kb ^ (64 * sK + 16)) + 4096); a1[sK] = __builtin_shufflevector(lo, hh, 0, 1, 2, 3, 4, 5, 6, 7); } }
    asm volatile("s_waitcnt lgkmcnt(0)" ::: "memory"); SBAR();
    if constexpr (MACC) {
        asm volatile("v_mfma_f32_32x32x64_f8f6f4 %0, %1, %2, %3" : "=&v"(p0) : "v"(a0[0]), "v"(qf[0]), "v"(mneg));
        asm volatile("v_mfma_f32_32x32x64_f8f6f4 %0, %1, %2, %3" : "=&v"(p1) : "v"(a1[0]), "v"(qf[0]), "v"(mneg)); }
    else { p0 = f32x16{}; p1 = f32x16{}; p0 = D8_MX(a0[0], qf[0], p0); p1 = D8_MX(a1[0], qf[0], p1); }
    if constexpr (NKS == 3) { i32x8 r0, r1;
        { const i32x4 lo = LDS16(rb), hh = LDS16(rb ^ 16); r0 = __builtin_shufflevector(lo, hh, 0, 1, 2, 3, 4, 5, 6, 7); }
        { const i32x4 lo = LDS16(rb + 2048), hh = LDS16((rb ^ 16) + 2048); r1 = __builtin_shufflevector(lo, hh, 0, 1, 2, 3, 4, 5, 6, 7); }
        p0 = D8_MX(a0[1], qf[1], p0); p1 = D8_MX(a1[1], qf[1], p1);
        p0 = D8_MX(r0, qf[2], p0); p1 = D8_MX(r1, qf[2], p1); }
    else { p0 = D8_MX(a0[1], qf[1], p0); p1 = D8_MX(a1[1], qf[1], p1); }
    if constexpr (MACC) asm volatile("" : "+v"(p1), "+v"(p0) : "v"(mneg));
}
__device__ __forceinline__ void pv8d(f32x16* o, LAS unsigned char* ldsl, int vb, const i32x8 pa) {
    i32x8 bfr[4];
#pragma unroll
    for (int d0 = 0; d0 < 4; ++d0) { const i32x4 lo = LDS16(vb + d0 * 2048), hh = LDS16((vb ^ 16) + d0 * 2048); bfr[d0] = __builtin_shufflevector(lo, hh, 0, 1, 2, 3, 4, 5, 6, 7); }
    asm volatile("s_waitcnt lgkmcnt(0)" ::: "memory"); SBAR();
#pragma unroll
    for (int d0 = 0; d0 < 4; ++d0) o[d0] = D8_MX(pa, bfr[d0], o[d0]);
}
template <int NKS, bool MACC>
__device__ __forceinline__ void attn_dense8_dma(int wv, const D8Args a, LAS unsigned char* ldsl) {
    constexpr int VAR = 0;
    constexpr bool LSUM = (NKS == 2);
    const int tid = fresh_tid(wv), wid = __builtin_amdgcn_readfirstlane(tid >> 6), lane = tid & 63, r32 = lane & 31, hi = lane >> 5;
    char* lds = (char*)ldsl;
    float m_reg = MACC ? 0.f : -1e30f, l_reg = 0; f32x16 o[4] = {}; i32x8 qf[NKS]; f32x16 mneg = {}; f32x16 lacc = {};
    const i32x8 ones8 = (i32x8){0x38383838, 0x38383838, 0x38383838, 0x38383838, 0x38383838, 0x38383838, 0x38383838, 0x38383838};
    constexpr float QC = MACC ? Cst8<NKS>::C : 1.0f;
    { const bf16_t* Qw = a.Q + (long)(wid * 32 + r32) * a.ldq;
#pragma unroll
      for (int sK = 0; sK < 2; ++sK) { const bf16_t* qp = Qw + 64 * sK + 32 * hi; unsigned w[8];
#pragma unroll
          for (int c = 0; c < 4; ++c) { const u32x4 v = *(const u32x4*)(qp + 8 * c);
              w[2 * c] = pk4_fp8(bflo(v.x) * QC, bfhi(v.x) * QC, bflo(v.y) * QC, bfhi(v.y) * QC); w[2 * c + 1] = pk4_fp8(bflo(v.z) * QC, bfhi(v.z) * QC, bflo(v.w) * QC, bfhi(v.w) * QC); }
          qf[sK] = (i32x8){(int)w[0], (int)w[1], (int)w[2], (int)w[3], (int)w[4], (int)w[5], (int)w[6], (int)w[7]}; }
      if constexpr (NKS == 3) {
          const float pos = (float)(a.pos0 + wid * 32 + r32); const bf16_t* qp = Qw + 128; unsigned w[8];
#pragma unroll
          for (int c = 0; c < 4; ++c) { const u32x4 v1 = *(const u32x4*)(qp + 8 * c), v2 = *(const u32x4*)(qp + 32 + 8 * c);
              const unsigned a1[4] = {v1.x, v1.y, v1.z, v1.w}, a2[4] = {v2.x, v2.y, v2.z, v2.w}; float y[8];
#pragma unroll
              for (int e = 0; e < 8; ++e) { const int i = 8 * c + e; float sn, cs; sincos_rev(pos * inv_freq32(i), sn, cs);
                  const float x1 = (e & 1) ? bfhi(a1[e >> 1]) : bflo(a1[e >> 1]), x2 = (e & 1) ? bfhi(a2[e >> 1]) : bflo(a2[e >> 1]);
                  y[e] = (hi ? (x2 * cs + x1 * sn) : (x1 * cs - x2 * sn)) * QC; }
              w[2 * c] = pk4_fp8(y[0], y[1], y[2], y[3]); w[2 * c + 1] = pk4_fp8(y[4], y[5], y[6], y[7]); }
          qf[2] = (i32x8){(int)w[0], (int)w[1], (int)w[2], (int)w[3], (int)w[4], (int)w[5], (int)w[6], (int)w[7]}; } }
    const unsigned char* ksrc; const unsigned char* vsrc; const unsigned char* rsrc = nullptr;
    { const int ri = 8 * wid + (lane >> 3), hk = (ri >> 2) & 1, ka = 32 * hk + (ri & 3) + 4 * ((ri >> 3) & 3) + 16 * (ri >> 5), kch = ((lane & 7) ^ (ri >> 1)) & 7;
      ksrc = a.K8 + (long)ka * a.ldk + kch * 16;
      const int vc = 16 * wid + (lane >> 2), vp = ((lane & 3) ^ (vc >> 2)) & 3; vsrc = a.Vt8 + (long)vc * a.ldvt + vp * 16;
      if constexpr (NKS == 3) { const int rr = 16 * (wid & 3) + (lane >> 2), rh = (rr >> 2) & 1, ra = 32 * rh + (rr & 3) + 4 * ((rr >> 3) & 3) + 16 * (rr >> 5), rch = ((lane & 3) ^ (rr >> 2)) & 3;
          rsrc = a.Kr8 + (long)ra * 64 + rch * 16; } }
#define D8_DMA2(k0, sb) do { _Pragma("unroll") for (int t_ = 0; t_ < 2; ++t_) { \
      __builtin_amdgcn_global_load_lds((const unsigned*)(ksrc + (long)((k0) + 64 * t_) * a.ldk), (LAS unsigned*)(ldsl + DM_K + (2 * (sb) + t_) * K8_BYTES + wid * 1024), 16, 0, 0); \
      __builtin_amdgcn_global_load_lds((const unsigned*)(vsrc + ((k0) + 64 * t_)), (LAS unsigned*)(ldsl + DM_VT + (2 * (sb) + t_) * K8_BYTES + wid * 1024), 16, 0, 0); } \
      if constexpr (NKS == 3) __builtin_amdgcn_global_load_lds((const unsigned*)(rsrc + (long)((k0) + 64 * (wid >> 2)) * 64), (LAS unsigned*)(ldsl + DM_KR + (2 * (sb) + (wid >> 2)) * KR8_BYTES + (wid & 3) * 1024), 16, 0, 0); } while (0)
#define RESC8(al) do { if (__any((al) < 1.f)) { if (hi == 0) al_l[r32] = (al); asm volatile("s_waitcnt lgkmcnt(0)" ::: "memory"); \
    _Pragma("unroll") for (int d = 0; d < 4; ++d) _Pragma("unroll") for (int r = 0; r < 16; ++r) o[d][r] *= al_l[da::crow(r, hi)]; \
    if constexpr (LSUM) { _Pragma("unroll") for (int r = 0; r < 16; ++r) lacc[r] *= al_l[da::crow(r, hi)]; } } } while (0)
#define D8Qm(P0, P1, b) qkt8d<NKS, MACC>(P0, P1, mneg, ldsl, kb0 + (b) * K8_BYTES, rb0 + (b) * KR8_BYTES, qf)
#define D8Vm(b) do { pv8d(o, ldsl, vb0 + (b) * K8_BYTES, pa); if constexpr (LSUM) lacc = D8_MX(pa, ones8, lacc); } while (0)
#define D8Fm(P0, P1, AL) do { if constexpr (LSUM) finishSM8n(P0, P1, pa); else finishSM8(P0, P1, AL, l_reg, pa); } while (0)
#define D8Pm(FIRST, P0, P1, AL) do { if constexpr (MACC) partialSM8<FIRST, (NKS == 3)>(P0, P1, m_reg, mneg, AL); else partialSM8z<NKS>(P0, P1, m_reg, AL); } while (0)
#define D8_TOP() do { asm volatile("s_waitcnt vmcnt(0)" ::: "memory"); __syncthreads(); } while (0)
    float* al_l = (float*)(lds + DM_WS) + wid * 64 + 32;
    const int kb0 = DM_K + r32 * 128 + ((((r32 >> 1) & 7) << 4) ^ (32 * hi)), rb0 = DM_KR + r32 * 64 + ((((r32 >> 2) & 3) << 4) ^ (32 * hi)), vb0 = DM_VT + r32 * 64 + ((((r32 >> 2) & 3) << 4) ^ (32 * hi));
    f32x16 pA0, pA1, pB0, pB1; float alA, alB; i32x8 pa;
    const int NS = a.seq / 128;
    D8_DMA2(0, 0);
    D8_TOP(); D8_DMA2(128, 1);
    D8Qm(pA0, pA1, 0); D8Pm(true, pA0, pA1, alA); RESC8(alA);
    SBAR(); D8Qm(pB0, pB1, 1);
    D8Fm(pA0, pA1, alA); SBAR();
    D8Vm(0); D8Pm(false, pB0, pB1, alB);
    RESC8(alB);
    int sb = 1, sbp = 0, sbn = 2;
#pragma unroll 1
    for (int J = 1; J < NS; ++J) {
        D8_TOP(); if (J + 1 < NS) D8_DMA2((J + 1) * 128, sbn);
        SBAR(); D8Qm(pA0, pA1, 2 * sb);
        D8Fm(pB0, pB1, alB); SBAR();
        D8Vm(2 * sbp + 1); D8Pm(false, pA0, pA1, alA);
        RESC8(alA);
        SBAR(); D8Qm(pB0, pB1, 2 * sb + 1);
        D8Fm(pA0, pA1, alA); SBAR();
        D8Vm(2 * sb); D8Pm(false, pB0, pB1, alB);
        RESC8(alB);
        { const int t = sbp; sbp = sb; sb = sbn; sbn = t; }
    }
    D8Fm(pB0, pB1, alB); SBAR();
    D8Vm(2 * sbp + 1);
    const int tid_e = fresh_tid(wv), wid_e = tid_e >> 6, r32e = tid_e & 31, hie = (tid_e >> 5) & 1;
    float* li_e = (float*)(lds + DM_WS) + wid_e * 64;
    float rli[16];
    if constexpr (LSUM) {
#pragma unroll
        for (int r = 0; r < 16; ++r) rli[r] = __builtin_amdgcn_rcpf(lacc[r]); (void)li_e; }
    else { if (hie == 0) li_e[r32e] = l_reg; asm volatile("s_waitcnt lgkmcnt(0)" ::: "memory");
#pragma unroll
        for (int r = 0; r < 16; ++r) rli[r] = __builtin_amdgcn_rcpf(li_e[da::crow(r, hie)]); }
    bf16_t* Ow = F8_OUT ? (bf16_t*)((unsigned char*)a.O + (long)(wid_e * 32) * a.ldo) : a.O + (long)(wid_e * 32) * a.ldo;
#pragma unroll
    for (int r = 0; r < 16; ++r) { const int orow = da::crow(r, hie);
#pragma unroll
        for (int d0 = 0; d0 < 4; ++d0) { if constexpr (F8_OUT) ((unsigned char*)Ow)[(long)orow * a.ldo + d0 * 32 + r32e] = f2fp8(o[d0][r] * rli[r] * O8_SCALE); else Ow[(long)orow * a.ldo + d0 * 32 + r32e] = f2bf(o[d0][r] * rli[r]); } }
#undef D8_DMA2
#undef RESC8
#undef D8Qm
#undef D8Vm
#undef D8Fm
#undef D8Pm
#undef D8_TOP
}
template <class P>
__device__ __forceinline__ void sparse8_wave(P& pol, LAS unsigned char* wll, int lane) {
    const int r32 = lane & 31, hi = lane >> 5;
    char* wl = (char*)wll; char* Kl = wl; char* Vl = wl + 8192; float* li_l = (float*)(wl + 16384); float* al_l = li_l + 32;
    constexpr float QCS = 0.088388347648318440f * LOG2E;
    i32x8 qf[2];
    { const bf16_t* Qw = pol.qptr(r32);
#pragma unroll
      for (int sK = 0; sK < 2; ++sK) { const bf16_t* qp = Qw + 64 * sK + 32 * hi; unsigned w[8];
#pragma unroll
          for (int c = 0; c < 4; ++c) { const u32x4 v = *(const u32x4*)(qp + 8 * c);
              w[2 * c] = pk4_fp8(bflo(v.x) * QCS, bfhi(v.x) * QCS, bflo(v.y) * QCS, bfhi(v.y) * QCS); w[2 * c + 1] = pk4_fp8(bflo(v.z) * QCS, bfhi(v.z) * QCS, bflo(v.w) * QCS, bfhi(v.w) * QCS); }
          qf[sK] = (i32x8){(int)w[0], (int)w[1], (int)w[2], (int)w[3], (int)w[4], (int)w[5], (int)w[6], (int)w[7]}; } }
    asm volatile("s_waitcnt vmcnt(0)" ::: "memory");
    f32x16 o[4] = {}; float m_reg = 0.f, l_reg = 0.f; f32x16 mneg = {};
    const int a0k = 32 * ((lane >> 5) & 1) + ((lane >> 3) & 3), che = (((lane & 7) ^ (lane >> 4)) & 7) << 4, cho = che ^ 64;
    const int vcol0 = lane >> 2; const unsigned voff = (unsigned)vcol0 * SEQ + ((((lane & 3) ^ (vcol0 >> 2)) & 3) << 4);
    const int nt = pol.ntiles();
    typename P::TI ti, tn;
#define SP8_UNI(p) ((const unsigned char*)(((unsigned long long)(unsigned)__builtin_amdgcn_readfirstlane((int)((unsigned long long)(p) >> 32)) << 32) | (unsigned)__builtin_amdgcn_readfirstlane((int)(unsigned long long)(p))))
#define SP8_DMA_K(T) do { const unsigned char* kb_ = SP8_UNI((T).k); const unsigned rs_ = (unsigned)__builtin_amdgcn_readfirstlane((int)(T).rs); const unsigned ko_ = (unsigned)a0k * rs_; \
        _Pragma("unroll") for (int i = 0; i < 8; ++i) { const unsigned char* src = kb_ + (unsigned long long)((4 * (i & 3) + 16 * (i >> 2)) * rs_) + (ko_ + (unsigned)((i & 1) ? cho : che)); \
        __builtin_amdgcn_global_load_lds((const unsigned*)src, (LAS unsigned*)(wll + i * 1024), 16, 0, 0); } } while (0)
#define SP8_DMA_V(T) do { const unsigned char* vb_ = SP8_UNI((T).v); \
        _Pragma("unroll") for (int i = 0; i < 8; ++i) { const unsigned char* src = vb_ + (unsigned long long)(16 * i) * SEQ + voff; \
        __builtin_amdgcn_global_load_lds((const unsigned*)src, (LAS unsigned*)(wll + 8192 + i * 1024), 16, 0, 0); } } while (0)
    pol.tile(0, ti);
    SP8_DMA_K(ti); SP8_DMA_V(ti);
#pragma unroll 1
    for (int j = 0; j < nt; ++j) {
        const bool more = (j + 1 < nt);
        if (more) pol.tile(j + 1, tn);
        asm volatile("s_waitcnt vmcnt(8)" ::: "memory");
        f32x16 p0, p1;
        { i32x8 a0[2], a1[2];
#pragma unroll
          for (int sK = 0; sK < 2; ++sK) { const int ch = 4 * sK + 2 * hi;
            { const i32x4 lo = *(const i32x4*)(Kl + K8SWZ(r32, ch)), hh = *(const i32x4*)(Kl + K8SWZ(r32, ch + 1)); a0[sK] = __builtin_shufflevector(lo, hh, 0, 1, 2, 3, 4, 5, 6, 7); }
            { const i32x4 lo = *(const i32x4*)(Kl + K8SWZ(32 + r32, ch)), hh = *(const i32x4*)(Kl + K8SWZ(32 + r32, ch + 1)); a1[sK] = __builtin_shufflevector(lo, hh, 0, 1, 2, 3, 4, 5, 6, 7); } }
          asm volatile("s_waitcnt lgkmcnt(0)" ::: "memory"); SBAR();
          if (more) SP8_DMA_K(tn);
          SBAR();
          if constexpr (P::SPLAT) { float nm = -m_reg; asm volatile("" : "+v"(nm));
#pragma unroll
              for (int r = 0; r < 16; ++r) mneg[r] = nm; }
          asm volatile("v_mfma_f32_32x32x64_f8f6f4 %0, %1, %2, %3" : "=&v"(p0) : "v"(a0[0]), "v"(qf[0]), "v"(mneg));
          asm volatile("v_mfma_f32_32x32x64_f8f6f4 %0, %1, %2, %3" : "=&v"(p1) : "v"(a1[0]), "v"(qf[0]), "v"(mneg));
          p0 = D8_MX(a0[1], qf[1], p0); p1 = D8_MX(a1[1], qf[1], p1);
          asm volatile("" : "+v"(p1), "+v"(p0) : "v"(mneg)); }
        float pmax = -INFINITY;
#pragma unroll
        for (int r = 0; r < 16; ++r) { p0[r] = pol.adj(ti, r, p0[r]); p1[r] = pol.adj(ti, 16 + r, p1[r]); pmax = fmaxf(pmax, fmaxf(p0[r], p1[r])); }
        { auto rr = __builtin_amdgcn_permlane32_swap(__float_as_uint(pmax), __float_as_uint(pmax), false, false);
          pmax = fmaxf(__uint_as_float(rr[0]), __uint_as_float(rr[1])); }
        float alpha = 1.f;
        { const bool first = (l_reg == 0.f) && (pmax > -INFINITY);
          const float delta = first ? pmax : (pmax > THR8 * LOG2E ? pmax : 0.f);
          if (__any(delta != 0.f)) { alpha = first ? 1.f : __builtin_amdgcn_exp2f(-delta); m_reg += delta;
#pragma unroll
              for (int r = 0; r < 16; ++r) { p0[r] -= delta; p1[r] -= delta; }
              if constexpr (!P::SPLAT) { const float nm = -m_reg;
#pragma unroll
                  for (int r = 0; r < 16; ++r) mneg[r] = nm; }
              if (hi == 0) al_l[r32] = alpha; asm volatile("s_waitcnt lgkmcnt(0)" ::: "memory");
#pragma unroll
              for (int d = 0; d < 4; ++d)
#pragma unroll
                  for (int r = 0; r < 16; ++r) o[d][r] *= al_l[da::crow(r, hi)]; } }
        float ps = 0.f;
#pragma unroll
        for (int r = 0; r < 16; ++r) { p0[r] = __builtin_amdgcn_exp2f(p0[r]); p1[r] = __builtin_amdgcn_exp2f(p1[r]); ps += p0[r] + p1[r]; }
        { auto rr = __builtin_amdgcn_permlane32_swap(__float_as_uint(ps), __float_as_uint(ps), false, false);
          ps = __uint_as_float(rr[0]) + __uint_as_float(rr[1]); }
        l_reg = l_reg * alpha + ps;
        const i32x8 pa = (i32x8){(int)pk4_fp8(p0[0], p0[1], p0[2], p0[3]), (int)pk4_fp8(p0[4], p0[5], p0[6], p0[7]), (int)pk4_fp8(p0[8], p0[9], p0[10], p0[11]), (int)pk4_fp8(p0[12], p0[13], p0[14], p0[15]),
                                 (int)pk4_fp8(p1[0], p1[1], p1[2], p1[3]), (int)pk4_fp8(p1[4], p1[5], p1[6], p1[7]), (int)pk4_fp8(p1[8], p1[9], p1[10], p1[11]), (int)pk4_fp8(p1[12], p1[13], p1[14], p1[15])};
        SBAR();
        if (more) asm volatile("s_waitcnt vmcnt(8)" ::: "memory"); else asm volatile("s_waitcnt vmcnt(0)" ::: "memory");
        SBAR();
        { i32x8 bfr[4];
#pragma unroll
          for (int d0 = 0; d0 < 4; ++d0) { const int c = 32 * d0 + r32; const char* vp = Vl + c * 64; const int sw = (c >> 2) & 3;
            const i32x4 lo = *(const i32x4*)(vp + (((2 * hi) ^ sw) << 4)), hh = *(const i32x4*)(vp + (((2 * hi + 1) ^ sw) << 4)); bfr[d0] = __builtin_shufflevector(lo, hh, 0, 1, 2, 3, 4, 5, 6, 7); }
          asm volatile("s_waitcnt lgkmcnt(0)" ::: "memory"); SBAR();
          if (more) SP8_DMA_V(tn);
          SBAR();
#pragma unroll
          for (int d0 = 0; d0 < 4; ++d0) o[d0] = D8_MX(pa, bfr[d0], o[d0]); }
        ti = tn;
    }
#undef SP8_DMA_K
#undef SP8_DMA_V
#undef SP8_UNI
    if (hi == 0) li_l[r32] = l_reg; asm volatile("s_waitcnt lgkmcnt(0)" ::: "memory");
#pragma unroll
    for (int r = 0; r < 16; ++r) { const int qn = da::crow(r, hi); const float rl = __builtin_amdgcn_rcpf(li_l[qn]); bf16_t* op = pol.optr(qn);
#pragma unroll
        for (int d0 = 0; d0 < 4; ++d0) { if constexpr (F8_OUT) ((unsigned char*)op)[d0 * 32 + r32] = f2fp8(o[d0][r] * rl * O8_SCALE); else op[d0 * 32 + r32] = f2bf(o[d0][r] * rl); } }
}
#undef D8Q
#undef D8P
#undef D8F
#undef D8V
#undef D8_LD32
#undef D8_MX
}


struct PolB {
    struct TI { const bf16_t* k; const bf16_t* v; long rs; int kpos0; int iq; float cd; };
    const bf16_t* H0; bf16_t* O; int b, h, a, r16, myn; int lo3, n3, lo2, n2, lo1, n1; float slope2;
    __device__ __forceinline__ void init(const bf16_t* H0_, bf16_t* O_, int w, int lane) {
        H0 = H0_; O = O_; b = w >> 10; h = (w >> 7) & 7; const int wu = w & 127; a = wu >> 4; r16 = wu & 15; myn = lane & 31;
        lo3 = max(a - 2, 0); n3 = min(a + 2, 7) - lo3 + 1;
        lo2 = max(4 * a - 2, 0); n2 = min(4 * a + 5, 31) - lo2 + 1;
        lo1 = max(16 * a - 2, 0); n1 = min(16 * a + 17, 127) - lo1 + 1;
        slope2 = __builtin_amdgcn_exp2f(-(float)(h + 1)) * LOG2E;
    }
    __device__ __forceinline__ const bf16_t* qptr(int n) const { return H0 + (long)(b * SEQ + 512 * a + r16 + 16 * n) * IN0 + 1536 + h * 128; }
    __device__ __forceinline__ bf16_t* optr(int qn) const { const long e = (long)(b * SEQ + 512 * a + r16 + 16 * qn) * DM + 1024 + h * 128; return F8_OUT ? (bf16_t*)((unsigned char*)O + e) : O + e; }
    __device__ __forceinline__ int ntiles() const { return n3 + n2 + n1; }
    __device__ __forceinline__ void tile(int j, TI& ti) const {
        int dil, kt, rd;
        if (j < n3) { dil = 16; kt = lo3 + j; rd = r16; }
        else if (j < n3 + n2) { dil = 4; kt = lo2 + (j - n3); rd = r16 & 3; }
        else { dil = 1; kt = lo1 + (j - n3 - n2); rd = 0; }
        const long tok = (long)b * SEQ + dil * 32 * kt + rd;
        ti.k = H0 + tok * IN0 + 2560 + h * 128; ti.v = H0 + tok * IN0 + 3584 + h * 128; ti.rs = (long)dil * IN0;
        ti.kpos0 = 32 * kt; ti.iq = (512 * a + r16 + 16 * myn - rd) / dil; ti.cd = slope2 * (float)dil;
    }
    __device__ __forceinline__ float adj(const TI& ti, int kloc, float s) const {
        const int d = ti.kpos0 + kloc - ti.iq; const int ad = d < 0 ? -d : d;
        return ad <= 64 ? fmaf(s, 0.088388347648318440f * LOG2E, -ti.cd * (float)ad) : -INFINITY;
    }
};
struct PolC {
    struct TI { const bf16_t* k; const bf16_t* v; long rs; int kc0; int drow; };
    const bf16_t* H1; bf16_t* O; const float* tab; int b, h, r, a, r0, qc, c0;
    __device__ __forceinline__ void init(const bf16_t* H1_, bf16_t* O_, const float* rpb, float* tab_, int w, int lane) {
        H1 = H1_; O = O_; tab = tab_; b = w >> 10; h = (w >> 7) & 7; const int wu = w & 127; r = wu >> 1; a = wu & 1;
        r0 = min(max(r - 4, 0), 56); qc = 32 * a + (lane & 31); c0 = min(max(qc - 8, 0), 48);
        for (int idx = lane; idx < 480; idx += 64) { const int dr = idx >> 5, dc = idx & 31; tab_[idx] = dc < 31 ? rpb[h * 465 + dr * 31 + dc] * LOG2E : 0.f; }
        asm volatile("s_waitcnt vmcnt(0) lgkmcnt(0)" ::: "memory");
    }
    __device__ __forceinline__ const bf16_t* qptr(int n) const { return H1 + (long)(b * SEQ + 64 * r + 32 * a + n) * IN1P + h * 128; }
    __device__ __forceinline__ bf16_t* optr(int qn) const { const long e = (long)(b * SEQ + 64 * r + 32 * a + qn) * DM + h * 128; return F8_OUT ? (bf16_t*)((unsigned char*)O + e) : O + e; }
    __device__ __forceinline__ int ntiles() const { return 16; }
    __device__ __forceinline__ void tile(int j, TI& ti) const {
        const int kr = r0 + (j >> 1), ch = j & 1; const long tok = (long)b * SEQ + 64 * kr + 32 * ch;
        ti.k = H1 + tok * IN1P + 1024 + h * 128; ti.v = H1 + tok * IN1P + 2048 + h * 128; ti.rs = IN1P; ti.kc0 = 32 * ch; ti.drow = kr - r + 7;
    }
    __device__ __forceinline__ float adj(const TI& ti, int kloc, float s) const {
        const int kc = ti.kc0 + kloc; const int dc = min(max(kc - qc + 15, 0), 30);
        const float bias = tab[ti.drow * 32 + dc];
        return (kc >= c0 && kc < c0 + 16) ? fmaf(s, 0.088388347648318440f * LOG2E, bias) : -INFINITY;
    }
};

struct PolB8 {
    static constexpr bool SPLAT = false;
    struct TI { const unsigned char* k; const unsigned char* v; long rs; float fb; float ncd; };
    const bf16_t* H0; bf16_t* O; const unsigned char* K8; const unsigned char* Vt1; const unsigned char* Vt4; const unsigned char* Vt16;
    int b, h, a, r16, myn, hi32; int lo3, n3, lo2, n2, lo1, n1; float slope2;
    __device__ __forceinline__ void init(const bf16_t* H0_, bf16_t* O_, const unsigned char* K8_, const unsigned char* Vt1_, const unsigned char* Vt4_, const unsigned char* Vt16_, int w, int lane) {
        H0 = H0_; O = O_; K8 = K8_; Vt1 = Vt1_; Vt4 = Vt4_; Vt16 = Vt16_; b = w >> 10; h = (w >> 7) & 7; const int wu = w & 127; a = wu >> 4; r16 = wu & 15; myn = lane & 31; hi32 = 32 * (lane >> 5);
        const int t = a >> 1; lo3 = max(t - 1, 0); n3 = min(t + 1, 3) - lo3 + 1;
        lo2 = max(2 * a - 1, 0); n2 = min(2 * a + 2, 15) - lo2 + 1;
        lo1 = max(8 * a - 1, 0); n1 = min(8 * a + 8, 63) - lo1 + 1;
        slope2 = __builtin_amdgcn_exp2f(-(float)(h + 1)) * LOG2E;
    }
    __device__ __forceinline__ const bf16_t* qptr(int n) const { return H0 + (long)(b * SEQ + 512 * a + r16 + 16 * n) * IN0 + 1536 + h * 128; }
    __device__ __forceinline__ bf16_t* optr(int qn) const { const long e = (long)(b * SEQ + 512 * a + r16 + 16 * qn) * DM + 1024 + h * 128; return F8_OUT ? (bf16_t*)((unsigned char*)O + e) : O + e; }
    __device__ __forceinline__ int ntiles() const { return n3 + n2 + n1; }
    __device__ __forceinline__ void tile(int j, TI& ti) const {
        int dil, kt, rd; const unsigned char* vt; int voff;
        if (j < n3) { dil = 16; kt = lo3 + j; rd = r16; vt = Vt16; voff = r16 * 256 + 64 * kt; }
        else if (j < n3 + n2) { dil = 4; kt = lo2 + (j - n3); rd = r16 & 3; vt = Vt4; voff = rd * 1024 + 64 * kt; }
        else { dil = 1; kt = lo1 + (j - n3 - n2); rd = 0; vt = Vt1; voff = 64 * kt; }
        const long tok = (long)b * SEQ + dil * 64 * kt + rd;
        ti.k = K8 + tok * 1024 + h * 128; ti.rs = (long)dil * 1024; ti.v = vt + (long)(b * 8 + h) * 128 * SEQ + voff;
        ti.fb = (float)(64 * kt + hi32 - (512 * a + r16 + 16 * myn - rd) / dil); ti.ncd = -slope2 * (float)dil;
    }
    __device__ __forceinline__ float adj(const TI& ti, int slot, float s) const {
        const float fd = ti.fb + (float)slot;
        return __builtin_fabsf(fd) <= 64.f ? fmaf(__builtin_fabsf(fd), ti.ncd, s) : -INFINITY;
    }
};
struct PolC8 {
    static constexpr bool SPLAT = true;
    struct TI { const unsigned char* k; const unsigned char* v; long rs; const float* tp; };
    const bf16_t* H1; bf16_t* O; const unsigned char* K8; const unsigned char* Vt; const float* tab0; int b, h, r, a, r0; int vmask;
    __device__ __forceinline__ void init(const bf16_t* H1_, bf16_t* O_, const unsigned char* K8_, const unsigned char* Vt_, const float* rpb, float* tab_, int w, int lane) {
        H1 = H1_; O = O_; K8 = K8_; Vt = Vt_; b = w >> 10; h = (w >> 7) & 7; const int wu = w & 127; r = wu >> 1; a = wu & 1;
        r0 = min(max(r - 4, 0), 56); const int qc = 32 * a + (lane & 31), c0 = min(max(qc - 8, 0), 48), hi32 = 32 * (lane >> 5);
        { const int lo = c0 - hi32; const unsigned m16 = 0xffffu; vmask = lo >= 32 || lo <= -16 ? 0 : (int)(lo >= 0 ? (m16 << lo) : (m16 >> (-lo))); }
        tab0 = tab_ + (hi32 - qc + 15);
        { float tv[8];
#pragma unroll
          for (int q = 0; q < 8; ++q) { const int idx = lane + 64 * q, dr = min(idx >> 5, 14), dc = idx & 31; tv[q] = rpb[h * 465 + dr * 31 + min(dc, 30)]; }
#pragma unroll
          for (int q = 0; q < 8; ++q) { const int idx = lane + 64 * q, dc = idx & 31; const float v = dc < 31 ? tv[q] * LOG2E : 0.f; if (idx < 480) tab_[idx] = v; } }
        asm volatile("s_waitcnt vmcnt(0) lgkmcnt(0)" ::: "memory");
    }
    __device__ __forceinline__ const bf16_t* qptr(int n) const { return H1 + (long)(b * SEQ + 64 * r + 32 * a + n) * IN1P + h * 128; }
    __device__ __forceinline__ bf16_t* optr(int qn) const { const long e = (long)(b * SEQ + 64 * r + 32 * a + qn) * DM + h * 128; return F8_OUT ? (bf16_t*)((unsigned char*)O + e) : O + e; }
    __device__ __forceinline__ int ntiles() const { return 8; }
    __device__ __forceinline__ void tile(int j, TI& ti) const {
        const int kr = r0 + j; const long tok = (long)b * SEQ + 64 * kr;
        ti.k = K8 + tok * 1024 + h * 128; ti.rs = 1024; ti.v = Vt + (long)(b * 8 + h) * 128 * SEQ + 64 * kr; ti.tp = tab0 + (kr - r + 7) * 32;
    }
    __device__ __forceinline__ float adj(const TI& ti, int slot, float s) const {
        const float v = s + ti.tp[slot];
        const int t = __builtin_amdgcn_sbfe(vmask, slot, 1);
        return __uint_as_float((__float_as_uint(v) & (unsigned)t) | (0xff800000u & ~(unsigned)t));
    }
};

struct Params { const float* in[28]; float* out; unsigned char* ws; int ph_lo, ph_hi; };
enum { I_X = 0, I_RW = 1, I_RB = 2, I_WIN0 = 3, I_AQN = 4, I_AKN = 5, I_WOUT0 = 6, I_LN1G0 = 7, I_LN1B0 = 8, I_WG0 = 9, I_WU0 = 10, I_WD0 = 11, I_LN2G0 = 12, I_LN2B0 = 13,
       I_WIN1 = 14, I_RPB = 15, I_DQN = 16, I_WQUP = 17, I_DKVN = 18, I_WKVUP = 19, I_WOUT1 = 20, I_LN1G1 = 21, I_LN1B1 = 22, I_WG1 = 23, I_WU1 = 24, I_WD1 = 25, I_LN2G1 = 26, I_LN2B1 = 27 };

__device__ __forceinline__ void tr_tile(const float* __restrict__ src, int N, const float* __restrict__ ksc, bf16_t* __restrict__ dst, int ldd, int k0, int n0, int drow0, LAS unsigned* tl, int tid) {
    const int c4 = (tid & 15) * 4;
#pragma unroll
    for (int i = 0; i < 2; ++i) {
        const int kp = (tid >> 4) + 32 * i;
        const float* s0 = src + (size_t)(k0 + 2 * kp) * N + n0 + c4;
        f32x4 a = *(const f32x4*)s0, b = *(const f32x4*)(s0 + N);
        if (ksc) { const float sa = ksc[k0 + 2 * kp], sb = ksc[k0 + 2 * kp + 1]; a *= sa; b *= sb; }
#pragma unroll
        for (int j = 0; j < 4; ++j) tl[(c4 + j) * 65 + kp] = cvtpk(a[j], b[j]);
    }
    __syncthreads();
    const int n = tid >> 3, seg = tid & 7;
    unsigned w[8];
#pragma unroll
    for (int q = 0; q < 8; ++q) w[q] = tl[n * 65 + seg * 8 + q];
    u32x4* d = (u32x4*)(dst + (size_t)(drow0 + n) * ldd + k0 + seg * 16);
    d[0] = (u32x4){w[0], w[1], w[2], w[3]}; d[1] = (u32x4){w[4], w[5], w[6], w[7]};
    __syncthreads();
}
__device__ __forceinline__ void tr_tile8(const float* __restrict__ src, int N, const float* __restrict__ ksc, float wscale, unsigned char* __restrict__ dst, int ldd, int k0, int n0, int drow0, LAS unsigned* tl, int tid) {
    const int c4 = (tid & 15) * 4, kq = tid >> 4;
    const float* s0 = src + (size_t)(k0 + 4 * kq) * N + n0 + c4;
    f32x4 a = *(const f32x4*)s0, b = *(const f32x4*)(s0 + N), c = *(const f32x4*)(s0 + 2 * (size_t)N), d = *(const f32x4*)(s0 + 3 * (size_t)N);
    float sa = wscale, sb = wscale, sc = wscale, sd = wscale;
    if (ksc) { sa *= ksc[k0 + 4 * kq]; sb *= ksc[k0 + 4 * kq + 1]; sc *= ksc[k0 + 4 * kq + 2]; sd *= ksc[k0 + 4 * kq + 3]; }
#pragma unroll
    for (int j = 0; j < 4; ++j) tl[(c4 + j) * 33 + kq] = pk4_fp8(a[j] * sa, b[j] * sb, c[j] * sc, d[j] * sd);
    __syncthreads();
    const int n = tid >> 3, seg = tid & 7;
    unsigned w[4];
#pragma unroll
    for (int q = 0; q < 4; ++q) w[q] = tl[n * 33 + seg * 4 + q];
    *(u32x4*)(dst + (size_t)(drow0 + n) * ldd + k0 + seg * 16) = (u32x4){w[0], w[1], w[2], w[3]};
    __syncthreads();
}
struct TJob { const float* src; bf16_t* dst; const float* ksc; int K, N, ldd, gu; size_t sbs, dbs; int f8; };
constexpr float W8_SCALE = 64.f;
constexpr int W8_SBYTE = 0x79797979;
__device__ __forceinline__ void run_tjob(const TJob& jb, int t, LAS unsigned* tl, int tid) {
    const int ntn = jb.N / 64, ntk = jb.K / 128, per = ntn * ntk;
    const int bi = t / per, r = t % per, tk = r / ntn, tn = r % ntn;
    const int n0 = tn * 64;
    const int drow0 = jb.gu ? (256 * (n0 >> 7) + (jb.gu == 2 ? 128 : 0) + (n0 & 127)) : n0;
    if (jb.f8) tr_tile8(jb.src + (size_t)bi * jb.sbs, jb.N, jb.ksc, W8_SCALE, (unsigned char*)jb.dst + (size_t)bi * jb.dbs, jb.ldd, tk * 128, n0, drow0, tl, tid);
    else tr_tile(jb.src + (size_t)bi * jb.sbs, jb.N, jb.ksc, jb.dst + (size_t)bi * jb.dbs, jb.ldd, tk * 128, n0, drow0, tl, tid);
}
typedef __attribute__((address_space(4))) const unsigned long long kcu64_t;
#define PIN(i) ((const float*)(__attribute__((address_space(1))) const float*)ka[i])
__device__ __forceinline__ void phase_prologue(kcu64_t* ka, unsigned char* ws, LAS unsigned char* lds, int G, int bid, int tid) {
    LAS unsigned* tl = (LAS unsigned*)lds;
    constexpr int NJ = 12;
    const int cnts[NJ] = {16 * 72, 16 * 32, 4096, 4096, 4096, 16 * 61, 16 * 32, 4096, 4096, 4096, 4 * 24, 2 * 32};
    int total = 0;
#pragma unroll
    for (int j = 0; j < NJ; ++j) total += cnts[j];
    for (int t = bid; t < total; t += G) {
        int j = 0, base = 0;
#pragma unroll
        for (int q = 0; q < NJ - 1; ++q) if (t >= base + cnts[q] && j == q) { base += cnts[q]; j = q + 1; }
        const int tt = t - base;
        TJob jb;
        switch (j) {
            case 0: jb = TJob{PIN(I_WIN0), (bf16_t*)(ws + WS_WIN0), nullptr, 2048, IN0, 2048, 0, 0, 0, F8_IN}; break;
            case 1: jb = TJob{PIN(I_WOUT0), (bf16_t*)(ws + WS_WOUT0), nullptr, 2048, 2048, 2048, 0, 0, 0, F8_OUT}; break;
            case 2: jb = TJob{PIN(I_WG0), (bf16_t*)(ws + WS_WGU0), nullptr, 2048, 512, 2048, 1, (size_t)2048 * 512, (size_t)1024 * 2048, F8_GU}; break;
            case 3: jb = TJob{PIN(I_WU0), (bf16_t*)(ws + WS_WGU0), nullptr, 2048, 512, 2048, 2, (size_t)2048 * 512, (size_t)1024 * 2048, F8_GU}; break;
            case 4: jb = TJob{PIN(I_WD0), (bf16_t*)(ws + WS_WD0), nullptr, 512, 2048, 512, 0, (size_t)512 * 2048, (size_t)2048 * 512, F8_DOWN}; break;
            case 5: jb = TJob{PIN(I_WIN1), (bf16_t*)(ws + WS_WIN1), nullptr, 2048, IN1, 2048, 0, 0, 0, F8_IN}; break;
            case 6: jb = TJob{PIN(I_WOUT1), (bf16_t*)(ws + WS_WOUT1), nullptr, 2048, 2048, 2048, 0, 0, 0, F8_OUT}; break;
            case 7: jb = TJob{PIN(I_WG1), (bf16_t*)(ws + WS_WGU1), nullptr, 2048, 512, 2048, 1, (size_t)2048 * 512, (size_t)1024 * 2048, F8_GU}; break;
            case 8: jb = TJob{PIN(I_WU1), (bf16_t*)(ws + WS_WGU1), nullptr, 2048, 512, 2048, 2, (size_t)2048 * 512, (size_t)1024 * 2048, F8_GU}; break;
            case 9: jb = TJob{PIN(I_WD1), (bf16_t*)(ws + WS_WD1), nullptr, 512, 2048, 512, 0, (size_t)512 * 2048, (size_t)2048 * 512, F8_DOWN}; break;
            case 10: jb = TJob{PIN(I_WQUP), (bf16_t*)(ws + WS_WQUP), PIN(I_DQN), 512, 1536, 512, 0, 0, 0, F8_P3}; break;
            default: jb = TJob{PIN(I_WKVUP), (bf16_t*)(ws + WS_WKVUP), PIN(I_DKVN), 256, 2048, 256, 0, 0, 0, F8_P3}; break;
        }
        run_tjob(jb, tt, tl, tid);
    }
    { constexpr size_t ESZ = F8_IN ? 1 : 2;
      u32x4* z = (u32x4*)(ws + WS_WIN1 + (size_t)IN1 * 2048 * ESZ); const size_t n16 = (size_t)(IN1P - IN1) * 2048 * ESZ / 16;
      const unsigned zu = __float_as_uint(fresh_zero());
      for (size_t i = (size_t)bid * NTHR + tid; i < n16; i += (size_t)G * NTHR) z[i] = (u32x4){zu, zu, zu, zu}; }
    { const f32x8* xs = (const f32x8*)PIN(I_X); const size_t n8 = (size_t)T_ * DM / 8;
      if constexpr (F8_IN) { u32x2* xd = (u32x2*)(ws + WS_RC + 64 * MiB);
          for (size_t i = (size_t)bid * NTHR + tid; i < n8; i += (size_t)G * NTHR) { const f32x8 v = xs[i]; xd[i] = (u32x2){pk4_fp8(v[0], v[1], v[2], v[3]), pk4_fp8(v[4], v[5], v[6], v[7])}; } }
      else { u32x4* xd = (u32x4*)(ws + WS_RA);
          for (size_t i = (size_t)bid * NTHR + tid; i < n8; i += (size_t)G * NTHR) { const f32x8 v = xs[i];
              xd[i] = (u32x4){cvtpk(v[0], v[1]), cvtpk(v[2], v[3]), cvtpk(v[4], v[5]), cvtpk(v[6], v[7])}; } } }
}

template <int X> __device__ __forceinline__ float swzf(float v) { return __int_as_float(__builtin_amdgcn_ds_swizzle(__float_as_int(v), (X << 10) | 0x1f)); }
template <int X> __device__ __forceinline__ unsigned swzu(unsigned v) { return (unsigned)__builtin_amdgcn_ds_swizzle((int)v, (X << 10) | 0x1f); }
__device__ __forceinline__ void phase_prep_qk(bf16_t* H0, const float* qn, const float* kn, unsigned char* K8, int G, int bid, int tid) {
    const int wid = __builtin_amdgcn_readfirstlane(tid >> 6), lane = tid & 63;
    const int cch = lane & 15, half = cch >> 3, ci = cch & 7; const bool isx2 = ci >= 4;
    float gqo[8], gqp[8], gko[8], gkp[8], invf[8];
#pragma unroll
    for (int j = 0; j < 8; ++j) { gqo[j] = qn[8 * cch + j]; gqp[j] = qn[8 * (cch ^ 4) + j]; gko[j] = kn[8 * cch + j]; gkp[j] = kn[8 * (cch ^ 4) + j]; invf[j] = inv_freq32(8 * (ci & 3) + j); }
    const int mstep = G * 8, m0 = bid * 8 + wid;
    u32x4 rawc[3], rawn[3];
#define PQK_LOAD(mm, R) do { const bf16_t* rp_ = H0 + (size_t)(mm) * IN0; _Pragma("unroll") for (int p = 0; p < 3; ++p) { if (p < 2 || lane < 32) { const int hh = 4 * p + (lane >> 4); \
        (R)[p] = *(const u32x4*)(rp_ + (hh < 8 ? hh * 128 : 1024 + (hh - 8) * 128) + 8 * cch); } } } while (0)
    rawc[2] = (u32x4){0u, 0u, 0u, 0u}; rawn[2] = rawc[2];
    if (m0 < T_) PQK_LOAD(m0, rawc);
    rawn[0] = rawc[0]; rawn[1] = rawc[1];
    for (int m = m0; m < T_; m += mstep) {
        if (m + mstep < T_) PQK_LOAD(m + mstep, rawn);
        const int sq = m & (SEQ - 1); const float pos = (float)(half ? (sq & 63) : (sq >> 6));
        float sn[8], cs[8];
#pragma unroll
        for (int j = 0; j < 8; ++j) sincos_rev(pos * invf[j], sn[j], cs[j]);
        bf16_t* rowp = H0 + (size_t)m * IN0;
#pragma unroll
        for (int p = 0; p < 3; ++p) {
            if (p < 2 || lane < 32) {
                const int hh = 4 * p + (lane >> 4); const bool isq = hh < 8;
                bf16_t* cp = rowp + (isq ? hh * 128 : 1024 + (hh - 8) * 128) + 8 * cch;
                const u32x4 raw = rawc[p];
                const unsigned rw4[4] = {raw.x, raw.y, raw.z, raw.w}; float x[8], xp[8]; float ss = 0.f;
#pragma unroll
                for (int q = 0; q < 4; ++q) { x[2 * q] = bflo(rw4[q]); x[2 * q + 1] = bfhi(rw4[q]); ss += x[2 * q] * x[2 * q] + x[2 * q + 1] * x[2 * q + 1];
                    const unsigned pw = swzu<4>(rw4[q]); xp[2 * q] = bflo(pw); xp[2 * q + 1] = bfhi(pw); }
                ss += swzf<1>(ss); ss += swzf<2>(ss); ss += swzf<4>(ss); ss += swzf<8>(ss);
                const float r = rsqrtf(ss * (1.0f / 128.0f) + 1e-6f);
                float o[8];
#pragma unroll
                for (int j = 0; j < 8; ++j) { const float yo = x[j] * r * (isq ? gqo[j] : gko[j]), yp = xp[j] * r * (isq ? gqp[j] : gkp[j]);
                    o[j] = isx2 ? (yo * cs[j] + yp * sn[j]) : (yo * cs[j] - yp * sn[j]); }
                *(u32x4*)cp = (u32x4){cvtpk(o[0], o[1]), cvtpk(o[2], o[3]), cvtpk(o[4], o[5]), cvtpk(o[6], o[7])};
                if (F8_ATTA && !isq) *(u32x2*)(K8 + (size_t)m * 256 + (hh - 8) * 128 + 8 * cch) = (u32x2){pk4_fp8(o[0], o[1], o[2], o[3]), pk4_fp8(o[4], o[5], o[6], o[7])};
            }
        }
        rawc[0] = rawn[0]; rawc[1] = rawn[1]; rawc[2] = rawn[2];
    }
#undef PQK_LOAD
}
__device__ __forceinline__ void phase_vt8(const bf16_t* H0, unsigned char* Vt8, LAS unsigned char* lds, int G, int bid, int tid) {
    const int t = tid >> 3, seg = tid & 7, c = tid >> 2, part = tid & 3;
    for (int u = bid; u < 1024; u += G) {
        const int b = u >> 7, kvh = (u >> 6) & 1, ch = u & 63;
        const bf16_t* src = H0 + (size_t)(b * SEQ + ch * 64 + t) * IN0 + 1280 + kvh * 128 + seg * 16;
        const u32x4 v0 = *(const u32x4*)src, v1 = *(const u32x4*)(src + 8);
        const unsigned w[8] = {v0.x, v0.y, v0.z, v0.w, v1.x, v1.y, v1.z, v1.w};
        __syncthreads();
#pragma unroll
        for (int j = 0; j < 8; ++j) { lds[(16 * seg + 2 * j) * 80 + t] = f2fp8(bflo(w[j])); lds[(16 * seg + 2 * j + 1) * 80 + t] = f2fp8(bfhi(w[j])); }
        __syncthreads();
        const u32x4 o = *(const LAS u32x4*)(lds + c * 80 + part * 16);
        *(u32x4*)(Vt8 + ((size_t)(b * 2 + kvh) * 128 + c) * SEQ + ch * 64 + part * 16) = o;
    }
    __syncthreads();
}
__device__ __forceinline__ void phase_k8_copy(const bf16_t* H, int ldh, int col0, unsigned char* K8, int G, int bid, int tid) {
    for (size_t i = (size_t)bid * NTHR + tid; i < (size_t)T_ * 128; i += (size_t)G * NTHR) { const size_t m = i >> 7; const int c = (int)(i & 127) * 8;
        const u32x4 v = *(const u32x4*)(H + m * ldh + col0 + c);
        *(u32x2*)(K8 + m * 1024 + c) = (u32x2){pk4_fp8(bflo(v.x), bfhi(v.x), bflo(v.y), bfhi(v.y)), pk4_fp8(bflo(v.z), bfhi(v.z), bflo(v.w), bfhi(v.w))}; }
}
__device__ __forceinline__ void tr4x4(unsigned w0, unsigned w1, unsigned w2, unsigned w3, unsigned (&o)[4]) {
    const unsigned a_lo = __builtin_amdgcn_perm(w1, w0, 0x05010400u), a_hi = __builtin_amdgcn_perm(w1, w0, 0x07030602u);
    const unsigned b_lo = __builtin_amdgcn_perm(w3, w2, 0x05010400u), b_hi = __builtin_amdgcn_perm(w3, w2, 0x07030602u);
    o[0] = __builtin_amdgcn_perm(b_lo, a_lo, 0x05040100u); o[1] = __builtin_amdgcn_perm(b_lo, a_lo, 0x07060302u);
    o[2] = __builtin_amdgcn_perm(b_hi, a_hi, 0x05040100u); o[3] = __builtin_amdgcn_perm(b_hi, a_hi, 0x07060302u);
}
template <bool DIL>
__device__ __forceinline__ void phase_vt_heads(const unsigned char* V8, unsigned char* Vt1, unsigned char* Vt4, unsigned char* Vt16, LAS unsigned char* lds, int G, int bid, int tid) {
    constexpr int PITCH = 272, IMG = 128 * PITCH;
    const int cb = tid & 31, tq = tid >> 5;
    for (int u = bid; u < 1024; u += G) {
        const int b = u >> 7, h = (u >> 4) & 7, ch = u & 15;
        const unsigned char* src = V8 + (size_t)(b * SEQ + 256 * ch) * 1024 + h * 128 + 4 * cb;
        __syncthreads();
#pragma unroll
        for (int k = 0; k < 4; ++k) { const int tg = tq + 16 * k;
            unsigned o[4];
            { const int t0 = 4 * tg;
              tr4x4(*(const unsigned*)(src + (size_t)(t0 + 0) * 1024), *(const unsigned*)(src + (size_t)(t0 + 1) * 1024), *(const unsigned*)(src + (size_t)(t0 + 2) * 1024), *(const unsigned*)(src + (size_t)(t0 + 3) * 1024), o);
#pragma unroll
              for (int j = 0; j < 4; ++j) *(LAS unsigned*)(lds + (4 * cb + j) * PITCH + 4 * tg) = o[j]; }
            if constexpr (DIL) {
                { const int r = tg & 3, g = tg >> 2; const int t0 = r + 16 * g;
                  tr4x4(*(const unsigned*)(src + (size_t)(t0 + 0) * 1024), *(const unsigned*)(src + (size_t)(t0 + 4) * 1024), *(const unsigned*)(src + (size_t)(t0 + 8) * 1024), *(const unsigned*)(src + (size_t)(t0 + 12) * 1024), o);
#pragma unroll
                  for (int j = 0; j < 4; ++j) *(LAS unsigned*)(lds + IMG + (4 * cb + j) * PITCH + r * 64 + 4 * g) = o[j]; }
                { const int cls = tg & 15, g = tg >> 4; const int t0 = cls + 64 * g;
                  tr4x4(*(const unsigned*)(src + (size_t)(t0 + 0) * 1024), *(const unsigned*)(src + (size_t)(t0 + 16) * 1024), *(const unsigned*)(src + (size_t)(t0 + 32) * 1024), *(const unsigned*)(src + (size_t)(t0 + 48) * 1024), o);
#pragma unroll
                  for (int j = 0; j < 4; ++j) *(LAS unsigned*)(lds + 2 * IMG + (4 * cb + j) * PITCH + cls * 16 + 4 * g) = o[j]; }
            }
        }
        __syncthreads();
        const size_t cbase = (size_t)(b * 8 + h) * 128;
#pragma unroll
        for (int k = 0; k < 4; ++k) { const int id = tid + NTHR * k, col = id >> 4, pc = id & 15;
            *(u32x4*)(Vt1 + (cbase + col) * SEQ + 256 * ch + pc * 16) = *(const LAS u32x4*)(lds + col * PITCH + pc * 16);
            if constexpr (DIL) {
                *(u32x4*)(Vt4 + (cbase + col) * SEQ + (pc >> 2) * 1024 + 64 * ch + (pc & 3) * 16) = *(const LAS u32x4*)(lds + IMG + col * PITCH + pc * 16);
                *(u32x4*)(Vt16 + (cbase + col) * SEQ + pc * 256 + 16 * ch) = *(const LAS u32x4*)(lds + 2 * IMG + col * PITCH + pc * 16); } }
    }
    __syncthreads();
}
__device__ __forceinline__ void phase_prep_mla(bf16_t* H1, bf16_t* krope, unsigned char* kr8, int G, int bid, int tid) {
    const int wid = __builtin_amdgcn_readfirstlane(tid >> 6), lane = tid & 63;
    const float invf = inv_freq32(lane & 31);
    for (int m = bid * 8 + wid; m < T_; m += G * 8) {
        bf16_t* rowp = H1 + (size_t)m * IN1P;
        const u32x4 a = *(const u32x4*)(rowp + 3072 + lane * 8);
        float ss = bflo(a.x) * bflo(a.x) + bfhi(a.x) * bfhi(a.x) + bflo(a.y) * bflo(a.y) + bfhi(a.y) * bfhi(a.y) + bflo(a.z) * bflo(a.z) + bfhi(a.z) * bfhi(a.z) + bflo(a.w) * bflo(a.w) + bfhi(a.w) * bfhi(a.w);
        ss = wave_sum(ss);
        const u32x2 c = *(const u32x2*)(rowp + 3584 + lane * 4);
        float s2 = bflo(c.x) * bflo(c.x) + bfhi(c.x) * bfhi(c.x) + bflo(c.y) * bflo(c.y) + bfhi(c.y) * bfhi(c.y);
        s2 = wave_sum(s2);
        const float rq = rsqrtf(ss * (1.0f / 512.0f) + 1e-6f), rkv = rsqrtf(s2 * (1.0f / 256.0f) + 1e-6f);
        if constexpr (F8_P3 != 0) {
            *(u32x2*)((unsigned char*)(rowp + 3072) + lane * 8) = (u32x2){pk4_fp8(bflo(a.x) * rq, bfhi(a.x) * rq, bflo(a.y) * rq, bfhi(a.y) * rq), pk4_fp8(bflo(a.z) * rq, bfhi(a.z) * rq, bflo(a.w) * rq, bfhi(a.w) * rq)};
            *(unsigned*)((unsigned char*)(rowp + 3584) + lane * 4) = pk4_fp8(bflo(c.x) * rkv, bfhi(c.x) * rkv, bflo(c.y) * rkv, bfhi(c.y) * rkv); }
        else {
        *(u32x4*)(rowp + 3072 + lane * 8) = (u32x4){cvtpk(bflo(a.x) * rq, bfhi(a.x) * rq), cvtpk(bflo(a.y) * rq, bfhi(a.y) * rq), cvtpk(bflo(a.z) * rq, bfhi(a.z) * rq), cvtpk(bflo(a.w) * rq, bfhi(a.w) * rq)};
        *(u32x2*)(rowp + 3584 + lane * 4) = (u32x2){cvtpk(bflo(c.x) * rkv, bfhi(c.x) * rkv), cvtpk(bflo(c.y) * rkv, bfhi(c.y) * rkv)}; }
        if (lane < 32) { const float x1 = bf2f(rowp[3840 + lane]), x2 = bf2f(rowp[3840 + 32 + lane]);
            float sn, cs; sincos_rev((float)(m & (SEQ - 1)) * invf, sn, cs);
            const float o1 = x1 * cs - x2 * sn, o2 = x2 * cs + x1 * sn;
            krope[(size_t)m * 64 + lane] = f2bf(o1); krope[(size_t)m * 64 + 32 + lane] = f2bf(o2);
            if (F8_ATTD) { kr8[(size_t)m * 64 + lane] = f2fp8(o1); kr8[(size_t)m * 64 + 32 + lane] = f2fp8(o2); } }
    }
}

constexpr int LNR_PITCH = 2052;
constexpr int LNR_PART = 131584, LNR_SC = 147968, LNR_SEL = 150016, LNR_BLE = 152064, LNR_HIST = 153088;
template <bool RES_F32>
__device__ __forceinline__ void phase_ln_router(const bf16_t* mix, const void* res, const float* g, const float* bb, const float* rw, const float* rb, bf16_t* x1b, unsigned char* x1q,
                                                int* tok_e, int* tok_p, float* tok_g, int* list, unsigned* cnt, LAS unsigned char* lds, int G, int bid, int tid, bool commit = true) {
    const int wid = __builtin_amdgcn_readfirstlane(tid >> 6), lane = tid & 63;
    float ALPHA = 1.4142135623730951f; asm volatile("" : "+v"(ALPHA));
    LAS float* xs = (LAS float*)lds; LAS float* part = (LAS float*)(lds + LNR_PART); LAS float* scs = (LAS float*)(lds + LNR_SC); LAS float* sels = (LAS float*)(lds + LNR_SEL);
    LAS int* ble = (LAS int*)(lds + LNR_BLE); LAS int* hist = (LAS int*)(lds + LNR_HIST);
    f16x8 bw[8][2];
    { const float* rwp = rw + (size_t)(256 * wid + 8 * (lane >> 4)) * 32 + (lane & 15);
#pragma unroll
      for (int ks = 0; ks < 8; ++ks)
#pragma unroll
        for (int hf = 0; hf < 2; ++hf)
#pragma unroll
          for (int j = 0; j < 8; ++j) bw[ks][hf][j] = (_Float16)rwp[(32 * ks + j) * 32 + 16 * hf]; }
    typedef typename std::conditional<RES_F32, f32x4, u32x2>::type res_t;
    typedef typename std::conditional<F8_MIX != 0, unsigned, u32x2>::type mix_t;
    mix_t mv[2][8]; res_t rv[2][8];
#define LNR_LOAD(tix_, rr) do { const size_t eo = ((size_t)(tix_) * 16 + 2 * wid + (rr)) * DM + 4 * lane; \
        _Pragma("unroll") for (int i = 0; i < 8; ++i) { if constexpr (F8_MIX != 0) mv[rr][i] = *(const mix_t*)((const unsigned char*)mix + eo + 256 * i); else mv[rr][i] = *(const mix_t*)(mix + eo + 256 * i); \
            if constexpr (RES_F32) rv[rr][i] = *(const res_t*)((const float*)res + eo + 256 * i); else rv[rr][i] = *(const res_t*)((const bf16_t*)res + eo + 256 * i); } } while (0)
    const int ntile = T_ / 16;
    int ntl = 0;
    if (bid < ntile) LNR_LOAD(bid, 0);
    const int lane0 = lane;
    for (int it = 0; bid + G * it < ntile; ++it) {
        const int tix = bid + G * it;
        int lane = lane0; asm volatile("" : "+v"(lane));
#pragma unroll
        for (int rr = 0; rr < 2; ++rr) {
            const int row = 2 * wid + rr; const size_t m = (size_t)tix * 16 + row;
            f32x4 zr[8]; float s = 0.f;
#pragma unroll
            for (int i = 0; i < 8; ++i) { f32x4 mx;
                if constexpr (F8_MIX != 0) { const int mw = (int)*(const unsigned*)&mv[rr][i]; const f32x2 m0 = __builtin_amdgcn_cvt_pk_f32_fp8(mw, false), m1 = __builtin_amdgcn_cvt_pk_f32_fp8(mw, true);
                    mx = (f32x4){m0[0], m0[1], m1[0], m1[1]} * (1.0f / 16.f); }
                else { const u32x2 mb = *(const u32x2*)&mv[rr][i]; mx = (f32x4){bflo(mb.x), bfhi(mb.x), bflo(mb.y), bfhi(mb.y)}; }
                f32x4 rx;
                if constexpr (RES_F32) rx = rv[rr][i]; else { const u32x2 rb2 = rv[rr][i]; rx = (f32x4){bflo(rb2.x), bfhi(rb2.x), bflo(rb2.y), bfhi(rb2.y)}; }
                zr[i] = ALPHA * rx + mx; s += (zr[i][0] + zr[i][1]) + (zr[i][2] + zr[i][3]); }
            if (rr == 0) { __builtin_amdgcn_sched_barrier(0); LNR_LOAD(tix, 1); __builtin_amdgcn_sched_barrier(0); }
            const float mean = wave_sum(s) * (1.0f / DM); float q = 0.f;
#pragma unroll
            for (int i = 0; i < 8; ++i) { const f32x4 d = zr[i] - mean; q += (d[0] * d[0] + d[1] * d[1]) + (d[2] * d[2] + d[3] * d[3]); }
            const float rstd = rsqrtf(wave_sum(q) * (1.0f / DM) + 1e-5f);
            f32x4 gv = *(const f32x4*)(g + 4 * lane), bv = *(const f32x4*)(bb + 4 * lane);
#pragma unroll
            for (int i = 0; i < 8; ++i) { const int col = 4 * lane + 256 * i; f32x4 gn = gv, bn = bv;
                if (i < 7) { gn = *(const f32x4*)(g + col + 256); bn = *(const f32x4*)(bb + col + 256); }
                __builtin_amdgcn_sched_barrier(0);
                const f32x4 y = (zr[i] - mean) * rstd * gv + bv;
                LAS f32x2* xp = (LAS f32x2*)(xs + row * LNR_PITCH + col); xp[0] = (f32x2){y[0], y[1]}; xp[1] = (f32x2){y[2], y[3]};
                *(u32x2*)(x1b + m * DM + col) = (u32x2){cvtpk(y[0], y[1]), cvtpk(y[2], y[3])};
                if constexpr (F8_GU) *(unsigned*)(x1q + m * DM + col) = pk4_fp8(y[0], y[1], y[2], y[3]);
                __builtin_amdgcn_sched_barrier(0);
                gv = gn; bv = bn; }
        }
        __builtin_amdgcn_sched_barrier(0);
        if (tix + G < ntile) LNR_LOAD(tix + G, 0);
        __builtin_amdgcn_sched_barrier(0);
        __syncthreads();
        { f32x4 acc0 = {0.f, 0.f, 0.f, 0.f}, acc1 = {0.f, 0.f, 0.f, 0.f}; const LAS float* xa = xs + (lane & 15) * LNR_PITCH + 256 * wid + 8 * (lane >> 4); const int e = lane & 15;
#pragma unroll
          for (int ks = 0; ks < 8; ++ks) { const f32x4 xa0 = *(const LAS f32x4*)(xa + 32 * ks), xa1 = *(const LAS f32x4*)(xa + 32 * ks + 4);
              const float xv[8] = {xa0[0], xa0[1], xa0[2], xa0[3], xa1[0], xa1[1], xa1[2], xa1[3]}; f16x8 ah, al;
#pragma unroll
              for (int j = 0; j < 8; ++j) { const _Float16 hh = (_Float16)xv[j]; ah[j] = hh; al[j] = (_Float16)(xv[j] - (float)hh); }
              acc0 = __builtin_amdgcn_mfma_f32_16x16x32_f16(ah, bw[ks][0], acc0, 0, 0, 0); acc1 = __builtin_amdgcn_mfma_f32_16x16x32_f16(ah, bw[ks][1], acc1, 0, 0, 0);
              acc0 = __builtin_amdgcn_mfma_f32_16x16x32_f16(al, bw[ks][0], acc0, 0, 0, 0); acc1 = __builtin_amdgcn_mfma_f32_16x16x32_f16(al, bw[ks][1], acc1, 0, 0, 0); }
          __builtin_amdgcn_sched_barrier(0);
          __builtin_amdgcn_sched_barrier(0);
#pragma unroll
          for (int r = 0; r < 4; ++r) { const int row = (lane >> 4) * 4 + r; part[(wid * 16 + row) * 32 + e] = acc0[r]; part[(wid * 16 + row) * 32 + 16 + e] = acc1[r]; } }
        __syncthreads();
        { const int row = tid >> 5, e = tid & 31; float lg = 0.f;
#pragma unroll
          for (int w = 0; w < 8; ++w) lg += part[(w * 16 + row) * 32 + e];
          const float sc = 1.0f / (1.0f + __expf(-lg)); scs[row * 32 + e] = sc; sels[row * 32 + e] = sc + rb[e]; }
        __syncthreads();
        if (tid < 16) { const int row = tid; float best = -INFINITY; int bg = 0;
            for (int gI = 0; gI < 8; ++gI) { const float a = sels[row * 32 + 4 * gI], b = sels[row * 32 + 4 * gI + 1], c = sels[row * 32 + 4 * gI + 2], d = sels[row * 32 + 4 * gI + 3];
                const float h1 = fmaxf(a, b), l1 = fminf(a, b), h2 = fmaxf(c, d), l2 = fminf(c, d); const float gs = fmaxf(h1, h2) + fmaxf(fminf(h1, h2), fmaxf(l1, l2));
                if (gs > best) { best = gs; bg = gI; } }
            const float v0 = sels[row * 32 + 4 * bg], v1 = sels[row * 32 + 4 * bg + 1], v2 = sels[row * 32 + 4 * bg + 2], v3 = sels[row * 32 + 4 * bg + 3];
            int i1 = 0; float b1v = v0; if (v1 > b1v) { b1v = v1; i1 = 1; } if (v2 > b1v) { b1v = v2; i1 = 2; } if (v3 > b1v) { b1v = v3; i1 = 3; }
            int i2 = -1; float b2v = -INFINITY;
            if (i1 != 0 && v0 > b2v) { b2v = v0; i2 = 0; } if (i1 != 1 && v1 > b2v) { b2v = v1; i2 = 1; } if (i1 != 2 && v2 > b2v) { b2v = v2; i2 = 2; } if (i1 != 3 && v3 > b2v) { b2v = v3; i2 = 3; }
            const int e1 = 4 * bg + i1, e2 = 4 * bg + i2; const float s1 = scs[row * 32 + e1], s2 = scs[row * 32 + e2]; const float inv = 1.0f / (s1 + s2);
            const int m = tix * 16 + row;
            tok_e[2 * m] = e1; tok_e[2 * m + 1] = e2; tok_g[2 * m] = s1 * inv; tok_g[2 * m + 1] = s2 * inv;
            ble[(it * 16 + row) * 2] = e1; ble[(it * 16 + row) * 2 + 1] = e2; }
        __syncthreads();
        ntl = it + 1;
    }
#undef LNR_LOAD
    const int nasg = commit ? ntl * 32 : 0;
    if (tid < 32) { int c = 0; for (int i = 0; i < nasg; ++i) c += (ble[i] == tid) ? 1 : 0;
        unsigned base = 0; if (c) base = __hip_atomic_fetch_add(cnt + tid, (unsigned)c, __ATOMIC_RELAXED, __HIP_MEMORY_SCOPE_AGENT);
        hist[tid] = (int)base; }
    __syncthreads();
    if (tid < 32) { int run = hist[tid];
        for (int i = 0; i < nasg; ++i) if (ble[i] == tid) { const int tr = i >> 1; const size_t m = (size_t)(bid + G * (tr >> 4)) * 16 + (tr & 15);
            list[(size_t)tid * 65536 + run] = (int)m; tok_p[2 * m + (i & 1)] = run; ++run; } }
    __syncthreads();
}

constexpr int MOE_LDS = 131072;
__device__ __forceinline__ int moe_prefix(const unsigned* cnt, LAS int* pblk, int tid) {
    if (tid == 0) { int acc = 0; for (int e = 0; e < NE; ++e) { pblk[e] = acc; acc += ((int)cnt[e] + 255) >> 8; } pblk[NE] = acc; }
    __syncthreads();
    return pblk[NE];
}
template <int NJ> __device__ __forceinline__ int moe_table(const unsigned* cnt, LAS int* pblk, LAS int* tab, LAS int* aux, int NB, int G, int bid, int tid) {
    const int NU = NB * NJ;
    if (tid < 16) { const int L = bid + G * tid;
        if (L < NU) { const int rb = L / NJ, j = L % NJ; int e = 0; for (int q = 1; q < NE; ++q) if (pblk[q] <= rb) e = q;
            tab[tid] = rb; tab[16 + tid] = NJ * e + j; aux[tid * 3] = e; aux[tid * 3 + 1] = (rb - pblk[e]) * 256; aux[tid * 3 + 2] = (int)cnt[e]; } }
    __syncthreads();
    int n = 0; for (int i = 0; i < 16; ++i) if (bid + G * i < NU) n = i + 1;
    return n;
}

template <bool FINAL>
__device__ __forceinline__ void phase_combine_ln(const float* dbg, const bf16_t* x1b, const bf16_t* Yr, const int* tok_e, const int* tok_p, const float* tok_g, const unsigned* cnt,
                                                 const float* g, const float* bb, bf16_t* xo, unsigned char* xq, float* fo, LAS unsigned char* lds, int G, int bid, int tid) {
    LAS int* pblk = (LAS int*)lds;
    moe_prefix(cnt, pblk, tid);
    const int wid = __builtin_amdgcn_readfirstlane(tid >> 6), lane = tid & 63;
    float ALPHA = 1.4142135623730951f; asm volatile("" : "+v"(ALPHA));
#if DBG_CHECK
    const bool dbg_bad = FINAL && (!(dbg[0] <= DBG_TOL * DBG_TOL * dbg[1]) || !(dbg[2] <= DBG_TOL * DBG_TOL * dbg[3]) || !(dbg[1] > 0.f) || !(dbg[3] > 0.f) ||
                                    !(dbg[4] <= DBG_TOL * DBG_TOL * dbg[5]) || !(dbg[6] <= DBG_TOL * DBG_TOL * dbg[7]) || !(dbg[5] > 0.f) || !(dbg[7] > 0.f) ||
                                    !(dbg[8] <= DBG_TOL_SP * DBG_TOL_SP * dbg[9]) || !(dbg[10] <= DBG_TOL_SP * DBG_TOL_SP * dbg[11]) || !(dbg[9] > 0.f) || !(dbg[11] > 0.f));
#endif
    static_assert(F8_YR, "the pipelined combine reads e4m3 expert rows");
    struct Meta { size_t p0, p1; float h0, h1; };
    struct Rows { u32x4 xa[4]; u32x2 ya[4], yb[4]; };
#define CMB_META(mm, M) do { const int _e0 = tok_e[2 * (mm)], _e1 = tok_e[2 * (mm) + 1]; (M).p0 = (size_t)pblk[_e0] * 256 + tok_p[2 * (mm)]; (M).p1 = (size_t)pblk[_e1] * 256 + tok_p[2 * (mm) + 1]; \
        (M).h0 = tok_g[2 * (mm)] * (1.0f / 16.0f); (M).h1 = tok_g[2 * (mm) + 1] * (1.0f / 16.0f); } while (0)
#define CMB_ROWS(mm, M, R) do { _Pragma("unroll") for (int i = 0; i < 4; ++i) { const int col = 8 * lane + 512 * i; (R).xa[i] = *(const u32x4*)(x1b + (size_t)(mm) * DM + col); \
        (R).ya[i] = *(const u32x2*)((const unsigned char*)Yr + (M).p0 * DM + col); (R).yb[i] = *(const u32x2*)((const unsigned char*)Yr + (M).p1 * DM + col); } } while (0)
    const int mstep = G * 8, m0 = bid * 8 + wid;
    Meta Mc, Mn; Rows Rc, Rn;
    Mc.p0 = Mc.p1 = 0; Mc.h0 = Mc.h1 = 0.f; Mn = Mc;
    if (m0 < T_) { CMB_META(m0, Mc); CMB_ROWS(m0, Mc, Rc); }
    if (m0 + mstep < T_) CMB_META(m0 + mstep, Mn);
    Rn = Rc;
    for (int m = m0; m < T_; m += mstep) {
        Meta Mnn = Mn;
        if (m + mstep < T_) CMB_ROWS(m + mstep, Mn, Rn);
        if (m + 2 * mstep < T_) CMB_META(m + 2 * mstep, Mnn);
        const float h0 = Mc.h0, h1 = Mc.h1;
        float v[32]; float s = 0.f;
#pragma unroll
        for (int i = 0; i < 4; ++i) {
            const unsigned xw[4] = {Rc.xa[i].x, Rc.xa[i].y, Rc.xa[i].z, Rc.xa[i].w}; const unsigned aw[2] = {Rc.ya[i].x, Rc.ya[i].y}, bw[2] = {Rc.yb[i].x, Rc.yb[i].y};
#define CMB_PAIR(j, W, SEL) do { const f32x2 a2 = __builtin_amdgcn_cvt_pk_f32_fp8((int)aw[W], SEL), b2 = __builtin_amdgcn_cvt_pk_f32_fp8((int)bw[W], SEL); \
                    v[i * 8 + 2 * (j)] = ALPHA * bflo(xw[j]) + h0 * a2[0] + h1 * b2[0]; v[i * 8 + 2 * (j) + 1] = ALPHA * bfhi(xw[j]) + h0 * a2[1] + h1 * b2[1]; \
                    s += v[i * 8 + 2 * (j)] + v[i * 8 + 2 * (j) + 1]; } while (0)
            CMB_PAIR(0, 0, false); CMB_PAIR(1, 0, true); CMB_PAIR(2, 1, false); CMB_PAIR(3, 1, true);
#undef CMB_PAIR
        }
        Mc = Mn; Mn = Mnn; Rc = Rn;
        const float mean = wave_sum(s) * (1.0f / DM); float q = 0.f;
#pragma unroll
        for (int i = 0; i < 32; ++i) { const float d = v[i] - mean; q += d * d; }
        const float rstd = rsqrtf(wave_sum(q) * (1.0f / DM) + 1e-5f);
#pragma unroll
        for (int i = 0; i < 4; ++i) { const int col = 8 * lane + 512 * i;
            const f32x4 ga = *(const f32x4*)(g + col), gb = *(const f32x4*)(g + col + 4), ba = *(const f32x4*)(bb + col), bbv = *(const f32x4*)(bb + col + 4);
            float y[8];
#pragma unroll
            for (int j = 0; j < 4; ++j) { y[j] = (v[i * 8 + j] - mean) * rstd * ga[j] + ba[j]; y[4 + j] = (v[i * 8 + 4 + j] - mean) * rstd * gb[j] + bbv[j]; }
#if DBG_CHECK
            if (dbg_bad) { for (int j = 0; j < 8; ++j) y[j] = 0.f; }
#endif
            if constexpr (FINAL) { *(f32x4*)(fo + (size_t)m * DM + col) = (f32x4){y[0], y[1], y[2], y[3]}; *(f32x4*)(fo + (size_t)m * DM + col + 4) = (f32x4){y[4], y[5], y[6], y[7]}; }
            else { *(u32x4*)(xo + (size_t)m * DM + col) = (u32x4){cvtpk(y[0], y[1]), cvtpk(y[2], y[3]), cvtpk(y[4], y[5]), cvtpk(y[6], y[7])};
                if constexpr (F8_IN) *(u32x2*)(xq + (size_t)m * DM + col) = (u32x2){pk4_fp8(y[0], y[1], y[2], y[3]), pk4_fp8(y[4], y[5], y[6], y[7])}; } }
    }
#undef CMB_META
#undef CMB_ROWS
}

#if DBG_CHECK
__device__ __forceinline__ void dbg_attn_check(int which, const bf16_t* Hx, const bf16_t* Qd, const bf16_t* KVd, const bf16_t* krope, const void* Oat, float* dbg, LAS unsigned char* lds, int bid, int tid) {
    const int wid = __builtin_amdgcn_readfirstlane(tid >> 6), lane = tid & 63;
    LAS float* sc = (LAS float*)lds + wid * 4096;
    LAS float* qs = (LAS float*)(lds + 131072) + wid * 192;
    const unsigned sid = (unsigned)(bid * 8 + wid);
    const int m = (int)((sid * 2654435761u) % (unsigned)T_), h = (int)(sid & 7u), b = m >> 12, pos = m & (SEQ - 1);
    const int DQ = which ? 192 : 128; const float scale = which ? 0.072168783648703220f : 0.088388347648318440f;
    for (int d = lane; d < DQ; d += 64) {
        float qv;
        if (which == 0) qv = bf2f(Hx[(size_t)m * IN0 + h * 128 + d]);
        else if (d < 128) qv = bf2f(Qd[(size_t)m * 1536 + h * 192 + d]);
        else { const int i = (d - 128) & 31; const float x1 = bf2f(Qd[(size_t)m * 1536 + h * 192 + 128 + i]), x2 = bf2f(Qd[(size_t)m * 1536 + h * 192 + 160 + i]);
            float sn, cs; sincos_rev((float)pos * inv_freq32(i), sn, cs); qv = (d < 160) ? (x1 * cs - x2 * sn) : (x2 * cs + x1 * sn); }
        qs[d] = qv; }
    asm volatile("s_waitcnt lgkmcnt(0)" ::: "memory");
    float mx = -INFINITY;
    for (int i = 0; i < 64; ++i) { const int j = lane + 64 * i; float dot = 0.f;
        if (which == 0) { const bf16_t* kp = Hx + (size_t)(b * SEQ + j) * IN0 + 1024 + (h >> 2) * 128; for (int d = 0; d < 128; ++d) dot += qs[d] * bf2f(kp[d]); }
        else { const bf16_t* kp = KVd + (size_t)(b * SEQ + j) * DM + h * 256; for (int d = 0; d < 128; ++d) dot += qs[d] * bf2f(kp[d]);
               const bf16_t* rp = krope + (size_t)(b * SEQ + j) * 64; for (int d = 0; d < 64; ++d) dot += qs[128 + d] * bf2f(rp[d]); }
        dot *= scale; sc[j] = dot; mx = fmaxf(mx, dot); }
    mx = wave_max(mx);
    float sum = 0.f;
    for (int i = 0; i < 64; ++i) { const int j = lane + 64 * i; const float pj = __expf(sc[j] - mx); sc[j] = pj; sum += pj; }
    sum = wave_sum(sum);
    asm volatile("s_waitcnt lgkmcnt(0)" ::: "memory");
    float e2 = 0.f, r2 = 0.f;
    for (int cc = 0; cc < 2; ++cc) { const int c = lane + 64 * cc; float acc = 0.f;
        for (int j = 0; j < SEQ; ++j) { const float vv = which == 0 ? bf2f(Hx[(size_t)(b * SEQ + j) * IN0 + 1280 + (h >> 2) * 128 + c]) : bf2f(KVd[(size_t)(b * SEQ + j) * DM + h * 256 + 128 + c]); acc += sc[j] * vv; }
        const float ref = acc / sum; const size_t eo = (size_t)m * DM + (which ? 1024 : 0) + h * 128 + c;
        float got; if (F8_OUT) { const unsigned char by = ((const unsigned char*)Oat)[eo]; const f32x2 g2 = __builtin_amdgcn_cvt_pk_f32_fp8((int)by, false); got = g2[0] * (1.0f / O8_SCALE); } else got = bf2f(((const bf16_t*)Oat)[eo]);
        e2 += (got - ref) * (got - ref); r2 += ref * ref; }
    e2 = wave_sum(e2); r2 = wave_sum(r2);
    if (lane == 0) { atomicAdd(dbg + 2 * which, e2); atomicAdd(dbg + 2 * which + 1, r2); }
}
#endif
#if DBG_CHECK
__device__ __forceinline__ void dbg_sparse_check(int L, const bf16_t* Hx, const unsigned char* K8r, const unsigned char* V8r, const float* rpb, const void* Oat, float* dbg, LAS unsigned char* lds, int bid, int tid) {
    const int wid = __builtin_amdgcn_readfirstlane(tid >> 6), lane = tid & 63;
    LAS float* sc = (LAS float*)lds + wid * 1024; LAS int* kt = (LAS int*)(lds + 65536) + wid * 1024; LAS float* qs = (LAS float*)(lds + 131072) + wid * 128;
    const unsigned sid = (unsigned)(bid * 8 + wid);
    const int m = (int)((sid * 2654435761u + 12345u) % (unsigned)T_), h = (int)((sid >> 3) & 7u), b = m >> 12, pos = m & (SEQ - 1);
    const int ldh = L ? IN1P : IN0, qoff = L ? h * 128 : 1536 + h * 128;
    for (int d = lane; d < 128; d += 64) qs[d] = bf2f(Hx[(size_t)m * ldh + qoff + d]);
    int nk;
    if (L == 0) { nk = 387; const float slope = __builtin_amdgcn_exp2f(-(float)(h + 1));
        for (int idx = lane; idx < nk; idx += 64) { const int br = idx / 129, dd = idx % 129 - 64, dil = br == 0 ? 1 : (br == 1 ? 4 : 16), rd = pos % dil, kd = pos / dil + dd;
            const bool ok = kd >= 0 && kd < SEQ / dil; kt[idx] = ok ? b * SEQ + kd * dil + rd : -1; sc[idx] = -slope * (float)dil * (float)(dd < 0 ? -dd : dd); } }
    else { nk = 128; const int r = pos >> 6, qc = pos & 63, r0 = min(max(r - 4, 0), 56), c0 = min(max(qc - 8, 0), 48);
        for (int idx = lane; idx < nk; idx += 64) { const int kr = r0 + (idx >> 4), kc = c0 + (idx & 15); kt[idx] = b * SEQ + kr * 64 + kc; sc[idx] = rpb[h * 465 + (kr - r + 7) * 31 + (kc - qc + 15)]; } }
    asm volatile("s_waitcnt lgkmcnt(0)" ::: "memory");
    float mx = -INFINITY;
    for (int idx = lane; idx < nk; idx += 64) { float sv = -INFINITY; const int t = kt[idx];
        if (t >= 0) { const unsigned char* kp = K8r + (size_t)t * 1024 + h * 128; float dot = 0.f;
            for (int d = 0; d < 128; ++d) { const f32x2 kv = __builtin_amdgcn_cvt_pk_f32_fp8((int)kp[d], false); dot += qs[d] * kv[0]; }
            sv = dot * 0.088388347648318440f + sc[idx]; }
        sc[idx] = sv; mx = fmaxf(mx, sv); }
    mx = wave_max(mx);
    float sum = 0.f;
    for (int idx = lane; idx < nk; idx += 64) { const float pj = __expf(sc[idx] - mx); sc[idx] = pj; sum += pj; }
    sum = wave_sum(sum);
    asm volatile("s_waitcnt lgkmcnt(0)" ::: "memory");
    float e2 = 0.f, r2 = 0.f;
    for (int cc = 0; cc < 2; ++cc) { const int c = lane + 64 * cc; float acc = 0.f;
        for (int idx = 0; idx < nk; ++idx) { const int t = kt[idx]; if (t >= 0) { const f32x2 vv = __builtin_amdgcn_cvt_pk_f32_fp8((int)V8r[(size_t)t * 1024 + h * 128 + c], false); acc += sc[idx] * vv[0]; } }
        const float ref = acc / sum; const size_t eo = (size_t)m * DM + (L ? 0 : 1024) + h * 128 + c;
        float got; if (F8_OUT) { const unsigned char by = ((const unsigned char*)Oat)[eo]; const f32x2 g2 = __builtin_amdgcn_cvt_pk_f32_fp8((int)by, false); got = g2[0] * (1.0f / O8_SCALE); } else got = bf2f(((const bf16_t*)Oat)[eo]);
        e2 += (got - ref) * (got - ref); r2 += ref * ref; }
    e2 = wave_sum(e2); r2 = wave_sum(r2);
    if (lane == 0) { atomicAdd(dbg + 8 + 2 * L, e2); atomicAdd(dbg + 9 + 2 * L, r2); }
}
#endif
#if DBG_CHECK
__device__ __forceinline__ void dbg_prep_check(int L, const float* xf, const bf16_t* xb2, const float* win, const float* gq, const float* gk, const bf16_t* H, const bf16_t* krope, float* dbg, LAS unsigned char* lds, int bid, int tid) {
    const int wid = __builtin_amdgcn_readfirstlane(tid >> 6), lane = tid & 63;
    const unsigned sid = (unsigned)(bid * 8 + wid);
    const int m = (int)((sid * 2246822519u) % (unsigned)T_); const int sq = m & (SEQ - 1);
    float e2 = 0.f, r2 = 0.f;
    if (L == 0) {
        const int hh = (int)(sid % 10u); const int colbase = hh < 8 ? hh * 128 : 1024 + (hh - 8) * 128; const float* gain = hh < 8 ? gq : gk;
        float a0 = 0.f, a1 = 0.f;
        for (int k = 0; k < DM; ++k) { const float xv = xf[(size_t)m * DM + k]; a0 += xv * win[(size_t)k * IN0 + colbase + lane]; a1 += xv * win[(size_t)k * IN0 + colbase + 64 + lane]; }
        const float ms = wave_sum(a0 * a0 + a1 * a1) * (1.0f / 128.0f); const float r = rsqrtf(ms + 1e-6f);
        const float y0 = a0 * r * gain[lane], y1 = a1 * r * gain[64 + lane];
        LAS float* ys = (LAS float*)lds + wid * 128; ys[lane] = y0; ys[64 + lane] = y1; asm volatile("s_waitcnt lgkmcnt(0)" ::: "memory");
#pragma unroll
        for (int q = 0; q < 2; ++q) { const int e = lane + 64 * q, hf = e >> 6, i = e & 31; const bool x2p = (e & 32) != 0;
            const float pos = (float)(hf ? (sq & 63) : (sq >> 6)); float sn, cs; sincos_rev(pos * inv_freq32(i), sn, cs);
            const float mine = ys[e], other = ys[e ^ 32];
            const float ref = x2p ? (mine * cs + other * sn) : (mine * cs - other * sn);
            const float got = bf2f(H[(size_t)m * IN0 + colbase + e]);
            e2 += (got - ref) * (got - ref); r2 += ref * ref; }
    } else {
        float acq[8] = {0.f, 0.f, 0.f, 0.f, 0.f, 0.f, 0.f, 0.f}; float akr = 0.f;
        for (int k = 0; k < DM; ++k) { const float xv = bf2f(xb2[(size_t)m * DM + k]); const float* wr = win + (size_t)k * IN1;
#pragma unroll
            for (int j = 0; j < 8; ++j) acq[j] += xv * wr[3072 + lane + 64 * j];
            akr += xv * wr[3840 + lane]; }
        float ss = 0.f;
#pragma unroll
        for (int j = 0; j < 8; ++j) ss += acq[j] * acq[j];
        const float r = rsqrtf(wave_sum(ss) * (1.0f / 512.0f) + 1e-6f);
#pragma unroll
        for (int j = 0; j < 8; ++j) { const float ref = acq[j] * r; float got; if (F8_P3) { const f32x2 g2 = __builtin_amdgcn_cvt_pk_f32_fp8((int)((const unsigned char*)(H + (size_t)m * IN1P + 3072))[lane + 64 * j], false); got = g2[0]; } else got = bf2f(H[(size_t)m * IN1P + 3072 + lane + 64 * j]);
            e2 += (got - ref) * (got - ref); r2 += ref * ref; }
        LAS float* ys = (LAS float*)lds + wid * 128; ys[lane] = akr; asm volatile("s_waitcnt lgkmcnt(0)" ::: "memory");
        { const int i = lane & 31; float sn, cs; sincos_rev((float)sq * inv_freq32(i), sn, cs); const float mine = ys[lane], other = ys[lane ^ 32];
          const float ref = (lane & 32) ? (mine * cs + other * sn) : (mine * cs - other * sn); const float got = bf2f(krope[(size_t)m * 64 + lane]);
          e2 += (got - ref) * (got - ref); r2 += ref * ref; }
    }
    e2 = wave_sum(e2); r2 = wave_sum(r2);
    if (lane == 0) { atomicAdd(dbg + 4 + 2 * L, e2); atomicAdd(dbg + 5 + 2 * L, r2); }
}
#endif
#ifndef ATT_ONLY
#define ATT_ONLY -1
#endif
#ifndef REP_K
#define REP_K -1
#endif
#ifndef REP_NULL
#define REP_NULL -1
#endif
#ifndef ABL_ATT
#define ABL_ATT -1
#endif
#ifndef REP_ATT
#define REP_ATT -1
#endif
#define NREP(k) ((REP_K == (k)) ? 2 : 1)
#define NREPA(k) ((REP_ATT == (k)) ? 2 : 1)
constexpr int N_PHASES = 20;
__global__ void __launch_bounds__(NTHR, 2) fwd(Params p) {
    extern __shared__ __attribute__((aligned(16))) unsigned char lds_raw[];
    LAS unsigned char* lds = (LAS unsigned char*)lds_raw;
    const int tid0 = threadIdx.x, bid = blockIdx.x, G = gridDim.x;
    const int wv = __builtin_amdgcn_readfirstlane(tid0 >> 6);
    const int vcu = (G % 8 == 0) ? (bid % 8) * (G / 8) + bid / 8 : bid;
    unsigned* ctl = (unsigned*)(p.ws + WS_CTL);
    if (tid0 < 4) ((LAS unsigned*)(lds + MISC_OFF))[tid0] = 0u;
    __syncthreads();
    XcdBarrier bar; bar.bar = ctl + CW_BAR; bar.x = 0; bar.st = (volatile LAS unsigned*)(lds + MISC_OFF);
    if (N_LAUNCH_MODE == 1) bar = xcd_barrier_post(ctl + CW_BAR, (volatile LAS unsigned*)(lds + MISC_OFF));
    const int lo = p.ph_lo, hi = p.ph_hi;
#ifndef PH_ONLY
#define PH_ONLY -1
#endif
#define IN(k) ((PH_ONLY < 0 || (PH_ONLY % 10) == ((k) % 10)) && lo <= (k) && (k) < hi)
#define SEAM(k) do { if ((k) + 1 < hi) xcd_barrier(bar, fresh_tid(wv)); } while (0)

    for (int L = 0; L < 2; ++L) {
        const int pb = L * 10;
        typedef __attribute__((address_space(1))) unsigned char gu8;
        typedef __attribute__((address_space(1))) const float gcf;
        typedef __attribute__((address_space(4))) const unsigned long long kcu64;
#define INP(i) ((const float*)(gcf*)ka[i])
#define PHASE_PTRS \
        kcu64* ka = (kcu64*)__builtin_amdgcn_kernarg_segment_ptr(); asm volatile("" : "+s"(ka)); \
        unsigned char* ws = (unsigned char*)(gu8*)ka[29]; unsigned char* outb = (unsigned char*)(gu8*)ka[28]; \
        unsigned* ctl = (unsigned*)(ws + WS_CTL); \
        bf16_t* RA = (bf16_t*)(ws + WS_RA); bf16_t* RB = (bf16_t*)(ws + WS_RB); bf16_t* RC = (bf16_t*)(ws + WS_RC); \
        int* list = (int*)(ws + WS_LIST); int* tok_e = (int*)(ws + WS_TOKE); int* tok_p = (int*)(ws + WS_TOKP); float* tok_g = (float*)(ws + WS_TOKG); \
        bf16_t* krope = (bf16_t*)(ws + WS_KROPE); \
        bf16_t* Qd = (bf16_t*)(outb + OUT_QD); bf16_t* O1 = (bf16_t*)(outb + OUT_O1); \
        const bf16_t* Win = (const bf16_t*)(ws + (L ? WS_WIN1 : WS_WIN0)); const bf16_t* Wout = (const bf16_t*)(ws + (L ? WS_WOUT1 : WS_WOUT0)); \
        const bf16_t* Wgu = (const bf16_t*)(ws + (L ? WS_WGU1 : WS_WGU0)); const bf16_t* Wd = (const bf16_t*)(ws + (L ? WS_WD1 : WS_WD0)); \
        const int NIN = L ? IN1P : IN0; \
        const bf16_t* xin = L ? RC : RA; \
        bf16_t* Hx = RB; bf16_t* Oat = L ? O1 : RC; float* Z = (float*)RB; \
        bf16_t* x1b = RA; bf16_t* Hm = RC; bf16_t* Yr = RB; \
        unsigned* cnt = ctl + CW_CNT + L * 64; \
        (void)ctl; (void)RA; (void)RB; (void)RC; (void)list; (void)tok_e; (void)tok_p; (void)tok_g; (void)krope; (void)Qd; (void)O1; (void)Win; (void)Wout; (void)Wgu; (void)Wd; (void)NIN; (void)xin; (void)Hx; (void)Oat; (void)Z; (void)x1b; (void)Hm; (void)Yr; (void)cnt; (void)outb

        if (L == 0 && IN(0)) { PHASE_PTRS; _Pragma("unroll 1") for (int rep = 0; rep < NREP(0); ++rep) phase_prologue(ka, ws, lds, G, bid, fresh_tid(wv)); SEAM(0); }

        if (IN(pb + 1)) {
            PHASE_PTRS;
            constexpr int KI = F8_IN ? 1024 : 2048;
            const bf16_t* ain = F8_IN ? (L ? (const bf16_t*)outb : (const bf16_t*)((unsigned char*)RC + 64 * MiB)) : xin;
            pg8::Gemm g{ain, Win, KI, KI, KI}; pg8::StaticOrder S; S.init(T_, NIN, G, bid, KI);
            pg8::EpiIn E{Hx, NIN, L ? ws + WS_WGU0 + 64 * MiB : (unsigned char*)RA, L ? ws + WS_WD0 + 32 * MiB : ws + WS_WGU1 + 64 * MiB, F8_SPARSE ? (L ? 4 : 10) : 99, F8_SPARSE ? (L ? 8 : 14) : 99, F8_SPARSE ? (L ? 12 : 18) : 99};
            _Pragma("unroll 1") for (int rep = 0; rep < NREP(1); ++rep) pg8::gemm_phase<F8_IN != 0>(wv, lds, g, S, E, F8_IN ? 1.0f / W8_SCALE : 1.0f);
#if REP_NULL == 1
            { pg8::EpiNull EN{(float*)(ctl + CW_DBG + 32)}; pg8::gemm_phase<F8_IN != 0>(wv, lds, g, S, EN, 1.0f / W8_SCALE); }
#endif
            SEAM(pb + 1);
        }
        if (IN(pb + 2)) {
            PHASE_PTRS;
            if (L == 0) { phase_prep_qk(Hx, INP(I_AQN), INP(I_AKN), ws + WS_WGU0 + 64 * MiB, G, bid, fresh_tid(wv));
                _Pragma("unroll 1") for (int rep = 0; rep < NREP(2); ++rep) {
                if (F8_ATTA) phase_vt8(Hx, ws + WS_WGU0 + 72 * MiB, lds, G, bid, fresh_tid(wv));
                if (F8_SPARSE) { unsigned char* ra8 = (unsigned char*)RA;
                    phase_vt_heads<true>(ws + WS_WGU1 + 64 * MiB, ra8 + 32 * MiB, ra8 + 64 * MiB, ra8 + 96 * MiB, lds, G, bid, fresh_tid(wv)); } } }
            else { phase_prep_mla(Hx, krope, ws + WS_WD1 + 32 * MiB, G, bid, fresh_tid(wv));
                if (F8_SPARSE) { unsigned char* c8 = ws + WS_WGU0 + 64 * MiB;
                    _Pragma("unroll 1") for (int rep = 0; rep < NREP(2); ++rep) phase_vt_heads<false>(ws + WS_WD0 + 32 * MiB, c8 + 32 * MiB, nullptr, nullptr, lds, G, bid, fresh_tid(wv)); } }
#if DBG_CHECK
            xcd_barrier(bar, fresh_tid(wv));
            dbg_prep_check(L, INP(I_X), RC, INP(L ? I_WIN1 : I_WIN0), INP(I_AQN), INP(I_AKN), Hx, krope, (float*)(ctl + CW_DBG), lds, bid, fresh_tid(wv));
            __syncthreads();
#endif
            SEAM(pb + 2);
        }
        if (L == 1 && IN(pb + 3)) _Pragma("unroll 1") for (int rep = 0; rep < NREP(3); ++rep) {
            PHASE_PTRS;
#ifndef P3_ONLY
#define P3_ONLY -1
#endif
            if (P3_ONLY < 0 || P3_ONLY == 0) { constexpr int KQ = F8_P3 ? 256 : 512; pg8::Gemm g{Hx + 3072, (const bf16_t*)(ws + WS_WQUP), KQ, IN1P, KQ}; pg8::StaticOrder S; S.init(T_, 1536, G, bid, IN1P);
              pg8::EpiBf16 E{Qd, 1536, 0xffff}; pg8::gemm_phase<F8_P3 != 0>(wv, lds, g, S, E, F8_P3 ? 1.0f / W8_SCALE : 1.0f); }
            if (P3_ONLY < 0 || P3_ONLY == 1) { constexpr int KV = F8_P3 ? 128 : 256; pg8::Gemm g{Hx + 3584, (const bf16_t*)(ws + WS_WKVUP), KV, IN1P, KV}; pg8::StaticOrder S; S.init(T_, 2048, G, bid, IN1P);
              if constexpr (F8_ATTD) { pg8::EpiKV8 E{ws + WS_WGU1 + 64 * MiB, ws + WS_WGU1 + 96 * MiB, RA, DBG_CHECK != 0}; pg8::gemm_phase<F8_P3 != 0>(wv, lds, g, S, E, F8_P3 ? 1.0f / W8_SCALE : 1.0f); }
              else { pg8::EpiBf16 E{RA, 2048, 0xffff}; pg8::gemm_phase<false>(wv, lds, g, S, E); } }
            if (rep + 1 == NREP(3)) SEAM(pb + 3);
        }
        if (IN(pb + 4)) {
            PHASE_PTRS;
            if (L == 0) {
                if (ATT_ONLY < 0 || ATT_ONLY == 0)
                _Pragma("unroll 1") for (int rep = 0; rep < NREPA(0); ++rep)
                for (int u = vcu; u < 1024; u += G) {
                    __syncthreads();
                    const int b = u >> 7, qb = u & 15, kvh = (u >> 6) & 1, gq = (u >> 4) & 3, h = kvh * 4 + gq;
                    if constexpr (F8_ATTA) {
                        d8::D8Args a; a.Q = Hx + (size_t)(b * SEQ + 256 * qb) * IN0 + h * 128; a.ldq = IN0;
                        a.K8 = ws + WS_WGU0 + 64 * MiB + (size_t)b * SEQ * 256 + kvh * 128; a.ldk = 256; a.Kr8 = nullptr;
                        a.Vt8 = ws + WS_WGU0 + 72 * MiB + (size_t)(b * 2 + kvh) * 128 * SEQ; a.ldvt = SEQ;
                        { const size_t eo = (size_t)(b * SEQ + 256 * qb) * DM + h * 128; a.O = F8_OUT ? (bf16_t*)((unsigned char*)Oat + eo) : Oat + eo; } a.ldo = DM; a.seq = SEQ; a.pos0 = 0;
                        if (D8_DMA_A) d8::attn_dense8_dma<2, true>(wv, a, lds); else d8::attn_dense8_body<2>(wv, a, (char*)lds_raw);
                    } else {
                    da::DArgs a; a.Q = Hx + (size_t)(b * SEQ + 256 * qb) * IN0 + h * 128; a.ldq = IN0;
                    a.K = Hx + (size_t)b * SEQ * IN0 + 1024 + kvh * 128; a.ldk = IN0; a.V = Hx + (size_t)b * SEQ * IN0 + 1280 + kvh * 128; a.ldv = IN0; a.Kr = nullptr;
                    { const size_t eo = (size_t)(b * SEQ + 256 * qb) * DM + h * 128; a.O = F8_OUT ? (bf16_t*)((unsigned char*)Oat + eo) : Oat + eo; } a.ldo = DM; a.seq = SEQ; a.pos0 = 0;
                    da::attn_dense_body<8, 1>(wv, a, (char*)lds_raw);
                    }
                }
                __syncthreads();
                if (ATT_ONLY < 0 || ATT_ONLY == 2)
                _Pragma("unroll 1") for (int rep = 0; rep < NREPA(2); ++rep)
                for (int it = vcu; it < 1024; it += G) {
                    const int tid2 = fresh_tid(wv), wid = __builtin_amdgcn_readfirstlane(tid2 >> 6), lane = tid2 & 63;
                    const int w = it * 8 + wid; LAS unsigned char* wl = lds + wid * da::SP_WAVE_LDS;
                    if constexpr (F8_SPARSE) { const unsigned char* ra8 = (const unsigned char*)RA; PolB8 pol; pol.init(Hx, Oat, ra8, ra8 + 32 * MiB, ra8 + 64 * MiB, ra8 + 96 * MiB, w, lane); d8::sparse8_wave(pol, wl, lane); }
                    else { PolB pol; pol.init(Hx, Oat, w, lane); da::sparse_wave(pol, wl, lane); }
                }
            } else {
                if (ATT_ONLY < 0 || ATT_ONLY == 1)
                _Pragma("unroll 1") for (int rep = 0; rep < NREPA(1); ++rep)
                for (int u = vcu; u < 1024; u += G) {
                    __syncthreads();
                    const int b = u >> 7, qb = u & 15, h = (u >> 4) & 7;
                    if constexpr (F8_ATTD) {
                        d8::D8Args a; a.Q = Qd + (size_t)(b * SEQ + 256 * qb) * 1536 + h * 192; a.ldq = 1536;
                        a.K8 = ws + WS_WGU1 + 64 * MiB + (size_t)b * SEQ * 1024 + h * 128; a.ldk = 1024; a.Kr8 = ws + WS_WD1 + 32 * MiB + (size_t)b * SEQ * 64;
                        a.Vt8 = ws + WS_WGU1 + 96 * MiB + (size_t)(b * 8 + h) * 128 * SEQ; a.ldvt = SEQ;
                        { const size_t eo = (size_t)(b * SEQ + 256 * qb) * DM + 1024 + h * 128; a.O = F8_OUT ? (bf16_t*)((unsigned char*)Oat + eo) : Oat + eo; } a.ldo = DM; a.seq = SEQ; a.pos0 = 256 * qb;
                        if (D8_DMA_D) d8::attn_dense8_dma<3, D8_MACC_D != 0>(wv, a, lds); else d8::attn_dense8_body<3>(wv, a, (char*)lds_raw);
                    } else {
                    da::DArgs a; a.Q = Qd + (size_t)(b * SEQ + 256 * qb) * 1536 + h * 192; a.ldq = 1536;
                    a.K = RA + (size_t)b * SEQ * DM + h * 256; a.ldk = DM; a.V = a.K + 128; a.ldv = DM; a.Kr = krope + (size_t)b * SEQ * 64;
                    { const size_t eo = (size_t)(b * SEQ + 256 * qb) * DM + 1024 + h * 128; a.O = F8_OUT ? (bf16_t*)((unsigned char*)Oat + eo) : Oat + eo; } a.ldo = DM; a.seq = SEQ; a.pos0 = 256 * qb;
                    da::attn_dense_body<12, 1>(wv, a, (char*)lds_raw);
                    }
                }
                __syncthreads();
                if (ATT_ONLY < 0 || ATT_ONLY == 3)
                _Pragma("unroll 1") for (int rep = 0; rep < NREPA(3); ++rep)
                for (int it = vcu; it < 1024; it += G) {
                    const int tid2 = fresh_tid(wv), wid = __builtin_amdgcn_readfirstlane(tid2 >> 6), lane = tid2 & 63;
                    const int w = it * 8 + wid; LAS unsigned char* wl = lds + wid * da::SP_WAVE_LDS;
                    if constexpr (F8_SPARSE) { const unsigned char* c8 = ws + WS_WGU0 + 64 * MiB; PolC8 pol; pol.init(Hx, Oat, c8, c8 + 32 * MiB, INP(I_RPB), (float*)((char*)wl + 16640), w, lane); d8::sparse8_wave(pol, wl, lane); }
                    else { PolC pol; pol.init(Hx, Oat, INP(I_RPB), (float*)((char*)wl + 16640), w, lane); da::sparse_wave(pol, wl, lane); }
                }
            }
#if DBG_CHECK
            xcd_barrier(bar, fresh_tid(wv));
            dbg_attn_check(L, Hx, Qd, RA, krope, Oat, (float*)(ctl + CW_DBG), lds, bid, fresh_tid(wv));
            __syncthreads();
            if (L == 0) dbg_sparse_check(0, Hx, (const unsigned char*)RA, ws + WS_WGU1 + 64 * MiB, INP(I_RPB), Oat, (float*)(ctl + CW_DBG), lds, bid, fresh_tid(wv));
            else dbg_sparse_check(1, Hx, ws + WS_WGU0 + 64 * MiB, ws + WS_WD0 + 32 * MiB, INP(I_RPB), Oat, (float*)(ctl + CW_DBG), lds, bid, fresh_tid(wv));
            __syncthreads();
#endif
            SEAM(pb + 4);
        }
        if (IN(pb + 5)) {
            PHASE_PTRS;
            constexpr int KO = F8_OUT ? 1024 : 2048;
            pg8::Gemm g{Oat, Wout, KO, KO, KO}; pg8::StaticOrder S; S.init(T_, DM, G, bid, KO);
            pg8::EpiBf16T<F8_MIX != 0> E{RB, DM, 0xffff};
            _Pragma("unroll 1") for (int rep = 0; rep < NREP(5); ++rep) pg8::gemm_phase<F8_OUT != 0>(wv, lds, g, S, E, F8_OUT ? 1.0f / (W8_SCALE * O8_SCALE) : 1.0f);
            SEAM(pb + 5);
        }
        if (IN(pb + 6)) {
            PHASE_PTRS;
            if (L == 0) { _Pragma("unroll 1") for (int rep = 0; rep < NREP(6); ++rep) phase_ln_router<true>(RB, INP(I_X), INP(I_LN1G0), INP(I_LN1B0), INP(I_RW), INP(I_RB), x1b, (unsigned char*)RC + 64 * MiB, tok_e, tok_p, tok_g, list, cnt, lds, G, bid, fresh_tid(wv), rep + 1 == NREP(6)); }
            else { _Pragma("unroll 1") for (int rep = 0; rep < NREP(6); ++rep) phase_ln_router<false>(RB, RC, INP(I_LN1G1), INP(I_LN1B1), INP(I_RW), INP(I_RB), x1b, outb  , tok_e, tok_p, tok_g, list, cnt, lds, G, bid, fresh_tid(wv), rep + 1 == NREP(6)); }
            SEAM(pb + 6);
        }
        if (IN(pb + 7)) {
            PHASE_PTRS;
            LAS int* pblk = (LAS int*)(lds + MOE_LDS); LAS int* tab = pblk + 64; LAS int* aux = tab + 32; LAS int* idx = aux + 64;
            const int tid = fresh_tid(wv);
            const int NB = moe_prefix(cnt, pblk, tid);
            const int n = moe_table<4>(cnt, pblk, tab, aux, NB, G, vcu, tid);
            for (int i = 0; i < n; ++i) if (tid < 256) { const int e = aux[i * 3], rs = aux[i * 3 + 1], ce = aux[i * 3 + 2]; idx[i * 256 + tid] = list[(size_t)e * 65536 + min(rs + tid, ce - 1)]; }
            __syncthreads();
            constexpr int KG = F8_GU ? 1024 : 2048;
            const bf16_t* agu = F8_GU ? (L ? (const bf16_t*)outb : (const bf16_t*)((unsigned char*)RC + 64 * MiB)) : x1b;
            pg8::Gemm g{agu, Wgu, KG, KG, KG}; pg8::TableOrder<true> S{tab, idx, n, KG}; pg8::EpiSiluMul<F8_DOWN != 0> E{Hm};
            _Pragma("unroll 1") for (int rep = 0; rep < NREP(7); ++rep) pg8::gemm_phase<F8_GU != 0>(wv, lds, g, S, E, F8_GU ? 1.0f / W8_SCALE : 1.0f);
            SEAM(pb + 7);
        }
        if (IN(pb + 8)) {
            PHASE_PTRS;
            LAS int* pblk = (LAS int*)(lds + MOE_LDS); LAS int* tab = pblk + 64; LAS int* aux = tab + 32;
            const int tid = fresh_tid(wv);
            const int NB = moe_prefix(cnt, pblk, tid);
            const int n = moe_table<8>(cnt, pblk, tab, aux, NB, G, vcu, tid);
            constexpr int KD = F8_DOWN ? 256 : 512;
            pg8::Gemm g{Hm, Wd, KD, KD, KD}; pg8::TableOrder<false> S{tab, nullptr, n, KD}; pg8::EpiBf16T<F8_YR != 0> E{Yr, DM, 7};
            _Pragma("unroll 1") for (int rep = 0; rep < NREP(8); ++rep) pg8::gemm_phase<F8_DOWN != 0>(wv, lds, g, S, E, F8_DOWN ? 1.0f / W8_SCALE : 1.0f);
            SEAM(pb + 8);
        }
        if (IN(pb + 9)) _Pragma("unroll 1") for (int rep = 0; rep < NREP(9); ++rep) {
            PHASE_PTRS;
            if (L == 0) phase_combine_ln<false>((const float*)(ctl + CW_DBG), x1b, Yr, tok_e, tok_p, tok_g, cnt, INP(I_LN2G0), INP(I_LN2B0), RC, outb, nullptr, lds, G, bid, fresh_tid(wv));
            else phase_combine_ln<true>((const float*)(ctl + CW_DBG), x1b, Yr, tok_e, tok_p, tok_g, cnt, INP(I_LN2G1), INP(I_LN2B1), nullptr, nullptr, (float*)outb, lds, G, bid, fresh_tid(wv));
            if (rep + 1 == NREP(9)) SEAM(pb + 9);
        }
    }
#undef IN
#undef SEAM
#undef INP
#undef PHASE_PTRS
}

extern "C" void kernel_launch(void* const* d_in, const int* in_sizes, int n_in, void* d_out, int out_size, void* d_ws, size_t ws_size, hipStream_t stream) {
    static int grid = 0;
    if (grid == 0) {
        if (n_in != 28 || out_size != T_ * DM || ws_size < WS_END) { fprintf(stderr, "kernel_launch: unexpected shapes: n_in %d out %d ws %zu (need %zu)\n", n_in, out_size, ws_size, (size_t)WS_END); grid = -1; return; }
        int dev = 0, cus = 0, per_cu = 0;
        if (hipGetDevice(&dev) != hipSuccess || hipDeviceGetAttribute(&cus, hipDeviceAttributeMultiprocessorCount, dev) != hipSuccess) { grid = -1; return; }
        if (hipFuncSetAttribute((const void*)fwd, hipFuncAttributeMaxDynamicSharedMemorySize, LDS_BYTES) != hipSuccess) { fprintf(stderr, "kernel_launch: hipFuncSetAttribute failed\n"); grid = -1; return; }
        if (hipOccupancyMaxActiveBlocksPerMultiprocessor(&per_cu, (const void*)fwd, NTHR, LDS_BYTES) != hipSuccess || per_cu < 1)
            fprintf(stderr, "kernel_launch: occupancy query reports %d workgroups per CU\n", per_cu);
        (void)hipGetLastError();
        grid = cus;
    }
    if (grid < 0) return;
    (void)hipMemsetAsync((char*)d_ws + WS_CTL, 0, CTL_ZERO_BYTES, stream);
    Params p{};
    for (int i = 0; i < 28; ++i) p.in[i] = (const float*)d_in[i];
    p.out = (float*)d_out; p.ws = (unsigned char*)d_ws;
#if N_LAUNCH_MODE == 1
    p.ph_lo = 0; p.ph_hi = N_PHASES;
    hipLaunchKernelGGL(fwd, dim3(grid), dim3(NTHR), LDS_BYTES, stream, p);
#else
    for (int k = 0; k < N_PHASES; ++k) { if (k == 3 || k == 10) continue; p.ph_lo = k; p.ph_hi = k + 1;
        hipLaunchKernelGGL(fwd, dim3(grid), dim3(NTHR), LDS_BYTES, stream, p); }
#endif
    const hipError_t le = hipPeekAtLastError();
    if (le != hipSuccess) fprintf(stderr, "kernel_launch: launch failed: %s\n", hipGetErrorName(le));
}
```

```cpp
#include <hip/hip_runtime.h>
#include <cstdio>
#include <cstdint>
#include <type_traits>

#ifndef N_LAUNCH_MODE
#define N_LAUNCH_MODE 1
#endif
#ifndef DBG_CHECK
#define DBG_CHECK 0
#define F8_P3 1
#define F8_MIX 1
#define D8_DMA_A 1
#define D8_DMA_D 1
#define D8_MACC_D 1
#endif
#ifndef DBG_TOL_SP
#define DBG_TOL_SP 0.08f
#endif
#ifndef DBG_TOL
#define DBG_TOL 0.3f
#endif
#ifndef F8_DOWN
#define F8_DOWN 1
#endif
#ifndef F8_GU
#define F8_GU 1
#endif
#ifndef F8_IN
#define F8_IN 1
#endif
#ifndef F8_OUT
#define F8_OUT 1
#endif
#ifndef F8_ATTA
#define F8_ATTA 1
#endif
#ifndef F8_ATTD
#define F8_ATTD 1
#endif
#ifndef F8_SPARSE
#define F8_SPARSE 1
#endif
#ifndef GEMM_SKEW
#define GEMM_SKEW 0
#endif
#ifndef F8_YR
#define F8_YR 1
#endif

#define LAS __attribute__((address_space(3)))
typedef unsigned short bf16_t;
typedef short bf16x8 __attribute__((ext_vector_type(8)));
typedef short s16x4 __attribute__((ext_vector_type(4)));
typedef float f32x2 __attribute__((ext_vector_type(2)));
typedef float f32x4 __attribute__((ext_vector_type(4)));
typedef float f32x8 __attribute__((ext_vector_type(8)));
typedef float f32x16 __attribute__((ext_vector_type(16)));
typedef unsigned u32x2 __attribute__((ext_vector_type(2)));
typedef unsigned u32x4 __attribute__((ext_vector_type(4)));
typedef int i32x8 __attribute__((ext_vector_type(8)));
typedef _Float16 f16x8 __attribute__((ext_vector_type(8)));
typedef _Float16 f16x2 __attribute__((ext_vector_type(2)));
typedef int i32x4 __attribute__((ext_vector_type(4)));

constexpr int T_ = 32768, DM = 2048, SEQ = 4096, NBATCH = 8;
constexpr int IN0 = 4608, IN1 = 3904, IN1P = 4096;
constexpr int NE = 32, DE = 512, MAXBLK = 288;
constexpr float ALPHA = 1.4142135623730951f;
constexpr float LOG2E = 1.4426950408889634f;
constexpr int NTHR = 512;

constexpr size_t MiB = 1u << 20;
constexpr size_t WS_CTL = 0, CTL_ZERO_BYTES = 1 * MiB;
constexpr size_t WS_LIST = 1 * MiB;
constexpr size_t WS_TOKE = 9 * MiB;
constexpr size_t WS_TOKP = WS_TOKE + 256 * 1024;
constexpr size_t WS_TOKG = WS_TOKP + 256 * 1024;
constexpr size_t WS_RSTAT = WS_TOKG + 256 * 1024;
constexpr size_t WS_KROPE = 10 * MiB;
constexpr size_t WS_WIN0 = 16 * MiB, WS_WOUT0 = 34 * MiB, WS_WGU0 = 42 * MiB, WS_WD0 = 170 * MiB;
constexpr size_t WS_WIN1 = 234 * MiB, WS_WOUT1 = 250 * MiB, WS_WGU1 = 258 * MiB, WS_WD1 = 386 * MiB;
constexpr size_t WS_WQUP = 450 * MiB, WS_WKVUP = 452 * MiB;
constexpr size_t WS_RA = 454 * MiB, WS_RB = 582 * MiB, WS_RC = 870 * MiB, WS_END = 998 * MiB;
constexpr size_t OUT_QD = 0, OUT_O1 = 96 * MiB;
constexpr int CW_CNT = 64;
constexpr int CW_DBG = 512;
constexpr int CW_BAR = 4096;

constexpr int LDS_BYTES = 155648;
constexpr int MISC_OFF = LDS_BYTES - 64;

__device__ __forceinline__ unsigned cvtpk(float lo, float hi) { unsigned r; asm volatile("v_cvt_pk_bf16_f32 %0, %1, %2" : "=v"(r) : "v"(lo), "v"(hi)); return r; }
__device__ __forceinline__ float bf2f(unsigned short b) { return __uint_as_float(((unsigned)b) << 16); }
__device__ __forceinline__ float bflo(unsigned w) { return __uint_as_float(w << 16); }
__device__ __forceinline__ float bfhi(unsigned w) { return __uint_as_float(w & 0xffff0000u); }
__device__ __forceinline__ bf16_t f2bf(float f) { return (bf16_t)(cvtpk(f, f) & 0xffffu); }
__device__ __forceinline__ unsigned pk4_fp8(float a, float b, float c, float d) { int w = (int)__float_as_uint(a);
    w = __builtin_amdgcn_cvt_pk_fp8_f32(a, b, w, false); w = __builtin_amdgcn_cvt_pk_fp8_f32(c, d, w, true); return (unsigned)w; }
constexpr float O8_SCALE = 16.f;
__device__ __forceinline__ unsigned char f2fp8(float v) { return (unsigned char)(__builtin_amdgcn_cvt_pk_fp8_f32(v, v, (int)__float_as_uint(v), false) & 0xff); }
__device__ __forceinline__ float clamp8(float v) { return fminf(fmaxf(v, -400.f), 400.f); }
__device__ __forceinline__ int fresh_tid(int wv) { int l; asm volatile("v_mbcnt_lo_u32_b32 %0, -1, 0\n\tv_mbcnt_hi_u32_b32 %0, -1, %0" : "=v"(l)); return wv * 64 + l; }
__device__ __forceinline__ float fresh_zero() { float z; asm volatile("v_mov_b32 %0, 0" : "=v"(z)); return z; }
__device__ __forceinline__ float wave_sum(float v) {
    v += __int_as_float(__builtin_amdgcn_ds_swizzle(__float_as_int(v), (1 << 10) | 0x1f));
    v += __int_as_float(__builtin_amdgcn_ds_swizzle(__float_as_int(v), (2 << 10) | 0x1f));
    v += __int_as_float(__builtin_amdgcn_ds_swizzle(__float_as_int(v), (4 << 10) | 0x1f));
    v += __int_as_float(__builtin_amdgcn_ds_swizzle(__float_as_int(v), (8 << 10) | 0x1f));
    v += __int_as_float(__builtin_amdgcn_ds_swizzle(__float_as_int(v), (16 << 10) | 0x1f));
    auto rr = __builtin_amdgcn_permlane32_swap(__float_as_uint(v), __float_as_uint(v), false, false);
    return __uint_as_float(rr[0]) + __uint_as_float(rr[1]);
}
__device__ __forceinline__ float wave_max(float v) {
    v = fmaxf(v, __int_as_float(__builtin_amdgcn_ds_swizzle(__float_as_int(v), (1 << 10) | 0x1f)));
    v = fmaxf(v, __int_as_float(__builtin_amdgcn_ds_swizzle(__float_as_int(v), (2 << 10) | 0x1f)));
    v = fmaxf(v, __int_as_float(__builtin_amdgcn_ds_swizzle(__float_as_int(v), (4 << 10) | 0x1f)));
    v = fmaxf(v, __int_as_float(__builtin_amdgcn_ds_swizzle(__float_as_int(v), (8 << 10) | 0x1f)));
    v = fmaxf(v, __int_as_float(__builtin_amdgcn_ds_swizzle(__float_as_int(v), (16 << 10) | 0x1f)));
    auto rr = __builtin_amdgcn_permlane32_swap(__float_as_uint(v), __float_as_uint(v), false, false);
    return fmaxf(__uint_as_float(rr[0]), __uint_as_float(rr[1]));
}
__device__ __forceinline__ float inv_freq32(int i) { return __builtin_amdgcn_exp2f(-(float)i * 0.41524101186092029f); }
__device__ __forceinline__ void sincos_rev(float angle, float& s, float& c) {
    float rev = angle * 0.15915494309189535f; rev = rev - floorf(rev);
    s = __builtin_amdgcn_sinf(rev); c = __builtin_amdgcn_cosf(rev);
}

#define XB_TMO      128
#define XB_XCNT(j)  (256  + 64 * (j))
#define XB_XSUB(j)  (1280 + 64 * (j))
#define XB_XGEN(j)  (2304 + 64 * (j))
#define XB_TOP      3328
#define XB_TOPGEN   3392
#define XCD_BAR_WORDS 3456
#define XB_SPIN_CAP (1u << 20)
__device__ __forceinline__ unsigned xb_ld(unsigned* p)              { return __hip_atomic_load(p, __ATOMIC_RELAXED, __HIP_MEMORY_SCOPE_AGENT); }
__device__ __forceinline__ unsigned xb_add(unsigned* p, unsigned v) { return __hip_atomic_fetch_add(p, v, __ATOMIC_RELAXED, __HIP_MEMORY_SCOPE_AGENT); }
__device__ __forceinline__ unsigned xb_xcc_id() { return (unsigned)__builtin_amdgcn_s_getreg((3 << 11) | 20) & 0xFu; }
#define XB_SPIN(cond, bar) do { unsigned _sp = 0; while (cond) { __builtin_amdgcn_s_sleep(1); \
    if ((++_sp & 255u) == 0u) { if (xb_ld(&(bar)[XB_TMO])) break; if (_sp > XB_SPIN_CAP) { atomicAdd(&(bar)[XB_TMO], 1u); break; } } } } while (0)
struct XcdBarrier { unsigned* bar; unsigned x; volatile LAS unsigned* st; };
__device__ __forceinline__ XcdBarrier xcd_barrier_post(unsigned* bar, volatile LAS unsigned* st) {
    XcdBarrier b; b.bar = bar; b.x = xb_xcc_id(); b.st = st;
    if (threadIdx.x == 0) (void)xb_add(&bar[XB_XCNT(b.x)], 1u);
    return b;
}
__device__ __forceinline__ void xcd_barrier_complete(unsigned* bar, unsigned x, unsigned& nloc, unsigned& nx) {
    const unsigned G = gridDim.x * gridDim.y * gridDim.z;
    unsigned sum, cnt, mine, sp = 0u;
    for (;;) {
        sum = 0u; cnt = 0u; mine = 0u;
#pragma unroll
        for (unsigned j = 0; j < 16; ++j) { const unsigned c = xb_ld(&bar[XB_XCNT(j)]); sum += c; cnt += (c > 0u) ? 1u : 0u; mine = (j == x) ? c : mine; }
        if (sum == G) break;
        __builtin_amdgcn_s_sleep(1);
        if ((++sp & 255u) == 0u) { if (xb_ld(&bar[XB_TMO])) break; if (sp > XB_SPIN_CAP) { atomicAdd(&bar[XB_TMO], 1u); break; } }
    }
    nloc = mine > 0u ? mine : 1u; nx = cnt > 0u ? cnt : 1u;
}
__device__ __forceinline__ void xcd_barrier(const XcdBarrier& b, int tid_now) {
    asm volatile("s_waitcnt vmcnt(0)" ::: "memory");
    __syncthreads();
    if (tid_now == 0) {
        unsigned* bar = b.bar;
        __builtin_amdgcn_s_waitcnt(0);
        unsigned nloc = b.st[0], nx = b.st[1];
        if (nloc == 0u) { xcd_barrier_complete(bar, b.x, nloc, nx); b.st[0] = nloc; b.st[1] = nx; }
        const unsigned old = xb_add(&bar[XB_XSUB(b.x)], 1u);
        const unsigned gen = old / nloc;
        if (old + 1u == (gen + 1u) * nloc) {
            __builtin_amdgcn_fence(__ATOMIC_RELEASE, "agent");
            asm volatile("s_waitcnt vmcnt(0)" ::: "memory");
            const unsigned og = xb_add(&bar[XB_TOP], 1u);
            const unsigned tg = og / nx;
            if (og + 1u == (tg + 1u) * nx) xb_add(&bar[XB_TOPGEN], 1u);
            else XB_SPIN(xb_ld(&bar[XB_TOPGEN]) == tg, bar);
            __builtin_amdgcn_fence(__ATOMIC_ACQUIRE, "agent");
            xb_add(&bar[XB_XGEN(b.x)], 1u);
            asm volatile("s_waitcnt vmcnt(0)" ::: "memory");
        } else {
            XB_SPIN(xb_ld(&bar[XB_XGEN(b.x)]) == gen, bar);
            __builtin_amdgcn_fence(__ATOMIC_ACQUIRE, "agent");
            asm volatile("s_waitcnt vmcnt(0)" ::: "memory");
        }
    }
    __syncthreads();
}

namespace pg8 {
constexpr int BM = 256, BK = 64, HALF = 128, HTB = HALF * BK * 2, STAGE_BYTES = 8 * HTB, NXCD = 8, WGM = 8;
__device__ __forceinline__ int lds_byte(int r, int c) { const int st = (r >> 4) * 2 + (c >> 5), rr = r & 15, cc = c & 31, ob = rr * 64 + cc * 2; return st * 1024 + (ob ^ (((ob >> 9) & 1) << 5)); }
__device__ __forceinline__ void stage_rc(int b, int& R, int& C) { const int st = b / 1024, sb = b % 1024, swz = sb ^ (((sb >> 9) & 1) << 5); R = (st >> 1) * 16 + swz / 64; C = (st & 1) * 32 + (swz % 64) / 2; }
__device__ __forceinline__ int perm32(int rho) { const int n = rho >> 4, i = rho & 15; return 8 * (i >> 2) + 4 * n + (i & 3); }
struct Unit { int pm, pn, q; };
struct Gemm { const bf16_t* A; const bf16_t* Bt; int K, lda, ldb; };

struct StaticOrder {
    static constexpr bool GATHER = false;
    int nM, nN, nwg, G, c, lda;
    __device__ void init(int M, int N, int G_, int c_, int lda_) { nM = M / BM; nN = N / BM; nwg = nM * nN; G = G_; c = c_; lda = lda_; }
    __device__ __forceinline__ bool next(int i, Unit& u) const {
        const long L = (long)i * G + c; if (L >= nwg) return false;
        int wgid = (int)L; { const int q = nwg / NXCD, r = nwg % NXCD, xcd = wgid % NXCD, off = wgid / NXCD; wgid = (xcd < r ? xcd * (q + 1) : r * (q + 1) + (xcd - r) * q) + off; }
        const int nig = WGM * nN, gid = wgid / nig, fm = gid * WGM, gsz = (nM - fm) < WGM ? (nM - fm) : WGM;
        u.pm = fm + ((wgid % nig) % gsz); u.pn = (wgid % nig) / gsz; u.q = i; return true;
    }
    __device__ __forceinline__ void aoff(const Unit& u, const int (&R)[2], const int (&C)[2], unsigned (&o)[2][2]) const {
#pragma unroll
        for (int h = 0; h < 2; ++h)
#pragma unroll
            for (int i = 0; i < 2; ++i) o[h][i] = (unsigned)((u.pm * BM + h * HALF + R[i]) * lda + C[i]) * 2u;
    }
};
template <bool GATHER_> struct TableOrder {
    static constexpr bool GATHER = GATHER_;
    const LAS int* tab; const LAS int* idx; int n, lda;
    __device__ __forceinline__ bool next(int i, Unit& u) const { if (i >= n) return false; u.pm = tab[i]; u.pn = tab[16 + i]; u.q = i; return true; }
    __device__ __forceinline__ void aoff(const Unit& u, const int (&R)[2], const int (&C)[2], unsigned (&o)[2][2]) const {
#pragma unroll
        for (int h = 0; h < 2; ++h)
#pragma unroll
            for (int i = 0; i < 2; ++i) { const int row = GATHER ? idx[u.q * 256 + h * HALF + R[i]] : (u.pm * BM + h * HALF + R[i]); o[h][i] = (unsigned)(row * lda + C[i]) * 2u; }
    }
};

template <bool O8> struct EpiBf16T {
    static constexpr bool PERM = true;
    bf16_t* O; int ldc; int pnmask;
    __device__ __forceinline__ void operator()(const f32x4 (&acc)[2][2][4][2], const Unit& u, int wr, int wc, int fr, int fq) const {
        const int row0 = u.pm * BM + wr * 64 + fr; const int col0 = (u.pn & pnmask) * BM + wc * 32 + 8 * fq;
#pragma unroll
        for (int ai = 0; ai < 2; ++ai)
#pragma unroll
            for (int m = 0; m < 4; ++m) { const size_t eoff = (size_t)(row0 + ai * HALF + m * 16) * ldc + col0;
#pragma unroll
                for (int bj = 0; bj < 2; ++bj) { const f32x4 v0 = acc[ai][bj][m][0], v1 = acc[ai][bj][m][1];
                    if constexpr (O8) { u32x2 w; w.x = pk4_fp8(v0[0] * 16.f, v0[1] * 16.f, v0[2] * 16.f, v0[3] * 16.f); w.y = pk4_fp8(v1[0] * 16.f, v1[1] * 16.f, v1[2] * 16.f, v1[3] * 16.f);
                        *(u32x2*)((unsigned char*)O + eoff + bj * HALF) = w; }
                    else { u32x4 w; w.x = cvtpk(v0[0], v0[1]); w.y = cvtpk(v0[2], v0[3]); w.z = cvtpk(v1[0], v1[1]); w.w = cvtpk(v1[2], v1[3]);
                        *(u32x4*)(O + eoff + bj * HALF) = w; } } }
    }
};
typedef EpiBf16T<false> EpiBf16;
struct EpiRowScale {
    static constexpr bool PERM = true;
    bf16_t* O; int ldc; const float* rs; int which;
    __device__ __forceinline__ void operator()(const f32x4 (&acc)[2][2][4][2], const Unit& u, int wr, int wc, int fr, int fq) const {
        const int row0 = u.pm * BM + wr * 64 + fr; const int col0 = u.pn * BM + wc * 32 + 8 * fq;
#pragma unroll
        for (int ai = 0; ai < 2; ++ai)
#pragma unroll
            for (int m = 0; m < 4; ++m) { const int row = row0 + ai * HALF + m * 16; const float s = rs[row * 2 + which]; bf16_t* rowp = O + (size_t)row * ldc + col0;
#pragma unroll
                for (int bj = 0; bj < 2; ++bj) { const f32x4 v0 = acc[ai][bj][m][0] * s, v1 = acc[ai][bj][m][1] * s;
                    u32x4 w; w.x = cvtpk(v0[0], v0[1]); w.y = cvtpk(v0[2], v0[3]); w.z = cvtpk(v1[0], v1[1]); w.w = cvtpk(v1[2], v1[3]);
                    *(u32x4*)(rowp + bj * HALF) = w; } }
    }
};
struct EpiIn {
    static constexpr bool PERM = true;
    bf16_t* H; int ldh; unsigned char* K8; unsigned char* V8; int k_lo, v_lo, v_hi;
    __device__ __forceinline__ void operator()(const f32x4 (&acc)[2][2][4][2], const Unit& u, int wr, int wc, int fr, int fq) const {
        const int row0 = u.pm * BM + wr * 64 + fr; const int cw = wc * 32 + 8 * fq;
        const bool is8 = (u.pn >= k_lo && u.pn < v_hi);
        unsigned char* b8 = (u.pn < v_lo) ? K8 + (size_t)(u.pn - k_lo) * BM : V8 + (size_t)(u.pn - v_lo) * BM;
#pragma unroll
        for (int ai = 0; ai < 2; ++ai)
#pragma unroll
            for (int m = 0; m < 4; ++m) { const size_t row = (size_t)(row0 + ai * HALF + m * 16);
#pragma unroll
                for (int bj = 0; bj < 2; ++bj) { const f32x4 v0 = acc[ai][bj][m][0], v1 = acc[ai][bj][m][1];
                    if (is8) *(u32x2*)(b8 + row * 1024 + bj * HALF + cw) = (u32x2){pk4_fp8(v0[0], v0[1], v0[2], v0[3]), pk4_fp8(v1[0], v1[1], v1[2], v1[3])};
                    else { u32x4 w; w.x = cvtpk(v0[0], v0[1]); w.y = cvtpk(v0[2], v0[3]); w.z = cvtpk(v1[0], v1[1]); w.w = cvtpk(v1[2], v1[3]);
                        *(u32x4*)(H + row * ldh + u.pn * BM + bj * HALF + cw) = w; } } }
    }
};
struct EpiNull { static constexpr bool PERM = true; float* sink;
    __device__ __forceinline__ void operator()(const f32x4 (&acc)[2][2][4][2], const Unit& u, int wr, int wc, int fr, int fq) const {
        float s = 0.f;
#pragma unroll
        for (int ai = 0; ai < 2; ++ai)
#pragma unroll
            for (int bj = 0; bj < 2; ++bj)
#pragma unroll
                for (int m = 0; m < 4; ++m)
#pragma unroll
                    for (int n = 0; n < 2; ++n) s += acc[ai][bj][m][n][0] + acc[ai][bj][m][n][1] + acc[ai][bj][m][n][2] + acc[ai][bj][m][n][3];
        if (s == 123.456f) sink[0] = s; } };
struct EpiKV8 {
    static constexpr bool PERM = true;
    unsigned char* K8; unsigned char* Vt8; bf16_t* KV; bool wr_bf16;
    __device__ __forceinline__ void operator()(const f32x4 (&acc)[2][2][4][2], const Unit& u, int wr, int wc, int fr, int fq) const {
        const int row0 = u.pm * BM + wr * 64 + fr; const int c0 = wc * 32 + 8 * fq;
#pragma unroll
        for (int ai = 0; ai < 2; ++ai)
#pragma unroll
            for (int m = 0; m < 4; ++m) { const int row = row0 + ai * HALF + m * 16;
                { const f32x4 v0 = acc[ai][0][m][0], v1 = acc[ai][0][m][1];
                  *(u32x2*)(K8 + (size_t)row * 1024 + u.pn * 128 + c0) = (u32x2){pk4_fp8(v0[0], v0[1], v0[2], v0[3]), pk4_fp8(v1[0], v1[1], v1[2], v1[3])}; }
                { const f32x4 v0 = acc[ai][1][m][0], v1 = acc[ai][1][m][1]; const float vv[8] = {v0[0], v0[1], v0[2], v0[3], v1[0], v1[1], v1[2], v1[3]};
                  unsigned char* vp = Vt8 + ((size_t)((row >> 12) * 8 + u.pn) * 128 + c0) * SEQ + (row & (SEQ - 1));
#pragma unroll
                  for (int e = 0; e < 8; ++e) vp[(size_t)e * SEQ] = f2fp8(vv[e]); }
                if (wr_bf16) {
#pragma unroll
                    for (int bj = 0; bj < 2; ++bj) { const f32x4 v0 = acc[ai][bj][m][0], v1 = acc[ai][bj][m][1];
                        u32x4 w; w.x = cvtpk(v0[0], v0[1]); w.y = cvtpk(v0[2], v0[3]); w.z = cvtpk(v1[0], v1[1]); w.w = cvtpk(v1[2], v1[3]);
                        *(u32x4*)(KV + (size_t)row * DM + u.pn * BM + bj * HALF + c0) = w; } } }
    }
};
template <bool O8> struct EpiSiluMul {
    static constexpr bool PERM = true;
    bf16_t* O;
    __device__ __forceinline__ void operator()(const f32x4 (&acc)[2][2][4][2], const Unit& u, int wr, int wc, int fr, int fq) const {
        const int row0 = u.pm * BM + wr * 64 + fr; const int col0 = (u.pn & 3) * HALF + wc * 32 + 8 * fq;
#pragma unroll
        for (int ai = 0; ai < 2; ++ai)
#pragma unroll
            for (int m = 0; m < 4; ++m) { const size_t eoff = (size_t)(row0 + ai * HALF + m * 16) * DE + col0; float h[8];
#pragma unroll
                for (int n = 0; n < 2; ++n)
#pragma unroll
                    for (int j = 0; j < 4; ++j) { const float g = acc[ai][0][m][n][j], up = acc[ai][1][m][n][j];
                        const float sg = g * __builtin_amdgcn_rcpf(1.0f + __builtin_amdgcn_exp2f(-g * LOG2E)); h[n * 4 + j] = sg * up; }
                if constexpr (O8) { u32x2 w; w.x = pk4_fp8(clamp8(h[0]), clamp8(h[1]), clamp8(h[2]), clamp8(h[3])); w.y = pk4_fp8(clamp8(h[4]), clamp8(h[5]), clamp8(h[6]), clamp8(h[7]));
                    *(u32x2*)((unsigned char*)O + eoff) = w; }
                else { u32x4 w; w.x = cvtpk(h[0], h[1]); w.y = cvtpk(h[2], h[3]); w.z = cvtpk(h[4], h[5]); w.w = cvtpk(h[6], h[7]);
                    *(u32x4*)(O + eoff) = w; } }
    }
};
template <bool RES_F32> struct EpiResF32 {
    static constexpr bool PERM = false;
    float* Z; const void* res;
    __device__ __forceinline__ void operator()(const f32x4 (&acc)[2][2][4][2], const Unit& u, int wr, int wc, int fr, int fq) const {
        const int row0 = u.pm * BM + wr * 64 + fr, col0 = u.pn * BM + wc * 32 + 4 * fq;
        float ALPHA = 1.4142135623730951f; asm volatile("" : "+v"(ALPHA));
#pragma unroll
        for (int ai = 0; ai < 2; ++ai)
#pragma unroll
            for (int m = 0; m < 4; ++m) { const size_t off = (size_t)(row0 + ai * HALF + m * 16) * DM + col0;
#pragma unroll
                for (int bj = 0; bj < 2; ++bj)
#pragma unroll
                    for (int n = 0; n < 2; ++n) { f32x4 o = acc[ai][bj][m][n];
                        if constexpr (RES_F32) { const f32x4 rv = *(const f32x4*)((const float*)res + off + bj * HALF + n * 16); o += ALPHA * rv; }
                        else { const u32x2 rb = *(const u32x2*)((const bf16_t*)res + off + bj * HALF + n * 16);
                            o[0] += ALPHA * bflo(rb.x); o[1] += ALPHA * bfhi(rb.x); o[2] += ALPHA * bflo(rb.y); o[3] += ALPHA * bfhi(rb.y); }
                        *(f32x4*)(Z + off + bj * HALF + n * 16) = o; } }
    }
};

template <bool F8, class Epi, class Sched>
__device__ __forceinline__ void gemm_phase(int wv, LAS unsigned char* lds, const Gemm g, const Sched& S, const Epi& E, float oscale = 1.0f) {
    constexpr bool GA = Sched::GATHER;
    const int tid = fresh_tid(wv), wid = __builtin_amdgcn_readfirstlane(tid >> 6), lane = tid & 63, wr = wid >> 2, wc = wid & 3, fr = lane & 15, fq = lane >> 4;
    int K = g.K; asm volatile("" : "+s"(K));
    const int nt = K / BK;
    int Rr[2], Cc[2]; unsigned voffA[2], voffB[2];
#pragma unroll
    for (int i = 0; i < 2; ++i) { int R, C; stage_rc(tid * 16 + i * 8192, R, C); Rr[i] = R; Cc[i] = C; const int Rb = Epi::PERM ? ((R & ~31) + perm32(R & 31)) : R;
        voffA[i] = (unsigned)(R * g.lda + C) * 2u; voffB[i] = (unsigned)(Rb * g.ldb + C) * 2u; }
    const size_t kstep = (size_t)(BK * 2);
    const size_t hstepA = (size_t)HALF * g.lda * 2, tstepA = 2 * hstepA;
    const size_t hstepB = (size_t)HALF * g.ldb * 2, tstepB = 2 * hstepB;
    const unsigned ldsw = (unsigned)wid * 1024u;
    const int aoff = lds_byte(wr * 64 + fr, fq * 8), boff = lds_byte(wc * 32 + fr, fq * 8);
#define PG8_SA(b, h) (((b) * 2 + (h)) * HTB)
#define PG8_SB(b, h) ((4 + (b) * 2 + (h)) * HTB)
#define PG8_STAGE(bufoff, gbase, voff) do { _Pragma("unroll") for (int _i = 0; _i < 2; ++_i) \
        __builtin_amdgcn_global_load_lds((const unsigned*)((const char*)(gbase) + (voff)[_i]), (LAS unsigned*)(lds + (bufoff) + ldsw + _i * 8192), 16, 0, 0); } while (0)
#define PG8_STAGE_A(bufoff, h, pbase, koff, goffs) do { if constexpr (GA) { PG8_STAGE(bufoff, gA + (koff), (goffs)[h]); } else { PG8_STAGE(bufoff, (pbase) + (h) * hstepA, voffA); } } while (0)
#define PG8_LD32(dst, off) do { const i32x4 _lo = *(const LAS i32x4*)(lds + (off)), _hi = *(const LAS i32x4*)(lds + (off) + 1024); dst = __builtin_shufflevector(_lo, _hi, 0, 1, 2, 3, 4, 5, 6, 7); } while (0)
#define PG8_LDA(dst, b, h) do { _Pragma("unroll") for (int m = 0; m < 4; ++m) PG8_LD32(dst[m], PG8_SA(b, h) + aoff + m * 2048); } while (0)
#define PG8_LDB(dst, b, h) do { _Pragma("unroll") for (int n = 0; n < 2; ++n) PG8_LD32(dst[n], PG8_SB(b, h) + boff + n * 2048); } while (0)
#define PG8_LOH(v) __builtin_bit_cast(bf16x8, __builtin_shufflevector(v, v, 0, 1, 2, 3))
#define PG8_HIH(v) __builtin_bit_cast(bf16x8, __builtin_shufflevector(v, v, 4, 5, 6, 7))
#define PG8_MMA(ai, bj, At, Bt) do { __builtin_amdgcn_s_setprio(1); \
        if constexpr (F8) { _Pragma("unroll") for (int m = 0; m < 4; ++m) _Pragma("unroll") for (int n = 0; n < 2; ++n) \
            asm volatile("v_mfma_f32_16x16x128_f8f6f4 %0, %1, %2, %0" : "+v"(acc[ai][bj][m][n]) : "v"(Bt[n]), "v"(At[m])); } \
        else { _Pragma("unroll") for (int m = 0; m < 4; ++m) _Pragma("unroll") for (int n = 0; n < 2; ++n) { \
            acc[ai][bj][m][n] = __builtin_amdgcn_mfma_f32_16x16x32_bf16(PG8_LOH(Bt[n]), PG8_LOH(At[m]), acc[ai][bj][m][n], 0, 0, 0); \
            acc[ai][bj][m][n] = __builtin_amdgcn_mfma_f32_16x16x32_bf16(PG8_HIH(Bt[n]), PG8_HIH(At[m]), acc[ai][bj][m][n], 0, 0, 0); } } \
        __builtin_amdgcn_s_setprio(0); } while (0)
#define PG8_WAIT_V(n) asm volatile("s_waitcnt vmcnt(" #n ")" ::: "memory")
#define PG8_WAIT_L(n) asm volatile("s_waitcnt lgkmcnt(" #n ")" ::: "memory")
#define PG8_BAR __builtin_amdgcn_s_barrier()
#define PG8_SCHED __builtin_amdgcn_sched_barrier(0)
    Unit cur, nxt; int ui = 0;
    if (!S.next(0, cur)) return;
    if (GEMM_SKEW > 0) { const unsigned long long t0 = __builtin_amdgcn_s_memrealtime(); const unsigned long long dl = (unsigned long long)((blockIdx.x >> 3) & 3) * GEMM_SKEW;
        while (__builtin_amdgcn_s_memrealtime() - t0 < dl) __builtin_amdgcn_s_sleep(8); }
    f32x4 acc[2][2][4][2];
#pragma unroll
    for (int a = 0; a < 2; ++a)
#pragma unroll
        for (int b = 0; b < 2; ++b)
#pragma unroll
            for (int m = 0; m < 4; ++m)
#pragma unroll
                for (int n = 0; n < 2; ++n) { const float zf = fresh_zero(); acc[a][b][m][n] = (f32x4){zf, zf, zf, zf}; }
    unsigned ca[2][2];
    if constexpr (GA) S.aoff(cur, Rr, Cc, ca);
    const char* gA = (const char*)g.A;
    const char* cA = gA + (GA ? (size_t)0 : (size_t)cur.pm * tstepA);
    const char* cB = (const char*)g.Bt + (size_t)cur.pn * tstepB;
    PG8_STAGE(PG8_SB(0, 0), cB, voffB); PG8_STAGE_A(PG8_SA(0, 0), 0, cA, 0, ca); PG8_STAGE(PG8_SB(0, 1), cB + hstepB, voffB); PG8_STAGE_A(PG8_SA(0, 1), 1, cA, 0, ca);
    if (wr == 1) PG8_BAR;
    PG8_WAIT_V(4); PG8_BAR;
    PG8_STAGE(PG8_SB(1, 0), cB + kstep, voffB); PG8_STAGE_A(PG8_SA(1, 0), 0, cA + kstep, kstep, ca); PG8_STAGE(PG8_SB(1, 1), cB + hstepB + kstep, voffB);
    PG8_WAIT_V(6); PG8_BAR;
    for (;;) {
        const bool has_next = S.next(ui + 1, nxt);
        const char* nA = (!GA && has_next) ? gA + (size_t)nxt.pm * tstepA : cA;
        const char* nB = has_next ? (const char*)g.Bt + (size_t)nxt.pn * tstepB : cB;
#pragma unroll 1
        for (int t = 0; t < nt; t += 2) {
            const bool last = (t == nt - 2);
            const size_t k1 = (size_t)(t + 1) * kstep, k2 = last ? (size_t)0 : (size_t)(t + 2) * kstep, k3 = k2 + kstep;
            const char* a1 = cA + k1;
            const char* a2 = last ? nA : cA + k2; const char* b2 = last ? nB : cB + (size_t)(t + 2) * kstep;
            const char* a3 = a2 + kstep; const char* b3 = b2 + kstep;
            i32x8 At[4], B0[2], B1[2];
            unsigned xa[2][2];
            if constexpr (GA) {
                if (last && has_next) { int R2[2], C2[2]; const int t2 = fresh_tid(wv); stage_rc(t2 * 16, R2[0], C2[0]); stage_rc(t2 * 16 + 8192, R2[1], C2[1]); S.aoff(nxt, R2, C2, xa); }
                else {
#pragma unroll
                    for (int h = 0; h < 2; ++h)
#pragma unroll
                        for (int i = 0; i < 2; ++i) xa[h][i] = ca[h][i];
                }
            }
            PG8_LDB(B0, 0, 0); PG8_SCHED; PG8_LDA(At, 0, 0); PG8_STAGE_A(PG8_SA(1, 1), 1, a1, k1, ca);
            PG8_WAIT_L(8); PG8_BAR; PG8_WAIT_L(0); PG8_MMA(0, 0, At, B0); PG8_BAR; PG8_SCHED;
            PG8_LDB(B1, 0, 1); PG8_STAGE(PG8_SB(0, 0), b2, voffB);
            PG8_BAR; PG8_WAIT_L(0); PG8_MMA(0, 1, At, B1); PG8_BAR;
            PG8_LDA(At, 0, 1); PG8_STAGE_A(PG8_SA(0, 0), 0, a2, k2, xa);
            PG8_BAR; PG8_WAIT_L(0); PG8_MMA(1, 0, At, B0); PG8_BAR; PG8_SCHED;
            PG8_STAGE(PG8_SB(0, 1), b2 + hstepB, voffB);
            PG8_WAIT_V(6); PG8_BAR; PG8_MMA(1, 1, At, B1); PG8_BAR;
            PG8_LDB(B0, 1, 0); PG8_SCHED; PG8_LDA(At, 1, 0); PG8_STAGE_A(PG8_SA(0, 1), 1, a2, k2, xa);
            PG8_WAIT_L(8); PG8_BAR; PG8_WAIT_L(0); PG8_MMA(0, 0, At, B0); PG8_BAR; PG8_SCHED;
            PG8_LDB(B1, 1, 1); PG8_STAGE(PG8_SB(1, 0), b3, voffB);
            PG8_BAR; PG8_WAIT_L(0); PG8_MMA(0, 1, At, B1); PG8_BAR;
            PG8_LDA(At, 1, 1); PG8_STAGE_A(PG8_SA(1, 0), 0, a3, k3, xa);
            PG8_BAR; PG8_WAIT_L(0); PG8_MMA(1, 0, At, B0); PG8_BAR; PG8_SCHED;
            PG8_STAGE(PG8_SB(1, 1), b3 + hstepB, voffB);
            PG8_WAIT_V(6); PG8_BAR; PG8_MMA(1, 1, At, B1); PG8_BAR;
        }
        if constexpr (F8) { asm volatile("s_nop 7\n\ts_nop 7\n\ts_nop 7" ::: "memory");
#pragma unroll
            for (int a = 0; a < 2; ++a)
#pragma unroll
                for (int b = 0; b < 2; ++b)
#pragma unroll
                    for (int m = 0; m < 4; ++m)
#pragma unroll
                        for (int n = 0; n < 2; ++n) acc[a][b][m][n] *= oscale; }
        { const int l2 = fresh_tid(0); E(acc, cur, wr, wc, l2 & 15, l2 >> 4); }
        if (!has_next) break;
#pragma unroll
        for (int a = 0; a < 2; ++a)
#pragma unroll
            for (int b = 0; b < 2; ++b)
#pragma unroll
                for (int m = 0; m < 4; ++m)
#pragma unroll
                    for (int n = 0; n < 2; ++n) { const float zf = fresh_zero(); acc[a][b][m][n] = (f32x4){zf, zf, zf, zf}; }
        cur = nxt; cA = nA; cB = nB; ++ui;
        if constexpr (GA) { int R2[2], C2[2]; const int t2 = fresh_tid(wv); stage_rc(t2 * 16, R2[0], C2[0]); stage_rc(t2 * 16 + 8192, R2[1], C2[1]); S.aoff(cur, R2, C2, ca); }
    }
    PG8_WAIT_V(0);
    if (wr == 0) PG8_BAR;
    PG8_BAR;
#undef PG8_SA
#undef PG8_SB
#undef PG8_STAGE
#undef PG8_STAGE_A
#undef PG8_LDA
#undef PG8_LDB
#undef PG8_MMA
#undef PG8_LD32
#undef PG8_LOH
#undef PG8_HIH
#undef PG8_WAIT_V
#undef PG8_WAIT_L
#undef PG8_BAR
#undef PG8_SCHED
}
}

namespace da {
constexpr int KVBLK = 64;
constexpr float THR = 8.f;
constexpr int SHM_V = KVBLK * 128 * 2, SHM_K = KVBLK * 128 * 2, SHM_KR = KVBLK * 64 * 2;
constexpr int OFF_V = 0, OFF_K = 2 * SHM_V, OFF_WS = OFF_K + 2 * SHM_K, OFF_KR = OFF_WS + 8 * 64 * 4, OFF_QR = OFF_KR + 2 * SHM_KR, LDS_DENSE = OFF_QR + 8 * 4096;
#define KSWZ(row, colB) ((row) * 256 + ((colB) ^ (((row) & 7) << 4)))
#define KRSWZ(row, ch) ((row) * 128 + ((((ch) ^ ((row) >> 1)) & 7) << 4))
#define SBAR() __builtin_amdgcn_sched_barrier(0)
__device__ __forceinline__ int crow(int r, int hi) { return (r & 3) + 8 * (r >> 2) + 4 * hi; }
__device__ __forceinline__ int v_st(int k, int c) { const int kk = (k & ~0xC) | ((k & 4) << 1) | ((k & 8) >> 1); return ((kk >> 3) * 4 + (c >> 5)) * 512 + ((kk & 7) * 32 + (c & 31)) * 2; }
__device__ __forceinline__ int v_rd_base(int lane) { return ((lane & 3) << 3) | (((lane >> 2) & 3) << 6) | (((lane >> 4) & 1) << 5) | (((lane >> 5) & 1) << 8); }
constexpr int v_rd_off(int d0, int ks, int half) { return d0 * 512 + ks * 4096 + half * 2048; }
template <int OFF> __device__ __forceinline__ s16x4 tr_read(int vb) {
    s16x4 r; asm volatile("ds_read_b64_tr_b16 %0, %1 offset:%2" : "=&v"(r) : "v"(vb), "i"(OFF) : "memory"); return r;
}
template <int D0> __device__ __forceinline__ void pv_one(f32x16& od, int vb, bf16x8 pa0, bf16x8 pa1, bf16x8 pa2, bf16x8 pa3) {
    const s16x4 l0 = tr_read<v_rd_off(D0, 0, 0)>(vb), h0 = tr_read<v_rd_off(D0, 0, 1)>(vb), l1 = tr_read<v_rd_off(D0, 1, 0)>(vb), h1 = tr_read<v_rd_off(D0, 1, 1)>(vb);
    const s16x4 l2 = tr_read<v_rd_off(D0, 2, 0)>(vb), h2 = tr_read<v_rd_off(D0, 2, 1)>(vb), l3 = tr_read<v_rd_off(D0, 3, 0)>(vb), h3 = tr_read<v_rd_off(D0, 3, 1)>(vb);
    asm volatile("s_waitcnt lgkmcnt(0)" ::: "memory"); SBAR();
#define PK(L, H) (bf16x8){L[0], L[1], L[2], L[3], H[0], H[1], H[2], H[3]}
    od = __builtin_amdgcn_mfma_f32_32x32x16_bf16(pa0, PK(l0, h0), od, 0, 0, 0);
    od = __builtin_amdgcn_mfma_f32_32x32x16_bf16(pa1, PK(l1, h1), od, 0, 0, 0);
    od = __builtin_amdgcn_mfma_f32_32x32x16_bf16(pa2, PK(l2, h2), od, 0, 0, 0);
    od = __builtin_amdgcn_mfma_f32_32x32x16_bf16(pa3, PK(l3, h3), od, 0, 0, 0);
}
__device__ __forceinline__ void pv_d0(f32x16* o, int vb, bf16x8 pa0, bf16x8 pa1, bf16x8 pa2, bf16x8 pa3) {
    pv_one<0>(o[0], vb, pa0, pa1, pa2, pa3); pv_one<1>(o[1], vb, pa0, pa1, pa2, pa3); pv_one<2>(o[2], vb, pa0, pa1, pa2, pa3); pv_one<3>(o[3], vb, pa0, pa1, pa2, pa3);
}
template <int D0> __device__ __forceinline__ void pv_one32(f32x16& od, int vb, bf16x8 pa0, bf16x8 pa1) {
    const s16x4 l0 = tr_read<v_rd_off(D0, 0, 0)>(vb), h0 = tr_read<v_rd_off(D0, 0, 1)>(vb), l1 = tr_read<v_rd_off(D0, 1, 0)>(vb), h1 = tr_read<v_rd_off(D0, 1, 1)>(vb);
    asm volatile("s_waitcnt lgkmcnt(0)" ::: "memory"); SBAR();
    od = __builtin_amdgcn_mfma_f32_32x32x16_bf16(pa0, PK(l0, h0), od, 0, 0, 0);
    od = __builtin_amdgcn_mfma_f32_32x32x16_bf16(pa1, PK(l1, h1), od, 0, 0, 0);
}
#undef PK
#define PK4(P, BASE, OUT) do { unsigned a0 = cvtpk(P[BASE + 0], P[BASE + 1]), a1 = cvtpk(P[BASE + 2], P[BASE + 3]);   \
    unsigned b0 = cvtpk(P[BASE + 4], P[BASE + 5]), b1 = cvtpk(P[BASE + 6], P[BASE + 7]);                              \
    auto r0 = __builtin_amdgcn_permlane32_swap(a0, b0, false, false); auto r1 = __builtin_amdgcn_permlane32_swap(a1, b1, false, false); \
    u32x4 w = {r0[0], r1[0], r0[1], r1[1]}; OUT = *reinterpret_cast<bf16x8*>(&w); } while (0)

template <int NDQ> struct Cst { static constexpr float SCALE = (NDQ == 8) ? 0.088388347648318440f : 0.072168783648703220f; static constexpr float C = SCALE * LOG2E; };

template <int NDQ>
__device__ __forceinline__ void partialSM(f32x16& p0, f32x16& p1, float& m_reg, float& mn, float& alpha) {
    constexpr float C = Cst<NDQ>::C, SCALE = Cst<NDQ>::SCALE;
    float pmax = p0[0];
#pragma unroll
    for (int r = 1; r < 16; ++r) pmax = fmaxf(pmax, p0[r]);
#pragma unroll
    for (int r = 0; r < 16; ++r) pmax = fmaxf(pmax, p1[r]);
    { auto rr = __builtin_amdgcn_permlane32_swap(__float_as_uint(pmax), __float_as_uint(pmax), false, false);
      pmax = fmaxf(__uint_as_float(rr[0]), __uint_as_float(rr[1])); }
    if (__builtin_expect(__all(pmax - m_reg <= THR / SCALE), 1)) { mn = m_reg; alpha = 1.f; }
    else { mn = fmaxf(m_reg, pmax); alpha = __builtin_amdgcn_exp2f((m_reg - mn) * C); m_reg = mn; }
    const float mnC = -mn * C;
#pragma unroll
    for (int r = 0; r < 16; ++r) p0[r] = fmaf(p0[r], C, mnC);
#pragma unroll
    for (int r = 0; r < 16; ++r) p1[r] = fmaf(p1[r], C, mnC);
#pragma unroll
    for (int r = 0; r < 16; ++r) p0[r] = __builtin_amdgcn_exp2f(p0[r]);
}
__device__ __forceinline__ void finishSM(f32x16& p0, f32x16& p1, float alpha, float& l_reg, bf16x8& pa0, bf16x8& pa1, bf16x8& pa2, bf16x8& pa3) {
#pragma unroll
    for (int r = 0; r < 16; ++r) p1[r] = __builtin_amdgcn_exp2f(p1[r]);
    float ps = 0;
#pragma unroll
    for (int r = 0; r < 16; ++r) ps += p0[r];
#pragma unroll
    for (int r = 0; r < 16; ++r) ps += p1[r];
    { auto rr = __builtin_amdgcn_permlane32_swap(__float_as_uint(ps), __float_as_uint(ps), false, false);
      ps = __uint_as_float(rr[0]) + __uint_as_float(rr[1]); }
    l_reg = l_reg * alpha + ps;
    PK4(p0, 0, pa0); PK4(p0, 8, pa1); PK4(p1, 0, pa2); PK4(p1, 8, pa3);
}
template <int NDQ>
__device__ __forceinline__ void qkt(f32x16& p0, f32x16& p1, const char* Ks, const char* Krs, const bf16x8* qr, const char* qrl, int r32, int hi) {
    p0 = f32x16{}; p1 = f32x16{};
#pragma unroll
    for (int d0 = 0; d0 < 8; ++d0) { const int cb = (d0 * 16 + hi * 8) * 2;
        bf16x8 b0 = *reinterpret_cast<const bf16x8*>(Ks + KSWZ(r32, cb));
        bf16x8 b1 = *reinterpret_cast<const bf16x8*>(Ks + KSWZ(32 + r32, cb));
        p0 = __builtin_amdgcn_mfma_f32_32x32x16_bf16(b0, qr[d0], p0, 0, 0, 0);
        p1 = __builtin_amdgcn_mfma_f32_32x32x16_bf16(b1, qr[d0], p1, 0, 0, 0); }
    if constexpr (NDQ == 12) {
#pragma unroll
        for (int d0 = 0; d0 < 4; ++d0) { const int ch = d0 * 2 + hi;
            bf16x8 b0 = *reinterpret_cast<const bf16x8*>(Krs + KRSWZ(r32, ch));
            bf16x8 b1 = *reinterpret_cast<const bf16x8*>(Krs + KRSWZ(32 + r32, ch));
            const bf16x8 qf = *reinterpret_cast<const bf16x8*>(qrl + d0 * 1024);
            p0 = __builtin_amdgcn_mfma_f32_32x32x16_bf16(b0, qf, p0, 0, 0, 0);
            p1 = __builtin_amdgcn_mfma_f32_32x32x16_bf16(b1, qf, p1, 0, 0, 0); }
    }
}

struct DArgs { const bf16_t* Q; const bf16_t* K; const bf16_t* V; const bf16_t* Kr; bf16_t* O; int ldq, ldk, ldv, ldo; int seq; int pos0; };

template <int NDQ, int SDEPTH>
__device__ __forceinline__ void attn_dense_body(int wv, const DArgs a, char* lds) {
    const int tid = fresh_tid(wv), wid = tid >> 6, lane = tid & 63, r32 = lane & 31, hi = lane >> 5;
    char* V_lds = lds + OFF_V; char* K_lds = lds + OFF_K; char* Kr_lds = lds + OFF_KR;
    float* ws = (float*)(lds + OFF_WS) + wid * 64; float* li_l = ws; float* al_l = ws + 32;
    float m_reg = -1e30f, l_reg = 0; f32x16 o[4] = {}; bf16x8 qr[8];
    char* qrl = lds + OFF_QR + wid * 4096 + lane * 16;
    const bf16_t* Qw = a.Q + (long)(wid * 32 + r32) * a.ldq + hi * 8;
#pragma unroll
    for (int d0 = 0; d0 < 8; ++d0) qr[d0] = *reinterpret_cast<const bf16x8*>(Qw + d0 * 16);
    if constexpr (NDQ == 12) {
        const float pos = (float)(a.pos0 + wid * 32 + r32);
#pragma unroll
        for (int f = 0; f < 2; ++f) {
            const bf16x8 x1v = *reinterpret_cast<const bf16x8*>(Qw + (8 + f) * 16), x2v = *reinterpret_cast<const bf16x8*>(Qw + (10 + f) * 16); bf16x8 y1v, y2v;
#pragma unroll
            for (int j = 0; j < 8; ++j) { const int i = f * 16 + hi * 8 + j; float sn, cs; sincos_rev(pos * inv_freq32(i), sn, cs);
                const float x1 = bf2f((unsigned short)x1v[j]), x2 = bf2f((unsigned short)x2v[j]);
                y1v[j] = (short)f2bf(x1 * cs - x2 * sn); y2v[j] = (short)f2bf(x2 * cs + x1 * sn); }
            *reinterpret_cast<bf16x8*>(qrl + f * 1024) = y1v; *reinterpret_cast<bf16x8*>(qrl + (2 + f) * 1024) = y2v;
        }
    }
    const int sr = tid >> 4, sc = (tid & 15) * 8, vst0 = v_st(sr, sc), vst1 = v_st(32 + sr, sc);
    const int krr = tid >> 3, krc = tid & 7;
    const int vb0 = (int)(uintptr_t)V_lds + v_rd_base(lane);
    struct { bf16x8 vs0, vs1, ks0, ks1, kr; } sr_[SDEPTH];
#define SLOAD(i, k0) do { sr_[i].vs0 = *(const bf16x8*)(a.V + (long)((k0) + sr) * a.ldv + sc); sr_[i].vs1 = *(const bf16x8*)(a.V + (long)((k0) + 32 + sr) * a.ldv + sc); \
    sr_[i].ks0 = *(const bf16x8*)(a.K + (long)((k0) + sr) * a.ldk + sc); sr_[i].ks1 = *(const bf16x8*)(a.K + (long)((k0) + 32 + sr) * a.ldk + sc); \
    if constexpr (NDQ == 12) sr_[i].kr = *(const bf16x8*)(a.Kr + (long)((k0) + krr) * 64 + krc * 8); } while (0)
#define SWRITE(b, i) do { *(bf16x8*)(V_lds + (b) * SHM_V + vst0) = sr_[i].vs0; *(bf16x8*)(V_lds + (b) * SHM_V + vst1) = sr_[i].vs1; const int kc = sc * 2; \
    *(bf16x8*)(K_lds + (b) * SHM_K + KSWZ(sr, kc)) = sr_[i].ks0; *(bf16x8*)(K_lds + (b) * SHM_K + KSWZ(32 + sr, kc)) = sr_[i].ks1; \
    if constexpr (NDQ == 12) *(bf16x8*)(Kr_lds + (b) * SHM_KR + KRSWZ(krr, krc)) = sr_[i].kr; } while (0)
#define SWAIT() do { if constexpr (SDEPTH == 2) { if constexpr (NDQ == 12) asm volatile("s_waitcnt vmcnt(5)" ::: "memory"); else asm volatile("s_waitcnt vmcnt(4)" ::: "memory"); } else asm volatile("s_waitcnt vmcnt(0)" ::: "memory"); } while (0)
#define RESC(al) do { if (__any((al) < 1.f)) { if (hi == 0) al_l[r32] = (al); asm volatile("s_waitcnt lgkmcnt(0)" ::: "memory"); \
    _Pragma("unroll") for (int d = 0; d < 4; ++d) _Pragma("unroll") for (int r = 0; r < 16; ++r) o[d][r] *= al_l[crow(r, hi)]; } } while (0)
    f32x16 pA0, pA1, pB0, pB1; float mnA, mnB, alA, alB; bf16x8 pa0, pa1, pa2, pa3; const int NT = a.seq / KVBLK;
    constexpr int SE = 0, SO = SDEPTH - 1;
    SLOAD(SE, 0); asm volatile("s_waitcnt vmcnt(0)" ::: "memory"); SWRITE(0, SE); __syncthreads();
    qkt<NDQ>(pA0, pA1, K_lds, Kr_lds, qr, qrl, r32, hi); partialSM<NDQ>(pA0, pA1, m_reg, mnA, alA);
    SLOAD(SO, KVBLK); if constexpr (SDEPTH == 2) { if (2 < NT) SLOAD(SE, 2 * KVBLK); }
    SWAIT(); SWRITE(1, SO); __syncthreads();
#pragma unroll 1
    for (int j = 1; j + 1 < NT; j += 2) {
        SBAR(); qkt<NDQ>(pB0, pB1, K_lds + SHM_K, Kr_lds + SHM_KR, qr, qrl, r32, hi);
        finishSM(pA0, pA1, alA, l_reg, pa0, pa1, pa2, pa3); SBAR();
        SLOAD(SO, (j + SDEPTH) * KVBLK); SBAR();
        pv_d0(o, vb0, pa0, pa1, pa2, pa3); partialSM<NDQ>(pB0, pB1, m_reg, mnB, alB);
        __syncthreads(); SWAIT(); SWRITE(0, SE);
        RESC(alB); __syncthreads();
        SBAR(); qkt<NDQ>(pA0, pA1, K_lds, Kr_lds, qr, qrl, r32, hi);
        finishSM(pB0, pB1, alB, l_reg, pa0, pa1, pa2, pa3); SBAR();
        if (SDEPTH == 1 || j + 3 < NT) SLOAD(SE, (j + 1 + SDEPTH) * KVBLK); SBAR();
        pv_d0(o, vb0 + (int)SHM_V, pa0, pa1, pa2, pa3); partialSM<NDQ>(pA0, pA1, m_reg, mnA, alA);
        __syncthreads(); SWAIT(); SWRITE(1, SO);
        RESC(alA); __syncthreads();
    }
    SBAR(); qkt<NDQ>(pB0, pB1, K_lds + SHM_K, Kr_lds + SHM_KR, qr, qrl, r32, hi);
    finishSM(pA0, pA1, alA, l_reg, pa0, pa1, pa2, pa3); SBAR();
    pv_d0(o, vb0, pa0, pa1, pa2, pa3); partialSM<NDQ>(pB0, pB1, m_reg, mnB, alB);
    __syncthreads(); RESC(alB);
    finishSM(pB0, pB1, alB, l_reg, pa0, pa1, pa2, pa3); SBAR();
    pv_d0(o, vb0 + (int)SHM_V, pa0, pa1, pa2, pa3);
    if (hi == 0) li_l[r32] = l_reg; asm volatile("s_waitcnt lgkmcnt(0)" ::: "memory");
    float rli[16];
#pragma unroll
    for (int r = 0; r < 16; ++r) rli[r] = __builtin_amdgcn_rcpf(li_l[crow(r, hi)]);
    bf16_t* Ow = F8_OUT ? (bf16_t*)((unsigned char*)a.O + (long)(wid * 32) * a.ldo) : a.O + (long)(wid * 32) * a.ldo;
#pragma unroll
    for (int r = 0; r < 16; ++r) { const int orow = crow(r, hi);
#pragma unroll
        for (int d0 = 0; d0 < 4; ++d0) { if constexpr (F8_OUT) ((unsigned char*)Ow)[(long)orow * a.ldo + d0 * 32 + r32] = f2fp8(o[d0][r] * rli[r] * O8_SCALE); else Ow[(long)orow * a.ldo + d0 * 32 + r32] = f2bf(o[d0][r] * rli[r]); } }
#undef SLOAD
#undef SWRITE
#undef SWAIT
#undef RESC
}

constexpr int SP_WAVE_LDS = 18688;
template <class P>
__device__ __forceinline__ void sparse_wave(P& pol, LAS unsigned char* wll, int lane) {
    const int r32 = lane & 31, hi = lane >> 5;
    char* wl = (char*)wll;
    char* Kl = wl; char* Vl = wl + 8192; float* li_l = (float*)(wl + 16384); float* al_l = li_l + 32;
    bf16x8 qr[8];
    { const bf16_t* qp = pol.qptr(r32) + hi * 8;
#pragma unroll
      for (int d0 = 0; d0 < 8; ++d0) qr[d0] = *reinterpret_cast<const bf16x8*>(qp + d0 * 16); }
    asm volatile("s_waitcnt vmcnt(0)" ::: "memory");
    f32x16 o[4] = {}; float m_reg = -1e30f, l_reg = 0.f;
    const int krow0 = lane >> 4;
    const int kce = (((lane & 15) ^ (krow0 & 7)) * 8), kco = (((lane & 15) ^ ((4 + krow0) & 7)) * 8);
    const int vk0 = 8 * ((lane >> 4) & 1) + ((lane >> 2) & 3), vc0 = 32 * (lane >> 5) + 8 * (lane & 3);
    const int vb = (int)(uintptr_t)Vl + v_rd_base(lane);
    const int nt = pol.ntiles();
    typename P::TI ti, tn;
#define SP_DMA_K(T) do { _Pragma("unroll") for (int i = 0; i < 8; ++i) { const bf16_t* src = (T).k + (long)(4 * i + krow0) * (T).rs + ((i & 1) ? kco : kce); \
        __builtin_amdgcn_global_load_lds((const unsigned*)src, (LAS unsigned*)(wll + i * 1024), 16, 0, 0); } } while (0)
#define SP_DMA_V(T) do { _Pragma("unroll") for (int i = 0; i < 8; ++i) { const bf16_t* src = (T).v + (long)(16 * (i >> 2) + 4 * ((i >> 1) & 1) + vk0) * (T).rs + 64 * (i & 1) + vc0; \
        __builtin_amdgcn_global_load_lds((const unsigned*)src, (LAS unsigned*)(wll + 8192 + i * 1024), 16, 0, 0); } } while (0)
    pol.tile(0, ti);
    SP_DMA_K(ti); SP_DMA_V(ti);
#pragma unroll 1
    for (int j = 0; j < nt; ++j) {
        const bool more = (j + 1 < nt);
        if (more) pol.tile(j + 1, tn);
        asm volatile("s_waitcnt vmcnt(8)" ::: "memory");
        f32x16 p = f32x16{};
#pragma unroll
        for (int d0 = 0; d0 < 8; ++d0) { const int cb = (d0 * 16 + hi * 8) * 2;
            bf16x8 b0 = *reinterpret_cast<const bf16x8*>(Kl + KSWZ(r32, cb));
            p = __builtin_amdgcn_mfma_f32_32x32x16_bf16(b0, qr[d0], p, 0, 0, 0); }
        asm volatile("s_waitcnt lgkmcnt(0)" ::: "memory"); SBAR();
        if (more) SP_DMA_K(tn);
        SBAR();
        float pmax = -INFINITY;
#pragma unroll
        for (int r = 0; r < 16; ++r) { p[r] = pol.adj(ti, crow(r, hi), p[r]); pmax = fmaxf(pmax, p[r]); }
        { auto rr = __builtin_amdgcn_permlane32_swap(__float_as_uint(pmax), __float_as_uint(pmax), false, false);
          pmax = fmaxf(__uint_as_float(rr[0]), __uint_as_float(rr[1])); }
        const float mn = fmaxf(m_reg, pmax); const float alpha = __builtin_amdgcn_exp2f(m_reg - mn); m_reg = mn;
        float ps = 0.f;
#pragma unroll
        for (int r = 0; r < 16; ++r) { p[r] = __builtin_amdgcn_exp2f(p[r] - mn); ps += p[r]; }
        { auto rr = __builtin_amdgcn_permlane32_swap(__float_as_uint(ps), __float_as_uint(ps), false, false);
          ps = __uint_as_float(rr[0]) + __uint_as_float(rr[1]); }
        l_reg = l_reg * alpha + ps;
        if (__any(alpha < 1.f)) { if (hi == 0) al_l[r32] = alpha; asm volatile("s_waitcnt lgkmcnt(0)" ::: "memory");
#pragma unroll
            for (int d = 0; d < 4; ++d)
#pragma unroll
                for (int r = 0; r < 16; ++r) o[d][r] *= al_l[crow(r, hi)]; }
        bf16x8 pa0, pa1; PK4(p, 0, pa0); PK4(p, 8, pa1);
        SBAR();
        if (more) asm volatile("s_waitcnt vmcnt(8)" ::: "memory"); else asm volatile("s_waitcnt vmcnt(0)" ::: "memory");
        SBAR();
        pv_one32<0>(o[0], vb, pa0, pa1); pv_one32<1>(o[1], vb, pa0, pa1); pv_one32<2>(o[2], vb, pa0, pa1); pv_one32<3>(o[3], vb, pa0, pa1);
        SBAR();
        if (more) SP_DMA_V(tn);
        SBAR();
        ti = tn;
    }
#undef SP_DMA_K
#undef SP_DMA_V
    if (hi == 0) li_l[r32] = l_reg; asm volatile("s_waitcnt lgkmcnt(0)" ::: "memory");
#pragma unroll
    for (int r = 0; r < 16; ++r) { const int qn = crow(r, hi); const float rl = __builtin_amdgcn_rcpf(li_l[qn]); bf16_t* op = pol.optr(qn);
#pragma unroll
        for (int d0 = 0; d0 < 4; ++d0) { if constexpr (F8_OUT) ((unsigned char*)op)[d0 * 32 + r32] = f2fp8(o[d0][r] * rl * O8_SCALE); else op[d0 * 32 + r32] = f2bf(o[d0][r] * rl); } }
}
#undef PK4
}

#define SBAR() __builtin_amdgcn_sched_barrier(0)
namespace d8 {
constexpr int K8_BYTES = 64 * 128, KR8_BYTES = 64 * 64, VT_PITCH = 80, VT_BYTES = 128 * VT_PITCH;
constexpr int OFF_K8 = 0, OFF_KR8 = 2 * K8_BYTES, OFF_VT = OFF_KR8 + 2 * KR8_BYTES, OFF_WS8 = OFF_VT + 2 * VT_BYTES, LDS_D8 = OFF_WS8 + 8 * 64 * 4;
constexpr float THR8 = 4.f;
#define K8SWZ(row, ch) ((row) * 128 + ((((ch) ^ ((row) >> 1)) & 7) << 4))
#define KR8SWZ(row, ch) ((row) * 64 + ((((ch) ^ ((row) >> 2)) & 3) << 4))
__device__ __forceinline__ int krow_of(int a) { const int hi = a >> 5, j = a & 31; return da::crow(j & 15, hi) + 32 * (j >> 4); }
struct D8Args { const bf16_t* Q; const unsigned char* K8; const unsigned char* Kr8; const unsigned char* Vt8; bf16_t* O; int ldq, ldk, ldvt, ldo; int seq; int pos0; };
template <int NKS> struct Cst8 { static constexpr float SCALE = (NKS == 2) ? 0.088388347648318440f : 0.072168783648703220f; static constexpr float C = SCALE * LOG2E; };
#define D8_LD32(dst, p) do { const i32x4 _lo = *(const i32x4*)(p), _hi = *(const i32x4*)((p) + 16); dst = __builtin_shufflevector(_lo, _hi, 0, 1, 2, 3, 4, 5, 6, 7); } while (0)
#define D8_MX(a, b, c) __builtin_amdgcn_mfma_scale_f32_32x32x64_f8f6f4(a, b, c, 0, 0, 0, 0, 0, 0)
template <int NKS, bool MACC = (NKS == 2)>
__device__ __forceinline__ void qkt8(f32x16& p0, f32x16& p1, const f32x16& mneg, const char* Ks, const char* Krs, const i32x8* qf, int r32, int hi) {
    i32x8 a0[2], a1[2];
#pragma unroll
    for (int sK = 0; sK < 2; ++sK) { const int ch = 4 * sK + 2 * hi;
        { const i32x4 lo = *(const i32x4*)(Ks + K8SWZ(r32, ch)), hh = *(const i32x4*)(Ks + K8SWZ(r32, ch + 1)); a0[sK] = __builtin_shufflevector(lo, hh, 0, 1, 2, 3, 4, 5, 6, 7); }
        { const i32x4 lo = *(const i32x4*)(Ks + K8SWZ(32 + r32, ch)), hh = *(const i32x4*)(Ks + K8SWZ(32 + r32, ch + 1)); a1[sK] = __builtin_shufflevector(lo, hh, 0, 1, 2, 3, 4, 5, 6, 7); } }
    asm volatile("s_waitcnt lgkmcnt(0)" ::: "memory"); SBAR();
    if constexpr (MACC) {
        asm volatile("v_mfma_f32_32x32x64_f8f6f4 %0, %1, %2, %3" : "=&v"(p0) : "v"(a0[0]), "v"(qf[0]), "v"(mneg));
        asm volatile("v_mfma_f32_32x32x64_f8f6f4 %0, %1, %2, %3" : "=&v"(p1) : "v"(a1[0]), "v"(qf[0]), "v"(mneg)); }
    else { p0 = f32x16{}; p1 = f32x16{}; p0 = D8_MX(a0[0], qf[0], p0); p1 = D8_MX(a1[0], qf[0], p1); }
    if constexpr (NKS == 3) { i32x8 r0, r1; const int ch = 2 * hi;
        { const i32x4 lo = *(const i32x4*)(Krs + KR8SWZ(r32, ch)), hh = *(const i32x4*)(Krs + KR8SWZ(r32, ch + 1)); r0 = __builtin_shufflevector(lo, hh, 0, 1, 2, 3, 4, 5, 6, 7); }
        { const i32x4 lo = *(const i32x4*)(Krs + KR8SWZ(32 + r32, ch)), hh = *(const i32x4*)(Krs + KR8SWZ(32 + r32, ch + 1)); r1 = __builtin_shufflevector(lo, hh, 0, 1, 2, 3, 4, 5, 6, 7); }
        p0 = D8_MX(a0[1], qf[1], p0); p1 = D8_MX(a1[1], qf[1], p1);
        p0 = D8_MX(r0, qf[2], p0); p1 = D8_MX(r1, qf[2], p1); }
    else { p0 = D8_MX(a0[1], qf[1], p0); p1 = D8_MX(a1[1], qf[1], p1); }
}
template <bool FIRST, bool SPLAT = false>
__device__ __forceinline__ void partialSM8(f32x16& p0, f32x16& p1, float& m_reg, f32x16& mneg, float& alpha) {
    float pmax = p0[0];
#pragma unroll
    for (int r = 1; r < 16; ++r) pmax = fmaxf(pmax, p0[r]);
#pragma unroll
    for (int r = 0; r < 16; ++r) pmax = fmaxf(pmax, p1[r]);
    { auto rr = __builtin_amdgcn_permlane32_swap(__float_as_uint(pmax), __float_as_uint(pmax), false, false);
      pmax = fmaxf(__uint_as_float(rr[0]), __uint_as_float(rr[1])); }
    if (!FIRST && __builtin_expect(__all(pmax <= THR8 * LOG2E), 1)) { alpha = 1.f; }
    else { const float delta = FIRST ? pmax : fmaxf(pmax, 0.f); alpha = FIRST ? 1.f : __builtin_amdgcn_exp2f(-delta); m_reg += delta;
#pragma unroll
        for (int r = 0; r < 16; ++r) { p0[r] -= delta; p1[r] -= delta; }
        if constexpr (!SPLAT) { const float nm = -m_reg;
#pragma unroll
            for (int r = 0; r < 16; ++r) mneg[r] = nm; } }
    if constexpr (SPLAT) { float nm = -m_reg; asm volatile("" : "+v"(nm));
#pragma unroll
        for (int r = 0; r < 16; ++r) mneg[r] = nm; }
#pragma unroll
    for (int r = 0; r < 16; ++r) p0[r] = __builtin_amdgcn_exp2f(p0[r]);
}
template <int NKS>
__device__ __forceinline__ void partialSM8z(f32x16& p0, f32x16& p1, float& m_reg, float& alpha) {
    constexpr float C = Cst8<NKS>::C, SCALE = Cst8<NKS>::SCALE; float mn;
    float pmax = p0[0];
#pragma unroll
    for (int r = 1; r < 16; ++r) pmax = fmaxf(pmax, p0[r]);
#pragma unroll
    for (int r = 0; r < 16; ++r) pmax = fmaxf(pmax, p1[r]);
    { auto rr = __builtin_amdgcn_permlane32_swap(__float_as_uint(pmax), __float_as_uint(pmax), false, false);
      pmax = fmaxf(__uint_as_float(rr[0]), __uint_as_float(rr[1])); }
    if (__builtin_expect(__all(pmax - m_reg <= THR8 / SCALE), 1)) { mn = m_reg; alpha = 1.f; }
    else { mn = fmaxf(m_reg, pmax); alpha = __builtin_amdgcn_exp2f((m_reg - mn) * C); m_reg = mn; }
    const float mnC = -mn * C;
#pragma unroll
    for (int r = 0; r < 16; ++r) p0[r] = fmaf(p0[r], C, mnC);
#pragma unroll
    for (int r = 0; r < 16; ++r) p1[r] = fmaf(p1[r], C, mnC);
#pragma unroll
    for (int r = 0; r < 16; ++r) p0[r] = __builtin_amdgcn_exp2f(p0[r]);
}
__device__ __forceinline__ void finishSM8n(f32x16& p0, f32x16& p1, i32x8& pa) {
#pragma unroll
    for (int r = 0; r < 16; ++r) p1[r] = __builtin_amdgcn_exp2f(p1[r]);
    pa = (i32x8){(int)pk4_fp8(p0[0], p0[1], p0[2], p0[3]), (int)pk4_fp8(p0[4], p0[5], p0[6], p0[7]), (int)pk4_fp8(p0[8], p0[9], p0[10], p0[11]), (int)pk4_fp8(p0[12], p0[13], p0[14], p0[15]),
                 (int)pk4_fp8(p1[0], p1[1], p1[2], p1[3]), (int)pk4_fp8(p1[4], p1[5], p1[6], p1[7]), (int)pk4_fp8(p1[8], p1[9], p1[10], p1[11]), (int)pk4_fp8(p1[12], p1[13], p1[14], p1[15])};
}
__device__ __forceinline__ void finishSM8(f32x16& p0, f32x16& p1, float alpha, float& l_reg, i32x8& pa) {
#pragma unroll
    for (int r = 0; r < 16; ++r) p1[r] = __builtin_amdgcn_exp2f(p1[r]);
    float ps = 0;
#pragma unroll
    for (int r = 0; r < 16; ++r) ps += p0[r];
#pragma unroll
    for (int r = 0; r < 16; ++r) ps += p1[r];
    { auto rr = __builtin_amdgcn_permlane32_swap(__float_as_uint(ps), __float_as_uint(ps), false, false);
      ps = __uint_as_float(rr[0]) + __uint_as_float(rr[1]); }
    l_reg = l_reg * alpha + ps;
    pa = (i32x8){(int)pk4_fp8(p0[0], p0[1], p0[2], p0[3]), (int)pk4_fp8(p0[4], p0[5], p0[6], p0[7]), (int)pk4_fp8(p0[8], p0[9], p0[10], p0[11]), (int)pk4_fp8(p0[12], p0[13], p0[14], p0[15]),
                 (int)pk4_fp8(p1[0], p1[1], p1[2], p1[3]), (int)pk4_fp8(p1[4], p1[5], p1[6], p1[7]), (int)pk4_fp8(p1[8], p1[9], p1[10], p1[11]), (int)pk4_fp8(p1[12], p1[13], p1[14], p1[15])};
}
__device__ __forceinline__ void pv8(f32x16* o, const char* Vt, const i32x8 pa, int r32, int hi) {
    i32x8 bfr[4];
#pragma unroll
    for (int d0 = 0; d0 < 4; ++d0) { const char* vp = Vt + (32 * d0 + r32) * VT_PITCH + 32 * hi;
        const i32x4 lo = *(const i32x4*)vp, hh = *(const i32x4*)(vp + 16); bfr[d0] = __builtin_shufflevector(lo, hh, 0, 1, 2, 3, 4, 5, 6, 7); }
    asm volatile("s_waitcnt lgkmcnt(0)" ::: "memory"); SBAR();
#pragma unroll
    for (int d0 = 0; d0 < 4; ++d0) o[d0] = D8_MX(pa, bfr[d0], o[d0]);
}
#define D8Q(P0, P1, KS, KRS, QF, R32, HI) do { if constexpr (VAR == 3) { P0 = f32x16{}; P1 = f32x16{}; } else qkt8<NKS>(P0, P1, mneg, KS, KRS, QF, R32, HI); } while (0)
#define D8P(FIRST, P0, P1, MR, AL) do { if constexpr (VAR == 1) { AL = 1.f; } else if constexpr (NKS == 2) partialSM8<FIRST>(P0, P1, MR, mneg, AL); else partialSM8z<NKS>(P0, P1, MR, AL); } while (0)
#define D8F(P0, P1, AL, LR, PA) do { if constexpr (VAR == 1) { PA = (i32x8){(int)pk4_fp8(P0[0], P0[1], P0[2], P0[3]), (int)pk4_fp8(P0[4], P0[5], P0[6], P0[7]), (int)pk4_fp8(P0[8], P0[9], P0[10], P0[11]), (int)pk4_fp8(P0[12], P0[13], P0[14], P0[15]), \
        (int)pk4_fp8(P1[0], P1[1], P1[2], P1[3]), (int)pk4_fp8(P1[4], P1[5], P1[6], P1[7]), (int)pk4_fp8(P1[8], P1[9], P1[10], P1[11]), (int)pk4_fp8(P1[12], P1[13], P1[14], P1[15])}; LR += 1.f; } else finishSM8(P0, P1, AL, LR, PA); } while (0)
#define D8V(O, VT, PA, R32, HI) do { if constexpr (VAR != 3) pv8(O, VT, PA, R32, HI); } while (0)
template <int NKS, int VAR = 0>
__device__ __forceinline__ void attn_dense8_body(int wv, const D8Args a, char* lds) {
    const int tid = fresh_tid(wv), wid = tid >> 6, lane = tid & 63, r32 = lane & 31, hi = lane >> 5;
    char* K_lds = lds + OFF_K8; char* Kr_lds = lds + OFF_KR8; char* Vt_lds = lds + OFF_VT;
    float* ws = (float*)(lds + OFF_WS8) + wid * 64; float* li_l = ws; float* al_l = ws + 32;
    float m_reg = (NKS == 2) ? 0.f : -1e30f, l_reg = 0; f32x16 o[4] = {}; i32x8 qf[NKS]; f32x16 mneg = {};
    constexpr float QC = (NKS == 2) ? Cst8<NKS>::C : 1.0f;
    { const bf16_t* Qw = a.Q + (long)(wid * 32 + r32) * a.ldq;
#pragma unroll
      for (int sK = 0; sK < 2; ++sK) { const bf16_t* qp = Qw + 64 * sK + 32 * hi; unsigned w[8];
#pragma unroll
          for (int c = 0; c < 4; ++c) { const u32x4 v = *(const u32x4*)(qp + 8 * c);
              w[2 * c] = pk4_fp8(bflo(v.x) * QC, bfhi(v.x) * QC, bflo(v.y) * QC, bfhi(v.y) * QC); w[2 * c + 1] = pk4_fp8(bflo(v.z) * QC, bfhi(v.z) * QC, bflo(v.w) * QC, bfhi(v.w) * QC); }
          qf[sK] = (i32x8){(int)w[0], (int)w[1], (int)w[2], (int)w[3], (int)w[4], (int)w[5], (int)w[6], (int)w[7]}; }
      if constexpr (NKS == 3) {
          const float pos = (float)(a.pos0 + wid * 32 + r32); const bf16_t* qp = Qw + 128; unsigned w[8];
#pragma unroll
          for (int c = 0; c < 4; ++c) { const u32x4 v1 = *(const u32x4*)(qp + 8 * c), v2 = *(const u32x4*)(qp + 32 + 8 * c);
              const unsigned a1[4] = {v1.x, v1.y, v1.z, v1.w}, a2[4] = {v2.x, v2.y, v2.z, v2.w}; float y[8];
#pragma unroll
              for (int e = 0; e < 8; ++e) { const int i = 8 * c + e; float sn, cs; sincos_rev(pos * inv_freq32(i), sn, cs);
                  const float x1 = (e & 1) ? bfhi(a1[e >> 1]) : bflo(a1[e >> 1]), x2 = (e & 1) ? bfhi(a2[e >> 1]) : bflo(a2[e >> 1]);
                  y[e] = (hi ? (x2 * cs + x1 * sn) : (x1 * cs - x2 * sn)) * QC; }
              w[2 * c] = pk4_fp8(y[0], y[1], y[2], y[3]); w[2 * c + 1] = pk4_fp8(y[4], y[5], y[6], y[7]); }
          qf[2] = (i32x8){(int)w[0], (int)w[1], (int)w[2], (int)w[3], (int)w[4], (int)w[5], (int)w[6], (int)w[7]}; } }
    const int ka = tid >> 3, kch = tid & 7, kdst = K8SWZ(krow_of(ka), kch);
    const int vc = tid >> 2, vq = tid & 3, vdst = vc * VT_PITCH + vq * 16;
    const int ra = (tid >> 2) & 63, rch = tid & 3, rdst = KR8SWZ(krow_of(ra), rch);
    struct { u32x4 k, v, r; } sr_[2];
    if constexpr (VAR == 2) { sr_[0].k = sr_[0].v = sr_[0].r = sr_[1].k = sr_[1].v = sr_[1].r = (u32x4){0x38383838u, 0x38383838u, 0x38383838u, 0x38383838u}; }
#define SLOAD8(i, k0) do { if constexpr (VAR == 2) break; sr_[i].k = *(const u32x4*)(a.K8 + (long)((k0) + ka) * a.ldk + kch * 16); sr_[i].v = *(const u32x4*)(a.Vt8 + (long)vc * a.ldvt + (k0) + vq * 16); \
    if constexpr (NKS == 3) sr_[i].r = *(const u32x4*)(a.Kr8 + (long)((k0) + ra) * 64 + rch * 16); } while (0)
#define SWRITE8(b, i) do { if constexpr (VAR == 4) break; *(u32x4*)(K_lds + (b) * K8_BYTES + kdst) = sr_[i].k; *(u32x4*)(Vt_lds + (b) * VT_BYTES + vdst) = sr_[i].v; \
    if constexpr (NKS == 3) *(u32x4*)(Kr_lds + (b) * KR8_BYTES + rdst) = sr_[i].r; } while (0)
#define RESC8(al) do { if (__any((al) < 1.f)) { if (hi == 0) al_l[r32] = (al); asm volatile("s_waitcnt lgkmcnt(0)" ::: "memory"); \
    _Pragma("unroll") for (int d = 0; d < 4; ++d) _Pragma("unroll") for (int r = 0; r < 16; ++r) o[d][r] *= al_l[da::crow(r, hi)]; } } while (0)
    f32x16 pA0, pA1, pB0, pB1; float alA, alB; i32x8 pa; const int NT = a.seq / 64;
    SLOAD8(0, 0); asm volatile("s_waitcnt vmcnt(0)" ::: "memory"); SWRITE8(0, 0); __syncthreads();
    D8Q(pA0, pA1, K_lds, Kr_lds, qf, r32, hi); D8P(true, pA0, pA1, m_reg, alA);
    SLOAD8(1, 64); if (2 < NT) SLOAD8(0, 128);
    if constexpr (NKS == 3) asm volatile("s_waitcnt vmcnt(3)" ::: "memory"); else asm volatile("s_waitcnt vmcnt(2)" ::: "memory");
    SWRITE8(1, 1); __syncthreads();
#pragma unroll 1
    for (int j = 1; j + 1 < NT; j += 2) {
        SBAR(); D8Q(pB0, pB1, K_lds + K8_BYTES, Kr_lds + KR8_BYTES, qf, r32, hi);
        D8F(pA0, pA1, alA, l_reg, pa); SBAR();
        SLOAD8(1, (j + 2) * 64); SBAR();
        D8V(o, Vt_lds, pa, r32, hi); D8P(false, pB0, pB1, m_reg, alB);
        __syncthreads(); if constexpr (NKS == 3) asm volatile("s_waitcnt vmcnt(3)" ::: "memory"); else asm volatile("s_waitcnt vmcnt(2)" ::: "memory");
        SWRITE8(0, 0);
        RESC8(alB); __syncthreads();
        SBAR(); D8Q(pA0, pA1, K_lds, Kr_lds, qf, r32, hi);
        D8F(pB0, pB1, alB, l_reg, pa); SBAR();
        if (j + 3 < NT) SLOAD8(0, (j + 3) * 64); SBAR();
        D8V(o, Vt_lds + VT_BYTES, pa, r32, hi); D8P(false, pA0, pA1, m_reg, alA);
        __syncthreads(); if constexpr (NKS == 3) asm volatile("s_waitcnt vmcnt(3)" ::: "memory"); else asm volatile("s_waitcnt vmcnt(2)" ::: "memory");
        SWRITE8(1, 1);
        RESC8(alA); __syncthreads();
    }
    SBAR(); D8Q(pB0, pB1, K_lds + K8_BYTES, Kr_lds + KR8_BYTES, qf, r32, hi);
    D8F(pA0, pA1, alA, l_reg, pa); SBAR();
    D8V(o, Vt_lds, pa, r32, hi); D8P(false, pB0, pB1, m_reg, alB);
    __syncthreads(); RESC8(alB);
    D8F(pB0, pB1, alB, l_reg, pa); SBAR();
    D8V(o, Vt_lds + VT_BYTES, pa, r32, hi);
    const int tid_e = fresh_tid(wv), wid_e = tid_e >> 6, r32e = tid_e & 31, hie = (tid_e >> 5) & 1;
    float* li_e = (float*)(lds + OFF_WS8) + wid_e * 64;
    if (hie == 0) li_e[r32e] = l_reg; asm volatile("s_waitcnt lgkmcnt(0)" ::: "memory");
    float rli[16];
#pragma unroll
    for (int r = 0; r < 16; ++r) rli[r] = __builtin_amdgcn_rcpf(li_e[da::crow(r, hie)]);
    bf16_t* Ow = F8_OUT ? (bf16_t*)((unsigned char*)a.O + (long)(wid_e * 32) * a.ldo) : a.O + (long)(wid_e * 32) * a.ldo;
#pragma unroll
    for (int r = 0; r < 16; ++r) { const int orow = da::crow(r, hie); const int r32 = r32e;
#pragma unroll
        for (int d0 = 0; d0 < 4; ++d0) { if constexpr (F8_OUT) ((unsigned char*)Ow)[(long)orow * a.ldo + d0 * 32 + r32] = f2fp8(o[d0][r] * rli[r] * O8_SCALE); else Ow[(long)orow * a.ldo + d0 * 32 + r32] = f2bf(o[d0][r] * rli[r]); } }
#undef SLOAD8
#undef SWRITE8
#undef RESC8
}
constexpr int DM_K = 0, DM_KR = 6 * K8_BYTES, DM_VT = DM_KR + 6 * KR8_BYTES, DM_WS = DM_VT + 6 * K8_BYTES, LDS_D8DMA = DM_WS + 8 * 64 * 4;
__device__ __forceinline__ void pv8s(f32x16* o, const char* Vl, const i32x8 pa, int r32, int hi) {
    i32x8 bfr[4];
#pragma unroll
    for (int d0 = 0; d0 < 4; ++d0) { const int c = 32 * d0 + r32; const char* vp = Vl + c * 64; const int sw = (c >> 2) & 3;
        const i32x4 lo = *(const i32x4*)(vp + (((2 * hi) ^ sw) << 4)), hh = *(const i32x4*)(vp + (((2 * hi + 1) ^ sw) << 4)); bfr[d0] = __builtin_shufflevector(lo, hh, 0, 1, 2, 3, 4, 5, 6, 7); }
    asm volatile("s_waitcnt lgkmcnt(0)" ::: "memory"); SBAR();
#pragma unroll
    for (int d0 = 0; d0 < 4; ++d0) o[d0] = D8_MX(pa, bfr[d0], o[d0]);
}
#define LDS16(off) (*(const LAS i32x4*)(ldsl + (off)))
template <int NKS, bool MACC>
__device__ __forceinline__ void qkt8d(f32x16& p0, f32x16& p1, const f32x16& mneg, LAS unsigned char* ldsl, int kb, int rb, const i32x8* qf) {
    i32x8 a0[2], a1[2];
#pragma unroll
    for (int sK = 0; sK < 2; ++sK) {
        { const i32x4 lo = LDS16(kb ^ (64 * sK)), hh = LDS16(kb ^ (64 * sK + 16)); a0[sK] = __builtin_shufflevector(lo, hh, 0, 1, 2, 3, 4, 5, 6, 7); }
        { const i32x4 lo = LDS16((kb ^ (64 * sK)) + 4096), hh = LDS16((kb ^ (64 * sK + 16)) + 4096); a1[sK] = __builtin_shufflevector(lo, hh, 0, 1, 2, 3, 4, 5, 6, 7); } }
    asm volatile("s_waitcnt lgkmcnt(0)" ::: "memory"); SBAR();
    if constexpr (MACC) {
        asm volatile("v_mfma_f32_32x32x64_f8f6f4 %0, %1, %2, %3" : "=&v"(p0) : "v"(a0[0]), "v"(qf[0]), "v"(mneg));
        asm volatile("v_mfma_f32_32x32x64_f8f6f4 %0, %1, %2, %3" : "=&v"(p1) : "v"(a1[0]), "v"(qf[0]), "v"(mneg)); }
    else { p0 = f32x16{}; p1 = f32x16{}; p0 = D8_MX(a0[0], qf[0], p0); p1 = D8_MX(a1[0], qf[0], p1); }
    if constexpr (NKS == 3) { i32x8 r0, r1;
        { const i32x4 lo = LDS16(rb), hh = LDS16(rb ^ 16); r0 = __builtin_shufflevector(lo, hh, 0, 1, 2, 3, 4, 5, 6, 7); }
        { const i32x4 lo = LDS16(rb + 2048), hh = LDS16((rb ^ 16) + 2048); r1 = __builtin_shufflevector(lo, hh, 0, 1, 2, 3, 4, 5, 6, 7); }
        p0 = D8_MX(a0[1], qf[1], p0); p1 = D8_MX(a1[1], qf[1], p1);
        p0 = D8_MX(r0, qf[2], p0); p1 = D8_MX(r1, qf[2], p1); }
    else { p0 = D8_MX(a0[1], qf[1], p0); p1 = D8_MX(a1[1], qf[1], p1); }
    if constexpr (MACC) asm volatile("" : "+v"(p1), "+v"(p0) : "v"(mneg));
}
__device__ __forceinline__ void pv8d(f32x16* o, LAS unsigned char* ldsl, int vb, const i32x8 pa) {
    i32x8 bfr[4];
#pragma unroll
    for (int d0 = 0; d0 < 4; ++d0) { const i32x4 lo = LDS16(vb + d0 * 2048), hh = LDS16((vb ^ 16) + d0 * 2048); bfr[d0] = __builtin_shufflevector(lo, hh, 0, 1, 2, 3, 4, 5, 6, 7); }
    asm volatile("s_waitcnt lgkmcnt(0)" ::: "memory"); SBAR();
#pragma unroll
    for (int d0 = 0; d0 < 4; ++d0) o[d0] = D8_MX(pa, bfr[d0], o[d0]);
}
template <int NKS, bool MACC>
__device__ __forceinline__ void attn_dense8_dma(int wv, const D8Args a, LAS unsigned char* ldsl) {
    constexpr int VAR = 0;
    constexpr bool LSUM = (NKS == 2);
    const int tid = fresh_tid(wv), wid = __builtin_amdgcn_readfirstlane(tid >> 6), lane = tid & 63, r32 = lane & 31, hi = lane >> 5;
    char* lds = (char*)ldsl;
    float m_reg = MACC ? 0.f : -1e30f, l_reg = 0; f32x16 o[4] = {}; i32x8 qf[NKS]; f32x16 mneg = {}; f32x16 lacc = {};
    const i32x8 ones8 = (i32x8){0x38383838, 0x38383838, 0x38383838, 0x38383838, 0x38383838, 0x38383838, 0x38383838, 0x38383838};
    constexpr float QC = MACC ? Cst8<NKS>::C : 1.0f;
    { const bf16_t* Qw = a.Q + (long)(wid * 32 + r32) * a.ldq;
#pragma unroll
      for (int sK = 0; sK < 2; ++sK) { const bf16_t* qp = Qw + 64 * sK + 32 * hi; unsigned w[8];
#pragma unroll
          for (int c = 0; c < 4; ++c) { const u32x4 v = *(const u32x4*)(qp + 8 * c);
              w[2 * c] = pk4_fp8(bflo(v.x) * QC, bfhi(v.x) * QC, bflo(v.y) * QC, bfhi(v.y) * QC); w[2 * c + 1] = pk4_fp8(bflo(v.z) * QC, bfhi(v.z) * QC, bflo(v.w) * QC, bfhi(v.w) * QC); }
          qf[sK] = (i32x8){(int)w[0], (int)w[1], (int)w[2], (int)w[3], (int)w[4], (int)w[5], (int)w[6], (int)w[7]}; }
      if constexpr (NKS == 3) {
          const float pos = (float)(a.pos0 + wid * 32 + r32); const bf16_t* qp = Qw + 128; unsigned w[8];
#pragma unroll
          for (int c = 0; c < 4; ++c) { const u32x4 v1 = *(const u32x4*)(qp + 8 * c), v2 = *(const u32x4*)(qp + 32 + 8 * c);
              const unsigned a1[4] = {v1.x, v1.y, v1.z, v1.w}, a2[4] = {v2.x, v2.y, v2.z, v2.w}; float y[8];
#pragma unroll
              for (int e = 0; e < 8; ++e) { const int i = 8 * c + e; float sn, cs; sincos_rev(pos * inv_freq32(i), sn, cs);
                  const float x1 = (e & 1) ? bfhi(a1[e >> 1]) : bflo(a1[e >> 1]), x2 = (e & 1) ? bfhi(a2[e >> 1]) : bflo(a2[e >> 1]);
                  y[e] = (hi ? (x2 * cs + x1 * sn) : (x1 * cs - x2 * sn)) * QC; }
              w[2 * c] = pk4_fp8(y[0], y[1], y[2], y[3]); w[2 * c + 1] = pk4_fp8(y[4], y[5], y[6], y[7]); }
          qf[2] = (i32x8){(int)w[0], (int)w[1], (int)w[2], (int)w[3], (int)w[4], (int)w[5], (int)w[6], (int)w[7]}; } }
    const unsigned char* ksrc; const unsigned char* vsrc; const unsigned char* rsrc = nullptr;
    { const int ri = 8 * wid + (lane >> 3), hk = (ri >> 2) & 1, ka = 32 * hk + (ri & 3) + 4 * ((ri >> 3) & 3) + 16 * (ri >> 5), kch = ((lane & 7) ^ (ri >> 1)) & 7;
      ksrc = a.K8 + (long)ka * a.ldk + kch * 16;
      const int vc = 16 * wid + (lane >> 2), vp = ((lane & 3) ^ (vc >> 2)) & 3; vsrc = a.Vt8 + (long)vc * a.ldvt + vp * 16;
      if constexpr (NKS == 3) { const int rr = 16 * (wid & 3) + (lane >> 2), rh = (rr >> 2) & 1, ra = 32 * rh + (rr & 3) + 4 * ((rr >> 3) & 3) + 16 * (rr >> 5), rch = ((lane & 3) ^ (rr >> 2)) & 3;
          rsrc = a.Kr8 + (long)ra * 64 + rch * 16; } }
#define D8_DMA2(k0, sb) do { _Pragma("unroll") for (int t_ = 0; t_ < 2; ++t_) { \
      __builtin_amdgcn_global_load_lds((const unsigned*)(ksrc + (long)((k0) + 64 * t_) * a.ldk), (LAS unsigned*)(ldsl + DM_K + (2 * (sb) + t_) * K8_BYTES + wid * 1024), 16, 0, 0); \
      __builtin_amdgcn_global_load_lds((const unsigned*)(vsrc + ((k0) + 64 * t_)), (LAS unsigned*)(ldsl + DM_VT + (2 * (sb) + t_) * K8_BYTES + wid * 1024), 16, 0, 0); } \
      if constexpr (NKS == 3) __builtin_amdgcn_global_load_lds((const unsigned*)(rsrc + (long)((k0) + 64 * (wid >> 2)) * 64), (LAS unsigned*)(ldsl + DM_KR + (2 * (sb) + (wid >> 2)) * KR8_BYTES + (wid & 3) * 1024), 16, 0, 0); } while (0)
#define RESC8(al) do { if (__any((al) < 1.f)) { if (hi == 0) al_l[r32] = (al); asm volatile("s_waitcnt lgkmcnt(0)" ::: "memory"); \
    _Pragma("unroll") for (int d = 0; d < 4; ++d) _Pragma("unroll") for (int r = 0; r < 16; ++r) o[d][r] *= al_l[da::crow(r, hi)]; \
    if constexpr (LSUM) { _Pragma("unroll") for (int r = 0; r < 16; ++r) lacc[r] *= al_l[da::crow(r, hi)]; } } } while (0)
#define D8Qm(P0, P1, b) qkt8d<NKS, MACC>(P0, P1, mneg, ldsl, kb0 + (b) * K8_BYTES, rb0 + (b) * KR8_BYTES, qf)
#define D8Vm(b) do { pv8d(o, ldsl, vb0 + (b) * K8_BYTES, pa); if constexpr (LSUM) lacc = D8_MX(pa, ones8, lacc); } while (0)
#define D8Fm(P0, P1, AL) do { if constexpr (LSUM) finishSM8n(P0, P1, pa); else finishSM8(P0, P1, AL, l_reg, pa); } while (0)
#define D8Pm(FIRST, P0, P1, AL) do { if constexpr (MACC) partialSM8<FIRST, (NKS == 3)>(P0, P1, m_reg, mneg, AL); else partialSM8z<NKS>(P0, P1, m_reg, AL); } while (0)
#define D8_TOP() do { asm volatile("s_waitcnt vmcnt(0)" ::: "memory"); __syncthreads(); } while (0)
    float* al_l = (float*)(lds + DM_WS) + wid * 64 + 32;
    const int kb0 = DM_K + r32 * 128 + ((((r32 >> 1) & 7) << 4) ^ (32 * hi)), rb0 = DM_KR + r32 * 64 + ((((r32 >> 2) & 3) << 4) ^ (32 * hi)), vb0 = DM_VT + r32 * 64 + ((((r32 >> 2) & 3) << 4) ^ (32 * hi));
    f32x16 pA0, pA1, pB0, pB1; float alA, alB; i32x8 pa;
    const int NS = a.seq / 128;
    D8_DMA2(0, 0);
    D8_TOP(); D8_DMA2(128, 1);
    D8Qm(pA0, pA1, 0); D8Pm(true, pA0, pA1, alA); RESC8(alA);
    SBAR(); D8Qm(pB0, pB1, 1);
    D8Fm(pA0, pA1, alA); SBAR();
    D8Vm(0); D8Pm(false, pB0, pB1, alB);
    RESC8(alB);
    int sb = 1, sbp = 0, sbn = 2;
#pragma unroll 1
    for (int J = 1; J < NS; ++J) {
        D8_TOP(); if (J + 1 < NS) D8_DMA2((J + 1) * 128, sbn);
        SBAR(); D8Qm(pA0, pA1, 2 * sb);
        D8Fm(pB0, pB1, alB); SBAR();
        D8Vm(2 * sbp + 1); D8Pm(false, pA0, pA1, alA);
        RESC8(alA);
        SBAR(); D8Qm(pB0, pB1, 2 * sb + 1);
        D8Fm(pA0, pA1, alA); SBAR();
        D8Vm(2 * sb); D8Pm(false, pB0, pB1, alB);
        RESC8(alB);
        { const int t = sbp; sbp = sb; sb = sbn; sbn = t; }
    }
    D8Fm(pB0, pB1, alB); SBAR();
    D8Vm(2 * sbp + 1);
    const int tid_e = fresh_tid(wv), wid_e = tid_e >> 6, r32e = tid_e & 31, hie = (tid_e >> 5) & 1;
    float* li_e = (float*)(lds + DM_WS) + wid_e * 64;
    float rli[16];
    if constexpr (LSUM) {
#pragma unroll
        for (int r = 0; r < 16; ++r) rli[r] = __builtin_amdgcn_rcpf(lacc[r]); (void)li_e; }
    else { if (hie == 0) li_e[r32e] = l_reg; asm volatile("s_waitcnt lgkmcnt(0)" ::: "memory");
#pragma unroll
        for (int r = 0; r < 16; ++r) rli[r] = __builtin_amdgcn_rcpf(li_e[da::crow(r, hie)]); }
    bf16_t* Ow = F8_OUT ? (bf16_t*)((unsigned char*)a.O + (long)(wid_e * 32) * a.ldo) : a.O + (long)(wid_e * 32) * a.ldo;
#pragma unroll
    for (int r = 0; r < 16; ++r) { const int orow = da::crow(r, hie);
#pragma unroll
        for (int d0 = 0; d0 < 4; ++d0) { if constexpr (F8_OUT) ((unsigned char*)Ow)[(long)orow * a.ldo + d0 * 32 + r32e] = f2fp8(o[d0][r] * rli[r] * O8_SCALE); else Ow[(long)orow * a.ldo + d0 * 32 + r32e] = f2bf(o[d0][r] * rli[r]); } }
#undef D8_DMA2
#undef RESC8
#undef D8Qm
#undef D8Vm
#undef D8Fm
#undef D8Pm
#undef D8_TOP
}
template <class P>
__device__ __forceinline__ void sparse8_wave(P& pol, LAS unsigned char* wll, int lane) {
    const int r32 = lane & 31, hi = lane >> 5;
    char* wl = (char*)wll; char* Kl = wl; char* Vl = wl + 8192; float* li_l = (float*)(wl + 16384); float* al_l = li_l + 32;
    constexpr float QCS = 0.088388347648318440f * LOG2E;
    i32x8 qf[2];
    { const bf16_t* Qw = pol.qptr(r32);
#pragma unroll
      for (int sK = 0; sK < 2; ++sK) { const bf16_t* qp = Qw + 64 * sK + 32 * hi; unsigned w[8];
#pragma unroll
          for (int c = 0; c < 4; ++c) { const u32x4 v = *(const u32x4*)(qp + 8 * c);
              w[2 * c] = pk4_fp8(bflo(v.x) * QCS, bfhi(v.x) * QCS, bflo(v.y) * QCS, bfhi(v.y) * QCS); w[2 * c + 1] = pk4_fp8(bflo(v.z) * QCS, bfhi(v.z) * QCS, bflo(v.w) * QCS, bfhi(v.w) * QCS); }
          qf[sK] = (i32x8){(int)w[0], (int)w[1], (int)w[2], (int)w[3], (int)w[4], (int)w[5], (int)w[6], (int)w[7]}; } }
    asm volatile("s_waitcnt vmcnt(0)" ::: "memory");
    f32x16 o[4] = {}; float m_reg = 0.f, l_reg = 0.f; f32x16 mneg = {}; f32x16 lacc = {}; bool seen = false;
    const i32x8 ones8 = (i32x8){0x38383838, 0x38383838, 0x38383838, 0x38383838, 0x38383838, 0x38383838, 0x38383838, 0x38383838};
    const int a0k = 32 * ((lane >> 5) & 1) + ((lane >> 3) & 3), che = (((lane & 7) ^ (lane >> 4)) & 7) << 4, cho = che ^ 64;
    const int vcol0 = lane >> 2; const unsigned voff = (unsigned)vcol0 * SEQ + ((((lane & 3) ^ (vcol0 >> 2)) & 3) << 4);
    const int nt = pol.ntiles();
    typename P::TI ti, tn;
#define SP8_UNI(p) ((const unsigned char*)(((unsigned long long)(unsigned)__builtin_amdgcn_readfirstlane((int)((unsigned long long)(p) >> 32)) << 32) | (unsigned)__builtin_amdgcn_readfirstlane((int)(unsigned long long)(p))))
#define SP8_DMA_K(T) do { const unsigned char* kb_ = SP8_UNI((T).k); const unsigned rs_ = (unsigned)__builtin_amdgcn_readfirstlane((int)(T).rs); const unsigned ko_ = (unsigned)a0k * rs_; \
        _Pragma("unroll") for (int i = 0; i < 8; ++i) { const unsigned char* src = kb_ + (unsigned long long)((4 * (i & 3) + 16 * (i >> 2)) * rs_) + (ko_ + (unsigned)((i & 1) ? cho : che)); \
        __builtin_amdgcn_global_load_lds((const unsigned*)src, (LAS unsigned*)(wll + i * 1024), 16, 0, 0); } } while (0)
#define SP8_DMA_V(T) do { const unsigned char* vb_ = SP8_UNI((T).v); \
        _Pragma("unroll") for (int i = 0; i < 8; ++i) { const unsigned char* src = vb_ + (unsigned long long)(16 * i) * SEQ + voff; \
        __builtin_amdgcn_global_load_lds((const unsigned*)src, (LAS unsigned*)(wll + 8192 + i * 1024), 16, 0, 0); } } while (0)
    pol.tile(0, ti);
    SP8_DMA_K(ti); SP8_DMA_V(ti);
#pragma unroll 1
    for (int j = 0; j < nt; ++j) {
        const bool more = (j + 1 < nt);
        if (more) pol.tile(j + 1, tn);
        asm volatile("s_waitcnt vmcnt(8)" ::: "memory");
        f32x16 p0, p1;
        { i32x8 a0[2], a1[2];
#pragma unroll
          for (int sK = 0; sK < 2; ++sK) { const int ch = 4 * sK + 2 * hi;
            { const i32x4 lo = *(const i32x4*)(Kl + K8SWZ(r32, ch)), hh = *(const i32x4*)(Kl + K8SWZ(r32, ch + 1)); a0[sK] = __builtin_shufflevector(lo, hh, 0, 1, 2, 3, 4, 5, 6, 7); }
            { const i32x4 lo = *(const i32x4*)(Kl + K8SWZ(32 + r32, ch)), hh = *(const i32x4*)(Kl + K8SWZ(32 + r32, ch + 1)); a1[sK] = __builtin_shufflevector(lo, hh, 0, 1, 2, 3, 4, 5, 6, 7); } }
          asm volatile("s_waitcnt lgkmcnt(0)" ::: "memory"); SBAR();
          if (more) SP8_DMA_K(tn);
          SBAR();
          if constexpr (P::SPLAT) { float nm = -m_reg; asm volatile("" : "+v"(nm));
#pragma unroll
              for (int r = 0; r < 16; ++r) mneg[r] = nm; }
          asm volatile("v_mfma_f32_32x32x64_f8f6f4 %0, %1, %2, %3" : "=&v"(p0) : "v"(a0[0]), "v"(qf[0]), "v"(mneg));
          asm volatile("v_mfma_f32_32x32x64_f8f6f4 %0, %1, %2, %3" : "=&v"(p1) : "v"(a1[0]), "v"(qf[0]), "v"(mneg));
          p0 = D8_MX(a0[1], qf[1], p0); p1 = D8_MX(a1[1], qf[1], p1);
          asm volatile("" : "+v"(p1), "+v"(p0) : "v"(mneg)); }
        float pmax = -INFINITY;
#pragma unroll
        for (int r = 0; r < 16; ++r) { p0[r] = pol.adj(ti, r, p0[r]); p1[r] = pol.adj(ti, 16 + r, p1[r]); pmax = fmaxf(pmax, fmaxf(p0[r], p1[r])); }
        { auto rr = __builtin_amdgcn_permlane32_swap(__float_as_uint(pmax), __float_as_uint(pmax), false, false);
          pmax = fmaxf(__uint_as_float(rr[0]), __uint_as_float(rr[1])); }
        float alpha = 1.f;
        { const bool first = (P::LSUM ? !seen : (l_reg == 0.f)) && (pmax > -INFINITY); if constexpr (P::LSUM) seen = seen || (pmax > -INFINITY);
          const float delta = first ? pmax : (pmax > THR8 * LOG2E ? pmax : 0.f);
          if (__any(delta != 0.f)) { alpha = first ? 1.f : __builtin_amdgcn_exp2f(-delta); m_reg += delta;
#pragma unroll
              for (int r = 0; r < 16; ++r) { p0[r] -= delta; p1[r] -= delta; }
              if constexpr (!P::SPLAT) { const float nm = -m_reg;
#pragma unroll
                  for (int r = 0; r < 16; ++r) mneg[r] = nm; }
              if (hi == 0) al_l[r32] = alpha; asm volatile("s_waitcnt lgkmcnt(0)" ::: "memory");
#pragma unroll
              for (int d = 0; d < 4; ++d)
#pragma unroll
                  for (int r = 0; r < 16; ++r) o[d][r] *= al_l[da::crow(r, hi)];
              if constexpr (P::LSUM) {
#pragma unroll
                  for (int r = 0; r < 16; ++r) lacc[r] *= al_l[da::crow(r, hi)]; } } }
        if constexpr (P::LSUM) {
#pragma unroll
            for (int r = 0; r < 16; ++r) { p0[r] = __builtin_amdgcn_exp2f(p0[r]); p1[r] = __builtin_amdgcn_exp2f(p1[r]); } }
        else { float ps = 0.f;
#pragma unroll
            for (int r = 0; r < 16; ++r) { p0[r] = __builtin_amdgcn_exp2f(p0[r]); p1[r] = __builtin_amdgcn_exp2f(p1[r]); ps += p0[r] + p1[r]; }
            { auto rr = __builtin_amdgcn_permlane32_swap(__float_as_uint(ps), __float_as_uint(ps), false, false);
              ps = __uint_as_float(rr[0]) + __uint_as_float(rr[1]); }
            l_reg = l_reg * alpha + ps; }
        const i32x8 pa = (i32x8){(int)pk4_fp8(p0[0], p0[1], p0[2], p0[3]), (int)pk4_fp8(p0[4], p0[5], p0[6], p0[7]), (int)pk4_fp8(p0[8], p0[9], p0[10], p0[11]), (int)pk4_fp8(p0[12], p0[13], p0[14], p0[15]),
                                 (int)pk4_fp8(p1[0], p1[1], p1[2], p1[3]), (int)pk4_fp8(p1[4], p1[5], p1[6], p1[7]), (int)pk4_fp8(p1[8], p1[9], p1[10], p1[11]), (int)pk4_fp8(p1[12], p1[13], p1[14], p1[15])};
        SBAR();
        if (more) asm volatile("s_waitcnt vmcnt(8)" ::: "memory"); else asm volatile("s_waitcnt vmcnt(0)" ::: "memory");
        SBAR();
        { i32x8 bfr[4];
#pragma unroll
          for (int d0 = 0; d0 < 4; ++d0) { const int c = 32 * d0 + r32; const char* vp = Vl + c * 64; const int sw = (c >> 2) & 3;
            const i32x4 lo = *(const i32x4*)(vp + (((2 * hi) ^ sw) << 4)), hh = *(const i32x4*)(vp + (((2 * hi + 1) ^ sw) << 4)); bfr[d0] = __builtin_shufflevector(lo, hh, 0, 1, 2, 3, 4, 5, 6, 7); }
          asm volatile("s_waitcnt lgkmcnt(0)" ::: "memory"); SBAR();
          if (more) SP8_DMA_V(tn);
          SBAR();
#pragma unroll
          for (int d0 = 0; d0 < 4; ++d0) o[d0] = D8_MX(pa, bfr[d0], o[d0]);
          if constexpr (P::LSUM) lacc = D8_MX(pa, ones8, lacc); }
        ti = tn;
    }
#undef SP8_DMA_K
#undef SP8_DMA_V
#undef SP8_UNI
    if constexpr (!P::LSUM) { if (hi == 0) li_l[r32] = l_reg; asm volatile("s_waitcnt lgkmcnt(0)" ::: "memory"); }
#pragma unroll
    for (int r = 0; r < 16; ++r) { const int qn = da::crow(r, hi); const float rl = __builtin_amdgcn_rcpf(P::LSUM ? lacc[r] : li_l[qn]); bf16_t* op = pol.optr(qn);
#pragma unroll
        for (int d0 = 0; d0 < 4; ++d0) { if constexpr (F8_OUT) ((unsigned char*)op)[d0 * 32 + r32] = f2fp8(o[d0][r] * rl * O8_SCALE); else op[d0 * 32 + r32] = f2bf(o[d0][r] * rl); } }
}
#undef D8Q
#undef D8P
#undef D8F
#undef D8V
#undef D8_LD32
#undef D8_MX
}


struct PolB {
    struct TI { const bf16_t* k; const bf16_t* v; long rs; int kpos0; int iq; float cd; };
    const bf16_t* H0; bf16_t* O; int b, h, a, r16, myn; int lo3, n3, lo2, n2, lo1, n1; float slope2;
    __device__ __forceinline__ void init(const bf16_t* H0_, bf16_t* O_, int w, int lane) {
        H0 = H0_; O = O_; b = w >> 10; h = (w >> 7) & 7; const int wu = w & 127; a = wu >> 4; r16 = wu & 15; myn = lane & 31;
        lo3 = max(a - 2, 0); n3 = min(a + 2, 7) - lo3 + 1;
        lo2 = max(4 * a - 2, 0); n2 = min(4 * a + 5, 31) - lo2 + 1;
        lo1 = max(16 * a - 2, 0); n1 = min(16 * a + 17, 127) - lo1 + 1;
        slope2 = __builtin_amdgcn_exp2f(-(float)(h + 1)) * LOG2E;
    }
    __device__ __forceinline__ const bf16_t* qptr(int n) const { return H0 + (long)(b * SEQ + 512 * a + r16 + 16 * n) * IN0 + 1536 + h * 128; }
    __device__ __forceinline__ bf16_t* optr(int qn) const { const long e = (long)(b * SEQ + 512 * a + r16 + 16 * qn) * DM + 1024 + h * 128; return F8_OUT ? (bf16_t*)((unsigned char*)O + e) : O + e; }
    __device__ __forceinline__ int ntiles() const { return n3 + n2 + n1; }
    __device__ __forceinline__ void tile(int j, TI& ti) const {
        int dil, kt, rd;
        if (j < n3) { dil = 16; kt = lo3 + j; rd = r16; }
        else if (j < n3 + n2) { dil = 4; kt = lo2 + (j - n3); rd = r16 & 3; }
        else { dil = 1; kt = lo1 + (j - n3 - n2); rd = 0; }
        const long tok = (long)b * SEQ + dil * 32 * kt + rd;
        ti.k = H0 + tok * IN0 + 2560 + h * 128; ti.v = H0 + tok * IN0 + 3584 + h * 128; ti.rs = (long)dil * IN0;
        ti.kpos0 = 32 * kt; ti.iq = (512 * a + r16 + 16 * myn - rd) / dil; ti.cd = slope2 * (float)dil;
    }
    __device__ __forceinline__ float adj(const TI& ti, int kloc, float s) const {
        const int d = ti.kpos0 + kloc - ti.iq; const int ad = d < 0 ? -d : d;
        return ad <= 64 ? fmaf(s, 0.088388347648318440f * LOG2E, -ti.cd * (float)ad) : -INFINITY;
    }
};
struct PolC {
    struct TI { const bf16_t* k; const bf16_t* v; long rs; int kc0; int drow; };
    const bf16_t* H1; bf16_t* O; const float* tab; int b, h, r, a, r0, qc, c0;
    __device__ __forceinline__ void init(const bf16_t* H1_, bf16_t* O_, const float* rpb, float* tab_, int w, int lane) {
        H1 = H1_; O = O_; tab = tab_; b = w >> 10; h = (w >> 7) & 7; const int wu = w & 127; r = wu >> 1; a = wu & 1;
        r0 = min(max(r - 4, 0), 56); qc = 32 * a + (lane & 31); c0 = min(max(qc - 8, 0), 48);
        for (int idx = lane; idx < 480; idx += 64) { const int dr = idx >> 5, dc = idx & 31; tab_[idx] = dc < 31 ? rpb[h * 465 + dr * 31 + dc] * LOG2E : 0.f; }
        asm volatile("s_waitcnt vmcnt(0) lgkmcnt(0)" ::: "memory");
    }
    __device__ __forceinline__ const bf16_t* qptr(int n) const { return H1 + (long)(b * SEQ + 64 * r + 32 * a + n) * IN1P + h * 128; }
    __device__ __forceinline__ bf16_t* optr(int qn) const { const long e = (long)(b * SEQ + 64 * r + 32 * a + qn) * DM + h * 128; return F8_OUT ? (bf16_t*)((unsigned char*)O + e) : O + e; }
    __device__ __forceinline__ int ntiles() const { return 16; }
    __device__ __forceinline__ void tile(int j, TI& ti) const {
        const int kr = r0 + (j >> 1), ch = j & 1; const long tok = (long)b * SEQ + 64 * kr + 32 * ch;
        ti.k = H1 + tok * IN1P + 1024 + h * 128; ti.v = H1 + tok * IN1P + 2048 + h * 128; ti.rs = IN1P; ti.kc0 = 32 * ch; ti.drow = kr - r + 7;
    }
    __device__ __forceinline__ float adj(const TI& ti, int kloc, float s) const {
        const int kc = ti.kc0 + kloc; const int dc = min(max(kc - qc + 15, 0), 30);
        const float bias = tab[ti.drow * 32 + dc];
        return (kc >= c0 && kc < c0 + 16) ? fmaf(s, 0.088388347648318440f * LOG2E, bias) : -INFINITY;
    }
};

struct PolB8 {
    static constexpr bool SPLAT = false; static constexpr bool LSUM = true;
    struct TI { const unsigned char* k; const unsigned char* v; long rs; float fb; float ncd; };
    const bf16_t* H0; bf16_t* O; const unsigned char* K8; const unsigned char* Vt1; const unsigned char* Vt4; const unsigned char* Vt16;
    int b, h, a, r16, myn, hi32; int lo3, n3, lo2, n2, lo1, n1; float slope2;
    __device__ __forceinline__ void init(const bf16_t* H0_, bf16_t* O_, const unsigned char* K8_, const unsigned char* Vt1_, const unsigned char* Vt4_, const unsigned char* Vt16_, int w, int lane) {
        H0 = H0_; O = O_; K8 = K8_; Vt1 = Vt1_; Vt4 = Vt4_; Vt16 = Vt16_; b = w >> 10; h = (w >> 7) & 7; const int wu = w & 127; a = wu >> 4; r16 = wu & 15; myn = lane & 31; hi32 = 32 * (lane >> 5);
        const int t = a >> 1; lo3 = max(t - 1, 0); n3 = min(t + 1, 3) - lo3 + 1;
        lo2 = max(2 * a - 1, 0); n2 = min(2 * a + 2, 15) - lo2 + 1;
        lo1 = max(8 * a - 1, 0); n1 = min(8 * a + 8, 63) - lo1 + 1;
        slope2 = __builtin_amdgcn_exp2f(-(float)(h + 1)) * LOG2E;
    }
    __device__ __forceinline__ const bf16_t* qptr(int n) const { return H0 + (long)(b * SEQ + 512 * a + r16 + 16 * n) * IN0 + 1536 + h * 128; }
    __device__ __forceinline__ bf16_t* optr(int qn) const { const long e = (long)(b * SEQ + 512 * a + r16 + 16 * qn) * DM + 1024 + h * 128; return F8_OUT ? (bf16_t*)((unsigned char*)O + e) : O + e; }
    __device__ __forceinline__ int ntiles() const { return n3 + n2 + n1; }
    __device__ __forceinline__ void tile(int j, TI& ti) const {
        int dil, kt, rd; const unsigned char* vt; int voff;
        if (j < n3) { dil = 16; kt = lo3 + j; rd = r16; vt = Vt16; voff = r16 * 256 + 64 * kt; }
        else if (j < n3 + n2) { dil = 4; kt = lo2 + (j - n3); rd = r16 & 3; vt = Vt4; voff = rd * 1024 + 64 * kt; }
        else { dil = 1; kt = lo1 + (j - n3 - n2); rd = 0; vt = Vt1; voff = 64 * kt; }
        const long tok = (long)b * SEQ + dil * 64 * kt + rd;
        ti.k = K8 + tok * 1024 + h * 128; ti.rs = (long)dil * 1024; ti.v = vt + (long)(b * 8 + h) * 128 * SEQ + voff;
        ti.fb = (float)(64 * kt + hi32 - (512 * a + r16 + 16 * myn - rd) / dil); ti.ncd = -slope2 * (float)dil;
    }
    __device__ __forceinline__ float adj(const TI& ti, int slot, float s) const {
        const float fd = ti.fb + (float)slot;
        return __builtin_fabsf(fd) <= 64.f ? fmaf(__builtin_fabsf(fd), ti.ncd, s) : -INFINITY;
    }
};
struct PolC8 {
    static constexpr bool SPLAT = true; static constexpr bool LSUM = false;
    struct TI { const unsigned char* k; const unsigned char* v; long rs; const float* tp; };
    const bf16_t* H1; bf16_t* O; const unsigned char* K8; const unsigned char* Vt; const float* tab0; int b, h, r, a, r0; int vmask;
    __device__ __forceinline__ void init(const bf16_t* H1_, bf16_t* O_, const unsigned char* K8_, const unsigned char* Vt_, const float* rpb, float* tab_, int w, int lane) {
        H1 = H1_; O = O_; K8 = K8_; Vt = Vt_; b = w >> 10; h = (w >> 7) & 7; const int wu = w & 127; r = wu >> 1; a = wu & 1;
        r0 = min(max(r - 4, 0), 56); const int qc = 32 * a + (lane & 31), c0 = min(max(qc - 8, 0), 48), hi32 = 32 * (lane >> 5);
        { const int lo = c0 - hi32; const unsigned m16 = 0xffffu; vmask = lo >= 32 || lo <= -16 ? 0 : (int)(lo >= 0 ? (m16 << lo) : (m16 >> (-lo))); }
        tab0 = tab_ + (hi32 - qc + 15);
        { float tv[8];
#pragma unroll
          for (int q = 0; q < 8; ++q) { const int idx = lane + 64 * q, dr = min(idx >> 5, 14), dc = idx & 31; tv[q] = rpb[h * 465 + dr * 31 + min(dc, 30)]; }
#pragma unroll
          for (int q = 0; q < 8; ++q) { const int idx = lane + 64 * q, dc = idx & 31; const float v = dc < 31 ? tv[q] * LOG2E : 0.f; if (idx < 480) tab_[idx] = v; } }
        asm volatile("s_waitcnt vmcnt(0) lgkmcnt(0)" ::: "memory");
    }
    __device__ __forceinline__ const bf16_t* qptr(int n) const { return H1 + (long)(b * SEQ + 64 * r + 32 * a + n) * IN1P + h * 128; }
    __device__ __forceinline__ bf16_t* optr(int qn) const { const long e = (long)(b * SEQ + 64 * r + 32 * a + qn) * DM + h * 128; return F8_OUT ? (bf16_t*)((unsigned char*)O + e) : O + e; }
    __device__ __forceinline__ int ntiles() const { return 8; }
    __device__ __forceinline__ void tile(int j, TI& ti) const {
        const int kr = r0 + j; const long tok = (long)b * SEQ + 64 * kr;
        ti.k = K8 + tok * 1024 + h * 128; ti.rs = 1024; ti.v = Vt + (long)(b * 8 + h) * 128 * SEQ + 64 * kr; ti.tp = tab0 + (kr - r + 7) * 32;
    }
    __device__ __forceinline__ float adj(const TI& ti, int slot, float s) const {
        const float v = s + ti.tp[slot];
        const int t = __builtin_amdgcn_sbfe(vmask, slot, 1);
        return __uint_as_float((__float_as_uint(v) & (unsigned)t) | (0xff800000u & ~(unsigned)t));
    }
};

struct Params { const float* in[28]; float* out; unsigned char* ws; int ph_lo, ph_hi; };
enum { I_X = 0, I_RW = 1, I_RB = 2, I_WIN0 = 3, I_AQN = 4, I_AKN = 5, I_WOUT0 = 6, I_LN1G0 = 7, I_LN1B0 = 8, I_WG0 = 9, I_WU0 = 10, I_WD0 = 11, I_LN2G0 = 12, I_LN2B0 = 13,
       I_WIN1 = 14, I_RPB = 15, I_DQN = 16, I_WQUP = 17, I_DKVN = 18, I_WKVUP = 19, I_WOUT1 = 20, I_LN1G1 = 21, I_LN1B1 = 22, I_WG1 = 23, I_WU1 = 24, I_WD1 = 25, I_LN2G1 = 26, I_LN2B1 = 27 };

__device__ __forceinline__ void tr_tile(const float* __restrict__ src, int N, const float* __restrict__ ksc, bf16_t* __restrict__ dst, int ldd, int k0, int n0, int drow0, LAS unsigned* tl, int tid) {
    const int c4 = (tid & 15) * 4;
#pragma unroll
    for (int i = 0; i < 2; ++i) {
        const int kp = (tid >> 4) + 32 * i;
        const float* s0 = src + (size_t)(k0 + 2 * kp) * N + n0 + c4;
        f32x4 a = *(const f32x4*)s0, b = *(const f32x4*)(s0 + N);
        if (ksc) { const float sa = ksc[k0 + 2 * kp], sb = ksc[k0 + 2 * kp + 1]; a *= sa; b *= sb; }
#pragma unroll
        for (int j = 0; j < 4; ++j) tl[(c4 + j) * 65 + kp] = cvtpk(a[j], b[j]);
    }
    __syncthreads();
    const int n = tid >> 3, seg = tid & 7;
    unsigned w[8];
#pragma unroll
    for (int q = 0; q < 8; ++q) w[q] = tl[n * 65 + seg * 8 + q];
    u32x4* d = (u32x4*)(dst + (size_t)(drow0 + n) * ldd + k0 + seg * 16);
    d[0] = (u32x4){w[0], w[1], w[2], w[3]}; d[1] = (u32x4){w[4], w[5], w[6], w[7]};
    __syncthreads();
}
__device__ __forceinline__ void tr_tile8(const float* __restrict__ src, int N, const float* __restrict__ ksc, float wscale, unsigned char* __restrict__ dst, int ldd, int k0, int n0, int drow0, LAS unsigned* tl, int tid) {
    const int c4 = (tid & 15) * 4, kq = tid >> 4;
    const float* s0 = src + (size_t)(k0 + 4 * kq) * N + n0 + c4;
    f32x4 a = *(const f32x4*)s0, b = *(const f32x4*)(s0 + N), c = *(const f32x4*)(s0 + 2 * (size_t)N), d = *(const f32x4*)(s0 + 3 * (size_t)N);
    float sa = wscale, sb = wscale, sc = wscale, sd = wscale;
    if (ksc) { sa *= ksc[k0 + 4 * kq]; sb *= ksc[k0 + 4 * kq + 1]; sc *= ksc[k0 + 4 * kq + 2]; sd *= ksc[k0 + 4 * kq + 3]; }
#pragma unroll
    for (int j = 0; j < 4; ++j) tl[(c4 + j) * 33 + kq] = pk4_fp8(a[j] * sa, b[j] * sb, c[j] * sc, d[j] * sd);
    __syncthreads();
    const int n = tid >> 3, seg = tid & 7;
    unsigned w[4];
#pragma unroll
    for (int q = 0; q < 4; ++q) w[q] = tl[n * 33 + seg * 4 + q];
    *(u32x4*)(dst + (size_t)(drow0 + n) * ldd + k0 + seg * 16) = (u32x4){w[0], w[1], w[2], w[3]};
    __syncthreads();
}
struct TJob { const float* src; bf16_t* dst; const float* ksc; int K, N, ldd, gu; size_t sbs, dbs; int f8; };
constexpr float W8_SCALE = 64.f;
constexpr int W8_SBYTE = 0x79797979;
__device__ __forceinline__ void run_tjob(const TJob& jb, int t, LAS unsigned* tl, int tid) {
    const int ntn = jb.N / 64, ntk = jb.K / 128, per = ntn * ntk;
    const int bi = t / per, r = t % per, tk = r / ntn, tn = r % ntn;
    const int n0 = tn * 64;
    const int drow0 = jb.gu ? (256 * (n0 >> 7) + (jb.gu == 2 ? 128 : 0) + (n0 & 127)) : n0;
    if (jb.f8) tr_tile8(jb.src + (size_t)bi * jb.sbs, jb.N, jb.ksc, W8_SCALE, (unsigned char*)jb.dst + (size_t)bi * jb.dbs, jb.ldd, tk * 128, n0, drow0, tl, tid);
    else tr_tile(jb.src + (size_t)bi * jb.sbs, jb.N, jb.ksc, jb.dst + (size_t)bi * jb.dbs, jb.ldd, tk * 128, n0, drow0, tl, tid);
}
typedef __attribute__((address_space(4))) const unsigned long long kcu64_t;
#define PIN(i) ((const float*)(__attribute__((address_space(1))) const float*)ka[i])
__device__ __forceinline__ void phase_prologue(kcu64_t* ka, unsigned char* ws, LAS unsigned char* lds, int G, int bid, int tid) {
    LAS unsigned* tl = (LAS unsigned*)lds;
    constexpr int NJ = 12;
    const int cnts[NJ] = {16 * 72, 16 * 32, 4096, 4096, 4096, 16 * 61, 16 * 32, 4096, 4096, 4096, 4 * 24, 2 * 32};
    int total = 0;
#pragma unroll
    for (int j = 0; j < NJ; ++j) total += cnts[j];
    for (int t = bid; t < total; t += G) {
        int j = 0, base = 0;
#pragma unroll
        for (int q = 0; q < NJ - 1; ++q) if (t >= base + cnts[q] && j == q) { base += cnts[q]; j = q + 1; }
        const int tt = t - base;
        TJob jb;
        switch (j) {
            case 0: jb = TJob{PIN(I_WIN0), (bf16_t*)(ws + WS_WIN0), nullptr, 2048, IN0, 2048, 0, 0, 0, F8_IN}; break;
            case 1: jb = TJob{PIN(I_WOUT0), (bf16_t*)(ws + WS_WOUT0), nullptr, 2048, 2048, 2048, 0, 0, 0, F8_OUT}; break;
            case 2: jb = TJob{PIN(I_WG0), (bf16_t*)(ws + WS_WGU0), nullptr, 2048, 512, 2048, 1, (size_t)2048 * 512, (size_t)1024 * 2048, F8_GU}; break;
            case 3: jb = TJob{PIN(I_WU0), (bf16_t*)(ws + WS_WGU0), nullptr, 2048, 512, 2048, 2, (size_t)2048 * 512, (size_t)1024 * 2048, F8_GU}; break;
            case 4: jb = TJob{PIN(I_WD0), (bf16_t*)(ws + WS_WD0), nullptr, 512, 2048, 512, 0, (size_t)512 * 2048, (size_t)2048 * 512, F8_DOWN}; break;
            case 5: jb = TJob{PIN(I_WIN1), (bf16_t*)(ws + WS_WIN1), nullptr, 2048, IN1, 2048, 0, 0, 0, F8_IN}; break;
            case 6: jb = TJob{PIN(I_WOUT1), (bf16_t*)(ws + WS_WOUT1), nullptr, 2048, 2048, 2048, 0, 0, 0, F8_OUT}; break;
            case 7: jb = TJob{PIN(I_WG1), (bf16_t*)(ws + WS_WGU1), nullptr, 2048, 512, 2048, 1, (size_t)2048 * 512, (size_t)1024 * 2048, F8_GU}; break;
            case 8: jb = TJob{PIN(I_WU1), (bf16_t*)(ws + WS_WGU1), nullptr, 2048, 512, 2048, 2, (size_t)2048 * 512, (size_t)1024 * 2048, F8_GU}; break;
            case 9: jb = TJob{PIN(I_WD1), (bf16_t*)(ws + WS_WD1), nullptr, 512, 2048, 512, 0, (size_t)512 * 2048, (size_t)2048 * 512, F8_DOWN}; break;
            case 10: jb = TJob{PIN(I_WQUP), (bf16_t*)(ws + WS_WQUP), PIN(I_DQN), 512, 1536, 512, 0, 0, 0, F8_P3}; break;
            default: jb = TJob{PIN(I_WKVUP), (bf16_t*)(ws + WS_WKVUP), PIN(I_DKVN), 256, 2048, 256, 0, 0, 0, F8_P3}; break;
        }
        run_tjob(jb, tt, tl, tid);
    }
    { constexpr size_t ESZ = F8_IN ? 1 : 2;
      u32x4* z = (u32x4*)(ws + WS_WIN1 + (size_t)IN1 * 2048 * ESZ); const size_t n16 = (size_t)(IN1P - IN1) * 2048 * ESZ / 16;
      const unsigned zu = __float_as_uint(fresh_zero());
      for (size_t i = (size_t)bid * NTHR + tid; i < n16; i += (size_t)G * NTHR) z[i] = (u32x4){zu, zu, zu, zu}; }
    { const f32x8* xs = (const f32x8*)PIN(I_X); const size_t n8 = (size_t)T_ * DM / 8;
      if constexpr (F8_IN) { u32x2* xd = (u32x2*)(ws + WS_RC + 64 * MiB);
          for (size_t i = (size_t)bid * NTHR + tid; i < n8; i += (size_t)G * NTHR) { const f32x8 v = xs[i]; xd[i] = (u32x2){pk4_fp8(v[0], v[1], v[2], v[3]), pk4_fp8(v[4], v[5], v[6], v[7])}; } }
      else { u32x4* xd = (u32x4*)(ws + WS_RA);
          for (size_t i = (size_t)bid * NTHR + tid; i < n8; i += (size_t)G * NTHR) { const f32x8 v = xs[i];
              xd[i] = (u32x4){cvtpk(v[0], v[1]), cvtpk(v[2], v[3]), cvtpk(v[4], v[5]), cvtpk(v[6], v[7])}; } } }
}

template <int X> __device__ __forceinline__ float swzf(float v) { return __int_as_float(__builtin_amdgcn_ds_swizzle(__float_as_int(v), (X << 10) | 0x1f)); }
template <int X> __device__ __forceinline__ unsigned swzu(unsigned v) { return (unsigned)__builtin_amdgcn_ds_swizzle((int)v, (X << 10) | 0x1f); }
__device__ __forceinline__ void phase_prep_qk(bf16_t* H0, const float* qn, const float* kn, unsigned char* K8, int G, int bid, int tid) {
    const int wid = __builtin_amdgcn_readfirstlane(tid >> 6), lane = tid & 63;
    const int cch = lane & 15, half = cch >> 3, ci = cch & 7; const bool isx2 = ci >= 4;
    float gqo[8], gqp[8], gko[8], gkp[8], invf[8];
#pragma unroll
    for (int j = 0; j < 8; ++j) { gqo[j] = qn[8 * cch + j]; gqp[j] = qn[8 * (cch ^ 4) + j]; gko[j] = kn[8 * cch + j]; gkp[j] = kn[8 * (cch ^ 4) + j]; invf[j] = inv_freq32(8 * (ci & 3) + j); }
    const int mstep = G * 8, m0 = bid * 8 + wid;
    u32x4 rawc[3], rawn[3];
#define PQK_LOAD(mm, R) do { const bf16_t* rp_ = H0 + (size_t)(mm) * IN0; _Pragma("unroll") for (int p = 0; p < 3; ++p) { if (p < 2 || lane < 32) { const int hh = 4 * p + (lane >> 4); \
        (R)[p] = *(const u32x4*)(rp_ + (hh < 8 ? hh * 128 : 1024 + (hh - 8) * 128) + 8 * cch); } } } while (0)
    rawc[2] = (u32x4){0u, 0u, 0u, 0u}; rawn[2] = rawc[2];
    if (m0 < T_) PQK_LOAD(m0, rawc);
    rawn[0] = rawc[0]; rawn[1] = rawc[1];
    for (int m = m0; m < T_; m += mstep) {
        if (m + mstep < T_) PQK_LOAD(m + mstep, rawn);
        const int sq = m & (SEQ - 1); const float pos = (float)(half ? (sq & 63) : (sq >> 6));
        float sn[8], cs[8];
#pragma unroll
        for (int j = 0; j < 8; ++j) sincos_rev(pos * invf[j], sn[j], cs[j]);
        bf16_t* rowp = H0 + (size_t)m * IN0;
#pragma unroll
        for (int p = 0; p < 3; ++p) {
            if (p < 2 || lane < 32) {
                const int hh = 4 * p + (lane >> 4); const bool isq = hh < 8;
                bf16_t* cp = rowp + (isq ? hh * 128 : 1024 + (hh - 8) * 128) + 8 * cch;
                const u32x4 raw = rawc[p];
                const unsigned rw4[4] = {raw.x, raw.y, raw.z, raw.w}; float x[8], xp[8]; float ss = 0.f;
#pragma unroll
                for (int q = 0; q < 4; ++q) { x[2 * q] = bflo(rw4[q]); x[2 * q + 1] = bfhi(rw4[q]); ss += x[2 * q] * x[2 * q] + x[2 * q + 1] * x[2 * q + 1];
                    const unsigned pw = swzu<4>(rw4[q]); xp[2 * q] = bflo(pw); xp[2 * q + 1] = bfhi(pw); }
                ss += swzf<1>(ss); ss += swzf<2>(ss); ss += swzf<4>(ss); ss += swzf<8>(ss);
                const float r = rsqrtf(ss * (1.0f / 128.0f) + 1e-6f);
                float o[8];
#pragma unroll
                for (int j = 0; j < 8; ++j) { const float yo = x[j] * r * (isq ? gqo[j] : gko[j]), yp = xp[j] * r * (isq ? gqp[j] : gkp[j]);
                    o[j] = isx2 ? (yo * cs[j] + yp * sn[j]) : (yo * cs[j] - yp * sn[j]); }
                *(u32x4*)cp = (u32x4){cvtpk(o[0], o[1]), cvtpk(o[2], o[3]), cvtpk(o[4], o[5]), cvtpk(o[6], o[7])};
                if (F8_ATTA && !isq) *(u32x2*)(K8 + (size_t)m * 256 + (hh - 8) * 128 + 8 * cch) = (u32x2){pk4_fp8(o[0], o[1], o[2], o[3]), pk4_fp8(o[4], o[5], o[6], o[7])};
            }
        }
        rawc[0] = rawn[0]; rawc[1] = rawn[1]; rawc[2] = rawn[2];
    }
#undef PQK_LOAD
}
__device__ __forceinline__ void phase_vt8(const bf16_t* H0, unsigned char* Vt8, LAS unsigned char* lds, int G, int bid, int tid) {
    const int t = tid >> 3, seg = tid & 7, c = tid >> 2, part = tid & 3;
    for (int u = bid; u < 1024; u += G) {
        const int b = u >> 7, kvh = (u >> 6) & 1, ch = u & 63;
        const bf16_t* src = H0 + (size_t)(b * SEQ + ch * 64 + t) * IN0 + 1280 + kvh * 128 + seg * 16;
        const u32x4 v0 = *(const u32x4*)src, v1 = *(const u32x4*)(src + 8);
        const unsigned w[8] = {v0.x, v0.y, v0.z, v0.w, v1.x, v1.y, v1.z, v1.w};
        __syncthreads();
#pragma unroll
        for (int j = 0; j < 8; ++j) { lds[(16 * seg + 2 * j) * 80 + t] = f2fp8(bflo(w[j])); lds[(16 * seg + 2 * j + 1) * 80 + t] = f2fp8(bfhi(w[j])); }
        __syncthreads();
        const u32x4 o = *(const LAS u32x4*)(lds + c * 80 + part * 16);
        *(u32x4*)(Vt8 + ((size_t)(b * 2 + kvh) * 128 + c) * SEQ + ch * 64 + part * 16) = o;
    }
    __syncthreads();
}
__device__ __forceinline__ void phase_k8_copy(const bf16_t* H, int ldh, int col0, unsigned char* K8, int G, int bid, int tid) {
    for (size_t i = (size_t)bid * NTHR + tid; i < (size_t)T_ * 128; i += (size_t)G * NTHR) { const size_t m = i >> 7; const int c = (int)(i & 127) * 8;
        const u32x4 v = *(const u32x4*)(H + m * ldh + col0 + c);
        *(u32x2*)(K8 + m * 1024 + c) = (u32x2){pk4_fp8(bflo(v.x), bfhi(v.x), bflo(v.y), bfhi(v.y)), pk4_fp8(bflo(v.z), bfhi(v.z), bflo(v.w), bfhi(v.w))}; }
}
__device__ __forceinline__ void tr4x4(unsigned w0, unsigned w1, unsigned w2, unsigned w3, unsigned (&o)[4]) {
    const unsigned a_lo = __builtin_amdgcn_perm(w1, w0, 0x05010400u), a_hi = __builtin_amdgcn_perm(w1, w0, 0x07030602u);
    const unsigned b_lo = __builtin_amdgcn_perm(w3, w2, 0x05010400u), b_hi = __builtin_amdgcn_perm(w3, w2, 0x07030602u);
    o[0] = __builtin_amdgcn_perm(b_lo, a_lo, 0x05040100u); o[1] = __builtin_amdgcn_perm(b_lo, a_lo, 0x07060302u);
    o[2] = __builtin_amdgcn_perm(b_hi, a_hi, 0x05040100u); o[3] = __builtin_amdgcn_perm(b_hi, a_hi, 0x07060302u);
}
template <bool DIL>
__device__ __forceinline__ void phase_vt_heads(const unsigned char* V8, unsigned char* Vt1, unsigned char* Vt4, unsigned char* Vt16, LAS unsigned char* lds, int G, int bid, int tid) {
    constexpr int PITCH = 272, IMG = 128 * PITCH;
    const int cb = tid & 31, tq = tid >> 5;
    for (int u = bid; u < 1024; u += G) {
        const int b = u >> 7, h = (u >> 4) & 7, ch = u & 15;
        const unsigned char* src = V8 + (size_t)(b * SEQ + 256 * ch) * 1024 + h * 128 + 4 * cb;
        __syncthreads();
#pragma unroll
        for (int k = 0; k < 4; ++k) { const int tg = tq + 16 * k;
            unsigned o[4];
            { const int t0 = 4 * tg;
              tr4x4(*(const unsigned*)(src + (size_t)(t0 + 0) * 1024), *(const unsigned*)(src + (size_t)(t0 + 1) * 1024), *(const unsigned*)(src + (size_t)(t0 + 2) * 1024), *(const unsigned*)(src + (size_t)(t0 + 3) * 1024), o);
#pragma unroll
              for (int j = 0; j < 4; ++j) *(LAS unsigned*)(lds + (4 * cb + j) * PITCH + 4 * tg) = o[j]; }
            if constexpr (DIL) {
                { const int r = tg & 3, g = tg >> 2; const int t0 = r + 16 * g;
                  tr4x4(*(const unsigned*)(src + (size_t)(t0 + 0) * 1024), *(const unsigned*)(src + (size_t)(t0 + 4) * 1024), *(const unsigned*)(src + (size_t)(t0 + 8) * 1024), *(const unsigned*)(src + (size_t)(t0 + 12) * 1024), o);
#pragma unroll
                  for (int j = 0; j < 4; ++j) *(LAS unsigned*)(lds + IMG + (4 * cb + j) * PITCH + r * 64 + 4 * g) = o[j]; }
                { const int cls = tg & 15, g = tg >> 4; const int t0 = cls + 64 * g;
                  tr4x4(*(const unsigned*)(src + (size_t)(t0 + 0) * 1024), *(const unsigned*)(src + (size_t)(t0 + 16) * 1024), *(const unsigned*)(src + (size_t)(t0 + 32) * 1024), *(const unsigned*)(src + (size_t)(t0 + 48) * 1024), o);
#pragma unroll
                  for (int j = 0; j < 4; ++j) *(LAS unsigned*)(lds + 2 * IMG + (4 * cb + j) * PITCH + cls * 16 + 4 * g) = o[j]; }
            }
        }
        __syncthreads();
        const size_t cbase = (size_t)(b * 8 + h) * 128;
#pragma unroll
        for (int k = 0; k < 4; ++k) { const int id = tid + NTHR * k, col = id >> 4, pc = id & 15;
            *(u32x4*)(Vt1 + (cbase + col) * SEQ + 256 * ch + pc * 16) = *(const LAS u32x4*)(lds + col * PITCH + pc * 16);
            if constexpr (DIL) {
                *(u32x4*)(Vt4 + (cbase + col) * SEQ + (pc >> 2) * 1024 + 64 * ch + (pc & 3) * 16) = *(const LAS u32x4*)(lds + IMG + col * PITCH + pc * 16);
                *(u32x4*)(Vt16 + (cbase + col) * SEQ + pc * 256 + 16 * ch) = *(const LAS u32x4*)(lds + 2 * IMG + col * PITCH + pc * 16); } }
    }
    __syncthreads();
}
__device__ __forceinline__ void phase_prep_mla(bf16_t* H1, bf16_t* krope, unsigned char* kr8, int G, int bid, int tid) {
    const int wid = __builtin_amdgcn_readfirstlane(tid >> 6), lane = tid & 63;
    const float invf = inv_freq32(lane & 31);
    for (int m = bid * 8 + wid; m < T_; m += G * 8) {
        bf16_t* rowp = H1 + (size_t)m * IN1P;
        const u32x4 a = *(const u32x4*)(rowp + 3072 + lane * 8);
        float ss = bflo(a.x) * bflo(a.x) + bfhi(a.x) * bfhi(a.x) + bflo(a.y) * bflo(a.y) + bfhi(a.y) * bfhi(a.y) + bflo(a.z) * bflo(a.z) + bfhi(a.z) * bfhi(a.z) + bflo(a.w) * bflo(a.w) + bfhi(a.w) * bfhi(a.w);
        ss = wave_sum(ss);
        const u32x2 c = *(const u32x2*)(rowp + 3584 + lane * 4);
        float s2 = bflo(c.x) * bflo(c.x) + bfhi(c.x) * bfhi(c.x) + bflo(c.y) * bflo(c.y) + bfhi(c.y) * bfhi(c.y);
        s2 = wave_sum(s2);
        const float rq = rsqrtf(ss * (1.0f / 512.0f) + 1e-6f), rkv = rsqrtf(s2 * (1.0f / 256.0f) + 1e-6f);
        if constexpr (F8_P3 != 0) {
            *(u32x2*)((unsigned char*)(rowp + 3072) + lane * 8) = (u32x2){pk4_fp8(bflo(a.x) * rq, bfhi(a.x) * rq, bflo(a.y) * rq, bfhi(a.y) * rq), pk4_fp8(bflo(a.z) * rq, bfhi(a.z) * rq, bflo(a.w) * rq, bfhi(a.w) * rq)};
            *(unsigned*)((unsigned char*)(rowp + 3584) + lane * 4) = pk4_fp8(bflo(c.x) * rkv, bfhi(c.x) * rkv, bflo(c.y) * rkv, bfhi(c.y) * rkv); }
        else {
        *(u32x4*)(rowp + 3072 + lane * 8) = (u32x4){cvtpk(bflo(a.x) * rq, bfhi(a.x) * rq), cvtpk(bflo(a.y) * rq, bfhi(a.y) * rq), cvtpk(bflo(a.z) * rq, bfhi(a.z) * rq), cvtpk(bflo(a.w) * rq, bfhi(a.w) * rq)};
        *(u32x2*)(rowp + 3584 + lane * 4) = (u32x2){cvtpk(bflo(c.x) * rkv, bfhi(c.x) * rkv), cvtpk(bflo(c.y) * rkv, bfhi(c.y) * rkv)}; }
        if (lane < 32) { const float x1 = bf2f(rowp[3840 + lane]), x2 = bf2f(rowp[3840 + 32 + lane]);
            float sn, cs; sincos_rev((float)(m & (SEQ - 1)) * invf, sn, cs);
            const float o1 = x1 * cs - x2 * sn, o2 = x2 * cs + x1 * sn;
            krope[(size_t)m * 64 + lane] = f2bf(o1); krope[(size_t)m * 64 + 32 + lane] = f2bf(o2);
            if (F8_ATTD) { kr8[(size_t)m * 64 + lane] = f2fp8(o1); kr8[(size_t)m * 64 + 32 + lane] = f2fp8(o2); } }
    }
}

constexpr int LNR_PITCH = 2052;
constexpr int LNR_PART = 131584, LNR_SC = 147968, LNR_SEL = 150016, LNR_BLE = 152064, LNR_HIST = 153088;
template <bool RES_F32>
__device__ __forceinline__ void phase_ln_router(const bf16_t* mix, const void* res, const float* g, const float* bb, const float* rw, const float* rb, bf16_t* x1b, unsigned char* x1q,
                                                int* tok_e, int* tok_p, float* tok_g, int* list, unsigned* cnt, LAS unsigned char* lds, int G, int bid, int tid, bool commit = true) {
    const int wid = __builtin_amdgcn_readfirstlane(tid >> 6), lane = tid & 63;
    float ALPHA = 1.4142135623730951f; asm volatile("" : "+v"(ALPHA));
    LAS float* xs = (LAS float*)lds; LAS float* part = (LAS float*)(lds + LNR_PART); LAS float* scs = (LAS float*)(lds + LNR_SC); LAS float* sels = (LAS float*)(lds + LNR_SEL);
    LAS int* ble = (LAS int*)(lds + LNR_BLE); LAS int* hist = (LAS int*)(lds + LNR_HIST);
    f16x8 bw[8][2];
    { const float* rwp = rw + (size_t)(256 * wid + 8 * (lane >> 4)) * 32 + (lane & 15);
#pragma unroll
      for (int ks = 0; ks < 8; ++ks)
#pragma unroll
        for (int hf = 0; hf < 2; ++hf)
#pragma unroll
          for (int j = 0; j < 8; ++j) bw[ks][hf][j] = (_Float16)rwp[(32 * ks + j) * 32 + 16 * hf]; }
    typedef typename std::conditional<RES_F32, f32x4, u32x2>::type res_t;
    typedef typename std::conditional<F8_MIX != 0, unsigned, u32x2>::type mix_t;
    mix_t mv[2][8]; res_t rv[2][8];
#define LNR_LOAD(tix_, rr) do { const size_t eo = ((size_t)(tix_) * 16 + 2 * wid + (rr)) * DM + 4 * lane; \
        _Pragma("unroll") for (int i = 0; i < 8; ++i) { if constexpr (F8_MIX != 0) mv[rr][i] = *(const mix_t*)((const unsigned char*)mix + eo + 256 * i); else mv[rr][i] = *(const mix_t*)(mix + eo + 256 * i); \
            if constexpr (RES_F32) rv[rr][i] = *(const res_t*)((const float*)res + eo + 256 * i); else rv[rr][i] = *(const res_t*)((const bf16_t*)res + eo + 256 * i); } } while (0)
    const int ntile = T_ / 16;
    int ntl = 0;
    if (bid < ntile) LNR_LOAD(bid, 0);
    const int lane0 = lane;
    for (int it = 0; bid + G * it < ntile; ++it) {
        const int tix = bid + G * it;
        int lane = lane0; asm volatile("" : "+v"(lane));
#pragma unroll
        for (int rr = 0; rr < 2; ++rr) {
            const int row = 2 * wid + rr; const size_t m = (size_t)tix * 16 + row;
            f32x4 zr[8]; float s = 0.f;
#pragma unroll
            for (int i = 0; i < 8; ++i) { f32x4 mx;
                if constexpr (F8_MIX != 0) { const int mw = (int)*(const unsigned*)&mv[rr][i]; const f32x2 m0 = __builtin_amdgcn_cvt_pk_f32_fp8(mw, false), m1 = __builtin_amdgcn_cvt_pk_f32_fp8(mw, true);
                    mx = (f32x4){m0[0], m0[1], m1[0], m1[1]} * (1.0f / 16.f); }
                else { const u32x2 mb = *(const u32x2*)&mv[rr][i]; mx = (f32x4){bflo(mb.x), bfhi(mb.x), bflo(mb.y), bfhi(mb.y)}; }
                f32x4 rx;
                if constexpr (RES_F32) rx = rv[rr][i]; else { const u32x2 rb2 = rv[rr][i]; rx = (f32x4){bflo(rb2.x), bfhi(rb2.x), bflo(rb2.y), bfhi(rb2.y)}; }
                zr[i] = ALPHA * rx + mx; s += (zr[i][0] + zr[i][1]) + (zr[i][2] + zr[i][3]); }
            if (rr == 0) { __builtin_amdgcn_sched_barrier(0); LNR_LOAD(tix, 1); __builtin_amdgcn_sched_barrier(0); }
            const float mean = wave_sum(s) * (1.0f / DM); float q = 0.f;
#pragma unroll
            for (int i = 0; i < 8; ++i) { const f32x4 d = zr[i] - mean; q += (d[0] * d[0] + d[1] * d[1]) + (d[2] * d[2] + d[3] * d[3]); }
            const float rstd = rsqrtf(wave_sum(q) * (1.0f / DM) + 1e-5f);
            f32x4 gv = *(const f32x4*)(g + 4 * lane), bv = *(const f32x4*)(bb + 4 * lane);
#pragma unroll
            for (int i = 0; i < 8; ++i) { const int col = 4 * lane + 256 * i; f32x4 gn = gv, bn = bv;
                if (i < 7) { gn = *(const f32x4*)(g + col + 256); bn = *(const f32x4*)(bb + col + 256); }
                __builtin_amdgcn_sched_barrier(0);
                const f32x4 y = (zr[i] - mean) * rstd * gv + bv;
                LAS f32x2* xp = (LAS f32x2*)(xs + row * LNR_PITCH + col); xp[0] = (f32x2){y[0], y[1]}; xp[1] = (f32x2){y[2], y[3]};
                *(u32x2*)(x1b + m * DM + col) = (u32x2){cvtpk(y[0], y[1]), cvtpk(y[2], y[3])};
                if constexpr (F8_GU) *(unsigned*)(x1q + m * DM + col) = pk4_fp8(y[0], y[1], y[2], y[3]);
                __builtin_amdgcn_sched_barrier(0);
                gv = gn; bv = bn; }
        }
        __builtin_amdgcn_sched_barrier(0);
        if (tix + G < ntile) LNR_LOAD(tix + G, 0);
        __builtin_amdgcn_sched_barrier(0);
        __syncthreads();
        { f32x4 acc0 = {0.f, 0.f, 0.f, 0.f}, acc1 = {0.f, 0.f, 0.f, 0.f}; const LAS float* xa = xs + (lane & 15) * LNR_PITCH + 256 * wid + 8 * (lane >> 4); const int e = lane & 15;
#pragma unroll
          for (int ks = 0; ks < 8; ++ks) { const f32x4 xa0 = *(const LAS f32x4*)(xa + 32 * ks), xa1 = *(const LAS f32x4*)(xa + 32 * ks + 4);
              const float xv[8] = {xa0[0], xa0[1], xa0[2], xa0[3], xa1[0], xa1[1], xa1[2], xa1[3]}; f16x8 ah, al;
#pragma unroll
              for (int j = 0; j < 8; ++j) { const _Float16 hh = (_Float16)xv[j]; ah[j] = hh; al[j] = (_Float16)(xv[j] - (float)hh); }
              acc0 = __builtin_amdgcn_mfma_f32_16x16x32_f16(ah, bw[ks][0], acc0, 0, 0, 0); acc1 = __builtin_amdgcn_mfma_f32_16x16x32_f16(ah, bw[ks][1], acc1, 0, 0, 0);
              acc0 = __builtin_amdgcn_mfma_f32_16x16x32_f16(al, bw[ks][0], acc0, 0, 0, 0); acc1 = __builtin_amdgcn_mfma_f32_16x16x32_f16(al, bw[ks][1], acc1, 0, 0, 0); }
          __builtin_amdgcn_sched_barrier(0);
          __builtin_amdgcn_sched_barrier(0);
#pragma unroll
          for (int r = 0; r < 4; ++r) { const int row = (lane >> 4) * 4 + r; part[(wid * 16 + row) * 32 + e] = acc0[r]; part[(wid * 16 + row) * 32 + 16 + e] = acc1[r]; } }
        __syncthreads();
        { const int row = tid >> 5, e = tid & 31; float lg = 0.f;
#pragma unroll
          for (int w = 0; w < 8; ++w) lg += part[(w * 16 + row) * 32 + e];
          const float sc = 1.0f / (1.0f + __expf(-lg)); scs[row * 32 + e] = sc; sels[row * 32 + e] = sc + rb[e]; }
        __syncthreads();
        if (tid < 16) { const int row = tid; float best = -INFINITY; int bg = 0;
            for (int gI = 0; gI < 8; ++gI) { const float a = sels[row * 32 + 4 * gI], b = sels[row * 32 + 4 * gI + 1], c = sels[row * 32 + 4 * gI + 2], d = sels[row * 32 + 4 * gI + 3];
                const float h1 = fmaxf(a, b), l1 = fminf(a, b), h2 = fmaxf(c, d), l2 = fminf(c, d); const float gs = fmaxf(h1, h2) + fmaxf(fminf(h1, h2), fmaxf(l1, l2));
                if (gs > best) { best = gs; bg = gI; } }
            const float v0 = sels[row * 32 + 4 * bg], v1 = sels[row * 32 + 4 * bg + 1], v2 = sels[row * 32 + 4 * bg + 2], v3 = sels[row * 32 + 4 * bg + 3];
            int i1 = 0; float b1v = v0; if (v1 > b1v) { b1v = v1; i1 = 1; } if (v2 > b1v) { b1v = v2; i1 = 2; } if (v3 > b1v) { b1v = v3; i1 = 3; }
            int i2 = -1; float b2v = -INFINITY;
            if (i1 != 0 && v0 > b2v) { b2v = v0; i2 = 0; } if (i1 != 1 && v1 > b2v) { b2v = v1; i2 = 1; } if (i1 != 2 && v2 > b2v) { b2v = v2; i2 = 2; } if (i1 != 3 && v3 > b2v) { b2v = v3; i2 = 3; }
            const int e1 = 4 * bg + i1, e2 = 4 * bg + i2; const float s1 = scs[row * 32 + e1], s2 = scs[row * 32 + e2]; const float inv = 1.0f / (s1 + s2);
            const int m = tix * 16 + row;
            tok_e[2 * m] = e1; tok_e[2 * m + 1] = e2; tok_g[2 * m] = s1 * inv; tok_g[2 * m + 1] = s2 * inv;
            ble[(it * 16 + row) * 2] = e1; ble[(it * 16 + row) * 2 + 1] = e2; }
        __syncthreads();
        ntl = it + 1;
    }
#undef LNR_LOAD
    const int nasg = commit ? ntl * 32 : 0;
    if (tid < 32) { int c = 0; for (int i = 0; i < nasg; ++i) c += (ble[i] == tid) ? 1 : 0;
        unsigned base = 0; if (c) base = __hip_atomic_fetch_add(cnt + tid, (unsigned)c, __ATOMIC_RELAXED, __HIP_MEMORY_SCOPE_AGENT);
        hist[tid] = (int)base; }
    __syncthreads();
    if (tid < 32) { int run = hist[tid];
        for (int i = 0; i < nasg; ++i) if (ble[i] == tid) { const int tr = i >> 1; const size_t m = (size_t)(bid + G * (tr >> 4)) * 16 + (tr & 15);
            list[(size_t)tid * 65536 + run] = (int)m; tok_p[2 * m + (i & 1)] = run; ++run; } }
    __syncthreads();
}

constexpr int MOE_LDS = 131072;
__device__ __forceinline__ int moe_prefix(const unsigned* cnt, LAS int* pblk, int tid) {
    if (tid == 0) { int acc = 0; for (int e = 0; e < NE; ++e) { pblk[e] = acc; acc += ((int)cnt[e] + 255) >> 8; } pblk[NE] = acc; }
    __syncthreads();
    return pblk[NE];
}
template <int NJ> __device__ __forceinline__ int moe_table(const unsigned* cnt, LAS int* pblk, LAS int* tab, LAS int* aux, int NB, int G, int bid, int tid) {
    const int NU = NB * NJ;
    if (tid < 16) { const int L = bid + G * tid;
        if (L < NU) { const int rb = L / NJ, j = L % NJ; int e = 0; for (int q = 1; q < NE; ++q) if (pblk[q] <= rb) e = q;
            tab[tid] = rb; tab[16 + tid] = NJ * e + j; aux[tid * 3] = e; aux[tid * 3 + 1] = (rb - pblk[e]) * 256; aux[tid * 3 + 2] = (int)cnt[e]; } }
    __syncthreads();
    int n = 0; for (int i = 0; i < 16; ++i) if (bid + G * i < NU) n = i + 1;
    return n;
}

template <bool FINAL>
__device__ __forceinline__ void phase_combine_ln(const float* dbg, const bf16_t* x1b, const bf16_t* Yr, const int* tok_e, const int* tok_p, const float* tok_g, const unsigned* cnt,
                                                 const float* g, const float* bb, bf16_t* xo, unsigned char* xq, float* fo, LAS unsigned char* lds, int G, int bid, int tid) {
    LAS int* pblk = (LAS int*)lds;
    moe_prefix(cnt, pblk, tid);
    const int wid = __builtin_amdgcn_readfirstlane(tid >> 6), lane = tid & 63;
    float ALPHA = 1.4142135623730951f; asm volatile("" : "+v"(ALPHA));
#if DBG_CHECK
    const bool dbg_bad = FINAL && (!(dbg[0] <= DBG_TOL * DBG_TOL * dbg[1]) || !(dbg[2] <= DBG_TOL * DBG_TOL * dbg[3]) || !(dbg[1] > 0.f) || !(dbg[3] > 0.f) ||
                                    !(dbg[4] <= DBG_TOL * DBG_TOL * dbg[5]) || !(dbg[6] <= DBG_TOL * DBG_TOL * dbg[7]) || !(dbg[5] > 0.f) || !(dbg[7] > 0.f) ||
                                    !(dbg[8] <= DBG_TOL_SP * DBG_TOL_SP * dbg[9]) || !(dbg[10] <= DBG_TOL_SP * DBG_TOL_SP * dbg[11]) || !(dbg[9] > 0.f) || !(dbg[11] > 0.f));
#endif
    static_assert(F8_YR, "the pipelined combine reads e4m3 expert rows");
    struct Meta { size_t p0, p1; float h0, h1; };
    struct Rows { u32x4 xa[4]; u32x2 ya[4], yb[4]; };
#define CMB_META(mm, M) do { const int _e0 = tok_e[2 * (mm)], _e1 = tok_e[2 * (mm) + 1]; (M).p0 = (size_t)pblk[_e0] * 256 + tok_p[2 * (mm)]; (M).p1 = (size_t)pblk[_e1] * 256 + tok_p[2 * (mm) + 1]; \
        (M).h0 = tok_g[2 * (mm)] * (1.0f / 16.0f); (M).h1 = tok_g[2 * (mm) + 1] * (1.0f / 16.0f); } while (0)
#define CMB_ROWS(mm, M, R) do { _Pragma("unroll") for (int i = 0; i < 4; ++i) { const int col = 8 * lane + 512 * i; (R).xa[i] = *(const u32x4*)(x1b + (size_t)(mm) * DM + col); \
        (R).ya[i] = *(const u32x2*)((const unsigned char*)Yr + (M).p0 * DM + col); (R).yb[i] = *(const u32x2*)((const unsigned char*)Yr + (M).p1 * DM + col); } } while (0)
    const int mstep = G * 8, m0 = bid * 8 + wid;
    Meta Mc, Mn; Rows Rc, Rn;
    Mc.p0 = Mc.p1 = 0; Mc.h0 = Mc.h1 = 0.f; Mn = Mc;
    if (m0 < T_) { CMB_META(m0, Mc); CMB_ROWS(m0, Mc, Rc); }
    if (m0 + mstep < T_) CMB_META(m0 + mstep, Mn);
    Rn = Rc;
    for (int m = m0; m < T_; m += mstep) {
        Meta Mnn = Mn;
        if (m + mstep < T_) CMB_ROWS(m + mstep, Mn, Rn);
        if (m + 2 * mstep < T_) CMB_META(m + 2 * mstep, Mnn);
        const float h0 = Mc.h0, h1 = Mc.h1;
        float v[32]; float s = 0.f;
#pragma unroll
        for (int i = 0; i < 4; ++i) {
            const unsigned xw[4] = {Rc.xa[i].x, Rc.xa[i].y, Rc.xa[i].z, Rc.xa[i].w}; const unsigned aw[2] = {Rc.ya[i].x, Rc.ya[i].y}, bw[2] = {Rc.yb[i].x, Rc.yb[i].y};
#define CMB_PAIR(j, W, SEL) do { const f32x2 a2 = __builtin_amdgcn_cvt_pk_f32_fp8((int)aw[W], SEL), b2 = __builtin_amdgcn_cvt_pk_f32_fp8((int)bw[W], SEL); \
                    v[i * 8 + 2 * (j)] = ALPHA * bflo(xw[j]) + h0 * a2[0] + h1 * b2[0]; v[i * 8 + 2 * (j) + 1] = ALPHA * bfhi(xw[j]) + h0 * a2[1] + h1 * b2[1]; \
                    s += v[i * 8 + 2 * (j)] + v[i * 8 + 2 * (j) + 1]; } while (0)
            CMB_PAIR(0, 0, false); CMB_PAIR(1, 0, true); CMB_PAIR(2, 1, false); CMB_PAIR(3, 1, true);
#undef CMB_PAIR
        }
        Mc = Mn; Mn = Mnn; Rc = Rn;
        const float mean = wave_sum(s) * (1.0f / DM); float q = 0.f;
#pragma unroll
        for (int i = 0; i < 32; ++i) { const float d = v[i] - mean; q += d * d; }
        const float rstd = rsqrtf(wave_sum(q) * (1.0f / DM) + 1e-5f);
#pragma unroll
        for (int i = 0; i < 4; ++i) { const int col = 8 * lane + 512 * i;
            const f32x4 ga = *(const f32x4*)(g + col), gb = *(const f32x4*)(g + col + 4), ba = *(const f32x4*)(bb + col), bbv = *(const f32x4*)(bb + col + 4);
            float y[8];
#pragma unroll
            for (int j = 0; j < 4; ++j) { y[j] = (v[i * 8 + j] - mean) * rstd * ga[j] + ba[j]; y[4 + j] = (v[i * 8 + 4 + j] - mean) * rstd * gb[j] + bbv[j]; }
#if DBG_CHECK
            if (dbg_bad) { for (int j = 0; j < 8; ++j) y[j] = 0.f; }
#endif
            if constexpr (FINAL) { *(f32x4*)(fo + (size_t)m * DM + col) = (f32x4){y[0], y[1], y[2], y[3]}; *(f32x4*)(fo + (size_t)m * DM + col + 4) = (f32x4){y[4], y[5], y[6], y[7]}; }
            else { *(u32x4*)(xo + (size_t)m * DM + col) = (u32x4){cvtpk(y[0], y[1]), cvtpk(y[2], y[3]), cvtpk(y[4], y[5]), cvtpk(y[6], y[7])};
                if constexpr (F8_IN) *(u32x2*)(xq + (size_t)m * DM + col) = (u32x2){pk4_fp8(y[0], y[1], y[2], y[3]), pk4_fp8(y[4], y[5], y[6], y[7])}; } }
    }
#undef CMB_META
#undef CMB_ROWS
}

#if DBG_CHECK
__device__ __forceinline__ void dbg_attn_check(int which, const bf16_t* Hx, const bf16_t* Qd, const bf16_t* KVd, const bf16_t* krope, const void* Oat, float* dbg, LAS unsigned char* lds, int bid, int tid) {
    const int wid = __builtin_amdgcn_readfirstlane(tid >> 6), lane = tid & 63;
    LAS float* sc = (LAS float*)lds + wid * 4096;
    LAS float* qs = (LAS float*)(lds + 131072) + wid * 192;
    const unsigned sid = (unsigned)(bid * 8 + wid);
    const int m = (int)((sid * 2654435761u) % (unsigned)T_), h = (int)(sid & 7u), b = m >> 12, pos = m & (SEQ - 1);
    const int DQ = which ? 192 : 128; const float scale = which ? 0.072168783648703220f : 0.088388347648318440f;
    for (int d = lane; d < DQ; d += 64) {
        float qv;
        if (which == 0) qv = bf2f(Hx[(size_t)m * IN0 + h * 128 + d]);
        else if (d < 128) qv = bf2f(Qd[(size_t)m * 1536 + h * 192 + d]);
        else { const int i = (d - 128) & 31; const float x1 = bf2f(Qd[(size_t)m * 1536 + h * 192 + 128 + i]), x2 = bf2f(Qd[(size_t)m * 1536 + h * 192 + 160 + i]);
            float sn, cs; sincos_rev((float)pos * inv_freq32(i), sn, cs); qv = (d < 160) ? (x1 * cs - x2 * sn) : (x2 * cs + x1 * sn); }
        qs[d] = qv; }
    asm volatile("s_waitcnt lgkmcnt(0)" ::: "memory");
    float mx = -INFINITY;
    for (int i = 0; i < 64; ++i) { const int j = lane + 64 * i; float dot = 0.f;
        if (which == 0) { const bf16_t* kp = Hx + (size_t)(b * SEQ + j) * IN0 + 1024 + (h >> 2) * 128; for (int d = 0; d < 128; ++d) dot += qs[d] * bf2f(kp[d]); }
        else { const bf16_t* kp = KVd + (size_t)(b * SEQ + j) * DM + h * 256; for (int d = 0; d < 128; ++d) dot += qs[d] * bf2f(kp[d]);
               const bf16_t* rp = krope + (size_t)(b * SEQ + j) * 64; for (int d = 0; d < 64; ++d) dot += qs[128 + d] * bf2f(rp[d]); }
        dot *= scale; sc[j] = dot; mx = fmaxf(mx, dot); }
    mx = wave_max(mx);
    float sum = 0.f;
    for (int i = 0; i < 64; ++i) { const int j = lane + 64 * i; const float pj = __expf(sc[j] - mx); sc[j] = pj; sum += pj; }
    sum = wave_sum(sum);
    asm volatile("s_waitcnt lgkmcnt(0)" ::: "memory");
    float e2 = 0.f, r2 = 0.f;
    for (int cc = 0; cc < 2; ++cc) { const int c = lane + 64 * cc; float acc = 0.f;
        for (int j = 0; j < SEQ; ++j) { const float vv = which == 0 ? bf2f(Hx[(size_t)(b * SEQ + j) * IN0 + 1280 + (h >> 2) * 128 + c]) : bf2f(KVd[(size_t)(b * SEQ + j) * DM + h * 256 + 128 + c]); acc += sc[j] * vv; }
        const float ref = acc / sum; const size_t eo = (size_t)m * DM + (which ? 1024 : 0) + h * 128 + c;
        float got; if (F8_OUT) { const unsigned char by = ((const unsigned char*)Oat)[eo]; const f32x2 g2 = __builtin_amdgcn_cvt_pk_f32_fp8((int)by, false); got = g2[0] * (1.0f / O8_SCALE); } else got = bf2f(((const bf16_t*)Oat)[eo]);
        e2 += (got - ref) * (got - ref); r2 += ref * ref; }
    e2 = wave_sum(e2); r2 = wave_sum(r2);
    if (lane == 0) { atomicAdd(dbg + 2 * which, e2); atomicAdd(dbg + 2 * which + 1, r2); }
}
#endif
#if DBG_CHECK
__device__ __forceinline__ void dbg_sparse_check(int L, const bf16_t* Hx, const unsigned char* K8r, const unsigned char* V8r, const float* rpb, const void* Oat, float* dbg, LAS unsigned char* lds, int bid, int tid) {
    const int wid = __builtin_amdgcn_readfirstlane(tid >> 6), lane = tid & 63;
    LAS float* sc = (LAS float*)lds + wid * 1024; LAS int* kt = (LAS int*)(lds + 65536) + wid * 1024; LAS float* qs = (LAS float*)(lds + 131072) + wid * 128;
    const unsigned sid = (unsigned)(bid * 8 + wid);
    const int m = (int)((sid * 2654435761u + 12345u) % (unsigned)T_), h = (int)((sid >> 3) & 7u), b = m >> 12, pos = m & (SEQ - 1);
    const int ldh = L ? IN1P : IN0, qoff = L ? h * 128 : 1536 + h * 128;
    for (int d = lane; d < 128; d += 64) qs[d] = bf2f(Hx[(size_t)m * ldh + qoff + d]);
    int nk;
    if (L == 0) { nk = 387; const float slope = __builtin_amdgcn_exp2f(-(float)(h + 1));
        for (int idx = lane; idx < nk; idx += 64) { const int br = idx / 129, dd = idx % 129 - 64, dil = br == 0 ? 1 : (br == 1 ? 4 : 16), rd = pos % dil, kd = pos / dil + dd;
            const bool ok = kd >= 0 && kd < SEQ / dil; kt[idx] = ok ? b * SEQ + kd * dil + rd : -1; sc[idx] = -slope * (float)dil * (float)(dd < 0 ? -dd : dd); } }
    else { nk = 128; const int r = pos >> 6, qc = pos & 63, r0 = min(max(r - 4, 0), 56), c0 = min(max(qc - 8, 0), 48);
        for (int idx = lane; idx < nk; idx += 64) { const int kr = r0 + (idx >> 4), kc = c0 + (idx & 15); kt[idx] = b * SEQ + kr * 64 + kc; sc[idx] = rpb[h * 465 + (kr - r + 7) * 31 + (kc - qc + 15)]; } }
    asm volatile("s_waitcnt lgkmcnt(0)" ::: "memory");
    float mx = -INFINITY;
    for (int idx = lane; idx < nk; idx += 64) { float sv = -INFINITY; const int t = kt[idx];
        if (t >= 0) { const unsigned char* kp = K8r + (size_t)t * 1024 + h * 128; float dot = 0.f;
            for (int d = 0; d < 128; ++d) { const f32x2 kv = __builtin_amdgcn_cvt_pk_f32_fp8((int)kp[d], false); dot += qs[d] * kv[0]; }
            sv = dot * 0.088388347648318440f + sc[idx]; }
        sc[idx] = sv; mx = fmaxf(mx, sv); }
    mx = wave_max(mx);
    float sum = 0.f;
    for (int idx = lane; idx < nk; idx += 64) { const float pj = __expf(sc[idx] - mx); sc[idx] = pj; sum += pj; }
    sum = wave_sum(sum);
    asm volatile("s_waitcnt lgkmcnt(0)" ::: "memory");
    float e2 = 0.f, r2 = 0.f;
    for (int cc = 0; cc < 2; ++cc) { const int c = lane + 64 * cc; float acc = 0.f;
        for (int idx = 0; idx < nk; ++idx) { const int t = kt[idx]; if (t >= 0) { const f32x2 vv = __builtin_amdgcn_cvt_pk_f32_fp8((int)V8r[(size_t)t * 1024 + h * 128 + c], false); acc += sc[idx] * vv[0]; } }
        const float ref = acc / sum; const size_t eo = (size_t)m * DM + (L ? 0 : 1024) + h * 128 + c;
        float got; if (F8_OUT) { const unsigned char by = ((const unsigned char*)Oat)[eo]; const f32x2 g2 = __builtin_amdgcn_cvt_pk_f32_fp8((int)by, false); got = g2[0] * (1.0f / O8_SCALE); } else got = bf2f(((const bf16_t*)Oat)[eo]);
        e2 += (got - ref) * (got - ref); r2 += ref * ref; }
    e2 = wave_sum(e2); r2 = wave_sum(r2);
    if (lane == 0) { atomicAdd(dbg + 8 + 2 * L, e2); atomicAdd(dbg + 9 + 2 * L, r2); }
}
#endif
#if DBG_CHECK
__device__ __forceinline__ void dbg_prep_check(int L, const float* xf, const bf16_t* xb2, const float* win, const float* gq, const float* gk, const bf16_t* H, const bf16_t* krope, float* dbg, LAS unsigned char* lds, int bid, int tid) {
    const int wid = __builtin_amdgcn_readfirstlane(tid >> 6), lane = tid & 63;
    const unsigned sid = (unsigned)(bid * 8 + wid);
    const int m = (int)((sid * 2246822519u) % (unsigned)T_); const int sq = m & (SEQ - 1);
    float e2 = 0.f, r2 = 0.f;
    if (L == 0) {
        const int hh = (int)(sid % 10u); const int colbase = hh < 8 ? hh * 128 : 1024 + (hh - 8) * 128; const float* gain = hh < 8 ? gq : gk;
        float a0 = 0.f, a1 = 0.f;
        for (int k = 0; k < DM; ++k) { const float xv = xf[(size_t)m * DM + k]; a0 += xv * win[(size_t)k * IN0 + colbase + lane]; a1 += xv * win[(size_t)k * IN0 + colbase + 64 + lane]; }
        const float ms = wave_sum(a0 * a0 + a1 * a1) * (1.0f / 128.0f); const float r = rsqrtf(ms + 1e-6f);
        const float y0 = a0 * r * gain[lane], y1 = a1 * r * gain[64 + lane];
        LAS float* ys = (LAS float*)lds + wid * 128; ys[lane] = y0; ys[64 + lane] = y1; asm volatile("s_waitcnt lgkmcnt(0)" ::: "memory");
#pragma unroll
        for (int q = 0; q < 2; ++q) { const int e = lane + 64 * q, hf = e >> 6, i = e & 31; const bool x2p = (e & 32) != 0;
            const float pos = (float)(hf ? (sq & 63) : (sq >> 6)); float sn, cs; sincos_rev(pos * inv_freq32(i), sn, cs);
            const float mine = ys[e], other = ys[e ^ 32];
            const float ref = x2p ? (mine * cs + other * sn) : (mine * cs - other * sn);
            const float got = bf2f(H[(size_t)m * IN0 + colbase + e]);
            e2 += (got - ref) * (got - ref); r2 += ref * ref; }
    } else {
        float acq[8] = {0.f, 0.f, 0.f, 0.f, 0.f, 0.f, 0.f, 0.f}; float akr = 0.f;
        for (int k = 0; k < DM; ++k) { const float xv = bf2f(xb2[(size_t)m * DM + k]); const float* wr = win + (size_t)k * IN1;
#pragma unroll
            for (int j = 0; j < 8; ++j) acq[j] += xv * wr[3072 + lane + 64 * j];
            akr += xv * wr[3840 + lane]; }
        float ss = 0.f;
#pragma unroll
        for (int j = 0; j < 8; ++j) ss += acq[j] * acq[j];
        const float r = rsqrtf(wave_sum(ss) * (1.0f / 512.0f) + 1e-6f);
#pragma unroll
        for (int j = 0; j < 8; ++j) { const float ref = acq[j] * r; float got; if (F8_P3) { const f32x2 g2 = __builtin_amdgcn_cvt_pk_f32_fp8((int)((const unsigned char*)(H + (size_t)m * IN1P + 3072))[lane + 64 * j], false); got = g2[0]; } else got = bf2f(H[(size_t)m * IN1P + 3072 + lane + 64 * j]);
            e2 += (got - ref) * (got - ref); r2 += ref * ref; }
        LAS float* ys = (LAS float*)lds + wid * 128; ys[lane] = akr; asm volatile("s_waitcnt lgkmcnt(0)" ::: "memory");
        { const int i = lane & 31; float sn, cs; sincos_rev((float)sq * inv_freq32(i), sn, cs); const float mine = ys[lane], other = ys[lane ^ 32];
          const float ref = (lane & 32) ? (mine * cs + other * sn) : (mine * cs - other * sn); const float got = bf2f(krope[(size_t)m * 64 + lane]);
          e2 += (got - ref) * (got - ref); r2 += ref * ref; }
    }
    e2 = wave_sum(e2); r2 = wave_sum(r2);
    if (lane == 0) { atomicAdd(dbg + 4 + 2 * L, e2); atomicAdd(dbg + 5 + 2 * L, r2); }
}
#endif
#ifndef ATT_ONLY
#define ATT_ONLY -1
#endif
#ifndef REP_K
#define REP_K -1
#endif
#ifndef REP_NULL
#define REP_NULL -1
#endif
#ifndef ABL_ATT
#define ABL_ATT -1
#endif
#ifndef REP_ATT
#define REP_ATT -1
#endif
#define NREP(k) ((REP_K == (k)) ? 2 : 1)
#define NREPA(k) ((REP_ATT == (k)) ? 2 : 1)
constexpr int N_PHASES = 20;
__global__ void __launch_bounds__(NTHR, 2) fwd(Params p) {
    extern __shared__ __attribute__((aligned(16))) unsigned char lds_raw[];
    LAS unsigned char* lds = (LAS unsigned char*)lds_raw;
    const int tid0 = threadIdx.x, bid = blockIdx.x, G = gridDim.x;
    const int wv = __builtin_amdgcn_readfirstlane(tid0 >> 6);
    const int vcu = (G % 8 == 0) ? (bid % 8) * (G / 8) + bid / 8 : bid;
    unsigned* ctl = (unsigned*)(p.ws + WS_CTL);
    if (tid0 < 4) ((LAS unsigned*)(lds + MISC_OFF))[tid0] = 0u;
    __syncthreads();
    XcdBarrier bar; bar.bar = ctl + CW_BAR; bar.x = 0; bar.st = (volatile LAS unsigned*)(lds + MISC_OFF);
    if (N_LAUNCH_MODE == 1) bar = xcd_barrier_post(ctl + CW_BAR, (volatile LAS unsigned*)(lds + MISC_OFF));
    const int lo = p.ph_lo, hi = p.ph_hi;
#ifndef PH_ONLY
#define PH_ONLY -1
#endif
#define IN(k) ((PH_ONLY < 0 || (PH_ONLY % 10) == ((k) % 10)) && lo <= (k) && (k) < hi)
#define SEAM(k) do { if ((k) + 1 < hi) xcd_barrier(bar, fresh_tid(wv)); } while (0)

    for (int L = 0; L < 2; ++L) {
        const int pb = L * 10;
        typedef __attribute__((address_space(1))) unsigned char gu8;
        typedef __attribute__((address_space(1))) const float gcf;
        typedef __attribute__((address_space(4))) const unsigned long long kcu64;
#define INP(i) ((const float*)(gcf*)ka[i])
#define PHASE_PTRS \
        kcu64* ka = (kcu64*)__builtin_amdgcn_kernarg_segment_ptr(); asm volatile("" : "+s"(ka)); \
        unsigned char* ws = (unsigned char*)(gu8*)ka[29]; unsigned char* outb = (unsigned char*)(gu8*)ka[28]; \
        unsigned* ctl = (unsigned*)(ws + WS_CTL); \
        bf16_t* RA = (bf16_t*)(ws + WS_RA); bf16_t* RB = (bf16_t*)(ws + WS_RB); bf16_t* RC = (bf16_t*)(ws + WS_RC); \
        int* list = (int*)(ws + WS_LIST); int* tok_e = (int*)(ws + WS_TOKE); int* tok_p = (int*)(ws + WS_TOKP); float* tok_g = (float*)(ws + WS_TOKG); \
        bf16_t* krope = (bf16_t*)(ws + WS_KROPE); \
        bf16_t* Qd = (bf16_t*)(outb + OUT_QD); bf16_t* O1 = (bf16_t*)(outb + OUT_O1); \
        const bf16_t* Win = (const bf16_t*)(ws + (L ? WS_WIN1 : WS_WIN0)); const bf16_t* Wout = (const bf16_t*)(ws + (L ? WS_WOUT1 : WS_WOUT0)); \
        const bf16_t* Wgu = (const bf16_t*)(ws + (L ? WS_WGU1 : WS_WGU0)); const bf16_t* Wd = (const bf16_t*)(ws + (L ? WS_WD1 : WS_WD0)); \
        const int NIN = L ? IN1P : IN0; \
        const bf16_t* xin = L ? RC : RA; \
        bf16_t* Hx = RB; bf16_t* Oat = L ? O1 : RC; float* Z = (float*)RB; \
        bf16_t* x1b = RA; bf16_t* Hm = RC; bf16_t* Yr = RB; \
        unsigned* cnt = ctl + CW_CNT + L * 64; \
        (void)ctl; (void)RA; (void)RB; (void)RC; (void)list; (void)tok_e; (void)tok_p; (void)tok_g; (void)krope; (void)Qd; (void)O1; (void)Win; (void)Wout; (void)Wgu; (void)Wd; (void)NIN; (void)xin; (void)Hx; (void)Oat; (void)Z; (void)x1b; (void)Hm; (void)Yr; (void)cnt; (void)outb

        if (L == 0 && IN(0)) { PHASE_PTRS; _Pragma("unroll 1") for (int rep = 0; rep < NREP(0); ++rep) phase_prologue(ka, ws, lds, G, bid, fresh_tid(wv)); SEAM(0); }

        if (IN(pb + 1)) {
            PHASE_PTRS;
            constexpr int KI = F8_IN ? 1024 : 2048;
            const bf16_t* ain = F8_IN ? (L ? (const bf16_t*)outb : (const bf16_t*)((unsigned char*)RC + 64 * MiB)) : xin;
            pg8::Gemm g{ain, Win, KI, KI, KI}; pg8::StaticOrder S; S.init(T_, NIN, G, bid, KI);
            pg8::EpiIn E{Hx, NIN, L ? ws + WS_WGU0 + 64 * MiB : (unsigned char*)RA, L ? ws + WS_WD0 + 32 * MiB : ws + WS_WGU1 + 64 * MiB, F8_SPARSE ? (L ? 4 : 10) : 99, F8_SPARSE ? (L ? 8 : 14) : 99, F8_SPARSE ? (L ? 12 : 18) : 99};
            _Pragma("unroll 1") for (int rep = 0; rep < NREP(1); ++rep) pg8::gemm_phase<F8_IN != 0>(wv, lds, g, S, E, F8_IN ? 1.0f / W8_SCALE : 1.0f);
#if REP_NULL == 1
            { pg8::EpiNull EN{(float*)(ctl + CW_DBG + 32)}; pg8::gemm_phase<F8_IN != 0>(wv, lds, g, S, EN, 1.0f / W8_SCALE); }
#endif
            SEAM(pb + 1);
        }
        if (IN(pb + 2)) {
            PHASE_PTRS;
            if (L == 0) { phase_prep_qk(Hx, INP(I_AQN), INP(I_AKN), ws + WS_WGU0 + 64 * MiB, G, bid, fresh_tid(wv));
                _Pragma("unroll 1") for (int rep = 0; rep < NREP(2); ++rep) {
                if (F8_ATTA) phase_vt8(Hx, ws + WS_WGU0 + 72 * MiB, lds, G, bid, fresh_tid(wv));
                if (F8_SPARSE) { unsigned char* ra8 = (unsigned char*)RA;
                    phase_vt_heads<true>(ws + WS_WGU1 + 64 * MiB, ra8 + 32 * MiB, ra8 + 64 * MiB, ra8 + 96 * MiB, lds, G, bid, fresh_tid(wv)); } } }
            else { phase_prep_mla(Hx, krope, ws + WS_WD1 + 32 * MiB, G, bid, fresh_tid(wv));
                if (F8_SPARSE) { unsigned char* c8 = ws + WS_WGU0 + 64 * MiB;
                    _Pragma("unroll 1") for (int rep = 0; rep < NREP(2); ++rep) phase_vt_heads<false>(ws + WS_WD0 + 32 * MiB, c8 + 32 * MiB, nullptr, nullptr, lds, G, bid, fresh_tid(wv)); } }
#if DBG_CHECK
            xcd_barrier(bar, fresh_tid(wv));
            dbg_prep_check(L, INP(I_X), RC, INP(L ? I_WIN1 : I_WIN0), INP(I_AQN), INP(I_AKN), Hx, krope, (float*)(ctl + CW_DBG), lds, bid, fresh_tid(wv));
            __syncthreads();
#endif
            SEAM(pb + 2);
        }
        if (L == 1 && IN(pb + 3)) _Pragma("unroll 1") for (int rep = 0; rep < NREP(3); ++rep) {
            PHASE_PTRS;
#ifndef P3_ONLY
#define P3_ONLY -1
#endif
            if (P3_ONLY < 0 || P3_ONLY == 0) { constexpr int KQ = F8_P3 ? 256 : 512; pg8::Gemm g{Hx + 3072, (const bf16_t*)(ws + WS_WQUP), KQ, IN1P, KQ}; pg8::StaticOrder S; S.init(T_, 1536, G, bid, IN1P);
              pg8::EpiBf16 E{Qd, 1536, 0xffff}; pg8::gemm_phase<F8_P3 != 0>(wv, lds, g, S, E, F8_P3 ? 1.0f / W8_SCALE : 1.0f); }
            if (P3_ONLY < 0 || P3_ONLY == 1) { constexpr int KV = F8_P3 ? 128 : 256; pg8::Gemm g{Hx + 3584, (const bf16_t*)(ws + WS_WKVUP), KV, IN1P, KV}; pg8::StaticOrder S; S.init(T_, 2048, G, bid, IN1P);
              if constexpr (F8_ATTD) { pg8::EpiKV8 E{ws + WS_WGU1 + 64 * MiB, ws + WS_WGU1 + 96 * MiB, RA, DBG_CHECK != 0}; pg8::gemm_phase<F8_P3 != 0>(wv, lds, g, S, E, F8_P3 ? 1.0f / W8_SCALE : 1.0f); }
              else { pg8::EpiBf16 E{RA, 2048, 0xffff}; pg8::gemm_phase<false>(wv, lds, g, S, E); } }
            if (rep + 1 == NREP(3)) SEAM(pb + 3);
        }
        if (IN(pb + 4)) {
            PHASE_PTRS;
            if (L == 0) {
                if (ATT_ONLY < 0 || ATT_ONLY == 0)
                _Pragma("unroll 1") for (int rep = 0; rep < NREPA(0); ++rep)
                for (int u = vcu; u < 1024; u += G) {
                    __syncthreads();
                    const int b = u >> 7, qb = u & 15, kvh = (u >> 6) & 1, gq = (u >> 4) & 3, h = kvh * 4 + gq;
                    if constexpr (F8_ATTA) {
                        d8::D8Args a; a.Q = Hx + (size_t)(b * SEQ + 256 * qb) * IN0 + h * 128; a.ldq = IN0;
                        a.K8 = ws + WS_WGU0 + 64 * MiB + (size_t)b * SEQ * 256 + kvh * 128; a.ldk = 256; a.Kr8 = nullptr;
                        a.Vt8 = ws + WS_WGU0 + 72 * MiB + (size_t)(b * 2 + kvh) * 128 * SEQ; a.ldvt = SEQ;
                        { const size_t eo = (size_t)(b * SEQ + 256 * qb) * DM + h * 128; a.O = F8_OUT ? (bf16_t*)((unsigned char*)Oat + eo) : Oat + eo; } a.ldo = DM; a.seq = SEQ; a.pos0 = 0;
                        if (D8_DMA_A) d8::attn_dense8_dma<2, true>(wv, a, lds); else d8::attn_dense8_body<2>(wv, a, (char*)lds_raw);
                    } else {
                    da::DArgs a; a.Q = Hx + (size_t)(b * SEQ + 256 * qb) * IN0 + h * 128; a.ldq = IN0;
                    a.K = Hx + (size_t)b * SEQ * IN0 + 1024 + kvh * 128; a.ldk = IN0; a.V = Hx + (size_t)b * SEQ * IN0 + 1280 + kvh * 128; a.ldv = IN0; a.Kr = nullptr;
                    { const size_t eo = (size_t)(b * SEQ + 256 * qb) * DM + h * 128; a.O = F8_OUT ? (bf16_t*)((unsigned char*)Oat + eo) : Oat + eo; } a.ldo = DM; a.seq = SEQ; a.pos0 = 0;
                    da::attn_dense_body<8, 1>(wv, a, (char*)lds_raw);
                    }
                }
                __syncthreads();
                if (ATT_ONLY < 0 || ATT_ONLY == 2)
                _Pragma("unroll 1") for (int rep = 0; rep < NREPA(2); ++rep)
                for (int it = vcu; it < 1024; it += G) {
                    const int tid2 = fresh_tid(wv), wid = __builtin_amdgcn_readfirstlane(tid2 >> 6), lane = tid2 & 63;
                    const int w = it * 8 + wid; LAS unsigned char* wl = lds + wid * da::SP_WAVE_LDS;
                    if constexpr (F8_SPARSE) { const unsigned char* ra8 = (const unsigned char*)RA; PolB8 pol; pol.init(Hx, Oat, ra8, ra8 + 32 * MiB, ra8 + 64 * MiB, ra8 + 96 * MiB, w, lane); d8::sparse8_wave(pol, wl, lane); }
                    else { PolB pol; pol.init(Hx, Oat, w, lane); da::sparse_wave(pol, wl, lane); }
                }
            } else {
                if (ATT_ONLY < 0 || ATT_ONLY == 1)
                _Pragma("unroll 1") for (int rep = 0; rep < NREPA(1); ++rep)
                for (int u = vcu; u < 1024; u += G) {
                    __syncthreads();
                    const int b = u >> 7, qb = u & 15, h = (u >> 4) & 7;
                    if constexpr (F8_ATTD) {
                        d8::D8Args a; a.Q = Qd + (size_t)(b * SEQ + 256 * qb) * 1536 + h * 192; a.ldq = 1536;
                        a.K8 = ws + WS_WGU1 + 64 * MiB + (size_t)b * SEQ * 1024 + h * 128; a.ldk = 1024; a.Kr8 = ws + WS_WD1 + 32 * MiB + (size_t)b * SEQ * 64;
                        a.Vt8 = ws + WS_WGU1 + 96 * MiB + (size_t)(b * 8 + h) * 128 * SEQ; a.ldvt = SEQ;
                        { const size_t eo = (size_t)(b * SEQ + 256 * qb) * DM + 1024 + h * 128; a.O = F8_OUT ? (bf16_t*)((unsigned char*)Oat + eo) : Oat + eo; } a.ldo = DM; a.seq = SEQ; a.pos0 = 256 * qb;
                        if (D8_DMA_D) d8::attn_dense8_dma<3, D8_MACC_D != 0>(wv, a, lds); else d8::attn_dense8_body<3>(wv, a, (char*)lds_raw);
                    } else {
                    da::DArgs a; a.Q = Qd + (size_t)(b * SEQ + 256 * qb) * 1536 + h * 192; a.ldq = 1536;
                    a.K = RA + (size_t)b * SEQ * DM + h * 256; a.ldk = DM; a.V = a.K + 128; a.ldv = DM; a.Kr = krope + (size_t)b * SEQ * 64;
                    { const size_t eo = (size_t)(b * SEQ + 256 * qb) * DM + 1024 + h * 128; a.O = F8_OUT ? (bf16_t*)((unsigned char*)Oat + eo) : Oat + eo; } a.ldo = DM; a.seq = SEQ; a.pos0 = 256 * qb;
                    da::attn_dense_body<12, 1>(wv, a, (char*)lds_raw);
                    }
                }
                __syncthreads();
                if (ATT_ONLY < 0 || ATT_ONLY == 3)
                _Pragma("unroll 1") for (int rep = 0; rep < NREPA(3); ++rep)
                for (int it = vcu; it < 1024; it += G) {
                    const int tid2 = fresh_tid(wv), wid = __builtin_amdgcn_readfirstlane(tid2 >> 6), lane = tid2 & 63;
                    const int w = it * 8 + wid; LAS unsigned char* wl = lds + wid * da::SP_WAVE_LDS;
                    if constexpr (F8_SPARSE) { const unsigned char* c8 = ws + WS_WGU0 + 64 * MiB; PolC8 pol; pol.init(Hx, Oat, c8, c8 + 32 * MiB, INP(I_RPB), (float*)((char*)wl + 16640), w, lane); d8::sparse8_wave(pol, wl, lane); }
                    else { PolC pol; pol.init(Hx, Oat, INP(I_RPB), (float*)((char*)wl + 16640), w, lane); da::sparse_wave(pol, wl, lane); }
                }
            }
#if DBG_CHECK
            xcd_barrier(bar, fresh_tid(wv));
            dbg_attn_check(L, Hx, Qd, RA, krope, Oat, (float*)(ctl + CW_DBG), lds, bid, fresh_tid(wv));
            __syncthreads();
            if (L == 0) dbg_sparse_check(0, Hx, (const unsigned char*)RA, ws + WS_WGU1 + 64 * MiB, INP(I_RPB), Oat, (float*)(ctl + CW_DBG), lds, bid, fresh_tid(wv));
            else dbg_sparse_check(1, Hx, ws + WS_WGU0 + 64 * MiB, ws + WS_WD0 + 32 * MiB, INP(I_RPB), Oat, (float*)(ctl + CW_DBG), lds, bid, fresh_tid(wv));
            __syncthreads();
#endif
            SEAM(pb + 4);
        }
        if (IN(pb + 5)) {
            PHASE_PTRS;
            constexpr int KO = F8_OUT ? 1024 : 2048;
            pg8::Gemm g{Oat, Wout, KO, KO, KO}; pg8::StaticOrder S; S.init(T_, DM, G, bid, KO);
            pg8::EpiBf16T<F8_MIX != 0> E{RB, DM, 0xffff};
            _Pragma("unroll 1") for (int rep = 0; rep < NREP(5); ++rep) pg8::gemm_phase<F8_OUT != 0>(wv, lds, g, S, E, F8_OUT ? 1.0f / (W8_SCALE * O8_SCALE) : 1.0f);
            SEAM(pb + 5);
        }
        if (IN(pb + 6)) {
            PHASE_PTRS;
            if (L == 0) { _Pragma("unroll 1") for (int rep = 0; rep < NREP(6); ++rep) phase_ln_router<true>(RB, INP(I_X), INP(I_LN1G0), INP(I_LN1B0), INP(I_RW), INP(I_RB), x1b, (unsigned char*)RC + 64 * MiB, tok_e, tok_p, tok_g, list, cnt, lds, G, bid, fresh_tid(wv), rep + 1 == NREP(6)); }
            else { _Pragma("unroll 1") for (int rep = 0; rep < NREP(6); ++rep) phase_ln_router<false>(RB, RC, INP(I_LN1G1), INP(I_LN1B1), INP(I_RW), INP(I_RB), x1b, outb  , tok_e, tok_p, tok_g, list, cnt, lds, G, bid, fresh_tid(wv), rep + 1 == NREP(6)); }
            SEAM(pb + 6);
        }
        if (IN(pb + 7)) {
            PHASE_PTRS;
            LAS int* pblk = (LAS int*)(lds + MOE_LDS); LAS int* tab = pblk + 64; LAS int* aux = tab + 32; LAS int* idx = aux + 64;
            const int tid = fresh_tid(wv);
            const int NB = moe_prefix(cnt, pblk, tid);
            const int n = moe_table<4>(cnt, pblk, tab, aux, NB, G, vcu, tid);
            for (int i = 0; i < n; ++i) if (tid < 256) { const int e = aux[i * 3], rs = aux[i * 3 + 1], ce = aux[i * 3 + 2]; idx[i * 256 + tid] = list[(size_t)e * 65536 + min(rs + tid, ce - 1)]; }
            __syncthreads();
            constexpr int KG = F8_GU ? 1024 : 2048;
            const bf16_t* agu = F8_GU ? (L ? (const bf16_t*)outb : (const bf16_t*)((unsigned char*)RC + 64 * MiB)) : x1b;
            pg8::Gemm g{agu, Wgu, KG, KG, KG}; pg8::TableOrder<true> S{tab, idx, n, KG}; pg8::EpiSiluMul<F8_DOWN != 0> E{Hm};
            _Pragma("unroll 1") for (int rep = 0; rep < NREP(7); ++rep) pg8::gemm_phase<F8_GU != 0>(wv, lds, g, S, E, F8_GU ? 1.0f / W8_SCALE : 1.0f);
            SEAM(pb + 7);
        }
        if (IN(pb + 8)) {
            PHASE_PTRS;
            LAS int* pblk = (LAS int*)(lds + MOE_LDS); LAS int* tab = pblk + 64; LAS int* aux = tab + 32;
            const int tid = fresh_tid(wv);
            const int NB = moe_prefix(cnt, pblk, tid);
            const int n = moe_table<8>(cnt, pblk, tab, aux, NB, G, vcu, tid);
            constexpr int KD = F8_DOWN ? 256 : 512;
            pg8::Gemm g{Hm, Wd, KD, KD, KD}; pg8::TableOrder<false> S{tab, nullptr, n, KD}; pg8::EpiBf16T<F8_YR != 0> E{Yr, DM, 7};
            _Pragma("unroll 1") for (int rep = 0; rep < NREP(8); ++rep) pg8::gemm_phase<F8_DOWN != 0>(wv, lds, g, S, E, F8_DOWN ? 1.0f / W8_SCALE : 1.0f);
            SEAM(pb + 8);
        }
        if (IN(pb + 9)) _Pragma("unroll 1") for (int rep = 0; rep < NREP(9); ++rep) {
            PHASE_PTRS;
            if (L == 0) phase_combine_ln<false>((const float*)(ctl + CW_DBG), x1b, Yr, tok_e, tok_p, tok_g, cnt, INP(I_LN2G0), INP(I_LN2B0), RC, outb, nullptr, lds, G, bid, fresh_tid(wv));
            else phase_combine_ln<true>((const float*)(ctl + CW_DBG), x1b, Yr, tok_e, tok_p, tok_g, cnt, INP(I_LN2G1), INP(I_LN2B1), nullptr, nullptr, (float*)outb, lds, G, bid, fresh_tid(wv));
            if (rep + 1 == NREP(9)) SEAM(pb + 9);
        }
    }
#undef IN
#undef SEAM
#undef INP
#undef PHASE_PTRS
}

extern "C" void kernel_launch(void* const* d_in, const int* in_sizes, int n_in, void* d_out, int out_size, void* d_ws, size_t ws_size, hipStream_t stream) {
    static int grid = 0;
    if (grid == 0) {
        if (n_in != 28 || out_size != T_ * DM || ws_size < WS_END) { fprintf(stderr, "kernel_launch: unexpected shapes: n_in %d out %d ws %zu (need %zu)\n", n_in, out_size, ws_size, (size_t)WS_END); grid = -1; return; }
        int dev = 0, cus = 0, per_cu = 0;
        if (hipGetDevice(&dev) != hipSuccess || hipDeviceGetAttribute(&cus, hipDeviceAttributeMultiprocessorCount, dev) != hipSuccess) { grid = -1; return; }
        if (hipFuncSetAttribute((const void*)fwd, hipFuncAttributeMaxDynamicSharedMemorySize, LDS_BYTES) != hipSuccess) { fprintf(stderr, "kernel_launch: hipFuncSetAttribute failed\n"); grid = -1; return; }
        if (hipOccupancyMaxActiveBlocksPerMultiprocessor(&per_cu, (const void*)fwd, NTHR, LDS_BYTES) != hipSuccess || per_cu < 1)
            fprintf(stderr, "kernel_launch: occupancy query reports %d workgroups per CU\n", per_cu);
        (void)hipGetLastError();
        grid = cus;
    }
    if (grid < 0) return;
    (void)hipMemsetAsync((char*)d_ws + WS_CTL, 0, CTL_ZERO_BYTES, stream);
    Params p{};
    for (int i = 0; i < 28; ++i) p.in[i] = (const float*)d_in[i];
    p.out = (float*)d_out; p.ws = (unsigned char*)d_ws;
#if N_LAUNCH_MODE == 1
    p.ph_lo = 0; p.ph_hi = N_PHASES;
    hipLaunchKernelGGL(fwd, dim3(grid), dim3(NTHR), LDS_BYTES, stream, p);
#else
    for (int k = 0; k < N_PHASES; ++k) { if (k == 3 || k == 10) continue; p.ph_lo = k; p.ph_hi = k + 1;
        hipLaunchKernelGGL(fwd, dim3(grid), dim3(NTHR), LDS_BYTES, stream, p); }
#endif
    const hipError_t le = hipPeekAtLastError();
    if (le != hipSuccess) fprintf(stderr, "kernel_launch: launch failed: %s\n", hipGetErrorName(le));
}
```
